# Optimizing an MI355X kernel written in HIP

```python
import jax, jax.numpy as jnp
from jax import lax
import numpy as np

D_MODEL = 1024
BATCH = 8
SEQ = 4096
DEPTH = 4

CHUNK = 64
PLE_DIM = 256
CONV_CH = 256
CONV_WIDTH = 31
GLA_HEADS = 6
GLA_DK = 32
GLA_DV = 64
GLA_GATE_RANK = 16
GLA_GATE_TAU = 16.0
FOX_HEADS = 6
FOX_DH = 64
FOX_BLOCK = 128
MIX_WIDTH = CONV_CH + GLA_HEADS * GLA_DV + FOX_HEADS * FOX_DH
PEER_HEADS = 8
PEER_NKEYS = 128
PEER_N = PEER_NKEYS * PEER_NKEYS
PEER_QDIM = 256
PEER_HALF = PEER_QDIM // 2
PEER_TOPK = 16
PEER_TOKEN_BLOCK = 128
DEEPNORM_ALPHA = (2.0 * DEPTH) ** 0.25
DEEPNORM_BETA = (8.0 * DEPTH) ** -0.25
LN_EPS = 1e-5
IN_SIZES = (CONV_CH, CONV_CH,
            GLA_HEADS * GLA_DK, GLA_HEADS * GLA_DK,
            GLA_HEADS * GLA_DV, GLA_HEADS * GLA_DV,
            GLA_GATE_RANK,
            FOX_HEADS * FOX_DH, FOX_HEADS * FOX_DH, FOX_HEADS * FOX_DH,
            FOX_HEADS)
IN_COLS = sum(IN_SIZES)
IN_SPLITS = tuple(int(s) for s in np.cumsum(IN_SIZES)[:-1])

kernel_name = "hybrid_conv_gla_fox_peer_deepnorm"


def layer_norm(x, g, b):
    xf = x.astype(jnp.float32)
    mu = jnp.mean(xf, axis=-1, keepdims=True)
    var = jnp.mean(jnp.square(xf - mu), axis=-1, keepdims=True)
    y = (xf - mu) * lax.rsqrt(var + LN_EPS)
    return (y * g.astype(jnp.float32) + b.astype(jnp.float32)).astype(x.dtype)


def conv_module(a_val, a_gate, w, bconv, g, b):
    u = a_val * jax.nn.sigmoid(a_gate)
    y = lax.conv_general_dilated(
        u, w[:, None, :].astype(u.dtype), window_strides=(1,),
        padding=[(CONV_WIDTH - 1, 0)],
        dimension_numbers=('NWC', 'WIO', 'NWC'),
        feature_group_count=CONV_CH) + bconv.astype(u.dtype)
    return jax.nn.silu(layer_norm(y, g, b))


def gla(q, k, v, g_out, lr, w2, b2, norm_g):
    bsz, s = q.shape[:2]
    n_chunks = s // CHUNK
    f32 = jnp.float32
    q = q.reshape(bsz, s, GLA_HEADS, GLA_DK).astype(f32) * (GLA_DK ** -0.5)
    k = k.reshape(bsz, s, GLA_HEADS, GLA_DK).astype(f32)
    v = v.reshape(bsz, s, GLA_HEADS, GLA_DV).astype(f32)
    gk = jax.nn.log_sigmoid((lr @ w2 + b2).astype(f32)) / GLA_GATE_TAU
    gk = gk.reshape(bsz, s, GLA_HEADS, GLA_DK)

    def to_chunks(t):
        return t.reshape(bsz, n_chunks, CHUNK, GLA_HEADS, t.shape[-1]).transpose(1, 0, 3, 2, 4)

    mask = jnp.tril(jnp.ones((CHUNK, CHUNK), dtype=bool))[:, :, None]

    def step(state, inp):
        qc, kc, vc, gc = inp
        cum = jnp.cumsum(gc, axis=2)
        inter = jnp.einsum('bhld,bhde->bhle', qc * jnp.exp(cum), state)
        diff = cum[:, :, :, None, :] - cum[:, :, None, :, :]
        decay = jnp.exp(jnp.where(mask, diff, -jnp.inf))
        attn = jnp.einsum('bhtd,bhsd,bhtsd->bhts', qc, kc, decay)
        intra = jnp.einsum('bhts,bhse->bhte', attn, vc)
        last = cum[:, :, -1:, :]
        k_dec = kc * jnp.exp(last - cum)
        new_state = state * jnp.exp(last[:, :, 0, :])[..., None] + \
            jnp.einsum('bhld,bhle->bhde', k_dec, vc)
        return new_state, inter + intra

    state0 = jnp.zeros((bsz, GLA_HEADS, GLA_DK, GLA_DV), f32)
    _, o = lax.scan(step, state0, (to_chunks(q), to_chunks(k), to_chunks(v), to_chunks(gk)))
    o = o.transpose(1, 0, 3, 2, 4).reshape(bsz, s, GLA_HEADS, GLA_DV)
    o = o * lax.rsqrt(jnp.mean(jnp.square(o), axis=-1, keepdims=True) + LN_EPS)
    o = o * norm_g.astype(f32).reshape(GLA_HEADS, GLA_DV)
    o = o.reshape(bsz, s, GLA_HEADS * GLA_DV) * jax.nn.silu(g_out.astype(f32))
    return o.astype(g_out.dtype)


def fox(q, k, v, f_logit, b_f):
    bsz, s = q.shape[:2]
    q = q.reshape(bsz, s, FOX_HEADS, FOX_DH)
    k = k.reshape(bsz, s, FOX_HEADS, FOX_DH)
    v = v.reshape(bsz, s, FOX_HEADS, FOX_DH)
    log_f = jax.nn.log_sigmoid(f_logit.astype(jnp.float32) + b_f.astype(jnp.float32))
    c = jnp.cumsum(log_f, axis=1).transpose(0, 2, 1)
    scale = FOX_DH ** -0.5
    outs = []
    for i in range(s // FOX_BLOCK):
        q0, q1 = i * FOX_BLOCK, (i + 1) * FOX_BLOCK
        sc = jnp.einsum('bqhd,bkhd->bhqk', q[:, q0:q1], k[:, :q1]).astype(jnp.float32) * scale
        sc = sc + c[:, :, q0:q1, None] - c[:, :, None, :q1]
        causal = jnp.arange(q0, q1)[:, None] >= jnp.arange(q1)[None, :]
        pr = jax.nn.softmax(jnp.where(causal, sc, -jnp.inf), axis=-1)
        outs.append(jnp.einsum('bhqk,bkhd->bqhd', pr.astype(v.dtype), v[:, :q1]))
    return jnp.concatenate(outs, axis=1).reshape(bsz, s, FOX_HEADS * FOX_DH)


def peer(x, wq, keys, u, v):
    bsz, s, d = x.shape
    qp = (x @ wq).reshape(bsz, s, PEER_HEADS, 2, PEER_HALF)
    sc = jnp.einsum('bshcd,hcnd->bshcn', qp, keys).astype(jnp.float32)
    sv, si = lax.top_k(sc, PEER_TOPK)
    cand = (sv[..., 0, :, None] + sv[..., 1, None, :]).reshape(bsz, s, PEER_HEADS, PEER_TOPK * PEER_TOPK)
    cv, ci = lax.top_k(cand, PEER_TOPK)
    i1 = jnp.take_along_axis(si[..., 0, :], ci // PEER_TOPK, axis=-1)
    i2 = jnp.take_along_axis(si[..., 1, :], ci % PEER_TOPK, axis=-1)
    n_tok = bsz * s
    n_blk = n_tok // PEER_TOKEN_BLOCK
    eidx = (i1 * PEER_NKEYS + i2).reshape(n_blk, PEER_TOKEN_BLOCK, PEER_HEADS * PEER_TOPK)
    gates = jax.nn.softmax(cv, axis=-1).reshape(n_blk, PEER_TOKEN_BLOCK, PEER_HEADS * PEER_TOPK)
    xt = x.reshape(n_blk, PEER_TOKEN_BLOCK, d)

    def block(args):
        xb, ib, gb = args
        h = jax.nn.gelu(jnp.einsum('td,tkd->tk', xb, u[ib]).astype(jnp.float32))
        return jnp.einsum('tk,tkd->td', (gb * h).astype(xb.dtype), v[ib])

    out = lax.map(block, (xt, eidx, gates))
    return out.reshape(bsz, s, d)


def setup_inputs(seed: int = 0) -> dict:
    key = jax.random.key(seed)
    ks = jax.random.split(key, 24)
    n = lambda k, shape: jax.random.normal(k, shape, jnp.float32)
    L, D = DEPTH, D_MODEL
    return {
        "x": n(ks[0], (BATCH, SEQ, D)),
        "p": n(ks[1], (DEPTH, BATCH, SEQ, PLE_DIM)),
        "w_in": n(ks[2], (L, D, IN_COLS)) * D ** -0.5,
        "conv_w": n(ks[3], (L, CONV_WIDTH, CONV_CH)) * CONV_WIDTH ** -0.5,
        "conv_b": 0.02 * n(ks[4], (L, CONV_CH)),
        "conv_ln_g": 1.0 + 0.02 * n(ks[5], (L, CONV_CH)),
        "conv_ln_b": 0.02 * n(ks[6], (L, CONV_CH)),
        "gla_gate_w": n(ks[7], (L, GLA_GATE_RANK, GLA_HEADS * GLA_DK)) * GLA_GATE_RANK ** -0.5,
        "gla_gate_b": 0.1 * n(ks[8], (L, GLA_HEADS * GLA_DK)),
        "gla_norm_g": 1.0 + 0.02 * n(ks[9], (L, GLA_HEADS * GLA_DV)),
        "fox_forget_b": 3.0 + 0.5 * n(ks[10], (L, FOX_HEADS)),
        "w_out": n(ks[11], (L, MIX_WIDTH, D)) * MIX_WIDTH ** -0.5 * DEEPNORM_BETA,
        "ln1_g": 1.0 + 0.02 * n(ks[12], (L, D)),
        "ln1_b": 0.02 * n(ks[13], (L, D)),
        "peer_wq": n(ks[14], (L, D, PEER_HEADS * PEER_QDIM)) * D ** -0.5,
        "peer_keys": n(ks[15], (L, PEER_HEADS, 2, PEER_NKEYS, PEER_HALF)) * PEER_HALF ** -0.5,
        "peer_u": n(ks[16], (L, PEER_N, D)) * D ** -0.5,
        "peer_v": n(ks[17], (L, PEER_N, D)) * DEEPNORM_BETA * PEER_HEADS ** -0.5,
        "ple_w": n(ks[18], (L, PLE_DIM, D)) * PLE_DIM ** -0.5 * DEEPNORM_BETA,
        "ple_gw": n(ks[19], (L, D, D)) * D ** -0.5,
        "ple_gb": 0.02 * n(ks[20], (L, D)),
        "ln2_g": 1.0 + 0.02 * n(ks[21], (L, D)),
        "ln2_b": 0.02 * n(ks[22], (L, D)),
    }


def reference(x, p, w_in, conv_w, conv_b, conv_ln_g, conv_ln_b, gla_gate_w, gla_gate_b, gla_norm_g,
              fox_forget_b, w_out, ln1_g, ln1_b, peer_wq, peer_keys, peer_u, peer_v,
              ple_w, ple_gw, ple_gb, ln2_g, ln2_b):
    for i in range(DEPTH):
        h = x @ w_in[i]
        (a_val, a_gate, b_q, b_k, b_v, b_g, b_lr, c_q, c_k, c_v, c_f) = jnp.split(h, IN_SPLITS, axis=-1)
        a_out = conv_module(a_val, a_gate, conv_w[i], conv_b[i], conv_ln_g[i], conv_ln_b[i])
        b_out = gla(b_q, b_k, b_v, b_g, b_lr, gla_gate_w[i], gla_gate_b[i], gla_norm_g[i])
        c_out = fox(c_q, c_k, c_v, c_f, fox_forget_b[i])
        mix = jnp.concatenate([a_out, b_out, c_out], axis=-1) @ w_out[i]
        x = layer_norm(DEEPNORM_ALPHA * x + mix, ln1_g[i], ln1_b[i])
        r = DEEPNORM_ALPHA * x + peer(x, peer_wq[i], peer_keys[i], peer_u[i], peer_v[i])
        r = r + jax.nn.sigmoid(r @ ple_gw[i] + ple_gb[i]) * (p[i] @ ple_w[i])
        x = layer_norm(r, ln2_g[i], ln2_b[i])
    return x
```

```cpp
#include <hip/hip_runtime.h>
#include <cstdio>
#include <cstdint>
#include <cstring>
#include <cmath>
namespace pg8 {
#define PG8_LAS __attribute__((address_space(3)))
typedef unsigned short bf16_t;
typedef short bf16x8 __attribute__((ext_vector_type(8)));
typedef float f32x4 __attribute__((ext_vector_type(4)));
typedef unsigned u32x4 __attribute__((ext_vector_type(4)));
constexpr int BM = 256, BK = 64, HALF = 128, HTB = HALF * BK * 2  , STAGE_BYTES = 8 * HTB, NXCD = 8, WGM = 8;

__host__ __device__ __forceinline__ int lds_byte(int r, int c) { const int st = (r >> 4) * 2 + (c >> 5), rr = r & 15, cc = c & 31, ob = rr * 64 + cc * 2; return st * 1024 + (ob ^ (((ob >> 9) & 1) << 5)); }
__host__ __device__ __forceinline__ void stage_rc(int b, int& R, int& C) { const int st = b / 1024, sb = b % 1024, swz = sb ^ (((sb >> 9) & 1) << 5); R = (st >> 1) * 16 + swz / 64; C = (st & 1) * 32 + (swz % 64) / 2; }
__host__ __device__ __forceinline__ int perm32(int rho) { const int n = rho >> 4, i = rho & 15; return 8 * (i >> 2) + 4 * n + (i & 3); }

struct Unit { int pm, pn; };
struct Gemm { const bf16_t* A; const bf16_t* Bt; int M, N, K; };

struct StaticOrder {
    int nM, nN, nwg, G, c;
    __host__ __device__ void init(int M, int N, int G_, int c_) { nM = M / BM; nN = N / BM; nwg = nM * nN; G = G_; c = c_; }
    __host__ __device__ bool next(int i, Unit& u) const {
        const long L = (long)i * G + c; if (L >= nwg) return false;
        int wgid = (int)L; { const int q = nwg / NXCD, r = nwg % NXCD, xcd = wgid % NXCD, off = wgid / NXCD; wgid = (xcd < r ? xcd * (q + 1) : r * (q + 1) + (xcd - r) * q) + off; }
        const int nig = WGM * nN, gid = wgid / nig, fm = gid * WGM, gsz = (nM - fm) < WGM ? (nM - fm) : WGM;
        u.pm = fm + ((wgid % nig) % gsz); u.pn = (wgid % nig) / gsz; return true;
    }
    __device__ __forceinline__ void a_ready(const Unit&) const {}
    __device__ __forceinline__ void done(const Unit&) const {}
};

__device__ __forceinline__ unsigned cvt_pk_bf16(float lo, float hi) { unsigned r; asm volatile("v_cvt_pk_bf16_f32 %0, %1, %2" : "=v"(r) : "v"(lo), "v"(hi)); return r; }
typedef float f32x2 __attribute__((ext_vector_type(2)));
__device__ __forceinline__ f32x2 gelu_pk(f32x2 v) {
    const f32x2 av = __builtin_elementwise_abs(v), d = av * 0.2316418882f + 1.0f;
    f32x2 t; t.x = __builtin_amdgcn_rcpf(d.x); t.y = __builtin_amdgcn_rcpf(d.y);
    f32x2 q = t * 0.5307027145f + (-0.7265760135f); q = q * t + 0.7107068705f; q = q * t + (-0.142248368f); q = q * t + 0.127414796f; q = q * t;
    const f32x2 s = (v * v) * (-0.72134752044f);
    f32x2 e; e.x = __builtin_amdgcn_exp2f(s.x); e.y = __builtin_amdgcn_exp2f(s.y);
    const f32x2 m = v * (q * e), r = v - m;
    f32x2 o; o.x = v.x < 0.f ? m.x : r.x; o.y = v.y < 0.f ? m.y : r.y; return o;
}

template <int ACT  > struct EpiBf16 {
    static constexpr bool PERM = true, AFTER_DRAIN = false; static_assert(ACT == 0 || ACT == 1, "EpiBf16: ACT is 0 (none) or 1 (gelu_pk)");
    bf16_t* O; int ldc; const float* bias; int split_cols; size_t split_stride; float scale0;
    __device__ __forceinline__ void operator()(const f32x4 (&acc)[2][2][4][2], const Unit& u, int wr, int wc, int fr, int fq) const {
        const int row0 = u.pm * BM + wr * 64 + fr; int colt = u.pn * BM; bf16_t* base = O;
        float sc = 1.f; if (split_cols) { const int t = colt / split_cols; base += (size_t)t * split_stride; colt -= t * split_cols; if (t == 0) sc = scale0; }
        const int col0 = colt + wc * 32 + 8 * fq, bcol0 = u.pn * BM + wc * 32 + 8 * fq;
        f32x4 bv[2][2];
#pragma unroll
        for (int bj = 0; bj < 2; ++bj)
#pragma unroll
            for (int n = 0; n < 2; ++n) bv[bj][n] = bias ? *(const f32x4*)(bias + bcol0 + bj * HALF + 4 * n) : (f32x4){0.f, 0.f, 0.f, 0.f};
#pragma unroll
        for (int ai = 0; ai < 2; ++ai)
#pragma unroll
            for (int m = 0; m < 4; ++m) { bf16_t* rowp = base + (size_t)(row0 + ai * HALF + m * 16) * ldc + col0;
#pragma unroll
                for (int bj = 0; bj < 2; ++bj) { f32x4 v0 = acc[ai][bj][m][0] + bv[bj][0], v1 = acc[ai][bj][m][1] + bv[bj][1];
                    if (ACT == 1) { f32x2 a = gelu_pk((f32x2){v0[0], v0[1]}), b = gelu_pk((f32x2){v0[2], v0[3]}), c = gelu_pk((f32x2){v1[0], v1[1]}), d = gelu_pk((f32x2){v1[2], v1[3]});
                        v0 = (f32x4){a.x, a.y, b.x, b.y}; v1 = (f32x4){c.x, c.y, d.x, d.y}; }
                    v0 = v0 * sc; v1 = v1 * sc; u32x4 w; w.x = cvt_pk_bf16(v0[0], v0[1]); w.y = cvt_pk_bf16(v0[2], v0[3]); w.z = cvt_pk_bf16(v1[0], v1[1]); w.w = cvt_pk_bf16(v1[2], v1[3]);
                    *(u32x4*)(rowp + bj * HALF) = w; } }
    }
};
struct EpiF32 {
    static constexpr bool PERM = true, AFTER_DRAIN = false;
    float* O; int ldc;
    __device__ __forceinline__ void operator()(const f32x4 (&acc)[2][2][4][2], const Unit& u, int wr, int wc, int fr, int fq) const {
        const int row0 = u.pm * BM + wr * 64 + fr, col0 = u.pn * BM + wc * 32 + 8 * fq;
#pragma unroll
        for (int ai = 0; ai < 2; ++ai)
#pragma unroll
            for (int m = 0; m < 4; ++m) { float* rowp = O + (size_t)(row0 + ai * HALF + m * 16) * ldc + col0;
#pragma unroll
                for (int bj = 0; bj < 2; ++bj) { *(f32x4*)(rowp + bj * HALF) = acc[ai][bj][m][0]; *(f32x4*)(rowp + bj * HALF + 4) = acc[ai][bj][m][1]; } }
    }
};
struct EpiResid {
    static constexpr bool PERM = true, AFTER_DRAIN = false;
    const float* res; float* Y; int ldc; float alpha;
    __device__ __forceinline__ void operator()(const f32x4 (&acc)[2][2][4][2], const Unit& u, int wr, int wc, int fr, int fq) const {
        const int row0 = u.pm * BM + wr * 64 + fr, col0 = u.pn * BM + wc * 32 + 8 * fq;
#pragma unroll
        for (int ai = 0; ai < 2; ++ai)
#pragma unroll
            for (int m = 0; m < 4; ++m) { const size_t off = (size_t)(row0 + ai * HALF + m * 16) * ldc + col0;
#pragma unroll
                for (int bj = 0; bj < 2; ++bj) { const f32x4 r0 = *(const f32x4*)(res + off + bj * HALF), r1 = *(const f32x4*)(res + off + bj * HALF + 4);
                    *(f32x4*)(Y + off + bj * HALF) = r0 * alpha + acc[ai][bj][m][0]; *(f32x4*)(Y + off + bj * HALF + 4) = r1 * alpha + acc[ai][bj][m][1]; } }
    }
};
struct EpiPle {
    static constexpr bool PERM = true, AFTER_DRAIN = false;
    const float* R; float* Y; const bf16_t* E; const float* gb; int ldc;
    __device__ __forceinline__ void operator()(const f32x4 (&acc)[2][2][4][2], const Unit& u, int wr, int wc, int fr, int fq) const {
        const int row0 = u.pm * BM + wr * 64 + fr, col0 = u.pn * BM + wc * 32 + 8 * fq;
        f32x4 bv[2][2];
#pragma unroll
        for (int bj = 0; bj < 2; ++bj)
#pragma unroll
            for (int n = 0; n < 2; ++n) bv[bj][n] = *(const f32x4*)(gb + col0 + bj * HALF + 4 * n);
#pragma unroll
        for (int ai = 0; ai < 2; ++ai)
#pragma unroll
            for (int m = 0; m < 4; ++m) { const size_t off = (size_t)(row0 + ai * HALF + m * 16) * ldc + col0;
#pragma unroll
                for (int bj = 0; bj < 2; ++bj) {
                    const u32x4 ev = *(const u32x4*)(E + off + bj * HALF);
#pragma unroll
                    for (int n = 0; n < 2; ++n) {
                        const f32x4 r = *(const f32x4*)(R + off + bj * HALF + 4 * n); const f32x4 z = acc[ai][bj][m][n] + bv[bj][n];
                        const unsigned e0 = n == 0 ? ev.x : ev.z, e1 = n == 0 ? ev.y : ev.w;
                        f32x4 e; e[0] = __uint_as_float(e0 << 16); e[1] = __uint_as_float(e0 & 0xffff0000u); e[2] = __uint_as_float(e1 << 16); e[3] = __uint_as_float(e1 & 0xffff0000u);
                        f32x4 o;
#pragma unroll
                        for (int i = 0; i < 4; ++i) o[i] = r[i] + e[i] / (1.0f + __expf(-z[i]));
                        *(f32x4*)(Y + off + bj * HALF + 4 * n) = o; } } }
    }
};
template <class Epi, class Sched, bool ALIGN_EPI = false, bool SP2 = false>
__device__ __forceinline__ void gemm_phase(PG8_LAS unsigned char* lds, const Gemm g, const Sched& S, const Epi& E) {
    const int tid = threadIdx.x, wid = __builtin_amdgcn_readfirstlane(tid >> 6), lane = tid & 63, wr = wid >> 2, wc = wid & 3, fr = lane & 15, fq = lane >> 4;
    const int K = g.K, nt = K / BK;
    unsigned voffA[2], voffB[2];
#pragma unroll
    for (int i = 0; i < 2; ++i) { int R, C; stage_rc(tid * 16 + i * 8192, R, C); const int Rb = Epi::PERM ? ((R & ~31) + perm32(R & 31)) : R;
        voffA[i] = (unsigned)(R * K + C) * 2u; voffB[i] = (unsigned)(Rb * K + C) * 2u; }
    const size_t kstep = (size_t)(BK * 2);
    const size_t hstep = (size_t)HALF * K * 2;
    const size_t tstep = 2 * hstep;
    const unsigned ldsw = (unsigned)wid * 1024u;
    const int aoff = lds_byte(wr * 64 + fr, fq * 8), boff = lds_byte(wc * 32 + fr, fq * 8);
#define PG8_SA(b, h) (((b) * 2 + (h)) * HTB)
#define PG8_SB(b, h) ((4 + (b) * 2 + (h)) * HTB)
#define PG8_STAGE(bufoff, gbase, voff) do { _Pragma("unroll") for (int _i = 0; _i < 2; ++_i) \
        __builtin_amdgcn_global_load_lds((const unsigned*)((const char*)(gbase) + (voff)[_i]), (PG8_LAS unsigned*)(lds + (bufoff) + ldsw + _i * 8192), 16, 0, 0); } while (0)
#define PG8_LDA(dst, b, h) do { _Pragma("unroll") for (int m = 0; m < 4; ++m) _Pragma("unroll") for (int k = 0; k < 2; ++k) dst[m][k] = *(const PG8_LAS bf16x8*)(lds + PG8_SA(b, h) + aoff + m * 2048 + k * 1024); } while (0)
#define PG8_LDB(dst, b, h) do { _Pragma("unroll") for (int n = 0; n < 2; ++n) _Pragma("unroll") for (int k = 0; k < 2; ++k) dst[n][k] = *(const PG8_LAS bf16x8*)(lds + PG8_SB(b, h) + boff + n * 2048 + k * 1024); } while (0)
#define PG8_MMA(ai, bj, At, Bt) do { __builtin_amdgcn_s_setprio(1); _Pragma("unroll") for (int m = 0; m < 4; ++m) _Pragma("unroll") for (int n = 0; n < 2; ++n) _Pragma("unroll") for (int k = 0; k < 2; ++k) \
        acc[ai][bj][m][n] = __builtin_amdgcn_mfma_f32_16x16x32_bf16(Bt[n][k], At[m][k], acc[ai][bj][m][n], 0, 0, 0); __builtin_amdgcn_s_setprio(0); } while (0)
#define PG8_WAIT_V(n) asm volatile("s_waitcnt vmcnt(" #n ")" ::: "memory")
#define PG8_WAIT_L(n) asm volatile("s_waitcnt lgkmcnt(" #n ")" ::: "memory")
#define PG8_BAR __builtin_amdgcn_s_barrier()
#define PG8_SCHED __builtin_amdgcn_sched_barrier(0)
    Unit cur, nxt; int ui = 0;
    if (!S.next(0, cur)) return;
    f32x4 acc[2][2][4][2];
#pragma unroll
    for (int a = 0; a < 2; ++a)
#pragma unroll
        for (int b = 0; b < 2; ++b)
#pragma unroll
            for (int m = 0; m < 4; ++m)
#pragma unroll
                for (int n = 0; n < 2; ++n) acc[a][b][m][n] = (f32x4){0.f, 0.f, 0.f, 0.f};
    bf16x8 At[4][2], B0[2][2], B1[2][2];
    const char* cA = (const char*)g.A + (size_t)cur.pm * tstep; const char* cB = (const char*)g.Bt + (size_t)cur.pn * tstep;
    S.a_ready(cur);
    if constexpr (SP2) {
        PG8_STAGE(PG8_SB(0, 0), cB, voffB); PG8_STAGE(PG8_SB(0, 1), cB + hstep, voffB); PG8_STAGE(PG8_SA(0, 0), cA, voffA); PG8_STAGE(PG8_SA(0, 1), cA + hstep, voffA);
        if (wr == 1) PG8_BAR;
        PG8_WAIT_V(2); PG8_BAR;
        PG8_STAGE(PG8_SB(1, 0), cB + kstep, voffB); PG8_STAGE(PG8_SA(1, 0), cA + kstep, voffA); PG8_STAGE(PG8_SB(1, 1), cB + hstep + kstep, voffB);
        PG8_WAIT_V(6); PG8_BAR;
    } else {
        PG8_STAGE(PG8_SB(0, 0), cB, voffB); PG8_STAGE(PG8_SA(0, 0), cA, voffA); PG8_STAGE(PG8_SB(0, 1), cB + hstep, voffB); PG8_STAGE(PG8_SA(0, 1), cA + hstep, voffA);
        if (wr == 1) PG8_BAR;
        PG8_WAIT_V(4); PG8_BAR;
        PG8_STAGE(PG8_SB(1, 0), cB + kstep, voffB); PG8_STAGE(PG8_SA(1, 0), cA + kstep, voffA); PG8_STAGE(PG8_SB(1, 1), cB + hstep + kstep, voffB);
        PG8_WAIT_V(6); PG8_BAR;
    }
    for (;;) {
        const bool has_next = S.next(ui + 1, nxt);
        const char* nA = has_next ? (const char*)g.A + (size_t)nxt.pm * tstep : cA; const char* nB = has_next ? (const char*)g.Bt + (size_t)nxt.pn * tstep : cB;
        for (int t = 0; t < nt; t += 2) {
            const bool last = (t == nt - 2);
            const char* a1 = cA + (size_t)(t + 1) * kstep;
            const char* a2 = last ? nA : cA + (size_t)(t + 2) * kstep; const char* b2 = last ? nB : cB + (size_t)(t + 2) * kstep;
            const char* a3 = a2 + kstep; const char* b3 = b2 + kstep;
            if (last && has_next) S.a_ready(nxt);
            if constexpr (SP2) {
            PG8_LDB(B0, 0, 0); PG8_LDB(B1, 0, 1); PG8_SCHED; PG8_LDA(At, 0, 0); PG8_STAGE(PG8_SA(1, 1), a1 + hstep, voffA);
            PG8_WAIT_V(8); PG8_WAIT_L(0); PG8_BAR; PG8_MMA(0, 0, At, B0); PG8_MMA(0, 1, At, B1); PG8_BAR; PG8_SCHED;
            PG8_LDA(At, 0, 1); PG8_STAGE(PG8_SB(0, 0), b2, voffB); PG8_STAGE(PG8_SB(0, 1), b2 + hstep, voffB); PG8_STAGE(PG8_SA(0, 0), a2, voffA);
            PG8_WAIT_V(8); PG8_WAIT_L(0); PG8_BAR; PG8_MMA(1, 0, At, B0); PG8_MMA(1, 1, At, B1); PG8_BAR; PG8_SCHED;
            PG8_LDB(B0, 1, 0); PG8_LDB(B1, 1, 1); PG8_SCHED; PG8_LDA(At, 1, 0); PG8_STAGE(PG8_SA(0, 1), a2 + hstep, voffA);
            PG8_WAIT_V(8); PG8_WAIT_L(0); PG8_BAR; PG8_MMA(0, 0, At, B0); PG8_MMA(0, 1, At, B1); PG8_BAR; PG8_SCHED;
            PG8_LDA(At, 1, 1); PG8_STAGE(PG8_SB(1, 0), b3, voffB); PG8_STAGE(PG8_SB(1, 1), b3 + hstep, voffB); PG8_STAGE(PG8_SA(1, 0), a3, voffA);
            PG8_WAIT_V(8); PG8_WAIT_L(0); PG8_BAR; PG8_MMA(1, 0, At, B0); PG8_MMA(1, 1, At, B1); PG8_BAR; PG8_SCHED;
            } else {
            PG8_LDB(B0, 0, 0); PG8_SCHED; PG8_LDA(At, 0, 0); PG8_STAGE(PG8_SA(1, 1), a1 + hstep, voffA);
            PG8_WAIT_L(8); PG8_BAR; PG8_WAIT_L(0); PG8_MMA(0, 0, At, B0); PG8_BAR; PG8_SCHED;
            PG8_LDB(B1, 0, 1); PG8_STAGE(PG8_SB(0, 0), b2, voffB);
            PG8_BAR; PG8_WAIT_L(0); PG8_MMA(0, 1, At, B1); PG8_BAR;
            PG8_LDA(At, 0, 1); PG8_STAGE(PG8_SA(0, 0), a2, voffA);
            PG8_BAR; PG8_WAIT_L(0); PG8_MMA(1, 0, At, B0); PG8_BAR; PG8_SCHED;
            PG8_STAGE(PG8_SB(0, 1), b2 + hstep, voffB);
            PG8_WAIT_V(6); PG8_BAR; PG8_MMA(1, 1, At, B1); PG8_BAR;
            PG8_LDB(B0, 1, 0); PG8_SCHED; PG8_LDA(At, 1, 0); PG8_STAGE(PG8_SA(0, 1), a2 + hstep, voffA);
            PG8_WAIT_L(8); PG8_BAR; PG8_WAIT_L(0); PG8_MMA(0, 0, At, B0); PG8_BAR; PG8_SCHED;
            PG8_LDB(B1, 1, 1); PG8_STAGE(PG8_SB(1, 0), b3, voffB);
            PG8_BAR; PG8_WAIT_L(0); PG8_MMA(0, 1, At, B1); PG8_BAR;
            PG8_LDA(At, 1, 1); PG8_STAGE(PG8_SA(1, 0), a3, voffA);
            PG8_BAR; PG8_WAIT_L(0); PG8_MMA(1, 0, At, B0); PG8_BAR; PG8_SCHED;
            PG8_STAGE(PG8_SB(1, 1), b3 + hstep, voffB);
            PG8_WAIT_V(6); PG8_BAR; PG8_MMA(1, 1, At, B1); PG8_BAR;
            }
        }
        if constexpr (ALIGN_EPI) { if (wr == 0) PG8_BAR; }
        if constexpr (!Epi::AFTER_DRAIN) { E(acc, cur, wr, wc, fr, fq); S.done(cur); }
        if (!has_next) break;
#pragma unroll
        for (int a = 0; a < 2; ++a)
#pragma unroll
            for (int b = 0; b < 2; ++b)
#pragma unroll
                for (int m = 0; m < 4; ++m)
#pragma unroll
                    for (int n = 0; n < 2; ++n) acc[a][b][m][n] = (f32x4){0.f, 0.f, 0.f, 0.f};
        cur = nxt; cA = nA; cB = nB; ++ui;
        if constexpr (ALIGN_EPI) { if (wr == 1) PG8_BAR; }
    }
    PG8_WAIT_V(0);
    if constexpr (!ALIGN_EPI) { if (wr == 0) PG8_BAR; }
    PG8_BAR;
    if constexpr (Epi::AFTER_DRAIN) { E.fused(acc, cur, wr, wc, fr, fq, lds, wid, lane); S.done(cur); }
#undef PG8_SA
#undef PG8_SB
#undef PG8_STAGE
#undef PG8_LDA
#undef PG8_LDB
#undef PG8_MMA
#undef PG8_WAIT_V
#undef PG8_WAIT_L
#undef PG8_BAR
#undef PG8_SCHED
}
}

constexpr int NB = 8, SEQ = 4096, T = NB * SEQ, D = 1024, DEPTH = 4;
constexpr int HCOLS = 3072;
constexpr int HC_AVAL = 0, HC_AGATE = 256, HC_BQ = 512, HC_BK = 704, HC_BV = 896, HC_BG = 1280, HC_CQ = 1664, HC_CK = 2048, HC_CV = 2432, HC_LR = 2816, HC_CF = 2832;
constexpr int IN_COLS = 2838;
constexpr int MC_A = 0, MC_B = 256, MC_C = 640;
constexpr float LN_EPS = 1e-5f;
constexpr float ALPHA = 1.6817928305074292f;
constexpr float LOG2E = 1.4426950408889634f;
constexpr float C2 = 0.125f * LOG2E;
constexpr float GLA_QSCALE = 0.17677669529663687f;
constexpr int NEXP = 16384;

constexpr size_t MiB = 1u << 20;
constexpr size_t WS_CTL = 0, CTL_ZERO_BYTES = 1 * MiB;
constexpr size_t WS_WIN = 1 * MiB;
constexpr size_t WS_WOUT = WS_WIN + 24 * MiB;
constexpr size_t WS_WP = WS_WOUT + 8 * MiB;
constexpr size_t WS_PGW = WS_WP + 16 * MiB;
constexpr size_t WS_PW = WS_PGW + 8 * MiB;
constexpr size_t WS_CK = WS_PW + 2 * MiB;
constexpr size_t WS_U = WS_CK + 1 * MiB;
constexpr size_t WS_V = WS_U + 32 * MiB;
constexpr size_t WS_XB = WS_V + 32 * MiB;
constexpr size_t WS_XF = WS_XB + 64 * MiB;
constexpr size_t WS_PB = WS_XF + 128 * MiB;
constexpr size_t WS_H = WS_PB + 16 * MiB;
constexpr size_t WS_MIX = WS_H + 192 * MiB;
constexpr size_t WS_SC = WS_H;
constexpr size_t WS_Y = WS_MIX + 64 * MiB;
constexpr size_t WS_GCUM = WS_Y;
constexpr size_t WS_GS = WS_GCUM + 24 * MiB;
constexpr size_t WS_GDEC = WS_GS + 24 * MiB;
constexpr size_t WS_E = WS_Y + 128 * MiB;
constexpr size_t WS_EIDX = WS_E + 64 * MiB;
constexpr size_t WS_GATE = WS_EIDX + 16 * MiB;
constexpr size_t WS_END = WS_GATE + 16 * MiB;
static_assert(WS_END <= 1024 * MiB, "d_ws map");

constexpr int LDS_BYTES = 147456;

typedef unsigned short bf16;
typedef float f32x4 __attribute__((ext_vector_type(4)));
typedef unsigned u32x4 __attribute__((ext_vector_type(4)));
typedef unsigned u32x2 __attribute__((ext_vector_type(2)));

struct Params {
    const float *x, *p, *w_in, *conv_w, *conv_b, *conv_ln_g, *conv_ln_b, *gla_gate_w, *gla_gate_b, *gla_norm_g, *fox_forget_b, *w_out, *ln1_g, *ln1_b,
        *peer_wq, *peer_keys, *peer_u, *peer_v, *ple_w, *ple_gw, *ple_gb, *ln2_g, *ln2_b;
    float* out; unsigned char* ws;
};

__device__ __forceinline__ float bf2f(unsigned h) { return __uint_as_float(h << 16); }
__device__ __forceinline__ unsigned f2bf(float f) { unsigned u = __float_as_uint(f); return (u + 0x7fffu + ((u >> 16) & 1u)) >> 16; }
__device__ __forceinline__ unsigned pk2(float lo, float hi) { return f2bf(lo) | (f2bf(hi) << 16); }
__device__ __forceinline__ float wave_sum(float v) {
#pragma unroll
    for (int o = 1; o < 64; o <<= 1) v += __shfl_xor(v, o);
    return v;
}
__device__ __forceinline__ float log_sigmoid(float z) { return fminf(z, 0.f) - log1pf(__expf(-fabsf(z))); }
__device__ __forceinline__ float sigmoidf_(float z) { return 1.0f / (1.0f + __expf(-z)); }

struct MapIdent { __device__ __forceinline__ void operator()(int n, int& c, float& s) const { c = n; s = 1.f; } };
struct MapWin {
    __device__ __forceinline__ void operator()(int n, int& c, float& s) const {
        s = 1.f;
        if (n < HC_CQ) { c = n; if (n >= HC_BQ && n < HC_BK) s = GLA_QSCALE; }
        else if (n < HC_LR) { c = n + 16; if (n < HC_CK) s = C2; }
        else if (n < HC_CF) c = n - HC_LR + 1664;
        else if (n < IN_COLS) c = n;
        else c = -1;
    }
};
template <class CM>
__device__ __forceinline__ void transpose_item(const float* W, int K, int Nsrc, bf16* WT, int item, int nblk, float* scr, int lane, const CM& cm) {
    const int kb = item / nblk, nb = item % nblk, k0 = 64 * kb, n0 = 32 * nb;
    int sc; float scale; cm(n0 + (lane & 31), sc, scale);
#pragma unroll 8
    for (int i = 0; i < 32; ++i) { const int kk = 2 * i + (lane >> 5); scr[kk * 33 + (lane & 31)] = sc >= 0 ? W[(size_t)(k0 + kk) * Nsrc + sc] * scale : 0.f; }
    __builtin_amdgcn_wave_barrier(); asm volatile("s_waitcnt lgkmcnt(0)" ::: "memory");
    const int c = lane & 7;
#pragma unroll
    for (int j = 0; j < 4; ++j) { const int n = (lane >> 3) + 8 * j; const float* s = scr + (8 * c) * 33 + n;
        u32x4 o; o.x = pk2(s[0 * 33], s[1 * 33]); o.y = pk2(s[2 * 33], s[3 * 33]); o.z = pk2(s[4 * 33], s[5 * 33]); o.w = pk2(s[6 * 33], s[7 * 33]);
        *(u32x4*)(WT + (size_t)(n0 + n) * K + k0 + 8 * c) = o; }
    asm volatile("s_waitcnt lgkmcnt(0)" ::: "memory"); __builtin_amdgcn_wave_barrier();
}
__device__ __forceinline__ void cvt_bf16_stream(const float* src, bf16* dst, size_t n8, size_t gtid, size_t gthreads) {
    for (size_t i = gtid; i < n8; i += gthreads) { const f32x4 a = *(const f32x4*)(src + i * 8), b = *(const f32x4*)(src + i * 8 + 4);
        u32x4 o; o.x = pk2(a[0], a[1]); o.y = pk2(a[2], a[3]); o.z = pk2(b[0], b[1]); o.w = pk2(b[2], b[3]); *(u32x4*)(dst + i * 8) = o; }
}

__device__ __forceinline__ void phase_pro_a(const Params& p, unsigned char* lds) {
    const int tid = threadIdx.x, lane = tid & 63, wave = tid >> 6;
    float* scr = (float*)(lds + wave * 16384);
    const int gw = blockIdx.x * 8 + wave, NGW = gridDim.x * 8;
    constexpr int I_WIN = (D / 64) * (HCOLS / 32), I_SQ = (D / 64) * (D / 32), I_PW = (256 / 64) * (D / 32);
    constexpr int PER_L = I_WIN + 2 * I_SQ + I_PW;
    for (int it = gw; it < DEPTH * PER_L; it += NGW) {
        const int l = it / PER_L; int r = it % PER_L;
        if (r < I_WIN) { transpose_item(p.w_in + (size_t)l * D * IN_COLS, D, IN_COLS, (bf16*)(p.ws + WS_WIN) + (size_t)l * HCOLS * D, r, HCOLS / 32, scr, lane, MapWin()); continue; } r -= I_WIN;
        if (r < I_SQ) { transpose_item(p.w_out + (size_t)l * D * D, D, D, (bf16*)(p.ws + WS_WOUT) + (size_t)l * D * D, r, D / 32, scr, lane, MapIdent()); continue; } r -= I_SQ;
        if (r < I_SQ) { transpose_item(p.ple_gw + (size_t)l * D * D, D, D, (bf16*)(p.ws + WS_PGW) + (size_t)l * D * D, r, D / 32, scr, lane, MapIdent()); continue; } r -= I_SQ;
        transpose_item(p.ple_w + (size_t)l * 256 * D, 256, D, (bf16*)(p.ws + WS_PW) + (size_t)l * D * 256, r, D / 32, scr, lane, MapIdent());
    }
    cvt_bf16_stream(p.x, (bf16*)(p.ws + WS_XB), (size_t)T * D / 8, (size_t)blockIdx.x * 512 + tid, (size_t)gridDim.x * 512);
}
__device__ __forceinline__ void phase_pro_b(const Params& p, unsigned char* lds) {
    const int tid = threadIdx.x;
    float* ks = (float*)lds;
    float* wqs = ks + 128 * 129;
    for (int it = blockIdx.x; it < DEPTH * 16 * 16; it += gridDim.x) {
        const int l = it >> 8, hc = (it >> 4) & 15, kt = it & 15;
        const float* keys = p.peer_keys + ((size_t)l * 16 + hc) * 16384;
        const float* wq = p.peer_wq + (size_t)l * D * 2048 + (size_t)(kt * 64) * 2048 + hc * 128;
        __syncthreads();
        for (int i = tid; i < 128 * 128; i += 512) ks[(i >> 7) * 129 + (i & 127)] = keys[i];
        for (int i = tid; i < 64 * 128; i += 512) wqs[(i >> 7) * 129 + (i & 127)] = wq[(size_t)(i >> 7) * 2048 + (i & 127)];
        __syncthreads();
        const int k = tid & 63, n0 = (tid >> 6) * 16;
        float acc[16];
#pragma unroll
        for (int j = 0; j < 16; ++j) acc[j] = 0.f;
        for (int d = 0; d < 128; ++d) { const float a = wqs[k * 129 + d];
#pragma unroll
            for (int j = 0; j < 16; ++j) acc[j] += a * ks[(n0 + j) * 129 + d]; }
        bf16* WpT = (bf16*)(p.ws + WS_WP) + (size_t)l * 2048 * D;
#pragma unroll
        for (int j = 0; j < 16; ++j) WpT[(size_t)(hc * 128 + n0 + j) * D + kt * 64 + k] = (bf16)f2bf(acc[j]);
    }
}
__device__ __forceinline__ void phase_cvt(const Params& p, int l) {
    const size_t gtid = (size_t)blockIdx.x * 512 + threadIdx.x, gth = (size_t)gridDim.x * 512;
    cvt_bf16_stream(p.p + (size_t)l * T * 256, (bf16*)(p.ws + WS_PB), (size_t)T * 256 / 8, gtid, gth);
    cvt_bf16_stream(p.peer_u + (size_t)l * NEXP * D, (bf16*)(p.ws + WS_U), (size_t)NEXP * D / 8, gtid, gth);
    cvt_bf16_stream(p.peer_v + (size_t)l * NEXP * D, (bf16*)(p.ws + WS_V), (size_t)NEXP * D / 8, gtid, gth);
}

#define GEMM_RUN(EPI, e, Aptr, Bptr, N_, K_) do { pg8::Gemm g{(const pg8::bf16_t*)(Aptr), (const pg8::bf16_t*)(Bptr), T, (N_), (K_)}; pg8::StaticOrder S; S.init(T, (N_), (int)gridDim.x, (int)blockIdx.x); \
    pg8::gemm_phase<EPI, pg8::StaticOrder, true, true>((PG8_LAS unsigned char*)lds, g, S, e); } while (0)

__device__ __forceinline__ void phase_gemm_in(const Params& p, int l, unsigned char* lds) {
    pg8::EpiBf16<0> e{(pg8::bf16_t*)(p.ws + WS_H), HCOLS, nullptr, 0, 0, 1.f};
    GEMM_RUN(pg8::EpiBf16<0>, e, p.ws + WS_XB, (bf16*)(p.ws + WS_WIN) + (size_t)l * HCOLS * D, HCOLS, D);
}
__device__ __forceinline__ void phase_gemm_e(const Params& p, int l, unsigned char* lds) {
    pg8::EpiBf16<0> e{(pg8::bf16_t*)(p.ws + WS_E), D, nullptr, 0, 0, 1.f};
    GEMM_RUN(pg8::EpiBf16<0>, e, p.ws + WS_PB, (bf16*)(p.ws + WS_PW) + (size_t)l * D * 256, D, 256);
}
__device__ __forceinline__ void phase_gemm_out(const Params& p, int l, unsigned char* lds) {
    pg8::EpiResid e{l == 0 ? p.x : (const float*)(p.ws + WS_XF), (float*)(p.ws + WS_Y), D, ALPHA};
    GEMM_RUN(pg8::EpiResid, e, p.ws + WS_MIX, (bf16*)(p.ws + WS_WOUT) + (size_t)l * D * D, D, D);
}
__device__ __forceinline__ void phase_gemm_sc(const Params& p, int l, unsigned char* lds) {
    pg8::EpiF32 e{(float*)(p.ws + WS_SC), 2048};
    GEMM_RUN(pg8::EpiF32, e, p.ws + WS_XB, (bf16*)(p.ws + WS_WP) + (size_t)l * 2048 * D, 2048, D);
}
__device__ __forceinline__ void phase_gemm_ple(const Params& p, int l, unsigned char* lds) {
    pg8::EpiPle e{(const float*)(p.ws + WS_Y), (float*)(p.ws + WS_Y), (const pg8::bf16_t*)(p.ws + WS_E), p.ple_gb + (size_t)l * D, D};
    GEMM_RUN(pg8::EpiPle, e, p.ws + WS_XB, (bf16*)(p.ws + WS_PGW) + (size_t)l * D * D, D, D);
}

__device__ __forceinline__ void phase_conv(const Params& p, int l, unsigned char* lds) {
    const int tid = threadIdx.x, lane = tid & 63, wave = tid >> 6;
    float* U = (float*)lds;
    float* Yt = U + 62 * 256;
    const bf16* H = (const bf16*)(p.ws + WS_H); bf16* MIX = (bf16*)(p.ws + WS_MIX);
    const float* cw = p.conv_w + (size_t)l * 31 * 256; const float* cb = p.conv_b + l * 256;
    const float* lg = p.conv_ln_g + l * 256; const float* lb = p.conv_ln_b + l * 256;
    for (int it = blockIdx.x; it < T / 32; it += gridDim.x) {
        const int b = it / (SEQ / 32), t0 = (it % (SEQ / 32)) * 32;
        __syncthreads();
        for (int i = tid; i < 62 * 256; i += 512) { const int r = i >> 8, c = i & 255, t = t0 - 30 + r; float u = 0.f;
            if (t >= 0) { const bf16* hr = H + (size_t)(b * SEQ + t) * HCOLS; const float a = bf2f(hr[HC_AVAL + c]), g = bf2f(hr[HC_AGATE + c]); u = a * sigmoidf_(g); }
            U[i] = u; }
        __syncthreads();
        { const int c = tid & 255, half = tid >> 8; float w[31];
#pragma unroll
          for (int j = 0; j < 31; ++j) w[j] = cw[j * 256 + c];
          const float bias = cb[c];
          for (int tl = half * 16; tl < half * 16 + 16; ++tl) { float y = bias;
#pragma unroll
              for (int j = 0; j < 31; ++j) y += w[j] * U[(tl + j) * 256 + c];
              Yt[tl * 256 + c] = y; } }
        __syncthreads();
        for (int tl = wave * 4; tl < wave * 4 + 4; ++tl) {
            const f32x4 v = *(const f32x4*)(Yt + tl * 256 + lane * 4);
            const float mean = wave_sum((v[0] + v[1]) + (v[2] + v[3])) * (1.f / 256.f);
            const f32x4 d = v - mean; const float var = wave_sum((d[0] * d[0] + d[1] * d[1]) + (d[2] * d[2] + d[3] * d[3])) * (1.f / 256.f);
            const float rstd = 1.0f / sqrtf(var + LN_EPS);
            const f32x4 g4 = *(const f32x4*)(lg + lane * 4), b4 = *(const f32x4*)(lb + lane * 4);
            float o[4];
#pragma unroll
            for (int i = 0; i < 4; ++i) { const float z = d[i] * rstd * g4[i] + b4[i]; o[i] = z * sigmoidf_(z); }
            u32x2 w2; w2.x = pk2(o[0], o[1]); w2.y = pk2(o[2], o[3]);
            *(u32x2*)(MIX + (size_t)(b * SEQ + t0 + tl) * D + MC_A + lane * 4) = w2;
        }
    }
}

__device__ __forceinline__ void phase_fox_cum(const Params& p, int l, unsigned char* lds) {
    const int tid = threadIdx.x, lane = tid & 63, wave = tid >> 6;
    float* wsum = (float*)lds;
    const bf16* H = (const bf16*)(p.ws + WS_H); float* CK = (float*)(p.ws + WS_CK);
    for (int bh = blockIdx.x; bh < 48; bh += gridDim.x) {
        const int b = bh / 6, h = bh % 6; const float bias = p.fox_forget_b[l * 6 + h];
        float v[8]; float s = 0.f;
#pragma unroll
        for (int i = 0; i < 8; ++i) { const float f = bf2f(H[(size_t)(b * SEQ + tid * 8 + i) * HCOLS + HC_CF + h]); s += log_sigmoid(f + bias) * LOG2E; v[i] = s; }
        float incl = s;
#pragma unroll
        for (int o = 1; o < 64; o <<= 1) { const float n = __shfl_up(incl, o); if (lane >= o) incl += n; }
        __syncthreads();
        if (lane == 63) wsum[wave] = incl;
        __syncthreads();
        float base = incl - s;
        for (int w = 0; w < wave; ++w) base += wsum[w];
#pragma unroll
        for (int i = 0; i < 8; ++i) CK[(size_t)bh * SEQ + tid * 8 + i] = base + v[i];
    }
}

__device__ __forceinline__ void phase_gla_b1(const Params& p, int l, unsigned char* lds) {
    const int tid = threadIdx.x;
    float* lr = (float*)lds;
    float* w2 = lr + 64 * 16;
    float* b2 = w2 + 16 * 32;
    float* cum = b2 + 32;
    float* kd = cum + 64 * 32;
    float* vs = kd + 64 * 32;
    const bf16* H = (const bf16*)(p.ws + WS_H);
    float* GCUM = (float*)(p.ws + WS_GCUM); float* GS = (float*)(p.ws + WS_GS); float* GDEC = (float*)(p.ws + WS_GDEC);
    for (int it = blockIdx.x; it < 48 * 64; it += gridDim.x) {
        const int bh = it >> 6, n = it & 63, b = bh / 6, h = bh % 6; const size_t tok0 = (size_t)b * SEQ + n * 64;
        __syncthreads();
        for (int i = tid; i < 64 * 16; i += 512) lr[i] = bf2f(H[(tok0 + (i >> 4)) * HCOLS + HC_LR + (i & 15)]);
        { const int r = tid >> 5, d = tid & 31; w2[tid] = p.gla_gate_w[(size_t)l * 16 * 192 + r * 192 + h * 32 + d]; }
        if (tid < 32) b2[tid] = p.gla_gate_b[l * 192 + h * 32 + tid];
        for (int i = tid; i < 64 * 64; i += 512) vs[i] = bf2f(H[(tok0 + (i >> 6)) * HCOLS + HC_BV + h * 64 + (i & 63)]);
        __syncthreads();
        for (int i = tid; i < 64 * 32; i += 512) { const int t = i >> 5, d = i & 31; float x = b2[d];
#pragma unroll
            for (int r = 0; r < 16; ++r) x += lr[t * 16 + r] * w2[r * 32 + d];
            cum[i] = log_sigmoid(x) * (1.0f / 16.0f); }
        __syncthreads();
        if (tid < 32) { float s = 0.f; for (int t = 0; t < 64; ++t) { s += cum[t * 32 + tid]; cum[t * 32 + tid] = s; } }
        __syncthreads();
        for (int i = tid; i < 64 * 32; i += 512) { const int t = i >> 5, d = i & 31; const float c = cum[i];
            GCUM[(tok0 + t) * 192 + h * 32 + d] = c;
            kd[i] = bf2f(H[(tok0 + t) * HCOLS + HC_BK + h * 32 + d]) * __expf(cum[63 * 32 + d] - c); }
        if (tid < 32) GDEC[(size_t)it * 32 + tid] = __expf(cum[63 * 32 + tid]);
        __syncthreads();
        { const int d = tid >> 4, e0 = (tid & 15) * 4; f32x4 acc = {0.f, 0.f, 0.f, 0.f};
          for (int t = 0; t < 64; ++t) { const float k = kd[t * 32 + d]; acc += k * *(const f32x4*)(vs + t * 64 + e0); }
          *(f32x4*)(GS + (size_t)it * 2048 + d * 64 + e0) = acc; }
    }
}
__device__ __forceinline__ void phase_gla_b2(const Params& p) {
    float* GS = (float*)(p.ws + WS_GS); const float* GDEC = (const float*)(p.ws + WS_GDEC);
    for (int g = blockIdx.x * 512 + threadIdx.x; g < 48 * 2048; g += gridDim.x * 512) {
        const int bh = g >> 11, de = g & 2047, d = de >> 6; float S = 0.f;
        for (int n = 0; n < 64; ++n) { const size_t ci = (size_t)bh * 64 + n; const float loc = GS[ci * 2048 + de]; GS[ci * 2048 + de] = S; S = S * GDEC[ci * 32 + d] + loc; }
    }
}
__device__ __forceinline__ void phase_gla_b3(const Params& p, int l, unsigned char* lds) {
    const int tid = threadIdx.x;
    float* qe = (float*)lds;
    float* ke = qe + 64 * 33;
    float* vs = ke + 64 * 33;
    float* Ss = vs + 64 * 64;
    float* at = Ss + 32 * 64;
    const bf16* H = (const bf16*)(p.ws + WS_H); bf16* MIX = (bf16*)(p.ws + WS_MIX);
    const float* GCUM = (const float*)(p.ws + WS_GCUM); const float* GS = (const float*)(p.ws + WS_GS);
    for (int it = blockIdx.x; it < 48 * 64; it += gridDim.x) {
        const int bh = it >> 6, n = it & 63, b = bh / 6, h = bh % 6; const size_t tok0 = (size_t)b * SEQ + n * 64;
        __syncthreads();
        for (int i = tid; i < 64 * 32; i += 512) { const int t = i >> 5, d = i & 31; const float c = GCUM[(tok0 + t) * 192 + h * 32 + d];
            qe[t * 33 + d] = bf2f(H[(tok0 + t) * HCOLS + HC_BQ + h * 32 + d]) * __expf(c);
            ke[t * 33 + d] = bf2f(H[(tok0 + t) * HCOLS + HC_BK + h * 32 + d]) * __expf(-c); }
        for (int i = tid; i < 64 * 64; i += 512) vs[i] = bf2f(H[(tok0 + (i >> 6)) * HCOLS + HC_BV + h * 64 + (i & 63)]);
        for (int i = tid; i < 32 * 64; i += 512) Ss[i] = GS[(size_t)it * 2048 + i];
        __syncthreads();
        for (int i = tid; i < 64 * 64; i += 512) { const int t = i >> 6, s = i & 63; float a = 0.f;
            if (s <= t) {
#pragma unroll
                for (int d = 0; d < 32; ++d) a += qe[t * 33 + d] * ke[s * 33 + d]; }
            at[t * 65 + s] = a; }
        __syncthreads();
        { const int t = tid >> 3, e0 = (tid & 7) * 8; float o[8];
#pragma unroll
          for (int i = 0; i < 8; ++i) o[i] = 0.f;
          for (int d = 0; d < 32; ++d) { const float a = qe[t * 33 + d];
#pragma unroll
              for (int i = 0; i < 8; ++i) o[i] += a * Ss[d * 64 + e0 + i]; }
          for (int s = 0; s <= t; ++s) { const float a = at[t * 65 + s];
#pragma unroll
              for (int i = 0; i < 8; ++i) o[i] += a * vs[s * 64 + e0 + i]; }
          float ss = 0.f;
#pragma unroll
          for (int i = 0; i < 8; ++i) ss += o[i] * o[i];
          ss += __shfl_xor(ss, 1); ss += __shfl_xor(ss, 2); ss += __shfl_xor(ss, 4);
          const float rs = 1.0f / sqrtf(ss * (1.f / 64.f) + LN_EPS);
          const float* ng = p.gla_norm_g + l * 384 + h * 64 + e0; const bf16* gr = H + (tok0 + t) * HCOLS + HC_BG + h * 64 + e0;
          float r[8];
#pragma unroll
          for (int i = 0; i < 8; ++i) { const float g = bf2f(gr[i]); r[i] = o[i] * rs * ng[i] * (g * sigmoidf_(g)); }
          u32x4 w; w.x = pk2(r[0], r[1]); w.y = pk2(r[2], r[3]); w.z = pk2(r[4], r[5]); w.w = pk2(r[6], r[7]);
          *(u32x4*)(MIX + (tok0 + t) * D + MC_B + h * 64 + e0) = w; }
    }
}

__device__ __forceinline__ void phase_fox_simple(const Params& p, unsigned char* lds) {
    const int tid = threadIdx.x, qi = tid >> 3, sub = tid & 7;
    float* Ks = (float*)lds;
    float* Vs = Ks + 64 * 65;
    float* Ps = Vs + 64 * 64;
    float* cks = Ps + 64 * 65;
    const bf16* H = (const bf16*)(p.ws + WS_H); bf16* MIX = (bf16*)(p.ws + WS_MIX); const float* CK = (const float*)(p.ws + WS_CK);
    for (int it = blockIdx.x; it < 48 * 64; it += gridDim.x) {
        const int bh = it / 64, qt = 63 - (it % 64), b = bh / 6, h = bh % 6; const size_t tokb = (size_t)b * SEQ;
        float q[64];
        { const bf16* qr = H + (tokb + qt * 64 + qi) * HCOLS + HC_CQ + h * 64;
#pragma unroll
          for (int d8 = 0; d8 < 8; ++d8) { const u32x4 v = *(const u32x4*)(qr + d8 * 8);
              q[d8 * 8 + 0] = bf2f(v.x & 0xffffu); q[d8 * 8 + 1] = bf2f(v.x >> 16); q[d8 * 8 + 2] = bf2f(v.y & 0xffffu); q[d8 * 8 + 3] = bf2f(v.y >> 16);
              q[d8 * 8 + 4] = bf2f(v.z & 0xffffu); q[d8 * 8 + 5] = bf2f(v.z >> 16); q[d8 * 8 + 6] = bf2f(v.w & 0xffffu); q[d8 * 8 + 7] = bf2f(v.w >> 16); } }
        const float cq = CK[(size_t)bh * SEQ + qt * 64 + qi];
        float m = -INFINITY, lsum = 0.f, o[8];
#pragma unroll
        for (int i = 0; i < 8; ++i) o[i] = 0.f;
        for (int kt = 0; kt <= qt; ++kt) {
            __syncthreads();
            for (int i = tid; i < 64 * 64; i += 512) { const int r = i >> 6, c = i & 63; const bf16* hr = H + (tokb + kt * 64 + r) * HCOLS + h * 64 + c;
                Ks[r * 65 + c] = bf2f(hr[HC_CK]); Vs[r * 64 + c] = bf2f(hr[HC_CV]); }
            if (tid < 64) cks[tid] = CK[(size_t)bh * SEQ + kt * 64 + tid];
            __syncthreads();
            float s[8]; float tmax = -INFINITY;
#pragma unroll
            for (int j = 0; j < 8; ++j) { const int kk = sub + 8 * j; float a = 0.f;
#pragma unroll
                for (int d = 0; d < 64; ++d) a += q[d] * Ks[kk * 65 + d];
                a += cq - cks[kk];
                if (kt == qt && kk > qi) a = -INFINITY;
                s[j] = a; tmax = fmaxf(tmax, a); }
            tmax = fmaxf(tmax, __shfl_xor(tmax, 1)); tmax = fmaxf(tmax, __shfl_xor(tmax, 2)); tmax = fmaxf(tmax, __shfl_xor(tmax, 4));
            const float mn = fmaxf(m, tmax), sc = exp2f(m - mn); float ps = 0.f;
#pragma unroll
            for (int j = 0; j < 8; ++j) { const float pj = exp2f(s[j] - mn); ps += pj; Ps[qi * 65 + sub + 8 * j] = pj; }
            ps += __shfl_xor(ps, 1); ps += __shfl_xor(ps, 2); ps += __shfl_xor(ps, 4);
            lsum = lsum * sc + ps; m = mn;
#pragma unroll
            for (int i = 0; i < 8; ++i) o[i] *= sc;
            __syncthreads();
            for (int k = 0; k < 64; ++k) { const float pk = Ps[qi * 65 + k];
#pragma unroll
                for (int i = 0; i < 8; ++i) o[i] += pk * Vs[k * 64 + sub * 8 + i]; }
        }
        const float inv = 1.0f / lsum;
        u32x4 w; w.x = pk2(o[0] * inv, o[1] * inv); w.y = pk2(o[2] * inv, o[3] * inv); w.z = pk2(o[4] * inv, o[5] * inv); w.w = pk2(o[6] * inv, o[7] * inv);
        *(u32x4*)(MIX + (tokb + qt * 64 + qi) * D + MC_C + h * 64 + sub * 8) = w;
    }
}

__device__ __forceinline__ void phase_ln(const float* Y, const float* g, const float* bta, float* dst, bf16* dstb) {
    const int tid = threadIdx.x, lane = tid & 63, wave = tid >> 6;
    for (int row = blockIdx.x * 8 + wave; row < T; row += gridDim.x * 8) {
        const float* yr = Y + (size_t)row * D; f32x4 v[4]; float s = 0.f;
#pragma unroll
        for (int j = 0; j < 4; ++j) { v[j] = *(const f32x4*)(yr + j * 256 + lane * 4); s += (v[j][0] + v[j][1]) + (v[j][2] + v[j][3]); }
        const float mean = wave_sum(s) * (1.f / D); float s2 = 0.f;
#pragma unroll
        for (int j = 0; j < 4; ++j) { v[j] = v[j] - mean; s2 += (v[j][0] * v[j][0] + v[j][1] * v[j][1]) + (v[j][2] * v[j][2] + v[j][3] * v[j][3]); }
        const float rstd = 1.0f / sqrtf(wave_sum(s2) * (1.f / D) + LN_EPS);
#pragma unroll
        for (int j = 0; j < 4; ++j) { const f32x4 g4 = *(const f32x4*)(g + j * 256 + lane * 4), b4 = *(const f32x4*)(bta + j * 256 + lane * 4);
            const f32x4 o = v[j] * rstd * g4 + b4;
            *(f32x4*)(dst + (size_t)row * D + j * 256 + lane * 4) = o;
            if (dstb) { u32x2 w; w.x = pk2(o[0], o[1]); w.y = pk2(o[2], o[3]); *(u32x2*)(dstb + (size_t)row * D + j * 256 + lane * 4) = w; } }
    }
}

#define TK_INSERT(tv, ti, x, id) do { \
    _Pragma("unroll") for (int j_ = 15; j_ >= 1; --j_) { const bool cj = (x) > tv[j_], cm = (x) > tv[j_ - 1]; \
        const float nv = cm ? tv[j_ - 1] : (x); const int ni = cm ? ti[j_ - 1] : (id); tv[j_] = cj ? nv : tv[j_]; ti[j_] = cj ? ni : ti[j_]; } \
    { const bool c0 = (x) > tv[0]; tv[0] = c0 ? (x) : tv[0]; ti[0] = c0 ? (id) : ti[0]; } } while (0)
__device__ __forceinline__ void phase_topk(const Params& p) {
    const float* SC = (const float*)(p.ws + WS_SC); int* EIDX = (int*)(p.ws + WS_EIDX); float* GATE = (float*)(p.ws + WS_GATE);
    for (int g = blockIdx.x * 512 + threadIdx.x; g < T * 16; g += gridDim.x * 512) {
        const int tok = g >> 4, hc = g & 15;
        const float* sp = SC + (size_t)tok * 2048 + hc * 128;
        float tv[16]; int ti[16];
#pragma unroll
        for (int j = 0; j < 16; ++j) { tv[j] = -INFINITY; ti[j] = 0; }
        for (int i4 = 0; i4 < 32; ++i4) { const f32x4 v = *(const f32x4*)(sp + i4 * 4);
#pragma unroll
            for (int e = 0; e < 4; ++e) { const float x = v[e]; const int id = i4 * 4 + e; if (x > tv[15]) TK_INSERT(tv, ti, x, id); } }
        float av[16], bv[16]; int ai[16], bi[16]; const bool c1 = (hc & 1) != 0;
#pragma unroll
        for (int j = 0; j < 16; ++j) { const float ov = __shfl_xor(tv[j], 1); const int oi = __shfl_xor(ti[j], 1);
            av[j] = c1 ? ov : tv[j]; ai[j] = c1 ? oi : ti[j]; bv[j] = c1 ? tv[j] : ov; bi[j] = c1 ? ti[j] : oi; }
        float cv[16]; int ce[16];
#pragma unroll
        for (int j = 0; j < 16; ++j) { cv[j] = -INFINITY; ce[j] = 0; }
#pragma unroll
        for (int i = 0; i < 16; ++i)
#pragma unroll
            for (int j = 0; j < 16 / (i + 1); ++j) { const float x = av[i] + bv[j]; const int id = ai[i] * 128 + bi[j]; TK_INSERT(cv, ce, x, id); }
        float den = 0.f; float ex[16];
#pragma unroll
        for (int j = 0; j < 16; ++j) { ex[j] = __expf(cv[j] - cv[0]); den += ex[j]; }
        const float inv = 1.0f / den;
        if (!c1) { const int h = hc >> 1; int* eo = EIDX + (size_t)tok * 128 + h * 16; float* go = GATE + (size_t)tok * 128 + h * 16;
#pragma unroll
            for (int j = 0; j < 16; ++j) { eo[j] = ce[j]; go[j] = ex[j] * inv; } }
    }
}

__device__ __forceinline__ float gelu_tanh(float h) { const float z = 0.7978845608028654f * (h + 0.044715f * h * h * h); const float t = 1.0f - 2.0f / (__expf(2.0f * z) + 1.0f); return 0.5f * h * (1.0f + t); }
__device__ __forceinline__ void phase_peer(const Params& p) {
    const int tid = threadIdx.x, lane = tid & 63, wave = tid >> 6;
    const float* XF = (const float*)(p.ws + WS_XF); const bf16* Ub = (const bf16*)(p.ws + WS_U); const bf16* Vb = (const bf16*)(p.ws + WS_V);
    const int* EIDX = (const int*)(p.ws + WS_EIDX); const float* GATE = (const float*)(p.ws + WS_GATE);
    float* Y = (float*)(p.ws + WS_Y); bf16* XB = (bf16*)(p.ws + WS_XB);
    for (int tok = blockIdx.x * 8 + wave; tok < T; tok += gridDim.x * 8) {
        float xv[16], acc[16];
#pragma unroll
        for (int j = 0; j < 2; ++j) { const f32x4 a = *(const f32x4*)(XF + (size_t)tok * D + j * 512 + lane * 8), b = *(const f32x4*)(XF + (size_t)tok * D + j * 512 + lane * 8 + 4);
#pragma unroll
            for (int i = 0; i < 4; ++i) { xv[j * 8 + i] = a[i]; xv[j * 8 + 4 + i] = b[i]; } }
#pragma unroll
        for (int i = 0; i < 16; ++i) acc[i] = 0.f;
        const int e_lo = EIDX[(size_t)tok * 128 + lane], e_hi = EIDX[(size_t)tok * 128 + 64 + lane];
        const float g_lo = GATE[(size_t)tok * 128 + lane], g_hi = GATE[(size_t)tok * 128 + 64 + lane];
        for (int k = 0; k < 128; ++k) {
            const int e = __builtin_amdgcn_readlane(k < 64 ? e_lo : e_hi, k & 63);
            const float gt = __uint_as_float(__builtin_amdgcn_readlane(__float_as_uint(k < 64 ? g_lo : g_hi), k & 63));
            const bf16* ur = Ub + (size_t)e * D + lane * 8; const bf16* vr = Vb + (size_t)e * D + lane * 8;
            const u32x4 u0 = *(const u32x4*)ur, u1 = *(const u32x4*)(ur + 512), v0 = *(const u32x4*)vr, v1 = *(const u32x4*)(vr + 512);
            float d = 0.f;
#pragma unroll
            for (int i = 0; i < 4; ++i) { d += xv[2 * i] * bf2f(u0[i] & 0xffffu) + xv[2 * i + 1] * __uint_as_float(u0[i] & 0xffff0000u);
                                          d += xv[8 + 2 * i] * bf2f(u1[i] & 0xffffu) + xv[8 + 2 * i + 1] * __uint_as_float(u1[i] & 0xffff0000u); }
            const float hh = wave_sum(d); const float coef = gt * gelu_tanh(hh);
#pragma unroll
            for (int i = 0; i < 4; ++i) { acc[2 * i] += coef * bf2f(v0[i] & 0xffffu); acc[2 * i + 1] += coef * __uint_as_float(v0[i] & 0xffff0000u);
                                          acc[8 + 2 * i] += coef * bf2f(v1[i] & 0xffffu); acc[8 + 2 * i + 1] += coef * __uint_as_float(v1[i] & 0xffff0000u); }
        }
#pragma unroll
        for (int j = 0; j < 2; ++j) { f32x4 a, b;
#pragma unroll
            for (int i = 0; i < 4; ++i) { a[i] = ALPHA * xv[j * 8 + i] + acc[j * 8 + i]; b[i] = ALPHA * xv[j * 8 + 4 + i] + acc[j * 8 + 4 + i]; }
            *(f32x4*)(Y + (size_t)tok * D + j * 512 + lane * 8) = a; *(f32x4*)(Y + (size_t)tok * D + j * 512 + lane * 8 + 4) = b;
            u32x4 w; w.x = pk2(a[0], a[1]); w.y = pk2(a[2], a[3]); w.z = pk2(b[0], b[1]); w.w = pk2(b[2], b[3]);
            *(u32x4*)(XB + (size_t)tok * D + j * 512 + lane * 8) = w; }
    }
}

enum { PH_PRO_A, PH_PRO_B, PH_CVT, PH_GEMM_IN, PH_GEMM_E, PH_CONV, PH_FOXCUM, PH_GLA1, PH_GLA2, PH_GLA3, PH_FOX, PH_GEMM_OUT, PH_LN1, PH_GEMM_SC, PH_TOPK, PH_PEER, PH_GEMM_PLE, PH_LN2, PH_COUNT };

template <int PH> __device__ __forceinline__ void run_phase(const Params& p, int l, unsigned char* lds) {
    if constexpr (PH == PH_PRO_A) phase_pro_a(p, lds);
    else if constexpr (PH == PH_PRO_B) phase_pro_b(p, lds);
    else if constexpr (PH == PH_CVT) phase_cvt(p, l);
    else if constexpr (PH == PH_GEMM_IN) phase_gemm_in(p, l, lds);
    else if constexpr (PH == PH_GEMM_E) phase_gemm_e(p, l, lds);
    else if constexpr (PH == PH_CONV) phase_conv(p, l, lds);
    else if constexpr (PH == PH_FOXCUM) phase_fox_cum(p, l, lds);
    else if constexpr (PH == PH_GLA1) phase_gla_b1(p, l, lds);
    else if constexpr (PH == PH_GLA2) phase_gla_b2(p);
    else if constexpr (PH == PH_GLA3) phase_gla_b3(p, l, lds);
    else if constexpr (PH == PH_FOX) phase_fox_simple(p, lds);
    else if constexpr (PH == PH_GEMM_OUT) phase_gemm_out(p, l, lds);
    else if constexpr (PH == PH_LN1) phase_ln((const float*)(p.ws + WS_Y), p.ln1_g + (size_t)l * D, p.ln1_b + (size_t)l * D, (float*)(p.ws + WS_XF), (bf16*)(p.ws + WS_XB));
    else if constexpr (PH == PH_GEMM_SC) phase_gemm_sc(p, l, lds);
    else if constexpr (PH == PH_TOPK) phase_topk(p);
    else if constexpr (PH == PH_PEER) phase_peer(p);
    else if constexpr (PH == PH_GEMM_PLE) phase_gemm_ple(p, l, lds);
    else if constexpr (PH == PH_LN2) phase_ln((const float*)(p.ws + WS_Y), p.ln2_g + (size_t)l * D, p.ln2_b + (size_t)l * D, l == DEPTH - 1 ? p.out : (float*)(p.ws + WS_XF), l == DEPTH - 1 ? nullptr : (bf16*)(p.ws + WS_XB));
}
template <int PH> __global__ void __launch_bounds__(512, 2) k_ph(Params p, int l) {
    extern __shared__ __attribute__((aligned(16))) unsigned char lds[];
    run_phase<PH>(p, l, lds);
}
template <int PH> static void launch_ph(const Params& p, int l, hipStream_t stream) {
    static bool init = false;
    if (!init) { (void)hipFuncSetAttribute((const void*)k_ph<PH>, hipFuncAttributeMaxDynamicSharedMemorySize, LDS_BYTES); init = true; }
    hipLaunchKernelGGL(k_ph<PH>, dim3(256), dim3(512), LDS_BYTES, stream, p, l);
}

extern "C" void kernel_launch(void* const* d_in, const int* in_sizes, int n_in, void* d_out, int out_size, void* d_ws, size_t ws_size, hipStream_t stream) {
    if (n_in != 23 || ws_size < WS_END) { fprintf(stderr, "kernel_launch: unexpected n_in %d or ws_size %zu\n", n_in, ws_size); return; }
    Params p; memset(&p, 0, sizeof(p));
    const float** f = (const float**)&p;
    for (int i = 0; i < 23; ++i) f[i] = (const float*)d_in[i];
    p.out = (float*)d_out; p.ws = (unsigned char*)d_ws;
    launch_ph<PH_PRO_A>(p, 0, stream);
    launch_ph<PH_PRO_B>(p, 0, stream);
    for (int l = 0; l < DEPTH; ++l) {
        launch_ph<PH_CVT>(p, l, stream);
        launch_ph<PH_GEMM_IN>(p, l, stream);
        launch_ph<PH_GEMM_E>(p, l, stream);
        launch_ph<PH_CONV>(p, l, stream);
        launch_ph<PH_FOXCUM>(p, l, stream);
        launch_ph<PH_GLA1>(p, l, stream);
        launch_ph<PH_GLA2>(p, l, stream);
        launch_ph<PH_GLA3>(p, l, stream);
        launch_ph<PH_FOX>(p, l, stream);
        launch_ph<PH_GEMM_OUT>(p, l, stream);
        launch_ph<PH_LN1>(p, l, stream);
        launch_ph<PH_GEMM_SC>(p, l, stream);
        launch_ph<PH_TOPK>(p, l, stream);
        launch_ph<PH_PEER>(p, l, stream);
        launch_ph<PH_GEMM_PLE>(p, l, stream);
        launch_ph<PH_LN2>(p, l, stream);
    }
}
```

```cpp
#include <hip/hip_runtime.h>
#include <cstdio>
#include <cstdint>
#include <cstring>
#include <cmath>
__device__ __forceinline__ int tid_l() { int t = threadIdx.x; asm volatile("" : "+v"(t)); return t; }
__device__ __forceinline__ int bid_l() { int b = blockIdx.x; asm volatile("" : "+s"(b)); return b; }
__device__ __forceinline__ int grid_l() { int g = gridDim.x; asm volatile("" : "+s"(g)); return g; }
namespace pg8 {
#define PG8_LAS __attribute__((address_space(3)))
typedef unsigned short bf16_t;
typedef short bf16x8 __attribute__((ext_vector_type(8)));
typedef float f32x4 __attribute__((ext_vector_type(4)));
typedef unsigned u32x4 __attribute__((ext_vector_type(4)));
constexpr int BM = 256, BK = 64, HALF = 128, HTB = HALF * BK * 2  , STAGE_BYTES = 8 * HTB, NXCD = 8, WGM = 8;

__host__ __device__ __forceinline__ int lds_byte(int r, int c) { const int st = (r >> 4) * 2 + (c >> 5), rr = r & 15, cc = c & 31, ob = rr * 64 + cc * 2; return st * 1024 + (ob ^ (((ob >> 9) & 1) << 5)); }
__host__ __device__ __forceinline__ void stage_rc(int b, int& R, int& C) { const int st = b / 1024, sb = b % 1024, swz = sb ^ (((sb >> 9) & 1) << 5); R = (st >> 1) * 16 + swz / 64; C = (st & 1) * 32 + (swz % 64) / 2; }
__host__ __device__ __forceinline__ int perm32(int rho) { const int n = rho >> 4, i = rho & 15; return 8 * (i >> 2) + 4 * n + (i & 3); }

struct Unit { int pm, pn; };
struct Gemm { const bf16_t* A; const bf16_t* Bt; int M, N, K; };

struct StaticOrder {
    int nM, nN, nwg, G, c;
    __host__ __device__ void init(int M, int N, int G_, int c_) { nM = M / BM; nN = N / BM; nwg = nM * nN; G = G_; c = c_; }
    __host__ __device__ bool next(int i, Unit& u) const {
        const long L = (long)i * G + c; if (L >= nwg) return false;
        int wgid = (int)L; { const int q = nwg / NXCD, r = nwg % NXCD, xcd = wgid % NXCD, off = wgid / NXCD; wgid = (xcd < r ? xcd * (q + 1) : r * (q + 1) + (xcd - r) * q) + off; }
        const int nig = WGM * nN, gid = wgid / nig, fm = gid * WGM, gsz = (nM - fm) < WGM ? (nM - fm) : WGM;
        u.pm = fm + ((wgid % nig) % gsz); u.pn = (wgid % nig) / gsz; return true;
    }
    __device__ __forceinline__ void a_ready(const Unit&) const {}
    __device__ __forceinline__ void done(const Unit&) const {}
};

__device__ __forceinline__ unsigned cvt_pk_bf16(float lo, float hi) { unsigned r; asm volatile("v_cvt_pk_bf16_f32 %0, %1, %2" : "=v"(r) : "v"(lo), "v"(hi)); return r; }
typedef float f32x2 __attribute__((ext_vector_type(2)));
__device__ __forceinline__ f32x2 gelu_pk(f32x2 v) {
    const f32x2 av = __builtin_elementwise_abs(v), d = av * 0.2316418882f + 1.0f;
    f32x2 t; t.x = __builtin_amdgcn_rcpf(d.x); t.y = __builtin_amdgcn_rcpf(d.y);
    f32x2 q = t * 0.5307027145f + (-0.7265760135f); q = q * t + 0.7107068705f; q = q * t + (-0.142248368f); q = q * t + 0.127414796f; q = q * t;
    const f32x2 s = (v * v) * (-0.72134752044f);
    f32x2 e; e.x = __builtin_amdgcn_exp2f(s.x); e.y = __builtin_amdgcn_exp2f(s.y);
    const f32x2 m = v * (q * e), r = v - m;
    f32x2 o; o.x = v.x < 0.f ? m.x : r.x; o.y = v.y < 0.f ? m.y : r.y; return o;
}

template <int ACT  > struct EpiBf16 {
    static constexpr bool PERM = true, AFTER_DRAIN = false; static_assert(ACT == 0 || ACT == 1, "EpiBf16: ACT is 0 (none) or 1 (gelu_pk)");
    bf16_t* O; int ldc; const float* bias; int split_cols; size_t split_stride; float scale0;
    __device__ __forceinline__ void operator()(const f32x4 (&acc)[2][2][4][2], const Unit& u, int wr, int wc, int fr, int fq) const {
        const int row0 = u.pm * BM + wr * 64 + fr; int colt = u.pn * BM; bf16_t* base = O;
        float sc = 1.f; if (split_cols) { const int t = colt / split_cols; base += (size_t)t * split_stride; colt -= t * split_cols; if (t == 0) sc = scale0; }
        const int col0 = colt + wc * 32 + 8 * fq, bcol0 = u.pn * BM + wc * 32 + 8 * fq;
        f32x4 bv[2][2];
#pragma unroll
        for (int bj = 0; bj < 2; ++bj)
#pragma unroll
            for (int n = 0; n < 2; ++n) bv[bj][n] = bias ? *(const f32x4*)(bias + bcol0 + bj * HALF + 4 * n) : (f32x4){0.f, 0.f, 0.f, 0.f};
#pragma unroll
        for (int ai = 0; ai < 2; ++ai)
#pragma unroll
            for (int m = 0; m < 4; ++m) { bf16_t* rowp = base + (size_t)(row0 + ai * HALF + m * 16) * ldc + col0;
#pragma unroll
                for (int bj = 0; bj < 2; ++bj) { f32x4 v0 = acc[ai][bj][m][0] + bv[bj][0], v1 = acc[ai][bj][m][1] + bv[bj][1];
                    if (ACT == 1) { f32x2 a = gelu_pk((f32x2){v0[0], v0[1]}), b = gelu_pk((f32x2){v0[2], v0[3]}), c = gelu_pk((f32x2){v1[0], v1[1]}), d = gelu_pk((f32x2){v1[2], v1[3]});
                        v0 = (f32x4){a.x, a.y, b.x, b.y}; v1 = (f32x4){c.x, c.y, d.x, d.y}; }
                    v0 = v0 * sc; v1 = v1 * sc; u32x4 w; w.x = cvt_pk_bf16(v0[0], v0[1]); w.y = cvt_pk_bf16(v0[2], v0[3]); w.z = cvt_pk_bf16(v1[0], v1[1]); w.w = cvt_pk_bf16(v1[2], v1[3]);
                    *(u32x4*)(rowp + bj * HALF) = w; } }
    }
};
struct EpiF16 {
    static constexpr bool PERM = true, AFTER_DRAIN = false;
    _Float16* O; int ldc;
    __device__ __forceinline__ void operator()(const f32x4 (&acc)[2][2][4][2], const Unit& u, int wr, int wc, int fr, int fq) const {
        typedef _Float16 h8 __attribute__((ext_vector_type(8)));
        const int row0 = u.pm * BM + wr * 64 + fr, col0 = u.pn * BM + wc * 32 + 8 * fq;
#pragma unroll
        for (int ai = 0; ai < 2; ++ai)
#pragma unroll
            for (int m = 0; m < 4; ++m) { _Float16* rowp = O + (size_t)(row0 + ai * HALF + m * 16) * ldc + col0;
#pragma unroll
                for (int bj = 0; bj < 2; ++bj) { const f32x4 a = acc[ai][bj][m][0], b = acc[ai][bj][m][1];
                    h8 o; o[0] = (_Float16)a[0]; o[1] = (_Float16)a[1]; o[2] = (_Float16)a[2]; o[3] = (_Float16)a[3]; o[4] = (_Float16)b[0]; o[5] = (_Float16)b[1]; o[6] = (_Float16)b[2]; o[7] = (_Float16)b[3];
                    *(h8*)(rowp + bj * HALF) = o; } }
    }
};
struct EpiResid {
    static constexpr bool PERM = true, AFTER_DRAIN = false;
    const bf16_t* res; _Float16* Y; int ldc; float alpha;
    __device__ __forceinline__ void operator()(const f32x4 (&acc)[2][2][4][2], const Unit& u, int wr, int wc, int fr, int fq) const {
        const int row0 = u.pm * BM + wr * 64 + fr, col0 = u.pn * BM + wc * 32 + 8 * fq;
#pragma unroll
        for (int ai = 0; ai < 2; ++ai)
#pragma unroll
            for (int m = 0; m < 4; ++m) { const size_t off = (size_t)(row0 + ai * HALF + m * 16) * ldc + col0;
#pragma unroll
                for (int bj = 0; bj < 2; ++bj) { const u32x4 rv = *(const u32x4*)(res + off + bj * HALF);
                    f32x4 r0, r1; r0[0] = __uint_as_float(rv.x << 16); r0[1] = __uint_as_float(rv.x & 0xffff0000u); r0[2] = __uint_as_float(rv.y << 16); r0[3] = __uint_as_float(rv.y & 0xffff0000u);
                    r1[0] = __uint_as_float(rv.z << 16); r1[1] = __uint_as_float(rv.z & 0xffff0000u); r1[2] = __uint_as_float(rv.w << 16); r1[3] = __uint_as_float(rv.w & 0xffff0000u);
                    const f32x4 y0 = r0 * alpha + acc[ai][bj][m][0], y1 = r1 * alpha + acc[ai][bj][m][1];
                    typedef _Float16 h8 __attribute__((ext_vector_type(8))); h8 w; w[0] = (_Float16)y0[0]; w[1] = (_Float16)y0[1]; w[2] = (_Float16)y0[2]; w[3] = (_Float16)y0[3]; w[4] = (_Float16)y1[0]; w[5] = (_Float16)y1[1]; w[6] = (_Float16)y1[2]; w[7] = (_Float16)y1[3];
                    *(h8*)(Y + off + bj * HALF) = w; } }
    }
};
struct EpiPle {
    static constexpr bool PERM = true, AFTER_DRAIN = false;
    const bf16_t* R; _Float16* Y; const bf16_t* E; const float* gb; int ldc;
    __device__ __forceinline__ void operator()(const f32x4 (&acc)[2][2][4][2], const Unit& u, int wr, int wc, int fr, int fq) const {
        const int row0 = u.pm * BM + wr * 64 + fr, col0 = u.pn * BM + wc * 32 + 8 * fq;
        f32x4 bv[2][2];
#pragma unroll
        for (int bj = 0; bj < 2; ++bj)
#pragma unroll
            for (int n = 0; n < 2; ++n) bv[bj][n] = *(const f32x4*)(gb + col0 + bj * HALF + 4 * n);
#pragma unroll
        for (int ai = 0; ai < 2; ++ai)
#pragma unroll
            for (int m = 0; m < 4; ++m) { const size_t off = (size_t)(row0 + ai * HALF + m * 16) * ldc + col0;
#pragma unroll
                for (int bj = 0; bj < 2; ++bj) {
                    const u32x4 ev = *(const u32x4*)(E + off + bj * HALF), rv = *(const u32x4*)(R + off + bj * HALF);
                    float o[8];
#pragma unroll
                    for (int n = 0; n < 2; ++n) {
                        const f32x4 z = acc[ai][bj][m][n] + bv[bj][n];
                        const unsigned e0 = n == 0 ? ev.x : ev.z, e1 = n == 0 ? ev.y : ev.w, r0 = n == 0 ? rv.x : rv.z, r1 = n == 0 ? rv.y : rv.w;
                        f32x4 ee, rr; ee[0] = __uint_as_float(e0 << 16); ee[1] = __uint_as_float(e0 & 0xffff0000u); ee[2] = __uint_as_float(e1 << 16); ee[3] = __uint_as_float(e1 & 0xffff0000u);
                        rr[0] = __uint_as_float(r0 << 16); rr[1] = __uint_as_float(r0 & 0xffff0000u); rr[2] = __uint_as_float(r1 << 16); rr[3] = __uint_as_float(r1 & 0xffff0000u);
#pragma unroll
                        for (int i = 0; i < 4; ++i) o[4 * n + i] = rr[i] + ee[i] * __builtin_amdgcn_rcpf(1.0f + __expf(-z[i])); }
                    typedef _Float16 h8 __attribute__((ext_vector_type(8))); h8 w;
#pragma unroll
                    for (int i = 0; i < 8; ++i) w[i] = (_Float16)o[i];
                    *(h8*)(Y + off + bj * HALF) = w; } }
    }
};
template <class Epi, class Sched, bool ALIGN_EPI = false, bool SP2 = false>
__device__ __forceinline__ void gemm_phase(PG8_LAS unsigned char* lds, const Gemm g, const Sched& S, const Epi& E) {
    const int tid = tid_l(), wid = __builtin_amdgcn_readfirstlane(tid >> 6), lane = tid & 63, wr = wid >> 2, wc = wid & 3, fr = lane & 15, fq = lane >> 4;
    const int K = g.K, nt = K / BK;
    unsigned voffA[2], voffB[2];
#pragma unroll
    for (int i = 0; i < 2; ++i) { int R, C; stage_rc(tid * 16 + i * 8192, R, C); const int Rb = Epi::PERM ? ((R & ~31) + perm32(R & 31)) : R;
        voffA[i] = (unsigned)(R * K + C) * 2u; voffB[i] = (unsigned)(Rb * K + C) * 2u; }
    const size_t kstep = (size_t)(BK * 2);
    const size_t hstep = (size_t)HALF * K * 2;
    const size_t tstep = 2 * hstep;
    const unsigned ldsw = (unsigned)wid * 1024u;
    const int aoff = lds_byte(wr * 64 + fr, fq * 8), boff = lds_byte(wc * 32 + fr, fq * 8);
#define PG8_SA(b, h) (((b) * 2 + (h)) * HTB)
#define PG8_SB(b, h) ((4 + (b) * 2 + (h)) * HTB)
#define PG8_STAGE(bufoff, gbase, voff) do { _Pragma("unroll") for (int _i = 0; _i < 2; ++_i) \
        __builtin_amdgcn_global_load_lds((const unsigned*)((const char*)(gbase) + (voff)[_i]), (PG8_LAS unsigned*)(lds + (bufoff) + ldsw + _i * 8192), 16, 0, 0); } while (0)
#define PG8_LDA(dst, b, h) do { _Pragma("unroll") for (int m = 0; m < 4; ++m) _Pragma("unroll") for (int k = 0; k < 2; ++k) dst[m][k] = *(const PG8_LAS bf16x8*)(lds + PG8_SA(b, h) + aoff + m * 2048 + k * 1024); } while (0)
#define PG8_LDB(dst, b, h) do { _Pragma("unroll") for (int n = 0; n < 2; ++n) _Pragma("unroll") for (int k = 0; k < 2; ++k) dst[n][k] = *(const PG8_LAS bf16x8*)(lds + PG8_SB(b, h) + boff + n * 2048 + k * 1024); } while (0)
#define PG8_MMA(ai, bj, At, Bt) do { __builtin_amdgcn_s_setprio(1); _Pragma("unroll") for (int m = 0; m < 4; ++m) _Pragma("unroll") for (int n = 0; n < 2; ++n) _Pragma("unroll") for (int k = 0; k < 2; ++k) \
        acc[ai][bj][m][n] = __builtin_amdgcn_mfma_f32_16x16x32_bf16(Bt[n][k], At[m][k], acc[ai][bj][m][n], 0, 0, 0); __builtin_amdgcn_s_setprio(0); } while (0)
#define PG8_WAIT_V(n) asm volatile("s_waitcnt vmcnt(" #n ")" ::: "memory")
#define PG8_WAIT_L(n) asm volatile("s_waitcnt lgkmcnt(" #n ")" ::: "memory")
#define PG8_BAR __builtin_amdgcn_s_barrier()
#define PG8_SCHED __builtin_amdgcn_sched_barrier(0)
    Unit cur, nxt; int ui = 0;
    if (!S.next(0, cur)) return;
    f32x4 acc[2][2][4][2];
#pragma unroll
    for (int a = 0; a < 2; ++a)
#pragma unroll
        for (int b = 0; b < 2; ++b)
#pragma unroll
            for (int m = 0; m < 4; ++m)
#pragma unroll
                for (int n = 0; n < 2; ++n) acc[a][b][m][n] = (f32x4){0.f, 0.f, 0.f, 0.f};
    bf16x8 At[4][2], B0[2][2], B1[2][2];
    const char* cA = (const char*)g.A + (size_t)cur.pm * tstep; const char* cB = (const char*)g.Bt + (size_t)cur.pn * tstep;
    S.a_ready(cur);
    if constexpr (SP2) {
        PG8_STAGE(PG8_SB(0, 0), cB, voffB); PG8_STAGE(PG8_SB(0, 1), cB + hstep, voffB); PG8_STAGE(PG8_SA(0, 0), cA, voffA); PG8_STAGE(PG8_SA(0, 1), cA + hstep, voffA);
        if (wr == 1) PG8_BAR;
        PG8_WAIT_V(2); PG8_BAR;
        PG8_STAGE(PG8_SB(1, 0), cB + kstep, voffB); PG8_STAGE(PG8_SA(1, 0), cA + kstep, voffA); PG8_STAGE(PG8_SB(1, 1), cB + hstep + kstep, voffB);
        PG8_WAIT_V(6); PG8_BAR;
    } else {
        PG8_STAGE(PG8_SB(0, 0), cB, voffB); PG8_STAGE(PG8_SA(0, 0), cA, voffA); PG8_STAGE(PG8_SB(0, 1), cB + hstep, voffB); PG8_STAGE(PG8_SA(0, 1), cA + hstep, voffA);
        if (wr == 1) PG8_BAR;
        PG8_WAIT_V(4); PG8_BAR;
        PG8_STAGE(PG8_SB(1, 0), cB + kstep, voffB); PG8_STAGE(PG8_SA(1, 0), cA + kstep, voffA); PG8_STAGE(PG8_SB(1, 1), cB + hstep + kstep, voffB);
        PG8_WAIT_V(6); PG8_BAR;
    }
    for (;;) {
        const bool has_next = S.next(ui + 1, nxt);
        const char* nA = has_next ? (const char*)g.A + (size_t)nxt.pm * tstep : cA; const char* nB = has_next ? (const char*)g.Bt + (size_t)nxt.pn * tstep : cB;
        for (int t = 0; t < nt; t += 2) {
            const bool last = (t == nt - 2);
            const char* a1 = cA + (size_t)(t + 1) * kstep;
            const char* a2 = last ? nA : cA + (size_t)(t + 2) * kstep; const char* b2 = last ? nB : cB + (size_t)(t + 2) * kstep;
            const char* a3 = a2 + kstep; const char* b3 = b2 + kstep;
            if (last && has_next) S.a_ready(nxt);
            if constexpr (SP2) {
            PG8_LDB(B0, 0, 0); PG8_LDB(B1, 0, 1); PG8_SCHED; PG8_LDA(At, 0, 0); PG8_STAGE(PG8_SA(1, 1), a1 + hstep, voffA);
            PG8_WAIT_V(8); PG8_WAIT_L(0); PG8_BAR; PG8_MMA(0, 0, At, B0); PG8_MMA(0, 1, At, B1); PG8_BAR; PG8_SCHED;
            PG8_LDA(At, 0, 1); PG8_STAGE(PG8_SB(0, 0), b2, voffB); PG8_STAGE(PG8_SB(0, 1), b2 + hstep, voffB); PG8_STAGE(PG8_SA(0, 0), a2, voffA);
            PG8_WAIT_V(8); PG8_WAIT_L(0); PG8_BAR; PG8_MMA(1, 0, At, B0); PG8_MMA(1, 1, At, B1); PG8_BAR; PG8_SCHED;
            PG8_LDB(B0, 1, 0); PG8_LDB(B1, 1, 1); PG8_SCHED; PG8_LDA(At, 1, 0); PG8_STAGE(PG8_SA(0, 1), a2 + hstep, voffA);
            PG8_WAIT_V(8); PG8_WAIT_L(0); PG8_BAR; PG8_MMA(0, 0, At, B0); PG8_MMA(0, 1, At, B1); PG8_BAR; PG8_SCHED;
            PG8_LDA(At, 1, 1); PG8_STAGE(PG8_SB(1, 0), b3, voffB); PG8_STAGE(PG8_SB(1, 1), b3 + hstep, voffB); PG8_STAGE(PG8_SA(1, 0), a3, voffA);
            PG8_WAIT_V(8); PG8_WAIT_L(0); PG8_BAR; PG8_MMA(1, 0, At, B0); PG8_MMA(1, 1, At, B1); PG8_BAR; PG8_SCHED;
            } else {
            PG8_LDB(B0, 0, 0); PG8_SCHED; PG8_LDA(At, 0, 0); PG8_STAGE(PG8_SA(1, 1), a1 + hstep, voffA);
            PG8_WAIT_L(8); PG8_BAR; PG8_WAIT_L(0); PG8_MMA(0, 0, At, B0); PG8_BAR; PG8_SCHED;
            PG8_LDB(B1, 0, 1); PG8_STAGE(PG8_SB(0, 0), b2, voffB);
            PG8_BAR; PG8_WAIT_L(0); PG8_MMA(0, 1, At, B1); PG8_BAR;
            PG8_LDA(At, 0, 1); PG8_STAGE(PG8_SA(0, 0), a2, voffA);
            PG8_BAR; PG8_WAIT_L(0); PG8_MMA(1, 0, At, B0); PG8_BAR; PG8_SCHED;
            PG8_STAGE(PG8_SB(0, 1), b2 + hstep, voffB);
            PG8_WAIT_V(6); PG8_BAR; PG8_MMA(1, 1, At, B1); PG8_BAR;
            PG8_LDB(B0, 1, 0); PG8_SCHED; PG8_LDA(At, 1, 0); PG8_STAGE(PG8_SA(0, 1), a2 + hstep, voffA);
            PG8_WAIT_L(8); PG8_BAR; PG8_WAIT_L(0); PG8_MMA(0, 0, At, B0); PG8_BAR; PG8_SCHED;
            PG8_LDB(B1, 1, 1); PG8_STAGE(PG8_SB(1, 0), b3, voffB);
            PG8_BAR; PG8_WAIT_L(0); PG8_MMA(0, 1, At, B1); PG8_BAR;
            PG8_LDA(At, 1, 1); PG8_STAGE(PG8_SA(1, 0), a3, voffA);
            PG8_BAR; PG8_WAIT_L(0); PG8_MMA(1, 0, At, B0); PG8_BAR; PG8_SCHED;
            PG8_STAGE(PG8_SB(1, 1), b3 + hstep, voffB);
            PG8_WAIT_V(6); PG8_BAR; PG8_MMA(1, 1, At, B1); PG8_BAR;
            }
        }
        if constexpr (ALIGN_EPI) { if (wr == 0) PG8_BAR; }
        if constexpr (!Epi::AFTER_DRAIN) { E(acc, cur, wr, wc, fr, fq); S.done(cur); }
        if (!has_next) break;
#pragma unroll
        for (int a = 0; a < 2; ++a)
#pragma unroll
            for (int b = 0; b < 2; ++b)
#pragma unroll
                for (int m = 0; m < 4; ++m)
#pragma unroll
                    for (int n = 0; n < 2; ++n) acc[a][b][m][n] = (f32x4){0.f, 0.f, 0.f, 0.f};
        cur = nxt; cA = nA; cB = nB; ++ui;
        if constexpr (ALIGN_EPI) { if (wr == 1) PG8_BAR; }
    }
    PG8_WAIT_V(0);
    if constexpr (!ALIGN_EPI) { if (wr == 0) PG8_BAR; }
    PG8_BAR;
    if constexpr (Epi::AFTER_DRAIN) { E.fused(acc, cur, wr, wc, fr, fq, lds, wid, lane); S.done(cur); }
#undef PG8_SA
#undef PG8_SB
#undef PG8_STAGE
#undef PG8_LDA
#undef PG8_LDB
#undef PG8_MMA
#undef PG8_WAIT_V
#undef PG8_WAIT_L
#undef PG8_BAR
#undef PG8_SCHED
}
}
#include <hip/hip_bf16.h>
#include <cmath>
namespace attn_body {
using bf16=__hip_bfloat16;
using bf16x8=__attribute__((ext_vector_type(8)))short;
using s16x4=__attribute__((ext_vector_type(4)))short;
using f32x16=__attribute__((ext_vector_type(16)))float;
using u32x4=__attribute__((ext_vector_type(4)))unsigned;
constexpr int BATCH=8,NHEAD=6,SEQ=4096,D=64,KVP=3072,OP=1024;
constexpr int NW=8,QBLK=32,QB=QBLK*NW,KVBLK=64,NQB=SEQ/QB;
constexpr int ATTN_UNIT_ROWS=QB;
__device__ __forceinline__ int crow(int r,int hi){return (r&3)+8*(r>>2)+4*hi;}
#define SBAR() __builtin_amdgcn_sched_barrier(0)
__device__ __forceinline__ void cmask(f32x16&p0,f32x16&p1,int jb,int qrel,int hi){
  const float NEG=-INFINITY; int kb=64*jb+4*hi;
  #pragma unroll
  for(int r=0;r<16;++r){int kv=kb+(r&3)+8*(r>>2); if(kv>qrel)p0[r]=NEG; if(kv+32>qrel)p1[r]=NEG;}
}

constexpr int NSLOT=3, SLOTB=8192;
constexpr int LDS_K=0, LDS_V=NSLOT*SLOTB, LDS_WS=2*NSLOT*SLOTB, LDS_OST=LDS_WS+NW*64*4, LDS_CK=LDS_OST+NW*4096, LDS_BYTES=LDS_CK+SEQ*4;
constexpr float C2=0.125f*1.4426950408889634f;
__device__ __forceinline__ void glds16(const void*gsrc,unsigned lds_dst){unsigned keep;
  asm volatile("s_mov_b32 %0, m0\n\ts_mov_b32 m0, %2\n\ts_nop 0\n\tglobal_load_lds_dwordx4 %1, off\n\ts_mov_b32 m0, %0":"=&s"(keep):"v"(gsrc),"s"(lds_dst):"memory");}
__device__ __forceinline__ float max3f(float a,float b,float c){float r;asm("v_max3_f32 %0, %1, %2, %3":"=v"(r):"v"(a),"v"(b),"v"(c));return r;}
__device__ __forceinline__ float max2f(float a,float b){float r;asm("v_max_f32_e32 %0, %1, %2":"=v"(r):"v"(a),"v"(b));return r;}
__device__ __forceinline__ float fadd_s(float a,float b){float r;asm("v_add_f32_e32 %0, %1, %2":"=v"(r):"v"(a),"v"(b));return r;}
__device__ __forceinline__ float fsub_s(float a,float b){float r;asm("v_sub_f32_e32 %0, %1, %2":"=v"(r):"v"(a),"v"(b));return r;}
typedef float f32x2_t __attribute__((ext_vector_type(2))); typedef float f32x4_t __attribute__((ext_vector_type(4))); typedef __bf16 bf16x2_t __attribute__((ext_vector_type(2)));
__device__ __forceinline__ unsigned cvtpk_s(float lo,float hi){f32x2_t v={lo,hi};bf16x2_t b=__builtin_convertvector(v,bf16x2_t);return __builtin_bit_cast(unsigned,b);}
#define WAIT_BAR(N) asm volatile("s_waitcnt vmcnt(" #N ") lgkmcnt(0)\n\ts_barrier":::"memory")

__device__ __forceinline__ void qkt(f32x16&p0,f32x16&p1,const char*Kslot,const bf16x8*qr,int r32,int hi){
  const char*kb=Kslot+hi*1024+r32*16;
  #pragma unroll
  for(int d0=0;d0<4;++d0){
    const bf16x8 b0=*reinterpret_cast<const bf16x8*>(kb+d0*2048);
    const bf16x8 b1=*reinterpret_cast<const bf16x8*>(kb+d0*2048+512);
    {p0=__builtin_amdgcn_mfma_f32_32x32x16_bf16(b0,qr[d0],p0,0,0,0);p1=__builtin_amdgcn_mfma_f32_32x32x16_bf16(b1,qr[d0],p1,0,0,0);}}
}
typedef __attribute__((address_space(3))) const char* lds_cptr;
typedef short v4i16_t __attribute__((ext_vector_type(4)));
__device__ __forceinline__ void kload8(bf16x8*kf,lds_cptr kp){
  kf[0]=*(const __attribute__((address_space(3))) bf16x8*)(kp);      kf[1]=*(const __attribute__((address_space(3))) bf16x8*)(kp+512);
  kf[2]=*(const __attribute__((address_space(3))) bf16x8*)(kp+2048); kf[3]=*(const __attribute__((address_space(3))) bf16x8*)(kp+2560);
  kf[4]=*(const __attribute__((address_space(3))) bf16x8*)(kp+4096); kf[5]=*(const __attribute__((address_space(3))) bf16x8*)(kp+4608);
  kf[6]=*(const __attribute__((address_space(3))) bf16x8*)(kp+6144); kf[7]=*(const __attribute__((address_space(3))) bf16x8*)(kp+6656);
}
__device__ __forceinline__ void kload2(bf16x8*kf,lds_cptr kp,int j){ kf[2*j]=*(const __attribute__((address_space(3))) bf16x8*)(kp+j*2048); kf[2*j+1]=*(const __attribute__((address_space(3))) bf16x8*)(kp+j*2048+512); }
__device__ __forceinline__ s16x4 vtr(lds_cptr p){ return __builtin_bit_cast(s16x4,__builtin_amdgcn_ds_read_tr16_b64_v4i16((__attribute__((address_space(3))) v4i16_t*)p)); }
__device__ __forceinline__ float rowmax(const f32x16&p0,const f32x16&p1){
  float a=max3f(p0[0],p0[1],p1[0]),b=max3f(p0[2],p0[3],p1[1]);a=max3f(a,p1[2],p1[3]);
  #pragma unroll
  for(int r=4;r<16;r+=4){a=max3f(a,p0[r],p0[r+1]);b=max3f(b,p0[r+2],p0[r+3]);a=max3f(a,p1[r],p1[r+1]);b=max3f(b,p1[r+2],p1[r+3]);}
  const float m=max2f(a,b);
  auto rr=__builtin_amdgcn_permlane32_swap(__float_as_uint(m),__float_as_uint(m),false,false);
  return max2f(__uint_as_float(rr[0]),__uint_as_float(rr[1]));
}
__device__ __forceinline__ void pv(f32x16*o,int vb,bf16x8 pa0,bf16x8 pa1,bf16x8 pa2,bf16x8 pa3){
  #pragma unroll
  for(int d0=0;d0<2;++d0){s16x4 lo[4],hi[4];
    #pragma unroll
    for(int ks=0;ks<4;++ks){
      asm volatile("ds_read_b64_tr_b16 %0,%1 offset:%c2":"=&v"(lo[ks]):"v"(vb),"i"(d0*4096+ks*1024):"memory");
      asm volatile("ds_read_b64_tr_b16 %0,%1 offset:%c2":"=&v"(hi[ks]):"v"(vb),"i"(d0*4096+ks*1024+512):"memory");}
    asm volatile("s_waitcnt lgkmcnt(0)":::"memory");SBAR();
    #define PK(k) (bf16x8){lo[k][0],lo[k][1],lo[k][2],lo[k][3],hi[k][0],hi[k][1],hi[k][2],hi[k][3]}
    o[d0]=__builtin_amdgcn_mfma_f32_32x32x16_bf16(pa0,PK(0),o[d0],0,0,0);
    o[d0]=__builtin_amdgcn_mfma_f32_32x32x16_bf16(pa1,PK(1),o[d0],0,0,0);
    o[d0]=__builtin_amdgcn_mfma_f32_32x32x16_bf16(pa2,PK(2),o[d0],0,0,0);
    o[d0]=__builtin_amdgcn_mfma_f32_32x32x16_bf16(pa3,PK(3),o[d0],0,0,0);
    #undef PK
  }
}

#ifndef ATTN_STORE16
#define ATTN_STORE16(p,v) (*(u32x4*)(p)=(v))
#endif
template<int THRL> __device__ __forceinline__ void attn_unit(int b,int h,int qb,const bf16*Q,const bf16*__restrict__ K,const bf16*__restrict__ V,bf16*O,const float*__restrict__ CKg,const float*__restrict__ KTm,const float*__restrict__ QBm,char*shm){
  const int tid=tid_l(),lane=tid&63,r32=lane&31,hi=lane>>5; const int wid=__builtin_amdgcn_readfirstlane(tid>>6);
  const long rowbase=(long)b*SEQ; const int q0=qb*QB;
  const bf16*Qw=Q+(rowbase+q0+wid*QBLK)*KVP+h*D;
  const float*ckg=CKg+(long)(b*NHEAD+h)*SEQ;
  int j0=0;
  { const int bh_=b*NHEAD+h, NT0_=(q0+QB)/KVBLK; const float qmx=QBm[bh_*NQB+qb]*1.01f;
    const float kd=fmaxf(fmaxf(KTm[bh_*64+4*qb],KTm[bh_*64+4*qb+1]),fmaxf(KTm[bh_*64+4*qb+2],KTm[bh_*64+4*qb+3]));
    const float thr=-(qmx*kd)-48.f; bool skip=false;
    if(lane<NT0_-4){ const float bound=qmx*KTm[bh_*64+lane]+(ckg[q0]-ckg[64*lane+63]); skip=bound<thr; }
    const unsigned long long m_=__ballot(skip); j0=__builtin_ctzll(~m_); j0=(j0<NT0_-4?j0:NT0_-4)&~1; j0=__builtin_amdgcn_readfirstlane(j0); }
  const bf16*Kh=K+(rowbase+(long)j0*KVBLK)*KVP+h*D,*Vh=V+(rowbase+(long)j0*KVBLK)*KVP+h*D;
  const unsigned lds0=(unsigned)(uintptr_t)shm;
  float*wsf=(float*)(shm+LDS_WS)+wid*64;
  const bf16*ksrc=Kh+(long)lane*KVP+wid*8;
  const bf16*vsrc=Vh+(long)(16*(wid&3)+(lane>>2))*KVP+(wid>>2)*32+(lane&3)*8;
  const unsigned kdst=lds0+LDS_K+wid*1024, vdst=lds0+LDS_V+wid*1024;
  #define DMA_K(t,slot) glds16(ksrc+(long)(t)*KVBLK*KVP,(unsigned)__builtin_amdgcn_readfirstlane(kdst+(slot)))
  #define DMA_V(t,slot) glds16(vsrc+(long)(t)*KVBLK*KVP,(unsigned)__builtin_amdgcn_readfirstlane(vdst+(slot)))
  const int vb0=(int)(lds0+LDS_V)+((lane>>4)&1)*32+(lane&3)*8+(4*hi+((lane&15)>>2))*64;
  const char*Kbase=shm+LDS_K; bf16x8 kf[8];
  const lds_cptr shm3=(lds_cptr)shm; const lds_cptr kp0=shm3+LDS_K+hi*1024+r32*16; const lds_cptr vp0=shm3+LDS_V+((lane>>4)&1)*32+(lane&3)*8+(4*hi+((lane&15)>>2))*64;
  const int NT=(q0+QB)/KVBLK-j0;
  float*cks=(float*)(shm+LDS_CK);
  for(int i=j0*KVBLK+tid*4;i<q0+QB;i+=NW*64*4){ *(f32x4_t*)(cks+i)=*(const f32x4_t*)(ckg+i); }
  float cqm=ckg[q0+wid*QBLK+r32];
  const lds_cptr ckp=(lds_cptr)shm+LDS_CK+j0*256+hi*16;
  DMA_K(0,0);DMA_V(0,0);DMA_K(1,SLOTB);
  bf16x8 qr[4];
  #pragma unroll
  for(int d0=0;d0<4;++d0)qr[d0]=*reinterpret_cast<const bf16x8*>(&Qw[(long)r32*KVP+d0*16+hi*8]);
  float l_reg=0.f;f32x16 o[2];o[0]=f32x16{};o[1]=f32x16{};
  #define CINIT(C0,C1,t) do{ const lds_cptr cp_=ckp+(t)*256; \
    _Pragma("unroll") for(int g_=0;g_<4;++g_){ const f32x4_t a_=*(const __attribute__((address_space(3))) f32x4_t*)(cp_+g_*32); const f32x4_t b_=*(const __attribute__((address_space(3))) f32x4_t*)(cp_+g_*32+128); \
      _Pragma("unroll") for(int i_=0;i_<4;++i_){ C0[g_*4+i_]=cqm-a_[i_]; C1[g_*4+i_]=cqm-b_[i_]; } } }while(0)
  const int qrel=wid*QBLK+r32;
  #define CMASK(P0,P1,t) do{int jb_=(t)-(NT-4); if(jb_>=0)cmask(P0,P1,jb_,qrel,hi);}while(0)
  bool resc=false;
  #define START(P0,P1) do{ const float rm=rowmax(P0,P1); resc=false; \
    { const float dl=rm; \
      _Pragma("unroll") for(int r=0;r<16;++r){P0[r]=fsub_s(P0[r],dl);P1[r]=fsub_s(P1[r],dl);} \
      cqm=fsub_s(cqm,dl); } \
    _Pragma("unroll") for(int r=0;r<16;++r)P0[r]=__builtin_amdgcn_exp2f(P0[r]); }while(0)
  #define RESC() do{ if(resc){ asm volatile("s_waitcnt lgkmcnt(0)":::"memory"); \
      _Pragma("unroll") for(int d_=0;d_<2;++d_) _Pragma("unroll") for(int r=0;r<16;++r)o[d_][r]*=wsf[crow(r,hi)]; } }while(0)
  f32x16 pA0,pA1,pB0,pB1;
  int sl_prev=0,sl_cur=0,sl_next=SLOTB;
  #define ROT() do{sl_prev=sl_cur;sl_cur=sl_next;sl_next=(sl_next==(NSLOT-1)*SLOTB)?0:sl_next+SLOTB;}while(0)
  DMA_K(2,2*SLOTB);
  WAIT_BAR(3);
  CINIT(pA0,pA1,0);
  qkt(pA0,pA1,Kbase,qr,r32,hi);asm volatile("s_nop 15\n\ts_nop 7":"+v"(pA0),"+v"(pA1));CMASK(pA0,pA1,0);
  START(pA0,pA1);
  _Pragma("unroll") for(int r=0;r<16;++r)pA1[r]=__builtin_amdgcn_exp2f(pA1[r]);
  WAIT_BAR(0);
  DMA_K(3,0);DMA_V(1,SLOTB);
  ROT();
  kload8(kf,kp0+sl_cur);
  WAIT_BAR(2);
  s16x4 vlo[8],vhi[8]; u32x4 pw0,pw1,pw2,pw3;
  #define PKW(P,B) cvtpk_s(P[B],P[B+1])
  #define PAF(k) __builtin_bit_cast(bf16x8,pw##k)
  #define VFR(i) (bf16x8){vlo[i][0],vlo[i][1],vlo[i][2],vlo[i][3],vhi[i][0],vhi[i][1],vhi[i][2],vhi[i][3]}
  #define PIN(x) asm volatile("":"+v"(x))
  #define MX3(a,b,c) __builtin_fmaxf(__builtin_fmaxf((a),(b)),(c))
  #define GAPA(MF,A0,A1,A2,A3,W0,W1,PW) do{ MF; sacc+=A0; sacc+=A1; sacc+=A2; sacc+=A3; PIN(sacc); W0; W1; PIN(PW); SBAR(); }while(0)
  #define EX(v) __builtin_amdgcn_exp2f(v)
  #define GAPB(MF,X,B) do{ MF; X[B]=EX(X[B]); X[B+1]=EX(X[B+1]); X[B+2]=EX(X[B+2]); X[B+3]=EX(X[B+3]); PIN(X); SBAR(); }while(0)
  #define VRD(i) do{ vlo[i]=vtr(vp_+(((i)>>2)*4096+((i)&3)*1024)); vhi[i]=vtr(vp_+(((i)>>2)*4096+((i)&3)*1024+512)); }while(0)
  #define KRD(G,j) do{ if(G){ kload2(kf,kp0+sl_next,j); SBAR(); } }while(0)
  #define STEP(C0,C1,P0,P1,t,GK,GV,GL) do{ SBAR(); \
    CINIT(C0,C1,t); SBAR(); \
    const lds_cptr vp_=vp0+sl_prev; \
    VRD(0); SBAR(); float sacc=(P0[0]+P0[1]); \
    GAPA(C0=__builtin_amdgcn_mfma_f32_32x32x16_bf16(kf[0],qr[0],C0,0,0,0), P0[2],P0[3],P0[4],P0[5],     pw0[0]=PKW(P0,0), pw0[1]=PKW(P0,2), pw0); \
    VRD(4); SBAR(); GAPA(C1=__builtin_amdgcn_mfma_f32_32x32x16_bf16(kf[1],qr[0],C1,0,0,0), P0[6],P0[7],P0[8],P0[9],     pw0[2]=PKW(P0,4), pw0[3]=PKW(P0,6), pw0); \
    VRD(1); SBAR(); GAPA(C0=__builtin_amdgcn_mfma_f32_32x32x16_bf16(kf[2],qr[1],C0,0,0,0),   P0[10],P0[11],P0[12],P0[13], pw1[0]=PKW(P0,8), pw1[1]=PKW(P0,10), pw1); \
    VRD(5); SBAR(); GAPA(C1=__builtin_amdgcn_mfma_f32_32x32x16_bf16(kf[3],qr[1],C1,0,0,0),   P0[14],P0[15],P1[0],P1[1],   pw1[2]=PKW(P0,12),pw1[3]=PKW(P0,14), pw1); \
    VRD(2); SBAR(); GAPA(C0=__builtin_amdgcn_mfma_f32_32x32x16_bf16(kf[4],qr[2],C0,0,0,0),   P1[2],P1[3],P1[4],P1[5],     pw2[0]=PKW(P1,0), pw2[1]=PKW(P1,2), pw2); \
    VRD(6); SBAR(); GAPA(C1=__builtin_amdgcn_mfma_f32_32x32x16_bf16(kf[5],qr[2],C1,0,0,0),   P1[6],P1[7],P1[8],P1[9],     pw2[2]=PKW(P1,4), pw2[3]=PKW(P1,6), pw2); \
    VRD(3); SBAR(); GAPA(C0=__builtin_amdgcn_mfma_f32_32x32x16_bf16(kf[6],qr[3],C0,0,0,0),   P1[10],P1[11],P1[12],P1[13], pw3[0]=PKW(P1,8), pw3[1]=PKW(P1,10), pw3); \
    VRD(7); SBAR(); GAPA(C1=__builtin_amdgcn_mfma_f32_32x32x16_bf16(kf[7],qr[3],C1,0,0,0),   P1[14],P1[15],0.f,0.f,       pw3[2]=PKW(P1,12),pw3[3]=PKW(P1,14), pw3); \
    l_reg+=sacc; \
    if(GK){DMA_K((t)+3,sl_cur);} if(GV){DMA_V((t)+1,sl_next);} \
    CMASK(C0,C1,t); \
    { float a=MX3(C0[0],C0[1],C1[0]),b=MX3(C0[2],C0[3],C1[1]); a=MX3(a,C1[2],C1[3]); \
      _Pragma("unroll") for(int r=4;r<16;r+=4){a=MX3(a,C0[r],C0[r+1]);b=MX3(b,C0[r+2],C0[r+3]);a=MX3(a,C1[r],C1[r+1]);b=MX3(b,C1[r+2],C1[r+3]);} \
      float rm=__builtin_fmaxf(a,b); { auto rr=__builtin_amdgcn_permlane32_swap(__float_as_uint(rm),__float_as_uint(rm),false,false); rm=__builtin_fmaxf(__uint_as_float(rr[0]),__uint_as_float(rr[1])); } \
      resc=false; \
      if(__builtin_expect(__any(rm>(float)THRL),0)){ const float dl=__builtin_fmaxf(rm,0.f); \
        _Pragma("unroll") for(int r=0;r<16;++r){C0[r]-=dl;C1[r]-=dl;} \
        cqm-=dl; \
        const float f=__builtin_amdgcn_exp2f(-dl); l_reg*=f; if(hi==0)wsf[r32]=f; resc=true; } } \
    SBAR(); \
    GAPB(o[0]=__builtin_amdgcn_mfma_f32_32x32x16_bf16(PAF(0),VFR(0),o[0],0,0,0), C0,0); \
    GAPB(o[1]=__builtin_amdgcn_mfma_f32_32x32x16_bf16(PAF(0),VFR(4),o[1],0,0,0), C0,4); \
    KRD(GL,0); GAPB(o[0]=__builtin_amdgcn_mfma_f32_32x32x16_bf16(PAF(1),VFR(1),o[0],0,0,0), C0,8); \
    KRD(GL,1); GAPB(o[1]=__builtin_amdgcn_mfma_f32_32x32x16_bf16(PAF(1),VFR(5),o[1],0,0,0), C0,12); \
    KRD(GL,2); GAPB(o[0]=__builtin_amdgcn_mfma_f32_32x32x16_bf16(PAF(2),VFR(2),o[0],0,0,0), C1,0); \
    KRD(GL,3); GAPB(o[1]=__builtin_amdgcn_mfma_f32_32x32x16_bf16(PAF(2),VFR(6),o[1],0,0,0), C1,4); \
    GAPB(o[0]=__builtin_amdgcn_mfma_f32_32x32x16_bf16(PAF(3),VFR(3),o[0],0,0,0), C1,8); \
    GAPB(o[1]=__builtin_amdgcn_mfma_f32_32x32x16_bf16(PAF(3),VFR(7),o[1],0,0,0), C1,12); \
    }while(0)
  int t=1;
  #undef CMASK
  #define CMASK(P0,P1,t) do{}while(0)
  for(;t+5<NT;t+=2){
    STEP(pB0,pB1,pA0,pA1,t,true,true,true);     WAIT_BAR(2); RESC(); ROT();
    STEP(pA0,pA1,pB0,pB1,t+1,true,true,true);   WAIT_BAR(2); RESC(); ROT();
  }
  #undef CMASK
  #define CMASK(P0,P1,t) do{int jb_=(t)-(NT-4); if(jb_>=0)cmask(P0,P1,jb_,qrel,hi);}while(0)
  #define ENDW(tt) do{ if((tt)+3<NT){WAIT_BAR(2);} else if((tt)+2<NT){WAIT_BAR(1);} else {WAIT_BAR(0);} }while(0)
  for(;t+1<NT;t+=2){
    STEP(pB0,pB1,pA0,pA1,t,(t+3<NT),(t+1<NT),(t+1<NT));       ENDW(t);   RESC(); ROT();
    STEP(pA0,pA1,pB0,pB1,t+1,(t+4<NT),(t+2<NT),(t+2<NT));     ENDW(t+1); RESC(); ROT();
  }
  STEP(pB0,pB1,pA0,pA1,NT-1,false,false,false); RESC();
  { float sacc=pB0[0]+pB0[1]; _Pragma("unroll") for(int r=2;r<16;++r)sacc+=pB0[r]; _Pragma("unroll") for(int r=0;r<16;++r)sacc+=pB1[r]; l_reg+=sacc;
    pw0=(u32x4){PKW(pB0,0),PKW(pB0,2),PKW(pB0,4),PKW(pB0,6)};pw1=(u32x4){PKW(pB0,8),PKW(pB0,10),PKW(pB0,12),PKW(pB0,14)};pw2=(u32x4){PKW(pB1,0),PKW(pB1,2),PKW(pB1,4),PKW(pB1,6)};pw3=(u32x4){PKW(pB1,8),PKW(pB1,10),PKW(pB1,12),PKW(pB1,14)};
    SBAR(); pv(o,vb0+sl_cur,PAF(0),PAF(1),PAF(2),PAF(3)); }
  #undef PKW
  #undef PAF
  #undef VFR
  #undef PIN
  #undef MX3
  #undef GAPA
  #undef GAPB
  #undef EX
  #undef VRD
  #undef KRD
  #undef STEP
  #undef ENDW
  {auto rr=__builtin_amdgcn_permlane32_swap(__float_as_uint(l_reg),__float_as_uint(l_reg),false,false);l_reg=__uint_as_float(rr[0])+__uint_as_float(rr[1]);}
  if(hi==0)wsf[32+r32]=l_reg;asm volatile("s_waitcnt lgkmcnt(0)":::"memory");
  float rli[16];
  #pragma unroll
  for(int r=0;r<16;++r)rli[r]=__builtin_amdgcn_rcpf(wsf[32+crow(r,hi)]);
  bf16*Ow=O+(rowbase+q0+wid*QBLK)*OP+h*D;
  { bf16*stg=(bf16*)(shm+LDS_OST)+wid*2048;
    #pragma unroll
    for(int r=0;r<16;++r){const int orow=crow(r,hi);
      #pragma unroll
      for(int d0=0;d0<2;++d0)stg[orow*64+d0*32+r32]=__float2bfloat16(o[d0][r]*rli[r]);}
    asm volatile("s_waitcnt lgkmcnt(0)":::"memory");
    #pragma unroll
    for(int i=0;i<4;++i){const int row=i*8+(lane>>3),ch=lane&7; const u32x4 v=*(const u32x4*)(stg+row*64+ch*8); ATTN_STORE16(Ow+(long)row*OP+ch*8,v);} }
  asm volatile("s_waitcnt lgkmcnt(0)\n\ts_barrier":::"memory");
  #undef DMA_K
  #undef DMA_V
  #undef CMASK
  #undef START
  #undef RESC
  #undef ROT
  #undef CINIT
}
constexpr int ATTN_LDS_BYTES=LDS_BYTES;
struct AttnTensors { const bf16* Q; const bf16* K; const bf16* V; bf16* O; const float* CK; const float* KT; const float* QB; };
struct AttnUnit { int bh; int qb; };
struct QueueOrder {
  unsigned* head; volatile __attribute__((address_space(3))) int* slot;
  __device__ __forceinline__ bool next(int,AttnUnit&u)const{
    if(tid_l()==0) *slot=(int)__hip_atomic_fetch_add(head,1u,__ATOMIC_RELAXED,__HIP_MEMORY_SCOPE_AGENT);
    __syncthreads(); const int v=*slot; __syncthreads();
    if(v>=BATCH*NHEAD*NQB)return false; u.qb=NQB-1-v/(BATCH*NHEAD); u.bh=v%(BATCH*NHEAD); return true; }
  __device__ __forceinline__ void a_ready(const AttnUnit&)const{}
  __device__ __forceinline__ void done(const AttnUnit&)const{}
};
template<class Sched,int THRL=8> __device__ __forceinline__ void attn_phase(char*lds,const AttnTensors&T,const Sched&S){
  AttnUnit u;
  for(int i=0;S.next(i,u);++i){ S.a_ready(u); attn_unit<THRL>(u.bh/NHEAD,u.bh%NHEAD,u.qb,T.Q,T.K,T.V,T.O,T.CK,T.KT,T.QB,lds); S.done(u); }
}
#undef SBAR
#undef WAIT_BAR
}

constexpr int NB = 8, SEQ = 4096, T = NB * SEQ, D = 1024, DEPTH = 4;
constexpr int HCOLS = 3072;
constexpr int HC_AVAL = 0, HC_AGATE = 256, HC_BQ = 512, HC_BK = 704, HC_BV = 896, HC_BG = 1280, HC_CQ = 1664, HC_CK = 2048, HC_CV = 2432, HC_LR = 2816, HC_CF = 2832;
constexpr int IN_COLS = 2838;
constexpr int MC_A = 0, MC_B = 256, MC_C = 640;
constexpr float LN_EPS = 1e-5f;
constexpr float ALPHA = 1.6817928305074292f;
constexpr float LOG2E = 1.4426950408889634f;
constexpr float C2 = 0.125f * LOG2E;
constexpr float GLA_QSCALE = 0.17677669529663687f;
constexpr int NEXP = 16384;

constexpr size_t MiB = 1u << 20;
constexpr size_t WS_CTL = 0, CTL_ZERO_BYTES = 1 * MiB;
constexpr size_t WS_WIN = 1 * MiB;
constexpr size_t WS_WOUT = WS_WIN + 24 * MiB;
constexpr size_t WS_WP = WS_WOUT + 8 * MiB;
constexpr size_t WS_PGW = WS_WP + 16 * MiB;
constexpr size_t WS_PW = WS_PGW + 8 * MiB;
constexpr size_t WS_CK = WS_PW + 2 * MiB;
constexpr size_t WS_FKT = WS_CK + 768 * 1024, WS_FQB = WS_FKT + 16 * 1024;
constexpr size_t WS_U = WS_CK + 1 * MiB;
constexpr size_t WS_V = WS_U + 32 * MiB;
constexpr size_t WS_XB = WS_V + 32 * MiB;
constexpr size_t WS_XF = WS_XB + 64 * MiB;
constexpr size_t WS_PB = WS_XF + 128 * MiB;
constexpr size_t WS_H = WS_PB + 16 * MiB;
constexpr size_t WS_MIX = WS_H + 192 * MiB;
constexpr size_t WS_SC = WS_H;
constexpr size_t WS_Y = WS_MIX + 64 * MiB;
constexpr size_t WS_GCUM = WS_Y;
constexpr size_t WS_GS = WS_GCUM + 24 * MiB;
constexpr size_t WS_GDEC = WS_GS + 24 * MiB;
constexpr size_t WS_E = WS_Y + 128 * MiB;
constexpr size_t WS_EIDX = WS_E + 64 * MiB;
constexpr size_t WS_GATE = WS_EIDX + 16 * MiB;
constexpr size_t WS_SOFF = WS_GATE + 16 * MiB;
constexpr size_t WS_END = WS_SOFF + 1 * MiB;
static_assert(WS_END <= 1024 * MiB, "d_ws map");

constexpr int LDS_BYTES = 147456;

typedef unsigned short bf16;
typedef float f32x4 __attribute__((ext_vector_type(4)));
typedef unsigned u32x4 __attribute__((ext_vector_type(4)));
typedef unsigned u32x2 __attribute__((ext_vector_type(2)));

struct Params {
    const float *x, *p, *w_in, *conv_w, *conv_b, *conv_ln_g, *conv_ln_b, *gla_gate_w, *gla_gate_b, *gla_norm_g, *fox_forget_b, *w_out, *ln1_g, *ln1_b,
        *peer_wq, *peer_keys, *peer_u, *peer_v, *ple_w, *ple_gw, *ple_gb, *ln2_g, *ln2_b;
    float* out; unsigned char* ws;
};

__device__ __forceinline__ float bf2f(unsigned h) { return __uint_as_float(h << 16); }
__device__ __forceinline__ unsigned f2bf(float f) { unsigned u = __float_as_uint(f); return (u + 0x7fffu + ((u >> 16) & 1u)) >> 16; }
__device__ __forceinline__ unsigned pk2(float lo, float hi) { return f2bf(lo) | (f2bf(hi) << 16); }
__device__ __forceinline__ float wave_sum(float v) {
#pragma unroll
    for (int o = 1; o < 64; o <<= 1) v += __shfl_xor(v, o);
    return v;
}
__device__ __forceinline__ float log_sigmoid(float z) { return fminf(z, 0.f) - log1pf(__expf(-fabsf(z))); }
__device__ __forceinline__ float sigmoidf_(float z) { return 1.0f / (1.0f + __expf(-z)); }

struct MapIdent { __device__ __forceinline__ void operator()(int n, int& c, float& s) const { c = n; s = 1.f; } };
struct MapWin {
    __device__ __forceinline__ void operator()(int n, int& c, float& s) const {
        s = 1.f;
        if (n < HC_CQ) { c = n; if (n >= HC_BQ && n < HC_BK) s = GLA_QSCALE; }
        else if (n < HC_LR) { c = n + 16; if (n < HC_CK) s = C2; }
        else if (n < HC_CF) c = n - HC_LR + 1664;
        else if (n < IN_COLS) c = n;
        else c = -1;
    }
};
template <class CM>
__device__ __forceinline__ void transpose_item(const float* W, int K, int Nsrc, bf16* WT, int item, int nblk, float* scr, int lane, const CM& cm) {
    const int kb = item / nblk, nb = item % nblk, k0 = 64 * kb, n0 = 32 * nb;
    int sc; float scale; cm(n0 + (lane & 31), sc, scale);
#pragma unroll 8
    for (int i = 0; i < 32; ++i) { const int kk = 2 * i + (lane >> 5); scr[kk * 33 + (lane & 31)] = sc >= 0 ? W[(size_t)(k0 + kk) * Nsrc + sc] * scale : 0.f; }
    __builtin_amdgcn_wave_barrier(); asm volatile("s_waitcnt lgkmcnt(0)" ::: "memory");
    const int c = lane & 7;
#pragma unroll
    for (int j = 0; j < 4; ++j) { const int n = (lane >> 3) + 8 * j; const float* s = scr + (8 * c) * 33 + n;
        u32x4 o; o.x = pk2(s[0 * 33], s[1 * 33]); o.y = pk2(s[2 * 33], s[3 * 33]); o.z = pk2(s[4 * 33], s[5 * 33]); o.w = pk2(s[6 * 33], s[7 * 33]);
        *(u32x4*)(WT + (size_t)(n0 + n) * K + k0 + 8 * c) = o; }
    asm volatile("s_waitcnt lgkmcnt(0)" ::: "memory"); __builtin_amdgcn_wave_barrier();
}
__device__ __forceinline__ void cvt_bf16_stream(const float* src, bf16* dst, size_t n8, size_t gtid, size_t gthreads) {
    for (size_t i = gtid; i < n8; i += gthreads) { const f32x4 a = *(const f32x4*)(src + i * 8), b = *(const f32x4*)(src + i * 8 + 4);
        u32x4 o; o.x = pk2(a[0], a[1]); o.y = pk2(a[2], a[3]); o.z = pk2(b[0], b[1]); o.w = pk2(b[2], b[3]); *(u32x4*)(dst + i * 8) = o; }
}

__device__ __forceinline__ void phase_pro_a(const Params& p, unsigned char* lds) {
    const int tid = tid_l(), lane = tid & 63, wave = tid >> 6;
    float* scr = (float*)(lds + wave * 16384);
    const int gw = bid_l() * 8 + wave, NGW = grid_l() * 8;
    constexpr int I_WIN = (D / 64) * (HCOLS / 32), I_SQ = (D / 64) * (D / 32), I_PW = (256 / 64) * (D / 32);
    constexpr int PER_L = I_WIN + 2 * I_SQ + I_PW;
    for (int it = gw; it < DEPTH * PER_L; it += NGW) {
        const int l = it / PER_L; int r = it % PER_L;
        if (r < I_WIN) { transpose_item(p.w_in + (size_t)l * D * IN_COLS, D, IN_COLS, (bf16*)(p.ws + WS_WIN) + (size_t)l * HCOLS * D, r, HCOLS / 32, scr, lane, MapWin()); continue; } r -= I_WIN;
        if (r < I_SQ) { transpose_item(p.w_out + (size_t)l * D * D, D, D, (bf16*)(p.ws + WS_WOUT) + (size_t)l * D * D, r, D / 32, scr, lane, MapIdent()); continue; } r -= I_SQ;
        if (r < I_SQ) { transpose_item(p.ple_gw + (size_t)l * D * D, D, D, (bf16*)(p.ws + WS_PGW) + (size_t)l * D * D, r, D / 32, scr, lane, MapIdent()); continue; } r -= I_SQ;
        transpose_item(p.ple_w + (size_t)l * 256 * D, 256, D, (bf16*)(p.ws + WS_PW) + (size_t)l * D * 256, r, D / 32, scr, lane, MapIdent());
    }
    cvt_bf16_stream(p.x, (bf16*)(p.ws + WS_XB), (size_t)T * D / 8, (size_t)bid_l() * 512 + tid, (size_t)grid_l() * 512);
}
__device__ __forceinline__ void phase_pro_b(const Params& p, unsigned char* lds) {
    const int tid = tid_l();
    float* ks = (float*)lds;
    float* wqs = ks + 128 * 129;
    for (int it = bid_l(); it < DEPTH * 16 * 16; it += grid_l()) {
        const int l = it >> 8, hc = (it >> 4) & 15, kt = it & 15;
        const float* keys = p.peer_keys + ((size_t)l * 16 + hc) * 16384;
        const float* wq = p.peer_wq + (size_t)l * D * 2048 + (size_t)(kt * 64) * 2048 + hc * 128;
        __syncthreads();
        for (int i = tid; i < 128 * 128; i += 512) ks[(i >> 7) * 129 + (i & 127)] = keys[i];
        for (int i = tid; i < 64 * 128; i += 512) wqs[(i >> 7) * 129 + (i & 127)] = wq[(size_t)(i >> 7) * 2048 + (i & 127)];
        __syncthreads();
        const int k = tid & 63, n0 = (tid >> 6) * 16;
        float acc[16];
#pragma unroll
        for (int j = 0; j < 16; ++j) acc[j] = 0.f;
        for (int d = 0; d < 128; ++d) { const float a = wqs[k * 129 + d];
#pragma unroll
            for (int j = 0; j < 16; ++j) acc[j] += a * ks[(n0 + j) * 129 + d]; }
        bf16* WpT = (bf16*)(p.ws + WS_WP) + (size_t)l * 2048 * D;
#pragma unroll
        for (int j = 0; j < 16; ++j) WpT[(size_t)(hc * 128 + n0 + j) * D + kt * 64 + k] = (bf16)f2bf(acc[j]);
    }
}
constexpr float U8_SCALE = 64.f, V8_SCALE = 16.f;
typedef float f32x2v __attribute__((ext_vector_type(2)));
__device__ __forceinline__ unsigned pk_fp8x4(f32x4 v, float sc) {
    const float a = fminf(fmaxf(v[0] * sc, -448.f), 448.f), b = fminf(fmaxf(v[1] * sc, -448.f), 448.f), c = fminf(fmaxf(v[2] * sc, -448.f), 448.f), d = fminf(fmaxf(v[3] * sc, -448.f), 448.f);
    int w = __builtin_amdgcn_cvt_pk_fp8_f32(a, b, 0, false); w = __builtin_amdgcn_cvt_pk_fp8_f32(c, d, w, true); return (unsigned)w;
}
__device__ __forceinline__ void cvt_fp8_stream(const float* src, unsigned char* dst, size_t n16, float sc, size_t gtid, size_t gthreads) {
    for (size_t i = gtid; i < n16; i += gthreads) { const float* s = src + i * 16; u32x4 o;
        o.x = pk_fp8x4(*(const f32x4*)(s), sc); o.y = pk_fp8x4(*(const f32x4*)(s + 4), sc); o.z = pk_fp8x4(*(const f32x4*)(s + 8), sc); o.w = pk_fp8x4(*(const f32x4*)(s + 12), sc);
        *(u32x4*)(dst + i * 16) = o; }
}
__device__ __forceinline__ void phase_cvt(const Params& p, int l) {
    const size_t gtid = (size_t)bid_l() * 512 + tid_l(), gth = (size_t)grid_l() * 512;
    cvt_bf16_stream(p.p + (size_t)l * T * 256, (bf16*)(p.ws + WS_PB), (size_t)T * 256 / 8, gtid, gth);
    cvt_fp8_stream(p.peer_u + (size_t)l * NEXP * D, p.ws + WS_U, (size_t)NEXP * D / 16, U8_SCALE, gtid, gth);
    cvt_fp8_stream(p.peer_v + (size_t)l * NEXP * D, p.ws + WS_V, (size_t)NEXP * D / 16, V8_SCALE, gtid, gth);
}

#define GEMM_RUN(EPI, e, Aptr, Bptr, N_, K_) do { int kk_ = (K_); asm volatile("" : "+s"(kk_)); pg8::Gemm g{(const pg8::bf16_t*)(Aptr), (const pg8::bf16_t*)(Bptr), T, (N_), kk_}; pg8::StaticOrder S; S.init(T, (N_), (int)grid_l(), (int)bid_l()); \
    pg8::gemm_phase<EPI, pg8::StaticOrder, true, true>((PG8_LAS unsigned char*)lds, g, S, e); } while (0)

__device__ __forceinline__ void phase_gemm_in(const Params& p, int l, unsigned char* lds) {
    pg8::EpiBf16<0> e{(pg8::bf16_t*)(p.ws + WS_H), HCOLS, nullptr, 0, 0, 1.f};
    GEMM_RUN(pg8::EpiBf16<0>, e, p.ws + WS_XB, (bf16*)(p.ws + WS_WIN) + (size_t)l * HCOLS * D, HCOLS, D);
}
__device__ __forceinline__ void phase_gemm_e(const Params& p, int l, unsigned char* lds) {
    pg8::EpiBf16<0> e{(pg8::bf16_t*)(p.ws + WS_E), D, nullptr, 0, 0, 1.f};
    GEMM_RUN(pg8::EpiBf16<0>, e, p.ws + WS_PB, (bf16*)(p.ws + WS_PW) + (size_t)l * D * 256, D, 256);
}
__device__ __forceinline__ void phase_gemm_out(const Params& p, int l, unsigned char* lds) {
    pg8::EpiResid e{(const pg8::bf16_t*)(p.ws + WS_XB), (_Float16*)(p.ws + WS_Y), D, ALPHA};
    GEMM_RUN(pg8::EpiResid, e, p.ws + WS_MIX, (bf16*)(p.ws + WS_WOUT) + (size_t)l * D * D, D, D);
}
__device__ __forceinline__ void phase_gemm_sc(const Params& p, int l, unsigned char* lds) {
    pg8::EpiF16 e{(_Float16*)(p.ws + WS_SC), 2048};
    GEMM_RUN(pg8::EpiF16, e, p.ws + WS_XB, (bf16*)(p.ws + WS_WP) + (size_t)l * 2048 * D, 2048, D);
}
__device__ __forceinline__ void phase_gemm_ple(const Params& p, int l, unsigned char* lds) {
    pg8::EpiPle e{(const pg8::bf16_t*)(p.ws + WS_XB), (_Float16*)(p.ws + WS_Y), (const pg8::bf16_t*)(p.ws + WS_E), p.ple_gb + (size_t)l * D, D};
    GEMM_RUN(pg8::EpiPle, e, p.ws + WS_XB, (bf16*)(p.ws + WS_PGW) + (size_t)l * D * D, D, D);
}

__device__ __forceinline__ void phase_conv(const Params& p, int l, unsigned char* lds) {
    const int tid = tid_l(), lane = tid & 63, wave = tid >> 6;
    float* U = (float*)lds;
    float* Yt = U + 62 * 256;
    const bf16* H = (const bf16*)(p.ws + WS_H); bf16* MIX = (bf16*)(p.ws + WS_MIX);
    const float* cw = p.conv_w + (size_t)l * 31 * 256; const float* cb = p.conv_b + l * 256;
    const float* lg = p.conv_ln_g + l * 256; const float* lb = p.conv_ln_b + l * 256;
    for (int it = bid_l(); it < T / 32; it += grid_l()) {
        const int b = it / (SEQ / 32), t0 = (it % (SEQ / 32)) * 32;
        __syncthreads();
        for (int i = tid; i < 62 * 32; i += 512) { const int r = i >> 5, c8 = (i & 31) * 8, t = t0 - 30 + r; f32x4 u0 = {0.f, 0.f, 0.f, 0.f}, u1 = {0.f, 0.f, 0.f, 0.f};
            if (t >= 0) { const bf16* hr = H + (size_t)(b * SEQ + t) * HCOLS; const u32x4 av = *(const u32x4*)(hr + HC_AVAL + c8), gv = *(const u32x4*)(hr + HC_AGATE + c8);
#pragma unroll
                for (int j = 0; j < 2; ++j) { u0[2 * j] = bf2f(av[j] & 0xffffu) * sigmoidf_(bf2f(gv[j] & 0xffffu)); u0[2 * j + 1] = __uint_as_float(av[j] & 0xffff0000u) * sigmoidf_(__uint_as_float(gv[j] & 0xffff0000u));
                                              u1[2 * j] = bf2f(av[2 + j] & 0xffffu) * sigmoidf_(bf2f(gv[2 + j] & 0xffffu)); u1[2 * j + 1] = __uint_as_float(av[2 + j] & 0xffff0000u) * sigmoidf_(__uint_as_float(gv[2 + j] & 0xffff0000u)); } }
            *(f32x4*)(U + r * 256 + c8) = u0; *(f32x4*)(U + r * 256 + c8 + 4) = u1; }
        __syncthreads();
        { const int c = tid & 255, half = tid >> 8; float w[31], win[46];
#pragma unroll
          for (int j = 0; j < 31; ++j) w[j] = cw[j * 256 + c];
#pragma unroll
          for (int j = 0; j < 46; ++j) win[j] = U[(half * 16 + j) * 256 + c];
          const float bias = cb[c];
#pragma unroll
          for (int tl = 0; tl < 16; ++tl) { float y = bias;
#pragma unroll
              for (int j = 0; j < 31; ++j) y += w[j] * win[tl + j];
              Yt[(half * 16 + tl) * 256 + c] = y; } }
        __syncthreads();
        for (int tl = wave * 4; tl < wave * 4 + 4; ++tl) {
            const f32x4 v = *(const f32x4*)(Yt + tl * 256 + lane * 4);
            const float mean = wave_sum((v[0] + v[1]) + (v[2] + v[3])) * (1.f / 256.f);
            const f32x4 d = v - mean; const float var = wave_sum((d[0] * d[0] + d[1] * d[1]) + (d[2] * d[2] + d[3] * d[3])) * (1.f / 256.f);
            const float rstd = 1.0f / sqrtf(var + LN_EPS);
            const f32x4 g4 = *(const f32x4*)(lg + lane * 4), b4 = *(const f32x4*)(lb + lane * 4);
            float o[4];
#pragma unroll
            for (int i = 0; i < 4; ++i) { const float z = d[i] * rstd * g4[i] + b4[i]; o[i] = z * sigmoidf_(z); }
            u32x2 w2; w2.x = pk2(o[0], o[1]); w2.y = pk2(o[2], o[3]);
            *(u32x2*)(MIX + (size_t)(b * SEQ + t0 + tl) * D + MC_A + lane * 4) = w2;
        }
    }
}

__device__ __forceinline__ void phase_fox_cum(const Params& p, int l, unsigned char* lds) {
    const int tid = tid_l(), lane = tid & 63, wave = tid >> 6;
    float* wsum = (float*)lds;
    const bf16* H = (const bf16*)(p.ws + WS_H); float* CK = (float*)(p.ws + WS_CK);
    for (int bh = bid_l(); bh < 48; bh += grid_l()) {
        const int b = bh / 6, h = bh % 6; const float bias = p.fox_forget_b[l * 6 + h];
        float v[8]; float s = 0.f;
#pragma unroll
        for (int i = 0; i < 8; ++i) { const float f = bf2f(H[(size_t)(b * SEQ + tid * 8 + i) * HCOLS + HC_CF + h]); s += log_sigmoid(f + bias) * LOG2E; v[i] = s; }
        float incl = s;
#pragma unroll
        for (int o = 1; o < 64; o <<= 1) { const float n = __shfl_up(incl, o); if (lane >= o) incl += n; }
        __syncthreads();
        if (lane == 63) wsum[wave] = incl;
        __syncthreads();
        float base = incl - s;
        for (int w = 0; w < wave; ++w) base += wsum[w];
#pragma unroll
        for (int i = 0; i < 8; ++i) CK[(size_t)bh * SEQ + tid * 8 + i] = base + v[i];
    }
}

__device__ __forceinline__ void phase_fox_norm(const Params& p, unsigned char* lds) {
    const int tid = tid_l(), lane = tid & 63, wave = tid >> 6;
    float* qns = (float*)lds; float* kns = qns + 256;
    const bf16* H = (const bf16*)(p.ws + WS_H); float* KT = (float*)(p.ws + WS_FKT); float* QBM = (float*)(p.ws + WS_FQB);
    for (int it = bid_l(); it < 48 * 16; it += grid_l()) {
        const int bh = it >> 4, qb = it & 15, b = bh / 6, h = bh % 6;
        __syncthreads();
        if (tid < 256) { const bf16* row = H + ((size_t)b * SEQ + qb * 256 + tid) * HCOLS + h * 64; float sq = 0.f, sk = 0.f;
#pragma unroll
            for (int j = 0; j < 8; ++j) { const u32x4 qv = *(const u32x4*)(row + HC_CQ + 8 * j), kv = *(const u32x4*)(row + HC_CK + 8 * j);
#pragma unroll
                for (int i = 0; i < 4; ++i) { const float a0 = bf2f(qv[i] & 0xffffu), a1 = __uint_as_float(qv[i] & 0xffff0000u), b0 = bf2f(kv[i] & 0xffffu), b1 = __uint_as_float(kv[i] & 0xffff0000u);
                    sq += a0 * a0 + a1 * a1; sk += b0 * b0 + b1 * b1; } }
            qns[tid] = sqrtf(sq); kns[tid] = sqrtf(sk); }
        __syncthreads();
        if (wave < 5) { float v = wave < 4 ? kns[wave * 64 + lane] : fmaxf(fmaxf(qns[lane], qns[64 + lane]), fmaxf(qns[128 + lane], qns[192 + lane]));
#pragma unroll
            for (int o = 1; o < 64; o <<= 1) v = fmaxf(v, __shfl_xor(v, o));
            if (lane == 0) { if (wave < 4) KT[bh * 64 + 4 * qb + wave] = v; else QBM[bh * 16 + qb] = v; } }
    }
}

typedef short bf16x8_t __attribute__((ext_vector_type(8)));
typedef float f32x16_t __attribute__((ext_vector_type(16)));
__device__ __forceinline__ int crow32(int r, int hi) { return (r & 3) + 8 * (r >> 2) + 4 * hi; }
__device__ __forceinline__ void phase_gla_b1(const Params& p, int l, unsigned char* lds) {
    const int tid = tid_l(), lane = tid & 63, wave = tid >> 6, r32 = lane & 31, hi = lane >> 5;
    bf16* KDT = (bf16*)lds;
    bf16* VT = KDT + 32 * 72;
    float* w2s = (float*)(VT + 64 * 72);
    float* b2s = w2s + 16 * 32;
    const bf16* H = (const bf16*)(p.ws + WS_H);
    float* GCUM = (float*)(p.ws + WS_GCUM); float* GS = (float*)(p.ws + WS_GS); float* GDEC = (float*)(p.ws + WS_GDEC);
    for (int it = bid_l(); it < 48 * 64; it += grid_l()) {
        const int bh = it >> 6, n = it & 63, b = bh / 6, h = bh % 6; const size_t tok0 = (size_t)b * SEQ + n * 64;
        __syncthreads();
        w2s[tid] = p.gla_gate_w[(size_t)l * 16 * 192 + (tid >> 5) * 192 + h * 32 + (tid & 31)];
        if (tid < 32) b2s[tid] = p.gla_gate_b[l * 192 + h * 32 + tid];
        { const int s_ = tid >> 3, e0 = (tid & 7) * 8; const u32x4 vv = *(const u32x4*)(H + (tok0 + s_) * HCOLS + HC_BV + h * 64 + e0);
#pragma unroll
          for (int i = 0; i < 4; ++i) { VT[(e0 + 2 * i) * 72 + s_] = (bf16)(vv[i] & 0xffffu); VT[(e0 + 2 * i + 1) * 72 + s_] = (bf16)(vv[i] >> 16); } }
        const u32x4 lr0 = *(const u32x4*)(H + (tok0 + lane) * HCOLS + HC_LR), lr1 = *(const u32x4*)(H + (tok0 + lane) * HCOLS + HC_LR + 8);
        const int d0 = wave * 4;
        const u32x2 kk = *(const u32x2*)(H + (tok0 + lane) * HCOLS + HC_BK + h * 32 + d0);
        __syncthreads();
        float lrf[16];
#pragma unroll
        for (int i = 0; i < 4; ++i) { lrf[2 * i] = bf2f(lr0[i] & 0xffffu); lrf[2 * i + 1] = __uint_as_float(lr0[i] & 0xffff0000u); lrf[8 + 2 * i] = bf2f(lr1[i] & 0xffffu); lrf[8 + 2 * i + 1] = __uint_as_float(lr1[i] & 0xffff0000u); }
        float g[4];
#pragma unroll
        for (int dd = 0; dd < 4; ++dd) { float x = b2s[d0 + dd];
#pragma unroll
            for (int r = 0; r < 16; ++r) x += lrf[r] * w2s[r * 32 + d0 + dd];
            g[dd] = log_sigmoid(x) * (1.0f / 16.0f); }
#pragma unroll
        for (int o = 1; o < 64; o <<= 1)
#pragma unroll
            for (int dd = 0; dd < 4; ++dd) { const float v = __shfl_up(g[dd], o); if (lane >= o) g[dd] += v; }
        *(f32x4*)(GCUM + (tok0 + lane) * 192 + h * 32 + d0) = (f32x4){g[0], g[1], g[2], g[3]};
        const float kf[4] = {bf2f(kk.x & 0xffffu), __uint_as_float(kk.x & 0xffff0000u), bf2f(kk.y & 0xffffu), __uint_as_float(kk.y & 0xffff0000u)};
#pragma unroll
        for (int dd = 0; dd < 4; ++dd) { const float last = __uint_as_float(__builtin_amdgcn_readlane(__float_as_uint(g[dd]), 63));
            KDT[(d0 + dd) * 72 + lane] = (bf16)f2bf(kf[dd] * __expf(last - g[dd]));
            if (lane == 63) GDEC[(size_t)it * 32 + d0 + dd] = __expf(last); }
        __syncthreads();
        if (wave < 2) {
            f32x16_t acc = {};
#pragma unroll
            for (int ks = 0; ks < 4; ++ks) { const bf16x8_t a = *(const bf16x8_t*)(KDT + r32 * 72 + 16 * ks + 8 * hi), bb = *(const bf16x8_t*)(VT + (32 * wave + r32) * 72 + 16 * ks + 8 * hi);
                acc = __builtin_amdgcn_mfma_f32_32x32x16_bf16(a, bb, acc, 0, 0, 0); }
#pragma unroll
            for (int r = 0; r < 16; ++r) GS[(size_t)it * 2048 + crow32(r, hi) * 64 + 32 * wave + r32] = acc[r];
        }
    }
}
__device__ __forceinline__ void phase_gla_b2(const Params& p) {
    float* GS = (float*)(p.ws + WS_GS); const float* GDEC = (const float*)(p.ws + WS_GDEC);
    for (int g = bid_l() * 512 + tid_l(); g < 48 * 2048; g += grid_l() * 512) {
        const int bh = g >> 11, de = g & 2047, d = de >> 6; float S = 0.f;
        float* gs = GS + (size_t)bh * 64 * 2048 + de; const float* gd = GDEC + (size_t)bh * 64 * 32 + d;
#pragma unroll 1
        for (int n0 = 0; n0 < 64; n0 += 16) { float loc[16], dec[16];
#pragma unroll
            for (int i = 0; i < 16; ++i) { loc[i] = gs[(size_t)(n0 + i) * 2048]; dec[i] = gd[(n0 + i) * 32]; }
#pragma unroll
            for (int i = 0; i < 16; ++i) { gs[(size_t)(n0 + i) * 2048] = S; S = S * dec[i] + loc[i]; } }
    }
}
__device__ __forceinline__ void phase_gla_b3(const Params& p, int l, unsigned char* lds) {
    const int tid = tid_l(), lane = tid & 63, wave = tid >> 6, r32 = lane & 31, hi = lane >> 5;
    bf16* QE = (bf16*)lds;
    bf16* KE = QE + 64 * 40;
    bf16* VT = KE + 64 * 40;
    bf16* ST = VT + 64 * 72;
    bf16* P = ST + 64 * 40;
    float* O = (float*)(P + 64 * 72);
    const bf16* H = (const bf16*)(p.ws + WS_H); bf16* MIX = (bf16*)(p.ws + WS_MIX);
    const float* GCUM = (const float*)(p.ws + WS_GCUM); const float* GS = (const float*)(p.ws + WS_GS);
    for (int it = bid_l(); it < 48 * 64; it += grid_l()) {
        const int bh = it >> 6, n = it & 63, b = bh / 6, h = bh % 6; const size_t tok0 = (size_t)b * SEQ + n * 64;
        __syncthreads();
        { const int t = tid >> 3, d0 = (tid & 7) * 4;
          const u32x2 qq = *(const u32x2*)(H + (tok0 + t) * HCOLS + HC_BQ + h * 32 + d0), kk = *(const u32x2*)(H + (tok0 + t) * HCOLS + HC_BK + h * 32 + d0);
          const f32x4 c = *(const f32x4*)(GCUM + (tok0 + t) * 192 + h * 32 + d0);
          const float e0 = __expf(c[0]), e1 = __expf(c[1]), e2 = __expf(c[2]), e3 = __expf(c[3]);
          u32x2 qo, ko;
          qo.x = pk2(bf2f(qq.x & 0xffffu) * e0, __uint_as_float(qq.x & 0xffff0000u) * e1); qo.y = pk2(bf2f(qq.y & 0xffffu) * e2, __uint_as_float(qq.y & 0xffff0000u) * e3);
          ko.x = pk2(bf2f(kk.x & 0xffffu) / e0, __uint_as_float(kk.x & 0xffff0000u) / e1); ko.y = pk2(bf2f(kk.y & 0xffffu) / e2, __uint_as_float(kk.y & 0xffff0000u) / e3);
          *(u32x2*)(QE + t * 40 + d0) = qo; *(u32x2*)(KE + t * 40 + d0) = ko; }
        { const int s_ = tid >> 3, e0 = (tid & 7) * 8; const u32x4 vv = *(const u32x4*)(H + (tok0 + s_) * HCOLS + HC_BV + h * 64 + e0);
#pragma unroll
          for (int i = 0; i < 4; ++i) { VT[(e0 + 2 * i) * 72 + s_] = (bf16)(vv[i] & 0xffffu); VT[(e0 + 2 * i + 1) * 72 + s_] = (bf16)(vv[i] >> 16); } }
        { const int d = tid >> 4, e0 = (tid & 15) * 4; const f32x4 sv = *(const f32x4*)(GS + (size_t)it * 2048 + d * 64 + e0);
#pragma unroll
          for (int i = 0; i < 4; ++i) ST[(e0 + i) * 40 + d] = (bf16)f2bf(sv[i]); }
        __syncthreads();
        f32x16_t acc = {};
        const int tt = (wave & 3) >> 1, tc = wave & 1;
        if (wave < 4) {
            if (!(tt == 0 && tc == 1)) {
#pragma unroll
                for (int ks = 0; ks < 2; ++ks) { const bf16x8_t a = *(const bf16x8_t*)(QE + (32 * tt + r32) * 40 + 16 * ks + 8 * hi), bb = *(const bf16x8_t*)(KE + (32 * tc + r32) * 40 + 16 * ks + 8 * hi);
                    acc = __builtin_amdgcn_mfma_f32_32x32x16_bf16(a, bb, acc, 0, 0, 0); }
#pragma unroll
                for (int r = 0; r < 16; ++r) { const int trow = 32 * tt + crow32(r, hi), scol = 32 * tc + r32; P[trow * 72 + scol] = (bf16)f2bf(scol <= trow ? acc[r] : 0.f); }
            }
        } else {
#pragma unroll
            for (int ks = 0; ks < 2; ++ks) { const bf16x8_t a = *(const bf16x8_t*)(QE + (32 * tt + r32) * 40 + 16 * ks + 8 * hi), bb = *(const bf16x8_t*)(ST + (32 * tc + r32) * 40 + 16 * ks + 8 * hi);
                acc = __builtin_amdgcn_mfma_f32_32x32x16_bf16(a, bb, acc, 0, 0, 0); }
        }
        __syncthreads();
        if (wave >= 4) {
            const int nks = tt == 0 ? 2 : 4;
            for (int ks = 0; ks < nks; ++ks) { const bf16x8_t a = *(const bf16x8_t*)(P + (32 * tt + r32) * 72 + 16 * ks + 8 * hi), bb = *(const bf16x8_t*)(VT + (32 * tc + r32) * 72 + 16 * ks + 8 * hi);
                acc = __builtin_amdgcn_mfma_f32_32x32x16_bf16(a, bb, acc, 0, 0, 0); }
#pragma unroll
            for (int r = 0; r < 16; ++r) O[(32 * tt + crow32(r, hi)) * 65 + 32 * tc + r32] = acc[r];
        }
        __syncthreads();
        { const int t = tid >> 3, e0 = (tid & 7) * 8; float o[8]; float ss = 0.f;
#pragma unroll
          for (int i = 0; i < 8; ++i) { o[i] = O[t * 65 + e0 + i]; ss += o[i] * o[i]; }
          ss += __shfl_xor(ss, 1); ss += __shfl_xor(ss, 2); ss += __shfl_xor(ss, 4);
          const float rs = 1.0f / sqrtf(ss * (1.f / 64.f) + LN_EPS);
          const float* ng = p.gla_norm_g + l * 384 + h * 64 + e0; const u32x4 gr = *(const u32x4*)(H + (tok0 + t) * HCOLS + HC_BG + h * 64 + e0);
          float r[8];
#pragma unroll
          for (int i = 0; i < 4; ++i) { const float ga = bf2f(gr[i] & 0xffffu), gb = __uint_as_float(gr[i] & 0xffff0000u);
              r[2 * i] = o[2 * i] * rs * ng[2 * i] * (ga * sigmoidf_(ga)); r[2 * i + 1] = o[2 * i + 1] * rs * ng[2 * i + 1] * (gb * sigmoidf_(gb)); }
          u32x4 w; w.x = pk2(r[0], r[1]); w.y = pk2(r[2], r[3]); w.z = pk2(r[4], r[5]); w.w = pk2(r[6], r[7]);
          *(u32x4*)(MIX + (tok0 + t) * D + MC_B + h * 64 + e0) = w; }
    }
}

constexpr int LDSQ_OFF = LDS_BYTES - 1024;
constexpr int CW_ATTNQ = 8192;
__device__ __forceinline__ void phase_fox_mfma(const Params& p, int l, unsigned char* lds) {
    const attn_body::bf16* H = (const attn_body::bf16*)(p.ws + WS_H);
    const attn_body::AttnTensors AT{H + HC_CQ, H + HC_CK, H + HC_CV, (attn_body::bf16*)(p.ws + WS_MIX) + MC_C, (const float*)(p.ws + WS_CK), (const float*)(p.ws + WS_FKT), (const float*)(p.ws + WS_FQB)};
    const attn_body::QueueOrder S{(unsigned*)(p.ws + WS_CTL) + CW_ATTNQ + l * 64, (volatile __attribute__((address_space(3))) int*)((__attribute__((address_space(3))) unsigned char*)lds + LDSQ_OFF)};
    attn_body::attn_phase<attn_body::QueueOrder>((char*)lds, AT, S);
}

__device__ __forceinline__ void phase_ln(const _Float16* Y, const float* g, const float* bta, float* dst, bf16* dstb) {
    const int tid = tid_l(), lane = tid & 63, wave = tid >> 6;
    for (int row = bid_l() * 8 + wave; row < T; row += grid_l() * 8) {
        const _Float16* yr = Y + (size_t)row * D; f32x4 v[4]; float s = 0.f; typedef _Float16 h4 __attribute__((ext_vector_type(4)));
#pragma unroll
        for (int j = 0; j < 4; ++j) { const h4 w = *(const h4*)(yr + j * 256 + lane * 4); v[j] = (f32x4){(float)w[0], (float)w[1], (float)w[2], (float)w[3]};
            s += (v[j][0] + v[j][1]) + (v[j][2] + v[j][3]); }
        const float mean = wave_sum(s) * (1.f / D); float s2 = 0.f;
#pragma unroll
        for (int j = 0; j < 4; ++j) { v[j] = v[j] - mean; s2 += (v[j][0] * v[j][0] + v[j][1] * v[j][1]) + (v[j][2] * v[j][2] + v[j][3] * v[j][3]); }
        const float rstd = 1.0f / sqrtf(wave_sum(s2) * (1.f / D) + LN_EPS);
#pragma unroll
        for (int j = 0; j < 4; ++j) { const f32x4 g4 = *(const f32x4*)(g + j * 256 + lane * 4), b4 = *(const f32x4*)(bta + j * 256 + lane * 4);
            const f32x4 o = v[j] * rstd * g4 + b4;
            if (dst) *(f32x4*)(dst + (size_t)row * D + j * 256 + lane * 4) = o;
            if (dstb) { u32x2 w; w.x = pk2(o[0], o[1]); w.y = pk2(o[2], o[3]); *(u32x2*)(dstb + (size_t)row * D + j * 256 + lane * 4) = w; } }
    }
}

__device__ __forceinline__ int f2ord(float x) { const int i = __float_as_int(x); return i ^ ((i >> 31) & 0x7fffffff); }
__device__ __forceinline__ float ord2f(int k) { return __int_as_float(k ^ ((k >> 31) & 0x7fffffff)); }
__device__ __forceinline__ void phase_topk(const Params& p, unsigned char* lds) {
    const int tid = tid_l(), lane = tid & 63, wave = tid >> 6;
    unsigned char* wreg = lds + wave * 17408; unsigned char* tab = wreg;
    const _Float16* SC = (const _Float16*)(p.ws + WS_SC); int* EIDX = (int*)(p.ws + WS_EIDX); float* GATE = (float*)(p.ws + WS_GATE); unsigned long long* SOFF = (unsigned long long*)(p.ws + WS_SOFF);
    for (int g = bid_l() * 512 + tid; g < T * 16; g += grid_l() * 512) {
        const int tok = g >> 4, hc = g & 15;
        typedef _Float16 h8 __attribute__((ext_vector_type(8)));
        { const unsigned char* blk = (const unsigned char*)(SC + (size_t)(g - lane) * 128);
          u32x4 st[16];
#pragma unroll
          for (int j = 0; j < 16; ++j) st[j] = *(const u32x4*)(blk + (size_t)(j * 64 + lane) * 16);
          __builtin_amdgcn_wave_barrier();
#pragma unroll
          for (int j = 0; j < 16; ++j) { const int c = j * 64 + lane; *(u32x4*)(wreg + (c + (c >> 4)) * 16) = st[j]; }
          __builtin_amdgcn_wave_barrier(); }
        const unsigned char* lp = wreg + lane * 272;
#define TK_CE(a, b) do { const int hi_ = max(a, b), lo_ = min(a, b); a = hi_; b = lo_; } while (0)
        int tk[16];
#pragma unroll 1
        for (int gi = 0; gi < 8; ++gi) { const h8 cA = *(const h8*)(lp + gi * 32), c1_ = *(const h8*)(lp + gi * 32 + 16);
            int v[16];
#pragma unroll
            for (int j = 0; j < 8; ++j) { v[j] = (f2ord((float)cA[j]) & ~127) | (127 - (gi * 16 + j)); v[8 + j] = (f2ord((float)c1_[j]) & ~127) | (127 - (gi * 16 + 8 + j)); }
            TK_CE(v[0], v[1]); TK_CE(v[3], v[2]); TK_CE(v[4], v[5]); TK_CE(v[7], v[6]); TK_CE(v[8], v[9]); TK_CE(v[11], v[10]); TK_CE(v[12], v[13]); TK_CE(v[15], v[14]); TK_CE(v[0], v[2]); TK_CE(v[1], v[3]); TK_CE(v[6], v[4]); TK_CE(v[7], v[5]); TK_CE(v[8], v[10]); TK_CE(v[9], v[11]); TK_CE(v[14], v[12]); TK_CE(v[15], v[13]); TK_CE(v[0], v[1]); TK_CE(v[2], v[3]); TK_CE(v[5], v[4]); TK_CE(v[7], v[6]); TK_CE(v[8], v[9]); TK_CE(v[10], v[11]); TK_CE(v[13], v[12]); TK_CE(v[15], v[14]); TK_CE(v[0], v[4]); TK_CE(v[1], v[5]); TK_CE(v[2], v[6]); TK_CE(v[3], v[7]); TK_CE(v[12], v[8]); TK_CE(v[13], v[9]); TK_CE(v[14], v[10]); TK_CE(v[15], v[11]); TK_CE(v[0], v[2]); TK_CE(v[1], v[3]); TK_CE(v[4], v[6]); TK_CE(v[5], v[7]); TK_CE(v[10], v[8]); TK_CE(v[11], v[9]); TK_CE(v[14], v[12]); TK_CE(v[15], v[13]); TK_CE(v[0], v[1]); TK_CE(v[2], v[3]); TK_CE(v[4], v[5]); TK_CE(v[6], v[7]); TK_CE(v[9], v[8]); TK_CE(v[11], v[10]); TK_CE(v[13], v[12]); TK_CE(v[15], v[14]); TK_CE(v[0], v[8]); TK_CE(v[1], v[9]); TK_CE(v[2], v[10]); TK_CE(v[3], v[11]); TK_CE(v[4], v[12]); TK_CE(v[5], v[13]); TK_CE(v[6], v[14]); TK_CE(v[7], v[15]); TK_CE(v[0], v[4]); TK_CE(v[1], v[5]); TK_CE(v[2], v[6]); TK_CE(v[3], v[7]); TK_CE(v[8], v[12]); TK_CE(v[9], v[13]); TK_CE(v[10], v[14]); TK_CE(v[11], v[15]); TK_CE(v[0], v[2]); TK_CE(v[1], v[3]); TK_CE(v[4], v[6]); TK_CE(v[5], v[7]); TK_CE(v[8], v[10]); TK_CE(v[9], v[11]); TK_CE(v[12], v[14]); TK_CE(v[13], v[15]); TK_CE(v[0], v[1]); TK_CE(v[2], v[3]); TK_CE(v[4], v[5]); TK_CE(v[6], v[7]); TK_CE(v[8], v[9]); TK_CE(v[10], v[11]); TK_CE(v[12], v[13]); TK_CE(v[14], v[15]);
            if (gi == 0) {
#pragma unroll
                for (int j = 0; j < 16; ++j) tk[j] = v[j]; }
            else {
#pragma unroll
                for (int j = 0; j < 16; ++j) tk[j] = max(tk[j], v[15 - j]);
                TK_CE(tk[0], tk[8]); TK_CE(tk[1], tk[9]); TK_CE(tk[2], tk[10]); TK_CE(tk[3], tk[11]); TK_CE(tk[4], tk[12]); TK_CE(tk[5], tk[13]); TK_CE(tk[6], tk[14]); TK_CE(tk[7], tk[15]); TK_CE(tk[0], tk[4]); TK_CE(tk[1], tk[5]); TK_CE(tk[2], tk[6]); TK_CE(tk[3], tk[7]); TK_CE(tk[8], tk[12]); TK_CE(tk[9], tk[13]); TK_CE(tk[10], tk[14]); TK_CE(tk[11], tk[15]); TK_CE(tk[0], tk[2]); TK_CE(tk[1], tk[3]); TK_CE(tk[4], tk[6]); TK_CE(tk[5], tk[7]); TK_CE(tk[8], tk[10]); TK_CE(tk[9], tk[11]); TK_CE(tk[12], tk[14]); TK_CE(tk[13], tk[15]); TK_CE(tk[0], tk[1]); TK_CE(tk[2], tk[3]); TK_CE(tk[4], tk[5]); TK_CE(tk[6], tk[7]); TK_CE(tk[8], tk[9]); TK_CE(tk[10], tk[11]); TK_CE(tk[12], tk[13]); TK_CE(tk[14], tk[15]); }
            }
        __builtin_amdgcn_wave_barrier();
#undef TK_CE
        float av[16], bv[16]; int ai[16], bi[16]; const bool c1 = (hc & 1) != 0;
#pragma unroll
        for (int j = 0; j < 16; ++j) { const int ok = __shfl_xor(tk[j], 1); const int ka = c1 ? ok : tk[j], kb = c1 ? tk[j] : ok;
            av[j] = ord2f(ka & ~127); ai[j] = 127 - (ka & 127); bv[j] = ord2f(kb & ~127); bi[j] = 127 - (kb & 127); }
#pragma unroll
        for (int j = 0; j < 16; ++j) { tab[j * 64 + lane] = (unsigned char)ai[j]; tab[(16 + j) * 64 + lane] = (unsigned char)bi[j]; }
        int ck[16];
#pragma unroll
        for (int j = 0; j < 16; ++j) ck[j] = (int)0x80000000;
#pragma unroll
        for (int i = 0; i < 16; ++i)
#pragma unroll
            for (int j = 0; j < 16 / (i + 1); ++j) { int x = (f2ord(av[i] + bv[j]) & ~255) | (255 - (i * 16 + j));
#pragma unroll
                for (int q = 0; q < 16; ++q) { const int hi = max(ck[q], x); x = min(ck[q], x); ck[q] = hi; } }
        float den = 0.f; float ex[16]; const float c0 = ord2f(ck[0] & ~255);
#pragma unroll
        for (int j = 0; j < 16; ++j) { ex[j] = __expf(ord2f(ck[j] & ~255) - c0); den += ex[j]; }
        const float inv = 1.0f / den;
        int eid[16]; unsigned long long cnt = 0ull;
#pragma unroll
        for (int j = 0; j < 16; ++j) { const int flat = 255 - (ck[j] & 255); eid[j] = (int)tab[(flat >> 4) * 64 + lane] * 128 + (int)tab[(16 + (flat & 15)) * 64 + lane];
            if (!c1) cnt += 1ull << (8 * (eid[j] >> 11)); }
        unsigned long long incl = cnt;
#pragma unroll
        for (int o = 1; o < 16; o <<= 1) { const unsigned lo = __shfl_up((unsigned)incl, o, 16), hi = __shfl_up((unsigned)(incl >> 32), o, 16); if ((hc & 15) >= o) incl += ((unsigned long long)hi << 32) | lo; }
        const unsigned long long total = ((unsigned long long)__shfl((unsigned)(incl >> 32), 15, 16) << 32) | __shfl((unsigned)incl, 15, 16);
        const unsigned long long base = total * 0x0101010101010100ull;
        unsigned long long run = base + (incl - cnt);
        if (hc == 0) SOFF[tok] = base;
        if (!c1) {
#pragma unroll
            for (int j = 0; j < 16; ++j) { const int sh = 8 * (eid[j] >> 11); const int pos = (int)((run >> sh) & 0xffull); run += 1ull << sh;
                EIDX[(size_t)tok * 128 + pos] = eid[j]; GATE[(size_t)tok * 128 + pos] = ex[j] * inv; } }
    }
}

__device__ __forceinline__ float gelu_tanh(float h) { const float z = 0.7978845608028654f * (h + 0.044715f * h * h * h); const float t = 1.0f - 2.0f / (__expf(2.0f * z) + 1.0f); return 0.5f * h * (1.0f + t); }
struct PeerTok { u32x4 xa, xb; unsigned long long so; int e_lo, e_hi; float g_lo, g_hi; };
__device__ __forceinline__ PeerTok peer_tok_load(const bf16* XB, const int* EIDX, const float* GATE, const unsigned long long* SOFF, int tok, int lane) {
    PeerTok t; const int tk = tok < T ? tok : T - 1;
    t.xa = __builtin_nontemporal_load((const u32x4*)(XB + (size_t)tk * D + lane * 16)); t.xb = __builtin_nontemporal_load((const u32x4*)(XB + (size_t)tk * D + lane * 16 + 8));
    t.so = SOFF[tk]; t.e_lo = EIDX[(size_t)tk * 128 + lane]; t.e_hi = EIDX[(size_t)tk * 128 + 64 + lane]; t.g_lo = GATE[(size_t)tk * 128 + lane]; t.g_hi = GATE[(size_t)tk * 128 + 64 + lane];
    return t;
}
template <int CTRL> __device__ __forceinline__ float dpp_mov(float v) { return __int_as_float(__builtin_amdgcn_update_dpp(0, __float_as_int(v), CTRL, 0xf, 0xf, false)); }
__device__ __forceinline__ float xor16_sum(float v) { const auto r = __builtin_amdgcn_permlane16_swap(__float_as_uint(v), __float_as_uint(v), false, false); return __uint_as_float(r[0]) + __uint_as_float(r[1]); }
__device__ __forceinline__ float xor32_sum(float v) { const auto r = __builtin_amdgcn_permlane32_swap(__float_as_uint(v), __float_as_uint(v), false, false); return __uint_as_float(r[0]) + __uint_as_float(r[1]); }
#define PEER_ISSUE(R, tk, k0_, kl_) do { _Pragma("unroll") for (int q_ = 0; q_ < 8; ++q_) { const int k_ = min((k0_) + q_, (kl_)); \
    const int e_ = __builtin_amdgcn_readlane(k_ < 64 ? (tk).e_lo : (tk).e_hi, k_ & 63); R[q_] = *(const u32x4*)(U8 + (size_t)e_ * D + lane * 16); } } while (0)
__device__ __forceinline__ float gelu_tanh_fast(float h) { const float z = 0.7978845608028654f * (h + 0.044715f * h * h * h); const float t = 1.0f - 2.0f * __builtin_amdgcn_rcpf(__expf(2.0f * z) + 1.0f); return 0.5f * h * (1.0f + t); }
typedef __bf16 bf16x2v __attribute__((ext_vector_type(2)));
#define PEER_DOT(RC, q) do { d[q] = 0.f; _Pragma("unroll") for (int w = 0; w < 4; ++w) { \
            d[q] = __builtin_amdgcn_fdot2_f32_bf16(__builtin_amdgcn_cvt_scalef32_pk_bf16_fp8(RC[q][w], 1.0f / U8_SCALE, false), __builtin_bit_cast(bf16x2v, xp[2 * w]), d[q], false); \
            d[q] = __builtin_amdgcn_fdot2_f32_bf16(__builtin_amdgcn_cvt_scalef32_pk_bf16_fp8(RC[q][w], 1.0f / U8_SCALE, true), __builtin_bit_cast(bf16x2v, xp[2 * w + 1]), d[q], false); } } while (0)
#define PEER_COMPUTE(RC) do { float d[8]; \
    PEER_DOT(RC, 0); PEER_DOT(RC, 1); PEER_DOT(RC, 2); PEER_DOT(RC, 3); \
    if (k0 + 4 < end) { PEER_DOT(RC, 4); PEER_DOT(RC, 5); PEER_DOT(RC, 6); PEER_DOT(RC, 7); } else { d[4] = 0.f; d[5] = 0.f; d[6] = 0.f; d[7] = 0.f; }     \
    float t4[4]; \
    _Pragma("unroll") for (int j = 0; j < 4; ++j) { const float keep = (lane & 1) ? d[2 * j + 1] : d[2 * j], give = (lane & 1) ? d[2 * j] : d[2 * j + 1]; t4[j] = keep + dpp_mov<0xB1>(give); } \
    float sA, sB; \
    { const float keep = (lane & 2) ? t4[1] : t4[0], give = (lane & 2) ? t4[0] : t4[1]; sA = keep + dpp_mov<0x4E>(give); } \
    { const float keep = (lane & 2) ? t4[3] : t4[2], give = (lane & 2) ? t4[2] : t4[3]; sB = keep + dpp_mov<0x4E>(give); } \
    sA += dpp_mov<0x124>(sA); sB += dpp_mov<0x124>(sB); sA += dpp_mov<0x128>(sA); sB += dpp_mov<0x128>(sB); \
    sA = xor16_sum(sA); sB = xor16_sum(sB); sA = xor32_sum(sA); sB = xor32_sum(sB); \
    const float geA = sA, geB = sB;     \
      \
    { const int rel = (lane - k0) & 63; const int src = (rel & 3) << 2; \
      const float ga = __int_as_float(__builtin_amdgcn_ds_bpermute(src, __float_as_int(geA))), gb = __int_as_float(__builtin_amdgcn_ds_bpermute(src, __float_as_int(geB))); \
      const float gq = (rel & 4) ? gb : ga; const int kq = k0 + rel;              \
      c_lo = (rel < 8 && kq < 64) ? gq : c_lo; c_hi = (rel < 8 && kq >= 64) ? gq : c_hi; } } while (0)
#define PEER_KL(st, en) min(max((en) - 1, (st)), 127)
#define PEER_NEXT(RN) do { __builtin_amdgcn_sched_barrier(0); if (k0 + 8 < end) { PEER_ISSUE(RN, c, k0 + 8, PEER_KL(start, end)); } else { PEER_ISSUE(RN, n, nstart, PEER_KL(nstart, nend)); } __builtin_amdgcn_sched_barrier(0); } while (0)
#define PEER_RANGE(tk, st, en) do { const unsigned lo_ = __builtin_amdgcn_readfirstlane((unsigned)(tk).so), hi_ = __builtin_amdgcn_readfirstlane((unsigned)((tk).so >> 32)); \
    const unsigned long long so_ = ((unsigned long long)hi_ << 32) | lo_; st = (int)((so_ >> (8 * g0)) & 0xffull); en = g1 < 8 ? (int)((so_ >> (8 * g1)) & 0xffull) : 128; } while (0)
#define PEER_XV() do { _Pragma("unroll") for (int i = 0; i < 4; ++i) { xp[i] = c.xa[i]; xp[4 + i] = c.xb[i]; } } while (0)
#define PEER_ADVANCE() do { k0 += 8; if (k0 >= end) { \
        if (lane >= start && lane < end) GATE[(size_t)tok * 128 + lane] = c.g_lo * gelu_tanh_fast(c_lo) * (1.0f / V8_SCALE); \
        if (lane + 64 >= start && lane + 64 < end) GATE[(size_t)tok * 128 + 64 + lane] = c.g_hi * gelu_tanh_fast(c_hi) * (1.0f / V8_SCALE); \
        tok += stride; c = n; start = nstart; end = nend; k0 = start; c_lo = 0.f; c_hi = 0.f; PEER_XV(); \
        n = peer_tok_load(XB, EIDX, GATE, SOFF, tok + stride, lane); PEER_RANGE(n, nstart, nend); } } while (0)
__device__ __forceinline__ void phase_peer_u(const Params& p) {
    const int tid = tid_l(), lane = tid & 63, wave = tid >> 6, bid = bid_l(), G = grid_l();
    const bf16* XB = (const bf16*)(p.ws + WS_XB); const unsigned char* U8 = p.ws + WS_U;
    const int* EIDX = (const int*)(p.ws + WS_EIDX); float* GATE = (float*)(p.ws + WS_GATE); const unsigned long long* SOFF = (const unsigned long long*)(p.ws + WS_SOFF);
    const int ngrp = (G % 8 == 0) ? 8 : 1;
    const int g0 = (ngrp == 8) ? (bid & 7) : 0, g1 = (ngrp == 8) ? g0 + 1 : 8, r = (ngrp == 8) ? (bid >> 3) : bid, R = (ngrp == 8) ? (G >> 3) : G;
    const int stride = R * 8; int tok = r * 8 + wave;
    if (tok >= T) return;
    PeerTok c = peer_tok_load(XB, EIDX, GATE, SOFF, tok, lane), n = peer_tok_load(XB, EIDX, GATE, SOFF, tok + stride, lane);
    int start, end, nstart, nend; PEER_RANGE(c, start, end); PEER_RANGE(n, nstart, nend);
    unsigned xp[8]; PEER_XV();
    float c_lo = 0.f, c_hi = 0.f;
    int k0 = start;
    u32x4 Ra[8], Rb[8];
    PEER_ISSUE(Ra, c, start, PEER_KL(start, end));
#pragma unroll 1
    for (;;) {
        PEER_NEXT(Rb); PEER_COMPUTE(Ra); PEER_ADVANCE(); if (tok >= T) break;
        PEER_NEXT(Ra); PEER_COMPUTE(Rb); PEER_ADVANCE(); if (tok >= T) break;
    }
}
#undef PEER_ISSUE
#undef PEER_COMPUTE
#undef PEER_DOT
#undef PEER_NEXT
#undef PEER_KL
#undef PEER_RANGE
#undef PEER_XV
#undef PEER_ADVANCE
__device__ __forceinline__ void phase_peer_v(const Params& p) {
    const int tid = tid_l(), lane = tid & 63, wave = tid >> 6;
    const float* XF = (const float*)(p.ws + WS_XF); const unsigned char* V8 = p.ws + WS_V;
    const int* EIDX = (const int*)(p.ws + WS_EIDX); const float* COEF = (const float*)(p.ws + WS_GATE);
    float* Y = (float*)(p.ws + WS_Y); bf16* XB = (bf16*)(p.ws + WS_XB);
    for (int tok = bid_l() * 8 + wave; tok < T; tok += grid_l() * 8) {
        float acc[16];
#pragma unroll
        for (int i = 0; i < 16; ++i) acc[i] = 0.f;
        const int e_lo = EIDX[(size_t)tok * 128 + lane], e_hi = EIDX[(size_t)tok * 128 + 64 + lane];
        const float c_lo = COEF[(size_t)tok * 128 + lane], c_hi = COEF[(size_t)tok * 128 + 64 + lane];
#pragma unroll 1
        for (int k0 = 0; k0 < 128; k0 += 8) {
            const int esel = k0 < 64 ? e_lo : e_hi; const unsigned csel = __float_as_uint(k0 < 64 ? c_lo : c_hi);
            u32x4 vr[8]; float cf[8];
#pragma unroll
            for (int q = 0; q < 8; ++q) { const int e = __builtin_amdgcn_readlane(esel, (k0 & 63) + q); cf[q] = __uint_as_float(__builtin_amdgcn_readlane(csel, (k0 & 63) + q));
                vr[q] = *(const u32x4*)(V8 + (size_t)e * D + lane * 16); }
#pragma unroll
            for (int q = 0; q < 8; ++q)
#pragma unroll
                for (int w = 0; w < 4; ++w) { const f32x2v a = __builtin_amdgcn_cvt_pk_f32_fp8((int)vr[q][w], false), b = __builtin_amdgcn_cvt_pk_f32_fp8((int)vr[q][w], true);
                    acc[4 * w] += cf[q] * a[0]; acc[4 * w + 1] += cf[q] * a[1]; acc[4 * w + 2] += cf[q] * b[0]; acc[4 * w + 3] += cf[q] * b[1]; }
        }
        float r[16];
#pragma unroll
        for (int w = 0; w < 2; ++w) { const u32x4 a = *(const u32x4*)(XB + (size_t)tok * D + lane * 16 + 8 * w);
#pragma unroll
            for (int i = 0; i < 4; ++i) { r[8 * w + 2 * i] = ALPHA * bf2f(a[i] & 0xffffu) + acc[8 * w + 2 * i]; r[8 * w + 2 * i + 1] = ALPHA * __uint_as_float(a[i] & 0xffff0000u) + acc[8 * w + 2 * i + 1]; } }
#pragma unroll
        for (int w = 0; w < 2; ++w) { u32x4 o; o.x = pk2(r[8 * w], r[8 * w + 1]); o.y = pk2(r[8 * w + 2], r[8 * w + 3]); o.z = pk2(r[8 * w + 4], r[8 * w + 5]); o.w = pk2(r[8 * w + 6], r[8 * w + 7]);
            *(u32x4*)(XB + (size_t)tok * D + lane * 16 + 8 * w) = o; }
    }
}
#define GAS __attribute__((address_space(1)))
#define LAS __attribute__((address_space(3)))
#define XB_TMO      128
#define XB_XCNT(j)  (256  + 64 * (j))
#define XB_XSUB(j)  (1280 + 64 * (j))
#define XB_XGEN(j)  (2304 + 64 * (j))
#define XB_TOP      3328
#define XB_TOPGEN   3392
#define XCD_BAR_WORDS 3456
#define XB_SPIN_CAP (1u << 18)

__device__ __forceinline__ unsigned xb_ld(unsigned* p)              { return __hip_atomic_load(p, __ATOMIC_RELAXED, __HIP_MEMORY_SCOPE_AGENT); }
__device__ __forceinline__ unsigned xb_add(unsigned* p, unsigned v) { return __hip_atomic_fetch_add(p, v, __ATOMIC_RELAXED, __HIP_MEMORY_SCOPE_AGENT); }
__device__ __forceinline__ unsigned xb_xcc_id() { return (unsigned)__builtin_amdgcn_s_getreg((3 << 11) | 20) & 0xFu; }
#define XB_SPIN(cond, bar) do { unsigned _sp = 0; while (cond) { __builtin_amdgcn_s_sleep(1); \
    if ((++_sp & 255u) == 0u) { if (xb_ld(&(bar)[XB_TMO])) break; if (_sp > XB_SPIN_CAP) { atomicAdd(&(bar)[XB_TMO], 1u); break; } } } } while (0)

struct XcdBarrier {
    unsigned* bar; unsigned x;
    volatile LAS unsigned* st;
};

__device__ __forceinline__ XcdBarrier xcd_barrier_post(unsigned* bar, volatile LAS unsigned* st) {
    XcdBarrier b; b.bar = bar; b.x = xb_xcc_id(); b.st = st;
    if (threadIdx.x == 0) (void)xb_add(&bar[XB_XCNT(b.x)], 1u);
    return b;
}
__device__ __forceinline__ void xcd_barrier_complete(unsigned* bar, unsigned x, unsigned& nloc, unsigned& nx) {
    const unsigned G = gridDim.x * gridDim.y * gridDim.z;
    unsigned sum, cnt, mine, sp = 0u;
    for (;;) {
        sum = 0u; cnt = 0u; mine = 0u;
#pragma unroll
        for (unsigned j = 0; j < 16; ++j) { const unsigned c = xb_ld(&bar[XB_XCNT(j)]); sum += c; cnt += (c > 0u) ? 1u : 0u; mine = (j == x) ? c : mine; }
        if (sum == G) break;
        __builtin_amdgcn_s_sleep(1);
        if ((++sp & 255u) == 0u) { if (xb_ld(&bar[XB_TMO])) break; if (sp > XB_SPIN_CAP) { atomicAdd(&bar[XB_TMO], 1u); break; } }
    }
    nloc = mine > 0u ? mine : 1u; nx = cnt > 0u ? cnt : 1u;
}

__device__ __forceinline__ void xcd_barrier(const XcdBarrier& b) {
    asm volatile("s_waitcnt vmcnt(0)" ::: "memory");
    __syncthreads();
    if (threadIdx.x == 0) {
        unsigned* bar = b.bar;
        __builtin_amdgcn_s_waitcnt(0);
        unsigned nloc = b.st[0], nx = b.st[1];
        if (nloc == 0u) { xcd_barrier_complete(bar, b.x, nloc, nx); b.st[0] = nloc; b.st[1] = nx; }
        const unsigned old = xb_add(&bar[XB_XSUB(b.x)], 1u);
        const unsigned gen = old / nloc;
        if (old + 1u == (gen + 1u) * nloc) {
            __builtin_amdgcn_fence(__ATOMIC_RELEASE, "agent");
            asm volatile("s_waitcnt vmcnt(0)" ::: "memory");
            const unsigned og = xb_add(&bar[XB_TOP], 1u);
            const unsigned tg = og / nx;
            if (og + 1u == (tg + 1u) * nx) xb_add(&bar[XB_TOPGEN], 1u);
            else XB_SPIN(xb_ld(&bar[XB_TOPGEN]) == tg, bar);
            __builtin_amdgcn_fence(__ATOMIC_ACQUIRE, "agent");
            xb_add(&bar[XB_XGEN(b.x)], 1u);
            asm volatile("s_waitcnt vmcnt(0)" ::: "memory");
        } else {
            XB_SPIN(xb_ld(&bar[XB_XGEN(b.x)]) == gen, bar);
            __builtin_amdgcn_fence(__ATOMIC_ACQUIRE, "agent");
            asm volatile("s_waitcnt vmcnt(0)" ::: "memory");
        }
    }
    __syncthreads();
}
enum { PH_PRO_A, PH_PRO_B, PH_CVT, PH_GEMM_IN, PH_GEMM_E, PH_CONV, PH_FOXCUM, PH_FOXNORM, PH_GLA1, PH_GLA2, PH_GLA3, PH_FOX, PH_GEMM_OUT, PH_LN1, PH_GEMM_SC, PH_TOPK, PH_PEERU, PH_PEERV, PH_GEMM_PLE, PH_LN2, PH_COUNT };

template <int PH> __device__ __forceinline__ void run_phase(const Params& p, int l, unsigned char* lds) {
    if constexpr (PH == PH_PRO_A) phase_pro_a(p, lds);
    else if constexpr (PH == PH_PRO_B) phase_pro_b(p, lds);
    else if constexpr (PH == PH_CVT) phase_cvt(p, l);
    else if constexpr (PH == PH_GEMM_IN) phase_gemm_in(p, l, lds);
    else if constexpr (PH == PH_GEMM_E) phase_gemm_e(p, l, lds);
    else if constexpr (PH == PH_CONV) phase_conv(p, l, lds);
    else if constexpr (PH == PH_FOXCUM) phase_fox_cum(p, l, lds);
    else if constexpr (PH == PH_FOXNORM) phase_fox_norm(p, lds);
    else if constexpr (PH == PH_GLA1) phase_gla_b1(p, l, lds);
    else if constexpr (PH == PH_GLA2) phase_gla_b2(p);
    else if constexpr (PH == PH_GLA3) phase_gla_b3(p, l, lds);
    else if constexpr (PH == PH_FOX) phase_fox_mfma(p, l, lds);
    else if constexpr (PH == PH_GEMM_OUT) phase_gemm_out(p, l, lds);
    else if constexpr (PH == PH_LN1) phase_ln((const _Float16*)(p.ws + WS_Y), p.ln1_g + (size_t)l * D, p.ln1_b + (size_t)l * D, nullptr, (bf16*)(p.ws + WS_XB));
    else if constexpr (PH == PH_GEMM_SC) phase_gemm_sc(p, l, lds);
    else if constexpr (PH == PH_TOPK) phase_topk(p, lds);
    else if constexpr (PH == PH_PEERU) phase_peer_u(p);
    else if constexpr (PH == PH_PEERV) phase_peer_v(p);
    else if constexpr (PH == PH_GEMM_PLE) phase_gemm_ple(p, l, lds);
    else if constexpr (PH == PH_LN2) phase_ln((const _Float16*)(p.ws + WS_Y), p.ln2_g + (size_t)l * D, p.ln2_b + (size_t)l * D, l == DEPTH - 1 ? p.out : nullptr, l == DEPTH - 1 ? nullptr : (bf16*)(p.ws + WS_XB));
}

constexpr int MISC_OFF = LDS_BYTES - 512;
constexpr int CW_BAR = 4096;
static_assert(MISC_OFF + 128 <= LDS_BYTES && (CW_BAR + XCD_BAR_WORDS) * 4 <= (int)CTL_ZERO_BYTES, "control words");

typedef __attribute__((address_space(4))) const Params CParams;
#define PHASE(PH) do { CParams* q_ = pp; asm volatile("" : "+s"(q_)); Params lp_; __builtin_memcpy(&lp_, q_, sizeof(Params)); run_phase<PH>(lp_, l, lds); } while (0)
__global__ void __launch_bounds__(512, 2) mk_fwd(Params p_unused) {
#if defined(__HIP_DEVICE_COMPILE__)
    extern __shared__ __attribute__((aligned(16))) unsigned char lds[];
    CParams* pp = (CParams*)__builtin_amdgcn_kernarg_segment_ptr();
    unsigned char* ws0; { CParams* q_ = pp; asm volatile("" : "+s"(q_)); ws0 = q_->ws; }
    volatile LAS unsigned* MISC = (volatile LAS unsigned*)((LAS unsigned char*)lds + MISC_OFF);
    if (threadIdx.x < 32) MISC[threadIdx.x] = 0u;
    __syncthreads();
    (void)xcd_barrier_post((unsigned*)(ws0 + WS_CTL) + CW_BAR, MISC + 8);
#define GB() do { CParams* qb_ = pp; asm volatile("" : "+s"(qb_)); XcdBarrier b_; b_.bar = (unsigned*)(qb_->ws + WS_CTL) + CW_BAR; b_.x = xb_xcc_id(); b_.st = MISC + 8; xcd_barrier(b_); } while (0)
    { const int l = 0; PHASE(PH_PRO_A); PHASE(PH_PRO_B); } GB();
    for (int l = 0; l < DEPTH; ++l) {
        PHASE(PH_CVT); PHASE(PH_GEMM_IN); GB();
        PHASE(PH_GEMM_E); PHASE(PH_CONV); PHASE(PH_FOXCUM); PHASE(PH_FOXNORM); PHASE(PH_GLA1); GB();
        PHASE(PH_GLA2); PHASE(PH_FOX); GB();
        PHASE(PH_GLA3); GB();
        PHASE(PH_GEMM_OUT); GB();
        PHASE(PH_LN1); GB();
        PHASE(PH_GEMM_SC); GB();
        PHASE(PH_TOPK); GB();
        PHASE(PH_PEERU); GB();
        PHASE(PH_PEERV); GB();
        PHASE(PH_GEMM_PLE); GB();
        PHASE(PH_LN2); GB();
    }
#undef GB
#endif
}

extern "C" void kernel_launch(void* const* d_in, const int* in_sizes, int n_in, void* d_out, int out_size, void* d_ws, size_t ws_size, hipStream_t stream) {
    static int grid = 0;
    if (grid == 0) {
        if (n_in != 23 || ws_size < WS_END) { fprintf(stderr, "kernel_launch: unexpected n_in %d or ws_size %zu\n", n_in, ws_size); grid = -1; return; }
        int dev = 0, cus = 0, per_cu = 0;
        if (hipGetDevice(&dev) != hipSuccess || hipDeviceGetAttribute(&cus, hipDeviceAttributeMultiprocessorCount, dev) != hipSuccess) { grid = -1; return; }
        if (hipFuncSetAttribute((const void*)mk_fwd, hipFuncAttributeMaxDynamicSharedMemorySize, LDS_BYTES) != hipSuccess) { grid = -1; return; }
        if (hipOccupancyMaxActiveBlocksPerMultiprocessor(&per_cu, (const void*)mk_fwd, 512, LDS_BYTES) != hipSuccess || per_cu < 1) { fprintf(stderr, "kernel_launch: occupancy query says %d\n", per_cu); }
        (void)hipGetLastError();
        grid = cus;
    }
    if (grid < 0) return;
    if (hipMemsetAsync((char*)d_ws + WS_CTL, 0, CTL_ZERO_BYTES, stream) != hipSuccess) return;
    Params p; memset(&p, 0, sizeof(p));
    const float** f = (const float**)&p;
    for (int i = 0; i < 23; ++i) f[i] = (const float*)d_in[i];
    p.out = (float*)d_out; p.ws = (unsigned char*)d_ws;
    hipLaunchKernelGGL(mk_fwd, dim3(grid), dim3(512), LDS_BYTES, stream, p);
}
```

```cpp
#include <hip/hip_runtime.h>
#include <cstdio>
#include <cstdint>
#include <cstring>
#include <cmath>
__device__ __forceinline__ int tid_l() { int t = threadIdx.x; asm volatile("" : "+v"(t)); return t; }
__device__ __forceinline__ int bid_l() { int b = blockIdx.x; asm volatile("" : "+s"(b)); return b; }
__device__ __forceinline__ int grid_l() { int g = gridDim.x; asm volatile("" : "+s"(g)); return g; }
namespace pg8 {
#define PG8_LAS __attribute__((address_space(3)))
typedef unsigned short bf16_t;
typedef short bf16x8 __attribute__((ext_vector_type(8)));
typedef float f32x4 __attribute__((ext_vector_type(4)));
typedef unsigned u32x4 __attribute__((ext_vector_type(4)));
constexpr int BM = 256, BK = 64, HALF = 128, HTB = HALF * BK * 2  , STAGE_BYTES = 8 * HTB, NXCD = 8, WGM = 8;

__host__ __device__ __forceinline__ int lds_byte(int r, int c) { const int st = (r >> 4) * 2 + (c >> 5), rr = r & 15, cc = c & 31, ob = rr * 64 + cc * 2; return st * 1024 + (ob ^ (((ob >> 9) & 1) << 5)); }
__host__ __device__ __forceinline__ void stage_rc(int b, int& R, int& C) { const int st = b / 1024, sb = b % 1024, swz = sb ^ (((sb >> 9) & 1) << 5); R = (st >> 1) * 16 + swz / 64; C = (st & 1) * 32 + (swz % 64) / 2; }
__host__ __device__ __forceinline__ int perm32(int rho) { const int n = rho >> 4, i = rho & 15; return 8 * (i >> 2) + 4 * n + (i & 3); }

struct Unit { int pm, pn; };
struct Gemm { const bf16_t* A; const bf16_t* Bt; int M, N, K; };

struct StaticOrder {
    int nM, nN, nwg, G, c;
    __host__ __device__ void init(int M, int N, int G_, int c_) { nM = M / BM; nN = N / BM; nwg = nM * nN; G = G_; c = c_; }
    __host__ __device__ bool next(int i, Unit& u) const {
        const long L = (long)i * G + c; if (L >= nwg) return false;
        int wgid = (int)L; { const int q = nwg / NXCD, r = nwg % NXCD, xcd = wgid % NXCD, off = wgid / NXCD; wgid = (xcd < r ? xcd * (q + 1) : r * (q + 1) + (xcd - r) * q) + off; }
        const int nig = WGM * nN, gid = wgid / nig, fm = gid * WGM, gsz = (nM - fm) < WGM ? (nM - fm) : WGM;
        u.pm = fm + ((wgid % nig) % gsz); u.pn = (wgid % nig) / gsz; return true;
    }
    __device__ __forceinline__ void a_ready(const Unit&) const {}
    __device__ __forceinline__ void done(const Unit&) const {}
};

__device__ __forceinline__ unsigned cvt_pk_bf16(float lo, float hi) { unsigned r; asm volatile("v_cvt_pk_bf16_f32 %0, %1, %2" : "=v"(r) : "v"(lo), "v"(hi)); return r; }
typedef float f32x2 __attribute__((ext_vector_type(2)));
__device__ __forceinline__ f32x2 gelu_pk(f32x2 v) {
    const f32x2 av = __builtin_elementwise_abs(v), d = av * 0.2316418882f + 1.0f;
    f32x2 t; t.x = __builtin_amdgcn_rcpf(d.x); t.y = __builtin_amdgcn_rcpf(d.y);
    f32x2 q = t * 0.5307027145f + (-0.7265760135f); q = q * t + 0.7107068705f; q = q * t + (-0.142248368f); q = q * t + 0.127414796f; q = q * t;
    const f32x2 s = (v * v) * (-0.72134752044f);
    f32x2 e; e.x = __builtin_amdgcn_exp2f(s.x); e.y = __builtin_amdgcn_exp2f(s.y);
    const f32x2 m = v * (q * e), r = v - m;
    f32x2 o; o.x = v.x < 0.f ? m.x : r.x; o.y = v.y < 0.f ? m.y : r.y; return o;
}

template <int ACT  > struct EpiBf16 {
    static constexpr bool PERM = true, AFTER_DRAIN = false; static_assert(ACT == 0 || ACT == 1, "EpiBf16: ACT is 0 (none) or 1 (gelu_pk)");
    bf16_t* O; int ldc; const float* bias; int split_cols; size_t split_stride; float scale0;
    __device__ __forceinline__ void operator()(const f32x4 (&acc)[2][2][4][2], const Unit& u, int wr, int wc, int fr, int fq) const {
        const int row0 = u.pm * BM + wr * 64 + fr; int colt = u.pn * BM; bf16_t* base = O;
        float sc = 1.f; if (split_cols) { const int t = colt / split_cols; base += (size_t)t * split_stride; colt -= t * split_cols; if (t == 0) sc = scale0; }
        const int col0 = colt + wc * 32 + 8 * fq, bcol0 = u.pn * BM + wc * 32 + 8 * fq;
        f32x4 bv[2][2];
#pragma unroll
        for (int bj = 0; bj < 2; ++bj)
#pragma unroll
            for (int n = 0; n < 2; ++n) bv[bj][n] = bias ? *(const f32x4*)(bias + bcol0 + bj * HALF + 4 * n) : (f32x4){0.f, 0.f, 0.f, 0.f};
#pragma unroll
        for (int ai = 0; ai < 2; ++ai)
#pragma unroll
            for (int m = 0; m < 4; ++m) { bf16_t* rowp = base + (size_t)(row0 + ai * HALF + m * 16) * ldc + col0;
#pragma unroll
                for (int bj = 0; bj < 2; ++bj) { f32x4 v0 = acc[ai][bj][m][0] + bv[bj][0], v1 = acc[ai][bj][m][1] + bv[bj][1];
                    if (ACT == 1) { f32x2 a = gelu_pk((f32x2){v0[0], v0[1]}), b = gelu_pk((f32x2){v0[2], v0[3]}), c = gelu_pk((f32x2){v1[0], v1[1]}), d = gelu_pk((f32x2){v1[2], v1[3]});
                        v0 = (f32x4){a.x, a.y, b.x, b.y}; v1 = (f32x4){c.x, c.y, d.x, d.y}; }
                    v0 = v0 * sc; v1 = v1 * sc; u32x4 w; w.x = cvt_pk_bf16(v0[0], v0[1]); w.y = cvt_pk_bf16(v0[2], v0[3]); w.z = cvt_pk_bf16(v1[0], v1[1]); w.w = cvt_pk_bf16(v1[2], v1[3]);
                    *(u32x4*)(rowp + bj * HALF) = w; } }
    }
};
struct EpiF16 {
    static constexpr bool PERM = true, AFTER_DRAIN = false;
    _Float16* O; int ldc;
    __device__ __forceinline__ void operator()(const f32x4 (&acc)[2][2][4][2], const Unit& u, int wr, int wc, int fr, int fq) const {
        typedef _Float16 h8 __attribute__((ext_vector_type(8)));
        const int row0 = u.pm * BM + wr * 64 + fr, col0 = u.pn * BM + wc * 32 + 8 * fq;
#pragma unroll
        for (int ai = 0; ai < 2; ++ai)
#pragma unroll
            for (int m = 0; m < 4; ++m) { _Float16* rowp = O + (size_t)(row0 + ai * HALF + m * 16) * ldc + col0;
#pragma unroll
                for (int bj = 0; bj < 2; ++bj) { const f32x4 a = acc[ai][bj][m][0], b = acc[ai][bj][m][1];
                    h8 o; o[0] = (_Float16)a[0]; o[1] = (_Float16)a[1]; o[2] = (_Float16)a[2]; o[3] = (_Float16)a[3]; o[4] = (_Float16)b[0]; o[5] = (_Float16)b[1]; o[6] = (_Float16)b[2]; o[7] = (_Float16)b[3];
                    *(h8*)(rowp + bj * HALF) = o; } }
    }
};
struct EpiResid {
    static constexpr bool PERM = true, AFTER_DRAIN = false;
    const bf16_t* res; _Float16* Y; int ldc; float alpha;
    __device__ __forceinline__ void operator()(const f32x4 (&acc)[2][2][4][2], const Unit& u, int wr, int wc, int fr, int fq) const {
        const int row0 = u.pm * BM + wr * 64 + fr, col0 = u.pn * BM + wc * 32 + 8 * fq;
#pragma unroll
        for (int ai = 0; ai < 2; ++ai)
#pragma unroll
            for (int m = 0; m < 4; ++m) { const size_t off = (size_t)(row0 + ai * HALF + m * 16) * ldc + col0;
#pragma unroll
                for (int bj = 0; bj < 2; ++bj) { const u32x4 rv = *(const u32x4*)(res + off + bj * HALF);
                    f32x4 r0, r1; r0[0] = __uint_as_float(rv.x << 16); r0[1] = __uint_as_float(rv.x & 0xffff0000u); r0[2] = __uint_as_float(rv.y << 16); r0[3] = __uint_as_float(rv.y & 0xffff0000u);
                    r1[0] = __uint_as_float(rv.z << 16); r1[1] = __uint_as_float(rv.z & 0xffff0000u); r1[2] = __uint_as_float(rv.w << 16); r1[3] = __uint_as_float(rv.w & 0xffff0000u);
                    const f32x4 y0 = r0 * alpha + acc[ai][bj][m][0], y1 = r1 * alpha + acc[ai][bj][m][1];
                    typedef _Float16 h8 __attribute__((ext_vector_type(8))); h8 w; w[0] = (_Float16)y0[0]; w[1] = (_Float16)y0[1]; w[2] = (_Float16)y0[2]; w[3] = (_Float16)y0[3]; w[4] = (_Float16)y1[0]; w[5] = (_Float16)y1[1]; w[6] = (_Float16)y1[2]; w[7] = (_Float16)y1[3];
                    *(h8*)(Y + off + bj * HALF) = w; } }
    }
};
struct EpiPle {
    static constexpr bool PERM = true, AFTER_DRAIN = false;
    const bf16_t* R; _Float16* Y; const bf16_t* E; const float* gb; int ldc;
    __device__ __forceinline__ void operator()(const f32x4 (&acc)[2][2][4][2], const Unit& u, int wr, int wc, int fr, int fq) const {
        const int row0 = u.pm * BM + wr * 64 + fr, col0 = u.pn * BM + wc * 32 + 8 * fq;
        f32x4 bv[2][2];
#pragma unroll
        for (int bj = 0; bj < 2; ++bj)
#pragma unroll
            for (int n = 0; n < 2; ++n) bv[bj][n] = *(const f32x4*)(gb + col0 + bj * HALF + 4 * n);
#pragma unroll
        for (int ai = 0; ai < 2; ++ai)
#pragma unroll
            for (int m = 0; m < 4; ++m) { const size_t off = (size_t)(row0 + ai * HALF + m * 16) * ldc + col0;
#pragma unroll
                for (int bj = 0; bj < 2; ++bj) {
                    const u32x4 ev = *(const u32x4*)(E + off + bj * HALF), rv = *(const u32x4*)(R + off + bj * HALF);
                    float o[8];
#pragma unroll
                    for (int n = 0; n < 2; ++n) {
                        const f32x4 z = acc[ai][bj][m][n] + bv[bj][n];
                        const unsigned e0 = n == 0 ? ev.x : ev.z, e1 = n == 0 ? ev.y : ev.w, r0 = n == 0 ? rv.x : rv.z, r1 = n == 0 ? rv.y : rv.w;
                        f32x4 ee, rr; ee[0] = __uint_as_float(e0 << 16); ee[1] = __uint_as_float(e0 & 0xffff0000u); ee[2] = __uint_as_float(e1 << 16); ee[3] = __uint_as_float(e1 & 0xffff0000u);
                        rr[0] = __uint_as_float(r0 << 16); rr[1] = __uint_as_float(r0 & 0xffff0000u); rr[2] = __uint_as_float(r1 << 16); rr[3] = __uint_as_float(r1 & 0xffff0000u);
#pragma unroll
                        for (int i = 0; i < 4; ++i) o[4 * n + i] = rr[i] + ee[i] * __builtin_amdgcn_rcpf(1.0f + __expf(-z[i])); }
                    typedef _Float16 h8 __attribute__((ext_vector_type(8))); h8 w;
#pragma unroll
                    for (int i = 0; i < 8; ++i) w[i] = (_Float16)o[i];
                    *(h8*)(Y + off + bj * HALF) = w; } }
    }
};
template <class Epi, class Sched, bool ALIGN_EPI = false, bool SP2 = false>
__device__ __forceinline__ void gemm_phase(PG8_LAS unsigned char* lds, const Gemm g, const Sched& S, const Epi& E) {
    const int tid = tid_l(), wid = __builtin_amdgcn_readfirstlane(tid >> 6), lane = tid & 63, wr = wid >> 2, wc = wid & 3, fr = lane & 15, fq = lane >> 4;
    const int K = g.K, nt = K / BK;
    unsigned voffA[2], voffB[2];
#pragma unroll
    for (int i = 0; i < 2; ++i) { int R, C; stage_rc(tid * 16 + i * 8192, R, C); const int Rb = Epi::PERM ? ((R & ~31) + perm32(R & 31)) : R;
        voffA[i] = (unsigned)(R * K + C) * 2u; voffB[i] = (unsigned)(Rb * K + C) * 2u; }
    const size_t kstep = (size_t)(BK * 2);
    const size_t hstep = (size_t)HALF * K * 2;
    const size_t tstep = 2 * hstep;
    const unsigned ldsw = (unsigned)wid * 1024u;
    const int aoff = lds_byte(wr * 64 + fr, fq * 8), boff = lds_byte(wc * 32 + fr, fq * 8);
#define PG8_SA(b, h) (((b) * 2 + (h)) * HTB)
#define PG8_SB(b, h) ((4 + (b) * 2 + (h)) * HTB)
#define PG8_STAGE(bufoff, gbase, voff) do { _Pragma("unroll") for (int _i = 0; _i < 2; ++_i) \
        __builtin_amdgcn_global_load_lds((const unsigned*)((const char*)(gbase) + (voff)[_i]), (PG8_LAS unsigned*)(lds + (bufoff) + ldsw + _i * 8192), 16, 0, 0); } while (0)
#define PG8_LDA(dst, b, h) do { _Pragma("unroll") for (int m = 0; m < 4; ++m) _Pragma("unroll") for (int k = 0; k < 2; ++k) dst[m][k] = *(const PG8_LAS bf16x8*)(lds + PG8_SA(b, h) + aoff + m * 2048 + k * 1024); } while (0)
#define PG8_LDB(dst, b, h) do { _Pragma("unroll") for (int n = 0; n < 2; ++n) _Pragma("unroll") for (int k = 0; k < 2; ++k) dst[n][k] = *(const PG8_LAS bf16x8*)(lds + PG8_SB(b, h) + boff + n * 2048 + k * 1024); } while (0)
#define PG8_MMA(ai, bj, At, Bt) do { __builtin_amdgcn_s_setprio(1); _Pragma("unroll") for (int m = 0; m < 4; ++m) _Pragma("unroll") for (int n = 0; n < 2; ++n) _Pragma("unroll") for (int k = 0; k < 2; ++k) \
        acc[ai][bj][m][n] = __builtin_amdgcn_mfma_f32_16x16x32_bf16(Bt[n][k], At[m][k], acc[ai][bj][m][n], 0, 0, 0); __builtin_amdgcn_s_setprio(0); } while (0)
#define PG8_WAIT_V(n) asm volatile("s_waitcnt vmcnt(" #n ")" ::: "memory")
#define PG8_WAIT_L(n) asm volatile("s_waitcnt lgkmcnt(" #n ")" ::: "memory")
#define PG8_BAR __builtin_amdgcn_s_barrier()
#define PG8_SCHED __builtin_amdgcn_sched_barrier(0)
    Unit cur, nxt; int ui = 0;
    if (!S.next(0, cur)) return;
    f32x4 acc[2][2][4][2];
#pragma unroll
    for (int a = 0; a < 2; ++a)
#pragma unroll
        for (int b = 0; b < 2; ++b)
#pragma unroll
            for (int m = 0; m < 4; ++m)
#pragma unroll
                for (int n = 0; n < 2; ++n) acc[a][b][m][n] = (f32x4){0.f, 0.f, 0.f, 0.f};
    bf16x8 At[4][2], B0[2][2], B1[2][2];
    const char* cA = (const char*)g.A + (size_t)cur.pm * tstep; const char* cB = (const char*)g.Bt + (size_t)cur.pn * tstep;
    S.a_ready(cur);
    if constexpr (SP2) {
        PG8_STAGE(PG8_SB(0, 0), cB, voffB); PG8_STAGE(PG8_SB(0, 1), cB + hstep, voffB); PG8_STAGE(PG8_SA(0, 0), cA, voffA); PG8_STAGE(PG8_SA(0, 1), cA + hstep, voffA);
        if (wr == 1) PG8_BAR;
        PG8_WAIT_V(2); PG8_BAR;
        PG8_STAGE(PG8_SB(1, 0), cB + kstep, voffB); PG8_STAGE(PG8_SA(1, 0), cA + kstep, voffA); PG8_STAGE(PG8_SB(1, 1), cB + hstep + kstep, voffB);
        PG8_WAIT_V(6); PG8_BAR;
    } else {
        PG8_STAGE(PG8_SB(0, 0), cB, voffB); PG8_STAGE(PG8_SA(0, 0), cA, voffA); PG8_STAGE(PG8_SB(0, 1), cB + hstep, voffB); PG8_STAGE(PG8_SA(0, 1), cA + hstep, voffA);
        if (wr == 1) PG8_BAR;
        PG8_WAIT_V(4); PG8_BAR;
        PG8_STAGE(PG8_SB(1, 0), cB + kstep, voffB); PG8_STAGE(PG8_SA(1, 0), cA + kstep, voffA); PG8_STAGE(PG8_SB(1, 1), cB + hstep + kstep, voffB);
        PG8_WAIT_V(6); PG8_BAR;
    }
    for (;;) {
        const bool has_next = S.next(ui + 1, nxt);
        const char* nA = has_next ? (const char*)g.A + (size_t)nxt.pm * tstep : cA; const char* nB = has_next ? (const char*)g.Bt + (size_t)nxt.pn * tstep : cB;
        for (int t = 0; t < nt; t += 2) {
            const bool last = (t == nt - 2);
            const char* a1 = cA + (size_t)(t + 1) * kstep;
            const char* a2 = last ? nA : cA + (size_t)(t + 2) * kstep; const char* b2 = last ? nB : cB + (size_t)(t + 2) * kstep;
            const char* a3 = a2 + kstep; const char* b3 = b2 + kstep;
            if (last && has_next) S.a_ready(nxt);
            if constexpr (SP2) {
            PG8_LDB(B0, 0, 0); PG8_LDB(B1, 0, 1); PG8_SCHED; PG8_LDA(At, 0, 0); PG8_STAGE(PG8_SA(1, 1), a1 + hstep, voffA);
            PG8_WAIT_V(8); PG8_WAIT_L(0); PG8_BAR; PG8_MMA(0, 0, At, B0); PG8_MMA(0, 1, At, B1); PG8_BAR; PG8_SCHED;
            PG8_LDA(At, 0, 1); PG8_STAGE(PG8_SB(0, 0), b2, voffB); PG8_STAGE(PG8_SB(0, 1), b2 + hstep, voffB); PG8_STAGE(PG8_SA(0, 0), a2, voffA);
            PG8_WAIT_V(8); PG8_WAIT_L(0); PG8_BAR; PG8_MMA(1, 0, At, B0); PG8_MMA(1, 1, At, B1); PG8_BAR; PG8_SCHED;
            PG8_LDB(B0, 1, 0); PG8_LDB(B1, 1, 1); PG8_SCHED; PG8_LDA(At, 1, 0); PG8_STAGE(PG8_SA(0, 1), a2 + hstep, voffA);
            PG8_WAIT_V(8); PG8_WAIT_L(0); PG8_BAR; PG8_MMA(0, 0, At, B0); PG8_MMA(0, 1, At, B1); PG8_BAR; PG8_SCHED;
            PG8_LDA(At, 1, 1); PG8_STAGE(PG8_SB(1, 0), b3, voffB); PG8_STAGE(PG8_SB(1, 1), b3 + hstep, voffB); PG8_STAGE(PG8_SA(1, 0), a3, voffA);
            PG8_WAIT_V(8); PG8_WAIT_L(0); PG8_BAR; PG8_MMA(1, 0, At, B0); PG8_MMA(1, 1, At, B1); PG8_BAR; PG8_SCHED;
            } else {
            PG8_LDB(B0, 0, 0); PG8_SCHED; PG8_LDA(At, 0, 0); PG8_STAGE(PG8_SA(1, 1), a1 + hstep, voffA);
            PG8_WAIT_L(8); PG8_BAR; PG8_WAIT_L(0); PG8_MMA(0, 0, At, B0); PG8_BAR; PG8_SCHED;
            PG8_LDB(B1, 0, 1); PG8_STAGE(PG8_SB(0, 0), b2, voffB);
            PG8_BAR; PG8_WAIT_L(0); PG8_MMA(0, 1, At, B1); PG8_BAR;
            PG8_LDA(At, 0, 1); PG8_STAGE(PG8_SA(0, 0), a2, voffA);
            PG8_BAR; PG8_WAIT_L(0); PG8_MMA(1, 0, At, B0); PG8_BAR; PG8_SCHED;
            PG8_STAGE(PG8_SB(0, 1), b2 + hstep, voffB);
            PG8_WAIT_V(6); PG8_BAR; PG8_MMA(1, 1, At, B1); PG8_BAR;
            PG8_LDB(B0, 1, 0); PG8_SCHED; PG8_LDA(At, 1, 0); PG8_STAGE(PG8_SA(0, 1), a2 + hstep, voffA);
            PG8_WAIT_L(8); PG8_BAR; PG8_WAIT_L(0); PG8_MMA(0, 0, At, B0); PG8_BAR; PG8_SCHED;
            PG8_LDB(B1, 1, 1); PG8_STAGE(PG8_SB(1, 0), b3, voffB);
            PG8_BAR; PG8_WAIT_L(0); PG8_MMA(0, 1, At, B1); PG8_BAR;
            PG8_LDA(At, 1, 1); PG8_STAGE(PG8_SA(1, 0), a3, voffA);
            PG8_BAR; PG8_WAIT_L(0); PG8_MMA(1, 0, At, B0); PG8_BAR; PG8_SCHED;
            PG8_STAGE(PG8_SB(1, 1), b3 + hstep, voffB);
            PG8_WAIT_V(6); PG8_BAR; PG8_MMA(1, 1, At, B1); PG8_BAR;
            }
        }
        if constexpr (ALIGN_EPI) { if (wr == 0) PG8_BAR; }
        if constexpr (!Epi::AFTER_DRAIN) { E(acc, cur, wr, wc, fr, fq); S.done(cur); }
        if (!has_next) break;
#pragma unroll
        for (int a = 0; a < 2; ++a)
#pragma unroll
            for (int b = 0; b < 2; ++b)
#pragma unroll
                for (int m = 0; m < 4; ++m)
#pragma unroll
                    for (int n = 0; n < 2; ++n) acc[a][b][m][n] = (f32x4){0.f, 0.f, 0.f, 0.f};
        cur = nxt; cA = nA; cB = nB; ++ui;
        if constexpr (ALIGN_EPI) { if (wr == 1) PG8_BAR; }
    }
    PG8_WAIT_V(0);
    if constexpr (!ALIGN_EPI) { if (wr == 0) PG8_BAR; }
    PG8_BAR;
    if constexpr (Epi::AFTER_DRAIN) { E.fused(acc, cur, wr, wc, fr, fq, lds, wid, lane); S.done(cur); }
#undef PG8_SA
#undef PG8_SB
#undef PG8_STAGE
#undef PG8_LDA
#undef PG8_LDB
#undef PG8_MMA
#undef PG8_WAIT_V
#undef PG8_WAIT_L
#undef PG8_BAR
#undef PG8_SCHED
}
}
#include <hip/hip_bf16.h>
#include <cmath>
namespace attn_body {
using bf16=__hip_bfloat16;
using bf16x8=__attribute__((ext_vector_type(8)))short;
using s16x4=__attribute__((ext_vector_type(4)))short;
using f32x16=__attribute__((ext_vector_type(16)))float;
using u32x4=__attribute__((ext_vector_type(4)))unsigned;
constexpr int BATCH=8,NHEAD=6,SEQ=4096,D=64,KVP=3072,OP=1024;
constexpr int NW=8,QBLK=32,QB=QBLK*NW,KVBLK=64,NQB=SEQ/QB;
constexpr int ATTN_UNIT_ROWS=QB;
__device__ __forceinline__ int crow(int r,int hi){return (r&3)+8*(r>>2)+4*hi;}
#define SBAR() __builtin_amdgcn_sched_barrier(0)
__device__ __forceinline__ void cmask(f32x16&p0,f32x16&p1,int jb,int qrel,int hi){
  const float NEG=-INFINITY; int kb=64*jb+4*hi;
  #pragma unroll
  for(int r=0;r<16;++r){int kv=kb+(r&3)+8*(r>>2); if(kv>qrel)p0[r]=NEG; if(kv+32>qrel)p1[r]=NEG;}
}

constexpr int NSLOT=3, SLOTB=8192;
constexpr int LDS_K=0, LDS_V=NSLOT*SLOTB, LDS_WS=2*NSLOT*SLOTB, LDS_OST=LDS_WS+NW*64*4, LDS_CK=LDS_OST+NW*4096, LDS_BYTES=LDS_CK+SEQ*4;
constexpr float C2=0.125f*1.4426950408889634f;
__device__ __forceinline__ void glds16(const void*gsrc,unsigned lds_dst){unsigned keep;
  asm volatile("s_mov_b32 %0, m0\n\ts_mov_b32 m0, %2\n\ts_nop 0\n\tglobal_load_lds_dwordx4 %1, off\n\ts_mov_b32 m0, %0":"=&s"(keep):"v"(gsrc),"s"(lds_dst):"memory");}
__device__ __forceinline__ float max3f(float a,float b,float c){float r;asm("v_max3_f32 %0, %1, %2, %3":"=v"(r):"v"(a),"v"(b),"v"(c));return r;}
__device__ __forceinline__ float max2f(float a,float b){float r;asm("v_max_f32_e32 %0, %1, %2":"=v"(r):"v"(a),"v"(b));return r;}
__device__ __forceinline__ float fadd_s(float a,float b){float r;asm("v_add_f32_e32 %0, %1, %2":"=v"(r):"v"(a),"v"(b));return r;}
__device__ __forceinline__ float fsub_s(float a,float b){float r;asm("v_sub_f32_e32 %0, %1, %2":"=v"(r):"v"(a),"v"(b));return r;}
typedef float f32x2_t __attribute__((ext_vector_type(2))); typedef float f32x4_t __attribute__((ext_vector_type(4))); typedef __bf16 bf16x2_t __attribute__((ext_vector_type(2)));
__device__ __forceinline__ unsigned cvtpk_s(float lo,float hi){f32x2_t v={lo,hi};bf16x2_t b=__builtin_convertvector(v,bf16x2_t);return __builtin_bit_cast(unsigned,b);}
#define WAIT_BAR(N) asm volatile("s_waitcnt vmcnt(" #N ") lgkmcnt(0)\n\ts_barrier":::"memory")

__device__ __forceinline__ void qkt(f32x16&p0,f32x16&p1,const char*Kslot,const bf16x8*qr,int r32,int hi){
  const char*kb=Kslot+hi*1024+r32*16;
  #pragma unroll
  for(int d0=0;d0<4;++d0){
    const bf16x8 b0=*reinterpret_cast<const bf16x8*>(kb+d0*2048);
    const bf16x8 b1=*reinterpret_cast<const bf16x8*>(kb+d0*2048+512);
    {p0=__builtin_amdgcn_mfma_f32_32x32x16_bf16(b0,qr[d0],p0,0,0,0);p1=__builtin_amdgcn_mfma_f32_32x32x16_bf16(b1,qr[d0],p1,0,0,0);}}
}
typedef __attribute__((address_space(3))) const char* lds_cptr;
typedef short v4i16_t __attribute__((ext_vector_type(4)));
__device__ __forceinline__ void kload8(bf16x8*kf,lds_cptr kp){
  kf[0]=*(const __attribute__((address_space(3))) bf16x8*)(kp);      kf[1]=*(const __attribute__((address_space(3))) bf16x8*)(kp+512);
  kf[2]=*(const __attribute__((address_space(3))) bf16x8*)(kp+2048); kf[3]=*(const __attribute__((address_space(3))) bf16x8*)(kp+2560);
  kf[4]=*(const __attribute__((address_space(3))) bf16x8*)(kp+4096); kf[5]=*(const __attribute__((address_space(3))) bf16x8*)(kp+4608);
  kf[6]=*(const __attribute__((address_space(3))) bf16x8*)(kp+6144); kf[7]=*(const __attribute__((address_space(3))) bf16x8*)(kp+6656);
}
__device__ __forceinline__ void kload2(bf16x8*kf,lds_cptr kp,int j){ kf[2*j]=*(const __attribute__((address_space(3))) bf16x8*)(kp+j*2048); kf[2*j+1]=*(const __attribute__((address_space(3))) bf16x8*)(kp+j*2048+512); }
__device__ __forceinline__ s16x4 vtr(lds_cptr p){ return __builtin_bit_cast(s16x4,__builtin_amdgcn_ds_read_tr16_b64_v4i16((__attribute__((address_space(3))) v4i16_t*)p)); }
__device__ __forceinline__ float rowmax(const f32x16&p0,const f32x16&p1){
  float a=max3f(p0[0],p0[1],p1[0]),b=max3f(p0[2],p0[3],p1[1]);a=max3f(a,p1[2],p1[3]);
  #pragma unroll
  for(int r=4;r<16;r+=4){a=max3f(a,p0[r],p0[r+1]);b=max3f(b,p0[r+2],p0[r+3]);a=max3f(a,p1[r],p1[r+1]);b=max3f(b,p1[r+2],p1[r+3]);}
  const float m=max2f(a,b);
  auto rr=__builtin_amdgcn_permlane32_swap(__float_as_uint(m),__float_as_uint(m),false,false);
  return max2f(__uint_as_float(rr[0]),__uint_as_float(rr[1]));
}
__device__ __forceinline__ void pv(f32x16*o,int vb,bf16x8 pa0,bf16x8 pa1,bf16x8 pa2,bf16x8 pa3){
  #pragma unroll
  for(int d0=0;d0<2;++d0){s16x4 lo[4],hi[4];
    #pragma unroll
    for(int ks=0;ks<4;++ks){
      asm volatile("ds_read_b64_tr_b16 %0,%1 offset:%c2":"=&v"(lo[ks]):"v"(vb),"i"(d0*4096+ks*1024):"memory");
      asm volatile("ds_read_b64_tr_b16 %0,%1 offset:%c2":"=&v"(hi[ks]):"v"(vb),"i"(d0*4096+ks*1024+512):"memory");}
    asm volatile("s_waitcnt lgkmcnt(0)":::"memory");SBAR();
    #define PK(k) (bf16x8){lo[k][0],lo[k][1],lo[k][2],lo[k][3],hi[k][0],hi[k][1],hi[k][2],hi[k][3]}
    o[d0]=__builtin_amdgcn_mfma_f32_32x32x16_bf16(pa0,PK(0),o[d0],0,0,0);
    o[d0]=__builtin_amdgcn_mfma_f32_32x32x16_bf16(pa1,PK(1),o[d0],0,0,0);
    o[d0]=__builtin_amdgcn_mfma_f32_32x32x16_bf16(pa2,PK(2),o[d0],0,0,0);
    o[d0]=__builtin_amdgcn_mfma_f32_32x32x16_bf16(pa3,PK(3),o[d0],0,0,0);
    #undef PK
  }
}

#ifndef ATTN_STORE16
#define ATTN_STORE16(p,v) (*(u32x4*)(p)=(v))
#endif
template<int THRL> __device__ __forceinline__ void attn_unit(int b,int h,int qb,const bf16*Q,const bf16*__restrict__ K,const bf16*__restrict__ V,bf16*O,const float*__restrict__ CKg,const float*__restrict__ KTm,const float*__restrict__ QBm,char*shm){
  const int tid=tid_l(),lane=tid&63,r32=lane&31,hi=lane>>5; const int wid=__builtin_amdgcn_readfirstlane(tid>>6);
  const long rowbase=(long)b*SEQ; const int q0=qb*QB;
  const bf16*Qw=Q+(rowbase+q0+wid*QBLK)*KVP+h*D;
  const float*ckg=CKg+(long)(b*NHEAD+h)*SEQ;
  int j0=0;
  { const int bh_=b*NHEAD+h, NT0_=(q0+QB)/KVBLK; const float qmx=QBm[bh_*NQB+qb]*1.01f;
    const float kd=fmaxf(fmaxf(KTm[bh_*64+4*qb],KTm[bh_*64+4*qb+1]),fmaxf(KTm[bh_*64+4*qb+2],KTm[bh_*64+4*qb+3]));
    const float thr=-(qmx*kd)-48.f; bool skip=false;
    if(lane<NT0_-4){ const float bound=qmx*KTm[bh_*64+lane]+(ckg[q0]-ckg[64*lane+63]); skip=bound<thr; }
    const unsigned long long m_=__ballot(skip); j0=__builtin_ctzll(~m_); j0=(j0<NT0_-4?j0:NT0_-4)&~1; j0=__builtin_amdgcn_readfirstlane(j0); }
  const bf16*Kh=K+(rowbase+(long)j0*KVBLK)*KVP+h*D,*Vh=V+(rowbase+(long)j0*KVBLK)*KVP+h*D;
  const unsigned lds0=(unsigned)(uintptr_t)shm;
  float*wsf=(float*)(shm+LDS_WS)+wid*64;
  const bf16*ksrc=Kh+(long)lane*KVP+wid*8;
  const bf16*vsrc=Vh+(long)(16*(wid&3)+(lane>>2))*KVP+(wid>>2)*32+(lane&3)*8;
  const unsigned kdst=lds0+LDS_K+wid*1024, vdst=lds0+LDS_V+wid*1024;
  #define DMA_K(t,slot) glds16(ksrc+(long)(t)*KVBLK*KVP,(unsigned)__builtin_amdgcn_readfirstlane(kdst+(slot)))
  #define DMA_V(t,slot) glds16(vsrc+(long)(t)*KVBLK*KVP,(unsigned)__builtin_amdgcn_readfirstlane(vdst+(slot)))
  const int vb0=(int)(lds0+LDS_V)+((lane>>4)&1)*32+(lane&3)*8+(4*hi+((lane&15)>>2))*64;
  const char*Kbase=shm+LDS_K; bf16x8 kf[8];
  const lds_cptr shm3=(lds_cptr)shm; const lds_cptr kp0=shm3+LDS_K+hi*1024+r32*16; const lds_cptr vp0=shm3+LDS_V+((lane>>4)&1)*32+(lane&3)*8+(4*hi+((lane&15)>>2))*64;
  const int NT=(q0+QB)/KVBLK-j0;
  float*cks=(float*)(shm+LDS_CK);
  for(int i=j0*KVBLK+tid*4;i<q0+QB;i+=NW*64*4){ *(f32x4_t*)(cks+i)=*(const f32x4_t*)(ckg+i); }
  float cqm=ckg[q0+wid*QBLK+r32];
  const lds_cptr ckp=(lds_cptr)shm+LDS_CK+j0*256+hi*16;
  DMA_K(0,0);DMA_V(0,0);DMA_K(1,SLOTB);
  bf16x8 qr[4];
  #pragma unroll
  for(int d0=0;d0<4;++d0)qr[d0]=*reinterpret_cast<const bf16x8*>(&Qw[(long)r32*KVP+d0*16+hi*8]);
  float l_reg=0.f;f32x16 o[2];o[0]=f32x16{};o[1]=f32x16{};
  #define CINIT(C0,C1,t) do{ const lds_cptr cp_=ckp+(t)*256; \
    _Pragma("unroll") for(int g_=0;g_<4;++g_){ const f32x4_t a_=*(const __attribute__((address_space(3))) f32x4_t*)(cp_+g_*32); const f32x4_t b_=*(const __attribute__((address_space(3))) f32x4_t*)(cp_+g_*32+128); \
      _Pragma("unroll") for(int i_=0;i_<4;++i_){ C0[g_*4+i_]=cqm-a_[i_]; C1[g_*4+i_]=cqm-b_[i_]; } } }while(0)
  const int qrel=wid*QBLK+r32;
  #define CMASK(P0,P1,t) do{int jb_=(t)-(NT-4); if(jb_>=0)cmask(P0,P1,jb_,qrel,hi);}while(0)
  bool resc=false;
  #define START(P0,P1) do{ const float rm=rowmax(P0,P1); resc=false; \
    { const float dl=rm; \
      _Pragma("unroll") for(int r=0;r<16;++r){P0[r]=fsub_s(P0[r],dl);P1[r]=fsub_s(P1[r],dl);} \
      cqm=fsub_s(cqm,dl); } \
    _Pragma("unroll") for(int r=0;r<16;++r)P0[r]=__builtin_amdgcn_exp2f(P0[r]); }while(0)
  #define RESC() do{ if(resc){ asm volatile("s_waitcnt lgkmcnt(0)":::"memory"); \
      _Pragma("unroll") for(int d_=0;d_<2;++d_) _Pragma("unroll") for(int r=0;r<16;++r)o[d_][r]*=wsf[crow(r,hi)]; } }while(0)
  f32x16 pA0,pA1,pB0,pB1;
  int sl_prev=0,sl_cur=0,sl_next=SLOTB;
  #define ROT() do{sl_prev=sl_cur;sl_cur=sl_next;sl_next=(sl_next==(NSLOT-1)*SLOTB)?0:sl_next+SLOTB;}while(0)
  DMA_K(2,2*SLOTB);
  WAIT_BAR(3);
  CINIT(pA0,pA1,0);
  qkt(pA0,pA1,Kbase,qr,r32,hi);asm volatile("s_nop 15\n\ts_nop 7":"+v"(pA0),"+v"(pA1));CMASK(pA0,pA1,0);
  START(pA0,pA1);
  _Pragma("unroll") for(int r=0;r<16;++r)pA1[r]=__builtin_amdgcn_exp2f(pA1[r]);
  WAIT_BAR(0);
  DMA_K(3,0);DMA_V(1,SLOTB);
  ROT();
  kload8(kf,kp0+sl_cur);
  WAIT_BAR(2);
  s16x4 vlo[8],vhi[8]; u32x4 pw0,pw1,pw2,pw3;
  #define PKW(P,B) cvtpk_s(P[B],P[B+1])
  #define PAF(k) __builtin_bit_cast(bf16x8,pw##k)
  #define VFR(i) (bf16x8){vlo[i][0],vlo[i][1],vlo[i][2],vlo[i][3],vhi[i][0],vhi[i][1],vhi[i][2],vhi[i][3]}
  #define PIN(x) asm volatile("":"+v"(x))
  #define MX3(a,b,c) __builtin_fmaxf(__builtin_fmaxf((a),(b)),(c))
  #define GAPA(MF,A0,A1,A2,A3,W0,W1,PW) do{ MF; sacc+=A0; sacc+=A1; sacc+=A2; sacc+=A3; PIN(sacc); W0; W1; PIN(PW); SBAR(); }while(0)
  #define EX(v) __builtin_amdgcn_exp2f(v)
  #define GAPB(MF,X,B) do{ MF; X[B]=EX(X[B]); X[B+1]=EX(X[B+1]); X[B+2]=EX(X[B+2]); X[B+3]=EX(X[B+3]); PIN(X); SBAR(); }while(0)
  #define VRD(i) do{ vlo[i]=vtr(vp_+(((i)>>2)*4096+((i)&3)*1024)); vhi[i]=vtr(vp_+(((i)>>2)*4096+((i)&3)*1024+512)); }while(0)
  #define KRD(G,j) do{ if(G){ kload2(kf,kp0+sl_next,j); SBAR(); } }while(0)
  #define STEP(C0,C1,P0,P1,t,GK,GV,GL) do{ SBAR(); \
    CINIT(C0,C1,t); SBAR(); \
    const lds_cptr vp_=vp0+sl_prev; \
    VRD(0); SBAR(); float sacc=(P0[0]+P0[1]); \
    GAPA(C0=__builtin_amdgcn_mfma_f32_32x32x16_bf16(kf[0],qr[0],C0,0,0,0), P0[2],P0[3],P0[4],P0[5],     pw0[0]=PKW(P0,0), pw0[1]=PKW(P0,2), pw0); \
    VRD(4); SBAR(); GAPA(C1=__builtin_amdgcn_mfma_f32_32x32x16_bf16(kf[1],qr[0],C1,0,0,0), P0[6],P0[7],P0[8],P0[9],     pw0[2]=PKW(P0,4), pw0[3]=PKW(P0,6), pw0); \
    VRD(1); SBAR(); GAPA(C0=__builtin_amdgcn_mfma_f32_32x32x16_bf16(kf[2],qr[1],C0,0,0,0),   P0[10],P0[11],P0[12],P0[13], pw1[0]=PKW(P0,8), pw1[1]=PKW(P0,10), pw1); \
    VRD(5); SBAR(); GAPA(C1=__builtin_amdgcn_mfma_f32_32x32x16_bf16(kf[3],qr[1],C1,0,0,0),   P0[14],P0[15],P1[0],P1[1],   pw1[2]=PKW(P0,12),pw1[3]=PKW(P0,14), pw1); \
    VRD(2); SBAR(); GAPA(C0=__builtin_amdgcn_mfma_f32_32x32x16_bf16(kf[4],qr[2],C0,0,0,0),   P1[2],P1[3],P1[4],P1[5],     pw2[0]=PKW(P1,0), pw2[1]=PKW(P1,2), pw2); \
    VRD(6); SBAR(); GAPA(C1=__builtin_amdgcn_mfma_f32_32x32x16_bf16(kf[5],qr[2],C1,0,0,0),   P1[6],P1[7],P1[8],P1[9],     pw2[2]=PKW(P1,4), pw2[3]=PKW(P1,6), pw2); \
    VRD(3); SBAR(); GAPA(C0=__builtin_amdgcn_mfma_f32_32x32x16_bf16(kf[6],qr[3],C0,0,0,0),   P1[10],P1[11],P1[12],P1[13], pw3[0]=PKW(P1,8), pw3[1]=PKW(P1,10), pw3); \
    VRD(7); SBAR(); GAPA(C1=__builtin_amdgcn_mfma_f32_32x32x16_bf16(kf[7],qr[3],C1,0,0,0),   P1[14],P1[15],0.f,0.f,       pw3[2]=PKW(P1,12),pw3[3]=PKW(P1,14), pw3); \
    l_reg+=sacc; \
    if(GK){DMA_K((t)+3,sl_cur);} if(GV){DMA_V((t)+1,sl_next);} \
    CMASK(C0,C1,t); \
    { float a=MX3(C0[0],C0[1],C1[0]),b=MX3(C0[2],C0[3],C1[1]); a=MX3(a,C1[2],C1[3]); \
      _Pragma("unroll") for(int r=4;r<16;r+=4){a=MX3(a,C0[r],C0[r+1]);b=MX3(b,C0[r+2],C0[r+3]);a=MX3(a,C1[r],C1[r+1]);b=MX3(b,C1[r+2],C1[r+3]);} \
      float rm=__builtin_fmaxf(a,b); { auto rr=__builtin_amdgcn_permlane32_swap(__float_as_uint(rm),__float_as_uint(rm),false,false); rm=__builtin_fmaxf(__uint_as_float(rr[0]),__uint_as_float(rr[1])); } \
      resc=false; \
      if(__builtin_expect(__any(rm>(float)THRL),0)){ const float dl=__builtin_fmaxf(rm,0.f); \
        _Pragma("unroll") for(int r=0;r<16;++r){C0[r]-=dl;C1[r]-=dl;} \
        cqm-=dl; \
        const float f=__builtin_amdgcn_exp2f(-dl); l_reg*=f; if(hi==0)wsf[r32]=f; resc=true; } } \
    SBAR(); \
    GAPB(o[0]=__builtin_amdgcn_mfma_f32_32x32x16_bf16(PAF(0),VFR(0),o[0],0,0,0), C0,0); \
    GAPB(o[1]=__builtin_amdgcn_mfma_f32_32x32x16_bf16(PAF(0),VFR(4),o[1],0,0,0), C0,4); \
    KRD(GL,0); GAPB(o[0]=__builtin_amdgcn_mfma_f32_32x32x16_bf16(PAF(1),VFR(1),o[0],0,0,0), C0,8); \
    KRD(GL,1); GAPB(o[1]=__builtin_amdgcn_mfma_f32_32x32x16_bf16(PAF(1),VFR(5),o[1],0,0,0), C0,12); \
    KRD(GL,2); GAPB(o[0]=__builtin_amdgcn_mfma_f32_32x32x16_bf16(PAF(2),VFR(2),o[0],0,0,0), C1,0); \
    KRD(GL,3); GAPB(o[1]=__builtin_amdgcn_mfma_f32_32x32x16_bf16(PAF(2),VFR(6),o[1],0,0,0), C1,4); \
    GAPB(o[0]=__builtin_amdgcn_mfma_f32_32x32x16_bf16(PAF(3),VFR(3),o[0],0,0,0), C1,8); \
    GAPB(o[1]=__builtin_amdgcn_mfma_f32_32x32x16_bf16(PAF(3),VFR(7),o[1],0,0,0), C1,12); \
    }while(0)
  int t=1;
  #undef CMASK
  #define CMASK(P0,P1,t) do{}while(0)
  for(;t+5<NT;t+=2){
    STEP(pB0,pB1,pA0,pA1,t,true,true,true);     WAIT_BAR(2); RESC(); ROT();
    STEP(pA0,pA1,pB0,pB1,t+1,true,true,true);   WAIT_BAR(2); RESC(); ROT();
  }
  #undef CMASK
  #define CMASK(P0,P1,t) do{int jb_=(t)-(NT-4); if(jb_>=0)cmask(P0,P1,jb_,qrel,hi);}while(0)
  #define ENDW(tt) do{ if((tt)+3<NT){WAIT_BAR(2);} else if((tt)+2<NT){WAIT_BAR(1);} else {WAIT_BAR(0);} }while(0)
  for(;t+1<NT;t+=2){
    STEP(pB0,pB1,pA0,pA1,t,(t+3<NT),(t+1<NT),(t+1<NT));       ENDW(t);   RESC(); ROT();
    STEP(pA0,pA1,pB0,pB1,t+1,(t+4<NT),(t+2<NT),(t+2<NT));     ENDW(t+1); RESC(); ROT();
  }
  STEP(pB0,pB1,pA0,pA1,NT-1,false,false,false); RESC();
  { float sacc=pB0[0]+pB0[1]; _Pragma("unroll") for(int r=2;r<16;++r)sacc+=pB0[r]; _Pragma("unroll") for(int r=0;r<16;++r)sacc+=pB1[r]; l_reg+=sacc;
    pw0=(u32x4){PKW(pB0,0),PKW(pB0,2),PKW(pB0,4),PKW(pB0,6)};pw1=(u32x4){PKW(pB0,8),PKW(pB0,10),PKW(pB0,12),PKW(pB0,14)};pw2=(u32x4){PKW(pB1,0),PKW(pB1,2),PKW(pB1,4),PKW(pB1,6)};pw3=(u32x4){PKW(pB1,8),PKW(pB1,10),PKW(pB1,12),PKW(pB1,14)};
    SBAR(); pv(o,vb0+sl_cur,PAF(0),PAF(1),PAF(2),PAF(3)); }
  #undef PKW
  #undef PAF
  #undef VFR
  #undef PIN
  #undef MX3
  #undef GAPA
  #undef GAPB
  #undef EX
  #undef VRD
  #undef KRD
  #undef STEP
  #undef ENDW
  {auto rr=__builtin_amdgcn_permlane32_swap(__float_as_uint(l_reg),__float_as_uint(l_reg),false,false);l_reg=__uint_as_float(rr[0])+__uint_as_float(rr[1]);}
  if(hi==0)wsf[32+r32]=l_reg;asm volatile("s_waitcnt lgkmcnt(0)":::"memory");
  float rli[16];
  #pragma unroll
  for(int r=0;r<16;++r)rli[r]=__builtin_amdgcn_rcpf(wsf[32+crow(r,hi)]);
  bf16*Ow=O+(rowbase+q0+wid*QBLK)*OP+h*D;
  { bf16*stg=(bf16*)(shm+LDS_OST)+wid*2048;
    #pragma unroll
    for(int r=0;r<16;++r){const int orow=crow(r,hi);
      #pragma unroll
      for(int d0=0;d0<2;++d0)stg[orow*64+d0*32+r32]=__float2bfloat16(o[d0][r]*rli[r]);}
    asm volatile("s_waitcnt lgkmcnt(0)":::"memory");
    #pragma unroll
    for(int i=0;i<4;++i){const int row=i*8+(lane>>3),ch=lane&7; const u32x4 v=*(const u32x4*)(stg+row*64+ch*8); ATTN_STORE16(Ow+(long)row*OP+ch*8,v);} }
  asm volatile("s_waitcnt lgkmcnt(0)\n\ts_barrier":::"memory");
  #undef DMA_K
  #undef DMA_V
  #undef CMASK
  #undef START
  #undef RESC
  #undef ROT
  #undef CINIT
}
constexpr int ATTN_LDS_BYTES=LDS_BYTES;
struct AttnTensors { const bf16* Q; const bf16* K; const bf16* V; bf16* O; const float* CK; const float* KT; const float* QB; };
struct AttnUnit { int bh; int qb; };
struct QueueOrder {
  unsigned* head; volatile __attribute__((address_space(3))) int* slot;
  __device__ __forceinline__ bool next(int,AttnUnit&u)const{
    if(tid_l()==0) *slot=(int)__hip_atomic_fetch_add(head,1u,__ATOMIC_RELAXED,__HIP_MEMORY_SCOPE_AGENT);
    __syncthreads(); const int v=*slot; __syncthreads();
    if(v>=BATCH*NHEAD*NQB)return false; u.qb=NQB-1-v/(BATCH*NHEAD); u.bh=v%(BATCH*NHEAD); return true; }
  __device__ __forceinline__ void a_ready(const AttnUnit&)const{}
  __device__ __forceinline__ void done(const AttnUnit&)const{}
};
template<class Sched,int THRL=8> __device__ __forceinline__ void attn_phase(char*lds,const AttnTensors&T,const Sched&S){
  AttnUnit u;
  for(int i=0;S.next(i,u);++i){ S.a_ready(u); attn_unit<THRL>(u.bh/NHEAD,u.bh%NHEAD,u.qb,T.Q,T.K,T.V,T.O,T.CK,T.KT,T.QB,lds); S.done(u); }
}
#undef SBAR
#undef WAIT_BAR
}

constexpr int NB = 8, SEQ = 4096, T = NB * SEQ, D = 1024, DEPTH = 4;
constexpr int HCOLS = 3072;
constexpr int HC_AVAL = 0, HC_AGATE = 256, HC_BQ = 512, HC_BK = 704, HC_BV = 896, HC_BG = 1280, HC_CQ = 1664, HC_CK = 2048, HC_CV = 2432, HC_LR = 2816, HC_CF = 2832;
constexpr int IN_COLS = 2838;
constexpr int MC_A = 0, MC_B = 256, MC_C = 640;
constexpr float LN_EPS = 1e-5f;
constexpr float ALPHA = 1.6817928305074292f;
constexpr float LOG2E = 1.4426950408889634f;
constexpr float C2 = 0.125f * LOG2E;
constexpr float GLA_QSCALE = 0.17677669529663687f;
constexpr int NEXP = 16384;

constexpr size_t MiB = 1u << 20;
constexpr size_t WS_CTL = 0, CTL_ZERO_BYTES = 1 * MiB;
constexpr size_t WS_WIN = 1 * MiB;
constexpr size_t WS_WOUT = WS_WIN + 24 * MiB;
constexpr size_t WS_WP = WS_WOUT + 8 * MiB;
constexpr size_t WS_PGW = WS_WP + 16 * MiB;
constexpr size_t WS_PW = WS_PGW + 8 * MiB;
constexpr size_t WS_CK = WS_PW + 2 * MiB;
constexpr size_t WS_FKT = WS_CK + 768 * 1024, WS_FQB = WS_FKT + 16 * 1024;
constexpr size_t WS_U = WS_CK + 1 * MiB;
constexpr size_t WS_V = WS_U + 32 * MiB;
constexpr size_t WS_XB = WS_V + 32 * MiB;
constexpr size_t WS_XF = WS_XB + 64 * MiB;
constexpr size_t WS_PB = WS_XF + 128 * MiB;
constexpr size_t WS_H = WS_PB + 16 * MiB;
constexpr size_t WS_MIX = WS_H + 192 * MiB;
constexpr size_t WS_SC = WS_H;
constexpr size_t WS_Y = WS_MIX + 64 * MiB;
constexpr size_t WS_GCUM = WS_Y;
constexpr size_t WS_GS = WS_GCUM + 24 * MiB;
constexpr size_t WS_GDEC = WS_GS + 24 * MiB;
constexpr size_t WS_E = WS_Y + 128 * MiB;
constexpr size_t WS_EIDX = WS_E + 64 * MiB;
constexpr size_t WS_GATE = WS_EIDX + 16 * MiB;
constexpr size_t WS_SOFF = WS_GATE + 16 * MiB;
constexpr size_t WS_END = WS_SOFF + 1 * MiB;
static_assert(WS_END <= 1024 * MiB, "d_ws map");

constexpr int LDS_BYTES = 147456;

typedef unsigned short bf16;
typedef float f32x4 __attribute__((ext_vector_type(4)));
typedef unsigned u32x4 __attribute__((ext_vector_type(4)));
typedef unsigned u32x2 __attribute__((ext_vector_type(2)));

struct Params {
    const float *x, *p, *w_in, *conv_w, *conv_b, *conv_ln_g, *conv_ln_b, *gla_gate_w, *gla_gate_b, *gla_norm_g, *fox_forget_b, *w_out, *ln1_g, *ln1_b,
        *peer_wq, *peer_keys, *peer_u, *peer_v, *ple_w, *ple_gw, *ple_gb, *ln2_g, *ln2_b;
    float* out; unsigned char* ws;
};

__device__ __forceinline__ float bf2f(unsigned h) { return __uint_as_float(h << 16); }
__device__ __forceinline__ unsigned f2bf(float f) { unsigned u = __float_as_uint(f); return (u + 0x7fffu + ((u >> 16) & 1u)) >> 16; }
__device__ __forceinline__ unsigned pk2(float lo, float hi) { return f2bf(lo) | (f2bf(hi) << 16); }
__device__ __forceinline__ float wave_sum(float v) {
#pragma unroll
    for (int o = 1; o < 64; o <<= 1) v += __shfl_xor(v, o);
    return v;
}
__device__ __forceinline__ float log_sigmoid(float z) { return fminf(z, 0.f) - log1pf(__expf(-fabsf(z))); }
__device__ __forceinline__ float sigmoidf_(float z) { return 1.0f / (1.0f + __expf(-z)); }

struct MapIdent { __device__ __forceinline__ void operator()(int n, int& c, float& s) const { c = n; s = 1.f; } };
struct MapWin {
    __device__ __forceinline__ void operator()(int n, int& c, float& s) const {
        s = 1.f;
        if (n < HC_CQ) { c = n; if (n >= HC_BQ && n < HC_BK) s = GLA_QSCALE; }
        else if (n < HC_LR) { c = n + 16; if (n < HC_CK) s = C2; }
        else if (n < HC_CF) c = n - HC_LR + 1664;
        else if (n < IN_COLS) c = n;
        else c = -1;
    }
};
template <class CM>
__device__ __forceinline__ void transpose_item(const float* W, int K, int Nsrc, bf16* WT, int item, int nblk, float* scr, int lane, const CM& cm) {
    const int kb = item / nblk, nb = item % nblk, k0 = 64 * kb, n0 = 32 * nb;
    int sc; float scale; cm(n0 + (lane & 31), sc, scale);
#pragma unroll 8
    for (int i = 0; i < 32; ++i) { const int kk = 2 * i + (lane >> 5); scr[kk * 33 + (lane & 31)] = sc >= 0 ? W[(size_t)(k0 + kk) * Nsrc + sc] * scale : 0.f; }
    __builtin_amdgcn_wave_barrier(); asm volatile("s_waitcnt lgkmcnt(0)" ::: "memory");
    const int c = lane & 7;
#pragma unroll
    for (int j = 0; j < 4; ++j) { const int n = (lane >> 3) + 8 * j; const float* s = scr + (8 * c) * 33 + n;
        u32x4 o; o.x = pk2(s[0 * 33], s[1 * 33]); o.y = pk2(s[2 * 33], s[3 * 33]); o.z = pk2(s[4 * 33], s[5 * 33]); o.w = pk2(s[6 * 33], s[7 * 33]);
        *(u32x4*)(WT + (size_t)(n0 + n) * K + k0 + 8 * c) = o; }
    asm volatile("s_waitcnt lgkmcnt(0)" ::: "memory"); __builtin_amdgcn_wave_barrier();
}
__device__ __forceinline__ void cvt_bf16_stream(const float* src, bf16* dst, size_t n8, size_t gtid, size_t gthreads) {
    for (size_t i = gtid; i < n8; i += gthreads) { const f32x4 a = *(const f32x4*)(src + i * 8), b = *(const f32x4*)(src + i * 8 + 4);
        u32x4 o; o.x = pk2(a[0], a[1]); o.y = pk2(a[2], a[3]); o.z = pk2(b[0], b[1]); o.w = pk2(b[2], b[3]); *(u32x4*)(dst + i * 8) = o; }
}

__device__ __forceinline__ void phase_pro_a(const Params& p, unsigned char* lds) {
    const int tid = tid_l(), lane = tid & 63, wave = tid >> 6;
    float* scr = (float*)(lds + wave * 16384);
    const int gw = bid_l() * 8 + wave, NGW = grid_l() * 8;
    constexpr int I_WIN = (D / 64) * (HCOLS / 32), I_SQ = (D / 64) * (D / 32), I_PW = (256 / 64) * (D / 32);
    constexpr int PER_L = I_WIN + 2 * I_SQ + I_PW;
    for (int it = gw; it < DEPTH * PER_L; it += NGW) {
        const int l = it / PER_L; int r = it % PER_L;
        if (r < I_WIN) { transpose_item(p.w_in + (size_t)l * D * IN_COLS, D, IN_COLS, (bf16*)(p.ws + WS_WIN) + (size_t)l * HCOLS * D, r, HCOLS / 32, scr, lane, MapWin()); continue; } r -= I_WIN;
        if (r < I_SQ) { transpose_item(p.w_out + (size_t)l * D * D, D, D, (bf16*)(p.ws + WS_WOUT) + (size_t)l * D * D, r, D / 32, scr, lane, MapIdent()); continue; } r -= I_SQ;
        if (r < I_SQ) { transpose_item(p.ple_gw + (size_t)l * D * D, D, D, (bf16*)(p.ws + WS_PGW) + (size_t)l * D * D, r, D / 32, scr, lane, MapIdent()); continue; } r -= I_SQ;
        transpose_item(p.ple_w + (size_t)l * 256 * D, 256, D, (bf16*)(p.ws + WS_PW) + (size_t)l * D * 256, r, D / 32, scr, lane, MapIdent());
    }
    cvt_bf16_stream(p.x, (bf16*)(p.ws + WS_XB), (size_t)T * D / 8, (size_t)bid_l() * 512 + tid, (size_t)grid_l() * 512);
}
__device__ __forceinline__ void phase_pro_b(const Params& p, unsigned char* lds) {
    const int tid = tid_l();
    float* ks = (float*)lds;
    float* wqs = ks + 128 * 129;
    for (int it = bid_l(); it < DEPTH * 16 * 16; it += grid_l()) {
        const int l = it >> 8, hc = (it >> 4) & 15, kt = it & 15;
        const float* keys = p.peer_keys + ((size_t)l * 16 + hc) * 16384;
        const float* wq = p.peer_wq + (size_t)l * D * 2048 + (size_t)(kt * 64) * 2048 + hc * 128;
        __syncthreads();
        for (int i = tid; i < 128 * 128; i += 512) ks[(i >> 7) * 129 + (i & 127)] = keys[i];
        for (int i = tid; i < 64 * 128; i += 512) wqs[(i >> 7) * 129 + (i & 127)] = wq[(size_t)(i >> 7) * 2048 + (i & 127)];
        __syncthreads();
        const int k = tid & 63, n0 = (tid >> 6) * 16;
        float acc[16];
#pragma unroll
        for (int j = 0; j < 16; ++j) acc[j] = 0.f;
        for (int d = 0; d < 128; ++d) { const float a = wqs[k * 129 + d];
#pragma unroll
            for (int j = 0; j < 16; ++j) acc[j] += a * ks[(n0 + j) * 129 + d]; }
        bf16* WpT = (bf16*)(p.ws + WS_WP) + (size_t)l * 2048 * D;
#pragma unroll
        for (int j = 0; j < 16; ++j) WpT[(size_t)(hc * 128 + n0 + j) * D + kt * 64 + k] = (bf16)f2bf(acc[j]);
    }
}
constexpr float U8_SCALE = 64.f, V8_SCALE = 16.f;
typedef float f32x2v __attribute__((ext_vector_type(2)));
__device__ __forceinline__ unsigned pk_fp8x4(f32x4 v, float sc) {
    const float a = fminf(fmaxf(v[0] * sc, -448.f), 448.f), b = fminf(fmaxf(v[1] * sc, -448.f), 448.f), c = fminf(fmaxf(v[2] * sc, -448.f), 448.f), d = fminf(fmaxf(v[3] * sc, -448.f), 448.f);
    int w = __builtin_amdgcn_cvt_pk_fp8_f32(a, b, 0, false); w = __builtin_amdgcn_cvt_pk_fp8_f32(c, d, w, true); return (unsigned)w;
}
__device__ __forceinline__ void cvt_fp8_stream(const float* src, unsigned char* dst, size_t n16, float sc, size_t gtid, size_t gthreads) {
    for (size_t i = gtid; i < n16; i += gthreads) { const float* s = src + i * 16; u32x4 o;
        o.x = pk_fp8x4(*(const f32x4*)(s), sc); o.y = pk_fp8x4(*(const f32x4*)(s + 4), sc); o.z = pk_fp8x4(*(const f32x4*)(s + 8), sc); o.w = pk_fp8x4(*(const f32x4*)(s + 12), sc);
        *(u32x4*)(dst + i * 16) = o; }
}
__device__ __forceinline__ void phase_cvt(const Params& p, int l) {
    const size_t gtid = (size_t)bid_l() * 512 + tid_l(), gth = (size_t)grid_l() * 512;
    cvt_bf16_stream(p.p + (size_t)l * T * 256, (bf16*)(p.ws + WS_PB), (size_t)T * 256 / 8, gtid, gth);
    cvt_fp8_stream(p.peer_u + (size_t)l * NEXP * D, p.ws + WS_U, (size_t)NEXP * D / 16, U8_SCALE, gtid, gth);
    cvt_fp8_stream(p.peer_v + (size_t)l * NEXP * D, p.ws + WS_V, (size_t)NEXP * D / 16, V8_SCALE, gtid, gth);
}

#define GEMM_RUN(EPI, e, Aptr, Bptr, N_, K_) do { int kk_ = (K_); asm volatile("" : "+s"(kk_)); pg8::Gemm g{(const pg8::bf16_t*)(Aptr), (const pg8::bf16_t*)(Bptr), T, (N_), kk_}; pg8::StaticOrder S; S.init(T, (N_), (int)grid_l(), (int)bid_l()); \
    pg8::gemm_phase<EPI, pg8::StaticOrder, true, true>((PG8_LAS unsigned char*)lds, g, S, e); } while (0)

__device__ __forceinline__ void phase_gemm_in(const Params& p, int l, unsigned char* lds) {
    pg8::EpiBf16<0> e{(pg8::bf16_t*)(p.ws + WS_H), HCOLS, nullptr, 0, 0, 1.f};
    GEMM_RUN(pg8::EpiBf16<0>, e, p.ws + WS_XB, (bf16*)(p.ws + WS_WIN) + (size_t)l * HCOLS * D, HCOLS, D);
}
__device__ __forceinline__ void phase_gemm_e(const Params& p, int l, unsigned char* lds) {
    pg8::EpiBf16<0> e{(pg8::bf16_t*)(p.ws + WS_E), D, nullptr, 0, 0, 1.f};
    GEMM_RUN(pg8::EpiBf16<0>, e, p.ws + WS_PB, (bf16*)(p.ws + WS_PW) + (size_t)l * D * 256, D, 256);
}
__device__ __forceinline__ void phase_gemm_out(const Params& p, int l, unsigned char* lds) {
    pg8::EpiResid e{(const pg8::bf16_t*)(p.ws + WS_XB), (_Float16*)(p.ws + WS_Y), D, ALPHA};
    GEMM_RUN(pg8::EpiResid, e, p.ws + WS_MIX, (bf16*)(p.ws + WS_WOUT) + (size_t)l * D * D, D, D);
}
__device__ __forceinline__ void phase_gemm_sc(const Params& p, int l, unsigned char* lds) {
    pg8::EpiF16 e{(_Float16*)(p.ws + WS_SC), 2048};
    GEMM_RUN(pg8::EpiF16, e, p.ws + WS_XB, (bf16*)(p.ws + WS_WP) + (size_t)l * 2048 * D, 2048, D);
}
__device__ __forceinline__ void phase_gemm_ple(const Params& p, int l, unsigned char* lds) {
    pg8::EpiPle e{(const pg8::bf16_t*)(p.ws + WS_XB), (_Float16*)(p.ws + WS_Y), (const pg8::bf16_t*)(p.ws + WS_E), p.ple_gb + (size_t)l * D, D};
    GEMM_RUN(pg8::EpiPle, e, p.ws + WS_XB, (bf16*)(p.ws + WS_PGW) + (size_t)l * D * D, D, D);
}

__device__ __forceinline__ void phase_conv(const Params& p, int l, unsigned char* lds) {
    const int tid = tid_l(), lane = tid & 63, wave = tid >> 6;
    float* U = (float*)lds;
    float* Yt = U + 62 * 256;
    const bf16* H = (const bf16*)(p.ws + WS_H); bf16* MIX = (bf16*)(p.ws + WS_MIX);
    const float* cw = p.conv_w + (size_t)l * 31 * 256; const float* cb = p.conv_b + l * 256;
    const float* lg = p.conv_ln_g + l * 256; const float* lb = p.conv_ln_b + l * 256;
    for (int it = bid_l(); it < T / 32; it += grid_l()) {
        const int b = it / (SEQ / 32), t0 = (it % (SEQ / 32)) * 32;
        __syncthreads();
        for (int i = tid; i < 62 * 32; i += 512) { const int r = i >> 5, c8 = (i & 31) * 8, t = t0 - 30 + r; f32x4 u0 = {0.f, 0.f, 0.f, 0.f}, u1 = {0.f, 0.f, 0.f, 0.f};
            if (t >= 0) { const bf16* hr = H + (size_t)(b * SEQ + t) * HCOLS; const u32x4 av = *(const u32x4*)(hr + HC_AVAL + c8), gv = *(const u32x4*)(hr + HC_AGATE + c8);
#pragma unroll
                for (int j = 0; j < 2; ++j) { u0[2 * j] = bf2f(av[j] & 0xffffu) * sigmoidf_(bf2f(gv[j] & 0xffffu)); u0[2 * j + 1] = __uint_as_float(av[j] & 0xffff0000u) * sigmoidf_(__uint_as_float(gv[j] & 0xffff0000u));
                                              u1[2 * j] = bf2f(av[2 + j] & 0xffffu) * sigmoidf_(bf2f(gv[2 + j] & 0xffffu)); u1[2 * j + 1] = __uint_as_float(av[2 + j] & 0xffff0000u) * sigmoidf_(__uint_as_float(gv[2 + j] & 0xffff0000u)); } }
            *(f32x4*)(U + r * 256 + c8) = u0; *(f32x4*)(U + r * 256 + c8 + 4) = u1; }
        __syncthreads();
        { const int c = tid & 255, half = tid >> 8; float w[31], win[46];
#pragma unroll
          for (int j = 0; j < 31; ++j) w[j] = cw[j * 256 + c];
#pragma unroll
          for (int j = 0; j < 46; ++j) win[j] = U[(half * 16 + j) * 256 + c];
          const float bias = cb[c];
#pragma unroll
          for (int tl = 0; tl < 16; ++tl) { float y = bias;
#pragma unroll
              for (int j = 0; j < 31; ++j) y += w[j] * win[tl + j];
              Yt[(half * 16 + tl) * 256 + c] = y; } }
        __syncthreads();
        for (int tl = wave * 4; tl < wave * 4 + 4; ++tl) {
            const f32x4 v = *(const f32x4*)(Yt + tl * 256 + lane * 4);
            const float mean = wave_sum((v[0] + v[1]) + (v[2] + v[3])) * (1.f / 256.f);
            const f32x4 d = v - mean; const float var = wave_sum((d[0] * d[0] + d[1] * d[1]) + (d[2] * d[2] + d[3] * d[3])) * (1.f / 256.f);
            const float rstd = 1.0f / sqrtf(var + LN_EPS);
            const f32x4 g4 = *(const f32x4*)(lg + lane * 4), b4 = *(const f32x4*)(lb + lane * 4);
            float o[4];
#pragma unroll
            for (int i = 0; i < 4; ++i) { const float z = d[i] * rstd * g4[i] + b4[i]; o[i] = z * sigmoidf_(z); }
            u32x2 w2; w2.x = pk2(o[0], o[1]); w2.y = pk2(o[2], o[3]);
            *(u32x2*)(MIX + (size_t)(b * SEQ + t0 + tl) * D + MC_A + lane * 4) = w2;
        }
    }
}

__device__ __forceinline__ void phase_fox_cum(const Params& p, int l, unsigned char* lds) {
    const int tid = tid_l(), lane = tid & 63, wave = tid >> 6;
    float* wsum = (float*)lds;
    const bf16* H = (const bf16*)(p.ws + WS_H); float* CK = (float*)(p.ws + WS_CK);
    for (int bh = bid_l(); bh < 48; bh += grid_l()) {
        const int b = bh / 6, h = bh % 6; const float bias = p.fox_forget_b[l * 6 + h];
        float v[8]; float s = 0.f;
#pragma unroll
        for (int i = 0; i < 8; ++i) { const float f = bf2f(H[(size_t)(b * SEQ + tid * 8 + i) * HCOLS + HC_CF + h]); s += log_sigmoid(f + bias) * LOG2E; v[i] = s; }
        float incl = s;
#pragma unroll
        for (int o = 1; o < 64; o <<= 1) { const float n = __shfl_up(incl, o); if (lane >= o) incl += n; }
        __syncthreads();
        if (lane == 63) wsum[wave] = incl;
        __syncthreads();
        float base = incl - s;
        for (int w = 0; w < wave; ++w) base += wsum[w];
#pragma unroll
        for (int i = 0; i < 8; ++i) CK[(size_t)bh * SEQ + tid * 8 + i] = base + v[i];
    }
}

__device__ __forceinline__ void phase_fox_norm(const Params& p, unsigned char* lds) {
    const int tid = tid_l(), lane = tid & 63, wave = tid >> 6;
    float* qns = (float*)lds; float* kns = qns + 256;
    const bf16* H = (const bf16*)(p.ws + WS_H); float* KT = (float*)(p.ws + WS_FKT); float* QBM = (float*)(p.ws + WS_FQB);
    for (int it = bid_l(); it < 48 * 16; it += grid_l()) {
        const int bh = it >> 4, qb = it & 15, b = bh / 6, h = bh % 6;
        __syncthreads();
        if (tid < 256) { const bf16* row = H + ((size_t)b * SEQ + qb * 256 + tid) * HCOLS + h * 64; float sq = 0.f, sk = 0.f;
#pragma unroll
            for (int j = 0; j < 8; ++j) { const u32x4 qv = *(const u32x4*)(row + HC_CQ + 8 * j), kv = *(const u32x4*)(row + HC_CK + 8 * j);
#pragma unroll
                for (int i = 0; i < 4; ++i) { const float a0 = bf2f(qv[i] & 0xffffu), a1 = __uint_as_float(qv[i] & 0xffff0000u), b0 = bf2f(kv[i] & 0xffffu), b1 = __uint_as_float(kv[i] & 0xffff0000u);
                    sq += a0 * a0 + a1 * a1; sk += b0 * b0 + b1 * b1; } }
            qns[tid] = sqrtf(sq); kns[tid] = sqrtf(sk); }
        __syncthreads();
        if (wave < 5) { float v = wave < 4 ? kns[wave * 64 + lane] : fmaxf(fmaxf(qns[lane], qns[64 + lane]), fmaxf(qns[128 + lane], qns[192 + lane]));
#pragma unroll
            for (int o = 1; o < 64; o <<= 1) v = fmaxf(v, __shfl_xor(v, o));
            if (lane == 0) { if (wave < 4) KT[bh * 64 + 4 * qb + wave] = v; else QBM[bh * 16 + qb] = v; } }
    }
}

typedef short bf16x8_t __attribute__((ext_vector_type(8)));
typedef float f32x16_t __attribute__((ext_vector_type(16)));
__device__ __forceinline__ int crow32(int r, int hi) { return (r & 3) + 8 * (r >> 2) + 4 * hi; }
struct GlaB1Pre { u32x4 vv, lr0, lr1; u32x2 kk; float w2v, b2v; };
__device__ __forceinline__ GlaB1Pre gla_b1_load(const Params& p, int l, int it, int tid, int lane, int wave) {
    const int bh = it >> 6, n = it & 63, b = bh / 6, h = bh % 6; const size_t tok0 = (size_t)b * SEQ + n * 64; const bf16* H = (const bf16*)(p.ws + WS_H);
    GlaB1Pre r; r.w2v = p.gla_gate_w[(size_t)l * 16 * 192 + (tid >> 5) * 192 + h * 32 + (tid & 31)]; r.b2v = p.gla_gate_b[l * 192 + h * 32 + (tid & 31)];
    r.vv = *(const u32x4*)(H + (tok0 + (tid >> 3)) * HCOLS + HC_BV + h * 64 + (tid & 7) * 8);
    r.lr0 = *(const u32x4*)(H + (tok0 + lane) * HCOLS + HC_LR); r.lr1 = *(const u32x4*)(H + (tok0 + lane) * HCOLS + HC_LR + 8);
    r.kk = *(const u32x2*)(H + (tok0 + lane) * HCOLS + HC_BK + h * 32 + wave * 4);
    return r;
}
__device__ __forceinline__ void phase_gla_b1(const Params& p, int l, unsigned char* lds) {
    const int tid = tid_l(), lane = tid & 63, wave = tid >> 6, r32 = lane & 31, hi = lane >> 5;
    bf16* KDT = (bf16*)lds;
    bf16* VT = KDT + 32 * 72;
    float* w2s = (float*)(VT + 64 * 72);
    float* b2s = w2s + 16 * 32;
    float* GCUM = (float*)(p.ws + WS_GCUM); float* GS = (float*)(p.ws + WS_GS); float* GDEC = (float*)(p.ws + WS_GDEC);
    const int NI = 48 * 64, G = grid_l(); int it = bid_l();
    if (it >= NI) return;
    GlaB1Pre cur = gla_b1_load(p, l, it, tid, lane, wave);
#pragma unroll 1
    for (; it < NI; it += G) {
        const GlaB1Pre nxt = gla_b1_load(p, l, it + G < NI ? it + G : it, tid, lane, wave);
        __builtin_amdgcn_sched_barrier(0);
        const int bh = it >> 6, n = it & 63, b = bh / 6, h = bh % 6; const size_t tok0 = (size_t)b * SEQ + n * 64;
        __syncthreads();
        w2s[tid] = cur.w2v;
        if (tid < 32) b2s[tid] = cur.b2v;
        { const int s_ = tid >> 3, e0 = (tid & 7) * 8;
#pragma unroll
          for (int i = 0; i < 4; ++i) { VT[(e0 + 2 * i) * 72 + s_] = (bf16)(cur.vv[i] & 0xffffu); VT[(e0 + 2 * i + 1) * 72 + s_] = (bf16)(cur.vv[i] >> 16); } }
        const int d0 = wave * 4;
        __syncthreads();
        float lrf[16];
#pragma unroll
        for (int i = 0; i < 4; ++i) { lrf[2 * i] = bf2f(cur.lr0[i] & 0xffffu); lrf[2 * i + 1] = __uint_as_float(cur.lr0[i] & 0xffff0000u); lrf[8 + 2 * i] = bf2f(cur.lr1[i] & 0xffffu); lrf[8 + 2 * i + 1] = __uint_as_float(cur.lr1[i] & 0xffff0000u); }
        float g[4];
#pragma unroll
        for (int dd = 0; dd < 4; ++dd) { float x = b2s[d0 + dd];
#pragma unroll
            for (int r = 0; r < 16; ++r) x += lrf[r] * w2s[r * 32 + d0 + dd];
            g[dd] = log_sigmoid(x) * (1.0f / 16.0f); }
#pragma unroll
        for (int o = 1; o < 64; o <<= 1)
#pragma unroll
            for (int dd = 0; dd < 4; ++dd) { const float v = __shfl_up(g[dd], o); if (lane >= o) g[dd] += v; }
        *(f32x4*)(GCUM + (tok0 + lane) * 192 + h * 32 + d0) = (f32x4){g[0], g[1], g[2], g[3]};
        const float kf[4] = {bf2f(cur.kk.x & 0xffffu), __uint_as_float(cur.kk.x & 0xffff0000u), bf2f(cur.kk.y & 0xffffu), __uint_as_float(cur.kk.y & 0xffff0000u)};
#pragma unroll
        for (int dd = 0; dd < 4; ++dd) { const float last = __uint_as_float(__builtin_amdgcn_readlane(__float_as_uint(g[dd]), 63));
            KDT[(d0 + dd) * 72 + lane] = (bf16)f2bf(kf[dd] * __expf(last - g[dd]));
            if (lane == 63) GDEC[(size_t)it * 32 + d0 + dd] = __expf(last); }
        __syncthreads();
        if (wave < 2) {
            f32x16_t acc = {};
#pragma unroll
            for (int ks = 0; ks < 4; ++ks) { const bf16x8_t a = *(const bf16x8_t*)(KDT + r32 * 72 + 16 * ks + 8 * hi), bb = *(const bf16x8_t*)(VT + (32 * wave + r32) * 72 + 16 * ks + 8 * hi);
                acc = __builtin_amdgcn_mfma_f32_32x32x16_bf16(a, bb, acc, 0, 0, 0); }
#pragma unroll
            for (int r = 0; r < 16; ++r) GS[(size_t)it * 2048 + crow32(r, hi) * 64 + 32 * wave + r32] = acc[r];
        }
        cur = nxt;
    }
}
__device__ __forceinline__ void phase_gla_b2(const Params& p) {
    float* GS = (float*)(p.ws + WS_GS); const float* GDEC = (const float*)(p.ws + WS_GDEC);
    for (int g = bid_l() * 512 + tid_l(); g < 48 * 2048; g += grid_l() * 512) {
        const int bh = g >> 11, de = g & 2047, d = de >> 6; float S = 0.f;
        float* gs = GS + (size_t)bh * 64 * 2048 + de; const float* gd = GDEC + (size_t)bh * 64 * 32 + d;
#pragma unroll 1
        for (int n0 = 0; n0 < 64; n0 += 16) { float loc[16], dec[16];
#pragma unroll
            for (int i = 0; i < 16; ++i) { loc[i] = gs[(size_t)(n0 + i) * 2048]; dec[i] = gd[(n0 + i) * 32]; }
#pragma unroll
            for (int i = 0; i < 16; ++i) { gs[(size_t)(n0 + i) * 2048] = S; S = S * dec[i] + loc[i]; } }
    }
}
struct GlaB3Pre { u32x2 qq, kk; f32x4 c; u32x4 vv; f32x4 sv; u32x4 gr; };
__device__ __forceinline__ GlaB3Pre gla_b3_load(const Params& p, int it, int tid) {
    const int bh = it >> 6, n = it & 63, b = bh / 6, h = bh % 6; const size_t tok0 = (size_t)b * SEQ + n * 64; const bf16* H = (const bf16*)(p.ws + WS_H);
    const float* GCUM = (const float*)(p.ws + WS_GCUM); const float* GS = (const float*)(p.ws + WS_GS);
    GlaB3Pre r; const int t = tid >> 3, d0 = (tid & 7) * 4;
    r.qq = *(const u32x2*)(H + (tok0 + t) * HCOLS + HC_BQ + h * 32 + d0); r.kk = *(const u32x2*)(H + (tok0 + t) * HCOLS + HC_BK + h * 32 + d0);
    r.c = *(const f32x4*)(GCUM + (tok0 + t) * 192 + h * 32 + d0);
    r.vv = *(const u32x4*)(H + (tok0 + t) * HCOLS + HC_BV + h * 64 + (tid & 7) * 8);
    r.sv = *(const f32x4*)(GS + (size_t)it * 2048 + (tid >> 4) * 64 + (tid & 15) * 4);
    r.gr = *(const u32x4*)(H + (tok0 + t) * HCOLS + HC_BG + h * 64 + (tid & 7) * 8);
    return r;
}
__device__ __forceinline__ void phase_gla_b3(const Params& p, int l, unsigned char* lds) {
    const int tid = tid_l(), lane = tid & 63, wave = tid >> 6, r32 = lane & 31, hi = lane >> 5;
    bf16* QE = (bf16*)lds;
    bf16* KE = QE + 64 * 40;
    bf16* VT = KE + 64 * 40;
    bf16* ST = VT + 64 * 72;
    bf16* P = ST + 64 * 40;
    float* O = (float*)(P + 64 * 72);
    bf16* MIX = (bf16*)(p.ws + WS_MIX);
    const int NI = 48 * 64, G = grid_l(); int it = bid_l();
    if (it >= NI) return;
    GlaB3Pre cur = gla_b3_load(p, it, tid);
#pragma unroll 1
    for (; it < NI; it += G) {
        const GlaB3Pre nxt = gla_b3_load(p, it + G < NI ? it + G : it, tid);
        __builtin_amdgcn_sched_barrier(0);
        const int bh = it >> 6, n = it & 63, b = bh / 6, h = bh % 6; const size_t tok0 = (size_t)b * SEQ + n * 64;
        __syncthreads();
        { const int t = tid >> 3, d0 = (tid & 7) * 4; const u32x2 qq = cur.qq, kk = cur.kk; const f32x4 c = cur.c;
          const float e0 = __expf(c[0]), e1 = __expf(c[1]), e2 = __expf(c[2]), e3 = __expf(c[3]);
          u32x2 qo, ko;
          qo.x = pk2(bf2f(qq.x & 0xffffu) * e0, __uint_as_float(qq.x & 0xffff0000u) * e1); qo.y = pk2(bf2f(qq.y & 0xffffu) * e2, __uint_as_float(qq.y & 0xffff0000u) * e3);
          ko.x = pk2(bf2f(kk.x & 0xffffu) / e0, __uint_as_float(kk.x & 0xffff0000u) / e1); ko.y = pk2(bf2f(kk.y & 0xffffu) / e2, __uint_as_float(kk.y & 0xffff0000u) / e3);
          *(u32x2*)(QE + t * 40 + d0) = qo; *(u32x2*)(KE + t * 40 + d0) = ko; }
        { const int s_ = tid >> 3, e0 = (tid & 7) * 8;
#pragma unroll
          for (int i = 0; i < 4; ++i) { VT[(e0 + 2 * i) * 72 + s_] = (bf16)(cur.vv[i] & 0xffffu); VT[(e0 + 2 * i + 1) * 72 + s_] = (bf16)(cur.vv[i] >> 16); } }
        { const int d = tid >> 4, e0 = (tid & 15) * 4;
#pragma unroll
          for (int i = 0; i < 4; ++i) ST[(e0 + i) * 40 + d] = (bf16)f2bf(cur.sv[i]); }
        __syncthreads();
        f32x16_t acc = {};
        const int tt = (wave & 3) >> 1, tc = wave & 1;
        if (wave < 4) {
            if (!(tt == 0 && tc == 1)) {
#pragma unroll
                for (int ks = 0; ks < 2; ++ks) { const bf16x8_t a = *(const bf16x8_t*)(QE + (32 * tt + r32) * 40 + 16 * ks + 8 * hi), bb = *(const bf16x8_t*)(KE + (32 * tc + r32) * 40 + 16 * ks + 8 * hi);
                    acc = __builtin_amdgcn_mfma_f32_32x32x16_bf16(a, bb, acc, 0, 0, 0); }
#pragma unroll
                for (int r = 0; r < 16; ++r) { const int trow = 32 * tt + crow32(r, hi), scol = 32 * tc + r32; P[trow * 72 + scol] = (bf16)f2bf(scol <= trow ? acc[r] : 0.f); }
            }
        } else {
#pragma unroll
            for (int ks = 0; ks < 2; ++ks) { const bf16x8_t a = *(const bf16x8_t*)(QE + (32 * tt + r32) * 40 + 16 * ks + 8 * hi), bb = *(const bf16x8_t*)(ST + (32 * tc + r32) * 40 + 16 * ks + 8 * hi);
                acc = __builtin_amdgcn_mfma_f32_32x32x16_bf16(a, bb, acc, 0, 0, 0); }
        }
        __syncthreads();
        if (wave >= 4) {
            const int nks = tt == 0 ? 2 : 4;
            for (int ks = 0; ks < nks; ++ks) { const bf16x8_t a = *(const bf16x8_t*)(P + (32 * tt + r32) * 72 + 16 * ks + 8 * hi), bb = *(const bf16x8_t*)(VT + (32 * tc + r32) * 72 + 16 * ks + 8 * hi);
                acc = __builtin_amdgcn_mfma_f32_32x32x16_bf16(a, bb, acc, 0, 0, 0); }
#pragma unroll
            for (int r = 0; r < 16; ++r) O[(32 * tt + crow32(r, hi)) * 65 + 32 * tc + r32] = acc[r];
        }
        __syncthreads();
        { const int t = tid >> 3, e0 = (tid & 7) * 8; float o[8]; float ss = 0.f;
#pragma unroll
          for (int i = 0; i < 8; ++i) { o[i] = O[t * 65 + e0 + i]; ss += o[i] * o[i]; }
          ss += __shfl_xor(ss, 1); ss += __shfl_xor(ss, 2); ss += __shfl_xor(ss, 4);
          const float rs = 1.0f / sqrtf(ss * (1.f / 64.f) + LN_EPS);
          const float* ng = p.gla_norm_g + l * 384 + h * 64 + e0; const u32x4 gr = cur.gr;
          float r[8];
#pragma unroll
          for (int i = 0; i < 4; ++i) { const float ga = bf2f(gr[i] & 0xffffu), gb = __uint_as_float(gr[i] & 0xffff0000u);
              r[2 * i] = o[2 * i] * rs * ng[2 * i] * (ga * sigmoidf_(ga)); r[2 * i + 1] = o[2 * i + 1] * rs * ng[2 * i + 1] * (gb * sigmoidf_(gb)); }
          u32x4 w; w.x = pk2(r[0], r[1]); w.y = pk2(r[2], r[3]); w.z = pk2(r[4], r[5]); w.w = pk2(r[6], r[7]);
          *(u32x4*)(MIX + (tok0 + t) * D + MC_B + h * 64 + e0) = w; }
        cur = nxt;
    }
}

constexpr int LDSQ_OFF = LDS_BYTES - 1024;
constexpr int CW_ATTNQ = 8192;
__device__ __forceinline__ void phase_fox_mfma(const Params& p, int l, unsigned char* lds) {
    const attn_body::bf16* H = (const attn_body::bf16*)(p.ws + WS_H);
    const attn_body::AttnTensors AT{H + HC_CQ, H + HC_CK, H + HC_CV, (attn_body::bf16*)(p.ws + WS_MIX) + MC_C, (const float*)(p.ws + WS_CK), (const float*)(p.ws + WS_FKT), (const float*)(p.ws + WS_FQB)};
    const attn_body::QueueOrder S{(unsigned*)(p.ws + WS_CTL) + CW_ATTNQ + l * 64, (volatile __attribute__((address_space(3))) int*)((__attribute__((address_space(3))) unsigned char*)lds + LDSQ_OFF)};
    attn_body::attn_phase<attn_body::QueueOrder>((char*)lds, AT, S);
}

__device__ __forceinline__ void phase_ln(const _Float16* Y, const float* g, const float* bta, float* dst, bf16* dstb) {
    const int tid = tid_l(), lane = tid & 63, wave = tid >> 6; typedef _Float16 h4 __attribute__((ext_vector_type(4)));
    const int stride = grid_l() * 8; int row = bid_l() * 8 + wave;
    if (row >= T) return;
    h4 cur[4];
#pragma unroll
    for (int j = 0; j < 4; ++j) cur[j] = *(const h4*)(Y + (size_t)row * D + j * 256 + lane * 4);
#pragma unroll 1
    for (; row < T; row += stride) {
        h4 nxt[4]; const int nr = row + stride < T ? row + stride : row;
#pragma unroll
        for (int j = 0; j < 4; ++j) nxt[j] = *(const h4*)(Y + (size_t)nr * D + j * 256 + lane * 4);
        __builtin_amdgcn_sched_barrier(0);
        f32x4 v[4]; float s = 0.f;
#pragma unroll
        for (int j = 0; j < 4; ++j) { v[j] = (f32x4){(float)cur[j][0], (float)cur[j][1], (float)cur[j][2], (float)cur[j][3]}; s += (v[j][0] + v[j][1]) + (v[j][2] + v[j][3]); }
        const float mean = wave_sum(s) * (1.f / D); float s2 = 0.f;
#pragma unroll
        for (int j = 0; j < 4; ++j) { v[j] = v[j] - mean; s2 += (v[j][0] * v[j][0] + v[j][1] * v[j][1]) + (v[j][2] * v[j][2] + v[j][3] * v[j][3]); }
        const float rstd = 1.0f / sqrtf(wave_sum(s2) * (1.f / D) + LN_EPS);
#pragma unroll
        for (int j = 0; j < 4; ++j) { const f32x4 g4 = *(const f32x4*)(g + j * 256 + lane * 4), b4 = *(const f32x4*)(bta + j * 256 + lane * 4);
            const f32x4 o = v[j] * rstd * g4 + b4;
            if (dst) *(f32x4*)(dst + (size_t)row * D + j * 256 + lane * 4) = o;
            if (dstb) { u32x2 w; w.x = pk2(o[0], o[1]); w.y = pk2(o[2], o[3]); *(u32x2*)(dstb + (size_t)row * D + j * 256 + lane * 4) = w; } }
#pragma unroll
        for (int j = 0; j < 4; ++j) cur[j] = nxt[j];
    }
}

__device__ __forceinline__ int f2ord(float x) { const int i = __float_as_int(x); return i ^ ((i >> 31) & 0x7fffffff); }
__device__ __forceinline__ float ord2f(int k) { return __int_as_float(k ^ ((k >> 31) & 0x7fffffff)); }
__device__ __forceinline__ void phase_topk(const Params& p, unsigned char* lds) {
    const int tid = tid_l(), lane = tid & 63, wave = tid >> 6;
    unsigned char* wreg = lds + wave * 17408; unsigned char* tab = wreg;
    const _Float16* SC = (const _Float16*)(p.ws + WS_SC); int* EIDX = (int*)(p.ws + WS_EIDX); float* GATE = (float*)(p.ws + WS_GATE); unsigned long long* SOFF = (unsigned long long*)(p.ws + WS_SOFF);
    for (int g = bid_l() * 512 + tid; g < T * 16; g += grid_l() * 512) {
        const int tok = g >> 4, hc = g & 15;
        typedef _Float16 h8 __attribute__((ext_vector_type(8)));
        { const unsigned char* blk = (const unsigned char*)(SC + (size_t)(g - lane) * 128);
          u32x4 st[16];
#pragma unroll
          for (int j = 0; j < 16; ++j) st[j] = *(const u32x4*)(blk + (size_t)(j * 64 + lane) * 16);
          __builtin_amdgcn_wave_barrier();
#pragma unroll
          for (int j = 0; j < 16; ++j) { const int c = j * 64 + lane; *(u32x4*)(wreg + (c + (c >> 4)) * 16) = st[j]; }
          __builtin_amdgcn_wave_barrier(); }
        const unsigned char* lp = wreg + lane * 272;
#define TK_CE(a, b) do { const int hi_ = max(a, b), lo_ = min(a, b); a = hi_; b = lo_; } while (0)
        int tk[16];
#pragma unroll 1
        for (int gi = 0; gi < 8; ++gi) { const h8 cA = *(const h8*)(lp + gi * 32), c1_ = *(const h8*)(lp + gi * 32 + 16);
            int v[16];
#pragma unroll
            for (int j = 0; j < 8; ++j) { v[j] = (f2ord((float)cA[j]) & ~127) | (127 - (gi * 16 + j)); v[8 + j] = (f2ord((float)c1_[j]) & ~127) | (127 - (gi * 16 + 8 + j)); }
            TK_CE(v[0], v[1]); TK_CE(v[3], v[2]); TK_CE(v[4], v[5]); TK_CE(v[7], v[6]); TK_CE(v[8], v[9]); TK_CE(v[11], v[10]); TK_CE(v[12], v[13]); TK_CE(v[15], v[14]); TK_CE(v[0], v[2]); TK_CE(v[1], v[3]); TK_CE(v[6], v[4]); TK_CE(v[7], v[5]); TK_CE(v[8], v[10]); TK_CE(v[9], v[11]); TK_CE(v[14], v[12]); TK_CE(v[15], v[13]); TK_CE(v[0], v[1]); TK_CE(v[2], v[3]); TK_CE(v[5], v[4]); TK_CE(v[7], v[6]); TK_CE(v[8], v[9]); TK_CE(v[10], v[11]); TK_CE(v[13], v[12]); TK_CE(v[15], v[14]); TK_CE(v[0], v[4]); TK_CE(v[1], v[5]); TK_CE(v[2], v[6]); TK_CE(v[3], v[7]); TK_CE(v[12], v[8]); TK_CE(v[13], v[9]); TK_CE(v[14], v[10]); TK_CE(v[15], v[11]); TK_CE(v[0], v[2]); TK_CE(v[1], v[3]); TK_CE(v[4], v[6]); TK_CE(v[5], v[7]); TK_CE(v[10], v[8]); TK_CE(v[11], v[9]); TK_CE(v[14], v[12]); TK_CE(v[15], v[13]); TK_CE(v[0], v[1]); TK_CE(v[2], v[3]); TK_CE(v[4], v[5]); TK_CE(v[6], v[7]); TK_CE(v[9], v[8]); TK_CE(v[11], v[10]); TK_CE(v[13], v[12]); TK_CE(v[15], v[14]); TK_CE(v[0], v[8]); TK_CE(v[1], v[9]); TK_CE(v[2], v[10]); TK_CE(v[3], v[11]); TK_CE(v[4], v[12]); TK_CE(v[5], v[13]); TK_CE(v[6], v[14]); TK_CE(v[7], v[15]); TK_CE(v[0], v[4]); TK_CE(v[1], v[5]); TK_CE(v[2], v[6]); TK_CE(v[3], v[7]); TK_CE(v[8], v[12]); TK_CE(v[9], v[13]); TK_CE(v[10], v[14]); TK_CE(v[11], v[15]); TK_CE(v[0], v[2]); TK_CE(v[1], v[3]); TK_CE(v[4], v[6]); TK_CE(v[5], v[7]); TK_CE(v[8], v[10]); TK_CE(v[9], v[11]); TK_CE(v[12], v[14]); TK_CE(v[13], v[15]); TK_CE(v[0], v[1]); TK_CE(v[2], v[3]); TK_CE(v[4], v[5]); TK_CE(v[6], v[7]); TK_CE(v[8], v[9]); TK_CE(v[10], v[11]); TK_CE(v[12], v[13]); TK_CE(v[14], v[15]);
            if (gi == 0) {
#pragma unroll
                for (int j = 0; j < 16; ++j) tk[j] = v[j]; }
            else {
#pragma unroll
                for (int j = 0; j < 16; ++j) tk[j] = max(tk[j], v[15 - j]);
                TK_CE(tk[0], tk[8]); TK_CE(tk[1], tk[9]); TK_CE(tk[2], tk[10]); TK_CE(tk[3], tk[11]); TK_CE(tk[4], tk[12]); TK_CE(tk[5], tk[13]); TK_CE(tk[6], tk[14]); TK_CE(tk[7], tk[15]); TK_CE(tk[0], tk[4]); TK_CE(tk[1], tk[5]); TK_CE(tk[2], tk[6]); TK_CE(tk[3], tk[7]); TK_CE(tk[8], tk[12]); TK_CE(tk[9], tk[13]); TK_CE(tk[10], tk[14]); TK_CE(tk[11], tk[15]); TK_CE(tk[0], tk[2]); TK_CE(tk[1], tk[3]); TK_CE(tk[4], tk[6]); TK_CE(tk[5], tk[7]); TK_CE(tk[8], tk[10]); TK_CE(tk[9], tk[11]); TK_CE(tk[12], tk[14]); TK_CE(tk[13], tk[15]); TK_CE(tk[0], tk[1]); TK_CE(tk[2], tk[3]); TK_CE(tk[4], tk[5]); TK_CE(tk[6], tk[7]); TK_CE(tk[8], tk[9]); TK_CE(tk[10], tk[11]); TK_CE(tk[12], tk[13]); TK_CE(tk[14], tk[15]); }
            }
        __builtin_amdgcn_wave_barrier();
#undef TK_CE
        float av[16], bv[16]; int ai[16], bi[16]; const bool c1 = (hc & 1) != 0;
#pragma unroll
        for (int j = 0; j < 16; ++j) { const int ok = __shfl_xor(tk[j], 1); const int ka = c1 ? ok : tk[j], kb = c1 ? tk[j] : ok;
            av[j] = ord2f(ka & ~127); ai[j] = 127 - (ka & 127); bv[j] = ord2f(kb & ~127); bi[j] = 127 - (kb & 127); }
#pragma unroll
        for (int j = 0; j < 16; ++j) { tab[j * 64 + lane] = (unsigned char)ai[j]; tab[(16 + j) * 64 + lane] = (unsigned char)bi[j]; }
        int ck[16];
#pragma unroll
        for (int j = 0; j < 16; ++j) ck[j] = (int)0x80000000;
#pragma unroll
        for (int i = 0; i < 16; ++i)
#pragma unroll
            for (int j = 0; j < 16 / (i + 1); ++j) { int x = (f2ord(av[i] + bv[j]) & ~255) | (255 - (i * 16 + j));
#pragma unroll
                for (int q = 0; q < 16; ++q) { const int hi = max(ck[q], x); x = min(ck[q], x); ck[q] = hi; } }
        float den = 0.f; float ex[16]; const float c0 = ord2f(ck[0] & ~255);
#pragma unroll
        for (int j = 0; j < 16; ++j) { ex[j] = __expf(ord2f(ck[j] & ~255) - c0); den += ex[j]; }
        const float inv = 1.0f / den;
        int eid[16]; unsigned long long cnt = 0ull;
#pragma unroll
        for (int j = 0; j < 16; ++j) { const int flat = 255 - (ck[j] & 255); eid[j] = (int)tab[(flat >> 4) * 64 + lane] * 128 + (int)tab[(16 + (flat & 15)) * 64 + lane];
            if (!c1) cnt += 1ull << (8 * (eid[j] >> 11)); }
        unsigned long long incl = cnt;
#pragma unroll
        for (int o = 1; o < 16; o <<= 1) { const unsigned lo = __shfl_up((unsigned)incl, o, 16), hi = __shfl_up((unsigned)(incl >> 32), o, 16); if ((hc & 15) >= o) incl += ((unsigned long long)hi << 32) | lo; }
        const unsigned long long total = ((unsigned long long)__shfl((unsigned)(incl >> 32), 15, 16) << 32) | __shfl((unsigned)incl, 15, 16);
        const unsigned long long base = total * 0x0101010101010100ull;
        unsigned long long run = base + (incl - cnt);
        if (hc == 0) SOFF[tok] = base;
        if (!c1) {
#pragma unroll
            for (int j = 0; j < 16; ++j) { const int sh = 8 * (eid[j] >> 11); const int pos = (int)((run >> sh) & 0xffull); run += 1ull << sh;
                EIDX[(size_t)tok * 128 + pos] = eid[j]; GATE[(size_t)tok * 128 + pos] = ex[j] * inv; } }
    }
}

__device__ __forceinline__ float gelu_tanh(float h) { const float z = 0.7978845608028654f * (h + 0.044715f * h * h * h); const float t = 1.0f - 2.0f / (__expf(2.0f * z) + 1.0f); return 0.5f * h * (1.0f + t); }
struct PeerTok { u32x4 xa, xb; unsigned long long so; int e_lo, e_hi; float g_lo, g_hi; };
__device__ __forceinline__ PeerTok peer_tok_load(const bf16* XB, const int* EIDX, const float* GATE, const unsigned long long* SOFF, int tok, int lane) {
    PeerTok t; const int tk = tok < T ? tok : T - 1;
    t.xa = __builtin_nontemporal_load((const u32x4*)(XB + (size_t)tk * D + lane * 16)); t.xb = __builtin_nontemporal_load((const u32x4*)(XB + (size_t)tk * D + lane * 16 + 8));
    t.so = SOFF[tk]; t.e_lo = EIDX[(size_t)tk * 128 + lane]; t.e_hi = EIDX[(size_t)tk * 128 + 64 + lane]; t.g_lo = GATE[(size_t)tk * 128 + lane]; t.g_hi = GATE[(size_t)tk * 128 + 64 + lane];
    return t;
}
template <int CTRL> __device__ __forceinline__ float dpp_mov(float v) { return __int_as_float(__builtin_amdgcn_update_dpp(0, __float_as_int(v), CTRL, 0xf, 0xf, false)); }
__device__ __forceinline__ float xor16_sum(float v) { const auto r = __builtin_amdgcn_permlane16_swap(__float_as_uint(v), __float_as_uint(v), false, false); return __uint_as_float(r[0]) + __uint_as_float(r[1]); }
__device__ __forceinline__ float xor32_sum(float v) { const auto r = __builtin_amdgcn_permlane32_swap(__float_as_uint(v), __float_as_uint(v), false, false); return __uint_as_float(r[0]) + __uint_as_float(r[1]); }
#define PEER_ISSUE(R, tk, k0_, kl_) do { _Pragma("unroll") for (int q_ = 0; q_ < 8; ++q_) { const int k_ = min((k0_) + q_, (kl_)); \
    const int e_ = __builtin_amdgcn_readlane(k_ < 64 ? (tk).e_lo : (tk).e_hi, k_ & 63); R[q_] = *(const u32x4*)(U8 + (size_t)e_ * D + lane * 16); } } while (0)
__device__ __forceinline__ float gelu_tanh_fast(float h) { const float z = 0.7978845608028654f * (h + 0.044715f * h * h * h); const float t = 1.0f - 2.0f * __builtin_amdgcn_rcpf(__expf(2.0f * z) + 1.0f); return 0.5f * h * (1.0f + t); }
typedef __bf16 bf16x2v __attribute__((ext_vector_type(2)));
#define PEER_DOT(RC, q) do { d[q] = 0.f; _Pragma("unroll") for (int w = 0; w < 4; ++w) { \
            d[q] = __builtin_amdgcn_fdot2_f32_bf16(__builtin_amdgcn_cvt_scalef32_pk_bf16_fp8(RC[q][w], 1.0f / U8_SCALE, false), __builtin_bit_cast(bf16x2v, xp[2 * w]), d[q], false); \
            d[q] = __builtin_amdgcn_fdot2_f32_bf16(__builtin_amdgcn_cvt_scalef32_pk_bf16_fp8(RC[q][w], 1.0f / U8_SCALE, true), __builtin_bit_cast(bf16x2v, xp[2 * w + 1]), d[q], false); } } while (0)
#define PEER_COMPUTE(RC) do { float d[8]; \
    PEER_DOT(RC, 0); PEER_DOT(RC, 1); PEER_DOT(RC, 2); PEER_DOT(RC, 3); \
    if (k0 + 4 < end) { PEER_DOT(RC, 4); PEER_DOT(RC, 5); PEER_DOT(RC, 6); PEER_DOT(RC, 7); } else { d[4] = 0.f; d[5] = 0.f; d[6] = 0.f; d[7] = 0.f; }     \
    float t4[4]; \
    _Pragma("unroll") for (int j = 0; j < 4; ++j) { const float keep = (lane & 1) ? d[2 * j + 1] : d[2 * j], give = (lane & 1) ? d[2 * j] : d[2 * j + 1]; t4[j] = keep + dpp_mov<0xB1>(give); } \
    float sA, sB; \
    { const float keep = (lane & 2) ? t4[1] : t4[0], give = (lane & 2) ? t4[0] : t4[1]; sA = keep + dpp_mov<0x4E>(give); } \
    { const float keep = (lane & 2) ? t4[3] : t4[2], give = (lane & 2) ? t4[2] : t4[3]; sB = keep + dpp_mov<0x4E>(give); } \
    sA += dpp_mov<0x124>(sA); sB += dpp_mov<0x124>(sB); sA += dpp_mov<0x128>(sA); sB += dpp_mov<0x128>(sB); \
    sA = xor16_sum(sA); sB = xor16_sum(sB); sA = xor32_sum(sA); sB = xor32_sum(sB); \
    const float geA = sA, geB = sB;     \
      \
    { const int rel = (lane - k0) & 63; const int src = (rel & 3) << 2; \
      const float ga = __int_as_float(__builtin_amdgcn_ds_bpermute(src, __float_as_int(geA))), gb = __int_as_float(__builtin_amdgcn_ds_bpermute(src, __float_as_int(geB))); \
      const float gq = (rel & 4) ? gb : ga; const int kq = k0 + rel;              \
      c_lo = (rel < 8 && kq < 64) ? gq : c_lo; c_hi = (rel < 8 && kq >= 64) ? gq : c_hi; } } while (0)
#define PEER_KL(st, en) min(max((en) - 1, (st)), 127)
#define PEER_NEXT(RN) do { __builtin_amdgcn_sched_barrier(0); if (k0 + 8 < end) { PEER_ISSUE(RN, c, k0 + 8, PEER_KL(start, end)); } else { PEER_ISSUE(RN, n, nstart, PEER_KL(nstart, nend)); } __builtin_amdgcn_sched_barrier(0); } while (0)
#define PEER_RANGE(tk, st, en) do { const unsigned lo_ = __builtin_amdgcn_readfirstlane((unsigned)(tk).so), hi_ = __builtin_amdgcn_readfirstlane((unsigned)((tk).so >> 32)); \
    const unsigned long long so_ = ((unsigned long long)hi_ << 32) | lo_; st = (int)((so_ >> (8 * g0)) & 0xffull); en = g1 < 8 ? (int)((so_ >> (8 * g1)) & 0xffull) : 128; } while (0)
#define PEER_XV() do { _Pragma("unroll") for (int i = 0; i < 4; ++i) { xp[i] = c.xa[i]; xp[4 + i] = c.xb[i]; } } while (0)
#define PEER_ADVANCE() do { k0 += 8; if (k0 >= end) { \
        if (lane >= start && lane < end) GATE[(size_t)tok * 128 + lane] = c.g_lo * gelu_tanh_fast(c_lo) * (1.0f / V8_SCALE); \
        if (lane + 64 >= start && lane + 64 < end) GATE[(size_t)tok * 128 + 64 + lane] = c.g_hi * gelu_tanh_fast(c_hi) * (1.0f / V8_SCALE); \
        tok += stride; c = n; start = nstart; end = nend; k0 = start; c_lo = 0.f; c_hi = 0.f; PEER_XV(); \
        n = peer_tok_load(XB, EIDX, GATE, SOFF, tok + stride, lane); PEER_RANGE(n, nstart, nend); } } while (0)
__device__ __forceinline__ void phase_peer_u(const Params& p) {
    const int tid = tid_l(), lane = tid & 63, wave = tid >> 6, bid = bid_l(), G = grid_l();
    const bf16* XB = (const bf16*)(p.ws + WS_XB); const unsigned char* U8 = p.ws + WS_U;
    const int* EIDX = (const int*)(p.ws + WS_EIDX); float* GATE = (float*)(p.ws + WS_GATE); const unsigned long long* SOFF = (const unsigned long long*)(p.ws + WS_SOFF);
    const int ngrp = (G % 8 == 0) ? 8 : 1;
    const int g0 = (ngrp == 8) ? (bid & 7) : 0, g1 = (ngrp == 8) ? g0 + 1 : 8, r = (ngrp == 8) ? (bid >> 3) : bid, R = (ngrp == 8) ? (G >> 3) : G;
    const int stride = R * 8; int tok = r * 8 + wave;
    if (tok >= T) return;
    PeerTok c = peer_tok_load(XB, EIDX, GATE, SOFF, tok, lane), n = peer_tok_load(XB, EIDX, GATE, SOFF, tok + stride, lane);
    int start, end, nstart, nend; PEER_RANGE(c, start, end); PEER_RANGE(n, nstart, nend);
    unsigned xp[8]; PEER_XV();
    float c_lo = 0.f, c_hi = 0.f;
    int k0 = start;
    u32x4 Ra[8], Rb[8];
    PEER_ISSUE(Ra, c, start, PEER_KL(start, end));
#pragma unroll 1
    for (;;) {
        PEER_NEXT(Rb); PEER_COMPUTE(Ra); PEER_ADVANCE(); if (tok >= T) break;
        PEER_NEXT(Ra); PEER_COMPUTE(Rb); PEER_ADVANCE(); if (tok >= T) break;
    }
}
#undef PEER_ISSUE
#undef PEER_COMPUTE
#undef PEER_DOT
#undef PEER_NEXT
#undef PEER_KL
#undef PEER_RANGE
#undef PEER_XV
#undef PEER_ADVANCE
struct PeerVMeta { int e_lo, e_hi; float c_lo, c_hi; u32x4 x0, x1; };
__device__ __forceinline__ PeerVMeta peer_vmeta_load(const int* EIDX, const float* COEF, const bf16* XB, int tok, int lane) {
    PeerVMeta m;
    m.e_lo = EIDX[(size_t)tok * 128 + lane]; m.e_hi = EIDX[(size_t)tok * 128 + 64 + lane]; m.c_lo = COEF[(size_t)tok * 128 + lane]; m.c_hi = COEF[(size_t)tok * 128 + 64 + lane];
    m.x0 = *(const u32x4*)(XB + (size_t)tok * D + lane * 16); m.x1 = *(const u32x4*)(XB + (size_t)tok * D + lane * 16 + 8);
    return m;
}
__device__ __forceinline__ void phase_peer_v(const Params& p) {
    const int tid = tid_l(), lane = tid & 63, wave = tid >> 6;
    const unsigned char* V8 = p.ws + WS_V;
    const int* EIDX = (const int*)(p.ws + WS_EIDX); const float* COEF = (const float*)(p.ws + WS_GATE);
    bf16* XB = (bf16*)(p.ws + WS_XB);
    const int stride = grid_l() * 8; int tok = bid_l() * 8 + wave;
    if (tok >= T) return;
    PeerVMeta cur = peer_vmeta_load(EIDX, COEF, XB, tok, lane);
#pragma unroll 1
    for (; tok < T; tok += stride) {
        const PeerVMeta nxt = peer_vmeta_load(EIDX, COEF, XB, tok + stride < T ? tok + stride : tok, lane);
        __builtin_amdgcn_sched_barrier(0);
        float acc[16];
#pragma unroll
        for (int i = 0; i < 16; ++i) acc[i] = 0.f;
#pragma unroll 1
        for (int k0 = 0; k0 < 128; k0 += 8) {
            const int esel = k0 < 64 ? cur.e_lo : cur.e_hi; const unsigned csel = __float_as_uint(k0 < 64 ? cur.c_lo : cur.c_hi);
            u32x4 vr[8]; float cf[8];
#pragma unroll
            for (int q = 0; q < 8; ++q) { const int e = __builtin_amdgcn_readlane(esel, (k0 & 63) + q); cf[q] = __uint_as_float(__builtin_amdgcn_readlane(csel, (k0 & 63) + q));
                vr[q] = *(const u32x4*)(V8 + (size_t)e * D + lane * 16); }
#pragma unroll
            for (int q = 0; q < 8; ++q)
#pragma unroll
                for (int w = 0; w < 4; ++w) { const f32x2v a = __builtin_amdgcn_cvt_pk_f32_fp8((int)vr[q][w], false), b = __builtin_amdgcn_cvt_pk_f32_fp8((int)vr[q][w], true);
                    acc[4 * w] += cf[q] * a[0]; acc[4 * w + 1] += cf[q] * a[1]; acc[4 * w + 2] += cf[q] * b[0]; acc[4 * w + 3] += cf[q] * b[1]; }
        }
        float r[16];
#pragma unroll
        for (int i = 0; i < 4; ++i) { r[2 * i] = ALPHA * bf2f(cur.x0[i] & 0xffffu) + acc[2 * i]; r[2 * i + 1] = ALPHA * __uint_as_float(cur.x0[i] & 0xffff0000u) + acc[2 * i + 1];
                                      r[8 + 2 * i] = ALPHA * bf2f(cur.x1[i] & 0xffffu) + acc[8 + 2 * i]; r[8 + 2 * i + 1] = ALPHA * __uint_as_float(cur.x1[i] & 0xffff0000u) + acc[8 + 2 * i + 1]; }
#pragma unroll
        for (int w = 0; w < 2; ++w) { u32x4 o; o.x = pk2(r[8 * w], r[8 * w + 1]); o.y = pk2(r[8 * w + 2], r[8 * w + 3]); o.z = pk2(r[8 * w + 4], r[8 * w + 5]); o.w = pk2(r[8 * w + 6], r[8 * w + 7]);
            *(u32x4*)(XB + (size_t)tok * D + lane * 16 + 8 * w) = o; }
        cur = nxt;
    }
}
#define GAS __attribute__((address_space(1)))
#define LAS __attribute__((address_space(3)))
#define XB_TMO      128
#define XB_XCNT(j)  (256  + 64 * (j))
#define XB_XSUB(j)  (1280 + 64 * (j))
#define XB_XGEN(j)  (2304 + 64 * (j))
#define XB_TOP      3328
#define XB_TOPGEN   3392
#define XCD_BAR_WORDS 3456
#define XB_SPIN_CAP (1u << 18)

__device__ __forceinline__ unsigned xb_ld(unsigned* p)              { return __hip_atomic_load(p, __ATOMIC_RELAXED, __HIP_MEMORY_SCOPE_AGENT); }
__device__ __forceinline__ unsigned xb_add(unsigned* p, unsigned v) { return __hip_atomic_fetch_add(p, v, __ATOMIC_RELAXED, __HIP_MEMORY_SCOPE_AGENT); }
__device__ __forceinline__ unsigned xb_xcc_id() { return (unsigned)__builtin_amdgcn_s_getreg((3 << 11) | 20) & 0xFu; }
#define XB_SPIN(cond, bar) do { unsigned _sp = 0; while (cond) { __builtin_amdgcn_s_sleep(1); \
    if ((++_sp & 255u) == 0u) { if (xb_ld(&(bar)[XB_TMO])) break; if (_sp > XB_SPIN_CAP) { atomicAdd(&(bar)[XB_TMO], 1u); break; } } } } while (0)

struct XcdBarrier {
    unsigned* bar; unsigned x;
    volatile LAS unsigned* st;
};

__device__ __forceinline__ XcdBarrier xcd_barrier_post(unsigned* bar, volatile LAS unsigned* st) {
    XcdBarrier b; b.bar = bar; b.x = xb_xcc_id(); b.st = st;
    if (threadIdx.x == 0) (void)xb_add(&bar[XB_XCNT(b.x)], 1u);
    return b;
}
__device__ __forceinline__ void xcd_barrier_complete(unsigned* bar, unsigned x, unsigned& nloc, unsigned& nx) {
    const unsigned G = gridDim.x * gridDim.y * gridDim.z;
    unsigned sum, cnt, mine, sp = 0u;
    for (;;) {
        sum = 0u; cnt = 0u; mine = 0u;
#pragma unroll
        for (unsigned j = 0; j < 16; ++j) { const unsigned c = xb_ld(&bar[XB_XCNT(j)]); sum += c; cnt += (c > 0u) ? 1u : 0u; mine = (j == x) ? c : mine; }
        if (sum == G) break;
        __builtin_amdgcn_s_sleep(1);
        if ((++sp & 255u) == 0u) { if (xb_ld(&bar[XB_TMO])) break; if (sp > XB_SPIN_CAP) { atomicAdd(&bar[XB_TMO], 1u); break; } }
    }
    nloc = mine > 0u ? mine : 1u; nx = cnt > 0u ? cnt : 1u;
}

__device__ __forceinline__ void xcd_barrier(const XcdBarrier& b) {
    asm volatile("s_waitcnt vmcnt(0)" ::: "memory");
    __syncthreads();
    if (threadIdx.x == 0) {
        unsigned* bar = b.bar;
        __builtin_amdgcn_s_waitcnt(0);
        unsigned nloc = b.st[0], nx = b.st[1];
        if (nloc == 0u) { xcd_barrier_complete(bar, b.x, nloc, nx); b.st[0] = nloc; b.st[1] = nx; }
        const unsigned old = xb_add(&bar[XB_XSUB(b.x)], 1u);
        const unsigned gen = old / nloc;
        if (old + 1u == (gen + 1u) * nloc) {
            __builtin_amdgcn_fence(__ATOMIC_RELEASE, "agent");
            asm volatile("s_waitcnt vmcnt(0)" ::: "memory");
            const unsigned og = xb_add(&bar[XB_TOP], 1u);
            const unsigned tg = og / nx;
            if (og + 1u == (tg + 1u) * nx) xb_add(&bar[XB_TOPGEN], 1u);
            else XB_SPIN(xb_ld(&bar[XB_TOPGEN]) == tg, bar);
            __builtin_amdgcn_fence(__ATOMIC_ACQUIRE, "agent");
            xb_add(&bar[XB_XGEN(b.x)], 1u);
            asm volatile("s_waitcnt vmcnt(0)" ::: "memory");
        } else {
            XB_SPIN(xb_ld(&bar[XB_XGEN(b.x)]) == gen, bar);
            __builtin_amdgcn_fence(__ATOMIC_ACQUIRE, "agent");
            asm volatile("s_waitcnt vmcnt(0)" ::: "memory");
        }
    }
    __syncthreads();
}
enum { PH_PRO_A, PH_PRO_B, PH_CVT, PH_GEMM_IN, PH_GEMM_E, PH_CONV, PH_FOXCUM, PH_FOXNORM, PH_GLA1, PH_GLA2, PH_GLA3, PH_FOX, PH_GEMM_OUT, PH_LN1, PH_GEMM_SC, PH_TOPK, PH_PEERU, PH_PEERV, PH_GEMM_PLE, PH_LN2, PH_COUNT };

template <int PH> __device__ __forceinline__ void run_phase(const Params& p, int l, unsigned char* lds) {
    if constexpr (PH == PH_PRO_A) phase_pro_a(p, lds);
    else if constexpr (PH == PH_PRO_B) phase_pro_b(p, lds);
    else if constexpr (PH == PH_CVT) phase_cvt(p, l);
    else if constexpr (PH == PH_GEMM_IN) phase_gemm_in(p, l, lds);
    else if constexpr (PH == PH_GEMM_E) phase_gemm_e(p, l, lds);
    else if constexpr (PH == PH_CONV) phase_conv(p, l, lds);
    else if constexpr (PH == PH_FOXCUM) phase_fox_cum(p, l, lds);
    else if constexpr (PH == PH_FOXNORM) phase_fox_norm(p, lds);
    else if constexpr (PH == PH_GLA1) phase_gla_b1(p, l, lds);
    else if constexpr (PH == PH_GLA2) phase_gla_b2(p);
    else if constexpr (PH == PH_GLA3) phase_gla_b3(p, l, lds);
    else if constexpr (PH == PH_FOX) phase_fox_mfma(p, l, lds);
    else if constexpr (PH == PH_GEMM_OUT) phase_gemm_out(p, l, lds);
    else if constexpr (PH == PH_LN1) phase_ln((const _Float16*)(p.ws + WS_Y), p.ln1_g + (size_t)l * D, p.ln1_b + (size_t)l * D, nullptr, (bf16*)(p.ws + WS_XB));
    else if constexpr (PH == PH_GEMM_SC) phase_gemm_sc(p, l, lds);
    else if constexpr (PH == PH_TOPK) phase_topk(p, lds);
    else if constexpr (PH == PH_PEERU) phase_peer_u(p);
    else if constexpr (PH == PH_PEERV) phase_peer_v(p);
    else if constexpr (PH == PH_GEMM_PLE) phase_gemm_ple(p, l, lds);
    else if constexpr (PH == PH_LN2) phase_ln((const _Float16*)(p.ws + WS_Y), p.ln2_g + (size_t)l * D, p.ln2_b + (size_t)l * D, l == DEPTH - 1 ? p.out : nullptr, l == DEPTH - 1 ? nullptr : (bf16*)(p.ws + WS_XB));
}

constexpr int MISC_OFF = LDS_BYTES - 512;
constexpr int CW_BAR = 4096;
static_assert(MISC_OFF + 128 <= LDS_BYTES && (CW_BAR + XCD_BAR_WORDS) * 4 <= (int)CTL_ZERO_BYTES, "control words");

typedef __attribute__((address_space(4))) const Params CParams;
#define PHASE(PH) do { CParams* q_ = pp; asm volatile("" : "+s"(q_)); Params lp_; __builtin_memcpy(&lp_, q_, sizeof(Params)); run_phase<PH>(lp_, l, lds); } while (0)
__global__ void __launch_bounds__(512, 2) mk_fwd(Params p_unused) {
#if defined(__HIP_DEVICE_COMPILE__)
    extern __shared__ __attribute__((aligned(16))) unsigned char lds[];
    CParams* pp = (CParams*)__builtin_amdgcn_kernarg_segment_ptr();
    unsigned char* ws0; { CParams* q_ = pp; asm volatile("" : "+s"(q_)); ws0 = q_->ws; }
    volatile LAS unsigned* MISC = (volatile LAS unsigned*)((LAS unsigned char*)lds + MISC_OFF);
    if (threadIdx.x < 32) MISC[threadIdx.x] = 0u;
    __syncthreads();
    (void)xcd_barrier_post((unsigned*)(ws0 + WS_CTL) + CW_BAR, MISC + 8);
#define GB() do { CParams* qb_ = pp; asm volatile("" : "+s"(qb_)); XcdBarrier b_; b_.bar = (unsigned*)(qb_->ws + WS_CTL) + CW_BAR; b_.x = xb_xcc_id(); b_.st = MISC + 8; xcd_barrier(b_); } while (0)
    { const int l = 0; PHASE(PH_PRO_A); PHASE(PH_PRO_B); } GB();
    for (int l = 0; l < DEPTH; ++l) {
        PHASE(PH_CVT); PHASE(PH_GEMM_IN); GB();
        PHASE(PH_GEMM_E); PHASE(PH_CONV); PHASE(PH_FOXCUM); PHASE(PH_FOXNORM); PHASE(PH_GLA1); GB();
        PHASE(PH_GLA2); PHASE(PH_FOX); GB();
        PHASE(PH_GLA3); GB();
        PHASE(PH_GEMM_OUT); GB();
        PHASE(PH_LN1); GB();
        PHASE(PH_GEMM_SC); GB();
        PHASE(PH_TOPK); GB();
        PHASE(PH_PEERU); GB();
        PHASE(PH_PEERV); GB();
        PHASE(PH_GEMM_PLE); GB();
        PHASE(PH_LN2); GB();
    }
#undef GB
#endif
}

extern "C" void kernel_launch(void* const* d_in, const int* in_sizes, int n_in, void* d_out, int out_size, void* d_ws, size_t ws_size, hipStream_t stream) {
    static int grid = 0;
    if (grid == 0) {
        if (n_in != 23 || ws_size < WS_END) { fprintf(stderr, "kernel_launch: unexpected n_in %d or ws_size %zu\n", n_in, ws_size); grid = -1; return; }
        int dev = 0, cus = 0, per_cu = 0;
        if (hipGetDevice(&dev) != hipSuccess || hipDeviceGetAttribute(&cus, hipDeviceAttributeMultiprocessorCount, dev) != hipSuccess) { grid = -1; return; }
        if (hipFuncSetAttribute((const void*)mk_fwd, hipFuncAttributeMaxDynamicSharedMemorySize, LDS_BYTES) != hipSuccess) { grid = -1; return; }
        if (hipOccupancyMaxActiveBlocksPerMultiprocessor(&per_cu, (const void*)mk_fwd, 512, LDS_BYTES) != hipSuccess || per_cu < 1) { fprintf(stderr, "kernel_launch: occupancy query says %d\n", per_cu); }
        (void)hipGetLastError();
        grid = cus;
    }
    if (grid < 0) return;
    if (hipMemsetAsync((char*)d_ws + WS_CTL, 0, CTL_ZERO_BYTES, stream) != hipSuccess) return;
    Params p; memset(&p, 0, sizeof(p));
    const float** f = (const float**)&p;
    for (int i = 0; i < 23; ++i) f[i] = (const float*)d_in[i];
    p.out = (float*)d_out; p.ws = (unsigned char*)d_ws;
    hipLaunchKernelGGL(mk_fwd, dim3(grid), dim3(512), LDS_BYTES, stream, p);
}
```

```cpp
#include <hip/hip_runtime.h>
#include <cstdio>
#include <cstdint>
#include <cstring>
#include <cmath>
__device__ __forceinline__ int tid_l() { int t = threadIdx.x; asm volatile("" : "+v"(t)); return t; }
__device__ __forceinline__ int bid_l() { int b = blockIdx.x; asm volatile("" : "+s"(b)); return b; }
__device__ __forceinline__ int grid_l() { int g = gridDim.x; asm volatile("" : "+s"(g)); return g; }
namespace pg8 {
#define PG8_LAS __attribute__((address_space(3)))
typedef unsigned short bf16_t;
typedef short bf16x8 __attribute__((ext_vector_type(8)));
typedef float f32x4 __attribute__((ext_vector_type(4)));
typedef unsigned u32x4 __attribute__((ext_vector_type(4)));
constexpr int BM = 256, BK = 64, HALF = 128, HTB = HALF * BK * 2  , STAGE_BYTES = 8 * HTB, NXCD = 8, WGM = 8;

__host__ __device__ __forceinline__ int lds_byte(int r, int c) { const int st = (r >> 4) * 2 + (c >> 5), rr = r & 15, cc = c & 31, ob = rr * 64 + cc * 2; return st * 1024 + (ob ^ (((ob >> 9) & 1) << 5)); }
__host__ __device__ __forceinline__ void stage_rc(int b, int& R, int& C) { const int st = b / 1024, sb = b % 1024, swz = sb ^ (((sb >> 9) & 1) << 5); R = (st >> 1) * 16 + swz / 64; C = (st & 1) * 32 + (swz % 64) / 2; }
__host__ __device__ __forceinline__ int perm32(int rho) { const int n = rho >> 4, i = rho & 15; return 8 * (i >> 2) + 4 * n + (i & 3); }

struct Unit { int pm, pn; };
struct Gemm { const bf16_t* A; const bf16_t* Bt; int M, N, K; };

struct StaticOrder {
    int nM, nN, nwg, G, c;
    __host__ __device__ void init(int M, int N, int G_, int c_) { nM = M / BM; nN = N / BM; nwg = nM * nN; G = G_; c = c_; }
    __host__ __device__ bool next(int i, Unit& u) const {
        const long L = (long)i * G + c; if (L >= nwg) return false;
        int wgid = (int)L; { const int q = nwg / NXCD, r = nwg % NXCD, xcd = wgid % NXCD, off = wgid / NXCD; wgid = (xcd < r ? xcd * (q + 1) : r * (q + 1) + (xcd - r) * q) + off; }
        const int nig = WGM * nN, gid = wgid / nig, fm = gid * WGM, gsz = (nM - fm) < WGM ? (nM - fm) : WGM;
        u.pm = fm + ((wgid % nig) % gsz); u.pn = (wgid % nig) / gsz; return true;
    }
    __device__ __forceinline__ void a_ready(const Unit&) const {}
    __device__ __forceinline__ void done(const Unit&) const {}
};

__device__ __forceinline__ unsigned cvt_pk_bf16(float lo, float hi) { unsigned r; asm volatile("v_cvt_pk_bf16_f32 %0, %1, %2" : "=v"(r) : "v"(lo), "v"(hi)); return r; }
typedef float f32x2 __attribute__((ext_vector_type(2)));
__device__ __forceinline__ f32x2 gelu_pk(f32x2 v) {
    const f32x2 av = __builtin_elementwise_abs(v), d = av * 0.2316418882f + 1.0f;
    f32x2 t; t.x = __builtin_amdgcn_rcpf(d.x); t.y = __builtin_amdgcn_rcpf(d.y);
    f32x2 q = t * 0.5307027145f + (-0.7265760135f); q = q * t + 0.7107068705f; q = q * t + (-0.142248368f); q = q * t + 0.127414796f; q = q * t;
    const f32x2 s = (v * v) * (-0.72134752044f);
    f32x2 e; e.x = __builtin_amdgcn_exp2f(s.x); e.y = __builtin_amdgcn_exp2f(s.y);
    const f32x2 m = v * (q * e), r = v - m;
    f32x2 o; o.x = v.x < 0.f ? m.x : r.x; o.y = v.y < 0.f ? m.y : r.y; return o;
}

template <int ACT  > struct EpiBf16 {
    static constexpr bool PERM = true, AFTER_DRAIN = false; static_assert(ACT == 0 || ACT == 1, "EpiBf16: ACT is 0 (none) or 1 (gelu_pk)");
    bf16_t* O; int ldc; const float* bias; int split_cols; size_t split_stride; float scale0;
    __device__ __forceinline__ void operator()(const f32x4 (&acc)[2][2][4][2], const Unit& u, int wr, int wc, int fr, int fq) const {
        const int row0 = u.pm * BM + wr * 64 + fr; int colt = u.pn * BM; bf16_t* base = O;
        float sc = 1.f; if (split_cols) { const int t = colt / split_cols; base += (size_t)t * split_stride; colt -= t * split_cols; if (t == 0) sc = scale0; }
        const int col0 = colt + wc * 32 + 8 * fq, bcol0 = u.pn * BM + wc * 32 + 8 * fq;
        f32x4 bv[2][2];
#pragma unroll
        for (int bj = 0; bj < 2; ++bj)
#pragma unroll
            for (int n = 0; n < 2; ++n) bv[bj][n] = bias ? *(const f32x4*)(bias + bcol0 + bj * HALF + 4 * n) : (f32x4){0.f, 0.f, 0.f, 0.f};
#pragma unroll
        for (int ai = 0; ai < 2; ++ai)
#pragma unroll
            for (int m = 0; m < 4; ++m) { bf16_t* rowp = base + (size_t)(row0 + ai * HALF + m * 16) * ldc + col0;
#pragma unroll
                for (int bj = 0; bj < 2; ++bj) { f32x4 v0 = acc[ai][bj][m][0] + bv[bj][0], v1 = acc[ai][bj][m][1] + bv[bj][1];
                    if (ACT == 1) { f32x2 a = gelu_pk((f32x2){v0[0], v0[1]}), b = gelu_pk((f32x2){v0[2], v0[3]}), c = gelu_pk((f32x2){v1[0], v1[1]}), d = gelu_pk((f32x2){v1[2], v1[3]});
                        v0 = (f32x4){a.x, a.y, b.x, b.y}; v1 = (f32x4){c.x, c.y, d.x, d.y}; }
                    v0 = v0 * sc; v1 = v1 * sc; u32x4 w; w.x = cvt_pk_bf16(v0[0], v0[1]); w.y = cvt_pk_bf16(v0[2], v0[3]); w.z = cvt_pk_bf16(v1[0], v1[1]); w.w = cvt_pk_bf16(v1[2], v1[3]);
                    *(u32x4*)(rowp + bj * HALF) = w; } }
    }
};
struct EpiF16 {
    static constexpr bool PERM = true, AFTER_DRAIN = false;
    _Float16* O; int ldc;
    __device__ __forceinline__ void operator()(const f32x4 (&acc)[2][2][4][2], const Unit& u, int wr, int wc, int fr, int fq) const {
        typedef _Float16 h8 __attribute__((ext_vector_type(8)));
        const int row0 = u.pm * BM + wr * 64 + fr, col0 = u.pn * BM + wc * 32 + 8 * fq;
#pragma unroll
        for (int ai = 0; ai < 2; ++ai)
#pragma unroll
            for (int m = 0; m < 4; ++m) { _Float16* rowp = O + (size_t)(row0 + ai * HALF + m * 16) * ldc + col0;
#pragma unroll
                for (int bj = 0; bj < 2; ++bj) { const f32x4 a = acc[ai][bj][m][0], b = acc[ai][bj][m][1];
                    h8 o; o[0] = (_Float16)a[0]; o[1] = (_Float16)a[1]; o[2] = (_Float16)a[2]; o[3] = (_Float16)a[3]; o[4] = (_Float16)b[0]; o[5] = (_Float16)b[1]; o[6] = (_Float16)b[2]; o[7] = (_Float16)b[3];
                    *(h8*)(rowp + bj * HALF) = o; } }
    }
};
struct EpiResid {
    static constexpr bool PERM = true, AFTER_DRAIN = false;
    const bf16_t* res; _Float16* Y; int ldc; float alpha;
    __device__ __forceinline__ void operator()(const f32x4 (&acc)[2][2][4][2], const Unit& u, int wr, int wc, int fr, int fq) const {
        const int row0 = u.pm * BM + wr * 64 + fr, col0 = u.pn * BM + wc * 32 + 8 * fq;
#pragma unroll
        for (int ai = 0; ai < 2; ++ai)
#pragma unroll
            for (int m = 0; m < 4; ++m) { const size_t off = (size_t)(row0 + ai * HALF + m * 16) * ldc + col0;
#pragma unroll
                for (int bj = 0; bj < 2; ++bj) { const u32x4 rv = *(const u32x4*)(res + off + bj * HALF);
                    f32x4 r0, r1; r0[0] = __uint_as_float(rv.x << 16); r0[1] = __uint_as_float(rv.x & 0xffff0000u); r0[2] = __uint_as_float(rv.y << 16); r0[3] = __uint_as_float(rv.y & 0xffff0000u);
                    r1[0] = __uint_as_float(rv.z << 16); r1[1] = __uint_as_float(rv.z & 0xffff0000u); r1[2] = __uint_as_float(rv.w << 16); r1[3] = __uint_as_float(rv.w & 0xffff0000u);
                    const f32x4 y0 = r0 * alpha + acc[ai][bj][m][0], y1 = r1 * alpha + acc[ai][bj][m][1];
                    typedef _Float16 h8 __attribute__((ext_vector_type(8))); h8 w; w[0] = (_Float16)y0[0]; w[1] = (_Float16)y0[1]; w[2] = (_Float16)y0[2]; w[3] = (_Float16)y0[3]; w[4] = (_Float16)y1[0]; w[5] = (_Float16)y1[1]; w[6] = (_Float16)y1[2]; w[7] = (_Float16)y1[3];
                    *(h8*)(Y + off + bj * HALF) = w; } }
    }
};
struct EpiPle {
    static constexpr bool PERM = true, AFTER_DRAIN = false;
    const bf16_t* R; _Float16* Y; const bf16_t* E; const float* gb; int ldc;
    __device__ __forceinline__ void operator()(const f32x4 (&acc)[2][2][4][2], const Unit& u, int wr, int wc, int fr, int fq) const {
        const int row0 = u.pm * BM + wr * 64 + fr, col0 = u.pn * BM + wc * 32 + 8 * fq;
        f32x4 bv[2][2];
#pragma unroll
        for (int bj = 0; bj < 2; ++bj)
#pragma unroll
            for (int n = 0; n < 2; ++n) bv[bj][n] = *(const f32x4*)(gb + col0 + bj * HALF + 4 * n);
#pragma unroll
        for (int ai = 0; ai < 2; ++ai)
#pragma unroll
            for (int m = 0; m < 4; ++m) { const size_t off = (size_t)(row0 + ai * HALF + m * 16) * ldc + col0;
#pragma unroll
                for (int bj = 0; bj < 2; ++bj) {
                    const u32x4 ev = *(const u32x4*)(E + off + bj * HALF), rv = *(const u32x4*)(R + off + bj * HALF);
                    float o[8];
#pragma unroll
                    for (int n = 0; n < 2; ++n) {
                        const f32x4 z = acc[ai][bj][m][n] + bv[bj][n];
                        const unsigned e0 = n == 0 ? ev.x : ev.z, e1 = n == 0 ? ev.y : ev.w, r0 = n == 0 ? rv.x : rv.z, r1 = n == 0 ? rv.y : rv.w;
                        f32x4 ee, rr; ee[0] = __uint_as_float(e0 << 16); ee[1] = __uint_as_float(e0 & 0xffff0000u); ee[2] = __uint_as_float(e1 << 16); ee[3] = __uint_as_float(e1 & 0xffff0000u);
                        rr[0] = __uint_as_float(r0 << 16); rr[1] = __uint_as_float(r0 & 0xffff0000u); rr[2] = __uint_as_float(r1 << 16); rr[3] = __uint_as_float(r1 & 0xffff0000u);
#pragma unroll
                        for (int i = 0; i < 4; ++i) o[4 * n + i] = rr[i] + ee[i] * __builtin_amdgcn_rcpf(1.0f + __expf(-z[i])); }
                    typedef _Float16 h8 __attribute__((ext_vector_type(8))); h8 w;
#pragma unroll
                    for (int i = 0; i < 8; ++i) w[i] = (_Float16)o[i];
                    *(h8*)(Y + off + bj * HALF) = w; } }
    }
};
template <class Epi, class Sched, bool ALIGN_EPI = false, bool SP2 = false>
__device__ __forceinline__ void gemm_phase(PG8_LAS unsigned char* lds, const Gemm g, const Sched& S, const Epi& E) {
    const int tid = tid_l(), wid = __builtin_amdgcn_readfirstlane(tid >> 6), lane = tid & 63, wr = wid >> 2, wc = wid & 3, fr = lane & 15, fq = lane >> 4;
    const int K = g.K, nt = K / BK;
    unsigned voffA[2], voffB[2];
#pragma unroll
    for (int i = 0; i < 2; ++i) { int R, C; stage_rc(tid * 16 + i * 8192, R, C); const int Rb = Epi::PERM ? ((R & ~31) + perm32(R & 31)) : R;
        voffA[i] = (unsigned)(R * K + C) * 2u; voffB[i] = (unsigned)(Rb * K + C) * 2u; }
    const size_t kstep = (size_t)(BK * 2);
    const size_t hstep = (size_t)HALF * K * 2;
    const size_t tstep = 2 * hstep;
    const unsigned ldsw = (unsigned)wid * 1024u;
    const int aoff = lds_byte(wr * 64 + fr, fq * 8), boff = lds_byte(wc * 32 + fr, fq * 8);
#define PG8_SA(b, h) (((b) * 2 + (h)) * HTB)
#define PG8_SB(b, h) ((4 + (b) * 2 + (h)) * HTB)
#define PG8_STAGE(bufoff, gbase, voff) do { _Pragma("unroll") for (int _i = 0; _i < 2; ++_i) \
        __builtin_amdgcn_global_load_lds((const unsigned*)((const char*)(gbase) + (voff)[_i]), (PG8_LAS unsigned*)(lds + (bufoff) + ldsw + _i * 8192), 16, 0, 0); } while (0)
#define PG8_LDA(dst, b, h) do { _Pragma("unroll") for (int m = 0; m < 4; ++m) _Pragma("unroll") for (int k = 0; k < 2; ++k) dst[m][k] = *(const PG8_LAS bf16x8*)(lds + PG8_SA(b, h) + aoff + m * 2048 + k * 1024); } while (0)
#define PG8_LDB(dst, b, h) do { _Pragma("unroll") for (int n = 0; n < 2; ++n) _Pragma("unroll") for (int k = 0; k < 2; ++k) dst[n][k] = *(const PG8_LAS bf16x8*)(lds + PG8_SB(b, h) + boff + n * 2048 + k * 1024); } while (0)
#define PG8_MMA(ai, bj, At, Bt) do { __builtin_amdgcn_s_setprio(1); _Pragma("unroll") for (int m = 0; m < 4; ++m) _Pragma("unroll") for (int n = 0; n < 2; ++n) _Pragma("unroll") for (int k = 0; k < 2; ++k) \
        acc[ai][bj][m][n] = __builtin_amdgcn_mfma_f32_16x16x32_bf16(Bt[n][k], At[m][k], acc[ai][bj][m][n], 0, 0, 0); __builtin_amdgcn_s_setprio(0); } while (0)
#define PG8_WAIT_V(n) asm volatile("s_waitcnt vmcnt(" #n ")" ::: "memory")
#define PG8_WAIT_L(n) asm volatile("s_waitcnt lgkmcnt(" #n ")" ::: "memory")
#define PG8_BAR __builtin_amdgcn_s_barrier()
#define PG8_SCHED __builtin_amdgcn_sched_barrier(0)
    Unit cur, nxt; int ui = 0;
    if (!S.next(0, cur)) return;
    f32x4 acc[2][2][4][2];
#pragma unroll
    for (int a = 0; a < 2; ++a)
#pragma unroll
        for (int b = 0; b < 2; ++b)
#pragma unroll
            for (int m = 0; m < 4; ++m)
#pragma unroll
                for (int n = 0; n < 2; ++n) acc[a][b][m][n] = (f32x4){0.f, 0.f, 0.f, 0.f};
    bf16x8 At[4][2], B0[2][2], B1[2][2];
    const char* cA = (const char*)g.A + (size_t)cur.pm * tstep; const char* cB = (const char*)g.Bt + (size_t)cur.pn * tstep;
    S.a_ready(cur);
    if constexpr (SP2) {
        PG8_STAGE(PG8_SB(0, 0), cB, voffB); PG8_STAGE(PG8_SB(0, 1), cB + hstep, voffB); PG8_STAGE(PG8_SA(0, 0), cA, voffA); PG8_STAGE(PG8_SA(0, 1), cA + hstep, voffA);
        if (wr == 1) PG8_BAR;
        PG8_WAIT_V(2); PG8_BAR;
        PG8_STAGE(PG8_SB(1, 0), cB + kstep, voffB); PG8_STAGE(PG8_SA(1, 0), cA + kstep, voffA); PG8_STAGE(PG8_SB(1, 1), cB + hstep + kstep, voffB);
        PG8_WAIT_V(6); PG8_BAR;
    } else {
        PG8_STAGE(PG8_SB(0, 0), cB, voffB); PG8_STAGE(PG8_SA(0, 0), cA, voffA); PG8_STAGE(PG8_SB(0, 1), cB + hstep, voffB); PG8_STAGE(PG8_SA(0, 1), cA + hstep, voffA);
        if (wr == 1) PG8_BAR;
        PG8_WAIT_V(4); PG8_BAR;
        PG8_STAGE(PG8_SB(1, 0), cB + kstep, voffB); PG8_STAGE(PG8_SA(1, 0), cA + kstep, voffA); PG8_STAGE(PG8_SB(1, 1), cB + hstep + kstep, voffB);
        PG8_WAIT_V(6); PG8_BAR;
    }
    for (;;) {
        const bool has_next = S.next(ui + 1, nxt);
        const char* nA = has_next ? (const char*)g.A + (size_t)nxt.pm * tstep : cA; const char* nB = has_next ? (const char*)g.Bt + (size_t)nxt.pn * tstep : cB;
        for (int t = 0; t < nt; t += 2) {
            const bool last = (t == nt - 2);
            const char* a1 = cA + (size_t)(t + 1) * kstep;
            const char* a2 = last ? nA : cA + (size_t)(t + 2) * kstep; const char* b2 = last ? nB : cB + (size_t)(t + 2) * kstep;
            const char* a3 = a2 + kstep; const char* b3 = b2 + kstep;
            if (last && has_next) S.a_ready(nxt);
            if constexpr (SP2) {
            PG8_LDB(B0, 0, 0); PG8_LDB(B1, 0, 1); PG8_SCHED; PG8_LDA(At, 0, 0); PG8_STAGE(PG8_SA(1, 1), a1 + hstep, voffA);
            PG8_WAIT_V(8); PG8_WAIT_L(0); PG8_BAR; PG8_MMA(0, 0, At, B0); PG8_MMA(0, 1, At, B1); PG8_BAR; PG8_SCHED;
            PG8_LDA(At, 0, 1); PG8_STAGE(PG8_SB(0, 0), b2, voffB); PG8_STAGE(PG8_SB(0, 1), b2 + hstep, voffB); PG8_STAGE(PG8_SA(0, 0), a2, voffA);
            PG8_WAIT_V(8); PG8_WAIT_L(0); PG8_BAR; PG8_MMA(1, 0, At, B0); PG8_MMA(1, 1, At, B1); PG8_BAR; PG8_SCHED;
            PG8_LDB(B0, 1, 0); PG8_LDB(B1, 1, 1); PG8_SCHED; PG8_LDA(At, 1, 0); PG8_STAGE(PG8_SA(0, 1), a2 + hstep, voffA);
            PG8_WAIT_V(8); PG8_WAIT_L(0); PG8_BAR; PG8_MMA(0, 0, At, B0); PG8_MMA(0, 1, At, B1); PG8_BAR; PG8_SCHED;
            PG8_LDA(At, 1, 1); PG8_STAGE(PG8_SB(1, 0), b3, voffB); PG8_STAGE(PG8_SB(1, 1), b3 + hstep, voffB); PG8_STAGE(PG8_SA(1, 0), a3, voffA);
            PG8_WAIT_V(8); PG8_WAIT_L(0); PG8_BAR; PG8_MMA(1, 0, At, B0); PG8_MMA(1, 1, At, B1); PG8_BAR; PG8_SCHED;
            } else {
            PG8_LDB(B0, 0, 0); PG8_SCHED; PG8_LDA(At, 0, 0); PG8_STAGE(PG8_SA(1, 1), a1 + hstep, voffA);
            PG8_WAIT_L(8); PG8_BAR; PG8_WAIT_L(0); PG8_MMA(0, 0, At, B0); PG8_BAR; PG8_SCHED;
            PG8_LDB(B1, 0, 1); PG8_STAGE(PG8_SB(0, 0), b2, voffB);
            PG8_BAR; PG8_WAIT_L(0); PG8_MMA(0, 1, At, B1); PG8_BAR;
            PG8_LDA(At, 0, 1); PG8_STAGE(PG8_SA(0, 0), a2, voffA);
            PG8_BAR; PG8_WAIT_L(0); PG8_MMA(1, 0, At, B0); PG8_BAR; PG8_SCHED;
            PG8_STAGE(PG8_SB(0, 1), b2 + hstep, voffB);
            PG8_WAIT_V(6); PG8_BAR; PG8_MMA(1, 1, At, B1); PG8_BAR;
            PG8_LDB(B0, 1, 0); PG8_SCHED; PG8_LDA(At, 1, 0); PG8_STAGE(PG8_SA(0, 1), a2 + hstep, voffA);
            PG8_WAIT_L(8); PG8_BAR; PG8_WAIT_L(0); PG8_MMA(0, 0, At, B0); PG8_BAR; PG8_SCHED;
            PG8_LDB(B1, 1, 1); PG8_STAGE(PG8_SB(1, 0), b3, voffB);
            PG8_BAR; PG8_WAIT_L(0); PG8_MMA(0, 1, At, B1); PG8_BAR;
            PG8_LDA(At, 1, 1); PG8_STAGE(PG8_SA(1, 0), a3, voffA);
            PG8_BAR; PG8_WAIT_L(0); PG8_MMA(1, 0, At, B0); PG8_BAR; PG8_SCHED;
            PG8_STAGE(PG8_SB(1, 1), b3 + hstep, voffB);
            PG8_WAIT_V(6); PG8_BAR; PG8_MMA(1, 1, At, B1); PG8_BAR;
            }
        }
        if constexpr (ALIGN_EPI) { if (wr == 0) PG8_BAR; }
        if constexpr (!Epi::AFTER_DRAIN) { E(acc, cur, wr, wc, fr, fq); S.done(cur); }
        if (!has_next) break;
#pragma unroll
        for (int a = 0; a < 2; ++a)
#pragma unroll
            for (int b = 0; b < 2; ++b)
#pragma unroll
                for (int m = 0; m < 4; ++m)
#pragma unroll
                    for (int n = 0; n < 2; ++n) acc[a][b][m][n] = (f32x4){0.f, 0.f, 0.f, 0.f};
        cur = nxt; cA = nA; cB = nB; ++ui;
        if constexpr (ALIGN_EPI) { if (wr == 1) PG8_BAR; }
    }
    PG8_WAIT_V(0);
    if constexpr (!ALIGN_EPI) { if (wr == 0) PG8_BAR; }
    PG8_BAR;
    if constexpr (Epi::AFTER_DRAIN) { E.fused(acc, cur, wr, wc, fr, fq, lds, wid, lane); S.done(cur); }
#undef PG8_SA
#undef PG8_SB
#undef PG8_STAGE
#undef PG8_LDA
#undef PG8_LDB
#undef PG8_MMA
#undef PG8_WAIT_V
#undef PG8_WAIT_L
#undef PG8_BAR
#undef PG8_SCHED
}
}
#include <hip/hip_bf16.h>
#include <cmath>
namespace attn_body {
using bf16=__hip_bfloat16;
using bf16x8=__attribute__((ext_vector_type(8)))short;
using s16x4=__attribute__((ext_vector_type(4)))short;
using f32x16=__attribute__((ext_vector_type(16)))float;
using u32x4=__attribute__((ext_vector_type(4)))unsigned;
constexpr int BATCH=8,NHEAD=6,SEQ=4096,D=64,KVP=3072,OP=1024;
constexpr int NW=8,QBLK=32,QB=QBLK*NW,KVBLK=64,NQB=SEQ/QB;
constexpr int ATTN_UNIT_ROWS=QB;
__device__ __forceinline__ int crow(int r,int hi){return (r&3)+8*(r>>2)+4*hi;}
#define SBAR() __builtin_amdgcn_sched_barrier(0)
__device__ __forceinline__ void cmask(f32x16&p0,f32x16&p1,int jb,int qrel,int hi){
  const float NEG=-INFINITY; int kb=64*jb+4*hi;
  #pragma unroll
  for(int r=0;r<16;++r){int kv=kb+(r&3)+8*(r>>2); if(kv>qrel)p0[r]=NEG; if(kv+32>qrel)p1[r]=NEG;}
}

constexpr int NSLOT=3, SLOTB=8192;
constexpr int LDS_K=0, LDS_V=NSLOT*SLOTB, LDS_WS=2*NSLOT*SLOTB, LDS_OST=LDS_WS+NW*64*4, LDS_CK=LDS_OST+NW*4096, LDS_BYTES=LDS_CK+SEQ*4;
constexpr float C2=0.125f*1.4426950408889634f;
__device__ __forceinline__ void glds16(const void*gsrc,unsigned lds_dst){unsigned keep;
  asm volatile("s_mov_b32 %0, m0\n\ts_mov_b32 m0, %2\n\ts_nop 0\n\tglobal_load_lds_dwordx4 %1, off\n\ts_mov_b32 m0, %0":"=&s"(keep):"v"(gsrc),"s"(lds_dst):"memory");}
__device__ __forceinline__ float max3f(float a,float b,float c){float r;asm("v_max3_f32 %0, %1, %2, %3":"=v"(r):"v"(a),"v"(b),"v"(c));return r;}
__device__ __forceinline__ float max2f(float a,float b){float r;asm("v_max_f32_e32 %0, %1, %2":"=v"(r):"v"(a),"v"(b));return r;}
__device__ __forceinline__ float fadd_s(float a,float b){float r;asm("v_add_f32_e32 %0, %1, %2":"=v"(r):"v"(a),"v"(b));return r;}
__device__ __forceinline__ float fsub_s(float a,float b){float r;asm("v_sub_f32_e32 %0, %1, %2":"=v"(r):"v"(a),"v"(b));return r;}
typedef float f32x2_t __attribute__((ext_vector_type(2))); typedef float f32x4_t __attribute__((ext_vector_type(4))); typedef __bf16 bf16x2_t __attribute__((ext_vector_type(2)));
__device__ __forceinline__ unsigned cvtpk_s(float lo,float hi){f32x2_t v={lo,hi};bf16x2_t b=__builtin_convertvector(v,bf16x2_t);return __builtin_bit_cast(unsigned,b);}
#define WAIT_BAR(N) asm volatile("s_waitcnt vmcnt(" #N ") lgkmcnt(0)\n\ts_barrier":::"memory")

__device__ __forceinline__ void qkt(f32x16&p0,f32x16&p1,const char*Kslot,const bf16x8*qr,int r32,int hi){
  const char*kb=Kslot+hi*1024+r32*16;
  #pragma unroll
  for(int d0=0;d0<4;++d0){
    const bf16x8 b0=*reinterpret_cast<const bf16x8*>(kb+d0*2048);
    const bf16x8 b1=*reinterpret_cast<const bf16x8*>(kb+d0*2048+512);
    {p0=__builtin_amdgcn_mfma_f32_32x32x16_bf16(b0,qr[d0],p0,0,0,0);p1=__builtin_amdgcn_mfma_f32_32x32x16_bf16(b1,qr[d0],p1,0,0,0);}}
}
typedef __attribute__((address_space(3))) const char* lds_cptr;
typedef short v4i16_t __attribute__((ext_vector_type(4)));
__device__ __forceinline__ void kload8(bf16x8*kf,lds_cptr kp){
  kf[0]=*(const __attribute__((address_space(3))) bf16x8*)(kp);      kf[1]=*(const __attribute__((address_space(3))) bf16x8*)(kp+512);
  kf[2]=*(const __attribute__((address_space(3))) bf16x8*)(kp+2048); kf[3]=*(const __attribute__((address_space(3))) bf16x8*)(kp+2560);
  kf[4]=*(const __attribute__((address_space(3))) bf16x8*)(kp+4096); kf[5]=*(const __attribute__((address_space(3))) bf16x8*)(kp+4608);
  kf[6]=*(const __attribute__((address_space(3))) bf16x8*)(kp+6144); kf[7]=*(const __attribute__((address_space(3))) bf16x8*)(kp+6656);
}
__device__ __forceinline__ void kload2(bf16x8*kf,lds_cptr kp,int j){ kf[2*j]=*(const __attribute__((address_space(3))) bf16x8*)(kp+j*2048); kf[2*j+1]=*(const __attribute__((address_space(3))) bf16x8*)(kp+j*2048+512); }
__device__ __forceinline__ s16x4 vtr(lds_cptr p){ return __builtin_bit_cast(s16x4,__builtin_amdgcn_ds_read_tr16_b64_v4i16((__attribute__((address_space(3))) v4i16_t*)p)); }
__device__ __forceinline__ float rowmax(const f32x16&p0,const f32x16&p1){
  float a=max3f(p0[0],p0[1],p1[0]),b=max3f(p0[2],p0[3],p1[1]);a=max3f(a,p1[2],p1[3]);
  #pragma unroll
  for(int r=4;r<16;r+=4){a=max3f(a,p0[r],p0[r+1]);b=max3f(b,p0[r+2],p0[r+3]);a=max3f(a,p1[r],p1[r+1]);b=max3f(b,p1[r+2],p1[r+3]);}
  const float m=max2f(a,b);
  auto rr=__builtin_amdgcn_permlane32_swap(__float_as_uint(m),__float_as_uint(m),false,false);
  return max2f(__uint_as_float(rr[0]),__uint_as_float(rr[1]));
}
__device__ __forceinline__ void pv(f32x16*o,int vb,bf16x8 pa0,bf16x8 pa1,bf16x8 pa2,bf16x8 pa3){
  #pragma unroll
  for(int d0=0;d0<2;++d0){s16x4 lo[4],hi[4];
    #pragma unroll
    for(int ks=0;ks<4;++ks){
      asm volatile("ds_read_b64_tr_b16 %0,%1 offset:%c2":"=&v"(lo[ks]):"v"(vb),"i"(d0*4096+ks*1024):"memory");
      asm volatile("ds_read_b64_tr_b16 %0,%1 offset:%c2":"=&v"(hi[ks]):"v"(vb),"i"(d0*4096+ks*1024+512):"memory");}
    asm volatile("s_waitcnt lgkmcnt(0)":::"memory");SBAR();
    #define PK(k) (bf16x8){lo[k][0],lo[k][1],lo[k][2],lo[k][3],hi[k][0],hi[k][1],hi[k][2],hi[k][3]}
    o[d0]=__builtin_amdgcn_mfma_f32_32x32x16_bf16(pa0,PK(0),o[d0],0,0,0);
    o[d0]=__builtin_amdgcn_mfma_f32_32x32x16_bf16(pa1,PK(1),o[d0],0,0,0);
    o[d0]=__builtin_amdgcn_mfma_f32_32x32x16_bf16(pa2,PK(2),o[d0],0,0,0);
    o[d0]=__builtin_amdgcn_mfma_f32_32x32x16_bf16(pa3,PK(3),o[d0],0,0,0);
    #undef PK
  }
}

#ifndef ATTN_STORE16
#define ATTN_STORE16(p,v) (*(u32x4*)(p)=(v))
#endif
template<int THRL> __device__ __forceinline__ void attn_unit(int b,int h,int qb,const bf16*Q,const bf16*__restrict__ K,const bf16*__restrict__ V,bf16*O,const float*__restrict__ CKg,const float*__restrict__ KTm,const float*__restrict__ QBm,char*shm){
  const int tid=tid_l(),lane=tid&63,r32=lane&31,hi=lane>>5; const int wid=__builtin_amdgcn_readfirstlane(tid>>6);
  const long rowbase=(long)b*SEQ; const int q0=qb*QB;
  const bf16*Qw=Q+(rowbase+q0+wid*QBLK)*KVP+h*D;
  const float*ckg=CKg+(long)(b*NHEAD+h)*SEQ;
  int j0=0;
  { const int bh_=b*NHEAD+h, NT0_=(q0+QB)/KVBLK; const float qmx=QBm[bh_*NQB+qb]*1.01f;
    const float kd=fmaxf(fmaxf(KTm[bh_*64+4*qb],KTm[bh_*64+4*qb+1]),fmaxf(KTm[bh_*64+4*qb+2],KTm[bh_*64+4*qb+3]));
    const float thr=-(qmx*kd)-48.f; bool skip=false;
    if(lane<NT0_-4){ const float bound=qmx*KTm[bh_*64+lane]+(ckg[q0]-ckg[64*lane+63]); skip=bound<thr; }
    const unsigned long long m_=__ballot(skip); j0=__builtin_ctzll(~m_); j0=(j0<NT0_-4?j0:NT0_-4)&~1; j0=__builtin_amdgcn_readfirstlane(j0); }
  const bf16*Kh=K+(rowbase+(long)j0*KVBLK)*KVP+h*D,*Vh=V+(rowbase+(long)j0*KVBLK)*KVP+h*D;
  const unsigned lds0=(unsigned)(uintptr_t)shm;
  float*wsf=(float*)(shm+LDS_WS)+wid*64;
  const bf16*ksrc=Kh+(long)lane*KVP+wid*8;
  const bf16*vsrc=Vh+(long)(16*(wid&3)+(lane>>2))*KVP+(wid>>2)*32+(lane&3)*8;
  const unsigned kdst=lds0+LDS_K+wid*1024, vdst=lds0+LDS_V+wid*1024;
  #define DMA_K(t,slot) glds16(ksrc+(long)(t)*KVBLK*KVP,(unsigned)__builtin_amdgcn_readfirstlane(kdst+(slot)))
  #define DMA_V(t,slot) glds16(vsrc+(long)(t)*KVBLK*KVP,(unsigned)__builtin_amdgcn_readfirstlane(vdst+(slot)))
  const int vb0=(int)(lds0+LDS_V)+((lane>>4)&1)*32+(lane&3)*8+(4*hi+((lane&15)>>2))*64;
  const char*Kbase=shm+LDS_K; bf16x8 kf[8];
  const lds_cptr shm3=(lds_cptr)shm; const lds_cptr kp0=shm3+LDS_K+hi*1024+r32*16; const lds_cptr vp0=shm3+LDS_V+((lane>>4)&1)*32+(lane&3)*8+(4*hi+((lane&15)>>2))*64;
  const int NT=(q0+QB)/KVBLK-j0;
  float*cks=(float*)(shm+LDS_CK);
  for(int i=j0*KVBLK+tid*4;i<q0+QB;i+=NW*64*4){ *(f32x4_t*)(cks+i)=*(const f32x4_t*)(ckg+i); }
  float cqm=ckg[q0+wid*QBLK+r32];
  const lds_cptr ckp=(lds_cptr)shm+LDS_CK+j0*256+hi*16;
  DMA_K(0,0);DMA_V(0,0);DMA_K(1,SLOTB);
  bf16x8 qr[4];
  #pragma unroll
  for(int d0=0;d0<4;++d0)qr[d0]=*reinterpret_cast<const bf16x8*>(&Qw[(long)r32*KVP+d0*16+hi*8]);
  float l_reg=0.f;f32x16 o[2];o[0]=f32x16{};o[1]=f32x16{};
  #define CINIT(C0,C1,t) do{ const lds_cptr cp_=ckp+(t)*256; \
    _Pragma("unroll") for(int g_=0;g_<4;++g_){ const f32x4_t a_=*(const __attribute__((address_space(3))) f32x4_t*)(cp_+g_*32); const f32x4_t b_=*(const __attribute__((address_space(3))) f32x4_t*)(cp_+g_*32+128); \
      _Pragma("unroll") for(int i_=0;i_<4;++i_){ C0[g_*4+i_]=cqm-a_[i_]; C1[g_*4+i_]=cqm-b_[i_]; } } }while(0)
  const int qrel=wid*QBLK+r32;
  #define CMASK(P0,P1,t) do{int jb_=(t)-(NT-4); if(jb_>=0)cmask(P0,P1,jb_,qrel,hi);}while(0)
  bool resc=false;
  #define START(P0,P1) do{ const float rm=rowmax(P0,P1); resc=false; \
    { const float dl=rm; \
      _Pragma("unroll") for(int r=0;r<16;++r){P0[r]=fsub_s(P0[r],dl);P1[r]=fsub_s(P1[r],dl);} \
      cqm=fsub_s(cqm,dl); } \
    _Pragma("unroll") for(int r=0;r<16;++r)P0[r]=__builtin_amdgcn_exp2f(P0[r]); }while(0)
  #define RESC() do{ if(resc){ asm volatile("s_waitcnt lgkmcnt(0)":::"memory"); \
      _Pragma("unroll") for(int d_=0;d_<2;++d_) _Pragma("unroll") for(int r=0;r<16;++r)o[d_][r]*=wsf[crow(r,hi)]; } }while(0)
  f32x16 pA0,pA1,pB0,pB1;
  int sl_prev=0,sl_cur=0,sl_next=SLOTB;
  #define ROT() do{sl_prev=sl_cur;sl_cur=sl_next;sl_next=(sl_next==(NSLOT-1)*SLOTB)?0:sl_next+SLOTB;}while(0)
  DMA_K(2,2*SLOTB);
  WAIT_BAR(3);
  CINIT(pA0,pA1,0);
  qkt(pA0,pA1,Kbase,qr,r32,hi);asm volatile("s_nop 15\n\ts_nop 7":"+v"(pA0),"+v"(pA1));CMASK(pA0,pA1,0);
  START(pA0,pA1);
  _Pragma("unroll") for(int r=0;r<16;++r)pA1[r]=__builtin_amdgcn_exp2f(pA1[r]);
  WAIT_BAR(0);
  DMA_K(3,0);DMA_V(1,SLOTB);
  ROT();
  kload8(kf,kp0+sl_cur);
  WAIT_BAR(2);
  s16x4 vlo[8],vhi[8]; u32x4 pw0,pw1,pw2,pw3;
  #define PKW(P,B) cvtpk_s(P[B],P[B+1])
  #define PAF(k) __builtin_bit_cast(bf16x8,pw##k)
  #define VFR(i) (bf16x8){vlo[i][0],vlo[i][1],vlo[i][2],vlo[i][3],vhi[i][0],vhi[i][1],vhi[i][2],vhi[i][3]}
  #define PIN(x) asm volatile("":"+v"(x))
  #define MX3(a,b,c) __builtin_fmaxf(__builtin_fmaxf((a),(b)),(c))
  #define GAPA(MF,A0,A1,A2,A3,W0,W1,PW) do{ MF; sacc+=A0; sacc+=A1; sacc+=A2; sacc+=A3; PIN(sacc); W0; W1; PIN(PW); SBAR(); }while(0)
  #define EX(v) __builtin_amdgcn_exp2f(v)
  #define GAPB(MF,X,B) do{ MF; X[B]=EX(X[B]); X[B+1]=EX(X[B+1]); X[B+2]=EX(X[B+2]); X[B+3]=EX(X[B+3]); PIN(X); SBAR(); }while(0)
  #define VRD(i) do{ vlo[i]=vtr(vp_+(((i)>>2)*4096+((i)&3)*1024)); vhi[i]=vtr(vp_+(((i)>>2)*4096+((i)&3)*1024+512)); }while(0)
  #define KRD(G,j) do{ if(G){ kload2(kf,kp0+sl_next,j); SBAR(); } }while(0)
  #define STEP(C0,C1,P0,P1,t,GK,GV,GL) do{ SBAR(); \
    CINIT(C0,C1,t); SBAR(); \
    const lds_cptr vp_=vp0+sl_prev; \
    VRD(0); SBAR(); float sacc=(P0[0]+P0[1]); \
    GAPA(C0=__builtin_amdgcn_mfma_f32_32x32x16_bf16(kf[0],qr[0],C0,0,0,0), P0[2],P0[3],P0[4],P0[5],     pw0[0]=PKW(P0,0), pw0[1]=PKW(P0,2), pw0); \
    VRD(4); SBAR(); GAPA(C1=__builtin_amdgcn_mfma_f32_32x32x16_bf16(kf[1],qr[0],C1,0,0,0), P0[6],P0[7],P0[8],P0[9],     pw0[2]=PKW(P0,4), pw0[3]=PKW(P0,6), pw0); \
    VRD(1); SBAR(); GAPA(C0=__builtin_amdgcn_mfma_f32_32x32x16_bf16(kf[2],qr[1],C0,0,0,0),   P0[10],P0[11],P0[12],P0[13], pw1[0]=PKW(P0,8), pw1[1]=PKW(P0,10), pw1); \
    VRD(5); SBAR(); GAPA(C1=__builtin_amdgcn_mfma_f32_32x32x16_bf16(kf[3],qr[1],C1,0,0,0),   P0[14],P0[15],P1[0],P1[1],   pw1[2]=PKW(P0,12),pw1[3]=PKW(P0,14), pw1); \
    VRD(2); SBAR(); GAPA(C0=__builtin_amdgcn_mfma_f32_32x32x16_bf16(kf[4],qr[2],C0,0,0,0),   P1[2],P1[3],P1[4],P1[5],     pw2[0]=PKW(P1,0), pw2[1]=PKW(P1,2), pw2); \
    VRD(6); SBAR(); GAPA(C1=__builtin_amdgcn_mfma_f32_32x32x16_bf16(kf[5],qr[2],C1,0,0,0),   P1[6],P1[7],P1[8],P1[9],     pw2[2]=PKW(P1,4), pw2[3]=PKW(P1,6), pw2); \
    VRD(3); SBAR(); GAPA(C0=__builtin_amdgcn_mfma_f32_32x32x16_bf16(kf[6],qr[3],C0,0,0,0),   P1[10],P1[11],P1[12],P1[13], pw3[0]=PKW(P1,8), pw3[1]=PKW(P1,10), pw3); \
    VRD(7); SBAR(); GAPA(C1=__builtin_amdgcn_mfma_f32_32x32x16_bf16(kf[7],qr[3],C1,0,0,0),   P1[14],P1[15],0.f,0.f,       pw3[2]=PKW(P1,12),pw3[3]=PKW(P1,14), pw3); \
    l_reg+=sacc; \
    if(GK){DMA_K((t)+3,sl_cur);} if(GV){DMA_V((t)+1,sl_next);} \
    CMASK(C0,C1,t); \
    { float a=MX3(C0[0],C0[1],C1[0]),b=MX3(C0[2],C0[3],C1[1]); a=MX3(a,C1[2],C1[3]); \
      _Pragma("unroll") for(int r=4;r<16;r+=4){a=MX3(a,C0[r],C0[r+1]);b=MX3(b,C0[r+2],C0[r+3]);a=MX3(a,C1[r],C1[r+1]);b=MX3(b,C1[r+2],C1[r+3]);} \
      float rm=__builtin_fmaxf(a,b); { auto rr=__builtin_amdgcn_permlane32_swap(__float_as_uint(rm),__float_as_uint(rm),false,false); rm=__builtin_fmaxf(__uint_as_float(rr[0]),__uint_as_float(rr[1])); } \
      resc=false; \
      if(__builtin_expect(__any(rm>(float)THRL),0)){ const float dl=__builtin_fmaxf(rm,0.f); \
        _Pragma("unroll") for(int r=0;r<16;++r){C0[r]-=dl;C1[r]-=dl;} \
        cqm-=dl; \
        const float f=__builtin_amdgcn_exp2f(-dl); l_reg*=f; if(hi==0)wsf[r32]=f; resc=true; } } \
    SBAR(); \
    GAPB(o[0]=__builtin_amdgcn_mfma_f32_32x32x16_bf16(PAF(0),VFR(0),o[0],0,0,0), C0,0); \
    GAPB(o[1]=__builtin_amdgcn_mfma_f32_32x32x16_bf16(PAF(0),VFR(4),o[1],0,0,0), C0,4); \
    KRD(GL,0); GAPB(o[0]=__builtin_amdgcn_mfma_f32_32x32x16_bf16(PAF(1),VFR(1),o[0],0,0,0), C0,8); \
    KRD(GL,1); GAPB(o[1]=__builtin_amdgcn_mfma_f32_32x32x16_bf16(PAF(1),VFR(5),o[1],0,0,0), C0,12); \
    KRD(GL,2); GAPB(o[0]=__builtin_amdgcn_mfma_f32_32x32x16_bf16(PAF(2),VFR(2),o[0],0,0,0), C1,0); \
    KRD(GL,3); GAPB(o[1]=__builtin_amdgcn_mfma_f32_32x32x16_bf16(PAF(2),VFR(6),o[1],0,0,0), C1,4); \
    GAPB(o[0]=__builtin_amdgcn_mfma_f32_32x32x16_bf16(PAF(3),VFR(3),o[0],0,0,0), C1,8); \
    GAPB(o[1]=__builtin_amdgcn_mfma_f32_32x32x16_bf16(PAF(3),VFR(7),o[1],0,0,0), C1,12); \
    }while(0)
  int t=1;
  #undef CMASK
  #define CMASK(P0,P1,t) do{}while(0)
  for(;t+5<NT;t+=2){
    STEP(pB0,pB1,pA0,pA1,t,true,true,true);     WAIT_BAR(2); RESC(); ROT();
    STEP(pA0,pA1,pB0,pB1,t+1,true,true,true);   WAIT_BAR(2); RESC(); ROT();
  }
  #undef CMASK
  #define CMASK(P0,P1,t) do{int jb_=(t)-(NT-4); if(jb_>=0)cmask(P0,P1,jb_,qrel,hi);}while(0)
  #define ENDW(tt) do{ if((tt)+3<NT){WAIT_BAR(2);} else if((tt)+2<NT){WAIT_BAR(1);} else {WAIT_BAR(0);} }while(0)
  for(;t+1<NT;t+=2){
    STEP(pB0,pB1,pA0,pA1,t,(t+3<NT),(t+1<NT),(t+1<NT));       ENDW(t);   RESC(); ROT();
    STEP(pA0,pA1,pB0,pB1,t+1,(t+4<NT),(t+2<NT),(t+2<NT));     ENDW(t+1); RESC(); ROT();
  }
  STEP(pB0,pB1,pA0,pA1,NT-1,false,false,false); RESC();
  { float sacc=pB0[0]+pB0[1]; _Pragma("unroll") for(int r=2;r<16;++r)sacc+=pB0[r]; _Pragma("unroll") for(int r=0;r<16;++r)sacc+=pB1[r]; l_reg+=sacc;
    pw0=(u32x4){PKW(pB0,0),PKW(pB0,2),PKW(pB0,4),PKW(pB0,6)};pw1=(u32x4){PKW(pB0,8),PKW(pB0,10),PKW(pB0,12),PKW(pB0,14)};pw2=(u32x4){PKW(pB1,0),PKW(pB1,2),PKW(pB1,4),PKW(pB1,6)};pw3=(u32x4){PKW(pB1,8),PKW(pB1,10),PKW(pB1,12),PKW(pB1,14)};
    SBAR(); pv(o,vb0+sl_cur,PAF(0),PAF(1),PAF(2),PAF(3)); }
  #undef PKW
  #undef PAF
  #undef VFR
  #undef PIN
  #undef MX3
  #undef GAPA
  #undef GAPB
  #undef EX
  #undef VRD
  #undef KRD
  #undef STEP
  #undef ENDW
  {auto rr=__builtin_amdgcn_permlane32_swap(__float_as_uint(l_reg),__float_as_uint(l_reg),false,false);l_reg=__uint_as_float(rr[0])+__uint_as_float(rr[1]);}
  if(hi==0)wsf[32+r32]=l_reg;asm volatile("s_waitcnt lgkmcnt(0)":::"memory");
  float rli[16];
  #pragma unroll
  for(int r=0;r<16;++r)rli[r]=__builtin_amdgcn_rcpf(wsf[32+crow(r,hi)]);
  bf16*Ow=O+(rowbase+q0+wid*QBLK)*OP+h*D;
  { bf16*stg=(bf16*)(shm+LDS_OST)+wid*2048;
    #pragma unroll
    for(int r=0;r<16;++r){const int orow=crow(r,hi);
      #pragma unroll
      for(int d0=0;d0<2;++d0)stg[orow*64+d0*32+r32]=__float2bfloat16(o[d0][r]*rli[r]);}
    asm volatile("s_waitcnt lgkmcnt(0)":::"memory");
    #pragma unroll
    for(int i=0;i<4;++i){const int row=i*8+(lane>>3),ch=lane&7; const u32x4 v=*(const u32x4*)(stg+row*64+ch*8); ATTN_STORE16(Ow+(long)row*OP+ch*8,v);} }
  asm volatile("s_waitcnt lgkmcnt(0)\n\ts_barrier":::"memory");
  #undef DMA_K
  #undef DMA_V
  #undef CMASK
  #undef START
  #undef RESC
  #undef ROT
  #undef CINIT
}
constexpr int ATTN_LDS_BYTES=LDS_BYTES;
struct AttnTensors { const bf16* Q; const bf16* K; const bf16* V; bf16* O; const float* CK; const float* KT; const float* QB; };
struct AttnUnit { int bh; int qb; };
struct QueueOrder {
  unsigned* head; volatile __attribute__((address_space(3))) int* slot;
  __device__ __forceinline__ bool next(int,AttnUnit&u)const{
    if(tid_l()==0) *slot=(int)__hip_atomic_fetch_add(head,1u,__ATOMIC_RELAXED,__HIP_MEMORY_SCOPE_AGENT);
    __syncthreads(); const int v=*slot; __syncthreads();
    if(v>=BATCH*NHEAD*NQB)return false; u.qb=NQB-1-v/(BATCH*NHEAD); u.bh=v%(BATCH*NHEAD); return true; }
  __device__ __forceinline__ void a_ready(const AttnUnit&)const{}
  __device__ __forceinline__ void done(const AttnUnit&)const{}
};
template<class Sched,int THRL=8> __device__ __forceinline__ void attn_phase(char*lds,const AttnTensors&T,const Sched&S){
  AttnUnit u;
  for(int i=0;S.next(i,u);++i){ S.a_ready(u); attn_unit<THRL>(u.bh/NHEAD,u.bh%NHEAD,u.qb,T.Q,T.K,T.V,T.O,T.CK,T.KT,T.QB,lds); S.done(u); }
}
#undef SBAR
#undef WAIT_BAR
}

constexpr int NB = 8, SEQ = 4096, T = NB * SEQ, D = 1024, DEPTH = 4;
constexpr int HCOLS = 3072;
constexpr int HC_AVAL = 0, HC_AGATE = 256, HC_BQ = 512, HC_BK = 704, HC_BV = 896, HC_BG = 1280, HC_CQ = 1664, HC_CK = 2048, HC_CV = 2432, HC_LR = 2816, HC_CF = 2832;
constexpr int IN_COLS = 2838;
constexpr int MC_A = 0, MC_B = 256, MC_C = 640;
constexpr float LN_EPS = 1e-5f;
constexpr float ALPHA = 1.6817928305074292f;
constexpr float LOG2E = 1.4426950408889634f;
constexpr float C2 = 0.125f * LOG2E;
constexpr float GLA_QSCALE = 0.17677669529663687f;
constexpr int NEXP = 16384;

constexpr size_t MiB = 1u << 20;
constexpr size_t WS_CTL = 0, CTL_ZERO_BYTES = 1 * MiB;
constexpr size_t WS_WIN = 1 * MiB;
constexpr size_t WS_WOUT = WS_WIN + 24 * MiB;
constexpr size_t WS_WP = WS_WOUT + 8 * MiB;
constexpr size_t WS_PGW = WS_WP + 16 * MiB;
constexpr size_t WS_PW = WS_PGW + 8 * MiB;
constexpr size_t WS_CK = WS_PW + 2 * MiB;
constexpr size_t WS_FKT = WS_CK + 768 * 1024, WS_FQB = WS_FKT + 16 * 1024;
constexpr size_t WS_U = WS_CK + 1 * MiB;
constexpr size_t WS_V = WS_U + 32 * MiB;
constexpr size_t WS_XB = WS_V + 32 * MiB;
constexpr size_t WS_XF = WS_XB + 64 * MiB;
constexpr size_t WS_XQ = WS_XF, WS_XS = WS_XF + 32 * MiB, WS_RS = WS_XS + 1 * MiB;
constexpr size_t WS_PB = WS_XF + 128 * MiB;
constexpr size_t WS_H = WS_PB + 16 * MiB;
constexpr size_t WS_MIX = WS_H + 192 * MiB;
constexpr size_t WS_SC = WS_H;
constexpr size_t WS_Y = WS_MIX + 64 * MiB;
constexpr size_t WS_GCUM = WS_Y;
constexpr size_t WS_GS = WS_GCUM + 24 * MiB;
constexpr size_t WS_GDEC = WS_GS + 24 * MiB;
constexpr size_t WS_E = WS_Y + 128 * MiB;
constexpr size_t WS_EIDX = WS_E + 64 * MiB;
constexpr size_t WS_GATE = WS_EIDX + 16 * MiB;
constexpr size_t WS_SOFF = WS_GATE + 16 * MiB;
constexpr size_t WS_END = WS_SOFF + 1 * MiB;
static_assert(WS_END <= 1024 * MiB, "d_ws map");

constexpr int LDS_BYTES = 147456;

typedef unsigned short bf16;
typedef float f32x4 __attribute__((ext_vector_type(4)));
typedef unsigned u32x4 __attribute__((ext_vector_type(4)));
typedef unsigned u32x2 __attribute__((ext_vector_type(2)));

struct Params {
    const float *x, *p, *w_in, *conv_w, *conv_b, *conv_ln_g, *conv_ln_b, *gla_gate_w, *gla_gate_b, *gla_norm_g, *fox_forget_b, *w_out, *ln1_g, *ln1_b,
        *peer_wq, *peer_keys, *peer_u, *peer_v, *ple_w, *ple_gw, *ple_gb, *ln2_g, *ln2_b;
    float* out; unsigned char* ws;
};

__device__ __forceinline__ float bf2f(unsigned h) { return __uint_as_float(h << 16); }
__device__ __forceinline__ unsigned f2bf(float f) { unsigned u = __float_as_uint(f); return (u + 0x7fffu + ((u >> 16) & 1u)) >> 16; }
__device__ __forceinline__ unsigned pk2(float lo, float hi) { return f2bf(lo) | (f2bf(hi) << 16); }
__device__ __forceinline__ float wave_sum(float v) {
#pragma unroll
    for (int o = 1; o < 64; o <<= 1) v += __shfl_xor(v, o);
    return v;
}
__device__ __forceinline__ float log_sigmoid(float z) { return fminf(z, 0.f) - log1pf(__expf(-fabsf(z))); }
__device__ __forceinline__ float sigmoidf_(float z) { return 1.0f / (1.0f + __expf(-z)); }

struct MapIdent { __device__ __forceinline__ void operator()(int n, int& c, float& s) const { c = n; s = 1.f; } };
struct MapWin {
    __device__ __forceinline__ void operator()(int n, int& c, float& s) const {
        s = 1.f;
        if (n < HC_CQ) { c = n; if (n >= HC_BQ && n < HC_BK) s = GLA_QSCALE; }
        else if (n < HC_LR) { c = n + 16; if (n < HC_CK) s = C2; }
        else if (n < HC_CF) c = n - HC_LR + 1664;
        else if (n < IN_COLS) c = n;
        else c = -1;
    }
};
template <class CM>
__device__ __forceinline__ void transpose_item(const float* W, int K, int Nsrc, bf16* WT, int item, int nblk, float* scr, int lane, const CM& cm) {
    const int kb = item / nblk, nb = item % nblk, k0 = 64 * kb, n0 = 32 * nb;
    int sc; float scale; cm(n0 + (lane & 31), sc, scale);
#pragma unroll 8
    for (int i = 0; i < 32; ++i) { const int kk = 2 * i + (lane >> 5); scr[kk * 33 + (lane & 31)] = sc >= 0 ? W[(size_t)(k0 + kk) * Nsrc + sc] * scale : 0.f; }
    __builtin_amdgcn_wave_barrier(); asm volatile("s_waitcnt lgkmcnt(0)" ::: "memory");
    const int c = lane & 7;
#pragma unroll
    for (int j = 0; j < 4; ++j) { const int n = (lane >> 3) + 8 * j; const float* s = scr + (8 * c) * 33 + n;
        u32x4 o; o.x = pk2(s[0 * 33], s[1 * 33]); o.y = pk2(s[2 * 33], s[3 * 33]); o.z = pk2(s[4 * 33], s[5 * 33]); o.w = pk2(s[6 * 33], s[7 * 33]);
        *(u32x4*)(WT + (size_t)(n0 + n) * K + k0 + 8 * c) = o; }
    asm volatile("s_waitcnt lgkmcnt(0)" ::: "memory"); __builtin_amdgcn_wave_barrier();
}
__device__ __forceinline__ void cvt_bf16_stream(const float* src, bf16* dst, size_t n8, size_t gtid, size_t gthreads) {
    for (size_t i = gtid; i < n8; i += gthreads) { const f32x4 a = *(const f32x4*)(src + i * 8), b = *(const f32x4*)(src + i * 8 + 4);
        u32x4 o; o.x = pk2(a[0], a[1]); o.y = pk2(a[2], a[3]); o.z = pk2(b[0], b[1]); o.w = pk2(b[2], b[3]); *(u32x4*)(dst + i * 8) = o; }
}

__device__ __forceinline__ void phase_pro_a(const Params& p, unsigned char* lds) {
    const int tid = tid_l(), lane = tid & 63, wave = tid >> 6;
    float* scr = (float*)(lds + wave * 16384);
    const int gw = bid_l() * 8 + wave, NGW = grid_l() * 8;
    constexpr int I_WIN = (D / 64) * (HCOLS / 32), I_SQ = (D / 64) * (D / 32), I_PW = (256 / 64) * (D / 32);
    constexpr int PER_L = I_WIN + 2 * I_SQ + I_PW;
    for (int it = gw; it < DEPTH * PER_L; it += NGW) {
        const int l = it / PER_L; int r = it % PER_L;
        if (r < I_WIN) { transpose_item(p.w_in + (size_t)l * D * IN_COLS, D, IN_COLS, (bf16*)(p.ws + WS_WIN) + (size_t)l * HCOLS * D, r, HCOLS / 32, scr, lane, MapWin()); continue; } r -= I_WIN;
        if (r < I_SQ) { transpose_item(p.w_out + (size_t)l * D * D, D, D, (bf16*)(p.ws + WS_WOUT) + (size_t)l * D * D, r, D / 32, scr, lane, MapIdent()); continue; } r -= I_SQ;
        if (r < I_SQ) { transpose_item(p.ple_gw + (size_t)l * D * D, D, D, (bf16*)(p.ws + WS_PGW) + (size_t)l * D * D, r, D / 32, scr, lane, MapIdent()); continue; } r -= I_SQ;
        transpose_item(p.ple_w + (size_t)l * 256 * D, 256, D, (bf16*)(p.ws + WS_PW) + (size_t)l * D * 256, r, D / 32, scr, lane, MapIdent());
    }
    cvt_bf16_stream(p.x, (bf16*)(p.ws + WS_XB), (size_t)T * D / 8, (size_t)bid_l() * 512 + tid, (size_t)grid_l() * 512);
}
__device__ __forceinline__ void phase_pro_b(const Params& p, unsigned char* lds) {
    const int tid = tid_l();
    float* ks = (float*)lds;
    float* wqs = ks + 128 * 129;
    for (int it = bid_l(); it < DEPTH * 16 * 16; it += grid_l()) {
        const int l = it >> 8, hc = (it >> 4) & 15, kt = it & 15;
        const float* keys = p.peer_keys + ((size_t)l * 16 + hc) * 16384;
        const float* wq = p.peer_wq + (size_t)l * D * 2048 + (size_t)(kt * 64) * 2048 + hc * 128;
        __syncthreads();
        for (int i = tid; i < 128 * 128; i += 512) ks[(i >> 7) * 129 + (i & 127)] = keys[i];
        for (int i = tid; i < 64 * 128; i += 512) wqs[(i >> 7) * 129 + (i & 127)] = wq[(size_t)(i >> 7) * 2048 + (i & 127)];
        __syncthreads();
        const int k = tid & 63, n0 = (tid >> 6) * 16;
        float acc[16];
#pragma unroll
        for (int j = 0; j < 16; ++j) acc[j] = 0.f;
        for (int d = 0; d < 128; ++d) { const float a = wqs[k * 129 + d];
#pragma unroll
            for (int j = 0; j < 16; ++j) acc[j] += a * ks[(n0 + j) * 129 + d]; }
        bf16* WpT = (bf16*)(p.ws + WS_WP) + (size_t)l * 2048 * D;
#pragma unroll
        for (int j = 0; j < 16; ++j) WpT[(size_t)(hc * 128 + n0 + j) * D + kt * 64 + k] = (bf16)f2bf(acc[j]);
    }
}
constexpr float U8_SCALE = 64.f, V8_SCALE = 16.f;
typedef float f32x2v __attribute__((ext_vector_type(2)));
__device__ __forceinline__ unsigned pk_fp8x4(f32x4 v, float sc) {
    const float a = fminf(fmaxf(v[0] * sc, -448.f), 448.f), b = fminf(fmaxf(v[1] * sc, -448.f), 448.f), c = fminf(fmaxf(v[2] * sc, -448.f), 448.f), d = fminf(fmaxf(v[3] * sc, -448.f), 448.f);
    int w = __builtin_amdgcn_cvt_pk_fp8_f32(a, b, 0, false); w = __builtin_amdgcn_cvt_pk_fp8_f32(c, d, w, true); return (unsigned)w;
}
__device__ __forceinline__ void cvt_fp8_stream(const float* src, unsigned char* dst, size_t n16, float sc, size_t gtid, size_t gthreads) {
    for (size_t i = gtid; i < n16; i += gthreads) { const float* s = src + i * 16; u32x4 o;
        o.x = pk_fp8x4(*(const f32x4*)(s), sc); o.y = pk_fp8x4(*(const f32x4*)(s + 4), sc); o.z = pk_fp8x4(*(const f32x4*)(s + 8), sc); o.w = pk_fp8x4(*(const f32x4*)(s + 12), sc);
        *(u32x4*)(dst + i * 16) = o; }
}
__device__ __forceinline__ float wave_max(float v) {
#pragma unroll
    for (int o = 32; o > 0; o >>= 1) v = fmaxf(v, __shfl_xor(v, o));
    return v;
}
__device__ __forceinline__ unsigned pk_i8x4(f32x4 v, float sc) {
    const int a = (int)__builtin_rintf(v[0] * sc), b = (int)__builtin_rintf(v[1] * sc), c = (int)__builtin_rintf(v[2] * sc), d = (int)__builtin_rintf(v[3] * sc);
    return (unsigned)(a & 255) | ((unsigned)(b & 255) << 8) | ((unsigned)(c & 255) << 16) | ((unsigned)d << 24);
}
__device__ __forceinline__ void cvt_i8_rows(const float* src, unsigned char* dst, float* RS, size_t n16, size_t gtid, size_t gthreads) {
    for (size_t i = gtid; i < n16; i += gthreads) { const float* s_ = src + i * 16;
        const f32x4 a = *(const f32x4*)(s_), b = *(const f32x4*)(s_ + 4), c = *(const f32x4*)(s_ + 8), d = *(const f32x4*)(s_ + 12);
        float m = fmaxf(fmaxf(fmaxf(fabsf(a[0]), fabsf(a[1])), fmaxf(fabsf(a[2]), fabsf(a[3]))), fmaxf(fmaxf(fabsf(b[0]), fabsf(b[1])), fmaxf(fabsf(b[2]), fabsf(b[3]))));
        m = fmaxf(m, fmaxf(fmaxf(fmaxf(fabsf(c[0]), fabsf(c[1])), fmaxf(fabsf(c[2]), fabsf(c[3]))), fmaxf(fmaxf(fabsf(d[0]), fabsf(d[1])), fmaxf(fabsf(d[2]), fabsf(d[3])))));
        m = wave_max(m); const float sc = m > 0.f ? 127.0f / m : 0.f;
        u32x4 o; o.x = pk_i8x4(a, sc); o.y = pk_i8x4(b, sc); o.z = pk_i8x4(c, sc); o.w = pk_i8x4(d, sc);
        *(u32x4*)(dst + i * 16) = o;
        if ((i & 63) == 0) RS[i >> 6] = m * (1.0f / 127.0f); }
}
__device__ __forceinline__ void phase_cvt(const Params& p, int l) {
    const size_t gtid = (size_t)bid_l() * 512 + tid_l(), gth = (size_t)grid_l() * 512;
    cvt_bf16_stream(p.p + (size_t)l * T * 256, (bf16*)(p.ws + WS_PB), (size_t)T * 256 / 8, gtid, gth);
    cvt_i8_rows(p.peer_u + (size_t)l * NEXP * D, p.ws + WS_U, (float*)(p.ws + WS_RS), (size_t)NEXP * D / 16, gtid, gth);
    cvt_fp8_stream(p.peer_v + (size_t)l * NEXP * D, p.ws + WS_V, (size_t)NEXP * D / 16, V8_SCALE, gtid, gth);
}

#define GEMM_RUN(EPI, e, Aptr, Bptr, N_, K_) do { int kk_ = (K_); asm volatile("" : "+s"(kk_)); pg8::Gemm g{(const pg8::bf16_t*)(Aptr), (const pg8::bf16_t*)(Bptr), T, (N_), kk_}; pg8::StaticOrder S; S.init(T, (N_), (int)grid_l(), (int)bid_l()); \
    pg8::gemm_phase<EPI, pg8::StaticOrder, true, true>((PG8_LAS unsigned char*)lds, g, S, e); } while (0)

__device__ __forceinline__ void phase_gemm_in(const Params& p, int l, unsigned char* lds) {
    pg8::EpiBf16<0> e{(pg8::bf16_t*)(p.ws + WS_H), HCOLS, nullptr, 0, 0, 1.f};
    GEMM_RUN(pg8::EpiBf16<0>, e, p.ws + WS_XB, (bf16*)(p.ws + WS_WIN) + (size_t)l * HCOLS * D, HCOLS, D);
}
__device__ __forceinline__ void phase_gemm_e(const Params& p, int l, unsigned char* lds) {
    pg8::EpiBf16<0> e{(pg8::bf16_t*)(p.ws + WS_E), D, nullptr, 0, 0, 1.f};
    GEMM_RUN(pg8::EpiBf16<0>, e, p.ws + WS_PB, (bf16*)(p.ws + WS_PW) + (size_t)l * D * 256, D, 256);
}
__device__ __forceinline__ void phase_gemm_out(const Params& p, int l, unsigned char* lds) {
    pg8::EpiResid e{(const pg8::bf16_t*)(p.ws + WS_XB), (_Float16*)(p.ws + WS_Y), D, ALPHA};
    GEMM_RUN(pg8::EpiResid, e, p.ws + WS_MIX, (bf16*)(p.ws + WS_WOUT) + (size_t)l * D * D, D, D);
}
__device__ __forceinline__ void phase_gemm_sc(const Params& p, int l, unsigned char* lds) {
    pg8::EpiF16 e{(_Float16*)(p.ws + WS_SC), 2048};
    GEMM_RUN(pg8::EpiF16, e, p.ws + WS_XB, (bf16*)(p.ws + WS_WP) + (size_t)l * 2048 * D, 2048, D);
}
__device__ __forceinline__ void phase_gemm_ple(const Params& p, int l, unsigned char* lds) {
    pg8::EpiPle e{(const pg8::bf16_t*)(p.ws + WS_XB), (_Float16*)(p.ws + WS_Y), (const pg8::bf16_t*)(p.ws + WS_E), p.ple_gb + (size_t)l * D, D};
    GEMM_RUN(pg8::EpiPle, e, p.ws + WS_XB, (bf16*)(p.ws + WS_PGW) + (size_t)l * D * D, D, D);
}

__device__ __forceinline__ void phase_conv(const Params& p, int l, unsigned char* lds) {
    const int tid = tid_l(), lane = tid & 63, wave = tid >> 6;
    float* U = (float*)lds;
    float* Yt = U + 62 * 256;
    const bf16* H = (const bf16*)(p.ws + WS_H); bf16* MIX = (bf16*)(p.ws + WS_MIX);
    const float* cw = p.conv_w + (size_t)l * 31 * 256; const float* cb = p.conv_b + l * 256;
    const float* lg = p.conv_ln_g + l * 256; const float* lb = p.conv_ln_b + l * 256;
    for (int it = bid_l(); it < T / 32; it += grid_l()) {
        const int b = it / (SEQ / 32), t0 = (it % (SEQ / 32)) * 32;
        __syncthreads();
        for (int i = tid; i < 62 * 32; i += 512) { const int r = i >> 5, c8 = (i & 31) * 8, t = t0 - 30 + r; f32x4 u0 = {0.f, 0.f, 0.f, 0.f}, u1 = {0.f, 0.f, 0.f, 0.f};
            if (t >= 0) { const bf16* hr = H + (size_t)(b * SEQ + t) * HCOLS; const u32x4 av = *(const u32x4*)(hr + HC_AVAL + c8), gv = *(const u32x4*)(hr + HC_AGATE + c8);
#pragma unroll
                for (int j = 0; j < 2; ++j) { u0[2 * j] = bf2f(av[j] & 0xffffu) * sigmoidf_(bf2f(gv[j] & 0xffffu)); u0[2 * j + 1] = __uint_as_float(av[j] & 0xffff0000u) * sigmoidf_(__uint_as_float(gv[j] & 0xffff0000u));
                                              u1[2 * j] = bf2f(av[2 + j] & 0xffffu) * sigmoidf_(bf2f(gv[2 + j] & 0xffffu)); u1[2 * j + 1] = __uint_as_float(av[2 + j] & 0xffff0000u) * sigmoidf_(__uint_as_float(gv[2 + j] & 0xffff0000u)); } }
            *(f32x4*)(U + r * 256 + c8) = u0; *(f32x4*)(U + r * 256 + c8 + 4) = u1; }
        __syncthreads();
        { const int c = tid & 255, half = tid >> 8; float w[31], win[46];
#pragma unroll
          for (int j = 0; j < 31; ++j) w[j] = cw[j * 256 + c];
#pragma unroll
          for (int j = 0; j < 46; ++j) win[j] = U[(half * 16 + j) * 256 + c];
          const float bias = cb[c];
#pragma unroll
          for (int tl = 0; tl < 16; ++tl) { float y = bias;
#pragma unroll
              for (int j = 0; j < 31; ++j) y += w[j] * win[tl + j];
              Yt[(half * 16 + tl) * 256 + c] = y; } }
        __syncthreads();
        for (int tl = wave * 4; tl < wave * 4 + 4; ++tl) {
            const f32x4 v = *(const f32x4*)(Yt + tl * 256 + lane * 4);
            const float mean = wave_sum((v[0] + v[1]) + (v[2] + v[3])) * (1.f / 256.f);
            const f32x4 d = v - mean; const float var = wave_sum((d[0] * d[0] + d[1] * d[1]) + (d[2] * d[2] + d[3] * d[3])) * (1.f / 256.f);
            const float rstd = 1.0f / sqrtf(var + LN_EPS);
            const f32x4 g4 = *(const f32x4*)(lg + lane * 4), b4 = *(const f32x4*)(lb + lane * 4);
            float o[4];
#pragma unroll
            for (int i = 0; i < 4; ++i) { const float z = d[i] * rstd * g4[i] + b4[i]; o[i] = z * sigmoidf_(z); }
            u32x2 w2; w2.x = pk2(o[0], o[1]); w2.y = pk2(o[2], o[3]);
            *(u32x2*)(MIX + (size_t)(b * SEQ + t0 + tl) * D + MC_A + lane * 4) = w2;
        }
    }
}

__device__ __forceinline__ void phase_fox_cum(const Params& p, int l, unsigned char* lds) {
    const int tid = tid_l(), lane = tid & 63, wave = tid >> 6;
    float* wsum = (float*)lds;
    const bf16* H = (const bf16*)(p.ws + WS_H); float* CK = (float*)(p.ws + WS_CK);
    for (int bh = bid_l(); bh < 48; bh += grid_l()) {
        const int b = bh / 6, h = bh % 6; const float bias = p.fox_forget_b[l * 6 + h];
        float v[8]; float s = 0.f;
#pragma unroll
        for (int i = 0; i < 8; ++i) { const float f = bf2f(H[(size_t)(b * SEQ + tid * 8 + i) * HCOLS + HC_CF + h]); s += log_sigmoid(f + bias) * LOG2E; v[i] = s; }
        float incl = s;
#pragma unroll
        for (int o = 1; o < 64; o <<= 1) { const float n = __shfl_up(incl, o); if (lane >= o) incl += n; }
        __syncthreads();
        if (lane == 63) wsum[wave] = incl;
        __syncthreads();
        float base = incl - s;
        for (int w = 0; w < wave; ++w) base += wsum[w];
#pragma unroll
        for (int i = 0; i < 8; ++i) CK[(size_t)bh * SEQ + tid * 8 + i] = base + v[i];
    }
}

__device__ __forceinline__ void phase_fox_norm(const Params& p, unsigned char* lds) {
    const int tid = tid_l(), lane = tid & 63, wave = tid >> 6;
    float* qns = (float*)lds; float* kns = qns + 256;
    const bf16* H = (const bf16*)(p.ws + WS_H); float* KT = (float*)(p.ws + WS_FKT); float* QBM = (float*)(p.ws + WS_FQB);
    for (int it = bid_l(); it < 48 * 16; it += grid_l()) {
        const int bh = it >> 4, qb = it & 15, b = bh / 6, h = bh % 6;
        __syncthreads();
        if (tid < 256) { const bf16* row = H + ((size_t)b * SEQ + qb * 256 + tid) * HCOLS + h * 64; float sq = 0.f, sk = 0.f;
#pragma unroll
            for (int j = 0; j < 8; ++j) { const u32x4 qv = *(const u32x4*)(row + HC_CQ + 8 * j), kv = *(const u32x4*)(row + HC_CK + 8 * j);
#pragma unroll
                for (int i = 0; i < 4; ++i) { const float a0 = bf2f(qv[i] & 0xffffu), a1 = __uint_as_float(qv[i] & 0xffff0000u), b0 = bf2f(kv[i] & 0xffffu), b1 = __uint_as_float(kv[i] & 0xffff0000u);
                    sq += a0 * a0 + a1 * a1; sk += b0 * b0 + b1 * b1; } }
            qns[tid] = sqrtf(sq); kns[tid] = sqrtf(sk); }
        __syncthreads();
        if (wave < 5) { float v = wave < 4 ? kns[wave * 64 + lane] : fmaxf(fmaxf(qns[lane], qns[64 + lane]), fmaxf(qns[128 + lane], qns[192 + lane]));
#pragma unroll
            for (int o = 1; o < 64; o <<= 1) v = fmaxf(v, __shfl_xor(v, o));
            if (lane == 0) { if (wave < 4) KT[bh * 64 + 4 * qb + wave] = v; else QBM[bh * 16 + qb] = v; } }
    }
}

typedef short bf16x8_t __attribute__((ext_vector_type(8)));
typedef float f32x16_t __attribute__((ext_vector_type(16)));
__device__ __forceinline__ int crow32(int r, int hi) { return (r & 3) + 8 * (r >> 2) + 4 * hi; }
struct GlaB1Pre { u32x4 vv, lr0, lr1; u32x2 kk; float w2v, b2v; };
__device__ __forceinline__ GlaB1Pre gla_b1_load(const Params& p, int l, int it, int tid, int lane, int wave) {
    const int bh = it >> 6, n = it & 63, b = bh / 6, h = bh % 6; const size_t tok0 = (size_t)b * SEQ + n * 64; const bf16* H = (const bf16*)(p.ws + WS_H);
    GlaB1Pre r; r.w2v = p.gla_gate_w[(size_t)l * 16 * 192 + (tid >> 5) * 192 + h * 32 + (tid & 31)]; r.b2v = p.gla_gate_b[l * 192 + h * 32 + (tid & 31)];
    r.vv = *(const u32x4*)(H + (tok0 + (tid >> 3)) * HCOLS + HC_BV + h * 64 + (tid & 7) * 8);
    r.lr0 = *(const u32x4*)(H + (tok0 + lane) * HCOLS + HC_LR); r.lr1 = *(const u32x4*)(H + (tok0 + lane) * HCOLS + HC_LR + 8);
    r.kk = *(const u32x2*)(H + (tok0 + lane) * HCOLS + HC_BK + h * 32 + wave * 4);
    return r;
}
__device__ __forceinline__ void phase_gla_b1(const Params& p, int l, unsigned char* lds) {
    const int tid = tid_l(), lane = tid & 63, wave = tid >> 6, r32 = lane & 31, hi = lane >> 5;
    bf16* KDT = (bf16*)lds;
    bf16* VT = KDT + 32 * 72;
    float* w2s = (float*)(VT + 64 * 72);
    float* b2s = w2s + 16 * 32;
    float* GCUM = (float*)(p.ws + WS_GCUM); float* GS = (float*)(p.ws + WS_GS); float* GDEC = (float*)(p.ws + WS_GDEC);
    const int NI = 48 * 64, G = grid_l(); int it = bid_l();
    if (it >= NI) return;
    GlaB1Pre cur = gla_b1_load(p, l, it, tid, lane, wave);
#pragma unroll 1
    for (; it < NI; it += G) {
        const GlaB1Pre nxt = gla_b1_load(p, l, it + G < NI ? it + G : it, tid, lane, wave);
        __builtin_amdgcn_sched_barrier(0);
        const int bh = it >> 6, n = it & 63, b = bh / 6, h = bh % 6; const size_t tok0 = (size_t)b * SEQ + n * 64;
        __syncthreads();
        w2s[tid] = cur.w2v;
        if (tid < 32) b2s[tid] = cur.b2v;
        { const int s_ = tid >> 3, e0 = (tid & 7) * 8;
#pragma unroll
          for (int i = 0; i < 4; ++i) { VT[(e0 + 2 * i) * 72 + s_] = (bf16)(cur.vv[i] & 0xffffu); VT[(e0 + 2 * i + 1) * 72 + s_] = (bf16)(cur.vv[i] >> 16); } }
        const int d0 = wave * 4;
        __syncthreads();
        float lrf[16];
#pragma unroll
        for (int i = 0; i < 4; ++i) { lrf[2 * i] = bf2f(cur.lr0[i] & 0xffffu); lrf[2 * i + 1] = __uint_as_float(cur.lr0[i] & 0xffff0000u); lrf[8 + 2 * i] = bf2f(cur.lr1[i] & 0xffffu); lrf[8 + 2 * i + 1] = __uint_as_float(cur.lr1[i] & 0xffff0000u); }
        float g[4];
#pragma unroll
        for (int dd = 0; dd < 4; ++dd) { float x = b2s[d0 + dd];
#pragma unroll
            for (int r = 0; r < 16; ++r) x += lrf[r] * w2s[r * 32 + d0 + dd];
            g[dd] = log_sigmoid(x) * (1.0f / 16.0f); }
#pragma unroll
        for (int o = 1; o < 64; o <<= 1)
#pragma unroll
            for (int dd = 0; dd < 4; ++dd) { const float v = __shfl_up(g[dd], o); if (lane >= o) g[dd] += v; }
        *(f32x4*)(GCUM + (tok0 + lane) * 192 + h * 32 + d0) = (f32x4){g[0], g[1], g[2], g[3]};
        const float kf[4] = {bf2f(cur.kk.x & 0xffffu), __uint_as_float(cur.kk.x & 0xffff0000u), bf2f(cur.kk.y & 0xffffu), __uint_as_float(cur.kk.y & 0xffff0000u)};
#pragma unroll
        for (int dd = 0; dd < 4; ++dd) { const float last = __uint_as_float(__builtin_amdgcn_readlane(__float_as_uint(g[dd]), 63));
            KDT[(d0 + dd) * 72 + lane] = (bf16)f2bf(kf[dd] * __expf(last - g[dd]));
            if (lane == 63) GDEC[(size_t)it * 32 + d0 + dd] = __expf(last); }
        __syncthreads();
        if (wave < 2) {
            f32x16_t acc = {};
#pragma unroll
            for (int ks = 0; ks < 4; ++ks) { const bf16x8_t a = *(const bf16x8_t*)(KDT + r32 * 72 + 16 * ks + 8 * hi), bb = *(const bf16x8_t*)(VT + (32 * wave + r32) * 72 + 16 * ks + 8 * hi);
                acc = __builtin_amdgcn_mfma_f32_32x32x16_bf16(a, bb, acc, 0, 0, 0); }
#pragma unroll
            for (int r = 0; r < 16; ++r) GS[(size_t)it * 2048 + crow32(r, hi) * 64 + 32 * wave + r32] = acc[r];
        }
        cur = nxt;
    }
}
__device__ __forceinline__ void phase_gla_b2(const Params& p) {
    float* GS = (float*)(p.ws + WS_GS); const float* GDEC = (const float*)(p.ws + WS_GDEC);
    for (int g = bid_l() * 512 + tid_l(); g < 48 * 2048; g += grid_l() * 512) {
        const int bh = g >> 11, de = g & 2047, d = de >> 6; float S = 0.f;
        float* gs = GS + (size_t)bh * 64 * 2048 + de; const float* gd = GDEC + (size_t)bh * 64 * 32 + d;
#pragma unroll 1
        for (int n0 = 0; n0 < 64; n0 += 16) { float loc[16], dec[16];
#pragma unroll
            for (int i = 0; i < 16; ++i) { loc[i] = gs[(size_t)(n0 + i) * 2048]; dec[i] = gd[(n0 + i) * 32]; }
#pragma unroll
            for (int i = 0; i < 16; ++i) { gs[(size_t)(n0 + i) * 2048] = S; S = S * dec[i] + loc[i]; } }
    }
}
struct GlaB3Pre { u32x2 qq, kk; f32x4 c; u32x4 vv; f32x4 sv; u32x4 gr; };
__device__ __forceinline__ GlaB3Pre gla_b3_load(const Params& p, int it, int tid) {
    const int bh = it >> 6, n = it & 63, b = bh / 6, h = bh % 6; const size_t tok0 = (size_t)b * SEQ + n * 64; const bf16* H = (const bf16*)(p.ws + WS_H);
    const float* GCUM = (const float*)(p.ws + WS_GCUM); const float* GS = (const float*)(p.ws + WS_GS);
    GlaB3Pre r; const int t = tid >> 3, d0 = (tid & 7) * 4;
    r.qq = *(const u32x2*)(H + (tok0 + t) * HCOLS + HC_BQ + h * 32 + d0); r.kk = *(const u32x2*)(H + (tok0 + t) * HCOLS + HC_BK + h * 32 + d0);
    r.c = *(const f32x4*)(GCUM + (tok0 + t) * 192 + h * 32 + d0);
    r.vv = *(const u32x4*)(H + (tok0 + t) * HCOLS + HC_BV + h * 64 + (tid & 7) * 8);
    r.sv = *(const f32x4*)(GS + (size_t)it * 2048 + (tid >> 4) * 64 + (tid & 15) * 4);
    r.gr = *(const u32x4*)(H + (tok0 + t) * HCOLS + HC_BG + h * 64 + (tid & 7) * 8);
    return r;
}
__device__ __forceinline__ void phase_gla_b3(const Params& p, int l, unsigned char* lds) {
    const int tid = tid_l(), lane = tid & 63, wave = tid >> 6, r32 = lane & 31, hi = lane >> 5;
    bf16* QE = (bf16*)lds;
    bf16* KE = QE + 64 * 40;
    bf16* VT = KE + 64 * 40;
    bf16* ST = VT + 64 * 72;
    bf16* P = ST + 64 * 40;
    float* O = (float*)(P + 64 * 72);
    bf16* MIX = (bf16*)(p.ws + WS_MIX);
    const int NI = 48 * 64, G = grid_l(); int it = bid_l();
    if (it >= NI) return;
    GlaB3Pre cur = gla_b3_load(p, it, tid);
#pragma unroll 1
    for (; it < NI; it += G) {
        const GlaB3Pre nxt = gla_b3_load(p, it + G < NI ? it + G : it, tid);
        __builtin_amdgcn_sched_barrier(0);
        const int bh = it >> 6, n = it & 63, b = bh / 6, h = bh % 6; const size_t tok0 = (size_t)b * SEQ + n * 64;
        __syncthreads();
        { const int t = tid >> 3, d0 = (tid & 7) * 4; const u32x2 qq = cur.qq, kk = cur.kk; const f32x4 c = cur.c;
          const float e0 = __expf(c[0]), e1 = __expf(c[1]), e2 = __expf(c[2]), e3 = __expf(c[3]);
          u32x2 qo, ko;
          qo.x = pk2(bf2f(qq.x & 0xffffu) * e0, __uint_as_float(qq.x & 0xffff0000u) * e1); qo.y = pk2(bf2f(qq.y & 0xffffu) * e2, __uint_as_float(qq.y & 0xffff0000u) * e3);
          ko.x = pk2(bf2f(kk.x & 0xffffu) / e0, __uint_as_float(kk.x & 0xffff0000u) / e1); ko.y = pk2(bf2f(kk.y & 0xffffu) / e2, __uint_as_float(kk.y & 0xffff0000u) / e3);
          *(u32x2*)(QE + t * 40 + d0) = qo; *(u32x2*)(KE + t * 40 + d0) = ko; }
        { const int s_ = tid >> 3, e0 = (tid & 7) * 8;
#pragma unroll
          for (int i = 0; i < 4; ++i) { VT[(e0 + 2 * i) * 72 + s_] = (bf16)(cur.vv[i] & 0xffffu); VT[(e0 + 2 * i + 1) * 72 + s_] = (bf16)(cur.vv[i] >> 16); } }
        { const int d = tid >> 4, e0 = (tid & 15) * 4;
#pragma unroll
          for (int i = 0; i < 4; ++i) ST[(e0 + i) * 40 + d] = (bf16)f2bf(cur.sv[i]); }
        __syncthreads();
        f32x16_t acc = {};
        const int tt = (wave & 3) >> 1, tc = wave & 1;
        if (wave < 4) {
            if (!(tt == 0 && tc == 1)) {
#pragma unroll
                for (int ks = 0; ks < 2; ++ks) { const bf16x8_t a = *(const bf16x8_t*)(QE + (32 * tt + r32) * 40 + 16 * ks + 8 * hi), bb = *(const bf16x8_t*)(KE + (32 * tc + r32) * 40 + 16 * ks + 8 * hi);
                    acc = __builtin_amdgcn_mfma_f32_32x32x16_bf16(a, bb, acc, 0, 0, 0); }
#pragma unroll
                for (int r = 0; r < 16; ++r) { const int trow = 32 * tt + crow32(r, hi), scol = 32 * tc + r32; P[trow * 72 + scol] = (bf16)f2bf(scol <= trow ? acc[r] : 0.f); }
            }
        } else {
#pragma unroll
            for (int ks = 0; ks < 2; ++ks) { const bf16x8_t a = *(const bf16x8_t*)(QE + (32 * tt + r32) * 40 + 16 * ks + 8 * hi), bb = *(const bf16x8_t*)(ST + (32 * tc + r32) * 40 + 16 * ks + 8 * hi);
                acc = __builtin_amdgcn_mfma_f32_32x32x16_bf16(a, bb, acc, 0, 0, 0); }
        }
        __syncthreads();
        if (wave >= 4) {
            const int nks = tt == 0 ? 2 : 4;
            for (int ks = 0; ks < nks; ++ks) { const bf16x8_t a = *(const bf16x8_t*)(P + (32 * tt + r32) * 72 + 16 * ks + 8 * hi), bb = *(const bf16x8_t*)(VT + (32 * tc + r32) * 72 + 16 * ks + 8 * hi);
                acc = __builtin_amdgcn_mfma_f32_32x32x16_bf16(a, bb, acc, 0, 0, 0); }
#pragma unroll
            for (int r = 0; r < 16; ++r) O[(32 * tt + crow32(r, hi)) * 65 + 32 * tc + r32] = acc[r];
        }
        __syncthreads();
        { const int t = tid >> 3, e0 = (tid & 7) * 8; float o[8]; float ss = 0.f;
#pragma unroll
          for (int i = 0; i < 8; ++i) { o[i] = O[t * 65 + e0 + i]; ss += o[i] * o[i]; }
          ss += __shfl_xor(ss, 1); ss += __shfl_xor(ss, 2); ss += __shfl_xor(ss, 4);
          const float rs = 1.0f / sqrtf(ss * (1.f / 64.f) + LN_EPS);
          const float* ng = p.gla_norm_g + l * 384 + h * 64 + e0; const u32x4 gr = cur.gr;
          float r[8];
#pragma unroll
          for (int i = 0; i < 4; ++i) { const float ga = bf2f(gr[i] & 0xffffu), gb = __uint_as_float(gr[i] & 0xffff0000u);
              r[2 * i] = o[2 * i] * rs * ng[2 * i] * (ga * sigmoidf_(ga)); r[2 * i + 1] = o[2 * i + 1] * rs * ng[2 * i + 1] * (gb * sigmoidf_(gb)); }
          u32x4 w; w.x = pk2(r[0], r[1]); w.y = pk2(r[2], r[3]); w.z = pk2(r[4], r[5]); w.w = pk2(r[6], r[7]);
          *(u32x4*)(MIX + (tok0 + t) * D + MC_B + h * 64 + e0) = w; }
        cur = nxt;
    }
}

constexpr int LDSQ_OFF = LDS_BYTES - 1024;
constexpr int CW_ATTNQ = 8192;
__device__ __forceinline__ void phase_fox_mfma(const Params& p, int l, unsigned char* lds) {
    const attn_body::bf16* H = (const attn_body::bf16*)(p.ws + WS_H);
    const attn_body::AttnTensors AT{H + HC_CQ, H + HC_CK, H + HC_CV, (attn_body::bf16*)(p.ws + WS_MIX) + MC_C, (const float*)(p.ws + WS_CK), (const float*)(p.ws + WS_FKT), (const float*)(p.ws + WS_FQB)};
    const attn_body::QueueOrder S{(unsigned*)(p.ws + WS_CTL) + CW_ATTNQ + l * 64, (volatile __attribute__((address_space(3))) int*)((__attribute__((address_space(3))) unsigned char*)lds + LDSQ_OFF)};
    attn_body::attn_phase<attn_body::QueueOrder>((char*)lds, AT, S);
}

__device__ __forceinline__ void phase_ln(const _Float16* Y, const float* g, const float* bta, float* dst, bf16* dstb, unsigned char* xq = nullptr, float* xs = nullptr) {
    const int tid = tid_l(), lane = tid & 63, wave = tid >> 6; typedef _Float16 h4 __attribute__((ext_vector_type(4)));
    const int stride = grid_l() * 8; int row = bid_l() * 8 + wave;
    if (row >= T) return;
    h4 cur[4];
#pragma unroll
    for (int j = 0; j < 4; ++j) cur[j] = *(const h4*)(Y + (size_t)row * D + j * 256 + lane * 4);
#pragma unroll 1
    for (; row < T; row += stride) {
        h4 nxt[4]; const int nr = row + stride < T ? row + stride : row;
#pragma unroll
        for (int j = 0; j < 4; ++j) nxt[j] = *(const h4*)(Y + (size_t)nr * D + j * 256 + lane * 4);
        __builtin_amdgcn_sched_barrier(0);
        f32x4 v[4]; float s = 0.f;
#pragma unroll
        for (int j = 0; j < 4; ++j) { v[j] = (f32x4){(float)cur[j][0], (float)cur[j][1], (float)cur[j][2], (float)cur[j][3]}; s += (v[j][0] + v[j][1]) + (v[j][2] + v[j][3]); }
        const float mean = wave_sum(s) * (1.f / D); float s2 = 0.f;
#pragma unroll
        for (int j = 0; j < 4; ++j) { v[j] = v[j] - mean; s2 += (v[j][0] * v[j][0] + v[j][1] * v[j][1]) + (v[j][2] * v[j][2] + v[j][3] * v[j][3]); }
        const float rstd = 1.0f / sqrtf(wave_sum(s2) * (1.f / D) + LN_EPS);
        float am = 0.f;
#pragma unroll
        for (int j = 0; j < 4; ++j) { const f32x4 g4 = *(const f32x4*)(g + j * 256 + lane * 4), b4 = *(const f32x4*)(bta + j * 256 + lane * 4);
            const f32x4 o = v[j] * rstd * g4 + b4; v[j] = o;
            am = fmaxf(am, fmaxf(fmaxf(fabsf(o[0]), fabsf(o[1])), fmaxf(fabsf(o[2]), fabsf(o[3]))));
            if (dst) *(f32x4*)(dst + (size_t)row * D + j * 256 + lane * 4) = o;
            if (dstb) { u32x2 w; w.x = pk2(o[0], o[1]); w.y = pk2(o[2], o[3]); *(u32x2*)(dstb + (size_t)row * D + j * 256 + lane * 4) = w; } }
        if (xq) {
            am = wave_max(am); const float sc = am > 0.f ? 127.0f / am : 0.f;
#pragma unroll
            for (int j = 0; j < 4; ++j) *(unsigned*)(xq + (size_t)row * D + j * 256 + lane * 4) = pk_i8x4(v[j], sc);
            if (lane == 0) xs[row] = am * (1.0f / 127.0f); }
#pragma unroll
        for (int j = 0; j < 4; ++j) cur[j] = nxt[j];
    }
}

__device__ __forceinline__ int f2ord(float x) { const int i = __float_as_int(x); return i ^ ((i >> 31) & 0x7fffffff); }
__device__ __forceinline__ float ord2f(int k) { return __int_as_float(k ^ ((k >> 31) & 0x7fffffff)); }
__device__ __forceinline__ void phase_topk(const Params& p, unsigned char* lds) {
    const int tid = tid_l(), lane = tid & 63, wave = tid >> 6;
    unsigned char* wreg = lds + wave * 17408; unsigned char* tab = wreg;
    const _Float16* SC = (const _Float16*)(p.ws + WS_SC); int* EIDX = (int*)(p.ws + WS_EIDX); float* GATE = (float*)(p.ws + WS_GATE); unsigned long long* SOFF = (unsigned long long*)(p.ws + WS_SOFF);
    for (int g = bid_l() * 512 + tid; g < T * 16; g += grid_l() * 512) {
        const int tok = g >> 4, hc = g & 15;
        typedef _Float16 h8 __attribute__((ext_vector_type(8)));
        { const unsigned char* blk = (const unsigned char*)(SC + (size_t)(g - lane) * 128);
          u32x4 st[16];
#pragma unroll
          for (int j = 0; j < 16; ++j) st[j] = *(const u32x4*)(blk + (size_t)(j * 64 + lane) * 16);
          __builtin_amdgcn_wave_barrier();
#pragma unroll
          for (int j = 0; j < 16; ++j) { const int c = j * 64 + lane; *(u32x4*)(wreg + (c + (c >> 4)) * 16) = st[j]; }
          __builtin_amdgcn_wave_barrier(); }
        const unsigned char* lp = wreg + lane * 272;
#define TK_CE(a, b) do { const int hi_ = max(a, b), lo_ = min(a, b); a = hi_; b = lo_; } while (0)
        int tk[16];
#pragma unroll 1
        for (int gi = 0; gi < 8; ++gi) { const h8 cA = *(const h8*)(lp + gi * 32), c1_ = *(const h8*)(lp + gi * 32 + 16);
            int v[16];
#pragma unroll
            for (int j = 0; j < 8; ++j) { v[j] = (f2ord((float)cA[j]) & ~127) | (127 - (gi * 16 + j)); v[8 + j] = (f2ord((float)c1_[j]) & ~127) | (127 - (gi * 16 + 8 + j)); }
            TK_CE(v[0], v[1]); TK_CE(v[3], v[2]); TK_CE(v[4], v[5]); TK_CE(v[7], v[6]); TK_CE(v[8], v[9]); TK_CE(v[11], v[10]); TK_CE(v[12], v[13]); TK_CE(v[15], v[14]); TK_CE(v[0], v[2]); TK_CE(v[1], v[3]); TK_CE(v[6], v[4]); TK_CE(v[7], v[5]); TK_CE(v[8], v[10]); TK_CE(v[9], v[11]); TK_CE(v[14], v[12]); TK_CE(v[15], v[13]); TK_CE(v[0], v[1]); TK_CE(v[2], v[3]); TK_CE(v[5], v[4]); TK_CE(v[7], v[6]); TK_CE(v[8], v[9]); TK_CE(v[10], v[11]); TK_CE(v[13], v[12]); TK_CE(v[15], v[14]); TK_CE(v[0], v[4]); TK_CE(v[1], v[5]); TK_CE(v[2], v[6]); TK_CE(v[3], v[7]); TK_CE(v[12], v[8]); TK_CE(v[13], v[9]); TK_CE(v[14], v[10]); TK_CE(v[15], v[11]); TK_CE(v[0], v[2]); TK_CE(v[1], v[3]); TK_CE(v[4], v[6]); TK_CE(v[5], v[7]); TK_CE(v[10], v[8]); TK_CE(v[11], v[9]); TK_CE(v[14], v[12]); TK_CE(v[15], v[13]); TK_CE(v[0], v[1]); TK_CE(v[2], v[3]); TK_CE(v[4], v[5]); TK_CE(v[6], v[7]); TK_CE(v[9], v[8]); TK_CE(v[11], v[10]); TK_CE(v[13], v[12]); TK_CE(v[15], v[14]); TK_CE(v[0], v[8]); TK_CE(v[1], v[9]); TK_CE(v[2], v[10]); TK_CE(v[3], v[11]); TK_CE(v[4], v[12]); TK_CE(v[5], v[13]); TK_CE(v[6], v[14]); TK_CE(v[7], v[15]); TK_CE(v[0], v[4]); TK_CE(v[1], v[5]); TK_CE(v[2], v[6]); TK_CE(v[3], v[7]); TK_CE(v[8], v[12]); TK_CE(v[9], v[13]); TK_CE(v[10], v[14]); TK_CE(v[11], v[15]); TK_CE(v[0], v[2]); TK_CE(v[1], v[3]); TK_CE(v[4], v[6]); TK_CE(v[5], v[7]); TK_CE(v[8], v[10]); TK_CE(v[9], v[11]); TK_CE(v[12], v[14]); TK_CE(v[13], v[15]); TK_CE(v[0], v[1]); TK_CE(v[2], v[3]); TK_CE(v[4], v[5]); TK_CE(v[6], v[7]); TK_CE(v[8], v[9]); TK_CE(v[10], v[11]); TK_CE(v[12], v[13]); TK_CE(v[14], v[15]);
            if (gi == 0) {
#pragma unroll
                for (int j = 0; j < 16; ++j) tk[j] = v[j]; }
            else {
#pragma unroll
                for (int j = 0; j < 16; ++j) tk[j] = max(tk[j], v[15 - j]);
                TK_CE(tk[0], tk[8]); TK_CE(tk[1], tk[9]); TK_CE(tk[2], tk[10]); TK_CE(tk[3], tk[11]); TK_CE(tk[4], tk[12]); TK_CE(tk[5], tk[13]); TK_CE(tk[6], tk[14]); TK_CE(tk[7], tk[15]); TK_CE(tk[0], tk[4]); TK_CE(tk[1], tk[5]); TK_CE(tk[2], tk[6]); TK_CE(tk[3], tk[7]); TK_CE(tk[8], tk[12]); TK_CE(tk[9], tk[13]); TK_CE(tk[10], tk[14]); TK_CE(tk[11], tk[15]); TK_CE(tk[0], tk[2]); TK_CE(tk[1], tk[3]); TK_CE(tk[4], tk[6]); TK_CE(tk[5], tk[7]); TK_CE(tk[8], tk[10]); TK_CE(tk[9], tk[11]); TK_CE(tk[12], tk[14]); TK_CE(tk[13], tk[15]); TK_CE(tk[0], tk[1]); TK_CE(tk[2], tk[3]); TK_CE(tk[4], tk[5]); TK_CE(tk[6], tk[7]); TK_CE(tk[8], tk[9]); TK_CE(tk[10], tk[11]); TK_CE(tk[12], tk[13]); TK_CE(tk[14], tk[15]); }
            }
        __builtin_amdgcn_wave_barrier();
#undef TK_CE
        float av[16], bv[16]; int ai[16], bi[16]; const bool c1 = (hc & 1) != 0;
#pragma unroll
        for (int j = 0; j < 16; ++j) { const int ok = __shfl_xor(tk[j], 1); const int ka = c1 ? ok : tk[j], kb = c1 ? tk[j] : ok;
            av[j] = ord2f(ka & ~127); ai[j] = 127 - (ka & 127); bv[j] = ord2f(kb & ~127); bi[j] = 127 - (kb & 127); }
#pragma unroll
        for (int j = 0; j < 16; ++j) { tab[j * 64 + lane] = (unsigned char)ai[j]; tab[(16 + j) * 64 + lane] = (unsigned char)bi[j]; }
        int ck[16];
#pragma unroll
        for (int j = 0; j < 16; ++j) ck[j] = (int)0x80000000;
#pragma unroll
        for (int i = 0; i < 16; ++i)
#pragma unroll
            for (int j = 0; j < 16 / (i + 1); ++j) { int x = (f2ord(av[i] + bv[j]) & ~255) | (255 - (i * 16 + j));
#pragma unroll
                for (int q = 0; q < 16; ++q) { const int hi = max(ck[q], x); x = min(ck[q], x); ck[q] = hi; } }
        float den = 0.f; float ex[16]; const float c0 = ord2f(ck[0] & ~255);
#pragma unroll
        for (int j = 0; j < 16; ++j) { ex[j] = __expf(ord2f(ck[j] & ~255) - c0); den += ex[j]; }
        const float inv = 1.0f / den;
        int eid[16]; unsigned long long cnt = 0ull;
#pragma unroll
        for (int j = 0; j < 16; ++j) { const int flat = 255 - (ck[j] & 255); eid[j] = (int)tab[(flat >> 4) * 64 + lane] * 128 + (int)tab[(16 + (flat & 15)) * 64 + lane];
            if (!c1) cnt += 1ull << (8 * (eid[j] >> 11)); }
        unsigned long long incl = cnt;
#pragma unroll
        for (int o = 1; o < 16; o <<= 1) { const unsigned lo = __shfl_up((unsigned)incl, o, 16), hi = __shfl_up((unsigned)(incl >> 32), o, 16); if ((hc & 15) >= o) incl += ((unsigned long long)hi << 32) | lo; }
        const unsigned long long total = ((unsigned long long)__shfl((unsigned)(incl >> 32), 15, 16) << 32) | __shfl((unsigned)incl, 15, 16);
        const unsigned long long base = total * 0x0101010101010100ull;
        unsigned long long run = base + (incl - cnt);
        if (hc == 0) SOFF[tok] = base;
        if (!c1) {
#pragma unroll
            for (int j = 0; j < 16; ++j) { const int sh = 8 * (eid[j] >> 11); const int pos = (int)((run >> sh) & 0xffull); run += 1ull << sh;
                EIDX[(size_t)tok * 128 + pos] = eid[j]; GATE[(size_t)tok * 128 + pos] = ex[j] * inv; } }
    }
}

__device__ __forceinline__ float gelu_tanh(float h) { const float z = 0.7978845608028654f * (h + 0.044715f * h * h * h); const float t = 1.0f - 2.0f / (__expf(2.0f * z) + 1.0f); return 0.5f * h * (1.0f + t); }
struct PeerTok { u32x4 xq; float xs; unsigned long long so; int e_lo, e_hi; float g_lo, g_hi; };
__device__ __forceinline__ PeerTok peer_tok_load(const unsigned char* XQ, const float* XS, const int* EIDX, const float* GATE, const unsigned long long* SOFF, int tok, int lane) {
    PeerTok t; const int tk = tok < T ? tok : T - 1;
    t.xq = __builtin_nontemporal_load((const u32x4*)(XQ + (size_t)tk * D + lane * 16)); t.xs = XS[tk];
    t.so = SOFF[tk]; t.e_lo = EIDX[(size_t)tk * 128 + lane]; t.e_hi = EIDX[(size_t)tk * 128 + 64 + lane]; t.g_lo = GATE[(size_t)tk * 128 + lane]; t.g_hi = GATE[(size_t)tk * 128 + 64 + lane];
    return t;
}
template <int CTRL> __device__ __forceinline__ float dpp_mov(float v) { return __int_as_float(__builtin_amdgcn_update_dpp(0, __float_as_int(v), CTRL, 0xf, 0xf, false)); }
__device__ __forceinline__ float xor16_sum(float v) { const auto r = __builtin_amdgcn_permlane16_swap(__float_as_uint(v), __float_as_uint(v), false, false); return __uint_as_float(r[0]) + __uint_as_float(r[1]); }
__device__ __forceinline__ float xor32_sum(float v) { const auto r = __builtin_amdgcn_permlane32_swap(__float_as_uint(v), __float_as_uint(v), false, false); return __uint_as_float(r[0]) + __uint_as_float(r[1]); }
#define PEER_ISSUE(R, tk, k0_, kl_) do { _Pragma("unroll") for (int q_ = 0; q_ < 8; ++q_) { const int k_ = min((k0_) + q_, (kl_)); \
    const int e_ = __builtin_amdgcn_readlane(k_ < 64 ? (tk).e_lo : (tk).e_hi, k_ & 63); R[q_] = *(const u32x4*)(U8 + (size_t)e_ * D + lane * 16); } } while (0)
__device__ __forceinline__ float gelu_tanh_fast(float h) { const float z = 0.7978845608028654f * (h + 0.044715f * h * h * h); const float t = 1.0f - 2.0f * __builtin_amdgcn_rcpf(__expf(2.0f * z) + 1.0f); return 0.5f * h * (1.0f + t); }
typedef __bf16 bf16x2v __attribute__((ext_vector_type(2)));
#define PEER_DOT(RC, q) do { int a_ = 0; _Pragma("unroll") for (int w = 0; w < 4; ++w) a_ = __builtin_amdgcn_sdot4((int)RC[q][w], (int)xp[w], a_, false); d[q] = (float)a_; } while (0)
#define PEER_COMPUTE(RC) do { float d[8]; \
    PEER_DOT(RC, 0); PEER_DOT(RC, 1); PEER_DOT(RC, 2); PEER_DOT(RC, 3); \
    if (k0 + 4 < end) { PEER_DOT(RC, 4); PEER_DOT(RC, 5); PEER_DOT(RC, 6); PEER_DOT(RC, 7); } else { d[4] = 0.f; d[5] = 0.f; d[6] = 0.f; d[7] = 0.f; asm volatile("" :: "v"(RC[4]), "v"(RC[5]), "v"(RC[6]), "v"(RC[7])); }     \
    float t4[4]; \
    _Pragma("unroll") for (int j = 0; j < 4; ++j) { const float keep = (lane & 1) ? d[2 * j + 1] : d[2 * j], give = (lane & 1) ? d[2 * j] : d[2 * j + 1]; t4[j] = keep + dpp_mov<0xB1>(give); } \
    float sA, sB; \
    { const float keep = (lane & 2) ? t4[1] : t4[0], give = (lane & 2) ? t4[0] : t4[1]; sA = keep + dpp_mov<0x4E>(give); } \
    { const float keep = (lane & 2) ? t4[3] : t4[2], give = (lane & 2) ? t4[2] : t4[3]; sB = keep + dpp_mov<0x4E>(give); } \
    sA += dpp_mov<0x124>(sA); sB += dpp_mov<0x124>(sB); sA += dpp_mov<0x128>(sA); sB += dpp_mov<0x128>(sB); \
    sA = xor16_sum(sA); sB = xor16_sum(sB); sA = xor32_sum(sA); sB = xor32_sum(sB); \
    const float geA = sA, geB = sB;     \
      \
    { const int rel = (lane - k0) & 63; const int src = (rel & 3) << 2; \
      const float ga = __int_as_float(__builtin_amdgcn_ds_bpermute(src, __float_as_int(geA))), gb = __int_as_float(__builtin_amdgcn_ds_bpermute(src, __float_as_int(geB))); \
      const float gq = (rel & 4) ? gb : ga; const int kq = k0 + rel;              \
      c_lo = (rel < 8 && kq < 64) ? gq : c_lo; c_hi = (rel < 8 && kq >= 64) ? gq : c_hi; } } while (0)
#define PEER_KL(st, en) min(max((en) - 1, (st)), 127)
#define PEER_NEXT(RN) do { __builtin_amdgcn_sched_barrier(0); if (k0 + 8 < end) { PEER_ISSUE(RN, c, k0 + 8, PEER_KL(start, end)); } else { int ns_, ne_; PEER_RANGE2(n.so_lo, n.so_hi, ns_, ne_); PEER_ISSUE(RN, n, ns_, PEER_KL(ns_, ne_)); } __builtin_amdgcn_sched_barrier(0); } while (0)
#define PEER_RANGE(tk, st, en) PEER_RANGE2((unsigned)(tk).so, (unsigned)((tk).so >> 32), st, en)
#define PEER_RANGE2(slo, shi, st, en) do { const unsigned lo_ = __builtin_amdgcn_readfirstlane(slo), hi_ = __builtin_amdgcn_readfirstlane(shi); \
    const unsigned long long so_ = ((unsigned long long)hi_ << 32) | lo_; st = (int)((so_ >> (8 * g0)) & 0xffull); en = g1 < 8 ? (int)((so_ >> (8 * g1)) & 0xffull) : 128; } while (0)

struct PeerNx { unsigned x[4], xs, so_lo, so_hi; int e_lo, e_hi; float g_lo, g_hi; };
#define PEER_ROT(N, L) do { \
    asm volatile("v_mov_b32 %0, %7\n\tv_mov_b32 %1, %8\n\tv_mov_b32 %2, %9\n\tv_mov_b32 %3, %10\n\tv_mov_b32 %4, %11\n\tv_mov_b32 %5, %12\n\tv_mov_b32 %6, %13" \
        : "=&v"(N.x[0]), "=&v"(N.x[1]), "=&v"(N.x[2]), "=&v"(N.x[3]), "=&v"(N.xs), "=&v"(N.so_lo), "=&v"(N.so_hi) \
        : "v"(L.xq[0]), "v"(L.xq[1]), "v"(L.xq[2]), "v"(L.xq[3]), "v"(__float_as_uint(L.xs)), "v"((unsigned)L.so), "v"((unsigned)(L.so >> 32))); \
    asm volatile("v_mov_b32 %0, %4\n\tv_mov_b32 %1, %5\n\tv_mov_b32 %2, %6\n\tv_mov_b32 %3, %7" \
        : "=&v"(N.e_lo), "=&v"(N.e_hi), "=&v"(N.g_lo), "=&v"(N.g_hi) : "v"(L.e_lo), "v"(L.e_hi), "v"(L.g_lo), "v"(L.g_hi)); } while (0)
#define PEER_ADVANCE() do { k0 += 8; if (k0 >= end) { \
        if (tok < T) { \
        if (lane >= start && lane < end) GATE[(size_t)tok * 128 + lane] = c.g_lo * gelu_tanh_fast(c_lo * (rs_lo * xs)) * (1.0f / V8_SCALE); \
        if (lane + 64 >= start && lane + 64 < end) GATE[(size_t)tok * 128 + 64 + lane] = c.g_hi * gelu_tanh_fast(c_hi * (rs_hi * xs)) * (1.0f / V8_SCALE); } \
        tok += stride; PEER_RANGE2(n.so_lo, n.so_hi, start, end); k0 = start; c_lo = 0.f; c_hi = 0.f; xs = __uint_as_float(n.xs); \
        _Pragma("unroll") for (int i = 0; i < 4; ++i) xp[i] = n.x[i]; \
        asm volatile("v_mov_b32 %0, %4\n\tv_mov_b32 %1, %5\n\tv_mov_b32 %2, %6\n\tv_mov_b32 %3, %7" : "=&v"(c.e_lo), "=&v"(c.e_hi), "=&v"(c.g_lo), "=&v"(c.g_hi) : "v"(n.e_lo), "v"(n.e_hi), "v"(n.g_lo), "v"(n.g_hi)); \
        PEER_ROT(n, n2); __builtin_amdgcn_sched_barrier(0); \
        rs_lo = RS[c.e_lo]; rs_hi = RS[c.e_hi]; \
        n2 = peer_tok_load(XQ, XS, EIDX, GATE, SOFF, tok + 2 * stride, lane); __builtin_amdgcn_sched_barrier(0); } } while (0)
__device__ __forceinline__ void phase_peer_u(const Params& p) {
    const int tid = tid_l(), lane = tid & 63, wave = tid >> 6, bid = bid_l(), G = grid_l();
    const unsigned char* XQ = p.ws + WS_XQ; const float* XS = (const float*)(p.ws + WS_XS); const float* RS = (const float*)(p.ws + WS_RS); const unsigned char* U8 = p.ws + WS_U;
    const int* EIDX = (const int*)(p.ws + WS_EIDX); float* GATE = (float*)(p.ws + WS_GATE); const unsigned long long* SOFF = (const unsigned long long*)(p.ws + WS_SOFF);
    const int ngrp = (G % 8 == 0) ? 8 : 1;
    const int g0 = (ngrp == 8) ? (bid & 7) : 0, g1 = (ngrp == 8) ? g0 + 1 : 8, r = (ngrp == 8) ? (bid >> 3) : bid, R = (ngrp == 8) ? (G >> 3) : G;
    const int stride = R * 8; int tok = __builtin_amdgcn_readfirstlane(r * 8 + wave);
    if (tok >= T) return;
    PeerTok c = peer_tok_load(XQ, XS, EIDX, GATE, SOFF, tok, lane), n2 = peer_tok_load(XQ, XS, EIDX, GATE, SOFF, tok + stride, lane);
    int start, end; PEER_RANGE(c, start, end);
    unsigned xp[4];
#pragma unroll
    for (int i = 0; i < 4; ++i) xp[i] = c.xq[i];
    float xs = c.xs, rs_lo = RS[c.e_lo], rs_hi = RS[c.e_hi];
    PeerNx n; PEER_ROT(n, n2);
    n2 = peer_tok_load(XQ, XS, EIDX, GATE, SOFF, tok + 2 * stride, lane);
    float c_lo = 0.f, c_hi = 0.f;
    int k0 = start;
    u32x4 Ra[8], Rb[8];
    PEER_ISSUE(Ra, c, start, PEER_KL(start, end));
#pragma unroll 1
    do {
        PEER_NEXT(Rb); PEER_COMPUTE(Ra); PEER_ADVANCE();
        PEER_NEXT(Ra); PEER_COMPUTE(Rb); PEER_ADVANCE();
    } while (tok < T);
}
#undef PEER_ISSUE
#undef PEER_COMPUTE
#undef PEER_DOT
#undef PEER_NEXT
#undef PEER_KL
#undef PEER_RANGE
#undef PEER_ROT
#undef PEER_RANGE2
#undef PEER_ADVANCE
struct PeerVMeta { int e_lo, e_hi; float c_lo, c_hi; u32x4 x0, x1; };
__device__ __forceinline__ PeerVMeta peer_vmeta_load(const int* EIDX, const float* COEF, const bf16* XB, int tok, int lane) {
    PeerVMeta m;
    m.e_lo = EIDX[(size_t)tok * 128 + lane]; m.e_hi = EIDX[(size_t)tok * 128 + 64 + lane]; m.c_lo = COEF[(size_t)tok * 128 + lane]; m.c_hi = COEF[(size_t)tok * 128 + 64 + lane];
    m.x0 = *(const u32x4*)(XB + (size_t)tok * D + lane * 16); m.x1 = *(const u32x4*)(XB + (size_t)tok * D + lane * 16 + 8);
    return m;
}
__device__ __forceinline__ void phase_peer_v(const Params& p) {
    const int tid = tid_l(), lane = tid & 63, wave = tid >> 6;
    const unsigned char* V8 = p.ws + WS_V;
    const int* EIDX = (const int*)(p.ws + WS_EIDX); const float* COEF = (const float*)(p.ws + WS_GATE);
    bf16* XB = (bf16*)(p.ws + WS_XB);
    const int stride = grid_l() * 8; int tok = bid_l() * 8 + wave;
    if (tok >= T) return;
    PeerVMeta cur = peer_vmeta_load(EIDX, COEF, XB, tok, lane);
#pragma unroll 1
    for (; tok < T; tok += stride) {
        const PeerVMeta nxt = peer_vmeta_load(EIDX, COEF, XB, tok + stride < T ? tok + stride : tok, lane);
        __builtin_amdgcn_sched_barrier(0);
        float acc[16];
#pragma unroll
        for (int i = 0; i < 16; ++i) acc[i] = 0.f;
#pragma unroll 1
        for (int k0 = 0; k0 < 128; k0 += 8) {
            const int esel = k0 < 64 ? cur.e_lo : cur.e_hi; const unsigned csel = __float_as_uint(k0 < 64 ? cur.c_lo : cur.c_hi);
            u32x4 vr[8]; float cf[8];
#pragma unroll
            for (int q = 0; q < 8; ++q) { const int e = __builtin_amdgcn_readlane(esel, (k0 & 63) + q); cf[q] = __uint_as_float(__builtin_amdgcn_readlane(csel, (k0 & 63) + q));
                vr[q] = *(const u32x4*)(V8 + (size_t)e * D + lane * 16); }
#pragma unroll
            for (int q = 0; q < 8; ++q)
#pragma unroll
                for (int w = 0; w < 4; ++w) { const f32x2v a = __builtin_amdgcn_cvt_pk_f32_fp8((int)vr[q][w], false), b = __builtin_amdgcn_cvt_pk_f32_fp8((int)vr[q][w], true);
                    acc[4 * w] += cf[q] * a[0]; acc[4 * w + 1] += cf[q] * a[1]; acc[4 * w + 2] += cf[q] * b[0]; acc[4 * w + 3] += cf[q] * b[1]; }
        }
        float r[16];
#pragma unroll
        for (int i = 0; i < 4; ++i) { r[2 * i] = ALPHA * bf2f(cur.x0[i] & 0xffffu) + acc[2 * i]; r[2 * i + 1] = ALPHA * __uint_as_float(cur.x0[i] & 0xffff0000u) + acc[2 * i + 1];
                                      r[8 + 2 * i] = ALPHA * bf2f(cur.x1[i] & 0xffffu) + acc[8 + 2 * i]; r[8 + 2 * i + 1] = ALPHA * __uint_as_float(cur.x1[i] & 0xffff0000u) + acc[8 + 2 * i + 1]; }
#pragma unroll
        for (int w = 0; w < 2; ++w) { u32x4 o; o.x = pk2(r[8 * w], r[8 * w + 1]); o.y = pk2(r[8 * w + 2], r[8 * w + 3]); o.z = pk2(r[8 * w + 4], r[8 * w + 5]); o.w = pk2(r[8 * w + 6], r[8 * w + 7]);
            *(u32x4*)(XB + (size_t)tok * D + lane * 16 + 8 * w) = o; }
        cur = nxt;
    }
}
#define GAS __attribute__((address_space(1)))
#define LAS __attribute__((address_space(3)))
#define XB_TMO      128
#define XB_XCNT(j)  (256  + 64 * (j))
#define XB_XSUB(j)  (1280 + 64 * (j))
#define XB_XGEN(j)  (2304 + 64 * (j))
#define XB_TOP      3328
#define XB_TOPGEN   3392
#define XCD_BAR_WORDS 3456
#define XB_SPIN_CAP (1u << 18)

__device__ __forceinline__ unsigned xb_ld(unsigned* p)              { return __hip_atomic_load(p, __ATOMIC_RELAXED, __HIP_MEMORY_SCOPE_AGENT); }
__device__ __forceinline__ unsigned xb_add(unsigned* p, unsigned v) { return __hip_atomic_fetch_add(p, v, __ATOMIC_RELAXED, __HIP_MEMORY_SCOPE_AGENT); }
__device__ __forceinline__ unsigned xb_xcc_id() { return (unsigned)__builtin_amdgcn_s_getreg((3 << 11) | 20) & 0xFu; }
#define XB_SPIN(cond, bar) do { unsigned _sp = 0; while (cond) { __builtin_amdgcn_s_sleep(1); \
    if ((++_sp & 255u) == 0u) { if (xb_ld(&(bar)[XB_TMO])) break; if (_sp > XB_SPIN_CAP) { atomicAdd(&(bar)[XB_TMO], 1u); break; } } } } while (0)

struct XcdBarrier {
    unsigned* bar; unsigned x;
    volatile LAS unsigned* st;
};

__device__ __forceinline__ XcdBarrier xcd_barrier_post(unsigned* bar, volatile LAS unsigned* st) {
    XcdBarrier b; b.bar = bar; b.x = xb_xcc_id(); b.st = st;
    if (threadIdx.x == 0) (void)xb_add(&bar[XB_XCNT(b.x)], 1u);
    return b;
}
__device__ __forceinline__ void xcd_barrier_complete(unsigned* bar, unsigned x, unsigned& nloc, unsigned& nx) {
    const unsigned G = gridDim.x * gridDim.y * gridDim.z;
    unsigned sum, cnt, mine, sp = 0u;
    for (;;) {
        sum = 0u; cnt = 0u; mine = 0u;
#pragma unroll
        for (unsigned j = 0; j < 16; ++j) { const unsigned c = xb_ld(&bar[XB_XCNT(j)]); sum += c; cnt += (c > 0u) ? 1u : 0u; mine = (j == x) ? c : mine; }
        if (sum == G) break;
        __builtin_amdgcn_s_sleep(1);
        if ((++sp & 255u) == 0u) { if (xb_ld(&bar[XB_TMO])) break; if (sp > XB_SPIN_CAP) { atomicAdd(&bar[XB_TMO], 1u); break; } }
    }
    nloc = mine > 0u ? mine : 1u; nx = cnt > 0u ? cnt : 1u;
}

__device__ __forceinline__ void xcd_barrier(const XcdBarrier& b) {
    asm volatile("s_waitcnt vmcnt(0)" ::: "memory");
    __syncthreads();
    if (threadIdx.x == 0) {
        unsigned* bar = b.bar;
        __builtin_amdgcn_s_waitcnt(0);
        unsigned nloc = b.st[0], nx = b.st[1];
        if (nloc == 0u) { xcd_barrier_complete(bar, b.x, nloc, nx); b.st[0] = nloc; b.st[1] = nx; }
        const unsigned old = xb_add(&bar[XB_XSUB(b.x)], 1u);
        const unsigned gen = old / nloc;
        if (old + 1u == (gen + 1u) * nloc) {
            __builtin_amdgcn_fence(__ATOMIC_RELEASE, "agent");
            asm volatile("s_waitcnt vmcnt(0)" ::: "memory");
            const unsigned og = xb_add(&bar[XB_TOP], 1u);
            const unsigned tg = og / nx;
            if (og + 1u == (tg + 1u) * nx) xb_add(&bar[XB_TOPGEN], 1u);
            else XB_SPIN(xb_ld(&bar[XB_TOPGEN]) == tg, bar);
            __builtin_amdgcn_fence(__ATOMIC_ACQUIRE, "agent");
            xb_add(&bar[XB_XGEN(b.x)], 1u);
            asm volatile("s_waitcnt vmcnt(0)" ::: "memory");
        } else {
            XB_SPIN(xb_ld(&bar[XB_XGEN(b.x)]) == gen, bar);
            __builtin_amdgcn_fence(__ATOMIC_ACQUIRE, "agent");
            asm volatile("s_waitcnt vmcnt(0)" ::: "memory");
        }
    }
    __syncthreads();
}
enum { PH_PRO_A, PH_PRO_B, PH_CVT, PH_GEMM_IN, PH_GEMM_E, PH_CONV, PH_FOXCUM, PH_FOXNORM, PH_GLA1, PH_GLA2, PH_GLA3, PH_FOX, PH_GEMM_OUT, PH_LN1, PH_GEMM_SC, PH_TOPK, PH_PEERU, PH_PEERV, PH_GEMM_PLE, PH_LN2, PH_COUNT };

template <int PH> __device__ __forceinline__ void run_phase(const Params& p, int l, unsigned char* lds) {
    if constexpr (PH == PH_PRO_A) phase_pro_a(p, lds);
    else if constexpr (PH == PH_PRO_B) phase_pro_b(p, lds);
    else if constexpr (PH == PH_CVT) phase_cvt(p, l);
    else if constexpr (PH == PH_GEMM_IN) phase_gemm_in(p, l, lds);
    else if constexpr (PH == PH_GEMM_E) phase_gemm_e(p, l, lds);
    else if constexpr (PH == PH_CONV) phase_conv(p, l, lds);
    else if constexpr (PH == PH_FOXCUM) phase_fox_cum(p, l, lds);
    else if constexpr (PH == PH_FOXNORM) phase_fox_norm(p, lds);
    else if constexpr (PH == PH_GLA1) phase_gla_b1(p, l, lds);
    else if constexpr (PH == PH_GLA2) phase_gla_b2(p);
    else if constexpr (PH == PH_GLA3) phase_gla_b3(p, l, lds);
    else if constexpr (PH == PH_FOX) phase_fox_mfma(p, l, lds);
    else if constexpr (PH == PH_GEMM_OUT) phase_gemm_out(p, l, lds);
    else if constexpr (PH == PH_LN1) phase_ln((const _Float16*)(p.ws + WS_Y), p.ln1_g + (size_t)l * D, p.ln1_b + (size_t)l * D, nullptr, (bf16*)(p.ws + WS_XB), p.ws + WS_XQ, (float*)(p.ws + WS_XS));
    else if constexpr (PH == PH_GEMM_SC) phase_gemm_sc(p, l, lds);
    else if constexpr (PH == PH_TOPK) phase_topk(p, lds);
    else if constexpr (PH == PH_PEERU) phase_peer_u(p);
    else if constexpr (PH == PH_PEERV) phase_peer_v(p);
    else if constexpr (PH == PH_GEMM_PLE) phase_gemm_ple(p, l, lds);
    else if constexpr (PH == PH_LN2) phase_ln((const _Float16*)(p.ws + WS_Y), p.ln2_g + (size_t)l * D, p.ln2_b + (size_t)l * D, l == DEPTH - 1 ? p.out : nullptr, l == DEPTH - 1 ? nullptr : (bf16*)(p.ws + WS_XB));
}

constexpr int MISC_OFF = LDS_BYTES - 512;
constexpr int CW_BAR = 4096;
static_assert(MISC_OFF + 128 <= LDS_BYTES && (CW_BAR + XCD_BAR_WORDS) * 4 <= (int)CTL_ZERO_BYTES, "control words");

typedef __attribute__((address_space(4))) const Params CParams;
#define PHASE(PH) do { CParams* q_ = pp; asm volatile("" : "+s"(q_)); Params lp_; __builtin_memcpy(&lp_, q_, sizeof(Params)); run_phase<PH>(lp_, l, lds); } while (0)
__global__ void __launch_bounds__(512, 2) mk_fwd(Params p_unused) {
#if defined(__HIP_DEVICE_COMPILE__)
    extern __shared__ __attribute__((aligned(16))) unsigned char lds[];
    CParams* pp = (CParams*)__builtin_amdgcn_kernarg_segment_ptr();
    unsigned char* ws0; { CParams* q_ = pp; asm volatile("" : "+s"(q_)); ws0 = q_->ws; }
    volatile LAS unsigned* MISC = (volatile LAS unsigned*)((LAS unsigned char*)lds + MISC_OFF);
    if (threadIdx.x < 32) MISC[threadIdx.x] = 0u;
    __syncthreads();
    (void)xcd_barrier_post((unsigned*)(ws0 + WS_CTL) + CW_BAR, MISC + 8);
#define GB() do { CParams* qb_ = pp; asm volatile("" : "+s"(qb_)); XcdBarrier b_; b_.bar = (unsigned*)(qb_->ws + WS_CTL) + CW_BAR; b_.x = xb_xcc_id(); b_.st = MISC + 8; xcd_barrier(b_); } while (0)
    { const int l = 0; PHASE(PH_PRO_A); PHASE(PH_PRO_B); } GB();
    for (int l = 0; l < DEPTH; ++l) {
        PHASE(PH_CVT); PHASE(PH_GEMM_IN); GB();
        PHASE(PH_GEMM_E); PHASE(PH_CONV); PHASE(PH_FOXCUM); PHASE(PH_FOXNORM); PHASE(PH_GLA1); GB();
        PHASE(PH_GLA2); PHASE(PH_FOX); GB();
        PHASE(PH_GLA3); GB();
        PHASE(PH_GEMM_OUT); GB();
        PHASE(PH_LN1); GB();
        PHASE(PH_GEMM_SC); GB();
        PHASE(PH_TOPK); GB();
        PHASE(PH_PEERU); GB();
        PHASE(PH_PEERV); GB();
        PHASE(PH_GEMM_PLE); GB();
        PHASE(PH_LN2); GB();
    }
#undef GB
#endif
}

extern "C" void kernel_launch(void* const* d_in, const int* in_sizes, int n_in, void* d_out, int out_size, void* d_ws, size_t ws_size, hipStream_t stream) {
    static int grid = 0;
    if (grid == 0) {
        if (n_in != 23 || ws_size < WS_END) { fprintf(stderr, "kernel_launch: unexpected n_in %d or ws_size %zu\n", n_in, ws_size); grid = -1; return; }
        int dev = 0, cus = 0, per_cu = 0;
        if (hipGetDevice(&dev) != hipSuccess || hipDeviceGetAttribute(&cus, hipDeviceAttributeMultiprocessorCount, dev) != hipSuccess) { grid = -1; return; }
        if (hipFuncSetAttribute((const void*)mk_fwd, hipFuncAttributeMaxDynamicSharedMemorySize, LDS_BYTES) != hipSuccess) { grid = -1; return; }
        if (hipOccupancyMaxActiveBlocksPerMultiprocessor(&per_cu, (const void*)mk_fwd, 512, LDS_BYTES) != hipSuccess || per_cu < 1) { fprintf(stderr, "kernel_launch: occupancy query says %d\n", per_cu); }
        (void)hipGetLastError();
        grid = cus;
    }
    if (grid < 0) return;
    if (hipMemsetAsync((char*)d_ws + WS_CTL, 0, CTL_ZERO_BYTES, stream) != hipSuccess) return;
    Params p; memset(&p, 0, sizeof(p));
    const float** f = (const float**)&p;
    for (int i = 0; i < 23; ++i) f[i] = (const float*)d_in[i];
    p.out = (float*)d_out; p.ws = (unsigned char*)d_ws;
    hipLaunchKernelGGL(mk_fwd, dim3(grid), dim3(512), LDS_BYTES, stream, p);
}
```

```cpp
#include <hip/hip_runtime.h>
#include <cstdio>
#include <cstdint>
#include <cstring>
#include <cmath>
__device__ __forceinline__ int tid_l() { int t = threadIdx.x; asm volatile("" : "+v"(t)); return t; }
__device__ __forceinline__ int bid_l() { int b = blockIdx.x; asm volatile("" : "+s"(b)); return b; }
__device__ __forceinline__ int grid_l() { int g = gridDim.x; asm volatile("" : "+s"(g)); return g; }
namespace pg8 {
#define PG8_LAS __attribute__((address_space(3)))
typedef unsigned short bf16_t;
typedef short bf16x8 __attribute__((ext_vector_type(8)));
typedef float f32x4 __attribute__((ext_vector_type(4)));
typedef unsigned u32x4 __attribute__((ext_vector_type(4)));
constexpr int BM = 256, BK = 64, HALF = 128, HTB = HALF * BK * 2  , STAGE_BYTES = 8 * HTB, NXCD = 8, WGM = 8;

__host__ __device__ __forceinline__ int lds_byte(int r, int c) { const int st = (r >> 4) * 2 + (c >> 5), rr = r & 15, cc = c & 31, ob = rr * 64 + cc * 2; return st * 1024 + (ob ^ (((ob >> 9) & 1) << 5)); }
__host__ __device__ __forceinline__ void stage_rc(int b, int& R, int& C) { const int st = b / 1024, sb = b % 1024, swz = sb ^ (((sb >> 9) & 1) << 5); R = (st >> 1) * 16 + swz / 64; C = (st & 1) * 32 + (swz % 64) / 2; }
__host__ __device__ __forceinline__ int perm32(int rho) { const int n = rho >> 4, i = rho & 15; return 8 * (i >> 2) + 4 * n + (i & 3); }

struct Unit { int pm, pn; };
struct Gemm { const bf16_t* A; const bf16_t* Bt; int M, N, K; };

struct StaticOrder {
    int nM, nN, nwg, G, c;
    __host__ __device__ void init(int M, int N, int G_, int c_) { nM = M / BM; nN = N / BM; nwg = nM * nN; G = G_; c = c_; }
    __host__ __device__ bool next(int i, Unit& u) const {
        const long L = (long)i * G + c; if (L >= nwg) return false;
        int wgid = (int)L; { const int q = nwg / NXCD, r = nwg % NXCD, xcd = wgid % NXCD, off = wgid / NXCD; wgid = (xcd < r ? xcd * (q + 1) : r * (q + 1) + (xcd - r) * q) + off; }
        const int nig = WGM * nN, gid = wgid / nig, fm = gid * WGM, gsz = (nM - fm) < WGM ? (nM - fm) : WGM;
        u.pm = fm + ((wgid % nig) % gsz); u.pn = (wgid % nig) / gsz; return true;
    }
    __device__ __forceinline__ void a_ready(const Unit&) const {}
    __device__ __forceinline__ void done(const Unit&) const {}
};

__device__ __forceinline__ unsigned cvt_pk_bf16(float lo, float hi) { unsigned r; asm volatile("v_cvt_pk_bf16_f32 %0, %1, %2" : "=v"(r) : "v"(lo), "v"(hi)); return r; }
typedef float f32x2 __attribute__((ext_vector_type(2)));
__device__ __forceinline__ f32x2 gelu_pk(f32x2 v) {
    const f32x2 av = __builtin_elementwise_abs(v), d = av * 0.2316418882f + 1.0f;
    f32x2 t; t.x = __builtin_amdgcn_rcpf(d.x); t.y = __builtin_amdgcn_rcpf(d.y);
    f32x2 q = t * 0.5307027145f + (-0.7265760135f); q = q * t + 0.7107068705f; q = q * t + (-0.142248368f); q = q * t + 0.127414796f; q = q * t;
    const f32x2 s = (v * v) * (-0.72134752044f);
    f32x2 e; e.x = __builtin_amdgcn_exp2f(s.x); e.y = __builtin_amdgcn_exp2f(s.y);
    const f32x2 m = v * (q * e), r = v - m;
    f32x2 o; o.x = v.x < 0.f ? m.x : r.x; o.y = v.y < 0.f ? m.y : r.y; return o;
}

template <int ACT  > struct EpiBf16 {
    static constexpr bool PERM = true, AFTER_DRAIN = false; static_assert(ACT == 0 || ACT == 1, "EpiBf16: ACT is 0 (none) or 1 (gelu_pk)");
    bf16_t* O; int ldc; const float* bias; int split_cols; size_t split_stride; float scale0;
    __device__ __forceinline__ void operator()(const f32x4 (&acc)[2][2][4][2], const Unit& u, int wr, int wc, int fr, int fq) const {
        const int row0 = u.pm * BM + wr * 64 + fr; int colt = u.pn * BM; bf16_t* base = O;
        float sc = 1.f; if (split_cols) { const int t = colt / split_cols; base += (size_t)t * split_stride; colt -= t * split_cols; if (t == 0) sc = scale0; }
        const int col0 = colt + wc * 32 + 8 * fq, bcol0 = u.pn * BM + wc * 32 + 8 * fq;
        f32x4 bv[2][2];
#pragma unroll
        for (int bj = 0; bj < 2; ++bj)
#pragma unroll
            for (int n = 0; n < 2; ++n) bv[bj][n] = bias ? *(const f32x4*)(bias + bcol0 + bj * HALF + 4 * n) : (f32x4){0.f, 0.f, 0.f, 0.f};
#pragma unroll
        for (int ai = 0; ai < 2; ++ai)
#pragma unroll
            for (int m = 0; m < 4; ++m) { bf16_t* rowp = base + (size_t)(row0 + ai * HALF + m * 16) * ldc + col0;
#pragma unroll
                for (int bj = 0; bj < 2; ++bj) { f32x4 v0 = acc[ai][bj][m][0] + bv[bj][0], v1 = acc[ai][bj][m][1] + bv[bj][1];
                    if (ACT == 1) { f32x2 a = gelu_pk((f32x2){v0[0], v0[1]}), b = gelu_pk((f32x2){v0[2], v0[3]}), c = gelu_pk((f32x2){v1[0], v1[1]}), d = gelu_pk((f32x2){v1[2], v1[3]});
                        v0 = (f32x4){a.x, a.y, b.x, b.y}; v1 = (f32x4){c.x, c.y, d.x, d.y}; }
                    v0 = v0 * sc; v1 = v1 * sc; u32x4 w; w.x = cvt_pk_bf16(v0[0], v0[1]); w.y = cvt_pk_bf16(v0[2], v0[3]); w.z = cvt_pk_bf16(v1[0], v1[1]); w.w = cvt_pk_bf16(v1[2], v1[3]);
                    *(u32x4*)(rowp + bj * HALF) = w; } }
    }
};
struct EpiF16 {
    static constexpr bool PERM = true, AFTER_DRAIN = false;
    _Float16* O; int ldc;
    __device__ __forceinline__ void operator()(const f32x4 (&acc)[2][2][4][2], const Unit& u, int wr, int wc, int fr, int fq) const {
        typedef _Float16 h8 __attribute__((ext_vector_type(8)));
        const int row0 = u.pm * BM + wr * 64 + fr, col0 = u.pn * BM + wc * 32 + 8 * fq;
#pragma unroll
        for (int ai = 0; ai < 2; ++ai)
#pragma unroll
            for (int m = 0; m < 4; ++m) { _Float16* rowp = O + (size_t)(row0 + ai * HALF + m * 16) * ldc + col0;
#pragma unroll
                for (int bj = 0; bj < 2; ++bj) { const f32x4 a = acc[ai][bj][m][0], b = acc[ai][bj][m][1];
                    h8 o; o[0] = (_Float16)a[0]; o[1] = (_Float16)a[1]; o[2] = (_Float16)a[2]; o[3] = (_Float16)a[3]; o[4] = (_Float16)b[0]; o[5] = (_Float16)b[1]; o[6] = (_Float16)b[2]; o[7] = (_Float16)b[3];
                    *(h8*)(rowp + bj * HALF) = o; } }
    }
};
struct EpiResid {
    static constexpr bool PERM = true, AFTER_DRAIN = false;
    const bf16_t* res; _Float16* Y; int ldc; float alpha;
    __device__ __forceinline__ void operator()(const f32x4 (&acc)[2][2][4][2], const Unit& u, int wr, int wc, int fr, int fq) const {
        const int row0 = u.pm * BM + wr * 64 + fr, col0 = u.pn * BM + wc * 32 + 8 * fq;
#pragma unroll
        for (int ai = 0; ai < 2; ++ai)
#pragma unroll
            for (int m = 0; m < 4; ++m) { const size_t off = (size_t)(row0 + ai * HALF + m * 16) * ldc + col0;
#pragma unroll
                for (int bj = 0; bj < 2; ++bj) { const u32x4 rv = *(const u32x4*)(res + off + bj * HALF);
                    f32x4 r0, r1; r0[0] = __uint_as_float(rv.x << 16); r0[1] = __uint_as_float(rv.x & 0xffff0000u); r0[2] = __uint_as_float(rv.y << 16); r0[3] = __uint_as_float(rv.y & 0xffff0000u);
                    r1[0] = __uint_as_float(rv.z << 16); r1[1] = __uint_as_float(rv.z & 0xffff0000u); r1[2] = __uint_as_float(rv.w << 16); r1[3] = __uint_as_float(rv.w & 0xffff0000u);
                    const f32x4 y0 = r0 * alpha + acc[ai][bj][m][0], y1 = r1 * alpha + acc[ai][bj][m][1];
                    typedef _Float16 h8 __attribute__((ext_vector_type(8))); h8 w; w[0] = (_Float16)y0[0]; w[1] = (_Float16)y0[1]; w[2] = (_Float16)y0[2]; w[3] = (_Float16)y0[3]; w[4] = (_Float16)y1[0]; w[5] = (_Float16)y1[1]; w[6] = (_Float16)y1[2]; w[7] = (_Float16)y1[3];
                    *(h8*)(Y + off + bj * HALF) = w; } }
    }
};
struct EpiPle {
    static constexpr bool PERM = true, AFTER_DRAIN = false;
    const bf16_t* R; _Float16* Y; const bf16_t* E; const float* gb; int ldc;
    __device__ __forceinline__ void operator()(const f32x4 (&acc)[2][2][4][2], const Unit& u, int wr, int wc, int fr, int fq) const {
        const int row0 = u.pm * BM + wr * 64 + fr, col0 = u.pn * BM + wc * 32 + 8 * fq;
        f32x4 bv[2][2];
#pragma unroll
        for (int bj = 0; bj < 2; ++bj)
#pragma unroll
            for (int n = 0; n < 2; ++n) bv[bj][n] = *(const f32x4*)(gb + col0 + bj * HALF + 4 * n);
#pragma unroll
        for (int ai = 0; ai < 2; ++ai)
#pragma unroll
            for (int m = 0; m < 4; ++m) { const size_t off = (size_t)(row0 + ai * HALF + m * 16) * ldc + col0;
#pragma unroll
                for (int bj = 0; bj < 2; ++bj) {
                    const u32x4 ev = *(const u32x4*)(E + off + bj * HALF), rv = *(const u32x4*)(R + off + bj * HALF);
                    float o[8];
#pragma unroll
                    for (int n = 0; n < 2; ++n) {
                        const f32x4 z = acc[ai][bj][m][n] + bv[bj][n];
                        const unsigned e0 = n == 0 ? ev.x : ev.z, e1 = n == 0 ? ev.y : ev.w, r0 = n == 0 ? rv.x : rv.z, r1 = n == 0 ? rv.y : rv.w;
                        f32x4 ee, rr; ee[0] = __uint_as_float(e0 << 16); ee[1] = __uint_as_float(e0 & 0xffff0000u); ee[2] = __uint_as_float(e1 << 16); ee[3] = __uint_as_float(e1 & 0xffff0000u);
                        rr[0] = __uint_as_float(r0 << 16); rr[1] = __uint_as_float(r0 & 0xffff0000u); rr[2] = __uint_as_float(r1 << 16); rr[3] = __uint_as_float(r1 & 0xffff0000u);
#pragma unroll
                        for (int i = 0; i < 4; ++i) o[4 * n + i] = rr[i] + ee[i] * __builtin_amdgcn_rcpf(1.0f + __expf(-z[i])); }
                    typedef _Float16 h8 __attribute__((ext_vector_type(8))); h8 w;
#pragma unroll
                    for (int i = 0; i < 8; ++i) w[i] = (_Float16)o[i];
                    *(h8*)(Y + off + bj * HALF) = w; } }
    }
};
template <class Epi, class Sched, bool ALIGN_EPI = false, bool SP2 = false>
__device__ __forceinline__ void gemm_phase(PG8_LAS unsigned char* lds, const Gemm g, const Sched& S, const Epi& E) {
    const int tid = tid_l(), wid = __builtin_amdgcn_readfirstlane(tid >> 6), lane = tid & 63, wr = wid >> 2, wc = wid & 3, fr = lane & 15, fq = lane >> 4;
    const int K = g.K, nt = K / BK;
    unsigned voffA[2], voffB[2];
#pragma unroll
    for (int i = 0; i < 2; ++i) { int R, C; stage_rc(tid * 16 + i * 8192, R, C); const int Rb = Epi::PERM ? ((R & ~31) + perm32(R & 31)) : R;
        voffA[i] = (unsigned)(R * K + C) * 2u; voffB[i] = (unsigned)(Rb * K + C) * 2u; }
    const size_t kstep = (size_t)(BK * 2);
    const size_t hstep = (size_t)HALF * K * 2;
    const size_t tstep = 2 * hstep;
    const unsigned ldsw = (unsigned)wid * 1024u;
    const int aoff = lds_byte(wr * 64 + fr, fq * 8), boff = lds_byte(wc * 32 + fr, fq * 8);
#define PG8_SA(b, h) (((b) * 2 + (h)) * HTB)
#define PG8_SB(b, h) ((4 + (b) * 2 + (h)) * HTB)
#define PG8_STAGE(bufoff, gbase, voff) do { _Pragma("unroll") for (int _i = 0; _i < 2; ++_i) \
        __builtin_amdgcn_global_load_lds((const unsigned*)((const char*)(gbase) + (voff)[_i]), (PG8_LAS unsigned*)(lds + (bufoff) + ldsw + _i * 8192), 16, 0, 0); } while (0)
#define PG8_LDA(dst, b, h) do { _Pragma("unroll") for (int m = 0; m < 4; ++m) _Pragma("unroll") for (int k = 0; k < 2; ++k) dst[m][k] = *(const PG8_LAS bf16x8*)(lds + PG8_SA(b, h) + aoff + m * 2048 + k * 1024); } while (0)
#define PG8_LDB(dst, b, h) do { _Pragma("unroll") for (int n = 0; n < 2; ++n) _Pragma("unroll") for (int k = 0; k < 2; ++k) dst[n][k] = *(const PG8_LAS bf16x8*)(lds + PG8_SB(b, h) + boff + n * 2048 + k * 1024); } while (0)
#define PG8_MMA(ai, bj, At, Bt) do { __builtin_amdgcn_s_setprio(1); _Pragma("unroll") for (int m = 0; m < 4; ++m) _Pragma("unroll") for (int n = 0; n < 2; ++n) _Pragma("unroll") for (int k = 0; k < 2; ++k) \
        acc[ai][bj][m][n] = __builtin_amdgcn_mfma_f32_16x16x32_bf16(Bt[n][k], At[m][k], acc[ai][bj][m][n], 0, 0, 0); __builtin_amdgcn_s_setprio(0); } while (0)
#define PG8_WAIT_V(n) asm volatile("s_waitcnt vmcnt(" #n ")" ::: "memory")
#define PG8_WAIT_L(n) asm volatile("s_waitcnt lgkmcnt(" #n ")" ::: "memory")
#define PG8_BAR __builtin_amdgcn_s_barrier()
#define PG8_SCHED __builtin_amdgcn_sched_barrier(0)
    Unit cur, nxt; int ui = 0;
    if (!S.next(0, cur)) return;
    f32x4 acc[2][2][4][2];
#pragma unroll
    for (int a = 0; a < 2; ++a)
#pragma unroll
        for (int b = 0; b < 2; ++b)
#pragma unroll
            for (int m = 0; m < 4; ++m)
#pragma unroll
                for (int n = 0; n < 2; ++n) acc[a][b][m][n] = (f32x4){0.f, 0.f, 0.f, 0.f};
    bf16x8 At[4][2], B0[2][2], B1[2][2];
    const char* cA = (const char*)g.A + (size_t)cur.pm * tstep; const char* cB = (const char*)g.Bt + (size_t)cur.pn * tstep;
    S.a_ready(cur);
    if constexpr (SP2) {
        PG8_STAGE(PG8_SB(0, 0), cB, voffB); PG8_STAGE(PG8_SB(0, 1), cB + hstep, voffB); PG8_STAGE(PG8_SA(0, 0), cA, voffA); PG8_STAGE(PG8_SA(0, 1), cA + hstep, voffA);
        if (wr == 1) PG8_BAR;
        PG8_WAIT_V(2); PG8_BAR;
        PG8_STAGE(PG8_SB(1, 0), cB + kstep, voffB); PG8_STAGE(PG8_SA(1, 0), cA + kstep, voffA); PG8_STAGE(PG8_SB(1, 1), cB + hstep + kstep, voffB);
        PG8_WAIT_V(6); PG8_BAR;
    } else {
        PG8_STAGE(PG8_SB(0, 0), cB, voffB); PG8_STAGE(PG8_SA(0, 0), cA, voffA); PG8_STAGE(PG8_SB(0, 1), cB + hstep, voffB); PG8_STAGE(PG8_SA(0, 1), cA + hstep, voffA);
        if (wr == 1) PG8_BAR;
        PG8_WAIT_V(4); PG8_BAR;
        PG8_STAGE(PG8_SB(1, 0), cB + kstep, voffB); PG8_STAGE(PG8_SA(1, 0), cA + kstep, voffA); PG8_STAGE(PG8_SB(1, 1), cB + hstep + kstep, voffB);
        PG8_WAIT_V(6); PG8_BAR;
    }
    for (;;) {
        const bool has_next = S.next(ui + 1, nxt);
        const char* nA = has_next ? (const char*)g.A + (size_t)nxt.pm * tstep : cA; const char* nB = has_next ? (const char*)g.Bt + (size_t)nxt.pn * tstep : cB;
        for (int t = 0; t < nt; t += 2) {
            const bool last = (t == nt - 2);
            const char* a1 = cA + (size_t)(t + 1) * kstep;
            const char* a2 = last ? nA : cA + (size_t)(t + 2) * kstep; const char* b2 = last ? nB : cB + (size_t)(t + 2) * kstep;
            const char* a3 = a2 + kstep; const char* b3 = b2 + kstep;
            if (last && has_next) S.a_ready(nxt);
            if constexpr (SP2) {
            PG8_LDB(B0, 0, 0); PG8_LDB(B1, 0, 1); PG8_SCHED; PG8_LDA(At, 0, 0); PG8_STAGE(PG8_SA(1, 1), a1 + hstep, voffA);
            PG8_WAIT_V(8); PG8_WAIT_L(0); PG8_BAR; PG8_MMA(0, 0, At, B0); PG8_MMA(0, 1, At, B1); PG8_BAR; PG8_SCHED;
            PG8_LDA(At, 0, 1); PG8_STAGE(PG8_SB(0, 0), b2, voffB); PG8_STAGE(PG8_SB(0, 1), b2 + hstep, voffB); PG8_STAGE(PG8_SA(0, 0), a2, voffA);
            PG8_WAIT_V(8); PG8_WAIT_L(0); PG8_BAR; PG8_MMA(1, 0, At, B0); PG8_MMA(1, 1, At, B1); PG8_BAR; PG8_SCHED;
            PG8_LDB(B0, 1, 0); PG8_LDB(B1, 1, 1); PG8_SCHED; PG8_LDA(At, 1, 0); PG8_STAGE(PG8_SA(0, 1), a2 + hstep, voffA);
            PG8_WAIT_V(8); PG8_WAIT_L(0); PG8_BAR; PG8_MMA(0, 0, At, B0); PG8_MMA(0, 1, At, B1); PG8_BAR; PG8_SCHED;
            PG8_LDA(At, 1, 1); PG8_STAGE(PG8_SB(1, 0), b3, voffB); PG8_STAGE(PG8_SB(1, 1), b3 + hstep, voffB); PG8_STAGE(PG8_SA(1, 0), a3, voffA);
            PG8_WAIT_V(8); PG8_WAIT_L(0); PG8_BAR; PG8_MMA(1, 0, At, B0); PG8_MMA(1, 1, At, B1); PG8_BAR; PG8_SCHED;
            } else {
            PG8_LDB(B0, 0, 0); PG8_SCHED; PG8_LDA(At, 0, 0); PG8_STAGE(PG8_SA(1, 1), a1 + hstep, voffA);
            PG8_WAIT_L(8); PG8_BAR; PG8_WAIT_L(0); PG8_MMA(0, 0, At, B0); PG8_BAR; PG8_SCHED;
            PG8_LDB(B1, 0, 1); PG8_STAGE(PG8_SB(0, 0), b2, voffB);
            PG8_BAR; PG8_WAIT_L(0); PG8_MMA(0, 1, At, B1); PG8_BAR;
            PG8_LDA(At, 0, 1); PG8_STAGE(PG8_SA(0, 0), a2, voffA);
            PG8_BAR; PG8_WAIT_L(0); PG8_MMA(1, 0, At, B0); PG8_BAR; PG8_SCHED;
            PG8_STAGE(PG8_SB(0, 1), b2 + hstep, voffB);
            PG8_WAIT_V(6); PG8_BAR; PG8_MMA(1, 1, At, B1); PG8_BAR;
            PG8_LDB(B0, 1, 0); PG8_SCHED; PG8_LDA(At, 1, 0); PG8_STAGE(PG8_SA(0, 1), a2 + hstep, voffA);
            PG8_WAIT_L(8); PG8_BAR; PG8_WAIT_L(0); PG8_MMA(0, 0, At, B0); PG8_BAR; PG8_SCHED;
            PG8_LDB(B1, 1, 1); PG8_STAGE(PG8_SB(1, 0), b3, voffB);
            PG8_BAR; PG8_WAIT_L(0); PG8_MMA(0, 1, At, B1); PG8_BAR;
            PG8_LDA(At, 1, 1); PG8_STAGE(PG8_SA(1, 0), a3, voffA);
            PG8_BAR; PG8_WAIT_L(0); PG8_MMA(1, 0, At, B0); PG8_BAR; PG8_SCHED;
            PG8_STAGE(PG8_SB(1, 1), b3 + hstep, voffB);
            PG8_WAIT_V(6); PG8_BAR; PG8_MMA(1, 1, At, B1); PG8_BAR;
            }
        }
        if constexpr (ALIGN_EPI) { if (wr == 0) PG8_BAR; }
        if constexpr (!Epi::AFTER_DRAIN) { E(acc, cur, wr, wc, fr, fq); S.done(cur); }
        if (!has_next) break;
#pragma unroll
        for (int a = 0; a < 2; ++a)
#pragma unroll
            for (int b = 0; b < 2; ++b)
#pragma unroll
                for (int m = 0; m < 4; ++m)
#pragma unroll
                    for (int n = 0; n < 2; ++n) acc[a][b][m][n] = (f32x4){0.f, 0.f, 0.f, 0.f};
        cur = nxt; cA = nA; cB = nB; ++ui;
        if constexpr (ALIGN_EPI) { if (wr == 1) PG8_BAR; }
    }
    PG8_WAIT_V(0);
    if constexpr (!ALIGN_EPI) { if (wr == 0) PG8_BAR; }
    PG8_BAR;
    if constexpr (Epi::AFTER_DRAIN) { E.fused(acc, cur, wr, wc, fr, fq, lds, wid, lane); S.done(cur); }
#undef PG8_SA
#undef PG8_SB
#undef PG8_STAGE
#undef PG8_LDA
#undef PG8_LDB
#undef PG8_MMA
#undef PG8_WAIT_V
#undef PG8_WAIT_L
#undef PG8_BAR
#undef PG8_SCHED
}
}
#include <hip/hip_bf16.h>
#include <cmath>
namespace attn_body {
using bf16=__hip_bfloat16;
using bf16x8=__attribute__((ext_vector_type(8)))short;
using s16x4=__attribute__((ext_vector_type(4)))short;
using f32x16=__attribute__((ext_vector_type(16)))float;
using u32x4=__attribute__((ext_vector_type(4)))unsigned;
constexpr int BATCH=8,NHEAD=6,SEQ=4096,D=64,KVP=3072,OP=1024;
constexpr int NW=8,QBLK=32,QB=QBLK*NW,KVBLK=64,NQB=SEQ/QB;
constexpr int ATTN_UNIT_ROWS=QB;
__device__ __forceinline__ int crow(int r,int hi){return (r&3)+8*(r>>2)+4*hi;}
#define SBAR() __builtin_amdgcn_sched_barrier(0)
__device__ __forceinline__ void cmask(f32x16&p0,f32x16&p1,int jb,int qrel,int hi){
  const float NEG=-INFINITY; int kb=64*jb+4*hi;
  #pragma unroll
  for(int r=0;r<16;++r){int kv=kb+(r&3)+8*(r>>2); if(kv>qrel)p0[r]=NEG; if(kv+32>qrel)p1[r]=NEG;}
}

constexpr int NSLOT=3, SLOTB=8192;
constexpr int LDS_K=0, LDS_V=NSLOT*SLOTB, LDS_WS=2*NSLOT*SLOTB, LDS_OST=LDS_WS+NW*64*4, LDS_CK=LDS_OST+NW*4096, LDS_BYTES=LDS_CK+SEQ*4;
constexpr float C2=0.125f*1.4426950408889634f;
__device__ __forceinline__ void glds16(const void*gsrc,unsigned lds_dst){unsigned keep;
  asm volatile("s_mov_b32 %0, m0\n\ts_mov_b32 m0, %2\n\ts_nop 0\n\tglobal_load_lds_dwordx4 %1, off\n\ts_mov_b32 m0, %0":"=&s"(keep):"v"(gsrc),"s"(lds_dst):"memory");}
__device__ __forceinline__ float max3f(float a,float b,float c){float r;asm("v_max3_f32 %0, %1, %2, %3":"=v"(r):"v"(a),"v"(b),"v"(c));return r;}
__device__ __forceinline__ float max2f(float a,float b){float r;asm("v_max_f32_e32 %0, %1, %2":"=v"(r):"v"(a),"v"(b));return r;}
__device__ __forceinline__ float fadd_s(float a,float b){float r;asm("v_add_f32_e32 %0, %1, %2":"=v"(r):"v"(a),"v"(b));return r;}
__device__ __forceinline__ float fsub_s(float a,float b){float r;asm("v_sub_f32_e32 %0, %1, %2":"=v"(r):"v"(a),"v"(b));return r;}
typedef float f32x2_t __attribute__((ext_vector_type(2))); typedef float f32x4_t __attribute__((ext_vector_type(4))); typedef __bf16 bf16x2_t __attribute__((ext_vector_type(2)));
__device__ __forceinline__ unsigned cvtpk_s(float lo,float hi){f32x2_t v={lo,hi};bf16x2_t b=__builtin_convertvector(v,bf16x2_t);return __builtin_bit_cast(unsigned,b);}
#define WAIT_BAR(N) asm volatile("s_waitcnt vmcnt(" #N ") lgkmcnt(0)\n\ts_barrier":::"memory")

__device__ __forceinline__ void qkt(f32x16&p0,f32x16&p1,const char*Kslot,const bf16x8*qr,int r32,int hi){
  const char*kb=Kslot+hi*1024+r32*16;
  #pragma unroll
  for(int d0=0;d0<4;++d0){
    const bf16x8 b0=*reinterpret_cast<const bf16x8*>(kb+d0*2048);
    const bf16x8 b1=*reinterpret_cast<const bf16x8*>(kb+d0*2048+512);
    {p0=__builtin_amdgcn_mfma_f32_32x32x16_bf16(b0,qr[d0],p0,0,0,0);p1=__builtin_amdgcn_mfma_f32_32x32x16_bf16(b1,qr[d0],p1,0,0,0);}}
}
typedef __attribute__((address_space(3))) const char* lds_cptr;
typedef short v4i16_t __attribute__((ext_vector_type(4)));
__device__ __forceinline__ void kload8(bf16x8*kf,lds_cptr kp){
  kf[0]=*(const __attribute__((address_space(3))) bf16x8*)(kp);      kf[1]=*(const __attribute__((address_space(3))) bf16x8*)(kp+512);
  kf[2]=*(const __attribute__((address_space(3))) bf16x8*)(kp+2048); kf[3]=*(const __attribute__((address_space(3))) bf16x8*)(kp+2560);
  kf[4]=*(const __attribute__((address_space(3))) bf16x8*)(kp+4096); kf[5]=*(const __attribute__((address_space(3))) bf16x8*)(kp+4608);
  kf[6]=*(const __attribute__((address_space(3))) bf16x8*)(kp+6144); kf[7]=*(const __attribute__((address_space(3))) bf16x8*)(kp+6656);
}
__device__ __forceinline__ void kload2(bf16x8*kf,lds_cptr kp,int j){ kf[2*j]=*(const __attribute__((address_space(3))) bf16x8*)(kp+j*2048); kf[2*j+1]=*(const __attribute__((address_space(3))) bf16x8*)(kp+j*2048+512); }
__device__ __forceinline__ s16x4 vtr(lds_cptr p){ return __builtin_bit_cast(s16x4,__builtin_amdgcn_ds_read_tr16_b64_v4i16((__attribute__((address_space(3))) v4i16_t*)p)); }
__device__ __forceinline__ float rowmax(const f32x16&p0,const f32x16&p1){
  float a=max3f(p0[0],p0[1],p1[0]),b=max3f(p0[2],p0[3],p1[1]);a=max3f(a,p1[2],p1[3]);
  #pragma unroll
  for(int r=4;r<16;r+=4){a=max3f(a,p0[r],p0[r+1]);b=max3f(b,p0[r+2],p0[r+3]);a=max3f(a,p1[r],p1[r+1]);b=max3f(b,p1[r+2],p1[r+3]);}
  const float m=max2f(a,b);
  auto rr=__builtin_amdgcn_permlane32_swap(__float_as_uint(m),__float_as_uint(m),false,false);
  return max2f(__uint_as_float(rr[0]),__uint_as_float(rr[1]));
}
__device__ __forceinline__ void pv(f32x16*o,int vb,bf16x8 pa0,bf16x8 pa1,bf16x8 pa2,bf16x8 pa3){
  #pragma unroll
  for(int d0=0;d0<2;++d0){s16x4 lo[4],hi[4];
    #pragma unroll
    for(int ks=0;ks<4;++ks){
      asm volatile("ds_read_b64_tr_b16 %0,%1 offset:%c2":"=&v"(lo[ks]):"v"(vb),"i"(d0*4096+ks*1024):"memory");
      asm volatile("ds_read_b64_tr_b16 %0,%1 offset:%c2":"=&v"(hi[ks]):"v"(vb),"i"(d0*4096+ks*1024+512):"memory");}
    asm volatile("s_waitcnt lgkmcnt(0)":::"memory");SBAR();
    #define PK(k) (bf16x8){lo[k][0],lo[k][1],lo[k][2],lo[k][3],hi[k][0],hi[k][1],hi[k][2],hi[k][3]}
    o[d0]=__builtin_amdgcn_mfma_f32_32x32x16_bf16(pa0,PK(0),o[d0],0,0,0);
    o[d0]=__builtin_amdgcn_mfma_f32_32x32x16_bf16(pa1,PK(1),o[d0],0,0,0);
    o[d0]=__builtin_amdgcn_mfma_f32_32x32x16_bf16(pa2,PK(2),o[d0],0,0,0);
    o[d0]=__builtin_amdgcn_mfma_f32_32x32x16_bf16(pa3,PK(3),o[d0],0,0,0);
    #undef PK
  }
}

#ifndef ATTN_STORE16
#define ATTN_STORE16(p,v) (*(u32x4*)(p)=(v))
#endif
template<int THRL> __device__ __forceinline__ void attn_unit(int b,int h,int qb,const bf16*Q,const bf16*__restrict__ K,const bf16*__restrict__ V,bf16*O,const float*__restrict__ CKg,const float*__restrict__ KTm,const float*__restrict__ QBm,char*shm){
  const int tid=tid_l(),lane=tid&63,r32=lane&31,hi=lane>>5; const int wid=__builtin_amdgcn_readfirstlane(tid>>6);
  const long rowbase=(long)b*SEQ; const int q0=qb*QB;
  const bf16*Qw=Q+(rowbase+q0+wid*QBLK)*KVP+h*D;
  const float*ckg=CKg+(long)(b*NHEAD+h)*SEQ;
  int j0=0;
  { const int bh_=b*NHEAD+h, NT0_=(q0+QB)/KVBLK; const float qmx=QBm[bh_*NQB+qb]*1.01f;
    const float kd=fmaxf(fmaxf(KTm[bh_*64+4*qb],KTm[bh_*64+4*qb+1]),fmaxf(KTm[bh_*64+4*qb+2],KTm[bh_*64+4*qb+3]));
    const float thr=-(qmx*kd)-48.f; bool skip=false;
    if(lane<NT0_-4){ const float bound=qmx*KTm[bh_*64+lane]+(ckg[q0]-ckg[64*lane+63]); skip=bound<thr; }
    const unsigned long long m_=__ballot(skip); j0=__builtin_ctzll(~m_); j0=(j0<NT0_-4?j0:NT0_-4)&~1; j0=__builtin_amdgcn_readfirstlane(j0); }
  const bf16*Kh=K+(rowbase+(long)j0*KVBLK)*KVP+h*D,*Vh=V+(rowbase+(long)j0*KVBLK)*KVP+h*D;
  const unsigned lds0=(unsigned)(uintptr_t)shm;
  float*wsf=(float*)(shm+LDS_WS)+wid*64;
  const bf16*ksrc=Kh+(long)lane*KVP+wid*8;
  const bf16*vsrc=Vh+(long)(16*(wid&3)+(lane>>2))*KVP+(wid>>2)*32+(lane&3)*8;
  const unsigned kdst=lds0+LDS_K+wid*1024, vdst=lds0+LDS_V+wid*1024;
  #define DMA_K(t,slot) glds16(ksrc+(long)(t)*KVBLK*KVP,(unsigned)__builtin_amdgcn_readfirstlane(kdst+(slot)))
  #define DMA_V(t,slot) glds16(vsrc+(long)(t)*KVBLK*KVP,(unsigned)__builtin_amdgcn_readfirstlane(vdst+(slot)))
  const int vb0=(int)(lds0+LDS_V)+((lane>>4)&1)*32+(lane&3)*8+(4*hi+((lane&15)>>2))*64;
  const char*Kbase=shm+LDS_K; bf16x8 kf[8];
  const lds_cptr shm3=(lds_cptr)shm; const lds_cptr kp0=shm3+LDS_K+hi*1024+r32*16; const lds_cptr vp0=shm3+LDS_V+((lane>>4)&1)*32+(lane&3)*8+(4*hi+((lane&15)>>2))*64;
  const int NT=(q0+QB)/KVBLK-j0;
  float*cks=(float*)(shm+LDS_CK);
  for(int i=j0*KVBLK+tid*4;i<q0+QB;i+=NW*64*4){ *(f32x4_t*)(cks+i)=*(const f32x4_t*)(ckg+i); }
  float cqm=ckg[q0+wid*QBLK+r32];
  const lds_cptr ckp=(lds_cptr)shm+LDS_CK+j0*256+hi*16;
  DMA_K(0,0);DMA_V(0,0);DMA_K(1,SLOTB);
  bf16x8 qr[4];
  #pragma unroll
  for(int d0=0;d0<4;++d0)qr[d0]=*reinterpret_cast<const bf16x8*>(&Qw[(long)r32*KVP+d0*16+hi*8]);
  float l_reg=0.f;f32x16 o[2];o[0]=f32x16{};o[1]=f32x16{};
  #define CINIT(C0,C1,t) do{ const lds_cptr cp_=ckp+(t)*256; \
    _Pragma("unroll") for(int g_=0;g_<4;++g_){ const f32x4_t a_=*(const __attribute__((address_space(3))) f32x4_t*)(cp_+g_*32); const f32x4_t b_=*(const __attribute__((address_space(3))) f32x4_t*)(cp_+g_*32+128); \
      _Pragma("unroll") for(int i_=0;i_<4;++i_){ C0[g_*4+i_]=cqm-a_[i_]; C1[g_*4+i_]=cqm-b_[i_]; } } }while(0)
  const int qrel=wid*QBLK+r32;
  #define CMASK(P0,P1,t) do{int jb_=(t)-(NT-4); if(jb_>=0)cmask(P0,P1,jb_,qrel,hi);}while(0)
  bool resc=false;
  #define START(P0,P1) do{ const float rm=rowmax(P0,P1); resc=false; \
    { const float dl=rm; \
      _Pragma("unroll") for(int r=0;r<16;++r){P0[r]=fsub_s(P0[r],dl);P1[r]=fsub_s(P1[r],dl);} \
      cqm=fsub_s(cqm,dl); } \
    _Pragma("unroll") for(int r=0;r<16;++r)P0[r]=__builtin_amdgcn_exp2f(P0[r]); }while(0)
  #define RESC() do{ if(resc){ asm volatile("s_waitcnt lgkmcnt(0)":::"memory"); \
      _Pragma("unroll") for(int d_=0;d_<2;++d_) _Pragma("unroll") for(int r=0;r<16;++r)o[d_][r]*=wsf[crow(r,hi)]; } }while(0)
  f32x16 pA0,pA1,pB0,pB1;
  int sl_prev=0,sl_cur=0,sl_next=SLOTB;
  #define ROT() do{sl_prev=sl_cur;sl_cur=sl_next;sl_next=(sl_next==(NSLOT-1)*SLOTB)?0:sl_next+SLOTB;}while(0)
  DMA_K(2,2*SLOTB);
  WAIT_BAR(3);
  CINIT(pA0,pA1,0);
  qkt(pA0,pA1,Kbase,qr,r32,hi);asm volatile("s_nop 15\n\ts_nop 7":"+v"(pA0),"+v"(pA1));CMASK(pA0,pA1,0);
  START(pA0,pA1);
  _Pragma("unroll") for(int r=0;r<16;++r)pA1[r]=__builtin_amdgcn_exp2f(pA1[r]);
  WAIT_BAR(0);
  DMA_K(3,0);DMA_V(1,SLOTB);
  ROT();
  kload8(kf,kp0+sl_cur);
  WAIT_BAR(2);
  s16x4 vlo[8],vhi[8]; u32x4 pw0,pw1,pw2,pw3;
  #define PKW(P,B) cvtpk_s(P[B],P[B+1])
  #define PAF(k) __builtin_bit_cast(bf16x8,pw##k)
  #define VFR(i) (bf16x8){vlo[i][0],vlo[i][1],vlo[i][2],vlo[i][3],vhi[i][0],vhi[i][1],vhi[i][2],vhi[i][3]}
  #define PIN(x) asm volatile("":"+v"(x))
  #define MX3(a,b,c) __builtin_fmaxf(__builtin_fmaxf((a),(b)),(c))
  #define GAPA(MF,A0,A1,A2,A3,W0,W1,PW) do{ MF; sacc+=A0; sacc+=A1; sacc+=A2; sacc+=A3; PIN(sacc); W0; W1; PIN(PW); SBAR(); }while(0)
  #define EX(v) __builtin_amdgcn_exp2f(v)
  #define GAPB(MF,X,B) do{ MF; X[B]=EX(X[B]); X[B+1]=EX(X[B+1]); X[B+2]=EX(X[B+2]); X[B+3]=EX(X[B+3]); PIN(X); SBAR(); }while(0)
  #define VRD(i) do{ vlo[i]=vtr(vp_+(((i)>>2)*4096+((i)&3)*1024)); vhi[i]=vtr(vp_+(((i)>>2)*4096+((i)&3)*1024+512)); }while(0)
  #define KRD(G,j) do{ if(G){ kload2(kf,kp0+sl_next,j); SBAR(); } }while(0)
  #define STEP(C0,C1,P0,P1,t,GK,GV,GL) do{ SBAR(); \
    CINIT(C0,C1,t); SBAR(); \
    const lds_cptr vp_=vp0+sl_prev; \
    VRD(0); SBAR(); float sacc=(P0[0]+P0[1]); \
    GAPA(C0=__builtin_amdgcn_mfma_f32_32x32x16_bf16(kf[0],qr[0],C0,0,0,0), P0[2],P0[3],P0[4],P0[5],     pw0[0]=PKW(P0,0), pw0[1]=PKW(P0,2), pw0); \
    VRD(4); SBAR(); GAPA(C1=__builtin_amdgcn_mfma_f32_32x32x16_bf16(kf[1],qr[0],C1,0,0,0), P0[6],P0[7],P0[8],P0[9],     pw0[2]=PKW(P0,4), pw0[3]=PKW(P0,6), pw0); \
    VRD(1); SBAR(); GAPA(C0=__builtin_amdgcn_mfma_f32_32x32x16_bf16(kf[2],qr[1],C0,0,0,0),   P0[10],P0[11],P0[12],P0[13], pw1[0]=PKW(P0,8), pw1[1]=PKW(P0,10), pw1); \
    VRD(5); SBAR(); GAPA(C1=__builtin_amdgcn_mfma_f32_32x32x16_bf16(kf[3],qr[1],C1,0,0,0),   P0[14],P0[15],P1[0],P1[1],   pw1[2]=PKW(P0,12),pw1[3]=PKW(P0,14), pw1); \
    VRD(2); SBAR(); GAPA(C0=__builtin_amdgcn_mfma_f32_32x32x16_bf16(kf[4],qr[2],C0,0,0,0),   P1[2],P1[3],P1[4],P1[5],     pw2[0]=PKW(P1,0), pw2[1]=PKW(P1,2), pw2); \
    VRD(6); SBAR(); GAPA(C1=__builtin_amdgcn_mfma_f32_32x32x16_bf16(kf[5],qr[2],C1,0,0,0),   P1[6],P1[7],P1[8],P1[9],     pw2[2]=PKW(P1,4), pw2[3]=PKW(P1,6), pw2); \
    VRD(3); SBAR(); GAPA(C0=__builtin_amdgcn_mfma_f32_32x32x16_bf16(kf[6],qr[3],C0,0,0,0),   P1[10],P1[11],P1[12],P1[13], pw3[0]=PKW(P1,8), pw3[1]=PKW(P1,10), pw3); \
    VRD(7); SBAR(); GAPA(C1=__builtin_amdgcn_mfma_f32_32x32x16_bf16(kf[7],qr[3],C1,0,0,0),   P1[14],P1[15],0.f,0.f,       pw3[2]=PKW(P1,12),pw3[3]=PKW(P1,14), pw3); \
    l_reg+=sacc; \
    if(GK){DMA_K((t)+3,sl_cur);} if(GV){DMA_V((t)+1,sl_next);} \
    CMASK(C0,C1,t); \
    { float a=MX3(C0[0],C0[1],C1[0]),b=MX3(C0[2],C0[3],C1[1]); a=MX3(a,C1[2],C1[3]); \
      _Pragma("unroll") for(int r=4;r<16;r+=4){a=MX3(a,C0[r],C0[r+1]);b=MX3(b,C0[r+2],C0[r+3]);a=MX3(a,C1[r],C1[r+1]);b=MX3(b,C1[r+2],C1[r+3]);} \
      float rm=__builtin_fmaxf(a,b); { auto rr=__builtin_amdgcn_permlane32_swap(__float_as_uint(rm),__float_as_uint(rm),false,false); rm=__builtin_fmaxf(__uint_as_float(rr[0]),__uint_as_float(rr[1])); } \
      resc=false; \
      if(__builtin_expect(__any(rm>(float)THRL),0)){ const float dl=__builtin_fmaxf(rm,0.f); \
        _Pragma("unroll") for(int r=0;r<16;++r){C0[r]-=dl;C1[r]-=dl;} \
        cqm-=dl; \
        const float f=__builtin_amdgcn_exp2f(-dl); l_reg*=f; if(hi==0)wsf[r32]=f; resc=true; } } \
    SBAR(); \
    GAPB(o[0]=__builtin_amdgcn_mfma_f32_32x32x16_bf16(PAF(0),VFR(0),o[0],0,0,0), C0,0); \
    GAPB(o[1]=__builtin_amdgcn_mfma_f32_32x32x16_bf16(PAF(0),VFR(4),o[1],0,0,0), C0,4); \
    KRD(GL,0); GAPB(o[0]=__builtin_amdgcn_mfma_f32_32x32x16_bf16(PAF(1),VFR(1),o[0],0,0,0), C0,8); \
    KRD(GL,1); GAPB(o[1]=__builtin_amdgcn_mfma_f32_32x32x16_bf16(PAF(1),VFR(5),o[1],0,0,0), C0,12); \
    KRD(GL,2); GAPB(o[0]=__builtin_amdgcn_mfma_f32_32x32x16_bf16(PAF(2),VFR(2),o[0],0,0,0), C1,0); \
    KRD(GL,3); GAPB(o[1]=__builtin_amdgcn_mfma_f32_32x32x16_bf16(PAF(2),VFR(6),o[1],0,0,0), C1,4); \
    GAPB(o[0]=__builtin_amdgcn_mfma_f32_32x32x16_bf16(PAF(3),VFR(3),o[0],0,0,0), C1,8); \
    GAPB(o[1]=__builtin_amdgcn_mfma_f32_32x32x16_bf16(PAF(3),VFR(7),o[1],0,0,0), C1,12); \
    }while(0)
  int t=1;
  #undef CMASK
  #define CMASK(P0,P1,t) do{}while(0)
  for(;t+5<NT;t+=2){
    STEP(pB0,pB1,pA0,pA1,t,true,true,true);     WAIT_BAR(2); RESC(); ROT();
    STEP(pA0,pA1,pB0,pB1,t+1,true,true,true);   WAIT_BAR(2); RESC(); ROT();
  }
  #undef CMASK
  #define CMASK(P0,P1,t) do{int jb_=(t)-(NT-4); if(jb_>=0)cmask(P0,P1,jb_,qrel,hi);}while(0)
  #define ENDW(tt) do{ if((tt)+3<NT){WAIT_BAR(2);} else if((tt)+2<NT){WAIT_BAR(1);} else {WAIT_BAR(0);} }while(0)
  for(;t+1<NT;t+=2){
    STEP(pB0,pB1,pA0,pA1,t,(t+3<NT),(t+1<NT),(t+1<NT));       ENDW(t);   RESC(); ROT();
    STEP(pA0,pA1,pB0,pB1,t+1,(t+4<NT),(t+2<NT),(t+2<NT));     ENDW(t+1); RESC(); ROT();
  }
  STEP(pB0,pB1,pA0,pA1,NT-1,false,false,false); RESC();
  { float sacc=pB0[0]+pB0[1]; _Pragma("unroll") for(int r=2;r<16;++r)sacc+=pB0[r]; _Pragma("unroll") for(int r=0;r<16;++r)sacc+=pB1[r]; l_reg+=sacc;
    pw0=(u32x4){PKW(pB0,0),PKW(pB0,2),PKW(pB0,4),PKW(pB0,6)};pw1=(u32x4){PKW(pB0,8),PKW(pB0,10),PKW(pB0,12),PKW(pB0,14)};pw2=(u32x4){PKW(pB1,0),PKW(pB1,2),PKW(pB1,4),PKW(pB1,6)};pw3=(u32x4){PKW(pB1,8),PKW(pB1,10),PKW(pB1,12),PKW(pB1,14)};
    SBAR(); pv(o,vb0+sl_cur,PAF(0),PAF(1),PAF(2),PAF(3)); }
  #undef PKW
  #undef PAF
  #undef VFR
  #undef PIN
  #undef MX3
  #undef GAPA
  #undef GAPB
  #undef EX
  #undef VRD
  #undef KRD
  #undef STEP
  #undef ENDW
  {auto rr=__builtin_amdgcn_permlane32_swap(__float_as_uint(l_reg),__float_as_uint(l_reg),false,false);l_reg=__uint_as_float(rr[0])+__uint_as_float(rr[1]);}
  if(hi==0)wsf[32+r32]=l_reg;asm volatile("s_waitcnt lgkmcnt(0)":::"memory");
  float rli[16];
  #pragma unroll
  for(int r=0;r<16;++r)rli[r]=__builtin_amdgcn_rcpf(wsf[32+crow(r,hi)]);
  bf16*Ow=O+(rowbase+q0+wid*QBLK)*OP+h*D;
  { bf16*stg=(bf16*)(shm+LDS_OST)+wid*2048;
    #pragma unroll
    for(int r=0;r<16;++r){const int orow=crow(r,hi);
      #pragma unroll
      for(int d0=0;d0<2;++d0)stg[orow*64+d0*32+r32]=__float2bfloat16(o[d0][r]*rli[r]);}
    asm volatile("s_waitcnt lgkmcnt(0)":::"memory");
    #pragma unroll
    for(int i=0;i<4;++i){const int row=i*8+(lane>>3),ch=lane&7; const u32x4 v=*(const u32x4*)(stg+row*64+ch*8); ATTN_STORE16(Ow+(long)row*OP+ch*8,v);} }
  asm volatile("s_waitcnt lgkmcnt(0)\n\ts_barrier":::"memory");
  #undef DMA_K
  #undef DMA_V
  #undef CMASK
  #undef START
  #undef RESC
  #undef ROT
  #undef CINIT
}
constexpr int ATTN_LDS_BYTES=LDS_BYTES;
struct AttnTensors { const bf16* Q; const bf16* K; const bf16* V; bf16* O; const float* CK; const float* KT; const float* QB; };
struct AttnUnit { int bh; int qb; };
struct QueueOrder {
  unsigned* head; volatile __attribute__((address_space(3))) int* slot;
  __device__ __forceinline__ bool next(int,AttnUnit&u)const{
    if(tid_l()==0) *slot=(int)__hip_atomic_fetch_add(head,1u,__ATOMIC_RELAXED,__HIP_MEMORY_SCOPE_AGENT);
    __syncthreads(); const int v=*slot; __syncthreads();
    if(v>=BATCH*NHEAD*NQB)return false; u.qb=NQB-1-v/(BATCH*NHEAD); u.bh=v%(BATCH*NHEAD); return true; }
  __device__ __forceinline__ void a_ready(const AttnUnit&)const{}
  __device__ __forceinline__ void done(const AttnUnit&)const{}
};
template<class Sched,int THRL=8> __device__ __forceinline__ void attn_phase(char*lds,const AttnTensors&T,const Sched&S){
  AttnUnit u;
  for(int i=0;S.next(i,u);++i){ S.a_ready(u); attn_unit<THRL>(u.bh/NHEAD,u.bh%NHEAD,u.qb,T.Q,T.K,T.V,T.O,T.CK,T.KT,T.QB,lds); S.done(u); }
}
#undef SBAR
#undef WAIT_BAR
}

constexpr int NB = 8, SEQ = 4096, T = NB * SEQ, D = 1024, DEPTH = 4;
constexpr int HCOLS = 3072;
constexpr int HC_AVAL = 0, HC_AGATE = 256, HC_BQ = 512, HC_BK = 704, HC_BV = 896, HC_BG = 1280, HC_CQ = 1664, HC_CK = 2048, HC_CV = 2432, HC_LR = 2816, HC_CF = 2832;
constexpr int IN_COLS = 2838;
constexpr int MC_A = 0, MC_B = 256, MC_C = 640;
constexpr float LN_EPS = 1e-5f;
constexpr float ALPHA = 1.6817928305074292f;
constexpr float LOG2E = 1.4426950408889634f;
constexpr float C2 = 0.125f * LOG2E;
constexpr float GLA_QSCALE = 0.17677669529663687f;
constexpr int NEXP = 16384;

constexpr size_t MiB = 1u << 20;
constexpr size_t WS_CTL = 0, CTL_ZERO_BYTES = 1 * MiB;
constexpr size_t WS_WIN = 1 * MiB;
constexpr size_t WS_WOUT = WS_WIN + 24 * MiB;
constexpr size_t WS_WP = WS_WOUT + 8 * MiB;
constexpr size_t WS_PGW = WS_WP + 16 * MiB;
constexpr size_t WS_PW = WS_PGW + 8 * MiB;
constexpr size_t WS_CK = WS_PW + 2 * MiB;
constexpr size_t WS_FKT = WS_CK + 768 * 1024, WS_FQB = WS_FKT + 16 * 1024;
constexpr size_t WS_U = WS_CK + 1 * MiB;
constexpr size_t WS_V = WS_U + 32 * MiB;
constexpr size_t WS_XB = WS_V + 32 * MiB;
constexpr size_t WS_XF = WS_XB + 64 * MiB;
constexpr size_t WS_XQ = WS_XF, WS_XS = WS_XF + 32 * MiB, WS_RS = WS_XS + 1 * MiB;
constexpr size_t WS_PB = WS_XF + 128 * MiB;
constexpr size_t WS_H = WS_PB + 16 * MiB;
constexpr size_t WS_MIX = WS_H + 192 * MiB;
constexpr size_t WS_SC = WS_H;
constexpr size_t WS_Y = WS_MIX + 64 * MiB;
constexpr size_t WS_GCUM = WS_Y;
constexpr size_t WS_GS = WS_GCUM + 24 * MiB;
constexpr size_t WS_GDEC = WS_GS + 24 * MiB;
constexpr size_t WS_E = WS_Y + 128 * MiB;
constexpr size_t WS_EIDX = WS_E + 64 * MiB;
constexpr size_t WS_GATE = WS_EIDX + 16 * MiB;
constexpr size_t WS_SOFF = WS_GATE + 16 * MiB;
constexpr size_t WS_END = WS_SOFF + 1 * MiB;
static_assert(WS_END <= 1024 * MiB, "d_ws map");

constexpr int LDS_BYTES = 147456;

typedef unsigned short bf16;
typedef float f32x4 __attribute__((ext_vector_type(4)));
typedef unsigned u32x4 __attribute__((ext_vector_type(4)));
typedef unsigned u32x2 __attribute__((ext_vector_type(2)));

struct Params {
    const float *x, *p, *w_in, *conv_w, *conv_b, *conv_ln_g, *conv_ln_b, *gla_gate_w, *gla_gate_b, *gla_norm_g, *fox_forget_b, *w_out, *ln1_g, *ln1_b,
        *peer_wq, *peer_keys, *peer_u, *peer_v, *ple_w, *ple_gw, *ple_gb, *ln2_g, *ln2_b;
    float* out; unsigned char* ws;
};

__device__ __forceinline__ float bf2f(unsigned h) { return __uint_as_float(h << 16); }
__device__ __forceinline__ unsigned f2bf(float f) { unsigned u = __float_as_uint(f); return (u + 0x7fffu + ((u >> 16) & 1u)) >> 16; }
__device__ __forceinline__ unsigned pk2(float lo, float hi) { return f2bf(lo) | (f2bf(hi) << 16); }
__device__ __forceinline__ float wave_sum(float v) {
#pragma unroll
    for (int o = 1; o < 64; o <<= 1) v += __shfl_xor(v, o);
    return v;
}
__device__ __forceinline__ float log_sigmoid(float z) { return fminf(z, 0.f) - log1pf(__expf(-fabsf(z))); }
__device__ __forceinline__ float sigmoidf_(float z) { return 1.0f / (1.0f + __expf(-z)); }

struct MapIdent { __device__ __forceinline__ void operator()(int n, int& c, float& s) const { c = n; s = 1.f; } };
struct MapWin {
    __device__ __forceinline__ void operator()(int n, int& c, float& s) const {
        s = 1.f;
        if (n < HC_CQ) { c = n; if (n >= HC_BQ && n < HC_BK) s = GLA_QSCALE; }
        else if (n < HC_LR) { c = n + 16; if (n < HC_CK) s = C2; }
        else if (n < HC_CF) c = n - HC_LR + 1664;
        else if (n < IN_COLS) c = n;
        else c = -1;
    }
};
template <class CM>
__device__ __forceinline__ void transpose_item(const float* W, int K, int Nsrc, bf16* WT, int item, int nblk, float* scr, int lane, const CM& cm) {
    const int kb = item / nblk, nb = item % nblk, k0 = 64 * kb, n0 = 32 * nb;
    int sc; float scale; cm(n0 + (lane & 31), sc, scale);
#pragma unroll 8
    for (int i = 0; i < 32; ++i) { const int kk = 2 * i + (lane >> 5); scr[kk * 33 + (lane & 31)] = sc >= 0 ? W[(size_t)(k0 + kk) * Nsrc + sc] * scale : 0.f; }
    __builtin_amdgcn_wave_barrier(); asm volatile("s_waitcnt lgkmcnt(0)" ::: "memory");
    const int c = lane & 7;
#pragma unroll
    for (int j = 0; j < 4; ++j) { const int n = (lane >> 3) + 8 * j; const float* s = scr + (8 * c) * 33 + n;
        u32x4 o; o.x = pk2(s[0 * 33], s[1 * 33]); o.y = pk2(s[2 * 33], s[3 * 33]); o.z = pk2(s[4 * 33], s[5 * 33]); o.w = pk2(s[6 * 33], s[7 * 33]);
        *(u32x4*)(WT + (size_t)(n0 + n) * K + k0 + 8 * c) = o; }
    asm volatile("s_waitcnt lgkmcnt(0)" ::: "memory"); __builtin_amdgcn_wave_barrier();
}
__device__ __forceinline__ void cvt_bf16_stream(const float* src, bf16* dst, size_t n8, size_t gtid, size_t gthreads) {
    for (size_t i = gtid; i < n8; i += gthreads) { const f32x4 a = *(const f32x4*)(src + i * 8), b = *(const f32x4*)(src + i * 8 + 4);
        u32x4 o; o.x = pk2(a[0], a[1]); o.y = pk2(a[2], a[3]); o.z = pk2(b[0], b[1]); o.w = pk2(b[2], b[3]); *(u32x4*)(dst + i * 8) = o; }
}

__device__ __forceinline__ void phase_pro_a(const Params& p, unsigned char* lds) {
    const int tid = tid_l(), lane = tid & 63, wave = tid >> 6;
    float* scr = (float*)(lds + wave * 16384);
    const int gw = bid_l() * 8 + wave, NGW = grid_l() * 8;
    constexpr int I_WIN = (D / 64) * (HCOLS / 32), I_SQ = (D / 64) * (D / 32), I_PW = (256 / 64) * (D / 32);
    constexpr int PER_L = I_WIN + 2 * I_SQ + I_PW;
    for (int it = gw; it < DEPTH * PER_L; it += NGW) {
        const int l = it / PER_L; int r = it % PER_L;
        if (r < I_WIN) { transpose_item(p.w_in + (size_t)l * D * IN_COLS, D, IN_COLS, (bf16*)(p.ws + WS_WIN) + (size_t)l * HCOLS * D, r, HCOLS / 32, scr, lane, MapWin()); continue; } r -= I_WIN;
        if (r < I_SQ) { transpose_item(p.w_out + (size_t)l * D * D, D, D, (bf16*)(p.ws + WS_WOUT) + (size_t)l * D * D, r, D / 32, scr, lane, MapIdent()); continue; } r -= I_SQ;
        if (r < I_SQ) { transpose_item(p.ple_gw + (size_t)l * D * D, D, D, (bf16*)(p.ws + WS_PGW) + (size_t)l * D * D, r, D / 32, scr, lane, MapIdent()); continue; } r -= I_SQ;
        transpose_item(p.ple_w + (size_t)l * 256 * D, 256, D, (bf16*)(p.ws + WS_PW) + (size_t)l * D * 256, r, D / 32, scr, lane, MapIdent());
    }
    cvt_bf16_stream(p.x, (bf16*)(p.ws + WS_XB), (size_t)T * D / 8, (size_t)bid_l() * 512 + tid, (size_t)grid_l() * 512);
}
__device__ __forceinline__ void phase_pro_b(const Params& p, unsigned char* lds) {
    const int tid = tid_l();
    float* ks = (float*)lds;
    float* wqs = ks + 128 * 129;
    for (int it = bid_l(); it < DEPTH * 16 * 16; it += grid_l()) {
        const int l = it >> 8, hc = (it >> 4) & 15, kt = it & 15;
        const float* keys = p.peer_keys + ((size_t)l * 16 + hc) * 16384;
        const float* wq = p.peer_wq + (size_t)l * D * 2048 + (size_t)(kt * 64) * 2048 + hc * 128;
        __syncthreads();
        for (int i = tid; i < 128 * 128; i += 512) ks[(i >> 7) * 129 + (i & 127)] = keys[i];
        for (int i = tid; i < 64 * 128; i += 512) wqs[(i >> 7) * 129 + (i & 127)] = wq[(size_t)(i >> 7) * 2048 + (i & 127)];
        __syncthreads();
        const int k = tid & 63, n0 = (tid >> 6) * 16;
        float acc[16];
#pragma unroll
        for (int j = 0; j < 16; ++j) acc[j] = 0.f;
        for (int d = 0; d < 128; ++d) { const float a = wqs[k * 129 + d];
#pragma unroll
            for (int j = 0; j < 16; ++j) acc[j] += a * ks[(n0 + j) * 129 + d]; }
        bf16* WpT = (bf16*)(p.ws + WS_WP) + (size_t)l * 2048 * D;
#pragma unroll
        for (int j = 0; j < 16; ++j) WpT[(size_t)(hc * 128 + n0 + j) * D + kt * 64 + k] = (bf16)f2bf(acc[j]);
    }
}
constexpr float U8_SCALE = 64.f, V8_SCALE = 16.f;
typedef float f32x2v __attribute__((ext_vector_type(2)));
__device__ __forceinline__ unsigned pk_fp8x4(f32x4 v, float sc) {
    const float a = fminf(fmaxf(v[0] * sc, -448.f), 448.f), b = fminf(fmaxf(v[1] * sc, -448.f), 448.f), c = fminf(fmaxf(v[2] * sc, -448.f), 448.f), d = fminf(fmaxf(v[3] * sc, -448.f), 448.f);
    int w = __builtin_amdgcn_cvt_pk_fp8_f32(a, b, 0, false); w = __builtin_amdgcn_cvt_pk_fp8_f32(c, d, w, true); return (unsigned)w;
}
__device__ __forceinline__ void cvt_fp8_stream(const float* src, unsigned char* dst, size_t n16, float sc, size_t gtid, size_t gthreads) {
    for (size_t i = gtid; i < n16; i += gthreads) { const float* s = src + i * 16; u32x4 o;
        o.x = pk_fp8x4(*(const f32x4*)(s), sc); o.y = pk_fp8x4(*(const f32x4*)(s + 4), sc); o.z = pk_fp8x4(*(const f32x4*)(s + 8), sc); o.w = pk_fp8x4(*(const f32x4*)(s + 12), sc);
        *(u32x4*)(dst + i * 16) = o; }
}
__device__ __forceinline__ float wave_max(float v) {
#pragma unroll
    for (int o = 32; o > 0; o >>= 1) v = fmaxf(v, __shfl_xor(v, o));
    return v;
}
__device__ __forceinline__ unsigned pk_i8x4(f32x4 v, float sc) {
    const int a = (int)__builtin_rintf(v[0] * sc), b = (int)__builtin_rintf(v[1] * sc), c = (int)__builtin_rintf(v[2] * sc), d = (int)__builtin_rintf(v[3] * sc);
    return (unsigned)(a & 255) | ((unsigned)(b & 255) << 8) | ((unsigned)(c & 255) << 16) | ((unsigned)d << 24);
}
__device__ __forceinline__ void cvt_i8_rows(const float* src, unsigned char* dst, float* RS, size_t n16, size_t gtid, size_t gthreads) {
    for (size_t i = gtid; i < n16; i += gthreads) { const float* s_ = src + i * 16;
        const f32x4 a = *(const f32x4*)(s_), b = *(const f32x4*)(s_ + 4), c = *(const f32x4*)(s_ + 8), d = *(const f32x4*)(s_ + 12);
        float m = fmaxf(fmaxf(fmaxf(fabsf(a[0]), fabsf(a[1])), fmaxf(fabsf(a[2]), fabsf(a[3]))), fmaxf(fmaxf(fabsf(b[0]), fabsf(b[1])), fmaxf(fabsf(b[2]), fabsf(b[3]))));
        m = fmaxf(m, fmaxf(fmaxf(fmaxf(fabsf(c[0]), fabsf(c[1])), fmaxf(fabsf(c[2]), fabsf(c[3]))), fmaxf(fmaxf(fabsf(d[0]), fabsf(d[1])), fmaxf(fabsf(d[2]), fabsf(d[3])))));
        m = wave_max(m); const float sc = m > 0.f ? 127.0f / m : 0.f;
        u32x4 o; o.x = pk_i8x4(a, sc); o.y = pk_i8x4(b, sc); o.z = pk_i8x4(c, sc); o.w = pk_i8x4(d, sc);
        *(u32x4*)(dst + i * 16) = o;
        if ((i & 63) == 0) RS[i >> 6] = m * (1.0f / 127.0f); }
}
__device__ __forceinline__ void phase_cvt(const Params& p, int l) {
    const size_t gtid = (size_t)bid_l() * 512 + tid_l(), gth = (size_t)grid_l() * 512;
    cvt_bf16_stream(p.p + (size_t)l * T * 256, (bf16*)(p.ws + WS_PB), (size_t)T * 256 / 8, gtid, gth);
    cvt_i8_rows(p.peer_u + (size_t)l * NEXP * D, p.ws + WS_U, (float*)(p.ws + WS_RS), (size_t)NEXP * D / 16, gtid, gth);
    cvt_fp8_stream(p.peer_v + (size_t)l * NEXP * D, p.ws + WS_V, (size_t)NEXP * D / 16, V8_SCALE, gtid, gth);
}

#define GEMM_RUN(EPI, e, Aptr, Bptr, N_, K_) do { int kk_ = (K_); asm volatile("" : "+s"(kk_)); pg8::Gemm g{(const pg8::bf16_t*)(Aptr), (const pg8::bf16_t*)(Bptr), T, (N_), kk_}; pg8::StaticOrder S; S.init(T, (N_), (int)grid_l(), (int)bid_l()); \
    pg8::gemm_phase<EPI, pg8::StaticOrder, true, true>((PG8_LAS unsigned char*)lds, g, S, e); } while (0)

__device__ __forceinline__ void phase_gemm_in(const Params& p, int l, unsigned char* lds) {
    pg8::EpiBf16<0> e{(pg8::bf16_t*)(p.ws + WS_H), HCOLS, nullptr, 0, 0, 1.f};
    GEMM_RUN(pg8::EpiBf16<0>, e, p.ws + WS_XB, (bf16*)(p.ws + WS_WIN) + (size_t)l * HCOLS * D, HCOLS, D);
}
__device__ __forceinline__ void phase_gemm_e(const Params& p, int l, unsigned char* lds) {
    pg8::EpiBf16<0> e{(pg8::bf16_t*)(p.ws + WS_E), D, nullptr, 0, 0, 1.f};
    GEMM_RUN(pg8::EpiBf16<0>, e, p.ws + WS_PB, (bf16*)(p.ws + WS_PW) + (size_t)l * D * 256, D, 256);
}
__device__ __forceinline__ void phase_gemm_out(const Params& p, int l, unsigned char* lds) {
    pg8::EpiResid e{(const pg8::bf16_t*)(p.ws + WS_XB), (_Float16*)(p.ws + WS_Y), D, ALPHA};
    GEMM_RUN(pg8::EpiResid, e, p.ws + WS_MIX, (bf16*)(p.ws + WS_WOUT) + (size_t)l * D * D, D, D);
}
__device__ __forceinline__ void phase_gemm_sc(const Params& p, int l, unsigned char* lds) {
    pg8::EpiF16 e{(_Float16*)(p.ws + WS_SC), 2048};
    GEMM_RUN(pg8::EpiF16, e, p.ws + WS_XB, (bf16*)(p.ws + WS_WP) + (size_t)l * 2048 * D, 2048, D);
}
__device__ __forceinline__ void phase_gemm_ple(const Params& p, int l, unsigned char* lds) {
    pg8::EpiPle e{(const pg8::bf16_t*)(p.ws + WS_XB), (_Float16*)(p.ws + WS_Y), (const pg8::bf16_t*)(p.ws + WS_E), p.ple_gb + (size_t)l * D, D};
    GEMM_RUN(pg8::EpiPle, e, p.ws + WS_XB, (bf16*)(p.ws + WS_PGW) + (size_t)l * D * D, D, D);
}

__device__ __forceinline__ void phase_conv(const Params& p, int l, unsigned char* lds) {
    const int tid = tid_l(), lane = tid & 63, wave = tid >> 6;
    float* U = (float*)lds;
    float* Yt = U + 62 * 256;
    const bf16* H = (const bf16*)(p.ws + WS_H); bf16* MIX = (bf16*)(p.ws + WS_MIX);
    const float* cw = p.conv_w + (size_t)l * 31 * 256; const float* cb = p.conv_b + l * 256;
    const float* lg = p.conv_ln_g + l * 256; const float* lb = p.conv_ln_b + l * 256;
    for (int it = bid_l(); it < T / 32; it += grid_l()) {
        const int b = it / (SEQ / 32), t0 = (it % (SEQ / 32)) * 32;
        __syncthreads();
        for (int i = tid; i < 62 * 32; i += 512) { const int r = i >> 5, c8 = (i & 31) * 8, t = t0 - 30 + r; f32x4 u0 = {0.f, 0.f, 0.f, 0.f}, u1 = {0.f, 0.f, 0.f, 0.f};
            if (t >= 0) { const bf16* hr = H + (size_t)(b * SEQ + t) * HCOLS; const u32x4 av = *(const u32x4*)(hr + HC_AVAL + c8), gv = *(const u32x4*)(hr + HC_AGATE + c8);
#pragma unroll
                for (int j = 0; j < 2; ++j) { u0[2 * j] = bf2f(av[j] & 0xffffu) * sigmoidf_(bf2f(gv[j] & 0xffffu)); u0[2 * j + 1] = __uint_as_float(av[j] & 0xffff0000u) * sigmoidf_(__uint_as_float(gv[j] & 0xffff0000u));
                                              u1[2 * j] = bf2f(av[2 + j] & 0xffffu) * sigmoidf_(bf2f(gv[2 + j] & 0xffffu)); u1[2 * j + 1] = __uint_as_float(av[2 + j] & 0xffff0000u) * sigmoidf_(__uint_as_float(gv[2 + j] & 0xffff0000u)); } }
            *(f32x4*)(U + r * 256 + c8) = u0; *(f32x4*)(U + r * 256 + c8 + 4) = u1; }
        __syncthreads();
        { const int c = tid & 255, half = tid >> 8; float w[31], win[46];
#pragma unroll
          for (int j = 0; j < 31; ++j) w[j] = cw[j * 256 + c];
#pragma unroll
          for (int j = 0; j < 46; ++j) win[j] = U[(half * 16 + j) * 256 + c];
          const float bias = cb[c];
#pragma unroll
          for (int tl = 0; tl < 16; ++tl) { float y = bias;
#pragma unroll
              for (int j = 0; j < 31; ++j) y += w[j] * win[tl + j];
              Yt[(half * 16 + tl) * 256 + c] = y; } }
        __syncthreads();
        for (int tl = wave * 4; tl < wave * 4 + 4; ++tl) {
            const f32x4 v = *(const f32x4*)(Yt + tl * 256 + lane * 4);
            const float mean = wave_sum((v[0] + v[1]) + (v[2] + v[3])) * (1.f / 256.f);
            const f32x4 d = v - mean; const float var = wave_sum((d[0] * d[0] + d[1] * d[1]) + (d[2] * d[2] + d[3] * d[3])) * (1.f / 256.f);
            const float rstd = 1.0f / sqrtf(var + LN_EPS);
            const f32x4 g4 = *(const f32x4*)(lg + lane * 4), b4 = *(const f32x4*)(lb + lane * 4);
            float o[4];
#pragma unroll
            for (int i = 0; i < 4; ++i) { const float z = d[i] * rstd * g4[i] + b4[i]; o[i] = z * sigmoidf_(z); }
            u32x2 w2; w2.x = pk2(o[0], o[1]); w2.y = pk2(o[2], o[3]);
            *(u32x2*)(MIX + (size_t)(b * SEQ + t0 + tl) * D + MC_A + lane * 4) = w2;
        }
    }
}

__device__ __forceinline__ void phase_fox_cum(const Params& p, int l, unsigned char* lds) {
    const int tid = tid_l(), lane = tid & 63, wave = tid >> 6;
    float* wsum = (float*)lds;
    const bf16* H = (const bf16*)(p.ws + WS_H); float* CK = (float*)(p.ws + WS_CK);
    for (int bh = bid_l(); bh < 48; bh += grid_l()) {
        const int b = bh / 6, h = bh % 6; const float bias = p.fox_forget_b[l * 6 + h];
        float v[8]; float s = 0.f;
#pragma unroll
        for (int i = 0; i < 8; ++i) { const float f = bf2f(H[(size_t)(b * SEQ + tid * 8 + i) * HCOLS + HC_CF + h]); s += log_sigmoid(f + bias) * LOG2E; v[i] = s; }
        float incl = s;
#pragma unroll
        for (int o = 1; o < 64; o <<= 1) { const float n = __shfl_up(incl, o); if (lane >= o) incl += n; }
        __syncthreads();
        if (lane == 63) wsum[wave] = incl;
        __syncthreads();
        float base = incl - s;
        for (int w = 0; w < wave; ++w) base += wsum[w];
#pragma unroll
        for (int i = 0; i < 8; ++i) CK[(size_t)bh * SEQ + tid * 8 + i] = base + v[i];
    }
}

__device__ __forceinline__ void phase_fox_norm(const Params& p, unsigned char* lds) {
    const int tid = tid_l(), lane = tid & 63, wave = tid >> 6;
    float* qns = (float*)lds; float* kns = qns + 256;
    const bf16* H = (const bf16*)(p.ws + WS_H); float* KT = (float*)(p.ws + WS_FKT); float* QBM = (float*)(p.ws + WS_FQB);
    for (int it = bid_l(); it < 48 * 16; it += grid_l()) {
        const int bh = it >> 4, qb = it & 15, b = bh / 6, h = bh % 6;
        __syncthreads();
        if (tid < 256) { const bf16* row = H + ((size_t)b * SEQ + qb * 256 + tid) * HCOLS + h * 64; float sq = 0.f, sk = 0.f;
#pragma unroll
            for (int j = 0; j < 8; ++j) { const u32x4 qv = *(const u32x4*)(row + HC_CQ + 8 * j), kv = *(const u32x4*)(row + HC_CK + 8 * j);
#pragma unroll
                for (int i = 0; i < 4; ++i) { const float a0 = bf2f(qv[i] & 0xffffu), a1 = __uint_as_float(qv[i] & 0xffff0000u), b0 = bf2f(kv[i] & 0xffffu), b1 = __uint_as_float(kv[i] & 0xffff0000u);
                    sq += a0 * a0 + a1 * a1; sk += b0 * b0 + b1 * b1; } }
            qns[tid] = sqrtf(sq); kns[tid] = sqrtf(sk); }
        __syncthreads();
        if (wave < 5) { float v = wave < 4 ? kns[wave * 64 + lane] : fmaxf(fmaxf(qns[lane], qns[64 + lane]), fmaxf(qns[128 + lane], qns[192 + lane]));
#pragma unroll
            for (int o = 1; o < 64; o <<= 1) v = fmaxf(v, __shfl_xor(v, o));
            if (lane == 0) { if (wave < 4) KT[bh * 64 + 4 * qb + wave] = v; else QBM[bh * 16 + qb] = v; } }
    }
}

typedef short bf16x8_t __attribute__((ext_vector_type(8)));
typedef float f32x16_t __attribute__((ext_vector_type(16)));
__device__ __forceinline__ int crow32(int r, int hi) { return (r & 3) + 8 * (r >> 2) + 4 * hi; }
struct GlaB1Pre { u32x4 vv, lr0, lr1; u32x2 kk; float w2v, b2v; };
__device__ __forceinline__ GlaB1Pre gla_b1_load(const Params& p, int l, int it, int tid, int lane, int wave) {
    const int bh = it >> 6, n = it & 63, b = bh / 6, h = bh % 6; const size_t tok0 = (size_t)b * SEQ + n * 64; const bf16* H = (const bf16*)(p.ws + WS_H);
    GlaB1Pre r; r.w2v = p.gla_gate_w[(size_t)l * 16 * 192 + (tid >> 5) * 192 + h * 32 + (tid & 31)]; r.b2v = p.gla_gate_b[l * 192 + h * 32 + (tid & 31)];
    r.vv = *(const u32x4*)(H + (tok0 + (tid >> 3)) * HCOLS + HC_BV + h * 64 + (tid & 7) * 8);
    r.lr0 = *(const u32x4*)(H + (tok0 + lane) * HCOLS + HC_LR); r.lr1 = *(const u32x4*)(H + (tok0 + lane) * HCOLS + HC_LR + 8);
    r.kk = *(const u32x2*)(H + (tok0 + lane) * HCOLS + HC_BK + h * 32 + wave * 4);
    return r;
}
__device__ __forceinline__ void phase_gla_b1(const Params& p, int l, unsigned char* lds) {
    const int tid = tid_l(), lane = tid & 63, wave = tid >> 6, r32 = lane & 31, hi = lane >> 5;
    bf16* KDT = (bf16*)lds;
    bf16* VT = KDT + 32 * 72;
    float* w2s = (float*)(VT + 64 * 72);
    float* b2s = w2s + 16 * 32;
    float* GCUM = (float*)(p.ws + WS_GCUM); float* GS = (float*)(p.ws + WS_GS); float* GDEC = (float*)(p.ws + WS_GDEC);
    const int NI = 48 * 64, G = grid_l(); int it = bid_l();
    if (it >= NI) return;
    GlaB1Pre cur = gla_b1_load(p, l, it, tid, lane, wave);
#pragma unroll 1
    for (; it < NI; it += G) {
        const GlaB1Pre nxt = gla_b1_load(p, l, it + G < NI ? it + G : it, tid, lane, wave);
        __builtin_amdgcn_sched_barrier(0);
        const int bh = it >> 6, n = it & 63, b = bh / 6, h = bh % 6; const size_t tok0 = (size_t)b * SEQ + n * 64;
        __syncthreads();
        w2s[tid] = cur.w2v;
        if (tid < 32) b2s[tid] = cur.b2v;
        { const int s_ = tid >> 3, e0 = (tid & 7) * 8;
#pragma unroll
          for (int i = 0; i < 4; ++i) { VT[(e0 + 2 * i) * 72 + s_] = (bf16)(cur.vv[i] & 0xffffu); VT[(e0 + 2 * i + 1) * 72 + s_] = (bf16)(cur.vv[i] >> 16); } }
        const int d0 = wave * 4;
        __syncthreads();
        float lrf[16];
#pragma unroll
        for (int i = 0; i < 4; ++i) { lrf[2 * i] = bf2f(cur.lr0[i] & 0xffffu); lrf[2 * i + 1] = __uint_as_float(cur.lr0[i] & 0xffff0000u); lrf[8 + 2 * i] = bf2f(cur.lr1[i] & 0xffffu); lrf[8 + 2 * i + 1] = __uint_as_float(cur.lr1[i] & 0xffff0000u); }
        float g[4];
#pragma unroll
        for (int dd = 0; dd < 4; ++dd) { float x = b2s[d0 + dd];
#pragma unroll
            for (int r = 0; r < 16; ++r) x += lrf[r] * w2s[r * 32 + d0 + dd];
            g[dd] = log_sigmoid(x) * (1.0f / 16.0f); }
#pragma unroll
        for (int o = 1; o < 64; o <<= 1)
#pragma unroll
            for (int dd = 0; dd < 4; ++dd) { const float v = __shfl_up(g[dd], o); if (lane >= o) g[dd] += v; }
        *(f32x4*)(GCUM + (tok0 + lane) * 192 + h * 32 + d0) = (f32x4){g[0], g[1], g[2], g[3]};
        const float kf[4] = {bf2f(cur.kk.x & 0xffffu), __uint_as_float(cur.kk.x & 0xffff0000u), bf2f(cur.kk.y & 0xffffu), __uint_as_float(cur.kk.y & 0xffff0000u)};
#pragma unroll
        for (int dd = 0; dd < 4; ++dd) { const float last = __uint_as_float(__builtin_amdgcn_readlane(__float_as_uint(g[dd]), 63));
            KDT[(d0 + dd) * 72 + lane] = (bf16)f2bf(kf[dd] * __expf(last - g[dd]));
            if (lane == 63) GDEC[(size_t)it * 32 + d0 + dd] = __expf(last); }
        __syncthreads();
        if (wave < 2) {
            f32x16_t acc = {};
#pragma unroll
            for (int ks = 0; ks < 4; ++ks) { const bf16x8_t a = *(const bf16x8_t*)(KDT + r32 * 72 + 16 * ks + 8 * hi), bb = *(const bf16x8_t*)(VT + (32 * wave + r32) * 72 + 16 * ks + 8 * hi);
                acc = __builtin_amdgcn_mfma_f32_32x32x16_bf16(a, bb, acc, 0, 0, 0); }
#pragma unroll
            for (int r = 0; r < 16; ++r) GS[(size_t)it * 2048 + crow32(r, hi) * 64 + 32 * wave + r32] = acc[r];
        }
        cur = nxt;
    }
}
__device__ __forceinline__ void phase_gla_b2(const Params& p) {
    float* GS = (float*)(p.ws + WS_GS); const float* GDEC = (const float*)(p.ws + WS_GDEC);
    for (int g = bid_l() * 512 + tid_l(); g < 48 * 2048; g += grid_l() * 512) {
        const int bh = g >> 11, de = g & 2047, d = de >> 6; float S = 0.f;
        float* gs = GS + (size_t)bh * 64 * 2048 + de; const float* gd = GDEC + (size_t)bh * 64 * 32 + d;
#pragma unroll 1
        for (int n0 = 0; n0 < 64; n0 += 16) { float loc[16], dec[16];
#pragma unroll
            for (int i = 0; i < 16; ++i) { loc[i] = gs[(size_t)(n0 + i) * 2048]; dec[i] = gd[(n0 + i) * 32]; }
#pragma unroll
            for (int i = 0; i < 16; ++i) { gs[(size_t)(n0 + i) * 2048] = S; S = S * dec[i] + loc[i]; } }
    }
}
struct GlaB3Pre { u32x2 qq, kk; f32x4 c; u32x4 vv; f32x4 sv; u32x4 gr; };
__device__ __forceinline__ GlaB3Pre gla_b3_load(const Params& p, int it, int tid) {
    const int bh = it >> 6, n = it & 63, b = bh / 6, h = bh % 6; const size_t tok0 = (size_t)b * SEQ + n * 64; const bf16* H = (const bf16*)(p.ws + WS_H);
    const float* GCUM = (const float*)(p.ws + WS_GCUM); const float* GS = (const float*)(p.ws + WS_GS);
    GlaB3Pre r; const int t = tid >> 3, d0 = (tid & 7) * 4;
    r.qq = *(const u32x2*)(H + (tok0 + t) * HCOLS + HC_BQ + h * 32 + d0); r.kk = *(const u32x2*)(H + (tok0 + t) * HCOLS + HC_BK + h * 32 + d0);
    r.c = *(const f32x4*)(GCUM + (tok0 + t) * 192 + h * 32 + d0);
    r.vv = *(const u32x4*)(H + (tok0 + t) * HCOLS + HC_BV + h * 64 + (tid & 7) * 8);
    r.sv = *(const f32x4*)(GS + (size_t)it * 2048 + (tid >> 4) * 64 + (tid & 15) * 4);
    r.gr = *(const u32x4*)(H + (tok0 + t) * HCOLS + HC_BG + h * 64 + (tid & 7) * 8);
    return r;
}
__device__ __forceinline__ void phase_gla_b3(const Params& p, int l, unsigned char* lds) {
    const int tid = tid_l(), lane = tid & 63, wave = tid >> 6, r32 = lane & 31, hi = lane >> 5;
    bf16* QE = (bf16*)lds;
    bf16* KE = QE + 64 * 40;
    bf16* VT = KE + 64 * 40;
    bf16* ST = VT + 64 * 72;
    bf16* P = ST + 64 * 40;
    float* O = (float*)(P + 64 * 72);
    bf16* MIX = (bf16*)(p.ws + WS_MIX);
    const int NI = 48 * 64, G = grid_l(); int it = bid_l();
    if (it >= NI) return;
    GlaB3Pre cur = gla_b3_load(p, it, tid);
#pragma unroll 1
    for (; it < NI; it += G) {
        const GlaB3Pre nxt = gla_b3_load(p, it + G < NI ? it + G : it, tid);
        __builtin_amdgcn_sched_barrier(0);
        const int bh = it >> 6, n = it & 63, b = bh / 6, h = bh % 6; const size_t tok0 = (size_t)b * SEQ + n * 64;
        __syncthreads();
        { const int t = tid >> 3, d0 = (tid & 7) * 4; const u32x2 qq = cur.qq, kk = cur.kk; const f32x4 c = cur.c;
          const float e0 = __expf(c[0]), e1 = __expf(c[1]), e2 = __expf(c[2]), e3 = __expf(c[3]);
          u32x2 qo, ko;
          qo.x = pk2(bf2f(qq.x & 0xffffu) * e0, __uint_as_float(qq.x & 0xffff0000u) * e1); qo.y = pk2(bf2f(qq.y & 0xffffu) * e2, __uint_as_float(qq.y & 0xffff0000u) * e3);
          ko.x = pk2(bf2f(kk.x & 0xffffu) / e0, __uint_as_float(kk.x & 0xffff0000u) / e1); ko.y = pk2(bf2f(kk.y & 0xffffu) / e2, __uint_as_float(kk.y & 0xffff0000u) / e3);
          *(u32x2*)(QE + t * 40 + d0) = qo; *(u32x2*)(KE + t * 40 + d0) = ko; }
        { const int s_ = tid >> 3, e0 = (tid & 7) * 8;
#pragma unroll
          for (int i = 0; i < 4; ++i) { VT[(e0 + 2 * i) * 72 + s_] = (bf16)(cur.vv[i] & 0xffffu); VT[(e0 + 2 * i + 1) * 72 + s_] = (bf16)(cur.vv[i] >> 16); } }
        { const int d = tid >> 4, e0 = (tid & 15) * 4;
#pragma unroll
          for (int i = 0; i < 4; ++i) ST[(e0 + i) * 40 + d] = (bf16)f2bf(cur.sv[i]); }
        __syncthreads();
        f32x16_t acc = {};
        const int tt = (wave & 3) >> 1, tc = wave & 1;
        if (wave < 4) {
            if (!(tt == 0 && tc == 1)) {
#pragma unroll
                for (int ks = 0; ks < 2; ++ks) { const bf16x8_t a = *(const bf16x8_t*)(QE + (32 * tt + r32) * 40 + 16 * ks + 8 * hi), bb = *(const bf16x8_t*)(KE + (32 * tc + r32) * 40 + 16 * ks + 8 * hi);
                    acc = __builtin_amdgcn_mfma_f32_32x32x16_bf16(a, bb, acc, 0, 0, 0); }
#pragma unroll
                for (int r = 0; r < 16; ++r) { const int trow = 32 * tt + crow32(r, hi), scol = 32 * tc + r32; P[trow * 72 + scol] = (bf16)f2bf(scol <= trow ? acc[r] : 0.f); }
            }
        } else {
#pragma unroll
            for (int ks = 0; ks < 2; ++ks) { const bf16x8_t a = *(const bf16x8_t*)(QE + (32 * tt + r32) * 40 + 16 * ks + 8 * hi), bb = *(const bf16x8_t*)(ST + (32 * tc + r32) * 40 + 16 * ks + 8 * hi);
                acc = __builtin_amdgcn_mfma_f32_32x32x16_bf16(a, bb, acc, 0, 0, 0); }
        }
        __syncthreads();
        if (wave >= 4) {
            const int nks = tt == 0 ? 2 : 4;
            for (int ks = 0; ks < nks; ++ks) { const bf16x8_t a = *(const bf16x8_t*)(P + (32 * tt + r32) * 72 + 16 * ks + 8 * hi), bb = *(const bf16x8_t*)(VT + (32 * tc + r32) * 72 + 16 * ks + 8 * hi);
                acc = __builtin_amdgcn_mfma_f32_32x32x16_bf16(a, bb, acc, 0, 0, 0); }
#pragma unroll
            for (int r = 0; r < 16; ++r) O[(32 * tt + crow32(r, hi)) * 65 + 32 * tc + r32] = acc[r];
        }
        __syncthreads();
        { const int t = tid >> 3, e0 = (tid & 7) * 8; float o[8]; float ss = 0.f;
#pragma unroll
          for (int i = 0; i < 8; ++i) { o[i] = O[t * 65 + e0 + i]; ss += o[i] * o[i]; }
          ss += __shfl_xor(ss, 1); ss += __shfl_xor(ss, 2); ss += __shfl_xor(ss, 4);
          const float rs = 1.0f / sqrtf(ss * (1.f / 64.f) + LN_EPS);
          const float* ng = p.gla_norm_g + l * 384 + h * 64 + e0; const u32x4 gr = cur.gr;
          float r[8];
#pragma unroll
          for (int i = 0; i < 4; ++i) { const float ga = bf2f(gr[i] & 0xffffu), gb = __uint_as_float(gr[i] & 0xffff0000u);
              r[2 * i] = o[2 * i] * rs * ng[2 * i] * (ga * sigmoidf_(ga)); r[2 * i + 1] = o[2 * i + 1] * rs * ng[2 * i + 1] * (gb * sigmoidf_(gb)); }
          u32x4 w; w.x = pk2(r[0], r[1]); w.y = pk2(r[2], r[3]); w.z = pk2(r[4], r[5]); w.w = pk2(r[6], r[7]);
          *(u32x4*)(MIX + (tok0 + t) * D + MC_B + h * 64 + e0) = w; }
        cur = nxt;
    }
}

constexpr int LDSQ_OFF = LDS_BYTES - 1024;
constexpr int CW_ATTNQ = 8192;
__device__ __forceinline__ void phase_fox_mfma(const Params& p, int l, unsigned char* lds) {
    const attn_body::bf16* H = (const attn_body::bf16*)(p.ws + WS_H);
    const attn_body::AttnTensors AT{H + HC_CQ, H + HC_CK, H + HC_CV, (attn_body::bf16*)(p.ws + WS_MIX) + MC_C, (const float*)(p.ws + WS_CK), (const float*)(p.ws + WS_FKT), (const float*)(p.ws + WS_FQB)};
    const attn_body::QueueOrder S{(unsigned*)(p.ws + WS_CTL) + CW_ATTNQ + l * 64, (volatile __attribute__((address_space(3))) int*)((__attribute__((address_space(3))) unsigned char*)lds + LDSQ_OFF)};
    attn_body::attn_phase<attn_body::QueueOrder>((char*)lds, AT, S);
}

__device__ __forceinline__ void phase_ln(const _Float16* Y, const float* g, const float* bta, float* dst, bf16* dstb, unsigned char* xq = nullptr, float* xs = nullptr) {
    const int tid = tid_l(), lane = tid & 63, wave = tid >> 6; typedef _Float16 h4 __attribute__((ext_vector_type(4)));
    const int stride = grid_l() * 8; int row = bid_l() * 8 + wave;
    if (row >= T) return;
    h4 cur[4];
#pragma unroll
    for (int j = 0; j < 4; ++j) cur[j] = *(const h4*)(Y + (size_t)row * D + j * 256 + lane * 4);
#pragma unroll 1
    for (; row < T; row += stride) {
        h4 nxt[4]; const int nr = row + stride < T ? row + stride : row;
#pragma unroll
        for (int j = 0; j < 4; ++j) nxt[j] = *(const h4*)(Y + (size_t)nr * D + j * 256 + lane * 4);
        __builtin_amdgcn_sched_barrier(0);
        f32x4 v[4]; float s = 0.f;
#pragma unroll
        for (int j = 0; j < 4; ++j) { v[j] = (f32x4){(float)cur[j][0], (float)cur[j][1], (float)cur[j][2], (float)cur[j][3]}; s += (v[j][0] + v[j][1]) + (v[j][2] + v[j][3]); }
        const float mean = wave_sum(s) * (1.f / D); float s2 = 0.f;
#pragma unroll
        for (int j = 0; j < 4; ++j) { v[j] = v[j] - mean; s2 += (v[j][0] * v[j][0] + v[j][1] * v[j][1]) + (v[j][2] * v[j][2] + v[j][3] * v[j][3]); }
        const float rstd = 1.0f / sqrtf(wave_sum(s2) * (1.f / D) + LN_EPS);
        float am = 0.f;
#pragma unroll
        for (int j = 0; j < 4; ++j) { const f32x4 g4 = *(const f32x4*)(g + j * 256 + lane * 4), b4 = *(const f32x4*)(bta + j * 256 + lane * 4);
            const f32x4 o = v[j] * rstd * g4 + b4; v[j] = o;
            am = fmaxf(am, fmaxf(fmaxf(fabsf(o[0]), fabsf(o[1])), fmaxf(fabsf(o[2]), fabsf(o[3]))));
            if (dst) *(f32x4*)(dst + (size_t)row * D + j * 256 + lane * 4) = o;
            if (dstb) { u32x2 w; w.x = pk2(o[0], o[1]); w.y = pk2(o[2], o[3]); *(u32x2*)(dstb + (size_t)row * D + j * 256 + lane * 4) = w; } }
        if (xq) {
            am = wave_max(am); const float sc = am > 0.f ? 127.0f / am : 0.f;
#pragma unroll
            for (int j = 0; j < 4; ++j) *(unsigned*)(xq + (size_t)row * D + j * 256 + lane * 4) = pk_i8x4(v[j], sc);
            if (lane == 0) xs[row] = am * (1.0f / 127.0f); }
#pragma unroll
        for (int j = 0; j < 4; ++j) cur[j] = nxt[j];
    }
}

__device__ __forceinline__ int f2ord(float x) { const int i = __float_as_int(x); return i ^ ((i >> 31) & 0x7fffffff); }
__device__ __forceinline__ float ord2f(int k) { return __int_as_float(k ^ ((k >> 31) & 0x7fffffff)); }
__device__ __forceinline__ void phase_topk(const Params& p, unsigned char* lds) {
    const int tid = tid_l(), lane = tid & 63, wave = tid >> 6;
    unsigned char* wreg = lds + wave * 17408; unsigned char* tab = wreg;
    const _Float16* SC = (const _Float16*)(p.ws + WS_SC); int* EIDX = (int*)(p.ws + WS_EIDX); float* GATE = (float*)(p.ws + WS_GATE); unsigned long long* SOFF = (unsigned long long*)(p.ws + WS_SOFF);
    for (int g = bid_l() * 512 + tid; g < T * 16; g += grid_l() * 512) {
        const int tok = g >> 4, hc = g & 15;
        typedef _Float16 h8 __attribute__((ext_vector_type(8)));
        { const unsigned char* blk = (const unsigned char*)(SC + (size_t)(g - lane) * 128);
          u32x4 st[16];
#pragma unroll
          for (int j = 0; j < 16; ++j) st[j] = *(const u32x4*)(blk + (size_t)(j * 64 + lane) * 16);
          __builtin_amdgcn_wave_barrier();
#pragma unroll
          for (int j = 0; j < 16; ++j) { const int c = j * 64 + lane; *(u32x4*)(wreg + (c + (c >> 4)) * 16) = st[j]; }
          __builtin_amdgcn_wave_barrier(); }
        const unsigned char* lp = wreg + lane * 272;
#define TK_CE(a, b) do { const int hi_ = max(a, b), lo_ = min(a, b); a = hi_; b = lo_; } while (0)
        int tk[16];
#pragma unroll 1
        for (int gi = 0; gi < 8; ++gi) { const h8 cA = *(const h8*)(lp + gi * 32), c1_ = *(const h8*)(lp + gi * 32 + 16);
            int v[16];
#pragma unroll
            for (int j = 0; j < 8; ++j) { v[j] = (f2ord((float)cA[j]) & ~127) | (127 - (gi * 16 + j)); v[8 + j] = (f2ord((float)c1_[j]) & ~127) | (127 - (gi * 16 + 8 + j)); }
            TK_CE(v[0], v[1]); TK_CE(v[3], v[2]); TK_CE(v[4], v[5]); TK_CE(v[7], v[6]); TK_CE(v[8], v[9]); TK_CE(v[11], v[10]); TK_CE(v[12], v[13]); TK_CE(v[15], v[14]); TK_CE(v[0], v[2]); TK_CE(v[1], v[3]); TK_CE(v[6], v[4]); TK_CE(v[7], v[5]); TK_CE(v[8], v[10]); TK_CE(v[9], v[11]); TK_CE(v[14], v[12]); TK_CE(v[15], v[13]); TK_CE(v[0], v[1]); TK_CE(v[2], v[3]); TK_CE(v[5], v[4]); TK_CE(v[7], v[6]); TK_CE(v[8], v[9]); TK_CE(v[10], v[11]); TK_CE(v[13], v[12]); TK_CE(v[15], v[14]); TK_CE(v[0], v[4]); TK_CE(v[1], v[5]); TK_CE(v[2], v[6]); TK_CE(v[3], v[7]); TK_CE(v[12], v[8]); TK_CE(v[13], v[9]); TK_CE(v[14], v[10]); TK_CE(v[15], v[11]); TK_CE(v[0], v[2]); TK_CE(v[1], v[3]); TK_CE(v[4], v[6]); TK_CE(v[5], v[7]); TK_CE(v[10], v[8]); TK_CE(v[11], v[9]); TK_CE(v[14], v[12]); TK_CE(v[15], v[13]); TK_CE(v[0], v[1]); TK_CE(v[2], v[3]); TK_CE(v[4], v[5]); TK_CE(v[6], v[7]); TK_CE(v[9], v[8]); TK_CE(v[11], v[10]); TK_CE(v[13], v[12]); TK_CE(v[15], v[14]); TK_CE(v[0], v[8]); TK_CE(v[1], v[9]); TK_CE(v[2], v[10]); TK_CE(v[3], v[11]); TK_CE(v[4], v[12]); TK_CE(v[5], v[13]); TK_CE(v[6], v[14]); TK_CE(v[7], v[15]); TK_CE(v[0], v[4]); TK_CE(v[1], v[5]); TK_CE(v[2], v[6]); TK_CE(v[3], v[7]); TK_CE(v[8], v[12]); TK_CE(v[9], v[13]); TK_CE(v[10], v[14]); TK_CE(v[11], v[15]); TK_CE(v[0], v[2]); TK_CE(v[1], v[3]); TK_CE(v[4], v[6]); TK_CE(v[5], v[7]); TK_CE(v[8], v[10]); TK_CE(v[9], v[11]); TK_CE(v[12], v[14]); TK_CE(v[13], v[15]); TK_CE(v[0], v[1]); TK_CE(v[2], v[3]); TK_CE(v[4], v[5]); TK_CE(v[6], v[7]); TK_CE(v[8], v[9]); TK_CE(v[10], v[11]); TK_CE(v[12], v[13]); TK_CE(v[14], v[15]);
            if (gi == 0) {
#pragma unroll
                for (int j = 0; j < 16; ++j) tk[j] = v[j]; }
            else {
#pragma unroll
                for (int j = 0; j < 16; ++j) tk[j] = max(tk[j], v[15 - j]);
                TK_CE(tk[0], tk[8]); TK_CE(tk[1], tk[9]); TK_CE(tk[2], tk[10]); TK_CE(tk[3], tk[11]); TK_CE(tk[4], tk[12]); TK_CE(tk[5], tk[13]); TK_CE(tk[6], tk[14]); TK_CE(tk[7], tk[15]); TK_CE(tk[0], tk[4]); TK_CE(tk[1], tk[5]); TK_CE(tk[2], tk[6]); TK_CE(tk[3], tk[7]); TK_CE(tk[8], tk[12]); TK_CE(tk[9], tk[13]); TK_CE(tk[10], tk[14]); TK_CE(tk[11], tk[15]); TK_CE(tk[0], tk[2]); TK_CE(tk[1], tk[3]); TK_CE(tk[4], tk[6]); TK_CE(tk[5], tk[7]); TK_CE(tk[8], tk[10]); TK_CE(tk[9], tk[11]); TK_CE(tk[12], tk[14]); TK_CE(tk[13], tk[15]); TK_CE(tk[0], tk[1]); TK_CE(tk[2], tk[3]); TK_CE(tk[4], tk[5]); TK_CE(tk[6], tk[7]); TK_CE(tk[8], tk[9]); TK_CE(tk[10], tk[11]); TK_CE(tk[12], tk[13]); TK_CE(tk[14], tk[15]); }
            }
        __builtin_amdgcn_wave_barrier();
#undef TK_CE
        float av[16], bv[16]; int ai[16], bi[16]; const bool c1 = (hc & 1) != 0;
#pragma unroll
        for (int j = 0; j < 16; ++j) { const int ok = __shfl_xor(tk[j], 1); const int ka = c1 ? ok : tk[j], kb = c1 ? tk[j] : ok;
            av[j] = ord2f(ka & ~127); ai[j] = 127 - (ka & 127); bv[j] = ord2f(kb & ~127); bi[j] = 127 - (kb & 127); }
#pragma unroll
        for (int j = 0; j < 16; ++j) { tab[j * 64 + lane] = (unsigned char)ai[j]; tab[(16 + j) * 64 + lane] = (unsigned char)bi[j]; }
        int ck[16];
#pragma unroll
        for (int j = 0; j < 16; ++j) ck[j] = (int)0x80000000;
#pragma unroll
        for (int i = 0; i < 16; ++i)
#pragma unroll
            for (int j = 0; j < 16 / (i + 1); ++j) { int x = (f2ord(av[i] + bv[j]) & ~255) | (255 - (i * 16 + j));
#pragma unroll
                for (int q = 0; q < 16; ++q) { const int hi = max(ck[q], x); x = min(ck[q], x); ck[q] = hi; } }
        float den = 0.f; float ex[16]; const float c0 = ord2f(ck[0] & ~255);
#pragma unroll
        for (int j = 0; j < 16; ++j) { ex[j] = __expf(ord2f(ck[j] & ~255) - c0); den += ex[j]; }
        const float inv = 1.0f / den;
        int eid[16]; unsigned long long cnt = 0ull;
#pragma unroll
        for (int j = 0; j < 16; ++j) { const int flat = 255 - (ck[j] & 255); eid[j] = (int)tab[(flat >> 4) * 64 + lane] * 128 + (int)tab[(16 + (flat & 15)) * 64 + lane];
            if (!c1) cnt += 1ull << (8 * (eid[j] >> 11)); }
        unsigned long long incl = cnt;
#pragma unroll
        for (int o = 1; o < 16; o <<= 1) { const unsigned lo = __shfl_up((unsigned)incl, o, 16), hi = __shfl_up((unsigned)(incl >> 32), o, 16); if ((hc & 15) >= o) incl += ((unsigned long long)hi << 32) | lo; }
        const unsigned long long total = ((unsigned long long)__shfl((unsigned)(incl >> 32), 15, 16) << 32) | __shfl((unsigned)incl, 15, 16);
        const unsigned long long base = total * 0x0101010101010100ull;
        unsigned long long run = base + (incl - cnt);
        if (hc == 0) SOFF[tok] = base;
        if (!c1) {
#pragma unroll
            for (int j = 0; j < 16; ++j) { const int sh = 8 * (eid[j] >> 11); const int pos = (int)((run >> sh) & 0xffull); run += 1ull << sh;
                EIDX[(size_t)tok * 128 + pos] = eid[j]; GATE[(size_t)tok * 128 + pos] = ex[j] * inv; } }
    }
}

__device__ __forceinline__ float gelu_tanh(float h) { const float z = 0.7978845608028654f * (h + 0.044715f * h * h * h); const float t = 1.0f - 2.0f / (__expf(2.0f * z) + 1.0f); return 0.5f * h * (1.0f + t); }
#define LAS3 __attribute__((address_space(3)))
struct PeerTok { u32x4 xq; float xs; unsigned long long so; int e_lo, e_hi; float g_lo, g_hi; };
__device__ __forceinline__ PeerTok peer_tok_load(const unsigned char* XQ, const float* XS, const int* EIDX, const float* GATE, const unsigned long long* SOFF, int tok, int lane) {
    PeerTok t; const int tk = tok < T ? tok : T - 1;
    t.xq = __builtin_nontemporal_load((const u32x4*)(XQ + (size_t)tk * D + lane * 16)); t.xs = XS[tk];
    t.so = SOFF[tk]; t.e_lo = EIDX[(size_t)tk * 128 + lane]; t.e_hi = EIDX[(size_t)tk * 128 + 64 + lane]; t.g_lo = GATE[(size_t)tk * 128 + lane]; t.g_hi = GATE[(size_t)tk * 128 + 64 + lane];
    return t;
}
__device__ __forceinline__ void peer_slot_write(LAS3 unsigned char* sl, const PeerTok& t, int lane) {
    *(LAS3 u32x4*)(sl + lane * 16) = t.xq; *(LAS3 int*)(sl + 1024 + lane * 4) = t.e_lo; *(LAS3 int*)(sl + 1280 + lane * 4) = t.e_hi;
    *(LAS3 float*)(sl + 1536 + lane * 4) = t.g_lo; *(LAS3 float*)(sl + 1792 + lane * 4) = t.g_hi;
}
template <int CTRL> __device__ __forceinline__ float dpp_mov(float v) { return __int_as_float(__builtin_amdgcn_update_dpp(0, __float_as_int(v), CTRL, 0xf, 0xf, false)); }
template <int CTRL> __device__ __forceinline__ int dpp_movi(int v) { return __builtin_amdgcn_update_dpp(0, v, CTRL, 0xf, 0xf, false); }
__device__ __forceinline__ float gelu_tanh_fast(float h) { const float z = 0.7978845608028654f * (h + 0.044715f * h * h * h); const float t = 1.0f - 2.0f * __builtin_amdgcn_rcpf(__expf(2.0f * z) + 1.0f); return 0.5f * h * (1.0f + t); }
#define PEER_ISSUE(R, sl_, ks_, kl_) do { const int kA_ = min((ks_) + g4, (kl_)), kB_ = min((ks_) + 4 + g4, (kl_)); \
    const int eA_ = *(const LAS3 int*)((sl_) + 1024 + kA_ * 4), eB_ = *(const LAS3 int*)((sl_) + 1024 + kB_ * 4); \
    const unsigned char* pA_ = U8l + (size_t)eA_ * D; const unsigned char* pB_ = U8l + (size_t)eB_ * D; \
    _Pragma("unroll") for (int i_ = 0; i_ < 4; ++i_) { R[i_] = *(const u32x4*)(pA_ + 256 * i_); R[4 + i_] = *(const u32x4*)(pB_ + 256 * i_); } } while (0)
#define PEER_COMPUTE(RC) do { int aA_ = 0, aB_ = 0; \
    _Pragma("unroll") for (int i_ = 0; i_ < 4; ++i_) _Pragma("unroll") for (int w_ = 0; w_ < 4; ++w_) aA_ = __builtin_amdgcn_sdot4((int)RC[i_][w_], (int)xp[i_][w_], aA_, false); \
    if (k0 + 4 < end) { _Pragma("unroll") for (int i_ = 0; i_ < 4; ++i_) _Pragma("unroll") for (int w_ = 0; w_ < 4; ++w_) aB_ = __builtin_amdgcn_sdot4((int)RC[4 + i_][w_], (int)xp[i_][w_], aB_, false); } \
    else { asm volatile("" :: "v"(RC[4]), "v"(RC[5]), "v"(RC[6]), "v"(RC[7])); }     \
    aA_ += dpp_movi<0x128>(aA_); aB_ += dpp_movi<0x128>(aB_); aA_ += dpp_movi<0x124>(aA_); aB_ += dpp_movi<0x124>(aB_); \
    aA_ += dpp_movi<0x122>(aA_); aB_ += dpp_movi<0x122>(aB_); aA_ += dpp_movi<0x121>(aA_); aB_ += dpp_movi<0x121>(aB_); \
    { const int rel = (lane - k0) & 63; const int src = (rel & 3) << 6; \
      const int ga = __builtin_amdgcn_ds_bpermute(src, aA_), gb = __builtin_amdgcn_ds_bpermute(src, aB_); \
      const float gq = (float)((rel & 4) ? gb : ga); const int kq = k0 + rel;              \
      c_lo = (rel < 8 && kq < 64) ? gq : c_lo; c_hi = (rel < 8 && kq >= 64) ? gq : c_hi; } } while (0)
#define PEER_KL(st, en) min(max((en) - 1, (st)), 127)
#define PEER_NEXT(RN) do { __builtin_amdgcn_sched_barrier(0); { const bool more_ = k0 + 8 < end; const LAS3 unsigned char* sl_ = wl + ((more_ ? sc : (sc ^ 1)) << 11); \
    const int ks_ = more_ ? k0 + 8 : ns, kl_ = more_ ? PEER_KL(start, end) : PEER_KL(ns, ne); PEER_ISSUE(RN, sl_, ks_, kl_); } __builtin_amdgcn_sched_barrier(0); } while (0)
#define PEER_RANGE(slo, shi, st, en) do { const unsigned lo_ = __builtin_amdgcn_readfirstlane(slo), hi_ = __builtin_amdgcn_readfirstlane(shi); \
    const unsigned long long so_ = ((unsigned long long)hi_ << 32) | lo_; st = (int)((so_ >> (8 * g0)) & 0xffull); en = g1 < 8 ? (int)((so_ >> (8 * g1)) & 0xffull) : 128; } while (0)
#define PEER_CUR() do { const LAS3 unsigned char* cs_ = wl + (sc << 11); \
    _Pragma("unroll") for (int i_ = 0; i_ < 4; ++i_) xp[i_] = *(const LAS3 u32x4*)(cs_ + 256 * i_ + l16 * 16); \
    const int e0_ = *(const LAS3 int*)(cs_ + 1024 + lane * 4), e1_ = *(const LAS3 int*)(cs_ + 1280 + lane * 4); cg_lo = *(const LAS3 float*)(cs_ + 1536 + lane * 4); cg_hi = *(const LAS3 float*)(cs_ + 1792 + lane * 4); \
    rs_lo = RS[e0_]; rs_hi = RS[e1_]; } while (0)
#define PEER_ADVANCE() do { k0 += 8; if (k0 >= end) { \
        if (tok < T) { \
        if (lane >= start && lane < end) GATE[(size_t)tok * 128 + lane] = cg_lo * gelu_tanh_fast(c_lo * (rs_lo * xs)) * (1.0f / V8_SCALE); \
        if (lane + 64 >= start && lane + 64 < end) GATE[(size_t)tok * 128 + 64 + lane] = cg_hi * gelu_tanh_fast(c_hi * (rs_hi * xs)) * (1.0f / V8_SCALE); } \
        tok += stride; peer_slot_write(wl + (sc << 11), n2, lane); sc ^= 1; \
        start = ns; end = ne; PEER_RANGE((unsigned)n2.so, (unsigned)(n2.so >> 32), ns, ne); xs = nxs; nxs = __uint_as_float(__builtin_amdgcn_readfirstlane(__float_as_uint(n2.xs))); k0 = start; c_lo = 0.f; c_hi = 0.f; \
        PEER_CUR(); __builtin_amdgcn_sched_barrier(0); \
        n2 = peer_tok_load(XQ, XS, EIDX, GATE, SOFF, tok + 2 * stride, lane); __builtin_amdgcn_sched_barrier(0); } } while (0)
__device__ __forceinline__ void phase_peer_u(const Params& p, unsigned char* lds) {
    const int tid = tid_l(), lane = tid & 63, wave = tid >> 6, bid = bid_l(), G = grid_l(), l16 = lane & 15, g4 = lane >> 4;
    const unsigned char* XQ = p.ws + WS_XQ; const float* XS = (const float*)(p.ws + WS_XS); const float* RS = (const float*)(p.ws + WS_RS); const unsigned char* U8l = p.ws + WS_U + l16 * 16;
    const int* EIDX = (const int*)(p.ws + WS_EIDX); float* GATE = (float*)(p.ws + WS_GATE); const unsigned long long* SOFF = (const unsigned long long*)(p.ws + WS_SOFF);
    const int ngrp = (G % 8 == 0) ? 8 : 1;
    const int g0 = (ngrp == 8) ? (bid & 7) : 0, g1 = (ngrp == 8) ? g0 + 1 : 8, r = (ngrp == 8) ? (bid >> 3) : bid, R = (ngrp == 8) ? (G >> 3) : G;
    const int stride = R * 8; int tok = __builtin_amdgcn_readfirstlane(r * 8 + wave);
    if (tok >= T) return;
    LAS3 unsigned char* wl = (LAS3 unsigned char*)lds + wave * 4096;
    int sc = 0, start, end, ns, ne; float xs, nxs;
    PeerTok n2;
    { const PeerTok t0 = peer_tok_load(XQ, XS, EIDX, GATE, SOFF, tok, lane), t1 = peer_tok_load(XQ, XS, EIDX, GATE, SOFF, tok + stride, lane);
      peer_slot_write(wl, t0, lane); peer_slot_write(wl + 2048, t1, lane);
      PEER_RANGE((unsigned)t0.so, (unsigned)(t0.so >> 32), start, end); PEER_RANGE((unsigned)t1.so, (unsigned)(t1.so >> 32), ns, ne); xs = __uint_as_float(__builtin_amdgcn_readfirstlane(__float_as_uint(t0.xs))); nxs = __uint_as_float(__builtin_amdgcn_readfirstlane(__float_as_uint(t1.xs))); }
    n2 = peer_tok_load(XQ, XS, EIDX, GATE, SOFF, tok + 2 * stride, lane);
    u32x4 xp[4]; float cg_lo, cg_hi, rs_lo, rs_hi;
    PEER_CUR();
    float c_lo = 0.f, c_hi = 0.f;
    int k0 = start;
    u32x4 Ra[8], Rb[8];
    PEER_ISSUE(Ra, wl, start, PEER_KL(start, end));
#pragma unroll 1
    do {
        PEER_NEXT(Rb); PEER_COMPUTE(Ra); PEER_ADVANCE();
        PEER_NEXT(Ra); PEER_COMPUTE(Rb); PEER_ADVANCE();
    } while (tok < T);
}
#undef PEER_ISSUE
#undef PEER_COMPUTE
#undef PEER_NEXT
#undef PEER_KL
#undef PEER_RANGE
#undef PEER_CUR
#undef PEER_ADVANCE
struct PeerVMeta { int e_lo, e_hi; float c_lo, c_hi; u32x4 x0, x1; };
__device__ __forceinline__ PeerVMeta peer_vmeta_load(const int* EIDX, const float* COEF, const bf16* XB, int tok, int lane) {
    PeerVMeta m;
    m.e_lo = EIDX[(size_t)tok * 128 + lane]; m.e_hi = EIDX[(size_t)tok * 128 + 64 + lane]; m.c_lo = COEF[(size_t)tok * 128 + lane]; m.c_hi = COEF[(size_t)tok * 128 + 64 + lane];
    m.x0 = *(const u32x4*)(XB + (size_t)tok * D + lane * 16); m.x1 = *(const u32x4*)(XB + (size_t)tok * D + lane * 16 + 8);
    return m;
}
__device__ __forceinline__ void phase_peer_v(const Params& p) {
    const int tid = tid_l(), lane = tid & 63, wave = tid >> 6;
    const unsigned char* V8 = p.ws + WS_V;
    const int* EIDX = (const int*)(p.ws + WS_EIDX); const float* COEF = (const float*)(p.ws + WS_GATE);
    bf16* XB = (bf16*)(p.ws + WS_XB);
    const int stride = grid_l() * 8; int tok = bid_l() * 8 + wave;
    if (tok >= T) return;
    PeerVMeta cur = peer_vmeta_load(EIDX, COEF, XB, tok, lane);
#pragma unroll 1
    for (; tok < T; tok += stride) {
        const PeerVMeta nxt = peer_vmeta_load(EIDX, COEF, XB, tok + stride < T ? tok + stride : tok, lane);
        __builtin_amdgcn_sched_barrier(0);
        float acc[16];
#pragma unroll
        for (int i = 0; i < 16; ++i) acc[i] = 0.f;
#pragma unroll 1
        for (int k0 = 0; k0 < 128; k0 += 8) {
            const int esel = k0 < 64 ? cur.e_lo : cur.e_hi; const unsigned csel = __float_as_uint(k0 < 64 ? cur.c_lo : cur.c_hi);
            u32x4 vr[8]; float cf[8];
#pragma unroll
            for (int q = 0; q < 8; ++q) { const int e = __builtin_amdgcn_readlane(esel, (k0 & 63) + q); cf[q] = __uint_as_float(__builtin_amdgcn_readlane(csel, (k0 & 63) + q));
                vr[q] = *(const u32x4*)(V8 + (size_t)e * D + lane * 16); }
#pragma unroll
            for (int q = 0; q < 8; ++q)
#pragma unroll
                for (int w = 0; w < 4; ++w) { const f32x2v a = __builtin_amdgcn_cvt_pk_f32_fp8((int)vr[q][w], false), b = __builtin_amdgcn_cvt_pk_f32_fp8((int)vr[q][w], true);
                    acc[4 * w] += cf[q] * a[0]; acc[4 * w + 1] += cf[q] * a[1]; acc[4 * w + 2] += cf[q] * b[0]; acc[4 * w + 3] += cf[q] * b[1]; }
        }
        float r[16];
#pragma unroll
        for (int i = 0; i < 4; ++i) { r[2 * i] = ALPHA * bf2f(cur.x0[i] & 0xffffu) + acc[2 * i]; r[2 * i + 1] = ALPHA * __uint_as_float(cur.x0[i] & 0xffff0000u) + acc[2 * i + 1];
                                      r[8 + 2 * i] = ALPHA * bf2f(cur.x1[i] & 0xffffu) + acc[8 + 2 * i]; r[8 + 2 * i + 1] = ALPHA * __uint_as_float(cur.x1[i] & 0xffff0000u) + acc[8 + 2 * i + 1]; }
#pragma unroll
        for (int w = 0; w < 2; ++w) { u32x4 o; o.x = pk2(r[8 * w], r[8 * w + 1]); o.y = pk2(r[8 * w + 2], r[8 * w + 3]); o.z = pk2(r[8 * w + 4], r[8 * w + 5]); o.w = pk2(r[8 * w + 6], r[8 * w + 7]);
            *(u32x4*)(XB + (size_t)tok * D + lane * 16 + 8 * w) = o; }
        cur = nxt;
    }
}
#define GAS __attribute__((address_space(1)))
#define LAS __attribute__((address_space(3)))
#define XB_TMO      128
#define XB_XCNT(j)  (256  + 64 * (j))
#define XB_XSUB(j)  (1280 + 64 * (j))
#define XB_XGEN(j)  (2304 + 64 * (j))
#define XB_TOP      3328
#define XB_TOPGEN   3392
#define XCD_BAR_WORDS 3456
#define XB_SPIN_CAP (1u << 18)

__device__ __forceinline__ unsigned xb_ld(unsigned* p)              { return __hip_atomic_load(p, __ATOMIC_RELAXED, __HIP_MEMORY_SCOPE_AGENT); }
__device__ __forceinline__ unsigned xb_add(unsigned* p, unsigned v) { return __hip_atomic_fetch_add(p, v, __ATOMIC_RELAXED, __HIP_MEMORY_SCOPE_AGENT); }
__device__ __forceinline__ unsigned xb_xcc_id() { return (unsigned)__builtin_amdgcn_s_getreg((3 << 11) | 20) & 0xFu; }
#define XB_SPIN(cond, bar) do { unsigned _sp = 0; while (cond) { __builtin_amdgcn_s_sleep(1); \
    if ((++_sp & 255u) == 0u) { if (xb_ld(&(bar)[XB_TMO])) break; if (_sp > XB_SPIN_CAP) { atomicAdd(&(bar)[XB_TMO], 1u); break; } } } } while (0)

struct XcdBarrier {
    unsigned* bar; unsigned x;
    volatile LAS unsigned* st;
};

__device__ __forceinline__ XcdBarrier xcd_barrier_post(unsigned* bar, volatile LAS unsigned* st) {
    XcdBarrier b; b.bar = bar; b.x = xb_xcc_id(); b.st = st;
    if (threadIdx.x == 0) (void)xb_add(&bar[XB_XCNT(b.x)], 1u);
    return b;
}
__device__ __forceinline__ void xcd_barrier_complete(unsigned* bar, unsigned x, unsigned& nloc, unsigned& nx) {
    const unsigned G = gridDim.x * gridDim.y * gridDim.z;
    unsigned sum, cnt, mine, sp = 0u;
    for (;;) {
        sum = 0u; cnt = 0u; mine = 0u;
#pragma unroll
        for (unsigned j = 0; j < 16; ++j) { const unsigned c = xb_ld(&bar[XB_XCNT(j)]); sum += c; cnt += (c > 0u) ? 1u : 0u; mine = (j == x) ? c : mine; }
        if (sum == G) break;
        __builtin_amdgcn_s_sleep(1);
        if ((++sp & 255u) == 0u) { if (xb_ld(&bar[XB_TMO])) break; if (sp > XB_SPIN_CAP) { atomicAdd(&bar[XB_TMO], 1u); break; } }
    }
    nloc = mine > 0u ? mine : 1u; nx = cnt > 0u ? cnt : 1u;
}

__device__ __forceinline__ void xcd_barrier(const XcdBarrier& b) {
    asm volatile("s_waitcnt vmcnt(0)" ::: "memory");
    __syncthreads();
    if (threadIdx.x == 0) {
        unsigned* bar = b.bar;
        __builtin_amdgcn_s_waitcnt(0);
        unsigned nloc = b.st[0], nx = b.st[1];
        if (nloc == 0u) { xcd_barrier_complete(bar, b.x, nloc, nx); b.st[0] = nloc; b.st[1] = nx; }
        const unsigned old = xb_add(&bar[XB_XSUB(b.x)], 1u);
        const unsigned gen = old / nloc;
        if (old + 1u == (gen + 1u) * nloc) {
            __builtin_amdgcn_fence(__ATOMIC_RELEASE, "agent");
            asm volatile("s_waitcnt vmcnt(0)" ::: "memory");
            const unsigned og = xb_add(&bar[XB_TOP], 1u);
            const unsigned tg = og / nx;
            if (og + 1u == (tg + 1u) * nx) xb_add(&bar[XB_TOPGEN], 1u);
            else XB_SPIN(xb_ld(&bar[XB_TOPGEN]) == tg, bar);
            __builtin_amdgcn_fence(__ATOMIC_ACQUIRE, "agent");
            xb_add(&bar[XB_XGEN(b.x)], 1u);
            asm volatile("s_waitcnt vmcnt(0)" ::: "memory");
        } else {
            XB_SPIN(xb_ld(&bar[XB_XGEN(b.x)]) == gen, bar);
            __builtin_amdgcn_fence(__ATOMIC_ACQUIRE, "agent");
            asm volatile("s_waitcnt vmcnt(0)" ::: "memory");
        }
    }
    __syncthreads();
}
enum { PH_PRO_A, PH_PRO_B, PH_CVT, PH_GEMM_IN, PH_GEMM_E, PH_CONV, PH_FOXCUM, PH_FOXNORM, PH_GLA1, PH_GLA2, PH_GLA3, PH_FOX, PH_GEMM_OUT, PH_LN1, PH_GEMM_SC, PH_TOPK, PH_PEERU, PH_PEERV, PH_GEMM_PLE, PH_LN2, PH_COUNT };

template <int PH> __device__ __forceinline__ void run_phase(const Params& p, int l, unsigned char* lds) {
    if constexpr (PH == PH_PRO_A) phase_pro_a(p, lds);
    else if constexpr (PH == PH_PRO_B) phase_pro_b(p, lds);
    else if constexpr (PH == PH_CVT) phase_cvt(p, l);
    else if constexpr (PH == PH_GEMM_IN) phase_gemm_in(p, l, lds);
    else if constexpr (PH == PH_GEMM_E) phase_gemm_e(p, l, lds);
    else if constexpr (PH == PH_CONV) phase_conv(p, l, lds);
    else if constexpr (PH == PH_FOXCUM) phase_fox_cum(p, l, lds);
    else if constexpr (PH == PH_FOXNORM) phase_fox_norm(p, lds);
    else if constexpr (PH == PH_GLA1) phase_gla_b1(p, l, lds);
    else if constexpr (PH == PH_GLA2) phase_gla_b2(p);
    else if constexpr (PH == PH_GLA3) phase_gla_b3(p, l, lds);
    else if constexpr (PH == PH_FOX) phase_fox_mfma(p, l, lds);
    else if constexpr (PH == PH_GEMM_OUT) phase_gemm_out(p, l, lds);
    else if constexpr (PH == PH_LN1) phase_ln((const _Float16*)(p.ws + WS_Y), p.ln1_g + (size_t)l * D, p.ln1_b + (size_t)l * D, nullptr, (bf16*)(p.ws + WS_XB), p.ws + WS_XQ, (float*)(p.ws + WS_XS));
    else if constexpr (PH == PH_GEMM_SC) phase_gemm_sc(p, l, lds);
    else if constexpr (PH == PH_TOPK) phase_topk(p, lds);
    else if constexpr (PH == PH_PEERU) phase_peer_u(p, lds);
    else if constexpr (PH == PH_PEERV) phase_peer_v(p);
    else if constexpr (PH == PH_GEMM_PLE) phase_gemm_ple(p, l, lds);
    else if constexpr (PH == PH_LN2) phase_ln((const _Float16*)(p.ws + WS_Y), p.ln2_g + (size_t)l * D, p.ln2_b + (size_t)l * D, l == DEPTH - 1 ? p.out : nullptr, l == DEPTH - 1 ? nullptr : (bf16*)(p.ws + WS_XB));
}

constexpr int MISC_OFF = LDS_BYTES - 512;
constexpr int CW_BAR = 4096;
static_assert(MISC_OFF + 128 <= LDS_BYTES && (CW_BAR + XCD_BAR_WORDS) * 4 <= (int)CTL_ZERO_BYTES, "control words");

typedef __attribute__((address_space(4))) const Params CParams;
#define PHASE(PH) do { CParams* q_ = pp; asm volatile("" : "+s"(q_)); Params lp_; __builtin_memcpy(&lp_, q_, sizeof(Params)); run_phase<PH>(lp_, l, lds); } while (0)
__global__ void __launch_bounds__(512, 2) mk_fwd(Params p_unused) {
#if defined(__HIP_DEVICE_COMPILE__)
    extern __shared__ __attribute__((aligned(16))) unsigned char lds[];
    CParams* pp = (CParams*)__builtin_amdgcn_kernarg_segment_ptr();
    unsigned char* ws0; { CParams* q_ = pp; asm volatile("" : "+s"(q_)); ws0 = q_->ws; }
    volatile LAS unsigned* MISC = (volatile LAS unsigned*)((LAS unsigned char*)lds + MISC_OFF);
    if (threadIdx.x < 32) MISC[threadIdx.x] = 0u;
    __syncthreads();
    (void)xcd_barrier_post((unsigned*)(ws0 + WS_CTL) + CW_BAR, MISC + 8);
#define GB() do { CParams* qb_ = pp; asm volatile("" : "+s"(qb_)); XcdBarrier b_; b_.bar = (unsigned*)(qb_->ws + WS_CTL) + CW_BAR; b_.x = xb_xcc_id(); b_.st = MISC + 8; xcd_barrier(b_); } while (0)
    { const int l = 0; PHASE(PH_PRO_A); PHASE(PH_PRO_B); } GB();
    for (int l = 0; l < DEPTH; ++l) {
        PHASE(PH_CVT); PHASE(PH_GEMM_IN); GB();
        PHASE(PH_GEMM_E); PHASE(PH_CONV); PHASE(PH_FOXCUM); PHASE(PH_FOXNORM); PHASE(PH_GLA1); GB();
        PHASE(PH_GLA2); PHASE(PH_FOX); GB();
        PHASE(PH_GLA3); GB();
        PHASE(PH_GEMM_OUT); GB();
        PHASE(PH_LN1); GB();
        PHASE(PH_GEMM_SC); GB();
        PHASE(PH_TOPK); GB();
        PHASE(PH_PEERU); GB();
        PHASE(PH_PEERV); GB();
        PHASE(PH_GEMM_PLE); GB();
        PHASE(PH_LN2); GB();
    }
#undef GB
#endif
}

extern "C" void kernel_launch(void* const* d_in, const int* in_sizes, int n_in, void* d_out, int out_size, void* d_ws, size_t ws_size, hipStream_t stream) {
    static int grid = 0;
    if (grid == 0) {
        if (n_in != 23 || ws_size < WS_END) { fprintf(stderr, "kernel_launch: unexpected n_in %d or ws_size %zu\n", n_in, ws_size); grid = -1; return; }
        int dev = 0, cus = 0, per_cu = 0;
        if (hipGetDevice(&dev) != hipSuccess || hipDeviceGetAttribute(&cus, hipDeviceAttributeMultiprocessorCount, dev) != hipSuccess) { grid = -1; return; }
        if (hipFuncSetAttribute((const void*)mk_fwd, hipFuncAttributeMaxDynamicSharedMemorySize, LDS_BYTES) != hipSuccess) { grid = -1; return; }
        if (hipOccupancyMaxActiveBlocksPerMultiprocessor(&per_cu, (const void*)mk_fwd, 512, LDS_BYTES) != hipSuccess || per_cu < 1) { fprintf(stderr, "kernel_launch: occupancy query says %d\n", per_cu); }
        (void)hipGetLastError();
        grid = cus;
    }
    if (grid < 0) return;
    if (hipMemsetAsync((char*)d_ws + WS_CTL, 0, CTL_ZERO_BYTES, stream) != hipSuccess) return;
    Params p; memset(&p, 0, sizeof(p));
    const float** f = (const float**)&p;
    for (int i = 0; i < 23; ++i) f[i] = (const float*)d_in[i];
    p.out = (float*)d_out; p.ws = (unsigned char*)d_ws;
    hipLaunchKernelGGL(mk_fwd, dim3(grid), dim3(512), LDS_BYTES, stream, p);
}
```

```cpp
#include <hip/hip_runtime.h>
#include <cstdio>
#include <cstdint>
#include <cstring>
#include <cmath>
__device__ __forceinline__ int tid_l() { int t = threadIdx.x; asm volatile("" : "+v"(t)); return t; }
__device__ __forceinline__ int bid_l() { int b = blockIdx.x; asm volatile("" : "+s"(b)); return b; }
__device__ __forceinline__ int grid_l() { int g = gridDim.x; asm volatile("" : "+s"(g)); return g; }
namespace pg8 {
#define PG8_LAS __attribute__((address_space(3)))
typedef unsigned short bf16_t;
typedef short bf16x8 __attribute__((ext_vector_type(8)));
typedef float f32x4 __attribute__((ext_vector_type(4)));
typedef unsigned u32x4 __attribute__((ext_vector_type(4)));
constexpr int BM = 256, BK = 64, HALF = 128, HTB = HALF * BK * 2  , STAGE_BYTES = 8 * HTB, NXCD = 8, WGM = 8;

__host__ __device__ __forceinline__ int lds_byte(int r, int c) { const int st = (r >> 4) * 2 + (c >> 5), rr = r & 15, cc = c & 31, ob = rr * 64 + cc * 2; return st * 1024 + (ob ^ (((ob >> 9) & 1) << 5)); }
__host__ __device__ __forceinline__ void stage_rc(int b, int& R, int& C) { const int st = b / 1024, sb = b % 1024, swz = sb ^ (((sb >> 9) & 1) << 5); R = (st >> 1) * 16 + swz / 64; C = (st & 1) * 32 + (swz % 64) / 2; }
__host__ __device__ __forceinline__ int perm32(int rho) { const int n = rho >> 4, i = rho & 15; return 8 * (i >> 2) + 4 * n + (i & 3); }

struct Unit { int pm, pn; };
struct Gemm { const bf16_t* A; const bf16_t* Bt; int M, N, K; };

struct StaticOrder {
    int nM, nN, nwg, G, c;
    __host__ __device__ void init(int M, int N, int G_, int c_) { nM = M / BM; nN = N / BM; nwg = nM * nN; G = G_; c = c_; }
    __host__ __device__ bool next(int i, Unit& u) const {
        const long L = (long)i * G + c; if (L >= nwg) return false;
        int wgid = (int)L; { const int q = nwg / NXCD, r = nwg % NXCD, xcd = wgid % NXCD, off = wgid / NXCD; wgid = (xcd < r ? xcd * (q + 1) : r * (q + 1) + (xcd - r) * q) + off; }
        const int nig = WGM * nN, gid = wgid / nig, fm = gid * WGM, gsz = (nM - fm) < WGM ? (nM - fm) : WGM;
        u.pm = fm + ((wgid % nig) % gsz); u.pn = (wgid % nig) / gsz; return true;
    }
    __device__ __forceinline__ void a_ready(const Unit&) const {}
    __device__ __forceinline__ void done(const Unit&) const {}
};

__device__ __forceinline__ unsigned cvt_pk_bf16(float lo, float hi) { unsigned r; asm volatile("v_cvt_pk_bf16_f32 %0, %1, %2" : "=v"(r) : "v"(lo), "v"(hi)); return r; }
typedef float f32x2 __attribute__((ext_vector_type(2)));
__device__ __forceinline__ f32x2 gelu_pk(f32x2 v) {
    const f32x2 av = __builtin_elementwise_abs(v), d = av * 0.2316418882f + 1.0f;
    f32x2 t; t.x = __builtin_amdgcn_rcpf(d.x); t.y = __builtin_amdgcn_rcpf(d.y);
    f32x2 q = t * 0.5307027145f + (-0.7265760135f); q = q * t + 0.7107068705f; q = q * t + (-0.142248368f); q = q * t + 0.127414796f; q = q * t;
    const f32x2 s = (v * v) * (-0.72134752044f);
    f32x2 e; e.x = __builtin_amdgcn_exp2f(s.x); e.y = __builtin_amdgcn_exp2f(s.y);
    const f32x2 m = v * (q * e), r = v - m;
    f32x2 o; o.x = v.x < 0.f ? m.x : r.x; o.y = v.y < 0.f ? m.y : r.y; return o;
}

template <int ACT  > struct EpiBf16 {
    static constexpr bool PERM = true, AFTER_DRAIN = false; static_assert(ACT == 0 || ACT == 1, "EpiBf16: ACT is 0 (none) or 1 (gelu_pk)");
    bf16_t* O; int ldc; const float* bias; int split_cols; size_t split_stride; float scale0;
    __device__ __forceinline__ void operator()(const f32x4 (&acc)[2][2][4][2], const Unit& u, int wr, int wc, int fr, int fq) const {
        const int row0 = u.pm * BM + wr * 64 + fr; int colt = u.pn * BM; bf16_t* base = O;
        float sc = 1.f; if (split_cols) { const int t = colt / split_cols; base += (size_t)t * split_stride; colt -= t * split_cols; if (t == 0) sc = scale0; }
        const int col0 = colt + wc * 32 + 8 * fq, bcol0 = u.pn * BM + wc * 32 + 8 * fq;
        f32x4 bv[2][2];
#pragma unroll
        for (int bj = 0; bj < 2; ++bj)
#pragma unroll
            for (int n = 0; n < 2; ++n) bv[bj][n] = bias ? *(const f32x4*)(bias + bcol0 + bj * HALF + 4 * n) : (f32x4){0.f, 0.f, 0.f, 0.f};
#pragma unroll
        for (int ai = 0; ai < 2; ++ai)
#pragma unroll
            for (int m = 0; m < 4; ++m) { bf16_t* rowp = base + (size_t)(row0 + ai * HALF + m * 16) * ldc + col0;
#pragma unroll
                for (int bj = 0; bj < 2; ++bj) { f32x4 v0 = acc[ai][bj][m][0] + bv[bj][0], v1 = acc[ai][bj][m][1] + bv[bj][1];
                    if (ACT == 1) { f32x2 a = gelu_pk((f32x2){v0[0], v0[1]}), b = gelu_pk((f32x2){v0[2], v0[3]}), c = gelu_pk((f32x2){v1[0], v1[1]}), d = gelu_pk((f32x2){v1[2], v1[3]});
                        v0 = (f32x4){a.x, a.y, b.x, b.y}; v1 = (f32x4){c.x, c.y, d.x, d.y}; }
                    v0 = v0 * sc; v1 = v1 * sc; u32x4 w; w.x = cvt_pk_bf16(v0[0], v0[1]); w.y = cvt_pk_bf16(v0[2], v0[3]); w.z = cvt_pk_bf16(v1[0], v1[1]); w.w = cvt_pk_bf16(v1[2], v1[3]);
                    *(u32x4*)(rowp + bj * HALF) = w; } }
    }
};
struct EpiF16 {
    static constexpr bool PERM = true, AFTER_DRAIN = false;
    _Float16* O; int ldc;
    __device__ __forceinline__ void operator()(const f32x4 (&acc)[2][2][4][2], const Unit& u, int wr, int wc, int fr, int fq) const {
        typedef _Float16 h8 __attribute__((ext_vector_type(8)));
        const int row0 = u.pm * BM + wr * 64 + fr, col0 = u.pn * BM + wc * 32 + 8 * fq;
#pragma unroll
        for (int ai = 0; ai < 2; ++ai)
#pragma unroll
            for (int m = 0; m < 4; ++m) { _Float16* rowp = O + (size_t)(row0 + ai * HALF + m * 16) * ldc + col0;
#pragma unroll
                for (int bj = 0; bj < 2; ++bj) { const f32x4 a = acc[ai][bj][m][0], b = acc[ai][bj][m][1];
                    h8 o; o[0] = (_Float16)a[0]; o[1] = (_Float16)a[1]; o[2] = (_Float16)a[2]; o[3] = (_Float16)a[3]; o[4] = (_Float16)b[0]; o[5] = (_Float16)b[1]; o[6] = (_Float16)b[2]; o[7] = (_Float16)b[3];
                    *(h8*)(rowp + bj * HALF) = o; } }
    }
};
struct EpiResid {
    static constexpr bool PERM = true, AFTER_DRAIN = false;
    const bf16_t* res; _Float16* Y; int ldc; float alpha;
    __device__ __forceinline__ void operator()(const f32x4 (&acc)[2][2][4][2], const Unit& u, int wr, int wc, int fr, int fq) const {
        const int row0 = u.pm * BM + wr * 64 + fr, col0 = u.pn * BM + wc * 32 + 8 * fq;
#pragma unroll
        for (int ai = 0; ai < 2; ++ai)
#pragma unroll
            for (int m = 0; m < 4; ++m) { const size_t off = (size_t)(row0 + ai * HALF + m * 16) * ldc + col0;
#pragma unroll
                for (int bj = 0; bj < 2; ++bj) { const u32x4 rv = *(const u32x4*)(res + off + bj * HALF);
                    f32x4 r0, r1; r0[0] = __uint_as_float(rv.x << 16); r0[1] = __uint_as_float(rv.x & 0xffff0000u); r0[2] = __uint_as_float(rv.y << 16); r0[3] = __uint_as_float(rv.y & 0xffff0000u);
                    r1[0] = __uint_as_float(rv.z << 16); r1[1] = __uint_as_float(rv.z & 0xffff0000u); r1[2] = __uint_as_float(rv.w << 16); r1[3] = __uint_as_float(rv.w & 0xffff0000u);
                    const f32x4 y0 = r0 * alpha + acc[ai][bj][m][0], y1 = r1 * alpha + acc[ai][bj][m][1];
                    typedef _Float16 h8 __attribute__((ext_vector_type(8))); h8 w; w[0] = (_Float16)y0[0]; w[1] = (_Float16)y0[1]; w[2] = (_Float16)y0[2]; w[3] = (_Float16)y0[3]; w[4] = (_Float16)y1[0]; w[5] = (_Float16)y1[1]; w[6] = (_Float16)y1[2]; w[7] = (_Float16)y1[3];
                    *(h8*)(Y + off + bj * HALF) = w; } }
    }
};
struct EpiPle {
    static constexpr bool PERM = true, AFTER_DRAIN = false;
    const bf16_t* R; _Float16* Y; const bf16_t* E; const float* gb; int ldc;
    __device__ __forceinline__ void operator()(const f32x4 (&acc)[2][2][4][2], const Unit& u, int wr, int wc, int fr, int fq) const {
        const int row0 = u.pm * BM + wr * 64 + fr, col0 = u.pn * BM + wc * 32 + 8 * fq;
        f32x4 bv[2][2];
#pragma unroll
        for (int bj = 0; bj < 2; ++bj)
#pragma unroll
            for (int n = 0; n < 2; ++n) bv[bj][n] = *(const f32x4*)(gb + col0 + bj * HALF + 4 * n);
#pragma unroll
        for (int ai = 0; ai < 2; ++ai)
#pragma unroll
            for (int m = 0; m < 4; ++m) { const size_t off = (size_t)(row0 + ai * HALF + m * 16) * ldc + col0;
#pragma unroll
                for (int bj = 0; bj < 2; ++bj) {
                    const u32x4 ev = *(const u32x4*)(E + off + bj * HALF), rv = *(const u32x4*)(R + off + bj * HALF);
                    float o[8];
#pragma unroll
                    for (int n = 0; n < 2; ++n) {
                        const f32x4 z = acc[ai][bj][m][n] + bv[bj][n];
                        const unsigned e0 = n == 0 ? ev.x : ev.z, e1 = n == 0 ? ev.y : ev.w, r0 = n == 0 ? rv.x : rv.z, r1 = n == 0 ? rv.y : rv.w;
                        f32x4 ee, rr; ee[0] = __uint_as_float(e0 << 16); ee[1] = __uint_as_float(e0 & 0xffff0000u); ee[2] = __uint_as_float(e1 << 16); ee[3] = __uint_as_float(e1 & 0xffff0000u);
                        rr[0] = __uint_as_float(r0 << 16); rr[1] = __uint_as_float(r0 & 0xffff0000u); rr[2] = __uint_as_float(r1 << 16); rr[3] = __uint_as_float(r1 & 0xffff0000u);
#pragma unroll
                        for (int i = 0; i < 4; ++i) o[4 * n + i] = rr[i] + ee[i] * __builtin_amdgcn_rcpf(1.0f + __expf(-z[i])); }
                    typedef _Float16 h8 __attribute__((ext_vector_type(8))); h8 w;
#pragma unroll
                    for (int i = 0; i < 8; ++i) w[i] = (_Float16)o[i];
                    *(h8*)(Y + off + bj * HALF) = w; } }
    }
};
template <class Epi, class Sched, bool ALIGN_EPI = false, bool SP2 = false>
__device__ __forceinline__ void gemm_phase(PG8_LAS unsigned char* lds, const Gemm g, const Sched& S, const Epi& E) {
    const int tid = tid_l(), wid = __builtin_amdgcn_readfirstlane(tid >> 6), lane = tid & 63, wr = wid >> 2, wc = wid & 3, fr = lane & 15, fq = lane >> 4;
    const int K = g.K, nt = K / BK;
    unsigned voffA[2], voffB[2];
#pragma unroll
    for (int i = 0; i < 2; ++i) { int R, C; stage_rc(tid * 16 + i * 8192, R, C); const int Rb = Epi::PERM ? ((R & ~31) + perm32(R & 31)) : R;
        voffA[i] = (unsigned)(R * K + C) * 2u; voffB[i] = (unsigned)(Rb * K + C) * 2u; }
    const size_t kstep = (size_t)(BK * 2);
    const size_t hstep = (size_t)HALF * K * 2;
    const size_t tstep = 2 * hstep;
    const unsigned ldsw = (unsigned)wid * 1024u;
    const int aoff = lds_byte(wr * 64 + fr, fq * 8), boff = lds_byte(wc * 32 + fr, fq * 8);
#define PG8_SA(b, h) (((b) * 2 + (h)) * HTB)
#define PG8_SB(b, h) ((4 + (b) * 2 + (h)) * HTB)
#define PG8_STAGE(bufoff, gbase, voff) do { _Pragma("unroll") for (int _i = 0; _i < 2; ++_i) \
        __builtin_amdgcn_global_load_lds((const unsigned*)((const char*)(gbase) + (voff)[_i]), (PG8_LAS unsigned*)(lds + (bufoff) + ldsw + _i * 8192), 16, 0, 0); } while (0)
#define PG8_LDA(dst, b, h) do { _Pragma("unroll") for (int m = 0; m < 4; ++m) _Pragma("unroll") for (int k = 0; k < 2; ++k) dst[m][k] = *(const PG8_LAS bf16x8*)(lds + PG8_SA(b, h) + aoff + m * 2048 + k * 1024); } while (0)
#define PG8_LDB(dst, b, h) do { _Pragma("unroll") for (int n = 0; n < 2; ++n) _Pragma("unroll") for (int k = 0; k < 2; ++k) dst[n][k] = *(const PG8_LAS bf16x8*)(lds + PG8_SB(b, h) + boff + n * 2048 + k * 1024); } while (0)
#define PG8_MMA(ai, bj, At, Bt) do { __builtin_amdgcn_s_setprio(1); _Pragma("unroll") for (int m = 0; m < 4; ++m) _Pragma("unroll") for (int n = 0; n < 2; ++n) _Pragma("unroll") for (int k = 0; k < 2; ++k) \
        acc[ai][bj][m][n] = __builtin_amdgcn_mfma_f32_16x16x32_bf16(Bt[n][k], At[m][k], acc[ai][bj][m][n], 0, 0, 0); __builtin_amdgcn_s_setprio(0); } while (0)
#define PG8_WAIT_V(n) asm volatile("s_waitcnt vmcnt(" #n ")" ::: "memory")
#define PG8_WAIT_L(n) asm volatile("s_waitcnt lgkmcnt(" #n ")" ::: "memory")
#define PG8_BAR __builtin_amdgcn_s_barrier()
#define PG8_SCHED __builtin_amdgcn_sched_barrier(0)
    Unit cur, nxt; int ui = 0;
    if (!S.next(0, cur)) return;
    f32x4 acc[2][2][4][2];
#pragma unroll
    for (int a = 0; a < 2; ++a)
#pragma unroll
        for (int b = 0; b < 2; ++b)
#pragma unroll
            for (int m = 0; m < 4; ++m)
#pragma unroll
                for (int n = 0; n < 2; ++n) acc[a][b][m][n] = (f32x4){0.f, 0.f, 0.f, 0.f};
    bf16x8 At[4][2], B0[2][2], B1[2][2];
    const char* cA = (const char*)g.A + (size_t)cur.pm * tstep; const char* cB = (const char*)g.Bt + (size_t)cur.pn * tstep;
    S.a_ready(cur);
    if constexpr (SP2) {
        PG8_STAGE(PG8_SB(0, 0), cB, voffB); PG8_STAGE(PG8_SB(0, 1), cB + hstep, voffB); PG8_STAGE(PG8_SA(0, 0), cA, voffA); PG8_STAGE(PG8_SA(0, 1), cA + hstep, voffA);
        if (wr == 1) PG8_BAR;
        PG8_WAIT_V(2); PG8_BAR;
        PG8_STAGE(PG8_SB(1, 0), cB + kstep, voffB); PG8_STAGE(PG8_SA(1, 0), cA + kstep, voffA); PG8_STAGE(PG8_SB(1, 1), cB + hstep + kstep, voffB);
        PG8_WAIT_V(6); PG8_BAR;
    } else {
        PG8_STAGE(PG8_SB(0, 0), cB, voffB); PG8_STAGE(PG8_SA(0, 0), cA, voffA); PG8_STAGE(PG8_SB(0, 1), cB + hstep, voffB); PG8_STAGE(PG8_SA(0, 1), cA + hstep, voffA);
        if (wr == 1) PG8_BAR;
        PG8_WAIT_V(4); PG8_BAR;
        PG8_STAGE(PG8_SB(1, 0), cB + kstep, voffB); PG8_STAGE(PG8_SA(1, 0), cA + kstep, voffA); PG8_STAGE(PG8_SB(1, 1), cB + hstep + kstep, voffB);
        PG8_WAIT_V(6); PG8_BAR;
    }
    for (;;) {
        const bool has_next = S.next(ui + 1, nxt);
        const char* nA = has_next ? (const char*)g.A + (size_t)nxt.pm * tstep : cA; const char* nB = has_next ? (const char*)g.Bt + (size_t)nxt.pn * tstep : cB;
        for (int t = 0; t < nt; t += 2) {
            const bool last = (t == nt - 2);
            const char* a1 = cA + (size_t)(t + 1) * kstep;
            const char* a2 = last ? nA : cA + (size_t)(t + 2) * kstep; const char* b2 = last ? nB : cB + (size_t)(t + 2) * kstep;
            const char* a3 = a2 + kstep; const char* b3 = b2 + kstep;
            if (last && has_next) S.a_ready(nxt);
            if constexpr (SP2) {
            PG8_LDB(B0, 0, 0); PG8_LDB(B1, 0, 1); PG8_SCHED; PG8_LDA(At, 0, 0); PG8_STAGE(PG8_SA(1, 1), a1 + hstep, voffA);
            PG8_WAIT_V(8); PG8_WAIT_L(0); PG8_BAR; PG8_MMA(0, 0, At, B0); PG8_MMA(0, 1, At, B1); PG8_BAR; PG8_SCHED;
            PG8_LDA(At, 0, 1); PG8_STAGE(PG8_SB(0, 0), b2, voffB); PG8_STAGE(PG8_SB(0, 1), b2 + hstep, voffB); PG8_STAGE(PG8_SA(0, 0), a2, voffA);
            PG8_WAIT_V(8); PG8_WAIT_L(0); PG8_BAR; PG8_MMA(1, 0, At, B0); PG8_MMA(1, 1, At, B1); PG8_BAR; PG8_SCHED;
            PG8_LDB(B0, 1, 0); PG8_LDB(B1, 1, 1); PG8_SCHED; PG8_LDA(At, 1, 0); PG8_STAGE(PG8_SA(0, 1), a2 + hstep, voffA);
            PG8_WAIT_V(8); PG8_WAIT_L(0); PG8_BAR; PG8_MMA(0, 0, At, B0); PG8_MMA(0, 1, At, B1); PG8_BAR; PG8_SCHED;
            PG8_LDA(At, 1, 1); PG8_STAGE(PG8_SB(1, 0), b3, voffB); PG8_STAGE(PG8_SB(1, 1), b3 + hstep, voffB); PG8_STAGE(PG8_SA(1, 0), a3, voffA);
            PG8_WAIT_V(8); PG8_WAIT_L(0); PG8_BAR; PG8_MMA(1, 0, At, B0); PG8_MMA(1, 1, At, B1); PG8_BAR; PG8_SCHED;
            } else {
            PG8_LDB(B0, 0, 0); PG8_SCHED; PG8_LDA(At, 0, 0); PG8_STAGE(PG8_SA(1, 1), a1 + hstep, voffA);
            PG8_WAIT_L(8); PG8_BAR; PG8_WAIT_L(0); PG8_MMA(0, 0, At, B0); PG8_BAR; PG8_SCHED;
            PG8_LDB(B1, 0, 1); PG8_STAGE(PG8_SB(0, 0), b2, voffB);
            PG8_BAR; PG8_WAIT_L(0); PG8_MMA(0, 1, At, B1); PG8_BAR;
            PG8_LDA(At, 0, 1); PG8_STAGE(PG8_SA(0, 0), a2, voffA);
            PG8_BAR; PG8_WAIT_L(0); PG8_MMA(1, 0, At, B0); PG8_BAR; PG8_SCHED;
            PG8_STAGE(PG8_SB(0, 1), b2 + hstep, voffB);
            PG8_WAIT_V(6); PG8_BAR; PG8_MMA(1, 1, At, B1); PG8_BAR;
            PG8_LDB(B0, 1, 0); PG8_SCHED; PG8_LDA(At, 1, 0); PG8_STAGE(PG8_SA(0, 1), a2 + hstep, voffA);
            PG8_WAIT_L(8); PG8_BAR; PG8_WAIT_L(0); PG8_MMA(0, 0, At, B0); PG8_BAR; PG8_SCHED;
            PG8_LDB(B1, 1, 1); PG8_STAGE(PG8_SB(1, 0), b3, voffB);
            PG8_BAR; PG8_WAIT_L(0); PG8_MMA(0, 1, At, B1); PG8_BAR;
            PG8_LDA(At, 1, 1); PG8_STAGE(PG8_SA(1, 0), a3, voffA);
            PG8_BAR; PG8_WAIT_L(0); PG8_MMA(1, 0, At, B0); PG8_BAR; PG8_SCHED;
            PG8_STAGE(PG8_SB(1, 1), b3 + hstep, voffB);
            PG8_WAIT_V(6); PG8_BAR; PG8_MMA(1, 1, At, B1); PG8_BAR;
            }
        }
        if constexpr (ALIGN_EPI) { if (wr == 0) PG8_BAR; }
        if constexpr (!Epi::AFTER_DRAIN) { E(acc, cur, wr, wc, fr, fq); S.done(cur); }
        if (!has_next) break;
#pragma unroll
        for (int a = 0; a < 2; ++a)
#pragma unroll
            for (int b = 0; b < 2; ++b)
#pragma unroll
                for (int m = 0; m < 4; ++m)
#pragma unroll
                    for (int n = 0; n < 2; ++n) acc[a][b][m][n] = (f32x4){0.f, 0.f, 0.f, 0.f};
        cur = nxt; cA = nA; cB = nB; ++ui;
        if constexpr (ALIGN_EPI) { if (wr == 1) PG8_BAR; }
    }
    PG8_WAIT_V(0);
    if constexpr (!ALIGN_EPI) { if (wr == 0) PG8_BAR; }
    PG8_BAR;
    if constexpr (Epi::AFTER_DRAIN) { E.fused(acc, cur, wr, wc, fr, fq, lds, wid, lane); S.done(cur); }
#undef PG8_SA
#undef PG8_SB
#undef PG8_STAGE
#undef PG8_LDA
#undef PG8_LDB
#undef PG8_MMA
#undef PG8_WAIT_V
#undef PG8_WAIT_L
#undef PG8_BAR
#undef PG8_SCHED
}
}
#include <hip/hip_bf16.h>
#include <cmath>
namespace attn_body {
using bf16=__hip_bfloat16;
using bf16x8=__attribute__((ext_vector_type(8)))short;
using s16x4=__attribute__((ext_vector_type(4)))short;
using f32x16=__attribute__((ext_vector_type(16)))float;
using u32x4=__attribute__((ext_vector_type(4)))unsigned;
constexpr int BATCH=8,NHEAD=6,SEQ=4096,D=64,KVP=3072,OP=1024;
constexpr int NW=8,QBLK=32,QB=QBLK*NW,KVBLK=64,NQB=SEQ/QB;
constexpr int ATTN_UNIT_ROWS=QB;
__device__ __forceinline__ int crow(int r,int hi){return (r&3)+8*(r>>2)+4*hi;}
#define SBAR() __builtin_amdgcn_sched_barrier(0)
__device__ __forceinline__ void cmask(f32x16&p0,f32x16&p1,int jb,int qrel,int hi){
  const float NEG=-INFINITY; int kb=64*jb+4*hi;
  #pragma unroll
  for(int r=0;r<16;++r){int kv=kb+(r&3)+8*(r>>2); if(kv>qrel)p0[r]=NEG; if(kv+32>qrel)p1[r]=NEG;}
}

constexpr int NSLOT=3, SLOTB=8192;
constexpr int LDS_K=0, LDS_V=NSLOT*SLOTB, LDS_WS=2*NSLOT*SLOTB, LDS_OST=LDS_WS+NW*64*4, LDS_CK=LDS_OST+NW*4096, LDS_BYTES=LDS_CK+SEQ*4;
constexpr float C2=0.125f*1.4426950408889634f;
__device__ __forceinline__ void glds16(const void*gsrc,unsigned lds_dst){unsigned keep;
  asm volatile("s_mov_b32 %0, m0\n\ts_mov_b32 m0, %2\n\ts_nop 0\n\tglobal_load_lds_dwordx4 %1, off\n\ts_mov_b32 m0, %0":"=&s"(keep):"v"(gsrc),"s"(lds_dst):"memory");}
__device__ __forceinline__ float max3f(float a,float b,float c){float r;asm("v_max3_f32 %0, %1, %2, %3":"=v"(r):"v"(a),"v"(b),"v"(c));return r;}
__device__ __forceinline__ float max2f(float a,float b){float r;asm("v_max_f32_e32 %0, %1, %2":"=v"(r):"v"(a),"v"(b));return r;}
__device__ __forceinline__ float fadd_s(float a,float b){float r;asm("v_add_f32_e32 %0, %1, %2":"=v"(r):"v"(a),"v"(b));return r;}
__device__ __forceinline__ float fsub_s(float a,float b){float r;asm("v_sub_f32_e32 %0, %1, %2":"=v"(r):"v"(a),"v"(b));return r;}
typedef float f32x2_t __attribute__((ext_vector_type(2))); typedef float f32x4_t __attribute__((ext_vector_type(4))); typedef __bf16 bf16x2_t __attribute__((ext_vector_type(2)));
__device__ __forceinline__ unsigned cvtpk_s(float lo,float hi){f32x2_t v={lo,hi};bf16x2_t b=__builtin_convertvector(v,bf16x2_t);return __builtin_bit_cast(unsigned,b);}
#define WAIT_BAR(N) asm volatile("s_waitcnt vmcnt(" #N ") lgkmcnt(0)\n\ts_barrier":::"memory")

__device__ __forceinline__ void qkt(f32x16&p0,f32x16&p1,const char*Kslot,const bf16x8*qr,int r32,int hi){
  const char*kb=Kslot+hi*1024+r32*16;
  #pragma unroll
  for(int d0=0;d0<4;++d0){
    const bf16x8 b0=*reinterpret_cast<const bf16x8*>(kb+d0*2048);
    const bf16x8 b1=*reinterpret_cast<const bf16x8*>(kb+d0*2048+512);
    {p0=__builtin_amdgcn_mfma_f32_32x32x16_bf16(b0,qr[d0],p0,0,0,0);p1=__builtin_amdgcn_mfma_f32_32x32x16_bf16(b1,qr[d0],p1,0,0,0);}}
}
typedef __attribute__((address_space(3))) const char* lds_cptr;
typedef short v4i16_t __attribute__((ext_vector_type(4)));
__device__ __forceinline__ void kload8(bf16x8*kf,lds_cptr kp){
  kf[0]=*(const __attribute__((address_space(3))) bf16x8*)(kp);      kf[1]=*(const __attribute__((address_space(3))) bf16x8*)(kp+512);
  kf[2]=*(const __attribute__((address_space(3))) bf16x8*)(kp+2048); kf[3]=*(const __attribute__((address_space(3))) bf16x8*)(kp+2560);
  kf[4]=*(const __attribute__((address_space(3))) bf16x8*)(kp+4096); kf[5]=*(const __attribute__((address_space(3))) bf16x8*)(kp+4608);
  kf[6]=*(const __attribute__((address_space(3))) bf16x8*)(kp+6144); kf[7]=*(const __attribute__((address_space(3))) bf16x8*)(kp+6656);
}
__device__ __forceinline__ void kload2(bf16x8*kf,lds_cptr kp,int j){ kf[2*j]=*(const __attribute__((address_space(3))) bf16x8*)(kp+j*2048); kf[2*j+1]=*(const __attribute__((address_space(3))) bf16x8*)(kp+j*2048+512); }
__device__ __forceinline__ s16x4 vtr(lds_cptr p){ return __builtin_bit_cast(s16x4,__builtin_amdgcn_ds_read_tr16_b64_v4i16((__attribute__((address_space(3))) v4i16_t*)p)); }
__device__ __forceinline__ float rowmax(const f32x16&p0,const f32x16&p1){
  float a=max3f(p0[0],p0[1],p1[0]),b=max3f(p0[2],p0[3],p1[1]);a=max3f(a,p1[2],p1[3]);
  #pragma unroll
  for(int r=4;r<16;r+=4){a=max3f(a,p0[r],p0[r+1]);b=max3f(b,p0[r+2],p0[r+3]);a=max3f(a,p1[r],p1[r+1]);b=max3f(b,p1[r+2],p1[r+3]);}
  const float m=max2f(a,b);
  auto rr=__builtin_amdgcn_permlane32_swap(__float_as_uint(m),__float_as_uint(m),false,false);
  return max2f(__uint_as_float(rr[0]),__uint_as_float(rr[1]));
}
__device__ __forceinline__ void pv(f32x16*o,int vb,bf16x8 pa0,bf16x8 pa1,bf16x8 pa2,bf16x8 pa3){
  #pragma unroll
  for(int d0=0;d0<2;++d0){s16x4 lo[4],hi[4];
    #pragma unroll
    for(int ks=0;ks<4;++ks){
      asm volatile("ds_read_b64_tr_b16 %0,%1 offset:%c2":"=&v"(lo[ks]):"v"(vb),"i"(d0*4096+ks*1024):"memory");
      asm volatile("ds_read_b64_tr_b16 %0,%1 offset:%c2":"=&v"(hi[ks]):"v"(vb),"i"(d0*4096+ks*1024+512):"memory");}
    asm volatile("s_waitcnt lgkmcnt(0)":::"memory");SBAR();
    #define PK(k) (bf16x8){lo[k][0],lo[k][1],lo[k][2],lo[k][3],hi[k][0],hi[k][1],hi[k][2],hi[k][3]}
    o[d0]=__builtin_amdgcn_mfma_f32_32x32x16_bf16(pa0,PK(0),o[d0],0,0,0);
    o[d0]=__builtin_amdgcn_mfma_f32_32x32x16_bf16(pa1,PK(1),o[d0],0,0,0);
    o[d0]=__builtin_amdgcn_mfma_f32_32x32x16_bf16(pa2,PK(2),o[d0],0,0,0);
    o[d0]=__builtin_amdgcn_mfma_f32_32x32x16_bf16(pa3,PK(3),o[d0],0,0,0);
    #undef PK
  }
}

#ifndef ATTN_STORE16
#define ATTN_STORE16(p,v) (*(u32x4*)(p)=(v))
#endif
template<int THRL> __device__ __forceinline__ void attn_unit(int b,int h,int qb,const bf16*Q,const bf16*__restrict__ K,const bf16*__restrict__ V,bf16*O,const float*__restrict__ CKg,const float*__restrict__ KTm,const float*__restrict__ QBm,char*shm){
  const int tid=tid_l(),lane=tid&63,r32=lane&31,hi=lane>>5; const int wid=__builtin_amdgcn_readfirstlane(tid>>6);
  const long rowbase=(long)b*SEQ; const int q0=qb*QB;
  const bf16*Qw=Q+(rowbase+q0+wid*QBLK)*KVP+h*D;
  const float*ckg=CKg+(long)(b*NHEAD+h)*SEQ;
  int j0=0;
  { const int bh_=b*NHEAD+h, NT0_=(q0+QB)/KVBLK; const float qmx=QBm[bh_*NQB+qb]*1.01f;
    const float kd=fmaxf(fmaxf(KTm[bh_*64+4*qb],KTm[bh_*64+4*qb+1]),fmaxf(KTm[bh_*64+4*qb+2],KTm[bh_*64+4*qb+3]));
    const float thr=-(qmx*kd)-48.f; bool skip=false;
    if(lane<NT0_-4){ const float bound=qmx*KTm[bh_*64+lane]+(ckg[q0]-ckg[64*lane+63]); skip=bound<thr; }
    const unsigned long long m_=__ballot(skip); j0=__builtin_ctzll(~m_); j0=(j0<NT0_-4?j0:NT0_-4)&~1; j0=__builtin_amdgcn_readfirstlane(j0); }
  const bf16*Kh=K+(rowbase+(long)j0*KVBLK)*KVP+h*D,*Vh=V+(rowbase+(long)j0*KVBLK)*KVP+h*D;
  const unsigned lds0=(unsigned)(uintptr_t)shm;
  float*wsf=(float*)(shm+LDS_WS)+wid*64;
  const bf16*ksrc=Kh+(long)lane*KVP+wid*8;
  const bf16*vsrc=Vh+(long)(16*(wid&3)+(lane>>2))*KVP+(wid>>2)*32+(lane&3)*8;
  const unsigned kdst=lds0+LDS_K+wid*1024, vdst=lds0+LDS_V+wid*1024;
  #define DMA_K(t,slot) glds16(ksrc+(long)(t)*KVBLK*KVP,(unsigned)__builtin_amdgcn_readfirstlane(kdst+(slot)))
  #define DMA_V(t,slot) glds16(vsrc+(long)(t)*KVBLK*KVP,(unsigned)__builtin_amdgcn_readfirstlane(vdst+(slot)))
  const int vb0=(int)(lds0+LDS_V)+((lane>>4)&1)*32+(lane&3)*8+(4*hi+((lane&15)>>2))*64;
  const char*Kbase=shm+LDS_K; bf16x8 kf[8];
  const lds_cptr shm3=(lds_cptr)shm; const lds_cptr kp0=shm3+LDS_K+hi*1024+r32*16; const lds_cptr vp0=shm3+LDS_V+((lane>>4)&1)*32+(lane&3)*8+(4*hi+((lane&15)>>2))*64;
  const int NT=(q0+QB)/KVBLK-j0;
  float*cks=(float*)(shm+LDS_CK);
  for(int i=j0*KVBLK+tid*4;i<q0+QB;i+=NW*64*4){ *(f32x4_t*)(cks+i)=*(const f32x4_t*)(ckg+i); }
  float cqm=ckg[q0+wid*QBLK+r32];
  const lds_cptr ckp=(lds_cptr)shm+LDS_CK+j0*256+hi*16;
  DMA_K(0,0);DMA_V(0,0);DMA_K(1,SLOTB);
  bf16x8 qr[4];
  #pragma unroll
  for(int d0=0;d0<4;++d0)qr[d0]=*reinterpret_cast<const bf16x8*>(&Qw[(long)r32*KVP+d0*16+hi*8]);
  float l_reg=0.f;f32x16 o[2];o[0]=f32x16{};o[1]=f32x16{};
  #define CINIT(C0,C1,t) do{ const lds_cptr cp_=ckp+(t)*256; \
    _Pragma("unroll") for(int g_=0;g_<4;++g_){ const f32x4_t a_=*(const __attribute__((address_space(3))) f32x4_t*)(cp_+g_*32); const f32x4_t b_=*(const __attribute__((address_space(3))) f32x4_t*)(cp_+g_*32+128); \
      _Pragma("unroll") for(int i_=0;i_<4;++i_){ C0[g_*4+i_]=cqm-a_[i_]; C1[g_*4+i_]=cqm-b_[i_]; } } }while(0)
  const int qrel=wid*QBLK+r32;
  #define CMASK(P0,P1,t) do{int jb_=(t)-(NT-4); if(jb_>=0)cmask(P0,P1,jb_,qrel,hi);}while(0)
  bool resc=false;
  #define START(P0,P1) do{ const float rm=rowmax(P0,P1); resc=false; \
    { const float dl=rm; \
      _Pragma("unroll") for(int r=0;r<16;++r){P0[r]=fsub_s(P0[r],dl);P1[r]=fsub_s(P1[r],dl);} \
      cqm=fsub_s(cqm,dl); } \
    _Pragma("unroll") for(int r=0;r<16;++r)P0[r]=__builtin_amdgcn_exp2f(P0[r]); }while(0)
  #define RESC() do{ if(resc){ asm volatile("s_waitcnt lgkmcnt(0)":::"memory"); \
      _Pragma("unroll") for(int d_=0;d_<2;++d_) _Pragma("unroll") for(int r=0;r<16;++r)o[d_][r]*=wsf[crow(r,hi)]; } }while(0)
  f32x16 pA0,pA1,pB0,pB1;
  int sl_prev=0,sl_cur=0,sl_next=SLOTB;
  #define ROT() do{sl_prev=sl_cur;sl_cur=sl_next;sl_next=(sl_next==(NSLOT-1)*SLOTB)?0:sl_next+SLOTB;}while(0)
  DMA_K(2,2*SLOTB);
  WAIT_BAR(3);
  CINIT(pA0,pA1,0);
  qkt(pA0,pA1,Kbase,qr,r32,hi);asm volatile("s_nop 15\n\ts_nop 7":"+v"(pA0),"+v"(pA1));CMASK(pA0,pA1,0);
  START(pA0,pA1);
  _Pragma("unroll") for(int r=0;r<16;++r)pA1[r]=__builtin_amdgcn_exp2f(pA1[r]);
  WAIT_BAR(0);
  DMA_K(3,0);DMA_V(1,SLOTB);
  ROT();
  kload8(kf,kp0+sl_cur);
  WAIT_BAR(2);
  s16x4 vlo[8],vhi[8]; u32x4 pw0,pw1,pw2,pw3;
  #define PKW(P,B) cvtpk_s(P[B],P[B+1])
  #define PAF(k) __builtin_bit_cast(bf16x8,pw##k)
  #define VFR(i) (bf16x8){vlo[i][0],vlo[i][1],vlo[i][2],vlo[i][3],vhi[i][0],vhi[i][1],vhi[i][2],vhi[i][3]}
  #define PIN(x) asm volatile("":"+v"(x))
  #define MX3(a,b,c) __builtin_fmaxf(__builtin_fmaxf((a),(b)),(c))
  #define GAPA(MF,A0,A1,A2,A3,W0,W1,PW) do{ MF; sacc+=A0; sacc+=A1; sacc+=A2; sacc+=A3; PIN(sacc); W0; W1; PIN(PW); SBAR(); }while(0)
  #define EX(v) __builtin_amdgcn_exp2f(v)
  #define GAPB(MF,X,B) do{ MF; X[B]=EX(X[B]); X[B+1]=EX(X[B+1]); X[B+2]=EX(X[B+2]); X[B+3]=EX(X[B+3]); PIN(X); SBAR(); }while(0)
  #define VRD(i) do{ vlo[i]=vtr(vp_+(((i)>>2)*4096+((i)&3)*1024)); vhi[i]=vtr(vp_+(((i)>>2)*4096+((i)&3)*1024+512)); }while(0)
  #define KRD(G,j) do{ if(G){ kload2(kf,kp0+sl_next,j); SBAR(); } }while(0)
  #define STEP(C0,C1,P0,P1,t,GK,GV,GL) do{ SBAR(); \
    CINIT(C0,C1,t); SBAR(); \
    const lds_cptr vp_=vp0+sl_prev; \
    VRD(0); SBAR(); float sacc=(P0[0]+P0[1]); \
    GAPA(C0=__builtin_amdgcn_mfma_f32_32x32x16_bf16(kf[0],qr[0],C0,0,0,0), P0[2],P0[3],P0[4],P0[5],     pw0[0]=PKW(P0,0), pw0[1]=PKW(P0,2), pw0); \
    VRD(4); SBAR(); GAPA(C1=__builtin_amdgcn_mfma_f32_32x32x16_bf16(kf[1],qr[0],C1,0,0,0), P0[6],P0[7],P0[8],P0[9],     pw0[2]=PKW(P0,4), pw0[3]=PKW(P0,6), pw0); \
    VRD(1); SBAR(); GAPA(C0=__builtin_amdgcn_mfma_f32_32x32x16_bf16(kf[2],qr[1],C0,0,0,0),   P0[10],P0[11],P0[12],P0[13], pw1[0]=PKW(P0,8), pw1[1]=PKW(P0,10), pw1); \
    VRD(5); SBAR(); GAPA(C1=__builtin_amdgcn_mfma_f32_32x32x16_bf16(kf[3],qr[1],C1,0,0,0),   P0[14],P0[15],P1[0],P1[1],   pw1[2]=PKW(P0,12),pw1[3]=PKW(P0,14), pw1); \
    VRD(2); SBAR(); GAPA(C0=__builtin_amdgcn_mfma_f32_32x32x16_bf16(kf[4],qr[2],C0,0,0,0),   P1[2],P1[3],P1[4],P1[5],     pw2[0]=PKW(P1,0), pw2[1]=PKW(P1,2), pw2); \
    VRD(6); SBAR(); GAPA(C1=__builtin_amdgcn_mfma_f32_32x32x16_bf16(kf[5],qr[2],C1,0,0,0),   P1[6],P1[7],P1[8],P1[9],     pw2[2]=PKW(P1,4), pw2[3]=PKW(P1,6), pw2); \
    VRD(3); SBAR(); GAPA(C0=__builtin_amdgcn_mfma_f32_32x32x16_bf16(kf[6],qr[3],C0,0,0,0),   P1[10],P1[11],P1[12],P1[13], pw3[0]=PKW(P1,8), pw3[1]=PKW(P1,10), pw3); \
    VRD(7); SBAR(); GAPA(C1=__builtin_amdgcn_mfma_f32_32x32x16_bf16(kf[7],qr[3],C1,0,0,0),   P1[14],P1[15],0.f,0.f,       pw3[2]=PKW(P1,12),pw3[3]=PKW(P1,14), pw3); \
    l_reg+=sacc; \
    if(GK){DMA_K((t)+3,sl_cur);} if(GV){DMA_V((t)+1,sl_next);} \
    CMASK(C0,C1,t); \
    { float a=MX3(C0[0],C0[1],C1[0]),b=MX3(C0[2],C0[3],C1[1]); a=MX3(a,C1[2],C1[3]); \
      _Pragma("unroll") for(int r=4;r<16;r+=4){a=MX3(a,C0[r],C0[r+1]);b=MX3(b,C0[r+2],C0[r+3]);a=MX3(a,C1[r],C1[r+1]);b=MX3(b,C1[r+2],C1[r+3]);} \
      float rm=__builtin_fmaxf(a,b); { auto rr=__builtin_amdgcn_permlane32_swap(__float_as_uint(rm),__float_as_uint(rm),false,false); rm=__builtin_fmaxf(__uint_as_float(rr[0]),__uint_as_float(rr[1])); } \
      resc=false; \
      if(__builtin_expect(__any(rm>(float)THRL),0)){ const float dl=__builtin_fmaxf(rm,0.f); \
        _Pragma("unroll") for(int r=0;r<16;++r){C0[r]-=dl;C1[r]-=dl;} \
        cqm-=dl; \
        const float f=__builtin_amdgcn_exp2f(-dl); l_reg*=f; if(hi==0)wsf[r32]=f; resc=true; } } \
    SBAR(); \
    GAPB(o[0]=__builtin_amdgcn_mfma_f32_32x32x16_bf16(PAF(0),VFR(0),o[0],0,0,0), C0,0); \
    GAPB(o[1]=__builtin_amdgcn_mfma_f32_32x32x16_bf16(PAF(0),VFR(4),o[1],0,0,0), C0,4); \
    KRD(GL,0); GAPB(o[0]=__builtin_amdgcn_mfma_f32_32x32x16_bf16(PAF(1),VFR(1),o[0],0,0,0), C0,8); \
    KRD(GL,1); GAPB(o[1]=__builtin_amdgcn_mfma_f32_32x32x16_bf16(PAF(1),VFR(5),o[1],0,0,0), C0,12); \
    KRD(GL,2); GAPB(o[0]=__builtin_amdgcn_mfma_f32_32x32x16_bf16(PAF(2),VFR(2),o[0],0,0,0), C1,0); \
    KRD(GL,3); GAPB(o[1]=__builtin_amdgcn_mfma_f32_32x32x16_bf16(PAF(2),VFR(6),o[1],0,0,0), C1,4); \
    GAPB(o[0]=__builtin_amdgcn_mfma_f32_32x32x16_bf16(PAF(3),VFR(3),o[0],0,0,0), C1,8); \
    GAPB(o[1]=__builtin_amdgcn_mfma_f32_32x32x16_bf16(PAF(3),VFR(7),o[1],0,0,0), C1,12); \
    }while(0)
  int t=1;
  #undef CMASK
  #define CMASK(P0,P1,t) do{}while(0)
  for(;t+5<NT;t+=2){
    STEP(pB0,pB1,pA0,pA1,t,true,true,true);     WAIT_BAR(2); RESC(); ROT();
    STEP(pA0,pA1,pB0,pB1,t+1,true,true,true);   WAIT_BAR(2); RESC(); ROT();
  }
  #undef CMASK
  #define CMASK(P0,P1,t) do{int jb_=(t)-(NT-4); if(jb_>=0)cmask(P0,P1,jb_,qrel,hi);}while(0)
  #define ENDW(tt) do{ if((tt)+3<NT){WAIT_BAR(2);} else if((tt)+2<NT){WAIT_BAR(1);} else {WAIT_BAR(0);} }while(0)
  for(;t+1<NT;t+=2){
    STEP(pB0,pB1,pA0,pA1,t,(t+3<NT),(t+1<NT),(t+1<NT));       ENDW(t);   RESC(); ROT();
    STEP(pA0,pA1,pB0,pB1,t+1,(t+4<NT),(t+2<NT),(t+2<NT));     ENDW(t+1); RESC(); ROT();
  }
  STEP(pB0,pB1,pA0,pA1,NT-1,false,false,false); RESC();
  { float sacc=pB0[0]+pB0[1]; _Pragma("unroll") for(int r=2;r<16;++r)sacc+=pB0[r]; _Pragma("unroll") for(int r=0;r<16;++r)sacc+=pB1[r]; l_reg+=sacc;
    pw0=(u32x4){PKW(pB0,0),PKW(pB0,2),PKW(pB0,4),PKW(pB0,6)};pw1=(u32x4){PKW(pB0,8),PKW(pB0,10),PKW(pB0,12),PKW(pB0,14)};pw2=(u32x4){PKW(pB1,0),PKW(pB1,2),PKW(pB1,4),PKW(pB1,6)};pw3=(u32x4){PKW(pB1,8),PKW(pB1,10),PKW(pB1,12),PKW(pB1,14)};
    SBAR(); pv(o,vb0+sl_cur,PAF(0),PAF(1),PAF(2),PAF(3)); }
  #undef PKW
  #undef PAF
  #undef VFR
  #undef PIN
  #undef MX3
  #undef GAPA
  #undef GAPB
  #undef EX
  #undef VRD
  #undef KRD
  #undef STEP
  #undef ENDW
  {auto rr=__builtin_amdgcn_permlane32_swap(__float_as_uint(l_reg),__float_as_uint(l_reg),false,false);l_reg=__uint_as_float(rr[0])+__uint_as_float(rr[1]);}
  if(hi==0)wsf[32+r32]=l_reg;asm volatile("s_waitcnt lgkmcnt(0)":::"memory");
  float rli[16];
  #pragma unroll
  for(int r=0;r<16;++r)rli[r]=__builtin_amdgcn_rcpf(wsf[32+crow(r,hi)]);
  bf16*Ow=O+(rowbase+q0+wid*QBLK)*OP+h*D;
  { bf16*stg=(bf16*)(shm+LDS_OST)+wid*2048;
    #pragma unroll
    for(int r=0;r<16;++r){const int orow=crow(r,hi);
      #pragma unroll
      for(int d0=0;d0<2;++d0)stg[orow*64+d0*32+r32]=__float2bfloat16(o[d0][r]*rli[r]);}
    asm volatile("s_waitcnt lgkmcnt(0)":::"memory");
    #pragma unroll
    for(int i=0;i<4;++i){const int row=i*8+(lane>>3),ch=lane&7; const u32x4 v=*(const u32x4*)(stg+row*64+ch*8); ATTN_STORE16(Ow+(long)row*OP+ch*8,v);} }
  asm volatile("s_waitcnt lgkmcnt(0)\n\ts_barrier":::"memory");
  #undef DMA_K
  #undef DMA_V
  #undef CMASK
  #undef START
  #undef RESC
  #undef ROT
  #undef CINIT
}
constexpr int ATTN_LDS_BYTES=LDS_BYTES;
struct AttnTensors { const bf16* Q; const bf16* K; const bf16* V; bf16* O; const float* CK; const float* KT; const float* QB; };
struct AttnUnit { int bh; int qb; };
struct QueueOrder {
  unsigned* head; volatile __attribute__((address_space(3))) int* slot;
  __device__ __forceinline__ bool next(int,AttnUnit&u)const{
    if(tid_l()==0) *slot=(int)__hip_atomic_fetch_add(head,1u,__ATOMIC_RELAXED,__HIP_MEMORY_SCOPE_AGENT);
    __syncthreads(); const int v=*slot; __syncthreads();
    if(v>=BATCH*NHEAD*NQB)return false; u.qb=NQB-1-v/(BATCH*NHEAD); u.bh=v%(BATCH*NHEAD); return true; }
  __device__ __forceinline__ void a_ready(const AttnUnit&)const{}
  __device__ __forceinline__ void done(const AttnUnit&)const{}
};
template<class Sched,int THRL=8> __device__ __forceinline__ void attn_phase(char*lds,const AttnTensors&T,const Sched&S){
  AttnUnit u;
  for(int i=0;S.next(i,u);++i){ S.a_ready(u); attn_unit<THRL>(u.bh/NHEAD,u.bh%NHEAD,u.qb,T.Q,T.K,T.V,T.O,T.CK,T.KT,T.QB,lds); S.done(u); }
}
#undef SBAR
#undef WAIT_BAR
}

constexpr int NB = 8, SEQ = 4096, T = NB * SEQ, D = 1024, DEPTH = 4;
constexpr int HCOLS = 3072;
constexpr int HC_AVAL = 0, HC_AGATE = 256, HC_BQ = 512, HC_BK = 704, HC_BV = 896, HC_BG = 1280, HC_CQ = 1664, HC_CK = 2048, HC_CV = 2432, HC_LR = 2816, HC_CF = 2832;
constexpr int IN_COLS = 2838;
constexpr int MC_A = 0, MC_B = 256, MC_C = 640;
constexpr float LN_EPS = 1e-5f;
constexpr float ALPHA = 1.6817928305074292f;
constexpr float LOG2E = 1.4426950408889634f;
constexpr float C2 = 0.125f * LOG2E;
constexpr float GLA_QSCALE = 0.17677669529663687f;
constexpr int NEXP = 16384;

constexpr size_t MiB = 1u << 20;
constexpr size_t WS_CTL = 0, CTL_ZERO_BYTES = 1 * MiB;
constexpr size_t WS_WIN = 1 * MiB;
constexpr size_t WS_WOUT = WS_WIN + 24 * MiB;
constexpr size_t WS_WP = WS_WOUT + 8 * MiB;
constexpr size_t WS_PGW = WS_WP + 16 * MiB;
constexpr size_t WS_PW = WS_PGW + 8 * MiB;
constexpr size_t WS_CK = WS_PW + 2 * MiB;
constexpr size_t WS_FKT = WS_CK + 768 * 1024, WS_FQB = WS_FKT + 16 * 1024;
constexpr size_t WS_U = WS_CK + 1 * MiB;
constexpr size_t WS_V = WS_U + 32 * MiB;
constexpr size_t WS_XB = WS_V + 32 * MiB;
constexpr size_t WS_XF = WS_XB + 64 * MiB;
constexpr size_t WS_XQ = WS_XF, WS_XS = WS_XF + 32 * MiB, WS_RS = WS_XS + 1 * MiB, WS_VS = WS_RS + 65536;
constexpr size_t WS_PB = WS_XF + 128 * MiB;
constexpr size_t WS_H = WS_PB + 16 * MiB;
constexpr size_t WS_MIX = WS_H + 192 * MiB;
constexpr size_t WS_SC = WS_H;
constexpr size_t WS_Y = WS_MIX + 64 * MiB;
constexpr size_t WS_GCUM = WS_Y;
constexpr size_t WS_GS = WS_GCUM + 24 * MiB;
constexpr size_t WS_GDEC = WS_GS + 24 * MiB;
constexpr size_t WS_E = WS_Y + 128 * MiB;
constexpr size_t WS_EIDX = WS_E + 64 * MiB;
constexpr size_t WS_GATE = WS_EIDX + 16 * MiB;
constexpr size_t WS_SOFF = WS_GATE + 16 * MiB;
constexpr size_t WS_END = WS_SOFF + 1 * MiB;
static_assert(WS_END <= 1024 * MiB, "d_ws map");

constexpr int LDS_BYTES = 147456;

typedef unsigned short bf16;
typedef float f32x4 __attribute__((ext_vector_type(4)));
typedef unsigned u32x4 __attribute__((ext_vector_type(4)));
typedef unsigned u32x2 __attribute__((ext_vector_type(2)));

struct Params {
    const float *x, *p, *w_in, *conv_w, *conv_b, *conv_ln_g, *conv_ln_b, *gla_gate_w, *gla_gate_b, *gla_norm_g, *fox_forget_b, *w_out, *ln1_g, *ln1_b,
        *peer_wq, *peer_keys, *peer_u, *peer_v, *ple_w, *ple_gw, *ple_gb, *ln2_g, *ln2_b;
    float* out; unsigned char* ws;
};

__device__ __forceinline__ float bf2f(unsigned h) { return __uint_as_float(h << 16); }
__device__ __forceinline__ unsigned f2bf(float f) { unsigned u = __float_as_uint(f); return (u + 0x7fffu + ((u >> 16) & 1u)) >> 16; }
__device__ __forceinline__ unsigned pk2(float lo, float hi) { return f2bf(lo) | (f2bf(hi) << 16); }
__device__ __forceinline__ float wave_sum(float v) {
#pragma unroll
    for (int o = 1; o < 64; o <<= 1) v += __shfl_xor(v, o);
    return v;
}
__device__ __forceinline__ float log_sigmoid(float z) { return fminf(z, 0.f) - log1pf(__expf(-fabsf(z))); }
__device__ __forceinline__ float sigmoidf_(float z) { return 1.0f / (1.0f + __expf(-z)); }

struct MapIdent { __device__ __forceinline__ void operator()(int n, int& c, float& s) const { c = n; s = 1.f; } };
struct MapWin {
    __device__ __forceinline__ void operator()(int n, int& c, float& s) const {
        s = 1.f;
        if (n < HC_CQ) { c = n; if (n >= HC_BQ && n < HC_BK) s = GLA_QSCALE; }
        else if (n < HC_LR) { c = n + 16; if (n < HC_CK) s = C2; }
        else if (n < HC_CF) c = n - HC_LR + 1664;
        else if (n < IN_COLS) c = n;
        else c = -1;
    }
};
template <class CM>
__device__ __forceinline__ void transpose_item(const float* W, int K, int Nsrc, bf16* WT, int item, int nblk, float* scr, int lane, const CM& cm) {
    const int kb = item / nblk, nb = item % nblk, k0 = 64 * kb, n0 = 32 * nb;
    int sc; float scale; cm(n0 + (lane & 31), sc, scale);
#pragma unroll 8
    for (int i = 0; i < 32; ++i) { const int kk = 2 * i + (lane >> 5); scr[kk * 33 + (lane & 31)] = sc >= 0 ? W[(size_t)(k0 + kk) * Nsrc + sc] * scale : 0.f; }
    __builtin_amdgcn_wave_barrier(); asm volatile("s_waitcnt lgkmcnt(0)" ::: "memory");
    const int c = lane & 7;
#pragma unroll
    for (int j = 0; j < 4; ++j) { const int n = (lane >> 3) + 8 * j; const float* s = scr + (8 * c) * 33 + n;
        u32x4 o; o.x = pk2(s[0 * 33], s[1 * 33]); o.y = pk2(s[2 * 33], s[3 * 33]); o.z = pk2(s[4 * 33], s[5 * 33]); o.w = pk2(s[6 * 33], s[7 * 33]);
        *(u32x4*)(WT + (size_t)(n0 + n) * K + k0 + 8 * c) = o; }
    asm volatile("s_waitcnt lgkmcnt(0)" ::: "memory"); __builtin_amdgcn_wave_barrier();
}
__device__ __forceinline__ void cvt_bf16_stream(const float* src, bf16* dst, size_t n8, size_t gtid, size_t gthreads) {
    for (size_t i = gtid; i < n8; i += gthreads) { const f32x4 a = *(const f32x4*)(src + i * 8), b = *(const f32x4*)(src + i * 8 + 4);
        u32x4 o; o.x = pk2(a[0], a[1]); o.y = pk2(a[2], a[3]); o.z = pk2(b[0], b[1]); o.w = pk2(b[2], b[3]); *(u32x4*)(dst + i * 8) = o; }
}

__device__ __forceinline__ void phase_pro_a(const Params& p, unsigned char* lds) {
    const int tid = tid_l(), lane = tid & 63, wave = tid >> 6;
    float* scr = (float*)(lds + wave * 16384);
    const int gw = bid_l() * 8 + wave, NGW = grid_l() * 8;
    constexpr int I_WIN = (D / 64) * (HCOLS / 32), I_SQ = (D / 64) * (D / 32), I_PW = (256 / 64) * (D / 32);
    constexpr int PER_L = I_WIN + 2 * I_SQ + I_PW;
    for (int it = gw; it < DEPTH * PER_L; it += NGW) {
        const int l = it / PER_L; int r = it % PER_L;
        if (r < I_WIN) { transpose_item(p.w_in + (size_t)l * D * IN_COLS, D, IN_COLS, (bf16*)(p.ws + WS_WIN) + (size_t)l * HCOLS * D, r, HCOLS / 32, scr, lane, MapWin()); continue; } r -= I_WIN;
        if (r < I_SQ) { transpose_item(p.w_out + (size_t)l * D * D, D, D, (bf16*)(p.ws + WS_WOUT) + (size_t)l * D * D, r, D / 32, scr, lane, MapIdent()); continue; } r -= I_SQ;
        if (r < I_SQ) { transpose_item(p.ple_gw + (size_t)l * D * D, D, D, (bf16*)(p.ws + WS_PGW) + (size_t)l * D * D, r, D / 32, scr, lane, MapIdent()); continue; } r -= I_SQ;
        transpose_item(p.ple_w + (size_t)l * 256 * D, 256, D, (bf16*)(p.ws + WS_PW) + (size_t)l * D * 256, r, D / 32, scr, lane, MapIdent());
    }
    cvt_bf16_stream(p.x, (bf16*)(p.ws + WS_XB), (size_t)T * D / 8, (size_t)bid_l() * 512 + tid, (size_t)grid_l() * 512);
}
__device__ __forceinline__ void phase_pro_b(const Params& p, unsigned char* lds) {
    const int tid = tid_l();
    float* ks = (float*)lds;
    float* wqs = ks + 128 * 129;
    for (int it = bid_l(); it < DEPTH * 16 * 16; it += grid_l()) {
        const int l = it >> 8, hc = (it >> 4) & 15, kt = it & 15;
        const float* keys = p.peer_keys + ((size_t)l * 16 + hc) * 16384;
        const float* wq = p.peer_wq + (size_t)l * D * 2048 + (size_t)(kt * 64) * 2048 + hc * 128;
        __syncthreads();
        for (int i = tid; i < 128 * 128; i += 512) ks[(i >> 7) * 129 + (i & 127)] = keys[i];
        for (int i = tid; i < 64 * 128; i += 512) wqs[(i >> 7) * 129 + (i & 127)] = wq[(size_t)(i >> 7) * 2048 + (i & 127)];
        __syncthreads();
        const int k = tid & 63, n0 = (tid >> 6) * 16;
        float acc[16];
#pragma unroll
        for (int j = 0; j < 16; ++j) acc[j] = 0.f;
        for (int d = 0; d < 128; ++d) { const float a = wqs[k * 129 + d];
#pragma unroll
            for (int j = 0; j < 16; ++j) acc[j] += a * ks[(n0 + j) * 129 + d]; }
        bf16* WpT = (bf16*)(p.ws + WS_WP) + (size_t)l * 2048 * D;
#pragma unroll
        for (int j = 0; j < 16; ++j) WpT[(size_t)(hc * 128 + n0 + j) * D + kt * 64 + k] = (bf16)f2bf(acc[j]);
    }
}
constexpr float U8_SCALE = 64.f, V8_SCALE = 1.f;
typedef float f32x2v __attribute__((ext_vector_type(2)));
__device__ __forceinline__ unsigned pk_fp8x4(f32x4 v, float sc) {
    const float a = fminf(fmaxf(v[0] * sc, -448.f), 448.f), b = fminf(fmaxf(v[1] * sc, -448.f), 448.f), c = fminf(fmaxf(v[2] * sc, -448.f), 448.f), d = fminf(fmaxf(v[3] * sc, -448.f), 448.f);
    int w = __builtin_amdgcn_cvt_pk_fp8_f32(a, b, 0, false); w = __builtin_amdgcn_cvt_pk_fp8_f32(c, d, w, true); return (unsigned)w;
}
__device__ __forceinline__ void cvt_fp8_stream(const float* src, unsigned char* dst, size_t n16, float sc, size_t gtid, size_t gthreads) {
    for (size_t i = gtid; i < n16; i += gthreads) { const float* s = src + i * 16; u32x4 o;
        o.x = pk_fp8x4(*(const f32x4*)(s), sc); o.y = pk_fp8x4(*(const f32x4*)(s + 4), sc); o.z = pk_fp8x4(*(const f32x4*)(s + 8), sc); o.w = pk_fp8x4(*(const f32x4*)(s + 12), sc);
        *(u32x4*)(dst + i * 16) = o; }
}
__device__ __forceinline__ float wave_max(float v) {
#pragma unroll
    for (int o = 32; o > 0; o >>= 1) v = fmaxf(v, __shfl_xor(v, o));
    return v;
}
__device__ __forceinline__ unsigned pk_i8x4(f32x4 v, float sc) {
    const int a = (int)__builtin_rintf(v[0] * sc), b = (int)__builtin_rintf(v[1] * sc), c = (int)__builtin_rintf(v[2] * sc), d = (int)__builtin_rintf(v[3] * sc);
    return (unsigned)(a & 255) | ((unsigned)(b & 255) << 8) | ((unsigned)(c & 255) << 16) | ((unsigned)d << 24);
}
__device__ __forceinline__ void cvt_i8_rows(const float* src, unsigned char* dst, float* RS, size_t n16, size_t gtid, size_t gthreads) {
    for (size_t i = gtid; i < n16; i += gthreads) { const float* s_ = src + i * 16;
        const f32x4 a = *(const f32x4*)(s_), b = *(const f32x4*)(s_ + 4), c = *(const f32x4*)(s_ + 8), d = *(const f32x4*)(s_ + 12);
        float m = fmaxf(fmaxf(fmaxf(fabsf(a[0]), fabsf(a[1])), fmaxf(fabsf(a[2]), fabsf(a[3]))), fmaxf(fmaxf(fabsf(b[0]), fabsf(b[1])), fmaxf(fabsf(b[2]), fabsf(b[3]))));
        m = fmaxf(m, fmaxf(fmaxf(fmaxf(fabsf(c[0]), fabsf(c[1])), fmaxf(fabsf(c[2]), fabsf(c[3]))), fmaxf(fmaxf(fabsf(d[0]), fabsf(d[1])), fmaxf(fabsf(d[2]), fabsf(d[3])))));
        m = wave_max(m); const float sc = m > 0.f ? 127.0f / m : 0.f;
        u32x4 o; o.x = pk_i8x4(a, sc); o.y = pk_i8x4(b, sc); o.z = pk_i8x4(c, sc); o.w = pk_i8x4(d, sc);
        *(u32x4*)(dst + i * 16) = o;
        if ((i & 63) == 0) RS[i >> 6] = m * (1.0f / 127.0f); }
}
__device__ __forceinline__ void cvt_fp4_rows(const float* src, unsigned char* dst, float* VS, size_t n16, size_t gtid, size_t gthreads) {
    for (size_t i = gtid; i < n16; i += gthreads) { const float* s_ = src + i * 16;
        const f32x4 a = *(const f32x4*)(s_), b = *(const f32x4*)(s_ + 4), c = *(const f32x4*)(s_ + 8), d = *(const f32x4*)(s_ + 12);
        float m = fmaxf(fmaxf(fmaxf(fabsf(a[0]), fabsf(a[1])), fmaxf(fabsf(a[2]), fabsf(a[3]))), fmaxf(fmaxf(fabsf(b[0]), fabsf(b[1])), fmaxf(fabsf(b[2]), fabsf(b[3]))));
        m = fmaxf(m, fmaxf(fmaxf(fmaxf(fabsf(c[0]), fabsf(c[1])), fmaxf(fabsf(c[2]), fabsf(c[3]))), fmaxf(fmaxf(fabsf(d[0]), fabsf(d[1])), fmaxf(fabsf(d[2]), fabsf(d[3])))));
        m = wave_max(m); const float sc = m > 0.f ? 6.0f / m : 0.f;
        unsigned w0 = 0u, w1 = 0u;
        w0 = __builtin_amdgcn_cvt_scalef32_pk_fp4_f32(w0, a[0] * sc, a[1] * sc, 1.0f, 0); w0 = __builtin_amdgcn_cvt_scalef32_pk_fp4_f32(w0, a[2] * sc, a[3] * sc, 1.0f, 1);
        w0 = __builtin_amdgcn_cvt_scalef32_pk_fp4_f32(w0, b[0] * sc, b[1] * sc, 1.0f, 2); w0 = __builtin_amdgcn_cvt_scalef32_pk_fp4_f32(w0, b[2] * sc, b[3] * sc, 1.0f, 3);
        w1 = __builtin_amdgcn_cvt_scalef32_pk_fp4_f32(w1, c[0] * sc, c[1] * sc, 1.0f, 0); w1 = __builtin_amdgcn_cvt_scalef32_pk_fp4_f32(w1, c[2] * sc, c[3] * sc, 1.0f, 1);
        w1 = __builtin_amdgcn_cvt_scalef32_pk_fp4_f32(w1, d[0] * sc, d[1] * sc, 1.0f, 2); w1 = __builtin_amdgcn_cvt_scalef32_pk_fp4_f32(w1, d[2] * sc, d[3] * sc, 1.0f, 3);
        u32x2 o; o.x = w0; o.y = w1; *(u32x2*)(dst + i * 8) = o;
        if ((i & 63) == 0) VS[i >> 6] = m * (1.0f / 6.0f); }
}
__device__ __forceinline__ void phase_cvt(const Params& p, int l) {
    const size_t gtid = (size_t)bid_l() * 512 + tid_l(), gth = (size_t)grid_l() * 512;
    cvt_bf16_stream(p.p + (size_t)l * T * 256, (bf16*)(p.ws + WS_PB), (size_t)T * 256 / 8, gtid, gth);
    cvt_i8_rows(p.peer_u + (size_t)l * NEXP * D, p.ws + WS_U, (float*)(p.ws + WS_RS), (size_t)NEXP * D / 16, gtid, gth);
    cvt_fp4_rows(p.peer_v + (size_t)l * NEXP * D, p.ws + WS_V, (float*)(p.ws + WS_VS), (size_t)NEXP * D / 16, gtid, gth);
}

#define GEMM_RUN(EPI, e, Aptr, Bptr, N_, K_) do { int kk_ = (K_); asm volatile("" : "+s"(kk_)); pg8::Gemm g{(const pg8::bf16_t*)(Aptr), (const pg8::bf16_t*)(Bptr), T, (N_), kk_}; pg8::StaticOrder S; S.init(T, (N_), (int)grid_l(), (int)bid_l()); \
    pg8::gemm_phase<EPI, pg8::StaticOrder, true, true>((PG8_LAS unsigned char*)lds, g, S, e); } while (0)

__device__ __forceinline__ void phase_gemm_in(const Params& p, int l, unsigned char* lds) {
    pg8::EpiBf16<0> e{(pg8::bf16_t*)(p.ws + WS_H), HCOLS, nullptr, 0, 0, 1.f};
    GEMM_RUN(pg8::EpiBf16<0>, e, p.ws + WS_XB, (bf16*)(p.ws + WS_WIN) + (size_t)l * HCOLS * D, HCOLS, D);
}
__device__ __forceinline__ void phase_gemm_e(const Params& p, int l, unsigned char* lds) {
    pg8::EpiBf16<0> e{(pg8::bf16_t*)(p.ws + WS_E), D, nullptr, 0, 0, 1.f};
    GEMM_RUN(pg8::EpiBf16<0>, e, p.ws + WS_PB, (bf16*)(p.ws + WS_PW) + (size_t)l * D * 256, D, 256);
}
__device__ __forceinline__ void phase_gemm_out(const Params& p, int l, unsigned char* lds) {
    pg8::EpiResid e{(const pg8::bf16_t*)(p.ws + WS_XB), (_Float16*)(p.ws + WS_Y), D, ALPHA};
    GEMM_RUN(pg8::EpiResid, e, p.ws + WS_MIX, (bf16*)(p.ws + WS_WOUT) + (size_t)l * D * D, D, D);
}
__device__ __forceinline__ void phase_gemm_sc(const Params& p, int l, unsigned char* lds) {
    pg8::EpiF16 e{(_Float16*)(p.ws + WS_SC), 2048};
    GEMM_RUN(pg8::EpiF16, e, p.ws + WS_XB, (bf16*)(p.ws + WS_WP) + (size_t)l * 2048 * D, 2048, D);
}
__device__ __forceinline__ void phase_gemm_ple(const Params& p, int l, unsigned char* lds) {
    pg8::EpiPle e{(const pg8::bf16_t*)(p.ws + WS_XB), (_Float16*)(p.ws + WS_Y), (const pg8::bf16_t*)(p.ws + WS_E), p.ple_gb + (size_t)l * D, D};
    GEMM_RUN(pg8::EpiPle, e, p.ws + WS_XB, (bf16*)(p.ws + WS_PGW) + (size_t)l * D * D, D, D);
}

__device__ __forceinline__ void phase_conv(const Params& p, int l, unsigned char* lds) {
    const int tid = tid_l(), lane = tid & 63, wave = tid >> 6;
    float* U = (float*)lds;
    float* Yt = U + 62 * 256;
    const bf16* H = (const bf16*)(p.ws + WS_H); bf16* MIX = (bf16*)(p.ws + WS_MIX);
    const float* cw = p.conv_w + (size_t)l * 31 * 256; const float* cb = p.conv_b + l * 256;
    const float* lg = p.conv_ln_g + l * 256; const float* lb = p.conv_ln_b + l * 256;
    for (int it = bid_l(); it < T / 32; it += grid_l()) {
        const int b = it / (SEQ / 32), t0 = (it % (SEQ / 32)) * 32;
        __syncthreads();
        for (int i = tid; i < 62 * 32; i += 512) { const int r = i >> 5, c8 = (i & 31) * 8, t = t0 - 30 + r; f32x4 u0 = {0.f, 0.f, 0.f, 0.f}, u1 = {0.f, 0.f, 0.f, 0.f};
            if (t >= 0) { const bf16* hr = H + (size_t)(b * SEQ + t) * HCOLS; const u32x4 av = *(const u32x4*)(hr + HC_AVAL + c8), gv = *(const u32x4*)(hr + HC_AGATE + c8);
#pragma unroll
                for (int j = 0; j < 2; ++j) { u0[2 * j] = bf2f(av[j] & 0xffffu) * sigmoidf_(bf2f(gv[j] & 0xffffu)); u0[2 * j + 1] = __uint_as_float(av[j] & 0xffff0000u) * sigmoidf_(__uint_as_float(gv[j] & 0xffff0000u));
                                              u1[2 * j] = bf2f(av[2 + j] & 0xffffu) * sigmoidf_(bf2f(gv[2 + j] & 0xffffu)); u1[2 * j + 1] = __uint_as_float(av[2 + j] & 0xffff0000u) * sigmoidf_(__uint_as_float(gv[2 + j] & 0xffff0000u)); } }
            *(f32x4*)(U + r * 256 + c8) = u0; *(f32x4*)(U + r * 256 + c8 + 4) = u1; }
        __syncthreads();
        { const int c = tid & 255, half = tid >> 8; float w[31], win[46];
#pragma unroll
          for (int j = 0; j < 31; ++j) w[j] = cw[j * 256 + c];
#pragma unroll
          for (int j = 0; j < 46; ++j) win[j] = U[(half * 16 + j) * 256 + c];
          const float bias = cb[c];
#pragma unroll
          for (int tl = 0; tl < 16; ++tl) { float y = bias;
#pragma unroll
              for (int j = 0; j < 31; ++j) y += w[j] * win[tl + j];
              Yt[(half * 16 + tl) * 256 + c] = y; } }
        __syncthreads();
        for (int tl = wave * 4; tl < wave * 4 + 4; ++tl) {
            const f32x4 v = *(const f32x4*)(Yt + tl * 256 + lane * 4);
            const float mean = wave_sum((v[0] + v[1]) + (v[2] + v[3])) * (1.f / 256.f);
            const f32x4 d = v - mean; const float var = wave_sum((d[0] * d[0] + d[1] * d[1]) + (d[2] * d[2] + d[3] * d[3])) * (1.f / 256.f);
            const float rstd = 1.0f / sqrtf(var + LN_EPS);
            const f32x4 g4 = *(const f32x4*)(lg + lane * 4), b4 = *(const f32x4*)(lb + lane * 4);
            float o[4];
#pragma unroll
            for (int i = 0; i < 4; ++i) { const float z = d[i] * rstd * g4[i] + b4[i]; o[i] = z * sigmoidf_(z); }
            u32x2 w2; w2.x = pk2(o[0], o[1]); w2.y = pk2(o[2], o[3]);
            *(u32x2*)(MIX + (size_t)(b * SEQ + t0 + tl) * D + MC_A + lane * 4) = w2;
        }
    }
}

__device__ __forceinline__ void phase_fox_cum(const Params& p, int l, unsigned char* lds) {
    const int tid = tid_l(), lane = tid & 63, wave = tid >> 6;
    float* wsum = (float*)lds;
    const bf16* H = (const bf16*)(p.ws + WS_H); float* CK = (float*)(p.ws + WS_CK);
    for (int bh = bid_l(); bh < 48; bh += grid_l()) {
        const int b = bh / 6, h = bh % 6; const float bias = p.fox_forget_b[l * 6 + h];
        float v[8]; float s = 0.f;
#pragma unroll
        for (int i = 0; i < 8; ++i) { const float f = bf2f(H[(size_t)(b * SEQ + tid * 8 + i) * HCOLS + HC_CF + h]); s += log_sigmoid(f + bias) * LOG2E; v[i] = s; }
        float incl = s;
#pragma unroll
        for (int o = 1; o < 64; o <<= 1) { const float n = __shfl_up(incl, o); if (lane >= o) incl += n; }
        __syncthreads();
        if (lane == 63) wsum[wave] = incl;
        __syncthreads();
        float base = incl - s;
        for (int w = 0; w < wave; ++w) base += wsum[w];
#pragma unroll
        for (int i = 0; i < 8; ++i) CK[(size_t)bh * SEQ + tid * 8 + i] = base + v[i];
    }
}

__device__ __forceinline__ void phase_fox_norm(const Params& p, unsigned char* lds) {
    const int tid = tid_l(), lane = tid & 63, wave = tid >> 6;
    float* qns = (float*)lds; float* kns = qns + 256;
    const bf16* H = (const bf16*)(p.ws + WS_H); float* KT = (float*)(p.ws + WS_FKT); float* QBM = (float*)(p.ws + WS_FQB);
    for (int it = bid_l(); it < 48 * 16; it += grid_l()) {
        const int bh = it >> 4, qb = it & 15, b = bh / 6, h = bh % 6;
        __syncthreads();
        if (tid < 256) { const bf16* row = H + ((size_t)b * SEQ + qb * 256 + tid) * HCOLS + h * 64; float sq = 0.f, sk = 0.f;
#pragma unroll
            for (int j = 0; j < 8; ++j) { const u32x4 qv = *(const u32x4*)(row + HC_CQ + 8 * j), kv = *(const u32x4*)(row + HC_CK + 8 * j);
#pragma unroll
                for (int i = 0; i < 4; ++i) { const float a0 = bf2f(qv[i] & 0xffffu), a1 = __uint_as_float(qv[i] & 0xffff0000u), b0 = bf2f(kv[i] & 0xffffu), b1 = __uint_as_float(kv[i] & 0xffff0000u);
                    sq += a0 * a0 + a1 * a1; sk += b0 * b0 + b1 * b1; } }
            qns[tid] = sqrtf(sq); kns[tid] = sqrtf(sk); }
        __syncthreads();
        if (wave < 5) { float v = wave < 4 ? kns[wave * 64 + lane] : fmaxf(fmaxf(qns[lane], qns[64 + lane]), fmaxf(qns[128 + lane], qns[192 + lane]));
#pragma unroll
            for (int o = 1; o < 64; o <<= 1) v = fmaxf(v, __shfl_xor(v, o));
            if (lane == 0) { if (wave < 4) KT[bh * 64 + 4 * qb + wave] = v; else QBM[bh * 16 + qb] = v; } }
    }
}

typedef short bf16x8_t __attribute__((ext_vector_type(8)));
typedef float f32x16_t __attribute__((ext_vector_type(16)));
__device__ __forceinline__ int crow32(int r, int hi) { return (r & 3) + 8 * (r >> 2) + 4 * hi; }
struct GlaB1Pre { u32x4 vv, lr0, lr1; u32x2 kk; float w2v, b2v; };
__device__ __forceinline__ GlaB1Pre gla_b1_load(const Params& p, int l, int it, int tid, int lane, int wave) {
    const int bh = it >> 6, n = it & 63, b = bh / 6, h = bh % 6; const size_t tok0 = (size_t)b * SEQ + n * 64; const bf16* H = (const bf16*)(p.ws + WS_H);
    GlaB1Pre r; r.w2v = p.gla_gate_w[(size_t)l * 16 * 192 + (tid >> 5) * 192 + h * 32 + (tid & 31)]; r.b2v = p.gla_gate_b[l * 192 + h * 32 + (tid & 31)];
    r.vv = *(const u32x4*)(H + (tok0 + (tid >> 3)) * HCOLS + HC_BV + h * 64 + (tid & 7) * 8);
    r.lr0 = *(const u32x4*)(H + (tok0 + lane) * HCOLS + HC_LR); r.lr1 = *(const u32x4*)(H + (tok0 + lane) * HCOLS + HC_LR + 8);
    r.kk = *(const u32x2*)(H + (tok0 + lane) * HCOLS + HC_BK + h * 32 + wave * 4);
    return r;
}
__device__ __forceinline__ void phase_gla_b1(const Params& p, int l, unsigned char* lds) {
    const int tid = tid_l(), lane = tid & 63, wave = tid >> 6, r32 = lane & 31, hi = lane >> 5;
    bf16* KDT = (bf16*)lds;
    bf16* VT = KDT + 32 * 72;
    float* w2s = (float*)(VT + 64 * 72);
    float* b2s = w2s + 16 * 32;
    float* GCUM = (float*)(p.ws + WS_GCUM); float* GS = (float*)(p.ws + WS_GS); float* GDEC = (float*)(p.ws + WS_GDEC);
    const int NI = 48 * 64, G = grid_l(); int it = bid_l();
    if (it >= NI) return;
    GlaB1Pre cur = gla_b1_load(p, l, it, tid, lane, wave);
#pragma unroll 1
    for (; it < NI; it += G) {
        const GlaB1Pre nxt = gla_b1_load(p, l, it + G < NI ? it + G : it, tid, lane, wave);
        __builtin_amdgcn_sched_barrier(0);
        const int bh = it >> 6, n = it & 63, b = bh / 6, h = bh % 6; const size_t tok0 = (size_t)b * SEQ + n * 64;
        __syncthreads();
        w2s[tid] = cur.w2v;
        if (tid < 32) b2s[tid] = cur.b2v;
        { const int s_ = tid >> 3, e0 = (tid & 7) * 8;
#pragma unroll
          for (int i = 0; i < 4; ++i) { VT[(e0 + 2 * i) * 72 + s_] = (bf16)(cur.vv[i] & 0xffffu); VT[(e0 + 2 * i + 1) * 72 + s_] = (bf16)(cur.vv[i] >> 16); } }
        const int d0 = wave * 4;
        __syncthreads();
        float lrf[16];
#pragma unroll
        for (int i = 0; i < 4; ++i) { lrf[2 * i] = bf2f(cur.lr0[i] & 0xffffu); lrf[2 * i + 1] = __uint_as_float(cur.lr0[i] & 0xffff0000u); lrf[8 + 2 * i] = bf2f(cur.lr1[i] & 0xffffu); lrf[8 + 2 * i + 1] = __uint_as_float(cur.lr1[i] & 0xffff0000u); }
        float g[4];
#pragma unroll
        for (int dd = 0; dd < 4; ++dd) { float x = b2s[d0 + dd];
#pragma unroll
            for (int r = 0; r < 16; ++r) x += lrf[r] * w2s[r * 32 + d0 + dd];
            g[dd] = log_sigmoid(x) * (1.0f / 16.0f); }
#pragma unroll
        for (int o = 1; o < 64; o <<= 1)
#pragma unroll
            for (int dd = 0; dd < 4; ++dd) { const float v = __shfl_up(g[dd], o); if (lane >= o) g[dd] += v; }
        *(f32x4*)(GCUM + (tok0 + lane) * 192 + h * 32 + d0) = (f32x4){g[0], g[1], g[2], g[3]};
        const float kf[4] = {bf2f(cur.kk.x & 0xffffu), __uint_as_float(cur.kk.x & 0xffff0000u), bf2f(cur.kk.y & 0xffffu), __uint_as_float(cur.kk.y & 0xffff0000u)};
#pragma unroll
        for (int dd = 0; dd < 4; ++dd) { const float last = __uint_as_float(__builtin_amdgcn_readlane(__float_as_uint(g[dd]), 63));
            KDT[(d0 + dd) * 72 + lane] = (bf16)f2bf(kf[dd] * __expf(last - g[dd]));
            if (lane == 63) GDEC[(size_t)it * 32 + d0 + dd] = __expf(last); }
        __syncthreads();
        if (wave < 2) {
            f32x16_t acc = {};
#pragma unroll
            for (int ks = 0; ks < 4; ++ks) { const bf16x8_t a = *(const bf16x8_t*)(KDT + r32 * 72 + 16 * ks + 8 * hi), bb = *(const bf16x8_t*)(VT + (32 * wave + r32) * 72 + 16 * ks + 8 * hi);
                acc = __builtin_amdgcn_mfma_f32_32x32x16_bf16(a, bb, acc, 0, 0, 0); }
#pragma unroll
            for (int r = 0; r < 16; ++r) GS[(size_t)it * 2048 + crow32(r, hi) * 64 + 32 * wave + r32] = acc[r];
        }
        cur = nxt;
    }
}
__device__ __forceinline__ void phase_gla_b2(const Params& p) {
    float* GS = (float*)(p.ws + WS_GS); const float* GDEC = (const float*)(p.ws + WS_GDEC);
    for (int g = bid_l() * 512 + tid_l(); g < 48 * 2048; g += grid_l() * 512) {
        const int bh = g >> 11, de = g & 2047, d = de >> 6; float S = 0.f;
        float* gs = GS + (size_t)bh * 64 * 2048 + de; const float* gd = GDEC + (size_t)bh * 64 * 32 + d;
#pragma unroll 1
        for (int n0 = 0; n0 < 64; n0 += 16) { float loc[16], dec[16];
#pragma unroll
            for (int i = 0; i < 16; ++i) { loc[i] = gs[(size_t)(n0 + i) * 2048]; dec[i] = gd[(n0 + i) * 32]; }
#pragma unroll
            for (int i = 0; i < 16; ++i) { gs[(size_t)(n0 + i) * 2048] = S; S = S * dec[i] + loc[i]; } }
    }
}
struct GlaB3Pre { u32x2 qq, kk; f32x4 c; u32x4 vv; f32x4 sv; u32x4 gr; };
__device__ __forceinline__ GlaB3Pre gla_b3_load(const Params& p, int it, int tid) {
    const int bh = it >> 6, n = it & 63, b = bh / 6, h = bh % 6; const size_t tok0 = (size_t)b * SEQ + n * 64; const bf16* H = (const bf16*)(p.ws + WS_H);
    const float* GCUM = (const float*)(p.ws + WS_GCUM); const float* GS = (const float*)(p.ws + WS_GS);
    GlaB3Pre r; const int t = tid >> 3, d0 = (tid & 7) * 4;
    r.qq = *(const u32x2*)(H + (tok0 + t) * HCOLS + HC_BQ + h * 32 + d0); r.kk = *(const u32x2*)(H + (tok0 + t) * HCOLS + HC_BK + h * 32 + d0);
    r.c = *(const f32x4*)(GCUM + (tok0 + t) * 192 + h * 32 + d0);
    r.vv = *(const u32x4*)(H + (tok0 + t) * HCOLS + HC_BV + h * 64 + (tid & 7) * 8);
    r.sv = *(const f32x4*)(GS + (size_t)it * 2048 + (tid >> 4) * 64 + (tid & 15) * 4);
    r.gr = *(const u32x4*)(H + (tok0 + t) * HCOLS + HC_BG + h * 64 + (tid & 7) * 8);
    return r;
}
__device__ __forceinline__ void phase_gla_b3(const Params& p, int l, unsigned char* lds) {
    const int tid = tid_l(), lane = tid & 63, wave = tid >> 6, r32 = lane & 31, hi = lane >> 5;
    bf16* QE = (bf16*)lds;
    bf16* KE = QE + 64 * 40;
    bf16* VT = KE + 64 * 40;
    bf16* ST = VT + 64 * 72;
    bf16* P = ST + 64 * 40;
    float* O = (float*)(P + 64 * 72);
    bf16* MIX = (bf16*)(p.ws + WS_MIX);
    const int NI = 48 * 64, G = grid_l(); int it = bid_l();
    if (it >= NI) return;
    GlaB3Pre cur = gla_b3_load(p, it, tid);
#pragma unroll 1
    for (; it < NI; it += G) {
        const GlaB3Pre nxt = gla_b3_load(p, it + G < NI ? it + G : it, tid);
        __builtin_amdgcn_sched_barrier(0);
        const int bh = it >> 6, n = it & 63, b = bh / 6, h = bh % 6; const size_t tok0 = (size_t)b * SEQ + n * 64;
        __syncthreads();
        { const int t = tid >> 3, d0 = (tid & 7) * 4; const u32x2 qq = cur.qq, kk = cur.kk; const f32x4 c = cur.c;
          const float e0 = __expf(c[0]), e1 = __expf(c[1]), e2 = __expf(c[2]), e3 = __expf(c[3]);
          u32x2 qo, ko;
          qo.x = pk2(bf2f(qq.x & 0xffffu) * e0, __uint_as_float(qq.x & 0xffff0000u) * e1); qo.y = pk2(bf2f(qq.y & 0xffffu) * e2, __uint_as_float(qq.y & 0xffff0000u) * e3);
          ko.x = pk2(bf2f(kk.x & 0xffffu) / e0, __uint_as_float(kk.x & 0xffff0000u) / e1); ko.y = pk2(bf2f(kk.y & 0xffffu) / e2, __uint_as_float(kk.y & 0xffff0000u) / e3);
          *(u32x2*)(QE + t * 40 + d0) = qo; *(u32x2*)(KE + t * 40 + d0) = ko; }
        { const int s_ = tid >> 3, e0 = (tid & 7) * 8;
#pragma unroll
          for (int i = 0; i < 4; ++i) { VT[(e0 + 2 * i) * 72 + s_] = (bf16)(cur.vv[i] & 0xffffu); VT[(e0 + 2 * i + 1) * 72 + s_] = (bf16)(cur.vv[i] >> 16); } }
        { const int d = tid >> 4, e0 = (tid & 15) * 4;
#pragma unroll
          for (int i = 0; i < 4; ++i) ST[(e0 + i) * 40 + d] = (bf16)f2bf(cur.sv[i]); }
        __syncthreads();
        f32x16_t acc = {};
        const int tt = (wave & 3) >> 1, tc = wave & 1;
        if (wave < 4) {
            if (!(tt == 0 && tc == 1)) {
#pragma unroll
                for (int ks = 0; ks < 2; ++ks) { const bf16x8_t a = *(const bf16x8_t*)(QE + (32 * tt + r32) * 40 + 16 * ks + 8 * hi), bb = *(const bf16x8_t*)(KE + (32 * tc + r32) * 40 + 16 * ks + 8 * hi);
                    acc = __builtin_amdgcn_mfma_f32_32x32x16_bf16(a, bb, acc, 0, 0, 0); }
#pragma unroll
                for (int r = 0; r < 16; ++r) { const int trow = 32 * tt + crow32(r, hi), scol = 32 * tc + r32; P[trow * 72 + scol] = (bf16)f2bf(scol <= trow ? acc[r] : 0.f); }
            }
        } else {
#pragma unroll
            for (int ks = 0; ks < 2; ++ks) { const bf16x8_t a = *(const bf16x8_t*)(QE + (32 * tt + r32) * 40 + 16 * ks + 8 * hi), bb = *(const bf16x8_t*)(ST + (32 * tc + r32) * 40 + 16 * ks + 8 * hi);
                acc = __builtin_amdgcn_mfma_f32_32x32x16_bf16(a, bb, acc, 0, 0, 0); }
        }
        __syncthreads();
        if (wave >= 4) {
            const int nks = tt == 0 ? 2 : 4;
            for (int ks = 0; ks < nks; ++ks) { const bf16x8_t a = *(const bf16x8_t*)(P + (32 * tt + r32) * 72 + 16 * ks + 8 * hi), bb = *(const bf16x8_t*)(VT + (32 * tc + r32) * 72 + 16 * ks + 8 * hi);
                acc = __builtin_amdgcn_mfma_f32_32x32x16_bf16(a, bb, acc, 0, 0, 0); }
#pragma unroll
            for (int r = 0; r < 16; ++r) O[(32 * tt + crow32(r, hi)) * 65 + 32 * tc + r32] = acc[r];
        }
        __syncthreads();
        { const int t = tid >> 3, e0 = (tid & 7) * 8; float o[8]; float ss = 0.f;
#pragma unroll
          for (int i = 0; i < 8; ++i) { o[i] = O[t * 65 + e0 + i]; ss += o[i] * o[i]; }
          ss += __shfl_xor(ss, 1); ss += __shfl_xor(ss, 2); ss += __shfl_xor(ss, 4);
          const float rs = 1.0f / sqrtf(ss * (1.f / 64.f) + LN_EPS);
          const float* ng = p.gla_norm_g + l * 384 + h * 64 + e0; const u32x4 gr = cur.gr;
          float r[8];
#pragma unroll
          for (int i = 0; i < 4; ++i) { const float ga = bf2f(gr[i] & 0xffffu), gb = __uint_as_float(gr[i] & 0xffff0000u);
              r[2 * i] = o[2 * i] * rs * ng[2 * i] * (ga * sigmoidf_(ga)); r[2 * i + 1] = o[2 * i + 1] * rs * ng[2 * i + 1] * (gb * sigmoidf_(gb)); }
          u32x4 w; w.x = pk2(r[0], r[1]); w.y = pk2(r[2], r[3]); w.z = pk2(r[4], r[5]); w.w = pk2(r[6], r[7]);
          *(u32x4*)(MIX + (tok0 + t) * D + MC_B + h * 64 + e0) = w; }
        cur = nxt;
    }
}

constexpr int LDSQ_OFF = LDS_BYTES - 1024;
constexpr int CW_ATTNQ = 8192;
__device__ __forceinline__ void phase_fox_mfma(const Params& p, int l, unsigned char* lds) {
    const attn_body::bf16* H = (const attn_body::bf16*)(p.ws + WS_H);
    const attn_body::AttnTensors AT{H + HC_CQ, H + HC_CK, H + HC_CV, (attn_body::bf16*)(p.ws + WS_MIX) + MC_C, (const float*)(p.ws + WS_CK), (const float*)(p.ws + WS_FKT), (const float*)(p.ws + WS_FQB)};
    const attn_body::QueueOrder S{(unsigned*)(p.ws + WS_CTL) + CW_ATTNQ + l * 64, (volatile __attribute__((address_space(3))) int*)((__attribute__((address_space(3))) unsigned char*)lds + LDSQ_OFF)};
    attn_body::attn_phase<attn_body::QueueOrder>((char*)lds, AT, S);
}

__device__ __forceinline__ void phase_ln(const _Float16* Y, const float* g, const float* bta, float* dst, bf16* dstb, unsigned char* xq = nullptr, float* xs = nullptr) {
    const int tid = tid_l(), lane = tid & 63, wave = tid >> 6; typedef _Float16 h4 __attribute__((ext_vector_type(4)));
    const int stride = grid_l() * 8; int row = bid_l() * 8 + wave;
    if (row >= T) return;
    h4 cur[4];
#pragma unroll
    for (int j = 0; j < 4; ++j) cur[j] = *(const h4*)(Y + (size_t)row * D + j * 256 + lane * 4);
#pragma unroll 1
    for (; row < T; row += stride) {
        h4 nxt[4]; const int nr = row + stride < T ? row + stride : row;
#pragma unroll
        for (int j = 0; j < 4; ++j) nxt[j] = *(const h4*)(Y + (size_t)nr * D + j * 256 + lane * 4);
        __builtin_amdgcn_sched_barrier(0);
        f32x4 v[4]; float s = 0.f;
#pragma unroll
        for (int j = 0; j < 4; ++j) { v[j] = (f32x4){(float)cur[j][0], (float)cur[j][1], (float)cur[j][2], (float)cur[j][3]}; s += (v[j][0] + v[j][1]) + (v[j][2] + v[j][3]); }
        const float mean = wave_sum(s) * (1.f / D); float s2 = 0.f;
#pragma unroll
        for (int j = 0; j < 4; ++j) { v[j] = v[j] - mean; s2 += (v[j][0] * v[j][0] + v[j][1] * v[j][1]) + (v[j][2] * v[j][2] + v[j][3] * v[j][3]); }
        const float rstd = 1.0f / sqrtf(wave_sum(s2) * (1.f / D) + LN_EPS);
        float am = 0.f;
#pragma unroll
        for (int j = 0; j < 4; ++j) { const f32x4 g4 = *(const f32x4*)(g + j * 256 + lane * 4), b4 = *(const f32x4*)(bta + j * 256 + lane * 4);
            const f32x4 o = v[j] * rstd * g4 + b4; v[j] = o;
            am = fmaxf(am, fmaxf(fmaxf(fabsf(o[0]), fabsf(o[1])), fmaxf(fabsf(o[2]), fabsf(o[3]))));
            if (dst) *(f32x4*)(dst + (size_t)row * D + j * 256 + lane * 4) = o;
            if (dstb) { u32x2 w; w.x = pk2(o[0], o[1]); w.y = pk2(o[2], o[3]); *(u32x2*)(dstb + (size_t)row * D + j * 256 + lane * 4) = w; } }
        if (xq) {
            am = wave_max(am); const float sc = am > 0.f ? 127.0f / am : 0.f;
#pragma unroll
            for (int j = 0; j < 4; ++j) *(unsigned*)(xq + (size_t)row * D + j * 256 + lane * 4) = pk_i8x4(v[j], sc);
            if (lane == 0) xs[row] = am * (1.0f / 127.0f); }
#pragma unroll
        for (int j = 0; j < 4; ++j) cur[j] = nxt[j];
    }
}

__device__ __forceinline__ int f2ord(float x) { const int i = __float_as_int(x); return i ^ ((i >> 31) & 0x7fffffff); }
__device__ __forceinline__ float ord2f(int k) { return __int_as_float(k ^ ((k >> 31) & 0x7fffffff)); }
__device__ __forceinline__ void phase_topk(const Params& p, unsigned char* lds) {
    const int tid = tid_l(), lane = tid & 63, wave = tid >> 6;
    unsigned char* wreg = lds + wave * 17408; unsigned char* tab = wreg;
    const _Float16* SC = (const _Float16*)(p.ws + WS_SC); int* EIDX = (int*)(p.ws + WS_EIDX); float* GATE = (float*)(p.ws + WS_GATE); unsigned long long* SOFF = (unsigned long long*)(p.ws + WS_SOFF);
    for (int g = bid_l() * 512 + tid; g < T * 16; g += grid_l() * 512) {
        const int tok = g >> 4, hc = g & 15;
        typedef _Float16 h8 __attribute__((ext_vector_type(8)));
        { const unsigned char* blk = (const unsigned char*)(SC + (size_t)(g - lane) * 128);
          u32x4 st[16];
#pragma unroll
          for (int j = 0; j < 16; ++j) st[j] = *(const u32x4*)(blk + (size_t)(j * 64 + lane) * 16);
          __builtin_amdgcn_wave_barrier();
#pragma unroll
          for (int j = 0; j < 16; ++j) { const int c = j * 64 + lane; *(u32x4*)(wreg + (c + (c >> 4)) * 16) = st[j]; }
          __builtin_amdgcn_wave_barrier(); }
        const unsigned char* lp = wreg + lane * 272;
#define TK_CE(a, b) do { const int hi_ = max(a, b), lo_ = min(a, b); a = hi_; b = lo_; } while (0)
        int tk[16];
#pragma unroll 1
        for (int gi = 0; gi < 8; ++gi) { const h8 cA = *(const h8*)(lp + gi * 32), c1_ = *(const h8*)(lp + gi * 32 + 16);
            int v[16];
#pragma unroll
            for (int j = 0; j < 8; ++j) { v[j] = (f2ord((float)cA[j]) & ~127) | (127 - (gi * 16 + j)); v[8 + j] = (f2ord((float)c1_[j]) & ~127) | (127 - (gi * 16 + 8 + j)); }
            TK_CE(v[0], v[1]); TK_CE(v[3], v[2]); TK_CE(v[4], v[5]); TK_CE(v[7], v[6]); TK_CE(v[8], v[9]); TK_CE(v[11], v[10]); TK_CE(v[12], v[13]); TK_CE(v[15], v[14]); TK_CE(v[0], v[2]); TK_CE(v[1], v[3]); TK_CE(v[6], v[4]); TK_CE(v[7], v[5]); TK_CE(v[8], v[10]); TK_CE(v[9], v[11]); TK_CE(v[14], v[12]); TK_CE(v[15], v[13]); TK_CE(v[0], v[1]); TK_CE(v[2], v[3]); TK_CE(v[5], v[4]); TK_CE(v[7], v[6]); TK_CE(v[8], v[9]); TK_CE(v[10], v[11]); TK_CE(v[13], v[12]); TK_CE(v[15], v[14]); TK_CE(v[0], v[4]); TK_CE(v[1], v[5]); TK_CE(v[2], v[6]); TK_CE(v[3], v[7]); TK_CE(v[12], v[8]); TK_CE(v[13], v[9]); TK_CE(v[14], v[10]); TK_CE(v[15], v[11]); TK_CE(v[0], v[2]); TK_CE(v[1], v[3]); TK_CE(v[4], v[6]); TK_CE(v[5], v[7]); TK_CE(v[10], v[8]); TK_CE(v[11], v[9]); TK_CE(v[14], v[12]); TK_CE(v[15], v[13]); TK_CE(v[0], v[1]); TK_CE(v[2], v[3]); TK_CE(v[4], v[5]); TK_CE(v[6], v[7]); TK_CE(v[9], v[8]); TK_CE(v[11], v[10]); TK_CE(v[13], v[12]); TK_CE(v[15], v[14]); TK_CE(v[0], v[8]); TK_CE(v[1], v[9]); TK_CE(v[2], v[10]); TK_CE(v[3], v[11]); TK_CE(v[4], v[12]); TK_CE(v[5], v[13]); TK_CE(v[6], v[14]); TK_CE(v[7], v[15]); TK_CE(v[0], v[4]); TK_CE(v[1], v[5]); TK_CE(v[2], v[6]); TK_CE(v[3], v[7]); TK_CE(v[8], v[12]); TK_CE(v[9], v[13]); TK_CE(v[10], v[14]); TK_CE(v[11], v[15]); TK_CE(v[0], v[2]); TK_CE(v[1], v[3]); TK_CE(v[4], v[6]); TK_CE(v[5], v[7]); TK_CE(v[8], v[10]); TK_CE(v[9], v[11]); TK_CE(v[12], v[14]); TK_CE(v[13], v[15]); TK_CE(v[0], v[1]); TK_CE(v[2], v[3]); TK_CE(v[4], v[5]); TK_CE(v[6], v[7]); TK_CE(v[8], v[9]); TK_CE(v[10], v[11]); TK_CE(v[12], v[13]); TK_CE(v[14], v[15]);
            if (gi == 0) {
#pragma unroll
                for (int j = 0; j < 16; ++j) tk[j] = v[j]; }
            else {
#pragma unroll
                for (int j = 0; j < 16; ++j) tk[j] = max(tk[j], v[15 - j]);
                TK_CE(tk[0], tk[8]); TK_CE(tk[1], tk[9]); TK_CE(tk[2], tk[10]); TK_CE(tk[3], tk[11]); TK_CE(tk[4], tk[12]); TK_CE(tk[5], tk[13]); TK_CE(tk[6], tk[14]); TK_CE(tk[7], tk[15]); TK_CE(tk[0], tk[4]); TK_CE(tk[1], tk[5]); TK_CE(tk[2], tk[6]); TK_CE(tk[3], tk[7]); TK_CE(tk[8], tk[12]); TK_CE(tk[9], tk[13]); TK_CE(tk[10], tk[14]); TK_CE(tk[11], tk[15]); TK_CE(tk[0], tk[2]); TK_CE(tk[1], tk[3]); TK_CE(tk[4], tk[6]); TK_CE(tk[5], tk[7]); TK_CE(tk[8], tk[10]); TK_CE(tk[9], tk[11]); TK_CE(tk[12], tk[14]); TK_CE(tk[13], tk[15]); TK_CE(tk[0], tk[1]); TK_CE(tk[2], tk[3]); TK_CE(tk[4], tk[5]); TK_CE(tk[6], tk[7]); TK_CE(tk[8], tk[9]); TK_CE(tk[10], tk[11]); TK_CE(tk[12], tk[13]); TK_CE(tk[14], tk[15]); }
            }
        __builtin_amdgcn_wave_barrier();
#undef TK_CE
        float av[16], bv[16]; int ai[16], bi[16]; const bool c1 = (hc & 1) != 0;
#pragma unroll
        for (int j = 0; j < 16; ++j) { const int ok = __shfl_xor(tk[j], 1); const int ka = c1 ? ok : tk[j], kb = c1 ? tk[j] : ok;
            av[j] = ord2f(ka & ~127); ai[j] = 127 - (ka & 127); bv[j] = ord2f(kb & ~127); bi[j] = 127 - (kb & 127); }
#pragma unroll
        for (int j = 0; j < 16; ++j) { tab[j * 64 + lane] = (unsigned char)ai[j]; tab[(16 + j) * 64 + lane] = (unsigned char)bi[j]; }
        int ck[16];
#pragma unroll
        for (int j = 0; j < 16; ++j) ck[j] = (int)0x80000000;
#pragma unroll
        for (int i = 0; i < 16; ++i)
#pragma unroll
            for (int j = 0; j < 16 / (i + 1); ++j) { int x = (f2ord(av[i] + bv[j]) & ~255) | (255 - (i * 16 + j));
#pragma unroll
                for (int q = 0; q < 16; ++q) { const int hi = max(ck[q], x); x = min(ck[q], x); ck[q] = hi; } }
        float den = 0.f; float ex[16]; const float c0 = ord2f(ck[0] & ~255);
#pragma unroll
        for (int j = 0; j < 16; ++j) { ex[j] = __expf(ord2f(ck[j] & ~255) - c0); den += ex[j]; }
        const float inv = 1.0f / den;
        int eid[16]; unsigned long long cnt = 0ull;
#pragma unroll
        for (int j = 0; j < 16; ++j) { const int flat = 255 - (ck[j] & 255); eid[j] = (int)tab[(flat >> 4) * 64 + lane] * 128 + (int)tab[(16 + (flat & 15)) * 64 + lane];
            if (!c1) cnt += 1ull << (8 * (eid[j] >> 11)); }
        unsigned long long incl = cnt;
#pragma unroll
        for (int o = 1; o < 16; o <<= 1) { const unsigned lo = __shfl_up((unsigned)incl, o, 16), hi = __shfl_up((unsigned)(incl >> 32), o, 16); if ((hc & 15) >= o) incl += ((unsigned long long)hi << 32) | lo; }
        const unsigned long long total = ((unsigned long long)__shfl((unsigned)(incl >> 32), 15, 16) << 32) | __shfl((unsigned)incl, 15, 16);
        const unsigned long long base = total * 0x0101010101010100ull;
        unsigned long long run = base + (incl - cnt);
        if (hc == 0) SOFF[tok] = base;
        if (!c1) {
#pragma unroll
            for (int j = 0; j < 16; ++j) { const int sh = 8 * (eid[j] >> 11); const int pos = (int)((run >> sh) & 0xffull); run += 1ull << sh;
                EIDX[(size_t)tok * 128 + pos] = eid[j]; GATE[(size_t)tok * 128 + pos] = ex[j] * inv; } }
    }
}

__device__ __forceinline__ float gelu_tanh(float h) { const float z = 0.7978845608028654f * (h + 0.044715f * h * h * h); const float t = 1.0f - 2.0f / (__expf(2.0f * z) + 1.0f); return 0.5f * h * (1.0f + t); }
#define LAS3 __attribute__((address_space(3)))
struct PeerTok { u32x4 xq; float xs; unsigned long long so; int e_lo, e_hi; float g_lo, g_hi; };
__device__ __forceinline__ PeerTok peer_tok_load(const unsigned char* XQ, const float* XS, const int* EIDX, const float* GATE, const unsigned long long* SOFF, int tok, int lane) {
    PeerTok t; const int tk = tok < T ? tok : T - 1;
    t.xq = __builtin_nontemporal_load((const u32x4*)(XQ + (size_t)tk * D + lane * 16)); t.xs = XS[tk];
    t.so = SOFF[tk]; t.e_lo = EIDX[(size_t)tk * 128 + lane]; t.e_hi = EIDX[(size_t)tk * 128 + 64 + lane]; t.g_lo = GATE[(size_t)tk * 128 + lane]; t.g_hi = GATE[(size_t)tk * 128 + 64 + lane];
    return t;
}
__device__ __forceinline__ void peer_slot_write(LAS3 unsigned char* sl, const PeerTok& t, int lane) {
    *(LAS3 u32x4*)(sl + lane * 16) = t.xq; *(LAS3 int*)(sl + 1024 + lane * 4) = t.e_lo; *(LAS3 int*)(sl + 1280 + lane * 4) = t.e_hi;
    *(LAS3 float*)(sl + 1536 + lane * 4) = t.g_lo; *(LAS3 float*)(sl + 1792 + lane * 4) = t.g_hi;
}
template <int CTRL> __device__ __forceinline__ float dpp_mov(float v) { return __int_as_float(__builtin_amdgcn_update_dpp(0, __float_as_int(v), CTRL, 0xf, 0xf, false)); }
template <int CTRL> __device__ __forceinline__ int dpp_movi(int v) { return __builtin_amdgcn_update_dpp(0, v, CTRL, 0xf, 0xf, false); }
__device__ __forceinline__ float gelu_tanh_fast(float h) { const float z = 0.7978845608028654f * (h + 0.044715f * h * h * h); const float t = 1.0f - 2.0f * __builtin_amdgcn_rcpf(__expf(2.0f * z) + 1.0f); return 0.5f * h * (1.0f + t); }
#define PEER_ISSUE(R, sl_, ks_, kl_) do { const int kA_ = min((ks_) + g4, (kl_)), kB_ = min((ks_) + 4 + g4, (kl_)); \
    const int eA_ = *(const LAS3 int*)((sl_) + 1024 + kA_ * 4), eB_ = *(const LAS3 int*)((sl_) + 1024 + kB_ * 4); \
    const unsigned char* pA_ = U8l + (size_t)eA_ * D; const unsigned char* pB_ = U8l + (size_t)eB_ * D; \
    _Pragma("unroll") for (int i_ = 0; i_ < 4; ++i_) { R[i_] = *(const u32x4*)(pA_ + 256 * i_); R[4 + i_] = *(const u32x4*)(pB_ + 256 * i_); } } while (0)
#define PEER_COMPUTE(RC) do { int aA_ = 0, aB_ = 0; \
    _Pragma("unroll") for (int i_ = 0; i_ < 4; ++i_) _Pragma("unroll") for (int w_ = 0; w_ < 4; ++w_) aA_ = __builtin_amdgcn_sdot4((int)RC[i_][w_], (int)xp[i_][w_], aA_, false); \
    if (k0 + 4 < end) { _Pragma("unroll") for (int i_ = 0; i_ < 4; ++i_) _Pragma("unroll") for (int w_ = 0; w_ < 4; ++w_) aB_ = __builtin_amdgcn_sdot4((int)RC[4 + i_][w_], (int)xp[i_][w_], aB_, false); } \
    else { asm volatile("" :: "v"(RC[4]), "v"(RC[5]), "v"(RC[6]), "v"(RC[7])); }     \
    aA_ += dpp_movi<0x128>(aA_); aB_ += dpp_movi<0x128>(aB_); aA_ += dpp_movi<0x124>(aA_); aB_ += dpp_movi<0x124>(aB_); \
    aA_ += dpp_movi<0x122>(aA_); aB_ += dpp_movi<0x122>(aB_); aA_ += dpp_movi<0x121>(aA_); aB_ += dpp_movi<0x121>(aB_); \
    { const int rel = (lane - k0) & 63; const int src = (rel & 3) << 6; \
      const int ga = __builtin_amdgcn_ds_bpermute(src, aA_), gb = __builtin_amdgcn_ds_bpermute(src, aB_); \
      const float gq = (float)((rel & 4) ? gb : ga); const int kq = k0 + rel;              \
      c_lo = (rel < 8 && kq < 64) ? gq : c_lo; c_hi = (rel < 8 && kq >= 64) ? gq : c_hi; } } while (0)
#define PEER_KL(st, en) min(max((en) - 1, (st)), 127)
#define PEER_NEXT(RN) do { __builtin_amdgcn_sched_barrier(0); { const bool more_ = k0 + 8 < end; const LAS3 unsigned char* sl_ = wl + ((more_ ? sc : (sc ^ 1)) << 11); \
    const int ks_ = more_ ? k0 + 8 : ns, kl_ = more_ ? PEER_KL(start, end) : PEER_KL(ns, ne); PEER_ISSUE(RN, sl_, ks_, kl_); } __builtin_amdgcn_sched_barrier(0); } while (0)
#define PEER_RANGE(slo, shi, st, en) do { const unsigned lo_ = __builtin_amdgcn_readfirstlane(slo), hi_ = __builtin_amdgcn_readfirstlane(shi); \
    const unsigned long long so_ = ((unsigned long long)hi_ << 32) | lo_; st = (int)((so_ >> (8 * g0)) & 0xffull); en = g1 < 8 ? (int)((so_ >> (8 * g1)) & 0xffull) : 128; } while (0)
#define PEER_CUR() do { const LAS3 unsigned char* cs_ = wl + (sc << 11); \
    _Pragma("unroll") for (int i_ = 0; i_ < 4; ++i_) xp[i_] = *(const LAS3 u32x4*)(cs_ + 256 * i_ + l16 * 16); \
    const int e0_ = *(const LAS3 int*)(cs_ + 1024 + lane * 4), e1_ = *(const LAS3 int*)(cs_ + 1280 + lane * 4); cg_lo = *(const LAS3 float*)(cs_ + 1536 + lane * 4); cg_hi = *(const LAS3 float*)(cs_ + 1792 + lane * 4); \
    rs_lo = RS[e0_]; rs_hi = RS[e1_]; vs_lo = VS[e0_]; vs_hi = VS[e1_]; } while (0)
#define PEER_ADVANCE() do { k0 += 8; if (k0 >= end) { \
        if (tok < T) { \
        if (lane >= start && lane < end) GATE[(size_t)tok * 128 + lane] = cg_lo * gelu_tanh_fast(c_lo * (rs_lo * xs)) * vs_lo; \
        if (lane + 64 >= start && lane + 64 < end) GATE[(size_t)tok * 128 + 64 + lane] = cg_hi * gelu_tanh_fast(c_hi * (rs_hi * xs)) * vs_hi; } \
        tok += stride; peer_slot_write(wl + (sc << 11), n2, lane); sc ^= 1; \
        start = ns; end = ne; PEER_RANGE((unsigned)n2.so, (unsigned)(n2.so >> 32), ns, ne); xs = nxs; nxs = __uint_as_float(__builtin_amdgcn_readfirstlane(__float_as_uint(n2.xs))); k0 = start; c_lo = 0.f; c_hi = 0.f; \
        PEER_CUR(); __builtin_amdgcn_sched_barrier(0); \
        n2 = peer_tok_load(XQ, XS, EIDX, GATE, SOFF, tok + 2 * stride, lane); __builtin_amdgcn_sched_barrier(0); } } while (0)
__device__ __forceinline__ void phase_peer_u(const Params& p, unsigned char* lds) {
    const int tid = tid_l(), lane = tid & 63, wave = tid >> 6, bid = bid_l(), G = grid_l(), l16 = lane & 15, g4 = lane >> 4;
    const unsigned char* XQ = p.ws + WS_XQ; const float* XS = (const float*)(p.ws + WS_XS); const float* RS = (const float*)(p.ws + WS_RS); const float* VS = (const float*)(p.ws + WS_VS); const unsigned char* U8l = p.ws + WS_U + l16 * 16;
    const int* EIDX = (const int*)(p.ws + WS_EIDX); float* GATE = (float*)(p.ws + WS_GATE); const unsigned long long* SOFF = (const unsigned long long*)(p.ws + WS_SOFF);
    const int ngrp = (G % 8 == 0) ? 8 : 1;
    const int g0 = (ngrp == 8) ? (bid & 7) : 0, g1 = (ngrp == 8) ? g0 + 1 : 8, r = (ngrp == 8) ? (bid >> 3) : bid, R = (ngrp == 8) ? (G >> 3) : G;
    const int stride = R * 8; int tok = __builtin_amdgcn_readfirstlane(r * 8 + wave);
    if (tok >= T) return;
    LAS3 unsigned char* wl = (LAS3 unsigned char*)lds + wave * 4096;
    int sc = 0, start, end, ns, ne; float xs, nxs;
    PeerTok n2;
    { const PeerTok t0 = peer_tok_load(XQ, XS, EIDX, GATE, SOFF, tok, lane), t1 = peer_tok_load(XQ, XS, EIDX, GATE, SOFF, tok + stride, lane);
      peer_slot_write(wl, t0, lane); peer_slot_write(wl + 2048, t1, lane);
      PEER_RANGE((unsigned)t0.so, (unsigned)(t0.so >> 32), start, end); PEER_RANGE((unsigned)t1.so, (unsigned)(t1.so >> 32), ns, ne); xs = __uint_as_float(__builtin_amdgcn_readfirstlane(__float_as_uint(t0.xs))); nxs = __uint_as_float(__builtin_amdgcn_readfirstlane(__float_as_uint(t1.xs))); }
    n2 = peer_tok_load(XQ, XS, EIDX, GATE, SOFF, tok + 2 * stride, lane);
    u32x4 xp[4]; float cg_lo, cg_hi, rs_lo, rs_hi, vs_lo, vs_hi;
    PEER_CUR();
    float c_lo = 0.f, c_hi = 0.f;
    int k0 = start;
    u32x4 Ra[8], Rb[8];
    PEER_ISSUE(Ra, wl, start, PEER_KL(start, end));
#pragma unroll 1
    do {
        PEER_NEXT(Rb); PEER_COMPUTE(Ra); PEER_ADVANCE();
        PEER_NEXT(Ra); PEER_COMPUTE(Rb); PEER_ADVANCE();
    } while (tok < T);
}
#undef PEER_ISSUE
#undef PEER_COMPUTE
#undef PEER_NEXT
#undef PEER_KL
#undef PEER_RANGE
#undef PEER_CUR
#undef PEER_ADVANCE
struct PeerVMeta { int e_lo, e_hi; float c_lo, c_hi; u32x4 x0, x1; };
__device__ __forceinline__ PeerVMeta peer_vmeta_load(const int* EIDX, const float* COEF, const bf16* XB, int tok, int lane) {
    PeerVMeta m;
    m.e_lo = EIDX[(size_t)tok * 128 + lane]; m.e_hi = EIDX[(size_t)tok * 128 + 64 + lane]; m.c_lo = COEF[(size_t)tok * 128 + lane]; m.c_hi = COEF[(size_t)tok * 128 + 64 + lane];
    const int xo = (lane & 31) * 32 + (lane >> 5) * 16;
    m.x0 = *(const u32x4*)(XB + (size_t)tok * D + xo); m.x1 = *(const u32x4*)(XB + (size_t)tok * D + xo + 8);
    return m;
}
__device__ __forceinline__ void phase_peer_v(const Params& p) {
    const int tid = tid_l(), lane = tid & 63, wave = tid >> 6;
    const unsigned char* V4l = p.ws + WS_V + (lane & 31) * 16;
    const int* EIDX = (const int*)(p.ws + WS_EIDX); const float* COEF = (const float*)(p.ws + WS_GATE);
    bf16* XB = (bf16*)(p.ws + WS_XB);
    const int hb = (lane & 32) << 2;
    const int stride = grid_l() * 8; int tok = __builtin_amdgcn_readfirstlane(bid_l() * 8 + wave);
    if (tok >= T) return;
    PeerVMeta cur = peer_vmeta_load(EIDX, COEF, XB, tok, lane);
#pragma unroll 1
    for (; tok < T; tok += stride) {
        const PeerVMeta nxt = peer_vmeta_load(EIDX, COEF, XB, tok + stride < T ? tok + stride : tok, lane);
        __builtin_amdgcn_sched_barrier(0);
        const auto se = __builtin_amdgcn_permlane32_swap((unsigned)cur.e_lo, (unsigned)cur.e_hi, false, false); const auto sc_ = __builtin_amdgcn_permlane32_swap(__float_as_uint(cur.c_lo), __float_as_uint(cur.c_hi), false, false);
        f32x2v acc[16];
#pragma unroll
        for (int i = 0; i < 16; ++i) acc[i] = (f32x2v){0.f, 0.f};
#pragma unroll 1
        for (int j0 = 0; j0 < 64; j0 += 8) {
            const int pe = j0 < 32 ? (int)se[0] : (int)se[1]; const int pc = j0 < 32 ? (int)sc_[0] : (int)sc_[1];
            u32x4 vr[8]; float cf[8];
#pragma unroll
            for (int q = 0; q < 8; ++q) { const int a_ = hb + (((j0 & 31) + q) << 2); const int e = __builtin_amdgcn_ds_bpermute(a_, pe); cf[q] = __int_as_float(__builtin_amdgcn_ds_bpermute(a_, pc));
                vr[q] = *(const u32x4*)(V4l + (size_t)e * 512); }
#pragma unroll
            for (int q = 0; q < 8; ++q) { const f32x2v c2 = (f32x2v){cf[q], cf[q]};
#pragma unroll
                for (int w = 0; w < 4; ++w) {
                    acc[4 * w] += __builtin_amdgcn_cvt_scalef32_pk_f32_fp4(vr[q][w], 1.0f, 0) * c2; acc[4 * w + 1] += __builtin_amdgcn_cvt_scalef32_pk_f32_fp4(vr[q][w], 1.0f, 1) * c2;
                    acc[4 * w + 2] += __builtin_amdgcn_cvt_scalef32_pk_f32_fp4(vr[q][w], 1.0f, 2) * c2; acc[4 * w + 3] += __builtin_amdgcn_cvt_scalef32_pk_f32_fp4(vr[q][w], 1.0f, 3) * c2; } }
        }
        float sres[16];
#pragma unroll
        for (int i = 0; i < 8; ++i)
#pragma unroll
            for (int c = 0; c < 2; ++c) { const auto r_ = __builtin_amdgcn_permlane32_swap(__float_as_uint(acc[i][c]), __float_as_uint(acc[8 + i][c]), false, false);
                sres[2 * i + c] = __uint_as_float(r_[0]) + __uint_as_float(r_[1]); }
        float r[16];
#pragma unroll
        for (int i = 0; i < 4; ++i) { r[2 * i] = ALPHA * bf2f(cur.x0[i] & 0xffffu) + sres[2 * i]; r[2 * i + 1] = ALPHA * __uint_as_float(cur.x0[i] & 0xffff0000u) + sres[2 * i + 1];
                                      r[8 + 2 * i] = ALPHA * bf2f(cur.x1[i] & 0xffffu) + sres[8 + 2 * i]; r[8 + 2 * i + 1] = ALPHA * __uint_as_float(cur.x1[i] & 0xffff0000u) + sres[8 + 2 * i + 1]; }
        const int xo = (lane & 31) * 32 + (lane >> 5) * 16;
#pragma unroll
        for (int w = 0; w < 2; ++w) { u32x4 o; o.x = pk2(r[8 * w], r[8 * w + 1]); o.y = pk2(r[8 * w + 2], r[8 * w + 3]); o.z = pk2(r[8 * w + 4], r[8 * w + 5]); o.w = pk2(r[8 * w + 6], r[8 * w + 7]);
            *(u32x4*)(XB + (size_t)tok * D + xo + 8 * w) = o; }
        cur = nxt;
    }
}
#define GAS __attribute__((address_space(1)))
#define LAS __attribute__((address_space(3)))
#define XB_TMO      128
#define XB_XCNT(j)  (256  + 64 * (j))
#define XB_XSUB(j)  (1280 + 64 * (j))
#define XB_XGEN(j)  (2304 + 64 * (j))
#define XB_TOP      3328
#define XB_TOPGEN   3392
#define XCD_BAR_WORDS 3456
#define XB_SPIN_CAP (1u << 18)

__device__ __forceinline__ unsigned xb_ld(unsigned* p)              { return __hip_atomic_load(p, __ATOMIC_RELAXED, __HIP_MEMORY_SCOPE_AGENT); }
__device__ __forceinline__ unsigned xb_add(unsigned* p, unsigned v) { return __hip_atomic_fetch_add(p, v, __ATOMIC_RELAXED, __HIP_MEMORY_SCOPE_AGENT); }
__device__ __forceinline__ unsigned xb_xcc_id() { return (unsigned)__builtin_amdgcn_s_getreg((3 << 11) | 20) & 0xFu; }
#define XB_SPIN(cond, bar) do { unsigned _sp = 0; while (cond) { __builtin_amdgcn_s_sleep(1); \
    if ((++_sp & 255u) == 0u) { if (xb_ld(&(bar)[XB_TMO])) break; if (_sp > XB_SPIN_CAP) { atomicAdd(&(bar)[XB_TMO], 1u); break; } } } } while (0)

struct XcdBarrier {
    unsigned* bar; unsigned x;
    volatile LAS unsigned* st;
};

__device__ __forceinline__ XcdBarrier xcd_barrier_post(unsigned* bar, volatile LAS unsigned* st) {
    XcdBarrier b; b.bar = bar; b.x = xb_xcc_id(); b.st = st;
    if (threadIdx.x == 0) (void)xb_add(&bar[XB_XCNT(b.x)], 1u);
    return b;
}
__device__ __forceinline__ void xcd_barrier_complete(unsigned* bar, unsigned x, unsigned& nloc, unsigned& nx) {
    const unsigned G = gridDim.x * gridDim.y * gridDim.z;
    unsigned sum, cnt, mine, sp = 0u;
    for (;;) {
        sum = 0u; cnt = 0u; mine = 0u;
#pragma unroll
        for (unsigned j = 0; j < 16; ++j) { const unsigned c = xb_ld(&bar[XB_XCNT(j)]); sum += c; cnt += (c > 0u) ? 1u : 0u; mine = (j == x) ? c : mine; }
        if (sum == G) break;
        __builtin_amdgcn_s_sleep(1);
        if ((++sp & 255u) == 0u) { if (xb_ld(&bar[XB_TMO])) break; if (sp > XB_SPIN_CAP) { atomicAdd(&bar[XB_TMO], 1u); break; } }
    }
    nloc = mine > 0u ? mine : 1u; nx = cnt > 0u ? cnt : 1u;
}

__device__ __forceinline__ void xcd_barrier(const XcdBarrier& b) {
    asm volatile("s_waitcnt vmcnt(0)" ::: "memory");
    __syncthreads();
    if (threadIdx.x == 0) {
        unsigned* bar = b.bar;
        __builtin_amdgcn_s_waitcnt(0);
        unsigned nloc = b.st[0], nx = b.st[1];
        if (nloc == 0u) { xcd_barrier_complete(bar, b.x, nloc, nx); b.st[0] = nloc; b.st[1] = nx; }
        const unsigned old = xb_add(&bar[XB_XSUB(b.x)], 1u);
        const unsigned gen = old / nloc;
        if (old + 1u == (gen + 1u) * nloc) {
            __builtin_amdgcn_fence(__ATOMIC_RELEASE, "agent");
            asm volatile("s_waitcnt vmcnt(0)" ::: "memory");
            const unsigned og = xb_add(&bar[XB_TOP], 1u);
            const unsigned tg = og / nx;
            if (og + 1u == (tg + 1u) * nx) xb_add(&bar[XB_TOPGEN], 1u);
            else XB_SPIN(xb_ld(&bar[XB_TOPGEN]) == tg, bar);
            __builtin_amdgcn_fence(__ATOMIC_ACQUIRE, "agent");
            xb_add(&bar[XB_XGEN(b.x)], 1u);
            asm volatile("s_waitcnt vmcnt(0)" ::: "memory");
        } else {
            XB_SPIN(xb_ld(&bar[XB_XGEN(b.x)]) == gen, bar);
            __builtin_amdgcn_fence(__ATOMIC_ACQUIRE, "agent");
            asm volatile("s_waitcnt vmcnt(0)" ::: "memory");
        }
    }
    __syncthreads();
}
enum { PH_PRO_A, PH_PRO_B, PH_CVT, PH_GEMM_IN, PH_GEMM_E, PH_CONV, PH_FOXCUM, PH_FOXNORM, PH_GLA1, PH_GLA2, PH_GLA3, PH_FOX, PH_GEMM_OUT, PH_LN1, PH_GEMM_SC, PH_TOPK, PH_PEERU, PH_PEERV, PH_GEMM_PLE, PH_LN2, PH_COUNT };

template <int PH> __device__ __forceinline__ void run_phase(const Params& p, int l, unsigned char* lds) {
    if constexpr (PH == PH_PRO_A) phase_pro_a(p, lds);
    else if constexpr (PH == PH_PRO_B) phase_pro_b(p, lds);
    else if constexpr (PH == PH_CVT) phase_cvt(p, l);
    else if constexpr (PH == PH_GEMM_IN) phase_gemm_in(p, l, lds);
    else if constexpr (PH == PH_GEMM_E) phase_gemm_e(p, l, lds);
    else if constexpr (PH == PH_CONV) phase_conv(p, l, lds);
    else if constexpr (PH == PH_FOXCUM) phase_fox_cum(p, l, lds);
    else if constexpr (PH == PH_FOXNORM) phase_fox_norm(p, lds);
    else if constexpr (PH == PH_GLA1) phase_gla_b1(p, l, lds);
    else if constexpr (PH == PH_GLA2) phase_gla_b2(p);
    else if constexpr (PH == PH_GLA3) phase_gla_b3(p, l, lds);
    else if constexpr (PH == PH_FOX) phase_fox_mfma(p, l, lds);
    else if constexpr (PH == PH_GEMM_OUT) phase_gemm_out(p, l, lds);
    else if constexpr (PH == PH_LN1) phase_ln((const _Float16*)(p.ws + WS_Y), p.ln1_g + (size_t)l * D, p.ln1_b + (size_t)l * D, nullptr, (bf16*)(p.ws + WS_XB), p.ws + WS_XQ, (float*)(p.ws + WS_XS));
    else if constexpr (PH == PH_GEMM_SC) phase_gemm_sc(p, l, lds);
    else if constexpr (PH == PH_TOPK) phase_topk(p, lds);
    else if constexpr (PH == PH_PEERU) phase_peer_u(p, lds);
    else if constexpr (PH == PH_PEERV) phase_peer_v(p);
    else if constexpr (PH == PH_GEMM_PLE) phase_gemm_ple(p, l, lds);
    else if constexpr (PH == PH_LN2) phase_ln((const _Float16*)(p.ws + WS_Y), p.ln2_g + (size_t)l * D, p.ln2_b + (size_t)l * D, l == DEPTH - 1 ? p.out : nullptr, l == DEPTH - 1 ? nullptr : (bf16*)(p.ws + WS_XB));
}

constexpr int MISC_OFF = LDS_BYTES - 512;
constexpr int CW_BAR = 4096;
static_assert(MISC_OFF + 128 <= LDS_BYTES && (CW_BAR + XCD_BAR_WORDS) * 4 <= (int)CTL_ZERO_BYTES, "control words");

typedef __attribute__((address_space(4))) const Params CParams;
#define PHASE(PH) do { CParams* q_ = pp; asm volatile("" : "+s"(q_)); Params lp_; __builtin_memcpy(&lp_, q_, sizeof(Params)); run_phase<PH>(lp_, l, lds); } while (0)
__global__ void __launch_bounds__(512, 2) mk_fwd(Params p_unused) {
#if defined(__HIP_DEVICE_COMPILE__)
    extern __shared__ __attribute__((aligned(16))) unsigned char lds[];
    CParams* pp = (CParams*)__builtin_amdgcn_kernarg_segment_ptr();
    unsigned char* ws0; { CParams* q_ = pp; asm volatile("" : "+s"(q_)); ws0 = q_->ws; }
    volatile LAS unsigned* MISC = (volatile LAS unsigned*)((LAS unsigned char*)lds + MISC_OFF);
    if (threadIdx.x < 32) MISC[threadIdx.x] = 0u;
    __syncthreads();
    (void)xcd_barrier_post((unsigned*)(ws0 + WS_CTL) + CW_BAR, MISC + 8);
#define GB() do { CParams* qb_ = pp; asm volatile("" : "+s"(qb_)); XcdBarrier b_; b_.bar = (unsigned*)(qb_->ws + WS_CTL) + CW_BAR; b_.x = xb_xcc_id(); b_.st = MISC + 8; xcd_barrier(b_); } while (0)
    { const int l = 0; PHASE(PH_PRO_A); PHASE(PH_PRO_B); } GB();
    for (int l = 0; l < DEPTH; ++l) {
        PHASE(PH_CVT); PHASE(PH_GEMM_IN); GB();
        PHASE(PH_GEMM_E); PHASE(PH_CONV); PHASE(PH_FOXCUM); PHASE(PH_FOXNORM); PHASE(PH_GLA1); GB();
        PHASE(PH_GLA2); PHASE(PH_FOX); GB();
        PHASE(PH_GLA3); GB();
        PHASE(PH_GEMM_OUT); GB();
        PHASE(PH_LN1); GB();
        PHASE(PH_GEMM_SC); GB();
        PHASE(PH_TOPK); GB();
        PHASE(PH_PEERU); GB();
        PHASE(PH_PEERV); GB();
        PHASE(PH_GEMM_PLE); GB();
        PHASE(PH_LN2); GB();
    }
#undef GB
#endif
}

extern "C" void kernel_launch(void* const* d_in, const int* in_sizes, int n_in, void* d_out, int out_size, void* d_ws, size_t ws_size, hipStream_t stream) {
    static int grid = 0;
    if (grid == 0) {
        if (n_in != 23 || ws_size < WS_END) { fprintf(stderr, "kernel_launch: unexpected n_in %d or ws_size %zu\n", n_in, ws_size); grid = -1; return; }
        int dev = 0, cus = 0, per_cu = 0;
        if (hipGetDevice(&dev) != hipSuccess || hipDeviceGetAttribute(&cus, hipDeviceAttributeMultiprocessorCount, dev) != hipSuccess) { grid = -1; return; }
        if (hipFuncSetAttribute((const void*)mk_fwd, hipFuncAttributeMaxDynamicSharedMemorySize, LDS_BYTES) != hipSuccess) { grid = -1; return; }
        if (hipOccupancyMaxActiveBlocksPerMultiprocessor(&per_cu, (const void*)mk_fwd, 512, LDS_BYTES) != hipSuccess || per_cu < 1) { fprintf(stderr, "kernel_launch: occupancy query says %d\n", per_cu); }
        (void)hipGetLastError();
        grid = cus;
    }
    if (grid < 0) return;
    if (hipMemsetAsync((char*)d_ws + WS_CTL, 0, CTL_ZERO_BYTES, stream) != hipSuccess) return;
    Params p; memset(&p, 0, sizeof(p));
    const float** f = (const float**)&p;
    for (int i = 0; i < 23; ++i) f[i] = (const float*)d_in[i];
    p.out = (float*)d_out; p.ws = (unsigned char*)d_ws;
    hipLaunchKernelGGL(mk_fwd, dim3(grid), dim3(512), LDS_BYTES, stream, p);
}
```

```cpp
#include <hip/hip_runtime.h>
#include <cstdio>
#include <cstdint>
#include <cstring>
#include <cmath>
__device__ __forceinline__ int tid_l() { int t = threadIdx.x; asm volatile("" : "+v"(t)); return t; }
__device__ __forceinline__ int bid_l() { int b = blockIdx.x; asm volatile("" : "+s"(b)); return b; }
__device__ __forceinline__ int grid_l() { int g = gridDim.x; asm volatile("" : "+s"(g)); return g; }
namespace pg8 {
#define PG8_LAS __attribute__((address_space(3)))
typedef unsigned short bf16_t;
typedef short bf16x8 __attribute__((ext_vector_type(8)));
typedef float f32x4 __attribute__((ext_vector_type(4)));
typedef unsigned u32x4 __attribute__((ext_vector_type(4)));
constexpr int BM = 256, BK = 64, HALF = 128, HTB = HALF * BK * 2  , STAGE_BYTES = 8 * HTB, NXCD = 8, WGM = 8;

__host__ __device__ __forceinline__ int lds_byte(int r, int c) { const int st = (r >> 4) * 2 + (c >> 5), rr = r & 15, cc = c & 31, ob = rr * 64 + cc * 2; return st * 1024 + (ob ^ (((ob >> 9) & 1) << 5)); }
__host__ __device__ __forceinline__ void stage_rc(int b, int& R, int& C) { const int st = b / 1024, sb = b % 1024, swz = sb ^ (((sb >> 9) & 1) << 5); R = (st >> 1) * 16 + swz / 64; C = (st & 1) * 32 + (swz % 64) / 2; }
__host__ __device__ __forceinline__ int perm32(int rho) { const int n = rho >> 4, i = rho & 15; return 8 * (i >> 2) + 4 * n + (i & 3); }

struct Unit { int pm, pn; };
struct Gemm { const bf16_t* A; const bf16_t* Bt; int M, N, K; };

struct StaticOrder {
    int nM, nN, nwg, G, c;
    __host__ __device__ void init(int M, int N, int G_, int c_) { nM = M / BM; nN = N / BM; nwg = nM * nN; G = G_; c = c_; }
    __host__ __device__ bool next(int i, Unit& u) const {
        const long L = (long)i * G + c; if (L >= nwg) return false;
        int wgid = (int)L; { const int q = nwg / NXCD, r = nwg % NXCD, xcd = wgid % NXCD, off = wgid / NXCD; wgid = (xcd < r ? xcd * (q + 1) : r * (q + 1) + (xcd - r) * q) + off; }
        const int nig = WGM * nN, gid = wgid / nig, fm = gid * WGM, gsz = (nM - fm) < WGM ? (nM - fm) : WGM;
        u.pm = fm + ((wgid % nig) % gsz); u.pn = (wgid % nig) / gsz; return true;
    }
    __device__ __forceinline__ void a_ready(const Unit&) const {}
    __device__ __forceinline__ void done(const Unit&) const {}
};

__device__ __forceinline__ unsigned cvt_pk_bf16(float lo, float hi) { unsigned r; asm volatile("v_cvt_pk_bf16_f32 %0, %1, %2" : "=v"(r) : "v"(lo), "v"(hi)); return r; }
typedef float f32x2 __attribute__((ext_vector_type(2)));
__device__ __forceinline__ f32x2 gelu_pk(f32x2 v) {
    const f32x2 av = __builtin_elementwise_abs(v), d = av * 0.2316418882f + 1.0f;
    f32x2 t; t.x = __builtin_amdgcn_rcpf(d.x); t.y = __builtin_amdgcn_rcpf(d.y);
    f32x2 q = t * 0.5307027145f + (-0.7265760135f); q = q * t + 0.7107068705f; q = q * t + (-0.142248368f); q = q * t + 0.127414796f; q = q * t;
    const f32x2 s = (v * v) * (-0.72134752044f);
    f32x2 e; e.x = __builtin_amdgcn_exp2f(s.x); e.y = __builtin_amdgcn_exp2f(s.y);
    const f32x2 m = v * (q * e), r = v - m;
    f32x2 o; o.x = v.x < 0.f ? m.x : r.x; o.y = v.y < 0.f ? m.y : r.y; return o;
}

template <int ACT  > struct EpiBf16 {
    static constexpr bool PERM = true, AFTER_DRAIN = false; static_assert(ACT == 0 || ACT == 1, "EpiBf16: ACT is 0 (none) or 1 (gelu_pk)");
    bf16_t* O; int ldc; const float* bias; int split_cols; size_t split_stride; float scale0;
    __device__ __forceinline__ void operator()(const f32x4 (&acc)[2][2][4][2], const Unit& u, int wr, int wc, int fr, int fq) const {
        const int row0 = u.pm * BM + wr * 64 + fr; int colt = u.pn * BM; bf16_t* base = O;
        float sc = 1.f; if (split_cols) { const int t = colt / split_cols; base += (size_t)t * split_stride; colt -= t * split_cols; if (t == 0) sc = scale0; }
        const int col0 = colt + wc * 32 + 8 * fq, bcol0 = u.pn * BM + wc * 32 + 8 * fq;
        f32x4 bv[2][2];
#pragma unroll
        for (int bj = 0; bj < 2; ++bj)
#pragma unroll
            for (int n = 0; n < 2; ++n) bv[bj][n] = bias ? *(const f32x4*)(bias + bcol0 + bj * HALF + 4 * n) : (f32x4){0.f, 0.f, 0.f, 0.f};
#pragma unroll
        for (int ai = 0; ai < 2; ++ai)
#pragma unroll
            for (int m = 0; m < 4; ++m) { bf16_t* rowp = base + (size_t)(row0 + ai * HALF + m * 16) * ldc + col0;
#pragma unroll
                for (int bj = 0; bj < 2; ++bj) { f32x4 v0 = acc[ai][bj][m][0] + bv[bj][0], v1 = acc[ai][bj][m][1] + bv[bj][1];
                    if (ACT == 1) { f32x2 a = gelu_pk((f32x2){v0[0], v0[1]}), b = gelu_pk((f32x2){v0[2], v0[3]}), c = gelu_pk((f32x2){v1[0], v1[1]}), d = gelu_pk((f32x2){v1[2], v1[3]});
                        v0 = (f32x4){a.x, a.y, b.x, b.y}; v1 = (f32x4){c.x, c.y, d.x, d.y}; }
                    v0 = v0 * sc; v1 = v1 * sc; u32x4 w; w.x = cvt_pk_bf16(v0[0], v0[1]); w.y = cvt_pk_bf16(v0[2], v0[3]); w.z = cvt_pk_bf16(v1[0], v1[1]); w.w = cvt_pk_bf16(v1[2], v1[3]);
                    *(u32x4*)(rowp + bj * HALF) = w; } }
    }
};
struct EpiF16 {
    static constexpr bool PERM = true, AFTER_DRAIN = false;
    _Float16* O; int ldc;
    __device__ __forceinline__ void operator()(const f32x4 (&acc)[2][2][4][2], const Unit& u, int wr, int wc, int fr, int fq) const {
        typedef _Float16 h8 __attribute__((ext_vector_type(8)));
        const int row0 = u.pm * BM + wr * 64 + fr, col0 = u.pn * BM + wc * 32 + 8 * fq;
#pragma unroll
        for (int ai = 0; ai < 2; ++ai)
#pragma unroll
            for (int m = 0; m < 4; ++m) { _Float16* rowp = O + (size_t)(row0 + ai * HALF + m * 16) * ldc + col0;
#pragma unroll
                for (int bj = 0; bj < 2; ++bj) { const f32x4 a = acc[ai][bj][m][0], b = acc[ai][bj][m][1];
                    h8 o; o[0] = (_Float16)a[0]; o[1] = (_Float16)a[1]; o[2] = (_Float16)a[2]; o[3] = (_Float16)a[3]; o[4] = (_Float16)b[0]; o[5] = (_Float16)b[1]; o[6] = (_Float16)b[2]; o[7] = (_Float16)b[3];
                    *(h8*)(rowp + bj * HALF) = o; } }
    }
};
struct EpiResid {
    static constexpr bool PERM = true, AFTER_DRAIN = false;
    const bf16_t* res; _Float16* Y; int ldc; float alpha;
    __device__ __forceinline__ void operator()(const f32x4 (&acc)[2][2][4][2], const Unit& u, int wr, int wc, int fr, int fq) const {
        const int row0 = u.pm * BM + wr * 64 + fr, col0 = u.pn * BM + wc * 32 + 8 * fq;
#pragma unroll
        for (int ai = 0; ai < 2; ++ai)
#pragma unroll
            for (int m = 0; m < 4; ++m) { const size_t off = (size_t)(row0 + ai * HALF + m * 16) * ldc + col0;
#pragma unroll
                for (int bj = 0; bj < 2; ++bj) { const u32x4 rv = *(const u32x4*)(res + off + bj * HALF);
                    f32x4 r0, r1; r0[0] = __uint_as_float(rv.x << 16); r0[1] = __uint_as_float(rv.x & 0xffff0000u); r0[2] = __uint_as_float(rv.y << 16); r0[3] = __uint_as_float(rv.y & 0xffff0000u);
                    r1[0] = __uint_as_float(rv.z << 16); r1[1] = __uint_as_float(rv.z & 0xffff0000u); r1[2] = __uint_as_float(rv.w << 16); r1[3] = __uint_as_float(rv.w & 0xffff0000u);
                    const f32x4 y0 = r0 * alpha + acc[ai][bj][m][0], y1 = r1 * alpha + acc[ai][bj][m][1];
                    typedef _Float16 h8 __attribute__((ext_vector_type(8))); h8 w; w[0] = (_Float16)y0[0]; w[1] = (_Float16)y0[1]; w[2] = (_Float16)y0[2]; w[3] = (_Float16)y0[3]; w[4] = (_Float16)y1[0]; w[5] = (_Float16)y1[1]; w[6] = (_Float16)y1[2]; w[7] = (_Float16)y1[3];
                    *(h8*)(Y + off + bj * HALF) = w; } }
    }
};
struct EpiPle {
    static constexpr bool PERM = true, AFTER_DRAIN = false;
    const bf16_t* R; _Float16* Y; const bf16_t* E; const float* gb; int ldc;
    __device__ __forceinline__ void operator()(const f32x4 (&acc)[2][2][4][2], const Unit& u, int wr, int wc, int fr, int fq) const {
        const int row0 = u.pm * BM + wr * 64 + fr, col0 = u.pn * BM + wc * 32 + 8 * fq;
        f32x4 bv[2][2];
#pragma unroll
        for (int bj = 0; bj < 2; ++bj)
#pragma unroll
            for (int n = 0; n < 2; ++n) bv[bj][n] = *(const f32x4*)(gb + col0 + bj * HALF + 4 * n);
#pragma unroll
        for (int ai = 0; ai < 2; ++ai)
#pragma unroll
            for (int m = 0; m < 4; ++m) { const size_t off = (size_t)(row0 + ai * HALF + m * 16) * ldc + col0;
#pragma unroll
                for (int bj = 0; bj < 2; ++bj) {
                    const u32x4 ev = *(const u32x4*)(E + off + bj * HALF), rv = *(const u32x4*)(R + off + bj * HALF);
                    float o[8];
#pragma unroll
                    for (int n = 0; n < 2; ++n) {
                        const f32x4 z = acc[ai][bj][m][n] + bv[bj][n];
                        const unsigned e0 = n == 0 ? ev.x : ev.z, e1 = n == 0 ? ev.y : ev.w, r0 = n == 0 ? rv.x : rv.z, r1 = n == 0 ? rv.y : rv.w;
                        f32x4 ee, rr; ee[0] = __uint_as_float(e0 << 16); ee[1] = __uint_as_float(e0 & 0xffff0000u); ee[2] = __uint_as_float(e1 << 16); ee[3] = __uint_as_float(e1 & 0xffff0000u);
                        rr[0] = __uint_as_float(r0 << 16); rr[1] = __uint_as_float(r0 & 0xffff0000u); rr[2] = __uint_as_float(r1 << 16); rr[3] = __uint_as_float(r1 & 0xffff0000u);
#pragma unroll
                        for (int i = 0; i < 4; ++i) o[4 * n + i] = rr[i] + ee[i] * __builtin_amdgcn_rcpf(1.0f + __expf(-z[i])); }
                    typedef _Float16 h8 __attribute__((ext_vector_type(8))); h8 w;
#pragma unroll
                    for (int i = 0; i < 8; ++i) w[i] = (_Float16)o[i];
                    *(h8*)(Y + off + bj * HALF) = w; } }
    }
};
template <class Epi, class Sched, bool ALIGN_EPI = false, bool SP2 = false>
__device__ __forceinline__ void gemm_phase(PG8_LAS unsigned char* lds, const Gemm g, const Sched& S, const Epi& E) {
    const int tid = tid_l(), wid = __builtin_amdgcn_readfirstlane(tid >> 6), lane = tid & 63, wr = wid >> 2, wc = wid & 3, fr = lane & 15, fq = lane >> 4;
    const int K = g.K, nt = K / BK;
    unsigned voffA[2], voffB[2];
#pragma unroll
    for (int i = 0; i < 2; ++i) { int R, C; stage_rc(tid * 16 + i * 8192, R, C); const int Rb = Epi::PERM ? ((R & ~31) + perm32(R & 31)) : R;
        voffA[i] = (unsigned)(R * K + C) * 2u; voffB[i] = (unsigned)(Rb * K + C) * 2u; }
    const size_t kstep = (size_t)(BK * 2);
    const size_t hstep = (size_t)HALF * K * 2;
    const size_t tstep = 2 * hstep;
    const unsigned ldsw = (unsigned)wid * 1024u;
    const int aoff = lds_byte(wr * 64 + fr, fq * 8), boff = lds_byte(wc * 32 + fr, fq * 8);
#define PG8_SA(b, h) (((b) * 2 + (h)) * HTB)
#define PG8_SB(b, h) ((4 + (b) * 2 + (h)) * HTB)
#define PG8_STAGE(bufoff, gbase, voff) do { _Pragma("unroll") for (int _i = 0; _i < 2; ++_i) \
        __builtin_amdgcn_global_load_lds((const unsigned*)((const char*)(gbase) + (voff)[_i]), (PG8_LAS unsigned*)(lds + (bufoff) + ldsw + _i * 8192), 16, 0, 0); } while (0)
#define PG8_LDA(dst, b, h) do { _Pragma("unroll") for (int m = 0; m < 4; ++m) _Pragma("unroll") for (int k = 0; k < 2; ++k) dst[m][k] = *(const PG8_LAS bf16x8*)(lds + PG8_SA(b, h) + aoff + m * 2048 + k * 1024); } while (0)
#define PG8_LDB(dst, b, h) do { _Pragma("unroll") for (int n = 0; n < 2; ++n) _Pragma("unroll") for (int k = 0; k < 2; ++k) dst[n][k] = *(const PG8_LAS bf16x8*)(lds + PG8_SB(b, h) + boff + n * 2048 + k * 1024); } while (0)
#define PG8_MMA(ai, bj, At, Bt) do { __builtin_amdgcn_s_setprio(1); _Pragma("unroll") for (int m = 0; m < 4; ++m) _Pragma("unroll") for (int n = 0; n < 2; ++n) _Pragma("unroll") for (int k = 0; k < 2; ++k) \
        acc[ai][bj][m][n] = __builtin_amdgcn_mfma_f32_16x16x32_bf16(Bt[n][k], At[m][k], acc[ai][bj][m][n], 0, 0, 0); __builtin_amdgcn_s_setprio(0); } while (0)
#define PG8_WAIT_V(n) asm volatile("s_waitcnt vmcnt(" #n ")" ::: "memory")
#define PG8_WAIT_L(n) asm volatile("s_waitcnt lgkmcnt(" #n ")" ::: "memory")
#define PG8_BAR __builtin_amdgcn_s_barrier()
#define PG8_SCHED __builtin_amdgcn_sched_barrier(0)
    Unit cur, nxt; int ui = 0;
    if (!S.next(0, cur)) return;
    f32x4 acc[2][2][4][2];
#pragma unroll
    for (int a = 0; a < 2; ++a)
#pragma unroll
        for (int b = 0; b < 2; ++b)
#pragma unroll
            for (int m = 0; m < 4; ++m)
#pragma unroll
                for (int n = 0; n < 2; ++n) acc[a][b][m][n] = (f32x4){0.f, 0.f, 0.f, 0.f};
    bf16x8 At[4][2], B0[2][2], B1[2][2];
    const char* cA = (const char*)g.A + (size_t)cur.pm * tstep; const char* cB = (const char*)g.Bt + (size_t)cur.pn * tstep;
    S.a_ready(cur);
    if constexpr (SP2) {
        PG8_STAGE(PG8_SB(0, 0), cB, voffB); PG8_STAGE(PG8_SB(0, 1), cB + hstep, voffB); PG8_STAGE(PG8_SA(0, 0), cA, voffA); PG8_STAGE(PG8_SA(0, 1), cA + hstep, voffA);
        if (wr == 1) PG8_BAR;
        PG8_WAIT_V(2); PG8_BAR;
        PG8_STAGE(PG8_SB(1, 0), cB + kstep, voffB); PG8_STAGE(PG8_SA(1, 0), cA + kstep, voffA); PG8_STAGE(PG8_SB(1, 1), cB + hstep + kstep, voffB);
        PG8_WAIT_V(6); PG8_BAR;
    } else {
        PG8_STAGE(PG8_SB(0, 0), cB, voffB); PG8_STAGE(PG8_SA(0, 0), cA, voffA); PG8_STAGE(PG8_SB(0, 1), cB + hstep, voffB); PG8_STAGE(PG8_SA(0, 1), cA + hstep, voffA);
        if (wr == 1) PG8_BAR;
        PG8_WAIT_V(4); PG8_BAR;
        PG8_STAGE(PG8_SB(1, 0), cB + kstep, voffB); PG8_STAGE(PG8_SA(1, 0), cA + kstep, voffA); PG8_STAGE(PG8_SB(1, 1), cB + hstep + kstep, voffB);
        PG8_WAIT_V(6); PG8_BAR;
    }
    for (;;) {
        const bool has_next = S.next(ui + 1, nxt);
        const char* nA = has_next ? (const char*)g.A + (size_t)nxt.pm * tstep : cA; const char* nB = has_next ? (const char*)g.Bt + (size_t)nxt.pn * tstep : cB;
        for (int t = 0; t < nt; t += 2) {
            const bool last = (t == nt - 2);
            const char* a1 = cA + (size_t)(t + 1) * kstep;
            const char* a2 = last ? nA : cA + (size_t)(t + 2) * kstep; const char* b2 = last ? nB : cB + (size_t)(t + 2) * kstep;
            const char* a3 = a2 + kstep; const char* b3 = b2 + kstep;
            if (last && has_next) S.a_ready(nxt);
            if constexpr (SP2) {
            PG8_LDB(B0, 0, 0); PG8_LDB(B1, 0, 1); PG8_SCHED; PG8_LDA(At, 0, 0); PG8_STAGE(PG8_SA(1, 1), a1 + hstep, voffA);
            PG8_WAIT_V(8); PG8_WAIT_L(0); PG8_BAR; PG8_MMA(0, 0, At, B0); PG8_MMA(0, 1, At, B1); PG8_BAR; PG8_SCHED;
            PG8_LDA(At, 0, 1); PG8_STAGE(PG8_SB(0, 0), b2, voffB); PG8_STAGE(PG8_SB(0, 1), b2 + hstep, voffB); PG8_STAGE(PG8_SA(0, 0), a2, voffA);
            PG8_WAIT_V(8); PG8_WAIT_L(0); PG8_BAR; PG8_MMA(1, 0, At, B0); PG8_MMA(1, 1, At, B1); PG8_BAR; PG8_SCHED;
            PG8_LDB(B0, 1, 0); PG8_LDB(B1, 1, 1); PG8_SCHED; PG8_LDA(At, 1, 0); PG8_STAGE(PG8_SA(0, 1), a2 + hstep, voffA);
            PG8_WAIT_V(8); PG8_WAIT_L(0); PG8_BAR; PG8_MMA(0, 0, At, B0); PG8_MMA(0, 1, At, B1); PG8_BAR; PG8_SCHED;
            PG8_LDA(At, 1, 1); PG8_STAGE(PG8_SB(1, 0), b3, voffB); PG8_STAGE(PG8_SB(1, 1), b3 + hstep, voffB); PG8_STAGE(PG8_SA(1, 0), a3, voffA);
            PG8_WAIT_V(8); PG8_WAIT_L(0); PG8_BAR; PG8_MMA(1, 0, At, B0); PG8_MMA(1, 1, At, B1); PG8_BAR; PG8_SCHED;
            } else {
            PG8_LDB(B0, 0, 0); PG8_SCHED; PG8_LDA(At, 0, 0); PG8_STAGE(PG8_SA(1, 1), a1 + hstep, voffA);
            PG8_WAIT_L(8); PG8_BAR; PG8_WAIT_L(0); PG8_MMA(0, 0, At, B0); PG8_BAR; PG8_SCHED;
            PG8_LDB(B1, 0, 1); PG8_STAGE(PG8_SB(0, 0), b2, voffB);
            PG8_BAR; PG8_WAIT_L(0); PG8_MMA(0, 1, At, B1); PG8_BAR;
            PG8_LDA(At, 0, 1); PG8_STAGE(PG8_SA(0, 0), a2, voffA);
            PG8_BAR; PG8_WAIT_L(0); PG8_MMA(1, 0, At, B0); PG8_BAR; PG8_SCHED;
            PG8_STAGE(PG8_SB(0, 1), b2 + hstep, voffB);
            PG8_WAIT_V(6); PG8_BAR; PG8_MMA(1, 1, At, B1); PG8_BAR;
            PG8_LDB(B0, 1, 0); PG8_SCHED; PG8_LDA(At, 1, 0); PG8_STAGE(PG8_SA(0, 1), a2 + hstep, voffA);
            PG8_WAIT_L(8); PG8_BAR; PG8_WAIT_L(0); PG8_MMA(0, 0, At, B0); PG8_BAR; PG8_SCHED;
            PG8_LDB(B1, 1, 1); PG8_STAGE(PG8_SB(1, 0), b3, voffB);
            PG8_BAR; PG8_WAIT_L(0); PG8_MMA(0, 1, At, B1); PG8_BAR;
            PG8_LDA(At, 1, 1); PG8_STAGE(PG8_SA(1, 0), a3, voffA);
            PG8_BAR; PG8_WAIT_L(0); PG8_MMA(1, 0, At, B0); PG8_BAR; PG8_SCHED;
            PG8_STAGE(PG8_SB(1, 1), b3 + hstep, voffB);
            PG8_WAIT_V(6); PG8_BAR; PG8_MMA(1, 1, At, B1); PG8_BAR;
            }
        }
        if constexpr (ALIGN_EPI) { if (wr == 0) PG8_BAR; }
        if constexpr (!Epi::AFTER_DRAIN) { E(acc, cur, wr, wc, fr, fq); S.done(cur); }
        if (!has_next) break;
#pragma unroll
        for (int a = 0; a < 2; ++a)
#pragma unroll
            for (int b = 0; b < 2; ++b)
#pragma unroll
                for (int m = 0; m < 4; ++m)
#pragma unroll
                    for (int n = 0; n < 2; ++n) acc[a][b][m][n] = (f32x4){0.f, 0.f, 0.f, 0.f};
        cur = nxt; cA = nA; cB = nB; ++ui;
        if constexpr (ALIGN_EPI) { if (wr == 1) PG8_BAR; }
    }
    PG8_WAIT_V(0);
    if constexpr (!ALIGN_EPI) { if (wr == 0) PG8_BAR; }
    PG8_BAR;
    if constexpr (Epi::AFTER_DRAIN) { E.fused(acc, cur, wr, wc, fr, fq, lds, wid, lane); S.done(cur); }
#undef PG8_SA
#undef PG8_SB
#undef PG8_STAGE
#undef PG8_LDA
#undef PG8_LDB
#undef PG8_MMA
#undef PG8_WAIT_V
#undef PG8_WAIT_L
#undef PG8_BAR
#undef PG8_SCHED
}
}
#include <hip/hip_bf16.h>
#include <cmath>
namespace attn_body {
using bf16=__hip_bfloat16;
using bf16x8=__attribute__((ext_vector_type(8)))short;
using s16x4=__attribute__((ext_vector_type(4)))short;
using f32x16=__attribute__((ext_vector_type(16)))float;
using u32x4=__attribute__((ext_vector_type(4)))unsigned;
constexpr int BATCH=8,NHEAD=6,SEQ=4096,D=64,KVP=3072,OP=1024;
constexpr int NW=8,QBLK=32,QB=QBLK*NW,KVBLK=64,NQB=SEQ/QB;
constexpr int ATTN_UNIT_ROWS=QB;
__device__ __forceinline__ int crow(int r,int hi){return (r&3)+8*(r>>2)+4*hi;}
#define SBAR() __builtin_amdgcn_sched_barrier(0)
__device__ __forceinline__ void cmask(f32x16&p0,f32x16&p1,int jb,int qrel,int hi){
  const float NEG=-INFINITY; int kb=64*jb+4*hi;
  #pragma unroll
  for(int r=0;r<16;++r){int kv=kb+(r&3)+8*(r>>2); if(kv>qrel)p0[r]=NEG; if(kv+32>qrel)p1[r]=NEG;}
}

constexpr int NSLOT=3, SLOTB=8192;
constexpr int LDS_K=0, LDS_V=NSLOT*SLOTB, LDS_WS=2*NSLOT*SLOTB, LDS_OST=LDS_WS+NW*64*4, LDS_CK=LDS_OST+NW*4096, LDS_BYTES=LDS_CK+SEQ*4;
constexpr float C2=0.125f*1.4426950408889634f;
__device__ __forceinline__ void glds16(const void*gsrc,unsigned lds_dst){unsigned keep;
  asm volatile("s_mov_b32 %0, m0\n\ts_mov_b32 m0, %2\n\ts_nop 0\n\tglobal_load_lds_dwordx4 %1, off\n\ts_mov_b32 m0, %0":"=&s"(keep):"v"(gsrc),"s"(lds_dst):"memory");}
__device__ __forceinline__ float max3f(float a,float b,float c){float r;asm("v_max3_f32 %0, %1, %2, %3":"=v"(r):"v"(a),"v"(b),"v"(c));return r;}
__device__ __forceinline__ float max2f(float a,float b){float r;asm("v_max_f32_e32 %0, %1, %2":"=v"(r):"v"(a),"v"(b));return r;}
__device__ __forceinline__ float fadd_s(float a,float b){float r;asm("v_add_f32_e32 %0, %1, %2":"=v"(r):"v"(a),"v"(b));return r;}
__device__ __forceinline__ float fsub_s(float a,float b){float r;asm("v_sub_f32_e32 %0, %1, %2":"=v"(r):"v"(a),"v"(b));return r;}
typedef float f32x2_t __attribute__((ext_vector_type(2))); typedef float f32x4_t __attribute__((ext_vector_type(4))); typedef __bf16 bf16x2_t __attribute__((ext_vector_type(2)));
__device__ __forceinline__ unsigned cvtpk_s(float lo,float hi){f32x2_t v={lo,hi};bf16x2_t b=__builtin_convertvector(v,bf16x2_t);return __builtin_bit_cast(unsigned,b);}
#define WAIT_BAR(N) asm volatile("s_waitcnt vmcnt(" #N ") lgkmcnt(0)\n\ts_barrier":::"memory")

__device__ __forceinline__ void qkt(f32x16&p0,f32x16&p1,const char*Kslot,const bf16x8*qr,int r32,int hi){
  const char*kb=Kslot+hi*1024+r32*16;
  #pragma unroll
  for(int d0=0;d0<4;++d0){
    const bf16x8 b0=*reinterpret_cast<const bf16x8*>(kb+d0*2048);
    const bf16x8 b1=*reinterpret_cast<const bf16x8*>(kb+d0*2048+512);
    {p0=__builtin_amdgcn_mfma_f32_32x32x16_bf16(b0,qr[d0],p0,0,0,0);p1=__builtin_amdgcn_mfma_f32_32x32x16_bf16(b1,qr[d0],p1,0,0,0);}}
}
typedef __attribute__((address_space(3))) const char* lds_cptr;
typedef short v4i16_t __attribute__((ext_vector_type(4)));
__device__ __forceinline__ void kload8(bf16x8*kf,lds_cptr kp){
  kf[0]=*(const __attribute__((address_space(3))) bf16x8*)(kp);      kf[1]=*(const __attribute__((address_space(3))) bf16x8*)(kp+512);
  kf[2]=*(const __attribute__((address_space(3))) bf16x8*)(kp+2048); kf[3]=*(const __attribute__((address_space(3))) bf16x8*)(kp+2560);
  kf[4]=*(const __attribute__((address_space(3))) bf16x8*)(kp+4096); kf[5]=*(const __attribute__((address_space(3))) bf16x8*)(kp+4608);
  kf[6]=*(const __attribute__((address_space(3))) bf16x8*)(kp+6144); kf[7]=*(const __attribute__((address_space(3))) bf16x8*)(kp+6656);
}
__device__ __forceinline__ void kload2(bf16x8*kf,lds_cptr kp,int j){ kf[2*j]=*(const __attribute__((address_space(3))) bf16x8*)(kp+j*2048); kf[2*j+1]=*(const __attribute__((address_space(3))) bf16x8*)(kp+j*2048+512); }
__device__ __forceinline__ s16x4 vtr(lds_cptr p){ return __builtin_bit_cast(s16x4,__builtin_amdgcn_ds_read_tr16_b64_v4i16((__attribute__((address_space(3))) v4i16_t*)p)); }
__device__ __forceinline__ float rowmax(const f32x16&p0,const f32x16&p1){
  float a=max3f(p0[0],p0[1],p1[0]),b=max3f(p0[2],p0[3],p1[1]);a=max3f(a,p1[2],p1[3]);
  #pragma unroll
  for(int r=4;r<16;r+=4){a=max3f(a,p0[r],p0[r+1]);b=max3f(b,p0[r+2],p0[r+3]);a=max3f(a,p1[r],p1[r+1]);b=max3f(b,p1[r+2],p1[r+3]);}
  const float m=max2f(a,b);
  auto rr=__builtin_amdgcn_permlane32_swap(__float_as_uint(m),__float_as_uint(m),false,false);
  return max2f(__uint_as_float(rr[0]),__uint_as_float(rr[1]));
}
__device__ __forceinline__ void pv(f32x16*o,int vb,bf16x8 pa0,bf16x8 pa1,bf16x8 pa2,bf16x8 pa3){
  #pragma unroll
  for(int d0=0;d0<2;++d0){s16x4 lo[4],hi[4];
    #pragma unroll
    for(int ks=0;ks<4;++ks){
      asm volatile("ds_read_b64_tr_b16 %0,%1 offset:%c2":"=&v"(lo[ks]):"v"(vb),"i"(d0*4096+ks*1024):"memory");
      asm volatile("ds_read_b64_tr_b16 %0,%1 offset:%c2":"=&v"(hi[ks]):"v"(vb),"i"(d0*4096+ks*1024+512):"memory");}
    asm volatile("s_waitcnt lgkmcnt(0)":::"memory");SBAR();
    #define PK(k) (bf16x8){lo[k][0],lo[k][1],lo[k][2],lo[k][3],hi[k][0],hi[k][1],hi[k][2],hi[k][3]}
    o[d0]=__builtin_amdgcn_mfma_f32_32x32x16_bf16(pa0,PK(0),o[d0],0,0,0);
    o[d0]=__builtin_amdgcn_mfma_f32_32x32x16_bf16(pa1,PK(1),o[d0],0,0,0);
    o[d0]=__builtin_amdgcn_mfma_f32_32x32x16_bf16(pa2,PK(2),o[d0],0,0,0);
    o[d0]=__builtin_amdgcn_mfma_f32_32x32x16_bf16(pa3,PK(3),o[d0],0,0,0);
    #undef PK
  }
}

#ifndef ATTN_STORE16
#define ATTN_STORE16(p,v) (*(u32x4*)(p)=(v))
#endif
template<int THRL> __device__ __forceinline__ void attn_unit(int b,int h,int qb,const bf16*Q,const bf16*__restrict__ K,const bf16*__restrict__ V,bf16*O,const float*__restrict__ CKg,const float*__restrict__ KTm,const float*__restrict__ QBm,char*shm){
  const int tid=tid_l(),lane=tid&63,r32=lane&31,hi=lane>>5; const int wid=__builtin_amdgcn_readfirstlane(tid>>6);
  const long rowbase=(long)b*SEQ; const int q0=qb*QB;
  const bf16*Qw=Q+(rowbase+q0+wid*QBLK)*KVP+h*D;
  const float*ckg=CKg+(long)(b*NHEAD+h)*SEQ;
  int j0=0;
  { const int bh_=b*NHEAD+h, NT0_=(q0+QB)/KVBLK; const float qmx=QBm[bh_*NQB+qb]*1.01f;
    const float kd=fmaxf(fmaxf(KTm[bh_*64+4*qb],KTm[bh_*64+4*qb+1]),fmaxf(KTm[bh_*64+4*qb+2],KTm[bh_*64+4*qb+3]));
    const float thr=-(qmx*kd)-48.f; bool skip=false;
    if(lane<NT0_-4){ const float bound=qmx*KTm[bh_*64+lane]+(ckg[q0]-ckg[64*lane+63]); skip=bound<thr; }
    const unsigned long long m_=__ballot(skip); j0=__builtin_ctzll(~m_); j0=(j0<NT0_-4?j0:NT0_-4)&~1; j0=__builtin_amdgcn_readfirstlane(j0); }
  const bf16*Kh=K+(rowbase+(long)j0*KVBLK)*KVP+h*D,*Vh=V+(rowbase+(long)j0*KVBLK)*KVP+h*D;
  const unsigned lds0=(unsigned)(uintptr_t)shm;
  float*wsf=(float*)(shm+LDS_WS)+wid*64;
  const bf16*ksrc=Kh+(long)lane*KVP+wid*8;
  const bf16*vsrc=Vh+(long)(16*(wid&3)+(lane>>2))*KVP+(wid>>2)*32+(lane&3)*8;
  const unsigned kdst=lds0+LDS_K+wid*1024, vdst=lds0+LDS_V+wid*1024;
  #define DMA_K(t,slot) glds16(ksrc+(long)(t)*KVBLK*KVP,(unsigned)__builtin_amdgcn_readfirstlane(kdst+(slot)))
  #define DMA_V(t,slot) glds16(vsrc+(long)(t)*KVBLK*KVP,(unsigned)__builtin_amdgcn_readfirstlane(vdst+(slot)))
  const int vb0=(int)(lds0+LDS_V)+((lane>>4)&1)*32+(lane&3)*8+(4*hi+((lane&15)>>2))*64;
  const char*Kbase=shm+LDS_K; bf16x8 kf[8];
  const lds_cptr shm3=(lds_cptr)shm; const lds_cptr kp0=shm3+LDS_K+hi*1024+r32*16; const lds_cptr vp0=shm3+LDS_V+((lane>>4)&1)*32+(lane&3)*8+(4*hi+((lane&15)>>2))*64;
  const int NT=(q0+QB)/KVBLK-j0;
  float*cks=(float*)(shm+LDS_CK);
  for(int i=j0*KVBLK+tid*4;i<q0+QB;i+=NW*64*4){ *(f32x4_t*)(cks+i)=*(const f32x4_t*)(ckg+i); }
  float cqm=ckg[q0+wid*QBLK+r32];
  const lds_cptr ckp=(lds_cptr)shm+LDS_CK+j0*256+hi*16;
  DMA_K(0,0);DMA_V(0,0);DMA_K(1,SLOTB);
  bf16x8 qr[4];
  #pragma unroll
  for(int d0=0;d0<4;++d0)qr[d0]=*reinterpret_cast<const bf16x8*>(&Qw[(long)r32*KVP+d0*16+hi*8]);
  float l_reg=0.f;f32x16 o[2];o[0]=f32x16{};o[1]=f32x16{};
  #define CINIT(C0,C1,t) do{ const lds_cptr cp_=ckp+(t)*256; \
    _Pragma("unroll") for(int g_=0;g_<4;++g_){ const f32x4_t a_=*(const __attribute__((address_space(3))) f32x4_t*)(cp_+g_*32); const f32x4_t b_=*(const __attribute__((address_space(3))) f32x4_t*)(cp_+g_*32+128); \
      _Pragma("unroll") for(int i_=0;i_<4;++i_){ C0[g_*4+i_]=cqm-a_[i_]; C1[g_*4+i_]=cqm-b_[i_]; } } }while(0)
  const int qrel=wid*QBLK+r32;
  #define CMASK(P0,P1,t) do{int jb_=(t)-(NT-4); if(jb_>=0)cmask(P0,P1,jb_,qrel,hi);}while(0)
  bool resc=false;
  #define START(P0,P1) do{ const float rm=rowmax(P0,P1); resc=false; \
    { const float dl=rm; \
      _Pragma("unroll") for(int r=0;r<16;++r){P0[r]=fsub_s(P0[r],dl);P1[r]=fsub_s(P1[r],dl);} \
      cqm=fsub_s(cqm,dl); } \
    _Pragma("unroll") for(int r=0;r<16;++r)P0[r]=__builtin_amdgcn_exp2f(P0[r]); }while(0)
  #define RESC() do{ if(resc){ asm volatile("s_waitcnt lgkmcnt(0)":::"memory"); \
      _Pragma("unroll") for(int d_=0;d_<2;++d_) _Pragma("unroll") for(int r=0;r<16;++r)o[d_][r]*=wsf[crow(r,hi)]; } }while(0)
  f32x16 pA0,pA1,pB0,pB1;
  int sl_prev=0,sl_cur=0,sl_next=SLOTB;
  #define ROT() do{sl_prev=sl_cur;sl_cur=sl_next;sl_next=(sl_next==(NSLOT-1)*SLOTB)?0:sl_next+SLOTB;}while(0)
  DMA_K(2,2*SLOTB);
  WAIT_BAR(3);
  CINIT(pA0,pA1,0);
  qkt(pA0,pA1,Kbase,qr,r32,hi);asm volatile("s_nop 15\n\ts_nop 7":"+v"(pA0),"+v"(pA1));CMASK(pA0,pA1,0);
  START(pA0,pA1);
  _Pragma("unroll") for(int r=0;r<16;++r)pA1[r]=__builtin_amdgcn_exp2f(pA1[r]);
  WAIT_BAR(0);
  DMA_K(3,0);DMA_V(1,SLOTB);
  ROT();
  kload8(kf,kp0+sl_cur);
  WAIT_BAR(2);
  s16x4 vlo[8],vhi[8]; u32x4 pw0,pw1,pw2,pw3;
  #define PKW(P,B) cvtpk_s(P[B],P[B+1])
  #define PAF(k) __builtin_bit_cast(bf16x8,pw##k)
  #define VFR(i) (bf16x8){vlo[i][0],vlo[i][1],vlo[i][2],vlo[i][3],vhi[i][0],vhi[i][1],vhi[i][2],vhi[i][3]}
  #define PIN(x) asm volatile("":"+v"(x))
  #define MX3(a,b,c) __builtin_fmaxf(__builtin_fmaxf((a),(b)),(c))
  #define GAPA(MF,A0,A1,A2,A3,W0,W1,PW) do{ MF; sacc+=A0; sacc+=A1; sacc+=A2; sacc+=A3; PIN(sacc); W0; W1; PIN(PW); SBAR(); }while(0)
  #define EX(v) __builtin_amdgcn_exp2f(v)
  #define GAPB(MF,X,B) do{ MF; X[B]=EX(X[B]); X[B+1]=EX(X[B+1]); X[B+2]=EX(X[B+2]); X[B+3]=EX(X[B+3]); PIN(X); SBAR(); }while(0)
  #define VRD(i) do{ vlo[i]=vtr(vp_+(((i)>>2)*4096+((i)&3)*1024)); vhi[i]=vtr(vp_+(((i)>>2)*4096+((i)&3)*1024+512)); }while(0)
  #define KRD(G,j) do{ if(G){ kload2(kf,kp0+sl_next,j); SBAR(); } }while(0)
  #define STEP(C0,C1,P0,P1,t,GK,GV,GL) do{ SBAR(); \
    CINIT(C0,C1,t); SBAR(); \
    const lds_cptr vp_=vp0+sl_prev; \
    VRD(0); SBAR(); float sacc=(P0[0]+P0[1]); \
    GAPA(C0=__builtin_amdgcn_mfma_f32_32x32x16_bf16(kf[0],qr[0],C0,0,0,0), P0[2],P0[3],P0[4],P0[5],     pw0[0]=PKW(P0,0), pw0[1]=PKW(P0,2), pw0); \
    VRD(4); SBAR(); GAPA(C1=__builtin_amdgcn_mfma_f32_32x32x16_bf16(kf[1],qr[0],C1,0,0,0), P0[6],P0[7],P0[8],P0[9],     pw0[2]=PKW(P0,4), pw0[3]=PKW(P0,6), pw0); \
    VRD(1); SBAR(); GAPA(C0=__builtin_amdgcn_mfma_f32_32x32x16_bf16(kf[2],qr[1],C0,0,0,0),   P0[10],P0[11],P0[12],P0[13], pw1[0]=PKW(P0,8), pw1[1]=PKW(P0,10), pw1); \
    VRD(5); SBAR(); GAPA(C1=__builtin_amdgcn_mfma_f32_32x32x16_bf16(kf[3],qr[1],C1,0,0,0),   P0[14],P0[15],P1[0],P1[1],   pw1[2]=PKW(P0,12),pw1[3]=PKW(P0,14), pw1); \
    VRD(2); SBAR(); GAPA(C0=__builtin_amdgcn_mfma_f32_32x32x16_bf16(kf[4],qr[2],C0,0,0,0),   P1[2],P1[3],P1[4],P1[5],     pw2[0]=PKW(P1,0), pw2[1]=PKW(P1,2), pw2); \
    VRD(6); SBAR(); GAPA(C1=__builtin_amdgcn_mfma_f32_32x32x16_bf16(kf[5],qr[2],C1,0,0,0),   P1[6],P1[7],P1[8],P1[9],     pw2[2]=PKW(P1,4), pw2[3]=PKW(P1,6), pw2); \
    VRD(3); SBAR(); GAPA(C0=__builtin_amdgcn_mfma_f32_32x32x16_bf16(kf[6],qr[3],C0,0,0,0),   P1[10],P1[11],P1[12],P1[13], pw3[0]=PKW(P1,8), pw3[1]=PKW(P1,10), pw3); \
    VRD(7); SBAR(); GAPA(C1=__builtin_amdgcn_mfma_f32_32x32x16_bf16(kf[7],qr[3],C1,0,0,0),   P1[14],P1[15],0.f,0.f,       pw3[2]=PKW(P1,12),pw3[3]=PKW(P1,14), pw3); \
    l_reg+=sacc; \
    if(GK){DMA_K((t)+3,sl_cur);} if(GV){DMA_V((t)+1,sl_next);} \
    CMASK(C0,C1,t); \
    { float a=MX3(C0[0],C0[1],C1[0]),b=MX3(C0[2],C0[3],C1[1]); a=MX3(a,C1[2],C1[3]); \
      _Pragma("unroll") for(int r=4;r<16;r+=4){a=MX3(a,C0[r],C0[r+1]);b=MX3(b,C0[r+2],C0[r+3]);a=MX3(a,C1[r],C1[r+1]);b=MX3(b,C1[r+2],C1[r+3]);} \
      float rm=__builtin_fmaxf(a,b); { auto rr=__builtin_amdgcn_permlane32_swap(__float_as_uint(rm),__float_as_uint(rm),false,false); rm=__builtin_fmaxf(__uint_as_float(rr[0]),__uint_as_float(rr[1])); } \
      resc=false; \
      if(__builtin_expect(__any(rm>(float)THRL),0)){ const float dl=__builtin_fmaxf(rm,0.f); \
        _Pragma("unroll") for(int r=0;r<16;++r){C0[r]-=dl;C1[r]-=dl;} \
        cqm-=dl; \
        const float f=__builtin_amdgcn_exp2f(-dl); l_reg*=f; if(hi==0)wsf[r32]=f; resc=true; } } \
    SBAR(); \
    GAPB(o[0]=__builtin_amdgcn_mfma_f32_32x32x16_bf16(PAF(0),VFR(0),o[0],0,0,0), C0,0); \
    GAPB(o[1]=__builtin_amdgcn_mfma_f32_32x32x16_bf16(PAF(0),VFR(4),o[1],0,0,0), C0,4); \
    KRD(GL,0); GAPB(o[0]=__builtin_amdgcn_mfma_f32_32x32x16_bf16(PAF(1),VFR(1),o[0],0,0,0), C0,8); \
    KRD(GL,1); GAPB(o[1]=__builtin_amdgcn_mfma_f32_32x32x16_bf16(PAF(1),VFR(5),o[1],0,0,0), C0,12); \
    KRD(GL,2); GAPB(o[0]=__builtin_amdgcn_mfma_f32_32x32x16_bf16(PAF(2),VFR(2),o[0],0,0,0), C1,0); \
    KRD(GL,3); GAPB(o[1]=__builtin_amdgcn_mfma_f32_32x32x16_bf16(PAF(2),VFR(6),o[1],0,0,0), C1,4); \
    GAPB(o[0]=__builtin_amdgcn_mfma_f32_32x32x16_bf16(PAF(3),VFR(3),o[0],0,0,0), C1,8); \
    GAPB(o[1]=__builtin_amdgcn_mfma_f32_32x32x16_bf16(PAF(3),VFR(7),o[1],0,0,0), C1,12); \
    }while(0)
  int t=1;
  #undef CMASK
  #define CMASK(P0,P1,t) do{}while(0)
  for(;t+5<NT;t+=2){
    STEP(pB0,pB1,pA0,pA1,t,true,true,true);     WAIT_BAR(2); RESC(); ROT();
    STEP(pA0,pA1,pB0,pB1,t+1,true,true,true);   WAIT_BAR(2); RESC(); ROT();
  }
  #undef CMASK
  #define CMASK(P0,P1,t) do{int jb_=(t)-(NT-4); if(jb_>=0)cmask(P0,P1,jb_,qrel,hi);}while(0)
  #define ENDW(tt) do{ if((tt)+3<NT){WAIT_BAR(2);} else if((tt)+2<NT){WAIT_BAR(1);} else {WAIT_BAR(0);} }while(0)
  for(;t+1<NT;t+=2){
    STEP(pB0,pB1,pA0,pA1,t,(t+3<NT),(t+1<NT),(t+1<NT));       ENDW(t);   RESC(); ROT();
    STEP(pA0,pA1,pB0,pB1,t+1,(t+4<NT),(t+2<NT),(t+2<NT));     ENDW(t+1); RESC(); ROT();
  }
  STEP(pB0,pB1,pA0,pA1,NT-1,false,false,false); RESC();
  { float sacc=pB0[0]+pB0[1]; _Pragma("unroll") for(int r=2;r<16;++r)sacc+=pB0[r]; _Pragma("unroll") for(int r=0;r<16;++r)sacc+=pB1[r]; l_reg+=sacc;
    pw0=(u32x4){PKW(pB0,0),PKW(pB0,2),PKW(pB0,4),PKW(pB0,6)};pw1=(u32x4){PKW(pB0,8),PKW(pB0,10),PKW(pB0,12),PKW(pB0,14)};pw2=(u32x4){PKW(pB1,0),PKW(pB1,2),PKW(pB1,4),PKW(pB1,6)};pw3=(u32x4){PKW(pB1,8),PKW(pB1,10),PKW(pB1,12),PKW(pB1,14)};
    SBAR(); pv(o,vb0+sl_cur,PAF(0),PAF(1),PAF(2),PAF(3)); }
  #undef PKW
  #undef PAF
  #undef VFR
  #undef PIN
  #undef MX3
  #undef GAPA
  #undef GAPB
  #undef EX
  #undef VRD
  #undef KRD
  #undef STEP
  #undef ENDW
  {auto rr=__builtin_amdgcn_permlane32_swap(__float_as_uint(l_reg),__float_as_uint(l_reg),false,false);l_reg=__uint_as_float(rr[0])+__uint_as_float(rr[1]);}
  if(hi==0)wsf[32+r32]=l_reg;asm volatile("s_waitcnt lgkmcnt(0)":::"memory");
  float rli[16];
  #pragma unroll
  for(int r=0;r<16;++r)rli[r]=__builtin_amdgcn_rcpf(wsf[32+crow(r,hi)]);
  bf16*Ow=O+(rowbase+q0+wid*QBLK)*OP+h*D;
  { bf16*stg=(bf16*)(shm+LDS_OST)+wid*2048;
    #pragma unroll
    for(int r=0;r<16;++r){const int orow=crow(r,hi);
      #pragma unroll
      for(int d0=0;d0<2;++d0)stg[orow*64+d0*32+r32]=__float2bfloat16(o[d0][r]*rli[r]);}
    asm volatile("s_waitcnt lgkmcnt(0)":::"memory");
    #pragma unroll
    for(int i=0;i<4;++i){const int row=i*8+(lane>>3),ch=lane&7; const u32x4 v=*(const u32x4*)(stg+row*64+ch*8); ATTN_STORE16(Ow+(long)row*OP+ch*8,v);} }
  asm volatile("s_waitcnt lgkmcnt(0)\n\ts_barrier":::"memory");
  #undef DMA_K
  #undef DMA_V
  #undef CMASK
  #undef START
  #undef RESC
  #undef ROT
  #undef CINIT
}
constexpr int ATTN_LDS_BYTES=LDS_BYTES;
struct AttnTensors { const bf16* Q; const bf16* K; const bf16* V; bf16* O; const float* CK; const float* KT; const float* QB; };
struct AttnUnit { int bh; int qb; };
struct QueueOrder {
  unsigned* head; volatile __attribute__((address_space(3))) int* slot;
  __device__ __forceinline__ bool next(int,AttnUnit&u)const{
    if(tid_l()==0) *slot=(int)__hip_atomic_fetch_add(head,1u,__ATOMIC_RELAXED,__HIP_MEMORY_SCOPE_AGENT);
    __syncthreads(); const int v=*slot; __syncthreads();
    if(v>=BATCH*NHEAD*NQB)return false; u.qb=NQB-1-v/(BATCH*NHEAD); u.bh=v%(BATCH*NHEAD); return true; }
  __device__ __forceinline__ void a_ready(const AttnUnit&)const{}
  __device__ __forceinline__ void done(const AttnUnit&)const{}
};
template<class Sched,int THRL=8> __device__ __forceinline__ void attn_phase(char*lds,const AttnTensors&T,const Sched&S){
  AttnUnit u;
  for(int i=0;S.next(i,u);++i){ S.a_ready(u); attn_unit<THRL>(u.bh/NHEAD,u.bh%NHEAD,u.qb,T.Q,T.K,T.V,T.O,T.CK,T.KT,T.QB,lds); S.done(u); }
}
#undef SBAR
#undef WAIT_BAR
}

constexpr int NB = 8, SEQ = 4096, T = NB * SEQ, D = 1024, DEPTH = 4;
constexpr int HCOLS = 3072;
constexpr int HC_AVAL = 0, HC_AGATE = 256, HC_BQ = 512, HC_BK = 704, HC_BV = 896, HC_BG = 1280, HC_CQ = 1664, HC_CK = 2048, HC_CV = 2432, HC_LR = 2816, HC_CF = 2832;
constexpr int IN_COLS = 2838;
constexpr int MC_A = 0, MC_B = 256, MC_C = 640;
constexpr float LN_EPS = 1e-5f;
constexpr float ALPHA = 1.6817928305074292f;
constexpr float LOG2E = 1.4426950408889634f;
constexpr float C2 = 0.125f * LOG2E;
constexpr float GLA_QSCALE = 0.17677669529663687f;
constexpr int NEXP = 16384;

constexpr size_t MiB = 1u << 20;
constexpr size_t WS_CTL = 0, CTL_ZERO_BYTES = 1 * MiB;
constexpr size_t WS_WIN = 1 * MiB;
constexpr size_t WS_WOUT = WS_WIN + 24 * MiB;
constexpr size_t WS_WP = WS_WOUT + 8 * MiB;
constexpr size_t WS_PGW = WS_WP + 16 * MiB;
constexpr size_t WS_PW = WS_PGW + 8 * MiB;
constexpr size_t WS_CK = WS_PW + 2 * MiB;
constexpr size_t WS_FKT = WS_CK + 768 * 1024, WS_FQB = WS_FKT + 16 * 1024;
constexpr size_t WS_U = WS_CK + 1 * MiB;
constexpr size_t WS_V = WS_U + 32 * MiB;
constexpr size_t WS_XB = WS_V + 32 * MiB;
constexpr size_t WS_XF = WS_XB + 64 * MiB;
constexpr size_t WS_XQ = WS_XF, WS_XS = WS_XF + 32 * MiB, WS_RS = WS_XS + 1 * MiB, WS_VS = WS_RS + 65536;
constexpr size_t WS_PB = WS_XF + 128 * MiB;
constexpr size_t WS_H = WS_PB + 16 * MiB;
constexpr size_t WS_MIX = WS_H + 192 * MiB;
constexpr size_t WS_SC = WS_H;
constexpr size_t WS_Y = WS_MIX + 64 * MiB;
constexpr size_t WS_GCUM = WS_Y;
constexpr size_t WS_GS = WS_GCUM + 24 * MiB;
constexpr size_t WS_GDEC = WS_GS + 24 * MiB;
constexpr size_t WS_E = WS_Y + 128 * MiB;
constexpr size_t WS_EIDX = WS_E + 64 * MiB;
constexpr size_t WS_GATE = WS_EIDX + 16 * MiB;
constexpr size_t WS_SOFF = WS_GATE + 16 * MiB;
constexpr size_t WS_END = WS_SOFF + 1 * MiB;
static_assert(WS_END <= 1024 * MiB, "d_ws map");

constexpr int LDS_BYTES = 147456;

typedef unsigned short bf16;
typedef float f32x4 __attribute__((ext_vector_type(4)));
typedef unsigned u32x4 __attribute__((ext_vector_type(4)));
typedef unsigned u32x2 __attribute__((ext_vector_type(2)));

struct Params {
    const float *x, *p, *w_in, *conv_w, *conv_b, *conv_ln_g, *conv_ln_b, *gla_gate_w, *gla_gate_b, *gla_norm_g, *fox_forget_b, *w_out, *ln1_g, *ln1_b,
        *peer_wq, *peer_keys, *peer_u, *peer_v, *ple_w, *ple_gw, *ple_gb, *ln2_g, *ln2_b;
    float* out; unsigned char* ws;
};

__device__ __forceinline__ float bf2f(unsigned h) { return __uint_as_float(h << 16); }
__device__ __forceinline__ unsigned f2bf(float f) { unsigned u = __float_as_uint(f); return (u + 0x7fffu + ((u >> 16) & 1u)) >> 16; }
__device__ __forceinline__ unsigned pk2(float lo, float hi) { return f2bf(lo) | (f2bf(hi) << 16); }
__device__ __forceinline__ float wave_sum(float v) {
#pragma unroll
    for (int o = 1; o < 64; o <<= 1) v += __shfl_xor(v, o);
    return v;
}
__device__ __forceinline__ float log_sigmoid(float z) { return fminf(z, 0.f) - log1pf(__expf(-fabsf(z))); }
__device__ __forceinline__ float sigmoidf_(float z) { return 1.0f / (1.0f + __expf(-z)); }

struct MapIdent { __device__ __forceinline__ void operator()(int n, int& c, float& s) const { c = n; s = 1.f; } };
struct MapWin {
    __device__ __forceinline__ void operator()(int n, int& c, float& s) const {
        s = 1.f;
        if (n < HC_CQ) { c = n; if (n >= HC_BQ && n < HC_BK) s = GLA_QSCALE; }
        else if (n < HC_LR) { c = n + 16; if (n < HC_CK) s = C2; }
        else if (n < HC_CF) c = n - HC_LR + 1664;
        else if (n < IN_COLS) c = n;
        else c = -1;
    }
};
template <class CM>
__device__ __forceinline__ void transpose_item(const float* W, int K, int Nsrc, bf16* WT, int item, int nblk, float* scr, int lane, const CM& cm) {
    const int kb = item / nblk, nb = item % nblk, k0 = 64 * kb, n0 = 32 * nb;
    int sc; float scale; cm(n0 + (lane & 31), sc, scale);
#pragma unroll 8
    for (int i = 0; i < 32; ++i) { const int kk = 2 * i + (lane >> 5); scr[kk * 33 + (lane & 31)] = sc >= 0 ? W[(size_t)(k0 + kk) * Nsrc + sc] * scale : 0.f; }
    __builtin_amdgcn_wave_barrier(); asm volatile("s_waitcnt lgkmcnt(0)" ::: "memory");
    const int c = lane & 7;
#pragma unroll
    for (int j = 0; j < 4; ++j) { const int n = (lane >> 3) + 8 * j; const float* s = scr + (8 * c) * 33 + n;
        u32x4 o; o.x = pk2(s[0 * 33], s[1 * 33]); o.y = pk2(s[2 * 33], s[3 * 33]); o.z = pk2(s[4 * 33], s[5 * 33]); o.w = pk2(s[6 * 33], s[7 * 33]);
        *(u32x4*)(WT + (size_t)(n0 + n) * K + k0 + 8 * c) = o; }
    asm volatile("s_waitcnt lgkmcnt(0)" ::: "memory"); __builtin_amdgcn_wave_barrier();
}
__device__ __forceinline__ void cvt_bf16_stream(const float* src, bf16* dst, size_t n8, size_t gtid, size_t gthreads) {
    for (size_t i = gtid; i < n8; i += gthreads) { const f32x4 a = *(const f32x4*)(src + i * 8), b = *(const f32x4*)(src + i * 8 + 4);
        u32x4 o; o.x = pk2(a[0], a[1]); o.y = pk2(a[2], a[3]); o.z = pk2(b[0], b[1]); o.w = pk2(b[2], b[3]); *(u32x4*)(dst + i * 8) = o; }
}

__device__ __forceinline__ void phase_pro_a(const Params& p, unsigned char* lds) {
    const int tid = tid_l(), lane = tid & 63, wave = tid >> 6;
    float* scr = (float*)(lds + wave * 16384);
    const int gw = bid_l() * 8 + wave, NGW = grid_l() * 8;
    constexpr int I_WIN = (D / 64) * (HCOLS / 32), I_SQ = (D / 64) * (D / 32), I_PW = (256 / 64) * (D / 32);
    constexpr int PER_L = I_WIN + 2 * I_SQ + I_PW;
    for (int it = gw; it < DEPTH * PER_L; it += NGW) {
        const int l = it / PER_L; int r = it % PER_L;
        if (r < I_WIN) { transpose_item(p.w_in + (size_t)l * D * IN_COLS, D, IN_COLS, (bf16*)(p.ws + WS_WIN) + (size_t)l * HCOLS * D, r, HCOLS / 32, scr, lane, MapWin()); continue; } r -= I_WIN;
        if (r < I_SQ) { transpose_item(p.w_out + (size_t)l * D * D, D, D, (bf16*)(p.ws + WS_WOUT) + (size_t)l * D * D, r, D / 32, scr, lane, MapIdent()); continue; } r -= I_SQ;
        if (r < I_SQ) { transpose_item(p.ple_gw + (size_t)l * D * D, D, D, (bf16*)(p.ws + WS_PGW) + (size_t)l * D * D, r, D / 32, scr, lane, MapIdent()); continue; } r -= I_SQ;
        transpose_item(p.ple_w + (size_t)l * 256 * D, 256, D, (bf16*)(p.ws + WS_PW) + (size_t)l * D * 256, r, D / 32, scr, lane, MapIdent());
    }
    cvt_bf16_stream(p.x, (bf16*)(p.ws + WS_XB), (size_t)T * D / 8, (size_t)bid_l() * 512 + tid, (size_t)grid_l() * 512);
}
__device__ __forceinline__ void phase_pro_b(const Params& p, unsigned char* lds) {
    const int tid = tid_l();
    float* ks = (float*)lds;
    float* wqs = ks + 128 * 129;
    for (int it = bid_l(); it < DEPTH * 16 * 16; it += grid_l()) {
        const int l = it >> 8, hc = (it >> 4) & 15, kt = it & 15;
        const float* keys = p.peer_keys + ((size_t)l * 16 + hc) * 16384;
        const float* wq = p.peer_wq + (size_t)l * D * 2048 + (size_t)(kt * 64) * 2048 + hc * 128;
        __syncthreads();
        for (int i = tid; i < 128 * 128; i += 512) ks[(i >> 7) * 129 + (i & 127)] = keys[i];
        for (int i = tid; i < 64 * 128; i += 512) wqs[(i >> 7) * 129 + (i & 127)] = wq[(size_t)(i >> 7) * 2048 + (i & 127)];
        __syncthreads();
        const int k = tid & 63, n0 = (tid >> 6) * 16;
        float acc[16];
#pragma unroll
        for (int j = 0; j < 16; ++j) acc[j] = 0.f;
        for (int d = 0; d < 128; ++d) { const float a = wqs[k * 129 + d];
#pragma unroll
            for (int j = 0; j < 16; ++j) acc[j] += a * ks[(n0 + j) * 129 + d]; }
        bf16* WpT = (bf16*)(p.ws + WS_WP) + (size_t)l * 2048 * D;
#pragma unroll
        for (int j = 0; j < 16; ++j) WpT[(size_t)(hc * 128 + n0 + j) * D + kt * 64 + k] = (bf16)f2bf(acc[j]);
    }
}
constexpr float U8_SCALE = 64.f, V8_SCALE = 1.f;
typedef float f32x2v __attribute__((ext_vector_type(2)));
__device__ __forceinline__ unsigned pk_fp8x4(f32x4 v, float sc) {
    const float a = fminf(fmaxf(v[0] * sc, -448.f), 448.f), b = fminf(fmaxf(v[1] * sc, -448.f), 448.f), c = fminf(fmaxf(v[2] * sc, -448.f), 448.f), d = fminf(fmaxf(v[3] * sc, -448.f), 448.f);
    int w = __builtin_amdgcn_cvt_pk_fp8_f32(a, b, 0, false); w = __builtin_amdgcn_cvt_pk_fp8_f32(c, d, w, true); return (unsigned)w;
}
__device__ __forceinline__ void cvt_fp8_stream(const float* src, unsigned char* dst, size_t n16, float sc, size_t gtid, size_t gthreads) {
    for (size_t i = gtid; i < n16; i += gthreads) { const float* s = src + i * 16; u32x4 o;
        o.x = pk_fp8x4(*(const f32x4*)(s), sc); o.y = pk_fp8x4(*(const f32x4*)(s + 4), sc); o.z = pk_fp8x4(*(const f32x4*)(s + 8), sc); o.w = pk_fp8x4(*(const f32x4*)(s + 12), sc);
        *(u32x4*)(dst + i * 16) = o; }
}
__device__ __forceinline__ float wave_max(float v) {
#pragma unroll
    for (int o = 32; o > 0; o >>= 1) v = fmaxf(v, __shfl_xor(v, o));
    return v;
}
__device__ __forceinline__ unsigned pk_i8x4(f32x4 v, float sc) {
    const int a = (int)__builtin_rintf(v[0] * sc), b = (int)__builtin_rintf(v[1] * sc), c = (int)__builtin_rintf(v[2] * sc), d = (int)__builtin_rintf(v[3] * sc);
    return (unsigned)(a & 255) | ((unsigned)(b & 255) << 8) | ((unsigned)(c & 255) << 16) | ((unsigned)d << 24);
}
__device__ __forceinline__ void cvt_i8_rows(const float* src, unsigned char* dst, float* RS, size_t n16, size_t gtid, size_t gthreads) {
    for (size_t i = gtid; i < n16; i += gthreads) { const float* s_ = src + i * 16;
        const f32x4 a = *(const f32x4*)(s_), b = *(const f32x4*)(s_ + 4), c = *(const f32x4*)(s_ + 8), d = *(const f32x4*)(s_ + 12);
        float m = fmaxf(fmaxf(fmaxf(fabsf(a[0]), fabsf(a[1])), fmaxf(fabsf(a[2]), fabsf(a[3]))), fmaxf(fmaxf(fabsf(b[0]), fabsf(b[1])), fmaxf(fabsf(b[2]), fabsf(b[3]))));
        m = fmaxf(m, fmaxf(fmaxf(fmaxf(fabsf(c[0]), fabsf(c[1])), fmaxf(fabsf(c[2]), fabsf(c[3]))), fmaxf(fmaxf(fabsf(d[0]), fabsf(d[1])), fmaxf(fabsf(d[2]), fabsf(d[3])))));
        m = wave_max(m); const float sc = m > 0.f ? 127.0f / m : 0.f;
        u32x4 o; o.x = pk_i8x4(a, sc); o.y = pk_i8x4(b, sc); o.z = pk_i8x4(c, sc); o.w = pk_i8x4(d, sc);
        *(u32x4*)(dst + i * 16) = o;
        if ((i & 63) == 0) RS[i >> 6] = m * (1.0f / 127.0f); }
}
__device__ __forceinline__ void cvt_fp4_rows(const float* src, unsigned char* dst, float* VS, size_t n16, size_t gtid, size_t gthreads) {
    for (size_t i = gtid; i < n16; i += gthreads) { const float* s_ = src + i * 16;
        const f32x4 a = *(const f32x4*)(s_), b = *(const f32x4*)(s_ + 4), c = *(const f32x4*)(s_ + 8), d = *(const f32x4*)(s_ + 12);
        float m = fmaxf(fmaxf(fmaxf(fabsf(a[0]), fabsf(a[1])), fmaxf(fabsf(a[2]), fabsf(a[3]))), fmaxf(fmaxf(fabsf(b[0]), fabsf(b[1])), fmaxf(fabsf(b[2]), fabsf(b[3]))));
        m = fmaxf(m, fmaxf(fmaxf(fmaxf(fabsf(c[0]), fabsf(c[1])), fmaxf(fabsf(c[2]), fabsf(c[3]))), fmaxf(fmaxf(fabsf(d[0]), fabsf(d[1])), fmaxf(fabsf(d[2]), fabsf(d[3])))));
        m = wave_max(m); const float sc = m > 0.f ? 6.0f / m : 0.f;
        unsigned w0 = 0u, w1 = 0u;
        w0 = __builtin_amdgcn_cvt_scalef32_pk_fp4_f32(w0, a[0] * sc, a[1] * sc, 1.0f, 0); w0 = __builtin_amdgcn_cvt_scalef32_pk_fp4_f32(w0, a[2] * sc, a[3] * sc, 1.0f, 1);
        w0 = __builtin_amdgcn_cvt_scalef32_pk_fp4_f32(w0, b[0] * sc, b[1] * sc, 1.0f, 2); w0 = __builtin_amdgcn_cvt_scalef32_pk_fp4_f32(w0, b[2] * sc, b[3] * sc, 1.0f, 3);
        w1 = __builtin_amdgcn_cvt_scalef32_pk_fp4_f32(w1, c[0] * sc, c[1] * sc, 1.0f, 0); w1 = __builtin_amdgcn_cvt_scalef32_pk_fp4_f32(w1, c[2] * sc, c[3] * sc, 1.0f, 1);
        w1 = __builtin_amdgcn_cvt_scalef32_pk_fp4_f32(w1, d[0] * sc, d[1] * sc, 1.0f, 2); w1 = __builtin_amdgcn_cvt_scalef32_pk_fp4_f32(w1, d[2] * sc, d[3] * sc, 1.0f, 3);
        u32x2 o; o.x = w0; o.y = w1; *(u32x2*)(dst + i * 8) = o;
        if ((i & 63) == 0) VS[i >> 6] = m * (1.0f / 6.0f); }
}
__device__ __forceinline__ void phase_cvt(const Params& p, int l) {
    const size_t gtid = (size_t)bid_l() * 512 + tid_l(), gth = (size_t)grid_l() * 512;
    cvt_bf16_stream(p.p + (size_t)l * T * 256, (bf16*)(p.ws + WS_PB), (size_t)T * 256 / 8, gtid, gth);
    cvt_i8_rows(p.peer_u + (size_t)l * NEXP * D, p.ws + WS_U, (float*)(p.ws + WS_RS), (size_t)NEXP * D / 16, gtid, gth);
    cvt_fp4_rows(p.peer_v + (size_t)l * NEXP * D, p.ws + WS_V, (float*)(p.ws + WS_VS), (size_t)NEXP * D / 16, gtid, gth);
}

#define GEMM_RUN(EPI, e, Aptr, Bptr, N_, K_) do { int kk_ = (K_); asm volatile("" : "+s"(kk_)); pg8::Gemm g{(const pg8::bf16_t*)(Aptr), (const pg8::bf16_t*)(Bptr), T, (N_), kk_}; pg8::StaticOrder S; S.init(T, (N_), (int)grid_l(), (int)bid_l()); \
    pg8::gemm_phase<EPI, pg8::StaticOrder, true, true>((PG8_LAS unsigned char*)lds, g, S, e); } while (0)

__device__ __forceinline__ void phase_gemm_in(const Params& p, int l, unsigned char* lds) {
    pg8::EpiBf16<0> e{(pg8::bf16_t*)(p.ws + WS_H), HCOLS, nullptr, 0, 0, 1.f};
    GEMM_RUN(pg8::EpiBf16<0>, e, p.ws + WS_XB, (bf16*)(p.ws + WS_WIN) + (size_t)l * HCOLS * D, HCOLS, D);
}
__device__ __forceinline__ void phase_gemm_e(const Params& p, int l, unsigned char* lds) {
    pg8::EpiBf16<0> e{(pg8::bf16_t*)(p.ws + WS_E), D, nullptr, 0, 0, 1.f};
    GEMM_RUN(pg8::EpiBf16<0>, e, p.ws + WS_PB, (bf16*)(p.ws + WS_PW) + (size_t)l * D * 256, D, 256);
}
__device__ __forceinline__ void phase_gemm_out(const Params& p, int l, unsigned char* lds) {
    pg8::EpiResid e{(const pg8::bf16_t*)(p.ws + WS_XB), (_Float16*)(p.ws + WS_Y), D, ALPHA};
    GEMM_RUN(pg8::EpiResid, e, p.ws + WS_MIX, (bf16*)(p.ws + WS_WOUT) + (size_t)l * D * D, D, D);
}
__device__ __forceinline__ void phase_gemm_sc(const Params& p, int l, unsigned char* lds) {
    pg8::EpiF16 e{(_Float16*)(p.ws + WS_SC), 2048};
    GEMM_RUN(pg8::EpiF16, e, p.ws + WS_XB, (bf16*)(p.ws + WS_WP) + (size_t)l * 2048 * D, 2048, D);
}
__device__ __forceinline__ void phase_gemm_ple(const Params& p, int l, unsigned char* lds) {
    pg8::EpiPle e{(const pg8::bf16_t*)(p.ws + WS_XB), (_Float16*)(p.ws + WS_Y), (const pg8::bf16_t*)(p.ws + WS_E), p.ple_gb + (size_t)l * D, D};
    GEMM_RUN(pg8::EpiPle, e, p.ws + WS_XB, (bf16*)(p.ws + WS_PGW) + (size_t)l * D * D, D, D);
}

__device__ __forceinline__ void phase_conv(const Params& p, int l, unsigned char* lds) {
    const int tid = tid_l(), lane = tid & 63, wave = tid >> 6;
    float* U = (float*)lds;
    float* Yt = U + 62 * 256;
    const bf16* H = (const bf16*)(p.ws + WS_H); bf16* MIX = (bf16*)(p.ws + WS_MIX);
    const float* cw = p.conv_w + (size_t)l * 31 * 256; const float* cb = p.conv_b + l * 256;
    const float* lg = p.conv_ln_g + l * 256; const float* lb = p.conv_ln_b + l * 256;
    for (int it = bid_l(); it < T / 32; it += grid_l()) {
        const int b = it / (SEQ / 32), t0 = (it % (SEQ / 32)) * 32;
        __syncthreads();
        for (int i = tid; i < 62 * 32; i += 512) { const int r = i >> 5, c8 = (i & 31) * 8, t = t0 - 30 + r; f32x4 u0 = {0.f, 0.f, 0.f, 0.f}, u1 = {0.f, 0.f, 0.f, 0.f};
            if (t >= 0) { const bf16* hr = H + (size_t)(b * SEQ + t) * HCOLS; const u32x4 av = *(const u32x4*)(hr + HC_AVAL + c8), gv = *(const u32x4*)(hr + HC_AGATE + c8);
#pragma unroll
                for (int j = 0; j < 2; ++j) { u0[2 * j] = bf2f(av[j] & 0xffffu) * sigmoidf_(bf2f(gv[j] & 0xffffu)); u0[2 * j + 1] = __uint_as_float(av[j] & 0xffff0000u) * sigmoidf_(__uint_as_float(gv[j] & 0xffff0000u));
                                              u1[2 * j] = bf2f(av[2 + j] & 0xffffu) * sigmoidf_(bf2f(gv[2 + j] & 0xffffu)); u1[2 * j + 1] = __uint_as_float(av[2 + j] & 0xffff0000u) * sigmoidf_(__uint_as_float(gv[2 + j] & 0xffff0000u)); } }
            *(f32x4*)(U + r * 256 + c8) = u0; *(f32x4*)(U + r * 256 + c8 + 4) = u1; }
        __syncthreads();
        { const int c = tid & 255, half = tid >> 8; float w[31], win[46];
#pragma unroll
          for (int j = 0; j < 31; ++j) w[j] = cw[j * 256 + c];
#pragma unroll
          for (int j = 0; j < 46; ++j) win[j] = U[(half * 16 + j) * 256 + c];
          const float bias = cb[c];
#pragma unroll
          for (int tl = 0; tl < 16; ++tl) { float y = bias;
#pragma unroll
              for (int j = 0; j < 31; ++j) y += w[j] * win[tl + j];
              Yt[(half * 16 + tl) * 256 + c] = y; } }
        __syncthreads();
        for (int tl = wave * 4; tl < wave * 4 + 4; ++tl) {
            const f32x4 v = *(const f32x4*)(Yt + tl * 256 + lane * 4);
            const float mean = wave_sum((v[0] + v[1]) + (v[2] + v[3])) * (1.f / 256.f);
            const f32x4 d = v - mean; const float var = wave_sum((d[0] * d[0] + d[1] * d[1]) + (d[2] * d[2] + d[3] * d[3])) * (1.f / 256.f);
            const float rstd = 1.0f / sqrtf(var + LN_EPS);
            const f32x4 g4 = *(const f32x4*)(lg + lane * 4), b4 = *(const f32x4*)(lb + lane * 4);
            float o[4];
#pragma unroll
            for (int i = 0; i < 4; ++i) { const float z = d[i] * rstd * g4[i] + b4[i]; o[i] = z * sigmoidf_(z); }
            u32x2 w2; w2.x = pk2(o[0], o[1]); w2.y = pk2(o[2], o[3]);
            *(u32x2*)(MIX + (size_t)(b * SEQ + t0 + tl) * D + MC_A + lane * 4) = w2;
        }
    }
}

__device__ __forceinline__ void phase_fox_cum(const Params& p, int l, unsigned char* lds) {
    const int tid = tid_l(), lane = tid & 63, wave = tid >> 6;
    float* wsum = (float*)lds;
    const bf16* H = (const bf16*)(p.ws + WS_H); float* CK = (float*)(p.ws + WS_CK);
    for (int bh = bid_l(); bh < 48; bh += grid_l()) {
        const int b = bh / 6, h = bh % 6; const float bias = p.fox_forget_b[l * 6 + h];
        float v[8]; float s = 0.f;
#pragma unroll
        for (int i = 0; i < 8; ++i) { const float f = bf2f(H[(size_t)(b * SEQ + tid * 8 + i) * HCOLS + HC_CF + h]); s += log_sigmoid(f + bias) * LOG2E; v[i] = s; }
        float incl = s;
#pragma unroll
        for (int o = 1; o < 64; o <<= 1) { const float n = __shfl_up(incl, o); if (lane >= o) incl += n; }
        __syncthreads();
        if (lane == 63) wsum[wave] = incl;
        __syncthreads();
        float base = incl - s;
        for (int w = 0; w < wave; ++w) base += wsum[w];
#pragma unroll
        for (int i = 0; i < 8; ++i) CK[(size_t)bh * SEQ + tid * 8 + i] = base + v[i];
    }
}

__device__ __forceinline__ void phase_fox_norm(const Params& p, unsigned char* lds) {
    const int tid = tid_l(), lane = tid & 63, wave = tid >> 6;
    float* qns = (float*)lds; float* kns = qns + 256;
    const bf16* H = (const bf16*)(p.ws + WS_H); float* KT = (float*)(p.ws + WS_FKT); float* QBM = (float*)(p.ws + WS_FQB);
    for (int it = bid_l(); it < 48 * 16; it += grid_l()) {
        const int bh = it >> 4, qb = it & 15, b = bh / 6, h = bh % 6;
        __syncthreads();
        if (tid < 256) { const bf16* row = H + ((size_t)b * SEQ + qb * 256 + tid) * HCOLS + h * 64; float sq = 0.f, sk = 0.f;
#pragma unroll
            for (int j = 0; j < 8; ++j) { const u32x4 qv = *(const u32x4*)(row + HC_CQ + 8 * j), kv = *(const u32x4*)(row + HC_CK + 8 * j);
#pragma unroll
                for (int i = 0; i < 4; ++i) { const float a0 = bf2f(qv[i] & 0xffffu), a1 = __uint_as_float(qv[i] & 0xffff0000u), b0 = bf2f(kv[i] & 0xffffu), b1 = __uint_as_float(kv[i] & 0xffff0000u);
                    sq += a0 * a0 + a1 * a1; sk += b0 * b0 + b1 * b1; } }
            qns[tid] = sqrtf(sq); kns[tid] = sqrtf(sk); }
        __syncthreads();
        if (wave < 5) { float v = wave < 4 ? kns[wave * 64 + lane] : fmaxf(fmaxf(qns[lane], qns[64 + lane]), fmaxf(qns[128 + lane], qns[192 + lane]));
#pragma unroll
            for (int o = 1; o < 64; o <<= 1) v = fmaxf(v, __shfl_xor(v, o));
            if (lane == 0) { if (wave < 4) KT[bh * 64 + 4 * qb + wave] = v; else QBM[bh * 16 + qb] = v; } }
    }
}

typedef short bf16x8_t __attribute__((ext_vector_type(8)));
typedef float f32x16_t __attribute__((ext_vector_type(16)));
__device__ __forceinline__ int crow32(int r, int hi) { return (r & 3) + 8 * (r >> 2) + 4 * hi; }
struct GlaB1Pre { u32x4 vv, lr0, lr1; u32x2 kk; float w2v, b2v; };
__device__ __forceinline__ GlaB1Pre gla_b1_load(const Params& p, int l, int it, int tid, int lane, int wave) {
    const int bh = it >> 6, n = it & 63, b = bh / 6, h = bh % 6; const size_t tok0 = (size_t)b * SEQ + n * 64; const bf16* H = (const bf16*)(p.ws + WS_H);
    GlaB1Pre r; r.w2v = p.gla_gate_w[(size_t)l * 16 * 192 + (tid >> 5) * 192 + h * 32 + (tid & 31)]; r.b2v = p.gla_gate_b[l * 192 + h * 32 + (tid & 31)];
    r.vv = *(const u32x4*)(H + (tok0 + (tid >> 3)) * HCOLS + HC_BV + h * 64 + (tid & 7) * 8);
    r.lr0 = *(const u32x4*)(H + (tok0 + lane) * HCOLS + HC_LR); r.lr1 = *(const u32x4*)(H + (tok0 + lane) * HCOLS + HC_LR + 8);
    r.kk = *(const u32x2*)(H + (tok0 + lane) * HCOLS + HC_BK + h * 32 + wave * 4);
    return r;
}
__device__ __forceinline__ void phase_gla_b1(const Params& p, int l, unsigned char* lds) {
    const int tid = tid_l(), lane = tid & 63, wave = tid >> 6, r32 = lane & 31, hi = lane >> 5;
    bf16* KDT = (bf16*)lds;
    bf16* VT = KDT + 32 * 72;
    float* w2s = (float*)(VT + 64 * 72);
    float* b2s = w2s + 16 * 32;
    float* GCUM = (float*)(p.ws + WS_GCUM); float* GS = (float*)(p.ws + WS_GS); float* GDEC = (float*)(p.ws + WS_GDEC);
    const int NI = 48 * 64, G = grid_l(); int it = bid_l();
    if (it >= NI) return;
    GlaB1Pre cur = gla_b1_load(p, l, it, tid, lane, wave);
#pragma unroll 1
    for (; it < NI; it += G) {
        const GlaB1Pre nxt = gla_b1_load(p, l, it + G < NI ? it + G : it, tid, lane, wave);
        __builtin_amdgcn_sched_barrier(0);
        const int bh = it >> 6, n = it & 63, b = bh / 6, h = bh % 6; const size_t tok0 = (size_t)b * SEQ + n * 64;
        __syncthreads();
        w2s[tid] = cur.w2v;
        if (tid < 32) b2s[tid] = cur.b2v;
        { const int s_ = tid >> 3, e0 = (tid & 7) * 8;
#pragma unroll
          for (int i = 0; i < 4; ++i) { VT[(e0 + 2 * i) * 72 + s_] = (bf16)(cur.vv[i] & 0xffffu); VT[(e0 + 2 * i + 1) * 72 + s_] = (bf16)(cur.vv[i] >> 16); } }
        const int d0 = wave * 4;
        __syncthreads();
        float lrf[16];
#pragma unroll
        for (int i = 0; i < 4; ++i) { lrf[2 * i] = bf2f(cur.lr0[i] & 0xffffu); lrf[2 * i + 1] = __uint_as_float(cur.lr0[i] & 0xffff0000u); lrf[8 + 2 * i] = bf2f(cur.lr1[i] & 0xffffu); lrf[8 + 2 * i + 1] = __uint_as_float(cur.lr1[i] & 0xffff0000u); }
        float g[4];
#pragma unroll
        for (int dd = 0; dd < 4; ++dd) { float x = b2s[d0 + dd];
#pragma unroll
            for (int r = 0; r < 16; ++r) x += lrf[r] * w2s[r * 32 + d0 + dd];
            g[dd] = log_sigmoid(x) * (1.0f / 16.0f); }
#pragma unroll
        for (int o = 1; o < 64; o <<= 1)
#pragma unroll
            for (int dd = 0; dd < 4; ++dd) { const float v = __shfl_up(g[dd], o); if (lane >= o) g[dd] += v; }
        *(f32x4*)(GCUM + (tok0 + lane) * 192 + h * 32 + d0) = (f32x4){g[0], g[1], g[2], g[3]};
        const float kf[4] = {bf2f(cur.kk.x & 0xffffu), __uint_as_float(cur.kk.x & 0xffff0000u), bf2f(cur.kk.y & 0xffffu), __uint_as_float(cur.kk.y & 0xffff0000u)};
#pragma unroll
        for (int dd = 0; dd < 4; ++dd) { const float last = __uint_as_float(__builtin_amdgcn_readlane(__float_as_uint(g[dd]), 63));
            KDT[(d0 + dd) * 72 + lane] = (bf16)f2bf(kf[dd] * __expf(last - g[dd]));
            if (lane == 63) GDEC[(size_t)it * 32 + d0 + dd] = __expf(last); }
        __syncthreads();
        if (wave < 2) {
            f32x16_t acc = {};
#pragma unroll
            for (int ks = 0; ks < 4; ++ks) { const bf16x8_t a = *(const bf16x8_t*)(KDT + r32 * 72 + 16 * ks + 8 * hi), bb = *(const bf16x8_t*)(VT + (32 * wave + r32) * 72 + 16 * ks + 8 * hi);
                acc = __builtin_amdgcn_mfma_f32_32x32x16_bf16(a, bb, acc, 0, 0, 0); }
#pragma unroll
            for (int r = 0; r < 16; ++r) GS[(size_t)it * 2048 + crow32(r, hi) * 64 + 32 * wave + r32] = acc[r];
        }
        cur = nxt;
    }
}
__device__ __forceinline__ void phase_gla_b2(const Params& p) {
    float* GS = (float*)(p.ws + WS_GS); const float* GDEC = (const float*)(p.ws + WS_GDEC);
    for (int g = bid_l() * 512 + tid_l(); g < 48 * 2048; g += grid_l() * 512) {
        const int bh = g >> 11, de = g & 2047, d = de >> 6; float S = 0.f;
        float* gs = GS + (size_t)bh * 64 * 2048 + de; const float* gd = GDEC + (size_t)bh * 64 * 32 + d;
#pragma unroll 1
        for (int n0 = 0; n0 < 64; n0 += 16) { float loc[16], dec[16];
#pragma unroll
            for (int i = 0; i < 16; ++i) { loc[i] = gs[(size_t)(n0 + i) * 2048]; dec[i] = gd[(n0 + i) * 32]; }
#pragma unroll
            for (int i = 0; i < 16; ++i) { gs[(size_t)(n0 + i) * 2048] = S; S = S * dec[i] + loc[i]; } }
    }
}
struct GlaB3Pre { u32x2 qq, kk; f32x4 c; u32x4 vv; f32x4 sv; u32x4 gr; };
__device__ __forceinline__ GlaB3Pre gla_b3_load(const Params& p, int it, int tid) {
    const int bh = it >> 6, n = it & 63, b = bh / 6, h = bh % 6; const size_t tok0 = (size_t)b * SEQ + n * 64; const bf16* H = (const bf16*)(p.ws + WS_H);
    const float* GCUM = (const float*)(p.ws + WS_GCUM); const float* GS = (const float*)(p.ws + WS_GS);
    GlaB3Pre r; const int t = tid >> 3, d0 = (tid & 7) * 4;
    r.qq = *(const u32x2*)(H + (tok0 + t) * HCOLS + HC_BQ + h * 32 + d0); r.kk = *(const u32x2*)(H + (tok0 + t) * HCOLS + HC_BK + h * 32 + d0);
    r.c = *(const f32x4*)(GCUM + (tok0 + t) * 192 + h * 32 + d0);
    r.vv = *(const u32x4*)(H + (tok0 + t) * HCOLS + HC_BV + h * 64 + (tid & 7) * 8);
    r.sv = *(const f32x4*)(GS + (size_t)it * 2048 + (tid >> 4) * 64 + (tid & 15) * 4);
    r.gr = *(const u32x4*)(H + (tok0 + t) * HCOLS + HC_BG + h * 64 + (tid & 7) * 8);
    return r;
}
__device__ __forceinline__ void phase_gla_b3(const Params& p, int l, unsigned char* lds) {
    const int tid = tid_l(), lane = tid & 63, wave = tid >> 6, r32 = lane & 31, hi = lane >> 5;
    bf16* QE = (bf16*)lds;
    bf16* KE = QE + 64 * 40;
    bf16* VT = KE + 64 * 40;
    bf16* ST = VT + 64 * 72;
    bf16* P = ST + 64 * 40;
    float* O = (float*)(P + 64 * 72);
    bf16* MIX = (bf16*)(p.ws + WS_MIX);
    const int NI = 48 * 64, G = grid_l(); int it = bid_l();
    if (it >= NI) return;
    GlaB3Pre cur = gla_b3_load(p, it, tid);
#pragma unroll 1
    for (; it < NI; it += G) {
        const GlaB3Pre nxt = gla_b3_load(p, it + G < NI ? it + G : it, tid);
        __builtin_amdgcn_sched_barrier(0);
        const int bh = it >> 6, n = it & 63, b = bh / 6, h = bh % 6; const size_t tok0 = (size_t)b * SEQ + n * 64;
        __syncthreads();
        { const int t = tid >> 3, d0 = (tid & 7) * 4; const u32x2 qq = cur.qq, kk = cur.kk; const f32x4 c = cur.c;
          const float e0 = __expf(c[0]), e1 = __expf(c[1]), e2 = __expf(c[2]), e3 = __expf(c[3]);
          u32x2 qo, ko;
          qo.x = pk2(bf2f(qq.x & 0xffffu) * e0, __uint_as_float(qq.x & 0xffff0000u) * e1); qo.y = pk2(bf2f(qq.y & 0xffffu) * e2, __uint_as_float(qq.y & 0xffff0000u) * e3);
          ko.x = pk2(bf2f(kk.x & 0xffffu) / e0, __uint_as_float(kk.x & 0xffff0000u) / e1); ko.y = pk2(bf2f(kk.y & 0xffffu) / e2, __uint_as_float(kk.y & 0xffff0000u) / e3);
          *(u32x2*)(QE + t * 40 + d0) = qo; *(u32x2*)(KE + t * 40 + d0) = ko; }
        { const int s_ = tid >> 3, e0 = (tid & 7) * 8;
#pragma unroll
          for (int i = 0; i < 4; ++i) { VT[(e0 + 2 * i) * 72 + s_] = (bf16)(cur.vv[i] & 0xffffu); VT[(e0 + 2 * i + 1) * 72 + s_] = (bf16)(cur.vv[i] >> 16); } }
        { const int d = tid >> 4, e0 = (tid & 15) * 4;
#pragma unroll
          for (int i = 0; i < 4; ++i) ST[(e0 + i) * 40 + d] = (bf16)f2bf(cur.sv[i]); }
        __syncthreads();
        f32x16_t acc = {};
        const int tt = (wave & 3) >> 1, tc = wave & 1;
        if (wave < 4) {
            if (!(tt == 0 && tc == 1)) {
#pragma unroll
                for (int ks = 0; ks < 2; ++ks) { const bf16x8_t a = *(const bf16x8_t*)(QE + (32 * tt + r32) * 40 + 16 * ks + 8 * hi), bb = *(const bf16x8_t*)(KE + (32 * tc + r32) * 40 + 16 * ks + 8 * hi);
                    acc = __builtin_amdgcn_mfma_f32_32x32x16_bf16(a, bb, acc, 0, 0, 0); }
#pragma unroll
                for (int r = 0; r < 16; ++r) { const int trow = 32 * tt + crow32(r, hi), scol = 32 * tc + r32; P[trow * 72 + scol] = (bf16)f2bf(scol <= trow ? acc[r] : 0.f); }
            }
        } else {
#pragma unroll
            for (int ks = 0; ks < 2; ++ks) { const bf16x8_t a = *(const bf16x8_t*)(QE + (32 * tt + r32) * 40 + 16 * ks + 8 * hi), bb = *(const bf16x8_t*)(ST + (32 * tc + r32) * 40 + 16 * ks + 8 * hi);
                acc = __builtin_amdgcn_mfma_f32_32x32x16_bf16(a, bb, acc, 0, 0, 0); }
        }
        __syncthreads();
        if (wave >= 4) {
            const int nks = tt == 0 ? 2 : 4;
            for (int ks = 0; ks < nks; ++ks) { const bf16x8_t a = *(const bf16x8_t*)(P + (32 * tt + r32) * 72 + 16 * ks + 8 * hi), bb = *(const bf16x8_t*)(VT + (32 * tc + r32) * 72 + 16 * ks + 8 * hi);
                acc = __builtin_amdgcn_mfma_f32_32x32x16_bf16(a, bb, acc, 0, 0, 0); }
#pragma unroll
            for (int r = 0; r < 16; ++r) O[(32 * tt + crow32(r, hi)) * 65 + 32 * tc + r32] = acc[r];
        }
        __syncthreads();
        { const int t = tid >> 3, e0 = (tid & 7) * 8; float o[8]; float ss = 0.f;
#pragma unroll
          for (int i = 0; i < 8; ++i) { o[i] = O[t * 65 + e0 + i]; ss += o[i] * o[i]; }
          ss += __shfl_xor(ss, 1); ss += __shfl_xor(ss, 2); ss += __shfl_xor(ss, 4);
          const float rs = 1.0f / sqrtf(ss * (1.f / 64.f) + LN_EPS);
          const float* ng = p.gla_norm_g + l * 384 + h * 64 + e0; const u32x4 gr = cur.gr;
          float r[8];
#pragma unroll
          for (int i = 0; i < 4; ++i) { const float ga = bf2f(gr[i] & 0xffffu), gb = __uint_as_float(gr[i] & 0xffff0000u);
              r[2 * i] = o[2 * i] * rs * ng[2 * i] * (ga * sigmoidf_(ga)); r[2 * i + 1] = o[2 * i + 1] * rs * ng[2 * i + 1] * (gb * sigmoidf_(gb)); }
          u32x4 w; w.x = pk2(r[0], r[1]); w.y = pk2(r[2], r[3]); w.z = pk2(r[4], r[5]); w.w = pk2(r[6], r[7]);
          *(u32x4*)(MIX + (tok0 + t) * D + MC_B + h * 64 + e0) = w; }
        cur = nxt;
    }
}

constexpr int LDSQ_OFF = LDS_BYTES - 1024;
constexpr int CW_ATTNQ = 8192;
__device__ __forceinline__ void phase_fox_mfma(const Params& p, int l, unsigned char* lds) {
    const attn_body::bf16* H = (const attn_body::bf16*)(p.ws + WS_H);
    const attn_body::AttnTensors AT{H + HC_CQ, H + HC_CK, H + HC_CV, (attn_body::bf16*)(p.ws + WS_MIX) + MC_C, (const float*)(p.ws + WS_CK), (const float*)(p.ws + WS_FKT), (const float*)(p.ws + WS_FQB)};
    const attn_body::QueueOrder S{(unsigned*)(p.ws + WS_CTL) + CW_ATTNQ + l * 64, (volatile __attribute__((address_space(3))) int*)((__attribute__((address_space(3))) unsigned char*)lds + LDSQ_OFF)};
    attn_body::attn_phase<attn_body::QueueOrder>((char*)lds, AT, S);
}

__device__ __forceinline__ void phase_ln(const _Float16* Y, const float* g, const float* bta, float* dst, bf16* dstb, unsigned char* xq = nullptr, float* xs = nullptr) {
    const int tid = tid_l(), lane = tid & 63, wave = tid >> 6; typedef _Float16 h4 __attribute__((ext_vector_type(4)));
    const int stride = grid_l() * 8; int row = bid_l() * 8 + wave;
    if (row >= T) return;
    h4 cur[4];
#pragma unroll
    for (int j = 0; j < 4; ++j) cur[j] = *(const h4*)(Y + (size_t)row * D + j * 256 + lane * 4);
#pragma unroll 1
    for (; row < T; row += stride) {
        h4 nxt[4]; const int nr = row + stride < T ? row + stride : row;
#pragma unroll
        for (int j = 0; j < 4; ++j) nxt[j] = *(const h4*)(Y + (size_t)nr * D + j * 256 + lane * 4);
        __builtin_amdgcn_sched_barrier(0);
        f32x4 v[4]; float s = 0.f;
#pragma unroll
        for (int j = 0; j < 4; ++j) { v[j] = (f32x4){(float)cur[j][0], (float)cur[j][1], (float)cur[j][2], (float)cur[j][3]}; s += (v[j][0] + v[j][1]) + (v[j][2] + v[j][3]); }
        const float mean = wave_sum(s) * (1.f / D); float s2 = 0.f;
#pragma unroll
        for (int j = 0; j < 4; ++j) { v[j] = v[j] - mean; s2 += (v[j][0] * v[j][0] + v[j][1] * v[j][1]) + (v[j][2] * v[j][2] + v[j][3] * v[j][3]); }
        const float rstd = 1.0f / sqrtf(wave_sum(s2) * (1.f / D) + LN_EPS);
        float am = 0.f;
#pragma unroll
        for (int j = 0; j < 4; ++j) { const f32x4 g4 = *(const f32x4*)(g + j * 256 + lane * 4), b4 = *(const f32x4*)(bta + j * 256 + lane * 4);
            const f32x4 o = v[j] * rstd * g4 + b4; v[j] = o;
            am = fmaxf(am, fmaxf(fmaxf(fabsf(o[0]), fabsf(o[1])), fmaxf(fabsf(o[2]), fabsf(o[3]))));
            if (dst) *(f32x4*)(dst + (size_t)row * D + j * 256 + lane * 4) = o;
            if (dstb) { u32x2 w; w.x = pk2(o[0], o[1]); w.y = pk2(o[2], o[3]); *(u32x2*)(dstb + (size_t)row * D + j * 256 + lane * 4) = w; } }
        if (xq) {
            am = wave_max(am); const float sc = am > 0.f ? 127.0f / am : 0.f;
#pragma unroll
            for (int j = 0; j < 4; ++j) *(unsigned*)(xq + (size_t)row * D + j * 256 + lane * 4) = pk_i8x4(v[j], sc);
            if (lane == 0) xs[row] = am * (1.0f / 127.0f); }
#pragma unroll
        for (int j = 0; j < 4; ++j) cur[j] = nxt[j];
    }
}

__device__ __forceinline__ int f2ord(float x) { const int i = __float_as_int(x); return i ^ ((i >> 31) & 0x7fffffff); }
__device__ __forceinline__ float ord2f(int k) { return __int_as_float(k ^ ((k >> 31) & 0x7fffffff)); }
__device__ __forceinline__ void phase_topk(const Params& p, unsigned char* lds) {
    const int tid = tid_l(), lane = tid & 63, wave = tid >> 6;
    unsigned char* wreg = lds + wave * 17408; unsigned char* tab = wreg;
    const _Float16* SC = (const _Float16*)(p.ws + WS_SC); int* EIDX = (int*)(p.ws + WS_EIDX); float* GATE = (float*)(p.ws + WS_GATE); unsigned long long* SOFF = (unsigned long long*)(p.ws + WS_SOFF);
    for (int g = bid_l() * 512 + tid; g < T * 16; g += grid_l() * 512) {
        const int tok = g >> 4, hc = g & 15;
        typedef _Float16 h8 __attribute__((ext_vector_type(8)));
        { const unsigned char* blk = (const unsigned char*)(SC + (size_t)(g - lane) * 128);
          u32x4 st[16];
#pragma unroll
          for (int j = 0; j < 16; ++j) st[j] = *(const u32x4*)(blk + (size_t)(j * 64 + lane) * 16);
          __builtin_amdgcn_wave_barrier();
#pragma unroll
          for (int j = 0; j < 16; ++j) { const int c = j * 64 + lane; *(u32x4*)(wreg + (c + (c >> 4)) * 16) = st[j]; }
          __builtin_amdgcn_wave_barrier(); }
        const unsigned char* lp = wreg + lane * 272;
#define TK_CE(a, b) do { const int hi_ = max(a, b), lo_ = min(a, b); a = hi_; b = lo_; } while (0)
        int tk[16];
#pragma unroll 1
        for (int gi = 0; gi < 8; ++gi) { const h8 cA = *(const h8*)(lp + gi * 32), c1_ = *(const h8*)(lp + gi * 32 + 16);
            int v[16];
#pragma unroll
            for (int j = 0; j < 8; ++j) { v[j] = (f2ord((float)cA[j]) & ~127) | (127 - (gi * 16 + j)); v[8 + j] = (f2ord((float)c1_[j]) & ~127) | (127 - (gi * 16 + 8 + j)); }
            TK_CE(v[0], v[1]); TK_CE(v[3], v[2]); TK_CE(v[4], v[5]); TK_CE(v[7], v[6]); TK_CE(v[8], v[9]); TK_CE(v[11], v[10]); TK_CE(v[12], v[13]); TK_CE(v[15], v[14]); TK_CE(v[0], v[2]); TK_CE(v[1], v[3]); TK_CE(v[6], v[4]); TK_CE(v[7], v[5]); TK_CE(v[8], v[10]); TK_CE(v[9], v[11]); TK_CE(v[14], v[12]); TK_CE(v[15], v[13]); TK_CE(v[0], v[1]); TK_CE(v[2], v[3]); TK_CE(v[5], v[4]); TK_CE(v[7], v[6]); TK_CE(v[8], v[9]); TK_CE(v[10], v[11]); TK_CE(v[13], v[12]); TK_CE(v[15], v[14]); TK_CE(v[0], v[4]); TK_CE(v[1], v[5]); TK_CE(v[2], v[6]); TK_CE(v[3], v[7]); TK_CE(v[12], v[8]); TK_CE(v[13], v[9]); TK_CE(v[14], v[10]); TK_CE(v[15], v[11]); TK_CE(v[0], v[2]); TK_CE(v[1], v[3]); TK_CE(v[4], v[6]); TK_CE(v[5], v[7]); TK_CE(v[10], v[8]); TK_CE(v[11], v[9]); TK_CE(v[14], v[12]); TK_CE(v[15], v[13]); TK_CE(v[0], v[1]); TK_CE(v[2], v[3]); TK_CE(v[4], v[5]); TK_CE(v[6], v[7]); TK_CE(v[9], v[8]); TK_CE(v[11], v[10]); TK_CE(v[13], v[12]); TK_CE(v[15], v[14]); TK_CE(v[0], v[8]); TK_CE(v[1], v[9]); TK_CE(v[2], v[10]); TK_CE(v[3], v[11]); TK_CE(v[4], v[12]); TK_CE(v[5], v[13]); TK_CE(v[6], v[14]); TK_CE(v[7], v[15]); TK_CE(v[0], v[4]); TK_CE(v[1], v[5]); TK_CE(v[2], v[6]); TK_CE(v[3], v[7]); TK_CE(v[8], v[12]); TK_CE(v[9], v[13]); TK_CE(v[10], v[14]); TK_CE(v[11], v[15]); TK_CE(v[0], v[2]); TK_CE(v[1], v[3]); TK_CE(v[4], v[6]); TK_CE(v[5], v[7]); TK_CE(v[8], v[10]); TK_CE(v[9], v[11]); TK_CE(v[12], v[14]); TK_CE(v[13], v[15]); TK_CE(v[0], v[1]); TK_CE(v[2], v[3]); TK_CE(v[4], v[5]); TK_CE(v[6], v[7]); TK_CE(v[8], v[9]); TK_CE(v[10], v[11]); TK_CE(v[12], v[13]); TK_CE(v[14], v[15]);
            if (gi == 0) {
#pragma unroll
                for (int j = 0; j < 16; ++j) tk[j] = v[j]; }
            else {
#pragma unroll
                for (int j = 0; j < 16; ++j) tk[j] = max(tk[j], v[15 - j]);
                TK_CE(tk[0], tk[8]); TK_CE(tk[1], tk[9]); TK_CE(tk[2], tk[10]); TK_CE(tk[3], tk[11]); TK_CE(tk[4], tk[12]); TK_CE(tk[5], tk[13]); TK_CE(tk[6], tk[14]); TK_CE(tk[7], tk[15]); TK_CE(tk[0], tk[4]); TK_CE(tk[1], tk[5]); TK_CE(tk[2], tk[6]); TK_CE(tk[3], tk[7]); TK_CE(tk[8], tk[12]); TK_CE(tk[9], tk[13]); TK_CE(tk[10], tk[14]); TK_CE(tk[11], tk[15]); TK_CE(tk[0], tk[2]); TK_CE(tk[1], tk[3]); TK_CE(tk[4], tk[6]); TK_CE(tk[5], tk[7]); TK_CE(tk[8], tk[10]); TK_CE(tk[9], tk[11]); TK_CE(tk[12], tk[14]); TK_CE(tk[13], tk[15]); TK_CE(tk[0], tk[1]); TK_CE(tk[2], tk[3]); TK_CE(tk[4], tk[5]); TK_CE(tk[6], tk[7]); TK_CE(tk[8], tk[9]); TK_CE(tk[10], tk[11]); TK_CE(tk[12], tk[13]); TK_CE(tk[14], tk[15]); }
            }
        __builtin_amdgcn_wave_barrier();
#undef TK_CE
        float av[16], bv[16]; int ai[16], bi[16]; const bool c1 = (hc & 1) != 0;
#pragma unroll
        for (int j = 0; j < 16; ++j) { const int ok = __shfl_xor(tk[j], 1); const int ka = c1 ? ok : tk[j], kb = c1 ? tk[j] : ok;
            av[j] = ord2f(ka & ~127); ai[j] = 127 - (ka & 127); bv[j] = ord2f(kb & ~127); bi[j] = 127 - (kb & 127); }
#pragma unroll
        for (int j = 0; j < 16; ++j) { tab[j * 64 + lane] = (unsigned char)ai[j]; tab[(16 + j) * 64 + lane] = (unsigned char)bi[j]; }
        int ck[16];
#pragma unroll
        for (int j = 0; j < 16; ++j) ck[j] = (int)0x80000000;
#pragma unroll
        for (int i = 0; i < 16; ++i)
#pragma unroll
            for (int j = 0; j < 16 / (i + 1); ++j) { int x = (f2ord(av[i] + bv[j]) & ~255) | (255 - (i * 16 + j));
#pragma unroll
                for (int q = 0; q < 16; ++q) { const int hi = max(ck[q], x); x = min(ck[q], x); ck[q] = hi; } }
        float den = 0.f; float ex[16]; const float c0 = ord2f(ck[0] & ~255);
#pragma unroll
        for (int j = 0; j < 16; ++j) { ex[j] = __expf(ord2f(ck[j] & ~255) - c0); den += ex[j]; }
        const float inv = 1.0f / den;
        int eid[16]; unsigned long long cnt = 0ull;
#pragma unroll
        for (int j = 0; j < 16; ++j) { const int flat = 255 - (ck[j] & 255); eid[j] = (int)tab[(flat >> 4) * 64 + lane] * 128 + (int)tab[(16 + (flat & 15)) * 64 + lane];
            if (!c1) cnt += 1ull << (8 * (eid[j] >> 11)); }
        unsigned long long incl = cnt;
#pragma unroll
        for (int o = 1; o < 16; o <<= 1) { const unsigned lo = __shfl_up((unsigned)incl, o, 16), hi = __shfl_up((unsigned)(incl >> 32), o, 16); if ((hc & 15) >= o) incl += ((unsigned long long)hi << 32) | lo; }
        const unsigned long long total = ((unsigned long long)__shfl((unsigned)(incl >> 32), 15, 16) << 32) | __shfl((unsigned)incl, 15, 16);
        const unsigned long long base = total * 0x0101010101010100ull;
        unsigned long long run = base + (incl - cnt);
        if (hc == 0) SOFF[tok] = base;
        if (!c1) {
#pragma unroll
            for (int j = 0; j < 16; ++j) { const int sh = 8 * (eid[j] >> 11); const int pos = (int)((run >> sh) & 0xffull); run += 1ull << sh;
                EIDX[(size_t)tok * 128 + pos] = eid[j]; GATE[(size_t)tok * 128 + pos] = ex[j] * inv; } }
    }
}

__device__ __forceinline__ float gelu_tanh(float h) { const float z = 0.7978845608028654f * (h + 0.044715f * h * h * h); const float t = 1.0f - 2.0f / (__expf(2.0f * z) + 1.0f); return 0.5f * h * (1.0f + t); }
#define LAS3 __attribute__((address_space(3)))
struct PeerTok { u32x4 xq; float xs; unsigned long long so; int e_lo, e_hi; float g_lo, g_hi; };
__device__ __forceinline__ PeerTok peer_tok_load(const unsigned char* XQ, const float* XS, const int* EIDX, const float* GATE, const unsigned long long* SOFF, int tok, int lane) {
    PeerTok t; const int tk = tok < T ? tok : T - 1;
    t.xq = __builtin_nontemporal_load((const u32x4*)(XQ + (size_t)tk * D + lane * 16)); t.xs = XS[tk];
    t.so = SOFF[tk]; t.e_lo = EIDX[(size_t)tk * 128 + lane]; t.e_hi = EIDX[(size_t)tk * 128 + 64 + lane]; t.g_lo = GATE[(size_t)tk * 128 + lane]; t.g_hi = GATE[(size_t)tk * 128 + 64 + lane];
    return t;
}
__device__ __forceinline__ void peer_slot_write(LAS3 unsigned char* sl, const PeerTok& t, int lane) {
    *(LAS3 u32x4*)(sl + lane * 16) = t.xq; *(LAS3 int*)(sl + 1024 + lane * 4) = t.e_lo; *(LAS3 int*)(sl + 1280 + lane * 4) = t.e_hi;
    *(LAS3 float*)(sl + 1536 + lane * 4) = t.g_lo; *(LAS3 float*)(sl + 1792 + lane * 4) = t.g_hi;
}
template <int CTRL> __device__ __forceinline__ float dpp_mov(float v) { return __int_as_float(__builtin_amdgcn_update_dpp(0, __float_as_int(v), CTRL, 0xf, 0xf, false)); }
template <int CTRL> __device__ __forceinline__ int dpp_movi(int v) { return __builtin_amdgcn_update_dpp(0, v, CTRL, 0xf, 0xf, false); }
__device__ __forceinline__ float gelu_tanh_fast(float h) { const float z = 0.7978845608028654f * (h + 0.044715f * h * h * h); const float t = 1.0f - 2.0f * __builtin_amdgcn_rcpf(__expf(2.0f * z) + 1.0f); return 0.5f * h * (1.0f + t); }
#define PEER_ISSUE(R, sl_, ks_, kl_) do { const int kA_ = min((ks_) + g4, (kl_)), kB_ = min((ks_) + 4 + g4, (kl_)); \
    const int eA_ = *(const LAS3 int*)((sl_) + 1024 + kA_ * 4), eB_ = *(const LAS3 int*)((sl_) + 1024 + kB_ * 4); \
    const unsigned char* pA_ = U8l + (size_t)eA_ * D; const unsigned char* pB_ = U8l + (size_t)eB_ * D; \
    _Pragma("unroll") for (int i_ = 0; i_ < 4; ++i_) { R[i_] = *(const u32x4*)(pA_ + 256 * i_); R[4 + i_] = *(const u32x4*)(pB_ + 256 * i_); } } while (0)
#define PEER_COMPUTE(RC) do { int aA_ = 0, aB_ = 0; \
    _Pragma("unroll") for (int i_ = 0; i_ < 4; ++i_) _Pragma("unroll") for (int w_ = 0; w_ < 4; ++w_) aA_ = __builtin_amdgcn_sdot4((int)RC[i_][w_], (int)xp[i_][w_], aA_, false); \
    if (k0 + 4 < end) { _Pragma("unroll") for (int i_ = 0; i_ < 4; ++i_) _Pragma("unroll") for (int w_ = 0; w_ < 4; ++w_) aB_ = __builtin_amdgcn_sdot4((int)RC[4 + i_][w_], (int)xp[i_][w_], aB_, false); } \
    else { asm volatile("" :: "v"(RC[4]), "v"(RC[5]), "v"(RC[6]), "v"(RC[7])); }     \
    aA_ += dpp_movi<0x128>(aA_); aB_ += dpp_movi<0x128>(aB_); aA_ += dpp_movi<0x124>(aA_); aB_ += dpp_movi<0x124>(aB_); \
    aA_ += dpp_movi<0x122>(aA_); aB_ += dpp_movi<0x122>(aB_); aA_ += dpp_movi<0x121>(aA_); aB_ += dpp_movi<0x121>(aB_); \
    { const int rel = (lane - k0) & 63; const int src = (rel & 3) << 6; \
      const int ga = __builtin_amdgcn_ds_bpermute(src, aA_), gb = __builtin_amdgcn_ds_bpermute(src, aB_); \
      const float gq = (float)((rel & 4) ? gb : ga); const int kq = k0 + rel;              \
      c_lo = (rel < 8 && kq < 64) ? gq : c_lo; c_hi = (rel < 8 && kq >= 64) ? gq : c_hi; } } while (0)
#define PEER_KL(st, en) min(max((en) - 1, (st)), 127)
#define PEER_NEXT(RN) do { __builtin_amdgcn_sched_barrier(0); { const bool more_ = k0 + 8 < end; const LAS3 unsigned char* sl_ = wl + ((more_ ? sc : (sc ^ 1)) << 11); \
    const int ks_ = more_ ? k0 + 8 : ns, kl_ = more_ ? PEER_KL(start, end) : PEER_KL(ns, ne); PEER_ISSUE(RN, sl_, ks_, kl_); } __builtin_amdgcn_sched_barrier(0); } while (0)
#define PEER_RANGE(slo, shi, st, en) do { const unsigned lo_ = __builtin_amdgcn_readfirstlane(slo), hi_ = __builtin_amdgcn_readfirstlane(shi); \
    const unsigned long long so_ = ((unsigned long long)hi_ << 32) | lo_; st = (int)((so_ >> (8 * g0)) & 0xffull); en = g1 < 8 ? (int)((so_ >> (8 * g1)) & 0xffull) : 128; } while (0)
#define PEER_CUR() do { const LAS3 unsigned char* cs_ = wl + (sc << 11); \
    _Pragma("unroll") for (int i_ = 0; i_ < 4; ++i_) xp[i_] = *(const LAS3 u32x4*)(cs_ + 256 * i_ + l16 * 16); \
    const int e0_ = *(const LAS3 int*)(cs_ + 1024 + lane * 4), e1_ = *(const LAS3 int*)(cs_ + 1280 + lane * 4); cg_lo = *(const LAS3 float*)(cs_ + 1536 + lane * 4); cg_hi = *(const LAS3 float*)(cs_ + 1792 + lane * 4); \
    rs_lo = RS[e0_]; rs_hi = RS[e1_]; vs_lo = VS[e0_]; vs_hi = VS[e1_]; } while (0)
#define PEER_ADVANCE() do { k0 += 8; if (k0 >= end) { \
        if (tok < T) { \
        if (lane >= start && lane < end) GATE[(size_t)tok * 128 + lane] = cg_lo * gelu_tanh_fast(c_lo * (rs_lo * xs)) * vs_lo; \
        if (lane + 64 >= start && lane + 64 < end) GATE[(size_t)tok * 128 + 64 + lane] = cg_hi * gelu_tanh_fast(c_hi * (rs_hi * xs)) * vs_hi; } \
        tok += stride; peer_slot_write(wl + (sc << 11), n2, lane); sc ^= 1; \
        start = ns; end = ne; PEER_RANGE((unsigned)n2.so, (unsigned)(n2.so >> 32), ns, ne); xs = nxs; nxs = __uint_as_float(__builtin_amdgcn_readfirstlane(__float_as_uint(n2.xs))); k0 = start; c_lo = 0.f; c_hi = 0.f; \
        PEER_CUR(); __builtin_amdgcn_sched_barrier(0); \
        n2 = peer_tok_load(XQ, XS, EIDX, GATE, SOFF, tok + 2 * stride, lane); __builtin_amdgcn_sched_barrier(0); } } while (0)
__device__ __forceinline__ void phase_peer_u(const Params& p, unsigned char* lds) {
    const int tid = tid_l(), lane = tid & 63, wave = tid >> 6, bid = bid_l(), G = grid_l(), l16 = lane & 15, g4 = lane >> 4;
    const unsigned char* XQ = p.ws + WS_XQ; const float* XS = (const float*)(p.ws + WS_XS); const float* RS = (const float*)(p.ws + WS_RS); const float* VS = (const float*)(p.ws + WS_VS); const unsigned char* U8l = p.ws + WS_U + l16 * 16;
    const int* EIDX = (const int*)(p.ws + WS_EIDX); float* GATE = (float*)(p.ws + WS_GATE); const unsigned long long* SOFF = (const unsigned long long*)(p.ws + WS_SOFF);
    const int ngrp = (G % 8 == 0) ? 8 : 1;
    const int g0 = (ngrp == 8) ? (bid & 7) : 0, g1 = (ngrp == 8) ? g0 + 1 : 8, r = (ngrp == 8) ? (bid >> 3) : bid, R = (ngrp == 8) ? (G >> 3) : G;
    const int stride = R * 8; int tok = __builtin_amdgcn_readfirstlane(r * 8 + wave);
    if (tok >= T) return;
    LAS3 unsigned char* wl = (LAS3 unsigned char*)lds + wave * 4096;
    int sc = 0, start, end, ns, ne; float xs, nxs;
    PeerTok n2;
    { const PeerTok t0 = peer_tok_load(XQ, XS, EIDX, GATE, SOFF, tok, lane), t1 = peer_tok_load(XQ, XS, EIDX, GATE, SOFF, tok + stride, lane);
      peer_slot_write(wl, t0, lane); peer_slot_write(wl + 2048, t1, lane);
      PEER_RANGE((unsigned)t0.so, (unsigned)(t0.so >> 32), start, end); PEER_RANGE((unsigned)t1.so, (unsigned)(t1.so >> 32), ns, ne); xs = __uint_as_float(__builtin_amdgcn_readfirstlane(__float_as_uint(t0.xs))); nxs = __uint_as_float(__builtin_amdgcn_readfirstlane(__float_as_uint(t1.xs))); }
    n2 = peer_tok_load(XQ, XS, EIDX, GATE, SOFF, tok + 2 * stride, lane);
    u32x4 xp[4]; float cg_lo, cg_hi, rs_lo, rs_hi, vs_lo, vs_hi;
    PEER_CUR();
    float c_lo = 0.f, c_hi = 0.f;
    int k0 = start;
    u32x4 Ra[8], Rb[8];
    PEER_ISSUE(Ra, wl, start, PEER_KL(start, end));
#pragma unroll 1
    do {
        PEER_NEXT(Rb); PEER_COMPUTE(Ra); PEER_ADVANCE();
        PEER_NEXT(Ra); PEER_COMPUTE(Rb); PEER_ADVANCE();
    } while (tok < T);
}
#undef PEER_ISSUE
#undef PEER_COMPUTE
#undef PEER_NEXT
#undef PEER_KL
#undef PEER_RANGE
#undef PEER_CUR
#undef PEER_ADVANCE
struct PeerVMeta { int e_lo, e_hi; float c_lo, c_hi; u32x4 x0, x1; };
__device__ __forceinline__ PeerVMeta peer_vmeta_load(const int* EIDX, const float* COEF, const bf16* XB, int tok, int lane) {
    PeerVMeta m;
    m.e_lo = EIDX[(size_t)tok * 128 + lane]; m.e_hi = EIDX[(size_t)tok * 128 + 64 + lane]; m.c_lo = COEF[(size_t)tok * 128 + lane]; m.c_hi = COEF[(size_t)tok * 128 + 64 + lane];
    const int xo = (lane & 31) * 32 + (lane >> 5) * 16;
    m.x0 = *(const u32x4*)(XB + (size_t)tok * D + xo); m.x1 = *(const u32x4*)(XB + (size_t)tok * D + xo + 8);
    return m;
}
#define PV_ISSUE(VR, CF, PE, PC, jj) do { _Pragma("unroll") for (int q = 0; q < 8; ++q) { const int a_ = hb + (((jj) + q) << 2); const int e_ = __builtin_amdgcn_ds_bpermute(a_, (int)(PE)); \
        CF[q] = __int_as_float(__builtin_amdgcn_ds_bpermute(a_, (int)(PC))); VR[q] = *(const u32x4*)(V4l + (size_t)e_ * 512); } __builtin_amdgcn_sched_barrier(0); } while (0)
#define PV_COMPUTE(VR, CF) do { _Pragma("unroll") for (int q = 0; q < 8; ++q) { const f32x2v c2 = (f32x2v){CF[q], CF[q]}; \
        _Pragma("unroll") for (int w = 0; w < 4; ++w) { \
            acc[4 * w] += __builtin_amdgcn_cvt_scalef32_pk_f32_fp4(VR[q][w], 1.0f, 0) * c2; acc[4 * w + 1] += __builtin_amdgcn_cvt_scalef32_pk_f32_fp4(VR[q][w], 1.0f, 1) * c2; \
            acc[4 * w + 2] += __builtin_amdgcn_cvt_scalef32_pk_f32_fp4(VR[q][w], 1.0f, 2) * c2; acc[4 * w + 3] += __builtin_amdgcn_cvt_scalef32_pk_f32_fp4(VR[q][w], 1.0f, 3) * c2; } } \
        __builtin_amdgcn_sched_barrier(0); } while (0)
__device__ __forceinline__ void phase_peer_v(const Params& p) {
    const int tid = tid_l(), lane = tid & 63, wave = tid >> 6;
    const unsigned char* V4l = p.ws + WS_V + (lane & 31) * 16;
    const int* EIDX = (const int*)(p.ws + WS_EIDX); const float* COEF = (const float*)(p.ws + WS_GATE);
    bf16* XB = (bf16*)(p.ws + WS_XB);
    const int hb = (lane & 32) << 2;
    const int xo = (lane & 31) * 32 + (lane >> 5) * 16;
    const int stride = grid_l() * 8; int tok = __builtin_amdgcn_readfirstlane(bid_l() * 8 + wave);
    if (tok >= T) return;
    PeerVMeta cur = peer_vmeta_load(EIDX, COEF, XB, tok, lane);
    auto se = __builtin_amdgcn_permlane32_swap((unsigned)cur.e_lo, (unsigned)cur.e_hi, false, false); auto sc_ = __builtin_amdgcn_permlane32_swap(__float_as_uint(cur.c_lo), __float_as_uint(cur.c_hi), false, false);
    u32x4 vrA[8], vrB[8]; float cfA[8], cfB[8];
    PV_ISSUE(vrA, cfA, se[0], sc_[0], 0);
#pragma unroll 1
    for (; tok < T; tok += stride) {
        const PeerVMeta nxt = peer_vmeta_load(EIDX, COEF, XB, tok + stride < T ? tok + stride : tok, lane);
        __builtin_amdgcn_sched_barrier(0);
        f32x2v acc[16];
#pragma unroll
        for (int i = 0; i < 16; ++i) acc[i] = (f32x2v){0.f, 0.f};
        PV_ISSUE(vrB, cfB, se[0], sc_[0], 8);  PV_COMPUTE(vrA, cfA);
        PV_ISSUE(vrA, cfA, se[0], sc_[0], 16); PV_COMPUTE(vrB, cfB);
        PV_ISSUE(vrB, cfB, se[0], sc_[0], 24); PV_COMPUTE(vrA, cfA);
        PV_ISSUE(vrA, cfA, se[1], sc_[1], 0);  PV_COMPUTE(vrB, cfB);
        PV_ISSUE(vrB, cfB, se[1], sc_[1], 8);  PV_COMPUTE(vrA, cfA);
        PV_ISSUE(vrA, cfA, se[1], sc_[1], 16); PV_COMPUTE(vrB, cfB);
        PV_ISSUE(vrB, cfB, se[1], sc_[1], 24); PV_COMPUTE(vrA, cfA);
        se = __builtin_amdgcn_permlane32_swap((unsigned)nxt.e_lo, (unsigned)nxt.e_hi, false, false); sc_ = __builtin_amdgcn_permlane32_swap(__float_as_uint(nxt.c_lo), __float_as_uint(nxt.c_hi), false, false);
        PV_ISSUE(vrA, cfA, se[0], sc_[0], 0);  PV_COMPUTE(vrB, cfB);
        float sres[16];
#pragma unroll
        for (int i = 0; i < 8; ++i)
#pragma unroll
            for (int c = 0; c < 2; ++c) { const auto r_ = __builtin_amdgcn_permlane32_swap(__float_as_uint(acc[i][c]), __float_as_uint(acc[8 + i][c]), false, false);
                sres[2 * i + c] = __uint_as_float(r_[0]) + __uint_as_float(r_[1]); }
        float r[16];
#pragma unroll
        for (int i = 0; i < 4; ++i) { r[2 * i] = ALPHA * bf2f(cur.x0[i] & 0xffffu) + sres[2 * i]; r[2 * i + 1] = ALPHA * __uint_as_float(cur.x0[i] & 0xffff0000u) + sres[2 * i + 1];
                                      r[8 + 2 * i] = ALPHA * bf2f(cur.x1[i] & 0xffffu) + sres[8 + 2 * i]; r[8 + 2 * i + 1] = ALPHA * __uint_as_float(cur.x1[i] & 0xffff0000u) + sres[8 + 2 * i + 1]; }
#pragma unroll
        for (int w = 0; w < 2; ++w) { u32x4 o; o.x = pk2(r[8 * w], r[8 * w + 1]); o.y = pk2(r[8 * w + 2], r[8 * w + 3]); o.z = pk2(r[8 * w + 4], r[8 * w + 5]); o.w = pk2(r[8 * w + 6], r[8 * w + 7]);
            *(u32x4*)(XB + (size_t)tok * D + xo + 8 * w) = o; }
        cur = nxt;
    }
}
#undef PV_ISSUE
#undef PV_COMPUTE
#define GAS __attribute__((address_space(1)))
#define LAS __attribute__((address_space(3)))
#define XB_TMO      128
#define XB_XCNT(j)  (256  + 64 * (j))
#define XB_XSUB(j)  (1280 + 64 * (j))
#define XB_XGEN(j)  (2304 + 64 * (j))
#define XB_TOP      3328
#define XB_TOPGEN   3392
#define XCD_BAR_WORDS 3456
#define XB_SPIN_CAP (1u << 18)

__device__ __forceinline__ unsigned xb_ld(unsigned* p)              { return __hip_atomic_load(p, __ATOMIC_RELAXED, __HIP_MEMORY_SCOPE_AGENT); }
__device__ __forceinline__ unsigned xb_add(unsigned* p, unsigned v) { return __hip_atomic_fetch_add(p, v, __ATOMIC_RELAXED, __HIP_MEMORY_SCOPE_AGENT); }
__device__ __forceinline__ unsigned xb_xcc_id() { return (unsigned)__builtin_amdgcn_s_getreg((3 << 11) | 20) & 0xFu; }
#define XB_SPIN(cond, bar) do { unsigned _sp = 0; while (cond) { __builtin_amdgcn_s_sleep(1); \
    if ((++_sp & 255u) == 0u) { if (xb_ld(&(bar)[XB_TMO])) break; if (_sp > XB_SPIN_CAP) { atomicAdd(&(bar)[XB_TMO], 1u); break; } } } } while (0)

struct XcdBarrier {
    unsigned* bar; unsigned x;
    volatile LAS unsigned* st;
};

__device__ __forceinline__ XcdBarrier xcd_barrier_post(unsigned* bar, volatile LAS unsigned* st) {
    XcdBarrier b; b.bar = bar; b.x = xb_xcc_id(); b.st = st;
    if (threadIdx.x == 0) (void)xb_add(&bar[XB_XCNT(b.x)], 1u);
    return b;
}
__device__ __forceinline__ void xcd_barrier_complete(unsigned* bar, unsigned x, unsigned& nloc, unsigned& nx) {
    const unsigned G = gridDim.x * gridDim.y * gridDim.z;
    unsigned sum, cnt, mine, sp = 0u;
    for (;;) {
        sum = 0u; cnt = 0u; mine = 0u;
#pragma unroll
        for (unsigned j = 0; j < 16; ++j) { const unsigned c = xb_ld(&bar[XB_XCNT(j)]); sum += c; cnt += (c > 0u) ? 1u : 0u; mine = (j == x) ? c : mine; }
        if (sum == G) break;
        __builtin_amdgcn_s_sleep(1);
        if ((++sp & 255u) == 0u) { if (xb_ld(&bar[XB_TMO])) break; if (sp > XB_SPIN_CAP) { atomicAdd(&bar[XB_TMO], 1u); break; } }
    }
    nloc = mine > 0u ? mine : 1u; nx = cnt > 0u ? cnt : 1u;
}

__device__ __forceinline__ void xcd_barrier(const XcdBarrier& b) {
    asm volatile("s_waitcnt vmcnt(0)" ::: "memory");
    __syncthreads();
    if (threadIdx.x == 0) {
        unsigned* bar = b.bar;
        __builtin_amdgcn_s_waitcnt(0);
        unsigned nloc = b.st[0], nx = b.st[1];
        if (nloc == 0u) { xcd_barrier_complete(bar, b.x, nloc, nx); b.st[0] = nloc; b.st[1] = nx; }
        const unsigned old = xb_add(&bar[XB_XSUB(b.x)], 1u);
        const unsigned gen = old / nloc;
        if (old + 1u == (gen + 1u) * nloc) {
            __builtin_amdgcn_fence(__ATOMIC_RELEASE, "agent");
            asm volatile("s_waitcnt vmcnt(0)" ::: "memory");
            const unsigned og = xb_add(&bar[XB_TOP], 1u);
            const unsigned tg = og / nx;
            if (og + 1u == (tg + 1u) * nx) xb_add(&bar[XB_TOPGEN], 1u);
            else XB_SPIN(xb_ld(&bar[XB_TOPGEN]) == tg, bar);
            __builtin_amdgcn_fence(__ATOMIC_ACQUIRE, "agent");
            xb_add(&bar[XB_XGEN(b.x)], 1u);
            asm volatile("s_waitcnt vmcnt(0)" ::: "memory");
        } else {
            XB_SPIN(xb_ld(&bar[XB_XGEN(b.x)]) == gen, bar);
            __builtin_amdgcn_fence(__ATOMIC_ACQUIRE, "agent");
            asm volatile("s_waitcnt vmcnt(0)" ::: "memory");
        }
    }
    __syncthreads();
}
enum { PH_PRO_A, PH_PRO_B, PH_CVT, PH_GEMM_IN, PH_GEMM_E, PH_CONV, PH_FOXCUM, PH_FOXNORM, PH_GLA1, PH_GLA2, PH_GLA3, PH_FOX, PH_GEMM_OUT, PH_LN1, PH_GEMM_SC, PH_TOPK, PH_PEERU, PH_PEERV, PH_GEMM_PLE, PH_LN2, PH_COUNT };

template <int PH> __device__ __forceinline__ void run_phase(const Params& p, int l, unsigned char* lds) {
    if constexpr (PH == PH_PRO_A) phase_pro_a(p, lds);
    else if constexpr (PH == PH_PRO_B) phase_pro_b(p, lds);
    else if constexpr (PH == PH_CVT) phase_cvt(p, l);
    else if constexpr (PH == PH_GEMM_IN) phase_gemm_in(p, l, lds);
    else if constexpr (PH == PH_GEMM_E) phase_gemm_e(p, l, lds);
    else if constexpr (PH == PH_CONV) phase_conv(p, l, lds);
    else if constexpr (PH == PH_FOXCUM) phase_fox_cum(p, l, lds);
    else if constexpr (PH == PH_FOXNORM) phase_fox_norm(p, lds);
    else if constexpr (PH == PH_GLA1) phase_gla_b1(p, l, lds);
    else if constexpr (PH == PH_GLA2) phase_gla_b2(p);
    else if constexpr (PH == PH_GLA3) phase_gla_b3(p, l, lds);
    else if constexpr (PH == PH_FOX) phase_fox_mfma(p, l, lds);
    else if constexpr (PH == PH_GEMM_OUT) phase_gemm_out(p, l, lds);
    else if constexpr (PH == PH_LN1) phase_ln((const _Float16*)(p.ws + WS_Y), p.ln1_g + (size_t)l * D, p.ln1_b + (size_t)l * D, nullptr, (bf16*)(p.ws + WS_XB), p.ws + WS_XQ, (float*)(p.ws + WS_XS));
    else if constexpr (PH == PH_GEMM_SC) phase_gemm_sc(p, l, lds);
    else if constexpr (PH == PH_TOPK) phase_topk(p, lds);
    else if constexpr (PH == PH_PEERU) phase_peer_u(p, lds);
    else if constexpr (PH == PH_PEERV) phase_peer_v(p);
    else if constexpr (PH == PH_GEMM_PLE) phase_gemm_ple(p, l, lds);
    else if constexpr (PH == PH_LN2) phase_ln((const _Float16*)(p.ws + WS_Y), p.ln2_g + (size_t)l * D, p.ln2_b + (size_t)l * D, l == DEPTH - 1 ? p.out : nullptr, l == DEPTH - 1 ? nullptr : (bf16*)(p.ws + WS_XB));
}

constexpr int MISC_OFF = LDS_BYTES - 512;
constexpr int CW_BAR = 4096;
static_assert(MISC_OFF + 128 <= LDS_BYTES && (CW_BAR + XCD_BAR_WORDS) * 4 <= (int)CTL_ZERO_BYTES, "control words");

typedef __attribute__((address_space(4))) const Params CParams;
#define PHASE(PH) do { CParams* q_ = pp; asm volatile("" : "+s"(q_)); Params lp_; __builtin_memcpy(&lp_, q_, sizeof(Params)); run_phase<PH>(lp_, l, lds); } while (0)
__global__ void __launch_bounds__(512, 2) mk_fwd(Params p_unused) {
#if defined(__HIP_DEVICE_COMPILE__)
    extern __shared__ __attribute__((aligned(16))) unsigned char lds[];
    CParams* pp = (CParams*)__builtin_amdgcn_kernarg_segment_ptr();
    unsigned char* ws0; { CParams* q_ = pp; asm volatile("" : "+s"(q_)); ws0 = q_->ws; }
    volatile LAS unsigned* MISC = (volatile LAS unsigned*)((LAS unsigned char*)lds + MISC_OFF);
    if (threadIdx.x < 32) MISC[threadIdx.x] = 0u;
    __syncthreads();
    (void)xcd_barrier_post((unsigned*)(ws0 + WS_CTL) + CW_BAR, MISC + 8);
#define GB() do { CParams* qb_ = pp; asm volatile("" : "+s"(qb_)); XcdBarrier b_; b_.bar = (unsigned*)(qb_->ws + WS_CTL) + CW_BAR; b_.x = xb_xcc_id(); b_.st = MISC + 8; xcd_barrier(b_); } while (0)
    { const int l = 0; PHASE(PH_PRO_A); PHASE(PH_PRO_B); } GB();
    for (int l = 0; l < DEPTH; ++l) {
        PHASE(PH_CVT); PHASE(PH_GEMM_IN); GB();
        PHASE(PH_GEMM_E); PHASE(PH_CONV); PHASE(PH_FOXCUM); PHASE(PH_FOXNORM); PHASE(PH_GLA1); GB();
        PHASE(PH_GLA2); PHASE(PH_FOX); GB();
        PHASE(PH_GLA3); GB();
        PHASE(PH_GEMM_OUT); GB();
        PHASE(PH_LN1); GB();
        PHASE(PH_GEMM_SC); GB();
        PHASE(PH_TOPK); GB();
        PHASE(PH_PEERU); GB();
        PHASE(PH_PEERV); GB();
        PHASE(PH_GEMM_PLE); GB();
        PHASE(PH_LN2); GB();
    }
#undef GB
#endif
}

extern "C" void kernel_launch(void* const* d_in, const int* in_sizes, int n_in, void* d_out, int out_size, void* d_ws, size_t ws_size, hipStream_t stream) {
    static int grid = 0;
    if (grid == 0) {
        if (n_in != 23 || ws_size < WS_END) { fprintf(stderr, "kernel_launch: unexpected n_in %d or ws_size %zu\n", n_in, ws_size); grid = -1; return; }
        int dev = 0, cus = 0, per_cu = 0;
        if (hipGetDevice(&dev) != hipSuccess || hipDeviceGetAttribute(&cus, hipDeviceAttributeMultiprocessorCount, dev) != hipSuccess) { grid = -1; return; }
        if (hipFuncSetAttribute((const void*)mk_fwd, hipFuncAttributeMaxDynamicSharedMemorySize, LDS_BYTES) != hipSuccess) { grid = -1; return; }
        if (hipOccupancyMaxActiveBlocksPerMultiprocessor(&per_cu, (const void*)mk_fwd, 512, LDS_BYTES) != hipSuccess || per_cu < 1) { fprintf(stderr, "kernel_launch: occupancy query says %d\n", per_cu); }
        (void)hipGetLastError();
        grid = cus;
    }
    if (grid < 0) return;
    if (hipMemsetAsync((char*)d_ws + WS_CTL, 0, CTL_ZERO_BYTES, stream) != hipSuccess) return;
    Params p; memset(&p, 0, sizeof(p));
    const float** f = (const float**)&p;
    for (int i = 0; i < 23; ++i) f[i] = (const float*)d_in[i];
    p.out = (float*)d_out; p.ws = (unsigned char*)d_ws;
    hipLaunchKernelGGL(mk_fwd, dim3(grid), dim3(512), LDS_BYTES, stream, p);
}
```

```cpp
#include <hip/hip_runtime.h>
#include <cstdio>
#include <cstdint>
#include <cstring>
#include <cmath>
__device__ __forceinline__ int tid_l() { int t = threadIdx.x; asm volatile("" : "+v"(t)); return t; }
__device__ __forceinline__ int bid_l() { int b = blockIdx.x; asm volatile("" : "+s"(b)); return b; }
__device__ __forceinline__ int grid_l() { int g = gridDim.x; asm volatile("" : "+s"(g)); return g; }
namespace pg8 {
#define PG8_LAS __attribute__((address_space(3)))
typedef unsigned short bf16_t;
typedef short bf16x8 __attribute__((ext_vector_type(8)));
typedef float f32x4 __attribute__((ext_vector_type(4)));
typedef unsigned u32x4 __attribute__((ext_vector_type(4)));
constexpr int BM = 256, BK = 64, HALF = 128, HTB = HALF * BK * 2  , STAGE_BYTES = 8 * HTB, NXCD = 8, WGM = 8;

__host__ __device__ __forceinline__ int lds_byte(int r, int c) { const int st = (r >> 4) * 2 + (c >> 5), rr = r & 15, cc = c & 31, ob = rr * 64 + cc * 2; return st * 1024 + (ob ^ (((ob >> 9) & 1) << 5)); }
__host__ __device__ __forceinline__ void stage_rc(int b, int& R, int& C) { const int st = b / 1024, sb = b % 1024, swz = sb ^ (((sb >> 9) & 1) << 5); R = (st >> 1) * 16 + swz / 64; C = (st & 1) * 32 + (swz % 64) / 2; }
__host__ __device__ __forceinline__ int perm32(int rho) { const int n = rho >> 4, i = rho & 15; return 8 * (i >> 2) + 4 * n + (i & 3); }

struct Unit { int pm, pn; };
struct Gemm { const bf16_t* A; const bf16_t* Bt; int M, N, K; };

struct StaticOrder {
    int nM, nN, nwg, G, c;
    __host__ __device__ void init(int M, int N, int G_, int c_) { nM = M / BM; nN = N / BM; nwg = nM * nN; G = G_; c = c_; }
    __host__ __device__ bool next(int i, Unit& u) const {
        const long L = (long)i * G + c; if (L >= nwg) return false;
        int wgid = (int)L; { const int q = nwg / NXCD, r = nwg % NXCD, xcd = wgid % NXCD, off = wgid / NXCD; wgid = (xcd < r ? xcd * (q + 1) : r * (q + 1) + (xcd - r) * q) + off; }
        const int nig = WGM * nN, gid = wgid / nig, fm = gid * WGM, gsz = (nM - fm) < WGM ? (nM - fm) : WGM;
        u.pm = fm + ((wgid % nig) % gsz); u.pn = (wgid % nig) / gsz; return true;
    }
    __device__ __forceinline__ void a_ready(const Unit&) const {}
    __device__ __forceinline__ void done(const Unit&) const {}
};

__device__ __forceinline__ unsigned cvt_pk_bf16(float lo, float hi) { unsigned r; asm volatile("v_cvt_pk_bf16_f32 %0, %1, %2" : "=v"(r) : "v"(lo), "v"(hi)); return r; }
typedef float f32x2 __attribute__((ext_vector_type(2)));
__device__ __forceinline__ f32x2 gelu_pk(f32x2 v) {
    const f32x2 av = __builtin_elementwise_abs(v), d = av * 0.2316418882f + 1.0f;
    f32x2 t; t.x = __builtin_amdgcn_rcpf(d.x); t.y = __builtin_amdgcn_rcpf(d.y);
    f32x2 q = t * 0.5307027145f + (-0.7265760135f); q = q * t + 0.7107068705f; q = q * t + (-0.142248368f); q = q * t + 0.127414796f; q = q * t;
    const f32x2 s = (v * v) * (-0.72134752044f);
    f32x2 e; e.x = __builtin_amdgcn_exp2f(s.x); e.y = __builtin_amdgcn_exp2f(s.y);
    const f32x2 m = v * (q * e), r = v - m;
    f32x2 o; o.x = v.x < 0.f ? m.x : r.x; o.y = v.y < 0.f ? m.y : r.y; return o;
}

template <int ACT  > struct EpiBf16 {
    static constexpr bool PERM = true, AFTER_DRAIN = false; static_assert(ACT == 0 || ACT == 1, "EpiBf16: ACT is 0 (none) or 1 (gelu_pk)");
    bf16_t* O; int ldc; const float* bias; int split_cols; size_t split_stride; float scale0;
    __device__ __forceinline__ void operator()(const f32x4 (&acc)[2][2][4][2], const Unit& u, int wr, int wc, int fr, int fq) const {
        const int row0 = u.pm * BM + wr * 64 + fr; int colt = u.pn * BM; bf16_t* base = O;
        float sc = 1.f; if (split_cols) { const int t = colt / split_cols; base += (size_t)t * split_stride; colt -= t * split_cols; if (t == 0) sc = scale0; }
        const int col0 = colt + wc * 32 + 8 * fq, bcol0 = u.pn * BM + wc * 32 + 8 * fq;
        f32x4 bv[2][2];
#pragma unroll
        for (int bj = 0; bj < 2; ++bj)
#pragma unroll
            for (int n = 0; n < 2; ++n) bv[bj][n] = bias ? *(const f32x4*)(bias + bcol0 + bj * HALF + 4 * n) : (f32x4){0.f, 0.f, 0.f, 0.f};
#pragma unroll
        for (int ai = 0; ai < 2; ++ai)
#pragma unroll
            for (int m = 0; m < 4; ++m) { bf16_t* rowp = base + (size_t)(row0 + ai * HALF + m * 16) * ldc + col0;
#pragma unroll
                for (int bj = 0; bj < 2; ++bj) { f32x4 v0 = acc[ai][bj][m][0] + bv[bj][0], v1 = acc[ai][bj][m][1] + bv[bj][1];
                    if (ACT == 1) { f32x2 a = gelu_pk((f32x2){v0[0], v0[1]}), b = gelu_pk((f32x2){v0[2], v0[3]}), c = gelu_pk((f32x2){v1[0], v1[1]}), d = gelu_pk((f32x2){v1[2], v1[3]});
                        v0 = (f32x4){a.x, a.y, b.x, b.y}; v1 = (f32x4){c.x, c.y, d.x, d.y}; }
                    v0 = v0 * sc; v1 = v1 * sc; u32x4 w; w.x = cvt_pk_bf16(v0[0], v0[1]); w.y = cvt_pk_bf16(v0[2], v0[3]); w.z = cvt_pk_bf16(v1[0], v1[1]); w.w = cvt_pk_bf16(v1[2], v1[3]);
                    *(u32x4*)(rowp + bj * HALF) = w; } }
    }
};
struct EpiF16 {
    static constexpr bool PERM = true, AFTER_DRAIN = false;
    _Float16* O; int ldc;
    __device__ __forceinline__ void operator()(const f32x4 (&acc)[2][2][4][2], const Unit& u, int wr, int wc, int fr, int fq) const {
        typedef _Float16 h8 __attribute__((ext_vector_type(8)));
        const int row0 = u.pm * BM + wr * 64 + fr, col0 = u.pn * BM + wc * 32 + 8 * fq;
#pragma unroll
        for (int ai = 0; ai < 2; ++ai)
#pragma unroll
            for (int m = 0; m < 4; ++m) { _Float16* rowp = O + (size_t)(row0 + ai * HALF + m * 16) * ldc + col0;
#pragma unroll
                for (int bj = 0; bj < 2; ++bj) { const f32x4 a = acc[ai][bj][m][0], b = acc[ai][bj][m][1];
                    h8 o; o[0] = (_Float16)a[0]; o[1] = (_Float16)a[1]; o[2] = (_Float16)a[2]; o[3] = (_Float16)a[3]; o[4] = (_Float16)b[0]; o[5] = (_Float16)b[1]; o[6] = (_Float16)b[2]; o[7] = (_Float16)b[3];
                    *(h8*)(rowp + bj * HALF) = o; } }
    }
};
struct EpiResid {
    static constexpr bool PERM = true, AFTER_DRAIN = false;
    const bf16_t* res; _Float16* Y; int ldc; float alpha;
    __device__ __forceinline__ void operator()(const f32x4 (&acc)[2][2][4][2], const Unit& u, int wr, int wc, int fr, int fq) const {
        const int row0 = u.pm * BM + wr * 64 + fr, col0 = u.pn * BM + wc * 32 + 8 * fq;
#pragma unroll
        for (int ai = 0; ai < 2; ++ai)
#pragma unroll
            for (int m = 0; m < 4; ++m) { const size_t off = (size_t)(row0 + ai * HALF + m * 16) * ldc + col0;
#pragma unroll
                for (int bj = 0; bj < 2; ++bj) { const u32x4 rv = *(const u32x4*)(res + off + bj * HALF);
                    f32x4 r0, r1; r0[0] = __uint_as_float(rv.x << 16); r0[1] = __uint_as_float(rv.x & 0xffff0000u); r0[2] = __uint_as_float(rv.y << 16); r0[3] = __uint_as_float(rv.y & 0xffff0000u);
                    r1[0] = __uint_as_float(rv.z << 16); r1[1] = __uint_as_float(rv.z & 0xffff0000u); r1[2] = __uint_as_float(rv.w << 16); r1[3] = __uint_as_float(rv.w & 0xffff0000u);
                    const f32x4 y0 = r0 * alpha + acc[ai][bj][m][0], y1 = r1 * alpha + acc[ai][bj][m][1];
                    typedef _Float16 h8 __attribute__((ext_vector_type(8))); h8 w; w[0] = (_Float16)y0[0]; w[1] = (_Float16)y0[1]; w[2] = (_Float16)y0[2]; w[3] = (_Float16)y0[3]; w[4] = (_Float16)y1[0]; w[5] = (_Float16)y1[1]; w[6] = (_Float16)y1[2]; w[7] = (_Float16)y1[3];
                    *(h8*)(Y + off + bj * HALF) = w; } }
    }
};
struct EpiPle {
    static constexpr bool PERM = true, AFTER_DRAIN = false;
    const bf16_t* R; _Float16* Y; const bf16_t* E; const float* gb; int ldc;
    __device__ __forceinline__ void operator()(const f32x4 (&acc)[2][2][4][2], const Unit& u, int wr, int wc, int fr, int fq) const {
        const int row0 = u.pm * BM + wr * 64 + fr, col0 = u.pn * BM + wc * 32 + 8 * fq;
        f32x4 bv[2][2];
#pragma unroll
        for (int bj = 0; bj < 2; ++bj)
#pragma unroll
            for (int n = 0; n < 2; ++n) bv[bj][n] = *(const f32x4*)(gb + col0 + bj * HALF + 4 * n);
#pragma unroll
        for (int ai = 0; ai < 2; ++ai)
#pragma unroll
            for (int m = 0; m < 4; ++m) { const size_t off = (size_t)(row0 + ai * HALF + m * 16) * ldc + col0;
#pragma unroll
                for (int bj = 0; bj < 2; ++bj) {
                    const u32x4 ev = *(const u32x4*)(E + off + bj * HALF), rv = *(const u32x4*)(R + off + bj * HALF);
                    float o[8];
#pragma unroll
                    for (int n = 0; n < 2; ++n) {
                        const f32x4 z = acc[ai][bj][m][n] + bv[bj][n];
                        const unsigned e0 = n == 0 ? ev.x : ev.z, e1 = n == 0 ? ev.y : ev.w, r0 = n == 0 ? rv.x : rv.z, r1 = n == 0 ? rv.y : rv.w;
                        f32x4 ee, rr; ee[0] = __uint_as_float(e0 << 16); ee[1] = __uint_as_float(e0 & 0xffff0000u); ee[2] = __uint_as_float(e1 << 16); ee[3] = __uint_as_float(e1 & 0xffff0000u);
                        rr[0] = __uint_as_float(r0 << 16); rr[1] = __uint_as_float(r0 & 0xffff0000u); rr[2] = __uint_as_float(r1 << 16); rr[3] = __uint_as_float(r1 & 0xffff0000u);
#pragma unroll
                        for (int i = 0; i < 4; ++i) o[4 * n + i] = rr[i] + ee[i] * __builtin_amdgcn_rcpf(1.0f + __expf(-z[i])); }
                    typedef _Float16 h8 __attribute__((ext_vector_type(8))); h8 w;
#pragma unroll
                    for (int i = 0; i < 8; ++i) w[i] = (_Float16)o[i];
                    *(h8*)(Y + off + bj * HALF) = w; } }
    }
};
template <class Epi, class Sched, bool ALIGN_EPI = false, bool SP2 = false>
__device__ __forceinline__ void gemm_phase(PG8_LAS unsigned char* lds, const Gemm g, const Sched& S, const Epi& E) {
    const int tid = tid_l(), wid = __builtin_amdgcn_readfirstlane(tid >> 6), lane = tid & 63, wr = wid >> 2, wc = wid & 3, fr = lane & 15, fq = lane >> 4;
    const int K = g.K, nt = K / BK;
    unsigned voffA[2], voffB[2];
#pragma unroll
    for (int i = 0; i < 2; ++i) { int R, C; stage_rc(tid * 16 + i * 8192, R, C); const int Rb = Epi::PERM ? ((R & ~31) + perm32(R & 31)) : R;
        voffA[i] = (unsigned)(R * K + C) * 2u; voffB[i] = (unsigned)(Rb * K + C) * 2u; }
    const size_t kstep = (size_t)(BK * 2);
    const size_t hstep = (size_t)HALF * K * 2;
    const size_t tstep = 2 * hstep;
    const unsigned ldsw = (unsigned)wid * 1024u;
    const int aoff = lds_byte(wr * 64 + fr, fq * 8), boff = lds_byte(wc * 32 + fr, fq * 8);
#define PG8_SA(b, h) (((b) * 2 + (h)) * HTB)
#define PG8_SB(b, h) ((4 + (b) * 2 + (h)) * HTB)
#define PG8_STAGE(bufoff, gbase, voff) do { _Pragma("unroll") for (int _i = 0; _i < 2; ++_i) \
        __builtin_amdgcn_global_load_lds((const unsigned*)((const char*)(gbase) + (voff)[_i]), (PG8_LAS unsigned*)(lds + (bufoff) + ldsw + _i * 8192), 16, 0, 0); } while (0)
#define PG8_LDA(dst, b, h) do { _Pragma("unroll") for (int m = 0; m < 4; ++m) _Pragma("unroll") for (int k = 0; k < 2; ++k) dst[m][k] = *(const PG8_LAS bf16x8*)(lds + PG8_SA(b, h) + aoff + m * 2048 + k * 1024); } while (0)
#define PG8_LDB(dst, b, h) do { _Pragma("unroll") for (int n = 0; n < 2; ++n) _Pragma("unroll") for (int k = 0; k < 2; ++k) dst[n][k] = *(const PG8_LAS bf16x8*)(lds + PG8_SB(b, h) + boff + n * 2048 + k * 1024); } while (0)
#define PG8_MMA(ai, bj, At, Bt) do { __builtin_amdgcn_s_setprio(1); _Pragma("unroll") for (int m = 0; m < 4; ++m) _Pragma("unroll") for (int n = 0; n < 2; ++n) _Pragma("unroll") for (int k = 0; k < 2; ++k) \
        acc[ai][bj][m][n] = __builtin_amdgcn_mfma_f32_16x16x32_bf16(Bt[n][k], At[m][k], acc[ai][bj][m][n], 0, 0, 0); __builtin_amdgcn_s_setprio(0); } while (0)
#define PG8_WAIT_V(n) asm volatile("s_waitcnt vmcnt(" #n ")" ::: "memory")
#define PG8_WAIT_L(n) asm volatile("s_waitcnt lgkmcnt(" #n ")" ::: "memory")
#define PG8_BAR __builtin_amdgcn_s_barrier()
#define PG8_SCHED __builtin_amdgcn_sched_barrier(0)
    Unit cur, nxt; int ui = 0;
    if (!S.next(0, cur)) return;
    f32x4 acc[2][2][4][2];
#pragma unroll
    for (int a = 0; a < 2; ++a)
#pragma unroll
        for (int b = 0; b < 2; ++b)
#pragma unroll
            for (int m = 0; m < 4; ++m)
#pragma unroll
                for (int n = 0; n < 2; ++n) acc[a][b][m][n] = (f32x4){0.f, 0.f, 0.f, 0.f};
    bf16x8 At[4][2], B0[2][2], B1[2][2];
    const char* cA = (const char*)g.A + (size_t)cur.pm * tstep; const char* cB = (const char*)g.Bt + (size_t)cur.pn * tstep;
    S.a_ready(cur);
    if constexpr (SP2) {
        PG8_STAGE(PG8_SB(0, 0), cB, voffB); PG8_STAGE(PG8_SB(0, 1), cB + hstep, voffB); PG8_STAGE(PG8_SA(0, 0), cA, voffA); PG8_STAGE(PG8_SA(0, 1), cA + hstep, voffA);
        if (wr == 1) PG8_BAR;
        PG8_WAIT_V(2); PG8_BAR;
        PG8_STAGE(PG8_SB(1, 0), cB + kstep, voffB); PG8_STAGE(PG8_SA(1, 0), cA + kstep, voffA); PG8_STAGE(PG8_SB(1, 1), cB + hstep + kstep, voffB);
        PG8_WAIT_V(6); PG8_BAR;
    } else {
        PG8_STAGE(PG8_SB(0, 0), cB, voffB); PG8_STAGE(PG8_SA(0, 0), cA, voffA); PG8_STAGE(PG8_SB(0, 1), cB + hstep, voffB); PG8_STAGE(PG8_SA(0, 1), cA + hstep, voffA);
        if (wr == 1) PG8_BAR;
        PG8_WAIT_V(4); PG8_BAR;
        PG8_STAGE(PG8_SB(1, 0), cB + kstep, voffB); PG8_STAGE(PG8_SA(1, 0), cA + kstep, voffA); PG8_STAGE(PG8_SB(1, 1), cB + hstep + kstep, voffB);
        PG8_WAIT_V(6); PG8_BAR;
    }
    for (;;) {
        const bool has_next = S.next(ui + 1, nxt);
        const char* nA = has_next ? (const char*)g.A + (size_t)nxt.pm * tstep : cA; const char* nB = has_next ? (const char*)g.Bt + (size_t)nxt.pn * tstep : cB;
        for (int t = 0; t < nt; t += 2) {
            const bool last = (t == nt - 2);
            const char* a1 = cA + (size_t)(t + 1) * kstep;
            const char* a2 = last ? nA : cA + (size_t)(t + 2) * kstep; const char* b2 = last ? nB : cB + (size_t)(t + 2) * kstep;
            const char* a3 = a2 + kstep; const char* b3 = b2 + kstep;
            if (last && has_next) S.a_ready(nxt);
            if constexpr (SP2) {
            PG8_LDB(B0, 0, 0); PG8_LDB(B1, 0, 1); PG8_SCHED; PG8_LDA(At, 0, 0); PG8_STAGE(PG8_SA(1, 1), a1 + hstep, voffA);
            PG8_WAIT_V(8); PG8_WAIT_L(0); PG8_BAR; PG8_MMA(0, 0, At, B0); PG8_MMA(0, 1, At, B1); PG8_BAR; PG8_SCHED;
            PG8_LDA(At, 0, 1); PG8_STAGE(PG8_SB(0, 0), b2, voffB); PG8_STAGE(PG8_SB(0, 1), b2 + hstep, voffB); PG8_STAGE(PG8_SA(0, 0), a2, voffA);
            PG8_WAIT_V(8); PG8_WAIT_L(0); PG8_BAR; PG8_MMA(1, 0, At, B0); PG8_MMA(1, 1, At, B1); PG8_BAR; PG8_SCHED;
            PG8_LDB(B0, 1, 0); PG8_LDB(B1, 1, 1); PG8_SCHED; PG8_LDA(At, 1, 0); PG8_STAGE(PG8_SA(0, 1), a2 + hstep, voffA);
            PG8_WAIT_V(8); PG8_WAIT_L(0); PG8_BAR; PG8_MMA(0, 0, At, B0); PG8_MMA(0, 1, At, B1); PG8_BAR; PG8_SCHED;
            PG8_LDA(At, 1, 1); PG8_STAGE(PG8_SB(1, 0), b3, voffB); PG8_STAGE(PG8_SB(1, 1), b3 + hstep, voffB); PG8_STAGE(PG8_SA(1, 0), a3, voffA);
            PG8_WAIT_V(8); PG8_WAIT_L(0); PG8_BAR; PG8_MMA(1, 0, At, B0); PG8_MMA(1, 1, At, B1); PG8_BAR; PG8_SCHED;
            } else {
            PG8_LDB(B0, 0, 0); PG8_SCHED; PG8_LDA(At, 0, 0); PG8_STAGE(PG8_SA(1, 1), a1 + hstep, voffA);
            PG8_WAIT_L(8); PG8_BAR; PG8_WAIT_L(0); PG8_MMA(0, 0, At, B0); PG8_BAR; PG8_SCHED;
            PG8_LDB(B1, 0, 1); PG8_STAGE(PG8_SB(0, 0), b2, voffB);
            PG8_BAR; PG8_WAIT_L(0); PG8_MMA(0, 1, At, B1); PG8_BAR;
            PG8_LDA(At, 0, 1); PG8_STAGE(PG8_SA(0, 0), a2, voffA);
            PG8_BAR; PG8_WAIT_L(0); PG8_MMA(1, 0, At, B0); PG8_BAR; PG8_SCHED;
            PG8_STAGE(PG8_SB(0, 1), b2 + hstep, voffB);
            PG8_WAIT_V(6); PG8_BAR; PG8_MMA(1, 1, At, B1); PG8_BAR;
            PG8_LDB(B0, 1, 0); PG8_SCHED; PG8_LDA(At, 1, 0); PG8_STAGE(PG8_SA(0, 1), a2 + hstep, voffA);
            PG8_WAIT_L(8); PG8_BAR; PG8_WAIT_L(0); PG8_MMA(0, 0, At, B0); PG8_BAR; PG8_SCHED;
            PG8_LDB(B1, 1, 1); PG8_STAGE(PG8_SB(1, 0), b3, voffB);
            PG8_BAR; PG8_WAIT_L(0); PG8_MMA(0, 1, At, B1); PG8_BAR;
            PG8_LDA(At, 1, 1); PG8_STAGE(PG8_SA(1, 0), a3, voffA);
            PG8_BAR; PG8_WAIT_L(0); PG8_MMA(1, 0, At, B0); PG8_BAR; PG8_SCHED;
            PG8_STAGE(PG8_SB(1, 1), b3 + hstep, voffB);
            PG8_WAIT_V(6); PG8_BAR; PG8_MMA(1, 1, At, B1); PG8_BAR;
            }
        }
        if constexpr (ALIGN_EPI) { if (wr == 0) PG8_BAR; }
        if constexpr (!Epi::AFTER_DRAIN) { E(acc, cur, wr, wc, fr, fq); S.done(cur); }
        if (!has_next) break;
#pragma unroll
        for (int a = 0; a < 2; ++a)
#pragma unroll
            for (int b = 0; b < 2; ++b)
#pragma unroll
                for (int m = 0; m < 4; ++m)
#pragma unroll
                    for (int n = 0; n < 2; ++n) acc[a][b][m][n] = (f32x4){0.f, 0.f, 0.f, 0.f};
        cur = nxt; cA = nA; cB = nB; ++ui;
        if constexpr (ALIGN_EPI) { if (wr == 1) PG8_BAR; }
    }
    PG8_WAIT_V(0);
    if constexpr (!ALIGN_EPI) { if (wr == 0) PG8_BAR; }
    PG8_BAR;
    if constexpr (Epi::AFTER_DRAIN) { E.fused(acc, cur, wr, wc, fr, fq, lds, wid, lane); S.done(cur); }
#undef PG8_SA
#undef PG8_SB
#undef PG8_STAGE
#undef PG8_LDA
#undef PG8_LDB
#undef PG8_MMA
#undef PG8_WAIT_V
#undef PG8_WAIT_L
#undef PG8_BAR
#undef PG8_SCHED
}
}
#include <hip/hip_bf16.h>
#include <cmath>
namespace attn_body {
using bf16=__hip_bfloat16;
using bf16x8=__attribute__((ext_vector_type(8)))short;
using s16x4=__attribute__((ext_vector_type(4)))short;
using f32x16=__attribute__((ext_vector_type(16)))float;
using u32x4=__attribute__((ext_vector_type(4)))unsigned;
constexpr int BATCH=8,NHEAD=6,SEQ=4096,D=64,KVP=3072,OP=1024;
constexpr int NW=8,QBLK=32,QB=QBLK*NW,KVBLK=64,NQB=SEQ/QB;
constexpr int ATTN_UNIT_ROWS=QB;
__device__ __forceinline__ int crow(int r,int hi){return (r&3)+8*(r>>2)+4*hi;}
#define SBAR() __builtin_amdgcn_sched_barrier(0)
__device__ __forceinline__ void cmask(f32x16&p0,f32x16&p1,int jb,int qrel,int hi){
  const float NEG=-INFINITY; int kb=64*jb+4*hi;
  #pragma unroll
  for(int r=0;r<16;++r){int kv=kb+(r&3)+8*(r>>2); if(kv>qrel)p0[r]=NEG; if(kv+32>qrel)p1[r]=NEG;}
}

constexpr int NSLOT=3, SLOTB=8192;
constexpr int LDS_K=0, LDS_V=NSLOT*SLOTB, LDS_WS=2*NSLOT*SLOTB, LDS_OST=LDS_WS+NW*64*4, LDS_CK=LDS_OST+NW*4096, LDS_BYTES=LDS_CK+SEQ*4;
constexpr float C2=0.125f*1.4426950408889634f;
__device__ __forceinline__ void glds16(const void*gsrc,unsigned lds_dst){unsigned keep;
  asm volatile("s_mov_b32 %0, m0\n\ts_mov_b32 m0, %2\n\ts_nop 0\n\tglobal_load_lds_dwordx4 %1, off\n\ts_mov_b32 m0, %0":"=&s"(keep):"v"(gsrc),"s"(lds_dst):"memory");}
__device__ __forceinline__ float max3f(float a,float b,float c){float r;asm("v_max3_f32 %0, %1, %2, %3":"=v"(r):"v"(a),"v"(b),"v"(c));return r;}
__device__ __forceinline__ float max2f(float a,float b){float r;asm("v_max_f32_e32 %0, %1, %2":"=v"(r):"v"(a),"v"(b));return r;}
__device__ __forceinline__ float fadd_s(float a,float b){float r;asm("v_add_f32_e32 %0, %1, %2":"=v"(r):"v"(a),"v"(b));return r;}
__device__ __forceinline__ float fsub_s(float a,float b){float r;asm("v_sub_f32_e32 %0, %1, %2":"=v"(r):"v"(a),"v"(b));return r;}
typedef float f32x2_t __attribute__((ext_vector_type(2))); typedef float f32x4_t __attribute__((ext_vector_type(4))); typedef __bf16 bf16x2_t __attribute__((ext_vector_type(2)));
__device__ __forceinline__ unsigned cvtpk_s(float lo,float hi){f32x2_t v={lo,hi};bf16x2_t b=__builtin_convertvector(v,bf16x2_t);return __builtin_bit_cast(unsigned,b);}
#define WAIT_BAR(N) asm volatile("s_waitcnt vmcnt(" #N ") lgkmcnt(0)\n\ts_barrier":::"memory")

__device__ __forceinline__ void qkt(f32x16&p0,f32x16&p1,const char*Kslot,const bf16x8*qr,int r32,int hi){
  const char*kb=Kslot+hi*1024+r32*16;
  #pragma unroll
  for(int d0=0;d0<4;++d0){
    const bf16x8 b0=*reinterpret_cast<const bf16x8*>(kb+d0*2048);
    const bf16x8 b1=*reinterpret_cast<const bf16x8*>(kb+d0*2048+512);
    {p0=__builtin_amdgcn_mfma_f32_32x32x16_bf16(b0,qr[d0],p0,0,0,0);p1=__builtin_amdgcn_mfma_f32_32x32x16_bf16(b1,qr[d0],p1,0,0,0);}}
}
typedef __attribute__((address_space(3))) const char* lds_cptr;
typedef short v4i16_t __attribute__((ext_vector_type(4)));
__device__ __forceinline__ void kload8(bf16x8*kf,lds_cptr kp){
  kf[0]=*(const __attribute__((address_space(3))) bf16x8*)(kp);      kf[1]=*(const __attribute__((address_space(3))) bf16x8*)(kp+512);
  kf[2]=*(const __attribute__((address_space(3))) bf16x8*)(kp+2048); kf[3]=*(const __attribute__((address_space(3))) bf16x8*)(kp+2560);
  kf[4]=*(const __attribute__((address_space(3))) bf16x8*)(kp+4096); kf[5]=*(const __attribute__((address_space(3))) bf16x8*)(kp+4608);
  kf[6]=*(const __attribute__((address_space(3))) bf16x8*)(kp+6144); kf[7]=*(const __attribute__((address_space(3))) bf16x8*)(kp+6656);
}
__device__ __forceinline__ void kload2(bf16x8*kf,lds_cptr kp,int j){ kf[2*j]=*(const __attribute__((address_space(3))) bf16x8*)(kp+j*2048); kf[2*j+1]=*(const __attribute__((address_space(3))) bf16x8*)(kp+j*2048+512); }
__device__ __forceinline__ s16x4 vtr(lds_cptr p){ return __builtin_bit_cast(s16x4,__builtin_amdgcn_ds_read_tr16_b64_v4i16((__attribute__((address_space(3))) v4i16_t*)p)); }
__device__ __forceinline__ float rowmax(const f32x16&p0,const f32x16&p1){
  float a=max3f(p0[0],p0[1],p1[0]),b=max3f(p0[2],p0[3],p1[1]);a=max3f(a,p1[2],p1[3]);
  #pragma unroll
  for(int r=4;r<16;r+=4){a=max3f(a,p0[r],p0[r+1]);b=max3f(b,p0[r+2],p0[r+3]);a=max3f(a,p1[r],p1[r+1]);b=max3f(b,p1[r+2],p1[r+3]);}
  const float m=max2f(a,b);
  auto rr=__builtin_amdgcn_permlane32_swap(__float_as_uint(m),__float_as_uint(m),false,false);
  return max2f(__uint_as_float(rr[0]),__uint_as_float(rr[1]));
}
__device__ __forceinline__ void pv(f32x16*o,int vb,bf16x8 pa0,bf16x8 pa1,bf16x8 pa2,bf16x8 pa3){
  #pragma unroll
  for(int d0=0;d0<2;++d0){s16x4 lo[4],hi[4];
    #pragma unroll
    for(int ks=0;ks<4;++ks){
      asm volatile("ds_read_b64_tr_b16 %0,%1 offset:%c2":"=&v"(lo[ks]):"v"(vb),"i"(d0*4096+ks*1024):"memory");
      asm volatile("ds_read_b64_tr_b16 %0,%1 offset:%c2":"=&v"(hi[ks]):"v"(vb),"i"(d0*4096+ks*1024+512):"memory");}
    asm volatile("s_waitcnt lgkmcnt(0)":::"memory");SBAR();
    #define PK(k) (bf16x8){lo[k][0],lo[k][1],lo[k][2],lo[k][3],hi[k][0],hi[k][1],hi[k][2],hi[k][3]}
    o[d0]=__builtin_amdgcn_mfma_f32_32x32x16_bf16(pa0,PK(0),o[d0],0,0,0);
    o[d0]=__builtin_amdgcn_mfma_f32_32x32x16_bf16(pa1,PK(1),o[d0],0,0,0);
    o[d0]=__builtin_amdgcn_mfma_f32_32x32x16_bf16(pa2,PK(2),o[d0],0,0,0);
    o[d0]=__builtin_amdgcn_mfma_f32_32x32x16_bf16(pa3,PK(3),o[d0],0,0,0);
    #undef PK
  }
}

#ifndef ATTN_STORE16
#define ATTN_STORE16(p,v) (*(u32x4*)(p)=(v))
#endif
template<int THRL> __device__ __forceinline__ void attn_unit(int b,int h,int qb,const bf16*Q,const bf16*__restrict__ K,const bf16*__restrict__ V,bf16*O,const float*__restrict__ CKg,const float*__restrict__ KTm,const float*__restrict__ QBm,char*shm){
  const int tid=tid_l(),lane=tid&63,r32=lane&31,hi=lane>>5; const int wid=__builtin_amdgcn_readfirstlane(tid>>6);
  const long rowbase=(long)b*SEQ; const int q0=qb*QB;
  const bf16*Qw=Q+(rowbase+q0+wid*QBLK)*KVP+h*D;
  const float*ckg=CKg+(long)(b*NHEAD+h)*SEQ;
  int j0=0;
  { const int bh_=b*NHEAD+h, NT0_=(q0+QB)/KVBLK; const float qmx=QBm[bh_*NQB+qb]*1.01f;
    const float kd=fmaxf(fmaxf(KTm[bh_*64+4*qb],KTm[bh_*64+4*qb+1]),fmaxf(KTm[bh_*64+4*qb+2],KTm[bh_*64+4*qb+3]));
    const float thr=-(qmx*kd)-48.f; bool skip=false;
    if(lane<NT0_-4){ const float bound=qmx*KTm[bh_*64+lane]+(ckg[q0]-ckg[64*lane+63]); skip=bound<thr; }
    const unsigned long long m_=__ballot(skip); j0=__builtin_ctzll(~m_); j0=(j0<NT0_-4?j0:NT0_-4)&~1; j0=__builtin_amdgcn_readfirstlane(j0); }
  const bf16*Kh=K+(rowbase+(long)j0*KVBLK)*KVP+h*D,*Vh=V+(rowbase+(long)j0*KVBLK)*KVP+h*D;
  const unsigned lds0=(unsigned)(uintptr_t)shm;
  float*wsf=(float*)(shm+LDS_WS)+wid*64;
  const bf16*ksrc=Kh+(long)lane*KVP+wid*8;
  const bf16*vsrc=Vh+(long)(16*(wid&3)+(lane>>2))*KVP+(wid>>2)*32+(lane&3)*8;
  const unsigned kdst=lds0+LDS_K+wid*1024, vdst=lds0+LDS_V+wid*1024;
  #define DMA_K(t,slot) glds16(ksrc+(long)(t)*KVBLK*KVP,(unsigned)__builtin_amdgcn_readfirstlane(kdst+(slot)))
  #define DMA_V(t,slot) glds16(vsrc+(long)(t)*KVBLK*KVP,(unsigned)__builtin_amdgcn_readfirstlane(vdst+(slot)))
  const int vb0=(int)(lds0+LDS_V)+((lane>>4)&1)*32+(lane&3)*8+(4*hi+((lane&15)>>2))*64;
  const char*Kbase=shm+LDS_K; bf16x8 kf[8];
  const lds_cptr shm3=(lds_cptr)shm; const lds_cptr kp0=shm3+LDS_K+hi*1024+r32*16; const lds_cptr vp0=shm3+LDS_V+((lane>>4)&1)*32+(lane&3)*8+(4*hi+((lane&15)>>2))*64;
  const int NT=(q0+QB)/KVBLK-j0;
  float*cks=(float*)(shm+LDS_CK);
  for(int i=j0*KVBLK+tid*4;i<q0+QB;i+=NW*64*4){ *(f32x4_t*)(cks+i)=*(const f32x4_t*)(ckg+i); }
  float cqm=ckg[q0+wid*QBLK+r32];
  const lds_cptr ckp=(lds_cptr)shm+LDS_CK+j0*256+hi*16;
  DMA_K(0,0);DMA_V(0,0);DMA_K(1,SLOTB);
  bf16x8 qr[4];
  #pragma unroll
  for(int d0=0;d0<4;++d0)qr[d0]=*reinterpret_cast<const bf16x8*>(&Qw[(long)r32*KVP+d0*16+hi*8]);
  float l_reg=0.f;f32x16 o[2];o[0]=f32x16{};o[1]=f32x16{};
  #define CINIT(C0,C1,t) do{ const lds_cptr cp_=ckp+(t)*256; \
    _Pragma("unroll") for(int g_=0;g_<4;++g_){ const f32x4_t a_=*(const __attribute__((address_space(3))) f32x4_t*)(cp_+g_*32); const f32x4_t b_=*(const __attribute__((address_space(3))) f32x4_t*)(cp_+g_*32+128); \
      _Pragma("unroll") for(int i_=0;i_<4;++i_){ C0[g_*4+i_]=cqm-a_[i_]; C1[g_*4+i_]=cqm-b_[i_]; } } }while(0)
  const int qrel=wid*QBLK+r32;
  #define CMASK(P0,P1,t) do{int jb_=(t)-(NT-4); if(jb_>=0)cmask(P0,P1,jb_,qrel,hi);}while(0)
  bool resc=false;
  #define START(P0,P1) do{ const float rm=rowmax(P0,P1); resc=false; \
    { const float dl=rm; \
      _Pragma("unroll") for(int r=0;r<16;++r){P0[r]=fsub_s(P0[r],dl);P1[r]=fsub_s(P1[r],dl);} \
      cqm=fsub_s(cqm,dl); } \
    _Pragma("unroll") for(int r=0;r<16;++r)P0[r]=__builtin_amdgcn_exp2f(P0[r]); }while(0)
  #define RESC() do{ if(resc){ asm volatile("s_waitcnt lgkmcnt(0)":::"memory"); \
      _Pragma("unroll") for(int d_=0;d_<2;++d_) _Pragma("unroll") for(int r=0;r<16;++r)o[d_][r]*=wsf[crow(r,hi)]; } }while(0)
  f32x16 pA0,pA1,pB0,pB1;
  int sl_prev=0,sl_cur=0,sl_next=SLOTB;
  #define ROT() do{sl_prev=sl_cur;sl_cur=sl_next;sl_next=(sl_next==(NSLOT-1)*SLOTB)?0:sl_next+SLOTB;}while(0)
  DMA_K(2,2*SLOTB);
  WAIT_BAR(3);
  CINIT(pA0,pA1,0);
  qkt(pA0,pA1,Kbase,qr,r32,hi);asm volatile("s_nop 15\n\ts_nop 7":"+v"(pA0),"+v"(pA1));CMASK(pA0,pA1,0);
  START(pA0,pA1);
  _Pragma("unroll") for(int r=0;r<16;++r)pA1[r]=__builtin_amdgcn_exp2f(pA1[r]);
  WAIT_BAR(0);
  DMA_K(3,0);DMA_V(1,SLOTB);
  ROT();
  kload8(kf,kp0+sl_cur);
  WAIT_BAR(2);
  s16x4 vlo[8],vhi[8]; u32x4 pw0,pw1,pw2,pw3;
  #define PKW(P,B) cvtpk_s(P[B],P[B+1])
  #define PAF(k) __builtin_bit_cast(bf16x8,pw##k)
  #define VFR(i) (bf16x8){vlo[i][0],vlo[i][1],vlo[i][2],vlo[i][3],vhi[i][0],vhi[i][1],vhi[i][2],vhi[i][3]}
  #define PIN(x) asm volatile("":"+v"(x))
  #define MX3(a,b,c) __builtin_fmaxf(__builtin_fmaxf((a),(b)),(c))
  #define GAPA(MF,A0,A1,A2,A3,W0,W1,PW) do{ MF; sacc+=A0; sacc+=A1; sacc+=A2; sacc+=A3; PIN(sacc); W0; W1; PIN(PW); SBAR(); }while(0)
  #define EX(v) __builtin_amdgcn_exp2f(v)
  #define GAPB(MF,X,B) do{ MF; X[B]=EX(X[B]); X[B+1]=EX(X[B+1]); X[B+2]=EX(X[B+2]); X[B+3]=EX(X[B+3]); PIN(X); SBAR(); }while(0)
  #define VRD(i) do{ vlo[i]=vtr(vp_+(((i)>>2)*4096+((i)&3)*1024)); vhi[i]=vtr(vp_+(((i)>>2)*4096+((i)&3)*1024+512)); }while(0)
  #define KRD(G,j) do{ if(G){ kload2(kf,kp0+sl_next,j); SBAR(); } }while(0)
  #define STEP(C0,C1,P0,P1,t,GK,GV,GL) do{ SBAR(); \
    CINIT(C0,C1,t); SBAR(); \
    const lds_cptr vp_=vp0+sl_prev; \
    VRD(0); SBAR(); float sacc=(P0[0]+P0[1]); \
    GAPA(C0=__builtin_amdgcn_mfma_f32_32x32x16_bf16(kf[0],qr[0],C0,0,0,0), P0[2],P0[3],P0[4],P0[5],     pw0[0]=PKW(P0,0), pw0[1]=PKW(P0,2), pw0); \
    VRD(4); SBAR(); GAPA(C1=__builtin_amdgcn_mfma_f32_32x32x16_bf16(kf[1],qr[0],C1,0,0,0), P0[6],P0[7],P0[8],P0[9],     pw0[2]=PKW(P0,4), pw0[3]=PKW(P0,6), pw0); \
    VRD(1); SBAR(); GAPA(C0=__builtin_amdgcn_mfma_f32_32x32x16_bf16(kf[2],qr[1],C0,0,0,0),   P0[10],P0[11],P0[12],P0[13], pw1[0]=PKW(P0,8), pw1[1]=PKW(P0,10), pw1); \
    VRD(5); SBAR(); GAPA(C1=__builtin_amdgcn_mfma_f32_32x32x16_bf16(kf[3],qr[1],C1,0,0,0),   P0[14],P0[15],P1[0],P1[1],   pw1[2]=PKW(P0,12),pw1[3]=PKW(P0,14), pw1); \
    VRD(2); SBAR(); GAPA(C0=__builtin_amdgcn_mfma_f32_32x32x16_bf16(kf[4],qr[2],C0,0,0,0),   P1[2],P1[3],P1[4],P1[5],     pw2[0]=PKW(P1,0), pw2[1]=PKW(P1,2), pw2); \
    VRD(6); SBAR(); GAPA(C1=__builtin_amdgcn_mfma_f32_32x32x16_bf16(kf[5],qr[2],C1,0,0,0),   P1[6],P1[7],P1[8],P1[9],     pw2[2]=PKW(P1,4), pw2[3]=PKW(P1,6), pw2); \
    VRD(3); SBAR(); GAPA(C0=__builtin_amdgcn_mfma_f32_32x32x16_bf16(kf[6],qr[3],C0,0,0,0),   P1[10],P1[11],P1[12],P1[13], pw3[0]=PKW(P1,8), pw3[1]=PKW(P1,10), pw3); \
    VRD(7); SBAR(); GAPA(C1=__builtin_amdgcn_mfma_f32_32x32x16_bf16(kf[7],qr[3],C1,0,0,0),   P1[14],P1[15],0.f,0.f,       pw3[2]=PKW(P1,12),pw3[3]=PKW(P1,14), pw3); \
    l_reg+=sacc; \
    if(GK){DMA_K((t)+3,sl_cur);} if(GV){DMA_V((t)+1,sl_next);} \
    CMASK(C0,C1,t); \
    { float a=MX3(C0[0],C0[1],C1[0]),b=MX3(C0[2],C0[3],C1[1]); a=MX3(a,C1[2],C1[3]); \
      _Pragma("unroll") for(int r=4;r<16;r+=4){a=MX3(a,C0[r],C0[r+1]);b=MX3(b,C0[r+2],C0[r+3]);a=MX3(a,C1[r],C1[r+1]);b=MX3(b,C1[r+2],C1[r+3]);} \
      float rm=__builtin_fmaxf(a,b); { auto rr=__builtin_amdgcn_permlane32_swap(__float_as_uint(rm),__float_as_uint(rm),false,false); rm=__builtin_fmaxf(__uint_as_float(rr[0]),__uint_as_float(rr[1])); } \
      resc=false; \
      if(__builtin_expect(__any(rm>(float)THRL),0)){ const float dl=__builtin_fmaxf(rm,0.f); \
        _Pragma("unroll") for(int r=0;r<16;++r){C0[r]-=dl;C1[r]-=dl;} \
        cqm-=dl; \
        const float f=__builtin_amdgcn_exp2f(-dl); l_reg*=f; if(hi==0)wsf[r32]=f; resc=true; } } \
    SBAR(); \
    GAPB(o[0]=__builtin_amdgcn_mfma_f32_32x32x16_bf16(PAF(0),VFR(0),o[0],0,0,0), C0,0); \
    GAPB(o[1]=__builtin_amdgcn_mfma_f32_32x32x16_bf16(PAF(0),VFR(4),o[1],0,0,0), C0,4); \
    KRD(GL,0); GAPB(o[0]=__builtin_amdgcn_mfma_f32_32x32x16_bf16(PAF(1),VFR(1),o[0],0,0,0), C0,8); \
    KRD(GL,1); GAPB(o[1]=__builtin_amdgcn_mfma_f32_32x32x16_bf16(PAF(1),VFR(5),o[1],0,0,0), C0,12); \
    KRD(GL,2); GAPB(o[0]=__builtin_amdgcn_mfma_f32_32x32x16_bf16(PAF(2),VFR(2),o[0],0,0,0), C1,0); \
    KRD(GL,3); GAPB(o[1]=__builtin_amdgcn_mfma_f32_32x32x16_bf16(PAF(2),VFR(6),o[1],0,0,0), C1,4); \
    GAPB(o[0]=__builtin_amdgcn_mfma_f32_32x32x16_bf16(PAF(3),VFR(3),o[0],0,0,0), C1,8); \
    GAPB(o[1]=__builtin_amdgcn_mfma_f32_32x32x16_bf16(PAF(3),VFR(7),o[1],0,0,0), C1,12); \
    }while(0)
  int t=1;
  #undef CMASK
  #define CMASK(P0,P1,t) do{}while(0)
  for(;t+5<NT;t+=2){
    STEP(pB0,pB1,pA0,pA1,t,true,true,true);     WAIT_BAR(2); RESC(); ROT();
    STEP(pA0,pA1,pB0,pB1,t+1,true,true,true);   WAIT_BAR(2); RESC(); ROT();
  }
  #undef CMASK
  #define CMASK(P0,P1,t) do{int jb_=(t)-(NT-4); if(jb_>=0)cmask(P0,P1,jb_,qrel,hi);}while(0)
  #define ENDW(tt) do{ if((tt)+3<NT){WAIT_BAR(2);} else if((tt)+2<NT){WAIT_BAR(1);} else {WAIT_BAR(0);} }while(0)
  for(;t+1<NT;t+=2){
    STEP(pB0,pB1,pA0,pA1,t,(t+3<NT),(t+1<NT),(t+1<NT));       ENDW(t);   RESC(); ROT();
    STEP(pA0,pA1,pB0,pB1,t+1,(t+4<NT),(t+2<NT),(t+2<NT));     ENDW(t+1); RESC(); ROT();
  }
  STEP(pB0,pB1,pA0,pA1,NT-1,false,false,false); RESC();
  { float sacc=pB0[0]+pB0[1]; _Pragma("unroll") for(int r=2;r<16;++r)sacc+=pB0[r]; _Pragma("unroll") for(int r=0;r<16;++r)sacc+=pB1[r]; l_reg+=sacc;
    pw0=(u32x4){PKW(pB0,0),PKW(pB0,2),PKW(pB0,4),PKW(pB0,6)};pw1=(u32x4){PKW(pB0,8),PKW(pB0,10),PKW(pB0,12),PKW(pB0,14)};pw2=(u32x4){PKW(pB1,0),PKW(pB1,2),PKW(pB1,4),PKW(pB1,6)};pw3=(u32x4){PKW(pB1,8),PKW(pB1,10),PKW(pB1,12),PKW(pB1,14)};
    SBAR(); pv(o,vb0+sl_cur,PAF(0),PAF(1),PAF(2),PAF(3)); }
  #undef PKW
  #undef PAF
  #undef VFR
  #undef PIN
  #undef MX3
  #undef GAPA
  #undef GAPB
  #undef EX
  #undef VRD
  #undef KRD
  #undef STEP
  #undef ENDW
  {auto rr=__builtin_amdgcn_permlane32_swap(__float_as_uint(l_reg),__float_as_uint(l_reg),false,false);l_reg=__uint_as_float(rr[0])+__uint_as_float(rr[1]);}
  if(hi==0)wsf[32+r32]=l_reg;asm volatile("s_waitcnt lgkmcnt(0)":::"memory");
  float rli[16];
  #pragma unroll
  for(int r=0;r<16;++r)rli[r]=__builtin_amdgcn_rcpf(wsf[32+crow(r,hi)]);
  bf16*Ow=O+(rowbase+q0+wid*QBLK)*OP+h*D;
  { bf16*stg=(bf16*)(shm+LDS_OST)+wid*2048;
    #pragma unroll
    for(int r=0;r<16;++r){const int orow=crow(r,hi);
      #pragma unroll
      for(int d0=0;d0<2;++d0)stg[orow*64+d0*32+r32]=__float2bfloat16(o[d0][r]*rli[r]);}
    asm volatile("s_waitcnt lgkmcnt(0)":::"memory");
    #pragma unroll
    for(int i=0;i<4;++i){const int row=i*8+(lane>>3),ch=lane&7; const u32x4 v=*(const u32x4*)(stg+row*64+ch*8); ATTN_STORE16(Ow+(long)row*OP+ch*8,v);} }
  asm volatile("s_waitcnt lgkmcnt(0)\n\ts_barrier":::"memory");
  #undef DMA_K
  #undef DMA_V
  #undef CMASK
  #undef START
  #undef RESC
  #undef ROT
  #undef CINIT
}
constexpr int ATTN_LDS_BYTES=LDS_BYTES;
struct AttnTensors { const bf16* Q; const bf16* K; const bf16* V; bf16* O; const float* CK; const float* KT; const float* QB; };
struct AttnUnit { int bh; int qb; };
struct QueueOrder {
  unsigned* head; volatile __attribute__((address_space(3))) int* slot;
  __device__ __forceinline__ bool next(int,AttnUnit&u)const{
    if(tid_l()==0) *slot=(int)__hip_atomic_fetch_add(head,1u,__ATOMIC_RELAXED,__HIP_MEMORY_SCOPE_AGENT);
    __syncthreads(); const int v=*slot; __syncthreads();
    if(v>=BATCH*NHEAD*NQB)return false; u.qb=NQB-1-v/(BATCH*NHEAD); u.bh=v%(BATCH*NHEAD); return true; }
  __device__ __forceinline__ void a_ready(const AttnUnit&)const{}
  __device__ __forceinline__ void done(const AttnUnit&)const{}
};
template<class Sched,int THRL=8> __device__ __forceinline__ void attn_phase(char*lds,const AttnTensors&T,const Sched&S){
  AttnUnit u;
  for(int i=0;S.next(i,u);++i){ S.a_ready(u); attn_unit<THRL>(u.bh/NHEAD,u.bh%NHEAD,u.qb,T.Q,T.K,T.V,T.O,T.CK,T.KT,T.QB,lds); S.done(u); }
}
#undef SBAR
#undef WAIT_BAR
}

constexpr int NB = 8, SEQ = 4096, T = NB * SEQ, D = 1024, DEPTH = 4;
constexpr int HCOLS = 3072;
constexpr int HC_AVAL = 0, HC_AGATE = 256, HC_BQ = 512, HC_BK = 704, HC_BV = 896, HC_BG = 1280, HC_CQ = 1664, HC_CK = 2048, HC_CV = 2432, HC_LR = 2816, HC_CF = 2832;
constexpr int IN_COLS = 2838;
constexpr int MC_A = 0, MC_B = 256, MC_C = 640;
constexpr float LN_EPS = 1e-5f;
constexpr float ALPHA = 1.6817928305074292f;
constexpr float LOG2E = 1.4426950408889634f;
constexpr float C2 = 0.125f * LOG2E;
constexpr float GLA_QSCALE = 0.17677669529663687f;
constexpr int NEXP = 16384;

constexpr size_t MiB = 1u << 20;
constexpr size_t WS_CTL = 0, CTL_ZERO_BYTES = 1 * MiB;
constexpr size_t WS_WIN = 1 * MiB;
constexpr size_t WS_WOUT = WS_WIN + 24 * MiB;
constexpr size_t WS_WP = WS_WOUT + 8 * MiB;
constexpr size_t WS_PGW = WS_WP + 16 * MiB;
constexpr size_t WS_PW = WS_PGW + 8 * MiB;
constexpr size_t WS_CK = WS_PW + 2 * MiB;
constexpr size_t WS_FKT = WS_CK + 768 * 1024, WS_FQB = WS_FKT + 16 * 1024;
constexpr size_t WS_U = WS_CK + 1 * MiB;
constexpr size_t WS_V = WS_U + 32 * MiB;
constexpr size_t WS_XB = WS_V + 32 * MiB;
constexpr size_t WS_XF = WS_XB + 64 * MiB;
constexpr size_t WS_XQ = WS_XF, WS_XS = WS_XF + 32 * MiB, WS_RS = WS_XS + 1 * MiB, WS_VS = WS_RS + 65536;
constexpr size_t WS_PB = WS_XF + 128 * MiB;
constexpr size_t WS_H = WS_PB + 16 * MiB;
constexpr size_t WS_MIX = WS_H + 192 * MiB;
constexpr size_t WS_SC = WS_H;
constexpr size_t WS_Y = WS_MIX + 64 * MiB;
constexpr size_t WS_GCUM = WS_Y;
constexpr size_t WS_GS = WS_GCUM + 24 * MiB;
constexpr size_t WS_GDEC = WS_GS + 24 * MiB;
constexpr size_t WS_E = WS_Y + 128 * MiB;
constexpr size_t WS_EIDX = WS_E + 64 * MiB;
constexpr size_t WS_GATE = WS_EIDX + 16 * MiB;
constexpr size_t WS_SOFF = WS_GATE + 16 * MiB;
constexpr size_t WS_END = WS_SOFF + 1 * MiB;
static_assert(WS_END <= 1024 * MiB, "d_ws map");

constexpr int LDS_BYTES = 147456;

typedef unsigned short bf16;
typedef float f32x4 __attribute__((ext_vector_type(4)));
typedef unsigned u32x4 __attribute__((ext_vector_type(4)));
typedef unsigned u32x2 __attribute__((ext_vector_type(2)));

struct Params {
    const float *x, *p, *w_in, *conv_w, *conv_b, *conv_ln_g, *conv_ln_b, *gla_gate_w, *gla_gate_b, *gla_norm_g, *fox_forget_b, *w_out, *ln1_g, *ln1_b,
        *peer_wq, *peer_keys, *peer_u, *peer_v, *ple_w, *ple_gw, *ple_gb, *ln2_g, *ln2_b;
    float* out; unsigned char* ws;
};

__device__ __forceinline__ float bf2f(unsigned h) { return __uint_as_float(h << 16); }
__device__ __forceinline__ unsigned f2bf(float f) { unsigned u = __float_as_uint(f); return (u + 0x7fffu + ((u >> 16) & 1u)) >> 16; }
__device__ __forceinline__ unsigned pk2(float lo, float hi) { return f2bf(lo) | (f2bf(hi) << 16); }
__device__ __forceinline__ float wave_sum(float v) {
#pragma unroll
    for (int o = 1; o < 64; o <<= 1) v += __shfl_xor(v, o);
    return v;
}
__device__ __forceinline__ float log_sigmoid(float z) { return fminf(z, 0.f) - log1pf(__expf(-fabsf(z))); }
__device__ __forceinline__ float sigmoidf_(float z) { return 1.0f / (1.0f + __expf(-z)); }

struct MapIdent { __device__ __forceinline__ void operator()(int n, int& c, float& s) const { c = n; s = 1.f; } };
struct MapWin {
    __device__ __forceinline__ void operator()(int n, int& c, float& s) const {
        s = 1.f;
        if (n < HC_CQ) { c = n; if (n >= HC_BQ && n < HC_BK) s = GLA_QSCALE; }
        else if (n < HC_LR) { c = n + 16; if (n < HC_CK) s = C2; }
        else if (n < HC_CF) c = n - HC_LR + 1664;
        else if (n < IN_COLS) c = n;
        else c = -1;
    }
};
template <class CM>
__device__ __forceinline__ void transpose_item(const float* W, int K, int Nsrc, bf16* WT, int item, int nblk, float* scr, int lane, const CM& cm) {
    const int kb = item / nblk, nb = item % nblk, k0 = 64 * kb, n0 = 32 * nb;
    int sc; float scale; cm(n0 + (lane & 31), sc, scale);
#pragma unroll 8
    for (int i = 0; i < 32; ++i) { const int kk = 2 * i + (lane >> 5); scr[kk * 33 + (lane & 31)] = sc >= 0 ? W[(size_t)(k0 + kk) * Nsrc + sc] * scale : 0.f; }
    __builtin_amdgcn_wave_barrier(); asm volatile("s_waitcnt lgkmcnt(0)" ::: "memory");
    const int c = lane & 7;
#pragma unroll
    for (int j = 0; j < 4; ++j) { const int n = (lane >> 3) + 8 * j; const float* s = scr + (8 * c) * 33 + n;
        u32x4 o; o.x = pk2(s[0 * 33], s[1 * 33]); o.y = pk2(s[2 * 33], s[3 * 33]); o.z = pk2(s[4 * 33], s[5 * 33]); o.w = pk2(s[6 * 33], s[7 * 33]);
        *(u32x4*)(WT + (size_t)(n0 + n) * K + k0 + 8 * c) = o; }
    asm volatile("s_waitcnt lgkmcnt(0)" ::: "memory"); __builtin_amdgcn_wave_barrier();
}
__device__ __forceinline__ void cvt_bf16_stream(const float* src, bf16* dst, size_t n8, size_t gtid, size_t gthreads) {
    for (size_t i = gtid; i < n8; i += gthreads) { const f32x4 a = *(const f32x4*)(src + i * 8), b = *(const f32x4*)(src + i * 8 + 4);
        u32x4 o; o.x = pk2(a[0], a[1]); o.y = pk2(a[2], a[3]); o.z = pk2(b[0], b[1]); o.w = pk2(b[2], b[3]); *(u32x4*)(dst + i * 8) = o; }
}

__device__ __forceinline__ void phase_pro_a(const Params& p, unsigned char* lds) {
    const int tid = tid_l(), lane = tid & 63, wave = tid >> 6;
    float* scr = (float*)(lds + wave * 16384);
    const int gw = bid_l() * 8 + wave, NGW = grid_l() * 8;
    constexpr int I_WIN = (D / 64) * (HCOLS / 32), I_SQ = (D / 64) * (D / 32), I_PW = (256 / 64) * (D / 32);
    constexpr int PER_L = I_WIN + 2 * I_SQ + I_PW;
    for (int it = gw; it < DEPTH * PER_L; it += NGW) {
        const int l = it / PER_L; int r = it % PER_L;
        if (r < I_WIN) { transpose_item(p.w_in + (size_t)l * D * IN_COLS, D, IN_COLS, (bf16*)(p.ws + WS_WIN) + (size_t)l * HCOLS * D, r, HCOLS / 32, scr, lane, MapWin()); continue; } r -= I_WIN;
        if (r < I_SQ) { transpose_item(p.w_out + (size_t)l * D * D, D, D, (bf16*)(p.ws + WS_WOUT) + (size_t)l * D * D, r, D / 32, scr, lane, MapIdent()); continue; } r -= I_SQ;
        if (r < I_SQ) { transpose_item(p.ple_gw + (size_t)l * D * D, D, D, (bf16*)(p.ws + WS_PGW) + (size_t)l * D * D, r, D / 32, scr, lane, MapIdent()); continue; } r -= I_SQ;
        transpose_item(p.ple_w + (size_t)l * 256 * D, 256, D, (bf16*)(p.ws + WS_PW) + (size_t)l * D * 256, r, D / 32, scr, lane, MapIdent());
    }
    cvt_bf16_stream(p.x, (bf16*)(p.ws + WS_XB), (size_t)T * D / 8, (size_t)bid_l() * 512 + tid, (size_t)grid_l() * 512);
}
__device__ __forceinline__ void phase_pro_b(const Params& p, unsigned char* lds) {
    const int tid = tid_l();
    float* ks = (float*)lds;
    float* wqs = ks + 128 * 129;
    for (int it = bid_l(); it < DEPTH * 16 * 16; it += grid_l()) {
        const int l = it >> 8, hc = (it >> 4) & 15, kt = it & 15;
        const float* keys = p.peer_keys + ((size_t)l * 16 + hc) * 16384;
        const float* wq = p.peer_wq + (size_t)l * D * 2048 + (size_t)(kt * 64) * 2048 + hc * 128;
        __syncthreads();
        for (int i = tid; i < 128 * 128; i += 512) ks[(i >> 7) * 129 + (i & 127)] = keys[i];
        for (int i = tid; i < 64 * 128; i += 512) wqs[(i >> 7) * 129 + (i & 127)] = wq[(size_t)(i >> 7) * 2048 + (i & 127)];
        __syncthreads();
        const int k = tid & 63, n0 = (tid >> 6) * 16;
        float acc[16];
#pragma unroll
        for (int j = 0; j < 16; ++j) acc[j] = 0.f;
        for (int d = 0; d < 128; ++d) { const float a = wqs[k * 129 + d];
#pragma unroll
            for (int j = 0; j < 16; ++j) acc[j] += a * ks[(n0 + j) * 129 + d]; }
        bf16* WpT = (bf16*)(p.ws + WS_WP) + (size_t)l * 2048 * D;
#pragma unroll
        for (int j = 0; j < 16; ++j) WpT[(size_t)(hc * 128 + n0 + j) * D + kt * 64 + k] = (bf16)f2bf(acc[j]);
    }
}
constexpr float U8_SCALE = 64.f, V8_SCALE = 1.f;
typedef float f32x2v __attribute__((ext_vector_type(2)));
__device__ __forceinline__ unsigned pk_fp8x4(f32x4 v, float sc) {
    const float a = fminf(fmaxf(v[0] * sc, -448.f), 448.f), b = fminf(fmaxf(v[1] * sc, -448.f), 448.f), c = fminf(fmaxf(v[2] * sc, -448.f), 448.f), d = fminf(fmaxf(v[3] * sc, -448.f), 448.f);
    int w = __builtin_amdgcn_cvt_pk_fp8_f32(a, b, 0, false); w = __builtin_amdgcn_cvt_pk_fp8_f32(c, d, w, true); return (unsigned)w;
}
__device__ __forceinline__ void cvt_fp8_stream(const float* src, unsigned char* dst, size_t n16, float sc, size_t gtid, size_t gthreads) {
    for (size_t i = gtid; i < n16; i += gthreads) { const float* s = src + i * 16; u32x4 o;
        o.x = pk_fp8x4(*(const f32x4*)(s), sc); o.y = pk_fp8x4(*(const f32x4*)(s + 4), sc); o.z = pk_fp8x4(*(const f32x4*)(s + 8), sc); o.w = pk_fp8x4(*(const f32x4*)(s + 12), sc);
        *(u32x4*)(dst + i * 16) = o; }
}
__device__ __forceinline__ float wave_max(float v) {
#pragma unroll
    for (int o = 32; o > 0; o >>= 1) v = fmaxf(v, __shfl_xor(v, o));
    return v;
}
__device__ __forceinline__ unsigned pk_i8x4(f32x4 v, float sc) {
    const int a = (int)__builtin_rintf(v[0] * sc), b = (int)__builtin_rintf(v[1] * sc), c = (int)__builtin_rintf(v[2] * sc), d = (int)__builtin_rintf(v[3] * sc);
    return (unsigned)(a & 255) | ((unsigned)(b & 255) << 8) | ((unsigned)(c & 255) << 16) | ((unsigned)d << 24);
}
__device__ __forceinline__ void cvt_i8_rows(const float* src, unsigned char* dst, float* RS, size_t n16, size_t gtid, size_t gthreads) {
    for (size_t i = gtid; i < n16; i += gthreads) { const float* s_ = src + i * 16;
        const f32x4 a = *(const f32x4*)(s_), b = *(const f32x4*)(s_ + 4), c = *(const f32x4*)(s_ + 8), d = *(const f32x4*)(s_ + 12);
        float m = fmaxf(fmaxf(fmaxf(fabsf(a[0]), fabsf(a[1])), fmaxf(fabsf(a[2]), fabsf(a[3]))), fmaxf(fmaxf(fabsf(b[0]), fabsf(b[1])), fmaxf(fabsf(b[2]), fabsf(b[3]))));
        m = fmaxf(m, fmaxf(fmaxf(fmaxf(fabsf(c[0]), fabsf(c[1])), fmaxf(fabsf(c[2]), fabsf(c[3]))), fmaxf(fmaxf(fabsf(d[0]), fabsf(d[1])), fmaxf(fabsf(d[2]), fabsf(d[3])))));
        m = wave_max(m); const float sc = m > 0.f ? 127.0f / m : 0.f;
        u32x4 o; o.x = pk_i8x4(a, sc); o.y = pk_i8x4(b, sc); o.z = pk_i8x4(c, sc); o.w = pk_i8x4(d, sc);
        *(u32x4*)(dst + i * 16) = o;
        if ((i & 63) == 0) RS[i >> 6] = m * (1.0f / 127.0f); }
}
__device__ __forceinline__ void cvt_fp4_rows(const float* src, unsigned char* dst, float* VS, size_t n16, size_t gtid, size_t gthreads) {
    for (size_t i = gtid; i < n16; i += gthreads) { const float* s_ = src + i * 16;
        const f32x4 a = *(const f32x4*)(s_), b = *(const f32x4*)(s_ + 4), c = *(const f32x4*)(s_ + 8), d = *(const f32x4*)(s_ + 12);
        float m = fmaxf(fmaxf(fmaxf(fabsf(a[0]), fabsf(a[1])), fmaxf(fabsf(a[2]), fabsf(a[3]))), fmaxf(fmaxf(fabsf(b[0]), fabsf(b[1])), fmaxf(fabsf(b[2]), fabsf(b[3]))));
        m = fmaxf(m, fmaxf(fmaxf(fmaxf(fabsf(c[0]), fabsf(c[1])), fmaxf(fabsf(c[2]), fabsf(c[3]))), fmaxf(fmaxf(fabsf(d[0]), fabsf(d[1])), fmaxf(fabsf(d[2]), fabsf(d[3])))));
        m = wave_max(m); const float sc = m > 0.f ? 6.0f / m : 0.f;
        unsigned w0 = 0u, w1 = 0u;
        w0 = __builtin_amdgcn_cvt_scalef32_pk_fp4_f32(w0, a[0] * sc, a[1] * sc, 1.0f, 0); w0 = __builtin_amdgcn_cvt_scalef32_pk_fp4_f32(w0, a[2] * sc, a[3] * sc, 1.0f, 1);
        w0 = __builtin_amdgcn_cvt_scalef32_pk_fp4_f32(w0, b[0] * sc, b[1] * sc, 1.0f, 2); w0 = __builtin_amdgcn_cvt_scalef32_pk_fp4_f32(w0, b[2] * sc, b[3] * sc, 1.0f, 3);
        w1 = __builtin_amdgcn_cvt_scalef32_pk_fp4_f32(w1, c[0] * sc, c[1] * sc, 1.0f, 0); w1 = __builtin_amdgcn_cvt_scalef32_pk_fp4_f32(w1, c[2] * sc, c[3] * sc, 1.0f, 1);
        w1 = __builtin_amdgcn_cvt_scalef32_pk_fp4_f32(w1, d[0] * sc, d[1] * sc, 1.0f, 2); w1 = __builtin_amdgcn_cvt_scalef32_pk_fp4_f32(w1, d[2] * sc, d[3] * sc, 1.0f, 3);
        u32x2 o; o.x = w0; o.y = w1; *(u32x2*)(dst + i * 8) = o;
        if ((i & 63) == 0) VS[i >> 6] = m * (1.0f / 6.0f); }
}
__device__ __forceinline__ void phase_cvt(const Params& p, int l) {
    const size_t gtid = (size_t)bid_l() * 512 + tid_l(), gth = (size_t)grid_l() * 512;
    cvt_bf16_stream(p.p + (size_t)l * T * 256, (bf16*)(p.ws + WS_PB), (size_t)T * 256 / 8, gtid, gth);
    cvt_i8_rows(p.peer_u + (size_t)l * NEXP * D, p.ws + WS_U, (float*)(p.ws + WS_RS), (size_t)NEXP * D / 16, gtid, gth);
    cvt_fp4_rows(p.peer_v + (size_t)l * NEXP * D, p.ws + WS_V, (float*)(p.ws + WS_VS), (size_t)NEXP * D / 16, gtid, gth);
}

#define GEMM_RUN(EPI, e, Aptr, Bptr, N_, K_) do { int kk_ = (K_); asm volatile("" : "+s"(kk_)); pg8::Gemm g{(const pg8::bf16_t*)(Aptr), (const pg8::bf16_t*)(Bptr), T, (N_), kk_}; pg8::StaticOrder S; S.init(T, (N_), (int)grid_l(), (int)bid_l()); \
    pg8::gemm_phase<EPI, pg8::StaticOrder, true, true>((PG8_LAS unsigned char*)lds, g, S, e); } while (0)

__device__ __forceinline__ void phase_gemm_in(const Params& p, int l, unsigned char* lds) {
    pg8::EpiBf16<0> e{(pg8::bf16_t*)(p.ws + WS_H), HCOLS, nullptr, 0, 0, 1.f};
    GEMM_RUN(pg8::EpiBf16<0>, e, p.ws + WS_XB, (bf16*)(p.ws + WS_WIN) + (size_t)l * HCOLS * D, HCOLS, D);
}
__device__ __forceinline__ void phase_gemm_e(const Params& p, int l, unsigned char* lds) {
    pg8::EpiBf16<0> e{(pg8::bf16_t*)(p.ws + WS_E), D, nullptr, 0, 0, 1.f};
    GEMM_RUN(pg8::EpiBf16<0>, e, p.ws + WS_PB, (bf16*)(p.ws + WS_PW) + (size_t)l * D * 256, D, 256);
}
__device__ __forceinline__ void phase_gemm_out(const Params& p, int l, unsigned char* lds) {
    pg8::EpiResid e{(const pg8::bf16_t*)(p.ws + WS_XB), (_Float16*)(p.ws + WS_Y), D, ALPHA};
    GEMM_RUN(pg8::EpiResid, e, p.ws + WS_MIX, (bf16*)(p.ws + WS_WOUT) + (size_t)l * D * D, D, D);
}
__device__ __forceinline__ void phase_gemm_sc(const Params& p, int l, unsigned char* lds) {
    pg8::EpiF16 e{(_Float16*)(p.ws + WS_SC), 2048};
    GEMM_RUN(pg8::EpiF16, e, p.ws + WS_XB, (bf16*)(p.ws + WS_WP) + (size_t)l * 2048 * D, 2048, D);
}
__device__ __forceinline__ void phase_gemm_ple(const Params& p, int l, unsigned char* lds) {
    pg8::EpiPle e{(const pg8::bf16_t*)(p.ws + WS_XB), (_Float16*)(p.ws + WS_Y), (const pg8::bf16_t*)(p.ws + WS_E), p.ple_gb + (size_t)l * D, D};
    GEMM_RUN(pg8::EpiPle, e, p.ws + WS_XB, (bf16*)(p.ws + WS_PGW) + (size_t)l * D * D, D, D);
}

__device__ __forceinline__ void phase_conv(const Params& p, int l, unsigned char* lds) {
    const int tid = tid_l(), lane = tid & 63, wave = tid >> 6;
    float* U = (float*)lds;
    float* Yt = U + 62 * 256;
    const bf16* H = (const bf16*)(p.ws + WS_H); bf16* MIX = (bf16*)(p.ws + WS_MIX);
    const float* cw = p.conv_w + (size_t)l * 31 * 256; const float* cb = p.conv_b + l * 256;
    const float* lg = p.conv_ln_g + l * 256; const float* lb = p.conv_ln_b + l * 256;
    for (int it = bid_l(); it < T / 32; it += grid_l()) {
        const int b = it / (SEQ / 32), t0 = (it % (SEQ / 32)) * 32;
        __syncthreads();
        for (int i = tid; i < 62 * 32; i += 512) { const int r = i >> 5, c8 = (i & 31) * 8, t = t0 - 30 + r; f32x4 u0 = {0.f, 0.f, 0.f, 0.f}, u1 = {0.f, 0.f, 0.f, 0.f};
            if (t >= 0) { const bf16* hr = H + (size_t)(b * SEQ + t) * HCOLS; const u32x4 av = *(const u32x4*)(hr + HC_AVAL + c8), gv = *(const u32x4*)(hr + HC_AGATE + c8);
#pragma unroll
                for (int j = 0; j < 2; ++j) { u0[2 * j] = bf2f(av[j] & 0xffffu) * sigmoidf_(bf2f(gv[j] & 0xffffu)); u0[2 * j + 1] = __uint_as_float(av[j] & 0xffff0000u) * sigmoidf_(__uint_as_float(gv[j] & 0xffff0000u));
                                              u1[2 * j] = bf2f(av[2 + j] & 0xffffu) * sigmoidf_(bf2f(gv[2 + j] & 0xffffu)); u1[2 * j + 1] = __uint_as_float(av[2 + j] & 0xffff0000u) * sigmoidf_(__uint_as_float(gv[2 + j] & 0xffff0000u)); } }
            *(f32x4*)(U + r * 256 + c8) = u0; *(f32x4*)(U + r * 256 + c8 + 4) = u1; }
        __syncthreads();
        { const int c = tid & 255, half = tid >> 8; float w[31], win[46];
#pragma unroll
          for (int j = 0; j < 31; ++j) w[j] = cw[j * 256 + c];
#pragma unroll
          for (int j = 0; j < 46; ++j) win[j] = U[(half * 16 + j) * 256 + c];
          const float bias = cb[c];
#pragma unroll
          for (int tl = 0; tl < 16; ++tl) { float y = bias;
#pragma unroll
              for (int j = 0; j < 31; ++j) y += w[j] * win[tl + j];
              Yt[(half * 16 + tl) * 256 + c] = y; } }
        __syncthreads();
        for (int tl = wave * 4; tl < wave * 4 + 4; ++tl) {
            const f32x4 v = *(const f32x4*)(Yt + tl * 256 + lane * 4);
            const float mean = wave_sum((v[0] + v[1]) + (v[2] + v[3])) * (1.f / 256.f);
            const f32x4 d = v - mean; const float var = wave_sum((d[0] * d[0] + d[1] * d[1]) + (d[2] * d[2] + d[3] * d[3])) * (1.f / 256.f);
            const float rstd = 1.0f / sqrtf(var + LN_EPS);
            const f32x4 g4 = *(const f32x4*)(lg + lane * 4), b4 = *(const f32x4*)(lb + lane * 4);
            float o[4];
#pragma unroll
            for (int i = 0; i < 4; ++i) { const float z = d[i] * rstd * g4[i] + b4[i]; o[i] = z * sigmoidf_(z); }
            u32x2 w2; w2.x = pk2(o[0], o[1]); w2.y = pk2(o[2], o[3]);
            *(u32x2*)(MIX + (size_t)(b * SEQ + t0 + tl) * D + MC_A + lane * 4) = w2;
        }
    }
}

__device__ __forceinline__ void phase_fox_cum(const Params& p, int l, unsigned char* lds) {
    const int tid = tid_l(), lane = tid & 63, wave = tid >> 6;
    float* wsum = (float*)lds;
    const bf16* H = (const bf16*)(p.ws + WS_H); float* CK = (float*)(p.ws + WS_CK);
    for (int bh = bid_l(); bh < 48; bh += grid_l()) {
        const int b = bh / 6, h = bh % 6; const float bias = p.fox_forget_b[l * 6 + h];
        float v[8]; float s = 0.f;
#pragma unroll
        for (int i = 0; i < 8; ++i) { const float f = bf2f(H[(size_t)(b * SEQ + tid * 8 + i) * HCOLS + HC_CF + h]); s += log_sigmoid(f + bias) * LOG2E; v[i] = s; }
        float incl = s;
#pragma unroll
        for (int o = 1; o < 64; o <<= 1) { const float n = __shfl_up(incl, o); if (lane >= o) incl += n; }
        __syncthreads();
        if (lane == 63) wsum[wave] = incl;
        __syncthreads();
        float base = incl - s;
        for (int w = 0; w < wave; ++w) base += wsum[w];
#pragma unroll
        for (int i = 0; i < 8; ++i) CK[(size_t)bh * SEQ + tid * 8 + i] = base + v[i];
    }
}

__device__ __forceinline__ void phase_fox_norm(const Params& p, unsigned char* lds) {
    const int tid = tid_l(), lane = tid & 63, wave = tid >> 6;
    float* qns = (float*)lds; float* kns = qns + 256;
    const bf16* H = (const bf16*)(p.ws + WS_H); float* KT = (float*)(p.ws + WS_FKT); float* QBM = (float*)(p.ws + WS_FQB);
    for (int it = bid_l(); it < 48 * 16; it += grid_l()) {
        const int bh = it >> 4, qb = it & 15, b = bh / 6, h = bh % 6;
        __syncthreads();
        if (tid < 256) { const bf16* row = H + ((size_t)b * SEQ + qb * 256 + tid) * HCOLS + h * 64; float sq = 0.f, sk = 0.f;
#pragma unroll
            for (int j = 0; j < 8; ++j) { const u32x4 qv = *(const u32x4*)(row + HC_CQ + 8 * j), kv = *(const u32x4*)(row + HC_CK + 8 * j);
#pragma unroll
                for (int i = 0; i < 4; ++i) { const float a0 = bf2f(qv[i] & 0xffffu), a1 = __uint_as_float(qv[i] & 0xffff0000u), b0 = bf2f(kv[i] & 0xffffu), b1 = __uint_as_float(kv[i] & 0xffff0000u);
                    sq += a0 * a0 + a1 * a1; sk += b0 * b0 + b1 * b1; } }
            qns[tid] = sqrtf(sq); kns[tid] = sqrtf(sk); }
        __syncthreads();
        if (wave < 5) { float v = wave < 4 ? kns[wave * 64 + lane] : fmaxf(fmaxf(qns[lane], qns[64 + lane]), fmaxf(qns[128 + lane], qns[192 + lane]));
#pragma unroll
            for (int o = 1; o < 64; o <<= 1) v = fmaxf(v, __shfl_xor(v, o));
            if (lane == 0) { if (wave < 4) KT[bh * 64 + 4 * qb + wave] = v; else QBM[bh * 16 + qb] = v; } }
    }
}

typedef short bf16x8_t __attribute__((ext_vector_type(8)));
typedef float f32x16_t __attribute__((ext_vector_type(16)));
__device__ __forceinline__ int crow32(int r, int hi) { return (r & 3) + 8 * (r >> 2) + 4 * hi; }
struct GlaB1Pre { u32x4 vv, lr0, lr1; u32x2 kk; float w2v, b2v; };
__device__ __forceinline__ GlaB1Pre gla_b1_load(const Params& p, int l, int it, int tid, int lane, int wave) {
    const int bh = it >> 6, n = it & 63, b = bh / 6, h = bh % 6; const size_t tok0 = (size_t)b * SEQ + n * 64; const bf16* H = (const bf16*)(p.ws + WS_H);
    GlaB1Pre r; r.w2v = p.gla_gate_w[(size_t)l * 16 * 192 + (tid >> 5) * 192 + h * 32 + (tid & 31)]; r.b2v = p.gla_gate_b[l * 192 + h * 32 + (tid & 31)];
    r.vv = *(const u32x4*)(H + (tok0 + (tid >> 3)) * HCOLS + HC_BV + h * 64 + (tid & 7) * 8);
    r.lr0 = *(const u32x4*)(H + (tok0 + lane) * HCOLS + HC_LR); r.lr1 = *(const u32x4*)(H + (tok0 + lane) * HCOLS + HC_LR + 8);
    r.kk = *(const u32x2*)(H + (tok0 + lane) * HCOLS + HC_BK + h * 32 + wave * 4);
    return r;
}
__device__ __forceinline__ void phase_gla_b1(const Params& p, int l, unsigned char* lds) {
    const int tid = tid_l(), lane = tid & 63, wave = tid >> 6, r32 = lane & 31, hi = lane >> 5;
    bf16* KDT = (bf16*)lds;
    bf16* VT = KDT + 32 * 72;
    float* w2s = (float*)(VT + 64 * 72);
    float* b2s = w2s + 16 * 32;
    float* GCUM = (float*)(p.ws + WS_GCUM); float* GS = (float*)(p.ws + WS_GS); float* GDEC = (float*)(p.ws + WS_GDEC);
    const int NI = 48 * 64, G = grid_l(); int it = bid_l();
    if (it >= NI) return;
    GlaB1Pre cur = gla_b1_load(p, l, it, tid, lane, wave);
#pragma unroll 1
    for (; it < NI; it += G) {
        const GlaB1Pre nxt = gla_b1_load(p, l, it + G < NI ? it + G : it, tid, lane, wave);
        __builtin_amdgcn_sched_barrier(0);
        const int bh = it >> 6, n = it & 63, b = bh / 6, h = bh % 6; const size_t tok0 = (size_t)b * SEQ + n * 64;
        __syncthreads();
        w2s[tid] = cur.w2v;
        if (tid < 32) b2s[tid] = cur.b2v;
        { const int s_ = tid >> 3, e0 = (tid & 7) * 8;
#pragma unroll
          for (int i = 0; i < 4; ++i) { VT[(e0 + 2 * i) * 72 + s_] = (bf16)(cur.vv[i] & 0xffffu); VT[(e0 + 2 * i + 1) * 72 + s_] = (bf16)(cur.vv[i] >> 16); } }
        const int d0 = wave * 4;
        __syncthreads();
        float lrf[16];
#pragma unroll
        for (int i = 0; i < 4; ++i) { lrf[2 * i] = bf2f(cur.lr0[i] & 0xffffu); lrf[2 * i + 1] = __uint_as_float(cur.lr0[i] & 0xffff0000u); lrf[8 + 2 * i] = bf2f(cur.lr1[i] & 0xffffu); lrf[8 + 2 * i + 1] = __uint_as_float(cur.lr1[i] & 0xffff0000u); }
        float g[4];
#pragma unroll
        for (int dd = 0; dd < 4; ++dd) { float x = b2s[d0 + dd];
#pragma unroll
            for (int r = 0; r < 16; ++r) x += lrf[r] * w2s[r * 32 + d0 + dd];
            g[dd] = log_sigmoid(x) * (1.0f / 16.0f); }
#pragma unroll
        for (int o = 1; o < 64; o <<= 1)
#pragma unroll
            for (int dd = 0; dd < 4; ++dd) { const float v = __shfl_up(g[dd], o); if (lane >= o) g[dd] += v; }
        *(f32x4*)(GCUM + (tok0 + lane) * 192 + h * 32 + d0) = (f32x4){g[0], g[1], g[2], g[3]};
        const float kf[4] = {bf2f(cur.kk.x & 0xffffu), __uint_as_float(cur.kk.x & 0xffff0000u), bf2f(cur.kk.y & 0xffffu), __uint_as_float(cur.kk.y & 0xffff0000u)};
#pragma unroll
        for (int dd = 0; dd < 4; ++dd) { const float last = __uint_as_float(__builtin_amdgcn_readlane(__float_as_uint(g[dd]), 63));
            KDT[(d0 + dd) * 72 + lane] = (bf16)f2bf(kf[dd] * __expf(last - g[dd]));
            if (lane == 63) GDEC[(size_t)it * 32 + d0 + dd] = __expf(last); }
        __syncthreads();
        if (wave < 2) {
            f32x16_t acc = {};
#pragma unroll
            for (int ks = 0; ks < 4; ++ks) { const bf16x8_t a = *(const bf16x8_t*)(KDT + r32 * 72 + 16 * ks + 8 * hi), bb = *(const bf16x8_t*)(VT + (32 * wave + r32) * 72 + 16 * ks + 8 * hi);
                acc = __builtin_amdgcn_mfma_f32_32x32x16_bf16(a, bb, acc, 0, 0, 0); }
#pragma unroll
            for (int r = 0; r < 16; ++r) GS[(size_t)it * 2048 + crow32(r, hi) * 64 + 32 * wave + r32] = acc[r];
        }
        cur = nxt;
    }
}
__device__ __forceinline__ void phase_gla_b2(const Params& p) {
    float* GS = (float*)(p.ws + WS_GS); const float* GDEC = (const float*)(p.ws + WS_GDEC);
    for (int g = bid_l() * 512 + tid_l(); g < 48 * 2048; g += grid_l() * 512) {
        const int bh = g >> 11, de = g & 2047, d = de >> 6; float S = 0.f;
        float* gs = GS + (size_t)bh * 64 * 2048 + de; const float* gd = GDEC + (size_t)bh * 64 * 32 + d;
#pragma unroll 1
        for (int n0 = 0; n0 < 64; n0 += 16) { float loc[16], dec[16];
#pragma unroll
            for (int i = 0; i < 16; ++i) { loc[i] = gs[(size_t)(n0 + i) * 2048]; dec[i] = gd[(n0 + i) * 32]; }
#pragma unroll
            for (int i = 0; i < 16; ++i) { gs[(size_t)(n0 + i) * 2048] = S; S = S * dec[i] + loc[i]; } }
    }
}
struct GlaB3Pre { u32x2 qq, kk; f32x4 c; u32x4 vv; f32x4 sv; u32x4 gr; };
__device__ __forceinline__ GlaB3Pre gla_b3_load(const Params& p, int it, int tid) {
    const int bh = it >> 6, n = it & 63, b = bh / 6, h = bh % 6; const size_t tok0 = (size_t)b * SEQ + n * 64; const bf16* H = (const bf16*)(p.ws + WS_H);
    const float* GCUM = (const float*)(p.ws + WS_GCUM); const float* GS = (const float*)(p.ws + WS_GS);
    GlaB3Pre r; const int t = tid >> 3, d0 = (tid & 7) * 4;
    r.qq = *(const u32x2*)(H + (tok0 + t) * HCOLS + HC_BQ + h * 32 + d0); r.kk = *(const u32x2*)(H + (tok0 + t) * HCOLS + HC_BK + h * 32 + d0);
    r.c = *(const f32x4*)(GCUM + (tok0 + t) * 192 + h * 32 + d0);
    r.vv = *(const u32x4*)(H + (tok0 + t) * HCOLS + HC_BV + h * 64 + (tid & 7) * 8);
    r.sv = *(const f32x4*)(GS + (size_t)it * 2048 + (tid >> 4) * 64 + (tid & 15) * 4);
    r.gr = *(const u32x4*)(H + (tok0 + t) * HCOLS + HC_BG + h * 64 + (tid & 7) * 8);
    return r;
}
__device__ __forceinline__ void phase_gla_b3(const Params& p, int l, unsigned char* lds) {
    const int tid = tid_l(), lane = tid & 63, wave = tid >> 6, r32 = lane & 31, hi = lane >> 5;
    bf16* QE = (bf16*)lds;
    bf16* KE = QE + 64 * 40;
    bf16* VT = KE + 64 * 40;
    bf16* ST = VT + 64 * 72;
    bf16* P = ST + 64 * 40;
    float* O = (float*)(P + 64 * 72);
    bf16* MIX = (bf16*)(p.ws + WS_MIX);
    const int NI = 48 * 64, G = grid_l(); int it = bid_l();
    if (it >= NI) return;
    GlaB3Pre cur = gla_b3_load(p, it, tid);
#pragma unroll 1
    for (; it < NI; it += G) {
        const GlaB3Pre nxt = gla_b3_load(p, it + G < NI ? it + G : it, tid);
        __builtin_amdgcn_sched_barrier(0);
        const int bh = it >> 6, n = it & 63, b = bh / 6, h = bh % 6; const size_t tok0 = (size_t)b * SEQ + n * 64;
        __syncthreads();
        { const int t = tid >> 3, d0 = (tid & 7) * 4; const u32x2 qq = cur.qq, kk = cur.kk; const f32x4 c = cur.c;
          const float e0 = __expf(c[0]), e1 = __expf(c[1]), e2 = __expf(c[2]), e3 = __expf(c[3]);
          u32x2 qo, ko;
          qo.x = pk2(bf2f(qq.x & 0xffffu) * e0, __uint_as_float(qq.x & 0xffff0000u) * e1); qo.y = pk2(bf2f(qq.y & 0xffffu) * e2, __uint_as_float(qq.y & 0xffff0000u) * e3);
          ko.x = pk2(bf2f(kk.x & 0xffffu) / e0, __uint_as_float(kk.x & 0xffff0000u) / e1); ko.y = pk2(bf2f(kk.y & 0xffffu) / e2, __uint_as_float(kk.y & 0xffff0000u) / e3);
          *(u32x2*)(QE + t * 40 + d0) = qo; *(u32x2*)(KE + t * 40 + d0) = ko; }
        { const int s_ = tid >> 3, e0 = (tid & 7) * 8;
#pragma unroll
          for (int i = 0; i < 4; ++i) { VT[(e0 + 2 * i) * 72 + s_] = (bf16)(cur.vv[i] & 0xffffu); VT[(e0 + 2 * i + 1) * 72 + s_] = (bf16)(cur.vv[i] >> 16); } }
        { const int d = tid >> 4, e0 = (tid & 15) * 4;
#pragma unroll
          for (int i = 0; i < 4; ++i) ST[(e0 + i) * 40 + d] = (bf16)f2bf(cur.sv[i]); }
        __syncthreads();
        f32x16_t acc = {};
        const int tt = (wave & 3) >> 1, tc = wave & 1;
        if (wave < 4) {
            if (!(tt == 0 && tc == 1)) {
#pragma unroll
                for (int ks = 0; ks < 2; ++ks) { const bf16x8_t a = *(const bf16x8_t*)(QE + (32 * tt + r32) * 40 + 16 * ks + 8 * hi), bb = *(const bf16x8_t*)(KE + (32 * tc + r32) * 40 + 16 * ks + 8 * hi);
                    acc = __builtin_amdgcn_mfma_f32_32x32x16_bf16(a, bb, acc, 0, 0, 0); }
#pragma unroll
                for (int r = 0; r < 16; ++r) { const int trow = 32 * tt + crow32(r, hi), scol = 32 * tc + r32; P[trow * 72 + scol] = (bf16)f2bf(scol <= trow ? acc[r] : 0.f); }
            }
        } else {
#pragma unroll
            for (int ks = 0; ks < 2; ++ks) { const bf16x8_t a = *(const bf16x8_t*)(QE + (32 * tt + r32) * 40 + 16 * ks + 8 * hi), bb = *(const bf16x8_t*)(ST + (32 * tc + r32) * 40 + 16 * ks + 8 * hi);
                acc = __builtin_amdgcn_mfma_f32_32x32x16_bf16(a, bb, acc, 0, 0, 0); }
        }
        __syncthreads();
        if (wave >= 4) {
            const int nks = tt == 0 ? 2 : 4;
            for (int ks = 0; ks < nks; ++ks) { const bf16x8_t a = *(const bf16x8_t*)(P + (32 * tt + r32) * 72 + 16 * ks + 8 * hi), bb = *(const bf16x8_t*)(VT + (32 * tc + r32) * 72 + 16 * ks + 8 * hi);
                acc = __builtin_amdgcn_mfma_f32_32x32x16_bf16(a, bb, acc, 0, 0, 0); }
#pragma unroll
            for (int r = 0; r < 16; ++r) O[(32 * tt + crow32(r, hi)) * 65 + 32 * tc + r32] = acc[r];
        }
        __syncthreads();
        { const int t = tid >> 3, e0 = (tid & 7) * 8; float o[8]; float ss = 0.f;
#pragma unroll
          for (int i = 0; i < 8; ++i) { o[i] = O[t * 65 + e0 + i]; ss += o[i] * o[i]; }
          ss += __shfl_xor(ss, 1); ss += __shfl_xor(ss, 2); ss += __shfl_xor(ss, 4);
          const float rs = 1.0f / sqrtf(ss * (1.f / 64.f) + LN_EPS);
          const float* ng = p.gla_norm_g + l * 384 + h * 64 + e0; const u32x4 gr = cur.gr;
          float r[8];
#pragma unroll
          for (int i = 0; i < 4; ++i) { const float ga = bf2f(gr[i] & 0xffffu), gb = __uint_as_float(gr[i] & 0xffff0000u);
              r[2 * i] = o[2 * i] * rs * ng[2 * i] * (ga * sigmoidf_(ga)); r[2 * i + 1] = o[2 * i + 1] * rs * ng[2 * i + 1] * (gb * sigmoidf_(gb)); }
          u32x4 w; w.x = pk2(r[0], r[1]); w.y = pk2(r[2], r[3]); w.z = pk2(r[4], r[5]); w.w = pk2(r[6], r[7]);
          *(u32x4*)(MIX + (tok0 + t) * D + MC_B + h * 64 + e0) = w; }
        cur = nxt;
    }
}

constexpr int LDSQ_OFF = LDS_BYTES - 1024;
constexpr int CW_ATTNQ = 8192;
__device__ __forceinline__ void phase_fox_mfma(const Params& p, int l, unsigned char* lds) {
    const attn_body::bf16* H = (const attn_body::bf16*)(p.ws + WS_H);
    const attn_body::AttnTensors AT{H + HC_CQ, H + HC_CK, H + HC_CV, (attn_body::bf16*)(p.ws + WS_MIX) + MC_C, (const float*)(p.ws + WS_CK), (const float*)(p.ws + WS_FKT), (const float*)(p.ws + WS_FQB)};
    const attn_body::QueueOrder S{(unsigned*)(p.ws + WS_CTL) + CW_ATTNQ + l * 64, (volatile __attribute__((address_space(3))) int*)((__attribute__((address_space(3))) unsigned char*)lds + LDSQ_OFF)};
    attn_body::attn_phase<attn_body::QueueOrder>((char*)lds, AT, S);
}

__device__ __forceinline__ void phase_ln(const _Float16* Y, const float* g, const float* bta, float* dst, bf16* dstb, unsigned char* xq = nullptr, float* xs = nullptr) {
    const int tid = tid_l(), lane = tid & 63, wave = tid >> 6; typedef _Float16 h4 __attribute__((ext_vector_type(4)));
    const int stride = grid_l() * 8; int row = bid_l() * 8 + wave;
    if (row >= T) return;
    h4 cur[4];
#pragma unroll
    for (int j = 0; j < 4; ++j) cur[j] = *(const h4*)(Y + (size_t)row * D + j * 256 + lane * 4);
#pragma unroll 1
    for (; row < T; row += stride) {
        h4 nxt[4]; const int nr = row + stride < T ? row + stride : row;
#pragma unroll
        for (int j = 0; j < 4; ++j) nxt[j] = *(const h4*)(Y + (size_t)nr * D + j * 256 + lane * 4);
        __builtin_amdgcn_sched_barrier(0);
        f32x4 v[4]; float s = 0.f;
#pragma unroll
        for (int j = 0; j < 4; ++j) { v[j] = (f32x4){(float)cur[j][0], (float)cur[j][1], (float)cur[j][2], (float)cur[j][3]}; s += (v[j][0] + v[j][1]) + (v[j][2] + v[j][3]); }
        const float mean = wave_sum(s) * (1.f / D); float s2 = 0.f;
#pragma unroll
        for (int j = 0; j < 4; ++j) { v[j] = v[j] - mean; s2 += (v[j][0] * v[j][0] + v[j][1] * v[j][1]) + (v[j][2] * v[j][2] + v[j][3] * v[j][3]); }
        const float rstd = 1.0f / sqrtf(wave_sum(s2) * (1.f / D) + LN_EPS);
        float am = 0.f;
#pragma unroll
        for (int j = 0; j < 4; ++j) { const f32x4 g4 = *(const f32x4*)(g + j * 256 + lane * 4), b4 = *(const f32x4*)(bta + j * 256 + lane * 4);
            const f32x4 o = v[j] * rstd * g4 + b4; v[j] = o;
            am = fmaxf(am, fmaxf(fmaxf(fabsf(o[0]), fabsf(o[1])), fmaxf(fabsf(o[2]), fabsf(o[3]))));
            if (dst) *(f32x4*)(dst + (size_t)row * D + j * 256 + lane * 4) = o;
            if (dstb) { u32x2 w; w.x = pk2(o[0], o[1]); w.y = pk2(o[2], o[3]); *(u32x2*)(dstb + (size_t)row * D + j * 256 + lane * 4) = w; } }
        if (xq) {
            am = wave_max(am); const float sc = am > 0.f ? 127.0f / am : 0.f;
#pragma unroll
            for (int j = 0; j < 4; ++j) *(unsigned*)(xq + (size_t)row * D + j * 256 + lane * 4) = pk_i8x4(v[j], sc);
            if (lane == 0) xs[row] = am * (1.0f / 127.0f); }
#pragma unroll
        for (int j = 0; j < 4; ++j) cur[j] = nxt[j];
    }
}

__device__ __forceinline__ int f2ord(float x) { const int i = __float_as_int(x); return i ^ ((i >> 31) & 0x7fffffff); }
__device__ __forceinline__ float ord2f(int k) { return __int_as_float(k ^ ((k >> 31) & 0x7fffffff)); }
__device__ __forceinline__ void phase_topk(const Params& p, unsigned char* lds) {
    const int tid = tid_l(), lane = tid & 63, wave = tid >> 6;
    unsigned char* wreg = lds + wave * 17408; unsigned char* tab = wreg;
    const _Float16* SC = (const _Float16*)(p.ws + WS_SC); int* EIDX = (int*)(p.ws + WS_EIDX); float* GATE = (float*)(p.ws + WS_GATE); unsigned long long* SOFF = (unsigned long long*)(p.ws + WS_SOFF);
    for (int g = bid_l() * 512 + tid; g < T * 16; g += grid_l() * 512) {
        const int tok = g >> 4, hc = g & 15;
        typedef _Float16 h8 __attribute__((ext_vector_type(8)));
        { const unsigned char* blk = (const unsigned char*)(SC + (size_t)(g - lane) * 128);
          u32x4 st[16];
#pragma unroll
          for (int j = 0; j < 16; ++j) st[j] = *(const u32x4*)(blk + (size_t)(j * 64 + lane) * 16);
          __builtin_amdgcn_wave_barrier();
#pragma unroll
          for (int j = 0; j < 16; ++j) { const int c = j * 64 + lane; *(u32x4*)(wreg + (c + (c >> 4)) * 16) = st[j]; }
          __builtin_amdgcn_wave_barrier(); }
        const unsigned char* lp = wreg + lane * 272;
#define TK_CE(a, b) do { const int hi_ = max(a, b), lo_ = min(a, b); a = hi_; b = lo_; } while (0)
        int tk[16];
#pragma unroll 1
        for (int gi = 0; gi < 8; ++gi) { const h8 cA = *(const h8*)(lp + gi * 32), c1_ = *(const h8*)(lp + gi * 32 + 16);
            int v[16];
#pragma unroll
            for (int j = 0; j < 8; ++j) { v[j] = (f2ord((float)cA[j]) & ~127) | (127 - (gi * 16 + j)); v[8 + j] = (f2ord((float)c1_[j]) & ~127) | (127 - (gi * 16 + 8 + j)); }
            TK_CE(v[0], v[1]); TK_CE(v[3], v[2]); TK_CE(v[4], v[5]); TK_CE(v[7], v[6]); TK_CE(v[8], v[9]); TK_CE(v[11], v[10]); TK_CE(v[12], v[13]); TK_CE(v[15], v[14]); TK_CE(v[0], v[2]); TK_CE(v[1], v[3]); TK_CE(v[6], v[4]); TK_CE(v[7], v[5]); TK_CE(v[8], v[10]); TK_CE(v[9], v[11]); TK_CE(v[14], v[12]); TK_CE(v[15], v[13]); TK_CE(v[0], v[1]); TK_CE(v[2], v[3]); TK_CE(v[5], v[4]); TK_CE(v[7], v[6]); TK_CE(v[8], v[9]); TK_CE(v[10], v[11]); TK_CE(v[13], v[12]); TK_CE(v[15], v[14]); TK_CE(v[0], v[4]); TK_CE(v[1], v[5]); TK_CE(v[2], v[6]); TK_CE(v[3], v[7]); TK_CE(v[12], v[8]); TK_CE(v[13], v[9]); TK_CE(v[14], v[10]); TK_CE(v[15], v[11]); TK_CE(v[0], v[2]); TK_CE(v[1], v[3]); TK_CE(v[4], v[6]); TK_CE(v[5], v[7]); TK_CE(v[10], v[8]); TK_CE(v[11], v[9]); TK_CE(v[14], v[12]); TK_CE(v[15], v[13]); TK_CE(v[0], v[1]); TK_CE(v[2], v[3]); TK_CE(v[4], v[5]); TK_CE(v[6], v[7]); TK_CE(v[9], v[8]); TK_CE(v[11], v[10]); TK_CE(v[13], v[12]); TK_CE(v[15], v[14]); TK_CE(v[0], v[8]); TK_CE(v[1], v[9]); TK_CE(v[2], v[10]); TK_CE(v[3], v[11]); TK_CE(v[4], v[12]); TK_CE(v[5], v[13]); TK_CE(v[6], v[14]); TK_CE(v[7], v[15]); TK_CE(v[0], v[4]); TK_CE(v[1], v[5]); TK_CE(v[2], v[6]); TK_CE(v[3], v[7]); TK_CE(v[8], v[12]); TK_CE(v[9], v[13]); TK_CE(v[10], v[14]); TK_CE(v[11], v[15]); TK_CE(v[0], v[2]); TK_CE(v[1], v[3]); TK_CE(v[4], v[6]); TK_CE(v[5], v[7]); TK_CE(v[8], v[10]); TK_CE(v[9], v[11]); TK_CE(v[12], v[14]); TK_CE(v[13], v[15]); TK_CE(v[0], v[1]); TK_CE(v[2], v[3]); TK_CE(v[4], v[5]); TK_CE(v[6], v[7]); TK_CE(v[8], v[9]); TK_CE(v[10], v[11]); TK_CE(v[12], v[13]); TK_CE(v[14], v[15]);
            if (gi == 0) {
#pragma unroll
                for (int j = 0; j < 16; ++j) tk[j] = v[j]; }
            else {
#pragma unroll
                for (int j = 0; j < 16; ++j) tk[j] = max(tk[j], v[15 - j]);
                TK_CE(tk[0], tk[8]); TK_CE(tk[1], tk[9]); TK_CE(tk[2], tk[10]); TK_CE(tk[3], tk[11]); TK_CE(tk[4], tk[12]); TK_CE(tk[5], tk[13]); TK_CE(tk[6], tk[14]); TK_CE(tk[7], tk[15]); TK_CE(tk[0], tk[4]); TK_CE(tk[1], tk[5]); TK_CE(tk[2], tk[6]); TK_CE(tk[3], tk[7]); TK_CE(tk[8], tk[12]); TK_CE(tk[9], tk[13]); TK_CE(tk[10], tk[14]); TK_CE(tk[11], tk[15]); TK_CE(tk[0], tk[2]); TK_CE(tk[1], tk[3]); TK_CE(tk[4], tk[6]); TK_CE(tk[5], tk[7]); TK_CE(tk[8], tk[10]); TK_CE(tk[9], tk[11]); TK_CE(tk[12], tk[14]); TK_CE(tk[13], tk[15]); TK_CE(tk[0], tk[1]); TK_CE(tk[2], tk[3]); TK_CE(tk[4], tk[5]); TK_CE(tk[6], tk[7]); TK_CE(tk[8], tk[9]); TK_CE(tk[10], tk[11]); TK_CE(tk[12], tk[13]); TK_CE(tk[14], tk[15]); }
            }
        __builtin_amdgcn_wave_barrier();
#undef TK_CE
        float av[16], bv[16]; int ai[16], bi[16]; const bool c1 = (hc & 1) != 0;
#pragma unroll
        for (int j = 0; j < 16; ++j) { const int ok = __shfl_xor(tk[j], 1); const int ka = c1 ? ok : tk[j], kb = c1 ? tk[j] : ok;
            av[j] = ord2f(ka & ~127); ai[j] = 127 - (ka & 127); bv[j] = ord2f(kb & ~127); bi[j] = 127 - (kb & 127); }
#pragma unroll
        for (int j = 0; j < 16; ++j) { tab[j * 64 + lane] = (unsigned char)ai[j]; tab[(16 + j) * 64 + lane] = (unsigned char)bi[j]; }
        int ck[16];
#pragma unroll
        for (int j = 0; j < 16; ++j) ck[j] = (int)0x80000000;
#pragma unroll
        for (int i = 0; i < 16; ++i)
#pragma unroll
            for (int j = 0; j < 16 / (i + 1); ++j) { int x = (f2ord(av[i] + bv[j]) & ~255) | (255 - (i * 16 + j));
#pragma unroll
                for (int q = 0; q < 16; ++q) { const int hi = max(ck[q], x); x = min(ck[q], x); ck[q] = hi; } }
        float den = 0.f; float ex[16]; const float c0 = ord2f(ck[0] & ~255);
#pragma unroll
        for (int j = 0; j < 16; ++j) { ex[j] = __expf(ord2f(ck[j] & ~255) - c0); den += ex[j]; }
        const float inv = 1.0f / den;
        int eid[16]; unsigned long long cnt = 0ull;
#pragma unroll
        for (int j = 0; j < 16; ++j) { const int flat = 255 - (ck[j] & 255); eid[j] = (int)tab[(flat >> 4) * 64 + lane] * 128 + (int)tab[(16 + (flat & 15)) * 64 + lane];
            if (!c1) cnt += 1ull << (8 * (eid[j] >> 11)); }
        unsigned long long incl = cnt;
#pragma unroll
        for (int o = 1; o < 16; o <<= 1) { const unsigned lo = __shfl_up((unsigned)incl, o, 16), hi = __shfl_up((unsigned)(incl >> 32), o, 16); if ((hc & 15) >= o) incl += ((unsigned long long)hi << 32) | lo; }
        const unsigned long long total = ((unsigned long long)__shfl((unsigned)(incl >> 32), 15, 16) << 32) | __shfl((unsigned)incl, 15, 16);
        const unsigned long long base = total * 0x0101010101010100ull;
        unsigned long long run = base + (incl - cnt);
        if (hc == 0) SOFF[tok] = base;
        if (!c1) {
#pragma unroll
            for (int j = 0; j < 16; ++j) { const int sh = 8 * (eid[j] >> 11); const int pos = (int)((run >> sh) & 0xffull); run += 1ull << sh;
                EIDX[(size_t)tok * 128 + pos] = eid[j]; GATE[(size_t)tok * 128 + pos] = ex[j] * inv; } }
    }
}

__device__ __forceinline__ float gelu_tanh(float h) { const float z = 0.7978845608028654f * (h + 0.044715f * h * h * h); const float t = 1.0f - 2.0f / (__expf(2.0f * z) + 1.0f); return 0.5f * h * (1.0f + t); }
#define LAS3 __attribute__((address_space(3)))
struct PeerTok { u32x4 xq; float xs; unsigned long long so; int e_lo, e_hi; float g_lo, g_hi; };
__device__ __forceinline__ PeerTok peer_tok_load(const unsigned char* XQ, const float* XS, const int* EIDX, const float* GATE, const unsigned long long* SOFF, int tok, int lane) {
    PeerTok t; const int tk = tok < T ? tok : T - 1;
    t.xq = __builtin_nontemporal_load((const u32x4*)(XQ + (size_t)tk * D + lane * 16)); t.xs = XS[tk];
    t.so = SOFF[tk]; t.e_lo = EIDX[(size_t)tk * 128 + lane]; t.e_hi = EIDX[(size_t)tk * 128 + 64 + lane]; t.g_lo = GATE[(size_t)tk * 128 + lane]; t.g_hi = GATE[(size_t)tk * 128 + 64 + lane];
    return t;
}
__device__ __forceinline__ void peer_slot_write(LAS3 unsigned char* sl, const PeerTok& t, int lane) {
    *(LAS3 u32x4*)(sl + lane * 16) = t.xq; *(LAS3 int*)(sl + 1024 + lane * 4) = t.e_lo; *(LAS3 int*)(sl + 1280 + lane * 4) = t.e_hi;
    *(LAS3 float*)(sl + 1536 + lane * 4) = t.g_lo; *(LAS3 float*)(sl + 1792 + lane * 4) = t.g_hi;
}
template <int CTRL> __device__ __forceinline__ float dpp_mov(float v) { return __int_as_float(__builtin_amdgcn_update_dpp(0, __float_as_int(v), CTRL, 0xf, 0xf, false)); }
template <int CTRL> __device__ __forceinline__ int dpp_movi(int v) { return __builtin_amdgcn_update_dpp(0, v, CTRL, 0xf, 0xf, false); }
__device__ __forceinline__ float gelu_tanh_fast(float h) { const float z = 0.7978845608028654f * (h + 0.044715f * h * h * h); const float t = 1.0f - 2.0f * __builtin_amdgcn_rcpf(__expf(2.0f * z) + 1.0f); return 0.5f * h * (1.0f + t); }
#define PEER_ISSUE(R, sl_, ks_, kl_) do { const int kA_ = min((ks_) + g4, (kl_)), kB_ = min((ks_) + 4 + g4, (kl_)); \
    const int eA_ = *(const LAS3 int*)((sl_) + 1024 + kA_ * 4), eB_ = *(const LAS3 int*)((sl_) + 1024 + kB_ * 4); \
    const unsigned char* pA_ = U8l + (size_t)eA_ * D; const unsigned char* pB_ = U8l + (size_t)eB_ * D; \
    _Pragma("unroll") for (int i_ = 0; i_ < 4; ++i_) { R[i_] = *(const u32x4*)(pA_ + 256 * i_); R[4 + i_] = *(const u32x4*)(pB_ + 256 * i_); } } while (0)
#define PEER_COMPUTE(RC) do { int aA_ = 0, aB_ = 0; \
    _Pragma("unroll") for (int i_ = 0; i_ < 4; ++i_) _Pragma("unroll") for (int w_ = 0; w_ < 4; ++w_) aA_ = __builtin_amdgcn_sdot4((int)RC[i_][w_], (int)xp[i_][w_], aA_, false); \
    if (k0 + 4 < end) { _Pragma("unroll") for (int i_ = 0; i_ < 4; ++i_) _Pragma("unroll") for (int w_ = 0; w_ < 4; ++w_) aB_ = __builtin_amdgcn_sdot4((int)RC[4 + i_][w_], (int)xp[i_][w_], aB_, false); } \
    else { asm volatile("" :: "v"(RC[4]), "v"(RC[5]), "v"(RC[6]), "v"(RC[7])); }     \
    aA_ += dpp_movi<0x128>(aA_); aB_ += dpp_movi<0x128>(aB_); aA_ += dpp_movi<0x124>(aA_); aB_ += dpp_movi<0x124>(aB_); \
    aA_ += dpp_movi<0x122>(aA_); aB_ += dpp_movi<0x122>(aB_); aA_ += dpp_movi<0x121>(aA_); aB_ += dpp_movi<0x121>(aB_); \
    { const int rel = (lane - k0) & 63; const int src = (rel & 3) << 6; \
      const int ga = __builtin_amdgcn_ds_bpermute(src, aA_), gb = __builtin_amdgcn_ds_bpermute(src, aB_); \
      const float gq = (float)((rel & 4) ? gb : ga); const int kq = k0 + rel;              \
      c_lo = (rel < 8 && kq < 64) ? gq : c_lo; c_hi = (rel < 8 && kq >= 64) ? gq : c_hi; } } while (0)
#define PEER_KL(st, en) min(max((en) - 1, (st)), 127)
#define PEER_NEXT(RN) do { __builtin_amdgcn_sched_barrier(0); { const bool more_ = k0 + 8 < end; const LAS3 unsigned char* sl_ = wl + ((more_ ? sc : (sc ^ 1)) << 11); \
    const int ks_ = more_ ? k0 + 8 : ns, kl_ = more_ ? PEER_KL(start, end) : PEER_KL(ns, ne); PEER_ISSUE(RN, sl_, ks_, kl_); } __builtin_amdgcn_sched_barrier(0); } while (0)
#define PEER_RANGE(slo, shi, st, en) do { const unsigned lo_ = __builtin_amdgcn_readfirstlane(slo), hi_ = __builtin_amdgcn_readfirstlane(shi); \
    const unsigned long long so_ = ((unsigned long long)hi_ << 32) | lo_; st = (int)((so_ >> (8 * g0)) & 0xffull); en = g1 < 8 ? (int)((so_ >> (8 * g1)) & 0xffull) : 128; } while (0)
#define PEER_CUR() do { const LAS3 unsigned char* cs_ = wl + (sc << 11); \
    _Pragma("unroll") for (int i_ = 0; i_ < 4; ++i_) xp[i_] = *(const LAS3 u32x4*)(cs_ + 256 * i_ + l16 * 16); \
    const int e0_ = *(const LAS3 int*)(cs_ + 1024 + lane * 4), e1_ = *(const LAS3 int*)(cs_ + 1280 + lane * 4); cg_lo = *(const LAS3 float*)(cs_ + 1536 + lane * 4); cg_hi = *(const LAS3 float*)(cs_ + 1792 + lane * 4); \
    rs_lo = RS[e0_]; rs_hi = RS[e1_]; vs_lo = VS[e0_]; vs_hi = VS[e1_]; } while (0)
#define PEER_ADVANCE() do { k0 += 8; if (k0 >= end) { \
        if (tok < T) { \
        if (lane >= start && lane < end) GATE[(size_t)tok * 128 + lane] = cg_lo * gelu_tanh_fast(c_lo * (rs_lo * xs)) * vs_lo; \
        if (lane + 64 >= start && lane + 64 < end) GATE[(size_t)tok * 128 + 64 + lane] = cg_hi * gelu_tanh_fast(c_hi * (rs_hi * xs)) * vs_hi; } \
        tok += stride; peer_slot_write(wl + (sc << 11), n2, lane); sc ^= 1; \
        start = ns; end = ne; PEER_RANGE((unsigned)n2.so, (unsigned)(n2.so >> 32), ns, ne); xs = nxs; nxs = __uint_as_float(__builtin_amdgcn_readfirstlane(__float_as_uint(n2.xs))); k0 = start; c_lo = 0.f; c_hi = 0.f; \
        PEER_CUR(); __builtin_amdgcn_sched_barrier(0); \
        n2 = peer_tok_load(XQ, XS, EIDX, GATE, SOFF, tok + 2 * stride, lane); __builtin_amdgcn_sched_barrier(0); } } while (0)
__device__ __forceinline__ void phase_peer_u(const Params& p, unsigned char* lds) {
    const int tid = tid_l(), lane = tid & 63, wave = tid >> 6, bid = bid_l(), G = grid_l(), l16 = lane & 15, g4 = lane >> 4;
    const unsigned char* XQ = p.ws + WS_XQ; const float* XS = (const float*)(p.ws + WS_XS); const float* RS = (const float*)(p.ws + WS_RS); const float* VS = (const float*)(p.ws + WS_VS); const unsigned char* U8l = p.ws + WS_U + l16 * 16;
    const int* EIDX = (const int*)(p.ws + WS_EIDX); float* GATE = (float*)(p.ws + WS_GATE); const unsigned long long* SOFF = (const unsigned long long*)(p.ws + WS_SOFF);
    const int ngrp = 1;
    const int g0 = (ngrp == 8) ? (bid & 7) : 0, g1 = (ngrp == 8) ? g0 + 1 : 8, r = (ngrp == 8) ? (bid >> 3) : bid, R = (ngrp == 8) ? (G >> 3) : G;
    const int stride = R * 8; int tok = __builtin_amdgcn_readfirstlane(r * 8 + wave);
    if (tok >= T) return;
    LAS3 unsigned char* wl = (LAS3 unsigned char*)lds + wave * 4096;
    int sc = 0, start, end, ns, ne; float xs, nxs;
    PeerTok n2;
    { const PeerTok t0 = peer_tok_load(XQ, XS, EIDX, GATE, SOFF, tok, lane), t1 = peer_tok_load(XQ, XS, EIDX, GATE, SOFF, tok + stride, lane);
      peer_slot_write(wl, t0, lane); peer_slot_write(wl + 2048, t1, lane);
      PEER_RANGE((unsigned)t0.so, (unsigned)(t0.so >> 32), start, end); PEER_RANGE((unsigned)t1.so, (unsigned)(t1.so >> 32), ns, ne); xs = __uint_as_float(__builtin_amdgcn_readfirstlane(__float_as_uint(t0.xs))); nxs = __uint_as_float(__builtin_amdgcn_readfirstlane(__float_as_uint(t1.xs))); }
    n2 = peer_tok_load(XQ, XS, EIDX, GATE, SOFF, tok + 2 * stride, lane);
    u32x4 xp[4]; float cg_lo, cg_hi, rs_lo, rs_hi, vs_lo, vs_hi;
    PEER_CUR();
    float c_lo = 0.f, c_hi = 0.f;
    int k0 = start;
    u32x4 Ra[8], Rb[8];
    PEER_ISSUE(Ra, wl, start, PEER_KL(start, end));
#pragma unroll 1
    do {
        PEER_NEXT(Rb); PEER_COMPUTE(Ra); PEER_ADVANCE();
        PEER_NEXT(Ra); PEER_COMPUTE(Rb); PEER_ADVANCE();
    } while (tok < T);
}
#undef PEER_ISSUE
#undef PEER_COMPUTE
#undef PEER_NEXT
#undef PEER_KL
#undef PEER_RANGE
#undef PEER_CUR
#undef PEER_ADVANCE
struct PeerVMeta { int e_lo, e_hi; float c_lo, c_hi; u32x4 x0, x1; };
__device__ __forceinline__ PeerVMeta peer_vmeta_load(const int* EIDX, const float* COEF, const bf16* XB, int tok, int lane) {
    PeerVMeta m;
    m.e_lo = EIDX[(size_t)tok * 128 + lane]; m.e_hi = EIDX[(size_t)tok * 128 + 64 + lane]; m.c_lo = COEF[(size_t)tok * 128 + lane]; m.c_hi = COEF[(size_t)tok * 128 + 64 + lane];
    const int xo = (lane & 31) * 32 + (lane >> 5) * 16;
    m.x0 = *(const u32x4*)(XB + (size_t)tok * D + xo); m.x1 = *(const u32x4*)(XB + (size_t)tok * D + xo + 8);
    return m;
}
#define PV_ISSUE(VR, CF, PE, PC, jj) do { _Pragma("unroll") for (int q = 0; q < 8; ++q) { const int a_ = hb + (((jj) + q) << 2); const int e_ = __builtin_amdgcn_ds_bpermute(a_, (int)(PE)); \
        CF[q] = __int_as_float(__builtin_amdgcn_ds_bpermute(a_, (int)(PC))); VR[q] = *(const u32x4*)(V4l + (size_t)e_ * 512); } __builtin_amdgcn_sched_barrier(0); } while (0)
#define PV_COMPUTE(VR, CF) do { _Pragma("unroll") for (int q = 0; q < 8; ++q) { const f32x2v c2 = (f32x2v){CF[q], CF[q]}; \
        _Pragma("unroll") for (int w = 0; w < 4; ++w) { \
            acc[4 * w] += __builtin_amdgcn_cvt_scalef32_pk_f32_fp4(VR[q][w], 1.0f, 0) * c2; acc[4 * w + 1] += __builtin_amdgcn_cvt_scalef32_pk_f32_fp4(VR[q][w], 1.0f, 1) * c2; \
            acc[4 * w + 2] += __builtin_amdgcn_cvt_scalef32_pk_f32_fp4(VR[q][w], 1.0f, 2) * c2; acc[4 * w + 3] += __builtin_amdgcn_cvt_scalef32_pk_f32_fp4(VR[q][w], 1.0f, 3) * c2; } } \
        __builtin_amdgcn_sched_barrier(0); } while (0)
__device__ __forceinline__ void phase_peer_v(const Params& p) {
    const int tid = tid_l(), lane = tid & 63, wave = tid >> 6;
    const unsigned char* V4l = p.ws + WS_V + (lane & 31) * 16;
    const int* EIDX = (const int*)(p.ws + WS_EIDX); const float* COEF = (const float*)(p.ws + WS_GATE);
    bf16* XB = (bf16*)(p.ws + WS_XB);
    const int hb = (lane & 32) << 2;
    const int xo = (lane & 31) * 32 + (lane >> 5) * 16;
    const int stride = grid_l() * 8; int tok = __builtin_amdgcn_readfirstlane(bid_l() * 8 + wave);
    if (tok >= T) return;
    PeerVMeta cur = peer_vmeta_load(EIDX, COEF, XB, tok, lane);
    auto se = __builtin_amdgcn_permlane32_swap((unsigned)cur.e_lo, (unsigned)cur.e_hi, false, false); auto sc_ = __builtin_amdgcn_permlane32_swap(__float_as_uint(cur.c_lo), __float_as_uint(cur.c_hi), false, false);
    u32x4 vrA[8], vrB[8]; float cfA[8], cfB[8];
    PV_ISSUE(vrA, cfA, se[0], sc_[0], 0);
#pragma unroll 1
    for (; tok < T; tok += stride) {
        const PeerVMeta nxt = peer_vmeta_load(EIDX, COEF, XB, tok + stride < T ? tok + stride : tok, lane);
        __builtin_amdgcn_sched_barrier(0);
        f32x2v acc[16];
#pragma unroll
        for (int i = 0; i < 16; ++i) acc[i] = (f32x2v){0.f, 0.f};
        PV_ISSUE(vrB, cfB, se[0], sc_[0], 8);  PV_COMPUTE(vrA, cfA);
        PV_ISSUE(vrA, cfA, se[0], sc_[0], 16); PV_COMPUTE(vrB, cfB);
        PV_ISSUE(vrB, cfB, se[0], sc_[0], 24); PV_COMPUTE(vrA, cfA);
        PV_ISSUE(vrA, cfA, se[1], sc_[1], 0);  PV_COMPUTE(vrB, cfB);
        PV_ISSUE(vrB, cfB, se[1], sc_[1], 8);  PV_COMPUTE(vrA, cfA);
        PV_ISSUE(vrA, cfA, se[1], sc_[1], 16); PV_COMPUTE(vrB, cfB);
        PV_ISSUE(vrB, cfB, se[1], sc_[1], 24); PV_COMPUTE(vrA, cfA);
        se = __builtin_amdgcn_permlane32_swap((unsigned)nxt.e_lo, (unsigned)nxt.e_hi, false, false); sc_ = __builtin_amdgcn_permlane32_swap(__float_as_uint(nxt.c_lo), __float_as_uint(nxt.c_hi), false, false);
        PV_ISSUE(vrA, cfA, se[0], sc_[0], 0);  PV_COMPUTE(vrB, cfB);
        float sres[16];
#pragma unroll
        for (int i = 0; i < 8; ++i)
#pragma unroll
            for (int c = 0; c < 2; ++c) { const auto r_ = __builtin_amdgcn_permlane32_swap(__float_as_uint(acc[i][c]), __float_as_uint(acc[8 + i][c]), false, false);
                sres[2 * i + c] = __uint_as_float(r_[0]) + __uint_as_float(r_[1]); }
        float r[16];
#pragma unroll
        for (int i = 0; i < 4; ++i) { r[2 * i] = ALPHA * bf2f(cur.x0[i] & 0xffffu) + sres[2 * i]; r[2 * i + 1] = ALPHA * __uint_as_float(cur.x0[i] & 0xffff0000u) + sres[2 * i + 1];
                                      r[8 + 2 * i] = ALPHA * bf2f(cur.x1[i] & 0xffffu) + sres[8 + 2 * i]; r[8 + 2 * i + 1] = ALPHA * __uint_as_float(cur.x1[i] & 0xffff0000u) + sres[8 + 2 * i + 1]; }
#pragma unroll
        for (int w = 0; w < 2; ++w) { u32x4 o; o.x = pk2(r[8 * w], r[8 * w + 1]); o.y = pk2(r[8 * w + 2], r[8 * w + 3]); o.z = pk2(r[8 * w + 4], r[8 * w + 5]); o.w = pk2(r[8 * w + 6], r[8 * w + 7]);
            *(u32x4*)(XB + (size_t)tok * D + xo + 8 * w) = o; }
        cur = nxt;
    }
}
#undef PV_ISSUE
#undef PV_COMPUTE
#define GAS __attribute__((address_space(1)))
#define LAS __attribute__((address_space(3)))
#define XB_TMO      128
#define XB_XCNT(j)  (256  + 64 * (j))
#define XB_XSUB(j)  (1280 + 64 * (j))
#define XB_XGEN(j)  (2304 + 64 * (j))
#define XB_TOP      3328
#define XB_TOPGEN   3392
#define XCD_BAR_WORDS 3456
#define XB_SPIN_CAP (1u << 18)

__device__ __forceinline__ unsigned xb_ld(unsigned* p)              { return __hip_atomic_load(p, __ATOMIC_RELAXED, __HIP_MEMORY_SCOPE_AGENT); }
__device__ __forceinline__ unsigned xb_add(unsigned* p, unsigned v) { return __hip_atomic_fetch_add(p, v, __ATOMIC_RELAXED, __HIP_MEMORY_SCOPE_AGENT); }
__device__ __forceinline__ unsigned xb_xcc_id() { return (unsigned)__builtin_amdgcn_s_getreg((3 << 11) | 20) & 0xFu; }
#define XB_SPIN(cond, bar) do { unsigned _sp = 0; while (cond) { __builtin_amdgcn_s_sleep(1); \
    if ((++_sp & 255u) == 0u) { if (xb_ld(&(bar)[XB_TMO])) break; if (_sp > XB_SPIN_CAP) { atomicAdd(&(bar)[XB_TMO], 1u); break; } } } } while (0)

struct XcdBarrier {
    unsigned* bar; unsigned x;
    volatile LAS unsigned* st;
};

__device__ __forceinline__ XcdBarrier xcd_barrier_post(unsigned* bar, volatile LAS unsigned* st) {
    XcdBarrier b; b.bar = bar; b.x = xb_xcc_id(); b.st = st;
    if (threadIdx.x == 0) (void)xb_add(&bar[XB_XCNT(b.x)], 1u);
    return b;
}
__device__ __forceinline__ void xcd_barrier_complete(unsigned* bar, unsigned x, unsigned& nloc, unsigned& nx) {
    const unsigned G = gridDim.x * gridDim.y * gridDim.z;
    unsigned sum, cnt, mine, sp = 0u;
    for (;;) {
        sum = 0u; cnt = 0u; mine = 0u;
#pragma unroll
        for (unsigned j = 0; j < 16; ++j) { const unsigned c = xb_ld(&bar[XB_XCNT(j)]); sum += c; cnt += (c > 0u) ? 1u : 0u; mine = (j == x) ? c : mine; }
        if (sum == G) break;
        __builtin_amdgcn_s_sleep(1);
        if ((++sp & 255u) == 0u) { if (xb_ld(&bar[XB_TMO])) break; if (sp > XB_SPIN_CAP) { atomicAdd(&bar[XB_TMO], 1u); break; } }
    }
    nloc = mine > 0u ? mine : 1u; nx = cnt > 0u ? cnt : 1u;
}

__device__ __forceinline__ void xcd_barrier(const XcdBarrier& b) {
    asm volatile("s_waitcnt vmcnt(0)" ::: "memory");
    __syncthreads();
    if (threadIdx.x == 0) {
        unsigned* bar = b.bar;
        __builtin_amdgcn_s_waitcnt(0);
        unsigned nloc = b.st[0], nx = b.st[1];
        if (nloc == 0u) { xcd_barrier_complete(bar, b.x, nloc, nx); b.st[0] = nloc; b.st[1] = nx; }
        const unsigned old = xb_add(&bar[XB_XSUB(b.x)], 1u);
        const unsigned gen = old / nloc;
        if (old + 1u == (gen + 1u) * nloc) {
            __builtin_amdgcn_fence(__ATOMIC_RELEASE, "agent");
            asm volatile("s_waitcnt vmcnt(0)" ::: "memory");
            const unsigned og = xb_add(&bar[XB_TOP], 1u);
            const unsigned tg = og / nx;
            if (og + 1u == (tg + 1u) * nx) xb_add(&bar[XB_TOPGEN], 1u);
            else XB_SPIN(xb_ld(&bar[XB_TOPGEN]) == tg, bar);
            __builtin_amdgcn_fence(__ATOMIC_ACQUIRE, "agent");
            xb_add(&bar[XB_XGEN(b.x)], 1u);
            asm volatile("s_waitcnt vmcnt(0)" ::: "memory");
        } else {
            XB_SPIN(xb_ld(&bar[XB_XGEN(b.x)]) == gen, bar);
            __builtin_amdgcn_fence(__ATOMIC_ACQUIRE, "agent");
            asm volatile("s_waitcnt vmcnt(0)" ::: "memory");
        }
    }
    __syncthreads();
}
enum { PH_PRO_A, PH_PRO_B, PH_CVT, PH_GEMM_IN, PH_GEMM_E, PH_CONV, PH_FOXCUM, PH_FOXNORM, PH_GLA1, PH_GLA2, PH_GLA3, PH_FOX, PH_GEMM_OUT, PH_LN1, PH_GEMM_SC, PH_TOPK, PH_PEERU, PH_PEERV, PH_GEMM_PLE, PH_LN2, PH_COUNT };

template <int PH> __device__ __forceinline__ void run_phase(const Params& p, int l, unsigned char* lds) {
    if constexpr (PH == PH_PRO_A) phase_pro_a(p, lds);
    else if constexpr (PH == PH_PRO_B) phase_pro_b(p, lds);
    else if constexpr (PH == PH_CVT) phase_cvt(p, l);
    else if constexpr (PH == PH_GEMM_IN) phase_gemm_in(p, l, lds);
    else if constexpr (PH == PH_GEMM_E) phase_gemm_e(p, l, lds);
    else if constexpr (PH == PH_CONV) phase_conv(p, l, lds);
    else if constexpr (PH == PH_FOXCUM) phase_fox_cum(p, l, lds);
    else if constexpr (PH == PH_FOXNORM) phase_fox_norm(p, lds);
    else if constexpr (PH == PH_GLA1) phase_gla_b1(p, l, lds);
    else if constexpr (PH == PH_GLA2) phase_gla_b2(p);
    else if constexpr (PH == PH_GLA3) phase_gla_b3(p, l, lds);
    else if constexpr (PH == PH_FOX) phase_fox_mfma(p, l, lds);
    else if constexpr (PH == PH_GEMM_OUT) phase_gemm_out(p, l, lds);
    else if constexpr (PH == PH_LN1) phase_ln((const _Float16*)(p.ws + WS_Y), p.ln1_g + (size_t)l * D, p.ln1_b + (size_t)l * D, nullptr, (bf16*)(p.ws + WS_XB), p.ws + WS_XQ, (float*)(p.ws + WS_XS));
    else if constexpr (PH == PH_GEMM_SC) phase_gemm_sc(p, l, lds);
    else if constexpr (PH == PH_TOPK) phase_topk(p, lds);
    else if constexpr (PH == PH_PEERU) phase_peer_u(p, lds);
    else if constexpr (PH == PH_PEERV) phase_peer_v(p);
    else if constexpr (PH == PH_GEMM_PLE) phase_gemm_ple(p, l, lds);
    else if constexpr (PH == PH_LN2) phase_ln((const _Float16*)(p.ws + WS_Y), p.ln2_g + (size_t)l * D, p.ln2_b + (size_t)l * D, l == DEPTH - 1 ? p.out : nullptr, l == DEPTH - 1 ? nullptr : (bf16*)(p.ws + WS_XB));
}

constexpr int MISC_OFF = LDS_BYTES - 512;
constexpr int CW_BAR = 4096;
static_assert(MISC_OFF + 128 <= LDS_BYTES && (CW_BAR + XCD_BAR_WORDS) * 4 <= (int)CTL_ZERO_BYTES, "control words");

typedef __attribute__((address_space(4))) const Params CParams;
#define PHASE(PH) do { CParams* q_ = pp; asm volatile("" : "+s"(q_)); Params lp_; __builtin_memcpy(&lp_, q_, sizeof(Params)); run_phase<PH>(lp_, l, lds); } while (0)
__global__ void __launch_bounds__(512, 2) mk_fwd(Params p_unused) {
#if defined(__HIP_DEVICE_COMPILE__)
    extern __shared__ __attribute__((aligned(16))) unsigned char lds[];
    CParams* pp = (CParams*)__builtin_amdgcn_kernarg_segment_ptr();
    unsigned char* ws0; { CParams* q_ = pp; asm volatile("" : "+s"(q_)); ws0 = q_->ws; }
    volatile LAS unsigned* MISC = (volatile LAS unsigned*)((LAS unsigned char*)lds + MISC_OFF);
    if (threadIdx.x < 32) MISC[threadIdx.x] = 0u;
    __syncthreads();
    (void)xcd_barrier_post((unsigned*)(ws0 + WS_CTL) + CW_BAR, MISC + 8);
#define GB() do { CParams* qb_ = pp; asm volatile("" : "+s"(qb_)); XcdBarrier b_; b_.bar = (unsigned*)(qb_->ws + WS_CTL) + CW_BAR; b_.x = xb_xcc_id(); b_.st = MISC + 8; xcd_barrier(b_); } while (0)
    { const int l = 0; PHASE(PH_PRO_A); PHASE(PH_PRO_B); } GB();
    for (int l = 0; l < DEPTH; ++l) {
        PHASE(PH_CVT); PHASE(PH_GEMM_IN); GB();
        PHASE(PH_GEMM_E); PHASE(PH_CONV); PHASE(PH_FOXCUM); PHASE(PH_FOXNORM); PHASE(PH_GLA1); GB();
        PHASE(PH_GLA2); PHASE(PH_FOX); GB();
        PHASE(PH_GLA3); GB();
        PHASE(PH_GEMM_OUT); GB();
        PHASE(PH_LN1); GB();
        PHASE(PH_GEMM_SC); GB();
        PHASE(PH_TOPK); GB();
        PHASE(PH_PEERU); GB();
        PHASE(PH_PEERV); GB();
        PHASE(PH_GEMM_PLE); GB();
        PHASE(PH_LN2); GB();
    }
#undef GB
#endif
}

extern "C" void kernel_launch(void* const* d_in, const int* in_sizes, int n_in, void* d_out, int out_size, void* d_ws, size_t ws_size, hipStream_t stream) {
    static int grid = 0;
    if (grid == 0) {
        if (n_in != 23 || ws_size < WS_END) { fprintf(stderr, "kernel_launch: unexpected n_in %d or ws_size %zu\n", n_in, ws_size); grid = -1; return; }
        int dev = 0, cus = 0, per_cu = 0;
        if (hipGetDevice(&dev) != hipSuccess || hipDeviceGetAttribute(&cus, hipDeviceAttributeMultiprocessorCount, dev) != hipSuccess) { grid = -1; return; }
        if (hipFuncSetAttribute((const void*)mk_fwd, hipFuncAttributeMaxDynamicSharedMemorySize, LDS_BYTES) != hipSuccess) { grid = -1; return; }
        if (hipOccupancyMaxActiveBlocksPerMultiprocessor(&per_cu, (const void*)mk_fwd, 512, LDS_BYTES) != hipSuccess || per_cu < 1) { fprintf(stderr, "kernel_launch: occupancy query says %d\n", per_cu); }
        (void)hipGetLastError();
        grid = cus;
    }
    if (grid < 0) return;
    if (hipMemsetAsync((char*)d_ws + WS_CTL, 0, CTL_ZERO_BYTES, stream) != hipSuccess) return;
    Params p; memset(&p, 0, sizeof(p));
    const float** f = (const float**)&p;
    for (int i = 0; i < 23; ++i) f[i] = (const float*)d_in[i];
    p.out = (float*)d_out; p.ws = (unsigned char*)d_ws;
    hipLaunchKernelGGL(mk_fwd, dim3(grid), dim3(512), LDS_BYTES, stream, p);
}
```

```cpp
#include <hip/hip_runtime.h>
#include <cstdio>
#include <cstdint>
#include <cstring>
#include <cmath>
__device__ __forceinline__ int tid_l() { int t = threadIdx.x; asm volatile("" : "+v"(t)); return t; }
__device__ __forceinline__ int bid_l() { int b = blockIdx.x; asm volatile("" : "+s"(b)); return b; }
__device__ __forceinline__ int grid_l() { int g = gridDim.x; asm volatile("" : "+s"(g)); return g; }
namespace pg8 {
#define PG8_LAS __attribute__((address_space(3)))
typedef unsigned short bf16_t;
typedef short bf16x8 __attribute__((ext_vector_type(8)));
typedef float f32x4 __attribute__((ext_vector_type(4)));
typedef unsigned u32x4 __attribute__((ext_vector_type(4)));
constexpr int BM = 256, BK = 64, HALF = 128, HTB = HALF * BK * 2  , STAGE_BYTES = 8 * HTB, NXCD = 8, WGM = 8;

__host__ __device__ __forceinline__ int lds_byte(int r, int c) { const int st = (r >> 4) * 2 + (c >> 5), rr = r & 15, cc = c & 31, ob = rr * 64 + cc * 2; return st * 1024 + (ob ^ (((ob >> 9) & 1) << 5)); }
__host__ __device__ __forceinline__ void stage_rc(int b, int& R, int& C) { const int st = b / 1024, sb = b % 1024, swz = sb ^ (((sb >> 9) & 1) << 5); R = (st >> 1) * 16 + swz / 64; C = (st & 1) * 32 + (swz % 64) / 2; }
__host__ __device__ __forceinline__ int perm32(int rho) { const int n = rho >> 4, i = rho & 15; return 8 * (i >> 2) + 4 * n + (i & 3); }

struct Unit { int pm, pn; };
struct Gemm { const bf16_t* A; const bf16_t* Bt; int M, N, K; };

struct StaticOrder {
    int nM, nN, nwg, G, c;
    __host__ __device__ void init(int M, int N, int G_, int c_) { nM = M / BM; nN = N / BM; nwg = nM * nN; G = G_; c = c_; }
    __host__ __device__ bool next(int i, Unit& u) const {
        const long L = (long)i * G + c; if (L >= nwg) return false;
        int wgid = (int)L; { const int q = nwg / NXCD, r = nwg % NXCD, xcd = wgid % NXCD, off = wgid / NXCD; wgid = (xcd < r ? xcd * (q + 1) : r * (q + 1) + (xcd - r) * q) + off; }
        const int nig = WGM * nN, gid = wgid / nig, fm = gid * WGM, gsz = (nM - fm) < WGM ? (nM - fm) : WGM;
        u.pm = fm + ((wgid % nig) % gsz); u.pn = (wgid % nig) / gsz; return true;
    }
    __device__ __forceinline__ void a_ready(const Unit&) const {}
    __device__ __forceinline__ void done(const Unit&) const {}
};

__device__ __forceinline__ unsigned cvt_pk_bf16(float lo, float hi) { unsigned r; asm volatile("v_cvt_pk_bf16_f32 %0, %1, %2" : "=v"(r) : "v"(lo), "v"(hi)); return r; }
typedef float f32x2 __attribute__((ext_vector_type(2)));
__device__ __forceinline__ f32x2 gelu_pk(f32x2 v) {
    const f32x2 av = __builtin_elementwise_abs(v), d = av * 0.2316418882f + 1.0f;
    f32x2 t; t.x = __builtin_amdgcn_rcpf(d.x); t.y = __builtin_amdgcn_rcpf(d.y);
    f32x2 q = t * 0.5307027145f + (-0.7265760135f); q = q * t + 0.7107068705f; q = q * t + (-0.142248368f); q = q * t + 0.127414796f; q = q * t;
    const f32x2 s = (v * v) * (-0.72134752044f);
    f32x2 e; e.x = __builtin_amdgcn_exp2f(s.x); e.y = __builtin_amdgcn_exp2f(s.y);
    const f32x2 m = v * (q * e), r = v - m;
    f32x2 o; o.x = v.x < 0.f ? m.x : r.x; o.y = v.y < 0.f ? m.y : r.y; return o;
}

template <int ACT  > struct EpiBf16 {
    static constexpr bool PERM = true, AFTER_DRAIN = false; static_assert(ACT == 0 || ACT == 1, "EpiBf16: ACT is 0 (none) or 1 (gelu_pk)");
    bf16_t* O; int ldc; const float* bias; int split_cols; size_t split_stride; float scale0;
    __device__ __forceinline__ void operator()(const f32x4 (&acc)[2][2][4][2], const Unit& u, int wr, int wc, int fr, int fq) const {
        const int row0 = u.pm * BM + wr * 64 + fr; int colt = u.pn * BM; bf16_t* base = O;
        float sc = 1.f; if (split_cols) { const int t = colt / split_cols; base += (size_t)t * split_stride; colt -= t * split_cols; if (t == 0) sc = scale0; }
        const int col0 = colt + wc * 32 + 8 * fq, bcol0 = u.pn * BM + wc * 32 + 8 * fq;
        f32x4 bv[2][2];
#pragma unroll
        for (int bj = 0; bj < 2; ++bj)
#pragma unroll
            for (int n = 0; n < 2; ++n) bv[bj][n] = bias ? *(const f32x4*)(bias + bcol0 + bj * HALF + 4 * n) : (f32x4){0.f, 0.f, 0.f, 0.f};
#pragma unroll
        for (int ai = 0; ai < 2; ++ai)
#pragma unroll
            for (int m = 0; m < 4; ++m) { bf16_t* rowp = base + (size_t)(row0 + ai * HALF + m * 16) * ldc + col0;
#pragma unroll
                for (int bj = 0; bj < 2; ++bj) { f32x4 v0 = acc[ai][bj][m][0] + bv[bj][0], v1 = acc[ai][bj][m][1] + bv[bj][1];
                    if (ACT == 1) { f32x2 a = gelu_pk((f32x2){v0[0], v0[1]}), b = gelu_pk((f32x2){v0[2], v0[3]}), c = gelu_pk((f32x2){v1[0], v1[1]}), d = gelu_pk((f32x2){v1[2], v1[3]});
                        v0 = (f32x4){a.x, a.y, b.x, b.y}; v1 = (f32x4){c.x, c.y, d.x, d.y}; }
                    v0 = v0 * sc; v1 = v1 * sc; u32x4 w; w.x = cvt_pk_bf16(v0[0], v0[1]); w.y = cvt_pk_bf16(v0[2], v0[3]); w.z = cvt_pk_bf16(v1[0], v1[1]); w.w = cvt_pk_bf16(v1[2], v1[3]);
                    *(u32x4*)(rowp + bj * HALF) = w; } }
    }
};
struct EpiF16 {
    static constexpr bool PERM = true, AFTER_DRAIN = false;
    _Float16* O; int ldc;
    __device__ __forceinline__ void operator()(const f32x4 (&acc)[2][2][4][2], const Unit& u, int wr, int wc, int fr, int fq) const {
        typedef _Float16 h8 __attribute__((ext_vector_type(8)));
        const int row0 = u.pm * BM + wr * 64 + fr, col0 = u.pn * BM + wc * 32 + 8 * fq;
#pragma unroll
        for (int ai = 0; ai < 2; ++ai)
#pragma unroll
            for (int m = 0; m < 4; ++m) { _Float16* rowp = O + (size_t)(row0 + ai * HALF + m * 16) * ldc + col0;
#pragma unroll
                for (int bj = 0; bj < 2; ++bj) { const f32x4 a = acc[ai][bj][m][0], b = acc[ai][bj][m][1];
                    h8 o; o[0] = (_Float16)a[0]; o[1] = (_Float16)a[1]; o[2] = (_Float16)a[2]; o[3] = (_Float16)a[3]; o[4] = (_Float16)b[0]; o[5] = (_Float16)b[1]; o[6] = (_Float16)b[2]; o[7] = (_Float16)b[3];
                    *(h8*)(rowp + bj * HALF) = o; } }
    }
};
struct EpiResid {
    static constexpr bool PERM = true, AFTER_DRAIN = false;
    const bf16_t* res; _Float16* Y; int ldc; float alpha;
    __device__ __forceinline__ void operator()(const f32x4 (&acc)[2][2][4][2], const Unit& u, int wr, int wc, int fr, int fq) const {
        const int row0 = u.pm * BM + wr * 64 + fr, col0 = u.pn * BM + wc * 32 + 8 * fq;
#pragma unroll
        for (int ai = 0; ai < 2; ++ai)
#pragma unroll
            for (int m = 0; m < 4; ++m) { const size_t off = (size_t)(row0 + ai * HALF + m * 16) * ldc + col0;
#pragma unroll
                for (int bj = 0; bj < 2; ++bj) { const u32x4 rv = *(const u32x4*)(res + off + bj * HALF);
                    f32x4 r0, r1; r0[0] = __uint_as_float(rv.x << 16); r0[1] = __uint_as_float(rv.x & 0xffff0000u); r0[2] = __uint_as_float(rv.y << 16); r0[3] = __uint_as_float(rv.y & 0xffff0000u);
                    r1[0] = __uint_as_float(rv.z << 16); r1[1] = __uint_as_float(rv.z & 0xffff0000u); r1[2] = __uint_as_float(rv.w << 16); r1[3] = __uint_as_float(rv.w & 0xffff0000u);
                    const f32x4 y0 = r0 * alpha + acc[ai][bj][m][0], y1 = r1 * alpha + acc[ai][bj][m][1];
                    typedef _Float16 h8 __attribute__((ext_vector_type(8))); h8 w; w[0] = (_Float16)y0[0]; w[1] = (_Float16)y0[1]; w[2] = (_Float16)y0[2]; w[3] = (_Float16)y0[3]; w[4] = (_Float16)y1[0]; w[5] = (_Float16)y1[1]; w[6] = (_Float16)y1[2]; w[7] = (_Float16)y1[3];
                    *(h8*)(Y + off + bj * HALF) = w; } }
    }
};
struct EpiPle {
    static constexpr bool PERM = true, AFTER_DRAIN = false;
    const bf16_t* R; _Float16* Y; const bf16_t* E; const float* gb; int ldc;
    __device__ __forceinline__ void operator()(const f32x4 (&acc)[2][2][4][2], const Unit& u, int wr, int wc, int fr, int fq) const {
        const int row0 = u.pm * BM + wr * 64 + fr, col0 = u.pn * BM + wc * 32 + 8 * fq;
        f32x4 bv[2][2];
#pragma unroll
        for (int bj = 0; bj < 2; ++bj)
#pragma unroll
            for (int n = 0; n < 2; ++n) bv[bj][n] = *(const f32x4*)(gb + col0 + bj * HALF + 4 * n);
#pragma unroll
        for (int ai = 0; ai < 2; ++ai)
#pragma unroll
            for (int m = 0; m < 4; ++m) { const size_t off = (size_t)(row0 + ai * HALF + m * 16) * ldc + col0;
#pragma unroll
                for (int bj = 0; bj < 2; ++bj) {
                    const u32x4 ev = *(const u32x4*)(E + off + bj * HALF), rv = *(const u32x4*)(R + off + bj * HALF);
                    float o[8];
#pragma unroll
                    for (int n = 0; n < 2; ++n) {
                        const f32x4 z = acc[ai][bj][m][n] + bv[bj][n];
                        const unsigned e0 = n == 0 ? ev.x : ev.z, e1 = n == 0 ? ev.y : ev.w, r0 = n == 0 ? rv.x : rv.z, r1 = n == 0 ? rv.y : rv.w;
                        f32x4 ee, rr; ee[0] = __uint_as_float(e0 << 16); ee[1] = __uint_as_float(e0 & 0xffff0000u); ee[2] = __uint_as_float(e1 << 16); ee[3] = __uint_as_float(e1 & 0xffff0000u);
                        rr[0] = __uint_as_float(r0 << 16); rr[1] = __uint_as_float(r0 & 0xffff0000u); rr[2] = __uint_as_float(r1 << 16); rr[3] = __uint_as_float(r1 & 0xffff0000u);
#pragma unroll
                        for (int i = 0; i < 4; ++i) o[4 * n + i] = rr[i] + ee[i] * __builtin_amdgcn_rcpf(1.0f + __expf(-z[i])); }
                    typedef _Float16 h8 __attribute__((ext_vector_type(8))); h8 w;
#pragma unroll
                    for (int i = 0; i < 8; ++i) w[i] = (_Float16)o[i];
                    *(h8*)(Y + off + bj * HALF) = w; } }
    }
};
template <class Epi, class Sched, bool ALIGN_EPI = false, bool SP2 = false>
__device__ __forceinline__ void gemm_phase(PG8_LAS unsigned char* lds, const Gemm g, const Sched& S, const Epi& E) {
    const int tid = tid_l(), wid = __builtin_amdgcn_readfirstlane(tid >> 6), lane = tid & 63, wr = wid >> 2, wc = wid & 3, fr = lane & 15, fq = lane >> 4;
    const int K = g.K, nt = K / BK;
    unsigned voffA[2], voffB[2];
#pragma unroll
    for (int i = 0; i < 2; ++i) { int R, C; stage_rc(tid * 16 + i * 8192, R, C); const int Rb = Epi::PERM ? ((R & ~31) + perm32(R & 31)) : R;
        voffA[i] = (unsigned)(R * K + C) * 2u; voffB[i] = (unsigned)(Rb * K + C) * 2u; }
    const size_t kstep = (size_t)(BK * 2);
    const size_t hstep = (size_t)HALF * K * 2;
    const size_t tstep = 2 * hstep;
    const unsigned ldsw = (unsigned)wid * 1024u;
    const int aoff = lds_byte(wr * 64 + fr, fq * 8), boff = lds_byte(wc * 32 + fr, fq * 8);
#define PG8_SA(b, h) (((b) * 2 + (h)) * HTB)
#define PG8_SB(b, h) ((4 + (b) * 2 + (h)) * HTB)
#define PG8_STAGE(bufoff, gbase, voff) do { _Pragma("unroll") for (int _i = 0; _i < 2; ++_i) \
        __builtin_amdgcn_global_load_lds((const unsigned*)((const char*)(gbase) + (voff)[_i]), (PG8_LAS unsigned*)(lds + (bufoff) + ldsw + _i * 8192), 16, 0, 0); } while (0)
#define PG8_LDA(dst, b, h) do { _Pragma("unroll") for (int m = 0; m < 4; ++m) _Pragma("unroll") for (int k = 0; k < 2; ++k) dst[m][k] = *(const PG8_LAS bf16x8*)(lds + PG8_SA(b, h) + aoff + m * 2048 + k * 1024); } while (0)
#define PG8_LDB(dst, b, h) do { _Pragma("unroll") for (int n = 0; n < 2; ++n) _Pragma("unroll") for (int k = 0; k < 2; ++k) dst[n][k] = *(const PG8_LAS bf16x8*)(lds + PG8_SB(b, h) + boff + n * 2048 + k * 1024); } while (0)
#define PG8_MMA(ai, bj, At, Bt) do { __builtin_amdgcn_s_setprio(1); _Pragma("unroll") for (int m = 0; m < 4; ++m) _Pragma("unroll") for (int n = 0; n < 2; ++n) _Pragma("unroll") for (int k = 0; k < 2; ++k) \
        acc[ai][bj][m][n] = __builtin_amdgcn_mfma_f32_16x16x32_bf16(Bt[n][k], At[m][k], acc[ai][bj][m][n], 0, 0, 0); __builtin_amdgcn_s_setprio(0); } while (0)
#define PG8_WAIT_V(n) asm volatile("s_waitcnt vmcnt(" #n ")" ::: "memory")
#define PG8_WAIT_L(n) asm volatile("s_waitcnt lgkmcnt(" #n ")" ::: "memory")
#define PG8_BAR __builtin_amdgcn_s_barrier()
#define PG8_SCHED __builtin_amdgcn_sched_barrier(0)
    Unit cur, nxt; int ui = 0;
    if (!S.next(0, cur)) return;
    f32x4 acc[2][2][4][2];
#pragma unroll
    for (int a = 0; a < 2; ++a)
#pragma unroll
        for (int b = 0; b < 2; ++b)
#pragma unroll
            for (int m = 0; m < 4; ++m)
#pragma unroll
                for (int n = 0; n < 2; ++n) acc[a][b][m][n] = (f32x4){0.f, 0.f, 0.f, 0.f};
    bf16x8 At[4][2], B0[2][2], B1[2][2];
    const char* cA = (const char*)g.A + (size_t)cur.pm * tstep; const char* cB = (const char*)g.Bt + (size_t)cur.pn * tstep;
    S.a_ready(cur);
    if constexpr (SP2) {
        PG8_STAGE(PG8_SB(0, 0), cB, voffB); PG8_STAGE(PG8_SB(0, 1), cB + hstep, voffB); PG8_STAGE(PG8_SA(0, 0), cA, voffA); PG8_STAGE(PG8_SA(0, 1), cA + hstep, voffA);
        if (wr == 1) PG8_BAR;
        PG8_WAIT_V(2); PG8_BAR;
        PG8_STAGE(PG8_SB(1, 0), cB + kstep, voffB); PG8_STAGE(PG8_SA(1, 0), cA + kstep, voffA); PG8_STAGE(PG8_SB(1, 1), cB + hstep + kstep, voffB);
        PG8_WAIT_V(6); PG8_BAR;
    } else {
        PG8_STAGE(PG8_SB(0, 0), cB, voffB); PG8_STAGE(PG8_SA(0, 0), cA, voffA); PG8_STAGE(PG8_SB(0, 1), cB + hstep, voffB); PG8_STAGE(PG8_SA(0, 1), cA + hstep, voffA);
        if (wr == 1) PG8_BAR;
        PG8_WAIT_V(4); PG8_BAR;
        PG8_STAGE(PG8_SB(1, 0), cB + kstep, voffB); PG8_STAGE(PG8_SA(1, 0), cA + kstep, voffA); PG8_STAGE(PG8_SB(1, 1), cB + hstep + kstep, voffB);
        PG8_WAIT_V(6); PG8_BAR;
    }
    for (;;) {
        const bool has_next = S.next(ui + 1, nxt);
        const char* nA = has_next ? (const char*)g.A + (size_t)nxt.pm * tstep : cA; const char* nB = has_next ? (const char*)g.Bt + (size_t)nxt.pn * tstep : cB;
        for (int t = 0; t < nt; t += 2) {
            const bool last = (t == nt - 2);
            const char* a1 = cA + (size_t)(t + 1) * kstep;
            const char* a2 = last ? nA : cA + (size_t)(t + 2) * kstep; const char* b2 = last ? nB : cB + (size_t)(t + 2) * kstep;
            const char* a3 = a2 + kstep; const char* b3 = b2 + kstep;
            if (last && has_next) S.a_ready(nxt);
            if constexpr (SP2) {
            PG8_LDB(B0, 0, 0); PG8_LDB(B1, 0, 1); PG8_SCHED; PG8_LDA(At, 0, 0); PG8_STAGE(PG8_SA(1, 1), a1 + hstep, voffA);
            PG8_WAIT_V(8); PG8_WAIT_L(0); PG8_BAR; PG8_MMA(0, 0, At, B0); PG8_MMA(0, 1, At, B1); PG8_BAR; PG8_SCHED;
            PG8_LDA(At, 0, 1); PG8_STAGE(PG8_SB(0, 0), b2, voffB); PG8_STAGE(PG8_SB(0, 1), b2 + hstep, voffB); PG8_STAGE(PG8_SA(0, 0), a2, voffA);
            PG8_WAIT_V(8); PG8_WAIT_L(0); PG8_BAR; PG8_MMA(1, 0, At, B0); PG8_MMA(1, 1, At, B1); PG8_BAR; PG8_SCHED;
            PG8_LDB(B0, 1, 0); PG8_LDB(B1, 1, 1); PG8_SCHED; PG8_LDA(At, 1, 0); PG8_STAGE(PG8_SA(0, 1), a2 + hstep, voffA);
            PG8_WAIT_V(8); PG8_WAIT_L(0); PG8_BAR; PG8_MMA(0, 0, At, B0); PG8_MMA(0, 1, At, B1); PG8_BAR; PG8_SCHED;
            PG8_LDA(At, 1, 1); PG8_STAGE(PG8_SB(1, 0), b3, voffB); PG8_STAGE(PG8_SB(1, 1), b3 + hstep, voffB); PG8_STAGE(PG8_SA(1, 0), a3, voffA);
            PG8_WAIT_V(8); PG8_WAIT_L(0); PG8_BAR; PG8_MMA(1, 0, At, B0); PG8_MMA(1, 1, At, B1); PG8_BAR; PG8_SCHED;
            } else {
            PG8_LDB(B0, 0, 0); PG8_SCHED; PG8_LDA(At, 0, 0); PG8_STAGE(PG8_SA(1, 1), a1 + hstep, voffA);
            PG8_WAIT_L(8); PG8_BAR; PG8_WAIT_L(0); PG8_MMA(0, 0, At, B0); PG8_BAR; PG8_SCHED;
            PG8_LDB(B1, 0, 1); PG8_STAGE(PG8_SB(0, 0), b2, voffB);
            PG8_BAR; PG8_WAIT_L(0); PG8_MMA(0, 1, At, B1); PG8_BAR;
            PG8_LDA(At, 0, 1); PG8_STAGE(PG8_SA(0, 0), a2, voffA);
            PG8_BAR; PG8_WAIT_L(0); PG8_MMA(1, 0, At, B0); PG8_BAR; PG8_SCHED;
            PG8_STAGE(PG8_SB(0, 1), b2 + hstep, voffB);
            PG8_WAIT_V(6); PG8_BAR; PG8_MMA(1, 1, At, B1); PG8_BAR;
            PG8_LDB(B0, 1, 0); PG8_SCHED; PG8_LDA(At, 1, 0); PG8_STAGE(PG8_SA(0, 1), a2 + hstep, voffA);
            PG8_WAIT_L(8); PG8_BAR; PG8_WAIT_L(0); PG8_MMA(0, 0, At, B0); PG8_BAR; PG8_SCHED;
            PG8_LDB(B1, 1, 1); PG8_STAGE(PG8_SB(1, 0), b3, voffB);
            PG8_BAR; PG8_WAIT_L(0); PG8_MMA(0, 1, At, B1); PG8_BAR;
            PG8_LDA(At, 1, 1); PG8_STAGE(PG8_SA(1, 0), a3, voffA);
            PG8_BAR; PG8_WAIT_L(0); PG8_MMA(1, 0, At, B0); PG8_BAR; PG8_SCHED;
            PG8_STAGE(PG8_SB(1, 1), b3 + hstep, voffB);
            PG8_WAIT_V(6); PG8_BAR; PG8_MMA(1, 1, At, B1); PG8_BAR;
            }
        }
        if constexpr (ALIGN_EPI) { if (wr == 0) PG8_BAR; }
        if constexpr (!Epi::AFTER_DRAIN) { E(acc, cur, wr, wc, fr, fq); S.done(cur); }
        if (!has_next) break;
#pragma unroll
        for (int a = 0; a < 2; ++a)
#pragma unroll
            for (int b = 0; b < 2; ++b)
#pragma unroll
                for (int m = 0; m < 4; ++m)
#pragma unroll
                    for (int n = 0; n < 2; ++n) acc[a][b][m][n] = (f32x4){0.f, 0.f, 0.f, 0.f};
        cur = nxt; cA = nA; cB = nB; ++ui;
        if constexpr (ALIGN_EPI) { if (wr == 1) PG8_BAR; }
    }
    PG8_WAIT_V(0);
    if constexpr (!ALIGN_EPI) { if (wr == 0) PG8_BAR; }
    PG8_BAR;
    if constexpr (Epi::AFTER_DRAIN) { E.fused(acc, cur, wr, wc, fr, fq, lds, wid, lane); S.done(cur); }
#undef PG8_SA
#undef PG8_SB
#undef PG8_STAGE
#undef PG8_LDA
#undef PG8_LDB
#undef PG8_MMA
#undef PG8_WAIT_V
#undef PG8_WAIT_L
#undef PG8_BAR
#undef PG8_SCHED
}
}
#include <hip/hip_bf16.h>
#include <cmath>
namespace attn_body {
using bf16=__hip_bfloat16;
using bf16x8=__attribute__((ext_vector_type(8)))short;
using s16x4=__attribute__((ext_vector_type(4)))short;
using f32x16=__attribute__((ext_vector_type(16)))float;
using u32x4=__attribute__((ext_vector_type(4)))unsigned;
constexpr int BATCH=8,NHEAD=6,SEQ=4096,D=64,KVP=3072,OP=1024;
constexpr int NW=8,QBLK=32,QB=QBLK*NW,KVBLK=64,NQB=SEQ/QB;
constexpr int ATTN_UNIT_ROWS=QB;
__device__ __forceinline__ int crow(int r,int hi){return (r&3)+8*(r>>2)+4*hi;}
#define SBAR() __builtin_amdgcn_sched_barrier(0)
__device__ __forceinline__ void cmask(f32x16&p0,f32x16&p1,int jb,int qrel,int hi){
  const float NEG=-INFINITY; int kb=64*jb+4*hi;
  #pragma unroll
  for(int r=0;r<16;++r){int kv=kb+(r&3)+8*(r>>2); if(kv>qrel)p0[r]=NEG; if(kv+32>qrel)p1[r]=NEG;}
}

constexpr int NSLOT=3, SLOTB=8192;
constexpr int LDS_K=0, LDS_V=NSLOT*SLOTB, LDS_WS=2*NSLOT*SLOTB, LDS_OST=LDS_WS+NW*64*4, LDS_CK=LDS_OST+NW*4096, LDS_BYTES=LDS_CK+SEQ*4;
constexpr float C2=0.125f*1.4426950408889634f;
__device__ __forceinline__ void glds16(const void*gsrc,unsigned lds_dst){unsigned keep;
  asm volatile("s_mov_b32 %0, m0\n\ts_mov_b32 m0, %2\n\ts_nop 0\n\tglobal_load_lds_dwordx4 %1, off\n\ts_mov_b32 m0, %0":"=&s"(keep):"v"(gsrc),"s"(lds_dst):"memory");}
__device__ __forceinline__ float max3f(float a,float b,float c){float r;asm("v_max3_f32 %0, %1, %2, %3":"=v"(r):"v"(a),"v"(b),"v"(c));return r;}
__device__ __forceinline__ float max2f(float a,float b){float r;asm("v_max_f32_e32 %0, %1, %2":"=v"(r):"v"(a),"v"(b));return r;}
__device__ __forceinline__ float fadd_s(float a,float b){float r;asm("v_add_f32_e32 %0, %1, %2":"=v"(r):"v"(a),"v"(b));return r;}
__device__ __forceinline__ float fsub_s(float a,float b){float r;asm("v_sub_f32_e32 %0, %1, %2":"=v"(r):"v"(a),"v"(b));return r;}
typedef float f32x2_t __attribute__((ext_vector_type(2))); typedef float f32x4_t __attribute__((ext_vector_type(4))); typedef __bf16 bf16x2_t __attribute__((ext_vector_type(2)));
__device__ __forceinline__ unsigned cvtpk_s(float lo,float hi){f32x2_t v={lo,hi};bf16x2_t b=__builtin_convertvector(v,bf16x2_t);return __builtin_bit_cast(unsigned,b);}
#define WAIT_BAR(N) asm volatile("s_waitcnt vmcnt(" #N ") lgkmcnt(0)\n\ts_barrier":::"memory")

__device__ __forceinline__ void qkt(f32x16&p0,f32x16&p1,const char*Kslot,const bf16x8*qr,int r32,int hi){
  const char*kb=Kslot+hi*1024+r32*16;
  #pragma unroll
  for(int d0=0;d0<4;++d0){
    const bf16x8 b0=*reinterpret_cast<const bf16x8*>(kb+d0*2048);
    const bf16x8 b1=*reinterpret_cast<const bf16x8*>(kb+d0*2048+512);
    {p0=__builtin_amdgcn_mfma_f32_32x32x16_bf16(b0,qr[d0],p0,0,0,0);p1=__builtin_amdgcn_mfma_f32_32x32x16_bf16(b1,qr[d0],p1,0,0,0);}}
}
typedef __attribute__((address_space(3))) const char* lds_cptr;
typedef short v4i16_t __attribute__((ext_vector_type(4)));
__device__ __forceinline__ void kload8(bf16x8*kf,lds_cptr kp){
  kf[0]=*(const __attribute__((address_space(3))) bf16x8*)(kp);      kf[1]=*(const __attribute__((address_space(3))) bf16x8*)(kp+512);
  kf[2]=*(const __attribute__((address_space(3))) bf16x8*)(kp+2048); kf[3]=*(const __attribute__((address_space(3))) bf16x8*)(kp+2560);
  kf[4]=*(const __attribute__((address_space(3))) bf16x8*)(kp+4096); kf[5]=*(const __attribute__((address_space(3))) bf16x8*)(kp+4608);
  kf[6]=*(const __attribute__((address_space(3))) bf16x8*)(kp+6144); kf[7]=*(const __attribute__((address_space(3))) bf16x8*)(kp+6656);
}
__device__ __forceinline__ void kload2(bf16x8*kf,lds_cptr kp,int j){ kf[2*j]=*(const __attribute__((address_space(3))) bf16x8*)(kp+j*2048); kf[2*j+1]=*(const __attribute__((address_space(3))) bf16x8*)(kp+j*2048+512); }
__device__ __forceinline__ s16x4 vtr(lds_cptr p){ return __builtin_bit_cast(s16x4,__builtin_amdgcn_ds_read_tr16_b64_v4i16((__attribute__((address_space(3))) v4i16_t*)p)); }
__device__ __forceinline__ float rowmax(const f32x16&p0,const f32x16&p1){
  float a=max3f(p0[0],p0[1],p1[0]),b=max3f(p0[2],p0[3],p1[1]);a=max3f(a,p1[2],p1[3]);
  #pragma unroll
  for(int r=4;r<16;r+=4){a=max3f(a,p0[r],p0[r+1]);b=max3f(b,p0[r+2],p0[r+3]);a=max3f(a,p1[r],p1[r+1]);b=max3f(b,p1[r+2],p1[r+3]);}
  const float m=max2f(a,b);
  auto rr=__builtin_amdgcn_permlane32_swap(__float_as_uint(m),__float_as_uint(m),false,false);
  return max2f(__uint_as_float(rr[0]),__uint_as_float(rr[1]));
}
__device__ __forceinline__ void pv(f32x16*o,int vb,bf16x8 pa0,bf16x8 pa1,bf16x8 pa2,bf16x8 pa3){
  #pragma unroll
  for(int d0=0;d0<2;++d0){s16x4 lo[4],hi[4];
    #pragma unroll
    for(int ks=0;ks<4;++ks){
      asm volatile("ds_read_b64_tr_b16 %0,%1 offset:%c2":"=&v"(lo[ks]):"v"(vb),"i"(d0*4096+ks*1024):"memory");
      asm volatile("ds_read_b64_tr_b16 %0,%1 offset:%c2":"=&v"(hi[ks]):"v"(vb),"i"(d0*4096+ks*1024+512):"memory");}
    asm volatile("s_waitcnt lgkmcnt(0)":::"memory");SBAR();
    #define PK(k) (bf16x8){lo[k][0],lo[k][1],lo[k][2],lo[k][3],hi[k][0],hi[k][1],hi[k][2],hi[k][3]}
    o[d0]=__builtin_amdgcn_mfma_f32_32x32x16_bf16(pa0,PK(0),o[d0],0,0,0);
    o[d0]=__builtin_amdgcn_mfma_f32_32x32x16_bf16(pa1,PK(1),o[d0],0,0,0);
    o[d0]=__builtin_amdgcn_mfma_f32_32x32x16_bf16(pa2,PK(2),o[d0],0,0,0);
    o[d0]=__builtin_amdgcn_mfma_f32_32x32x16_bf16(pa3,PK(3),o[d0],0,0,0);
    #undef PK
  }
}

#ifndef ATTN_STORE16
#define ATTN_STORE16(p,v) (*(u32x4*)(p)=(v))
#endif
template<int THRL> __device__ __forceinline__ void attn_unit(int b,int h,int qb,const bf16*Q,const bf16*__restrict__ K,const bf16*__restrict__ V,bf16*O,const float*__restrict__ CKg,const float*__restrict__ KTm,const float*__restrict__ QBm,char*shm){
  const int tid=tid_l(),lane=tid&63,r32=lane&31,hi=lane>>5; const int wid=__builtin_amdgcn_readfirstlane(tid>>6);
  const long rowbase=(long)b*SEQ; const int q0=qb*QB;
  const bf16*Qw=Q+(rowbase+q0+wid*QBLK)*KVP+h*D;
  const float*ckg=CKg+(long)(b*NHEAD+h)*SEQ;
  int j0=0;
  { const int bh_=b*NHEAD+h, NT0_=(q0+QB)/KVBLK; const float qmx=QBm[bh_*NQB+qb]*1.01f;
    const float kd=fmaxf(fmaxf(KTm[bh_*64+4*qb],KTm[bh_*64+4*qb+1]),fmaxf(KTm[bh_*64+4*qb+2],KTm[bh_*64+4*qb+3]));
    const float thr=-(qmx*kd)-48.f; bool skip=false;
    if(lane<NT0_-4){ const float bound=qmx*KTm[bh_*64+lane]+(ckg[q0]-ckg[64*lane+63]); skip=bound<thr; }
    const unsigned long long m_=__ballot(skip); j0=__builtin_ctzll(~m_); j0=(j0<NT0_-4?j0:NT0_-4)&~1; j0=__builtin_amdgcn_readfirstlane(j0); }
  const bf16*Kh=K+(rowbase+(long)j0*KVBLK)*KVP+h*D,*Vh=V+(rowbase+(long)j0*KVBLK)*KVP+h*D;
  const unsigned lds0=(unsigned)(uintptr_t)shm;
  float*wsf=(float*)(shm+LDS_WS)+wid*64;
  const bf16*ksrc=Kh+(long)lane*KVP+wid*8;
  const bf16*vsrc=Vh+(long)(16*(wid&3)+(lane>>2))*KVP+(wid>>2)*32+(lane&3)*8;
  const unsigned kdst=lds0+LDS_K+wid*1024, vdst=lds0+LDS_V+wid*1024;
  #define DMA_K(t,slot) glds16(ksrc+(long)(t)*KVBLK*KVP,(unsigned)__builtin_amdgcn_readfirstlane(kdst+(slot)))
  #define DMA_V(t,slot) glds16(vsrc+(long)(t)*KVBLK*KVP,(unsigned)__builtin_amdgcn_readfirstlane(vdst+(slot)))
  const int vb0=(int)(lds0+LDS_V)+((lane>>4)&1)*32+(lane&3)*8+(4*hi+((lane&15)>>2))*64;
  const char*Kbase=shm+LDS_K; bf16x8 kf[8];
  const lds_cptr shm3=(lds_cptr)shm; const lds_cptr kp0=shm3+LDS_K+hi*1024+r32*16; const lds_cptr vp0=shm3+LDS_V+((lane>>4)&1)*32+(lane&3)*8+(4*hi+((lane&15)>>2))*64;
  const int NT=(q0+QB)/KVBLK-j0;
  float*cks=(float*)(shm+LDS_CK);
  for(int i=j0*KVBLK+tid*4;i<q0+QB;i+=NW*64*4){ *(f32x4_t*)(cks+i)=*(const f32x4_t*)(ckg+i); }
  float cqm=ckg[q0+wid*QBLK+r32];
  const lds_cptr ckp=(lds_cptr)shm+LDS_CK+j0*256+hi*16;
  DMA_K(0,0);DMA_V(0,0);DMA_K(1,SLOTB);
  bf16x8 qr[4];
  #pragma unroll
  for(int d0=0;d0<4;++d0)qr[d0]=*reinterpret_cast<const bf16x8*>(&Qw[(long)r32*KVP+d0*16+hi*8]);
  float l_reg=0.f;f32x16 o[2];o[0]=f32x16{};o[1]=f32x16{};
  #define CINIT(C0,C1,t) do{ const lds_cptr cp_=ckp+(t)*256; \
    _Pragma("unroll") for(int g_=0;g_<4;++g_){ const f32x4_t a_=*(const __attribute__((address_space(3))) f32x4_t*)(cp_+g_*32); const f32x4_t b_=*(const __attribute__((address_space(3))) f32x4_t*)(cp_+g_*32+128); \
      _Pragma("unroll") for(int i_=0;i_<4;++i_){ C0[g_*4+i_]=cqm-a_[i_]; C1[g_*4+i_]=cqm-b_[i_]; } } }while(0)
  const int qrel=wid*QBLK+r32;
  #define CMASK(P0,P1,t) do{int jb_=(t)-(NT-4); if(jb_>=0)cmask(P0,P1,jb_,qrel,hi);}while(0)
  bool resc=false;
  #define START(P0,P1) do{ const float rm=rowmax(P0,P1); resc=false; \
    { const float dl=rm; \
      _Pragma("unroll") for(int r=0;r<16;++r){P0[r]=fsub_s(P0[r],dl);P1[r]=fsub_s(P1[r],dl);} \
      cqm=fsub_s(cqm,dl); } \
    _Pragma("unroll") for(int r=0;r<16;++r)P0[r]=__builtin_amdgcn_exp2f(P0[r]); }while(0)
  #define RESC() do{ if(resc){ asm volatile("s_waitcnt lgkmcnt(0)":::"memory"); \
      _Pragma("unroll") for(int d_=0;d_<2;++d_) _Pragma("unroll") for(int r=0;r<16;++r)o[d_][r]*=wsf[crow(r,hi)]; } }while(0)
  f32x16 pA0,pA1,pB0,pB1;
  int sl_prev=0,sl_cur=0,sl_next=SLOTB;
  #define ROT() do{sl_prev=sl_cur;sl_cur=sl_next;sl_next=(sl_next==(NSLOT-1)*SLOTB)?0:sl_next+SLOTB;}while(0)
  DMA_K(2,2*SLOTB);
  WAIT_BAR(3);
  CINIT(pA0,pA1,0);
  qkt(pA0,pA1,Kbase,qr,r32,hi);asm volatile("s_nop 15\n\ts_nop 7":"+v"(pA0),"+v"(pA1));CMASK(pA0,pA1,0);
  START(pA0,pA1);
  _Pragma("unroll") for(int r=0;r<16;++r)pA1[r]=__builtin_amdgcn_exp2f(pA1[r]);
  WAIT_BAR(0);
  DMA_K(3,0);DMA_V(1,SLOTB);
  ROT();
  kload8(kf,kp0+sl_cur);
  WAIT_BAR(2);
  s16x4 vlo[8],vhi[8]; u32x4 pw0,pw1,pw2,pw3;
  #define PKW(P,B) cvtpk_s(P[B],P[B+1])
  #define PAF(k) __builtin_bit_cast(bf16x8,pw##k)
  #define VFR(i) (bf16x8){vlo[i][0],vlo[i][1],vlo[i][2],vlo[i][3],vhi[i][0],vhi[i][1],vhi[i][2],vhi[i][3]}
  #define PIN(x) asm volatile("":"+v"(x))
  #define MX3(a,b,c) __builtin_fmaxf(__builtin_fmaxf((a),(b)),(c))
  #define GAPA(MF,A0,A1,A2,A3,W0,W1,PW) do{ MF; sacc+=A0; sacc+=A1; sacc+=A2; sacc+=A3; PIN(sacc); W0; W1; PIN(PW); SBAR(); }while(0)
  #define EX(v) __builtin_amdgcn_exp2f(v)
  #define GAPB(MF,X,B) do{ MF; X[B]=EX(X[B]); X[B+1]=EX(X[B+1]); X[B+2]=EX(X[B+2]); X[B+3]=EX(X[B+3]); PIN(X); SBAR(); }while(0)
  #define VRD(i) do{ vlo[i]=vtr(vp_+(((i)>>2)*4096+((i)&3)*1024)); vhi[i]=vtr(vp_+(((i)>>2)*4096+((i)&3)*1024+512)); }while(0)
  #define KRD(G,j) do{ if(G){ kload2(kf,kp0+sl_next,j); SBAR(); } }while(0)
  #define STEP(C0,C1,P0,P1,t,GK,GV,GL) do{ SBAR(); \
    CINIT(C0,C1,t); SBAR(); \
    const lds_cptr vp_=vp0+sl_prev; \
    VRD(0); SBAR(); float sacc=(P0[0]+P0[1]); \
    GAPA(C0=__builtin_amdgcn_mfma_f32_32x32x16_bf16(kf[0],qr[0],C0,0,0,0), P0[2],P0[3],P0[4],P0[5],     pw0[0]=PKW(P0,0), pw0[1]=PKW(P0,2), pw0); \
    VRD(4); SBAR(); GAPA(C1=__builtin_amdgcn_mfma_f32_32x32x16_bf16(kf[1],qr[0],C1,0,0,0), P0[6],P0[7],P0[8],P0[9],     pw0[2]=PKW(P0,4), pw0[3]=PKW(P0,6), pw0); \
    VRD(1); SBAR(); GAPA(C0=__builtin_amdgcn_mfma_f32_32x32x16_bf16(kf[2],qr[1],C0,0,0,0),   P0[10],P0[11],P0[12],P0[13], pw1[0]=PKW(P0,8), pw1[1]=PKW(P0,10), pw1); \
    VRD(5); SBAR(); GAPA(C1=__builtin_amdgcn_mfma_f32_32x32x16_bf16(kf[3],qr[1],C1,0,0,0),   P0[14],P0[15],P1[0],P1[1],   pw1[2]=PKW(P0,12),pw1[3]=PKW(P0,14), pw1); \
    VRD(2); SBAR(); GAPA(C0=__builtin_amdgcn_mfma_f32_32x32x16_bf16(kf[4],qr[2],C0,0,0,0),   P1[2],P1[3],P1[4],P1[5],     pw2[0]=PKW(P1,0), pw2[1]=PKW(P1,2), pw2); \
    VRD(6); SBAR(); GAPA(C1=__builtin_amdgcn_mfma_f32_32x32x16_bf16(kf[5],qr[2],C1,0,0,0),   P1[6],P1[7],P1[8],P1[9],     pw2[2]=PKW(P1,4), pw2[3]=PKW(P1,6), pw2); \
    VRD(3); SBAR(); GAPA(C0=__builtin_amdgcn_mfma_f32_32x32x16_bf16(kf[6],qr[3],C0,0,0,0),   P1[10],P1[11],P1[12],P1[13], pw3[0]=PKW(P1,8), pw3[1]=PKW(P1,10), pw3); \
    VRD(7); SBAR(); GAPA(C1=__builtin_amdgcn_mfma_f32_32x32x16_bf16(kf[7],qr[3],C1,0,0,0),   P1[14],P1[15],0.f,0.f,       pw3[2]=PKW(P1,12),pw3[3]=PKW(P1,14), pw3); \
    l_reg+=sacc; \
    if(GK){DMA_K((t)+3,sl_cur);} if(GV){DMA_V((t)+1,sl_next);} \
    CMASK(C0,C1,t); \
    { float a=MX3(C0[0],C0[1],C1[0]),b=MX3(C0[2],C0[3],C1[1]); a=MX3(a,C1[2],C1[3]); \
      _Pragma("unroll") for(int r=4;r<16;r+=4){a=MX3(a,C0[r],C0[r+1]);b=MX3(b,C0[r+2],C0[r+3]);a=MX3(a,C1[r],C1[r+1]);b=MX3(b,C1[r+2],C1[r+3]);} \
      float rm=__builtin_fmaxf(a,b); { auto rr=__builtin_amdgcn_permlane32_swap(__float_as_uint(rm),__float_as_uint(rm),false,false); rm=__builtin_fmaxf(__uint_as_float(rr[0]),__uint_as_float(rr[1])); } \
      resc=false; \
      if(__builtin_expect(__any(rm>(float)THRL),0)){ const float dl=__builtin_fmaxf(rm,0.f); \
        _Pragma("unroll") for(int r=0;r<16;++r){C0[r]-=dl;C1[r]-=dl;} \
        cqm-=dl; \
        const float f=__builtin_amdgcn_exp2f(-dl); l_reg*=f; if(hi==0)wsf[r32]=f; resc=true; } } \
    SBAR(); \
    GAPB(o[0]=__builtin_amdgcn_mfma_f32_32x32x16_bf16(PAF(0),VFR(0),o[0],0,0,0), C0,0); \
    GAPB(o[1]=__builtin_amdgcn_mfma_f32_32x32x16_bf16(PAF(0),VFR(4),o[1],0,0,0), C0,4); \
    KRD(GL,0); GAPB(o[0]=__builtin_amdgcn_mfma_f32_32x32x16_bf16(PAF(1),VFR(1),o[0],0,0,0), C0,8); \
    KRD(GL,1); GAPB(o[1]=__builtin_amdgcn_mfma_f32_32x32x16_bf16(PAF(1),VFR(5),o[1],0,0,0), C0,12); \
    KRD(GL,2); GAPB(o[0]=__builtin_amdgcn_mfma_f32_32x32x16_bf16(PAF(2),VFR(2),o[0],0,0,0), C1,0); \
    KRD(GL,3); GAPB(o[1]=__builtin_amdgcn_mfma_f32_32x32x16_bf16(PAF(2),VFR(6),o[1],0,0,0), C1,4); \
    GAPB(o[0]=__builtin_amdgcn_mfma_f32_32x32x16_bf16(PAF(3),VFR(3),o[0],0,0,0), C1,8); \
    GAPB(o[1]=__builtin_amdgcn_mfma_f32_32x32x16_bf16(PAF(3),VFR(7),o[1],0,0,0), C1,12); \
    }while(0)
  int t=1;
  #undef CMASK
  #define CMASK(P0,P1,t) do{}while(0)
  for(;t+5<NT;t+=2){
    STEP(pB0,pB1,pA0,pA1,t,true,true,true);     WAIT_BAR(2); RESC(); ROT();
    STEP(pA0,pA1,pB0,pB1,t+1,true,true,true);   WAIT_BAR(2); RESC(); ROT();
  }
  #undef CMASK
  #define CMASK(P0,P1,t) do{int jb_=(t)-(NT-4); if(jb_>=0)cmask(P0,P1,jb_,qrel,hi);}while(0)
  #define ENDW(tt) do{ if((tt)+3<NT){WAIT_BAR(2);} else if((tt)+2<NT){WAIT_BAR(1);} else {WAIT_BAR(0);} }while(0)
  for(;t+1<NT;t+=2){
    STEP(pB0,pB1,pA0,pA1,t,(t+3<NT),(t+1<NT),(t+1<NT));       ENDW(t);   RESC(); ROT();
    STEP(pA0,pA1,pB0,pB1,t+1,(t+4<NT),(t+2<NT),(t+2<NT));     ENDW(t+1); RESC(); ROT();
  }
  STEP(pB0,pB1,pA0,pA1,NT-1,false,false,false); RESC();
  { float sacc=pB0[0]+pB0[1]; _Pragma("unroll") for(int r=2;r<16;++r)sacc+=pB0[r]; _Pragma("unroll") for(int r=0;r<16;++r)sacc+=pB1[r]; l_reg+=sacc;
    pw0=(u32x4){PKW(pB0,0),PKW(pB0,2),PKW(pB0,4),PKW(pB0,6)};pw1=(u32x4){PKW(pB0,8),PKW(pB0,10),PKW(pB0,12),PKW(pB0,14)};pw2=(u32x4){PKW(pB1,0),PKW(pB1,2),PKW(pB1,4),PKW(pB1,6)};pw3=(u32x4){PKW(pB1,8),PKW(pB1,10),PKW(pB1,12),PKW(pB1,14)};
    SBAR(); pv(o,vb0+sl_cur,PAF(0),PAF(1),PAF(2),PAF(3)); }
  #undef PKW
  #undef PAF
  #undef VFR
  #undef PIN
  #undef MX3
  #undef GAPA
  #undef GAPB
  #undef EX
  #undef VRD
  #undef KRD
  #undef STEP
  #undef ENDW
  {auto rr=__builtin_amdgcn_permlane32_swap(__float_as_uint(l_reg),__float_as_uint(l_reg),false,false);l_reg=__uint_as_float(rr[0])+__uint_as_float(rr[1]);}
  if(hi==0)wsf[32+r32]=l_reg;asm volatile("s_waitcnt lgkmcnt(0)":::"memory");
  float rli[16];
  #pragma unroll
  for(int r=0;r<16;++r)rli[r]=__builtin_amdgcn_rcpf(wsf[32+crow(r,hi)]);
  bf16*Ow=O+(rowbase+q0+wid*QBLK)*OP+h*D;
  { bf16*stg=(bf16*)(shm+LDS_OST)+wid*2048;
    #pragma unroll
    for(int r=0;r<16;++r){const int orow=crow(r,hi);
      #pragma unroll
      for(int d0=0;d0<2;++d0)stg[orow*64+d0*32+r32]=__float2bfloat16(o[d0][r]*rli[r]);}
    asm volatile("s_waitcnt lgkmcnt(0)":::"memory");
    #pragma unroll
    for(int i=0;i<4;++i){const int row=i*8+(lane>>3),ch=lane&7; const u32x4 v=*(const u32x4*)(stg+row*64+ch*8); ATTN_STORE16(Ow+(long)row*OP+ch*8,v);} }
  asm volatile("s_waitcnt lgkmcnt(0)\n\ts_barrier":::"memory");
  #undef DMA_K
  #undef DMA_V
  #undef CMASK
  #undef START
  #undef RESC
  #undef ROT
  #undef CINIT
}
constexpr int ATTN_LDS_BYTES=LDS_BYTES;
struct AttnTensors { const bf16* Q; const bf16* K; const bf16* V; bf16* O; const float* CK; const float* KT; const float* QB; };
struct AttnUnit { int bh; int qb; };
struct QueueOrder {
  unsigned* head; volatile __attribute__((address_space(3))) int* slot;
  __device__ __forceinline__ bool next(int,AttnUnit&u)const{
    if(tid_l()==0) *slot=(int)__hip_atomic_fetch_add(head,1u,__ATOMIC_RELAXED,__HIP_MEMORY_SCOPE_AGENT);
    __syncthreads(); const int v=*slot; __syncthreads();
    if(v>=BATCH*NHEAD*NQB)return false; u.qb=NQB-1-v/(BATCH*NHEAD); u.bh=v%(BATCH*NHEAD); return true; }
  __device__ __forceinline__ void a_ready(const AttnUnit&)const{}
  __device__ __forceinline__ void done(const AttnUnit&)const{}
};
template<class Sched,int THRL=8> __device__ __forceinline__ void attn_phase(char*lds,const AttnTensors&T,const Sched&S){
  AttnUnit u;
  for(int i=0;S.next(i,u);++i){ S.a_ready(u); attn_unit<THRL>(u.bh/NHEAD,u.bh%NHEAD,u.qb,T.Q,T.K,T.V,T.O,T.CK,T.KT,T.QB,lds); S.done(u); }
}
#undef SBAR
#undef WAIT_BAR
}

constexpr int NB = 8, SEQ = 4096, T = NB * SEQ, D = 1024, DEPTH = 4;
constexpr int HCOLS = 3072;
constexpr int HC_AVAL = 0, HC_AGATE = 256, HC_BQ = 512, HC_BK = 704, HC_BV = 896, HC_BG = 1280, HC_CQ = 1664, HC_CK = 2048, HC_CV = 2432, HC_LR = 2816, HC_CF = 2832;
constexpr int IN_COLS = 2838;
constexpr int MC_A = 0, MC_B = 256, MC_C = 640;
constexpr float LN_EPS = 1e-5f;
constexpr float ALPHA = 1.6817928305074292f;
constexpr float LOG2E = 1.4426950408889634f;
constexpr float C2 = 0.125f * LOG2E;
constexpr float GLA_QSCALE = 0.17677669529663687f;
constexpr int NEXP = 16384;

constexpr size_t MiB = 1u << 20;
constexpr size_t WS_CTL = 0, CTL_ZERO_BYTES = 1 * MiB;
constexpr size_t WS_WIN = 1 * MiB;
constexpr size_t WS_WOUT = WS_WIN + 24 * MiB;
constexpr size_t WS_WP = WS_WOUT + 8 * MiB;
constexpr size_t WS_PGW = WS_WP + 16 * MiB;
constexpr size_t WS_PW = WS_PGW + 8 * MiB;
constexpr size_t WS_CK = WS_PW + 2 * MiB;
constexpr size_t WS_FKT = WS_CK + 768 * 1024, WS_FQB = WS_FKT + 16 * 1024;
constexpr size_t WS_U = WS_CK + 1 * MiB;
constexpr size_t WS_V = WS_U + 32 * MiB;
constexpr size_t WS_XB = WS_V + 32 * MiB;
constexpr size_t WS_XF = WS_XB + 64 * MiB;
constexpr size_t WS_XQ = WS_XF, WS_XS = WS_XF + 32 * MiB, WS_RS = WS_XS + 1 * MiB, WS_VS = WS_RS + 65536;
constexpr size_t WS_PB = WS_XF + 128 * MiB;
constexpr size_t WS_H = WS_PB + 16 * MiB;
constexpr size_t WS_MIX = WS_H + 192 * MiB;
constexpr size_t WS_SC = WS_H;
constexpr size_t WS_Y = WS_MIX + 64 * MiB;
constexpr size_t WS_GCUM = WS_Y;
constexpr size_t WS_GS = WS_GCUM + 24 * MiB;
constexpr size_t WS_GDEC = WS_GS + 24 * MiB;
constexpr size_t WS_E = WS_Y + 128 * MiB;
constexpr size_t WS_EIDX = WS_E + 64 * MiB;
constexpr size_t WS_GATE = WS_EIDX + 16 * MiB;
constexpr size_t WS_SOFF = WS_GATE + 16 * MiB;
constexpr size_t WS_END = WS_SOFF + 1 * MiB;
static_assert(WS_END <= 1024 * MiB, "d_ws map");

constexpr int LDS_BYTES = 147456;

typedef unsigned short bf16;
typedef float f32x4 __attribute__((ext_vector_type(4)));
typedef unsigned u32x4 __attribute__((ext_vector_type(4)));
typedef unsigned u32x2 __attribute__((ext_vector_type(2)));

struct Params {
    const float *x, *p, *w_in, *conv_w, *conv_b, *conv_ln_g, *conv_ln_b, *gla_gate_w, *gla_gate_b, *gla_norm_g, *fox_forget_b, *w_out, *ln1_g, *ln1_b,
        *peer_wq, *peer_keys, *peer_u, *peer_v, *ple_w, *ple_gw, *ple_gb, *ln2_g, *ln2_b;
    float* out; unsigned char* ws;
};

__device__ __forceinline__ float bf2f(unsigned h) { return __uint_as_float(h << 16); }
__device__ __forceinline__ unsigned f2bf(float f) { unsigned u = __float_as_uint(f); return (u + 0x7fffu + ((u >> 16) & 1u)) >> 16; }
__device__ __forceinline__ unsigned pk2(float lo, float hi) { return f2bf(lo) | (f2bf(hi) << 16); }
__device__ __forceinline__ float wave_sum(float v) {
#pragma unroll
    for (int o = 1; o < 64; o <<= 1) v += __shfl_xor(v, o);
    return v;
}
__device__ __forceinline__ float log_sigmoid(float z) { return fminf(z, 0.f) - log1pf(__expf(-fabsf(z))); }
__device__ __forceinline__ float sigmoidf_(float z) { return 1.0f / (1.0f + __expf(-z)); }

struct MapIdent { __device__ __forceinline__ void operator()(int n, int& c, float& s) const { c = n; s = 1.f; } };
struct MapWin {
    __device__ __forceinline__ void operator()(int n, int& c, float& s) const {
        s = 1.f;
        if (n < HC_CQ) { c = n; if (n >= HC_BQ && n < HC_BK) s = GLA_QSCALE; }
        else if (n < HC_LR) { c = n + 16; if (n < HC_CK) s = C2; }
        else if (n < HC_CF) c = n - HC_LR + 1664;
        else if (n < IN_COLS) c = n;
        else c = -1;
    }
};
template <class CM>
__device__ __forceinline__ void transpose_item(const float* W, int K, int Nsrc, bf16* WT, int item, int nblk, float* scr, int lane, const CM& cm) {
    const int kb = item / nblk, nb = item % nblk, k0 = 64 * kb, n0 = 32 * nb;
    int sc; float scale; cm(n0 + (lane & 31), sc, scale);
#pragma unroll 8
    for (int i = 0; i < 32; ++i) { const int kk = 2 * i + (lane >> 5); scr[kk * 33 + (lane & 31)] = sc >= 0 ? W[(size_t)(k0 + kk) * Nsrc + sc] * scale : 0.f; }
    __builtin_amdgcn_wave_barrier(); asm volatile("s_waitcnt lgkmcnt(0)" ::: "memory");
    const int c = lane & 7;
#pragma unroll
    for (int j = 0; j < 4; ++j) { const int n = (lane >> 3) + 8 * j; const float* s = scr + (8 * c) * 33 + n;
        u32x4 o; o.x = pk2(s[0 * 33], s[1 * 33]); o.y = pk2(s[2 * 33], s[3 * 33]); o.z = pk2(s[4 * 33], s[5 * 33]); o.w = pk2(s[6 * 33], s[7 * 33]);
        *(u32x4*)(WT + (size_t)(n0 + n) * K + k0 + 8 * c) = o; }
    asm volatile("s_waitcnt lgkmcnt(0)" ::: "memory"); __builtin_amdgcn_wave_barrier();
}
__device__ __forceinline__ void cvt_bf16_stream(const float* src, bf16* dst, size_t n8, size_t gtid, size_t gthreads) {
    for (size_t i = gtid; i < n8; i += gthreads) { const f32x4 a = *(const f32x4*)(src + i * 8), b = *(const f32x4*)(src + i * 8 + 4);
        u32x4 o; o.x = pk2(a[0], a[1]); o.y = pk2(a[2], a[3]); o.z = pk2(b[0], b[1]); o.w = pk2(b[2], b[3]); *(u32x4*)(dst + i * 8) = o; }
}

__device__ __forceinline__ void phase_pro_a(const Params& p, unsigned char* lds) {
    const int tid = tid_l(), lane = tid & 63, wave = tid >> 6;
    float* scr = (float*)(lds + wave * 16384);
    const int gw = bid_l() * 8 + wave, NGW = grid_l() * 8;
    constexpr int I_WIN = (D / 64) * (HCOLS / 32), I_SQ = (D / 64) * (D / 32), I_PW = (256 / 64) * (D / 32);
    constexpr int PER_L = I_WIN + 2 * I_SQ + I_PW;
    for (int it = gw; it < DEPTH * PER_L; it += NGW) {
        const int l = it / PER_L; int r = it % PER_L;
        if (r < I_WIN) { transpose_item(p.w_in + (size_t)l * D * IN_COLS, D, IN_COLS, (bf16*)(p.ws + WS_WIN) + (size_t)l * HCOLS * D, r, HCOLS / 32, scr, lane, MapWin()); continue; } r -= I_WIN;
        if (r < I_SQ) { transpose_item(p.w_out + (size_t)l * D * D, D, D, (bf16*)(p.ws + WS_WOUT) + (size_t)l * D * D, r, D / 32, scr, lane, MapIdent()); continue; } r -= I_SQ;
        if (r < I_SQ) { transpose_item(p.ple_gw + (size_t)l * D * D, D, D, (bf16*)(p.ws + WS_PGW) + (size_t)l * D * D, r, D / 32, scr, lane, MapIdent()); continue; } r -= I_SQ;
        transpose_item(p.ple_w + (size_t)l * 256 * D, 256, D, (bf16*)(p.ws + WS_PW) + (size_t)l * D * 256, r, D / 32, scr, lane, MapIdent());
    }
    cvt_bf16_stream(p.x, (bf16*)(p.ws + WS_XB), (size_t)T * D / 8, (size_t)bid_l() * 512 + tid, (size_t)grid_l() * 512);
}
__device__ __forceinline__ void phase_pro_b(const Params& p, unsigned char* lds) {
    const int tid = tid_l();
    float* ks = (float*)lds;
    float* wqs = ks + 128 * 129;
    for (int it = bid_l(); it < DEPTH * 16 * 16; it += grid_l()) {
        const int l = it >> 8, hc = (it >> 4) & 15, kt = it & 15;
        const float* keys = p.peer_keys + ((size_t)l * 16 + hc) * 16384;
        const float* wq = p.peer_wq + (size_t)l * D * 2048 + (size_t)(kt * 64) * 2048 + hc * 128;
        __syncthreads();
        for (int i = tid; i < 128 * 128; i += 512) ks[(i >> 7) * 129 + (i & 127)] = keys[i];
        for (int i = tid; i < 64 * 128; i += 512) wqs[(i >> 7) * 129 + (i & 127)] = wq[(size_t)(i >> 7) * 2048 + (i & 127)];
        __syncthreads();
        const int k = tid & 63, n0 = (tid >> 6) * 16;
        float acc[16];
#pragma unroll
        for (int j = 0; j < 16; ++j) acc[j] = 0.f;
        for (int d = 0; d < 128; ++d) { const float a = wqs[k * 129 + d];
#pragma unroll
            for (int j = 0; j < 16; ++j) acc[j] += a * ks[(n0 + j) * 129 + d]; }
        bf16* WpT = (bf16*)(p.ws + WS_WP) + (size_t)l * 2048 * D;
#pragma unroll
        for (int j = 0; j < 16; ++j) WpT[(size_t)(hc * 128 + n0 + j) * D + kt * 64 + k] = (bf16)f2bf(acc[j]);
    }
}
constexpr float U8_SCALE = 64.f, V8_SCALE = 1.f;
typedef float f32x2v __attribute__((ext_vector_type(2)));
__device__ __forceinline__ unsigned pk_fp8x4(f32x4 v, float sc) {
    const float a = fminf(fmaxf(v[0] * sc, -448.f), 448.f), b = fminf(fmaxf(v[1] * sc, -448.f), 448.f), c = fminf(fmaxf(v[2] * sc, -448.f), 448.f), d = fminf(fmaxf(v[3] * sc, -448.f), 448.f);
    int w = __builtin_amdgcn_cvt_pk_fp8_f32(a, b, 0, false); w = __builtin_amdgcn_cvt_pk_fp8_f32(c, d, w, true); return (unsigned)w;
}
__device__ __forceinline__ void cvt_fp8_stream(const float* src, unsigned char* dst, size_t n16, float sc, size_t gtid, size_t gthreads) {
    for (size_t i = gtid; i < n16; i += gthreads) { const float* s = src + i * 16; u32x4 o;
        o.x = pk_fp8x4(*(const f32x4*)(s), sc); o.y = pk_fp8x4(*(const f32x4*)(s + 4), sc); o.z = pk_fp8x4(*(const f32x4*)(s + 8), sc); o.w = pk_fp8x4(*(const f32x4*)(s + 12), sc);
        *(u32x4*)(dst + i * 16) = o; }
}
__device__ __forceinline__ float wave_max(float v) {
#pragma unroll
    for (int o = 32; o > 0; o >>= 1) v = fmaxf(v, __shfl_xor(v, o));
    return v;
}
__device__ __forceinline__ unsigned pk_i8x4(f32x4 v, float sc) {
    const int a = (int)__builtin_rintf(v[0] * sc), b = (int)__builtin_rintf(v[1] * sc), c = (int)__builtin_rintf(v[2] * sc), d = (int)__builtin_rintf(v[3] * sc);
    return (unsigned)(a & 255) | ((unsigned)(b & 255) << 8) | ((unsigned)(c & 255) << 16) | ((unsigned)d << 24);
}
__device__ __forceinline__ void cvt_i8_rows(const float* src, unsigned char* dst, float* RS, size_t n16, size_t gtid, size_t gthreads) {
    for (size_t i = gtid; i < n16; i += gthreads) { const float* s_ = src + i * 16;
        const f32x4 a = *(const f32x4*)(s_), b = *(const f32x4*)(s_ + 4), c = *(const f32x4*)(s_ + 8), d = *(const f32x4*)(s_ + 12);
        float m = fmaxf(fmaxf(fmaxf(fabsf(a[0]), fabsf(a[1])), fmaxf(fabsf(a[2]), fabsf(a[3]))), fmaxf(fmaxf(fabsf(b[0]), fabsf(b[1])), fmaxf(fabsf(b[2]), fabsf(b[3]))));
        m = fmaxf(m, fmaxf(fmaxf(fmaxf(fabsf(c[0]), fabsf(c[1])), fmaxf(fabsf(c[2]), fabsf(c[3]))), fmaxf(fmaxf(fabsf(d[0]), fabsf(d[1])), fmaxf(fabsf(d[2]), fabsf(d[3])))));
        m = wave_max(m); const float sc = m > 0.f ? 127.0f / m : 0.f;
        u32x4 o; o.x = pk_i8x4(a, sc); o.y = pk_i8x4(b, sc); o.z = pk_i8x4(c, sc); o.w = pk_i8x4(d, sc);
        *(u32x4*)(dst + i * 16) = o;
        if ((i & 63) == 0) RS[i >> 6] = m * (1.0f / 127.0f); }
}
__device__ __forceinline__ unsigned pk_i4x8(f32x4 a, f32x4 b, float sc) {
    unsigned w = 0u;
#pragma unroll
    for (int i = 0; i < 4; ++i) { w |= ((unsigned)(int)__builtin_rintf(a[i] * sc) & 15u) << (4 * i); w |= ((unsigned)(int)__builtin_rintf(b[i] * sc) & 15u) << (16 + 4 * i); }
    return w;
}
__device__ __forceinline__ void cvt_i4_rows(const float* src, unsigned char* dst, float* RS, size_t n16, size_t gtid, size_t gthreads) {
    for (size_t i = gtid; i < n16; i += gthreads) { const float* s_ = src + i * 16;
        const f32x4 a = *(const f32x4*)(s_), b = *(const f32x4*)(s_ + 4), c = *(const f32x4*)(s_ + 8), d = *(const f32x4*)(s_ + 12);
        float m = fmaxf(fmaxf(fmaxf(fabsf(a[0]), fabsf(a[1])), fmaxf(fabsf(a[2]), fabsf(a[3]))), fmaxf(fmaxf(fabsf(b[0]), fabsf(b[1])), fmaxf(fabsf(b[2]), fabsf(b[3]))));
        m = fmaxf(m, fmaxf(fmaxf(fmaxf(fabsf(c[0]), fabsf(c[1])), fmaxf(fabsf(c[2]), fabsf(c[3]))), fmaxf(fmaxf(fabsf(d[0]), fabsf(d[1])), fmaxf(fabsf(d[2]), fabsf(d[3])))));
        m = wave_max(m); const float sc = m > 0.f ? 7.49f / m : 0.f;
        u32x2 o; o.x = pk_i4x8(a, b, sc); o.y = pk_i4x8(c, d, sc); *(u32x2*)(dst + i * 8) = o;
        if ((i & 63) == 0) RS[i >> 6] = m * (1.0f / 7.49f); }
}
__device__ __forceinline__ void cvt_fp4_rows(const float* src, unsigned char* dst, float* VS, size_t n16, size_t gtid, size_t gthreads) {
    for (size_t i = gtid; i < n16; i += gthreads) { const float* s_ = src + i * 16;
        const f32x4 a = *(const f32x4*)(s_), b = *(const f32x4*)(s_ + 4), c = *(const f32x4*)(s_ + 8), d = *(const f32x4*)(s_ + 12);
        float m = fmaxf(fmaxf(fmaxf(fabsf(a[0]), fabsf(a[1])), fmaxf(fabsf(a[2]), fabsf(a[3]))), fmaxf(fmaxf(fabsf(b[0]), fabsf(b[1])), fmaxf(fabsf(b[2]), fabsf(b[3]))));
        m = fmaxf(m, fmaxf(fmaxf(fmaxf(fabsf(c[0]), fabsf(c[1])), fmaxf(fabsf(c[2]), fabsf(c[3]))), fmaxf(fmaxf(fabsf(d[0]), fabsf(d[1])), fmaxf(fabsf(d[2]), fabsf(d[3])))));
        m = wave_max(m); const float sc = m > 0.f ? 6.0f / m : 0.f;
        unsigned w0 = 0u, w1 = 0u;
        w0 = __builtin_amdgcn_cvt_scalef32_pk_fp4_f32(w0, a[0] * sc, a[1] * sc, 1.0f, 0); w0 = __builtin_amdgcn_cvt_scalef32_pk_fp4_f32(w0, a[2] * sc, a[3] * sc, 1.0f, 1);
        w0 = __builtin_amdgcn_cvt_scalef32_pk_fp4_f32(w0, b[0] * sc, b[1] * sc, 1.0f, 2); w0 = __builtin_amdgcn_cvt_scalef32_pk_fp4_f32(w0, b[2] * sc, b[3] * sc, 1.0f, 3);
        w1 = __builtin_amdgcn_cvt_scalef32_pk_fp4_f32(w1, c[0] * sc, c[1] * sc, 1.0f, 0); w1 = __builtin_amdgcn_cvt_scalef32_pk_fp4_f32(w1, c[2] * sc, c[3] * sc, 1.0f, 1);
        w1 = __builtin_amdgcn_cvt_scalef32_pk_fp4_f32(w1, d[0] * sc, d[1] * sc, 1.0f, 2); w1 = __builtin_amdgcn_cvt_scalef32_pk_fp4_f32(w1, d[2] * sc, d[3] * sc, 1.0f, 3);
        u32x2 o; o.x = w0; o.y = w1; *(u32x2*)(dst + i * 8) = o;
        if ((i & 63) == 0) VS[i >> 6] = m * (1.0f / 6.0f); }
}
__device__ __forceinline__ void phase_cvt(const Params& p, int l) {
    const size_t gtid = (size_t)bid_l() * 512 + tid_l(), gth = (size_t)grid_l() * 512;
    cvt_bf16_stream(p.p + (size_t)l * T * 256, (bf16*)(p.ws + WS_PB), (size_t)T * 256 / 8, gtid, gth);
    cvt_i4_rows(p.peer_u + (size_t)l * NEXP * D, p.ws + WS_U, (float*)(p.ws + WS_RS), (size_t)NEXP * D / 16, gtid, gth);
    cvt_fp4_rows(p.peer_v + (size_t)l * NEXP * D, p.ws + WS_V, (float*)(p.ws + WS_VS), (size_t)NEXP * D / 16, gtid, gth);
}

#define GEMM_RUN(EPI, e, Aptr, Bptr, N_, K_) do { int kk_ = (K_); asm volatile("" : "+s"(kk_)); pg8::Gemm g{(const pg8::bf16_t*)(Aptr), (const pg8::bf16_t*)(Bptr), T, (N_), kk_}; pg8::StaticOrder S; S.init(T, (N_), (int)grid_l(), (int)bid_l()); \
    pg8::gemm_phase<EPI, pg8::StaticOrder, true, true>((PG8_LAS unsigned char*)lds, g, S, e); } while (0)

__device__ __forceinline__ void phase_gemm_in(const Params& p, int l, unsigned char* lds) {
    pg8::EpiBf16<0> e{(pg8::bf16_t*)(p.ws + WS_H), HCOLS, nullptr, 0, 0, 1.f};
    GEMM_RUN(pg8::EpiBf16<0>, e, p.ws + WS_XB, (bf16*)(p.ws + WS_WIN) + (size_t)l * HCOLS * D, HCOLS, D);
}
__device__ __forceinline__ void phase_gemm_e(const Params& p, int l, unsigned char* lds) {
    pg8::EpiBf16<0> e{(pg8::bf16_t*)(p.ws + WS_E), D, nullptr, 0, 0, 1.f};
    GEMM_RUN(pg8::EpiBf16<0>, e, p.ws + WS_PB, (bf16*)(p.ws + WS_PW) + (size_t)l * D * 256, D, 256);
}
__device__ __forceinline__ void phase_gemm_out(const Params& p, int l, unsigned char* lds) {
    pg8::EpiResid e{(const pg8::bf16_t*)(p.ws + WS_XB), (_Float16*)(p.ws + WS_Y), D, ALPHA};
    GEMM_RUN(pg8::EpiResid, e, p.ws + WS_MIX, (bf16*)(p.ws + WS_WOUT) + (size_t)l * D * D, D, D);
}
__device__ __forceinline__ void phase_gemm_sc(const Params& p, int l, unsigned char* lds) {
    pg8::EpiF16 e{(_Float16*)(p.ws + WS_SC), 2048};
    GEMM_RUN(pg8::EpiF16, e, p.ws + WS_XB, (bf16*)(p.ws + WS_WP) + (size_t)l * 2048 * D, 2048, D);
}
__device__ __forceinline__ void phase_gemm_ple(const Params& p, int l, unsigned char* lds) {
    pg8::EpiPle e{(const pg8::bf16_t*)(p.ws + WS_XB), (_Float16*)(p.ws + WS_Y), (const pg8::bf16_t*)(p.ws + WS_E), p.ple_gb + (size_t)l * D, D};
    GEMM_RUN(pg8::EpiPle, e, p.ws + WS_XB, (bf16*)(p.ws + WS_PGW) + (size_t)l * D * D, D, D);
}

__device__ __forceinline__ void phase_conv(const Params& p, int l, unsigned char* lds) {
    const int tid = tid_l(), lane = tid & 63, wave = tid >> 6;
    float* U = (float*)lds;
    float* Yt = U + 62 * 256;
    const bf16* H = (const bf16*)(p.ws + WS_H); bf16* MIX = (bf16*)(p.ws + WS_MIX);
    const float* cw = p.conv_w + (size_t)l * 31 * 256; const float* cb = p.conv_b + l * 256;
    const float* lg = p.conv_ln_g + l * 256; const float* lb = p.conv_ln_b + l * 256;
    for (int it = bid_l(); it < T / 32; it += grid_l()) {
        const int b = it / (SEQ / 32), t0 = (it % (SEQ / 32)) * 32;
        __syncthreads();
        for (int i = tid; i < 62 * 32; i += 512) { const int r = i >> 5, c8 = (i & 31) * 8, t = t0 - 30 + r; f32x4 u0 = {0.f, 0.f, 0.f, 0.f}, u1 = {0.f, 0.f, 0.f, 0.f};
            if (t >= 0) { const bf16* hr = H + (size_t)(b * SEQ + t) * HCOLS; const u32x4 av = *(const u32x4*)(hr + HC_AVAL + c8), gv = *(const u32x4*)(hr + HC_AGATE + c8);
#pragma unroll
                for (int j = 0; j < 2; ++j) { u0[2 * j] = bf2f(av[j] & 0xffffu) * sigmoidf_(bf2f(gv[j] & 0xffffu)); u0[2 * j + 1] = __uint_as_float(av[j] & 0xffff0000u) * sigmoidf_(__uint_as_float(gv[j] & 0xffff0000u));
                                              u1[2 * j] = bf2f(av[2 + j] & 0xffffu) * sigmoidf_(bf2f(gv[2 + j] & 0xffffu)); u1[2 * j + 1] = __uint_as_float(av[2 + j] & 0xffff0000u) * sigmoidf_(__uint_as_float(gv[2 + j] & 0xffff0000u)); } }
            *(f32x4*)(U + r * 256 + c8) = u0; *(f32x4*)(U + r * 256 + c8 + 4) = u1; }
        __syncthreads();
        { const int c = tid & 255, half = tid >> 8; float w[31], win[46];
#pragma unroll
          for (int j = 0; j < 31; ++j) w[j] = cw[j * 256 + c];
#pragma unroll
          for (int j = 0; j < 46; ++j) win[j] = U[(half * 16 + j) * 256 + c];
          const float bias = cb[c];
#pragma unroll
          for (int tl = 0; tl < 16; ++tl) { float y = bias;
#pragma unroll
              for (int j = 0; j < 31; ++j) y += w[j] * win[tl + j];
              Yt[(half * 16 + tl) * 256 + c] = y; } }
        __syncthreads();
        for (int tl = wave * 4; tl < wave * 4 + 4; ++tl) {
            const f32x4 v = *(const f32x4*)(Yt + tl * 256 + lane * 4);
            const float mean = wave_sum((v[0] + v[1]) + (v[2] + v[3])) * (1.f / 256.f);
            const f32x4 d = v - mean; const float var = wave_sum((d[0] * d[0] + d[1] * d[1]) + (d[2] * d[2] + d[3] * d[3])) * (1.f / 256.f);
            const float rstd = 1.0f / sqrtf(var + LN_EPS);
            const f32x4 g4 = *(const f32x4*)(lg + lane * 4), b4 = *(const f32x4*)(lb + lane * 4);
            float o[4];
#pragma unroll
            for (int i = 0; i < 4; ++i) { const float z = d[i] * rstd * g4[i] + b4[i]; o[i] = z * sigmoidf_(z); }
            u32x2 w2; w2.x = pk2(o[0], o[1]); w2.y = pk2(o[2], o[3]);
            *(u32x2*)(MIX + (size_t)(b * SEQ + t0 + tl) * D + MC_A + lane * 4) = w2;
        }
    }
}

__device__ __forceinline__ void phase_fox_cum(const Params& p, int l, unsigned char* lds) {
    const int tid = tid_l(), lane = tid & 63, wave = tid >> 6;
    float* wsum = (float*)lds;
    const bf16* H = (const bf16*)(p.ws + WS_H); float* CK = (float*)(p.ws + WS_CK);
    for (int bh = bid_l(); bh < 48; bh += grid_l()) {
        const int b = bh / 6, h = bh % 6; const float bias = p.fox_forget_b[l * 6 + h];
        float v[8]; float s = 0.f;
#pragma unroll
        for (int i = 0; i < 8; ++i) { const float f = bf2f(H[(size_t)(b * SEQ + tid * 8 + i) * HCOLS + HC_CF + h]); s += log_sigmoid(f + bias) * LOG2E; v[i] = s; }
        float incl = s;
#pragma unroll
        for (int o = 1; o < 64; o <<= 1) { const float n = __shfl_up(incl, o); if (lane >= o) incl += n; }
        __syncthreads();
        if (lane == 63) wsum[wave] = incl;
        __syncthreads();
        float base = incl - s;
        for (int w = 0; w < wave; ++w) base += wsum[w];
#pragma unroll
        for (int i = 0; i < 8; ++i) CK[(size_t)bh * SEQ + tid * 8 + i] = base + v[i];
    }
}

__device__ __forceinline__ void phase_fox_norm(const Params& p, unsigned char* lds) {
    const int tid = tid_l(), lane = tid & 63, wave = tid >> 6;
    float* qns = (float*)lds; float* kns = qns + 256;
    const bf16* H = (const bf16*)(p.ws + WS_H); float* KT = (float*)(p.ws + WS_FKT); float* QBM = (float*)(p.ws + WS_FQB);
    for (int it = bid_l(); it < 48 * 16; it += grid_l()) {
        const int bh = it >> 4, qb = it & 15, b = bh / 6, h = bh % 6;
        __syncthreads();
        if (tid < 256) { const bf16* row = H + ((size_t)b * SEQ + qb * 256 + tid) * HCOLS + h * 64; float sq = 0.f, sk = 0.f;
#pragma unroll
            for (int j = 0; j < 8; ++j) { const u32x4 qv = *(const u32x4*)(row + HC_CQ + 8 * j), kv = *(const u32x4*)(row + HC_CK + 8 * j);
#pragma unroll
                for (int i = 0; i < 4; ++i) { const float a0 = bf2f(qv[i] & 0xffffu), a1 = __uint_as_float(qv[i] & 0xffff0000u), b0 = bf2f(kv[i] & 0xffffu), b1 = __uint_as_float(kv[i] & 0xffff0000u);
                    sq += a0 * a0 + a1 * a1; sk += b0 * b0 + b1 * b1; } }
            qns[tid] = sqrtf(sq); kns[tid] = sqrtf(sk); }
        __syncthreads();
        if (wave < 5) { float v = wave < 4 ? kns[wave * 64 + lane] : fmaxf(fmaxf(qns[lane], qns[64 + lane]), fmaxf(qns[128 + lane], qns[192 + lane]));
#pragma unroll
            for (int o = 1; o < 64; o <<= 1) v = fmaxf(v, __shfl_xor(v, o));
            if (lane == 0) { if (wave < 4) KT[bh * 64 + 4 * qb + wave] = v; else QBM[bh * 16 + qb] = v; } }
    }
}

typedef short bf16x8_t __attribute__((ext_vector_type(8)));
typedef float f32x16_t __attribute__((ext_vector_type(16)));
__device__ __forceinline__ int crow32(int r, int hi) { return (r & 3) + 8 * (r >> 2) + 4 * hi; }
struct GlaB1Pre { u32x4 vv, lr0, lr1; u32x2 kk; float w2v, b2v; };
__device__ __forceinline__ GlaB1Pre gla_b1_load(const Params& p, int l, int it, int tid, int lane, int wave) {
    const int bh = it >> 6, n = it & 63, b = bh / 6, h = bh % 6; const size_t tok0 = (size_t)b * SEQ + n * 64; const bf16* H = (const bf16*)(p.ws + WS_H);
    GlaB1Pre r; r.w2v = p.gla_gate_w[(size_t)l * 16 * 192 + (tid >> 5) * 192 + h * 32 + (tid & 31)]; r.b2v = p.gla_gate_b[l * 192 + h * 32 + (tid & 31)];
    r.vv = *(const u32x4*)(H + (tok0 + (tid >> 3)) * HCOLS + HC_BV + h * 64 + (tid & 7) * 8);
    r.lr0 = *(const u32x4*)(H + (tok0 + lane) * HCOLS + HC_LR); r.lr1 = *(const u32x4*)(H + (tok0 + lane) * HCOLS + HC_LR + 8);
    r.kk = *(const u32x2*)(H + (tok0 + lane) * HCOLS + HC_BK + h * 32 + wave * 4);
    return r;
}
__device__ __forceinline__ void phase_gla_b1(const Params& p, int l, unsigned char* lds) {
    const int tid = tid_l(), lane = tid & 63, wave = tid >> 6, r32 = lane & 31, hi = lane >> 5;
    bf16* KDT = (bf16*)lds;
    bf16* VT = KDT + 32 * 72;
    float* w2s = (float*)(VT + 64 * 72);
    float* b2s = w2s + 16 * 32;
    float* GCUM = (float*)(p.ws + WS_GCUM); float* GS = (float*)(p.ws + WS_GS); float* GDEC = (float*)(p.ws + WS_GDEC);
    const int NI = 48 * 64, G = grid_l(); int it = bid_l();
    if (it >= NI) return;
    GlaB1Pre cur = gla_b1_load(p, l, it, tid, lane, wave);
#pragma unroll 1
    for (; it < NI; it += G) {
        const GlaB1Pre nxt = gla_b1_load(p, l, it + G < NI ? it + G : it, tid, lane, wave);
        __builtin_amdgcn_sched_barrier(0);
        const int bh = it >> 6, n = it & 63, b = bh / 6, h = bh % 6; const size_t tok0 = (size_t)b * SEQ + n * 64;
        __syncthreads();
        w2s[tid] = cur.w2v;
        if (tid < 32) b2s[tid] = cur.b2v;
        { const int s_ = tid >> 3, e0 = (tid & 7) * 8;
#pragma unroll
          for (int i = 0; i < 4; ++i) { VT[(e0 + 2 * i) * 72 + s_] = (bf16)(cur.vv[i] & 0xffffu); VT[(e0 + 2 * i + 1) * 72 + s_] = (bf16)(cur.vv[i] >> 16); } }
        const int d0 = wave * 4;
        __syncthreads();
        float lrf[16];
#pragma unroll
        for (int i = 0; i < 4; ++i) { lrf[2 * i] = bf2f(cur.lr0[i] & 0xffffu); lrf[2 * i + 1] = __uint_as_float(cur.lr0[i] & 0xffff0000u); lrf[8 + 2 * i] = bf2f(cur.lr1[i] & 0xffffu); lrf[8 + 2 * i + 1] = __uint_as_float(cur.lr1[i] & 0xffff0000u); }
        float g[4];
#pragma unroll
        for (int dd = 0; dd < 4; ++dd) { float x = b2s[d0 + dd];
#pragma unroll
            for (int r = 0; r < 16; ++r) x += lrf[r] * w2s[r * 32 + d0 + dd];
            g[dd] = log_sigmoid(x) * (1.0f / 16.0f); }
#pragma unroll
        for (int o = 1; o < 64; o <<= 1)
#pragma unroll
            for (int dd = 0; dd < 4; ++dd) { const float v = __shfl_up(g[dd], o); if (lane >= o) g[dd] += v; }
        *(f32x4*)(GCUM + (tok0 + lane) * 192 + h * 32 + d0) = (f32x4){g[0], g[1], g[2], g[3]};
        const float kf[4] = {bf2f(cur.kk.x & 0xffffu), __uint_as_float(cur.kk.x & 0xffff0000u), bf2f(cur.kk.y & 0xffffu), __uint_as_float(cur.kk.y & 0xffff0000u)};
#pragma unroll
        for (int dd = 0; dd < 4; ++dd) { const float last = __uint_as_float(__builtin_amdgcn_readlane(__float_as_uint(g[dd]), 63));
            KDT[(d0 + dd) * 72 + lane] = (bf16)f2bf(kf[dd] * __expf(last - g[dd]));
            if (lane == 63) GDEC[(size_t)it * 32 + d0 + dd] = __expf(last); }
        __syncthreads();
        if (wave < 2) {
            f32x16_t acc = {};
#pragma unroll
            for (int ks = 0; ks < 4; ++ks) { const bf16x8_t a = *(const bf16x8_t*)(KDT + r32 * 72 + 16 * ks + 8 * hi), bb = *(const bf16x8_t*)(VT + (32 * wave + r32) * 72 + 16 * ks + 8 * hi);
                acc = __builtin_amdgcn_mfma_f32_32x32x16_bf16(a, bb, acc, 0, 0, 0); }
#pragma unroll
            for (int r = 0; r < 16; ++r) GS[(size_t)it * 2048 + crow32(r, hi) * 64 + 32 * wave + r32] = acc[r];
        }
        cur = nxt;
    }
}
__device__ __forceinline__ void phase_gla_b2(const Params& p) {
    float* GS = (float*)(p.ws + WS_GS); const float* GDEC = (const float*)(p.ws + WS_GDEC);
    for (int g = bid_l() * 512 + tid_l(); g < 48 * 2048; g += grid_l() * 512) {
        const int bh = g >> 11, de = g & 2047, d = de >> 6; float S = 0.f;
        float* gs = GS + (size_t)bh * 64 * 2048 + de; const float* gd = GDEC + (size_t)bh * 64 * 32 + d;
#pragma unroll 1
        for (int n0 = 0; n0 < 64; n0 += 16) { float loc[16], dec[16];
#pragma unroll
            for (int i = 0; i < 16; ++i) { loc[i] = gs[(size_t)(n0 + i) * 2048]; dec[i] = gd[(n0 + i) * 32]; }
#pragma unroll
            for (int i = 0; i < 16; ++i) { gs[(size_t)(n0 + i) * 2048] = S; S = S * dec[i] + loc[i]; } }
    }
}
struct GlaB3Pre { u32x2 qq, kk; f32x4 c; u32x4 vv; f32x4 sv; u32x4 gr; };
__device__ __forceinline__ GlaB3Pre gla_b3_load(const Params& p, int it, int tid) {
    const int bh = it >> 6, n = it & 63, b = bh / 6, h = bh % 6; const size_t tok0 = (size_t)b * SEQ + n * 64; const bf16* H = (const bf16*)(p.ws + WS_H);
    const float* GCUM = (const float*)(p.ws + WS_GCUM); const float* GS = (const float*)(p.ws + WS_GS);
    GlaB3Pre r; const int t = tid >> 3, d0 = (tid & 7) * 4;
    r.qq = *(const u32x2*)(H + (tok0 + t) * HCOLS + HC_BQ + h * 32 + d0); r.kk = *(const u32x2*)(H + (tok0 + t) * HCOLS + HC_BK + h * 32 + d0);
    r.c = *(const f32x4*)(GCUM + (tok0 + t) * 192 + h * 32 + d0);
    r.vv = *(const u32x4*)(H + (tok0 + t) * HCOLS + HC_BV + h * 64 + (tid & 7) * 8);
    r.sv = *(const f32x4*)(GS + (size_t)it * 2048 + (tid >> 4) * 64 + (tid & 15) * 4);
    r.gr = *(const u32x4*)(H + (tok0 + t) * HCOLS + HC_BG + h * 64 + (tid & 7) * 8);
    return r;
}
__device__ __forceinline__ void phase_gla_b3(const Params& p, int l, unsigned char* lds) {
    const int tid = tid_l(), lane = tid & 63, wave = tid >> 6, r32 = lane & 31, hi = lane >> 5;
    bf16* QE = (bf16*)lds;
    bf16* KE = QE + 64 * 40;
    bf16* VT = KE + 64 * 40;
    bf16* ST = VT + 64 * 72;
    bf16* P = ST + 64 * 40;
    float* O = (float*)(P + 64 * 72);
    bf16* MIX = (bf16*)(p.ws + WS_MIX);
    const int NI = 48 * 64, G = grid_l(); int it = bid_l();
    if (it >= NI) return;
    GlaB3Pre cur = gla_b3_load(p, it, tid);
#pragma unroll 1
    for (; it < NI; it += G) {
        const GlaB3Pre nxt = gla_b3_load(p, it + G < NI ? it + G : it, tid);
        __builtin_amdgcn_sched_barrier(0);
        const int bh = it >> 6, n = it & 63, b = bh / 6, h = bh % 6; const size_t tok0 = (size_t)b * SEQ + n * 64;
        __syncthreads();
        { const int t = tid >> 3, d0 = (tid & 7) * 4; const u32x2 qq = cur.qq, kk = cur.kk; const f32x4 c = cur.c;
          const float e0 = __expf(c[0]), e1 = __expf(c[1]), e2 = __expf(c[2]), e3 = __expf(c[3]);
          u32x2 qo, ko;
          qo.x = pk2(bf2f(qq.x & 0xffffu) * e0, __uint_as_float(qq.x & 0xffff0000u) * e1); qo.y = pk2(bf2f(qq.y & 0xffffu) * e2, __uint_as_float(qq.y & 0xffff0000u) * e3);
          ko.x = pk2(bf2f(kk.x & 0xffffu) / e0, __uint_as_float(kk.x & 0xffff0000u) / e1); ko.y = pk2(bf2f(kk.y & 0xffffu) / e2, __uint_as_float(kk.y & 0xffff0000u) / e3);
          *(u32x2*)(QE + t * 40 + d0) = qo; *(u32x2*)(KE + t * 40 + d0) = ko; }
        { const int s_ = tid >> 3, e0 = (tid & 7) * 8;
#pragma unroll
          for (int i = 0; i < 4; ++i) { VT[(e0 + 2 * i) * 72 + s_] = (bf16)(cur.vv[i] & 0xffffu); VT[(e0 + 2 * i + 1) * 72 + s_] = (bf16)(cur.vv[i] >> 16); } }
        { const int d = tid >> 4, e0 = (tid & 15) * 4;
#pragma unroll
          for (int i = 0; i < 4; ++i) ST[(e0 + i) * 40 + d] = (bf16)f2bf(cur.sv[i]); }
        __syncthreads();
        f32x16_t acc = {};
        const int tt = (wave & 3) >> 1, tc = wave & 1;
        if (wave < 4) {
            if (!(tt == 0 && tc == 1)) {
#pragma unroll
                for (int ks = 0; ks < 2; ++ks) { const bf16x8_t a = *(const bf16x8_t*)(QE + (32 * tt + r32) * 40 + 16 * ks + 8 * hi), bb = *(const bf16x8_t*)(KE + (32 * tc + r32) * 40 + 16 * ks + 8 * hi);
                    acc = __builtin_amdgcn_mfma_f32_32x32x16_bf16(a, bb, acc, 0, 0, 0); }
#pragma unroll
                for (int r = 0; r < 16; ++r) { const int trow = 32 * tt + crow32(r, hi), scol = 32 * tc + r32; P[trow * 72 + scol] = (bf16)f2bf(scol <= trow ? acc[r] : 0.f); }
            }
        } else {
#pragma unroll
            for (int ks = 0; ks < 2; ++ks) { const bf16x8_t a = *(const bf16x8_t*)(QE + (32 * tt + r32) * 40 + 16 * ks + 8 * hi), bb = *(const bf16x8_t*)(ST + (32 * tc + r32) * 40 + 16 * ks + 8 * hi);
                acc = __builtin_amdgcn_mfma_f32_32x32x16_bf16(a, bb, acc, 0, 0, 0); }
        }
        __syncthreads();
        if (wave >= 4) {
            const int nks = tt == 0 ? 2 : 4;
            for (int ks = 0; ks < nks; ++ks) { const bf16x8_t a = *(const bf16x8_t*)(P + (32 * tt + r32) * 72 + 16 * ks + 8 * hi), bb = *(const bf16x8_t*)(VT + (32 * tc + r32) * 72 + 16 * ks + 8 * hi);
                acc = __builtin_amdgcn_mfma_f32_32x32x16_bf16(a, bb, acc, 0, 0, 0); }
#pragma unroll
            for (int r = 0; r < 16; ++r) O[(32 * tt + crow32(r, hi)) * 65 + 32 * tc + r32] = acc[r];
        }
        __syncthreads();
        { const int t = tid >> 3, e0 = (tid & 7) * 8; float o[8]; float ss = 0.f;
#pragma unroll
          for (int i = 0; i < 8; ++i) { o[i] = O[t * 65 + e0 + i]; ss += o[i] * o[i]; }
          ss += __shfl_xor(ss, 1); ss += __shfl_xor(ss, 2); ss += __shfl_xor(ss, 4);
          const float rs = 1.0f / sqrtf(ss * (1.f / 64.f) + LN_EPS);
          const float* ng = p.gla_norm_g + l * 384 + h * 64 + e0; const u32x4 gr = cur.gr;
          float r[8];
#pragma unroll
          for (int i = 0; i < 4; ++i) { const float ga = bf2f(gr[i] & 0xffffu), gb = __uint_as_float(gr[i] & 0xffff0000u);
              r[2 * i] = o[2 * i] * rs * ng[2 * i] * (ga * sigmoidf_(ga)); r[2 * i + 1] = o[2 * i + 1] * rs * ng[2 * i + 1] * (gb * sigmoidf_(gb)); }
          u32x4 w; w.x = pk2(r[0], r[1]); w.y = pk2(r[2], r[3]); w.z = pk2(r[4], r[5]); w.w = pk2(r[6], r[7]);
          *(u32x4*)(MIX + (tok0 + t) * D + MC_B + h * 64 + e0) = w; }
        cur = nxt;
    }
}

constexpr int LDSQ_OFF = LDS_BYTES - 1024;
constexpr int CW_ATTNQ = 8192;
__device__ __forceinline__ void phase_fox_mfma(const Params& p, int l, unsigned char* lds) {
    const attn_body::bf16* H = (const attn_body::bf16*)(p.ws + WS_H);
    const attn_body::AttnTensors AT{H + HC_CQ, H + HC_CK, H + HC_CV, (attn_body::bf16*)(p.ws + WS_MIX) + MC_C, (const float*)(p.ws + WS_CK), (const float*)(p.ws + WS_FKT), (const float*)(p.ws + WS_FQB)};
    const attn_body::QueueOrder S{(unsigned*)(p.ws + WS_CTL) + CW_ATTNQ + l * 64, (volatile __attribute__((address_space(3))) int*)((__attribute__((address_space(3))) unsigned char*)lds + LDSQ_OFF)};
    attn_body::attn_phase<attn_body::QueueOrder>((char*)lds, AT, S);
}

__device__ __forceinline__ void phase_ln(const _Float16* Y, const float* g, const float* bta, float* dst, bf16* dstb, unsigned char* xq = nullptr, float* xs = nullptr) {
    const int tid = tid_l(), lane = tid & 63, wave = tid >> 6; typedef _Float16 h4 __attribute__((ext_vector_type(4)));
    const int stride = grid_l() * 8; int row = bid_l() * 8 + wave;
    if (row >= T) return;
    h4 cur[4];
#pragma unroll
    for (int j = 0; j < 4; ++j) cur[j] = *(const h4*)(Y + (size_t)row * D + j * 256 + lane * 4);
#pragma unroll 1
    for (; row < T; row += stride) {
        h4 nxt[4]; const int nr = row + stride < T ? row + stride : row;
#pragma unroll
        for (int j = 0; j < 4; ++j) nxt[j] = *(const h4*)(Y + (size_t)nr * D + j * 256 + lane * 4);
        __builtin_amdgcn_sched_barrier(0);
        f32x4 v[4]; float s = 0.f;
#pragma unroll
        for (int j = 0; j < 4; ++j) { v[j] = (f32x4){(float)cur[j][0], (float)cur[j][1], (float)cur[j][2], (float)cur[j][3]}; s += (v[j][0] + v[j][1]) + (v[j][2] + v[j][3]); }
        const float mean = wave_sum(s) * (1.f / D); float s2 = 0.f;
#pragma unroll
        for (int j = 0; j < 4; ++j) { v[j] = v[j] - mean; s2 += (v[j][0] * v[j][0] + v[j][1] * v[j][1]) + (v[j][2] * v[j][2] + v[j][3] * v[j][3]); }
        const float rstd = 1.0f / sqrtf(wave_sum(s2) * (1.f / D) + LN_EPS);
        float am = 0.f;
#pragma unroll
        for (int j = 0; j < 4; ++j) { const f32x4 g4 = *(const f32x4*)(g + j * 256 + lane * 4), b4 = *(const f32x4*)(bta + j * 256 + lane * 4);
            const f32x4 o = v[j] * rstd * g4 + b4; v[j] = o;
            am = fmaxf(am, fmaxf(fmaxf(fabsf(o[0]), fabsf(o[1])), fmaxf(fabsf(o[2]), fabsf(o[3]))));
            if (dst) *(f32x4*)(dst + (size_t)row * D + j * 256 + lane * 4) = o;
            if (dstb) { u32x2 w; w.x = pk2(o[0], o[1]); w.y = pk2(o[2], o[3]); *(u32x2*)(dstb + (size_t)row * D + j * 256 + lane * 4) = w; } }
        if (xq) {
            am = wave_max(am); const float sc = am > 0.f ? 119.0f / am : 0.f;
#pragma unroll
            for (int j = 0; j < 4; ++j) { unsigned hh = 0u, ll = 0u;
#pragma unroll
                for (int i = 0; i < 4; ++i) { const int q8 = (int)__builtin_rintf(v[j][i] * sc), qh = (q8 + 8) >> 4, ql = q8 - (qh << 4); hh |= ((unsigned)qh & 15u) << (4 * i); ll |= ((unsigned)ql & 15u) << (4 * i); }
                *(unsigned short*)(xq + (size_t)row * D + j * 128 + lane * 2) = (unsigned short)hh; *(unsigned short*)(xq + (size_t)row * D + 512 + j * 128 + lane * 2) = (unsigned short)ll; }
            if (lane == 0) xs[row] = am * (1.0f / 119.0f); }
#pragma unroll
        for (int j = 0; j < 4; ++j) cur[j] = nxt[j];
    }
}

__device__ __forceinline__ int f2ord(float x) { const int i = __float_as_int(x); return i ^ ((i >> 31) & 0x7fffffff); }
__device__ __forceinline__ float ord2f(int k) { return __int_as_float(k ^ ((k >> 31) & 0x7fffffff)); }
__device__ __forceinline__ void phase_topk(const Params& p, unsigned char* lds) {
    const int tid = tid_l(), lane = tid & 63, wave = tid >> 6;
    unsigned char* wreg = lds + wave * 17408; unsigned char* tab = wreg;
    const _Float16* SC = (const _Float16*)(p.ws + WS_SC); int* EIDX = (int*)(p.ws + WS_EIDX); float* GATE = (float*)(p.ws + WS_GATE); unsigned long long* SOFF = (unsigned long long*)(p.ws + WS_SOFF);
    for (int g = bid_l() * 512 + tid; g < T * 16; g += grid_l() * 512) {
        const int tok = g >> 4, hc = g & 15;
        typedef _Float16 h8 __attribute__((ext_vector_type(8)));
        { const unsigned char* blk = (const unsigned char*)(SC + (size_t)(g - lane) * 128);
          u32x4 st[16];
#pragma unroll
          for (int j = 0; j < 16; ++j) st[j] = *(const u32x4*)(blk + (size_t)(j * 64 + lane) * 16);
          __builtin_amdgcn_wave_barrier();
#pragma unroll
          for (int j = 0; j < 16; ++j) { const int c = j * 64 + lane; *(u32x4*)(wreg + (c + (c >> 4)) * 16) = st[j]; }
          __builtin_amdgcn_wave_barrier(); }
        const unsigned char* lp = wreg + lane * 272;
#define TK_CE(a, b) do { const int hi_ = max(a, b), lo_ = min(a, b); a = hi_; b = lo_; } while (0)
        int tk[16];
#pragma unroll 1
        for (int gi = 0; gi < 8; ++gi) { const h8 cA = *(const h8*)(lp + gi * 32), c1_ = *(const h8*)(lp + gi * 32 + 16);
            int v[16];
#pragma unroll
            for (int j = 0; j < 8; ++j) { v[j] = (f2ord((float)cA[j]) & ~127) | (127 - (gi * 16 + j)); v[8 + j] = (f2ord((float)c1_[j]) & ~127) | (127 - (gi * 16 + 8 + j)); }
            TK_CE(v[0], v[1]); TK_CE(v[3], v[2]); TK_CE(v[4], v[5]); TK_CE(v[7], v[6]); TK_CE(v[8], v[9]); TK_CE(v[11], v[10]); TK_CE(v[12], v[13]); TK_CE(v[15], v[14]); TK_CE(v[0], v[2]); TK_CE(v[1], v[3]); TK_CE(v[6], v[4]); TK_CE(v[7], v[5]); TK_CE(v[8], v[10]); TK_CE(v[9], v[11]); TK_CE(v[14], v[12]); TK_CE(v[15], v[13]); TK_CE(v[0], v[1]); TK_CE(v[2], v[3]); TK_CE(v[5], v[4]); TK_CE(v[7], v[6]); TK_CE(v[8], v[9]); TK_CE(v[10], v[11]); TK_CE(v[13], v[12]); TK_CE(v[15], v[14]); TK_CE(v[0], v[4]); TK_CE(v[1], v[5]); TK_CE(v[2], v[6]); TK_CE(v[3], v[7]); TK_CE(v[12], v[8]); TK_CE(v[13], v[9]); TK_CE(v[14], v[10]); TK_CE(v[15], v[11]); TK_CE(v[0], v[2]); TK_CE(v[1], v[3]); TK_CE(v[4], v[6]); TK_CE(v[5], v[7]); TK_CE(v[10], v[8]); TK_CE(v[11], v[9]); TK_CE(v[14], v[12]); TK_CE(v[15], v[13]); TK_CE(v[0], v[1]); TK_CE(v[2], v[3]); TK_CE(v[4], v[5]); TK_CE(v[6], v[7]); TK_CE(v[9], v[8]); TK_CE(v[11], v[10]); TK_CE(v[13], v[12]); TK_CE(v[15], v[14]); TK_CE(v[0], v[8]); TK_CE(v[1], v[9]); TK_CE(v[2], v[10]); TK_CE(v[3], v[11]); TK_CE(v[4], v[12]); TK_CE(v[5], v[13]); TK_CE(v[6], v[14]); TK_CE(v[7], v[15]); TK_CE(v[0], v[4]); TK_CE(v[1], v[5]); TK_CE(v[2], v[6]); TK_CE(v[3], v[7]); TK_CE(v[8], v[12]); TK_CE(v[9], v[13]); TK_CE(v[10], v[14]); TK_CE(v[11], v[15]); TK_CE(v[0], v[2]); TK_CE(v[1], v[3]); TK_CE(v[4], v[6]); TK_CE(v[5], v[7]); TK_CE(v[8], v[10]); TK_CE(v[9], v[11]); TK_CE(v[12], v[14]); TK_CE(v[13], v[15]); TK_CE(v[0], v[1]); TK_CE(v[2], v[3]); TK_CE(v[4], v[5]); TK_CE(v[6], v[7]); TK_CE(v[8], v[9]); TK_CE(v[10], v[11]); TK_CE(v[12], v[13]); TK_CE(v[14], v[15]);
            if (gi == 0) {
#pragma unroll
                for (int j = 0; j < 16; ++j) tk[j] = v[j]; }
            else {
#pragma unroll
                for (int j = 0; j < 16; ++j) tk[j] = max(tk[j], v[15 - j]);
                TK_CE(tk[0], tk[8]); TK_CE(tk[1], tk[9]); TK_CE(tk[2], tk[10]); TK_CE(tk[3], tk[11]); TK_CE(tk[4], tk[12]); TK_CE(tk[5], tk[13]); TK_CE(tk[6], tk[14]); TK_CE(tk[7], tk[15]); TK_CE(tk[0], tk[4]); TK_CE(tk[1], tk[5]); TK_CE(tk[2], tk[6]); TK_CE(tk[3], tk[7]); TK_CE(tk[8], tk[12]); TK_CE(tk[9], tk[13]); TK_CE(tk[10], tk[14]); TK_CE(tk[11], tk[15]); TK_CE(tk[0], tk[2]); TK_CE(tk[1], tk[3]); TK_CE(tk[4], tk[6]); TK_CE(tk[5], tk[7]); TK_CE(tk[8], tk[10]); TK_CE(tk[9], tk[11]); TK_CE(tk[12], tk[14]); TK_CE(tk[13], tk[15]); TK_CE(tk[0], tk[1]); TK_CE(tk[2], tk[3]); TK_CE(tk[4], tk[5]); TK_CE(tk[6], tk[7]); TK_CE(tk[8], tk[9]); TK_CE(tk[10], tk[11]); TK_CE(tk[12], tk[13]); TK_CE(tk[14], tk[15]); }
            }
        __builtin_amdgcn_wave_barrier();
#undef TK_CE
        float av[16], bv[16]; int ai[16], bi[16]; const bool c1 = (hc & 1) != 0;
#pragma unroll
        for (int j = 0; j < 16; ++j) { const int ok = __shfl_xor(tk[j], 1); const int ka = c1 ? ok : tk[j], kb = c1 ? tk[j] : ok;
            av[j] = ord2f(ka & ~127); ai[j] = 127 - (ka & 127); bv[j] = ord2f(kb & ~127); bi[j] = 127 - (kb & 127); }
#pragma unroll
        for (int j = 0; j < 16; ++j) { tab[j * 64 + lane] = (unsigned char)ai[j]; tab[(16 + j) * 64 + lane] = (unsigned char)bi[j]; }
        int ck[16];
#pragma unroll
        for (int j = 0; j < 16; ++j) ck[j] = (int)0x80000000;
#pragma unroll
        for (int i = 0; i < 16; ++i)
#pragma unroll
            for (int j = 0; j < 16 / (i + 1); ++j) { int x = (f2ord(av[i] + bv[j]) & ~255) | (255 - (i * 16 + j));
#pragma unroll
                for (int q = 0; q < 16; ++q) { const int hi = max(ck[q], x); x = min(ck[q], x); ck[q] = hi; } }
        float den = 0.f; float ex[16]; const float c0 = ord2f(ck[0] & ~255);
#pragma unroll
        for (int j = 0; j < 16; ++j) { ex[j] = __expf(ord2f(ck[j] & ~255) - c0); den += ex[j]; }
        const float inv = 1.0f / den;
        int eid[16]; unsigned long long cnt = 0ull;
#pragma unroll
        for (int j = 0; j < 16; ++j) { const int flat = 255 - (ck[j] & 255); eid[j] = (int)tab[(flat >> 4) * 64 + lane] * 128 + (int)tab[(16 + (flat & 15)) * 64 + lane];
            if (!c1) cnt += 1ull << (8 * (eid[j] >> 11)); }
        unsigned long long incl = cnt;
#pragma unroll
        for (int o = 1; o < 16; o <<= 1) { const unsigned lo = __shfl_up((unsigned)incl, o, 16), hi = __shfl_up((unsigned)(incl >> 32), o, 16); if ((hc & 15) >= o) incl += ((unsigned long long)hi << 32) | lo; }
        const unsigned long long total = ((unsigned long long)__shfl((unsigned)(incl >> 32), 15, 16) << 32) | __shfl((unsigned)incl, 15, 16);
        const unsigned long long base = total * 0x0101010101010100ull;
        unsigned long long run = base + (incl - cnt);
        if (hc == 0) SOFF[tok] = base;
        if (!c1) {
#pragma unroll
            for (int j = 0; j < 16; ++j) { const int sh = 8 * (eid[j] >> 11); const int pos = (int)((run >> sh) & 0xffull); run += 1ull << sh;
                EIDX[(size_t)tok * 128 + pos] = eid[j]; GATE[(size_t)tok * 128 + pos] = ex[j] * inv; } }
    }
}

__device__ __forceinline__ float gelu_tanh(float h) { const float z = 0.7978845608028654f * (h + 0.044715f * h * h * h); const float t = 1.0f - 2.0f / (__expf(2.0f * z) + 1.0f); return 0.5f * h * (1.0f + t); }
struct PeerUMeta { int e_lo, e_hi; float g_lo, g_hi, xs; u32x4 xh0, xh1, xl0, xl1; };
__device__ __forceinline__ PeerUMeta peer_umeta_load(const unsigned char* XQ, const float* XS, const int* EIDX, const float* GATE, int tok, int lane) {
    PeerUMeta m; const unsigned char* xr = XQ + (size_t)tok * D + (lane & 15) * 16;
    m.e_lo = EIDX[(size_t)tok * 128 + lane]; m.e_hi = EIDX[(size_t)tok * 128 + 64 + lane]; m.g_lo = GATE[(size_t)tok * 128 + lane]; m.g_hi = GATE[(size_t)tok * 128 + 64 + lane]; m.xs = XS[tok];
    m.xh0 = *(const u32x4*)(xr); m.xh1 = *(const u32x4*)(xr + 256); m.xl0 = *(const u32x4*)(xr + 512); m.xl1 = *(const u32x4*)(xr + 768);
    return m;
}
template <int CTRL> __device__ __forceinline__ int dpp_movi(int v) { return __builtin_amdgcn_update_dpp(0, v, CTRL, 0xf, 0xf, false); }
__device__ __forceinline__ float gelu_tanh_fast(float h) { const float z = 0.7978845608028654f * (h + 0.044715f * h * h * h); const float t = 1.0f - 2.0f * __builtin_amdgcn_rcpf(__expf(2.0f * z) + 1.0f); return 0.5f * h * (1.0f + t); }
#define PU_ISSUE(R, E, kk) do { _Pragma("unroll") for (int a_ = 0; a_ < 4; ++a_) { const int e_ = __builtin_amdgcn_ds_bpermute((g4 << 2) + (((kk) + 4 * a_) << 2), (E)); \
        const unsigned char* p_ = U4l + (size_t)e_ * 512; R[2 * a_] = *(const u32x4*)(p_); R[2 * a_ + 1] = *(const u32x4*)(p_ + 256); } __builtin_amdgcn_sched_barrier(0); } while (0)
#define PU_COMPUTE(R, CD, kk) do { int t_[4]; \
        _Pragma("unroll") for (int a_ = 0; a_ < 4; ++a_) { int h_ = 0, l_ = 0; \
            _Pragma("unroll") for (int w_ = 0; w_ < 4; ++w_) { h_ = __builtin_amdgcn_sdot8((int)R[2 * a_][w_], (int)cur.xh0[w_], h_, false); l_ = __builtin_amdgcn_sdot8((int)R[2 * a_][w_], (int)cur.xl0[w_], l_, false); \
                                                               h_ = __builtin_amdgcn_sdot8((int)R[2 * a_ + 1][w_], (int)cur.xh1[w_], h_, false); l_ = __builtin_amdgcn_sdot8((int)R[2 * a_ + 1][w_], (int)cur.xl1[w_], l_, false); } \
            int s_ = 16 * h_ + l_; s_ += dpp_movi<0x128>(s_); s_ += dpp_movi<0x124>(s_); s_ += dpp_movi<0x122>(s_); s_ += dpp_movi<0x121>(s_); t_[a_] = s_; } \
        const int mine_ = (l16 & 2) ? ((l16 & 1) ? t_[3] : t_[2]) : ((l16 & 1) ? t_[1] : t_[0]);            \
        const int q_ = (lane - (kk)) & 63; const int got_ = __builtin_amdgcn_ds_bpermute((((q_ & 3) << 4) + ((q_ >> 2) & 3)) << 2, mine_); \
        CD = q_ < 16 ? (float)got_ : CD; __builtin_amdgcn_sched_barrier(0); } while (0)
__device__ __forceinline__ void phase_peer_u(const Params& p, unsigned char* lds) {
    const int tid = tid_l(), lane = tid & 63, wave = tid >> 6, l16 = lane & 15, g4 = lane >> 4;
    const unsigned char* XQ = p.ws + WS_XQ; const float* XS = (const float*)(p.ws + WS_XS); const float* RS = (const float*)(p.ws + WS_RS); const float* VS = (const float*)(p.ws + WS_VS);
    const unsigned char* U4l = p.ws + WS_U + l16 * 16;
    const int* EIDX = (const int*)(p.ws + WS_EIDX); float* GATE = (float*)(p.ws + WS_GATE);
    const int stride = grid_l() * 8; int tok = __builtin_amdgcn_readfirstlane(bid_l() * 8 + wave);
    if (tok >= T) return;
    PeerUMeta cur = peer_umeta_load(XQ, XS, EIDX, GATE, tok, lane);
    u32x4 Ra[8], Rb[8];
    PU_ISSUE(Ra, cur.e_lo, 0);
#pragma unroll 1
    for (; tok < T; tok += stride) {
        const PeerUMeta nxt = peer_umeta_load(XQ, XS, EIDX, GATE, tok + stride < T ? tok + stride : tok, lane);
        const float rs_lo = RS[cur.e_lo], rs_hi = RS[cur.e_hi], vs_lo = VS[cur.e_lo], vs_hi = VS[cur.e_hi];
        __builtin_amdgcn_sched_barrier(0);
        float c_lo = 0.f, c_hi = 0.f;
        PU_ISSUE(Rb, cur.e_lo, 16); PU_COMPUTE(Ra, c_lo, 0);
        PU_ISSUE(Ra, cur.e_lo, 32); PU_COMPUTE(Rb, c_lo, 16);
        PU_ISSUE(Rb, cur.e_lo, 48); PU_COMPUTE(Ra, c_lo, 32);
        PU_ISSUE(Ra, cur.e_hi, 0);  PU_COMPUTE(Rb, c_lo, 48);
        PU_ISSUE(Rb, cur.e_hi, 16); PU_COMPUTE(Ra, c_hi, 0);
        PU_ISSUE(Ra, cur.e_hi, 32); PU_COMPUTE(Rb, c_hi, 16);
        PU_ISSUE(Rb, cur.e_hi, 48); PU_COMPUTE(Ra, c_hi, 32);
        PU_ISSUE(Ra, nxt.e_lo, 0);  PU_COMPUTE(Rb, c_hi, 48);
        GATE[(size_t)tok * 128 + lane] = cur.g_lo * gelu_tanh_fast(c_lo * (rs_lo * cur.xs)) * vs_lo;
        GATE[(size_t)tok * 128 + 64 + lane] = cur.g_hi * gelu_tanh_fast(c_hi * (rs_hi * cur.xs)) * vs_hi;
        cur = nxt;
    }
}
#undef PU_ISSUE
#undef PU_COMPUTE
struct PeerVMeta { int e_lo, e_hi; float c_lo, c_hi; u32x4 x0, x1; };
__device__ __forceinline__ PeerVMeta peer_vmeta_load(const int* EIDX, const float* COEF, const bf16* XB, int tok, int lane) {
    PeerVMeta m;
    m.e_lo = EIDX[(size_t)tok * 128 + lane]; m.e_hi = EIDX[(size_t)tok * 128 + 64 + lane]; m.c_lo = COEF[(size_t)tok * 128 + lane]; m.c_hi = COEF[(size_t)tok * 128 + 64 + lane];
    const int xo = (lane & 31) * 32 + (lane >> 5) * 16;
    m.x0 = *(const u32x4*)(XB + (size_t)tok * D + xo); m.x1 = *(const u32x4*)(XB + (size_t)tok * D + xo + 8);
    return m;
}
#define PV_ISSUE(VR, CF, PE, PC, jj) do { _Pragma("unroll") for (int q = 0; q < 8; ++q) { const int a_ = hb + (((jj) + q) << 2); const int e_ = __builtin_amdgcn_ds_bpermute(a_, (int)(PE)); \
        CF[q] = __int_as_float(__builtin_amdgcn_ds_bpermute(a_, (int)(PC))); VR[q] = *(const u32x4*)(V4l + (size_t)e_ * 512); } __builtin_amdgcn_sched_barrier(0); } while (0)
#define PV_COMPUTE(VR, CF) do { _Pragma("unroll") for (int q = 0; q < 8; ++q) { const f32x2v c2 = (f32x2v){CF[q], CF[q]}; \
        _Pragma("unroll") for (int w = 0; w < 4; ++w) { \
            acc[4 * w] += __builtin_amdgcn_cvt_scalef32_pk_f32_fp4(VR[q][w], 1.0f, 0) * c2; acc[4 * w + 1] += __builtin_amdgcn_cvt_scalef32_pk_f32_fp4(VR[q][w], 1.0f, 1) * c2; \
            acc[4 * w + 2] += __builtin_amdgcn_cvt_scalef32_pk_f32_fp4(VR[q][w], 1.0f, 2) * c2; acc[4 * w + 3] += __builtin_amdgcn_cvt_scalef32_pk_f32_fp4(VR[q][w], 1.0f, 3) * c2; } } \
        __builtin_amdgcn_sched_barrier(0); } while (0)
__device__ __forceinline__ void phase_peer_v(const Params& p) {
    const int tid = tid_l(), lane = tid & 63, wave = tid >> 6;
    const unsigned char* V4l = p.ws + WS_V + (lane & 31) * 16;
    const int* EIDX = (const int*)(p.ws + WS_EIDX); const float* COEF = (const float*)(p.ws + WS_GATE);
    bf16* XB = (bf16*)(p.ws + WS_XB);
    const int hb = (lane & 32) << 2;
    const int xo = (lane & 31) * 32 + (lane >> 5) * 16;
    const int stride = grid_l() * 8; int tok = __builtin_amdgcn_readfirstlane(bid_l() * 8 + wave);
    if (tok >= T) return;
    PeerVMeta cur = peer_vmeta_load(EIDX, COEF, XB, tok, lane);
    auto se = __builtin_amdgcn_permlane32_swap((unsigned)cur.e_lo, (unsigned)cur.e_hi, false, false); auto sc_ = __builtin_amdgcn_permlane32_swap(__float_as_uint(cur.c_lo), __float_as_uint(cur.c_hi), false, false);
    u32x4 vrA[8], vrB[8]; float cfA[8], cfB[8];
    PV_ISSUE(vrA, cfA, se[0], sc_[0], 0);
#pragma unroll 1
    for (; tok < T; tok += stride) {
        const PeerVMeta nxt = peer_vmeta_load(EIDX, COEF, XB, tok + stride < T ? tok + stride : tok, lane);
        __builtin_amdgcn_sched_barrier(0);
        f32x2v acc[16];
#pragma unroll
        for (int i = 0; i < 16; ++i) acc[i] = (f32x2v){0.f, 0.f};
        PV_ISSUE(vrB, cfB, se[0], sc_[0], 8);  PV_COMPUTE(vrA, cfA);
        PV_ISSUE(vrA, cfA, se[0], sc_[0], 16); PV_COMPUTE(vrB, cfB);
        PV_ISSUE(vrB, cfB, se[0], sc_[0], 24); PV_COMPUTE(vrA, cfA);
        PV_ISSUE(vrA, cfA, se[1], sc_[1], 0);  PV_COMPUTE(vrB, cfB);
        PV_ISSUE(vrB, cfB, se[1], sc_[1], 8);  PV_COMPUTE(vrA, cfA);
        PV_ISSUE(vrA, cfA, se[1], sc_[1], 16); PV_COMPUTE(vrB, cfB);
        PV_ISSUE(vrB, cfB, se[1], sc_[1], 24); PV_COMPUTE(vrA, cfA);
        se = __builtin_amdgcn_permlane32_swap((unsigned)nxt.e_lo, (unsigned)nxt.e_hi, false, false); sc_ = __builtin_amdgcn_permlane32_swap(__float_as_uint(nxt.c_lo), __float_as_uint(nxt.c_hi), false, false);
        PV_ISSUE(vrA, cfA, se[0], sc_[0], 0);  PV_COMPUTE(vrB, cfB);
        float sres[16];
#pragma unroll
        for (int i = 0; i < 8; ++i)
#pragma unroll
            for (int c = 0; c < 2; ++c) { const auto r_ = __builtin_amdgcn_permlane32_swap(__float_as_uint(acc[i][c]), __float_as_uint(acc[8 + i][c]), false, false);
                sres[2 * i + c] = __uint_as_float(r_[0]) + __uint_as_float(r_[1]); }
        float r[16];
#pragma unroll
        for (int i = 0; i < 4; ++i) { r[2 * i] = ALPHA * bf2f(cur.x0[i] & 0xffffu) + sres[2 * i]; r[2 * i + 1] = ALPHA * __uint_as_float(cur.x0[i] & 0xffff0000u) + sres[2 * i + 1];
                                      r[8 + 2 * i] = ALPHA * bf2f(cur.x1[i] & 0xffffu) + sres[8 + 2 * i]; r[8 + 2 * i + 1] = ALPHA * __uint_as_float(cur.x1[i] & 0xffff0000u) + sres[8 + 2 * i + 1]; }
#pragma unroll
        for (int w = 0; w < 2; ++w) { u32x4 o; o.x = pk2(r[8 * w], r[8 * w + 1]); o.y = pk2(r[8 * w + 2], r[8 * w + 3]); o.z = pk2(r[8 * w + 4], r[8 * w + 5]); o.w = pk2(r[8 * w + 6], r[8 * w + 7]);
            *(u32x4*)(XB + (size_t)tok * D + xo + 8 * w) = o; }
        cur = nxt;
    }
}
#undef PV_ISSUE
#undef PV_COMPUTE
#define GAS __attribute__((address_space(1)))
#define LAS __attribute__((address_space(3)))
#define XB_TMO      128
#define XB_XCNT(j)  (256  + 64 * (j))
#define XB_XSUB(j)  (1280 + 64 * (j))
#define XB_XGEN(j)  (2304 + 64 * (j))
#define XB_TOP      3328
#define XB_TOPGEN   3392
#define XCD_BAR_WORDS 3456
#define XB_SPIN_CAP (1u << 18)

__device__ __forceinline__ unsigned xb_ld(unsigned* p)              { return __hip_atomic_load(p, __ATOMIC_RELAXED, __HIP_MEMORY_SCOPE_AGENT); }
__device__ __forceinline__ unsigned xb_add(unsigned* p, unsigned v) { return __hip_atomic_fetch_add(p, v, __ATOMIC_RELAXED, __HIP_MEMORY_SCOPE_AGENT); }
__device__ __forceinline__ unsigned xb_xcc_id() { return (unsigned)__builtin_amdgcn_s_getreg((3 << 11) | 20) & 0xFu; }
#define XB_SPIN(cond, bar) do { unsigned _sp = 0; while (cond) { __builtin_amdgcn_s_sleep(1); \
    if ((++_sp & 255u) == 0u) { if (xb_ld(&(bar)[XB_TMO])) break; if (_sp > XB_SPIN_CAP) { atomicAdd(&(bar)[XB_TMO], 1u); break; } } } } while (0)

struct XcdBarrier {
    unsigned* bar; unsigned x;
    volatile LAS unsigned* st;
};

__device__ __forceinline__ XcdBarrier xcd_barrier_post(unsigned* bar, volatile LAS unsigned* st) {
    XcdBarrier b; b.bar = bar; b.x = xb_xcc_id(); b.st = st;
    if (threadIdx.x == 0) (void)xb_add(&bar[XB_XCNT(b.x)], 1u);
    return b;
}
__device__ __forceinline__ void xcd_barrier_complete(unsigned* bar, unsigned x, unsigned& nloc, unsigned& nx) {
    const unsigned G = gridDim.x * gridDim.y * gridDim.z;
    unsigned sum, cnt, mine, sp = 0u;
    for (;;) {
        sum = 0u; cnt = 0u; mine = 0u;
#pragma unroll
        for (unsigned j = 0; j < 16; ++j) { const unsigned c = xb_ld(&bar[XB_XCNT(j)]); sum += c; cnt += (c > 0u) ? 1u : 0u; mine = (j == x) ? c : mine; }
        if (sum == G) break;
        __builtin_amdgcn_s_sleep(1);
        if ((++sp & 255u) == 0u) { if (xb_ld(&bar[XB_TMO])) break; if (sp > XB_SPIN_CAP) { atomicAdd(&bar[XB_TMO], 1u); break; } }
    }
    nloc = mine > 0u ? mine : 1u; nx = cnt > 0u ? cnt : 1u;
}

__device__ __forceinline__ void xcd_barrier(const XcdBarrier& b) {
    asm volatile("s_waitcnt vmcnt(0)" ::: "memory");
    __syncthreads();
    if (threadIdx.x == 0) {
        unsigned* bar = b.bar;
        __builtin_amdgcn_s_waitcnt(0);
        unsigned nloc = b.st[0], nx = b.st[1];
        if (nloc == 0u) { xcd_barrier_complete(bar, b.x, nloc, nx); b.st[0] = nloc; b.st[1] = nx; }
        const unsigned old = xb_add(&bar[XB_XSUB(b.x)], 1u);
        const unsigned gen = old / nloc;
        if (old + 1u == (gen + 1u) * nloc) {
            __builtin_amdgcn_fence(__ATOMIC_RELEASE, "agent");
            asm volatile("s_waitcnt vmcnt(0)" ::: "memory");
            const unsigned og = xb_add(&bar[XB_TOP], 1u);
            const unsigned tg = og / nx;
            if (og + 1u == (tg + 1u) * nx) xb_add(&bar[XB_TOPGEN], 1u);
            else XB_SPIN(xb_ld(&bar[XB_TOPGEN]) == tg, bar);
            __builtin_amdgcn_fence(__ATOMIC_ACQUIRE, "agent");
            xb_add(&bar[XB_XGEN(b.x)], 1u);
            asm volatile("s_waitcnt vmcnt(0)" ::: "memory");
        } else {
            XB_SPIN(xb_ld(&bar[XB_XGEN(b.x)]) == gen, bar);
            __builtin_amdgcn_fence(__ATOMIC_ACQUIRE, "agent");
            asm volatile("s_waitcnt vmcnt(0)" ::: "memory");
        }
    }
    __syncthreads();
}
enum { PH_PRO_A, PH_PRO_B, PH_CVT, PH_GEMM_IN, PH_GEMM_E, PH_CONV, PH_FOXCUM, PH_FOXNORM, PH_GLA1, PH_GLA2, PH_GLA3, PH_FOX, PH_GEMM_OUT, PH_LN1, PH_GEMM_SC, PH_TOPK, PH_PEERU, PH_PEERV, PH_GEMM_PLE, PH_LN2, PH_COUNT };

template <int PH> __device__ __forceinline__ void run_phase(const Params& p, int l, unsigned char* lds) {
    if constexpr (PH == PH_PRO_A) phase_pro_a(p, lds);
    else if constexpr (PH == PH_PRO_B) phase_pro_b(p, lds);
    else if constexpr (PH == PH_CVT) phase_cvt(p, l);
    else if constexpr (PH == PH_GEMM_IN) phase_gemm_in(p, l, lds);
    else if constexpr (PH == PH_GEMM_E) phase_gemm_e(p, l, lds);
    else if constexpr (PH == PH_CONV) phase_conv(p, l, lds);
    else if constexpr (PH == PH_FOXCUM) phase_fox_cum(p, l, lds);
    else if constexpr (PH == PH_FOXNORM) phase_fox_norm(p, lds);
    else if constexpr (PH == PH_GLA1) phase_gla_b1(p, l, lds);
    else if constexpr (PH == PH_GLA2) phase_gla_b2(p);
    else if constexpr (PH == PH_GLA3) phase_gla_b3(p, l, lds);
    else if constexpr (PH == PH_FOX) phase_fox_mfma(p, l, lds);
    else if constexpr (PH == PH_GEMM_OUT) phase_gemm_out(p, l, lds);
    else if constexpr (PH == PH_LN1) phase_ln((const _Float16*)(p.ws + WS_Y), p.ln1_g + (size_t)l * D, p.ln1_b + (size_t)l * D, nullptr, (bf16*)(p.ws + WS_XB), p.ws + WS_XQ, (float*)(p.ws + WS_XS));
    else if constexpr (PH == PH_GEMM_SC) phase_gemm_sc(p, l, lds);
    else if constexpr (PH == PH_TOPK) phase_topk(p, lds);
    else if constexpr (PH == PH_PEERU) phase_peer_u(p, lds);
    else if constexpr (PH == PH_PEERV) phase_peer_v(p);
    else if constexpr (PH == PH_GEMM_PLE) phase_gemm_ple(p, l, lds);
    else if constexpr (PH == PH_LN2) phase_ln((const _Float16*)(p.ws + WS_Y), p.ln2_g + (size_t)l * D, p.ln2_b + (size_t)l * D, l == DEPTH - 1 ? p.out : nullptr, l == DEPTH - 1 ? nullptr : (bf16*)(p.ws + WS_XB));
}

constexpr int MISC_OFF = LDS_BYTES - 512;
constexpr int CW_BAR = 4096;
static_assert(MISC_OFF + 128 <= LDS_BYTES && (CW_BAR + XCD_BAR_WORDS) * 4 <= (int)CTL_ZERO_BYTES, "control words");

typedef __attribute__((address_space(4))) const Params CParams;
#define PHASE(PH) do { CParams* q_ = pp; asm volatile("" : "+s"(q_)); Params lp_; __builtin_memcpy(&lp_, q_, sizeof(Params)); run_phase<PH>(lp_, l, lds); } while (0)
__global__ void __launch_bounds__(512, 2) mk_fwd(Params p_unused) {
#if defined(__HIP_DEVICE_COMPILE__)
    extern __shared__ __attribute__((aligned(16))) unsigned char lds[];
    CParams* pp = (CParams*)__builtin_amdgcn_kernarg_segment_ptr();
    unsigned char* ws0; { CParams* q_ = pp; asm volatile("" : "+s"(q_)); ws0 = q_->ws; }
    volatile LAS unsigned* MISC = (volatile LAS unsigned*)((LAS unsigned char*)lds + MISC_OFF);
    if (threadIdx.x < 32) MISC[threadIdx.x] = 0u;
    __syncthreads();
    (void)xcd_barrier_post((unsigned*)(ws0 + WS_CTL) + CW_BAR, MISC + 8);
#define GB() do { CParams* qb_ = pp; asm volatile("" : "+s"(qb_)); XcdBarrier b_; b_.bar = (unsigned*)(qb_->ws + WS_CTL) + CW_BAR; b_.x = xb_xcc_id(); b_.st = MISC + 8; xcd_barrier(b_); } while (0)
    { const int l = 0; PHASE(PH_PRO_A); PHASE(PH_PRO_B); } GB();
    for (int l = 0; l < DEPTH; ++l) {
        PHASE(PH_CVT); PHASE(PH_GEMM_IN); GB();
        PHASE(PH_GEMM_E); PHASE(PH_CONV); PHASE(PH_FOXCUM); PHASE(PH_FOXNORM); PHASE(PH_GLA1); GB();
        PHASE(PH_GLA2); PHASE(PH_FOX); GB();
        PHASE(PH_GLA3); GB();
        PHASE(PH_GEMM_OUT); GB();
        PHASE(PH_LN1); GB();
        PHASE(PH_GEMM_SC); GB();
        PHASE(PH_TOPK); GB();
        PHASE(PH_PEERU); GB();
        PHASE(PH_PEERV); GB();
        PHASE(PH_GEMM_PLE); GB();
        PHASE(PH_LN2); GB();
    }
#undef GB
#endif
}

extern "C" void kernel_launch(void* const* d_in, const int* in_sizes, int n_in, void* d_out, int out_size, void* d_ws, size_t ws_size, hipStream_t stream) {
    static int grid = 0;
    if (grid == 0) {
        if (n_in != 23 || ws_size < WS_END) { fprintf(stderr, "kernel_launch: unexpected n_in %d or ws_size %zu\n", n_in, ws_size); grid = -1; return; }
        int dev = 0, cus = 0, per_cu = 0;
        if (hipGetDevice(&dev) != hipSuccess || hipDeviceGetAttribute(&cus, hipDeviceAttributeMultiprocessorCount, dev) != hipSuccess) { grid = -1; return; }
        if (hipFuncSetAttribute((const void*)mk_fwd, hipFuncAttributeMaxDynamicSharedMemorySize, LDS_BYTES) != hipSuccess) { grid = -1; return; }
        if (hipOccupancyMaxActiveBlocksPerMultiprocessor(&per_cu, (const void*)mk_fwd, 512, LDS_BYTES) != hipSuccess || per_cu < 1) { fprintf(stderr, "kernel_launch: occupancy query says %d\n", per_cu); }
        (void)hipGetLastError();
        grid = cus;
    }
    if (grid < 0) return;
    if (hipMemsetAsync((char*)d_ws + WS_CTL, 0, CTL_ZERO_BYTES, stream) != hipSuccess) return;
    Params p; memset(&p, 0, sizeof(p));
    const float** f = (const float**)&p;
    for (int i = 0; i < 23; ++i) f[i] = (const float*)d_in[i];
    p.out = (float*)d_out; p.ws = (unsigned char*)d_ws;
    hipLaunchKernelGGL(mk_fwd, dim3(grid), dim3(512), LDS_BYTES, stream, p);
}
```

```cpp
#include <hip/hip_runtime.h>
#include <cstdio>
#include <cstdint>
#include <cstring>
#include <cmath>
__device__ __forceinline__ int tid_l() { int t = threadIdx.x; asm volatile("" : "+v"(t)); return t; }
__device__ __forceinline__ int bid_l() { int b = blockIdx.x; asm volatile("" : "+s"(b)); return b; }
__device__ __forceinline__ int grid_l() { int g = gridDim.x; asm volatile("" : "+s"(g)); return g; }
namespace pg8 {
#define PG8_LAS __attribute__((address_space(3)))
typedef unsigned short bf16_t;
typedef short bf16x8 __attribute__((ext_vector_type(8)));
typedef float f32x4 __attribute__((ext_vector_type(4)));
typedef unsigned u32x4 __attribute__((ext_vector_type(4)));
constexpr int BM = 256, BK = 64, HALF = 128, HTB = HALF * BK * 2  , STAGE_BYTES = 8 * HTB, NXCD = 8, WGM = 8;

__host__ __device__ __forceinline__ int lds_byte(int r, int c) { const int st = (r >> 4) * 2 + (c >> 5), rr = r & 15, cc = c & 31, ob = rr * 64 + cc * 2; return st * 1024 + (ob ^ (((ob >> 9) & 1) << 5)); }
__host__ __device__ __forceinline__ void stage_rc(int b, int& R, int& C) { const int st = b / 1024, sb = b % 1024, swz = sb ^ (((sb >> 9) & 1) << 5); R = (st >> 1) * 16 + swz / 64; C = (st & 1) * 32 + (swz % 64) / 2; }
__host__ __device__ __forceinline__ int perm32(int rho) { const int n = rho >> 4, i = rho & 15; return 8 * (i >> 2) + 4 * n + (i & 3); }

struct Unit { int pm, pn; };
struct Gemm { const bf16_t* A; const bf16_t* Bt; int M, N, K; };

struct StaticOrder {
    int nM, nN, nwg, G, c;
    __host__ __device__ void init(int M, int N, int G_, int c_) { nM = M / BM; nN = N / BM; nwg = nM * nN; G = G_; c = c_; }
    __host__ __device__ bool next(int i, Unit& u) const {
        const long L = (long)i * G + c; if (L >= nwg) return false;
        int wgid = (int)L; { const int q = nwg / NXCD, r = nwg % NXCD, xcd = wgid % NXCD, off = wgid / NXCD; wgid = (xcd < r ? xcd * (q + 1) : r * (q + 1) + (xcd - r) * q) + off; }
        const int nig = WGM * nN, gid = wgid / nig, fm = gid * WGM, gsz = (nM - fm) < WGM ? (nM - fm) : WGM;
        u.pm = fm + ((wgid % nig) % gsz); u.pn = (wgid % nig) / gsz; return true;
    }
    __device__ __forceinline__ void a_ready(const Unit&) const {}
    __device__ __forceinline__ void done(const Unit&) const {}
};

__device__ __forceinline__ unsigned cvt_pk_bf16(float lo, float hi) { unsigned r; asm volatile("v_cvt_pk_bf16_f32 %0, %1, %2" : "=v"(r) : "v"(lo), "v"(hi)); return r; }
typedef float f32x2 __attribute__((ext_vector_type(2)));
__device__ __forceinline__ f32x2 gelu_pk(f32x2 v) {
    const f32x2 av = __builtin_elementwise_abs(v), d = av * 0.2316418882f + 1.0f;
    f32x2 t; t.x = __builtin_amdgcn_rcpf(d.x); t.y = __builtin_amdgcn_rcpf(d.y);
    f32x2 q = t * 0.5307027145f + (-0.7265760135f); q = q * t + 0.7107068705f; q = q * t + (-0.142248368f); q = q * t + 0.127414796f; q = q * t;
    const f32x2 s = (v * v) * (-0.72134752044f);
    f32x2 e; e.x = __builtin_amdgcn_exp2f(s.x); e.y = __builtin_amdgcn_exp2f(s.y);
    const f32x2 m = v * (q * e), r = v - m;
    f32x2 o; o.x = v.x < 0.f ? m.x : r.x; o.y = v.y < 0.f ? m.y : r.y; return o;
}

template <int ACT  > struct EpiBf16 {
    static constexpr bool PERM = true, AFTER_DRAIN = false; static_assert(ACT == 0 || ACT == 1, "EpiBf16: ACT is 0 (none) or 1 (gelu_pk)");
    bf16_t* O; int ldc; const float* bias; int split_cols; size_t split_stride; float scale0;
    __device__ __forceinline__ void operator()(const f32x4 (&acc)[2][2][4][2], const Unit& u, int wr, int wc, int fr, int fq) const {
        const int row0 = u.pm * BM + wr * 64 + fr; int colt = u.pn * BM; bf16_t* base = O;
        float sc = 1.f; if (split_cols) { const int t = colt / split_cols; base += (size_t)t * split_stride; colt -= t * split_cols; if (t == 0) sc = scale0; }
        const int col0 = colt + wc * 32 + 8 * fq, bcol0 = u.pn * BM + wc * 32 + 8 * fq;
        f32x4 bv[2][2];
#pragma unroll
        for (int bj = 0; bj < 2; ++bj)
#pragma unroll
            for (int n = 0; n < 2; ++n) bv[bj][n] = bias ? *(const f32x4*)(bias + bcol0 + bj * HALF + 4 * n) : (f32x4){0.f, 0.f, 0.f, 0.f};
#pragma unroll
        for (int ai = 0; ai < 2; ++ai)
#pragma unroll
            for (int m = 0; m < 4; ++m) { bf16_t* rowp = base + (size_t)(row0 + ai * HALF + m * 16) * ldc + col0;
#pragma unroll
                for (int bj = 0; bj < 2; ++bj) { f32x4 v0 = acc[ai][bj][m][0] + bv[bj][0], v1 = acc[ai][bj][m][1] + bv[bj][1];
                    if (ACT == 1) { f32x2 a = gelu_pk((f32x2){v0[0], v0[1]}), b = gelu_pk((f32x2){v0[2], v0[3]}), c = gelu_pk((f32x2){v1[0], v1[1]}), d = gelu_pk((f32x2){v1[2], v1[3]});
                        v0 = (f32x4){a.x, a.y, b.x, b.y}; v1 = (f32x4){c.x, c.y, d.x, d.y}; }
                    v0 = v0 * sc; v1 = v1 * sc; u32x4 w; w.x = cvt_pk_bf16(v0[0], v0[1]); w.y = cvt_pk_bf16(v0[2], v0[3]); w.z = cvt_pk_bf16(v1[0], v1[1]); w.w = cvt_pk_bf16(v1[2], v1[3]);
                    *(u32x4*)(rowp + bj * HALF) = w; } }
    }
};
struct EpiF16 {
    static constexpr bool PERM = true, AFTER_DRAIN = false;
    _Float16* O; int ldc;
    __device__ __forceinline__ void operator()(const f32x4 (&acc)[2][2][4][2], const Unit& u, int wr, int wc, int fr, int fq) const {
        typedef _Float16 h8 __attribute__((ext_vector_type(8)));
        const int row0 = u.pm * BM + wr * 64 + fr, col0 = u.pn * BM + wc * 32 + 8 * fq;
#pragma unroll
        for (int ai = 0; ai < 2; ++ai)
#pragma unroll
            for (int m = 0; m < 4; ++m) { _Float16* rowp = O + (size_t)(row0 + ai * HALF + m * 16) * ldc + col0;
#pragma unroll
                for (int bj = 0; bj < 2; ++bj) { const f32x4 a = acc[ai][bj][m][0], b = acc[ai][bj][m][1];
                    h8 o; o[0] = (_Float16)a[0]; o[1] = (_Float16)a[1]; o[2] = (_Float16)a[2]; o[3] = (_Float16)a[3]; o[4] = (_Float16)b[0]; o[5] = (_Float16)b[1]; o[6] = (_Float16)b[2]; o[7] = (_Float16)b[3];
                    *(h8*)(rowp + bj * HALF) = o; } }
    }
};
struct EpiResid {
    static constexpr bool PERM = true, AFTER_DRAIN = false;
    const bf16_t* res; _Float16* Y; int ldc; float alpha;
    __device__ __forceinline__ void operator()(const f32x4 (&acc)[2][2][4][2], const Unit& u, int wr, int wc, int fr, int fq) const {
        const int row0 = u.pm * BM + wr * 64 + fr, col0 = u.pn * BM + wc * 32 + 8 * fq;
#pragma unroll
        for (int ai = 0; ai < 2; ++ai)
#pragma unroll
            for (int m = 0; m < 4; ++m) { const size_t off = (size_t)(row0 + ai * HALF + m * 16) * ldc + col0;
#pragma unroll
                for (int bj = 0; bj < 2; ++bj) { const u32x4 rv = *(const u32x4*)(res + off + bj * HALF);
                    f32x4 r0, r1; r0[0] = __uint_as_float(rv.x << 16); r0[1] = __uint_as_float(rv.x & 0xffff0000u); r0[2] = __uint_as_float(rv.y << 16); r0[3] = __uint_as_float(rv.y & 0xffff0000u);
                    r1[0] = __uint_as_float(rv.z << 16); r1[1] = __uint_as_float(rv.z & 0xffff0000u); r1[2] = __uint_as_float(rv.w << 16); r1[3] = __uint_as_float(rv.w & 0xffff0000u);
                    const f32x4 y0 = r0 * alpha + acc[ai][bj][m][0], y1 = r1 * alpha + acc[ai][bj][m][1];
                    typedef _Float16 h8 __attribute__((ext_vector_type(8))); h8 w; w[0] = (_Float16)y0[0]; w[1] = (_Float16)y0[1]; w[2] = (_Float16)y0[2]; w[3] = (_Float16)y0[3]; w[4] = (_Float16)y1[0]; w[5] = (_Float16)y1[1]; w[6] = (_Float16)y1[2]; w[7] = (_Float16)y1[3];
                    *(h8*)(Y + off + bj * HALF) = w; } }
    }
};
struct EpiPle {
    static constexpr bool PERM = true, AFTER_DRAIN = false;
    const bf16_t* R; _Float16* Y; const bf16_t* E; const float* gb; int ldc;
    __device__ __forceinline__ void operator()(const f32x4 (&acc)[2][2][4][2], const Unit& u, int wr, int wc, int fr, int fq) const {
        const int row0 = u.pm * BM + wr * 64 + fr, col0 = u.pn * BM + wc * 32 + 8 * fq;
        f32x4 bv[2][2];
#pragma unroll
        for (int bj = 0; bj < 2; ++bj)
#pragma unroll
            for (int n = 0; n < 2; ++n) bv[bj][n] = *(const f32x4*)(gb + col0 + bj * HALF + 4 * n);
#pragma unroll
        for (int ai = 0; ai < 2; ++ai)
#pragma unroll
            for (int m = 0; m < 4; ++m) { const size_t off = (size_t)(row0 + ai * HALF + m * 16) * ldc + col0;
#pragma unroll
                for (int bj = 0; bj < 2; ++bj) {
                    const u32x4 ev = *(const u32x4*)(E + off + bj * HALF), rv = *(const u32x4*)(R + off + bj * HALF);
                    float o[8];
#pragma unroll
                    for (int n = 0; n < 2; ++n) {
                        const f32x4 z = acc[ai][bj][m][n] + bv[bj][n];
                        const unsigned e0 = n == 0 ? ev.x : ev.z, e1 = n == 0 ? ev.y : ev.w, r0 = n == 0 ? rv.x : rv.z, r1 = n == 0 ? rv.y : rv.w;
                        f32x4 ee, rr; ee[0] = __uint_as_float(e0 << 16); ee[1] = __uint_as_float(e0 & 0xffff0000u); ee[2] = __uint_as_float(e1 << 16); ee[3] = __uint_as_float(e1 & 0xffff0000u);
                        rr[0] = __uint_as_float(r0 << 16); rr[1] = __uint_as_float(r0 & 0xffff0000u); rr[2] = __uint_as_float(r1 << 16); rr[3] = __uint_as_float(r1 & 0xffff0000u);
#pragma unroll
                        for (int i = 0; i < 4; ++i) o[4 * n + i] = rr[i] + ee[i] * __builtin_amdgcn_rcpf(1.0f + __expf(-z[i])); }
                    typedef _Float16 h8 __attribute__((ext_vector_type(8))); h8 w;
#pragma unroll
                    for (int i = 0; i < 8; ++i) w[i] = (_Float16)o[i];
                    *(h8*)(Y + off + bj * HALF) = w; } }
    }
};
template <class Epi, class Sched, bool ALIGN_EPI = false, bool SP2 = false>
__device__ __forceinline__ void gemm_phase(PG8_LAS unsigned char* lds, const Gemm g, const Sched& S, const Epi& E) {
    const int tid = tid_l(), wid = __builtin_amdgcn_readfirstlane(tid >> 6), lane = tid & 63, wr = wid >> 2, wc = wid & 3, fr = lane & 15, fq = lane >> 4;
    const int K = g.K, nt = K / BK;
    unsigned voffA[2], voffB[2];
#pragma unroll
    for (int i = 0; i < 2; ++i) { int R, C; stage_rc(tid * 16 + i * 8192, R, C); const int Rb = Epi::PERM ? ((R & ~31) + perm32(R & 31)) : R;
        voffA[i] = (unsigned)(R * K + C) * 2u; voffB[i] = (unsigned)(Rb * K + C) * 2u; }
    const size_t kstep = (size_t)(BK * 2);
    const size_t hstep = (size_t)HALF * K * 2;
    const size_t tstep = 2 * hstep;
    const unsigned ldsw = (unsigned)wid * 1024u;
    const int aoff = lds_byte(wr * 64 + fr, fq * 8), boff = lds_byte(wc * 32 + fr, fq * 8);
#define PG8_SA(b, h) (((b) * 2 + (h)) * HTB)
#define PG8_SB(b, h) ((4 + (b) * 2 + (h)) * HTB)
#define PG8_STAGE(bufoff, gbase, voff) do { _Pragma("unroll") for (int _i = 0; _i < 2; ++_i) \
        __builtin_amdgcn_global_load_lds((const unsigned*)((const char*)(gbase) + (voff)[_i]), (PG8_LAS unsigned*)(lds + (bufoff) + ldsw + _i * 8192), 16, 0, 0); } while (0)
#define PG8_LDA(dst, b, h) do { _Pragma("unroll") for (int m = 0; m < 4; ++m) _Pragma("unroll") for (int k = 0; k < 2; ++k) dst[m][k] = *(const PG8_LAS bf16x8*)(lds + PG8_SA(b, h) + aoff + m * 2048 + k * 1024); } while (0)
#define PG8_LDB(dst, b, h) do { _Pragma("unroll") for (int n = 0; n < 2; ++n) _Pragma("unroll") for (int k = 0; k < 2; ++k) dst[n][k] = *(const PG8_LAS bf16x8*)(lds + PG8_SB(b, h) + boff + n * 2048 + k * 1024); } while (0)
#define PG8_MMA(ai, bj, At, Bt) do { __builtin_amdgcn_s_setprio(1); _Pragma("unroll") for (int m = 0; m < 4; ++m) _Pragma("unroll") for (int n = 0; n < 2; ++n) _Pragma("unroll") for (int k = 0; k < 2; ++k) \
        acc[ai][bj][m][n] = __builtin_amdgcn_mfma_f32_16x16x32_bf16(Bt[n][k], At[m][k], acc[ai][bj][m][n], 0, 0, 0); __builtin_amdgcn_s_setprio(0); } while (0)
#define PG8_WAIT_V(n) asm volatile("s_waitcnt vmcnt(" #n ")" ::: "memory")
#define PG8_WAIT_L(n) asm volatile("s_waitcnt lgkmcnt(" #n ")" ::: "memory")
#define PG8_BAR __builtin_amdgcn_s_barrier()
#define PG8_SCHED __builtin_amdgcn_sched_barrier(0)
    Unit cur, nxt; int ui = 0;
    if (!S.next(0, cur)) return;
    f32x4 acc[2][2][4][2];
#pragma unroll
    for (int a = 0; a < 2; ++a)
#pragma unroll
        for (int b = 0; b < 2; ++b)
#pragma unroll
            for (int m = 0; m < 4; ++m)
#pragma unroll
                for (int n = 0; n < 2; ++n) acc[a][b][m][n] = (f32x4){0.f, 0.f, 0.f, 0.f};
    bf16x8 At[4][2], B0[2][2], B1[2][2];
    const char* cA = (const char*)g.A + (size_t)cur.pm * tstep; const char* cB = (const char*)g.Bt + (size_t)cur.pn * tstep;
    S.a_ready(cur);
    if constexpr (SP2) {
        PG8_STAGE(PG8_SB(0, 0), cB, voffB); PG8_STAGE(PG8_SB(0, 1), cB + hstep, voffB); PG8_STAGE(PG8_SA(0, 0), cA, voffA); PG8_STAGE(PG8_SA(0, 1), cA + hstep, voffA);
        if (wr == 1) PG8_BAR;
        PG8_WAIT_V(2); PG8_BAR;
        PG8_STAGE(PG8_SB(1, 0), cB + kstep, voffB); PG8_STAGE(PG8_SA(1, 0), cA + kstep, voffA); PG8_STAGE(PG8_SB(1, 1), cB + hstep + kstep, voffB);
        PG8_WAIT_V(6); PG8_BAR;
    } else {
        PG8_STAGE(PG8_SB(0, 0), cB, voffB); PG8_STAGE(PG8_SA(0, 0), cA, voffA); PG8_STAGE(PG8_SB(0, 1), cB + hstep, voffB); PG8_STAGE(PG8_SA(0, 1), cA + hstep, voffA);
        if (wr == 1) PG8_BAR;
        PG8_WAIT_V(4); PG8_BAR;
        PG8_STAGE(PG8_SB(1, 0), cB + kstep, voffB); PG8_STAGE(PG8_SA(1, 0), cA + kstep, voffA); PG8_STAGE(PG8_SB(1, 1), cB + hstep + kstep, voffB);
        PG8_WAIT_V(6); PG8_BAR;
    }
    for (;;) {
        const bool has_next = S.next(ui + 1, nxt);
        const char* nA = has_next ? (const char*)g.A + (size_t)nxt.pm * tstep : cA; const char* nB = has_next ? (const char*)g.Bt + (size_t)nxt.pn * tstep : cB;
        for (int t = 0; t < nt; t += 2) {
            const bool last = (t == nt - 2);
            const char* a1 = cA + (size_t)(t + 1) * kstep;
            const char* a2 = last ? nA : cA + (size_t)(t + 2) * kstep; const char* b2 = last ? nB : cB + (size_t)(t + 2) * kstep;
            const char* a3 = a2 + kstep; const char* b3 = b2 + kstep;
            if (last && has_next) S.a_ready(nxt);
            if constexpr (SP2) {
            PG8_LDB(B0, 0, 0); PG8_LDB(B1, 0, 1); PG8_SCHED; PG8_LDA(At, 0, 0); PG8_STAGE(PG8_SA(1, 1), a1 + hstep, voffA);
            PG8_WAIT_V(8); PG8_WAIT_L(0); PG8_BAR; PG8_MMA(0, 0, At, B0); PG8_MMA(0, 1, At, B1); PG8_BAR; PG8_SCHED;
            PG8_LDA(At, 0, 1); PG8_STAGE(PG8_SB(0, 0), b2, voffB); PG8_STAGE(PG8_SB(0, 1), b2 + hstep, voffB); PG8_STAGE(PG8_SA(0, 0), a2, voffA);
            PG8_WAIT_V(8); PG8_WAIT_L(0); PG8_BAR; PG8_MMA(1, 0, At, B0); PG8_MMA(1, 1, At, B1); PG8_BAR; PG8_SCHED;
            PG8_LDB(B0, 1, 0); PG8_LDB(B1, 1, 1); PG8_SCHED; PG8_LDA(At, 1, 0); PG8_STAGE(PG8_SA(0, 1), a2 + hstep, voffA);
            PG8_WAIT_V(8); PG8_WAIT_L(0); PG8_BAR; PG8_MMA(0, 0, At, B0); PG8_MMA(0, 1, At, B1); PG8_BAR; PG8_SCHED;
            PG8_LDA(At, 1, 1); PG8_STAGE(PG8_SB(1, 0), b3, voffB); PG8_STAGE(PG8_SB(1, 1), b3 + hstep, voffB); PG8_STAGE(PG8_SA(1, 0), a3, voffA);
            PG8_WAIT_V(8); PG8_WAIT_L(0); PG8_BAR; PG8_MMA(1, 0, At, B0); PG8_MMA(1, 1, At, B1); PG8_BAR; PG8_SCHED;
            } else {
            PG8_LDB(B0, 0, 0); PG8_SCHED; PG8_LDA(At, 0, 0); PG8_STAGE(PG8_SA(1, 1), a1 + hstep, voffA);
            PG8_WAIT_L(8); PG8_BAR; PG8_WAIT_L(0); PG8_MMA(0, 0, At, B0); PG8_BAR; PG8_SCHED;
            PG8_LDB(B1, 0, 1); PG8_STAGE(PG8_SB(0, 0), b2, voffB);
            PG8_BAR; PG8_WAIT_L(0); PG8_MMA(0, 1, At, B1); PG8_BAR;
            PG8_LDA(At, 0, 1); PG8_STAGE(PG8_SA(0, 0), a2, voffA);
            PG8_BAR; PG8_WAIT_L(0); PG8_MMA(1, 0, At, B0); PG8_BAR; PG8_SCHED;
            PG8_STAGE(PG8_SB(0, 1), b2 + hstep, voffB);
            PG8_WAIT_V(6); PG8_BAR; PG8_MMA(1, 1, At, B1); PG8_BAR;
            PG8_LDB(B0, 1, 0); PG8_SCHED; PG8_LDA(At, 1, 0); PG8_STAGE(PG8_SA(0, 1), a2 + hstep, voffA);
            PG8_WAIT_L(8); PG8_BAR; PG8_WAIT_L(0); PG8_MMA(0, 0, At, B0); PG8_BAR; PG8_SCHED;
            PG8_LDB(B1, 1, 1); PG8_STAGE(PG8_SB(1, 0), b3, voffB);
            PG8_BAR; PG8_WAIT_L(0); PG8_MMA(0, 1, At, B1); PG8_BAR;
            PG8_LDA(At, 1, 1); PG8_STAGE(PG8_SA(1, 0), a3, voffA);
            PG8_BAR; PG8_WAIT_L(0); PG8_MMA(1, 0, At, B0); PG8_BAR; PG8_SCHED;
            PG8_STAGE(PG8_SB(1, 1), b3 + hstep, voffB);
            PG8_WAIT_V(6); PG8_BAR; PG8_MMA(1, 1, At, B1); PG8_BAR;
            }
        }
        if constexpr (ALIGN_EPI) { if (wr == 0) PG8_BAR; }
        if constexpr (!Epi::AFTER_DRAIN) { E(acc, cur, wr, wc, fr, fq); S.done(cur); }
        if (!has_next) break;
#pragma unroll
        for (int a = 0; a < 2; ++a)
#pragma unroll
            for (int b = 0; b < 2; ++b)
#pragma unroll
                for (int m = 0; m < 4; ++m)
#pragma unroll
                    for (int n = 0; n < 2; ++n) acc[a][b][m][n] = (f32x4){0.f, 0.f, 0.f, 0.f};
        cur = nxt; cA = nA; cB = nB; ++ui;
        if constexpr (ALIGN_EPI) { if (wr == 1) PG8_BAR; }
    }
    PG8_WAIT_V(0);
    if constexpr (!ALIGN_EPI) { if (wr == 0) PG8_BAR; }
    PG8_BAR;
    if constexpr (Epi::AFTER_DRAIN) { E.fused(acc, cur, wr, wc, fr, fq, lds, wid, lane); S.done(cur); }
#undef PG8_SA
#undef PG8_SB
#undef PG8_STAGE
#undef PG8_LDA
#undef PG8_LDB
#undef PG8_MMA
#undef PG8_WAIT_V
#undef PG8_WAIT_L
#undef PG8_BAR
#undef PG8_SCHED
}
}
#include <hip/hip_bf16.h>
#include <cmath>
namespace attn_body {
using bf16=__hip_bfloat16;
using bf16x8=__attribute__((ext_vector_type(8)))short;
using s16x4=__attribute__((ext_vector_type(4)))short;
using f32x16=__attribute__((ext_vector_type(16)))float;
using u32x4=__attribute__((ext_vector_type(4)))unsigned;
constexpr int BATCH=8,NHEAD=6,SEQ=4096,D=64,KVP=3072,OP=1024;
constexpr int NW=8,QBLK=32,QB=QBLK*NW,KVBLK=64,NQB=SEQ/QB;
constexpr int ATTN_UNIT_ROWS=QB;
__device__ __forceinline__ int crow(int r,int hi){return (r&3)+8*(r>>2)+4*hi;}
#define SBAR() __builtin_amdgcn_sched_barrier(0)
__device__ __forceinline__ void cmask(f32x16&p0,f32x16&p1,int jb,int qrel,int hi){
  const float NEG=-INFINITY; int kb=64*jb+4*hi;
  #pragma unroll
  for(int r=0;r<16;++r){int kv=kb+(r&3)+8*(r>>2); if(kv>qrel)p0[r]=NEG; if(kv+32>qrel)p1[r]=NEG;}
}

constexpr int NSLOT=3, SLOTB=8192;
constexpr int LDS_K=0, LDS_V=NSLOT*SLOTB, LDS_WS=2*NSLOT*SLOTB, LDS_OST=LDS_WS+NW*64*4, LDS_CK=LDS_OST+NW*4096, LDS_BYTES=LDS_CK+SEQ*4;
constexpr float C2=0.125f*1.4426950408889634f;
__device__ __forceinline__ void glds16(const void*gsrc,unsigned lds_dst){unsigned keep;
  asm volatile("s_mov_b32 %0, m0\n\ts_mov_b32 m0, %2\n\ts_nop 0\n\tglobal_load_lds_dwordx4 %1, off\n\ts_mov_b32 m0, %0":"=&s"(keep):"v"(gsrc),"s"(lds_dst):"memory");}
__device__ __forceinline__ float max3f(float a,float b,float c){float r;asm("v_max3_f32 %0, %1, %2, %3":"=v"(r):"v"(a),"v"(b),"v"(c));return r;}
__device__ __forceinline__ float max2f(float a,float b){float r;asm("v_max_f32_e32 %0, %1, %2":"=v"(r):"v"(a),"v"(b));return r;}
__device__ __forceinline__ float fadd_s(float a,float b){float r;asm("v_add_f32_e32 %0, %1, %2":"=v"(r):"v"(a),"v"(b));return r;}
__device__ __forceinline__ float fsub_s(float a,float b){float r;asm("v_sub_f32_e32 %0, %1, %2":"=v"(r):"v"(a),"v"(b));return r;}
typedef float f32x2_t __attribute__((ext_vector_type(2))); typedef float f32x4_t __attribute__((ext_vector_type(4))); typedef __bf16 bf16x2_t __attribute__((ext_vector_type(2)));
__device__ __forceinline__ unsigned cvtpk_s(float lo,float hi){f32x2_t v={lo,hi};bf16x2_t b=__builtin_convertvector(v,bf16x2_t);return __builtin_bit_cast(unsigned,b);}
#define WAIT_BAR(N) asm volatile("s_waitcnt vmcnt(" #N ") lgkmcnt(0)\n\ts_barrier":::"memory")

__device__ __forceinline__ void qkt(f32x16&p0,f32x16&p1,const char*Kslot,const bf16x8*qr,int r32,int hi){
  const char*kb=Kslot+hi*1024+r32*16;
  #pragma unroll
  for(int d0=0;d0<4;++d0){
    const bf16x8 b0=*reinterpret_cast<const bf16x8*>(kb+d0*2048);
    const bf16x8 b1=*reinterpret_cast<const bf16x8*>(kb+d0*2048+512);
    {p0=__builtin_amdgcn_mfma_f32_32x32x16_bf16(b0,qr[d0],p0,0,0,0);p1=__builtin_amdgcn_mfma_f32_32x32x16_bf16(b1,qr[d0],p1,0,0,0);}}
}
typedef __attribute__((address_space(3))) const char* lds_cptr;
typedef short v4i16_t __attribute__((ext_vector_type(4)));
__device__ __forceinline__ void kload8(bf16x8*kf,lds_cptr kp){
  kf[0]=*(const __attribute__((address_space(3))) bf16x8*)(kp);      kf[1]=*(const __attribute__((address_space(3))) bf16x8*)(kp+512);
  kf[2]=*(const __attribute__((address_space(3))) bf16x8*)(kp+2048); kf[3]=*(const __attribute__((address_space(3))) bf16x8*)(kp+2560);
  kf[4]=*(const __attribute__((address_space(3))) bf16x8*)(kp+4096); kf[5]=*(const __attribute__((address_space(3))) bf16x8*)(kp+4608);
  kf[6]=*(const __attribute__((address_space(3))) bf16x8*)(kp+6144); kf[7]=*(const __attribute__((address_space(3))) bf16x8*)(kp+6656);
}
__device__ __forceinline__ void kload2(bf16x8*kf,lds_cptr kp,int j){ kf[2*j]=*(const __attribute__((address_space(3))) bf16x8*)(kp+j*2048); kf[2*j+1]=*(const __attribute__((address_space(3))) bf16x8*)(kp+j*2048+512); }
__device__ __forceinline__ s16x4 vtr(lds_cptr p){ return __builtin_bit_cast(s16x4,__builtin_amdgcn_ds_read_tr16_b64_v4i16((__attribute__((address_space(3))) v4i16_t*)p)); }
__device__ __forceinline__ float rowmax(const f32x16&p0,const f32x16&p1){
  float a=max3f(p0[0],p0[1],p1[0]),b=max3f(p0[2],p0[3],p1[1]);a=max3f(a,p1[2],p1[3]);
  #pragma unroll
  for(int r=4;r<16;r+=4){a=max3f(a,p0[r],p0[r+1]);b=max3f(b,p0[r+2],p0[r+3]);a=max3f(a,p1[r],p1[r+1]);b=max3f(b,p1[r+2],p1[r+3]);}
  const float m=max2f(a,b);
  auto rr=__builtin_amdgcn_permlane32_swap(__float_as_uint(m),__float_as_uint(m),false,false);
  return max2f(__uint_as_float(rr[0]),__uint_as_float(rr[1]));
}
__device__ __forceinline__ void pv(f32x16*o,int vb,bf16x8 pa0,bf16x8 pa1,bf16x8 pa2,bf16x8 pa3){
  #pragma unroll
  for(int d0=0;d0<2;++d0){s16x4 lo[4],hi[4];
    #pragma unroll
    for(int ks=0;ks<4;++ks){
      asm volatile("ds_read_b64_tr_b16 %0,%1 offset:%c2":"=&v"(lo[ks]):"v"(vb),"i"(d0*4096+ks*1024):"memory");
      asm volatile("ds_read_b64_tr_b16 %0,%1 offset:%c2":"=&v"(hi[ks]):"v"(vb),"i"(d0*4096+ks*1024+512):"memory");}
    asm volatile("s_waitcnt lgkmcnt(0)":::"memory");SBAR();
    #define PK(k) (bf16x8){lo[k][0],lo[k][1],lo[k][2],lo[k][3],hi[k][0],hi[k][1],hi[k][2],hi[k][3]}
    o[d0]=__builtin_amdgcn_mfma_f32_32x32x16_bf16(pa0,PK(0),o[d0],0,0,0);
    o[d0]=__builtin_amdgcn_mfma_f32_32x32x16_bf16(pa1,PK(1),o[d0],0,0,0);
    o[d0]=__builtin_amdgcn_mfma_f32_32x32x16_bf16(pa2,PK(2),o[d0],0,0,0);
    o[d0]=__builtin_amdgcn_mfma_f32_32x32x16_bf16(pa3,PK(3),o[d0],0,0,0);
    #undef PK
  }
}

#ifndef ATTN_STORE16
#define ATTN_STORE16(p,v) (*(u32x4*)(p)=(v))
#endif
template<int THRL> __device__ __forceinline__ void attn_unit(int b,int h,int qb,const bf16*Q,const bf16*__restrict__ K,const bf16*__restrict__ V,bf16*O,const float*__restrict__ CKg,const float*__restrict__ KTm,const float*__restrict__ QBm,char*shm){
  const int tid=tid_l(),lane=tid&63,r32=lane&31,hi=lane>>5; const int wid=__builtin_amdgcn_readfirstlane(tid>>6);
  const long rowbase=(long)b*SEQ; const int q0=qb*QB;
  const bf16*Qw=Q+(rowbase+q0+wid*QBLK)*KVP+h*D;
  const float*ckg=CKg+(long)(b*NHEAD+h)*SEQ;
  int j0=0;
  { const int bh_=b*NHEAD+h, NT0_=(q0+QB)/KVBLK; const float qmx=QBm[bh_*NQB+qb]*1.01f;
    const float kd=fmaxf(fmaxf(KTm[bh_*64+4*qb],KTm[bh_*64+4*qb+1]),fmaxf(KTm[bh_*64+4*qb+2],KTm[bh_*64+4*qb+3]));
    const float thr=-(qmx*kd)-48.f; bool skip=false;
    if(lane<NT0_-4){ const float bound=qmx*KTm[bh_*64+lane]+(ckg[q0]-ckg[64*lane+63]); skip=bound<thr; }
    const unsigned long long m_=__ballot(skip); j0=__builtin_ctzll(~m_); j0=(j0<NT0_-4?j0:NT0_-4)&~1; j0=__builtin_amdgcn_readfirstlane(j0); }
  const bf16*Kh=K+(rowbase+(long)j0*KVBLK)*KVP+h*D,*Vh=V+(rowbase+(long)j0*KVBLK)*KVP+h*D;
  const unsigned lds0=(unsigned)(uintptr_t)shm;
  float*wsf=(float*)(shm+LDS_WS)+wid*64;
  const bf16*ksrc=Kh+(long)lane*KVP+wid*8;
  const bf16*vsrc=Vh+(long)(16*(wid&3)+(lane>>2))*KVP+(wid>>2)*32+(lane&3)*8;
  const unsigned kdst=lds0+LDS_K+wid*1024, vdst=lds0+LDS_V+wid*1024;
  #define DMA_K(t,slot) glds16(ksrc+(long)(t)*KVBLK*KVP,(unsigned)__builtin_amdgcn_readfirstlane(kdst+(slot)))
  #define DMA_V(t,slot) glds16(vsrc+(long)(t)*KVBLK*KVP,(unsigned)__builtin_amdgcn_readfirstlane(vdst+(slot)))
  const int vb0=(int)(lds0+LDS_V)+((lane>>4)&1)*32+(lane&3)*8+(4*hi+((lane&15)>>2))*64;
  const char*Kbase=shm+LDS_K; bf16x8 kf[8];
  const lds_cptr shm3=(lds_cptr)shm; const lds_cptr kp0=shm3+LDS_K+hi*1024+r32*16; const lds_cptr vp0=shm3+LDS_V+((lane>>4)&1)*32+(lane&3)*8+(4*hi+((lane&15)>>2))*64;
  const int NT=(q0+QB)/KVBLK-j0;
  float*cks=(float*)(shm+LDS_CK);
  for(int i=j0*KVBLK+tid*4;i<q0+QB;i+=NW*64*4){ *(f32x4_t*)(cks+i)=*(const f32x4_t*)(ckg+i); }
  float cqm=ckg[q0+wid*QBLK+r32];
  const lds_cptr ckp=(lds_cptr)shm+LDS_CK+j0*256+hi*16;
  DMA_K(0,0);DMA_V(0,0);DMA_K(1,SLOTB);
  bf16x8 qr[4];
  #pragma unroll
  for(int d0=0;d0<4;++d0)qr[d0]=*reinterpret_cast<const bf16x8*>(&Qw[(long)r32*KVP+d0*16+hi*8]);
  float l_reg=0.f;f32x16 o[2];o[0]=f32x16{};o[1]=f32x16{};
  #define CINIT(C0,C1,t) do{ const lds_cptr cp_=ckp+(t)*256; \
    _Pragma("unroll") for(int g_=0;g_<4;++g_){ const f32x4_t a_=*(const __attribute__((address_space(3))) f32x4_t*)(cp_+g_*32); const f32x4_t b_=*(const __attribute__((address_space(3))) f32x4_t*)(cp_+g_*32+128); \
      _Pragma("unroll") for(int i_=0;i_<4;++i_){ C0[g_*4+i_]=cqm-a_[i_]; C1[g_*4+i_]=cqm-b_[i_]; } } }while(0)
  const int qrel=wid*QBLK+r32;
  #define CMASK(P0,P1,t) do{int jb_=(t)-(NT-4); if(jb_>=0)cmask(P0,P1,jb_,qrel,hi);}while(0)
  bool resc=false;
  #define START(P0,P1) do{ const float rm=rowmax(P0,P1); resc=false; \
    { const float dl=rm; \
      _Pragma("unroll") for(int r=0;r<16;++r){P0[r]=fsub_s(P0[r],dl);P1[r]=fsub_s(P1[r],dl);} \
      cqm=fsub_s(cqm,dl); } \
    _Pragma("unroll") for(int r=0;r<16;++r)P0[r]=__builtin_amdgcn_exp2f(P0[r]); }while(0)
  #define RESC() do{ if(resc){ asm volatile("s_waitcnt lgkmcnt(0)":::"memory"); \
      _Pragma("unroll") for(int d_=0;d_<2;++d_) _Pragma("unroll") for(int r=0;r<16;++r)o[d_][r]*=wsf[crow(r,hi)]; } }while(0)
  f32x16 pA0,pA1,pB0,pB1;
  int sl_prev=0,sl_cur=0,sl_next=SLOTB;
  #define ROT() do{sl_prev=sl_cur;sl_cur=sl_next;sl_next=(sl_next==(NSLOT-1)*SLOTB)?0:sl_next+SLOTB;}while(0)
  DMA_K(2,2*SLOTB);
  WAIT_BAR(3);
  CINIT(pA0,pA1,0);
  qkt(pA0,pA1,Kbase,qr,r32,hi);asm volatile("s_nop 15\n\ts_nop 7":"+v"(pA0),"+v"(pA1));CMASK(pA0,pA1,0);
  START(pA0,pA1);
  _Pragma("unroll") for(int r=0;r<16;++r)pA1[r]=__builtin_amdgcn_exp2f(pA1[r]);
  WAIT_BAR(0);
  DMA_K(3,0);DMA_V(1,SLOTB);
  ROT();
  kload8(kf,kp0+sl_cur);
  WAIT_BAR(2);
  s16x4 vlo[8],vhi[8]; u32x4 pw0,pw1,pw2,pw3;
  #define PKW(P,B) cvtpk_s(P[B],P[B+1])
  #define PAF(k) __builtin_bit_cast(bf16x8,pw##k)
  #define VFR(i) (bf16x8){vlo[i][0],vlo[i][1],vlo[i][2],vlo[i][3],vhi[i][0],vhi[i][1],vhi[i][2],vhi[i][3]}
  #define PIN(x) asm volatile("":"+v"(x))
  #define MX3(a,b,c) __builtin_fmaxf(__builtin_fmaxf((a),(b)),(c))
  #define GAPA(MF,A0,A1,A2,A3,W0,W1,PW) do{ MF; sacc+=A0; sacc+=A1; sacc+=A2; sacc+=A3; PIN(sacc); W0; W1; PIN(PW); SBAR(); }while(0)
  #define EX(v) __builtin_amdgcn_exp2f(v)
  #define GAPB(MF,X,B) do{ MF; X[B]=EX(X[B]); X[B+1]=EX(X[B+1]); X[B+2]=EX(X[B+2]); X[B+3]=EX(X[B+3]); PIN(X); SBAR(); }while(0)
  #define VRD(i) do{ vlo[i]=vtr(vp_+(((i)>>2)*4096+((i)&3)*1024)); vhi[i]=vtr(vp_+(((i)>>2)*4096+((i)&3)*1024+512)); }while(0)
  #define KRD(G,j) do{ if(G){ kload2(kf,kp0+sl_next,j); SBAR(); } }while(0)
  #define STEP(C0,C1,P0,P1,t,GK,GV,GL) do{ SBAR(); \
    CINIT(C0,C1,t); SBAR(); \
    const lds_cptr vp_=vp0+sl_prev; \
    VRD(0); SBAR(); float sacc=(P0[0]+P0[1]); \
    GAPA(C0=__builtin_amdgcn_mfma_f32_32x32x16_bf16(kf[0],qr[0],C0,0,0,0), P0[2],P0[3],P0[4],P0[5],     pw0[0]=PKW(P0,0), pw0[1]=PKW(P0,2), pw0); \
    VRD(4); SBAR(); GAPA(C1=__builtin_amdgcn_mfma_f32_32x32x16_bf16(kf[1],qr[0],C1,0,0,0), P0[6],P0[7],P0[8],P0[9],     pw0[2]=PKW(P0,4), pw0[3]=PKW(P0,6), pw0); \
    VRD(1); SBAR(); GAPA(C0=__builtin_amdgcn_mfma_f32_32x32x16_bf16(kf[2],qr[1],C0,0,0,0),   P0[10],P0[11],P0[12],P0[13], pw1[0]=PKW(P0,8), pw1[1]=PKW(P0,10), pw1); \
    VRD(5); SBAR(); GAPA(C1=__builtin_amdgcn_mfma_f32_32x32x16_bf16(kf[3],qr[1],C1,0,0,0),   P0[14],P0[15],P1[0],P1[1],   pw1[2]=PKW(P0,12),pw1[3]=PKW(P0,14), pw1); \
    VRD(2); SBAR(); GAPA(C0=__builtin_amdgcn_mfma_f32_32x32x16_bf16(kf[4],qr[2],C0,0,0,0),   P1[2],P1[3],P1[4],P1[5],     pw2[0]=PKW(P1,0), pw2[1]=PKW(P1,2), pw2); \
    VRD(6); SBAR(); GAPA(C1=__builtin_amdgcn_mfma_f32_32x32x16_bf16(kf[5],qr[2],C1,0,0,0),   P1[6],P1[7],P1[8],P1[9],     pw2[2]=PKW(P1,4), pw2[3]=PKW(P1,6), pw2); \
    VRD(3); SBAR(); GAPA(C0=__builtin_amdgcn_mfma_f32_32x32x16_bf16(kf[6],qr[3],C0,0,0,0),   P1[10],P1[11],P1[12],P1[13], pw3[0]=PKW(P1,8), pw3[1]=PKW(P1,10), pw3); \
    VRD(7); SBAR(); GAPA(C1=__builtin_amdgcn_mfma_f32_32x32x16_bf16(kf[7],qr[3],C1,0,0,0),   P1[14],P1[15],0.f,0.f,       pw3[2]=PKW(P1,12),pw3[3]=PKW(P1,14), pw3); \
    l_reg+=sacc; \
    if(GK){DMA_K((t)+3,sl_cur);} if(GV){DMA_V((t)+1,sl_next);} \
    CMASK(C0,C1,t); \
    { float a=MX3(C0[0],C0[1],C1[0]),b=MX3(C0[2],C0[3],C1[1]); a=MX3(a,C1[2],C1[3]); \
      _Pragma("unroll") for(int r=4;r<16;r+=4){a=MX3(a,C0[r],C0[r+1]);b=MX3(b,C0[r+2],C0[r+3]);a=MX3(a,C1[r],C1[r+1]);b=MX3(b,C1[r+2],C1[r+3]);} \
      float rm=__builtin_fmaxf(a,b); { auto rr=__builtin_amdgcn_permlane32_swap(__float_as_uint(rm),__float_as_uint(rm),false,false); rm=__builtin_fmaxf(__uint_as_float(rr[0]),__uint_as_float(rr[1])); } \
      resc=false; \
      if(__builtin_expect(__any(rm>(float)THRL),0)){ const float dl=__builtin_fmaxf(rm,0.f); \
        _Pragma("unroll") for(int r=0;r<16;++r){C0[r]-=dl;C1[r]-=dl;} \
        cqm-=dl; \
        const float f=__builtin_amdgcn_exp2f(-dl); l_reg*=f; if(hi==0)wsf[r32]=f; resc=true; } } \
    SBAR(); \
    GAPB(o[0]=__builtin_amdgcn_mfma_f32_32x32x16_bf16(PAF(0),VFR(0),o[0],0,0,0), C0,0); \
    GAPB(o[1]=__builtin_amdgcn_mfma_f32_32x32x16_bf16(PAF(0),VFR(4),o[1],0,0,0), C0,4); \
    KRD(GL,0); GAPB(o[0]=__builtin_amdgcn_mfma_f32_32x32x16_bf16(PAF(1),VFR(1),o[0],0,0,0), C0,8); \
    KRD(GL,1); GAPB(o[1]=__builtin_amdgcn_mfma_f32_32x32x16_bf16(PAF(1),VFR(5),o[1],0,0,0), C0,12); \
    KRD(GL,2); GAPB(o[0]=__builtin_amdgcn_mfma_f32_32x32x16_bf16(PAF(2),VFR(2),o[0],0,0,0), C1,0); \
    KRD(GL,3); GAPB(o[1]=__builtin_amdgcn_mfma_f32_32x32x16_bf16(PAF(2),VFR(6),o[1],0,0,0), C1,4); \
    GAPB(o[0]=__builtin_amdgcn_mfma_f32_32x32x16_bf16(PAF(3),VFR(3),o[0],0,0,0), C1,8); \
    GAPB(o[1]=__builtin_amdgcn_mfma_f32_32x32x16_bf16(PAF(3),VFR(7),o[1],0,0,0), C1,12); \
    }while(0)
  int t=1;
  #undef CMASK
  #define CMASK(P0,P1,t) do{}while(0)
  for(;t+5<NT;t+=2){
    STEP(pB0,pB1,pA0,pA1,t,true,true,true);     WAIT_BAR(2); RESC(); ROT();
    STEP(pA0,pA1,pB0,pB1,t+1,true,true,true);   WAIT_BAR(2); RESC(); ROT();
  }
  #undef CMASK
  #define CMASK(P0,P1,t) do{int jb_=(t)-(NT-4); if(jb_>=0)cmask(P0,P1,jb_,qrel,hi);}while(0)
  #define ENDW(tt) do{ if((tt)+3<NT){WAIT_BAR(2);} else if((tt)+2<NT){WAIT_BAR(1);} else {WAIT_BAR(0);} }while(0)
  for(;t+1<NT;t+=2){
    STEP(pB0,pB1,pA0,pA1,t,(t+3<NT),(t+1<NT),(t+1<NT));       ENDW(t);   RESC(); ROT();
    STEP(pA0,pA1,pB0,pB1,t+1,(t+4<NT),(t+2<NT),(t+2<NT));     ENDW(t+1); RESC(); ROT();
  }
  STEP(pB0,pB1,pA0,pA1,NT-1,false,false,false); RESC();
  { float sacc=pB0[0]+pB0[1]; _Pragma("unroll") for(int r=2;r<16;++r)sacc+=pB0[r]; _Pragma("unroll") for(int r=0;r<16;++r)sacc+=pB1[r]; l_reg+=sacc;
    pw0=(u32x4){PKW(pB0,0),PKW(pB0,2),PKW(pB0,4),PKW(pB0,6)};pw1=(u32x4){PKW(pB0,8),PKW(pB0,10),PKW(pB0,12),PKW(pB0,14)};pw2=(u32x4){PKW(pB1,0),PKW(pB1,2),PKW(pB1,4),PKW(pB1,6)};pw3=(u32x4){PKW(pB1,8),PKW(pB1,10),PKW(pB1,12),PKW(pB1,14)};
    SBAR(); pv(o,vb0+sl_cur,PAF(0),PAF(1),PAF(2),PAF(3)); }
  #undef PKW
  #undef PAF
  #undef VFR
  #undef PIN
  #undef MX3
  #undef GAPA
  #undef GAPB
  #undef EX
  #undef VRD
  #undef KRD
  #undef STEP
  #undef ENDW
  {auto rr=__builtin_amdgcn_permlane32_swap(__float_as_uint(l_reg),__float_as_uint(l_reg),false,false);l_reg=__uint_as_float(rr[0])+__uint_as_float(rr[1]);}
  if(hi==0)wsf[32+r32]=l_reg;asm volatile("s_waitcnt lgkmcnt(0)":::"memory");
  float rli[16];
  #pragma unroll
  for(int r=0;r<16;++r)rli[r]=__builtin_amdgcn_rcpf(wsf[32+crow(r,hi)]);
  bf16*Ow=O+(rowbase+q0+wid*QBLK)*OP+h*D;
  { bf16*stg=(bf16*)(shm+LDS_OST)+wid*2048;
    #pragma unroll
    for(int r=0;r<16;++r){const int orow=crow(r,hi);
      #pragma unroll
      for(int d0=0;d0<2;++d0)stg[orow*64+d0*32+r32]=__float2bfloat16(o[d0][r]*rli[r]);}
    asm volatile("s_waitcnt lgkmcnt(0)":::"memory");
    #pragma unroll
    for(int i=0;i<4;++i){const int row=i*8+(lane>>3),ch=lane&7; const u32x4 v=*(const u32x4*)(stg+row*64+ch*8); ATTN_STORE16(Ow+(long)row*OP+ch*8,v);} }
  asm volatile("s_waitcnt lgkmcnt(0)\n\ts_barrier":::"memory");
  #undef DMA_K
  #undef DMA_V
  #undef CMASK
  #undef START
  #undef RESC
  #undef ROT
  #undef CINIT
}
constexpr int ATTN_LDS_BYTES=LDS_BYTES;
struct AttnTensors { const bf16* Q; const bf16* K; const bf16* V; bf16* O; const float* CK; const float* KT; const float* QB; };
struct AttnUnit { int bh; int qb; };
struct QueueOrder {
  unsigned* head; volatile __attribute__((address_space(3))) int* slot;
  __device__ __forceinline__ bool next(int,AttnUnit&u)const{
    if(tid_l()==0) *slot=(int)__hip_atomic_fetch_add(head,1u,__ATOMIC_RELAXED,__HIP_MEMORY_SCOPE_AGENT);
    __syncthreads(); const int v=*slot; __syncthreads();
    if(v>=BATCH*NHEAD*NQB)return false; u.qb=NQB-1-v/(BATCH*NHEAD); u.bh=v%(BATCH*NHEAD); return true; }
  __device__ __forceinline__ void a_ready(const AttnUnit&)const{}
  __device__ __forceinline__ void done(const AttnUnit&)const{}
};
template<class Sched,int THRL=8> __device__ __forceinline__ void attn_phase(char*lds,const AttnTensors&T,const Sched&S){
  AttnUnit u;
  for(int i=0;S.next(i,u);++i){ S.a_ready(u); attn_unit<THRL>(u.bh/NHEAD,u.bh%NHEAD,u.qb,T.Q,T.K,T.V,T.O,T.CK,T.KT,T.QB,lds); S.done(u); }
}
#undef SBAR
#undef WAIT_BAR
}

constexpr int NB = 8, SEQ = 4096, T = NB * SEQ, D = 1024, DEPTH = 4;
constexpr int HCOLS = 3072;
constexpr int HC_AVAL = 0, HC_AGATE = 256, HC_BQ = 512, HC_BK = 704, HC_BV = 896, HC_BG = 1280, HC_CQ = 1664, HC_CK = 2048, HC_CV = 2432, HC_LR = 2816, HC_CF = 2832;
constexpr int IN_COLS = 2838;
constexpr int MC_A = 0, MC_B = 256, MC_C = 640;
constexpr float LN_EPS = 1e-5f;
constexpr float ALPHA = 1.6817928305074292f;
constexpr float LOG2E = 1.4426950408889634f;
constexpr float C2 = 0.125f * LOG2E;
constexpr float GLA_QSCALE = 0.17677669529663687f;
constexpr int NEXP = 16384;

constexpr size_t MiB = 1u << 20;
constexpr size_t WS_CTL = 0, CTL_ZERO_BYTES = 1 * MiB;
constexpr size_t WS_WIN = 1 * MiB;
constexpr size_t WS_WOUT = WS_WIN + 24 * MiB;
constexpr size_t WS_WP = WS_WOUT + 8 * MiB;
constexpr size_t WS_PGW = WS_WP + 16 * MiB;
constexpr size_t WS_PW = WS_PGW + 8 * MiB;
constexpr size_t WS_CK = WS_PW + 2 * MiB;
constexpr size_t WS_FKT = WS_CK + 768 * 1024, WS_FQB = WS_FKT + 16 * 1024;
constexpr size_t WS_U = WS_CK + 1 * MiB;
constexpr size_t WS_V = WS_U + 32 * MiB;
constexpr size_t WS_XB = WS_V + 32 * MiB;
constexpr size_t WS_XF = WS_XB + 64 * MiB;
constexpr size_t WS_XQ = WS_XF, WS_XS = WS_XF + 32 * MiB, WS_RS = WS_XS + 1 * MiB, WS_VS = WS_RS + 65536;
constexpr size_t WS_PB = WS_XF + 128 * MiB;
constexpr size_t WS_H = WS_PB + 16 * MiB;
constexpr size_t WS_MIX = WS_H + 192 * MiB;
constexpr size_t WS_SC = WS_H;
constexpr size_t WS_Y = WS_MIX + 64 * MiB;
constexpr size_t WS_GCUM = WS_Y;
constexpr size_t WS_GS = WS_GCUM + 24 * MiB;
constexpr size_t WS_GDEC = WS_GS + 24 * MiB;
constexpr size_t WS_E = WS_Y + 128 * MiB;
constexpr size_t WS_EIDX = WS_E + 64 * MiB;
constexpr size_t WS_GATE = WS_EIDX + 16 * MiB;
constexpr size_t WS_SOFF = WS_GATE + 16 * MiB;
constexpr size_t WS_END = WS_SOFF + 1 * MiB;
static_assert(WS_END <= 1024 * MiB, "d_ws map");

constexpr int LDS_BYTES = 147456;

typedef unsigned short bf16;
typedef float f32x4 __attribute__((ext_vector_type(4)));
typedef unsigned u32x4 __attribute__((ext_vector_type(4)));
typedef unsigned u32x2 __attribute__((ext_vector_type(2)));

struct Params {
    const float *x, *p, *w_in, *conv_w, *conv_b, *conv_ln_g, *conv_ln_b, *gla_gate_w, *gla_gate_b, *gla_norm_g, *fox_forget_b, *w_out, *ln1_g, *ln1_b,
        *peer_wq, *peer_keys, *peer_u, *peer_v, *ple_w, *ple_gw, *ple_gb, *ln2_g, *ln2_b;
    float* out; unsigned char* ws;
};

__device__ __forceinline__ float bf2f(unsigned h) { return __uint_as_float(h << 16); }
__device__ __forceinline__ unsigned f2bf(float f) { unsigned u = __float_as_uint(f); return (u + 0x7fffu + ((u >> 16) & 1u)) >> 16; }
__device__ __forceinline__ unsigned pk2(float lo, float hi) { return f2bf(lo) | (f2bf(hi) << 16); }
__device__ __forceinline__ float wave_sum(float v) {
#pragma unroll
    for (int o = 1; o < 64; o <<= 1) v += __shfl_xor(v, o);
    return v;
}
__device__ __forceinline__ float log_sigmoid(float z) { return fminf(z, 0.f) - log1pf(__expf(-fabsf(z))); }
__device__ __forceinline__ float sigmoidf_(float z) { return 1.0f / (1.0f + __expf(-z)); }

struct MapIdent { __device__ __forceinline__ void operator()(int n, int& c, float& s) const { c = n; s = 1.f; } };
struct MapWin {
    __device__ __forceinline__ void operator()(int n, int& c, float& s) const {
        s = 1.f;
        if (n < HC_CQ) { c = n; if (n >= HC_BQ && n < HC_BK) s = GLA_QSCALE; }
        else if (n < HC_LR) { c = n + 16; if (n < HC_CK) s = C2; }
        else if (n < HC_CF) c = n - HC_LR + 1664;
        else if (n < IN_COLS) c = n;
        else c = -1;
    }
};
template <class CM>
__device__ __forceinline__ void transpose_item(const float* W, int K, int Nsrc, bf16* WT, int item, int nblk, float* scr, int lane, const CM& cm) {
    const int kb = item / nblk, nb = item % nblk, k0 = 64 * kb, n0 = 32 * nb;
    int sc; float scale; cm(n0 + (lane & 31), sc, scale);
#pragma unroll 8
    for (int i = 0; i < 32; ++i) { const int kk = 2 * i + (lane >> 5); scr[kk * 33 + (lane & 31)] = sc >= 0 ? W[(size_t)(k0 + kk) * Nsrc + sc] * scale : 0.f; }
    __builtin_amdgcn_wave_barrier(); asm volatile("s_waitcnt lgkmcnt(0)" ::: "memory");
    const int c = lane & 7;
#pragma unroll
    for (int j = 0; j < 4; ++j) { const int n = (lane >> 3) + 8 * j; const float* s = scr + (8 * c) * 33 + n;
        u32x4 o; o.x = pk2(s[0 * 33], s[1 * 33]); o.y = pk2(s[2 * 33], s[3 * 33]); o.z = pk2(s[4 * 33], s[5 * 33]); o.w = pk2(s[6 * 33], s[7 * 33]);
        *(u32x4*)(WT + (size_t)(n0 + n) * K + k0 + 8 * c) = o; }
    asm volatile("s_waitcnt lgkmcnt(0)" ::: "memory"); __builtin_amdgcn_wave_barrier();
}
__device__ __forceinline__ void cvt_bf16_stream(const float* src, bf16* dst, size_t n8, size_t gtid, size_t gthreads) {
    for (size_t i = gtid; i < n8; i += gthreads) { const f32x4 a = *(const f32x4*)(src + i * 8), b = *(const f32x4*)(src + i * 8 + 4);
        u32x4 o; o.x = pk2(a[0], a[1]); o.y = pk2(a[2], a[3]); o.z = pk2(b[0], b[1]); o.w = pk2(b[2], b[3]); *(u32x4*)(dst + i * 8) = o; }
}

__device__ __forceinline__ void phase_pro_a(const Params& p, unsigned char* lds) {
    const int tid = tid_l(), lane = tid & 63, wave = tid >> 6;
    float* scr = (float*)(lds + wave * 16384);
    const int gw = bid_l() * 8 + wave, NGW = grid_l() * 8;
    constexpr int I_WIN = (D / 64) * (HCOLS / 32), I_SQ = (D / 64) * (D / 32), I_PW = (256 / 64) * (D / 32);
    constexpr int PER_L = I_WIN + 2 * I_SQ + I_PW;
    for (int it = gw; it < DEPTH * PER_L; it += NGW) {
        const int l = it / PER_L; int r = it % PER_L;
        if (r < I_WIN) { transpose_item(p.w_in + (size_t)l * D * IN_COLS, D, IN_COLS, (bf16*)(p.ws + WS_WIN) + (size_t)l * HCOLS * D, r, HCOLS / 32, scr, lane, MapWin()); continue; } r -= I_WIN;
        if (r < I_SQ) { transpose_item(p.w_out + (size_t)l * D * D, D, D, (bf16*)(p.ws + WS_WOUT) + (size_t)l * D * D, r, D / 32, scr, lane, MapIdent()); continue; } r -= I_SQ;
        if (r < I_SQ) { transpose_item(p.ple_gw + (size_t)l * D * D, D, D, (bf16*)(p.ws + WS_PGW) + (size_t)l * D * D, r, D / 32, scr, lane, MapIdent()); continue; } r -= I_SQ;
        transpose_item(p.ple_w + (size_t)l * 256 * D, 256, D, (bf16*)(p.ws + WS_PW) + (size_t)l * D * 256, r, D / 32, scr, lane, MapIdent());
    }
    cvt_bf16_stream(p.x, (bf16*)(p.ws + WS_XB), (size_t)T * D / 8, (size_t)bid_l() * 512 + tid, (size_t)grid_l() * 512);
}
__device__ __forceinline__ void phase_pro_b(const Params& p, unsigned char* lds) {
    const int tid = tid_l();
    float* ks = (float*)lds;
    float* wqs = ks + 128 * 129;
    for (int it = bid_l(); it < DEPTH * 16 * 16; it += grid_l()) {
        const int l = it >> 8, hc = (it >> 4) & 15, kt = it & 15;
        const float* keys = p.peer_keys + ((size_t)l * 16 + hc) * 16384;
        const float* wq = p.peer_wq + (size_t)l * D * 2048 + (size_t)(kt * 64) * 2048 + hc * 128;
        __syncthreads();
        for (int i = tid; i < 128 * 128; i += 512) ks[(i >> 7) * 129 + (i & 127)] = keys[i];
        for (int i = tid; i < 64 * 128; i += 512) wqs[(i >> 7) * 129 + (i & 127)] = wq[(size_t)(i >> 7) * 2048 + (i & 127)];
        __syncthreads();
        const int k = tid & 63, n0 = (tid >> 6) * 16;
        float acc[16];
#pragma unroll
        for (int j = 0; j < 16; ++j) acc[j] = 0.f;
        for (int d = 0; d < 128; ++d) { const float a = wqs[k * 129 + d];
#pragma unroll
            for (int j = 0; j < 16; ++j) acc[j] += a * ks[(n0 + j) * 129 + d]; }
        bf16* WpT = (bf16*)(p.ws + WS_WP) + (size_t)l * 2048 * D;
#pragma unroll
        for (int j = 0; j < 16; ++j) WpT[(size_t)(hc * 128 + n0 + j) * D + kt * 64 + k] = (bf16)f2bf(acc[j]);
    }
}
constexpr float U8_SCALE = 64.f, V8_SCALE = 1.f;
typedef float f32x2v __attribute__((ext_vector_type(2)));
__device__ __forceinline__ unsigned pk_fp8x4(f32x4 v, float sc) {
    const float a = fminf(fmaxf(v[0] * sc, -448.f), 448.f), b = fminf(fmaxf(v[1] * sc, -448.f), 448.f), c = fminf(fmaxf(v[2] * sc, -448.f), 448.f), d = fminf(fmaxf(v[3] * sc, -448.f), 448.f);
    int w = __builtin_amdgcn_cvt_pk_fp8_f32(a, b, 0, false); w = __builtin_amdgcn_cvt_pk_fp8_f32(c, d, w, true); return (unsigned)w;
}
__device__ __forceinline__ void cvt_fp8_stream(const float* src, unsigned char* dst, size_t n16, float sc, size_t gtid, size_t gthreads) {
    for (size_t i = gtid; i < n16; i += gthreads) { const float* s = src + i * 16; u32x4 o;
        o.x = pk_fp8x4(*(const f32x4*)(s), sc); o.y = pk_fp8x4(*(const f32x4*)(s + 4), sc); o.z = pk_fp8x4(*(const f32x4*)(s + 8), sc); o.w = pk_fp8x4(*(const f32x4*)(s + 12), sc);
        *(u32x4*)(dst + i * 16) = o; }
}
__device__ __forceinline__ float wave_max(float v) {
#pragma unroll
    for (int o = 32; o > 0; o >>= 1) v = fmaxf(v, __shfl_xor(v, o));
    return v;
}
__device__ __forceinline__ unsigned pk_i8x4(f32x4 v, float sc) {
    const int a = (int)__builtin_rintf(v[0] * sc), b = (int)__builtin_rintf(v[1] * sc), c = (int)__builtin_rintf(v[2] * sc), d = (int)__builtin_rintf(v[3] * sc);
    return (unsigned)(a & 255) | ((unsigned)(b & 255) << 8) | ((unsigned)(c & 255) << 16) | ((unsigned)d << 24);
}
__device__ __forceinline__ void cvt_i8_rows(const float* src, unsigned char* dst, float* RS, size_t n16, size_t gtid, size_t gthreads) {
    for (size_t i = gtid; i < n16; i += gthreads) { const float* s_ = src + i * 16;
        const f32x4 a = *(const f32x4*)(s_), b = *(const f32x4*)(s_ + 4), c = *(const f32x4*)(s_ + 8), d = *(const f32x4*)(s_ + 12);
        float m = fmaxf(fmaxf(fmaxf(fabsf(a[0]), fabsf(a[1])), fmaxf(fabsf(a[2]), fabsf(a[3]))), fmaxf(fmaxf(fabsf(b[0]), fabsf(b[1])), fmaxf(fabsf(b[2]), fabsf(b[3]))));
        m = fmaxf(m, fmaxf(fmaxf(fmaxf(fabsf(c[0]), fabsf(c[1])), fmaxf(fabsf(c[2]), fabsf(c[3]))), fmaxf(fmaxf(fabsf(d[0]), fabsf(d[1])), fmaxf(fabsf(d[2]), fabsf(d[3])))));
        m = wave_max(m); const float sc = m > 0.f ? 127.0f / m : 0.f;
        u32x4 o; o.x = pk_i8x4(a, sc); o.y = pk_i8x4(b, sc); o.z = pk_i8x4(c, sc); o.w = pk_i8x4(d, sc);
        *(u32x4*)(dst + i * 16) = o;
        if ((i & 63) == 0) RS[i >> 6] = m * (1.0f / 127.0f); }
}
__device__ __forceinline__ unsigned pk_i4x8(f32x4 a, f32x4 b, float sc) {
    unsigned w = 0u;
#pragma unroll
    for (int i = 0; i < 4; ++i) { w |= ((unsigned)(int)__builtin_rintf(a[i] * sc) & 15u) << (4 * i); w |= ((unsigned)(int)__builtin_rintf(b[i] * sc) & 15u) << (16 + 4 * i); }
    return w;
}
__device__ __forceinline__ void cvt_i4_rows(const float* src, unsigned char* dst, float* RS, size_t n16, size_t gtid, size_t gthreads) {
    for (size_t i = gtid; i < n16; i += gthreads) { const float* s_ = src + i * 16;
        const f32x4 a = *(const f32x4*)(s_), b = *(const f32x4*)(s_ + 4), c = *(const f32x4*)(s_ + 8), d = *(const f32x4*)(s_ + 12);
        float m = fmaxf(fmaxf(fmaxf(fabsf(a[0]), fabsf(a[1])), fmaxf(fabsf(a[2]), fabsf(a[3]))), fmaxf(fmaxf(fabsf(b[0]), fabsf(b[1])), fmaxf(fabsf(b[2]), fabsf(b[3]))));
        m = fmaxf(m, fmaxf(fmaxf(fmaxf(fabsf(c[0]), fabsf(c[1])), fmaxf(fabsf(c[2]), fabsf(c[3]))), fmaxf(fmaxf(fabsf(d[0]), fabsf(d[1])), fmaxf(fabsf(d[2]), fabsf(d[3])))));
        m = wave_max(m); const float sc = m > 0.f ? 7.49f / m : 0.f;
        u32x2 o; o.x = pk_i4x8(a, b, sc); o.y = pk_i4x8(c, d, sc); *(u32x2*)(dst + i * 8) = o;
        if ((i & 63) == 0) RS[i >> 6] = m * (1.0f / 7.49f); }
}
__device__ __forceinline__ void cvt_fp4_rows(const float* src, unsigned char* dst, float* VS, size_t n16, size_t gtid, size_t gthreads) {
    for (size_t i = gtid; i < n16; i += gthreads) { const float* s_ = src + i * 16;
        const f32x4 a = *(const f32x4*)(s_), b = *(const f32x4*)(s_ + 4), c = *(const f32x4*)(s_ + 8), d = *(const f32x4*)(s_ + 12);
        float m = fmaxf(fmaxf(fmaxf(fabsf(a[0]), fabsf(a[1])), fmaxf(fabsf(a[2]), fabsf(a[3]))), fmaxf(fmaxf(fabsf(b[0]), fabsf(b[1])), fmaxf(fabsf(b[2]), fabsf(b[3]))));
        m = fmaxf(m, fmaxf(fmaxf(fmaxf(fabsf(c[0]), fabsf(c[1])), fmaxf(fabsf(c[2]), fabsf(c[3]))), fmaxf(fmaxf(fabsf(d[0]), fabsf(d[1])), fmaxf(fabsf(d[2]), fabsf(d[3])))));
        m = wave_max(m); const float sc = m > 0.f ? 6.0f / m : 0.f;
        unsigned w0 = 0u, w1 = 0u;
        w0 = __builtin_amdgcn_cvt_scalef32_pk_fp4_f32(w0, a[0] * sc, a[1] * sc, 1.0f, 0); w0 = __builtin_amdgcn_cvt_scalef32_pk_fp4_f32(w0, a[2] * sc, a[3] * sc, 1.0f, 1);
        w0 = __builtin_amdgcn_cvt_scalef32_pk_fp4_f32(w0, b[0] * sc, b[1] * sc, 1.0f, 2); w0 = __builtin_amdgcn_cvt_scalef32_pk_fp4_f32(w0, b[2] * sc, b[3] * sc, 1.0f, 3);
        w1 = __builtin_amdgcn_cvt_scalef32_pk_fp4_f32(w1, c[0] * sc, c[1] * sc, 1.0f, 0); w1 = __builtin_amdgcn_cvt_scalef32_pk_fp4_f32(w1, c[2] * sc, c[3] * sc, 1.0f, 1);
        w1 = __builtin_amdgcn_cvt_scalef32_pk_fp4_f32(w1, d[0] * sc, d[1] * sc, 1.0f, 2); w1 = __builtin_amdgcn_cvt_scalef32_pk_fp4_f32(w1, d[2] * sc, d[3] * sc, 1.0f, 3);
        u32x2 o; o.x = w0; o.y = w1; *(u32x2*)(dst + i * 8) = o;
        if ((i & 63) == 0) VS[i >> 6] = m * (1.0f / 6.0f); }
}
__device__ __forceinline__ void phase_cvt(const Params& p, int l) {
    const size_t gtid = (size_t)bid_l() * 512 + tid_l(), gth = (size_t)grid_l() * 512;
    cvt_bf16_stream(p.p + (size_t)l * T * 256, (bf16*)(p.ws + WS_PB), (size_t)T * 256 / 8, gtid, gth);
    cvt_i4_rows(p.peer_u + (size_t)l * NEXP * D, p.ws + WS_U, (float*)(p.ws + WS_RS), (size_t)NEXP * D / 16, gtid, gth);
    cvt_fp4_rows(p.peer_v + (size_t)l * NEXP * D, p.ws + WS_V, (float*)(p.ws + WS_VS), (size_t)NEXP * D / 16, gtid, gth);
}

#define GEMM_RUN(EPI, e, Aptr, Bptr, N_, K_) do { int kk_ = (K_); asm volatile("" : "+s"(kk_)); pg8::Gemm g{(const pg8::bf16_t*)(Aptr), (const pg8::bf16_t*)(Bptr), T, (N_), kk_}; pg8::StaticOrder S; S.init(T, (N_), (int)grid_l(), (int)bid_l()); \
    pg8::gemm_phase<EPI, pg8::StaticOrder, true, true>((PG8_LAS unsigned char*)lds, g, S, e); } while (0)

__device__ __forceinline__ void phase_gemm_in(const Params& p, int l, unsigned char* lds) {
    pg8::EpiBf16<0> e{(pg8::bf16_t*)(p.ws + WS_H), HCOLS, nullptr, 0, 0, 1.f};
    GEMM_RUN(pg8::EpiBf16<0>, e, p.ws + WS_XB, (bf16*)(p.ws + WS_WIN) + (size_t)l * HCOLS * D, HCOLS, D);
}
__device__ __forceinline__ void phase_gemm_e(const Params& p, int l, unsigned char* lds) {
    pg8::EpiBf16<0> e{(pg8::bf16_t*)(p.ws + WS_E), D, nullptr, 0, 0, 1.f};
    GEMM_RUN(pg8::EpiBf16<0>, e, p.ws + WS_PB, (bf16*)(p.ws + WS_PW) + (size_t)l * D * 256, D, 256);
}
__device__ __forceinline__ void phase_gemm_out(const Params& p, int l, unsigned char* lds) {
    pg8::EpiResid e{(const pg8::bf16_t*)(p.ws + WS_XB), (_Float16*)(p.ws + WS_Y), D, ALPHA};
    GEMM_RUN(pg8::EpiResid, e, p.ws + WS_MIX, (bf16*)(p.ws + WS_WOUT) + (size_t)l * D * D, D, D);
}
__device__ __forceinline__ void phase_gemm_sc(const Params& p, int l, unsigned char* lds) {
    pg8::EpiF16 e{(_Float16*)(p.ws + WS_SC), 2048};
    GEMM_RUN(pg8::EpiF16, e, p.ws + WS_XB, (bf16*)(p.ws + WS_WP) + (size_t)l * 2048 * D, 2048, D);
}
__device__ __forceinline__ void phase_gemm_ple(const Params& p, int l, unsigned char* lds) {
    pg8::EpiPle e{(const pg8::bf16_t*)(p.ws + WS_XB), (_Float16*)(p.ws + WS_Y), (const pg8::bf16_t*)(p.ws + WS_E), p.ple_gb + (size_t)l * D, D};
    GEMM_RUN(pg8::EpiPle, e, p.ws + WS_XB, (bf16*)(p.ws + WS_PGW) + (size_t)l * D * D, D, D);
}

__device__ __forceinline__ void phase_conv(const Params& p, int l, unsigned char* lds) {
    const int tid = tid_l(), lane = tid & 63, wave = tid >> 6;
    float* U = (float*)lds;
    float* Yt = U + 62 * 256;
    const bf16* H = (const bf16*)(p.ws + WS_H); bf16* MIX = (bf16*)(p.ws + WS_MIX);
    const float* cw = p.conv_w + (size_t)l * 31 * 256; const float* cb = p.conv_b + l * 256;
    const float* lg = p.conv_ln_g + l * 256; const float* lb = p.conv_ln_b + l * 256;
    for (int it = bid_l(); it < T / 32; it += grid_l()) {
        const int b = it / (SEQ / 32), t0 = (it % (SEQ / 32)) * 32;
        __syncthreads();
        for (int i = tid; i < 62 * 32; i += 512) { const int r = i >> 5, c8 = (i & 31) * 8, t = t0 - 30 + r; f32x4 u0 = {0.f, 0.f, 0.f, 0.f}, u1 = {0.f, 0.f, 0.f, 0.f};
            if (t >= 0) { const bf16* hr = H + (size_t)(b * SEQ + t) * HCOLS; const u32x4 av = *(const u32x4*)(hr + HC_AVAL + c8), gv = *(const u32x4*)(hr + HC_AGATE + c8);
#pragma unroll
                for (int j = 0; j < 2; ++j) { u0[2 * j] = bf2f(av[j] & 0xffffu) * sigmoidf_(bf2f(gv[j] & 0xffffu)); u0[2 * j + 1] = __uint_as_float(av[j] & 0xffff0000u) * sigmoidf_(__uint_as_float(gv[j] & 0xffff0000u));
                                              u1[2 * j] = bf2f(av[2 + j] & 0xffffu) * sigmoidf_(bf2f(gv[2 + j] & 0xffffu)); u1[2 * j + 1] = __uint_as_float(av[2 + j] & 0xffff0000u) * sigmoidf_(__uint_as_float(gv[2 + j] & 0xffff0000u)); } }
            *(f32x4*)(U + r * 256 + c8) = u0; *(f32x4*)(U + r * 256 + c8 + 4) = u1; }
        __syncthreads();
        { const int c = tid & 255, half = tid >> 8; float w[31], win[46];
#pragma unroll
          for (int j = 0; j < 31; ++j) w[j] = cw[j * 256 + c];
#pragma unroll
          for (int j = 0; j < 46; ++j) win[j] = U[(half * 16 + j) * 256 + c];
          const float bias = cb[c];
#pragma unroll
          for (int tl = 0; tl < 16; ++tl) { float y = bias;
#pragma unroll
              for (int j = 0; j < 31; ++j) y += w[j] * win[tl + j];
              Yt[(half * 16 + tl) * 256 + c] = y; } }
        __syncthreads();
        for (int tl = wave * 4; tl < wave * 4 + 4; ++tl) {
            const f32x4 v = *(const f32x4*)(Yt + tl * 256 + lane * 4);
            const float mean = wave_sum((v[0] + v[1]) + (v[2] + v[3])) * (1.f / 256.f);
            const f32x4 d = v - mean; const float var = wave_sum((d[0] * d[0] + d[1] * d[1]) + (d[2] * d[2] + d[3] * d[3])) * (1.f / 256.f);
            const float rstd = 1.0f / sqrtf(var + LN_EPS);
            const f32x4 g4 = *(const f32x4*)(lg + lane * 4), b4 = *(const f32x4*)(lb + lane * 4);
            float o[4];
#pragma unroll
            for (int i = 0; i < 4; ++i) { const float z = d[i] * rstd * g4[i] + b4[i]; o[i] = z * sigmoidf_(z); }
            u32x2 w2; w2.x = pk2(o[0], o[1]); w2.y = pk2(o[2], o[3]);
            *(u32x2*)(MIX + (size_t)(b * SEQ + t0 + tl) * D + MC_A + lane * 4) = w2;
        }
    }
}

__device__ __forceinline__ void phase_fox_cum(const Params& p, int l, unsigned char* lds) {
    const int tid = tid_l(), lane = tid & 63, wave = tid >> 6;
    float* wsum = (float*)lds;
    const bf16* H = (const bf16*)(p.ws + WS_H); float* CK = (float*)(p.ws + WS_CK);
    for (int bh = bid_l(); bh < 48; bh += grid_l()) {
        const int b = bh / 6, h = bh % 6; const float bias = p.fox_forget_b[l * 6 + h];
        float v[8]; float s = 0.f;
#pragma unroll
        for (int i = 0; i < 8; ++i) { const float f = bf2f(H[(size_t)(b * SEQ + tid * 8 + i) * HCOLS + HC_CF + h]); s += log_sigmoid(f + bias) * LOG2E; v[i] = s; }
        float incl = s;
#pragma unroll
        for (int o = 1; o < 64; o <<= 1) { const float n = __shfl_up(incl, o); if (lane >= o) incl += n; }
        __syncthreads();
        if (lane == 63) wsum[wave] = incl;
        __syncthreads();
        float base = incl - s;
        for (int w = 0; w < wave; ++w) base += wsum[w];
#pragma unroll
        for (int i = 0; i < 8; ++i) CK[(size_t)bh * SEQ + tid * 8 + i] = base + v[i];
    }
}

__device__ __forceinline__ void phase_fox_norm(const Params& p, unsigned char* lds) {
    const int tid = tid_l(), lane = tid & 63, wave = tid >> 6;
    float* qns = (float*)lds; float* kns = qns + 256;
    const bf16* H = (const bf16*)(p.ws + WS_H); float* KT = (float*)(p.ws + WS_FKT); float* QBM = (float*)(p.ws + WS_FQB);
    for (int it = bid_l(); it < 48 * 16; it += grid_l()) {
        const int bh = it >> 4, qb = it & 15, b = bh / 6, h = bh % 6;
        __syncthreads();
        if (tid < 256) { const bf16* row = H + ((size_t)b * SEQ + qb * 256 + tid) * HCOLS + h * 64; float sq = 0.f, sk = 0.f;
#pragma unroll
            for (int j = 0; j < 8; ++j) { const u32x4 qv = *(const u32x4*)(row + HC_CQ + 8 * j), kv = *(const u32x4*)(row + HC_CK + 8 * j);
#pragma unroll
                for (int i = 0; i < 4; ++i) { const float a0 = bf2f(qv[i] & 0xffffu), a1 = __uint_as_float(qv[i] & 0xffff0000u), b0 = bf2f(kv[i] & 0xffffu), b1 = __uint_as_float(kv[i] & 0xffff0000u);
                    sq += a0 * a0 + a1 * a1; sk += b0 * b0 + b1 * b1; } }
            qns[tid] = sqrtf(sq); kns[tid] = sqrtf(sk); }
        __syncthreads();
        if (wave < 5) { float v = wave < 4 ? kns[wave * 64 + lane] : fmaxf(fmaxf(qns[lane], qns[64 + lane]), fmaxf(qns[128 + lane], qns[192 + lane]));
#pragma unroll
            for (int o = 1; o < 64; o <<= 1) v = fmaxf(v, __shfl_xor(v, o));
            if (lane == 0) { if (wave < 4) KT[bh * 64 + 4 * qb + wave] = v; else QBM[bh * 16 + qb] = v; } }
    }
}

typedef short bf16x8_t __attribute__((ext_vector_type(8)));
typedef float f32x16_t __attribute__((ext_vector_type(16)));
__device__ __forceinline__ int crow32(int r, int hi) { return (r & 3) + 8 * (r >> 2) + 4 * hi; }
struct GlaB1Pre { u32x4 vv, lr0, lr1; u32x2 kk; float w2v, b2v; };
__device__ __forceinline__ GlaB1Pre gla_b1_load(const Params& p, int l, int it, int tid, int lane, int wave) {
    const int bh = it >> 6, n = it & 63, b = bh / 6, h = bh % 6; const size_t tok0 = (size_t)b * SEQ + n * 64; const bf16* H = (const bf16*)(p.ws + WS_H);
    GlaB1Pre r; r.w2v = p.gla_gate_w[(size_t)l * 16 * 192 + (tid >> 5) * 192 + h * 32 + (tid & 31)]; r.b2v = p.gla_gate_b[l * 192 + h * 32 + (tid & 31)];
    r.vv = *(const u32x4*)(H + (tok0 + (tid >> 3)) * HCOLS + HC_BV + h * 64 + (tid & 7) * 8);
    r.lr0 = *(const u32x4*)(H + (tok0 + lane) * HCOLS + HC_LR); r.lr1 = *(const u32x4*)(H + (tok0 + lane) * HCOLS + HC_LR + 8);
    r.kk = *(const u32x2*)(H + (tok0 + lane) * HCOLS + HC_BK + h * 32 + wave * 4);
    return r;
}
__device__ __forceinline__ void phase_gla_b1(const Params& p, int l, unsigned char* lds) {
    const int tid = tid_l(), lane = tid & 63, wave = tid >> 6, r32 = lane & 31, hi = lane >> 5;
    bf16* KDT = (bf16*)lds;
    bf16* VT = KDT + 32 * 72;
    float* w2s = (float*)(VT + 64 * 72);
    float* b2s = w2s + 16 * 32;
    float* GCUM = (float*)(p.ws + WS_GCUM); float* GS = (float*)(p.ws + WS_GS); float* GDEC = (float*)(p.ws + WS_GDEC);
    const int NI = 48 * 64, G = grid_l(); int it = bid_l();
    if (it >= NI) return;
    GlaB1Pre cur = gla_b1_load(p, l, it, tid, lane, wave);
#pragma unroll 1
    for (; it < NI; it += G) {
        const GlaB1Pre nxt = gla_b1_load(p, l, it + G < NI ? it + G : it, tid, lane, wave);
        __builtin_amdgcn_sched_barrier(0);
        const int bh = it >> 6, n = it & 63, b = bh / 6, h = bh % 6; const size_t tok0 = (size_t)b * SEQ + n * 64;
        __syncthreads();
        w2s[tid] = cur.w2v;
        if (tid < 32) b2s[tid] = cur.b2v;
        { const int s_ = tid >> 3, e0 = (tid & 7) * 8;
#pragma unroll
          for (int i = 0; i < 4; ++i) { VT[(e0 + 2 * i) * 72 + s_] = (bf16)(cur.vv[i] & 0xffffu); VT[(e0 + 2 * i + 1) * 72 + s_] = (bf16)(cur.vv[i] >> 16); } }
        const int d0 = wave * 4;
        __syncthreads();
        float lrf[16];
#pragma unroll
        for (int i = 0; i < 4; ++i) { lrf[2 * i] = bf2f(cur.lr0[i] & 0xffffu); lrf[2 * i + 1] = __uint_as_float(cur.lr0[i] & 0xffff0000u); lrf[8 + 2 * i] = bf2f(cur.lr1[i] & 0xffffu); lrf[8 + 2 * i + 1] = __uint_as_float(cur.lr1[i] & 0xffff0000u); }
        float g[4];
#pragma unroll
        for (int dd = 0; dd < 4; ++dd) { float x = b2s[d0 + dd];
#pragma unroll
            for (int r = 0; r < 16; ++r) x += lrf[r] * w2s[r * 32 + d0 + dd];
            g[dd] = log_sigmoid(x) * (1.0f / 16.0f); }
#pragma unroll
        for (int o = 1; o < 64; o <<= 1)
#pragma unroll
            for (int dd = 0; dd < 4; ++dd) { const float v = __shfl_up(g[dd], o); if (lane >= o) g[dd] += v; }
        *(f32x4*)(GCUM + (tok0 + lane) * 192 + h * 32 + d0) = (f32x4){g[0], g[1], g[2], g[3]};
        const float kf[4] = {bf2f(cur.kk.x & 0xffffu), __uint_as_float(cur.kk.x & 0xffff0000u), bf2f(cur.kk.y & 0xffffu), __uint_as_float(cur.kk.y & 0xffff0000u)};
#pragma unroll
        for (int dd = 0; dd < 4; ++dd) { const float last = __uint_as_float(__builtin_amdgcn_readlane(__float_as_uint(g[dd]), 63));
            KDT[(d0 + dd) * 72 + lane] = (bf16)f2bf(kf[dd] * __expf(last - g[dd]));
            if (lane == 63) GDEC[(size_t)it * 32 + d0 + dd] = __expf(last); }
        __syncthreads();
        if (wave < 2) {
            f32x16_t acc = {};
#pragma unroll
            for (int ks = 0; ks < 4; ++ks) { const bf16x8_t a = *(const bf16x8_t*)(KDT + r32 * 72 + 16 * ks + 8 * hi), bb = *(const bf16x8_t*)(VT + (32 * wave + r32) * 72 + 16 * ks + 8 * hi);
                acc = __builtin_amdgcn_mfma_f32_32x32x16_bf16(a, bb, acc, 0, 0, 0); }
#pragma unroll
            for (int r = 0; r < 16; ++r) GS[(size_t)it * 2048 + crow32(r, hi) * 64 + 32 * wave + r32] = acc[r];
        }
        cur = nxt;
    }
}
__device__ __forceinline__ void phase_gla_b2(const Params& p) {
    float* GS = (float*)(p.ws + WS_GS); const float* GDEC = (const float*)(p.ws + WS_GDEC);
    for (int g = bid_l() * 512 + tid_l(); g < 48 * 2048; g += grid_l() * 512) {
        const int bh = g >> 11, de = g & 2047, d = de >> 6; float S = 0.f;
        float* gs = GS + (size_t)bh * 64 * 2048 + de; const float* gd = GDEC + (size_t)bh * 64 * 32 + d;
#pragma unroll 1
        for (int n0 = 0; n0 < 64; n0 += 16) { float loc[16], dec[16];
#pragma unroll
            for (int i = 0; i < 16; ++i) { loc[i] = gs[(size_t)(n0 + i) * 2048]; dec[i] = gd[(n0 + i) * 32]; }
#pragma unroll
            for (int i = 0; i < 16; ++i) { gs[(size_t)(n0 + i) * 2048] = S; S = S * dec[i] + loc[i]; } }
    }
}
struct GlaB3Pre { u32x2 qq, kk; f32x4 c; u32x4 vv; f32x4 sv; u32x4 gr; };
__device__ __forceinline__ GlaB3Pre gla_b3_load(const Params& p, int it, int tid) {
    const int bh = it >> 6, n = it & 63, b = bh / 6, h = bh % 6; const size_t tok0 = (size_t)b * SEQ + n * 64; const bf16* H = (const bf16*)(p.ws + WS_H);
    const float* GCUM = (const float*)(p.ws + WS_GCUM); const float* GS = (const float*)(p.ws + WS_GS);
    GlaB3Pre r; const int t = tid >> 3, d0 = (tid & 7) * 4;
    r.qq = *(const u32x2*)(H + (tok0 + t) * HCOLS + HC_BQ + h * 32 + d0); r.kk = *(const u32x2*)(H + (tok0 + t) * HCOLS + HC_BK + h * 32 + d0);
    r.c = *(const f32x4*)(GCUM + (tok0 + t) * 192 + h * 32 + d0);
    r.vv = *(const u32x4*)(H + (tok0 + t) * HCOLS + HC_BV + h * 64 + (tid & 7) * 8);
    r.sv = *(const f32x4*)(GS + (size_t)it * 2048 + (tid >> 4) * 64 + (tid & 15) * 4);
    r.gr = *(const u32x4*)(H + (tok0 + t) * HCOLS + HC_BG + h * 64 + (tid & 7) * 8);
    return r;
}
__device__ __forceinline__ void phase_gla_b3(const Params& p, int l, unsigned char* lds) {
    const int tid = tid_l(), lane = tid & 63, wave = tid >> 6, r32 = lane & 31, hi = lane >> 5;
    bf16* QE = (bf16*)lds;
    bf16* KE = QE + 64 * 40;
    bf16* VT = KE + 64 * 40;
    bf16* ST = VT + 64 * 72;
    bf16* P = ST + 64 * 40;
    float* O = (float*)(P + 64 * 72);
    bf16* MIX = (bf16*)(p.ws + WS_MIX);
    const int NI = 48 * 64, G = grid_l(); int it = bid_l();
    if (it >= NI) return;
    GlaB3Pre cur = gla_b3_load(p, it, tid);
#pragma unroll 1
    for (; it < NI; it += G) {
        const GlaB3Pre nxt = gla_b3_load(p, it + G < NI ? it + G : it, tid);
        __builtin_amdgcn_sched_barrier(0);
        const int bh = it >> 6, n = it & 63, b = bh / 6, h = bh % 6; const size_t tok0 = (size_t)b * SEQ + n * 64;
        __syncthreads();
        { const int t = tid >> 3, d0 = (tid & 7) * 4; const u32x2 qq = cur.qq, kk = cur.kk; const f32x4 c = cur.c;
          const float e0 = __expf(c[0]), e1 = __expf(c[1]), e2 = __expf(c[2]), e3 = __expf(c[3]);
          u32x2 qo, ko;
          qo.x = pk2(bf2f(qq.x & 0xffffu) * e0, __uint_as_float(qq.x & 0xffff0000u) * e1); qo.y = pk2(bf2f(qq.y & 0xffffu) * e2, __uint_as_float(qq.y & 0xffff0000u) * e3);
          ko.x = pk2(bf2f(kk.x & 0xffffu) / e0, __uint_as_float(kk.x & 0xffff0000u) / e1); ko.y = pk2(bf2f(kk.y & 0xffffu) / e2, __uint_as_float(kk.y & 0xffff0000u) / e3);
          *(u32x2*)(QE + t * 40 + d0) = qo; *(u32x2*)(KE + t * 40 + d0) = ko; }
        { const int s_ = tid >> 3, e0 = (tid & 7) * 8;
#pragma unroll
          for (int i = 0; i < 4; ++i) { VT[(e0 + 2 * i) * 72 + s_] = (bf16)(cur.vv[i] & 0xffffu); VT[(e0 + 2 * i + 1) * 72 + s_] = (bf16)(cur.vv[i] >> 16); } }
        { const int d = tid >> 4, e0 = (tid & 15) * 4;
#pragma unroll
          for (int i = 0; i < 4; ++i) ST[(e0 + i) * 40 + d] = (bf16)f2bf(cur.sv[i]); }
        __syncthreads();
        f32x16_t acc = {};
        const int tt = (wave & 3) >> 1, tc = wave & 1;
        if (wave < 4) {
            if (!(tt == 0 && tc == 1)) {
#pragma unroll
                for (int ks = 0; ks < 2; ++ks) { const bf16x8_t a = *(const bf16x8_t*)(QE + (32 * tt + r32) * 40 + 16 * ks + 8 * hi), bb = *(const bf16x8_t*)(KE + (32 * tc + r32) * 40 + 16 * ks + 8 * hi);
                    acc = __builtin_amdgcn_mfma_f32_32x32x16_bf16(a, bb, acc, 0, 0, 0); }
#pragma unroll
                for (int r = 0; r < 16; ++r) { const int trow = 32 * tt + crow32(r, hi), scol = 32 * tc + r32; P[trow * 72 + scol] = (bf16)f2bf(scol <= trow ? acc[r] : 0.f); }
            }
        } else {
#pragma unroll
            for (int ks = 0; ks < 2; ++ks) { const bf16x8_t a = *(const bf16x8_t*)(QE + (32 * tt + r32) * 40 + 16 * ks + 8 * hi), bb = *(const bf16x8_t*)(ST + (32 * tc + r32) * 40 + 16 * ks + 8 * hi);
                acc = __builtin_amdgcn_mfma_f32_32x32x16_bf16(a, bb, acc, 0, 0, 0); }
        }
        __syncthreads();
        if (wave >= 4) {
            const int nks = tt == 0 ? 2 : 4;
            for (int ks = 0; ks < nks; ++ks) { const bf16x8_t a = *(const bf16x8_t*)(P + (32 * tt + r32) * 72 + 16 * ks + 8 * hi), bb = *(const bf16x8_t*)(VT + (32 * tc + r32) * 72 + 16 * ks + 8 * hi);
                acc = __builtin_amdgcn_mfma_f32_32x32x16_bf16(a, bb, acc, 0, 0, 0); }
#pragma unroll
            for (int r = 0; r < 16; ++r) O[(32 * tt + crow32(r, hi)) * 65 + 32 * tc + r32] = acc[r];
        }
        __syncthreads();
        { const int t = tid >> 3, e0 = (tid & 7) * 8; float o[8]; float ss = 0.f;
#pragma unroll
          for (int i = 0; i < 8; ++i) { o[i] = O[t * 65 + e0 + i]; ss += o[i] * o[i]; }
          ss += __shfl_xor(ss, 1); ss += __shfl_xor(ss, 2); ss += __shfl_xor(ss, 4);
          const float rs = 1.0f / sqrtf(ss * (1.f / 64.f) + LN_EPS);
          const float* ng = p.gla_norm_g + l * 384 + h * 64 + e0; const u32x4 gr = cur.gr;
          float r[8];
#pragma unroll
          for (int i = 0; i < 4; ++i) { const float ga = bf2f(gr[i] & 0xffffu), gb = __uint_as_float(gr[i] & 0xffff0000u);
              r[2 * i] = o[2 * i] * rs * ng[2 * i] * (ga * sigmoidf_(ga)); r[2 * i + 1] = o[2 * i + 1] * rs * ng[2 * i + 1] * (gb * sigmoidf_(gb)); }
          u32x4 w; w.x = pk2(r[0], r[1]); w.y = pk2(r[2], r[3]); w.z = pk2(r[4], r[5]); w.w = pk2(r[6], r[7]);
          *(u32x4*)(MIX + (tok0 + t) * D + MC_B + h * 64 + e0) = w; }
        cur = nxt;
    }
}

constexpr int LDSQ_OFF = LDS_BYTES - 1024;
constexpr int CW_ATTNQ = 8192;
__device__ __forceinline__ void phase_fox_mfma(const Params& p, int l, unsigned char* lds) {
    const attn_body::bf16* H = (const attn_body::bf16*)(p.ws + WS_H);
    const attn_body::AttnTensors AT{H + HC_CQ, H + HC_CK, H + HC_CV, (attn_body::bf16*)(p.ws + WS_MIX) + MC_C, (const float*)(p.ws + WS_CK), (const float*)(p.ws + WS_FKT), (const float*)(p.ws + WS_FQB)};
    const attn_body::QueueOrder S{(unsigned*)(p.ws + WS_CTL) + CW_ATTNQ + l * 64, (volatile __attribute__((address_space(3))) int*)((__attribute__((address_space(3))) unsigned char*)lds + LDSQ_OFF)};
    attn_body::attn_phase<attn_body::QueueOrder>((char*)lds, AT, S);
}

__device__ __forceinline__ void phase_ln(const _Float16* Y, const float* g, const float* bta, float* dst, bf16* dstb, unsigned char* xq = nullptr, float* xs = nullptr) {
    const int tid = tid_l(), lane = tid & 63, wave = tid >> 6; typedef _Float16 h4 __attribute__((ext_vector_type(4)));
    const int stride = grid_l() * 8; int row = bid_l() * 8 + wave;
    if (row >= T) return;
    h4 cur[4];
#pragma unroll
    for (int j = 0; j < 4; ++j) cur[j] = *(const h4*)(Y + (size_t)row * D + j * 256 + lane * 4);
#pragma unroll 1
    for (; row < T; row += stride) {
        h4 nxt[4]; const int nr = row + stride < T ? row + stride : row;
#pragma unroll
        for (int j = 0; j < 4; ++j) nxt[j] = *(const h4*)(Y + (size_t)nr * D + j * 256 + lane * 4);
        __builtin_amdgcn_sched_barrier(0);
        f32x4 v[4]; float s = 0.f;
#pragma unroll
        for (int j = 0; j < 4; ++j) { v[j] = (f32x4){(float)cur[j][0], (float)cur[j][1], (float)cur[j][2], (float)cur[j][3]}; s += (v[j][0] + v[j][1]) + (v[j][2] + v[j][3]); }
        const float mean = wave_sum(s) * (1.f / D); float s2 = 0.f;
#pragma unroll
        for (int j = 0; j < 4; ++j) { v[j] = v[j] - mean; s2 += (v[j][0] * v[j][0] + v[j][1] * v[j][1]) + (v[j][2] * v[j][2] + v[j][3] * v[j][3]); }
        const float rstd = 1.0f / sqrtf(wave_sum(s2) * (1.f / D) + LN_EPS);
        float am = 0.f;
#pragma unroll
        for (int j = 0; j < 4; ++j) { const f32x4 g4 = *(const f32x4*)(g + j * 256 + lane * 4), b4 = *(const f32x4*)(bta + j * 256 + lane * 4);
            const f32x4 o = v[j] * rstd * g4 + b4; v[j] = o;
            am = fmaxf(am, fmaxf(fmaxf(fabsf(o[0]), fabsf(o[1])), fmaxf(fabsf(o[2]), fabsf(o[3]))));
            if (dst) *(f32x4*)(dst + (size_t)row * D + j * 256 + lane * 4) = o;
            if (dstb) { u32x2 w; w.x = pk2(o[0], o[1]); w.y = pk2(o[2], o[3]); *(u32x2*)(dstb + (size_t)row * D + j * 256 + lane * 4) = w; } }
        if (xq) {
            am = wave_max(am); const float sc = am > 0.f ? 119.0f / am : 0.f;
#pragma unroll
            for (int j = 0; j < 4; ++j) { unsigned hh = 0u, ll = 0u;
#pragma unroll
                for (int i = 0; i < 4; ++i) { const int q8 = (int)__builtin_rintf(v[j][i] * sc), qh = (q8 + 8) >> 4, ql = q8 - (qh << 4); hh |= ((unsigned)qh & 15u) << (4 * i); ll |= ((unsigned)ql & 15u) << (4 * i); }
                *(unsigned short*)(xq + (size_t)row * D + j * 128 + lane * 2) = (unsigned short)hh; *(unsigned short*)(xq + (size_t)row * D + 512 + j * 128 + lane * 2) = (unsigned short)ll; }
            if (lane == 0) xs[row] = am * (1.0f / 119.0f); }
#pragma unroll
        for (int j = 0; j < 4; ++j) cur[j] = nxt[j];
    }
}

__device__ __forceinline__ int f2ord(float x) { const int i = __float_as_int(x); return i ^ ((i >> 31) & 0x7fffffff); }
__device__ __forceinline__ float ord2f(int k) { return __int_as_float(k ^ ((k >> 31) & 0x7fffffff)); }
__device__ __forceinline__ void phase_topk(const Params& p, unsigned char* lds) {
    const int tid = tid_l(), lane = tid & 63, wave = tid >> 6;
    unsigned char* wreg = lds + wave * 17408; unsigned char* tab = wreg;
    const _Float16* SC = (const _Float16*)(p.ws + WS_SC); int* EIDX = (int*)(p.ws + WS_EIDX); float* GATE = (float*)(p.ws + WS_GATE); unsigned long long* SOFF = (unsigned long long*)(p.ws + WS_SOFF);
    for (int g = bid_l() * 512 + tid; g < T * 16; g += grid_l() * 512) {
        const int tok = g >> 4, hc = g & 15;
        typedef _Float16 h8 __attribute__((ext_vector_type(8)));
        { const unsigned char* blk = (const unsigned char*)(SC + (size_t)(g - lane) * 128);
          u32x4 st[16];
#pragma unroll
          for (int j = 0; j < 16; ++j) st[j] = *(const u32x4*)(blk + (size_t)(j * 64 + lane) * 16);
          __builtin_amdgcn_wave_barrier();
#pragma unroll
          for (int j = 0; j < 16; ++j) { const int c = j * 64 + lane; *(u32x4*)(wreg + (c + (c >> 4)) * 16) = st[j]; }
          __builtin_amdgcn_wave_barrier(); }
        const unsigned char* lp = wreg + lane * 272;
#define TK_CE(a, b) do { const int hi_ = max(a, b), lo_ = min(a, b); a = hi_; b = lo_; } while (0)
        int tk[16];
#pragma unroll 1
        for (int gi = 0; gi < 8; ++gi) { const h8 cA = *(const h8*)(lp + gi * 32), c1_ = *(const h8*)(lp + gi * 32 + 16);
            int v[16];
#pragma unroll
            for (int j = 0; j < 8; ++j) { v[j] = (f2ord((float)cA[j]) & ~127) | (127 - (gi * 16 + j)); v[8 + j] = (f2ord((float)c1_[j]) & ~127) | (127 - (gi * 16 + 8 + j)); }
            TK_CE(v[0], v[1]); TK_CE(v[3], v[2]); TK_CE(v[4], v[5]); TK_CE(v[7], v[6]); TK_CE(v[8], v[9]); TK_CE(v[11], v[10]); TK_CE(v[12], v[13]); TK_CE(v[15], v[14]); TK_CE(v[0], v[2]); TK_CE(v[1], v[3]); TK_CE(v[6], v[4]); TK_CE(v[7], v[5]); TK_CE(v[8], v[10]); TK_CE(v[9], v[11]); TK_CE(v[14], v[12]); TK_CE(v[15], v[13]); TK_CE(v[0], v[1]); TK_CE(v[2], v[3]); TK_CE(v[5], v[4]); TK_CE(v[7], v[6]); TK_CE(v[8], v[9]); TK_CE(v[10], v[11]); TK_CE(v[13], v[12]); TK_CE(v[15], v[14]); TK_CE(v[0], v[4]); TK_CE(v[1], v[5]); TK_CE(v[2], v[6]); TK_CE(v[3], v[7]); TK_CE(v[12], v[8]); TK_CE(v[13], v[9]); TK_CE(v[14], v[10]); TK_CE(v[15], v[11]); TK_CE(v[0], v[2]); TK_CE(v[1], v[3]); TK_CE(v[4], v[6]); TK_CE(v[5], v[7]); TK_CE(v[10], v[8]); TK_CE(v[11], v[9]); TK_CE(v[14], v[12]); TK_CE(v[15], v[13]); TK_CE(v[0], v[1]); TK_CE(v[2], v[3]); TK_CE(v[4], v[5]); TK_CE(v[6], v[7]); TK_CE(v[9], v[8]); TK_CE(v[11], v[10]); TK_CE(v[13], v[12]); TK_CE(v[15], v[14]); TK_CE(v[0], v[8]); TK_CE(v[1], v[9]); TK_CE(v[2], v[10]); TK_CE(v[3], v[11]); TK_CE(v[4], v[12]); TK_CE(v[5], v[13]); TK_CE(v[6], v[14]); TK_CE(v[7], v[15]); TK_CE(v[0], v[4]); TK_CE(v[1], v[5]); TK_CE(v[2], v[6]); TK_CE(v[3], v[7]); TK_CE(v[8], v[12]); TK_CE(v[9], v[13]); TK_CE(v[10], v[14]); TK_CE(v[11], v[15]); TK_CE(v[0], v[2]); TK_CE(v[1], v[3]); TK_CE(v[4], v[6]); TK_CE(v[5], v[7]); TK_CE(v[8], v[10]); TK_CE(v[9], v[11]); TK_CE(v[12], v[14]); TK_CE(v[13], v[15]); TK_CE(v[0], v[1]); TK_CE(v[2], v[3]); TK_CE(v[4], v[5]); TK_CE(v[6], v[7]); TK_CE(v[8], v[9]); TK_CE(v[10], v[11]); TK_CE(v[12], v[13]); TK_CE(v[14], v[15]);
            if (gi == 0) {
#pragma unroll
                for (int j = 0; j < 16; ++j) tk[j] = v[j]; }
            else {
#pragma unroll
                for (int j = 0; j < 16; ++j) tk[j] = max(tk[j], v[15 - j]);
                TK_CE(tk[0], tk[8]); TK_CE(tk[1], tk[9]); TK_CE(tk[2], tk[10]); TK_CE(tk[3], tk[11]); TK_CE(tk[4], tk[12]); TK_CE(tk[5], tk[13]); TK_CE(tk[6], tk[14]); TK_CE(tk[7], tk[15]); TK_CE(tk[0], tk[4]); TK_CE(tk[1], tk[5]); TK_CE(tk[2], tk[6]); TK_CE(tk[3], tk[7]); TK_CE(tk[8], tk[12]); TK_CE(tk[9], tk[13]); TK_CE(tk[10], tk[14]); TK_CE(tk[11], tk[15]); TK_CE(tk[0], tk[2]); TK_CE(tk[1], tk[3]); TK_CE(tk[4], tk[6]); TK_CE(tk[5], tk[7]); TK_CE(tk[8], tk[10]); TK_CE(tk[9], tk[11]); TK_CE(tk[12], tk[14]); TK_CE(tk[13], tk[15]); TK_CE(tk[0], tk[1]); TK_CE(tk[2], tk[3]); TK_CE(tk[4], tk[5]); TK_CE(tk[6], tk[7]); TK_CE(tk[8], tk[9]); TK_CE(tk[10], tk[11]); TK_CE(tk[12], tk[13]); TK_CE(tk[14], tk[15]); }
            }
        __builtin_amdgcn_wave_barrier();
#undef TK_CE
        float av[16], bv[16]; int ai[16], bi[16]; const bool c1 = (hc & 1) != 0;
#pragma unroll
        for (int j = 0; j < 16; ++j) { const int ok = __shfl_xor(tk[j], 1); const int ka = c1 ? ok : tk[j], kb = c1 ? tk[j] : ok;
            av[j] = ord2f(ka & ~127); ai[j] = 127 - (ka & 127); bv[j] = ord2f(kb & ~127); bi[j] = 127 - (kb & 127); }
#pragma unroll
        for (int j = 0; j < 16; ++j) { tab[j * 64 + lane] = (unsigned char)ai[j]; tab[(16 + j) * 64 + lane] = (unsigned char)bi[j]; }
        int ck[16];
#pragma unroll
        for (int j = 0; j < 16; ++j) ck[j] = (int)0x80000000;
#pragma unroll
        for (int i = 0; i < 16; ++i)
#pragma unroll
            for (int j = 0; j < 16 / (i + 1); ++j) { int x = (f2ord(av[i] + bv[j]) & ~255) | (255 - (i * 16 + j));
#pragma unroll
                for (int q = 0; q < 16; ++q) { const int hi = max(ck[q], x); x = min(ck[q], x); ck[q] = hi; } }
        float den = 0.f; float ex[16]; const float c0 = ord2f(ck[0] & ~255);
#pragma unroll
        for (int j = 0; j < 16; ++j) { ex[j] = __expf(ord2f(ck[j] & ~255) - c0); den += ex[j]; }
        const float inv = 1.0f / den;
        if (!c1) { int* ep = EIDX + (size_t)tok * 128 + (hc >> 1) * 16; float* gp = GATE + (size_t)tok * 128 + (hc >> 1) * 16;
#pragma unroll
            for (int q = 0; q < 4; ++q) { u32x4 ev; f32x4 gv;
#pragma unroll
                for (int j = 0; j < 4; ++j) { const int flat = 255 - (ck[4 * q + j] & 255); ev[j] = (unsigned)((int)tab[(flat >> 4) * 64 + lane] * 128 + (int)tab[(16 + (flat & 15)) * 64 + lane]); gv[j] = ex[4 * q + j] * inv; }
                *(u32x4*)(ep + 4 * q) = ev; *(f32x4*)(gp + 4 * q) = gv; } }
    }
}

__device__ __forceinline__ float gelu_tanh(float h) { const float z = 0.7978845608028654f * (h + 0.044715f * h * h * h); const float t = 1.0f - 2.0f / (__expf(2.0f * z) + 1.0f); return 0.5f * h * (1.0f + t); }
struct PeerUMeta { int e_lo, e_hi; float g_lo, g_hi, xs; u32x4 xh0, xh1, xl0, xl1; };
__device__ __forceinline__ PeerUMeta peer_umeta_load(const unsigned char* XQ, const float* XS, const int* EIDX, const float* GATE, int tok, int lane) {
    PeerUMeta m; const unsigned char* xr = XQ + (size_t)tok * D + (lane & 15) * 16;
    m.e_lo = EIDX[(size_t)tok * 128 + lane]; m.e_hi = EIDX[(size_t)tok * 128 + 64 + lane]; m.g_lo = GATE[(size_t)tok * 128 + lane]; m.g_hi = GATE[(size_t)tok * 128 + 64 + lane]; m.xs = XS[tok];
    m.xh0 = *(const u32x4*)(xr); m.xh1 = *(const u32x4*)(xr + 256); m.xl0 = *(const u32x4*)(xr + 512); m.xl1 = *(const u32x4*)(xr + 768);
    return m;
}
template <int CTRL> __device__ __forceinline__ int dpp_movi(int v) { return __builtin_amdgcn_update_dpp(0, v, CTRL, 0xf, 0xf, false); }
__device__ __forceinline__ float gelu_tanh_fast(float h) { const float z = 0.7978845608028654f * (h + 0.044715f * h * h * h); const float t = 1.0f - 2.0f * __builtin_amdgcn_rcpf(__expf(2.0f * z) + 1.0f); return 0.5f * h * (1.0f + t); }
#define PU_IDS(I, E, kk) do { _Pragma("unroll") for (int a_ = 0; a_ < 4; ++a_) I[a_] = __builtin_amdgcn_ds_bpermute((g4 << 2) + (((kk) + 4 * a_) << 2), (E)); } while (0)
#define PU_LOAD(R, I) do { _Pragma("unroll") for (int a_ = 0; a_ < 4; ++a_) { const unsigned char* p_ = U4l + (size_t)I[a_] * 512; R[2 * a_] = *(const u32x4*)(p_); R[2 * a_ + 1] = *(const u32x4*)(p_ + 256); } \
        __builtin_amdgcn_sched_barrier(0); } while (0)
#define PU_COMP(R, M) do { int t_[4]; \
        _Pragma("unroll") for (int a_ = 0; a_ < 4; ++a_) { int h_ = 0, l_ = 0; \
            _Pragma("unroll") for (int w_ = 0; w_ < 4; ++w_) { h_ = __builtin_amdgcn_sdot8((int)R[2 * a_][w_], (int)cur.xh0[w_], h_, false); l_ = __builtin_amdgcn_sdot8((int)R[2 * a_][w_], (int)cur.xl0[w_], l_, false); \
                                                               h_ = __builtin_amdgcn_sdot8((int)R[2 * a_ + 1][w_], (int)cur.xh1[w_], h_, false); l_ = __builtin_amdgcn_sdot8((int)R[2 * a_ + 1][w_], (int)cur.xl1[w_], l_, false); } \
            int s_ = 16 * h_ + l_; s_ += dpp_movi<0x128>(s_); s_ += dpp_movi<0x124>(s_); s_ += dpp_movi<0x122>(s_); s_ += dpp_movi<0x121>(s_); t_[a_] = s_; } \
        M = (l16 & 2) ? ((l16 & 1) ? t_[3] : t_[2]) : ((l16 & 1) ? t_[1] : t_[0]); __builtin_amdgcn_sched_barrier(0); } while (0)
__device__ __forceinline__ void phase_peer_u(const Params& p, unsigned char* lds) {
    const int tid = tid_l(), lane = tid & 63, wave = tid >> 6, l16 = lane & 15, g4 = lane >> 4;
    const unsigned char* XQ = p.ws + WS_XQ; const float* XS = (const float*)(p.ws + WS_XS); const float* RS = (const float*)(p.ws + WS_RS); const float* VS = (const float*)(p.ws + WS_VS);
    const unsigned char* U4l = p.ws + WS_U + l16 * 16;
    const int* EIDX = (const int*)(p.ws + WS_EIDX); float* GATE = (float*)(p.ws + WS_GATE);
    const int stride = grid_l() * 8; int tok = __builtin_amdgcn_readfirstlane(bid_l() * 8 + wave);
    if (tok >= T) return;
    PeerUMeta cur = peer_umeta_load(XQ, XS, EIDX, GATE, tok, lane);
    u32x4 Ra[8], Rb[8]; int Ia[4], Ib[4];
    PU_IDS(Ia, cur.e_lo, 0); PU_LOAD(Ra, Ia); PU_IDS(Ib, cur.e_lo, 16);
    const int qd = ((((lane & 3) << 4) + ((lane >> 2) & 3)) << 2);
#pragma unroll 1
    for (; tok < T; tok += stride) {
        const PeerUMeta nxt = peer_umeta_load(XQ, XS, EIDX, GATE, tok + stride < T ? tok + stride : tok, lane);
        const float rs_lo = RS[cur.e_lo], rs_hi = RS[cur.e_hi], vs_lo = VS[cur.e_lo], vs_hi = VS[cur.e_hi];
        __builtin_amdgcn_sched_barrier(0);
        int m0, m1, m2, m3, m4, m5, m6, m7;
        PU_LOAD(Rb, Ib); PU_IDS(Ia, cur.e_lo, 32); PU_COMP(Ra, m0);
        PU_LOAD(Ra, Ia); PU_IDS(Ib, cur.e_lo, 48); PU_COMP(Rb, m1);
        PU_LOAD(Rb, Ib); PU_IDS(Ia, cur.e_hi, 0);  PU_COMP(Ra, m2);
        PU_LOAD(Ra, Ia); PU_IDS(Ib, cur.e_hi, 16); PU_COMP(Rb, m3);
        PU_LOAD(Rb, Ib); PU_IDS(Ia, cur.e_hi, 32); PU_COMP(Ra, m4);
        PU_LOAD(Ra, Ia); PU_IDS(Ib, cur.e_hi, 48); PU_COMP(Rb, m5);
        PU_LOAD(Rb, Ib); PU_IDS(Ia, nxt.e_lo, 0);  PU_COMP(Ra, m6);
        PU_LOAD(Ra, Ia); PU_IDS(Ib, nxt.e_lo, 16); PU_COMP(Rb, m7);
        const int d0 = __builtin_amdgcn_ds_bpermute(qd, m0), d1 = __builtin_amdgcn_ds_bpermute(qd, m1), d2 = __builtin_amdgcn_ds_bpermute(qd, m2), d3 = __builtin_amdgcn_ds_bpermute(qd, m3);
        const int d4 = __builtin_amdgcn_ds_bpermute(qd, m4), d5 = __builtin_amdgcn_ds_bpermute(qd, m5), d6 = __builtin_amdgcn_ds_bpermute(qd, m6), d7 = __builtin_amdgcn_ds_bpermute(qd, m7);
        const float c_lo = (float)((lane & 32) ? ((lane & 16) ? d3 : d2) : ((lane & 16) ? d1 : d0)), c_hi = (float)((lane & 32) ? ((lane & 16) ? d7 : d6) : ((lane & 16) ? d5 : d4));
        GATE[(size_t)tok * 128 + lane] = cur.g_lo * gelu_tanh_fast(c_lo * (rs_lo * cur.xs)) * vs_lo;
        GATE[(size_t)tok * 128 + 64 + lane] = cur.g_hi * gelu_tanh_fast(c_hi * (rs_hi * cur.xs)) * vs_hi;
        cur = nxt;
    }
}
#undef PU_IDS
#undef PU_LOAD
#undef PU_COMP
struct PeerVMeta { int e_lo, e_hi; float c_lo, c_hi; u32x4 x0, x1; };
__device__ __forceinline__ PeerVMeta peer_vmeta_load(const int* EIDX, const float* COEF, const bf16* XB, int tok, int lane) {
    PeerVMeta m;
    m.e_lo = EIDX[(size_t)tok * 128 + lane]; m.e_hi = EIDX[(size_t)tok * 128 + 64 + lane]; m.c_lo = COEF[(size_t)tok * 128 + lane]; m.c_hi = COEF[(size_t)tok * 128 + 64 + lane];
    const int xo = (lane & 31) * 32 + (lane >> 5) * 16;
    m.x0 = *(const u32x4*)(XB + (size_t)tok * D + xo); m.x1 = *(const u32x4*)(XB + (size_t)tok * D + xo + 8);
    return m;
}
#define PV_ISSUE(VR, CF, PE, PC, jj) do { _Pragma("unroll") for (int q = 0; q < 8; ++q) { const int a_ = hb + (((jj) + q) << 2); const int e_ = __builtin_amdgcn_ds_bpermute(a_, (int)(PE)); \
        CF[q] = __int_as_float(__builtin_amdgcn_ds_bpermute(a_, (int)(PC))); VR[q] = *(const u32x4*)(V4l + (size_t)e_ * 512); } __builtin_amdgcn_sched_barrier(0); } while (0)
#define PV_COMPUTE(VR, CF) do { _Pragma("unroll") for (int q = 0; q < 8; ++q) { const f32x2v c2 = (f32x2v){CF[q], CF[q]}; \
        _Pragma("unroll") for (int w = 0; w < 4; ++w) { \
            acc[4 * w] += __builtin_amdgcn_cvt_scalef32_pk_f32_fp4(VR[q][w], 1.0f, 0) * c2; acc[4 * w + 1] += __builtin_amdgcn_cvt_scalef32_pk_f32_fp4(VR[q][w], 1.0f, 1) * c2; \
            acc[4 * w + 2] += __builtin_amdgcn_cvt_scalef32_pk_f32_fp4(VR[q][w], 1.0f, 2) * c2; acc[4 * w + 3] += __builtin_amdgcn_cvt_scalef32_pk_f32_fp4(VR[q][w], 1.0f, 3) * c2; } } \
        __builtin_amdgcn_sched_barrier(0); } while (0)
__device__ __forceinline__ void phase_peer_v(const Params& p) {
    const int tid = tid_l(), lane = tid & 63, wave = tid >> 6;
    const unsigned char* V4l = p.ws + WS_V + (lane & 31) * 16;
    const int* EIDX = (const int*)(p.ws + WS_EIDX); const float* COEF = (const float*)(p.ws + WS_GATE);
    bf16* XB = (bf16*)(p.ws + WS_XB);
    const int hb = (lane & 32) << 2;
    const int xo = (lane & 31) * 32 + (lane >> 5) * 16;
    const int stride = grid_l() * 8; int tok = __builtin_amdgcn_readfirstlane(bid_l() * 8 + wave);
    if (tok >= T) return;
    PeerVMeta cur = peer_vmeta_load(EIDX, COEF, XB, tok, lane);
    auto se = __builtin_amdgcn_permlane32_swap((unsigned)cur.e_lo, (unsigned)cur.e_hi, false, false); auto sc_ = __builtin_amdgcn_permlane32_swap(__float_as_uint(cur.c_lo), __float_as_uint(cur.c_hi), false, false);
    u32x4 vrA[8], vrB[8]; float cfA[8], cfB[8];
    PV_ISSUE(vrA, cfA, se[0], sc_[0], 0);
#pragma unroll 1
    for (; tok < T; tok += stride) {
        const PeerVMeta nxt = peer_vmeta_load(EIDX, COEF, XB, tok + stride < T ? tok + stride : tok, lane);
        __builtin_amdgcn_sched_barrier(0);
        f32x2v acc[16];
#pragma unroll
        for (int i = 0; i < 16; ++i) acc[i] = (f32x2v){0.f, 0.f};
        PV_ISSUE(vrB, cfB, se[0], sc_[0], 8);  PV_COMPUTE(vrA, cfA);
        PV_ISSUE(vrA, cfA, se[0], sc_[0], 16); PV_COMPUTE(vrB, cfB);
        PV_ISSUE(vrB, cfB, se[0], sc_[0], 24); PV_COMPUTE(vrA, cfA);
        PV_ISSUE(vrA, cfA, se[1], sc_[1], 0);  PV_COMPUTE(vrB, cfB);
        PV_ISSUE(vrB, cfB, se[1], sc_[1], 8);  PV_COMPUTE(vrA, cfA);
        PV_ISSUE(vrA, cfA, se[1], sc_[1], 16); PV_COMPUTE(vrB, cfB);
        PV_ISSUE(vrB, cfB, se[1], sc_[1], 24); PV_COMPUTE(vrA, cfA);
        se = __builtin_amdgcn_permlane32_swap((unsigned)nxt.e_lo, (unsigned)nxt.e_hi, false, false); sc_ = __builtin_amdgcn_permlane32_swap(__float_as_uint(nxt.c_lo), __float_as_uint(nxt.c_hi), false, false);
        PV_ISSUE(vrA, cfA, se[0], sc_[0], 0);  PV_COMPUTE(vrB, cfB);
        float sres[16];
#pragma unroll
        for (int i = 0; i < 8; ++i)
#pragma unroll
            for (int c = 0; c < 2; ++c) { const auto r_ = __builtin_amdgcn_permlane32_swap(__float_as_uint(acc[i][c]), __float_as_uint(acc[8 + i][c]), false, false);
                sres[2 * i + c] = __uint_as_float(r_[0]) + __uint_as_float(r_[1]); }
        float r[16];
#pragma unroll
        for (int i = 0; i < 4; ++i) { r[2 * i] = ALPHA * bf2f(cur.x0[i] & 0xffffu) + sres[2 * i]; r[2 * i + 1] = ALPHA * __uint_as_float(cur.x0[i] & 0xffff0000u) + sres[2 * i + 1];
                                      r[8 + 2 * i] = ALPHA * bf2f(cur.x1[i] & 0xffffu) + sres[8 + 2 * i]; r[8 + 2 * i + 1] = ALPHA * __uint_as_float(cur.x1[i] & 0xffff0000u) + sres[8 + 2 * i + 1]; }
#pragma unroll
        for (int w = 0; w < 2; ++w) { u32x4 o; o.x = pk2(r[8 * w], r[8 * w + 1]); o.y = pk2(r[8 * w + 2], r[8 * w + 3]); o.z = pk2(r[8 * w + 4], r[8 * w + 5]); o.w = pk2(r[8 * w + 6], r[8 * w + 7]);
            *(u32x4*)(XB + (size_t)tok * D + xo + 8 * w) = o; }
        cur = nxt;
    }
}
#undef PV_ISSUE
#undef PV_COMPUTE
#define GAS __attribute__((address_space(1)))
#define LAS __attribute__((address_space(3)))
#define XB_TMO      128
#define XB_XCNT(j)  (256  + 64 * (j))
#define XB_XSUB(j)  (1280 + 64 * (j))
#define XB_XGEN(j)  (2304 + 64 * (j))
#define XB_TOP      3328
#define XB_TOPGEN   3392
#define XCD_BAR_WORDS 3456
#define XB_SPIN_CAP (1u << 18)

__device__ __forceinline__ unsigned xb_ld(unsigned* p)              { return __hip_atomic_load(p, __ATOMIC_RELAXED, __HIP_MEMORY_SCOPE_AGENT); }
__device__ __forceinline__ unsigned xb_add(unsigned* p, unsigned v) { return __hip_atomic_fetch_add(p, v, __ATOMIC_RELAXED, __HIP_MEMORY_SCOPE_AGENT); }
__device__ __forceinline__ unsigned xb_xcc_id() { return (unsigned)__builtin_amdgcn_s_getreg((3 << 11) | 20) & 0xFu; }
#define XB_SPIN(cond, bar) do { unsigned _sp = 0; while (cond) { __builtin_amdgcn_s_sleep(1); \
    if ((++_sp & 255u) == 0u) { if (xb_ld(&(bar)[XB_TMO])) break; if (_sp > XB_SPIN_CAP) { atomicAdd(&(bar)[XB_TMO], 1u); break; } } } } while (0)

struct XcdBarrier {
    unsigned* bar; unsigned x;
    volatile LAS unsigned* st;
};

__device__ __forceinline__ XcdBarrier xcd_barrier_post(unsigned* bar, volatile LAS unsigned* st) {
    XcdBarrier b; b.bar = bar; b.x = xb_xcc_id(); b.st = st;
    if (threadIdx.x == 0) (void)xb_add(&bar[XB_XCNT(b.x)], 1u);
    return b;
}
__device__ __forceinline__ void xcd_barrier_complete(unsigned* bar, unsigned x, unsigned& nloc, unsigned& nx) {
    const unsigned G = gridDim.x * gridDim.y * gridDim.z;
    unsigned sum, cnt, mine, sp = 0u;
    for (;;) {
        sum = 0u; cnt = 0u; mine = 0u;
#pragma unroll
        for (unsigned j = 0; j < 16; ++j) { const unsigned c = xb_ld(&bar[XB_XCNT(j)]); sum += c; cnt += (c > 0u) ? 1u : 0u; mine = (j == x) ? c : mine; }
        if (sum == G) break;
        __builtin_amdgcn_s_sleep(1);
        if ((++sp & 255u) == 0u) { if (xb_ld(&bar[XB_TMO])) break; if (sp > XB_SPIN_CAP) { atomicAdd(&bar[XB_TMO], 1u); break; } }
    }
    nloc = mine > 0u ? mine : 1u; nx = cnt > 0u ? cnt : 1u;
}

__device__ __forceinline__ void xcd_barrier(const XcdBarrier& b) {
    asm volatile("s_waitcnt vmcnt(0)" ::: "memory");
    __syncthreads();
    if (threadIdx.x == 0) {
        unsigned* bar = b.bar;
        __builtin_amdgcn_s_waitcnt(0);
        unsigned nloc = b.st[0], nx = b.st[1];
        if (nloc == 0u) { xcd_barrier_complete(bar, b.x, nloc, nx); b.st[0] = nloc; b.st[1] = nx; }
        const unsigned old = xb_add(&bar[XB_XSUB(b.x)], 1u);
        const unsigned gen = old / nloc;
        if (old + 1u == (gen + 1u) * nloc) {
            __builtin_amdgcn_fence(__ATOMIC_RELEASE, "agent");
            asm volatile("s_waitcnt vmcnt(0)" ::: "memory");
            const unsigned og = xb_add(&bar[XB_TOP], 1u);
            const unsigned tg = og / nx;
            if (og + 1u == (tg + 1u) * nx) xb_add(&bar[XB_TOPGEN], 1u);
            else XB_SPIN(xb_ld(&bar[XB_TOPGEN]) == tg, bar);
            __builtin_amdgcn_fence(__ATOMIC_ACQUIRE, "agent");
            xb_add(&bar[XB_XGEN(b.x)], 1u);
            asm volatile("s_waitcnt vmcnt(0)" ::: "memory");
        } else {
            XB_SPIN(xb_ld(&bar[XB_XGEN(b.x)]) == gen, bar);
            __builtin_amdgcn_fence(__ATOMIC_ACQUIRE, "agent");
            asm volatile("s_waitcnt vmcnt(0)" ::: "memory");
        }
    }
    __syncthreads();
}
enum { PH_PRO_A, PH_PRO_B, PH_CVT, PH_GEMM_IN, PH_GEMM_E, PH_CONV, PH_FOXCUM, PH_FOXNORM, PH_GLA1, PH_GLA2, PH_GLA3, PH_FOX, PH_GEMM_OUT, PH_LN1, PH_GEMM_SC, PH_TOPK, PH_PEERU, PH_PEERV, PH_GEMM_PLE, PH_LN2, PH_COUNT };

template <int PH> __device__ __forceinline__ void run_phase(const Params& p, int l, unsigned char* lds) {
    if constexpr (PH == PH_PRO_A) phase_pro_a(p, lds);
    else if constexpr (PH == PH_PRO_B) phase_pro_b(p, lds);
    else if constexpr (PH == PH_CVT) phase_cvt(p, l);
    else if constexpr (PH == PH_GEMM_IN) phase_gemm_in(p, l, lds);
    else if constexpr (PH == PH_GEMM_E) phase_gemm_e(p, l, lds);
    else if constexpr (PH == PH_CONV) phase_conv(p, l, lds);
    else if constexpr (PH == PH_FOXCUM) phase_fox_cum(p, l, lds);
    else if constexpr (PH == PH_FOXNORM) phase_fox_norm(p, lds);
    else if constexpr (PH == PH_GLA1) phase_gla_b1(p, l, lds);
    else if constexpr (PH == PH_GLA2) phase_gla_b2(p);
    else if constexpr (PH == PH_GLA3) phase_gla_b3(p, l, lds);
    else if constexpr (PH == PH_FOX) phase_fox_mfma(p, l, lds);
    else if constexpr (PH == PH_GEMM_OUT) phase_gemm_out(p, l, lds);
    else if constexpr (PH == PH_LN1) phase_ln((const _Float16*)(p.ws + WS_Y), p.ln1_g + (size_t)l * D, p.ln1_b + (size_t)l * D, nullptr, (bf16*)(p.ws + WS_XB), p.ws + WS_XQ, (float*)(p.ws + WS_XS));
    else if constexpr (PH == PH_GEMM_SC) phase_gemm_sc(p, l, lds);
    else if constexpr (PH == PH_TOPK) phase_topk(p, lds);
    else if constexpr (PH == PH_PEERU) phase_peer_u(p, lds);
    else if constexpr (PH == PH_PEERV) phase_peer_v(p);
    else if constexpr (PH == PH_GEMM_PLE) phase_gemm_ple(p, l, lds);
    else if constexpr (PH == PH_LN2) phase_ln((const _Float16*)(p.ws + WS_Y), p.ln2_g + (size_t)l * D, p.ln2_b + (size_t)l * D, l == DEPTH - 1 ? p.out : nullptr, l == DEPTH - 1 ? nullptr : (bf16*)(p.ws + WS_XB));
}

constexpr int MISC_OFF = LDS_BYTES - 512;
constexpr int CW_BAR = 4096;
static_assert(MISC_OFF + 128 <= LDS_BYTES && (CW_BAR + XCD_BAR_WORDS) * 4 <= (int)CTL_ZERO_BYTES, "control words");

typedef __attribute__((address_space(4))) const Params CParams;
#define PHASE(PH) do { CParams* q_ = pp; asm volatile("" : "+s"(q_)); Params lp_; __builtin_memcpy(&lp_, q_, sizeof(Params)); run_phase<PH>(lp_, l, lds); } while (0)
__global__ void __launch_bounds__(512, 2) mk_fwd(Params p_unused) {
#if defined(__HIP_DEVICE_COMPILE__)
    extern __shared__ __attribute__((aligned(16))) unsigned char lds[];
    CParams* pp = (CParams*)__builtin_amdgcn_kernarg_segment_ptr();
    unsigned char* ws0; { CParams* q_ = pp; asm volatile("" : "+s"(q_)); ws0 = q_->ws; }
    volatile LAS unsigned* MISC = (volatile LAS unsigned*)((LAS unsigned char*)lds + MISC_OFF);
    if (threadIdx.x < 32) MISC[threadIdx.x] = 0u;
    __syncthreads();
    (void)xcd_barrier_post((unsigned*)(ws0 + WS_CTL) + CW_BAR, MISC + 8);
#define GB() do { CParams* qb_ = pp; asm volatile("" : "+s"(qb_)); XcdBarrier b_; b_.bar = (unsigned*)(qb_->ws + WS_CTL) + CW_BAR; b_.x = xb_xcc_id(); b_.st = MISC + 8; xcd_barrier(b_); } while (0)
    { const int l = 0; PHASE(PH_PRO_A); PHASE(PH_PRO_B); } GB();
    for (int l = 0; l < DEPTH; ++l) {
        PHASE(PH_CVT); PHASE(PH_GEMM_IN); GB();
        PHASE(PH_GEMM_E); PHASE(PH_CONV); PHASE(PH_FOXCUM); PHASE(PH_FOXNORM); PHASE(PH_GLA1); GB();
        PHASE(PH_GLA2); PHASE(PH_FOX); GB();
        PHASE(PH_GLA3); GB();
        PHASE(PH_GEMM_OUT); GB();
        PHASE(PH_LN1); GB();
        PHASE(PH_GEMM_SC); GB();
        PHASE(PH_TOPK); GB();
        PHASE(PH_PEERU); GB();
        PHASE(PH_PEERV); GB();
        PHASE(PH_GEMM_PLE); GB();
        PHASE(PH_LN2); GB();
    }
#undef GB
#endif
}

extern "C" void kernel_launch(void* const* d_in, const int* in_sizes, int n_in, void* d_out, int out_size, void* d_ws, size_t ws_size, hipStream_t stream) {
    static int grid = 0;
    if (grid == 0) {
        if (n_in != 23 || ws_size < WS_END) { fprintf(stderr, "kernel_launch: unexpected n_in %d or ws_size %zu\n", n_in, ws_size); grid = -1; return; }
        int dev = 0, cus = 0, per_cu = 0;
        if (hipGetDevice(&dev) != hipSuccess || hipDeviceGetAttribute(&cus, hipDeviceAttributeMultiprocessorCount, dev) != hipSuccess) { grid = -1; return; }
        if (hipFuncSetAttribute((const void*)mk_fwd, hipFuncAttributeMaxDynamicSharedMemorySize, LDS_BYTES) != hipSuccess) { grid = -1; return; }
        if (hipOccupancyMaxActiveBlocksPerMultiprocessor(&per_cu, (const void*)mk_fwd, 512, LDS_BYTES) != hipSuccess || per_cu < 1) { fprintf(stderr, "kernel_launch: occupancy query says %d\n", per_cu); }
        (void)hipGetLastError();
        grid = cus;
    }
    if (grid < 0) return;
    if (hipMemsetAsync((char*)d_ws + WS_CTL, 0, CTL_ZERO_BYTES, stream) != hipSuccess) return;
    Params p; memset(&p, 0, sizeof(p));
    const float** f = (const float**)&p;
    for (int i = 0; i < 23; ++i) f[i] = (const float*)d_in[i];
    p.out = (float*)d_out; p.ws = (unsigned char*)d_ws;
    hipLaunchKernelGGL(mk_fwd, dim3(grid), dim3(512), LDS_BYTES, stream, p);
}
```

```cpp
#include <hip/hip_runtime.h>
#include <cstdio>
#include <cstdint>
#include <cstring>
#include <cmath>
__device__ __forceinline__ int tid_l() { int t = threadIdx.x; asm volatile("" : "+v"(t)); return t; }
__device__ __forceinline__ int bid_l() { int b = blockIdx.x; asm volatile("" : "+s"(b)); return b; }
__device__ __forceinline__ int grid_l() { int g = gridDim.x; asm volatile("" : "+s"(g)); return g; }
namespace pg8 {
#define PG8_LAS __attribute__((address_space(3)))
typedef unsigned short bf16_t;
typedef short bf16x8 __attribute__((ext_vector_type(8)));
typedef float f32x4 __attribute__((ext_vector_type(4)));
typedef unsigned u32x4 __attribute__((ext_vector_type(4)));
constexpr int BM = 256, BK = 64, HALF = 128, HTB = HALF * BK * 2  , STAGE_BYTES = 8 * HTB, NXCD = 8, WGM = 8;

__host__ __device__ __forceinline__ int lds_byte(int r, int c) { const int st = (r >> 4) * 2 + (c >> 5), rr = r & 15, cc = c & 31, ob = rr * 64 + cc * 2; return st * 1024 + (ob ^ (((ob >> 9) & 1) << 5)); }
__host__ __device__ __forceinline__ void stage_rc(int b, int& R, int& C) { const int st = b / 1024, sb = b % 1024, swz = sb ^ (((sb >> 9) & 1) << 5); R = (st >> 1) * 16 + swz / 64; C = (st & 1) * 32 + (swz % 64) / 2; }
__host__ __device__ __forceinline__ int perm32(int rho) { const int n = rho >> 4, i = rho & 15; return 8 * (i >> 2) + 4 * n + (i & 3); }

struct Unit { int pm, pn; };
struct Gemm { const bf16_t* A; const bf16_t* Bt; int M, N, K; };

struct StaticOrder {
    int nM, nN, nwg, G, c;
    __host__ __device__ void init(int M, int N, int G_, int c_) { nM = M / BM; nN = N / BM; nwg = nM * nN; G = G_; c = c_; }
    __host__ __device__ bool next(int i, Unit& u) const {
        const long L = (long)i * G + c; if (L >= nwg) return false;
        int wgid = (int)L; { const int q = nwg / NXCD, r = nwg % NXCD, xcd = wgid % NXCD, off = wgid / NXCD; wgid = (xcd < r ? xcd * (q + 1) : r * (q + 1) + (xcd - r) * q) + off; }
        const int nig = WGM * nN, gid = wgid / nig, fm = gid * WGM, gsz = (nM - fm) < WGM ? (nM - fm) : WGM;
        u.pm = fm + ((wgid % nig) % gsz); u.pn = (wgid % nig) / gsz; return true;
    }
    __device__ __forceinline__ void a_ready(const Unit&) const {}
    __device__ __forceinline__ void done(const Unit&) const {}
};

__device__ __forceinline__ unsigned cvt_pk_bf16(float lo, float hi) { unsigned r; asm volatile("v_cvt_pk_bf16_f32 %0, %1, %2" : "=v"(r) : "v"(lo), "v"(hi)); return r; }
typedef float f32x2 __attribute__((ext_vector_type(2)));
__device__ __forceinline__ f32x2 gelu_pk(f32x2 v) {
    const f32x2 av = __builtin_elementwise_abs(v), d = av * 0.2316418882f + 1.0f;
    f32x2 t; t.x = __builtin_amdgcn_rcpf(d.x); t.y = __builtin_amdgcn_rcpf(d.y);
    f32x2 q = t * 0.5307027145f + (-0.7265760135f); q = q * t + 0.7107068705f; q = q * t + (-0.142248368f); q = q * t + 0.127414796f; q = q * t;
    const f32x2 s = (v * v) * (-0.72134752044f);
    f32x2 e; e.x = __builtin_amdgcn_exp2f(s.x); e.y = __builtin_amdgcn_exp2f(s.y);
    const f32x2 m = v * (q * e), r = v - m;
    f32x2 o; o.x = v.x < 0.f ? m.x : r.x; o.y = v.y < 0.f ? m.y : r.y; return o;
}

template <int ACT  > struct EpiBf16 {
    static constexpr bool PERM = true, AFTER_DRAIN = false; static_assert(ACT == 0 || ACT == 1, "EpiBf16: ACT is 0 (none) or 1 (gelu_pk)");
    bf16_t* O; int ldc; const float* bias; int split_cols; size_t split_stride; float scale0;
    __device__ __forceinline__ void operator()(const f32x4 (&acc)[2][2][4][2], const Unit& u, int wr, int wc, int fr, int fq) const {
        const int row0 = u.pm * BM + wr * 64 + fr; int colt = u.pn * BM; bf16_t* base = O;
        float sc = 1.f; if (split_cols) { const int t = colt / split_cols; base += (size_t)t * split_stride; colt -= t * split_cols; if (t == 0) sc = scale0; }
        const int col0 = colt + wc * 32 + 8 * fq, bcol0 = u.pn * BM + wc * 32 + 8 * fq;
        f32x4 bv[2][2];
#pragma unroll
        for (int bj = 0; bj < 2; ++bj)
#pragma unroll
            for (int n = 0; n < 2; ++n) bv[bj][n] = bias ? *(const f32x4*)(bias + bcol0 + bj * HALF + 4 * n) : (f32x4){0.f, 0.f, 0.f, 0.f};
#pragma unroll
        for (int ai = 0; ai < 2; ++ai)
#pragma unroll
            for (int m = 0; m < 4; ++m) { bf16_t* rowp = base + (size_t)(row0 + ai * HALF + m * 16) * ldc + col0;
#pragma unroll
                for (int bj = 0; bj < 2; ++bj) { f32x4 v0 = acc[ai][bj][m][0] + bv[bj][0], v1 = acc[ai][bj][m][1] + bv[bj][1];
                    if (ACT == 1) { f32x2 a = gelu_pk((f32x2){v0[0], v0[1]}), b = gelu_pk((f32x2){v0[2], v0[3]}), c = gelu_pk((f32x2){v1[0], v1[1]}), d = gelu_pk((f32x2){v1[2], v1[3]});
                        v0 = (f32x4){a.x, a.y, b.x, b.y}; v1 = (f32x4){c.x, c.y, d.x, d.y}; }
                    v0 = v0 * sc; v1 = v1 * sc; u32x4 w; w.x = cvt_pk_bf16(v0[0], v0[1]); w.y = cvt_pk_bf16(v0[2], v0[3]); w.z = cvt_pk_bf16(v1[0], v1[1]); w.w = cvt_pk_bf16(v1[2], v1[3]);
                    *(u32x4*)(rowp + bj * HALF) = w; } }
    }
};
struct EpiF16 {
    static constexpr bool PERM = true, AFTER_DRAIN = false;
    _Float16* O; int ldc;
    __device__ __forceinline__ void operator()(const f32x4 (&acc)[2][2][4][2], const Unit& u, int wr, int wc, int fr, int fq) const {
        typedef _Float16 h8 __attribute__((ext_vector_type(8)));
        const int row0 = u.pm * BM + wr * 64 + fr, col0 = u.pn * BM + wc * 32 + 8 * fq;
#pragma unroll
        for (int ai = 0; ai < 2; ++ai)
#pragma unroll
            for (int m = 0; m < 4; ++m) { _Float16* rowp = O + (size_t)(row0 + ai * HALF + m * 16) * ldc + col0;
#pragma unroll
                for (int bj = 0; bj < 2; ++bj) { const f32x4 a = acc[ai][bj][m][0], b = acc[ai][bj][m][1];
                    h8 o; o[0] = (_Float16)a[0]; o[1] = (_Float16)a[1]; o[2] = (_Float16)a[2]; o[3] = (_Float16)a[3]; o[4] = (_Float16)b[0]; o[5] = (_Float16)b[1]; o[6] = (_Float16)b[2]; o[7] = (_Float16)b[3];
                    *(h8*)(rowp + bj * HALF) = o; } }
    }
};
struct EpiResid {
    static constexpr bool PERM = true, AFTER_DRAIN = false;
    const bf16_t* res; _Float16* Y; int ldc; float alpha;
    __device__ __forceinline__ void operator()(const f32x4 (&acc)[2][2][4][2], const Unit& u, int wr, int wc, int fr, int fq) const {
        const int row0 = u.pm * BM + wr * 64 + fr, col0 = u.pn * BM + wc * 32 + 8 * fq;
#pragma unroll
        for (int ai = 0; ai < 2; ++ai)
#pragma unroll
            for (int m = 0; m < 4; ++m) { const size_t off = (size_t)(row0 + ai * HALF + m * 16) * ldc + col0;
#pragma unroll
                for (int bj = 0; bj < 2; ++bj) { const u32x4 rv = *(const u32x4*)(res + off + bj * HALF);
                    f32x4 r0, r1; r0[0] = __uint_as_float(rv.x << 16); r0[1] = __uint_as_float(rv.x & 0xffff0000u); r0[2] = __uint_as_float(rv.y << 16); r0[3] = __uint_as_float(rv.y & 0xffff0000u);
                    r1[0] = __uint_as_float(rv.z << 16); r1[1] = __uint_as_float(rv.z & 0xffff0000u); r1[2] = __uint_as_float(rv.w << 16); r1[3] = __uint_as_float(rv.w & 0xffff0000u);
                    const f32x4 y0 = r0 * alpha + acc[ai][bj][m][0], y1 = r1 * alpha + acc[ai][bj][m][1];
                    typedef _Float16 h8 __attribute__((ext_vector_type(8))); h8 w; w[0] = (_Float16)y0[0]; w[1] = (_Float16)y0[1]; w[2] = (_Float16)y0[2]; w[3] = (_Float16)y0[3]; w[4] = (_Float16)y1[0]; w[5] = (_Float16)y1[1]; w[6] = (_Float16)y1[2]; w[7] = (_Float16)y1[3];
                    *(h8*)(Y + off + bj * HALF) = w; } }
    }
};
struct EpiPle {
    static constexpr bool PERM = true, AFTER_DRAIN = false;
    const bf16_t* R; _Float16* Y; const bf16_t* E; const float* gb; int ldc;
    __device__ __forceinline__ void operator()(const f32x4 (&acc)[2][2][4][2], const Unit& u, int wr, int wc, int fr, int fq) const {
        const int row0 = u.pm * BM + wr * 64 + fr, col0 = u.pn * BM + wc * 32 + 8 * fq;
        f32x4 bv[2][2];
#pragma unroll
        for (int bj = 0; bj < 2; ++bj)
#pragma unroll
            for (int n = 0; n < 2; ++n) bv[bj][n] = *(const f32x4*)(gb + col0 + bj * HALF + 4 * n);
#pragma unroll
        for (int ai = 0; ai < 2; ++ai)
#pragma unroll
            for (int m = 0; m < 4; ++m) { const size_t off = (size_t)(row0 + ai * HALF + m * 16) * ldc + col0;
#pragma unroll
                for (int bj = 0; bj < 2; ++bj) {
                    const u32x4 ev = *(const u32x4*)(E + off + bj * HALF), rv = *(const u32x4*)(R + off + bj * HALF);
                    float o[8];
#pragma unroll
                    for (int n = 0; n < 2; ++n) {
                        const f32x4 z = acc[ai][bj][m][n] + bv[bj][n];
                        const unsigned e0 = n == 0 ? ev.x : ev.z, e1 = n == 0 ? ev.y : ev.w, r0 = n == 0 ? rv.x : rv.z, r1 = n == 0 ? rv.y : rv.w;
                        f32x4 ee, rr; ee[0] = __uint_as_float(e0 << 16); ee[1] = __uint_as_float(e0 & 0xffff0000u); ee[2] = __uint_as_float(e1 << 16); ee[3] = __uint_as_float(e1 & 0xffff0000u);
                        rr[0] = __uint_as_float(r0 << 16); rr[1] = __uint_as_float(r0 & 0xffff0000u); rr[2] = __uint_as_float(r1 << 16); rr[3] = __uint_as_float(r1 & 0xffff0000u);
#pragma unroll
                        for (int i = 0; i < 4; ++i) o[4 * n + i] = rr[i] + ee[i] * __builtin_amdgcn_rcpf(1.0f + __expf(-z[i])); }
                    typedef _Float16 h8 __attribute__((ext_vector_type(8))); h8 w;
#pragma unroll
                    for (int i = 0; i < 8; ++i) w[i] = (_Float16)o[i];
                    *(h8*)(Y + off + bj * HALF) = w; } }
    }
};
template <class Epi, class Sched, bool ALIGN_EPI = false, bool SP2 = false>
__device__ __forceinline__ void gemm_phase(PG8_LAS unsigned char* lds, const Gemm g, const Sched& S, const Epi& E) {
    const int tid = tid_l(), wid = __builtin_amdgcn_readfirstlane(tid >> 6), lane = tid & 63, wr = wid >> 2, wc = wid & 3, fr = lane & 15, fq = lane >> 4;
    const int K = g.K, nt = K / BK;
    unsigned voffA[2], voffB[2];
#pragma unroll
    for (int i = 0; i < 2; ++i) { int R, C; stage_rc(tid * 16 + i * 8192, R, C); const int Rb = Epi::PERM ? ((R & ~31) + perm32(R & 31)) : R;
        voffA[i] = (unsigned)(R * K + C) * 2u; voffB[i] = (unsigned)(Rb * K + C) * 2u; }
    const size_t kstep = (size_t)(BK * 2);
    const size_t hstep = (size_t)HALF * K * 2;
    const size_t tstep = 2 * hstep;
    const unsigned ldsw = (unsigned)wid * 1024u;
    const int aoff = lds_byte(wr * 64 + fr, fq * 8), boff = lds_byte(wc * 32 + fr, fq * 8);
#define PG8_SA(b, h) (((b) * 2 + (h)) * HTB)
#define PG8_SB(b, h) ((4 + (b) * 2 + (h)) * HTB)
#define PG8_STAGE(bufoff, gbase, voff) do { _Pragma("unroll") for (int _i = 0; _i < 2; ++_i) \
        __builtin_amdgcn_global_load_lds((const unsigned*)((const char*)(gbase) + (voff)[_i]), (PG8_LAS unsigned*)(lds + (bufoff) + ldsw + _i * 8192), 16, 0, 0); } while (0)
#define PG8_LDA(dst, b, h) do { _Pragma("unroll") for (int m = 0; m < 4; ++m) _Pragma("unroll") for (int k = 0; k < 2; ++k) dst[m][k] = *(const PG8_LAS bf16x8*)(lds + PG8_SA(b, h) + aoff + m * 2048 + k * 1024); } while (0)
#define PG8_LDB(dst, b, h) do { _Pragma("unroll") for (int n = 0; n < 2; ++n) _Pragma("unroll") for (int k = 0; k < 2; ++k) dst[n][k] = *(const PG8_LAS bf16x8*)(lds + PG8_SB(b, h) + boff + n * 2048 + k * 1024); } while (0)
#define PG8_MMA(ai, bj, At, Bt) do { __builtin_amdgcn_s_setprio(1); _Pragma("unroll") for (int m = 0; m < 4; ++m) _Pragma("unroll") for (int n = 0; n < 2; ++n) _Pragma("unroll") for (int k = 0; k < 2; ++k) \
        acc[ai][bj][m][n] = __builtin_amdgcn_mfma_f32_16x16x32_bf16(Bt[n][k], At[m][k], acc[ai][bj][m][n], 0, 0, 0); __builtin_amdgcn_s_setprio(0); } while (0)
#define PG8_WAIT_V(n) asm volatile("s_waitcnt vmcnt(" #n ")" ::: "memory")
#define PG8_WAIT_L(n) asm volatile("s_waitcnt lgkmcnt(" #n ")" ::: "memory")
#define PG8_BAR __builtin_amdgcn_s_barrier()
#define PG8_SCHED __builtin_amdgcn_sched_barrier(0)
    Unit cur, nxt; int ui = 0;
    if (!S.next(0, cur)) return;
    f32x4 acc[2][2][4][2];
#pragma unroll
    for (int a = 0; a < 2; ++a)
#pragma unroll
        for (int b = 0; b < 2; ++b)
#pragma unroll
            for (int m = 0; m < 4; ++m)
#pragma unroll
                for (int n = 0; n < 2; ++n) acc[a][b][m][n] = (f32x4){0.f, 0.f, 0.f, 0.f};
    bf16x8 At[4][2], B0[2][2], B1[2][2];
    const char* cA = (const char*)g.A + (size_t)cur.pm * tstep; const char* cB = (const char*)g.Bt + (size_t)cur.pn * tstep;
    S.a_ready(cur);
    if constexpr (SP2) {
        PG8_STAGE(PG8_SB(0, 0), cB, voffB); PG8_STAGE(PG8_SB(0, 1), cB + hstep, voffB); PG8_STAGE(PG8_SA(0, 0), cA, voffA); PG8_STAGE(PG8_SA(0, 1), cA + hstep, voffA);
        if (wr == 1) PG8_BAR;
        PG8_WAIT_V(2); PG8_BAR;
        PG8_STAGE(PG8_SB(1, 0), cB + kstep, voffB); PG8_STAGE(PG8_SA(1, 0), cA + kstep, voffA); PG8_STAGE(PG8_SB(1, 1), cB + hstep + kstep, voffB);
        PG8_WAIT_V(6); PG8_BAR;
    } else {
        PG8_STAGE(PG8_SB(0, 0), cB, voffB); PG8_STAGE(PG8_SA(0, 0), cA, voffA); PG8_STAGE(PG8_SB(0, 1), cB + hstep, voffB); PG8_STAGE(PG8_SA(0, 1), cA + hstep, voffA);
        if (wr == 1) PG8_BAR;
        PG8_WAIT_V(4); PG8_BAR;
        PG8_STAGE(PG8_SB(1, 0), cB + kstep, voffB); PG8_STAGE(PG8_SA(1, 0), cA + kstep, voffA); PG8_STAGE(PG8_SB(1, 1), cB + hstep + kstep, voffB);
        PG8_WAIT_V(6); PG8_BAR;
    }
    for (;;) {
        const bool has_next = S.next(ui + 1, nxt);
        const char* nA = has_next ? (const char*)g.A + (size_t)nxt.pm * tstep : cA; const char* nB = has_next ? (const char*)g.Bt + (size_t)nxt.pn * tstep : cB;
        for (int t = 0; t < nt; t += 2) {
            const bool last = (t == nt - 2);
            const char* a1 = cA + (size_t)(t + 1) * kstep;
            const char* a2 = last ? nA : cA + (size_t)(t + 2) * kstep; const char* b2 = last ? nB : cB + (size_t)(t + 2) * kstep;
            const char* a3 = a2 + kstep; const char* b3 = b2 + kstep;
            if (last && has_next) S.a_ready(nxt);
            if constexpr (SP2) {
            PG8_LDB(B0, 0, 0); PG8_LDB(B1, 0, 1); PG8_SCHED; PG8_LDA(At, 0, 0); PG8_STAGE(PG8_SA(1, 1), a1 + hstep, voffA);
            PG8_WAIT_V(8); PG8_WAIT_L(0); PG8_BAR; PG8_MMA(0, 0, At, B0); PG8_MMA(0, 1, At, B1); PG8_BAR; PG8_SCHED;
            PG8_LDA(At, 0, 1); PG8_STAGE(PG8_SB(0, 0), b2, voffB); PG8_STAGE(PG8_SB(0, 1), b2 + hstep, voffB); PG8_STAGE(PG8_SA(0, 0), a2, voffA);
            PG8_WAIT_V(8); PG8_WAIT_L(0); PG8_BAR; PG8_MMA(1, 0, At, B0); PG8_MMA(1, 1, At, B1); PG8_BAR; PG8_SCHED;
            PG8_LDB(B0, 1, 0); PG8_LDB(B1, 1, 1); PG8_SCHED; PG8_LDA(At, 1, 0); PG8_STAGE(PG8_SA(0, 1), a2 + hstep, voffA);
            PG8_WAIT_V(8); PG8_WAIT_L(0); PG8_BAR; PG8_MMA(0, 0, At, B0); PG8_MMA(0, 1, At, B1); PG8_BAR; PG8_SCHED;
            PG8_LDA(At, 1, 1); PG8_STAGE(PG8_SB(1, 0), b3, voffB); PG8_STAGE(PG8_SB(1, 1), b3 + hstep, voffB); PG8_STAGE(PG8_SA(1, 0), a3, voffA);
            PG8_WAIT_V(8); PG8_WAIT_L(0); PG8_BAR; PG8_MMA(1, 0, At, B0); PG8_MMA(1, 1, At, B1); PG8_BAR; PG8_SCHED;
            } else {
            PG8_LDB(B0, 0, 0); PG8_SCHED; PG8_LDA(At, 0, 0); PG8_STAGE(PG8_SA(1, 1), a1 + hstep, voffA);
            PG8_WAIT_L(8); PG8_BAR; PG8_WAIT_L(0); PG8_MMA(0, 0, At, B0); PG8_BAR; PG8_SCHED;
            PG8_LDB(B1, 0, 1); PG8_STAGE(PG8_SB(0, 0), b2, voffB);
            PG8_BAR; PG8_WAIT_L(0); PG8_MMA(0, 1, At, B1); PG8_BAR;
            PG8_LDA(At, 0, 1); PG8_STAGE(PG8_SA(0, 0), a2, voffA);
            PG8_BAR; PG8_WAIT_L(0); PG8_MMA(1, 0, At, B0); PG8_BAR; PG8_SCHED;
            PG8_STAGE(PG8_SB(0, 1), b2 + hstep, voffB);
            PG8_WAIT_V(6); PG8_BAR; PG8_MMA(1, 1, At, B1); PG8_BAR;
            PG8_LDB(B0, 1, 0); PG8_SCHED; PG8_LDA(At, 1, 0); PG8_STAGE(PG8_SA(0, 1), a2 + hstep, voffA);
            PG8_WAIT_L(8); PG8_BAR; PG8_WAIT_L(0); PG8_MMA(0, 0, At, B0); PG8_BAR; PG8_SCHED;
            PG8_LDB(B1, 1, 1); PG8_STAGE(PG8_SB(1, 0), b3, voffB);
            PG8_BAR; PG8_WAIT_L(0); PG8_MMA(0, 1, At, B1); PG8_BAR;
            PG8_LDA(At, 1, 1); PG8_STAGE(PG8_SA(1, 0), a3, voffA);
            PG8_BAR; PG8_WAIT_L(0); PG8_MMA(1, 0, At, B0); PG8_BAR; PG8_SCHED;
            PG8_STAGE(PG8_SB(1, 1), b3 + hstep, voffB);
            PG8_WAIT_V(6); PG8_BAR; PG8_MMA(1, 1, At, B1); PG8_BAR;
            }
        }
        if constexpr (ALIGN_EPI) { if (wr == 0) PG8_BAR; }
        if constexpr (!Epi::AFTER_DRAIN) { E(acc, cur, wr, wc, fr, fq); S.done(cur); }
        if (!has_next) break;
#pragma unroll
        for (int a = 0; a < 2; ++a)
#pragma unroll
            for (int b = 0; b < 2; ++b)
#pragma unroll
                for (int m = 0; m < 4; ++m)
#pragma unroll
                    for (int n = 0; n < 2; ++n) acc[a][b][m][n] = (f32x4){0.f, 0.f, 0.f, 0.f};
        cur = nxt; cA = nA; cB = nB; ++ui;
        if constexpr (ALIGN_EPI) { if (wr == 1) PG8_BAR; }
    }
    PG8_WAIT_V(0);
    if constexpr (!ALIGN_EPI) { if (wr == 0) PG8_BAR; }
    PG8_BAR;
    if constexpr (Epi::AFTER_DRAIN) { E.fused(acc, cur, wr, wc, fr, fq, lds, wid, lane); S.done(cur); }
#undef PG8_SA
#undef PG8_SB
#undef PG8_STAGE
#undef PG8_LDA
#undef PG8_LDB
#undef PG8_MMA
#undef PG8_WAIT_V
#undef PG8_WAIT_L
#undef PG8_BAR
#undef PG8_SCHED
}
}
#include <hip/hip_bf16.h>
#include <cmath>
namespace attn_body {
using bf16=__hip_bfloat16;
using bf16x8=__attribute__((ext_vector_type(8)))short;
using s16x4=__attribute__((ext_vector_type(4)))short;
using f32x16=__attribute__((ext_vector_type(16)))float;
using u32x4=__attribute__((ext_vector_type(4)))unsigned;
constexpr int BATCH=8,NHEAD=6,SEQ=4096,D=64,KVP=3072,OP=1024;
constexpr int NW=8,QBLK=32,QB=QBLK*NW,KVBLK=64,NQB=SEQ/QB;
constexpr int ATTN_UNIT_ROWS=QB;
__device__ __forceinline__ int crow(int r,int hi){return (r&3)+8*(r>>2)+4*hi;}
#define SBAR() __builtin_amdgcn_sched_barrier(0)
__device__ __forceinline__ void cmask(f32x16&p0,f32x16&p1,int jb,int qrel,int hi){
  const float NEG=-INFINITY; int kb=64*jb+4*hi;
  #pragma unroll
  for(int r=0;r<16;++r){int kv=kb+(r&3)+8*(r>>2); if(kv>qrel)p0[r]=NEG; if(kv+32>qrel)p1[r]=NEG;}
}

constexpr int NSLOT=3, SLOTB=8192;
constexpr int LDS_K=0, LDS_V=NSLOT*SLOTB, LDS_WS=2*NSLOT*SLOTB, LDS_OST=LDS_WS+NW*64*4, LDS_CK=LDS_OST+NW*4096, LDS_BYTES=LDS_CK+SEQ*4;
constexpr float C2=0.125f*1.4426950408889634f;
__device__ __forceinline__ void glds16(const void*gsrc,unsigned lds_dst){unsigned keep;
  asm volatile("s_mov_b32 %0, m0\n\ts_mov_b32 m0, %2\n\ts_nop 0\n\tglobal_load_lds_dwordx4 %1, off\n\ts_mov_b32 m0, %0":"=&s"(keep):"v"(gsrc),"s"(lds_dst):"memory");}
__device__ __forceinline__ float max3f(float a,float b,float c){float r;asm("v_max3_f32 %0, %1, %2, %3":"=v"(r):"v"(a),"v"(b),"v"(c));return r;}
__device__ __forceinline__ float max2f(float a,float b){float r;asm("v_max_f32_e32 %0, %1, %2":"=v"(r):"v"(a),"v"(b));return r;}
__device__ __forceinline__ float fadd_s(float a,float b){float r;asm("v_add_f32_e32 %0, %1, %2":"=v"(r):"v"(a),"v"(b));return r;}
__device__ __forceinline__ float fsub_s(float a,float b){float r;asm("v_sub_f32_e32 %0, %1, %2":"=v"(r):"v"(a),"v"(b));return r;}
typedef float f32x2_t __attribute__((ext_vector_type(2))); typedef float f32x4_t __attribute__((ext_vector_type(4))); typedef __bf16 bf16x2_t __attribute__((ext_vector_type(2)));
__device__ __forceinline__ unsigned cvtpk_s(float lo,float hi){f32x2_t v={lo,hi};bf16x2_t b=__builtin_convertvector(v,bf16x2_t);return __builtin_bit_cast(unsigned,b);}
#define WAIT_BAR(N) asm volatile("s_waitcnt vmcnt(" #N ") lgkmcnt(0)\n\ts_barrier":::"memory")

__device__ __forceinline__ void qkt(f32x16&p0,f32x16&p1,const char*Kslot,const bf16x8*qr,int r32,int hi){
  const char*kb=Kslot+hi*1024+r32*16;
  #pragma unroll
  for(int d0=0;d0<4;++d0){
    const bf16x8 b0=*reinterpret_cast<const bf16x8*>(kb+d0*2048);
    const bf16x8 b1=*reinterpret_cast<const bf16x8*>(kb+d0*2048+512);
    {p0=__builtin_amdgcn_mfma_f32_32x32x16_bf16(b0,qr[d0],p0,0,0,0);p1=__builtin_amdgcn_mfma_f32_32x32x16_bf16(b1,qr[d0],p1,0,0,0);}}
}
typedef __attribute__((address_space(3))) const char* lds_cptr;
typedef short v4i16_t __attribute__((ext_vector_type(4)));
__device__ __forceinline__ void kload8(bf16x8*kf,lds_cptr kp){
  kf[0]=*(const __attribute__((address_space(3))) bf16x8*)(kp);      kf[1]=*(const __attribute__((address_space(3))) bf16x8*)(kp+512);
  kf[2]=*(const __attribute__((address_space(3))) bf16x8*)(kp+2048); kf[3]=*(const __attribute__((address_space(3))) bf16x8*)(kp+2560);
  kf[4]=*(const __attribute__((address_space(3))) bf16x8*)(kp+4096); kf[5]=*(const __attribute__((address_space(3))) bf16x8*)(kp+4608);
  kf[6]=*(const __attribute__((address_space(3))) bf16x8*)(kp+6144); kf[7]=*(const __attribute__((address_space(3))) bf16x8*)(kp+6656);
}
__device__ __forceinline__ void kload2(bf16x8*kf,lds_cptr kp,int j){ kf[2*j]=*(const __attribute__((address_space(3))) bf16x8*)(kp+j*2048); kf[2*j+1]=*(const __attribute__((address_space(3))) bf16x8*)(kp+j*2048+512); }
__device__ __forceinline__ s16x4 vtr(lds_cptr p){ return __builtin_bit_cast(s16x4,__builtin_amdgcn_ds_read_tr16_b64_v4i16((__attribute__((address_space(3))) v4i16_t*)p)); }
__device__ __forceinline__ float rowmax(const f32x16&p0,const f32x16&p1){
  float a=max3f(p0[0],p0[1],p1[0]),b=max3f(p0[2],p0[3],p1[1]);a=max3f(a,p1[2],p1[3]);
  #pragma unroll
  for(int r=4;r<16;r+=4){a=max3f(a,p0[r],p0[r+1]);b=max3f(b,p0[r+2],p0[r+3]);a=max3f(a,p1[r],p1[r+1]);b=max3f(b,p1[r+2],p1[r+3]);}
  const float m=max2f(a,b);
  auto rr=__builtin_amdgcn_permlane32_swap(__float_as_uint(m),__float_as_uint(m),false,false);
  return max2f(__uint_as_float(rr[0]),__uint_as_float(rr[1]));
}
__device__ __forceinline__ void pv(f32x16*o,int vb,bf16x8 pa0,bf16x8 pa1,bf16x8 pa2,bf16x8 pa3){
  #pragma unroll
  for(int d0=0;d0<2;++d0){s16x4 lo[4],hi[4];
    #pragma unroll
    for(int ks=0;ks<4;++ks){
      asm volatile("ds_read_b64_tr_b16 %0,%1 offset:%c2":"=&v"(lo[ks]):"v"(vb),"i"(d0*4096+ks*1024):"memory");
      asm volatile("ds_read_b64_tr_b16 %0,%1 offset:%c2":"=&v"(hi[ks]):"v"(vb),"i"(d0*4096+ks*1024+512):"memory");}
    asm volatile("s_waitcnt lgkmcnt(0)":::"memory");SBAR();
    #define PK(k) (bf16x8){lo[k][0],lo[k][1],lo[k][2],lo[k][3],hi[k][0],hi[k][1],hi[k][2],hi[k][3]}
    o[d0]=__builtin_amdgcn_mfma_f32_32x32x16_bf16(pa0,PK(0),o[d0],0,0,0);
    o[d0]=__builtin_amdgcn_mfma_f32_32x32x16_bf16(pa1,PK(1),o[d0],0,0,0);
    o[d0]=__builtin_amdgcn_mfma_f32_32x32x16_bf16(pa2,PK(2),o[d0],0,0,0);
    o[d0]=__builtin_amdgcn_mfma_f32_32x32x16_bf16(pa3,PK(3),o[d0],0,0,0);
    #undef PK
  }
}

#ifndef ATTN_STORE16
#define ATTN_STORE16(p,v) (*(u32x4*)(p)=(v))
#endif
template<int THRL> __device__ __forceinline__ void attn_unit(int b,int h,int qb,const bf16*Q,const bf16*__restrict__ K,const bf16*__restrict__ V,bf16*O,const float*__restrict__ CKg,const float*__restrict__ KTm,const float*__restrict__ QBm,char*shm){
  const int tid=tid_l(),lane=tid&63,r32=lane&31,hi=lane>>5; const int wid=__builtin_amdgcn_readfirstlane(tid>>6);
  const long rowbase=(long)b*SEQ; const int q0=qb*QB;
  const bf16*Qw=Q+(rowbase+q0+wid*QBLK)*KVP+h*D;
  const float*ckg=CKg+(long)(b*NHEAD+h)*SEQ;
  int j0=0;
  { const int bh_=b*NHEAD+h, NT0_=(q0+QB)/KVBLK; const float qmx=QBm[bh_*NQB+qb]*1.01f;
    const float kd=fmaxf(fmaxf(KTm[bh_*64+4*qb],KTm[bh_*64+4*qb+1]),fmaxf(KTm[bh_*64+4*qb+2],KTm[bh_*64+4*qb+3]));
    const float thr=-(qmx*kd)-48.f; bool skip=false;
    if(lane<NT0_-4){ const float bound=qmx*KTm[bh_*64+lane]+(ckg[q0]-ckg[64*lane+63]); skip=bound<thr; }
    const unsigned long long m_=__ballot(skip); j0=__builtin_ctzll(~m_); j0=(j0<NT0_-4?j0:NT0_-4)&~1; j0=__builtin_amdgcn_readfirstlane(j0); }
  const bf16*Kh=K+(rowbase+(long)j0*KVBLK)*KVP+h*D,*Vh=V+(rowbase+(long)j0*KVBLK)*KVP+h*D;
  const unsigned lds0=(unsigned)(uintptr_t)shm;
  float*wsf=(float*)(shm+LDS_WS)+wid*64;
  const bf16*ksrc=Kh+(long)lane*KVP+wid*8;
  const bf16*vsrc=Vh+(long)(16*(wid&3)+(lane>>2))*KVP+(wid>>2)*32+(lane&3)*8;
  const unsigned kdst=lds0+LDS_K+wid*1024, vdst=lds0+LDS_V+wid*1024;
  #define DMA_K(t,slot) glds16(ksrc+(long)(t)*KVBLK*KVP,(unsigned)__builtin_amdgcn_readfirstlane(kdst+(slot)))
  #define DMA_V(t,slot) glds16(vsrc+(long)(t)*KVBLK*KVP,(unsigned)__builtin_amdgcn_readfirstlane(vdst+(slot)))
  const int vb0=(int)(lds0+LDS_V)+((lane>>4)&1)*32+(lane&3)*8+(4*hi+((lane&15)>>2))*64;
  const char*Kbase=shm+LDS_K; bf16x8 kf[8];
  const lds_cptr shm3=(lds_cptr)shm; const lds_cptr kp0=shm3+LDS_K+hi*1024+r32*16; const lds_cptr vp0=shm3+LDS_V+((lane>>4)&1)*32+(lane&3)*8+(4*hi+((lane&15)>>2))*64;
  const int NT=(q0+QB)/KVBLK-j0;
  float*cks=(float*)(shm+LDS_CK);
  for(int i=j0*KVBLK+tid*4;i<q0+QB;i+=NW*64*4){ *(f32x4_t*)(cks+i)=*(const f32x4_t*)(ckg+i); }
  float cqm=ckg[q0+wid*QBLK+r32];
  const lds_cptr ckp=(lds_cptr)shm+LDS_CK+j0*256+hi*16;
  DMA_K(0,0);DMA_V(0,0);DMA_K(1,SLOTB);
  bf16x8 qr[4];
  #pragma unroll
  for(int d0=0;d0<4;++d0)qr[d0]=*reinterpret_cast<const bf16x8*>(&Qw[(long)r32*KVP+d0*16+hi*8]);
  float l_reg=0.f;f32x16 o[2];o[0]=f32x16{};o[1]=f32x16{};
  #define CINIT(C0,C1,t) do{ const lds_cptr cp_=ckp+(t)*256; \
    _Pragma("unroll") for(int g_=0;g_<4;++g_){ const f32x4_t a_=*(const __attribute__((address_space(3))) f32x4_t*)(cp_+g_*32); const f32x4_t b_=*(const __attribute__((address_space(3))) f32x4_t*)(cp_+g_*32+128); \
      _Pragma("unroll") for(int i_=0;i_<4;++i_){ C0[g_*4+i_]=cqm-a_[i_]; C1[g_*4+i_]=cqm-b_[i_]; } } }while(0)
  const int qrel=wid*QBLK+r32;
  #define CMASK(P0,P1,t) do{int jb_=(t)-(NT-4); if(jb_>=0)cmask(P0,P1,jb_,qrel,hi);}while(0)
  bool resc=false;
  #define START(P0,P1) do{ const float rm=rowmax(P0,P1); resc=false; \
    { const float dl=rm; \
      _Pragma("unroll") for(int r=0;r<16;++r){P0[r]=fsub_s(P0[r],dl);P1[r]=fsub_s(P1[r],dl);} \
      cqm=fsub_s(cqm,dl); } \
    _Pragma("unroll") for(int r=0;r<16;++r)P0[r]=__builtin_amdgcn_exp2f(P0[r]); }while(0)
  #define RESC() do{ if(resc){ asm volatile("s_waitcnt lgkmcnt(0)":::"memory"); \
      _Pragma("unroll") for(int d_=0;d_<2;++d_) _Pragma("unroll") for(int r=0;r<16;++r)o[d_][r]*=wsf[crow(r,hi)]; } }while(0)
  f32x16 pA0,pA1,pB0,pB1;
  int sl_prev=0,sl_cur=0,sl_next=SLOTB;
  #define ROT() do{sl_prev=sl_cur;sl_cur=sl_next;sl_next=(sl_next==(NSLOT-1)*SLOTB)?0:sl_next+SLOTB;}while(0)
  DMA_K(2,2*SLOTB);
  WAIT_BAR(3);
  CINIT(pA0,pA1,0);
  qkt(pA0,pA1,Kbase,qr,r32,hi);asm volatile("s_nop 15\n\ts_nop 7":"+v"(pA0),"+v"(pA1));CMASK(pA0,pA1,0);
  START(pA0,pA1);
  _Pragma("unroll") for(int r=0;r<16;++r)pA1[r]=__builtin_amdgcn_exp2f(pA1[r]);
  WAIT_BAR(0);
  DMA_K(3,0);DMA_V(1,SLOTB);
  ROT();
  kload8(kf,kp0+sl_cur);
  WAIT_BAR(2);
  s16x4 vlo[8],vhi[8]; u32x4 pw0,pw1,pw2,pw3;
  #define PKW(P,B) cvtpk_s(P[B],P[B+1])
  #define PAF(k) __builtin_bit_cast(bf16x8,pw##k)
  #define VFR(i) (bf16x8){vlo[i][0],vlo[i][1],vlo[i][2],vlo[i][3],vhi[i][0],vhi[i][1],vhi[i][2],vhi[i][3]}
  #define PIN(x) asm volatile("":"+v"(x))
  #define MX3(a,b,c) __builtin_fmaxf(__builtin_fmaxf((a),(b)),(c))
  #define GAPA(MF,A0,A1,A2,A3,W0,W1,PW) do{ MF; sacc+=A0; sacc+=A1; sacc+=A2; sacc+=A3; PIN(sacc); W0; W1; PIN(PW); SBAR(); }while(0)
  #define EX(v) __builtin_amdgcn_exp2f(v)
  #define GAPB(MF,X,B) do{ MF; X[B]=EX(X[B]); X[B+1]=EX(X[B+1]); X[B+2]=EX(X[B+2]); X[B+3]=EX(X[B+3]); PIN(X); SBAR(); }while(0)
  #define VRD(i) do{ vlo[i]=vtr(vp_+(((i)>>2)*4096+((i)&3)*1024)); vhi[i]=vtr(vp_+(((i)>>2)*4096+((i)&3)*1024+512)); }while(0)
  #define KRD(G,j) do{ if(G){ kload2(kf,kp0+sl_next,j); SBAR(); } }while(0)
  #define STEP(C0,C1,P0,P1,t,GK,GV,GL) do{ SBAR(); \
    CINIT(C0,C1,t); SBAR(); \
    const lds_cptr vp_=vp0+sl_prev; \
    VRD(0); SBAR(); float sacc=(P0[0]+P0[1]); \
    GAPA(C0=__builtin_amdgcn_mfma_f32_32x32x16_bf16(kf[0],qr[0],C0,0,0,0), P0[2],P0[3],P0[4],P0[5],     pw0[0]=PKW(P0,0), pw0[1]=PKW(P0,2), pw0); \
    VRD(4); SBAR(); GAPA(C1=__builtin_amdgcn_mfma_f32_32x32x16_bf16(kf[1],qr[0],C1,0,0,0), P0[6],P0[7],P0[8],P0[9],     pw0[2]=PKW(P0,4), pw0[3]=PKW(P0,6), pw0); \
    VRD(1); SBAR(); GAPA(C0=__builtin_amdgcn_mfma_f32_32x32x16_bf16(kf[2],qr[1],C0,0,0,0),   P0[10],P0[11],P0[12],P0[13], pw1[0]=PKW(P0,8), pw1[1]=PKW(P0,10), pw1); \
    VRD(5); SBAR(); GAPA(C1=__builtin_amdgcn_mfma_f32_32x32x16_bf16(kf[3],qr[1],C1,0,0,0),   P0[14],P0[15],P1[0],P1[1],   pw1[2]=PKW(P0,12),pw1[3]=PKW(P0,14), pw1); \
    VRD(2); SBAR(); GAPA(C0=__builtin_amdgcn_mfma_f32_32x32x16_bf16(kf[4],qr[2],C0,0,0,0),   P1[2],P1[3],P1[4],P1[5],     pw2[0]=PKW(P1,0), pw2[1]=PKW(P1,2), pw2); \
    VRD(6); SBAR(); GAPA(C1=__builtin_amdgcn_mfma_f32_32x32x16_bf16(kf[5],qr[2],C1,0,0,0),   P1[6],P1[7],P1[8],P1[9],     pw2[2]=PKW(P1,4), pw2[3]=PKW(P1,6), pw2); \
    VRD(3); SBAR(); GAPA(C0=__builtin_amdgcn_mfma_f32_32x32x16_bf16(kf[6],qr[3],C0,0,0,0),   P1[10],P1[11],P1[12],P1[13], pw3[0]=PKW(P1,8), pw3[1]=PKW(P1,10), pw3); \
    VRD(7); SBAR(); GAPA(C1=__builtin_amdgcn_mfma_f32_32x32x16_bf16(kf[7],qr[3],C1,0,0,0),   P1[14],P1[15],0.f,0.f,       pw3[2]=PKW(P1,12),pw3[3]=PKW(P1,14), pw3); \
    l_reg+=sacc; \
    if(GK){DMA_K((t)+3,sl_cur);} if(GV){DMA_V((t)+1,sl_next);} \
    CMASK(C0,C1,t); \
    { float a=MX3(C0[0],C0[1],C1[0]),b=MX3(C0[2],C0[3],C1[1]); a=MX3(a,C1[2],C1[3]); \
      _Pragma("unroll") for(int r=4;r<16;r+=4){a=MX3(a,C0[r],C0[r+1]);b=MX3(b,C0[r+2],C0[r+3]);a=MX3(a,C1[r],C1[r+1]);b=MX3(b,C1[r+2],C1[r+3]);} \
      float rm=__builtin_fmaxf(a,b); { auto rr=__builtin_amdgcn_permlane32_swap(__float_as_uint(rm),__float_as_uint(rm),false,false); rm=__builtin_fmaxf(__uint_as_float(rr[0]),__uint_as_float(rr[1])); } \
      resc=false; \
      if(__builtin_expect(__any(rm>(float)THRL),0)){ const float dl=__builtin_fmaxf(rm,0.f); \
        _Pragma("unroll") for(int r=0;r<16;++r){C0[r]-=dl;C1[r]-=dl;} \
        cqm-=dl; \
        const float f=__builtin_amdgcn_exp2f(-dl); l_reg*=f; if(hi==0)wsf[r32]=f; resc=true; } } \
    SBAR(); \
    GAPB(o[0]=__builtin_amdgcn_mfma_f32_32x32x16_bf16(PAF(0),VFR(0),o[0],0,0,0), C0,0); \
    GAPB(o[1]=__builtin_amdgcn_mfma_f32_32x32x16_bf16(PAF(0),VFR(4),o[1],0,0,0), C0,4); \
    KRD(GL,0); GAPB(o[0]=__builtin_amdgcn_mfma_f32_32x32x16_bf16(PAF(1),VFR(1),o[0],0,0,0), C0,8); \
    KRD(GL,1); GAPB(o[1]=__builtin_amdgcn_mfma_f32_32x32x16_bf16(PAF(1),VFR(5),o[1],0,0,0), C0,12); \
    KRD(GL,2); GAPB(o[0]=__builtin_amdgcn_mfma_f32_32x32x16_bf16(PAF(2),VFR(2),o[0],0,0,0), C1,0); \
    KRD(GL,3); GAPB(o[1]=__builtin_amdgcn_mfma_f32_32x32x16_bf16(PAF(2),VFR(6),o[1],0,0,0), C1,4); \
    GAPB(o[0]=__builtin_amdgcn_mfma_f32_32x32x16_bf16(PAF(3),VFR(3),o[0],0,0,0), C1,8); \
    GAPB(o[1]=__builtin_amdgcn_mfma_f32_32x32x16_bf16(PAF(3),VFR(7),o[1],0,0,0), C1,12); \
    }while(0)
  int t=1;
  #undef CMASK
  #define CMASK(P0,P1,t) do{}while(0)
  for(;t+5<NT;t+=2){
    STEP(pB0,pB1,pA0,pA1,t,true,true,true);     WAIT_BAR(2); RESC(); ROT();
    STEP(pA0,pA1,pB0,pB1,t+1,true,true,true);   WAIT_BAR(2); RESC(); ROT();
  }
  #undef CMASK
  #define CMASK(P0,P1,t) do{int jb_=(t)-(NT-4); if(jb_>=0)cmask(P0,P1,jb_,qrel,hi);}while(0)
  #define ENDW(tt) do{ if((tt)+3<NT){WAIT_BAR(2);} else if((tt)+2<NT){WAIT_BAR(1);} else {WAIT_BAR(0);} }while(0)
  for(;t+1<NT;t+=2){
    STEP(pB0,pB1,pA0,pA1,t,(t+3<NT),(t+1<NT),(t+1<NT));       ENDW(t);   RESC(); ROT();
    STEP(pA0,pA1,pB0,pB1,t+1,(t+4<NT),(t+2<NT),(t+2<NT));     ENDW(t+1); RESC(); ROT();
  }
  STEP(pB0,pB1,pA0,pA1,NT-1,false,false,false); RESC();
  { float sacc=pB0[0]+pB0[1]; _Pragma("unroll") for(int r=2;r<16;++r)sacc+=pB0[r]; _Pragma("unroll") for(int r=0;r<16;++r)sacc+=pB1[r]; l_reg+=sacc;
    pw0=(u32x4){PKW(pB0,0),PKW(pB0,2),PKW(pB0,4),PKW(pB0,6)};pw1=(u32x4){PKW(pB0,8),PKW(pB0,10),PKW(pB0,12),PKW(pB0,14)};pw2=(u32x4){PKW(pB1,0),PKW(pB1,2),PKW(pB1,4),PKW(pB1,6)};pw3=(u32x4){PKW(pB1,8),PKW(pB1,10),PKW(pB1,12),PKW(pB1,14)};
    SBAR(); pv(o,vb0+sl_cur,PAF(0),PAF(1),PAF(2),PAF(3)); }
  #undef PKW
  #undef PAF
  #undef VFR
  #undef PIN
  #undef MX3
  #undef GAPA
  #undef GAPB
  #undef EX
  #undef VRD
  #undef KRD
  #undef STEP
  #undef ENDW
  {auto rr=__builtin_amdgcn_permlane32_swap(__float_as_uint(l_reg),__float_as_uint(l_reg),false,false);l_reg=__uint_as_float(rr[0])+__uint_as_float(rr[1]);}
  if(hi==0)wsf[32+r32]=l_reg;asm volatile("s_waitcnt lgkmcnt(0)":::"memory");
  float rli[16];
  #pragma unroll
  for(int r=0;r<16;++r)rli[r]=__builtin_amdgcn_rcpf(wsf[32+crow(r,hi)]);
  bf16*Ow=O+(rowbase+q0+wid*QBLK)*OP+h*D;
  { bf16*stg=(bf16*)(shm+LDS_OST)+wid*2048;
    #pragma unroll
    for(int r=0;r<16;++r){const int orow=crow(r,hi);
      #pragma unroll
      for(int d0=0;d0<2;++d0)stg[orow*64+d0*32+r32]=__float2bfloat16(o[d0][r]*rli[r]);}
    asm volatile("s_waitcnt lgkmcnt(0)":::"memory");
    #pragma unroll
    for(int i=0;i<4;++i){const int row=i*8+(lane>>3),ch=lane&7; const u32x4 v=*(const u32x4*)(stg+row*64+ch*8); ATTN_STORE16(Ow+(long)row*OP+ch*8,v);} }
  asm volatile("s_waitcnt lgkmcnt(0)\n\ts_barrier":::"memory");
  #undef DMA_K
  #undef DMA_V
  #undef CMASK
  #undef START
  #undef RESC
  #undef ROT
  #undef CINIT
}
constexpr int ATTN_LDS_BYTES=LDS_BYTES;
struct AttnTensors { const bf16* Q; const bf16* K; const bf16* V; bf16* O; const float* CK; const float* KT; const float* QB; };
struct AttnUnit { int bh; int qb; };
struct QueueOrder {
  unsigned* head; volatile __attribute__((address_space(3))) int* slot;
  __device__ __forceinline__ bool next(int,AttnUnit&u)const{
    if(tid_l()==0) *slot=(int)__hip_atomic_fetch_add(head,1u,__ATOMIC_RELAXED,__HIP_MEMORY_SCOPE_AGENT);
    __syncthreads(); const int v=*slot; __syncthreads();
    if(v>=BATCH*NHEAD*NQB)return false; u.qb=NQB-1-v/(BATCH*NHEAD); u.bh=v%(BATCH*NHEAD); return true; }
  __device__ __forceinline__ void a_ready(const AttnUnit&)const{}
  __device__ __forceinline__ void done(const AttnUnit&)const{}
};
template<class Sched,int THRL=8> __device__ __forceinline__ void attn_phase(char*lds,const AttnTensors&T,const Sched&S){
  AttnUnit u;
  for(int i=0;S.next(i,u);++i){ S.a_ready(u); attn_unit<THRL>(u.bh/NHEAD,u.bh%NHEAD,u.qb,T.Q,T.K,T.V,T.O,T.CK,T.KT,T.QB,lds); S.done(u); }
}
#undef SBAR
#undef WAIT_BAR
}

constexpr int NB = 8, SEQ = 4096, T = NB * SEQ, D = 1024, DEPTH = 4;
constexpr int HCOLS = 3072;
constexpr int HC_AVAL = 0, HC_AGATE = 256, HC_BQ = 512, HC_BK = 704, HC_BV = 896, HC_BG = 1280, HC_CQ = 1664, HC_CK = 2048, HC_CV = 2432, HC_LR = 2816, HC_CF = 2832;
constexpr int IN_COLS = 2838;
constexpr int MC_A = 0, MC_B = 256, MC_C = 640;
constexpr float LN_EPS = 1e-5f;
constexpr float ALPHA = 1.6817928305074292f;
constexpr float LOG2E = 1.4426950408889634f;
constexpr float C2 = 0.125f * LOG2E;
constexpr float GLA_QSCALE = 0.17677669529663687f;
constexpr int NEXP = 16384;

constexpr size_t MiB = 1u << 20;
constexpr size_t WS_CTL = 0, CTL_ZERO_BYTES = 1 * MiB;
constexpr size_t WS_WIN = 1 * MiB;
constexpr size_t WS_WOUT = WS_WIN + 24 * MiB;
constexpr size_t WS_WP = WS_WOUT + 8 * MiB;
constexpr size_t WS_PGW = WS_WP + 16 * MiB;
constexpr size_t WS_PW = WS_PGW + 8 * MiB;
constexpr size_t WS_CK = WS_PW + 2 * MiB;
constexpr size_t WS_FKT = WS_CK + 768 * 1024, WS_FQB = WS_FKT + 16 * 1024;
constexpr size_t WS_U = WS_CK + 1 * MiB;
constexpr size_t WS_V = WS_U + 32 * MiB;
constexpr size_t WS_XB = WS_V + 32 * MiB;
constexpr size_t WS_XF = WS_XB + 64 * MiB;
constexpr size_t WS_XQ = WS_XF, WS_XS = WS_XF + 32 * MiB, WS_RS = WS_XS + 1 * MiB, WS_VS = WS_RS + 65536;
constexpr size_t WS_PB = WS_XF + 128 * MiB;
constexpr size_t WS_H = WS_PB + 16 * MiB;
constexpr size_t WS_MIX = WS_H + 192 * MiB;
constexpr size_t WS_SC = WS_H;
constexpr size_t WS_Y = WS_MIX + 64 * MiB;
constexpr size_t WS_GCUM = WS_Y;
constexpr size_t WS_GS = WS_GCUM + 24 * MiB;
constexpr size_t WS_GDEC = WS_GS + 24 * MiB;
constexpr size_t WS_E = WS_Y + 128 * MiB;
constexpr size_t WS_EIDX = WS_E + 64 * MiB;
constexpr size_t WS_GATE = WS_EIDX + 16 * MiB;
constexpr size_t WS_SOFF = WS_GATE + 16 * MiB;
constexpr size_t WS_END = WS_SOFF + 1 * MiB;
static_assert(WS_END <= 1024 * MiB, "d_ws map");

constexpr int LDS_BYTES = 147456;

typedef unsigned short bf16;
typedef float f32x4 __attribute__((ext_vector_type(4)));
typedef unsigned u32x4 __attribute__((ext_vector_type(4)));
typedef unsigned u32x2 __attribute__((ext_vector_type(2)));

struct Params {
    const float *x, *p, *w_in, *conv_w, *conv_b, *conv_ln_g, *conv_ln_b, *gla_gate_w, *gla_gate_b, *gla_norm_g, *fox_forget_b, *w_out, *ln1_g, *ln1_b,
        *peer_wq, *peer_keys, *peer_u, *peer_v, *ple_w, *ple_gw, *ple_gb, *ln2_g, *ln2_b;
    float* out; unsigned char* ws;
};

__device__ __forceinline__ float bf2f(unsigned h) { return __uint_as_float(h << 16); }
__device__ __forceinline__ unsigned f2bf(float f) { unsigned u = __float_as_uint(f); return (u + 0x7fffu + ((u >> 16) & 1u)) >> 16; }
__device__ __forceinline__ unsigned pk2(float lo, float hi) { return f2bf(lo) | (f2bf(hi) << 16); }
__device__ __forceinline__ float wave_sum(float v) {
#pragma unroll
    for (int o = 1; o < 64; o <<= 1) v += __shfl_xor(v, o);
    return v;
}
__device__ __forceinline__ float log_sigmoid(float z) { return fminf(z, 0.f) - log1pf(__expf(-fabsf(z))); }
__device__ __forceinline__ float sigmoidf_(float z) { return 1.0f / (1.0f + __expf(-z)); }

struct MapIdent { __device__ __forceinline__ void operator()(int n, int& c, float& s) const { c = n; s = 1.f; } };
struct MapWin {
    __device__ __forceinline__ void operator()(int n, int& c, float& s) const {
        s = 1.f;
        if (n < HC_CQ) { c = n; if (n >= HC_BQ && n < HC_BK) s = GLA_QSCALE; }
        else if (n < HC_LR) { c = n + 16; if (n < HC_CK) s = C2; }
        else if (n < HC_CF) c = n - HC_LR + 1664;
        else if (n < IN_COLS) c = n;
        else c = -1;
    }
};
template <class CM>
__device__ __forceinline__ void transpose_item(const float* W, int K, int Nsrc, bf16* WT, int item, int nblk, float* scr, int lane, const CM& cm) {
    const int kb = item / nblk, nb = item % nblk, k0 = 64 * kb, n0 = 32 * nb;
    int sc; float scale; cm(n0 + (lane & 31), sc, scale);
#pragma unroll
    for (int i = 0; i < 32; ++i) { const int kk = 2 * i + (lane >> 5); scr[kk * 33 + (lane & 31)] = sc >= 0 ? W[(size_t)(k0 + kk) * Nsrc + sc] * scale : 0.f; }
    __builtin_amdgcn_wave_barrier(); asm volatile("s_waitcnt lgkmcnt(0)" ::: "memory");
    const int c = lane & 7;
#pragma unroll
    for (int j = 0; j < 4; ++j) { const int n = (lane >> 3) + 8 * j; const float* s = scr + (8 * c) * 33 + n;
        u32x4 o; o.x = pk2(s[0 * 33], s[1 * 33]); o.y = pk2(s[2 * 33], s[3 * 33]); o.z = pk2(s[4 * 33], s[5 * 33]); o.w = pk2(s[6 * 33], s[7 * 33]);
        *(u32x4*)(WT + (size_t)(n0 + n) * K + k0 + 8 * c) = o; }
    asm volatile("s_waitcnt lgkmcnt(0)" ::: "memory"); __builtin_amdgcn_wave_barrier();
}
__device__ __forceinline__ void cvt_bf16_stream(const float* src, bf16* dst, size_t n8, size_t gtid, size_t gthreads) {
    for (size_t i = gtid; i < n8; i += gthreads) { const f32x4 a = *(const f32x4*)(src + i * 8), b = *(const f32x4*)(src + i * 8 + 4);
        u32x4 o; o.x = pk2(a[0], a[1]); o.y = pk2(a[2], a[3]); o.z = pk2(b[0], b[1]); o.w = pk2(b[2], b[3]); *(u32x4*)(dst + i * 8) = o; }
}

__device__ __forceinline__ void phase_pro_a(const Params& p, unsigned char* lds) {
    const int tid = tid_l(), lane = tid & 63, wave = tid >> 6;
    float* scr = (float*)(lds + wave * 16384);
    const int gw = bid_l() * 8 + wave, NGW = grid_l() * 8;
    constexpr int I_WIN = (D / 64) * (HCOLS / 32), I_SQ = (D / 64) * (D / 32), I_PW = (256 / 64) * (D / 32);
    constexpr int PER_L = I_WIN + 2 * I_SQ + I_PW;
    for (int it = gw; it < DEPTH * PER_L; it += NGW) {
        const int l = it / PER_L; int r = it % PER_L;
        if (r < I_WIN) { transpose_item(p.w_in + (size_t)l * D * IN_COLS, D, IN_COLS, (bf16*)(p.ws + WS_WIN) + (size_t)l * HCOLS * D, r, HCOLS / 32, scr, lane, MapWin()); continue; } r -= I_WIN;
        if (r < I_SQ) { transpose_item(p.w_out + (size_t)l * D * D, D, D, (bf16*)(p.ws + WS_WOUT) + (size_t)l * D * D, r, D / 32, scr, lane, MapIdent()); continue; } r -= I_SQ;
        if (r < I_SQ) { transpose_item(p.ple_gw + (size_t)l * D * D, D, D, (bf16*)(p.ws + WS_PGW) + (size_t)l * D * D, r, D / 32, scr, lane, MapIdent()); continue; } r -= I_SQ;
        transpose_item(p.ple_w + (size_t)l * 256 * D, 256, D, (bf16*)(p.ws + WS_PW) + (size_t)l * D * 256, r, D / 32, scr, lane, MapIdent());
    }
    cvt_bf16_stream(p.x, (bf16*)(p.ws + WS_XB), (size_t)T * D / 8, (size_t)bid_l() * 512 + tid, (size_t)grid_l() * 512);
}
__device__ __forceinline__ void phase_pro_b(const Params& p, unsigned char* lds) {
    const int tid = tid_l();
    constexpr int PB = 132;
    float* ks = (float*)lds;
    float* wqs = ks + 128 * PB;
    for (int it = bid_l(); it < DEPTH * 16 * 16; it += grid_l()) {
        const int l = it >> 8, hc = (it >> 4) & 15, kt = it & 15;
        const float* keys = p.peer_keys + ((size_t)l * 16 + hc) * 16384;
        const float* wq = p.peer_wq + (size_t)l * D * 2048 + (size_t)(kt * 64) * 2048 + hc * 128;
        __syncthreads();
        for (int i = tid; i < 128 * 32; i += 512) *(f32x4*)(ks + (i >> 5) * PB + (i & 31) * 4) = *(const f32x4*)(keys + (size_t)i * 4);
        for (int i = tid; i < 64 * 32; i += 512) *(f32x4*)(wqs + (i >> 5) * PB + (i & 31) * 4) = *(const f32x4*)(wq + (size_t)(i >> 5) * 2048 + (i & 31) * 4);
        __syncthreads();
        const int kq = tid & 15, nq = tid >> 4;
        float acc[4][4];
#pragma unroll
        for (int i = 0; i < 4; ++i)
#pragma unroll
            for (int j = 0; j < 4; ++j) acc[i][j] = 0.f;
#pragma unroll 2
        for (int d = 0; d < 128; d += 4) { f32x4 a[4], b[4];
#pragma unroll
            for (int i = 0; i < 4; ++i) { a[i] = *(const f32x4*)(wqs + (kq + 16 * i) * PB + d); b[i] = *(const f32x4*)(ks + (nq + 32 * i) * PB + d); }
#pragma unroll
            for (int i = 0; i < 4; ++i)
#pragma unroll
                for (int j = 0; j < 4; ++j) acc[i][j] += (a[i][0] * b[j][0] + a[i][1] * b[j][1]) + (a[i][2] * b[j][2] + a[i][3] * b[j][3]); }
        bf16* WpT = (bf16*)(p.ws + WS_WP) + (size_t)l * 2048 * D;
#pragma unroll
        for (int i = 0; i < 4; ++i)
#pragma unroll
            for (int j = 0; j < 4; ++j) WpT[(size_t)(hc * 128 + nq + 32 * j) * D + kt * 64 + kq + 16 * i] = (bf16)f2bf(acc[i][j]);
    }
}
constexpr float U8_SCALE = 64.f, V8_SCALE = 1.f;
typedef float f32x2v __attribute__((ext_vector_type(2)));
__device__ __forceinline__ unsigned pk_fp8x4(f32x4 v, float sc) {
    const float a = fminf(fmaxf(v[0] * sc, -448.f), 448.f), b = fminf(fmaxf(v[1] * sc, -448.f), 448.f), c = fminf(fmaxf(v[2] * sc, -448.f), 448.f), d = fminf(fmaxf(v[3] * sc, -448.f), 448.f);
    int w = __builtin_amdgcn_cvt_pk_fp8_f32(a, b, 0, false); w = __builtin_amdgcn_cvt_pk_fp8_f32(c, d, w, true); return (unsigned)w;
}
__device__ __forceinline__ void cvt_fp8_stream(const float* src, unsigned char* dst, size_t n16, float sc, size_t gtid, size_t gthreads) {
    for (size_t i = gtid; i < n16; i += gthreads) { const float* s = src + i * 16; u32x4 o;
        o.x = pk_fp8x4(*(const f32x4*)(s), sc); o.y = pk_fp8x4(*(const f32x4*)(s + 4), sc); o.z = pk_fp8x4(*(const f32x4*)(s + 8), sc); o.w = pk_fp8x4(*(const f32x4*)(s + 12), sc);
        *(u32x4*)(dst + i * 16) = o; }
}
__device__ __forceinline__ float wave_max(float v) {
#pragma unroll
    for (int o = 32; o > 0; o >>= 1) v = fmaxf(v, __shfl_xor(v, o));
    return v;
}
__device__ __forceinline__ unsigned pk_i8x4(f32x4 v, float sc) {
    const int a = (int)__builtin_rintf(v[0] * sc), b = (int)__builtin_rintf(v[1] * sc), c = (int)__builtin_rintf(v[2] * sc), d = (int)__builtin_rintf(v[3] * sc);
    return (unsigned)(a & 255) | ((unsigned)(b & 255) << 8) | ((unsigned)(c & 255) << 16) | ((unsigned)d << 24);
}
__device__ __forceinline__ void cvt_i8_rows(const float* src, unsigned char* dst, float* RS, size_t n16, size_t gtid, size_t gthreads) {
    for (size_t i = gtid; i < n16; i += gthreads) { const float* s_ = src + i * 16;
        const f32x4 a = *(const f32x4*)(s_), b = *(const f32x4*)(s_ + 4), c = *(const f32x4*)(s_ + 8), d = *(const f32x4*)(s_ + 12);
        float m = fmaxf(fmaxf(fmaxf(fabsf(a[0]), fabsf(a[1])), fmaxf(fabsf(a[2]), fabsf(a[3]))), fmaxf(fmaxf(fabsf(b[0]), fabsf(b[1])), fmaxf(fabsf(b[2]), fabsf(b[3]))));
        m = fmaxf(m, fmaxf(fmaxf(fmaxf(fabsf(c[0]), fabsf(c[1])), fmaxf(fabsf(c[2]), fabsf(c[3]))), fmaxf(fmaxf(fabsf(d[0]), fabsf(d[1])), fmaxf(fabsf(d[2]), fabsf(d[3])))));
        m = wave_max(m); const float sc = m > 0.f ? 127.0f / m : 0.f;
        u32x4 o; o.x = pk_i8x4(a, sc); o.y = pk_i8x4(b, sc); o.z = pk_i8x4(c, sc); o.w = pk_i8x4(d, sc);
        *(u32x4*)(dst + i * 16) = o;
        if ((i & 63) == 0) RS[i >> 6] = m * (1.0f / 127.0f); }
}
__device__ __forceinline__ unsigned pk_i4x8(f32x4 a, f32x4 b, float sc) {
    unsigned w = 0u;
#pragma unroll
    for (int i = 0; i < 4; ++i) { w |= ((unsigned)(int)__builtin_rintf(a[i] * sc) & 15u) << (4 * i); w |= ((unsigned)(int)__builtin_rintf(b[i] * sc) & 15u) << (16 + 4 * i); }
    return w;
}
__device__ __forceinline__ void cvt_i4_rows(const float* src, unsigned char* dst, float* RS, size_t n16, size_t gtid, size_t gthreads) {
    for (size_t i = gtid; i < n16; i += gthreads) { const float* s_ = src + i * 16;
        const f32x4 a = *(const f32x4*)(s_), b = *(const f32x4*)(s_ + 4), c = *(const f32x4*)(s_ + 8), d = *(const f32x4*)(s_ + 12);
        float m = fmaxf(fmaxf(fmaxf(fabsf(a[0]), fabsf(a[1])), fmaxf(fabsf(a[2]), fabsf(a[3]))), fmaxf(fmaxf(fabsf(b[0]), fabsf(b[1])), fmaxf(fabsf(b[2]), fabsf(b[3]))));
        m = fmaxf(m, fmaxf(fmaxf(fmaxf(fabsf(c[0]), fabsf(c[1])), fmaxf(fabsf(c[2]), fabsf(c[3]))), fmaxf(fmaxf(fabsf(d[0]), fabsf(d[1])), fmaxf(fabsf(d[2]), fabsf(d[3])))));
        m = wave_max(m); const float sc = m > 0.f ? 7.49f / m : 0.f;
        u32x2 o; o.x = pk_i4x8(a, b, sc); o.y = pk_i4x8(c, d, sc); *(u32x2*)(dst + i * 8) = o;
        if ((i & 63) == 0) RS[i >> 6] = m * (1.0f / 7.49f); }
}
__device__ __forceinline__ void cvt_fp4_rows(const float* src, unsigned char* dst, float* VS, size_t n16, size_t gtid, size_t gthreads) {
    for (size_t i = gtid; i < n16; i += gthreads) { const float* s_ = src + i * 16;
        const f32x4 a = *(const f32x4*)(s_), b = *(const f32x4*)(s_ + 4), c = *(const f32x4*)(s_ + 8), d = *(const f32x4*)(s_ + 12);
        float m = fmaxf(fmaxf(fmaxf(fabsf(a[0]), fabsf(a[1])), fmaxf(fabsf(a[2]), fabsf(a[3]))), fmaxf(fmaxf(fabsf(b[0]), fabsf(b[1])), fmaxf(fabsf(b[2]), fabsf(b[3]))));
        m = fmaxf(m, fmaxf(fmaxf(fmaxf(fabsf(c[0]), fabsf(c[1])), fmaxf(fabsf(c[2]), fabsf(c[3]))), fmaxf(fmaxf(fabsf(d[0]), fabsf(d[1])), fmaxf(fabsf(d[2]), fabsf(d[3])))));
        m = wave_max(m); const float sc = m > 0.f ? 6.0f / m : 0.f;
        unsigned w0 = 0u, w1 = 0u;
        w0 = __builtin_amdgcn_cvt_scalef32_pk_fp4_f32(w0, a[0] * sc, a[1] * sc, 1.0f, 0); w0 = __builtin_amdgcn_cvt_scalef32_pk_fp4_f32(w0, a[2] * sc, a[3] * sc, 1.0f, 1);
        w0 = __builtin_amdgcn_cvt_scalef32_pk_fp4_f32(w0, b[0] * sc, b[1] * sc, 1.0f, 2); w0 = __builtin_amdgcn_cvt_scalef32_pk_fp4_f32(w0, b[2] * sc, b[3] * sc, 1.0f, 3);
        w1 = __builtin_amdgcn_cvt_scalef32_pk_fp4_f32(w1, c[0] * sc, c[1] * sc, 1.0f, 0); w1 = __builtin_amdgcn_cvt_scalef32_pk_fp4_f32(w1, c[2] * sc, c[3] * sc, 1.0f, 1);
        w1 = __builtin_amdgcn_cvt_scalef32_pk_fp4_f32(w1, d[0] * sc, d[1] * sc, 1.0f, 2); w1 = __builtin_amdgcn_cvt_scalef32_pk_fp4_f32(w1, d[2] * sc, d[3] * sc, 1.0f, 3);
        u32x2 o; o.x = w0; o.y = w1; *(u32x2*)(dst + i * 8) = o;
        if ((i & 63) == 0) VS[i >> 6] = m * (1.0f / 6.0f); }
}
__device__ __forceinline__ void phase_cvt(const Params& p, int l) {
    const size_t gtid = (size_t)bid_l() * 512 + tid_l(), gth = (size_t)grid_l() * 512;
    cvt_bf16_stream(p.p + (size_t)l * T * 256, (bf16*)(p.ws + WS_PB), (size_t)T * 256 / 8, gtid, gth);
    cvt_i4_rows(p.peer_u + (size_t)l * NEXP * D, p.ws + WS_U, (float*)(p.ws + WS_RS), (size_t)NEXP * D / 16, gtid, gth);
    cvt_fp4_rows(p.peer_v + (size_t)l * NEXP * D, p.ws + WS_V, (float*)(p.ws + WS_VS), (size_t)NEXP * D / 16, gtid, gth);
}

#define GEMM_RUN(EPI, e, Aptr, Bptr, N_, K_) do { int kk_ = (K_); asm volatile("" : "+s"(kk_)); pg8::Gemm g{(const pg8::bf16_t*)(Aptr), (const pg8::bf16_t*)(Bptr), T, (N_), kk_}; pg8::StaticOrder S; S.init(T, (N_), (int)grid_l(), (int)bid_l()); \
    pg8::gemm_phase<EPI, pg8::StaticOrder, true, true>((PG8_LAS unsigned char*)lds, g, S, e); } while (0)

__device__ __forceinline__ void phase_gemm_in(const Params& p, int l, unsigned char* lds) {
    pg8::EpiBf16<0> e{(pg8::bf16_t*)(p.ws + WS_H), HCOLS, nullptr, 0, 0, 1.f};
    GEMM_RUN(pg8::EpiBf16<0>, e, p.ws + WS_XB, (bf16*)(p.ws + WS_WIN) + (size_t)l * HCOLS * D, HCOLS, D);
}
__device__ __forceinline__ void phase_gemm_e(const Params& p, int l, unsigned char* lds) {
    pg8::EpiBf16<0> e{(pg8::bf16_t*)(p.ws + WS_E), D, nullptr, 0, 0, 1.f};
    GEMM_RUN(pg8::EpiBf16<0>, e, p.ws + WS_PB, (bf16*)(p.ws + WS_PW) + (size_t)l * D * 256, D, 256);
}
__device__ __forceinline__ void phase_gemm_out(const Params& p, int l, unsigned char* lds) {
    pg8::EpiResid e{(const pg8::bf16_t*)(p.ws + WS_XB), (_Float16*)(p.ws + WS_Y), D, ALPHA};
    GEMM_RUN(pg8::EpiResid, e, p.ws + WS_MIX, (bf16*)(p.ws + WS_WOUT) + (size_t)l * D * D, D, D);
}
__device__ __forceinline__ void phase_gemm_sc(const Params& p, int l, unsigned char* lds) {
    pg8::EpiF16 e{(_Float16*)(p.ws + WS_SC), 2048};
    GEMM_RUN(pg8::EpiF16, e, p.ws + WS_XB, (bf16*)(p.ws + WS_WP) + (size_t)l * 2048 * D, 2048, D);
}
__device__ __forceinline__ void phase_gemm_ple(const Params& p, int l, unsigned char* lds) {
    pg8::EpiPle e{(const pg8::bf16_t*)(p.ws + WS_XB), (_Float16*)(p.ws + WS_Y), (const pg8::bf16_t*)(p.ws + WS_E), p.ple_gb + (size_t)l * D, D};
    GEMM_RUN(pg8::EpiPle, e, p.ws + WS_XB, (bf16*)(p.ws + WS_PGW) + (size_t)l * D * D, D, D);
}

__device__ __forceinline__ void phase_conv(const Params& p, int l, unsigned char* lds) {
    const int tid = tid_l(), lane = tid & 63, wave = tid >> 6;
    float* U = (float*)lds;
    float* Yt = U + 62 * 256;
    const bf16* H = (const bf16*)(p.ws + WS_H); bf16* MIX = (bf16*)(p.ws + WS_MIX);
    const float* cw = p.conv_w + (size_t)l * 31 * 256; const float* cb = p.conv_b + l * 256;
    const float* lg = p.conv_ln_g + l * 256; const float* lb = p.conv_ln_b + l * 256;
    for (int it = bid_l(); it < T / 32; it += grid_l()) {
        const int b = it / (SEQ / 32), t0 = (it % (SEQ / 32)) * 32;
        __syncthreads();
        for (int i = tid; i < 62 * 32; i += 512) { const int r = i >> 5, c8 = (i & 31) * 8, t = t0 - 30 + r; f32x4 u0 = {0.f, 0.f, 0.f, 0.f}, u1 = {0.f, 0.f, 0.f, 0.f};
            if (t >= 0) { const bf16* hr = H + (size_t)(b * SEQ + t) * HCOLS; const u32x4 av = *(const u32x4*)(hr + HC_AVAL + c8), gv = *(const u32x4*)(hr + HC_AGATE + c8);
#pragma unroll
                for (int j = 0; j < 2; ++j) { u0[2 * j] = bf2f(av[j] & 0xffffu) * sigmoidf_(bf2f(gv[j] & 0xffffu)); u0[2 * j + 1] = __uint_as_float(av[j] & 0xffff0000u) * sigmoidf_(__uint_as_float(gv[j] & 0xffff0000u));
                                              u1[2 * j] = bf2f(av[2 + j] & 0xffffu) * sigmoidf_(bf2f(gv[2 + j] & 0xffffu)); u1[2 * j + 1] = __uint_as_float(av[2 + j] & 0xffff0000u) * sigmoidf_(__uint_as_float(gv[2 + j] & 0xffff0000u)); } }
            *(f32x4*)(U + r * 256 + c8) = u0; *(f32x4*)(U + r * 256 + c8 + 4) = u1; }
        __syncthreads();
        { const int c = tid & 255, half = tid >> 8; float w[31], win[46];
#pragma unroll
          for (int j = 0; j < 31; ++j) w[j] = cw[j * 256 + c];
#pragma unroll
          for (int j = 0; j < 46; ++j) win[j] = U[(half * 16 + j) * 256 + c];
          const float bias = cb[c];
#pragma unroll
          for (int tl = 0; tl < 16; ++tl) { float y = bias;
#pragma unroll
              for (int j = 0; j < 31; ++j) y += w[j] * win[tl + j];
              Yt[(half * 16 + tl) * 256 + c] = y; } }
        __syncthreads();
        for (int tl = wave * 4; tl < wave * 4 + 4; ++tl) {
            const f32x4 v = *(const f32x4*)(Yt + tl * 256 + lane * 4);
            const float mean = wave_sum((v[0] + v[1]) + (v[2] + v[3])) * (1.f / 256.f);
            const f32x4 d = v - mean; const float var = wave_sum((d[0] * d[0] + d[1] * d[1]) + (d[2] * d[2] + d[3] * d[3])) * (1.f / 256.f);
            const float rstd = 1.0f / sqrtf(var + LN_EPS);
            const f32x4 g4 = *(const f32x4*)(lg + lane * 4), b4 = *(const f32x4*)(lb + lane * 4);
            float o[4];
#pragma unroll
            for (int i = 0; i < 4; ++i) { const float z = d[i] * rstd * g4[i] + b4[i]; o[i] = z * sigmoidf_(z); }
            u32x2 w2; w2.x = pk2(o[0], o[1]); w2.y = pk2(o[2], o[3]);
            *(u32x2*)(MIX + (size_t)(b * SEQ + t0 + tl) * D + MC_A + lane * 4) = w2;
        }
    }
}

__device__ __forceinline__ void phase_fox_cum(const Params& p, int l, unsigned char* lds) {
    const int tid = tid_l(), lane = tid & 63, wave = tid >> 6;
    float* wsum = (float*)lds;
    const bf16* H = (const bf16*)(p.ws + WS_H); float* CK = (float*)(p.ws + WS_CK);
    for (int bh = bid_l(); bh < 48; bh += grid_l()) {
        const int b = bh / 6, h = bh % 6; const float bias = p.fox_forget_b[l * 6 + h];
        float v[8]; float s = 0.f;
#pragma unroll
        for (int i = 0; i < 8; ++i) { const float f = bf2f(H[(size_t)(b * SEQ + tid * 8 + i) * HCOLS + HC_CF + h]); s += log_sigmoid(f + bias) * LOG2E; v[i] = s; }
        float incl = s;
#pragma unroll
        for (int o = 1; o < 64; o <<= 1) { const float n = __shfl_up(incl, o); if (lane >= o) incl += n; }
        __syncthreads();
        if (lane == 63) wsum[wave] = incl;
        __syncthreads();
        float base = incl - s;
        for (int w = 0; w < wave; ++w) base += wsum[w];
#pragma unroll
        for (int i = 0; i < 8; ++i) CK[(size_t)bh * SEQ + tid * 8 + i] = base + v[i];
    }
}

__device__ __forceinline__ void phase_fox_norm(const Params& p, unsigned char* lds) {
    const int tid = tid_l(), lane = tid & 63, wave = tid >> 6;
    float* qns = (float*)lds; float* kns = qns + 256;
    const bf16* H = (const bf16*)(p.ws + WS_H); float* KT = (float*)(p.ws + WS_FKT); float* QBM = (float*)(p.ws + WS_FQB);
    for (int it = bid_l(); it < 48 * 16; it += grid_l()) {
        const int bh = it >> 4, qb = it & 15, b = bh / 6, h = bh % 6;
        __syncthreads();
        if (tid < 256) { const bf16* row = H + ((size_t)b * SEQ + qb * 256 + tid) * HCOLS + h * 64; float sq = 0.f, sk = 0.f;
#pragma unroll
            for (int j = 0; j < 8; ++j) { const u32x4 qv = *(const u32x4*)(row + HC_CQ + 8 * j), kv = *(const u32x4*)(row + HC_CK + 8 * j);
#pragma unroll
                for (int i = 0; i < 4; ++i) { const float a0 = bf2f(qv[i] & 0xffffu), a1 = __uint_as_float(qv[i] & 0xffff0000u), b0 = bf2f(kv[i] & 0xffffu), b1 = __uint_as_float(kv[i] & 0xffff0000u);
                    sq += a0 * a0 + a1 * a1; sk += b0 * b0 + b1 * b1; } }
            qns[tid] = sqrtf(sq); kns[tid] = sqrtf(sk); }
        __syncthreads();
        if (wave < 5) { float v = wave < 4 ? kns[wave * 64 + lane] : fmaxf(fmaxf(qns[lane], qns[64 + lane]), fmaxf(qns[128 + lane], qns[192 + lane]));
#pragma unroll
            for (int o = 1; o < 64; o <<= 1) v = fmaxf(v, __shfl_xor(v, o));
            if (lane == 0) { if (wave < 4) KT[bh * 64 + 4 * qb + wave] = v; else QBM[bh * 16 + qb] = v; } }
    }
}

typedef short bf16x8_t __attribute__((ext_vector_type(8)));
typedef float f32x16_t __attribute__((ext_vector_type(16)));
__device__ __forceinline__ int crow32(int r, int hi) { return (r & 3) + 8 * (r >> 2) + 4 * hi; }
struct GlaB1Pre { u32x4 vv, lr0, lr1; u32x2 kk; float w2v, b2v; };
__device__ __forceinline__ GlaB1Pre gla_b1_load(const Params& p, int l, int it, int tid, int lane, int wave) {
    const int bh = it >> 6, n = it & 63, b = bh / 6, h = bh % 6; const size_t tok0 = (size_t)b * SEQ + n * 64; const bf16* H = (const bf16*)(p.ws + WS_H);
    GlaB1Pre r; r.w2v = p.gla_gate_w[(size_t)l * 16 * 192 + (tid >> 5) * 192 + h * 32 + (tid & 31)]; r.b2v = p.gla_gate_b[l * 192 + h * 32 + (tid & 31)];
    r.vv = *(const u32x4*)(H + (tok0 + (tid >> 3)) * HCOLS + HC_BV + h * 64 + (tid & 7) * 8);
    r.lr0 = *(const u32x4*)(H + (tok0 + lane) * HCOLS + HC_LR); r.lr1 = *(const u32x4*)(H + (tok0 + lane) * HCOLS + HC_LR + 8);
    r.kk = *(const u32x2*)(H + (tok0 + lane) * HCOLS + HC_BK + h * 32 + wave * 4);
    return r;
}
__device__ __forceinline__ void phase_gla_b1(const Params& p, int l, unsigned char* lds) {
    const int tid = tid_l(), lane = tid & 63, wave = tid >> 6, r32 = lane & 31, hi = lane >> 5;
    bf16* KDT = (bf16*)lds;
    bf16* VT = KDT + 32 * 72;
    float* w2s = (float*)(VT + 64 * 72);
    float* b2s = w2s + 16 * 32;
    float* GCUM = (float*)(p.ws + WS_GCUM); float* GS = (float*)(p.ws + WS_GS); float* GDEC = (float*)(p.ws + WS_GDEC);
    const int NI = 48 * 64, G = grid_l(); int it = bid_l();
    if (it >= NI) return;
    GlaB1Pre cur = gla_b1_load(p, l, it, tid, lane, wave);
#pragma unroll 1
    for (; it < NI; it += G) {
        const GlaB1Pre nxt = gla_b1_load(p, l, it + G < NI ? it + G : it, tid, lane, wave);
        __builtin_amdgcn_sched_barrier(0);
        const int bh = it >> 6, n = it & 63, b = bh / 6, h = bh % 6; const size_t tok0 = (size_t)b * SEQ + n * 64;
        __syncthreads();
        w2s[tid] = cur.w2v;
        if (tid < 32) b2s[tid] = cur.b2v;
        { const int s_ = tid >> 3, e0 = (tid & 7) * 8;
#pragma unroll
          for (int i = 0; i < 4; ++i) { VT[(e0 + 2 * i) * 72 + s_] = (bf16)(cur.vv[i] & 0xffffu); VT[(e0 + 2 * i + 1) * 72 + s_] = (bf16)(cur.vv[i] >> 16); } }
        const int d0 = wave * 4;
        __syncthreads();
        float lrf[16];
#pragma unroll
        for (int i = 0; i < 4; ++i) { lrf[2 * i] = bf2f(cur.lr0[i] & 0xffffu); lrf[2 * i + 1] = __uint_as_float(cur.lr0[i] & 0xffff0000u); lrf[8 + 2 * i] = bf2f(cur.lr1[i] & 0xffffu); lrf[8 + 2 * i + 1] = __uint_as_float(cur.lr1[i] & 0xffff0000u); }
        float g[4];
#pragma unroll
        for (int dd = 0; dd < 4; ++dd) { float x = b2s[d0 + dd];
#pragma unroll
            for (int r = 0; r < 16; ++r) x += lrf[r] * w2s[r * 32 + d0 + dd];
            g[dd] = log_sigmoid(x) * (1.0f / 16.0f); }
#pragma unroll
        for (int o = 1; o < 64; o <<= 1)
#pragma unroll
            for (int dd = 0; dd < 4; ++dd) { const float v = __shfl_up(g[dd], o); if (lane >= o) g[dd] += v; }
        *(f32x4*)(GCUM + (tok0 + lane) * 192 + h * 32 + d0) = (f32x4){g[0], g[1], g[2], g[3]};
        const float kf[4] = {bf2f(cur.kk.x & 0xffffu), __uint_as_float(cur.kk.x & 0xffff0000u), bf2f(cur.kk.y & 0xffffu), __uint_as_float(cur.kk.y & 0xffff0000u)};
#pragma unroll
        for (int dd = 0; dd < 4; ++dd) { const float last = __uint_as_float(__builtin_amdgcn_readlane(__float_as_uint(g[dd]), 63));
            KDT[(d0 + dd) * 72 + lane] = (bf16)f2bf(kf[dd] * __expf(last - g[dd]));
            if (lane == 63) GDEC[(size_t)it * 32 + d0 + dd] = __expf(last); }
        __syncthreads();
        if (wave < 2) {
            f32x16_t acc = {};
#pragma unroll
            for (int ks = 0; ks < 4; ++ks) { const bf16x8_t a = *(const bf16x8_t*)(KDT + r32 * 72 + 16 * ks + 8 * hi), bb = *(const bf16x8_t*)(VT + (32 * wave + r32) * 72 + 16 * ks + 8 * hi);
                acc = __builtin_amdgcn_mfma_f32_32x32x16_bf16(a, bb, acc, 0, 0, 0); }
#pragma unroll
            for (int r = 0; r < 16; ++r) GS[(size_t)it * 2048 + crow32(r, hi) * 64 + 32 * wave + r32] = acc[r];
        }
        cur = nxt;
    }
}
__device__ __forceinline__ void phase_gla_b2(const Params& p) {
    float* GS = (float*)(p.ws + WS_GS); const float* GDEC = (const float*)(p.ws + WS_GDEC);
    for (int g = bid_l() * 512 + tid_l(); g < 48 * 2048; g += grid_l() * 512) {
        const int bh = g >> 11, de = g & 2047, d = de >> 6; float S = 0.f;
        float* gs = GS + (size_t)bh * 64 * 2048 + de; const float* gd = GDEC + (size_t)bh * 64 * 32 + d;
#pragma unroll 1
        for (int n0 = 0; n0 < 64; n0 += 16) { float loc[16], dec[16];
#pragma unroll
            for (int i = 0; i < 16; ++i) { loc[i] = gs[(size_t)(n0 + i) * 2048]; dec[i] = gd[(n0 + i) * 32]; }
#pragma unroll
            for (int i = 0; i < 16; ++i) { gs[(size_t)(n0 + i) * 2048] = S; S = S * dec[i] + loc[i]; } }
    }
}
struct GlaB3Pre { u32x2 qq, kk; f32x4 c; u32x4 vv; f32x4 sv; u32x4 gr; };
__device__ __forceinline__ GlaB3Pre gla_b3_load(const Params& p, int it, int tid) {
    const int bh = it >> 6, n = it & 63, b = bh / 6, h = bh % 6; const size_t tok0 = (size_t)b * SEQ + n * 64; const bf16* H = (const bf16*)(p.ws + WS_H);
    const float* GCUM = (const float*)(p.ws + WS_GCUM); const float* GS = (const float*)(p.ws + WS_GS);
    GlaB3Pre r; const int t = tid >> 3, d0 = (tid & 7) * 4;
    r.qq = *(const u32x2*)(H + (tok0 + t) * HCOLS + HC_BQ + h * 32 + d0); r.kk = *(const u32x2*)(H + (tok0 + t) * HCOLS + HC_BK + h * 32 + d0);
    r.c = *(const f32x4*)(GCUM + (tok0 + t) * 192 + h * 32 + d0);
    r.vv = *(const u32x4*)(H + (tok0 + t) * HCOLS + HC_BV + h * 64 + (tid & 7) * 8);
    r.sv = *(const f32x4*)(GS + (size_t)it * 2048 + (tid >> 4) * 64 + (tid & 15) * 4);
    r.gr = *(const u32x4*)(H + (tok0 + t) * HCOLS + HC_BG + h * 64 + (tid & 7) * 8);
    return r;
}
__device__ __forceinline__ void phase_gla_b3(const Params& p, int l, unsigned char* lds) {
    const int tid = tid_l(), lane = tid & 63, wave = tid >> 6, r32 = lane & 31, hi = lane >> 5;
    bf16* QE = (bf16*)lds;
    bf16* KE = QE + 64 * 40;
    bf16* VT = KE + 64 * 40;
    bf16* ST = VT + 64 * 72;
    bf16* P = ST + 64 * 40;
    float* O = (float*)(P + 64 * 72);
    bf16* MIX = (bf16*)(p.ws + WS_MIX);
    const int NI = 48 * 64, G = grid_l(); int it = bid_l();
    if (it >= NI) return;
    GlaB3Pre cur = gla_b3_load(p, it, tid);
#pragma unroll 1
    for (; it < NI; it += G) {
        const GlaB3Pre nxt = gla_b3_load(p, it + G < NI ? it + G : it, tid);
        __builtin_amdgcn_sched_barrier(0);
        const int bh = it >> 6, n = it & 63, b = bh / 6, h = bh % 6; const size_t tok0 = (size_t)b * SEQ + n * 64;
        __syncthreads();
        { const int t = tid >> 3, d0 = (tid & 7) * 4; const u32x2 qq = cur.qq, kk = cur.kk; const f32x4 c = cur.c;
          const float e0 = __expf(c[0]), e1 = __expf(c[1]), e2 = __expf(c[2]), e3 = __expf(c[3]);
          u32x2 qo, ko;
          qo.x = pk2(bf2f(qq.x & 0xffffu) * e0, __uint_as_float(qq.x & 0xffff0000u) * e1); qo.y = pk2(bf2f(qq.y & 0xffffu) * e2, __uint_as_float(qq.y & 0xffff0000u) * e3);
          ko.x = pk2(bf2f(kk.x & 0xffffu) / e0, __uint_as_float(kk.x & 0xffff0000u) / e1); ko.y = pk2(bf2f(kk.y & 0xffffu) / e2, __uint_as_float(kk.y & 0xffff0000u) / e3);
          *(u32x2*)(QE + t * 40 + d0) = qo; *(u32x2*)(KE + t * 40 + d0) = ko; }
        { const int s_ = tid >> 3, e0 = (tid & 7) * 8;
#pragma unroll
          for (int i = 0; i < 4; ++i) { VT[(e0 + 2 * i) * 72 + s_] = (bf16)(cur.vv[i] & 0xffffu); VT[(e0 + 2 * i + 1) * 72 + s_] = (bf16)(cur.vv[i] >> 16); } }
        { const int d = tid >> 4, e0 = (tid & 15) * 4;
#pragma unroll
          for (int i = 0; i < 4; ++i) ST[(e0 + i) * 40 + d] = (bf16)f2bf(cur.sv[i]); }
        __syncthreads();
        f32x16_t acc = {};
        const int tt = (wave & 3) >> 1, tc = wave & 1;
        if (wave < 4) {
            if (!(tt == 0 && tc == 1)) {
#pragma unroll
                for (int ks = 0; ks < 2; ++ks) { const bf16x8_t a = *(const bf16x8_t*)(QE + (32 * tt + r32) * 40 + 16 * ks + 8 * hi), bb = *(const bf16x8_t*)(KE + (32 * tc + r32) * 40 + 16 * ks + 8 * hi);
                    acc = __builtin_amdgcn_mfma_f32_32x32x16_bf16(a, bb, acc, 0, 0, 0); }
#pragma unroll
                for (int r = 0; r < 16; ++r) { const int trow = 32 * tt + crow32(r, hi), scol = 32 * tc + r32; P[trow * 72 + scol] = (bf16)f2bf(scol <= trow ? acc[r] : 0.f); }
            }
        } else {
#pragma unroll
            for (int ks = 0; ks < 2; ++ks) { const bf16x8_t a = *(const bf16x8_t*)(QE + (32 * tt + r32) * 40 + 16 * ks + 8 * hi), bb = *(const bf16x8_t*)(ST + (32 * tc + r32) * 40 + 16 * ks + 8 * hi);
                acc = __builtin_amdgcn_mfma_f32_32x32x16_bf16(a, bb, acc, 0, 0, 0); }
        }
        __syncthreads();
        if (wave >= 4) {
            const int nks = tt == 0 ? 2 : 4;
            for (int ks = 0; ks < nks; ++ks) { const bf16x8_t a = *(const bf16x8_t*)(P + (32 * tt + r32) * 72 + 16 * ks + 8 * hi), bb = *(const bf16x8_t*)(VT + (32 * tc + r32) * 72 + 16 * ks + 8 * hi);
                acc = __builtin_amdgcn_mfma_f32_32x32x16_bf16(a, bb, acc, 0, 0, 0); }
#pragma unroll
            for (int r = 0; r < 16; ++r) O[(32 * tt + crow32(r, hi)) * 65 + 32 * tc + r32] = acc[r];
        }
        __syncthreads();
        { const int t = tid >> 3, e0 = (tid & 7) * 8; float o[8]; float ss = 0.f;
#pragma unroll
          for (int i = 0; i < 8; ++i) { o[i] = O[t * 65 + e0 + i]; ss += o[i] * o[i]; }
          ss += __shfl_xor(ss, 1); ss += __shfl_xor(ss, 2); ss += __shfl_xor(ss, 4);
          const float rs = 1.0f / sqrtf(ss * (1.f / 64.f) + LN_EPS);
          const float* ng = p.gla_norm_g + l * 384 + h * 64 + e0; const u32x4 gr = cur.gr;
          float r[8];
#pragma unroll
          for (int i = 0; i < 4; ++i) { const float ga = bf2f(gr[i] & 0xffffu), gb = __uint_as_float(gr[i] & 0xffff0000u);
              r[2 * i] = o[2 * i] * rs * ng[2 * i] * (ga * sigmoidf_(ga)); r[2 * i + 1] = o[2 * i + 1] * rs * ng[2 * i + 1] * (gb * sigmoidf_(gb)); }
          u32x4 w; w.x = pk2(r[0], r[1]); w.y = pk2(r[2], r[3]); w.z = pk2(r[4], r[5]); w.w = pk2(r[6], r[7]);
          *(u32x4*)(MIX + (tok0 + t) * D + MC_B + h * 64 + e0) = w; }
        cur = nxt;
    }
}

constexpr int LDSQ_OFF = LDS_BYTES - 1024;
constexpr int CW_ATTNQ = 8192;
__device__ __forceinline__ void phase_fox_mfma(const Params& p, int l, unsigned char* lds) {
    const attn_body::bf16* H = (const attn_body::bf16*)(p.ws + WS_H);
    const attn_body::AttnTensors AT{H + HC_CQ, H + HC_CK, H + HC_CV, (attn_body::bf16*)(p.ws + WS_MIX) + MC_C, (const float*)(p.ws + WS_CK), (const float*)(p.ws + WS_FKT), (const float*)(p.ws + WS_FQB)};
    const attn_body::QueueOrder S{(unsigned*)(p.ws + WS_CTL) + CW_ATTNQ + l * 64, (volatile __attribute__((address_space(3))) int*)((__attribute__((address_space(3))) unsigned char*)lds + LDSQ_OFF)};
    attn_body::attn_phase<attn_body::QueueOrder>((char*)lds, AT, S);
}

__device__ __forceinline__ void phase_ln(const _Float16* Y, const float* g, const float* bta, float* dst, bf16* dstb, unsigned char* xq = nullptr, float* xs = nullptr) {
    const int tid = tid_l(), lane = tid & 63, wave = tid >> 6; typedef _Float16 h4 __attribute__((ext_vector_type(4)));
    const int stride = grid_l() * 8; int row = bid_l() * 8 + wave;
    if (row >= T) return;
    h4 cur[4];
#pragma unroll
    for (int j = 0; j < 4; ++j) cur[j] = *(const h4*)(Y + (size_t)row * D + j * 256 + lane * 4);
#pragma unroll 1
    for (; row < T; row += stride) {
        h4 nxt[4]; const int nr = row + stride < T ? row + stride : row;
#pragma unroll
        for (int j = 0; j < 4; ++j) nxt[j] = *(const h4*)(Y + (size_t)nr * D + j * 256 + lane * 4);
        __builtin_amdgcn_sched_barrier(0);
        f32x4 v[4]; float s = 0.f;
#pragma unroll
        for (int j = 0; j < 4; ++j) { v[j] = (f32x4){(float)cur[j][0], (float)cur[j][1], (float)cur[j][2], (float)cur[j][3]}; s += (v[j][0] + v[j][1]) + (v[j][2] + v[j][3]); }
        const float mean = wave_sum(s) * (1.f / D); float s2 = 0.f;
#pragma unroll
        for (int j = 0; j < 4; ++j) { v[j] = v[j] - mean; s2 += (v[j][0] * v[j][0] + v[j][1] * v[j][1]) + (v[j][2] * v[j][2] + v[j][3] * v[j][3]); }
        const float rstd = 1.0f / sqrtf(wave_sum(s2) * (1.f / D) + LN_EPS);
        float am = 0.f;
#pragma unroll
        for (int j = 0; j < 4; ++j) { const f32x4 g4 = *(const f32x4*)(g + j * 256 + lane * 4), b4 = *(const f32x4*)(bta + j * 256 + lane * 4);
            const f32x4 o = v[j] * rstd * g4 + b4; v[j] = o;
            am = fmaxf(am, fmaxf(fmaxf(fabsf(o[0]), fabsf(o[1])), fmaxf(fabsf(o[2]), fabsf(o[3]))));
            if (dst) *(f32x4*)(dst + (size_t)row * D + j * 256 + lane * 4) = o;
            if (dstb) { u32x2 w; w.x = pk2(o[0], o[1]); w.y = pk2(o[2], o[3]); *(u32x2*)(dstb + (size_t)row * D + j * 256 + lane * 4) = w; } }
        if (xq) {
            am = wave_max(am); const float sc = am > 0.f ? 119.0f / am : 0.f;
#pragma unroll
            for (int j = 0; j < 4; ++j) { unsigned hh = 0u, ll = 0u;
#pragma unroll
                for (int i = 0; i < 4; ++i) { const int q8 = (int)__builtin_rintf(v[j][i] * sc), qh = (q8 + 8) >> 4, ql = q8 - (qh << 4); hh |= ((unsigned)qh & 15u) << (4 * i); ll |= ((unsigned)ql & 15u) << (4 * i); }
                *(unsigned short*)(xq + (size_t)row * D + j * 128 + lane * 2) = (unsigned short)hh; *(unsigned short*)(xq + (size_t)row * D + 512 + j * 128 + lane * 2) = (unsigned short)ll; }
            if (lane == 0) xs[row] = am * (1.0f / 119.0f); }
#pragma unroll
        for (int j = 0; j < 4; ++j) cur[j] = nxt[j];
    }
}

__device__ __forceinline__ int f2ord(float x) { const int i = __float_as_int(x); return i ^ ((i >> 31) & 0x7fffffff); }
__device__ __forceinline__ float ord2f(int k) { return __int_as_float(k ^ ((k >> 31) & 0x7fffffff)); }
__device__ __forceinline__ void phase_topk(const Params& p, unsigned char* lds) {
    const int tid = tid_l(), lane = tid & 63, wave = tid >> 6;
    unsigned char* wreg = lds + wave * 17408; unsigned char* tab = wreg;
    const _Float16* SC = (const _Float16*)(p.ws + WS_SC); int* EIDX = (int*)(p.ws + WS_EIDX); float* GATE = (float*)(p.ws + WS_GATE); unsigned long long* SOFF = (unsigned long long*)(p.ws + WS_SOFF);
    for (int g = bid_l() * 512 + tid; g < T * 16; g += grid_l() * 512) {
        const int tok = g >> 4, hc = g & 15;
        typedef _Float16 h8 __attribute__((ext_vector_type(8)));
        { const unsigned char* blk = (const unsigned char*)(SC + (size_t)(g - lane) * 128);
          u32x4 st[16];
#pragma unroll
          for (int j = 0; j < 16; ++j) st[j] = *(const u32x4*)(blk + (size_t)(j * 64 + lane) * 16);
          __builtin_amdgcn_wave_barrier();
#pragma unroll
          for (int j = 0; j < 16; ++j) { const int c = j * 64 + lane; *(u32x4*)(wreg + (c + (c >> 4)) * 16) = st[j]; }
          __builtin_amdgcn_wave_barrier(); }
        const unsigned char* lp = wreg + lane * 272;
#define TK_CE(a, b) do { const int hi_ = max(a, b), lo_ = min(a, b); a = hi_; b = lo_; } while (0)
        int tk[16];
#pragma unroll 1
        for (int gi = 0; gi < 8; ++gi) { const h8 cA = *(const h8*)(lp + gi * 32), c1_ = *(const h8*)(lp + gi * 32 + 16);
            int v[16];
#pragma unroll
            for (int j = 0; j < 8; ++j) { v[j] = (f2ord((float)cA[j]) & ~127) | (127 - (gi * 16 + j)); v[8 + j] = (f2ord((float)c1_[j]) & ~127) | (127 - (gi * 16 + 8 + j)); }
            TK_CE(v[0], v[1]); TK_CE(v[3], v[2]); TK_CE(v[4], v[5]); TK_CE(v[7], v[6]); TK_CE(v[8], v[9]); TK_CE(v[11], v[10]); TK_CE(v[12], v[13]); TK_CE(v[15], v[14]); TK_CE(v[0], v[2]); TK_CE(v[1], v[3]); TK_CE(v[6], v[4]); TK_CE(v[7], v[5]); TK_CE(v[8], v[10]); TK_CE(v[9], v[11]); TK_CE(v[14], v[12]); TK_CE(v[15], v[13]); TK_CE(v[0], v[1]); TK_CE(v[2], v[3]); TK_CE(v[5], v[4]); TK_CE(v[7], v[6]); TK_CE(v[8], v[9]); TK_CE(v[10], v[11]); TK_CE(v[13], v[12]); TK_CE(v[15], v[14]); TK_CE(v[0], v[4]); TK_CE(v[1], v[5]); TK_CE(v[2], v[6]); TK_CE(v[3], v[7]); TK_CE(v[12], v[8]); TK_CE(v[13], v[9]); TK_CE(v[14], v[10]); TK_CE(v[15], v[11]); TK_CE(v[0], v[2]); TK_CE(v[1], v[3]); TK_CE(v[4], v[6]); TK_CE(v[5], v[7]); TK_CE(v[10], v[8]); TK_CE(v[11], v[9]); TK_CE(v[14], v[12]); TK_CE(v[15], v[13]); TK_CE(v[0], v[1]); TK_CE(v[2], v[3]); TK_CE(v[4], v[5]); TK_CE(v[6], v[7]); TK_CE(v[9], v[8]); TK_CE(v[11], v[10]); TK_CE(v[13], v[12]); TK_CE(v[15], v[14]); TK_CE(v[0], v[8]); TK_CE(v[1], v[9]); TK_CE(v[2], v[10]); TK_CE(v[3], v[11]); TK_CE(v[4], v[12]); TK_CE(v[5], v[13]); TK_CE(v[6], v[14]); TK_CE(v[7], v[15]); TK_CE(v[0], v[4]); TK_CE(v[1], v[5]); TK_CE(v[2], v[6]); TK_CE(v[3], v[7]); TK_CE(v[8], v[12]); TK_CE(v[9], v[13]); TK_CE(v[10], v[14]); TK_CE(v[11], v[15]); TK_CE(v[0], v[2]); TK_CE(v[1], v[3]); TK_CE(v[4], v[6]); TK_CE(v[5], v[7]); TK_CE(v[8], v[10]); TK_CE(v[9], v[11]); TK_CE(v[12], v[14]); TK_CE(v[13], v[15]); TK_CE(v[0], v[1]); TK_CE(v[2], v[3]); TK_CE(v[4], v[5]); TK_CE(v[6], v[7]); TK_CE(v[8], v[9]); TK_CE(v[10], v[11]); TK_CE(v[12], v[13]); TK_CE(v[14], v[15]);
            if (gi == 0) {
#pragma unroll
                for (int j = 0; j < 16; ++j) tk[j] = v[j]; }
            else {
#pragma unroll
                for (int j = 0; j < 16; ++j) tk[j] = max(tk[j], v[15 - j]);
                TK_CE(tk[0], tk[8]); TK_CE(tk[1], tk[9]); TK_CE(tk[2], tk[10]); TK_CE(tk[3], tk[11]); TK_CE(tk[4], tk[12]); TK_CE(tk[5], tk[13]); TK_CE(tk[6], tk[14]); TK_CE(tk[7], tk[15]); TK_CE(tk[0], tk[4]); TK_CE(tk[1], tk[5]); TK_CE(tk[2], tk[6]); TK_CE(tk[3], tk[7]); TK_CE(tk[8], tk[12]); TK_CE(tk[9], tk[13]); TK_CE(tk[10], tk[14]); TK_CE(tk[11], tk[15]); TK_CE(tk[0], tk[2]); TK_CE(tk[1], tk[3]); TK_CE(tk[4], tk[6]); TK_CE(tk[5], tk[7]); TK_CE(tk[8], tk[10]); TK_CE(tk[9], tk[11]); TK_CE(tk[12], tk[14]); TK_CE(tk[13], tk[15]); TK_CE(tk[0], tk[1]); TK_CE(tk[2], tk[3]); TK_CE(tk[4], tk[5]); TK_CE(tk[6], tk[7]); TK_CE(tk[8], tk[9]); TK_CE(tk[10], tk[11]); TK_CE(tk[12], tk[13]); TK_CE(tk[14], tk[15]); }
            }
        __builtin_amdgcn_wave_barrier();
#undef TK_CE
        float av[16], bv[16]; int ai[16], bi[16]; const bool c1 = (hc & 1) != 0;
#pragma unroll
        for (int j = 0; j < 16; ++j) { const int ok = __shfl_xor(tk[j], 1); const int ka = c1 ? ok : tk[j], kb = c1 ? tk[j] : ok;
            av[j] = ord2f(ka & ~127); ai[j] = 127 - (ka & 127); bv[j] = ord2f(kb & ~127); bi[j] = 127 - (kb & 127); }
#pragma unroll
        for (int j = 0; j < 16; ++j) { tab[j * 64 + lane] = (unsigned char)ai[j]; tab[(16 + j) * 64 + lane] = (unsigned char)bi[j]; }
        int ck[16];
#pragma unroll
        for (int j = 0; j < 16; ++j) ck[j] = (int)0x80000000;
#pragma unroll
        for (int i = 0; i < 16; ++i)
#pragma unroll
            for (int j = 0; j < 16 / (i + 1); ++j) { int x = (f2ord(av[i] + bv[j]) & ~255) | (255 - (i * 16 + j));
#pragma unroll
                for (int q = 0; q < 16; ++q) { const int hi = max(ck[q], x); x = min(ck[q], x); ck[q] = hi; } }
        float den = 0.f; float ex[16]; const float c0 = ord2f(ck[0] & ~255);
#pragma unroll
        for (int j = 0; j < 16; ++j) { ex[j] = __expf(ord2f(ck[j] & ~255) - c0); den += ex[j]; }
        const float inv = 1.0f / den;
        if (!c1) { int* ep = EIDX + (size_t)tok * 128 + (hc >> 1) * 16; float* gp = GATE + (size_t)tok * 128 + (hc >> 1) * 16;
#pragma unroll
            for (int q = 0; q < 4; ++q) { u32x4 ev; f32x4 gv;
#pragma unroll
                for (int j = 0; j < 4; ++j) { const int flat = 255 - (ck[4 * q + j] & 255); ev[j] = (unsigned)((int)tab[(flat >> 4) * 64 + lane] * 128 + (int)tab[(16 + (flat & 15)) * 64 + lane]); gv[j] = ex[4 * q + j] * inv; }
                *(u32x4*)(ep + 4 * q) = ev; *(f32x4*)(gp + 4 * q) = gv; } }
    }
}

__device__ __forceinline__ float gelu_tanh(float h) { const float z = 0.7978845608028654f * (h + 0.044715f * h * h * h); const float t = 1.0f - 2.0f / (__expf(2.0f * z) + 1.0f); return 0.5f * h * (1.0f + t); }
struct PeerUMeta { int e_lo, e_hi; float g_lo, g_hi, xs; u32x4 xh0, xh1, xl0, xl1; };
__device__ __forceinline__ PeerUMeta peer_umeta_load(const unsigned char* XQ, const float* XS, const int* EIDX, const float* GATE, int tok, int lane) {
    PeerUMeta m; const unsigned char* xr = XQ + (size_t)tok * D + (lane & 15) * 16;
    m.e_lo = EIDX[(size_t)tok * 128 + lane]; m.e_hi = EIDX[(size_t)tok * 128 + 64 + lane]; m.g_lo = GATE[(size_t)tok * 128 + lane]; m.g_hi = GATE[(size_t)tok * 128 + 64 + lane]; m.xs = XS[tok];
    m.xh0 = *(const u32x4*)(xr); m.xh1 = *(const u32x4*)(xr + 256); m.xl0 = *(const u32x4*)(xr + 512); m.xl1 = *(const u32x4*)(xr + 768);
    return m;
}
template <int CTRL> __device__ __forceinline__ int dpp_movi(int v) { return __builtin_amdgcn_update_dpp(0, v, CTRL, 0xf, 0xf, false); }
__device__ __forceinline__ float gelu_tanh_fast(float h) { const float z = 0.7978845608028654f * (h + 0.044715f * h * h * h); const float t = 1.0f - 2.0f * __builtin_amdgcn_rcpf(__expf(2.0f * z) + 1.0f); return 0.5f * h * (1.0f + t); }
#define PU_IDS(I, E, kk) do { _Pragma("unroll") for (int a_ = 0; a_ < 4; ++a_) I[a_] = __builtin_amdgcn_ds_bpermute((g4 << 2) + (((kk) + 4 * a_) << 2), (E)); } while (0)
#define PU_LOAD(R, I) do { _Pragma("unroll") for (int a_ = 0; a_ < 4; ++a_) { const unsigned char* p_ = U4l + (size_t)I[a_] * 512; R[2 * a_] = *(const u32x4*)(p_); R[2 * a_ + 1] = *(const u32x4*)(p_ + 256); } \
        __builtin_amdgcn_sched_barrier(0); } while (0)
#define PU_COMP(R, M) do { int t_[4]; \
        _Pragma("unroll") for (int a_ = 0; a_ < 4; ++a_) { int h_ = 0, l_ = 0; \
            _Pragma("unroll") for (int w_ = 0; w_ < 4; ++w_) { h_ = __builtin_amdgcn_sdot8((int)R[2 * a_][w_], (int)cur.xh0[w_], h_, false); l_ = __builtin_amdgcn_sdot8((int)R[2 * a_][w_], (int)cur.xl0[w_], l_, false); \
                                                               h_ = __builtin_amdgcn_sdot8((int)R[2 * a_ + 1][w_], (int)cur.xh1[w_], h_, false); l_ = __builtin_amdgcn_sdot8((int)R[2 * a_ + 1][w_], (int)cur.xl1[w_], l_, false); } \
            int s_ = 16 * h_ + l_; s_ += dpp_movi<0x128>(s_); s_ += dpp_movi<0x124>(s_); s_ += dpp_movi<0x122>(s_); s_ += dpp_movi<0x121>(s_); t_[a_] = s_; } \
        M = (l16 & 2) ? ((l16 & 1) ? t_[3] : t_[2]) : ((l16 & 1) ? t_[1] : t_[0]); __builtin_amdgcn_sched_barrier(0); } while (0)
__device__ __forceinline__ void phase_peer_u(const Params& p, unsigned char* lds) {
    const int tid = tid_l(), lane = tid & 63, wave = tid >> 6, l16 = lane & 15, g4 = lane >> 4;
    const unsigned char* XQ = p.ws + WS_XQ; const float* XS = (const float*)(p.ws + WS_XS); const float* RS = (const float*)(p.ws + WS_RS); const float* VS = (const float*)(p.ws + WS_VS);
    const unsigned char* U4l = p.ws + WS_U + l16 * 16;
    const int* EIDX = (const int*)(p.ws + WS_EIDX); float* GATE = (float*)(p.ws + WS_GATE);
    const int stride = grid_l() * 8; int tok = __builtin_amdgcn_readfirstlane(bid_l() * 8 + wave);
    if (tok >= T) return;
    PeerUMeta cur = peer_umeta_load(XQ, XS, EIDX, GATE, tok, lane);
    u32x4 Ra[8], Rb[8]; int Ia[4], Ib[4];
    PU_IDS(Ia, cur.e_lo, 0); PU_LOAD(Ra, Ia); PU_IDS(Ib, cur.e_lo, 16);
    const int qd = ((((lane & 3) << 4) + ((lane >> 2) & 3)) << 2);
#pragma unroll 1
    for (; tok < T; tok += stride) {
        const PeerUMeta nxt = peer_umeta_load(XQ, XS, EIDX, GATE, tok + stride < T ? tok + stride : tok, lane);
        const float rs_lo = RS[cur.e_lo], rs_hi = RS[cur.e_hi], vs_lo = VS[cur.e_lo], vs_hi = VS[cur.e_hi];
        __builtin_amdgcn_sched_barrier(0);
        int m0, m1, m2, m3, m4, m5, m6, m7;
        PU_LOAD(Rb, Ib); PU_IDS(Ia, cur.e_lo, 32); PU_COMP(Ra, m0);
        PU_LOAD(Ra, Ia); PU_IDS(Ib, cur.e_lo, 48); PU_COMP(Rb, m1);
        PU_LOAD(Rb, Ib); PU_IDS(Ia, cur.e_hi, 0);  PU_COMP(Ra, m2);
        PU_LOAD(Ra, Ia); PU_IDS(Ib, cur.e_hi, 16); PU_COMP(Rb, m3);
        PU_LOAD(Rb, Ib); PU_IDS(Ia, cur.e_hi, 32); PU_COMP(Ra, m4);
        PU_LOAD(Ra, Ia); PU_IDS(Ib, cur.e_hi, 48); PU_COMP(Rb, m5);
        PU_LOAD(Rb, Ib); PU_IDS(Ia, nxt.e_lo, 0);  PU_COMP(Ra, m6);
        PU_LOAD(Ra, Ia); PU_IDS(Ib, nxt.e_lo, 16); PU_COMP(Rb, m7);
        const int d0 = __builtin_amdgcn_ds_bpermute(qd, m0), d1 = __builtin_amdgcn_ds_bpermute(qd, m1), d2 = __builtin_amdgcn_ds_bpermute(qd, m2), d3 = __builtin_amdgcn_ds_bpermute(qd, m3);
        const int d4 = __builtin_amdgcn_ds_bpermute(qd, m4), d5 = __builtin_amdgcn_ds_bpermute(qd, m5), d6 = __builtin_amdgcn_ds_bpermute(qd, m6), d7 = __builtin_amdgcn_ds_bpermute(qd, m7);
        const float c_lo = (float)((lane & 32) ? ((lane & 16) ? d3 : d2) : ((lane & 16) ? d1 : d0)), c_hi = (float)((lane & 32) ? ((lane & 16) ? d7 : d6) : ((lane & 16) ? d5 : d4));
        GATE[(size_t)tok * 128 + lane] = cur.g_lo * gelu_tanh_fast(c_lo * (rs_lo * cur.xs)) * vs_lo;
        GATE[(size_t)tok * 128 + 64 + lane] = cur.g_hi * gelu_tanh_fast(c_hi * (rs_hi * cur.xs)) * vs_hi;
        cur = nxt;
    }
}
#undef PU_IDS
#undef PU_LOAD
#undef PU_COMP
struct PeerVMeta { int e_lo, e_hi; float c_lo, c_hi; u32x4 x0, x1; };
__device__ __forceinline__ PeerVMeta peer_vmeta_load(const int* EIDX, const float* COEF, const bf16* XB, int tok, int lane) {
    PeerVMeta m;
    m.e_lo = EIDX[(size_t)tok * 128 + lane]; m.e_hi = EIDX[(size_t)tok * 128 + 64 + lane]; m.c_lo = COEF[(size_t)tok * 128 + lane]; m.c_hi = COEF[(size_t)tok * 128 + 64 + lane];
    const int xo = (lane & 31) * 32 + (lane >> 5) * 16;
    m.x0 = *(const u32x4*)(XB + (size_t)tok * D + xo); m.x1 = *(const u32x4*)(XB + (size_t)tok * D + xo + 8);
    return m;
}
#define PV_ISSUE(VR, CF, PE, PC, jj) do { _Pragma("unroll") for (int q = 0; q < 8; ++q) { const int a_ = hb + (((jj) + q) << 2); const int e_ = __builtin_amdgcn_ds_bpermute(a_, (int)(PE)); \
        CF[q] = __int_as_float(__builtin_amdgcn_ds_bpermute(a_, (int)(PC))); VR[q] = *(const u32x4*)(V4l + (size_t)e_ * 512); } __builtin_amdgcn_sched_barrier(0); } while (0)
#define PV_COMPUTE(VR, CF) do { _Pragma("unroll") for (int q = 0; q < 8; ++q) { const f32x2v c2 = (f32x2v){CF[q], CF[q]}; \
        _Pragma("unroll") for (int w = 0; w < 4; ++w) { \
            acc[4 * w] += __builtin_amdgcn_cvt_scalef32_pk_f32_fp4(VR[q][w], 1.0f, 0) * c2; acc[4 * w + 1] += __builtin_amdgcn_cvt_scalef32_pk_f32_fp4(VR[q][w], 1.0f, 1) * c2; \
            acc[4 * w + 2] += __builtin_amdgcn_cvt_scalef32_pk_f32_fp4(VR[q][w], 1.0f, 2) * c2; acc[4 * w + 3] += __builtin_amdgcn_cvt_scalef32_pk_f32_fp4(VR[q][w], 1.0f, 3) * c2; } } \
        __builtin_amdgcn_sched_barrier(0); } while (0)
__device__ __forceinline__ void phase_peer_v(const Params& p) {
    const int tid = tid_l(), lane = tid & 63, wave = tid >> 6;
    const unsigned char* V4l = p.ws + WS_V + (lane & 31) * 16;
    const int* EIDX = (const int*)(p.ws + WS_EIDX); const float* COEF = (const float*)(p.ws + WS_GATE);
    bf16* XB = (bf16*)(p.ws + WS_XB);
    const int hb = (lane & 32) << 2;
    const int xo = (lane & 31) * 32 + (lane >> 5) * 16;
    const int stride = grid_l() * 8; int tok = __builtin_amdgcn_readfirstlane(bid_l() * 8 + wave);
    if (tok >= T) return;
    PeerVMeta cur = peer_vmeta_load(EIDX, COEF, XB, tok, lane);
    auto se = __builtin_amdgcn_permlane32_swap((unsigned)cur.e_lo, (unsigned)cur.e_hi, false, false); auto sc_ = __builtin_amdgcn_permlane32_swap(__float_as_uint(cur.c_lo), __float_as_uint(cur.c_hi), false, false);
    u32x4 vrA[8], vrB[8]; float cfA[8], cfB[8];
    PV_ISSUE(vrA, cfA, se[0], sc_[0], 0);
#pragma unroll 1
    for (; tok < T; tok += stride) {
        const PeerVMeta nxt = peer_vmeta_load(EIDX, COEF, XB, tok + stride < T ? tok + stride : tok, lane);
        __builtin_amdgcn_sched_barrier(0);
        f32x2v acc[16];
#pragma unroll
        for (int i = 0; i < 16; ++i) acc[i] = (f32x2v){0.f, 0.f};
        PV_ISSUE(vrB, cfB, se[0], sc_[0], 8);  PV_COMPUTE(vrA, cfA);
        PV_ISSUE(vrA, cfA, se[0], sc_[0], 16); PV_COMPUTE(vrB, cfB);
        PV_ISSUE(vrB, cfB, se[0], sc_[0], 24); PV_COMPUTE(vrA, cfA);
        PV_ISSUE(vrA, cfA, se[1], sc_[1], 0);  PV_COMPUTE(vrB, cfB);
        PV_ISSUE(vrB, cfB, se[1], sc_[1], 8);  PV_COMPUTE(vrA, cfA);
        PV_ISSUE(vrA, cfA, se[1], sc_[1], 16); PV_COMPUTE(vrB, cfB);
        PV_ISSUE(vrB, cfB, se[1], sc_[1], 24); PV_COMPUTE(vrA, cfA);
        se = __builtin_amdgcn_permlane32_swap((unsigned)nxt.e_lo, (unsigned)nxt.e_hi, false, false); sc_ = __builtin_amdgcn_permlane32_swap(__float_as_uint(nxt.c_lo), __float_as_uint(nxt.c_hi), false, false);
        PV_ISSUE(vrA, cfA, se[0], sc_[0], 0);  PV_COMPUTE(vrB, cfB);
        float sres[16];
#pragma unroll
        for (int i = 0; i < 8; ++i)
#pragma unroll
            for (int c = 0; c < 2; ++c) { const auto r_ = __builtin_amdgcn_permlane32_swap(__float_as_uint(acc[i][c]), __float_as_uint(acc[8 + i][c]), false, false);
                sres[2 * i + c] = __uint_as_float(r_[0]) + __uint_as_float(r_[1]); }
        float r[16];
#pragma unroll
        for (int i = 0; i < 4; ++i) { r[2 * i] = ALPHA * bf2f(cur.x0[i] & 0xffffu) + sres[2 * i]; r[2 * i + 1] = ALPHA * __uint_as_float(cur.x0[i] & 0xffff0000u) + sres[2 * i + 1];
                                      r[8 + 2 * i] = ALPHA * bf2f(cur.x1[i] & 0xffffu) + sres[8 + 2 * i]; r[8 + 2 * i + 1] = ALPHA * __uint_as_float(cur.x1[i] & 0xffff0000u) + sres[8 + 2 * i + 1]; }
#pragma unroll
        for (int w = 0; w < 2; ++w) { u32x4 o; o.x = pk2(r[8 * w], r[8 * w + 1]); o.y = pk2(r[8 * w + 2], r[8 * w + 3]); o.z = pk2(r[8 * w + 4], r[8 * w + 5]); o.w = pk2(r[8 * w + 6], r[8 * w + 7]);
            *(u32x4*)(XB + (size_t)tok * D + xo + 8 * w) = o; }
        cur = nxt;
    }
}
#undef PV_ISSUE
#undef PV_COMPUTE
#define GAS __attribute__((address_space(1)))
#define LAS __attribute__((address_space(3)))
#define XB_TMO      128
#define XB_XCNT(j)  (256  + 64 * (j))
#define XB_XSUB(j)  (1280 + 64 * (j))
#define XB_XGEN(j)  (2304 + 64 * (j))
#define XB_TOP      3328
#define XB_TOPGEN   3392
#define XCD_BAR_WORDS 3456
#define XB_SPIN_CAP (1u << 18)

__device__ __forceinline__ unsigned xb_ld(unsigned* p)              { return __hip_atomic_load(p, __ATOMIC_RELAXED, __HIP_MEMORY_SCOPE_AGENT); }
__device__ __forceinline__ unsigned xb_add(unsigned* p, unsigned v) { return __hip_atomic_fetch_add(p, v, __ATOMIC_RELAXED, __HIP_MEMORY_SCOPE_AGENT); }
__device__ __forceinline__ unsigned xb_xcc_id() { return (unsigned)__builtin_amdgcn_s_getreg((3 << 11) | 20) & 0xFu; }
#define XB_SPIN(cond, bar) do { unsigned _sp = 0; while (cond) { __builtin_amdgcn_s_sleep(1); \
    if ((++_sp & 255u) == 0u) { if (xb_ld(&(bar)[XB_TMO])) break; if (_sp > XB_SPIN_CAP) { atomicAdd(&(bar)[XB_TMO], 1u); break; } } } } while (0)

struct XcdBarrier {
    unsigned* bar; unsigned x;
    volatile LAS unsigned* st;
};

__device__ __forceinline__ XcdBarrier xcd_barrier_post(unsigned* bar, volatile LAS unsigned* st) {
    XcdBarrier b; b.bar = bar; b.x = xb_xcc_id(); b.st = st;
    if (threadIdx.x == 0) (void)xb_add(&bar[XB_XCNT(b.x)], 1u);
    return b;
}
__device__ __forceinline__ void xcd_barrier_complete(unsigned* bar, unsigned x, unsigned& nloc, unsigned& nx) {
    const unsigned G = gridDim.x * gridDim.y * gridDim.z;
    unsigned sum, cnt, mine, sp = 0u;
    for (;;) {
        sum = 0u; cnt = 0u; mine = 0u;
#pragma unroll
        for (unsigned j = 0; j < 16; ++j) { const unsigned c = xb_ld(&bar[XB_XCNT(j)]); sum += c; cnt += (c > 0u) ? 1u : 0u; mine = (j == x) ? c : mine; }
        if (sum == G) break;
        __builtin_amdgcn_s_sleep(1);
        if ((++sp & 255u) == 0u) { if (xb_ld(&bar[XB_TMO])) break; if (sp > XB_SPIN_CAP) { atomicAdd(&bar[XB_TMO], 1u); break; } }
    }
    nloc = mine > 0u ? mine : 1u; nx = cnt > 0u ? cnt : 1u;
}

__device__ __forceinline__ void xcd_barrier(const XcdBarrier& b) {
    asm volatile("s_waitcnt vmcnt(0)" ::: "memory");
    __syncthreads();
    if (threadIdx.x == 0) {
        unsigned* bar = b.bar;
        __builtin_amdgcn_s_waitcnt(0);
        unsigned nloc = b.st[0], nx = b.st[1];
        if (nloc == 0u) { xcd_barrier_complete(bar, b.x, nloc, nx); b.st[0] = nloc; b.st[1] = nx; }
        const unsigned old = xb_add(&bar[XB_XSUB(b.x)], 1u);
        const unsigned gen = old / nloc;
        if (old + 1u == (gen + 1u) * nloc) {
            __builtin_amdgcn_fence(__ATOMIC_RELEASE, "agent");
            asm volatile("s_waitcnt vmcnt(0)" ::: "memory");
            const unsigned og = xb_add(&bar[XB_TOP], 1u);
            const unsigned tg = og / nx;
            if (og + 1u == (tg + 1u) * nx) xb_add(&bar[XB_TOPGEN], 1u);
            else XB_SPIN(xb_ld(&bar[XB_TOPGEN]) == tg, bar);
            __builtin_amdgcn_fence(__ATOMIC_ACQUIRE, "agent");
            xb_add(&bar[XB_XGEN(b.x)], 1u);
            asm volatile("s_waitcnt vmcnt(0)" ::: "memory");
        } else {
            XB_SPIN(xb_ld(&bar[XB_XGEN(b.x)]) == gen, bar);
            __builtin_amdgcn_fence(__ATOMIC_ACQUIRE, "agent");
            asm volatile("s_waitcnt vmcnt(0)" ::: "memory");
        }
    }
    __syncthreads();
}
enum { PH_PRO_A, PH_PRO_B, PH_CVT, PH_GEMM_IN, PH_GEMM_E, PH_CONV, PH_FOXCUM, PH_FOXNORM, PH_GLA1, PH_GLA2, PH_GLA3, PH_FOX, PH_GEMM_OUT, PH_LN1, PH_GEMM_SC, PH_TOPK, PH_PEERU, PH_PEERV, PH_GEMM_PLE, PH_LN2, PH_COUNT };

template <int PH> __device__ __forceinline__ void run_phase(const Params& p, int l, unsigned char* lds) {
    if constexpr (PH == PH_PRO_A) phase_pro_a(p, lds);
    else if constexpr (PH == PH_PRO_B) phase_pro_b(p, lds);
    else if constexpr (PH == PH_CVT) phase_cvt(p, l);
    else if constexpr (PH == PH_GEMM_IN) phase_gemm_in(p, l, lds);
    else if constexpr (PH == PH_GEMM_E) phase_gemm_e(p, l, lds);
    else if constexpr (PH == PH_CONV) phase_conv(p, l, lds);
    else if constexpr (PH == PH_FOXCUM) phase_fox_cum(p, l, lds);
    else if constexpr (PH == PH_FOXNORM) phase_fox_norm(p, lds);
    else if constexpr (PH == PH_GLA1) phase_gla_b1(p, l, lds);
    else if constexpr (PH == PH_GLA2) phase_gla_b2(p);
    else if constexpr (PH == PH_GLA3) phase_gla_b3(p, l, lds);
    else if constexpr (PH == PH_FOX) phase_fox_mfma(p, l, lds);
    else if constexpr (PH == PH_GEMM_OUT) phase_gemm_out(p, l, lds);
    else if constexpr (PH == PH_LN1) phase_ln((const _Float16*)(p.ws + WS_Y), p.ln1_g + (size_t)l * D, p.ln1_b + (size_t)l * D, nullptr, (bf16*)(p.ws + WS_XB), p.ws + WS_XQ, (float*)(p.ws + WS_XS));
    else if constexpr (PH == PH_GEMM_SC) phase_gemm_sc(p, l, lds);
    else if constexpr (PH == PH_TOPK) phase_topk(p, lds);
    else if constexpr (PH == PH_PEERU) phase_peer_u(p, lds);
    else if constexpr (PH == PH_PEERV) phase_peer_v(p);
    else if constexpr (PH == PH_GEMM_PLE) phase_gemm_ple(p, l, lds);
    else if constexpr (PH == PH_LN2) phase_ln((const _Float16*)(p.ws + WS_Y), p.ln2_g + (size_t)l * D, p.ln2_b + (size_t)l * D, l == DEPTH - 1 ? p.out : nullptr, l == DEPTH - 1 ? nullptr : (bf16*)(p.ws + WS_XB));
}

constexpr int MISC_OFF = LDS_BYTES - 512;
constexpr int CW_BAR = 4096;
static_assert(MISC_OFF + 128 <= LDS_BYTES && (CW_BAR + XCD_BAR_WORDS) * 4 <= (int)CTL_ZERO_BYTES, "control words");

typedef __attribute__((address_space(4))) const Params CParams;
#define PHASE(PH) do { CParams* q_ = pp; asm volatile("" : "+s"(q_)); Params lp_; __builtin_memcpy(&lp_, q_, sizeof(Params)); run_phase<PH>(lp_, l, lds); } while (0)
__global__ void __launch_bounds__(512, 2) mk_fwd(Params p_unused) {
#if defined(__HIP_DEVICE_COMPILE__)
    extern __shared__ __attribute__((aligned(16))) unsigned char lds[];
    CParams* pp = (CParams*)__builtin_amdgcn_kernarg_segment_ptr();
    unsigned char* ws0; { CParams* q_ = pp; asm volatile("" : "+s"(q_)); ws0 = q_->ws; }
    volatile LAS unsigned* MISC = (volatile LAS unsigned*)((LAS unsigned char*)lds + MISC_OFF);
    if (threadIdx.x < 32) MISC[threadIdx.x] = 0u;
    __syncthreads();
    (void)xcd_barrier_post((unsigned*)(ws0 + WS_CTL) + CW_BAR, MISC + 8);
#define GB() do { CParams* qb_ = pp; asm volatile("" : "+s"(qb_)); XcdBarrier b_; b_.bar = (unsigned*)(qb_->ws + WS_CTL) + CW_BAR; b_.x = xb_xcc_id(); b_.st = MISC + 8; xcd_barrier(b_); } while (0)
    { const int l = 0; PHASE(PH_PRO_A); PHASE(PH_PRO_B); } GB();
    for (int l = 0; l < DEPTH; ++l) {
        PHASE(PH_CVT); PHASE(PH_GEMM_IN); GB();
        PHASE(PH_GEMM_E); PHASE(PH_CONV); PHASE(PH_FOXCUM); PHASE(PH_FOXNORM); PHASE(PH_GLA1); GB();
        PHASE(PH_GLA2); PHASE(PH_FOX); GB();
        PHASE(PH_GLA3); GB();
        PHASE(PH_GEMM_OUT); GB();
        PHASE(PH_LN1); GB();
        PHASE(PH_GEMM_SC); GB();
        PHASE(PH_TOPK); GB();
        PHASE(PH_PEERU); GB();
        PHASE(PH_PEERV); GB();
        PHASE(PH_GEMM_PLE); GB();
        PHASE(PH_LN2); GB();
    }
#undef GB
#endif
}

extern "C" void kernel_launch(void* const* d_in, const int* in_sizes, int n_in, void* d_out, int out_size, void* d_ws, size_t ws_size, hipStream_t stream) {
    static int grid = 0;
    if (grid == 0) {
        if (n_in != 23 || ws_size < WS_END) { fprintf(stderr, "kernel_launch: unexpected n_in %d or ws_size %zu\n", n_in, ws_size); grid = -1; return; }
        int dev = 0, cus = 0, per_cu = 0;
        if (hipGetDevice(&dev) != hipSuccess || hipDeviceGetAttribute(&cus, hipDeviceAttributeMultiprocessorCount, dev) != hipSuccess) { grid = -1; return; }
        if (hipFuncSetAttribute((const void*)mk_fwd, hipFuncAttributeMaxDynamicSharedMemorySize, LDS_BYTES) != hipSuccess) { grid = -1; return; }
        if (hipOccupancyMaxActiveBlocksPerMultiprocessor(&per_cu, (const void*)mk_fwd, 512, LDS_BYTES) != hipSuccess || per_cu < 1) { fprintf(stderr, "kernel_launch: occupancy query says %d\n", per_cu); }
        (void)hipGetLastError();
        grid = cus;
    }
    if (grid < 0) return;
    if (hipMemsetAsync((char*)d_ws + WS_CTL, 0, CTL_ZERO_BYTES, stream) != hipSuccess) return;
    Params p; memset(&p, 0, sizeof(p));
    const float** f = (const float**)&p;
    for (int i = 0; i < 23; ++i) f[i] = (const float*)d_in[i];
    p.out = (float*)d_out; p.ws = (unsigned char*)d_ws;
    hipLaunchKernelGGL(mk_fwd, dim3(grid), dim3(512), LDS_BYTES, stream, p);
}
```

```cpp
#include <hip/hip_runtime.h>
#include <cstdio>
#include <cstdint>
#include <cstring>
#include <cmath>
__device__ __forceinline__ int tid_l() { int t = threadIdx.x; asm volatile("" : "+v"(t)); return t; }
__device__ __forceinline__ int bid_l() { int b = blockIdx.x; asm volatile("" : "+s"(b)); return b; }
__device__ __forceinline__ int grid_l() { int g = gridDim.x; asm volatile("" : "+s"(g)); return g; }
namespace pg8 {
#define PG8_LAS __attribute__((address_space(3)))
typedef unsigned short bf16_t;
typedef short bf16x8 __attribute__((ext_vector_type(8)));
typedef float f32x4 __attribute__((ext_vector_type(4)));
typedef unsigned u32x4 __attribute__((ext_vector_type(4)));
constexpr int BM = 256, BK = 64, HALF = 128, HTB = HALF * BK * 2  , STAGE_BYTES = 8 * HTB, NXCD = 8, WGM = 8;

__host__ __device__ __forceinline__ int lds_byte(int r, int c) { const int st = (r >> 4) * 2 + (c >> 5), rr = r & 15, cc = c & 31, ob = rr * 64 + cc * 2; return st * 1024 + (ob ^ (((ob >> 9) & 1) << 5)); }
__host__ __device__ __forceinline__ void stage_rc(int b, int& R, int& C) { const int st = b / 1024, sb = b % 1024, swz = sb ^ (((sb >> 9) & 1) << 5); R = (st >> 1) * 16 + swz / 64; C = (st & 1) * 32 + (swz % 64) / 2; }
__host__ __device__ __forceinline__ int perm32(int rho) { const int n = rho >> 4, i = rho & 15; return 8 * (i >> 2) + 4 * n + (i & 3); }

struct Unit { int pm, pn; };
struct Gemm { const bf16_t* A; const bf16_t* Bt; int M, N, K; };

struct StaticOrder {
    int nM, nN, nwg, G, c;
    __host__ __device__ void init(int M, int N, int G_, int c_) { nM = M / BM; nN = N / BM; nwg = nM * nN; G = G_; c = c_; }
    __host__ __device__ bool next(int i, Unit& u) const {
        const long L = (long)i * G + c; if (L >= nwg) return false;
        int wgid = (int)L; { const int q = nwg / NXCD, r = nwg % NXCD, xcd = wgid % NXCD, off = wgid / NXCD; wgid = (xcd < r ? xcd * (q + 1) : r * (q + 1) + (xcd - r) * q) + off; }
        const int nig = WGM * nN, gid = wgid / nig, fm = gid * WGM, gsz = (nM - fm) < WGM ? (nM - fm) : WGM;
        u.pm = fm + ((wgid % nig) % gsz); u.pn = (wgid % nig) / gsz; return true;
    }
    __device__ __forceinline__ void a_ready(const Unit&) const {}
    __device__ __forceinline__ void done(const Unit&) const {}
};

__device__ __forceinline__ unsigned cvt_pk_bf16(float lo, float hi) { unsigned r; asm volatile("v_cvt_pk_bf16_f32 %0, %1, %2" : "=v"(r) : "v"(lo), "v"(hi)); return r; }
typedef float f32x2 __attribute__((ext_vector_type(2)));
__device__ __forceinline__ f32x2 gelu_pk(f32x2 v) {
    const f32x2 av = __builtin_elementwise_abs(v), d = av * 0.2316418882f + 1.0f;
    f32x2 t; t.x = __builtin_amdgcn_rcpf(d.x); t.y = __builtin_amdgcn_rcpf(d.y);
    f32x2 q = t * 0.5307027145f + (-0.7265760135f); q = q * t + 0.7107068705f; q = q * t + (-0.142248368f); q = q * t + 0.127414796f; q = q * t;
    const f32x2 s = (v * v) * (-0.72134752044f);
    f32x2 e; e.x = __builtin_amdgcn_exp2f(s.x); e.y = __builtin_amdgcn_exp2f(s.y);
    const f32x2 m = v * (q * e), r = v - m;
    f32x2 o; o.x = v.x < 0.f ? m.x : r.x; o.y = v.y < 0.f ? m.y : r.y; return o;
}

template <int ACT  > struct EpiBf16 {
    static constexpr bool PERM = true, AFTER_DRAIN = false; static_assert(ACT == 0 || ACT == 1, "EpiBf16: ACT is 0 (none) or 1 (gelu_pk)");
    bf16_t* O; int ldc; const float* bias; int split_cols; size_t split_stride; float scale0;
    __device__ __forceinline__ void operator()(const f32x4 (&acc)[2][2][4][2], const Unit& u, int wr, int wc, int fr, int fq) const {
        const int row0 = u.pm * BM + wr * 64 + fr; int colt = u.pn * BM; bf16_t* base = O;
        float sc = 1.f; if (split_cols) { const int t = colt / split_cols; base += (size_t)t * split_stride; colt -= t * split_cols; if (t == 0) sc = scale0; }
        const int col0 = colt + wc * 32 + 8 * fq, bcol0 = u.pn * BM + wc * 32 + 8 * fq;
        f32x4 bv[2][2];
#pragma unroll
        for (int bj = 0; bj < 2; ++bj)
#pragma unroll
            for (int n = 0; n < 2; ++n) bv[bj][n] = bias ? *(const f32x4*)(bias + bcol0 + bj * HALF + 4 * n) : (f32x4){0.f, 0.f, 0.f, 0.f};
#pragma unroll
        for (int ai = 0; ai < 2; ++ai)
#pragma unroll
            for (int m = 0; m < 4; ++m) { bf16_t* rowp = base + (size_t)(row0 + ai * HALF + m * 16) * ldc + col0;
#pragma unroll
                for (int bj = 0; bj < 2; ++bj) { f32x4 v0 = acc[ai][bj][m][0] + bv[bj][0], v1 = acc[ai][bj][m][1] + bv[bj][1];
                    if (ACT == 1) { f32x2 a = gelu_pk((f32x2){v0[0], v0[1]}), b = gelu_pk((f32x2){v0[2], v0[3]}), c = gelu_pk((f32x2){v1[0], v1[1]}), d = gelu_pk((f32x2){v1[2], v1[3]});
                        v0 = (f32x4){a.x, a.y, b.x, b.y}; v1 = (f32x4){c.x, c.y, d.x, d.y}; }
                    v0 = v0 * sc; v1 = v1 * sc; u32x4 w; w.x = cvt_pk_bf16(v0[0], v0[1]); w.y = cvt_pk_bf16(v0[2], v0[3]); w.z = cvt_pk_bf16(v1[0], v1[1]); w.w = cvt_pk_bf16(v1[2], v1[3]);
                    *(u32x4*)(rowp + bj * HALF) = w; } }
    }
};
struct EpiF16 {
    static constexpr bool PERM = true, AFTER_DRAIN = false;
    _Float16* O; int ldc;
    __device__ __forceinline__ void operator()(const f32x4 (&acc)[2][2][4][2], const Unit& u, int wr, int wc, int fr, int fq) const {
        typedef _Float16 h8 __attribute__((ext_vector_type(8)));
        const int row0 = u.pm * BM + wr * 64 + fr, col0 = u.pn * BM + wc * 32 + 8 * fq;
#pragma unroll
        for (int ai = 0; ai < 2; ++ai)
#pragma unroll
            for (int m = 0; m < 4; ++m) { _Float16* rowp = O + (size_t)(row0 + ai * HALF + m * 16) * ldc + col0;
#pragma unroll
                for (int bj = 0; bj < 2; ++bj) { const f32x4 a = acc[ai][bj][m][0], b = acc[ai][bj][m][1];
                    h8 o; o[0] = (_Float16)a[0]; o[1] = (_Float16)a[1]; o[2] = (_Float16)a[2]; o[3] = (_Float16)a[3]; o[4] = (_Float16)b[0]; o[5] = (_Float16)b[1]; o[6] = (_Float16)b[2]; o[7] = (_Float16)b[3];
                    *(h8*)(rowp + bj * HALF) = o; } }
    }
};
struct EpiResid {
    static constexpr bool PERM = true, AFTER_DRAIN = false;
    const bf16_t* res; _Float16* Y; int ldc; float alpha;
    __device__ __forceinline__ void operator()(const f32x4 (&acc)[2][2][4][2], const Unit& u, int wr, int wc, int fr, int fq) const {
        const int row0 = u.pm * BM + wr * 64 + fr, col0 = u.pn * BM + wc * 32 + 8 * fq;
#pragma unroll
        for (int ai = 0; ai < 2; ++ai)
#pragma unroll
            for (int m = 0; m < 4; ++m) { const size_t off = (size_t)(row0 + ai * HALF + m * 16) * ldc + col0;
#pragma unroll
                for (int bj = 0; bj < 2; ++bj) { const u32x4 rv = *(const u32x4*)(res + off + bj * HALF);
                    f32x4 r0, r1; r0[0] = __uint_as_float(rv.x << 16); r0[1] = __uint_as_float(rv.x & 0xffff0000u); r0[2] = __uint_as_float(rv.y << 16); r0[3] = __uint_as_float(rv.y & 0xffff0000u);
                    r1[0] = __uint_as_float(rv.z << 16); r1[1] = __uint_as_float(rv.z & 0xffff0000u); r1[2] = __uint_as_float(rv.w << 16); r1[3] = __uint_as_float(rv.w & 0xffff0000u);
                    const f32x4 y0 = r0 * alpha + acc[ai][bj][m][0], y1 = r1 * alpha + acc[ai][bj][m][1];
                    typedef _Float16 h8 __attribute__((ext_vector_type(8))); h8 w; w[0] = (_Float16)y0[0]; w[1] = (_Float16)y0[1]; w[2] = (_Float16)y0[2]; w[3] = (_Float16)y0[3]; w[4] = (_Float16)y1[0]; w[5] = (_Float16)y1[1]; w[6] = (_Float16)y1[2]; w[7] = (_Float16)y1[3];
                    *(h8*)(Y + off + bj * HALF) = w; } }
    }
};
struct EpiPle {
    static constexpr bool PERM = true, AFTER_DRAIN = false;
    const bf16_t* R; _Float16* Y; const bf16_t* E; const float* gb; int ldc;
    __device__ __forceinline__ void operator()(const f32x4 (&acc)[2][2][4][2], const Unit& u, int wr, int wc, int fr, int fq) const {
        const int row0 = u.pm * BM + wr * 64 + fr, col0 = u.pn * BM + wc * 32 + 8 * fq;
        f32x4 bv[2][2];
#pragma unroll
        for (int bj = 0; bj < 2; ++bj)
#pragma unroll
            for (int n = 0; n < 2; ++n) bv[bj][n] = *(const f32x4*)(gb + col0 + bj * HALF + 4 * n);
#pragma unroll
        for (int ai = 0; ai < 2; ++ai)
#pragma unroll
            for (int m = 0; m < 4; ++m) { const size_t off = (size_t)(row0 + ai * HALF + m * 16) * ldc + col0;
#pragma unroll
                for (int bj = 0; bj < 2; ++bj) {
                    const u32x4 ev = *(const u32x4*)(E + off + bj * HALF), rv = *(const u32x4*)(R + off + bj * HALF);
                    float o[8];
#pragma unroll
                    for (int n = 0; n < 2; ++n) {
                        const f32x4 z = acc[ai][bj][m][n] + bv[bj][n];
                        const unsigned e0 = n == 0 ? ev.x : ev.z, e1 = n == 0 ? ev.y : ev.w, r0 = n == 0 ? rv.x : rv.z, r1 = n == 0 ? rv.y : rv.w;
                        f32x4 ee, rr; ee[0] = __uint_as_float(e0 << 16); ee[1] = __uint_as_float(e0 & 0xffff0000u); ee[2] = __uint_as_float(e1 << 16); ee[3] = __uint_as_float(e1 & 0xffff0000u);
                        rr[0] = __uint_as_float(r0 << 16); rr[1] = __uint_as_float(r0 & 0xffff0000u); rr[2] = __uint_as_float(r1 << 16); rr[3] = __uint_as_float(r1 & 0xffff0000u);
#pragma unroll
                        for (int i = 0; i < 4; ++i) o[4 * n + i] = rr[i] + ee[i] * __builtin_amdgcn_rcpf(1.0f + __expf(-z[i])); }
                    typedef _Float16 h8 __attribute__((ext_vector_type(8))); h8 w;
#pragma unroll
                    for (int i = 0; i < 8; ++i) w[i] = (_Float16)o[i];
                    *(h8*)(Y + off + bj * HALF) = w; } }
    }
};
template <class Epi, class Sched, bool ALIGN_EPI = false, bool SP2 = false>
__device__ __forceinline__ void gemm_phase(PG8_LAS unsigned char* lds, const Gemm g, const Sched& S, const Epi& E) {
    const int tid = tid_l(), wid = __builtin_amdgcn_readfirstlane(tid >> 6), lane = tid & 63, wr = wid >> 2, wc = wid & 3, fr = lane & 15, fq = lane >> 4;
    const int K = g.K, nt = K / BK;
    unsigned voffA[2], voffB[2];
#pragma unroll
    for (int i = 0; i < 2; ++i) { int R, C; stage_rc(tid * 16 + i * 8192, R, C); const int Rb = Epi::PERM ? ((R & ~31) + perm32(R & 31)) : R;
        voffA[i] = (unsigned)(R * K + C) * 2u; voffB[i] = (unsigned)(Rb * K + C) * 2u; }
    const size_t kstep = (size_t)(BK * 2);
    const size_t hstep = (size_t)HALF * K * 2;
    const size_t tstep = 2 * hstep;
    const unsigned ldsw = (unsigned)wid * 1024u;
    const int aoff = lds_byte(wr * 64 + fr, fq * 8), boff = lds_byte(wc * 32 + fr, fq * 8);
#define PG8_SA(b, h) (((b) * 2 + (h)) * HTB)
#define PG8_SB(b, h) ((4 + (b) * 2 + (h)) * HTB)
#define PG8_STAGE(bufoff, gbase, voff) do { _Pragma("unroll") for (int _i = 0; _i < 2; ++_i) \
        __builtin_amdgcn_global_load_lds((const unsigned*)((const char*)(gbase) + (voff)[_i]), (PG8_LAS unsigned*)(lds + (bufoff) + ldsw + _i * 8192), 16, 0, 0); } while (0)
#define PG8_LDA(dst, b, h) do { _Pragma("unroll") for (int m = 0; m < 4; ++m) _Pragma("unroll") for (int k = 0; k < 2; ++k) dst[m][k] = *(const PG8_LAS bf16x8*)(lds + PG8_SA(b, h) + aoff + m * 2048 + k * 1024); } while (0)
#define PG8_LDB(dst, b, h) do { _Pragma("unroll") for (int n = 0; n < 2; ++n) _Pragma("unroll") for (int k = 0; k < 2; ++k) dst[n][k] = *(const PG8_LAS bf16x8*)(lds + PG8_SB(b, h) + boff + n * 2048 + k * 1024); } while (0)
#define PG8_MMA(ai, bj, At, Bt) do { __builtin_amdgcn_s_setprio(1); _Pragma("unroll") for (int m = 0; m < 4; ++m) _Pragma("unroll") for (int n = 0; n < 2; ++n) _Pragma("unroll") for (int k = 0; k < 2; ++k) \
        acc[ai][bj][m][n] = __builtin_amdgcn_mfma_f32_16x16x32_bf16(Bt[n][k], At[m][k], acc[ai][bj][m][n], 0, 0, 0); __builtin_amdgcn_s_setprio(0); } while (0)
#define PG8_WAIT_V(n) asm volatile("s_waitcnt vmcnt(" #n ")" ::: "memory")
#define PG8_WAIT_L(n) asm volatile("s_waitcnt lgkmcnt(" #n ")" ::: "memory")
#define PG8_BAR __builtin_amdgcn_s_barrier()
#define PG8_SCHED __builtin_amdgcn_sched_barrier(0)
    Unit cur, nxt; int ui = 0;
    if (!S.next(0, cur)) return;
    f32x4 acc[2][2][4][2];
#pragma unroll
    for (int a = 0; a < 2; ++a)
#pragma unroll
        for (int b = 0; b < 2; ++b)
#pragma unroll
            for (int m = 0; m < 4; ++m)
#pragma unroll
                for (int n = 0; n < 2; ++n) acc[a][b][m][n] = (f32x4){0.f, 0.f, 0.f, 0.f};
    bf16x8 At[4][2], B0[2][2], B1[2][2];
    const char* cA = (const char*)g.A + (size_t)cur.pm * tstep; const char* cB = (const char*)g.Bt + (size_t)cur.pn * tstep;
    S.a_ready(cur);
    if constexpr (SP2) {
        PG8_STAGE(PG8_SB(0, 0), cB, voffB); PG8_STAGE(PG8_SB(0, 1), cB + hstep, voffB); PG8_STAGE(PG8_SA(0, 0), cA, voffA); PG8_STAGE(PG8_SA(0, 1), cA + hstep, voffA);
        if (wr == 1) PG8_BAR;
        PG8_WAIT_V(2); PG8_BAR;
        PG8_STAGE(PG8_SB(1, 0), cB + kstep, voffB); PG8_STAGE(PG8_SA(1, 0), cA + kstep, voffA); PG8_STAGE(PG8_SB(1, 1), cB + hstep + kstep, voffB);
        PG8_WAIT_V(6); PG8_BAR;
    } else {
        PG8_STAGE(PG8_SB(0, 0), cB, voffB); PG8_STAGE(PG8_SA(0, 0), cA, voffA); PG8_STAGE(PG8_SB(0, 1), cB + hstep, voffB); PG8_STAGE(PG8_SA(0, 1), cA + hstep, voffA);
        if (wr == 1) PG8_BAR;
        PG8_WAIT_V(4); PG8_BAR;
        PG8_STAGE(PG8_SB(1, 0), cB + kstep, voffB); PG8_STAGE(PG8_SA(1, 0), cA + kstep, voffA); PG8_STAGE(PG8_SB(1, 1), cB + hstep + kstep, voffB);
        PG8_WAIT_V(6); PG8_BAR;
    }
    for (;;) {
        const bool has_next = S.next(ui + 1, nxt);
        const char* nA = has_next ? (const char*)g.A + (size_t)nxt.pm * tstep : cA; const char* nB = has_next ? (const char*)g.Bt + (size_t)nxt.pn * tstep : cB;
        for (int t = 0; t < nt; t += 2) {
            const bool last = (t == nt - 2);
            const char* a1 = cA + (size_t)(t + 1) * kstep;
            const char* a2 = last ? nA : cA + (size_t)(t + 2) * kstep; const char* b2 = last ? nB : cB + (size_t)(t + 2) * kstep;
            const char* a3 = a2 + kstep; const char* b3 = b2 + kstep;
            if (last && has_next) S.a_ready(nxt);
            if constexpr (SP2) {
            PG8_LDB(B0, 0, 0); PG8_LDB(B1, 0, 1); PG8_SCHED; PG8_LDA(At, 0, 0); PG8_STAGE(PG8_SA(1, 1), a1 + hstep, voffA);
            PG8_WAIT_V(8); PG8_WAIT_L(0); PG8_BAR; PG8_MMA(0, 0, At, B0); PG8_MMA(0, 1, At, B1); PG8_BAR; PG8_SCHED;
            PG8_LDA(At, 0, 1); PG8_STAGE(PG8_SB(0, 0), b2, voffB); PG8_STAGE(PG8_SB(0, 1), b2 + hstep, voffB); PG8_STAGE(PG8_SA(0, 0), a2, voffA);
            PG8_WAIT_V(8); PG8_WAIT_L(0); PG8_BAR; PG8_MMA(1, 0, At, B0); PG8_MMA(1, 1, At, B1); PG8_BAR; PG8_SCHED;
            PG8_LDB(B0, 1, 0); PG8_LDB(B1, 1, 1); PG8_SCHED; PG8_LDA(At, 1, 0); PG8_STAGE(PG8_SA(0, 1), a2 + hstep, voffA);
            PG8_WAIT_V(8); PG8_WAIT_L(0); PG8_BAR; PG8_MMA(0, 0, At, B0); PG8_MMA(0, 1, At, B1); PG8_BAR; PG8_SCHED;
            PG8_LDA(At, 1, 1); PG8_STAGE(PG8_SB(1, 0), b3, voffB); PG8_STAGE(PG8_SB(1, 1), b3 + hstep, voffB); PG8_STAGE(PG8_SA(1, 0), a3, voffA);
            PG8_WAIT_V(8); PG8_WAIT_L(0); PG8_BAR; PG8_MMA(1, 0, At, B0); PG8_MMA(1, 1, At, B1); PG8_BAR; PG8_SCHED;
            } else {
            PG8_LDB(B0, 0, 0); PG8_SCHED; PG8_LDA(At, 0, 0); PG8_STAGE(PG8_SA(1, 1), a1 + hstep, voffA);
            PG8_WAIT_L(8); PG8_BAR; PG8_WAIT_L(0); PG8_MMA(0, 0, At, B0); PG8_BAR; PG8_SCHED;
            PG8_LDB(B1, 0, 1); PG8_STAGE(PG8_SB(0, 0), b2, voffB);
            PG8_BAR; PG8_WAIT_L(0); PG8_MMA(0, 1, At, B1); PG8_BAR;
            PG8_LDA(At, 0, 1); PG8_STAGE(PG8_SA(0, 0), a2, voffA);
            PG8_BAR; PG8_WAIT_L(0); PG8_MMA(1, 0, At, B0); PG8_BAR; PG8_SCHED;
            PG8_STAGE(PG8_SB(0, 1), b2 + hstep, voffB);
            PG8_WAIT_V(6); PG8_BAR; PG8_MMA(1, 1, At, B1); PG8_BAR;
            PG8_LDB(B0, 1, 0); PG8_SCHED; PG8_LDA(At, 1, 0); PG8_STAGE(PG8_SA(0, 1), a2 + hstep, voffA);
            PG8_WAIT_L(8); PG8_BAR; PG8_WAIT_L(0); PG8_MMA(0, 0, At, B0); PG8_BAR; PG8_SCHED;
            PG8_LDB(B1, 1, 1); PG8_STAGE(PG8_SB(1, 0), b3, voffB);
            PG8_BAR; PG8_WAIT_L(0); PG8_MMA(0, 1, At, B1); PG8_BAR;
            PG8_LDA(At, 1, 1); PG8_STAGE(PG8_SA(1, 0), a3, voffA);
            PG8_BAR; PG8_WAIT_L(0); PG8_MMA(1, 0, At, B0); PG8_BAR; PG8_SCHED;
            PG8_STAGE(PG8_SB(1, 1), b3 + hstep, voffB);
            PG8_WAIT_V(6); PG8_BAR; PG8_MMA(1, 1, At, B1); PG8_BAR;
            }
        }
        if constexpr (ALIGN_EPI) { if (wr == 0) PG8_BAR; }
        if constexpr (!Epi::AFTER_DRAIN) { E(acc, cur, wr, wc, fr, fq); S.done(cur); }
        if (!has_next) break;
#pragma unroll
        for (int a = 0; a < 2; ++a)
#pragma unroll
            for (int b = 0; b < 2; ++b)
#pragma unroll
                for (int m = 0; m < 4; ++m)
#pragma unroll
                    for (int n = 0; n < 2; ++n) acc[a][b][m][n] = (f32x4){0.f, 0.f, 0.f, 0.f};
        cur = nxt; cA = nA; cB = nB; ++ui;
        if constexpr (ALIGN_EPI) { if (wr == 1) PG8_BAR; }
    }
    PG8_WAIT_V(0);
    if constexpr (!ALIGN_EPI) { if (wr == 0) PG8_BAR; }
    PG8_BAR;
    if constexpr (Epi::AFTER_DRAIN) { E.fused(acc, cur, wr, wc, fr, fq, lds, wid, lane); S.done(cur); }
#undef PG8_SA
#undef PG8_SB
#undef PG8_STAGE
#undef PG8_LDA
#undef PG8_LDB
#undef PG8_MMA
#undef PG8_WAIT_V
#undef PG8_WAIT_L
#undef PG8_BAR
#undef PG8_SCHED
}
}
#include <hip/hip_bf16.h>
#include <cmath>
namespace attn_body {
using bf16=__hip_bfloat16;
using bf16x8=__attribute__((ext_vector_type(8)))short;
using s16x4=__attribute__((ext_vector_type(4)))short;
using f32x16=__attribute__((ext_vector_type(16)))float;
using u32x4=__attribute__((ext_vector_type(4)))unsigned;
constexpr int BATCH=8,NHEAD=6,SEQ=4096,D=64,KVP=3072,OP=1024;
constexpr int NW=8,QBLK=32,QB=QBLK*NW,KVBLK=64,NQB=SEQ/QB;
constexpr int ATTN_UNIT_ROWS=QB;
__device__ __forceinline__ int crow(int r,int hi){return (r&3)+8*(r>>2)+4*hi;}
#define SBAR() __builtin_amdgcn_sched_barrier(0)
__device__ __forceinline__ void cmask(f32x16&p0,f32x16&p1,int jb,int qrel,int hi){
  const float NEG=-INFINITY; int kb=64*jb+4*hi;
  #pragma unroll
  for(int r=0;r<16;++r){int kv=kb+(r&3)+8*(r>>2); if(kv>qrel)p0[r]=NEG; if(kv+32>qrel)p1[r]=NEG;}
}

constexpr int NSLOT=3, SLOTB=8192;
constexpr int LDS_K=0, LDS_V=NSLOT*SLOTB, LDS_WS=2*NSLOT*SLOTB, LDS_OST=LDS_WS+NW*64*4, LDS_CK=LDS_OST+NW*4096, LDS_BYTES=LDS_CK+SEQ*4;
constexpr float C2=0.125f*1.4426950408889634f;
__device__ __forceinline__ void glds16(const void*gsrc,unsigned lds_dst){unsigned keep;
  asm volatile("s_mov_b32 %0, m0\n\ts_mov_b32 m0, %2\n\ts_nop 0\n\tglobal_load_lds_dwordx4 %1, off\n\ts_mov_b32 m0, %0":"=&s"(keep):"v"(gsrc),"s"(lds_dst):"memory");}
__device__ __forceinline__ float max3f(float a,float b,float c){float r;asm("v_max3_f32 %0, %1, %2, %3":"=v"(r):"v"(a),"v"(b),"v"(c));return r;}
__device__ __forceinline__ float max2f(float a,float b){float r;asm("v_max_f32_e32 %0, %1, %2":"=v"(r):"v"(a),"v"(b));return r;}
__device__ __forceinline__ float fadd_s(float a,float b){float r;asm("v_add_f32_e32 %0, %1, %2":"=v"(r):"v"(a),"v"(b));return r;}
__device__ __forceinline__ float fsub_s(float a,float b){float r;asm("v_sub_f32_e32 %0, %1, %2":"=v"(r):"v"(a),"v"(b));return r;}
typedef float f32x2_t __attribute__((ext_vector_type(2))); typedef float f32x4_t __attribute__((ext_vector_type(4))); typedef __bf16 bf16x2_t __attribute__((ext_vector_type(2)));
__device__ __forceinline__ unsigned cvtpk_s(float lo,float hi){f32x2_t v={lo,hi};bf16x2_t b=__builtin_convertvector(v,bf16x2_t);return __builtin_bit_cast(unsigned,b);}
#define WAIT_BAR(N) asm volatile("s_waitcnt vmcnt(" #N ") lgkmcnt(0)\n\ts_barrier":::"memory")

__device__ __forceinline__ void qkt(f32x16&p0,f32x16&p1,const char*Kslot,const bf16x8*qr,int r32,int hi){
  const char*kb=Kslot+hi*1024+r32*16;
  #pragma unroll
  for(int d0=0;d0<4;++d0){
    const bf16x8 b0=*reinterpret_cast<const bf16x8*>(kb+d0*2048);
    const bf16x8 b1=*reinterpret_cast<const bf16x8*>(kb+d0*2048+512);
    {p0=__builtin_amdgcn_mfma_f32_32x32x16_bf16(b0,qr[d0],p0,0,0,0);p1=__builtin_amdgcn_mfma_f32_32x32x16_bf16(b1,qr[d0],p1,0,0,0);}}
}
typedef __attribute__((address_space(3))) const char* lds_cptr;
typedef short v4i16_t __attribute__((ext_vector_type(4)));
__device__ __forceinline__ void kload8(bf16x8*kf,lds_cptr kp){
  kf[0]=*(const __attribute__((address_space(3))) bf16x8*)(kp);      kf[1]=*(const __attribute__((address_space(3))) bf16x8*)(kp+512);
  kf[2]=*(const __attribute__((address_space(3))) bf16x8*)(kp+2048); kf[3]=*(const __attribute__((address_space(3))) bf16x8*)(kp+2560);
  kf[4]=*(const __attribute__((address_space(3))) bf16x8*)(kp+4096); kf[5]=*(const __attribute__((address_space(3))) bf16x8*)(kp+4608);
  kf[6]=*(const __attribute__((address_space(3))) bf16x8*)(kp+6144); kf[7]=*(const __attribute__((address_space(3))) bf16x8*)(kp+6656);
}
__device__ __forceinline__ void kload2(bf16x8*kf,lds_cptr kp,int j){ kf[2*j]=*(const __attribute__((address_space(3))) bf16x8*)(kp+j*2048); kf[2*j+1]=*(const __attribute__((address_space(3))) bf16x8*)(kp+j*2048+512); }
__device__ __forceinline__ s16x4 vtr(lds_cptr p){ return __builtin_bit_cast(s16x4,__builtin_amdgcn_ds_read_tr16_b64_v4i16((__attribute__((address_space(3))) v4i16_t*)p)); }
__device__ __forceinline__ float rowmax(const f32x16&p0,const f32x16&p1){
  float a=max3f(p0[0],p0[1],p1[0]),b=max3f(p0[2],p0[3],p1[1]);a=max3f(a,p1[2],p1[3]);
  #pragma unroll
  for(int r=4;r<16;r+=4){a=max3f(a,p0[r],p0[r+1]);b=max3f(b,p0[r+2],p0[r+3]);a=max3f(a,p1[r],p1[r+1]);b=max3f(b,p1[r+2],p1[r+3]);}
  const float m=max2f(a,b);
  auto rr=__builtin_amdgcn_permlane32_swap(__float_as_uint(m),__float_as_uint(m),false,false);
  return max2f(__uint_as_float(rr[0]),__uint_as_float(rr[1]));
}
__device__ __forceinline__ void pv(f32x16*o,int vb,bf16x8 pa0,bf16x8 pa1,bf16x8 pa2,bf16x8 pa3){
  #pragma unroll
  for(int d0=0;d0<2;++d0){s16x4 lo[4],hi[4];
    #pragma unroll
    for(int ks=0;ks<4;++ks){
      asm volatile("ds_read_b64_tr_b16 %0,%1 offset:%c2":"=&v"(lo[ks]):"v"(vb),"i"(d0*4096+ks*1024):"memory");
      asm volatile("ds_read_b64_tr_b16 %0,%1 offset:%c2":"=&v"(hi[ks]):"v"(vb),"i"(d0*4096+ks*1024+512):"memory");}
    asm volatile("s_waitcnt lgkmcnt(0)":::"memory");SBAR();
    #define PK(k) (bf16x8){lo[k][0],lo[k][1],lo[k][2],lo[k][3],hi[k][0],hi[k][1],hi[k][2],hi[k][3]}
    o[d0]=__builtin_amdgcn_mfma_f32_32x32x16_bf16(pa0,PK(0),o[d0],0,0,0);
    o[d0]=__builtin_amdgcn_mfma_f32_32x32x16_bf16(pa1,PK(1),o[d0],0,0,0);
    o[d0]=__builtin_amdgcn_mfma_f32_32x32x16_bf16(pa2,PK(2),o[d0],0,0,0);
    o[d0]=__builtin_amdgcn_mfma_f32_32x32x16_bf16(pa3,PK(3),o[d0],0,0,0);
    #undef PK
  }
}

#ifndef ATTN_STORE16
#define ATTN_STORE16(p,v) (*(u32x4*)(p)=(v))
#endif
template<int THRL> __device__ __forceinline__ void attn_unit(int b,int h,int qb,const bf16*Q,const bf16*__restrict__ K,const bf16*__restrict__ V,bf16*O,const float*__restrict__ CKg,const float*__restrict__ KTm,const float*__restrict__ QBm,char*shm){
  const int tid=tid_l(),lane=tid&63,r32=lane&31,hi=lane>>5; const int wid=__builtin_amdgcn_readfirstlane(tid>>6);
  const long rowbase=(long)b*SEQ; const int q0=qb*QB;
  const bf16*Qw=Q+(rowbase+q0+wid*QBLK)*KVP+h*D;
  const float*ckg=CKg+(long)(b*NHEAD+h)*SEQ;
  int j0=0;
  { const int bh_=b*NHEAD+h, NT0_=(q0+QB)/KVBLK; const float qmx=QBm[bh_*NQB+qb]*1.01f;
    const float kd=fmaxf(fmaxf(KTm[bh_*64+4*qb],KTm[bh_*64+4*qb+1]),fmaxf(KTm[bh_*64+4*qb+2],KTm[bh_*64+4*qb+3]));
    const float thr=-(qmx*kd)-48.f; bool skip=false;
    if(lane<NT0_-4){ const float bound=qmx*KTm[bh_*64+lane]+(ckg[q0]-ckg[64*lane+63]); skip=bound<thr; }
    const unsigned long long m_=__ballot(skip); j0=__builtin_ctzll(~m_); j0=(j0<NT0_-4?j0:NT0_-4)&~1; j0=__builtin_amdgcn_readfirstlane(j0); }
  const bf16*Kh=K+(rowbase+(long)j0*KVBLK)*KVP+h*D,*Vh=V+(rowbase+(long)j0*KVBLK)*KVP+h*D;
  const unsigned lds0=(unsigned)(uintptr_t)shm;
  float*wsf=(float*)(shm+LDS_WS)+wid*64;
  const bf16*ksrc=Kh+(long)lane*KVP+wid*8;
  const bf16*vsrc=Vh+(long)(16*(wid&3)+(lane>>2))*KVP+(wid>>2)*32+(lane&3)*8;
  const unsigned kdst=lds0+LDS_K+wid*1024, vdst=lds0+LDS_V+wid*1024;
  #define DMA_K(t,slot) glds16(ksrc+(long)(t)*KVBLK*KVP,(unsigned)__builtin_amdgcn_readfirstlane(kdst+(slot)))
  #define DMA_V(t,slot) glds16(vsrc+(long)(t)*KVBLK*KVP,(unsigned)__builtin_amdgcn_readfirstlane(vdst+(slot)))
  const int vb0=(int)(lds0+LDS_V)+((lane>>4)&1)*32+(lane&3)*8+(4*hi+((lane&15)>>2))*64;
  const char*Kbase=shm+LDS_K; bf16x8 kf[8];
  const lds_cptr shm3=(lds_cptr)shm; const lds_cptr kp0=shm3+LDS_K+hi*1024+r32*16; const lds_cptr vp0=shm3+LDS_V+((lane>>4)&1)*32+(lane&3)*8+(4*hi+((lane&15)>>2))*64;
  const int NT=(q0+QB)/KVBLK-j0;
  float*cks=(float*)(shm+LDS_CK);
  for(int i=j0*KVBLK+tid*4;i<q0+QB;i+=NW*64*4){ *(f32x4_t*)(cks+i)=*(const f32x4_t*)(ckg+i); }
  float cqm=ckg[q0+wid*QBLK+r32];
  const lds_cptr ckp=(lds_cptr)shm+LDS_CK+j0*256+hi*16;
  DMA_K(0,0);DMA_V(0,0);DMA_K(1,SLOTB);
  bf16x8 qr[4];
  #pragma unroll
  for(int d0=0;d0<4;++d0)qr[d0]=*reinterpret_cast<const bf16x8*>(&Qw[(long)r32*KVP+d0*16+hi*8]);
  float l_reg=0.f;f32x16 o[2];o[0]=f32x16{};o[1]=f32x16{};
  #define CINIT(C0,C1,t) do{ const lds_cptr cp_=ckp+(t)*256; \
    _Pragma("unroll") for(int g_=0;g_<4;++g_){ const f32x4_t a_=*(const __attribute__((address_space(3))) f32x4_t*)(cp_+g_*32); const f32x4_t b_=*(const __attribute__((address_space(3))) f32x4_t*)(cp_+g_*32+128); \
      _Pragma("unroll") for(int i_=0;i_<4;++i_){ C0[g_*4+i_]=cqm-a_[i_]; C1[g_*4+i_]=cqm-b_[i_]; } } }while(0)
  const int qrel=wid*QBLK+r32;
  #define CMASK(P0,P1,t) do{int jb_=(t)-(NT-4); if(jb_>=0)cmask(P0,P1,jb_,qrel,hi);}while(0)
  bool resc=false;
  #define START(P0,P1) do{ const float rm=rowmax(P0,P1); resc=false; \
    { const float dl=rm; \
      _Pragma("unroll") for(int r=0;r<16;++r){P0[r]=fsub_s(P0[r],dl);P1[r]=fsub_s(P1[r],dl);} \
      cqm=fsub_s(cqm,dl); } \
    _Pragma("unroll") for(int r=0;r<16;++r)P0[r]=__builtin_amdgcn_exp2f(P0[r]); }while(0)
  #define RESC() do{ if(resc){ asm volatile("s_waitcnt lgkmcnt(0)":::"memory"); \
      _Pragma("unroll") for(int d_=0;d_<2;++d_) _Pragma("unroll") for(int r=0;r<16;++r)o[d_][r]*=wsf[crow(r,hi)]; } }while(0)
  f32x16 pA0,pA1,pB0,pB1;
  int sl_prev=0,sl_cur=0,sl_next=SLOTB;
  #define ROT() do{sl_prev=sl_cur;sl_cur=sl_next;sl_next=(sl_next==(NSLOT-1)*SLOTB)?0:sl_next+SLOTB;}while(0)
  DMA_K(2,2*SLOTB);
  WAIT_BAR(3);
  CINIT(pA0,pA1,0);
  qkt(pA0,pA1,Kbase,qr,r32,hi);asm volatile("s_nop 15\n\ts_nop 7":"+v"(pA0),"+v"(pA1));CMASK(pA0,pA1,0);
  START(pA0,pA1);
  _Pragma("unroll") for(int r=0;r<16;++r)pA1[r]=__builtin_amdgcn_exp2f(pA1[r]);
  WAIT_BAR(0);
  DMA_K(3,0);DMA_V(1,SLOTB);
  ROT();
  kload8(kf,kp0+sl_cur);
  WAIT_BAR(2);
  s16x4 vlo[8],vhi[8]; u32x4 pw0,pw1,pw2,pw3;
  #define PKW(P,B) cvtpk_s(P[B],P[B+1])
  #define PAF(k) __builtin_bit_cast(bf16x8,pw##k)
  #define VFR(i) (bf16x8){vlo[i][0],vlo[i][1],vlo[i][2],vlo[i][3],vhi[i][0],vhi[i][1],vhi[i][2],vhi[i][3]}
  #define PIN(x) asm volatile("":"+v"(x))
  #define MX3(a,b,c) __builtin_fmaxf(__builtin_fmaxf((a),(b)),(c))
  #define GAPA(MF,A0,A1,A2,A3,W0,W1,PW) do{ MF; sacc+=A0; sacc+=A1; sacc+=A2; sacc+=A3; PIN(sacc); W0; W1; PIN(PW); SBAR(); }while(0)
  #define EX(v) __builtin_amdgcn_exp2f(v)
  #define GAPB(MF,X,B) do{ MF; X[B]=EX(X[B]); X[B+1]=EX(X[B+1]); X[B+2]=EX(X[B+2]); X[B+3]=EX(X[B+3]); PIN(X); SBAR(); }while(0)
  #define VRD(i) do{ vlo[i]=vtr(vp_+(((i)>>2)*4096+((i)&3)*1024)); vhi[i]=vtr(vp_+(((i)>>2)*4096+((i)&3)*1024+512)); }while(0)
  #define KRD(G,j) do{ if(G){ kload2(kf,kp0+sl_next,j); SBAR(); } }while(0)
  #define STEP(C0,C1,P0,P1,t,GK,GV,GL) do{ SBAR(); \
    CINIT(C0,C1,t); SBAR(); \
    const lds_cptr vp_=vp0+sl_prev; \
    VRD(0); SBAR(); float sacc=(P0[0]+P0[1]); \
    GAPA(C0=__builtin_amdgcn_mfma_f32_32x32x16_bf16(kf[0],qr[0],C0,0,0,0), P0[2],P0[3],P0[4],P0[5],     pw0[0]=PKW(P0,0), pw0[1]=PKW(P0,2), pw0); \
    VRD(4); SBAR(); GAPA(C1=__builtin_amdgcn_mfma_f32_32x32x16_bf16(kf[1],qr[0],C1,0,0,0), P0[6],P0[7],P0[8],P0[9],     pw0[2]=PKW(P0,4), pw0[3]=PKW(P0,6), pw0); \
    VRD(1); SBAR(); GAPA(C0=__builtin_amdgcn_mfma_f32_32x32x16_bf16(kf[2],qr[1],C0,0,0,0),   P0[10],P0[11],P0[12],P0[13], pw1[0]=PKW(P0,8), pw1[1]=PKW(P0,10), pw1); \
    VRD(5); SBAR(); GAPA(C1=__builtin_amdgcn_mfma_f32_32x32x16_bf16(kf[3],qr[1],C1,0,0,0),   P0[14],P0[15],P1[0],P1[1],   pw1[2]=PKW(P0,12),pw1[3]=PKW(P0,14), pw1); \
    VRD(2); SBAR(); GAPA(C0=__builtin_amdgcn_mfma_f32_32x32x16_bf16(kf[4],qr[2],C0,0,0,0),   P1[2],P1[3],P1[4],P1[5],     pw2[0]=PKW(P1,0), pw2[1]=PKW(P1,2), pw2); \
    VRD(6); SBAR(); GAPA(C1=__builtin_amdgcn_mfma_f32_32x32x16_bf16(kf[5],qr[2],C1,0,0,0),   P1[6],P1[7],P1[8],P1[9],     pw2[2]=PKW(P1,4), pw2[3]=PKW(P1,6), pw2); \
    VRD(3); SBAR(); GAPA(C0=__builtin_amdgcn_mfma_f32_32x32x16_bf16(kf[6],qr[3],C0,0,0,0),   P1[10],P1[11],P1[12],P1[13], pw3[0]=PKW(P1,8), pw3[1]=PKW(P1,10), pw3); \
    VRD(7); SBAR(); GAPA(C1=__builtin_amdgcn_mfma_f32_32x32x16_bf16(kf[7],qr[3],C1,0,0,0),   P1[14],P1[15],0.f,0.f,       pw3[2]=PKW(P1,12),pw3[3]=PKW(P1,14), pw3); \
    l_reg+=sacc; \
    if(GK){DMA_K((t)+3,sl_cur);} if(GV){DMA_V((t)+1,sl_next);} \
    CMASK(C0,C1,t); \
    { float a=MX3(C0[0],C0[1],C1[0]),b=MX3(C0[2],C0[3],C1[1]); a=MX3(a,C1[2],C1[3]); \
      _Pragma("unroll") for(int r=4;r<16;r+=4){a=MX3(a,C0[r],C0[r+1]);b=MX3(b,C0[r+2],C0[r+3]);a=MX3(a,C1[r],C1[r+1]);b=MX3(b,C1[r+2],C1[r+3]);} \
      float rm=__builtin_fmaxf(a,b); { auto rr=__builtin_amdgcn_permlane32_swap(__float_as_uint(rm),__float_as_uint(rm),false,false); rm=__builtin_fmaxf(__uint_as_float(rr[0]),__uint_as_float(rr[1])); } \
      resc=false; \
      if(__builtin_expect(__any(rm>(float)THRL),0)){ const float dl=__builtin_fmaxf(rm,0.f); \
        _Pragma("unroll") for(int r=0;r<16;++r){C0[r]-=dl;C1[r]-=dl;} \
        cqm-=dl; \
        const float f=__builtin_amdgcn_exp2f(-dl); l_reg*=f; if(hi==0)wsf[r32]=f; resc=true; } } \
    SBAR(); \
    GAPB(o[0]=__builtin_amdgcn_mfma_f32_32x32x16_bf16(PAF(0),VFR(0),o[0],0,0,0), C0,0); \
    GAPB(o[1]=__builtin_amdgcn_mfma_f32_32x32x16_bf16(PAF(0),VFR(4),o[1],0,0,0), C0,4); \
    KRD(GL,0); GAPB(o[0]=__builtin_amdgcn_mfma_f32_32x32x16_bf16(PAF(1),VFR(1),o[0],0,0,0), C0,8); \
    KRD(GL,1); GAPB(o[1]=__builtin_amdgcn_mfma_f32_32x32x16_bf16(PAF(1),VFR(5),o[1],0,0,0), C0,12); \
    KRD(GL,2); GAPB(o[0]=__builtin_amdgcn_mfma_f32_32x32x16_bf16(PAF(2),VFR(2),o[0],0,0,0), C1,0); \
    KRD(GL,3); GAPB(o[1]=__builtin_amdgcn_mfma_f32_32x32x16_bf16(PAF(2),VFR(6),o[1],0,0,0), C1,4); \
    GAPB(o[0]=__builtin_amdgcn_mfma_f32_32x32x16_bf16(PAF(3),VFR(3),o[0],0,0,0), C1,8); \
    GAPB(o[1]=__builtin_amdgcn_mfma_f32_32x32x16_bf16(PAF(3),VFR(7),o[1],0,0,0), C1,12); \
    }while(0)
  int t=1;
  #undef CMASK
  #define CMASK(P0,P1,t) do{}while(0)
  for(;t+5<NT;t+=2){
    STEP(pB0,pB1,pA0,pA1,t,true,true,true);     WAIT_BAR(2); RESC(); ROT();
    STEP(pA0,pA1,pB0,pB1,t+1,true,true,true);   WAIT_BAR(2); RESC(); ROT();
  }
  #undef CMASK
  #define CMASK(P0,P1,t) do{int jb_=(t)-(NT-4); if(jb_>=0)cmask(P0,P1,jb_,qrel,hi);}while(0)
  #define ENDW(tt) do{ if((tt)+3<NT){WAIT_BAR(2);} else if((tt)+2<NT){WAIT_BAR(1);} else {WAIT_BAR(0);} }while(0)
  for(;t+1<NT;t+=2){
    STEP(pB0,pB1,pA0,pA1,t,(t+3<NT),(t+1<NT),(t+1<NT));       ENDW(t);   RESC(); ROT();
    STEP(pA0,pA1,pB0,pB1,t+1,(t+4<NT),(t+2<NT),(t+2<NT));     ENDW(t+1); RESC(); ROT();
  }
  STEP(pB0,pB1,pA0,pA1,NT-1,false,false,false); RESC();
  { float sacc=pB0[0]+pB0[1]; _Pragma("unroll") for(int r=2;r<16;++r)sacc+=pB0[r]; _Pragma("unroll") for(int r=0;r<16;++r)sacc+=pB1[r]; l_reg+=sacc;
    pw0=(u32x4){PKW(pB0,0),PKW(pB0,2),PKW(pB0,4),PKW(pB0,6)};pw1=(u32x4){PKW(pB0,8),PKW(pB0,10),PKW(pB0,12),PKW(pB0,14)};pw2=(u32x4){PKW(pB1,0),PKW(pB1,2),PKW(pB1,4),PKW(pB1,6)};pw3=(u32x4){PKW(pB1,8),PKW(pB1,10),PKW(pB1,12),PKW(pB1,14)};
    SBAR(); pv(o,vb0+sl_cur,PAF(0),PAF(1),PAF(2),PAF(3)); }
  #undef PKW
  #undef PAF
  #undef VFR
  #undef PIN
  #undef MX3
  #undef GAPA
  #undef GAPB
  #undef EX
  #undef VRD
  #undef KRD
  #undef STEP
  #undef ENDW
  {auto rr=__builtin_amdgcn_permlane32_swap(__float_as_uint(l_reg),__float_as_uint(l_reg),false,false);l_reg=__uint_as_float(rr[0])+__uint_as_float(rr[1]);}
  if(hi==0)wsf[32+r32]=l_reg;asm volatile("s_waitcnt lgkmcnt(0)":::"memory");
  float rli[16];
  #pragma unroll
  for(int r=0;r<16;++r)rli[r]=__builtin_amdgcn_rcpf(wsf[32+crow(r,hi)]);
  bf16*Ow=O+(rowbase+q0+wid*QBLK)*OP+h*D;
  { bf16*stg=(bf16*)(shm+LDS_OST)+wid*2048;
    #pragma unroll
    for(int r=0;r<16;++r){const int orow=crow(r,hi);
      #pragma unroll
      for(int d0=0;d0<2;++d0)stg[orow*64+d0*32+r32]=__float2bfloat16(o[d0][r]*rli[r]);}
    asm volatile("s_waitcnt lgkmcnt(0)":::"memory");
    #pragma unroll
    for(int i=0;i<4;++i){const int row=i*8+(lane>>3),ch=lane&7; const u32x4 v=*(const u32x4*)(stg+row*64+ch*8); ATTN_STORE16(Ow+(long)row*OP+ch*8,v);} }
  asm volatile("s_waitcnt lgkmcnt(0)\n\ts_barrier":::"memory");
  #undef DMA_K
  #undef DMA_V
  #undef CMASK
  #undef START
  #undef RESC
  #undef ROT
  #undef CINIT
}
constexpr int ATTN_LDS_BYTES=LDS_BYTES;
struct AttnTensors { const bf16* Q; const bf16* K; const bf16* V; bf16* O; const float* CK; const float* KT; const float* QB; };
struct AttnUnit { int bh; int qb; };
struct QueueOrder {
  unsigned* head; volatile __attribute__((address_space(3))) int* slot;
  __device__ __forceinline__ bool next(int,AttnUnit&u)const{
    if(tid_l()==0) *slot=(int)__hip_atomic_fetch_add(head,1u,__ATOMIC_RELAXED,__HIP_MEMORY_SCOPE_AGENT);
    __syncthreads(); const int v=*slot; __syncthreads();
    if(v>=BATCH*NHEAD*NQB)return false; u.qb=NQB-1-v/(BATCH*NHEAD); u.bh=v%(BATCH*NHEAD); return true; }
  __device__ __forceinline__ void a_ready(const AttnUnit&)const{}
  __device__ __forceinline__ void done(const AttnUnit&)const{}
};
template<class Sched,int THRL=8> __device__ __forceinline__ void attn_phase(char*lds,const AttnTensors&T,const Sched&S){
  AttnUnit u;
  for(int i=0;S.next(i,u);++i){ S.a_ready(u); attn_unit<THRL>(u.bh/NHEAD,u.bh%NHEAD,u.qb,T.Q,T.K,T.V,T.O,T.CK,T.KT,T.QB,lds); S.done(u); }
}
#undef SBAR
#undef WAIT_BAR
}

constexpr int NB = 8, SEQ = 4096, T = NB * SEQ, D = 1024, DEPTH = 4;
constexpr int HCOLS = 3072;
constexpr int HC_AVAL = 0, HC_AGATE = 256, HC_BQ = 512, HC_BK = 704, HC_BV = 896, HC_BG = 1280, HC_CQ = 1664, HC_CK = 2048, HC_CV = 2432, HC_LR = 2816, HC_CF = 2832;
constexpr int IN_COLS = 2838;
constexpr int MC_A = 0, MC_B = 256, MC_C = 640;
constexpr float LN_EPS = 1e-5f;
constexpr float ALPHA = 1.6817928305074292f;
constexpr float LOG2E = 1.4426950408889634f;
constexpr float C2 = 0.125f * LOG2E;
constexpr float GLA_QSCALE = 0.17677669529663687f;
constexpr int NEXP = 16384;

constexpr size_t MiB = 1u << 20;
constexpr size_t WS_CTL = 0, CTL_ZERO_BYTES = 1 * MiB;
constexpr size_t WS_WIN = 1 * MiB;
constexpr size_t WS_WOUT = WS_WIN + 24 * MiB;
constexpr size_t WS_WP = WS_WOUT + 8 * MiB;
constexpr size_t WS_PGW = WS_WP + 16 * MiB;
constexpr size_t WS_PW = WS_PGW + 8 * MiB;
constexpr size_t WS_CK = WS_PW + 2 * MiB;
constexpr size_t WS_FKT = WS_CK + 768 * 1024, WS_FQB = WS_FKT + 16 * 1024;
constexpr size_t WS_U = WS_CK + 1 * MiB;
constexpr size_t WS_V = WS_U + 32 * MiB;
constexpr size_t WS_XB = WS_V + 32 * MiB;
constexpr size_t WS_XF = WS_XB + 64 * MiB;
constexpr size_t WS_XQ = WS_XF, WS_XS = WS_XF + 32 * MiB, WS_RS = WS_XS + 1 * MiB, WS_VS = WS_RS + 65536;
constexpr size_t WS_PB = WS_XF + 128 * MiB;
constexpr size_t WS_H = WS_PB + 16 * MiB;
constexpr size_t WS_MIX = WS_H + 192 * MiB;
constexpr size_t WS_SC = WS_H;
constexpr size_t WS_Y = WS_MIX + 64 * MiB;
constexpr size_t WS_GCUM = WS_Y;
constexpr size_t WS_GS = WS_GCUM + 24 * MiB;
constexpr size_t WS_GDEC = WS_GS + 24 * MiB;
constexpr size_t WS_E = WS_Y + 128 * MiB;
constexpr size_t WS_EIDX = WS_E + 64 * MiB;
constexpr size_t WS_GATE = WS_EIDX + 16 * MiB;
constexpr size_t WS_SOFF = WS_GATE + 16 * MiB;
constexpr size_t WS_END = WS_SOFF + 1 * MiB;
static_assert(WS_END <= 1024 * MiB, "d_ws map");

constexpr int LDS_BYTES = 147456;

typedef unsigned short bf16;
typedef float f32x4 __attribute__((ext_vector_type(4)));
typedef unsigned u32x4 __attribute__((ext_vector_type(4)));
typedef unsigned u32x2 __attribute__((ext_vector_type(2)));

struct Params {
    const float *x, *p, *w_in, *conv_w, *conv_b, *conv_ln_g, *conv_ln_b, *gla_gate_w, *gla_gate_b, *gla_norm_g, *fox_forget_b, *w_out, *ln1_g, *ln1_b,
        *peer_wq, *peer_keys, *peer_u, *peer_v, *ple_w, *ple_gw, *ple_gb, *ln2_g, *ln2_b;
    float* out; unsigned char* ws;
};

__device__ __forceinline__ float bf2f(unsigned h) { return __uint_as_float(h << 16); }
__device__ __forceinline__ unsigned f2bf(float f) { unsigned u = __float_as_uint(f); return (u + 0x7fffu + ((u >> 16) & 1u)) >> 16; }
__device__ __forceinline__ unsigned pk2(float lo, float hi) { return f2bf(lo) | (f2bf(hi) << 16); }
__device__ __forceinline__ float wave_sum(float v) {
#pragma unroll
    for (int o = 1; o < 64; o <<= 1) v += __shfl_xor(v, o);
    return v;
}
__device__ __forceinline__ float log_sigmoid(float z) { return fminf(z, 0.f) - log1pf(__expf(-fabsf(z))); }
__device__ __forceinline__ float sigmoidf_(float z) { return 1.0f / (1.0f + __expf(-z)); }

struct MapIdent { __device__ __forceinline__ void operator()(int n, int& c, float& s) const { c = n; s = 1.f; } };
struct MapWin {
    __device__ __forceinline__ void operator()(int n, int& c, float& s) const {
        s = 1.f;
        if (n < HC_CQ) { c = n; if (n >= HC_BQ && n < HC_BK) s = GLA_QSCALE; }
        else if (n < HC_LR) { c = n + 16; if (n < HC_CK) s = C2; }
        else if (n < HC_CF) c = n - HC_LR + 1664;
        else if (n < IN_COLS) c = n;
        else c = -1;
    }
};
template <class CM>
__device__ __forceinline__ void transpose_item(const float* W, int K, int Nsrc, bf16* WT, int item, int nblk, float* scr, int lane, const CM& cm) {
    const int kb = item / nblk, nb = item % nblk, k0 = 64 * kb, n0 = 32 * nb;
    int sc; float scale; cm(n0 + (lane & 31), sc, scale);
#pragma unroll
    for (int i = 0; i < 32; ++i) { const int kk = 2 * i + (lane >> 5); scr[kk * 33 + (lane & 31)] = sc >= 0 ? W[(size_t)(k0 + kk) * Nsrc + sc] * scale : 0.f; }
    __builtin_amdgcn_wave_barrier(); asm volatile("s_waitcnt lgkmcnt(0)" ::: "memory");
    const int c = lane & 7;
#pragma unroll
    for (int j = 0; j < 4; ++j) { const int n = (lane >> 3) + 8 * j; const float* s = scr + (8 * c) * 33 + n;
        u32x4 o; o.x = pk2(s[0 * 33], s[1 * 33]); o.y = pk2(s[2 * 33], s[3 * 33]); o.z = pk2(s[4 * 33], s[5 * 33]); o.w = pk2(s[6 * 33], s[7 * 33]);
        *(u32x4*)(WT + (size_t)(n0 + n) * K + k0 + 8 * c) = o; }
    asm volatile("s_waitcnt lgkmcnt(0)" ::: "memory"); __builtin_amdgcn_wave_barrier();
}
__device__ __forceinline__ void cvt_bf16_stream(const float* src, bf16* dst, size_t n8, size_t gtid, size_t gthreads) {
    for (size_t i = gtid; i < n8; i += gthreads) { const f32x4 a = *(const f32x4*)(src + i * 8), b = *(const f32x4*)(src + i * 8 + 4);
        u32x4 o; o.x = pk2(a[0], a[1]); o.y = pk2(a[2], a[3]); o.z = pk2(b[0], b[1]); o.w = pk2(b[2], b[3]); *(u32x4*)(dst + i * 8) = o; }
}

__device__ __forceinline__ void phase_pro_a(const Params& p, unsigned char* lds) {
    const int tid = tid_l(), lane = tid & 63, wave = tid >> 6;
    float* scr = (float*)(lds + wave * 16384);
    const int gw = bid_l() * 8 + wave, NGW = grid_l() * 8;
    constexpr int I_WIN = (D / 64) * (HCOLS / 32), I_SQ = (D / 64) * (D / 32), I_PW = (256 / 64) * (D / 32);
    constexpr int PER_L = I_WIN + 2 * I_SQ + I_PW;
    for (int it = gw; it < DEPTH * PER_L; it += NGW) {
        const int l = it / PER_L; int r = it % PER_L;
        if (r < I_WIN) { transpose_item(p.w_in + (size_t)l * D * IN_COLS, D, IN_COLS, (bf16*)(p.ws + WS_WIN) + (size_t)l * HCOLS * D, r, HCOLS / 32, scr, lane, MapWin()); continue; } r -= I_WIN;
        if (r < I_SQ) { transpose_item(p.w_out + (size_t)l * D * D, D, D, (bf16*)(p.ws + WS_WOUT) + (size_t)l * D * D, r, D / 32, scr, lane, MapIdent()); continue; } r -= I_SQ;
        if (r < I_SQ) { transpose_item(p.ple_gw + (size_t)l * D * D, D, D, (bf16*)(p.ws + WS_PGW) + (size_t)l * D * D, r, D / 32, scr, lane, MapIdent()); continue; } r -= I_SQ;
        transpose_item(p.ple_w + (size_t)l * 256 * D, 256, D, (bf16*)(p.ws + WS_PW) + (size_t)l * D * 256, r, D / 32, scr, lane, MapIdent());
    }
    cvt_bf16_stream(p.x, (bf16*)(p.ws + WS_XB), (size_t)T * D / 8, (size_t)bid_l() * 512 + tid, (size_t)grid_l() * 512);
}
__device__ __forceinline__ void phase_pro_b(const Params& p, unsigned char* lds) {
    const int tid = tid_l();
    constexpr int PB = 132;
    float* ks = (float*)lds;
    float* wqs = ks + 128 * PB;
    for (int it = bid_l(); it < DEPTH * 16 * 16; it += grid_l()) {
        const int l = it >> 8, hc = (it >> 4) & 15, kt = it & 15;
        const float* keys = p.peer_keys + ((size_t)l * 16 + hc) * 16384;
        const float* wq = p.peer_wq + (size_t)l * D * 2048 + (size_t)(kt * 64) * 2048 + hc * 128;
        __syncthreads();
        for (int i = tid; i < 128 * 32; i += 512) *(f32x4*)(ks + (i >> 5) * PB + (i & 31) * 4) = *(const f32x4*)(keys + (size_t)i * 4);
        for (int i = tid; i < 64 * 32; i += 512) *(f32x4*)(wqs + (i >> 5) * PB + (i & 31) * 4) = *(const f32x4*)(wq + (size_t)(i >> 5) * 2048 + (i & 31) * 4);
        __syncthreads();
        const int kq = tid & 15, nq = tid >> 4;
        float acc[4][4];
#pragma unroll
        for (int i = 0; i < 4; ++i)
#pragma unroll
            for (int j = 0; j < 4; ++j) acc[i][j] = 0.f;
#pragma unroll 2
        for (int d = 0; d < 128; d += 4) { f32x4 a[4], b[4];
#pragma unroll
            for (int i = 0; i < 4; ++i) { a[i] = *(const f32x4*)(wqs + (kq + 16 * i) * PB + d); b[i] = *(const f32x4*)(ks + (nq + 32 * i) * PB + d); }
#pragma unroll
            for (int i = 0; i < 4; ++i)
#pragma unroll
                for (int j = 0; j < 4; ++j) acc[i][j] += (a[i][0] * b[j][0] + a[i][1] * b[j][1]) + (a[i][2] * b[j][2] + a[i][3] * b[j][3]); }
        bf16* WpT = (bf16*)(p.ws + WS_WP) + (size_t)l * 2048 * D;
#pragma unroll
        for (int i = 0; i < 4; ++i)
#pragma unroll
            for (int j = 0; j < 4; ++j) WpT[(size_t)(hc * 128 + nq + 32 * j) * D + kt * 64 + kq + 16 * i] = (bf16)f2bf(acc[i][j]);
    }
}
constexpr float U8_SCALE = 64.f, V8_SCALE = 1.f;
typedef float f32x2v __attribute__((ext_vector_type(2)));
__device__ __forceinline__ unsigned pk_fp8x4(f32x4 v, float sc) {
    const float a = fminf(fmaxf(v[0] * sc, -448.f), 448.f), b = fminf(fmaxf(v[1] * sc, -448.f), 448.f), c = fminf(fmaxf(v[2] * sc, -448.f), 448.f), d = fminf(fmaxf(v[3] * sc, -448.f), 448.f);
    int w = __builtin_amdgcn_cvt_pk_fp8_f32(a, b, 0, false); w = __builtin_amdgcn_cvt_pk_fp8_f32(c, d, w, true); return (unsigned)w;
}
__device__ __forceinline__ void cvt_fp8_stream(const float* src, unsigned char* dst, size_t n16, float sc, size_t gtid, size_t gthreads) {
    for (size_t i = gtid; i < n16; i += gthreads) { const float* s = src + i * 16; u32x4 o;
        o.x = pk_fp8x4(*(const f32x4*)(s), sc); o.y = pk_fp8x4(*(const f32x4*)(s + 4), sc); o.z = pk_fp8x4(*(const f32x4*)(s + 8), sc); o.w = pk_fp8x4(*(const f32x4*)(s + 12), sc);
        *(u32x4*)(dst + i * 16) = o; }
}
__device__ __forceinline__ float wave_max(float v) {
#pragma unroll
    for (int o = 32; o > 0; o >>= 1) v = fmaxf(v, __shfl_xor(v, o));
    return v;
}
__device__ __forceinline__ unsigned pk_i8x4(f32x4 v, float sc) {
    const int a = (int)__builtin_rintf(v[0] * sc), b = (int)__builtin_rintf(v[1] * sc), c = (int)__builtin_rintf(v[2] * sc), d = (int)__builtin_rintf(v[3] * sc);
    return (unsigned)(a & 255) | ((unsigned)(b & 255) << 8) | ((unsigned)(c & 255) << 16) | ((unsigned)d << 24);
}
__device__ __forceinline__ void cvt_i8_rows(const float* src, unsigned char* dst, float* RS, size_t n16, size_t gtid, size_t gthreads) {
    for (size_t i = gtid; i < n16; i += gthreads) { const float* s_ = src + i * 16;
        const f32x4 a = *(const f32x4*)(s_), b = *(const f32x4*)(s_ + 4), c = *(const f32x4*)(s_ + 8), d = *(const f32x4*)(s_ + 12);
        float m = fmaxf(fmaxf(fmaxf(fabsf(a[0]), fabsf(a[1])), fmaxf(fabsf(a[2]), fabsf(a[3]))), fmaxf(fmaxf(fabsf(b[0]), fabsf(b[1])), fmaxf(fabsf(b[2]), fabsf(b[3]))));
        m = fmaxf(m, fmaxf(fmaxf(fmaxf(fabsf(c[0]), fabsf(c[1])), fmaxf(fabsf(c[2]), fabsf(c[3]))), fmaxf(fmaxf(fabsf(d[0]), fabsf(d[1])), fmaxf(fabsf(d[2]), fabsf(d[3])))));
        m = wave_max(m); const float sc = m > 0.f ? 127.0f / m : 0.f;
        u32x4 o; o.x = pk_i8x4(a, sc); o.y = pk_i8x4(b, sc); o.z = pk_i8x4(c, sc); o.w = pk_i8x4(d, sc);
        *(u32x4*)(dst + i * 16) = o;
        if ((i & 63) == 0) RS[i >> 6] = m * (1.0f / 127.0f); }
}
__device__ __forceinline__ unsigned pk_i4x8(f32x4 a, f32x4 b, float sc) {
    unsigned w = 0u;
#pragma unroll
    for (int i = 0; i < 4; ++i) { w |= ((unsigned)(int)__builtin_rintf(a[i] * sc) & 15u) << (4 * i); w |= ((unsigned)(int)__builtin_rintf(b[i] * sc) & 15u) << (16 + 4 * i); }
    return w;
}
__device__ __forceinline__ void cvt_i4_rows(const float* src, unsigned char* dst, float* RS, size_t n16, size_t gtid, size_t gthreads) {
    for (size_t i = gtid; i < n16; i += gthreads) { const float* s_ = src + i * 16;
        const f32x4 a = *(const f32x4*)(s_), b = *(const f32x4*)(s_ + 4), c = *(const f32x4*)(s_ + 8), d = *(const f32x4*)(s_ + 12);
        float m = fmaxf(fmaxf(fmaxf(fabsf(a[0]), fabsf(a[1])), fmaxf(fabsf(a[2]), fabsf(a[3]))), fmaxf(fmaxf(fabsf(b[0]), fabsf(b[1])), fmaxf(fabsf(b[2]), fabsf(b[3]))));
        m = fmaxf(m, fmaxf(fmaxf(fmaxf(fabsf(c[0]), fabsf(c[1])), fmaxf(fabsf(c[2]), fabsf(c[3]))), fmaxf(fmaxf(fabsf(d[0]), fabsf(d[1])), fmaxf(fabsf(d[2]), fabsf(d[3])))));
        m = wave_max(m); const float sc = m > 0.f ? 7.49f / m : 0.f;
        u32x2 o; o.x = pk_i4x8(a, b, sc); o.y = pk_i4x8(c, d, sc); *(u32x2*)(dst + i * 8) = o;
        if ((i & 63) == 0) RS[i >> 6] = m * (1.0f / 7.49f); }
}
__device__ __forceinline__ void cvt_fp4_rows(const float* src, unsigned char* dst, float* VS, size_t n16, size_t gtid, size_t gthreads) {
    for (size_t i = gtid; i < n16; i += gthreads) { const float* s_ = src + i * 16;
        const f32x4 a = *(const f32x4*)(s_), b = *(const f32x4*)(s_ + 4), c = *(const f32x4*)(s_ + 8), d = *(const f32x4*)(s_ + 12);
        float m = fmaxf(fmaxf(fmaxf(fabsf(a[0]), fabsf(a[1])), fmaxf(fabsf(a[2]), fabsf(a[3]))), fmaxf(fmaxf(fabsf(b[0]), fabsf(b[1])), fmaxf(fabsf(b[2]), fabsf(b[3]))));
        m = fmaxf(m, fmaxf(fmaxf(fmaxf(fabsf(c[0]), fabsf(c[1])), fmaxf(fabsf(c[2]), fabsf(c[3]))), fmaxf(fmaxf(fabsf(d[0]), fabsf(d[1])), fmaxf(fabsf(d[2]), fabsf(d[3])))));
        m = wave_max(m); const float sc = m > 0.f ? 6.0f / m : 0.f;
        unsigned w0 = 0u, w1 = 0u;
        w0 = __builtin_amdgcn_cvt_scalef32_pk_fp4_f32(w0, a[0] * sc, a[1] * sc, 1.0f, 0); w0 = __builtin_amdgcn_cvt_scalef32_pk_fp4_f32(w0, a[2] * sc, a[3] * sc, 1.0f, 1);
        w0 = __builtin_amdgcn_cvt_scalef32_pk_fp4_f32(w0, b[0] * sc, b[1] * sc, 1.0f, 2); w0 = __builtin_amdgcn_cvt_scalef32_pk_fp4_f32(w0, b[2] * sc, b[3] * sc, 1.0f, 3);
        w1 = __builtin_amdgcn_cvt_scalef32_pk_fp4_f32(w1, c[0] * sc, c[1] * sc, 1.0f, 0); w1 = __builtin_amdgcn_cvt_scalef32_pk_fp4_f32(w1, c[2] * sc, c[3] * sc, 1.0f, 1);
        w1 = __builtin_amdgcn_cvt_scalef32_pk_fp4_f32(w1, d[0] * sc, d[1] * sc, 1.0f, 2); w1 = __builtin_amdgcn_cvt_scalef32_pk_fp4_f32(w1, d[2] * sc, d[3] * sc, 1.0f, 3);
        u32x2 o; o.x = w0; o.y = w1; *(u32x2*)(dst + i * 8) = o;
        if ((i & 63) == 0) VS[i >> 6] = m * (1.0f / 6.0f); }
}
__device__ __forceinline__ void phase_cvt(const Params& p, int l) {
    const size_t gtid = (size_t)bid_l() * 512 + tid_l(), gth = (size_t)grid_l() * 512;
    cvt_bf16_stream(p.p + (size_t)l * T * 256, (bf16*)(p.ws + WS_PB), (size_t)T * 256 / 8, gtid, gth);
    cvt_i4_rows(p.peer_u + (size_t)l * NEXP * D, p.ws + WS_U, (float*)(p.ws + WS_RS), (size_t)NEXP * D / 16, gtid, gth);
    cvt_fp4_rows(p.peer_v + (size_t)l * NEXP * D, p.ws + WS_V, (float*)(p.ws + WS_VS), (size_t)NEXP * D / 16, gtid, gth);
}

#define GEMM_RUN(EPI, e, Aptr, Bptr, N_, K_) do { int kk_ = (K_); asm volatile("" : "+s"(kk_)); pg8::Gemm g{(const pg8::bf16_t*)(Aptr), (const pg8::bf16_t*)(Bptr), T, (N_), kk_}; pg8::StaticOrder S; S.init(T, (N_), (int)grid_l(), (int)bid_l()); \
    pg8::gemm_phase<EPI, pg8::StaticOrder, true, true>((PG8_LAS unsigned char*)lds, g, S, e); } while (0)

__device__ __forceinline__ void phase_gemm_in(const Params& p, int l, unsigned char* lds) {
    pg8::EpiBf16<0> e{(pg8::bf16_t*)(p.ws + WS_H), HCOLS, nullptr, 0, 0, 1.f};
    GEMM_RUN(pg8::EpiBf16<0>, e, p.ws + WS_XB, (bf16*)(p.ws + WS_WIN) + (size_t)l * HCOLS * D, HCOLS, D);
}
__device__ __forceinline__ void phase_gemm_e(const Params& p, int l, unsigned char* lds) {
    pg8::EpiBf16<0> e{(pg8::bf16_t*)(p.ws + WS_E), D, nullptr, 0, 0, 1.f};
    GEMM_RUN(pg8::EpiBf16<0>, e, p.ws + WS_PB, (bf16*)(p.ws + WS_PW) + (size_t)l * D * 256, D, 256);
}
__device__ __forceinline__ void phase_gemm_out(const Params& p, int l, unsigned char* lds) {
    pg8::EpiResid e{(const pg8::bf16_t*)(p.ws + WS_XB), (_Float16*)(p.ws + WS_Y), D, ALPHA};
    GEMM_RUN(pg8::EpiResid, e, p.ws + WS_MIX, (bf16*)(p.ws + WS_WOUT) + (size_t)l * D * D, D, D);
}
__device__ __forceinline__ void phase_gemm_sc(const Params& p, int l, unsigned char* lds) {
    pg8::EpiF16 e{(_Float16*)(p.ws + WS_SC), 2048};
    GEMM_RUN(pg8::EpiF16, e, p.ws + WS_XB, (bf16*)(p.ws + WS_WP) + (size_t)l * 2048 * D, 2048, D);
}
__device__ __forceinline__ void phase_gemm_ple(const Params& p, int l, unsigned char* lds) {
    pg8::EpiPle e{(const pg8::bf16_t*)(p.ws + WS_XB), (_Float16*)(p.ws + WS_Y), (const pg8::bf16_t*)(p.ws + WS_E), p.ple_gb + (size_t)l * D, D};
    GEMM_RUN(pg8::EpiPle, e, p.ws + WS_XB, (bf16*)(p.ws + WS_PGW) + (size_t)l * D * D, D, D);
}

__device__ __forceinline__ void phase_conv(const Params& p, int l, unsigned char* lds) {
    const int tid = tid_l(), lane = tid & 63, wave = tid >> 6;
    float* U = (float*)lds;
    float* Yt = U + 62 * 256;
    const bf16* H = (const bf16*)(p.ws + WS_H); bf16* MIX = (bf16*)(p.ws + WS_MIX);
    const float* cw = p.conv_w + (size_t)l * 31 * 256; const float* cb = p.conv_b + l * 256;
    const float* lg = p.conv_ln_g + l * 256; const float* lb = p.conv_ln_b + l * 256;
    for (int it = bid_l(); it < T / 32; it += grid_l()) {
        const int b = it / (SEQ / 32), t0 = (it % (SEQ / 32)) * 32;
        __syncthreads();
        for (int i = tid; i < 62 * 32; i += 512) { const int r = i >> 5, c8 = (i & 31) * 8, t = t0 - 30 + r; f32x4 u0 = {0.f, 0.f, 0.f, 0.f}, u1 = {0.f, 0.f, 0.f, 0.f};
            if (t >= 0) { const bf16* hr = H + (size_t)(b * SEQ + t) * HCOLS; const u32x4 av = *(const u32x4*)(hr + HC_AVAL + c8), gv = *(const u32x4*)(hr + HC_AGATE + c8);
#pragma unroll
                for (int j = 0; j < 2; ++j) { u0[2 * j] = bf2f(av[j] & 0xffffu) * sigmoidf_(bf2f(gv[j] & 0xffffu)); u0[2 * j + 1] = __uint_as_float(av[j] & 0xffff0000u) * sigmoidf_(__uint_as_float(gv[j] & 0xffff0000u));
                                              u1[2 * j] = bf2f(av[2 + j] & 0xffffu) * sigmoidf_(bf2f(gv[2 + j] & 0xffffu)); u1[2 * j + 1] = __uint_as_float(av[2 + j] & 0xffff0000u) * sigmoidf_(__uint_as_float(gv[2 + j] & 0xffff0000u)); } }
            *(f32x4*)(U + r * 256 + c8) = u0; *(f32x4*)(U + r * 256 + c8 + 4) = u1; }
        __syncthreads();
        { const int c = tid & 255, half = tid >> 8; float w[31], win[46];
#pragma unroll
          for (int j = 0; j < 31; ++j) w[j] = cw[j * 256 + c];
#pragma unroll
          for (int j = 0; j < 46; ++j) win[j] = U[(half * 16 + j) * 256 + c];
          const float bias = cb[c];
#pragma unroll
          for (int tl = 0; tl < 16; ++tl) { float y = bias;
#pragma unroll
              for (int j = 0; j < 31; ++j) y += w[j] * win[tl + j];
              Yt[(half * 16 + tl) * 256 + c] = y; } }
        __syncthreads();
        for (int tl = wave * 4; tl < wave * 4 + 4; ++tl) {
            const f32x4 v = *(const f32x4*)(Yt + tl * 256 + lane * 4);
            const float mean = wave_sum((v[0] + v[1]) + (v[2] + v[3])) * (1.f / 256.f);
            const f32x4 d = v - mean; const float var = wave_sum((d[0] * d[0] + d[1] * d[1]) + (d[2] * d[2] + d[3] * d[3])) * (1.f / 256.f);
            const float rstd = 1.0f / sqrtf(var + LN_EPS);
            const f32x4 g4 = *(const f32x4*)(lg + lane * 4), b4 = *(const f32x4*)(lb + lane * 4);
            float o[4];
#pragma unroll
            for (int i = 0; i < 4; ++i) { const float z = d[i] * rstd * g4[i] + b4[i]; o[i] = z * sigmoidf_(z); }
            u32x2 w2; w2.x = pk2(o[0], o[1]); w2.y = pk2(o[2], o[3]);
            *(u32x2*)(MIX + (size_t)(b * SEQ + t0 + tl) * D + MC_A + lane * 4) = w2;
        }
    }
}

__device__ __forceinline__ void phase_fox_cum(const Params& p, int l, unsigned char* lds) {
    const int tid = tid_l(), lane = tid & 63, wave = tid >> 6;
    float* wsum = (float*)lds;
    const bf16* H = (const bf16*)(p.ws + WS_H); float* CK = (float*)(p.ws + WS_CK);
    for (int bh = bid_l(); bh < 48; bh += grid_l()) {
        const int b = bh / 6, h = bh % 6; const float bias = p.fox_forget_b[l * 6 + h];
        float v[8]; float s = 0.f;
#pragma unroll
        for (int i = 0; i < 8; ++i) { const float f = bf2f(H[(size_t)(b * SEQ + tid * 8 + i) * HCOLS + HC_CF + h]); s += log_sigmoid(f + bias) * LOG2E; v[i] = s; }
        float incl = s;
#pragma unroll
        for (int o = 1; o < 64; o <<= 1) { const float n = __shfl_up(incl, o); if (lane >= o) incl += n; }
        __syncthreads();
        if (lane == 63) wsum[wave] = incl;
        __syncthreads();
        float base = incl - s;
        for (int w = 0; w < wave; ++w) base += wsum[w];
#pragma unroll
        for (int i = 0; i < 8; ++i) CK[(size_t)bh * SEQ + tid * 8 + i] = base + v[i];
    }
}

__device__ __forceinline__ void phase_fox_norm(const Params& p, unsigned char* lds) {
    const int tid = tid_l(), lane = tid & 63, wave = tid >> 6;
    float* qns = (float*)lds; float* kns = qns + 256;
    const bf16* H = (const bf16*)(p.ws + WS_H); float* KT = (float*)(p.ws + WS_FKT); float* QBM = (float*)(p.ws + WS_FQB);
    for (int it = bid_l(); it < 48 * 16; it += grid_l()) {
        const int bh = it >> 4, qb = it & 15, b = bh / 6, h = bh % 6;
        __syncthreads();
        if (tid < 256) { const bf16* row = H + ((size_t)b * SEQ + qb * 256 + tid) * HCOLS + h * 64; float sq = 0.f, sk = 0.f;
#pragma unroll
            for (int j = 0; j < 8; ++j) { const u32x4 qv = *(const u32x4*)(row + HC_CQ + 8 * j), kv = *(const u32x4*)(row + HC_CK + 8 * j);
#pragma unroll
                for (int i = 0; i < 4; ++i) { const float a0 = bf2f(qv[i] & 0xffffu), a1 = __uint_as_float(qv[i] & 0xffff0000u), b0 = bf2f(kv[i] & 0xffffu), b1 = __uint_as_float(kv[i] & 0xffff0000u);
                    sq += a0 * a0 + a1 * a1; sk += b0 * b0 + b1 * b1; } }
            qns[tid] = sqrtf(sq); kns[tid] = sqrtf(sk); }
        __syncthreads();
        if (wave < 5) { float v = wave < 4 ? kns[wave * 64 + lane] : fmaxf(fmaxf(qns[lane], qns[64 + lane]), fmaxf(qns[128 + lane], qns[192 + lane]));
#pragma unroll
            for (int o = 1; o < 64; o <<= 1) v = fmaxf(v, __shfl_xor(v, o));
            if (lane == 0) { if (wave < 4) KT[bh * 64 + 4 * qb + wave] = v; else QBM[bh * 16 + qb] = v; } }
    }
}

typedef short bf16x8_t __attribute__((ext_vector_type(8)));
typedef float f32x16_t __attribute__((ext_vector_type(16)));
__device__ __forceinline__ int crow32(int r, int hi) { return (r & 3) + 8 * (r >> 2) + 4 * hi; }
struct GlaB1Pre { u32x4 vv, lr0, lr1; u32x2 kk; float w2v, b2v; };
__device__ __forceinline__ GlaB1Pre gla_b1_load(const Params& p, int l, int it, int tid, int lane, int wave) {
    const int bh = it >> 6, n = it & 63, b = bh / 6, h = bh % 6; const size_t tok0 = (size_t)b * SEQ + n * 64; const bf16* H = (const bf16*)(p.ws + WS_H);
    GlaB1Pre r; r.w2v = p.gla_gate_w[(size_t)l * 16 * 192 + (tid >> 5) * 192 + h * 32 + (tid & 31)]; r.b2v = p.gla_gate_b[l * 192 + h * 32 + (tid & 31)];
    r.vv = *(const u32x4*)(H + (tok0 + (tid >> 3)) * HCOLS + HC_BV + h * 64 + (tid & 7) * 8);
    r.lr0 = *(const u32x4*)(H + (tok0 + lane) * HCOLS + HC_LR); r.lr1 = *(const u32x4*)(H + (tok0 + lane) * HCOLS + HC_LR + 8);
    r.kk = *(const u32x2*)(H + (tok0 + lane) * HCOLS + HC_BK + h * 32 + wave * 4);
    return r;
}
__device__ __forceinline__ void phase_gla_b1(const Params& p, int l, unsigned char* lds) {
    const int tid = tid_l(), lane = tid & 63, wave = tid >> 6, r32 = lane & 31, hi = lane >> 5;
    bf16* KDT = (bf16*)lds;
    bf16* VT = KDT + 32 * 72;
    float* w2s = (float*)(VT + 64 * 72);
    float* b2s = w2s + 16 * 32;
    float* GCUM = (float*)(p.ws + WS_GCUM); float* GS = (float*)(p.ws + WS_GS); float* GDEC = (float*)(p.ws + WS_GDEC);
    const int NI = 48 * 64, G = grid_l(); int it = bid_l();
    if (it >= NI) return;
    GlaB1Pre cur = gla_b1_load(p, l, it, tid, lane, wave);
#pragma unroll 1
    for (; it < NI; it += G) {
        const GlaB1Pre nxt = gla_b1_load(p, l, it + G < NI ? it + G : it, tid, lane, wave);
        __builtin_amdgcn_sched_barrier(0);
        const int bh = it >> 6, n = it & 63, b = bh / 6, h = bh % 6; const size_t tok0 = (size_t)b * SEQ + n * 64;
        __syncthreads();
        w2s[tid] = cur.w2v;
        if (tid < 32) b2s[tid] = cur.b2v;
        { const int s_ = tid >> 3, e0 = (tid & 7) * 8;
#pragma unroll
          for (int i = 0; i < 4; ++i) { VT[(e0 + 2 * i) * 72 + s_] = (bf16)(cur.vv[i] & 0xffffu); VT[(e0 + 2 * i + 1) * 72 + s_] = (bf16)(cur.vv[i] >> 16); } }
        const int d0 = wave * 4;
        __syncthreads();
        float lrf[16];
#pragma unroll
        for (int i = 0; i < 4; ++i) { lrf[2 * i] = bf2f(cur.lr0[i] & 0xffffu); lrf[2 * i + 1] = __uint_as_float(cur.lr0[i] & 0xffff0000u); lrf[8 + 2 * i] = bf2f(cur.lr1[i] & 0xffffu); lrf[8 + 2 * i + 1] = __uint_as_float(cur.lr1[i] & 0xffff0000u); }
        float g[4];
#pragma unroll
        for (int dd = 0; dd < 4; ++dd) { float x = b2s[d0 + dd];
#pragma unroll
            for (int r = 0; r < 16; ++r) x += lrf[r] * w2s[r * 32 + d0 + dd];
            g[dd] = log_sigmoid(x) * (1.0f / 16.0f); }
#pragma unroll
        for (int o = 1; o < 64; o <<= 1)
#pragma unroll
            for (int dd = 0; dd < 4; ++dd) { const float v = __shfl_up(g[dd], o); if (lane >= o) g[dd] += v; }
        *(f32x4*)(GCUM + (tok0 + lane) * 192 + h * 32 + d0) = (f32x4){g[0], g[1], g[2], g[3]};
        const float kf[4] = {bf2f(cur.kk.x & 0xffffu), __uint_as_float(cur.kk.x & 0xffff0000u), bf2f(cur.kk.y & 0xffffu), __uint_as_float(cur.kk.y & 0xffff0000u)};
#pragma unroll
        for (int dd = 0; dd < 4; ++dd) { const float last = __uint_as_float(__builtin_amdgcn_readlane(__float_as_uint(g[dd]), 63));
            KDT[(d0 + dd) * 72 + lane] = (bf16)f2bf(kf[dd] * __expf(last - g[dd]));
            if (lane == 63) GDEC[(size_t)it * 32 + d0 + dd] = __expf(last); }
        __syncthreads();
        if (wave < 2) {
            f32x16_t acc = {};
#pragma unroll
            for (int ks = 0; ks < 4; ++ks) { const bf16x8_t a = *(const bf16x8_t*)(KDT + r32 * 72 + 16 * ks + 8 * hi), bb = *(const bf16x8_t*)(VT + (32 * wave + r32) * 72 + 16 * ks + 8 * hi);
                acc = __builtin_amdgcn_mfma_f32_32x32x16_bf16(a, bb, acc, 0, 0, 0); }
#pragma unroll
            for (int r = 0; r < 16; ++r) GS[(size_t)it * 2048 + crow32(r, hi) * 64 + 32 * wave + r32] = acc[r];
        }
        cur = nxt;
    }
}
__device__ __forceinline__ void phase_gla_b2(const Params& p) {
    float* GS = (float*)(p.ws + WS_GS); const float* GDEC = (const float*)(p.ws + WS_GDEC);
    for (int g = bid_l() * 512 + tid_l(); g < 48 * 2048; g += grid_l() * 512) {
        const int bh = g >> 11, de = g & 2047, d = de >> 6; float S = 0.f;
        float* gs = GS + (size_t)bh * 64 * 2048 + de; const float* gd = GDEC + (size_t)bh * 64 * 32 + d;
#pragma unroll 1
        for (int n0 = 0; n0 < 64; n0 += 16) { float loc[16], dec[16];
#pragma unroll
            for (int i = 0; i < 16; ++i) { loc[i] = gs[(size_t)(n0 + i) * 2048]; dec[i] = gd[(n0 + i) * 32]; }
#pragma unroll
            for (int i = 0; i < 16; ++i) { gs[(size_t)(n0 + i) * 2048] = S; S = S * dec[i] + loc[i]; } }
    }
}
struct GlaB3Pre { u32x2 qq, kk; f32x4 c; u32x4 vv; f32x4 sv; u32x4 gr; };
__device__ __forceinline__ GlaB3Pre gla_b3_load(const Params& p, int it, int tid) {
    const int bh = it >> 6, n = it & 63, b = bh / 6, h = bh % 6; const size_t tok0 = (size_t)b * SEQ + n * 64; const bf16* H = (const bf16*)(p.ws + WS_H);
    const float* GCUM = (const float*)(p.ws + WS_GCUM); const float* GS = (const float*)(p.ws + WS_GS);
    GlaB3Pre r; const int t = tid >> 3, d0 = (tid & 7) * 4;
    r.qq = *(const u32x2*)(H + (tok0 + t) * HCOLS + HC_BQ + h * 32 + d0); r.kk = *(const u32x2*)(H + (tok0 + t) * HCOLS + HC_BK + h * 32 + d0);
    r.c = *(const f32x4*)(GCUM + (tok0 + t) * 192 + h * 32 + d0);
    r.vv = *(const u32x4*)(H + (tok0 + t) * HCOLS + HC_BV + h * 64 + (tid & 7) * 8);
    r.sv = *(const f32x4*)(GS + (size_t)it * 2048 + (tid >> 4) * 64 + (tid & 15) * 4);
    r.gr = *(const u32x4*)(H + (tok0 + t) * HCOLS + HC_BG + h * 64 + (tid & 7) * 8);
    return r;
}
__device__ __forceinline__ void phase_gla_b3(const Params& p, int l, unsigned char* lds) {
    const int tid = tid_l(), lane = tid & 63, wave = tid >> 6, r32 = lane & 31, hi = lane >> 5;
    bf16* QE = (bf16*)lds;
    bf16* KE = QE + 64 * 40;
    bf16* VT = KE + 64 * 40;
    bf16* ST = VT + 64 * 72;
    bf16* P = ST + 64 * 40;
    float* O = (float*)(P + 64 * 72);
    bf16* MIX = (bf16*)(p.ws + WS_MIX);
    const int NI = 48 * 64, G = grid_l(); int it = bid_l();
    if (it >= NI) return;
    GlaB3Pre cur = gla_b3_load(p, it, tid);
#pragma unroll 1
    for (; it < NI; it += G) {
        const GlaB3Pre nxt = gla_b3_load(p, it + G < NI ? it + G : it, tid);
        __builtin_amdgcn_sched_barrier(0);
        const int bh = it >> 6, n = it & 63, b = bh / 6, h = bh % 6; const size_t tok0 = (size_t)b * SEQ + n * 64;
        __syncthreads();
        { const int t = tid >> 3, d0 = (tid & 7) * 4; const u32x2 qq = cur.qq, kk = cur.kk; const f32x4 c = cur.c;
          const float e0 = __expf(c[0]), e1 = __expf(c[1]), e2 = __expf(c[2]), e3 = __expf(c[3]);
          u32x2 qo, ko;
          qo.x = pk2(bf2f(qq.x & 0xffffu) * e0, __uint_as_float(qq.x & 0xffff0000u) * e1); qo.y = pk2(bf2f(qq.y & 0xffffu) * e2, __uint_as_float(qq.y & 0xffff0000u) * e3);
          ko.x = pk2(bf2f(kk.x & 0xffffu) / e0, __uint_as_float(kk.x & 0xffff0000u) / e1); ko.y = pk2(bf2f(kk.y & 0xffffu) / e2, __uint_as_float(kk.y & 0xffff0000u) / e3);
          *(u32x2*)(QE + t * 40 + d0) = qo; *(u32x2*)(KE + t * 40 + d0) = ko; }
        { const int s_ = tid >> 3, e0 = (tid & 7) * 8;
#pragma unroll
          for (int i = 0; i < 4; ++i) { VT[(e0 + 2 * i) * 72 + s_] = (bf16)(cur.vv[i] & 0xffffu); VT[(e0 + 2 * i + 1) * 72 + s_] = (bf16)(cur.vv[i] >> 16); } }
        { const int d = tid >> 4, e0 = (tid & 15) * 4;
#pragma unroll
          for (int i = 0; i < 4; ++i) ST[(e0 + i) * 40 + d] = (bf16)f2bf(cur.sv[i]); }
        __syncthreads();
        f32x16_t acc = {};
        const int tt = (wave & 3) >> 1, tc = wave & 1;
        if (wave < 4) {
            if (!(tt == 0 && tc == 1)) {
#pragma unroll
                for (int ks = 0; ks < 2; ++ks) { const bf16x8_t a = *(const bf16x8_t*)(QE + (32 * tt + r32) * 40 + 16 * ks + 8 * hi), bb = *(const bf16x8_t*)(KE + (32 * tc + r32) * 40 + 16 * ks + 8 * hi);
                    acc = __builtin_amdgcn_mfma_f32_32x32x16_bf16(a, bb, acc, 0, 0, 0); }
#pragma unroll
                for (int r = 0; r < 16; ++r) { const int trow = 32 * tt + crow32(r, hi), scol = 32 * tc + r32; P[trow * 72 + scol] = (bf16)f2bf(scol <= trow ? acc[r] : 0.f); }
            }
        } else {
#pragma unroll
            for (int ks = 0; ks < 2; ++ks) { const bf16x8_t a = *(const bf16x8_t*)(QE + (32 * tt + r32) * 40 + 16 * ks + 8 * hi), bb = *(const bf16x8_t*)(ST + (32 * tc + r32) * 40 + 16 * ks + 8 * hi);
                acc = __builtin_amdgcn_mfma_f32_32x32x16_bf16(a, bb, acc, 0, 0, 0); }
        }
        __syncthreads();
        if (wave >= 4) {
            const int nks = tt == 0 ? 2 : 4;
            for (int ks = 0; ks < nks; ++ks) { const bf16x8_t a = *(const bf16x8_t*)(P + (32 * tt + r32) * 72 + 16 * ks + 8 * hi), bb = *(const bf16x8_t*)(VT + (32 * tc + r32) * 72 + 16 * ks + 8 * hi);
                acc = __builtin_amdgcn_mfma_f32_32x32x16_bf16(a, bb, acc, 0, 0, 0); }
#pragma unroll
            for (int r = 0; r < 16; ++r) O[(32 * tt + crow32(r, hi)) * 65 + 32 * tc + r32] = acc[r];
        }
        __syncthreads();
        { const int t = tid >> 3, e0 = (tid & 7) * 8; float o[8]; float ss = 0.f;
#pragma unroll
          for (int i = 0; i < 8; ++i) { o[i] = O[t * 65 + e0 + i]; ss += o[i] * o[i]; }
          ss += __shfl_xor(ss, 1); ss += __shfl_xor(ss, 2); ss += __shfl_xor(ss, 4);
          const float rs = 1.0f / sqrtf(ss * (1.f / 64.f) + LN_EPS);
          const float* ng = p.gla_norm_g + l * 384 + h * 64 + e0; const u32x4 gr = cur.gr;
          float r[8];
#pragma unroll
          for (int i = 0; i < 4; ++i) { const float ga = bf2f(gr[i] & 0xffffu), gb = __uint_as_float(gr[i] & 0xffff0000u);
              r[2 * i] = o[2 * i] * rs * ng[2 * i] * (ga * sigmoidf_(ga)); r[2 * i + 1] = o[2 * i + 1] * rs * ng[2 * i + 1] * (gb * sigmoidf_(gb)); }
          u32x4 w; w.x = pk2(r[0], r[1]); w.y = pk2(r[2], r[3]); w.z = pk2(r[4], r[5]); w.w = pk2(r[6], r[7]);
          *(u32x4*)(MIX + (tok0 + t) * D + MC_B + h * 64 + e0) = w; }
        cur = nxt;
    }
}

constexpr int LDSQ_OFF = LDS_BYTES - 1024;
constexpr int CW_ATTNQ = 8192;
__device__ __forceinline__ void phase_fox_mfma(const Params& p, int l, unsigned char* lds) {
    const attn_body::bf16* H = (const attn_body::bf16*)(p.ws + WS_H);
    const attn_body::AttnTensors AT{H + HC_CQ, H + HC_CK, H + HC_CV, (attn_body::bf16*)(p.ws + WS_MIX) + MC_C, (const float*)(p.ws + WS_CK), (const float*)(p.ws + WS_FKT), (const float*)(p.ws + WS_FQB)};
    const attn_body::QueueOrder S{(unsigned*)(p.ws + WS_CTL) + CW_ATTNQ + l * 64, (volatile __attribute__((address_space(3))) int*)((__attribute__((address_space(3))) unsigned char*)lds + LDSQ_OFF)};
    attn_body::attn_phase<attn_body::QueueOrder>((char*)lds, AT, S);
}

__device__ __forceinline__ void phase_ln(const _Float16* Y, const float* g, const float* bta, float* dst, bf16* dstb, unsigned char* xq = nullptr, float* xs = nullptr) {
    const int tid = tid_l(), lane = tid & 63, wave = tid >> 6; typedef _Float16 h4 __attribute__((ext_vector_type(4)));
    const int stride = grid_l() * 8; int row = bid_l() * 8 + wave;
    if (row >= T) return;
    h4 cur[4];
#pragma unroll
    for (int j = 0; j < 4; ++j) cur[j] = *(const h4*)(Y + (size_t)row * D + j * 256 + lane * 4);
#pragma unroll 1
    for (; row < T; row += stride) {
        h4 nxt[4]; const int nr = row + stride < T ? row + stride : row;
#pragma unroll
        for (int j = 0; j < 4; ++j) nxt[j] = *(const h4*)(Y + (size_t)nr * D + j * 256 + lane * 4);
        __builtin_amdgcn_sched_barrier(0);
        f32x4 v[4]; float s = 0.f;
#pragma unroll
        for (int j = 0; j < 4; ++j) { v[j] = (f32x4){(float)cur[j][0], (float)cur[j][1], (float)cur[j][2], (float)cur[j][3]}; s += (v[j][0] + v[j][1]) + (v[j][2] + v[j][3]); }
        const float mean = wave_sum(s) * (1.f / D); float s2 = 0.f;
#pragma unroll
        for (int j = 0; j < 4; ++j) { v[j] = v[j] - mean; s2 += (v[j][0] * v[j][0] + v[j][1] * v[j][1]) + (v[j][2] * v[j][2] + v[j][3] * v[j][3]); }
        const float rstd = 1.0f / sqrtf(wave_sum(s2) * (1.f / D) + LN_EPS);
        float am = 0.f;
#pragma unroll
        for (int j = 0; j < 4; ++j) { const f32x4 g4 = *(const f32x4*)(g + j * 256 + lane * 4), b4 = *(const f32x4*)(bta + j * 256 + lane * 4);
            const f32x4 o = v[j] * rstd * g4 + b4; v[j] = o;
            am = fmaxf(am, fmaxf(fmaxf(fabsf(o[0]), fabsf(o[1])), fmaxf(fabsf(o[2]), fabsf(o[3]))));
            if (dst) *(f32x4*)(dst + (size_t)row * D + j * 256 + lane * 4) = o;
            if (dstb) { u32x2 w; w.x = pk2(o[0], o[1]); w.y = pk2(o[2], o[3]); *(u32x2*)(dstb + (size_t)row * D + j * 256 + lane * 4) = w; } }
        if (xq) {
            am = wave_max(am); const float sc = am > 0.f ? 119.0f / am : 0.f;
#pragma unroll
            for (int j = 0; j < 4; ++j) { unsigned hh = 0u, ll = 0u;
#pragma unroll
                for (int i = 0; i < 4; ++i) { const int q8 = (int)__builtin_rintf(v[j][i] * sc), qh = (q8 + 8) >> 4, ql = q8 - (qh << 4); hh |= ((unsigned)qh & 15u) << (4 * i); ll |= ((unsigned)ql & 15u) << (4 * i); }
                *(unsigned short*)(xq + (size_t)row * D + j * 128 + lane * 2) = (unsigned short)hh; *(unsigned short*)(xq + (size_t)row * D + 512 + j * 128 + lane * 2) = (unsigned short)ll; }
            if (lane == 0) xs[row] = am * (1.0f / 119.0f); }
#pragma unroll
        for (int j = 0; j < 4; ++j) cur[j] = nxt[j];
    }
}

__device__ __forceinline__ int f2ord(float x) { const int i = __float_as_int(x); return i ^ ((i >> 31) & 0x7fffffff); }
__device__ __forceinline__ float ord2f(int k) { return __int_as_float(k ^ ((k >> 31) & 0x7fffffff)); }
__device__ __forceinline__ void phase_topk(const Params& p, unsigned char* lds) {
    const int tid = tid_l(), lane = tid & 63, wave = tid >> 6;
    unsigned char* wreg = lds + wave * 17408; unsigned char* tab = wreg;
    const _Float16* SC = (const _Float16*)(p.ws + WS_SC); int* EIDX = (int*)(p.ws + WS_EIDX); float* GATE = (float*)(p.ws + WS_GATE); unsigned long long* SOFF = (unsigned long long*)(p.ws + WS_SOFF);
    for (int g = bid_l() * 512 + tid; g < T * 16; g += grid_l() * 512) {
        const int tok = g >> 4, hc = g & 15;
        typedef _Float16 h8 __attribute__((ext_vector_type(8)));
        { const unsigned char* blk = (const unsigned char*)(SC + (size_t)(g - lane) * 128);
          u32x4 st[16];
#pragma unroll
          for (int j = 0; j < 16; ++j) st[j] = *(const u32x4*)(blk + (size_t)(j * 64 + lane) * 16);
          __builtin_amdgcn_wave_barrier();
#pragma unroll
          for (int j = 0; j < 16; ++j) { const int c = j * 64 + lane; *(u32x4*)(wreg + (c + (c >> 4)) * 16) = st[j]; }
          __builtin_amdgcn_wave_barrier(); }
        const unsigned char* lp = wreg + lane * 272;
#define TK_CE(a, b) do { const int hi_ = max(a, b), lo_ = min(a, b); a = hi_; b = lo_; } while (0)
#define TK_SORT16(v) do { TK_CE(v[0], v[1]); TK_CE(v[3], v[2]); TK_CE(v[4], v[5]); TK_CE(v[7], v[6]); TK_CE(v[8], v[9]); TK_CE(v[11], v[10]); TK_CE(v[12], v[13]); TK_CE(v[15], v[14]); TK_CE(v[0], v[2]); TK_CE(v[1], v[3]); TK_CE(v[6], v[4]); TK_CE(v[7], v[5]); TK_CE(v[8], v[10]); TK_CE(v[9], v[11]); TK_CE(v[14], v[12]); TK_CE(v[15], v[13]); TK_CE(v[0], v[1]); TK_CE(v[2], v[3]); TK_CE(v[5], v[4]); TK_CE(v[7], v[6]); TK_CE(v[8], v[9]); TK_CE(v[10], v[11]); TK_CE(v[13], v[12]); TK_CE(v[15], v[14]); TK_CE(v[0], v[4]); TK_CE(v[1], v[5]); TK_CE(v[2], v[6]); TK_CE(v[3], v[7]); TK_CE(v[12], v[8]); TK_CE(v[13], v[9]); TK_CE(v[14], v[10]); TK_CE(v[15], v[11]); TK_CE(v[0], v[2]); TK_CE(v[1], v[3]); TK_CE(v[4], v[6]); TK_CE(v[5], v[7]); TK_CE(v[10], v[8]); TK_CE(v[11], v[9]); TK_CE(v[14], v[12]); TK_CE(v[15], v[13]); TK_CE(v[0], v[1]); TK_CE(v[2], v[3]); TK_CE(v[4], v[5]); TK_CE(v[6], v[7]); TK_CE(v[9], v[8]); TK_CE(v[11], v[10]); TK_CE(v[13], v[12]); TK_CE(v[15], v[14]); TK_CE(v[0], v[8]); TK_CE(v[1], v[9]); TK_CE(v[2], v[10]); TK_CE(v[3], v[11]); TK_CE(v[4], v[12]); TK_CE(v[5], v[13]); TK_CE(v[6], v[14]); TK_CE(v[7], v[15]); TK_CE(v[0], v[4]); TK_CE(v[1], v[5]); TK_CE(v[2], v[6]); TK_CE(v[3], v[7]); TK_CE(v[8], v[12]); TK_CE(v[9], v[13]); TK_CE(v[10], v[14]); TK_CE(v[11], v[15]); TK_CE(v[0], v[2]); TK_CE(v[1], v[3]); TK_CE(v[4], v[6]); TK_CE(v[5], v[7]); TK_CE(v[8], v[10]); TK_CE(v[9], v[11]); TK_CE(v[12], v[14]); TK_CE(v[13], v[15]); TK_CE(v[0], v[1]); TK_CE(v[2], v[3]); TK_CE(v[4], v[5]); TK_CE(v[6], v[7]); TK_CE(v[8], v[9]); TK_CE(v[10], v[11]); TK_CE(v[12], v[13]); TK_CE(v[14], v[15]); } while (0)
#define TK_BMERGE(tk) do { TK_CE(tk[0], tk[8]); TK_CE(tk[1], tk[9]); TK_CE(tk[2], tk[10]); TK_CE(tk[3], tk[11]); TK_CE(tk[4], tk[12]); TK_CE(tk[5], tk[13]); TK_CE(tk[6], tk[14]); TK_CE(tk[7], tk[15]); TK_CE(tk[0], tk[4]); TK_CE(tk[1], tk[5]); TK_CE(tk[2], tk[6]); TK_CE(tk[3], tk[7]); TK_CE(tk[8], tk[12]); TK_CE(tk[9], tk[13]); TK_CE(tk[10], tk[14]); TK_CE(tk[11], tk[15]); TK_CE(tk[0], tk[2]); TK_CE(tk[1], tk[3]); TK_CE(tk[4], tk[6]); TK_CE(tk[5], tk[7]); TK_CE(tk[8], tk[10]); TK_CE(tk[9], tk[11]); TK_CE(tk[12], tk[14]); TK_CE(tk[13], tk[15]); TK_CE(tk[0], tk[1]); TK_CE(tk[2], tk[3]); TK_CE(tk[4], tk[5]); TK_CE(tk[6], tk[7]); TK_CE(tk[8], tk[9]); TK_CE(tk[10], tk[11]); TK_CE(tk[12], tk[13]); TK_CE(tk[14], tk[15]); } while (0)
        int tk[16];
#pragma unroll 1
        for (int gi = 0; gi < 8; ++gi) { const h8 cA = *(const h8*)(lp + gi * 32), c1_ = *(const h8*)(lp + gi * 32 + 16);
            int v[16];
#pragma unroll
            for (int j = 0; j < 8; ++j) { v[j] = (f2ord((float)cA[j]) & ~127) | (127 - (gi * 16 + j)); v[8 + j] = (f2ord((float)c1_[j]) & ~127) | (127 - (gi * 16 + 8 + j)); }
            TK_SORT16(v);
            if (gi == 0) {
#pragma unroll
                for (int j = 0; j < 16; ++j) tk[j] = v[j]; }
            else {
#pragma unroll
                for (int j = 0; j < 16; ++j) tk[j] = max(tk[j], v[15 - j]);
                TK_BMERGE(tk); }
            }
        __builtin_amdgcn_wave_barrier();
        float av[16], bv[16]; int ai[16], bi[16]; const bool c1 = (hc & 1) != 0;
#pragma unroll
        for (int j = 0; j < 16; ++j) { const int ok = __shfl_xor(tk[j], 1); const int ka = c1 ? ok : tk[j], kb = c1 ? tk[j] : ok;
            av[j] = ord2f(ka & ~127); ai[j] = 127 - (ka & 127); bv[j] = ord2f(kb & ~127); bi[j] = 127 - (kb & 127); }
#pragma unroll
        for (int j = 0; j < 16; ++j) { tab[j * 64 + lane] = (unsigned char)ai[j]; tab[(16 + j) * 64 + lane] = (unsigned char)bi[j]; }
#define TK_KEY(i, j) ((f2ord(av[i] + bv[j]) & ~255) | (255 - ((i) * 16 + (j))))
        int ck[16], g1[16], g2[16], g3[16]; constexpr int TKPAD = (int)0x80000000;
#pragma unroll
        for (int j = 0; j < 16; ++j) ck[j] = TK_KEY(0, j);
#pragma unroll
        for (int j = 0; j < 8; ++j) g1[j] = TK_KEY(1, j);
        g1[8] = TKPAD; g1[9] = TKPAD; g1[10] = TKPAD; g1[11] = TK_KEY(2, 4); g1[12] = TK_KEY(2, 3); g1[13] = TK_KEY(2, 2); g1[14] = TK_KEY(2, 1); g1[15] = TK_KEY(2, 0);
        TK_BMERGE(g1);
        g2[0] = TK_KEY(3, 0); g2[1] = TK_KEY(3, 1); g2[2] = TK_KEY(3, 2); g2[3] = TK_KEY(3, 3); g2[4] = TK_KEY(4, 0); g2[5] = TK_KEY(4, 1); g2[6] = TK_KEY(4, 2); g2[7] = TK_KEY(5, 0); g2[8] = TK_KEY(5, 1);
        g2[9] = TK_KEY(6, 0); g2[10] = TK_KEY(6, 1); g2[11] = TK_KEY(7, 0); g2[12] = TK_KEY(7, 1); g2[13] = TKPAD; g2[14] = TKPAD; g2[15] = TKPAD;
        TK_SORT16(g2);
#pragma unroll
        for (int i = 0; i < 8; ++i) { g3[i] = TK_KEY(8 + i, 0); g3[8 + i] = TKPAD; }
#pragma unroll
        for (int j = 0; j < 16; ++j) { ck[j] = max(ck[j], g1[15 - j]); g2[j] = max(g2[j], g3[15 - j]); }
        TK_BMERGE(ck); TK_BMERGE(g2);
#pragma unroll
        for (int j = 0; j < 16; ++j) ck[j] = max(ck[j], g2[15 - j]);
        TK_BMERGE(ck);
#undef TK_KEY
#undef TK_SORT16
#undef TK_BMERGE
#undef TK_CE
        float den = 0.f; float ex[16]; const float c0 = ord2f(ck[0] & ~255);
#pragma unroll
        for (int j = 0; j < 16; ++j) { ex[j] = __expf(ord2f(ck[j] & ~255) - c0); den += ex[j]; }
        const float inv = 1.0f / den;
        if (!c1) { int* ep = EIDX + (size_t)tok * 128 + (hc >> 1) * 16; float* gp = GATE + (size_t)tok * 128 + (hc >> 1) * 16;
#pragma unroll
            for (int q = 0; q < 4; ++q) { u32x4 ev; f32x4 gv;
#pragma unroll
                for (int j = 0; j < 4; ++j) { const int flat = 255 - (ck[4 * q + j] & 255); ev[j] = (unsigned)((int)tab[(flat >> 4) * 64 + lane] * 128 + (int)tab[(16 + (flat & 15)) * 64 + lane]); gv[j] = ex[4 * q + j] * inv; }
                *(u32x4*)(ep + 4 * q) = ev; *(f32x4*)(gp + 4 * q) = gv; } }
    }
}

__device__ __forceinline__ float gelu_tanh(float h) { const float z = 0.7978845608028654f * (h + 0.044715f * h * h * h); const float t = 1.0f - 2.0f / (__expf(2.0f * z) + 1.0f); return 0.5f * h * (1.0f + t); }
struct PeerUMeta { int e_lo, e_hi; float g_lo, g_hi, xs; u32x4 xh0, xh1, xl0, xl1; };
__device__ __forceinline__ PeerUMeta peer_umeta_load(const unsigned char* XQ, const float* XS, const int* EIDX, const float* GATE, int tok, int lane) {
    PeerUMeta m; const unsigned char* xr = XQ + (size_t)tok * D + (lane & 15) * 16;
    m.e_lo = EIDX[(size_t)tok * 128 + lane]; m.e_hi = EIDX[(size_t)tok * 128 + 64 + lane]; m.g_lo = GATE[(size_t)tok * 128 + lane]; m.g_hi = GATE[(size_t)tok * 128 + 64 + lane]; m.xs = XS[tok];
    m.xh0 = *(const u32x4*)(xr); m.xh1 = *(const u32x4*)(xr + 256); m.xl0 = *(const u32x4*)(xr + 512); m.xl1 = *(const u32x4*)(xr + 768);
    return m;
}
template <int CTRL> __device__ __forceinline__ int dpp_movi(int v) { return __builtin_amdgcn_update_dpp(0, v, CTRL, 0xf, 0xf, false); }
__device__ __forceinline__ float gelu_tanh_fast(float h) { const float z = 0.7978845608028654f * (h + 0.044715f * h * h * h); const float t = 1.0f - 2.0f * __builtin_amdgcn_rcpf(__expf(2.0f * z) + 1.0f); return 0.5f * h * (1.0f + t); }
#define PU_IDS(I, E, kk) do { _Pragma("unroll") for (int a_ = 0; a_ < 4; ++a_) I[a_] = __builtin_amdgcn_ds_bpermute((g4 << 2) + (((kk) + 4 * a_) << 2), (E)); } while (0)
#define PU_LOAD(R, I) do { _Pragma("unroll") for (int a_ = 0; a_ < 4; ++a_) { const unsigned char* p_ = U4l + (size_t)I[a_] * 512; R[2 * a_] = *(const u32x4*)(p_); R[2 * a_ + 1] = *(const u32x4*)(p_ + 256); } \
        __builtin_amdgcn_sched_barrier(0); } while (0)
#define PU_COMP(R, M) do { int t_[4]; \
        _Pragma("unroll") for (int a_ = 0; a_ < 4; ++a_) { int h_ = 0, l_ = 0; \
            _Pragma("unroll") for (int w_ = 0; w_ < 4; ++w_) { h_ = __builtin_amdgcn_sdot8((int)R[2 * a_][w_], (int)cur.xh0[w_], h_, false); l_ = __builtin_amdgcn_sdot8((int)R[2 * a_][w_], (int)cur.xl0[w_], l_, false); \
                                                               h_ = __builtin_amdgcn_sdot8((int)R[2 * a_ + 1][w_], (int)cur.xh1[w_], h_, false); l_ = __builtin_amdgcn_sdot8((int)R[2 * a_ + 1][w_], (int)cur.xl1[w_], l_, false); } \
            int s_ = 16 * h_ + l_; s_ += dpp_movi<0x128>(s_); s_ += dpp_movi<0x124>(s_); s_ += dpp_movi<0x122>(s_); s_ += dpp_movi<0x121>(s_); t_[a_] = s_; } \
        M = (l16 & 2) ? ((l16 & 1) ? t_[3] : t_[2]) : ((l16 & 1) ? t_[1] : t_[0]); __builtin_amdgcn_sched_barrier(0); } while (0)
__device__ __forceinline__ void phase_peer_u(const Params& p, unsigned char* lds) {
    const int tid = tid_l(), lane = tid & 63, wave = tid >> 6, l16 = lane & 15, g4 = lane >> 4;
    const unsigned char* XQ = p.ws + WS_XQ; const float* XS = (const float*)(p.ws + WS_XS); const float* RS = (const float*)(p.ws + WS_RS); const float* VS = (const float*)(p.ws + WS_VS);
    const unsigned char* U4l = p.ws + WS_U + l16 * 16;
    const int* EIDX = (const int*)(p.ws + WS_EIDX); float* GATE = (float*)(p.ws + WS_GATE);
    const int stride = grid_l() * 8; int tok = __builtin_amdgcn_readfirstlane(bid_l() * 8 + wave);
    if (tok >= T) return;
    PeerUMeta cur = peer_umeta_load(XQ, XS, EIDX, GATE, tok, lane);
    u32x4 Ra[8], Rb[8]; int Ia[4], Ib[4];
    PU_IDS(Ia, cur.e_lo, 0); PU_LOAD(Ra, Ia); PU_IDS(Ib, cur.e_lo, 16);
    const int qd = ((((lane & 3) << 4) + ((lane >> 2) & 3)) << 2);
#pragma unroll 1
    for (; tok < T; tok += stride) {
        const PeerUMeta nxt = peer_umeta_load(XQ, XS, EIDX, GATE, tok + stride < T ? tok + stride : tok, lane);
        const float rs_lo = RS[cur.e_lo], rs_hi = RS[cur.e_hi], vs_lo = VS[cur.e_lo], vs_hi = VS[cur.e_hi];
        __builtin_amdgcn_sched_barrier(0);
        int m0, m1, m2, m3, m4, m5, m6, m7;
        PU_LOAD(Rb, Ib); PU_IDS(Ia, cur.e_lo, 32); PU_COMP(Ra, m0);
        PU_LOAD(Ra, Ia); PU_IDS(Ib, cur.e_lo, 48); PU_COMP(Rb, m1);
        PU_LOAD(Rb, Ib); PU_IDS(Ia, cur.e_hi, 0);  PU_COMP(Ra, m2);
        PU_LOAD(Ra, Ia); PU_IDS(Ib, cur.e_hi, 16); PU_COMP(Rb, m3);
        PU_LOAD(Rb, Ib); PU_IDS(Ia, cur.e_hi, 32); PU_COMP(Ra, m4);
        PU_LOAD(Ra, Ia); PU_IDS(Ib, cur.e_hi, 48); PU_COMP(Rb, m5);
        PU_LOAD(Rb, Ib); PU_IDS(Ia, nxt.e_lo, 0);  PU_COMP(Ra, m6);
        PU_LOAD(Ra, Ia); PU_IDS(Ib, nxt.e_lo, 16); PU_COMP(Rb, m7);
        const int d0 = __builtin_amdgcn_ds_bpermute(qd, m0), d1 = __builtin_amdgcn_ds_bpermute(qd, m1), d2 = __builtin_amdgcn_ds_bpermute(qd, m2), d3 = __builtin_amdgcn_ds_bpermute(qd, m3);
        const int d4 = __builtin_amdgcn_ds_bpermute(qd, m4), d5 = __builtin_amdgcn_ds_bpermute(qd, m5), d6 = __builtin_amdgcn_ds_bpermute(qd, m6), d7 = __builtin_amdgcn_ds_bpermute(qd, m7);
        const float c_lo = (float)((lane & 32) ? ((lane & 16) ? d3 : d2) : ((lane & 16) ? d1 : d0)), c_hi = (float)((lane & 32) ? ((lane & 16) ? d7 : d6) : ((lane & 16) ? d5 : d4));
        GATE[(size_t)tok * 128 + lane] = cur.g_lo * gelu_tanh_fast(c_lo * (rs_lo * cur.xs)) * vs_lo;
        GATE[(size_t)tok * 128 + 64 + lane] = cur.g_hi * gelu_tanh_fast(c_hi * (rs_hi * cur.xs)) * vs_hi;
        cur = nxt;
    }
}
#undef PU_IDS
#undef PU_LOAD
#undef PU_COMP
struct PeerVMeta { int e_lo, e_hi; float c_lo, c_hi; u32x4 x0, x1; };
__device__ __forceinline__ PeerVMeta peer_vmeta_load(const int* EIDX, const float* COEF, const bf16* XB, int tok, int lane) {
    PeerVMeta m;
    m.e_lo = EIDX[(size_t)tok * 128 + lane]; m.e_hi = EIDX[(size_t)tok * 128 + 64 + lane]; m.c_lo = COEF[(size_t)tok * 128 + lane]; m.c_hi = COEF[(size_t)tok * 128 + 64 + lane];
    const int xo = (lane & 31) * 32 + (lane >> 5) * 16;
    m.x0 = *(const u32x4*)(XB + (size_t)tok * D + xo); m.x1 = *(const u32x4*)(XB + (size_t)tok * D + xo + 8);
    return m;
}
#define PV_ISSUE(VR, CF, PE, PC, jj) do { _Pragma("unroll") for (int q = 0; q < 8; ++q) { const int a_ = hb + (((jj) + q) << 2); const int e_ = __builtin_amdgcn_ds_bpermute(a_, (int)(PE)); \
        CF[q] = __int_as_float(__builtin_amdgcn_ds_bpermute(a_, (int)(PC))); VR[q] = *(const u32x4*)(V4l + (size_t)e_ * 512); } __builtin_amdgcn_sched_barrier(0); } while (0)
#define PV_COMPUTE(VR, CF) do { _Pragma("unroll") for (int q = 0; q < 8; ++q) { const f32x2v c2 = (f32x2v){CF[q], CF[q]}; \
        _Pragma("unroll") for (int w = 0; w < 4; ++w) { \
            acc[4 * w] += __builtin_amdgcn_cvt_scalef32_pk_f32_fp4(VR[q][w], 1.0f, 0) * c2; acc[4 * w + 1] += __builtin_amdgcn_cvt_scalef32_pk_f32_fp4(VR[q][w], 1.0f, 1) * c2; \
            acc[4 * w + 2] += __builtin_amdgcn_cvt_scalef32_pk_f32_fp4(VR[q][w], 1.0f, 2) * c2; acc[4 * w + 3] += __builtin_amdgcn_cvt_scalef32_pk_f32_fp4(VR[q][w], 1.0f, 3) * c2; } } \
        __builtin_amdgcn_sched_barrier(0); } while (0)
__device__ __forceinline__ void phase_peer_v(const Params& p) {
    const int tid = tid_l(), lane = tid & 63, wave = tid >> 6;
    const unsigned char* V4l = p.ws + WS_V + (lane & 31) * 16;
    const int* EIDX = (const int*)(p.ws + WS_EIDX); const float* COEF = (const float*)(p.ws + WS_GATE);
    bf16* XB = (bf16*)(p.ws + WS_XB);
    const int hb = (lane & 32) << 2;
    const int xo = (lane & 31) * 32 + (lane >> 5) * 16;
    const int stride = grid_l() * 8; int tok = __builtin_amdgcn_readfirstlane(bid_l() * 8 + wave);
    if (tok >= T) return;
    PeerVMeta cur = peer_vmeta_load(EIDX, COEF, XB, tok, lane);
    auto se = __builtin_amdgcn_permlane32_swap((unsigned)cur.e_lo, (unsigned)cur.e_hi, false, false); auto sc_ = __builtin_amdgcn_permlane32_swap(__float_as_uint(cur.c_lo), __float_as_uint(cur.c_hi), false, false);
    u32x4 vrA[8], vrB[8]; float cfA[8], cfB[8];
    PV_ISSUE(vrA, cfA, se[0], sc_[0], 0);
#pragma unroll 1
    for (; tok < T; tok += stride) {
        const PeerVMeta nxt = peer_vmeta_load(EIDX, COEF, XB, tok + stride < T ? tok + stride : tok, lane);
        __builtin_amdgcn_sched_barrier(0);
        f32x2v acc[16];
#pragma unroll
        for (int i = 0; i < 16; ++i) acc[i] = (f32x2v){0.f, 0.f};
        PV_ISSUE(vrB, cfB, se[0], sc_[0], 8);  PV_COMPUTE(vrA, cfA);
        PV_ISSUE(vrA, cfA, se[0], sc_[0], 16); PV_COMPUTE(vrB, cfB);
        PV_ISSUE(vrB, cfB, se[0], sc_[0], 24); PV_COMPUTE(vrA, cfA);
        PV_ISSUE(vrA, cfA, se[1], sc_[1], 0);  PV_COMPUTE(vrB, cfB);
        PV_ISSUE(vrB, cfB, se[1], sc_[1], 8);  PV_COMPUTE(vrA, cfA);
        PV_ISSUE(vrA, cfA, se[1], sc_[1], 16); PV_COMPUTE(vrB, cfB);
        PV_ISSUE(vrB, cfB, se[1], sc_[1], 24); PV_COMPUTE(vrA, cfA);
        se = __builtin_amdgcn_permlane32_swap((unsigned)nxt.e_lo, (unsigned)nxt.e_hi, false, false); sc_ = __builtin_amdgcn_permlane32_swap(__float_as_uint(nxt.c_lo), __float_as_uint(nxt.c_hi), false, false);
        PV_ISSUE(vrA, cfA, se[0], sc_[0], 0);  PV_COMPUTE(vrB, cfB);
        float sres[16];
#pragma unroll
        for (int i = 0; i < 8; ++i)
#pragma unroll
            for (int c = 0; c < 2; ++c) { const auto r_ = __builtin_amdgcn_permlane32_swap(__float_as_uint(acc[i][c]), __float_as_uint(acc[8 + i][c]), false, false);
                sres[2 * i + c] = __uint_as_float(r_[0]) + __uint_as_float(r_[1]); }
        float r[16];
#pragma unroll
        for (int i = 0; i < 4; ++i) { r[2 * i] = ALPHA * bf2f(cur.x0[i] & 0xffffu) + sres[2 * i]; r[2 * i + 1] = ALPHA * __uint_as_float(cur.x0[i] & 0xffff0000u) + sres[2 * i + 1];
                                      r[8 + 2 * i] = ALPHA * bf2f(cur.x1[i] & 0xffffu) + sres[8 + 2 * i]; r[8 + 2 * i + 1] = ALPHA * __uint_as_float(cur.x1[i] & 0xffff0000u) + sres[8 + 2 * i + 1]; }
#pragma unroll
        for (int w = 0; w < 2; ++w) { u32x4 o; o.x = pk2(r[8 * w], r[8 * w + 1]); o.y = pk2(r[8 * w + 2], r[8 * w + 3]); o.z = pk2(r[8 * w + 4], r[8 * w + 5]); o.w = pk2(r[8 * w + 6], r[8 * w + 7]);
            *(u32x4*)(XB + (size_t)tok * D + xo + 8 * w) = o; }
        cur = nxt;
    }
}
#undef PV_ISSUE
#undef PV_COMPUTE
#define GAS __attribute__((address_space(1)))
#define LAS __attribute__((address_space(3)))
#define XB_TMO      128
#define XB_XCNT(j)  (256  + 64 * (j))
#define XB_XSUB(j)  (1280 + 64 * (j))
#define XB_XGEN(j)  (2304 + 64 * (j))
#define XB_TOP      3328
#define XB_TOPGEN   3392
#define XCD_BAR_WORDS 3456
#define XB_SPIN_CAP (1u << 18)

__device__ __forceinline__ unsigned xb_ld(unsigned* p)              { return __hip_atomic_load(p, __ATOMIC_RELAXED, __HIP_MEMORY_SCOPE_AGENT); }
__device__ __forceinline__ unsigned xb_add(unsigned* p, unsigned v) { return __hip_atomic_fetch_add(p, v, __ATOMIC_RELAXED, __HIP_MEMORY_SCOPE_AGENT); }
__device__ __forceinline__ unsigned xb_xcc_id() { return (unsigned)__builtin_amdgcn_s_getreg((3 << 11) | 20) & 0xFu; }
#define XB_SPIN(cond, bar) do { unsigned _sp = 0; while (cond) { __builtin_amdgcn_s_sleep(1); \
    if ((++_sp & 255u) == 0u) { if (xb_ld(&(bar)[XB_TMO])) break; if (_sp > XB_SPIN_CAP) { atomicAdd(&(bar)[XB_TMO], 1u); break; } } } } while (0)

struct XcdBarrier {
    unsigned* bar; unsigned x;
    volatile LAS unsigned* st;
};

__device__ __forceinline__ XcdBarrier xcd_barrier_post(unsigned* bar, volatile LAS unsigned* st) {
    XcdBarrier b; b.bar = bar; b.x = xb_xcc_id(); b.st = st;
    if (threadIdx.x == 0) (void)xb_add(&bar[XB_XCNT(b.x)], 1u);
    return b;
}
__device__ __forceinline__ void xcd_barrier_complete(unsigned* bar, unsigned x, unsigned& nloc, unsigned& nx) {
    const unsigned G = gridDim.x * gridDim.y * gridDim.z;
    unsigned sum, cnt, mine, sp = 0u;
    for (;;) {
        sum = 0u; cnt = 0u; mine = 0u;
#pragma unroll
        for (unsigned j = 0; j < 16; ++j) { const unsigned c = xb_ld(&bar[XB_XCNT(j)]); sum += c; cnt += (c > 0u) ? 1u : 0u; mine = (j == x) ? c : mine; }
        if (sum == G) break;
        __builtin_amdgcn_s_sleep(1);
        if ((++sp & 255u) == 0u) { if (xb_ld(&bar[XB_TMO])) break; if (sp > XB_SPIN_CAP) { atomicAdd(&bar[XB_TMO], 1u); break; } }
    }
    nloc = mine > 0u ? mine : 1u; nx = cnt > 0u ? cnt : 1u;
}

__device__ __forceinline__ void xcd_barrier(const XcdBarrier& b) {
    asm volatile("s_waitcnt vmcnt(0)" ::: "memory");
    __syncthreads();
    if (threadIdx.x == 0) {
        unsigned* bar = b.bar;
        __builtin_amdgcn_s_waitcnt(0);
        unsigned nloc = b.st[0], nx = b.st[1];
        if (nloc == 0u) { xcd_barrier_complete(bar, b.x, nloc, nx); b.st[0] = nloc; b.st[1] = nx; }
        const unsigned old = xb_add(&bar[XB_XSUB(b.x)], 1u);
        const unsigned gen = old / nloc;
        if (old + 1u == (gen + 1u) * nloc) {
            __builtin_amdgcn_fence(__ATOMIC_RELEASE, "agent");
            asm volatile("s_waitcnt vmcnt(0)" ::: "memory");
            const unsigned og = xb_add(&bar[XB_TOP], 1u);
            const unsigned tg = og / nx;
            if (og + 1u == (tg + 1u) * nx) xb_add(&bar[XB_TOPGEN], 1u);
            else XB_SPIN(xb_ld(&bar[XB_TOPGEN]) == tg, bar);
            __builtin_amdgcn_fence(__ATOMIC_ACQUIRE, "agent");
            xb_add(&bar[XB_XGEN(b.x)], 1u);
            asm volatile("s_waitcnt vmcnt(0)" ::: "memory");
        } else {
            XB_SPIN(xb_ld(&bar[XB_XGEN(b.x)]) == gen, bar);
            __builtin_amdgcn_fence(__ATOMIC_ACQUIRE, "agent");
            asm volatile("s_waitcnt vmcnt(0)" ::: "memory");
        }
    }
    __syncthreads();
}
enum { PH_PRO_A, PH_PRO_B, PH_CVT, PH_GEMM_IN, PH_GEMM_E, PH_CONV, PH_FOXCUM, PH_FOXNORM, PH_GLA1, PH_GLA2, PH_GLA3, PH_FOX, PH_GEMM_OUT, PH_LN1, PH_GEMM_SC, PH_TOPK, PH_PEERU, PH_PEERV, PH_GEMM_PLE, PH_LN2, PH_COUNT };

template <int PH> __device__ __forceinline__ void run_phase(const Params& p, int l, unsigned char* lds) {
    if constexpr (PH == PH_PRO_A) phase_pro_a(p, lds);
    else if constexpr (PH == PH_PRO_B) phase_pro_b(p, lds);
    else if constexpr (PH == PH_CVT) phase_cvt(p, l);
    else if constexpr (PH == PH_GEMM_IN) phase_gemm_in(p, l, lds);
    else if constexpr (PH == PH_GEMM_E) phase_gemm_e(p, l, lds);
    else if constexpr (PH == PH_CONV) phase_conv(p, l, lds);
    else if constexpr (PH == PH_FOXCUM) phase_fox_cum(p, l, lds);
    else if constexpr (PH == PH_FOXNORM) phase_fox_norm(p, lds);
    else if constexpr (PH == PH_GLA1) phase_gla_b1(p, l, lds);
    else if constexpr (PH == PH_GLA2) phase_gla_b2(p);
    else if constexpr (PH == PH_GLA3) phase_gla_b3(p, l, lds);
    else if constexpr (PH == PH_FOX) phase_fox_mfma(p, l, lds);
    else if constexpr (PH == PH_GEMM_OUT) phase_gemm_out(p, l, lds);
    else if constexpr (PH == PH_LN1) phase_ln((const _Float16*)(p.ws + WS_Y), p.ln1_g + (size_t)l * D, p.ln1_b + (size_t)l * D, nullptr, (bf16*)(p.ws + WS_XB), p.ws + WS_XQ, (float*)(p.ws + WS_XS));
    else if constexpr (PH == PH_GEMM_SC) phase_gemm_sc(p, l, lds);
    else if constexpr (PH == PH_TOPK) phase_topk(p, lds);
    else if constexpr (PH == PH_PEERU) phase_peer_u(p, lds);
    else if constexpr (PH == PH_PEERV) phase_peer_v(p);
    else if constexpr (PH == PH_GEMM_PLE) phase_gemm_ple(p, l, lds);
    else if constexpr (PH == PH_LN2) phase_ln((const _Float16*)(p.ws + WS_Y), p.ln2_g + (size_t)l * D, p.ln2_b + (size_t)l * D, l == DEPTH - 1 ? p.out : nullptr, l == DEPTH - 1 ? nullptr : (bf16*)(p.ws + WS_XB));
}

constexpr int MISC_OFF = LDS_BYTES - 512;
constexpr int CW_BAR = 4096;
static_assert(MISC_OFF + 128 <= LDS_BYTES && (CW_BAR + XCD_BAR_WORDS) * 4 <= (int)CTL_ZERO_BYTES, "control words");

typedef __attribute__((address_space(4))) const Params CParams;
#define PHASE(PH) do { CParams* q_ = pp; asm volatile("" : "+s"(q_)); Params lp_; __builtin_memcpy(&lp_, q_, sizeof(Params)); run_phase<PH>(lp_, l, lds); } while (0)
__global__ void __launch_bounds__(512, 2) mk_fwd(Params p_unused) {
#if defined(__HIP_DEVICE_COMPILE__)
    extern __shared__ __attribute__((aligned(16))) unsigned char lds[];
    CParams* pp = (CParams*)__builtin_amdgcn_kernarg_segment_ptr();
    unsigned char* ws0; { CParams* q_ = pp; asm volatile("" : "+s"(q_)); ws0 = q_->ws; }
    volatile LAS unsigned* MISC = (volatile LAS unsigned*)((LAS unsigned char*)lds + MISC_OFF);
    if (threadIdx.x < 32) MISC[threadIdx.x] = 0u;
    __syncthreads();
    (void)xcd_barrier_post((unsigned*)(ws0 + WS_CTL) + CW_BAR, MISC + 8);
#define GB() do { CParams* qb_ = pp; asm volatile("" : "+s"(qb_)); XcdBarrier b_; b_.bar = (unsigned*)(qb_->ws + WS_CTL) + CW_BAR; b_.x = xb_xcc_id(); b_.st = MISC + 8; xcd_barrier(b_); } while (0)
    { const int l = 0; PHASE(PH_PRO_A); PHASE(PH_PRO_B); } GB();
    for (int l = 0; l < DEPTH; ++l) {
        PHASE(PH_CVT); PHASE(PH_GEMM_IN); GB();
        PHASE(PH_GEMM_E); PHASE(PH_CONV); PHASE(PH_FOXCUM); PHASE(PH_FOXNORM); PHASE(PH_GLA1); GB();
        PHASE(PH_GLA2); PHASE(PH_FOX); GB();
        PHASE(PH_GLA3); GB();
        PHASE(PH_GEMM_OUT); GB();
        PHASE(PH_LN1); GB();
        PHASE(PH_GEMM_SC); GB();
        PHASE(PH_TOPK); GB();
        PHASE(PH_PEERU); GB();
        PHASE(PH_PEERV); GB();
        PHASE(PH_GEMM_PLE); GB();
        PHASE(PH_LN2); GB();
    }
#undef GB
#endif
}

extern "C" void kernel_launch(void* const* d_in, const int* in_sizes, int n_in, void* d_out, int out_size, void* d_ws, size_t ws_size, hipStream_t stream) {
    static int grid = 0;
    if (grid == 0) {
        if (n_in != 23 || ws_size < WS_END) { fprintf(stderr, "kernel_launch: unexpected n_in %d or ws_size %zu\n", n_in, ws_size); grid = -1; return; }
        int dev = 0, cus = 0, per_cu = 0;
        if (hipGetDevice(&dev) != hipSuccess || hipDeviceGetAttribute(&cus, hipDeviceAttributeMultiprocessorCount, dev) != hipSuccess) { grid = -1; return; }
        if (hipFuncSetAttribute((const void*)mk_fwd, hipFuncAttributeMaxDynamicSharedMemorySize, LDS_BYTES) != hipSuccess) { grid = -1; return; }
        if (hipOccupancyMaxActiveBlocksPerMultiprocessor(&per_cu, (const void*)mk_fwd, 512, LDS_BYTES) != hipSuccess || per_cu < 1) { fprintf(stderr, "kernel_launch: occupancy query says %d\n", per_cu); }
        (void)hipGetLastError();
        grid = cus;
    }
    if (grid < 0) return;
    if (hipMemsetAsync((char*)d_ws + WS_CTL, 0, CTL_ZERO_BYTES, stream) != hipSuccess) return;
    Params p; memset(&p, 0, sizeof(p));
    const float** f = (const float**)&p;
    for (int i = 0; i < 23; ++i) f[i] = (const float*)d_in[i];
    p.out = (float*)d_out; p.ws = (unsigned char*)d_ws;
    hipLaunchKernelGGL(mk_fwd, dim3(grid), dim3(512), LDS_BYTES, stream, p);
}
```

```cpp
#include <hip/hip_runtime.h>
#include <cstdio>
#include <cstdint>
#include <cstring>
#include <cmath>
__device__ __forceinline__ int tid_l() { int t = threadIdx.x; asm volatile("" : "+v"(t)); return t; }
__device__ __forceinline__ int bid_l() { int b = blockIdx.x; asm volatile("" : "+s"(b)); return b; }
__device__ __forceinline__ int grid_l() { int g = gridDim.x; asm volatile("" : "+s"(g)); return g; }
namespace pg8 {
#define PG8_LAS __attribute__((address_space(3)))
typedef unsigned short bf16_t;
typedef short bf16x8 __attribute__((ext_vector_type(8)));
typedef float f32x4 __attribute__((ext_vector_type(4)));
typedef unsigned u32x4 __attribute__((ext_vector_type(4)));
constexpr int BM = 256, BK = 64, HALF = 128, HTB = HALF * BK * 2  , STAGE_BYTES = 8 * HTB, NXCD = 8, WGM = 8;

__host__ __device__ __forceinline__ int lds_byte(int r, int c) { const int st = (r >> 4) * 2 + (c >> 5), rr = r & 15, cc = c & 31, ob = rr * 64 + cc * 2; return st * 1024 + (ob ^ (((ob >> 9) & 1) << 5)); }
__host__ __device__ __forceinline__ void stage_rc(int b, int& R, int& C) { const int st = b / 1024, sb = b % 1024, swz = sb ^ (((sb >> 9) & 1) << 5); R = (st >> 1) * 16 + swz / 64; C = (st & 1) * 32 + (swz % 64) / 2; }
__host__ __device__ __forceinline__ int perm32(int rho) { const int n = rho >> 4, i = rho & 15; return 8 * (i >> 2) + 4 * n + (i & 3); }

struct Unit { int pm, pn; };
struct Gemm { const bf16_t* A; const bf16_t* Bt; int M, N, K; };

struct StaticOrder {
    int nM, nN, nwg, G, c;
    __host__ __device__ void init(int M, int N, int G_, int c_) { nM = M / BM; nN = N / BM; nwg = nM * nN; G = G_; c = c_; }
    __host__ __device__ bool next(int i, Unit& u) const {
        const long L = (long)i * G + c; if (L >= nwg) return false;
        int wgid = (int)L; { const int q = nwg / NXCD, r = nwg % NXCD, xcd = wgid % NXCD, off = wgid / NXCD; wgid = (xcd < r ? xcd * (q + 1) : r * (q + 1) + (xcd - r) * q) + off; }
        const int nig = WGM * nN, gid = wgid / nig, fm = gid * WGM, gsz = (nM - fm) < WGM ? (nM - fm) : WGM;
        u.pm = fm + ((wgid % nig) % gsz); u.pn = (wgid % nig) / gsz; return true;
    }
    __device__ __forceinline__ void a_ready(const Unit&) const {}
    __device__ __forceinline__ void done(const Unit&) const {}
};

__device__ __forceinline__ unsigned cvt_pk_bf16(float lo, float hi) { unsigned r; asm volatile("v_cvt_pk_bf16_f32 %0, %1, %2" : "=v"(r) : "v"(lo), "v"(hi)); return r; }
typedef float f32x2 __attribute__((ext_vector_type(2)));
__device__ __forceinline__ f32x2 gelu_pk(f32x2 v) {
    const f32x2 av = __builtin_elementwise_abs(v), d = av * 0.2316418882f + 1.0f;
    f32x2 t; t.x = __builtin_amdgcn_rcpf(d.x); t.y = __builtin_amdgcn_rcpf(d.y);
    f32x2 q = t * 0.5307027145f + (-0.7265760135f); q = q * t + 0.7107068705f; q = q * t + (-0.142248368f); q = q * t + 0.127414796f; q = q * t;
    const f32x2 s = (v * v) * (-0.72134752044f);
    f32x2 e; e.x = __builtin_amdgcn_exp2f(s.x); e.y = __builtin_amdgcn_exp2f(s.y);
    const f32x2 m = v * (q * e), r = v - m;
    f32x2 o; o.x = v.x < 0.f ? m.x : r.x; o.y = v.y < 0.f ? m.y : r.y; return o;
}

template <int ACT  > struct EpiBf16 {
    static constexpr bool PERM = true, AFTER_DRAIN = false; static_assert(ACT == 0 || ACT == 1, "EpiBf16: ACT is 0 (none) or 1 (gelu_pk)");
    bf16_t* O; int ldc; const float* bias; int split_cols; size_t split_stride; float scale0;
    __device__ __forceinline__ void operator()(const f32x4 (&acc)[2][2][4][2], const Unit& u, int wr, int wc, int fr, int fq) const {
        const int row0 = u.pm * BM + wr * 64 + fr; int colt = u.pn * BM; bf16_t* base = O;
        float sc = 1.f; if (split_cols) { const int t = colt / split_cols; base += (size_t)t * split_stride; colt -= t * split_cols; if (t == 0) sc = scale0; }
        const int col0 = colt + wc * 32 + 8 * fq, bcol0 = u.pn * BM + wc * 32 + 8 * fq;
        f32x4 bv[2][2];
#pragma unroll
        for (int bj = 0; bj < 2; ++bj)
#pragma unroll
            for (int n = 0; n < 2; ++n) bv[bj][n] = bias ? *(const f32x4*)(bias + bcol0 + bj * HALF + 4 * n) : (f32x4){0.f, 0.f, 0.f, 0.f};
#pragma unroll
        for (int ai = 0; ai < 2; ++ai)
#pragma unroll
            for (int m = 0; m < 4; ++m) { bf16_t* rowp = base + (size_t)(row0 + ai * HALF + m * 16) * ldc + col0;
#pragma unroll
                for (int bj = 0; bj < 2; ++bj) { f32x4 v0 = acc[ai][bj][m][0] + bv[bj][0], v1 = acc[ai][bj][m][1] + bv[bj][1];
                    if (ACT == 1) { f32x2 a = gelu_pk((f32x2){v0[0], v0[1]}), b = gelu_pk((f32x2){v0[2], v0[3]}), c = gelu_pk((f32x2){v1[0], v1[1]}), d = gelu_pk((f32x2){v1[2], v1[3]});
                        v0 = (f32x4){a.x, a.y, b.x, b.y}; v1 = (f32x4){c.x, c.y, d.x, d.y}; }
                    v0 = v0 * sc; v1 = v1 * sc; u32x4 w; w.x = cvt_pk_bf16(v0[0], v0[1]); w.y = cvt_pk_bf16(v0[2], v0[3]); w.z = cvt_pk_bf16(v1[0], v1[1]); w.w = cvt_pk_bf16(v1[2], v1[3]);
                    *(u32x4*)(rowp + bj * HALF) = w; } }
    }
};
struct EpiF16 {
    static constexpr bool PERM = true, AFTER_DRAIN = false;
    _Float16* O; int ldc;
    __device__ __forceinline__ void operator()(const f32x4 (&acc)[2][2][4][2], const Unit& u, int wr, int wc, int fr, int fq) const {
        typedef _Float16 h8 __attribute__((ext_vector_type(8)));
        const int row0 = u.pm * BM + wr * 64 + fr, col0 = u.pn * BM + wc * 32 + 8 * fq;
#pragma unroll
        for (int ai = 0; ai < 2; ++ai)
#pragma unroll
            for (int m = 0; m < 4; ++m) { _Float16* rowp = O + (size_t)(row0 + ai * HALF + m * 16) * ldc + col0;
#pragma unroll
                for (int bj = 0; bj < 2; ++bj) { const f32x4 a = acc[ai][bj][m][0], b = acc[ai][bj][m][1];
                    h8 o; o[0] = (_Float16)a[0]; o[1] = (_Float16)a[1]; o[2] = (_Float16)a[2]; o[3] = (_Float16)a[3]; o[4] = (_Float16)b[0]; o[5] = (_Float16)b[1]; o[6] = (_Float16)b[2]; o[7] = (_Float16)b[3];
                    *(h8*)(rowp + bj * HALF) = o; } }
    }
};
struct EpiResid {
    static constexpr bool PERM = true, AFTER_DRAIN = false;
    const bf16_t* res; _Float16* Y; int ldc; float alpha;
    __device__ __forceinline__ void operator()(const f32x4 (&acc)[2][2][4][2], const Unit& u, int wr, int wc, int fr, int fq) const {
        const int row0 = u.pm * BM + wr * 64 + fr, col0 = u.pn * BM + wc * 32 + 8 * fq;
#pragma unroll
        for (int ai = 0; ai < 2; ++ai)
#pragma unroll
            for (int m = 0; m < 4; ++m) { const size_t off = (size_t)(row0 + ai * HALF + m * 16) * ldc + col0;
#pragma unroll
                for (int bj = 0; bj < 2; ++bj) { const u32x4 rv = *(const u32x4*)(res + off + bj * HALF);
                    f32x4 r0, r1; r0[0] = __uint_as_float(rv.x << 16); r0[1] = __uint_as_float(rv.x & 0xffff0000u); r0[2] = __uint_as_float(rv.y << 16); r0[3] = __uint_as_float(rv.y & 0xffff0000u);
                    r1[0] = __uint_as_float(rv.z << 16); r1[1] = __uint_as_float(rv.z & 0xffff0000u); r1[2] = __uint_as_float(rv.w << 16); r1[3] = __uint_as_float(rv.w & 0xffff0000u);
                    const f32x4 y0 = r0 * alpha + acc[ai][bj][m][0], y1 = r1 * alpha + acc[ai][bj][m][1];
                    typedef _Float16 h8 __attribute__((ext_vector_type(8))); h8 w; w[0] = (_Float16)y0[0]; w[1] = (_Float16)y0[1]; w[2] = (_Float16)y0[2]; w[3] = (_Float16)y0[3]; w[4] = (_Float16)y1[0]; w[5] = (_Float16)y1[1]; w[6] = (_Float16)y1[2]; w[7] = (_Float16)y1[3];
                    *(h8*)(Y + off + bj * HALF) = w; } }
    }
};
struct EpiPle {
    static constexpr bool PERM = true, AFTER_DRAIN = false;
    const bf16_t* R; _Float16* Y; const bf16_t* E; const float* gb; int ldc;
    __device__ __forceinline__ void operator()(const f32x4 (&acc)[2][2][4][2], const Unit& u, int wr, int wc, int fr, int fq) const {
        const int row0 = u.pm * BM + wr * 64 + fr, col0 = u.pn * BM + wc * 32 + 8 * fq;
        f32x4 bv[2][2];
#pragma unroll
        for (int bj = 0; bj < 2; ++bj)
#pragma unroll
            for (int n = 0; n < 2; ++n) bv[bj][n] = *(const f32x4*)(gb + col0 + bj * HALF + 4 * n);
#pragma unroll
        for (int ai = 0; ai < 2; ++ai)
#pragma unroll
            for (int m = 0; m < 4; ++m) { const size_t off = (size_t)(row0 + ai * HALF + m * 16) * ldc + col0;
#pragma unroll
                for (int bj = 0; bj < 2; ++bj) {
                    const u32x4 ev = *(const u32x4*)(E + off + bj * HALF), rv = *(const u32x4*)(R + off + bj * HALF);
                    float o[8];
#pragma unroll
                    for (int n = 0; n < 2; ++n) {
                        const f32x4 z = acc[ai][bj][m][n] + bv[bj][n];
                        const unsigned e0 = n == 0 ? ev.x : ev.z, e1 = n == 0 ? ev.y : ev.w, r0 = n == 0 ? rv.x : rv.z, r1 = n == 0 ? rv.y : rv.w;
                        f32x4 ee, rr; ee[0] = __uint_as_float(e0 << 16); ee[1] = __uint_as_float(e0 & 0xffff0000u); ee[2] = __uint_as_float(e1 << 16); ee[3] = __uint_as_float(e1 & 0xffff0000u);
                        rr[0] = __uint_as_float(r0 << 16); rr[1] = __uint_as_float(r0 & 0xffff0000u); rr[2] = __uint_as_float(r1 << 16); rr[3] = __uint_as_float(r1 & 0xffff0000u);
#pragma unroll
                        for (int i = 0; i < 4; ++i) o[4 * n + i] = rr[i] + ee[i] * __builtin_amdgcn_rcpf(1.0f + __expf(-z[i])); }
                    typedef _Float16 h8 __attribute__((ext_vector_type(8))); h8 w;
#pragma unroll
                    for (int i = 0; i < 8; ++i) w[i] = (_Float16)o[i];
                    *(h8*)(Y + off + bj * HALF) = w; } }
    }
};
template <class Epi, class Sched, bool ALIGN_EPI = false, bool SP2 = false>
__device__ __forceinline__ void gemm_phase(PG8_LAS unsigned char* lds, const Gemm g, const Sched& S, const Epi& E) {
    const int tid = tid_l(), wid = __builtin_amdgcn_readfirstlane(tid >> 6), lane = tid & 63, wr = wid >> 2, wc = wid & 3, fr = lane & 15, fq = lane >> 4;
    const int K = g.K, nt = K / BK;
    unsigned voffA[2], voffB[2];
#pragma unroll
    for (int i = 0; i < 2; ++i) { int R, C; stage_rc(tid * 16 + i * 8192, R, C); const int Rb = Epi::PERM ? ((R & ~31) + perm32(R & 31)) : R;
        voffA[i] = (unsigned)(R * K + C) * 2u; voffB[i] = (unsigned)(Rb * K + C) * 2u; }
    const size_t kstep = (size_t)(BK * 2);
    const size_t hstep = (size_t)HALF * K * 2;
    const size_t tstep = 2 * hstep;
    const unsigned ldsw = (unsigned)wid * 1024u;
    const int aoff = lds_byte(wr * 64 + fr, fq * 8), boff = lds_byte(wc * 32 + fr, fq * 8);
#define PG8_SA(b, h) (((b) * 2 + (h)) * HTB)
#define PG8_SB(b, h) ((4 + (b) * 2 + (h)) * HTB)
#define PG8_STAGE(bufoff, gbase, voff) do { _Pragma("unroll") for (int _i = 0; _i < 2; ++_i) \
        __builtin_amdgcn_global_load_lds((const unsigned*)((const char*)(gbase) + (voff)[_i]), (PG8_LAS unsigned*)(lds + (bufoff) + ldsw + _i * 8192), 16, 0, 0); } while (0)
#define PG8_LDA(dst, b, h) do { _Pragma("unroll") for (int m = 0; m < 4; ++m) _Pragma("unroll") for (int k = 0; k < 2; ++k) dst[m][k] = *(const PG8_LAS bf16x8*)(lds + PG8_SA(b, h) + aoff + m * 2048 + k * 1024); } while (0)
#define PG8_LDB(dst, b, h) do { _Pragma("unroll") for (int n = 0; n < 2; ++n) _Pragma("unroll") for (int k = 0; k < 2; ++k) dst[n][k] = *(const PG8_LAS bf16x8*)(lds + PG8_SB(b, h) + boff + n * 2048 + k * 1024); } while (0)
#define PG8_MMA(ai, bj, At, Bt) do { __builtin_amdgcn_s_setprio(1); _Pragma("unroll") for (int m = 0; m < 4; ++m) _Pragma("unroll") for (int n = 0; n < 2; ++n) _Pragma("unroll") for (int k = 0; k < 2; ++k) \
        acc[ai][bj][m][n] = __builtin_amdgcn_mfma_f32_16x16x32_bf16(Bt[n][k], At[m][k], acc[ai][bj][m][n], 0, 0, 0); __builtin_amdgcn_s_setprio(0); } while (0)
#define PG8_WAIT_V(n) asm volatile("s_waitcnt vmcnt(" #n ")" ::: "memory")
#define PG8_WAIT_L(n) asm volatile("s_waitcnt lgkmcnt(" #n ")" ::: "memory")
#define PG8_BAR __builtin_amdgcn_s_barrier()
#define PG8_SCHED __builtin_amdgcn_sched_barrier(0)
    Unit cur, nxt; int ui = 0;
    if (!S.next(0, cur)) return;
    f32x4 acc[2][2][4][2];
#pragma unroll
    for (int a = 0; a < 2; ++a)
#pragma unroll
        for (int b = 0; b < 2; ++b)
#pragma unroll
            for (int m = 0; m < 4; ++m)
#pragma unroll
                for (int n = 0; n < 2; ++n) acc[a][b][m][n] = (f32x4){0.f, 0.f, 0.f, 0.f};
    bf16x8 At[4][2], B0[2][2], B1[2][2];
    const char* cA = (const char*)g.A + (size_t)cur.pm * tstep; const char* cB = (const char*)g.Bt + (size_t)cur.pn * tstep;
    S.a_ready(cur);
    if constexpr (SP2) {
        PG8_STAGE(PG8_SB(0, 0), cB, voffB); PG8_STAGE(PG8_SB(0, 1), cB + hstep, voffB); PG8_STAGE(PG8_SA(0, 0), cA, voffA); PG8_STAGE(PG8_SA(0, 1), cA + hstep, voffA);
        if (wr == 1) PG8_BAR;
        PG8_WAIT_V(2); PG8_BAR;
        PG8_STAGE(PG8_SB(1, 0), cB + kstep, voffB); PG8_STAGE(PG8_SA(1, 0), cA + kstep, voffA); PG8_STAGE(PG8_SB(1, 1), cB + hstep + kstep, voffB);
        PG8_WAIT_V(6); PG8_BAR;
    } else {
        PG8_STAGE(PG8_SB(0, 0), cB, voffB); PG8_STAGE(PG8_SA(0, 0), cA, voffA); PG8_STAGE(PG8_SB(0, 1), cB + hstep, voffB); PG8_STAGE(PG8_SA(0, 1), cA + hstep, voffA);
        if (wr == 1) PG8_BAR;
        PG8_WAIT_V(4); PG8_BAR;
        PG8_STAGE(PG8_SB(1, 0), cB + kstep, voffB); PG8_STAGE(PG8_SA(1, 0), cA + kstep, voffA); PG8_STAGE(PG8_SB(1, 1), cB + hstep + kstep, voffB);
        PG8_WAIT_V(6); PG8_BAR;
    }
    for (;;) {
        const bool has_next = S.next(ui + 1, nxt);
        const char* nA = has_next ? (const char*)g.A + (size_t)nxt.pm * tstep : cA; const char* nB = has_next ? (const char*)g.Bt + (size_t)nxt.pn * tstep : cB;
        for (int t = 0; t < nt; t += 2) {
            const bool last = (t == nt - 2);
            const char* a1 = cA + (size_t)(t + 1) * kstep;
            const char* a2 = last ? nA : cA + (size_t)(t + 2) * kstep; const char* b2 = last ? nB : cB + (size_t)(t + 2) * kstep;
            const char* a3 = a2 + kstep; const char* b3 = b2 + kstep;
            if (last && has_next) S.a_ready(nxt);
            if constexpr (SP2) {
            PG8_LDB(B0, 0, 0); PG8_LDB(B1, 0, 1); PG8_SCHED; PG8_LDA(At, 0, 0); PG8_STAGE(PG8_SA(1, 1), a1 + hstep, voffA);
            PG8_WAIT_V(8); PG8_WAIT_L(0); PG8_BAR; PG8_MMA(0, 0, At, B0); PG8_MMA(0, 1, At, B1); PG8_BAR; PG8_SCHED;
            PG8_LDA(At, 0, 1); PG8_STAGE(PG8_SB(0, 0), b2, voffB); PG8_STAGE(PG8_SB(0, 1), b2 + hstep, voffB); PG8_STAGE(PG8_SA(0, 0), a2, voffA);
            PG8_WAIT_V(8); PG8_WAIT_L(0); PG8_BAR; PG8_MMA(1, 0, At, B0); PG8_MMA(1, 1, At, B1); PG8_BAR; PG8_SCHED;
            PG8_LDB(B0, 1, 0); PG8_LDB(B1, 1, 1); PG8_SCHED; PG8_LDA(At, 1, 0); PG8_STAGE(PG8_SA(0, 1), a2 + hstep, voffA);
            PG8_WAIT_V(8); PG8_WAIT_L(0); PG8_BAR; PG8_MMA(0, 0, At, B0); PG8_MMA(0, 1, At, B1); PG8_BAR; PG8_SCHED;
            PG8_LDA(At, 1, 1); PG8_STAGE(PG8_SB(1, 0), b3, voffB); PG8_STAGE(PG8_SB(1, 1), b3 + hstep, voffB); PG8_STAGE(PG8_SA(1, 0), a3, voffA);
            PG8_WAIT_V(8); PG8_WAIT_L(0); PG8_BAR; PG8_MMA(1, 0, At, B0); PG8_MMA(1, 1, At, B1); PG8_BAR; PG8_SCHED;
            } else {
            PG8_LDB(B0, 0, 0); PG8_SCHED; PG8_LDA(At, 0, 0); PG8_STAGE(PG8_SA(1, 1), a1 + hstep, voffA);
            PG8_WAIT_L(8); PG8_BAR; PG8_WAIT_L(0); PG8_MMA(0, 0, At, B0); PG8_BAR; PG8_SCHED;
            PG8_LDB(B1, 0, 1); PG8_STAGE(PG8_SB(0, 0), b2, voffB);
            PG8_BAR; PG8_WAIT_L(0); PG8_MMA(0, 1, At, B1); PG8_BAR;
            PG8_LDA(At, 0, 1); PG8_STAGE(PG8_SA(0, 0), a2, voffA);
            PG8_BAR; PG8_WAIT_L(0); PG8_MMA(1, 0, At, B0); PG8_BAR; PG8_SCHED;
            PG8_STAGE(PG8_SB(0, 1), b2 + hstep, voffB);
            PG8_WAIT_V(6); PG8_BAR; PG8_MMA(1, 1, At, B1); PG8_BAR;
            PG8_LDB(B0, 1, 0); PG8_SCHED; PG8_LDA(At, 1, 0); PG8_STAGE(PG8_SA(0, 1), a2 + hstep, voffA);
            PG8_WAIT_L(8); PG8_BAR; PG8_WAIT_L(0); PG8_MMA(0, 0, At, B0); PG8_BAR; PG8_SCHED;
            PG8_LDB(B1, 1, 1); PG8_STAGE(PG8_SB(1, 0), b3, voffB);
            PG8_BAR; PG8_WAIT_L(0); PG8_MMA(0, 1, At, B1); PG8_BAR;
            PG8_LDA(At, 1, 1); PG8_STAGE(PG8_SA(1, 0), a3, voffA);
            PG8_BAR; PG8_WAIT_L(0); PG8_MMA(1, 0, At, B0); PG8_BAR; PG8_SCHED;
            PG8_STAGE(PG8_SB(1, 1), b3 + hstep, voffB);
            PG8_WAIT_V(6); PG8_BAR; PG8_MMA(1, 1, At, B1); PG8_BAR;
            }
        }
        if constexpr (ALIGN_EPI) { if (wr == 0) PG8_BAR; }
        if constexpr (!Epi::AFTER_DRAIN) { E(acc, cur, wr, wc, fr, fq); S.done(cur); }
        if (!has_next) break;
#pragma unroll
        for (int a = 0; a < 2; ++a)
#pragma unroll
            for (int b = 0; b < 2; ++b)
#pragma unroll
                for (int m = 0; m < 4; ++m)
#pragma unroll
                    for (int n = 0; n < 2; ++n) acc[a][b][m][n] = (f32x4){0.f, 0.f, 0.f, 0.f};
        cur = nxt; cA = nA; cB = nB; ++ui;
        if constexpr (ALIGN_EPI) { if (wr == 1) PG8_BAR; }
    }
    PG8_WAIT_V(0);
    if constexpr (!ALIGN_EPI) { if (wr == 0) PG8_BAR; }
    PG8_BAR;
    if constexpr (Epi::AFTER_DRAIN) { E.fused(acc, cur, wr, wc, fr, fq, lds, wid, lane); S.done(cur); }
#undef PG8_SA
#undef PG8_SB
#undef PG8_STAGE
#undef PG8_LDA
#undef PG8_LDB
#undef PG8_MMA
#undef PG8_WAIT_V
#undef PG8_WAIT_L
#undef PG8_BAR
#undef PG8_SCHED
}
}
#include <hip/hip_bf16.h>
#include <cmath>
namespace attn_body {
using bf16=__hip_bfloat16;
using bf16x8=__attribute__((ext_vector_type(8)))short;
using s16x4=__attribute__((ext_vector_type(4)))short;
using f32x16=__attribute__((ext_vector_type(16)))float;
using u32x4=__attribute__((ext_vector_type(4)))unsigned;
constexpr int BATCH=8,NHEAD=6,SEQ=4096,D=64,KVP=3072,OP=1024;
constexpr int NW=8,QBLK=32,QB=QBLK*NW,KVBLK=64,NQB=SEQ/QB;
constexpr int ATTN_UNIT_ROWS=QB;
__device__ __forceinline__ int crow(int r,int hi){return (r&3)+8*(r>>2)+4*hi;}
#define SBAR() __builtin_amdgcn_sched_barrier(0)
__device__ __forceinline__ void cmask(f32x16&p0,f32x16&p1,int jb,int qrel,int hi){
  const float NEG=-INFINITY; int kb=64*jb+4*hi;
  #pragma unroll
  for(int r=0;r<16;++r){int kv=kb+(r&3)+8*(r>>2); if(kv>qrel)p0[r]=NEG; if(kv+32>qrel)p1[r]=NEG;}
}

constexpr int NSLOT=3, SLOTB=8192;
constexpr int LDS_K=0, LDS_V=NSLOT*SLOTB, LDS_WS=2*NSLOT*SLOTB, LDS_OST=LDS_WS+NW*64*4, LDS_CK=LDS_OST+NW*4096, LDS_BYTES=LDS_CK+SEQ*4;
constexpr float C2=0.125f*1.4426950408889634f;
__device__ __forceinline__ void glds16(const void*gsrc,unsigned lds_dst){unsigned keep;
  asm volatile("s_mov_b32 %0, m0\n\ts_mov_b32 m0, %2\n\ts_nop 0\n\tglobal_load_lds_dwordx4 %1, off\n\ts_mov_b32 m0, %0":"=&s"(keep):"v"(gsrc),"s"(lds_dst):"memory");}
__device__ __forceinline__ float max3f(float a,float b,float c){float r;asm("v_max3_f32 %0, %1, %2, %3":"=v"(r):"v"(a),"v"(b),"v"(c));return r;}
__device__ __forceinline__ float max2f(float a,float b){float r;asm("v_max_f32_e32 %0, %1, %2":"=v"(r):"v"(a),"v"(b));return r;}
__device__ __forceinline__ float fadd_s(float a,float b){float r;asm("v_add_f32_e32 %0, %1, %2":"=v"(r):"v"(a),"v"(b));return r;}
__device__ __forceinline__ float fsub_s(float a,float b){float r;asm("v_sub_f32_e32 %0, %1, %2":"=v"(r):"v"(a),"v"(b));return r;}
typedef float f32x2_t __attribute__((ext_vector_type(2))); typedef float f32x4_t __attribute__((ext_vector_type(4))); typedef __bf16 bf16x2_t __attribute__((ext_vector_type(2)));
__device__ __forceinline__ unsigned cvtpk_s(float lo,float hi){f32x2_t v={lo,hi};bf16x2_t b=__builtin_convertvector(v,bf16x2_t);return __builtin_bit_cast(unsigned,b);}
#define WAIT_BAR(N) asm volatile("s_waitcnt vmcnt(" #N ") lgkmcnt(0)\n\ts_barrier":::"memory")

__device__ __forceinline__ void qkt(f32x16&p0,f32x16&p1,const char*Kslot,const bf16x8*qr,int r32,int hi){
  const char*kb=Kslot+hi*1024+r32*16;
  #pragma unroll
  for(int d0=0;d0<4;++d0){
    const bf16x8 b0=*reinterpret_cast<const bf16x8*>(kb+d0*2048);
    const bf16x8 b1=*reinterpret_cast<const bf16x8*>(kb+d0*2048+512);
    {p0=__builtin_amdgcn_mfma_f32_32x32x16_bf16(b0,qr[d0],p0,0,0,0);p1=__builtin_amdgcn_mfma_f32_32x32x16_bf16(b1,qr[d0],p1,0,0,0);}}
}
typedef __attribute__((address_space(3))) const char* lds_cptr;
typedef short v4i16_t __attribute__((ext_vector_type(4)));
__device__ __forceinline__ void kload8(bf16x8*kf,lds_cptr kp){
  kf[0]=*(const __attribute__((address_space(3))) bf16x8*)(kp);      kf[1]=*(const __attribute__((address_space(3))) bf16x8*)(kp+512);
  kf[2]=*(const __attribute__((address_space(3))) bf16x8*)(kp+2048); kf[3]=*(const __attribute__((address_space(3))) bf16x8*)(kp+2560);
  kf[4]=*(const __attribute__((address_space(3))) bf16x8*)(kp+4096); kf[5]=*(const __attribute__((address_space(3))) bf16x8*)(kp+4608);
  kf[6]=*(const __attribute__((address_space(3))) bf16x8*)(kp+6144); kf[7]=*(const __attribute__((address_space(3))) bf16x8*)(kp+6656);
}
__device__ __forceinline__ void kload2(bf16x8*kf,lds_cptr kp,int j){ kf[2*j]=*(const __attribute__((address_space(3))) bf16x8*)(kp+j*2048); kf[2*j+1]=*(const __attribute__((address_space(3))) bf16x8*)(kp+j*2048+512); }
__device__ __forceinline__ s16x4 vtr(lds_cptr p){ return __builtin_bit_cast(s16x4,__builtin_amdgcn_ds_read_tr16_b64_v4i16((__attribute__((address_space(3))) v4i16_t*)p)); }
__device__ __forceinline__ float rowmax(const f32x16&p0,const f32x16&p1){
  float a=max3f(p0[0],p0[1],p1[0]),b=max3f(p0[2],p0[3],p1[1]);a=max3f(a,p1[2],p1[3]);
  #pragma unroll
  for(int r=4;r<16;r+=4){a=max3f(a,p0[r],p0[r+1]);b=max3f(b,p0[r+2],p0[r+3]);a=max3f(a,p1[r],p1[r+1]);b=max3f(b,p1[r+2],p1[r+3]);}
  const float m=max2f(a,b);
  auto rr=__builtin_amdgcn_permlane32_swap(__float_as_uint(m),__float_as_uint(m),false,false);
  return max2f(__uint_as_float(rr[0]),__uint_as_float(rr[1]));
}
__device__ __forceinline__ void pv(f32x16*o,int vb,bf16x8 pa0,bf16x8 pa1,bf16x8 pa2,bf16x8 pa3){
  #pragma unroll
  for(int d0=0;d0<2;++d0){s16x4 lo[4],hi[4];
    #pragma unroll
    for(int ks=0;ks<4;++ks){
      asm volatile("ds_read_b64_tr_b16 %0,%1 offset:%c2":"=&v"(lo[ks]):"v"(vb),"i"(d0*4096+ks*1024):"memory");
      asm volatile("ds_read_b64_tr_b16 %0,%1 offset:%c2":"=&v"(hi[ks]):"v"(vb),"i"(d0*4096+ks*1024+512):"memory");}
    asm volatile("s_waitcnt lgkmcnt(0)":::"memory");SBAR();
    #define PK(k) (bf16x8){lo[k][0],lo[k][1],lo[k][2],lo[k][3],hi[k][0],hi[k][1],hi[k][2],hi[k][3]}
    o[d0]=__builtin_amdgcn_mfma_f32_32x32x16_bf16(pa0,PK(0),o[d0],0,0,0);
    o[d0]=__builtin_amdgcn_mfma_f32_32x32x16_bf16(pa1,PK(1),o[d0],0,0,0);
    o[d0]=__builtin_amdgcn_mfma_f32_32x32x16_bf16(pa2,PK(2),o[d0],0,0,0);
    o[d0]=__builtin_amdgcn_mfma_f32_32x32x16_bf16(pa3,PK(3),o[d0],0,0,0);
    #undef PK
  }
}

#ifndef ATTN_STORE16
#define ATTN_STORE16(p,v) (*(u32x4*)(p)=(v))
#endif
template<int THRL> __device__ __forceinline__ void attn_unit(int b,int h,int qb,const bf16*Q,const bf16*__restrict__ K,const bf16*__restrict__ V,bf16*O,const float*__restrict__ CKg,const float*__restrict__ KTm,const float*__restrict__ QBm,char*shm){
  const int tid=tid_l(),lane=tid&63,r32=lane&31,hi=lane>>5; const int wid=__builtin_amdgcn_readfirstlane(tid>>6);
  const long rowbase=(long)b*SEQ; const int q0=qb*QB;
  const bf16*Qw=Q+(rowbase+q0+wid*QBLK)*KVP+h*D;
  const float*ckg=CKg+(long)(b*NHEAD+h)*SEQ;
  int j0=0;
  { const int bh_=b*NHEAD+h, NT0_=(q0+QB)/KVBLK; const float qmx=QBm[bh_*NQB+qb]*1.01f;
    const float kd=fmaxf(fmaxf(KTm[bh_*64+4*qb],KTm[bh_*64+4*qb+1]),fmaxf(KTm[bh_*64+4*qb+2],KTm[bh_*64+4*qb+3]));
    const float thr=-(qmx*kd)-48.f; bool skip=false;
    if(lane<NT0_-4){ const float bound=qmx*KTm[bh_*64+lane]+(ckg[q0]-ckg[64*lane+63]); skip=bound<thr; }
    const unsigned long long m_=__ballot(skip); j0=__builtin_ctzll(~m_); j0=(j0<NT0_-4?j0:NT0_-4)&~1; j0=__builtin_amdgcn_readfirstlane(j0); }
  const bf16*Kh=K+(rowbase+(long)j0*KVBLK)*KVP+h*D,*Vh=V+(rowbase+(long)j0*KVBLK)*KVP+h*D;
  const unsigned lds0=(unsigned)(uintptr_t)shm;
  float*wsf=(float*)(shm+LDS_WS)+wid*64;
  const bf16*ksrc=Kh+(long)lane*KVP+wid*8;
  const bf16*vsrc=Vh+(long)(16*(wid&3)+(lane>>2))*KVP+(wid>>2)*32+(lane&3)*8;
  const unsigned kdst=lds0+LDS_K+wid*1024, vdst=lds0+LDS_V+wid*1024;
  #define DMA_K(t,slot) glds16(ksrc+(long)(t)*KVBLK*KVP,(unsigned)__builtin_amdgcn_readfirstlane(kdst+(slot)))
  #define DMA_V(t,slot) glds16(vsrc+(long)(t)*KVBLK*KVP,(unsigned)__builtin_amdgcn_readfirstlane(vdst+(slot)))
  const int vb0=(int)(lds0+LDS_V)+((lane>>4)&1)*32+(lane&3)*8+(4*hi+((lane&15)>>2))*64;
  const char*Kbase=shm+LDS_K; bf16x8 kf[8];
  const lds_cptr shm3=(lds_cptr)shm; const lds_cptr kp0=shm3+LDS_K+hi*1024+r32*16; const lds_cptr vp0=shm3+LDS_V+((lane>>4)&1)*32+(lane&3)*8+(4*hi+((lane&15)>>2))*64;
  const int NT=(q0+QB)/KVBLK-j0;
  float*cks=(float*)(shm+LDS_CK);
  for(int i=j0*KVBLK+tid*4;i<q0+QB;i+=NW*64*4){ *(f32x4_t*)(cks+i)=*(const f32x4_t*)(ckg+i); }
  float cqm=ckg[q0+wid*QBLK+r32];
  const lds_cptr ckp=(lds_cptr)shm+LDS_CK+j0*256+hi*16;
  DMA_K(0,0);DMA_V(0,0);DMA_K(1,SLOTB);
  bf16x8 qr[4];
  #pragma unroll
  for(int d0=0;d0<4;++d0)qr[d0]=*reinterpret_cast<const bf16x8*>(&Qw[(long)r32*KVP+d0*16+hi*8]);
  float l_reg=0.f;f32x16 o[2];o[0]=f32x16{};o[1]=f32x16{};
  #define CINIT(C0,C1,t) do{ const lds_cptr cp_=ckp+(t)*256; \
    _Pragma("unroll") for(int g_=0;g_<4;++g_){ const f32x4_t a_=*(const __attribute__((address_space(3))) f32x4_t*)(cp_+g_*32); const f32x4_t b_=*(const __attribute__((address_space(3))) f32x4_t*)(cp_+g_*32+128); \
      _Pragma("unroll") for(int i_=0;i_<4;++i_){ C0[g_*4+i_]=cqm-a_[i_]; C1[g_*4+i_]=cqm-b_[i_]; } } }while(0)
  const int qrel=wid*QBLK+r32;
  #define CMASK(P0,P1,t) do{int jb_=(t)-(NT-4); if(jb_>=0)cmask(P0,P1,jb_,qrel,hi);}while(0)
  bool resc=false;
  #define START(P0,P1) do{ const float rm=rowmax(P0,P1); resc=false; \
    { const float dl=rm; \
      _Pragma("unroll") for(int r=0;r<16;++r){P0[r]=fsub_s(P0[r],dl);P1[r]=fsub_s(P1[r],dl);} \
      cqm=fsub_s(cqm,dl); } \
    _Pragma("unroll") for(int r=0;r<16;++r)P0[r]=__builtin_amdgcn_exp2f(P0[r]); }while(0)
  #define RESC() do{ if(resc){ asm volatile("s_waitcnt lgkmcnt(0)":::"memory"); \
      _Pragma("unroll") for(int d_=0;d_<2;++d_) _Pragma("unroll") for(int r=0;r<16;++r)o[d_][r]*=wsf[crow(r,hi)]; } }while(0)
  f32x16 pA0,pA1,pB0,pB1;
  int sl_prev=0,sl_cur=0,sl_next=SLOTB;
  #define ROT() do{sl_prev=sl_cur;sl_cur=sl_next;sl_next=(sl_next==(NSLOT-1)*SLOTB)?0:sl_next+SLOTB;}while(0)
  DMA_K(2,2*SLOTB);
  WAIT_BAR(3);
  CINIT(pA0,pA1,0);
  qkt(pA0,pA1,Kbase,qr,r32,hi);asm volatile("s_nop 15\n\ts_nop 7":"+v"(pA0),"+v"(pA1));CMASK(pA0,pA1,0);
  START(pA0,pA1);
  _Pragma("unroll") for(int r=0;r<16;++r)pA1[r]=__builtin_amdgcn_exp2f(pA1[r]);
  WAIT_BAR(0);
  DMA_K(3,0);DMA_V(1,SLOTB);
  ROT();
  kload8(kf,kp0+sl_cur);
  WAIT_BAR(2);
  s16x4 vlo[8],vhi[8]; u32x4 pw0,pw1,pw2,pw3;
  #define PKW(P,B) cvtpk_s(P[B],P[B+1])
  #define PAF(k) __builtin_bit_cast(bf16x8,pw##k)
  #define VFR(i) (bf16x8){vlo[i][0],vlo[i][1],vlo[i][2],vlo[i][3],vhi[i][0],vhi[i][1],vhi[i][2],vhi[i][3]}
  #define PIN(x) asm volatile("":"+v"(x))
  #define MX3(a,b,c) __builtin_fmaxf(__builtin_fmaxf((a),(b)),(c))
  #define GAPA(MF,A0,A1,A2,A3,W0,W1,PW) do{ MF; sacc+=A0; sacc+=A1; sacc+=A2; sacc+=A3; PIN(sacc); W0; W1; PIN(PW); SBAR(); }while(0)
  #define EX(v) __builtin_amdgcn_exp2f(v)
  #define GAPB(MF,X,B) do{ MF; X[B]=EX(X[B]); X[B+1]=EX(X[B+1]); X[B+2]=EX(X[B+2]); X[B+3]=EX(X[B+3]); PIN(X); SBAR(); }while(0)
  #define VRD(i) do{ vlo[i]=vtr(vp_+(((i)>>2)*4096+((i)&3)*1024)); vhi[i]=vtr(vp_+(((i)>>2)*4096+((i)&3)*1024+512)); }while(0)
  #define KRD(G,j) do{ if(G){ kload2(kf,kp0+sl_next,j); SBAR(); } }while(0)
  #define STEP(C0,C1,P0,P1,t,GK,GV,GL) do{ SBAR(); \
    CINIT(C0,C1,t); SBAR(); \
    const lds_cptr vp_=vp0+sl_prev; \
    VRD(0); SBAR(); float sacc=(P0[0]+P0[1]); \
    GAPA(C0=__builtin_amdgcn_mfma_f32_32x32x16_bf16(kf[0],qr[0],C0,0,0,0), P0[2],P0[3],P0[4],P0[5],     pw0[0]=PKW(P0,0), pw0[1]=PKW(P0,2), pw0); \
    VRD(4); SBAR(); GAPA(C1=__builtin_amdgcn_mfma_f32_32x32x16_bf16(kf[1],qr[0],C1,0,0,0), P0[6],P0[7],P0[8],P0[9],     pw0[2]=PKW(P0,4), pw0[3]=PKW(P0,6), pw0); \
    VRD(1); SBAR(); GAPA(C0=__builtin_amdgcn_mfma_f32_32x32x16_bf16(kf[2],qr[1],C0,0,0,0),   P0[10],P0[11],P0[12],P0[13], pw1[0]=PKW(P0,8), pw1[1]=PKW(P0,10), pw1); \
    VRD(5); SBAR(); GAPA(C1=__builtin_amdgcn_mfma_f32_32x32x16_bf16(kf[3],qr[1],C1,0,0,0),   P0[14],P0[15],P1[0],P1[1],   pw1[2]=PKW(P0,12),pw1[3]=PKW(P0,14), pw1); \
    VRD(2); SBAR(); GAPA(C0=__builtin_amdgcn_mfma_f32_32x32x16_bf16(kf[4],qr[2],C0,0,0,0),   P1[2],P1[3],P1[4],P1[5],     pw2[0]=PKW(P1,0), pw2[1]=PKW(P1,2), pw2); \
    VRD(6); SBAR(); GAPA(C1=__builtin_amdgcn_mfma_f32_32x32x16_bf16(kf[5],qr[2],C1,0,0,0),   P1[6],P1[7],P1[8],P1[9],     pw2[2]=PKW(P1,4), pw2[3]=PKW(P1,6), pw2); \
    VRD(3); SBAR(); GAPA(C0=__builtin_amdgcn_mfma_f32_32x32x16_bf16(kf[6],qr[3],C0,0,0,0),   P1[10],P1[11],P1[12],P1[13], pw3[0]=PKW(P1,8), pw3[1]=PKW(P1,10), pw3); \
    VRD(7); SBAR(); GAPA(C1=__builtin_amdgcn_mfma_f32_32x32x16_bf16(kf[7],qr[3],C1,0,0,0),   P1[14],P1[15],0.f,0.f,       pw3[2]=PKW(P1,12),pw3[3]=PKW(P1,14), pw3); \
    l_reg+=sacc; \
    if(GK){DMA_K((t)+3,sl_cur);} if(GV){DMA_V((t)+1,sl_next);} \
    CMASK(C0,C1,t); \
    { float a=MX3(C0[0],C0[1],C1[0]),b=MX3(C0[2],C0[3],C1[1]); a=MX3(a,C1[2],C1[3]); \
      _Pragma("unroll") for(int r=4;r<16;r+=4){a=MX3(a,C0[r],C0[r+1]);b=MX3(b,C0[r+2],C0[r+3]);a=MX3(a,C1[r],C1[r+1]);b=MX3(b,C1[r+2],C1[r+3]);} \
      float rm=__builtin_fmaxf(a,b); { auto rr=__builtin_amdgcn_permlane32_swap(__float_as_uint(rm),__float_as_uint(rm),false,false); rm=__builtin_fmaxf(__uint_as_float(rr[0]),__uint_as_float(rr[1])); } \
      resc=false; \
      if(__builtin_expect(__any(rm>(float)THRL),0)){ const float dl=__builtin_fmaxf(rm,0.f); \
        _Pragma("unroll") for(int r=0;r<16;++r){C0[r]-=dl;C1[r]-=dl;} \
        cqm-=dl; \
        const float f=__builtin_amdgcn_exp2f(-dl); l_reg*=f; if(hi==0)wsf[r32]=f; resc=true; } } \
    SBAR(); \
    GAPB(o[0]=__builtin_amdgcn_mfma_f32_32x32x16_bf16(PAF(0),VFR(0),o[0],0,0,0), C0,0); \
    GAPB(o[1]=__builtin_amdgcn_mfma_f32_32x32x16_bf16(PAF(0),VFR(4),o[1],0,0,0), C0,4); \
    KRD(GL,0); GAPB(o[0]=__builtin_amdgcn_mfma_f32_32x32x16_bf16(PAF(1),VFR(1),o[0],0,0,0), C0,8); \
    KRD(GL,1); GAPB(o[1]=__builtin_amdgcn_mfma_f32_32x32x16_bf16(PAF(1),VFR(5),o[1],0,0,0), C0,12); \
    KRD(GL,2); GAPB(o[0]=__builtin_amdgcn_mfma_f32_32x32x16_bf16(PAF(2),VFR(2),o[0],0,0,0), C1,0); \
    KRD(GL,3); GAPB(o[1]=__builtin_amdgcn_mfma_f32_32x32x16_bf16(PAF(2),VFR(6),o[1],0,0,0), C1,4); \
    GAPB(o[0]=__builtin_amdgcn_mfma_f32_32x32x16_bf16(PAF(3),VFR(3),o[0],0,0,0), C1,8); \
    GAPB(o[1]=__builtin_amdgcn_mfma_f32_32x32x16_bf16(PAF(3),VFR(7),o[1],0,0,0), C1,12); \
    }while(0)
  int t=1;
  #undef CMASK
  #define CMASK(P0,P1,t) do{}while(0)
  for(;t+5<NT;t+=2){
    STEP(pB0,pB1,pA0,pA1,t,true,true,true);     WAIT_BAR(2); RESC(); ROT();
    STEP(pA0,pA1,pB0,pB1,t+1,true,true,true);   WAIT_BAR(2); RESC(); ROT();
  }
  #undef CMASK
  #define CMASK(P0,P1,t) do{int jb_=(t)-(NT-4); if(jb_>=0)cmask(P0,P1,jb_,qrel,hi);}while(0)
  #define ENDW(tt) do{ if((tt)+3<NT){WAIT_BAR(2);} else if((tt)+2<NT){WAIT_BAR(1);} else {WAIT_BAR(0);} }while(0)
  for(;t+1<NT;t+=2){
    STEP(pB0,pB1,pA0,pA1,t,(t+3<NT),(t+1<NT),(t+1<NT));       ENDW(t);   RESC(); ROT();
    STEP(pA0,pA1,pB0,pB1,t+1,(t+4<NT),(t+2<NT),(t+2<NT));     ENDW(t+1); RESC(); ROT();
  }
  STEP(pB0,pB1,pA0,pA1,NT-1,false,false,false); RESC();
  { float sacc=pB0[0]+pB0[1]; _Pragma("unroll") for(int r=2;r<16;++r)sacc+=pB0[r]; _Pragma("unroll") for(int r=0;r<16;++r)sacc+=pB1[r]; l_reg+=sacc;
    pw0=(u32x4){PKW(pB0,0),PKW(pB0,2),PKW(pB0,4),PKW(pB0,6)};pw1=(u32x4){PKW(pB0,8),PKW(pB0,10),PKW(pB0,12),PKW(pB0,14)};pw2=(u32x4){PKW(pB1,0),PKW(pB1,2),PKW(pB1,4),PKW(pB1,6)};pw3=(u32x4){PKW(pB1,8),PKW(pB1,10),PKW(pB1,12),PKW(pB1,14)};
    SBAR(); pv(o,vb0+sl_cur,PAF(0),PAF(1),PAF(2),PAF(3)); }
  #undef PKW
  #undef PAF
  #undef VFR
  #undef PIN
  #undef MX3
  #undef GAPA
  #undef GAPB
  #undef EX
  #undef VRD
  #undef KRD
  #undef STEP
  #undef ENDW
  {auto rr=__builtin_amdgcn_permlane32_swap(__float_as_uint(l_reg),__float_as_uint(l_reg),false,false);l_reg=__uint_as_float(rr[0])+__uint_as_float(rr[1]);}
  if(hi==0)wsf[32+r32]=l_reg;asm volatile("s_waitcnt lgkmcnt(0)":::"memory");
  float rli[16];
  #pragma unroll
  for(int r=0;r<16;++r)rli[r]=__builtin_amdgcn_rcpf(wsf[32+crow(r,hi)]);
  bf16*Ow=O+(rowbase+q0+wid*QBLK)*OP+h*D;
  { bf16*stg=(bf16*)(shm+LDS_OST)+wid*2048;
    #pragma unroll
    for(int r=0;r<16;++r){const int orow=crow(r,hi);
      #pragma unroll
      for(int d0=0;d0<2;++d0)stg[orow*64+d0*32+r32]=__float2bfloat16(o[d0][r]*rli[r]);}
    asm volatile("s_waitcnt lgkmcnt(0)":::"memory");
    #pragma unroll
    for(int i=0;i<4;++i){const int row=i*8+(lane>>3),ch=lane&7; const u32x4 v=*(const u32x4*)(stg+row*64+ch*8); ATTN_STORE16(Ow+(long)row*OP+ch*8,v);} }
  asm volatile("s_waitcnt lgkmcnt(0)\n\ts_barrier":::"memory");
  #undef DMA_K
  #undef DMA_V
  #undef CMASK
  #undef START
  #undef RESC
  #undef ROT
  #undef CINIT
}
constexpr int ATTN_LDS_BYTES=LDS_BYTES;
struct AttnTensors { const bf16* Q; const bf16* K; const bf16* V; bf16* O; const float* CK; const float* KT; const float* QB; };
struct AttnUnit { int bh; int qb; };
struct QueueOrder {
  unsigned* head; volatile __attribute__((address_space(3))) int* slot;
  __device__ __forceinline__ bool next(int,AttnUnit&u)const{
    if(tid_l()==0) *slot=(int)__hip_atomic_fetch_add(head,1u,__ATOMIC_RELAXED,__HIP_MEMORY_SCOPE_AGENT);
    __syncthreads(); const int v=*slot; __syncthreads();
    if(v>=BATCH*NHEAD*NQB)return false; u.qb=NQB-1-v/(BATCH*NHEAD); u.bh=v%(BATCH*NHEAD); return true; }
  __device__ __forceinline__ void a_ready(const AttnUnit&)const{}
  __device__ __forceinline__ void done(const AttnUnit&)const{}
};
template<class Sched,int THRL=8> __device__ __forceinline__ void attn_phase(char*lds,const AttnTensors&T,const Sched&S){
  AttnUnit u;
  for(int i=0;S.next(i,u);++i){ S.a_ready(u); attn_unit<THRL>(u.bh/NHEAD,u.bh%NHEAD,u.qb,T.Q,T.K,T.V,T.O,T.CK,T.KT,T.QB,lds); S.done(u); }
}
#undef SBAR
#undef WAIT_BAR
}

constexpr int NB = 8, SEQ = 4096, T = NB * SEQ, D = 1024, DEPTH = 4;
constexpr int HCOLS = 3072;
constexpr int HC_AVAL = 0, HC_AGATE = 256, HC_BQ = 512, HC_BK = 704, HC_BV = 896, HC_BG = 1280, HC_CQ = 1664, HC_CK = 2048, HC_CV = 2432, HC_LR = 2816, HC_CF = 2832;
constexpr int IN_COLS = 2838;
constexpr int MC_A = 0, MC_B = 256, MC_C = 640;
constexpr float LN_EPS = 1e-5f;
constexpr float ALPHA = 1.6817928305074292f;
constexpr float LOG2E = 1.4426950408889634f;
constexpr float C2 = 0.125f * LOG2E;
constexpr float GLA_QSCALE = 0.17677669529663687f;
constexpr int NEXP = 16384;

constexpr size_t MiB = 1u << 20;
constexpr size_t WS_CTL = 0, CTL_ZERO_BYTES = 1 * MiB;
constexpr size_t WS_WIN = 1 * MiB;
constexpr size_t WS_WOUT = WS_WIN + 24 * MiB;
constexpr size_t WS_WP = WS_WOUT + 8 * MiB;
constexpr size_t WS_PGW = WS_WP + 16 * MiB;
constexpr size_t WS_PW = WS_PGW + 8 * MiB;
constexpr size_t WS_CK = WS_PW + 2 * MiB;
constexpr size_t WS_FKT = WS_CK + 768 * 1024, WS_FQB = WS_FKT + 16 * 1024;
constexpr size_t WS_U = WS_CK + 1 * MiB;
constexpr size_t WS_V = WS_U + 32 * MiB;
constexpr size_t WS_XB = WS_V + 32 * MiB;
constexpr size_t WS_XF = WS_XB + 64 * MiB;
constexpr size_t WS_XQ = WS_XF, WS_XS = WS_XF + 32 * MiB, WS_RS = WS_XS + 1 * MiB, WS_VS = WS_RS + 65536;
constexpr size_t WS_PB = WS_XF + 128 * MiB;
constexpr size_t WS_H = WS_PB + 16 * MiB;
constexpr size_t WS_MIX = WS_H + 192 * MiB;
constexpr size_t WS_SC = WS_H;
constexpr size_t WS_Y = WS_MIX + 64 * MiB;
constexpr size_t WS_GCUM = WS_Y;
constexpr size_t WS_GS = WS_GCUM + 24 * MiB;
constexpr size_t WS_GDEC = WS_GS + 24 * MiB;
constexpr size_t WS_E = WS_Y + 128 * MiB;
constexpr size_t WS_EIDX = WS_E + 64 * MiB;
constexpr size_t WS_GATE = WS_EIDX + 16 * MiB;
constexpr size_t WS_END = WS_GATE + 16 * MiB;
static_assert(WS_END <= 1024 * MiB, "d_ws map");

constexpr int LDS_BYTES = 147456;

typedef unsigned short bf16;
typedef float f32x4 __attribute__((ext_vector_type(4)));
typedef unsigned u32x4 __attribute__((ext_vector_type(4)));
typedef unsigned u32x2 __attribute__((ext_vector_type(2)));

struct Params {
    const float *x, *p, *w_in, *conv_w, *conv_b, *conv_ln_g, *conv_ln_b, *gla_gate_w, *gla_gate_b, *gla_norm_g, *fox_forget_b, *w_out, *ln1_g, *ln1_b,
        *peer_wq, *peer_keys, *peer_u, *peer_v, *ple_w, *ple_gw, *ple_gb, *ln2_g, *ln2_b;
    float* out; unsigned char* ws;
};

__device__ __forceinline__ float bf2f(unsigned h) { return __uint_as_float(h << 16); }
__device__ __forceinline__ unsigned f2bf(float f) { unsigned u = __float_as_uint(f); return (u + 0x7fffu + ((u >> 16) & 1u)) >> 16; }
__device__ __forceinline__ unsigned pk2(float lo, float hi) { return f2bf(lo) | (f2bf(hi) << 16); }
__device__ __forceinline__ float wave_sum(float v) {
#pragma unroll
    for (int o = 1; o < 64; o <<= 1) v += __shfl_xor(v, o);
    return v;
}
__device__ __forceinline__ float log_sigmoid(float z) { return fminf(z, 0.f) - log1pf(__expf(-fabsf(z))); }
__device__ __forceinline__ float sigmoidf_(float z) { return 1.0f / (1.0f + __expf(-z)); }

struct MapIdent { __device__ __forceinline__ void operator()(int n, int& c, float& s) const { c = n; s = 1.f; } };
struct MapWin {
    __device__ __forceinline__ void operator()(int n, int& c, float& s) const {
        s = 1.f;
        if (n < HC_CQ) { c = n; if (n >= HC_BQ && n < HC_BK) s = GLA_QSCALE; }
        else if (n < HC_LR) { c = n + 16; if (n < HC_CK) s = C2; }
        else if (n < HC_CF) c = n - HC_LR + 1664;
        else if (n < IN_COLS) c = n;
        else c = -1;
    }
};
template <class CM>
__device__ __forceinline__ void transpose_item(const float* W, int K, int Nsrc, bf16* WT, int item, int nblk, float* scr, int lane, const CM& cm) {
    const int kb = item / nblk, nb = item % nblk, k0 = 64 * kb, n0 = 32 * nb;
    int sc; float scale; cm(n0 + (lane & 31), sc, scale);
#pragma unroll
    for (int i = 0; i < 32; ++i) { const int kk = 2 * i + (lane >> 5); scr[kk * 33 + (lane & 31)] = sc >= 0 ? W[(size_t)(k0 + kk) * Nsrc + sc] * scale : 0.f; }
    __builtin_amdgcn_wave_barrier(); asm volatile("s_waitcnt lgkmcnt(0)" ::: "memory");
    const int c = lane & 7;
#pragma unroll
    for (int j = 0; j < 4; ++j) { const int n = (lane >> 3) + 8 * j; const float* s = scr + (8 * c) * 33 + n;
        u32x4 o; o.x = pk2(s[0 * 33], s[1 * 33]); o.y = pk2(s[2 * 33], s[3 * 33]); o.z = pk2(s[4 * 33], s[5 * 33]); o.w = pk2(s[6 * 33], s[7 * 33]);
        *(u32x4*)(WT + (size_t)(n0 + n) * K + k0 + 8 * c) = o; }
    asm volatile("s_waitcnt lgkmcnt(0)" ::: "memory"); __builtin_amdgcn_wave_barrier();
}
__device__ __forceinline__ void cvt_bf16_stream(const float* src, bf16* dst, size_t n8, size_t gtid, size_t gthreads) {
    for (size_t i = gtid; i < n8; i += gthreads) { const f32x4 a = *(const f32x4*)(src + i * 8), b = *(const f32x4*)(src + i * 8 + 4);
        u32x4 o; o.x = pk2(a[0], a[1]); o.y = pk2(a[2], a[3]); o.z = pk2(b[0], b[1]); o.w = pk2(b[2], b[3]); *(u32x4*)(dst + i * 8) = o; }
}

__device__ __forceinline__ void phase_pro_a(const Params& p, unsigned char* lds) {
    const int tid = tid_l(), lane = tid & 63, wave = tid >> 6;
    float* scr = (float*)(lds + wave * 16384);
    const int gw = bid_l() * 8 + wave, NGW = grid_l() * 8;
    constexpr int I_WIN = (D / 64) * (HCOLS / 32), I_SQ = (D / 64) * (D / 32), I_PW = (256 / 64) * (D / 32);
    constexpr int PER_L = I_WIN + 2 * I_SQ + I_PW;
    for (int it = gw; it < DEPTH * PER_L; it += NGW) {
        const int l = it / PER_L; int r = it % PER_L;
        if (r < I_WIN) { transpose_item(p.w_in + (size_t)l * D * IN_COLS, D, IN_COLS, (bf16*)(p.ws + WS_WIN) + (size_t)l * HCOLS * D, r, HCOLS / 32, scr, lane, MapWin()); continue; } r -= I_WIN;
        if (r < I_SQ) { transpose_item(p.w_out + (size_t)l * D * D, D, D, (bf16*)(p.ws + WS_WOUT) + (size_t)l * D * D, r, D / 32, scr, lane, MapIdent()); continue; } r -= I_SQ;
        if (r < I_SQ) { transpose_item(p.ple_gw + (size_t)l * D * D, D, D, (bf16*)(p.ws + WS_PGW) + (size_t)l * D * D, r, D / 32, scr, lane, MapIdent()); continue; } r -= I_SQ;
        transpose_item(p.ple_w + (size_t)l * 256 * D, 256, D, (bf16*)(p.ws + WS_PW) + (size_t)l * D * 256, r, D / 32, scr, lane, MapIdent());
    }
    cvt_bf16_stream(p.x, (bf16*)(p.ws + WS_XB), (size_t)T * D / 8, (size_t)bid_l() * 512 + tid, (size_t)grid_l() * 512);
}
__device__ __forceinline__ void phase_pro_b(const Params& p, unsigned char* lds) {
    const int tid = tid_l();
    constexpr int PB = 132;
    float* ks = (float*)lds;
    float* wqs = ks + 128 * PB;
    for (int it = bid_l(); it < DEPTH * 16 * 16; it += grid_l()) {
        const int l = it >> 8, hc = (it >> 4) & 15, kt = it & 15;
        const float* keys = p.peer_keys + ((size_t)l * 16 + hc) * 16384;
        const float* wq = p.peer_wq + (size_t)l * D * 2048 + (size_t)(kt * 64) * 2048 + hc * 128;
        __syncthreads();
        for (int i = tid; i < 128 * 32; i += 512) *(f32x4*)(ks + (i >> 5) * PB + (i & 31) * 4) = *(const f32x4*)(keys + (size_t)i * 4);
        for (int i = tid; i < 64 * 32; i += 512) *(f32x4*)(wqs + (i >> 5) * PB + (i & 31) * 4) = *(const f32x4*)(wq + (size_t)(i >> 5) * 2048 + (i & 31) * 4);
        __syncthreads();
        const int kq = tid & 15, nq = tid >> 4;
        float acc[4][4];
#pragma unroll
        for (int i = 0; i < 4; ++i)
#pragma unroll
            for (int j = 0; j < 4; ++j) acc[i][j] = 0.f;
#pragma unroll 2
        for (int d = 0; d < 128; d += 4) { f32x4 a[4], b[4];
#pragma unroll
            for (int i = 0; i < 4; ++i) { a[i] = *(const f32x4*)(wqs + (kq + 16 * i) * PB + d); b[i] = *(const f32x4*)(ks + (nq + 32 * i) * PB + d); }
#pragma unroll
            for (int i = 0; i < 4; ++i)
#pragma unroll
                for (int j = 0; j < 4; ++j) acc[i][j] += (a[i][0] * b[j][0] + a[i][1] * b[j][1]) + (a[i][2] * b[j][2] + a[i][3] * b[j][3]); }
        bf16* WpT = (bf16*)(p.ws + WS_WP) + (size_t)l * 2048 * D;
#pragma unroll
        for (int i = 0; i < 4; ++i)
#pragma unroll
            for (int j = 0; j < 4; ++j) WpT[(size_t)(hc * 128 + nq + 32 * j) * D + kt * 64 + kq + 16 * i] = (bf16)f2bf(acc[i][j]);
    }
}
typedef float f32x2v __attribute__((ext_vector_type(2)));
__device__ __forceinline__ float wave_max(float v) {
#pragma unroll
    for (int o = 32; o > 0; o >>= 1) v = fmaxf(v, __shfl_xor(v, o));
    return v;
}
__device__ __forceinline__ unsigned pk_i4x8(f32x4 a, f32x4 b, float sc) {
    unsigned w = 0u;
#pragma unroll
    for (int i = 0; i < 4; ++i) { w |= ((unsigned)(int)__builtin_rintf(a[i] * sc) & 15u) << (4 * i); w |= ((unsigned)(int)__builtin_rintf(b[i] * sc) & 15u) << (16 + 4 * i); }
    return w;
}
__device__ __forceinline__ void cvt_i4_rows(const float* src, unsigned char* dst, float* RS, size_t n16, size_t gtid, size_t gthreads) {
    for (size_t i = gtid; i < n16; i += gthreads) { const float* s_ = src + i * 16;
        const f32x4 a = *(const f32x4*)(s_), b = *(const f32x4*)(s_ + 4), c = *(const f32x4*)(s_ + 8), d = *(const f32x4*)(s_ + 12);
        float m = fmaxf(fmaxf(fmaxf(fabsf(a[0]), fabsf(a[1])), fmaxf(fabsf(a[2]), fabsf(a[3]))), fmaxf(fmaxf(fabsf(b[0]), fabsf(b[1])), fmaxf(fabsf(b[2]), fabsf(b[3]))));
        m = fmaxf(m, fmaxf(fmaxf(fmaxf(fabsf(c[0]), fabsf(c[1])), fmaxf(fabsf(c[2]), fabsf(c[3]))), fmaxf(fmaxf(fabsf(d[0]), fabsf(d[1])), fmaxf(fabsf(d[2]), fabsf(d[3])))));
        m = wave_max(m); const float sc = m > 0.f ? 7.49f / m : 0.f;
        u32x2 o; o.x = pk_i4x8(a, b, sc); o.y = pk_i4x8(c, d, sc); *(u32x2*)(dst + i * 8) = o;
        if ((i & 63) == 0) RS[i >> 6] = m * (1.0f / 7.49f); }
}
__device__ __forceinline__ void cvt_fp4_rows(const float* src, unsigned char* dst, float* VS, size_t n16, size_t gtid, size_t gthreads) {
    for (size_t i = gtid; i < n16; i += gthreads) { const float* s_ = src + i * 16;
        const f32x4 a = *(const f32x4*)(s_), b = *(const f32x4*)(s_ + 4), c = *(const f32x4*)(s_ + 8), d = *(const f32x4*)(s_ + 12);
        float m = fmaxf(fmaxf(fmaxf(fabsf(a[0]), fabsf(a[1])), fmaxf(fabsf(a[2]), fabsf(a[3]))), fmaxf(fmaxf(fabsf(b[0]), fabsf(b[1])), fmaxf(fabsf(b[2]), fabsf(b[3]))));
        m = fmaxf(m, fmaxf(fmaxf(fmaxf(fabsf(c[0]), fabsf(c[1])), fmaxf(fabsf(c[2]), fabsf(c[3]))), fmaxf(fmaxf(fabsf(d[0]), fabsf(d[1])), fmaxf(fabsf(d[2]), fabsf(d[3])))));
        m = wave_max(m); const float sc = m > 0.f ? 6.0f / m : 0.f;
        unsigned w0 = 0u, w1 = 0u;
        w0 = __builtin_amdgcn_cvt_scalef32_pk_fp4_f32(w0, a[0] * sc, a[1] * sc, 1.0f, 0); w0 = __builtin_amdgcn_cvt_scalef32_pk_fp4_f32(w0, a[2] * sc, a[3] * sc, 1.0f, 1);
        w0 = __builtin_amdgcn_cvt_scalef32_pk_fp4_f32(w0, b[0] * sc, b[1] * sc, 1.0f, 2); w0 = __builtin_amdgcn_cvt_scalef32_pk_fp4_f32(w0, b[2] * sc, b[3] * sc, 1.0f, 3);
        w1 = __builtin_amdgcn_cvt_scalef32_pk_fp4_f32(w1, c[0] * sc, c[1] * sc, 1.0f, 0); w1 = __builtin_amdgcn_cvt_scalef32_pk_fp4_f32(w1, c[2] * sc, c[3] * sc, 1.0f, 1);
        w1 = __builtin_amdgcn_cvt_scalef32_pk_fp4_f32(w1, d[0] * sc, d[1] * sc, 1.0f, 2); w1 = __builtin_amdgcn_cvt_scalef32_pk_fp4_f32(w1, d[2] * sc, d[3] * sc, 1.0f, 3);
        u32x2 o; o.x = w0; o.y = w1; *(u32x2*)(dst + i * 8) = o;
        if ((i & 63) == 0) VS[i >> 6] = m * (1.0f / 6.0f); }
}
__device__ __forceinline__ void phase_cvt(const Params& p, int l) {
    const size_t gtid = (size_t)bid_l() * 512 + tid_l(), gth = (size_t)grid_l() * 512;
    cvt_bf16_stream(p.p + (size_t)l * T * 256, (bf16*)(p.ws + WS_PB), (size_t)T * 256 / 8, gtid, gth);
    cvt_i4_rows(p.peer_u + (size_t)l * NEXP * D, p.ws + WS_U, (float*)(p.ws + WS_RS), (size_t)NEXP * D / 16, gtid, gth);
    cvt_fp4_rows(p.peer_v + (size_t)l * NEXP * D, p.ws + WS_V, (float*)(p.ws + WS_VS), (size_t)NEXP * D / 16, gtid, gth);
}

#define GEMM_RUN(EPI, e, Aptr, Bptr, N_, K_) do { int kk_ = (K_); asm volatile("" : "+s"(kk_)); pg8::Gemm g{(const pg8::bf16_t*)(Aptr), (const pg8::bf16_t*)(Bptr), T, (N_), kk_}; pg8::StaticOrder S; S.init(T, (N_), (int)grid_l(), (int)bid_l()); \
    pg8::gemm_phase<EPI, pg8::StaticOrder, true, true>((PG8_LAS unsigned char*)lds, g, S, e); } while (0)

__device__ __forceinline__ void phase_gemm_in(const Params& p, int l, unsigned char* lds) {
    pg8::EpiBf16<0> e{(pg8::bf16_t*)(p.ws + WS_H), HCOLS, nullptr, 0, 0, 1.f};
    GEMM_RUN(pg8::EpiBf16<0>, e, p.ws + WS_XB, (bf16*)(p.ws + WS_WIN) + (size_t)l * HCOLS * D, HCOLS, D);
}
__device__ __forceinline__ void phase_gemm_e(const Params& p, int l, unsigned char* lds) {
    pg8::EpiBf16<0> e{(pg8::bf16_t*)(p.ws + WS_E), D, nullptr, 0, 0, 1.f};
    GEMM_RUN(pg8::EpiBf16<0>, e, p.ws + WS_PB, (bf16*)(p.ws + WS_PW) + (size_t)l * D * 256, D, 256);
}
__device__ __forceinline__ void phase_gemm_out(const Params& p, int l, unsigned char* lds) {
    pg8::EpiResid e{(const pg8::bf16_t*)(p.ws + WS_XB), (_Float16*)(p.ws + WS_Y), D, ALPHA};
    GEMM_RUN(pg8::EpiResid, e, p.ws + WS_MIX, (bf16*)(p.ws + WS_WOUT) + (size_t)l * D * D, D, D);
}
__device__ __forceinline__ void phase_gemm_sc(const Params& p, int l, unsigned char* lds) {
    pg8::EpiF16 e{(_Float16*)(p.ws + WS_SC), 2048};
    GEMM_RUN(pg8::EpiF16, e, p.ws + WS_XB, (bf16*)(p.ws + WS_WP) + (size_t)l * 2048 * D, 2048, D);
}
__device__ __forceinline__ void phase_gemm_ple(const Params& p, int l, unsigned char* lds) {
    pg8::EpiPle e{(const pg8::bf16_t*)(p.ws + WS_XB), (_Float16*)(p.ws + WS_Y), (const pg8::bf16_t*)(p.ws + WS_E), p.ple_gb + (size_t)l * D, D};
    GEMM_RUN(pg8::EpiPle, e, p.ws + WS_XB, (bf16*)(p.ws + WS_PGW) + (size_t)l * D * D, D, D);
}

__device__ __forceinline__ void phase_conv(const Params& p, int l, unsigned char* lds) {
    const int tid = tid_l(), lane = tid & 63, wave = tid >> 6;
    float* U = (float*)lds;
    float* Yt = U + 62 * 256;
    const bf16* H = (const bf16*)(p.ws + WS_H); bf16* MIX = (bf16*)(p.ws + WS_MIX);
    const float* cw = p.conv_w + (size_t)l * 31 * 256; const float* cb = p.conv_b + l * 256;
    const float* lg = p.conv_ln_g + l * 256; const float* lb = p.conv_ln_b + l * 256;
    for (int it = bid_l(); it < T / 32; it += grid_l()) {
        const int b = it / (SEQ / 32), t0 = (it % (SEQ / 32)) * 32;
        __syncthreads();
        for (int i = tid; i < 62 * 32; i += 512) { const int r = i >> 5, c8 = (i & 31) * 8, t = t0 - 30 + r; f32x4 u0 = {0.f, 0.f, 0.f, 0.f}, u1 = {0.f, 0.f, 0.f, 0.f};
            if (t >= 0) { const bf16* hr = H + (size_t)(b * SEQ + t) * HCOLS; const u32x4 av = *(const u32x4*)(hr + HC_AVAL + c8), gv = *(const u32x4*)(hr + HC_AGATE + c8);
#pragma unroll
                for (int j = 0; j < 2; ++j) { u0[2 * j] = bf2f(av[j] & 0xffffu) * sigmoidf_(bf2f(gv[j] & 0xffffu)); u0[2 * j + 1] = __uint_as_float(av[j] & 0xffff0000u) * sigmoidf_(__uint_as_float(gv[j] & 0xffff0000u));
                                              u1[2 * j] = bf2f(av[2 + j] & 0xffffu) * sigmoidf_(bf2f(gv[2 + j] & 0xffffu)); u1[2 * j + 1] = __uint_as_float(av[2 + j] & 0xffff0000u) * sigmoidf_(__uint_as_float(gv[2 + j] & 0xffff0000u)); } }
            *(f32x4*)(U + r * 256 + c8) = u0; *(f32x4*)(U + r * 256 + c8 + 4) = u1; }
        __syncthreads();
        { const int c = tid & 255, half = tid >> 8; float w[31], win[46];
#pragma unroll
          for (int j = 0; j < 31; ++j) w[j] = cw[j * 256 + c];
#pragma unroll
          for (int j = 0; j < 46; ++j) win[j] = U[(half * 16 + j) * 256 + c];
          const float bias = cb[c];
#pragma unroll
          for (int tl = 0; tl < 16; ++tl) { float y = bias;
#pragma unroll
              for (int j = 0; j < 31; ++j) y += w[j] * win[tl + j];
              Yt[(half * 16 + tl) * 256 + c] = y; } }
        __syncthreads();
        for (int tl = wave * 4; tl < wave * 4 + 4; ++tl) {
            const f32x4 v = *(const f32x4*)(Yt + tl * 256 + lane * 4);
            const float mean = wave_sum((v[0] + v[1]) + (v[2] + v[3])) * (1.f / 256.f);
            const f32x4 d = v - mean; const float var = wave_sum((d[0] * d[0] + d[1] * d[1]) + (d[2] * d[2] + d[3] * d[3])) * (1.f / 256.f);
            const float rstd = 1.0f / sqrtf(var + LN_EPS);
            const f32x4 g4 = *(const f32x4*)(lg + lane * 4), b4 = *(const f32x4*)(lb + lane * 4);
            float o[4];
#pragma unroll
            for (int i = 0; i < 4; ++i) { const float z = d[i] * rstd * g4[i] + b4[i]; o[i] = z * sigmoidf_(z); }
            u32x2 w2; w2.x = pk2(o[0], o[1]); w2.y = pk2(o[2], o[3]);
            *(u32x2*)(MIX + (size_t)(b * SEQ + t0 + tl) * D + MC_A + lane * 4) = w2;
        }
    }
}

__device__ __forceinline__ void phase_fox_cum(const Params& p, int l, unsigned char* lds) {
    const int tid = tid_l(), lane = tid & 63, wave = tid >> 6;
    float* wsum = (float*)lds;
    const bf16* H = (const bf16*)(p.ws + WS_H); float* CK = (float*)(p.ws + WS_CK);
    for (int bh = bid_l(); bh < 48; bh += grid_l()) {
        const int b = bh / 6, h = bh % 6; const float bias = p.fox_forget_b[l * 6 + h];
        float v[8]; float s = 0.f;
#pragma unroll
        for (int i = 0; i < 8; ++i) { const float f = bf2f(H[(size_t)(b * SEQ + tid * 8 + i) * HCOLS + HC_CF + h]); s += log_sigmoid(f + bias) * LOG2E; v[i] = s; }
        float incl = s;
#pragma unroll
        for (int o = 1; o < 64; o <<= 1) { const float n = __shfl_up(incl, o); if (lane >= o) incl += n; }
        __syncthreads();
        if (lane == 63) wsum[wave] = incl;
        __syncthreads();
        float base = incl - s;
        for (int w = 0; w < wave; ++w) base += wsum[w];
#pragma unroll
        for (int i = 0; i < 8; ++i) CK[(size_t)bh * SEQ + tid * 8 + i] = base + v[i];
    }
}

__device__ __forceinline__ void phase_fox_norm(const Params& p, unsigned char* lds) {
    const int tid = tid_l(), lane = tid & 63, wave = tid >> 6;
    float* qns = (float*)lds; float* kns = qns + 256;
    const bf16* H = (const bf16*)(p.ws + WS_H); float* KT = (float*)(p.ws + WS_FKT); float* QBM = (float*)(p.ws + WS_FQB);
    for (int it = bid_l(); it < 48 * 16; it += grid_l()) {
        const int bh = it >> 4, qb = it & 15, b = bh / 6, h = bh % 6;
        __syncthreads();
        if (tid < 256) { const bf16* row = H + ((size_t)b * SEQ + qb * 256 + tid) * HCOLS + h * 64; float sq = 0.f, sk = 0.f;
#pragma unroll
            for (int j = 0; j < 8; ++j) { const u32x4 qv = *(const u32x4*)(row + HC_CQ + 8 * j), kv = *(const u32x4*)(row + HC_CK + 8 * j);
#pragma unroll
                for (int i = 0; i < 4; ++i) { const float a0 = bf2f(qv[i] & 0xffffu), a1 = __uint_as_float(qv[i] & 0xffff0000u), b0 = bf2f(kv[i] & 0xffffu), b1 = __uint_as_float(kv[i] & 0xffff0000u);
                    sq += a0 * a0 + a1 * a1; sk += b0 * b0 + b1 * b1; } }
            qns[tid] = sqrtf(sq); kns[tid] = sqrtf(sk); }
        __syncthreads();
        if (wave < 5) { float v = wave < 4 ? kns[wave * 64 + lane] : fmaxf(fmaxf(qns[lane], qns[64 + lane]), fmaxf(qns[128 + lane], qns[192 + lane]));
#pragma unroll
            for (int o = 1; o < 64; o <<= 1) v = fmaxf(v, __shfl_xor(v, o));
            if (lane == 0) { if (wave < 4) KT[bh * 64 + 4 * qb + wave] = v; else QBM[bh * 16 + qb] = v; } }
    }
}

typedef short bf16x8_t __attribute__((ext_vector_type(8)));
typedef float f32x16_t __attribute__((ext_vector_type(16)));
__device__ __forceinline__ int crow32(int r, int hi) { return (r & 3) + 8 * (r >> 2) + 4 * hi; }
struct GlaB1Pre { u32x4 vv, lr0, lr1; u32x2 kk; float w2v, b2v; };
__device__ __forceinline__ GlaB1Pre gla_b1_load(const Params& p, int l, int it, int tid, int lane, int wave) {
    const int bh = it >> 6, n = it & 63, b = bh / 6, h = bh % 6; const size_t tok0 = (size_t)b * SEQ + n * 64; const bf16* H = (const bf16*)(p.ws + WS_H);
    GlaB1Pre r; r.w2v = p.gla_gate_w[(size_t)l * 16 * 192 + (tid >> 5) * 192 + h * 32 + (tid & 31)]; r.b2v = p.gla_gate_b[l * 192 + h * 32 + (tid & 31)];
    r.vv = *(const u32x4*)(H + (tok0 + (tid >> 3)) * HCOLS + HC_BV + h * 64 + (tid & 7) * 8);
    r.lr0 = *(const u32x4*)(H + (tok0 + lane) * HCOLS + HC_LR); r.lr1 = *(const u32x4*)(H + (tok0 + lane) * HCOLS + HC_LR + 8);
    r.kk = *(const u32x2*)(H + (tok0 + lane) * HCOLS + HC_BK + h * 32 + wave * 4);
    return r;
}
__device__ __forceinline__ void phase_gla_b1(const Params& p, int l, unsigned char* lds) {
    const int tid = tid_l(), lane = tid & 63, wave = tid >> 6, r32 = lane & 31, hi = lane >> 5;
    bf16* KDT = (bf16*)lds;
    bf16* VT = KDT + 32 * 72;
    float* w2s = (float*)(VT + 64 * 72);
    float* b2s = w2s + 16 * 32;
    float* GCUM = (float*)(p.ws + WS_GCUM); float* GS = (float*)(p.ws + WS_GS); float* GDEC = (float*)(p.ws + WS_GDEC);
    const int NI = 48 * 64, G = grid_l(); int it = bid_l();
    if (it >= NI) return;
    GlaB1Pre cur = gla_b1_load(p, l, it, tid, lane, wave);
#pragma unroll 1
    for (; it < NI; it += G) {
        const GlaB1Pre nxt = gla_b1_load(p, l, it + G < NI ? it + G : it, tid, lane, wave);
        __builtin_amdgcn_sched_barrier(0);
        const int bh = it >> 6, n = it & 63, b = bh / 6, h = bh % 6; const size_t tok0 = (size_t)b * SEQ + n * 64;
        __syncthreads();
        w2s[tid] = cur.w2v;
        if (tid < 32) b2s[tid] = cur.b2v;
        { const int s_ = tid >> 3, e0 = (tid & 7) * 8;
#pragma unroll
          for (int i = 0; i < 4; ++i) { VT[(e0 + 2 * i) * 72 + s_] = (bf16)(cur.vv[i] & 0xffffu); VT[(e0 + 2 * i + 1) * 72 + s_] = (bf16)(cur.vv[i] >> 16); } }
        const int d0 = wave * 4;
        __syncthreads();
        float lrf[16];
#pragma unroll
        for (int i = 0; i < 4; ++i) { lrf[2 * i] = bf2f(cur.lr0[i] & 0xffffu); lrf[2 * i + 1] = __uint_as_float(cur.lr0[i] & 0xffff0000u); lrf[8 + 2 * i] = bf2f(cur.lr1[i] & 0xffffu); lrf[8 + 2 * i + 1] = __uint_as_float(cur.lr1[i] & 0xffff0000u); }
        float g[4];
#pragma unroll
        for (int dd = 0; dd < 4; ++dd) { float x = b2s[d0 + dd];
#pragma unroll
            for (int r = 0; r < 16; ++r) x += lrf[r] * w2s[r * 32 + d0 + dd];
            g[dd] = log_sigmoid(x) * (1.0f / 16.0f); }
#pragma unroll
        for (int o = 1; o < 64; o <<= 1)
#pragma unroll
            for (int dd = 0; dd < 4; ++dd) { const float v = __shfl_up(g[dd], o); if (lane >= o) g[dd] += v; }
        *(f32x4*)(GCUM + (tok0 + lane) * 192 + h * 32 + d0) = (f32x4){g[0], g[1], g[2], g[3]};
        const float kf[4] = {bf2f(cur.kk.x & 0xffffu), __uint_as_float(cur.kk.x & 0xffff0000u), bf2f(cur.kk.y & 0xffffu), __uint_as_float(cur.kk.y & 0xffff0000u)};
#pragma unroll
        for (int dd = 0; dd < 4; ++dd) { const float last = __uint_as_float(__builtin_amdgcn_readlane(__float_as_uint(g[dd]), 63));
            KDT[(d0 + dd) * 72 + lane] = (bf16)f2bf(kf[dd] * __expf(last - g[dd]));
            if (lane == 63) GDEC[(size_t)it * 32 + d0 + dd] = __expf(last); }
        __syncthreads();
        if (wave < 2) {
            f32x16_t acc = {};
#pragma unroll
            for (int ks = 0; ks < 4; ++ks) { const bf16x8_t a = *(const bf16x8_t*)(KDT + r32 * 72 + 16 * ks + 8 * hi), bb = *(const bf16x8_t*)(VT + (32 * wave + r32) * 72 + 16 * ks + 8 * hi);
                acc = __builtin_amdgcn_mfma_f32_32x32x16_bf16(a, bb, acc, 0, 0, 0); }
#pragma unroll
            for (int r = 0; r < 16; ++r) GS[(size_t)it * 2048 + crow32(r, hi) * 64 + 32 * wave + r32] = acc[r];
        }
        cur = nxt;
    }
}
__device__ __forceinline__ void phase_gla_b2(const Params& p) {
    float* GS = (float*)(p.ws + WS_GS); const float* GDEC = (const float*)(p.ws + WS_GDEC);
    for (int g = bid_l() * 512 + tid_l(); g < 48 * 2048; g += grid_l() * 512) {
        const int bh = g >> 11, de = g & 2047, d = de >> 6; float S = 0.f;
        float* gs = GS + (size_t)bh * 64 * 2048 + de; const float* gd = GDEC + (size_t)bh * 64 * 32 + d;
#pragma unroll 1
        for (int n0 = 0; n0 < 64; n0 += 16) { float loc[16], dec[16];
#pragma unroll
            for (int i = 0; i < 16; ++i) { loc[i] = gs[(size_t)(n0 + i) * 2048]; dec[i] = gd[(n0 + i) * 32]; }
#pragma unroll
            for (int i = 0; i < 16; ++i) { gs[(size_t)(n0 + i) * 2048] = S; S = S * dec[i] + loc[i]; } }
    }
}
struct GlaB3Pre { u32x2 qq, kk; f32x4 c; u32x4 vv; f32x4 sv; u32x4 gr; };
__device__ __forceinline__ GlaB3Pre gla_b3_load(const Params& p, int it, int tid) {
    const int bh = it >> 6, n = it & 63, b = bh / 6, h = bh % 6; const size_t tok0 = (size_t)b * SEQ + n * 64; const bf16* H = (const bf16*)(p.ws + WS_H);
    const float* GCUM = (const float*)(p.ws + WS_GCUM); const float* GS = (const float*)(p.ws + WS_GS);
    GlaB3Pre r; const int t = tid >> 3, d0 = (tid & 7) * 4;
    r.qq = *(const u32x2*)(H + (tok0 + t) * HCOLS + HC_BQ + h * 32 + d0); r.kk = *(const u32x2*)(H + (tok0 + t) * HCOLS + HC_BK + h * 32 + d0);
    r.c = *(const f32x4*)(GCUM + (tok0 + t) * 192 + h * 32 + d0);
    r.vv = *(const u32x4*)(H + (tok0 + t) * HCOLS + HC_BV + h * 64 + (tid & 7) * 8);
    r.sv = *(const f32x4*)(GS + (size_t)it * 2048 + (tid >> 4) * 64 + (tid & 15) * 4);
    r.gr = *(const u32x4*)(H + (tok0 + t) * HCOLS + HC_BG + h * 64 + (tid & 7) * 8);
    return r;
}
__device__ __forceinline__ void phase_gla_b3(const Params& p, int l, unsigned char* lds) {
    const int tid = tid_l(), lane = tid & 63, wave = tid >> 6, r32 = lane & 31, hi = lane >> 5;
    bf16* QE = (bf16*)lds;
    bf16* KE = QE + 64 * 40;
    bf16* VT = KE + 64 * 40;
    bf16* ST = VT + 64 * 72;
    bf16* P = ST + 64 * 40;
    float* O = (float*)(P + 64 * 72);
    bf16* MIX = (bf16*)(p.ws + WS_MIX);
    const int NI = 48 * 64, G = grid_l(); int it = bid_l();
    if (it >= NI) return;
    GlaB3Pre cur = gla_b3_load(p, it, tid);
#pragma unroll 1
    for (; it < NI; it += G) {
        const GlaB3Pre nxt = gla_b3_load(p, it + G < NI ? it + G : it, tid);
        __builtin_amdgcn_sched_barrier(0);
        const int bh = it >> 6, n = it & 63, b = bh / 6, h = bh % 6; const size_t tok0 = (size_t)b * SEQ + n * 64;
        __syncthreads();
        { const int t = tid >> 3, d0 = (tid & 7) * 4; const u32x2 qq = cur.qq, kk = cur.kk; const f32x4 c = cur.c;
          const float e0 = __expf(c[0]), e1 = __expf(c[1]), e2 = __expf(c[2]), e3 = __expf(c[3]);
          u32x2 qo, ko;
          qo.x = pk2(bf2f(qq.x & 0xffffu) * e0, __uint_as_float(qq.x & 0xffff0000u) * e1); qo.y = pk2(bf2f(qq.y & 0xffffu) * e2, __uint_as_float(qq.y & 0xffff0000u) * e3);
          ko.x = pk2(bf2f(kk.x & 0xffffu) / e0, __uint_as_float(kk.x & 0xffff0000u) / e1); ko.y = pk2(bf2f(kk.y & 0xffffu) / e2, __uint_as_float(kk.y & 0xffff0000u) / e3);
          *(u32x2*)(QE + t * 40 + d0) = qo; *(u32x2*)(KE + t * 40 + d0) = ko; }
        { const int s_ = tid >> 3, e0 = (tid & 7) * 8;
#pragma unroll
          for (int i = 0; i < 4; ++i) { VT[(e0 + 2 * i) * 72 + s_] = (bf16)(cur.vv[i] & 0xffffu); VT[(e0 + 2 * i + 1) * 72 + s_] = (bf16)(cur.vv[i] >> 16); } }
        { const int d = tid >> 4, e0 = (tid & 15) * 4;
#pragma unroll
          for (int i = 0; i < 4; ++i) ST[(e0 + i) * 40 + d] = (bf16)f2bf(cur.sv[i]); }
        __syncthreads();
        f32x16_t acc = {};
        const int tt = (wave & 3) >> 1, tc = wave & 1;
        if (wave < 4) {
            if (!(tt == 0 && tc == 1)) {
#pragma unroll
                for (int ks = 0; ks < 2; ++ks) { const bf16x8_t a = *(const bf16x8_t*)(QE + (32 * tt + r32) * 40 + 16 * ks + 8 * hi), bb = *(const bf16x8_t*)(KE + (32 * tc + r32) * 40 + 16 * ks + 8 * hi);
                    acc = __builtin_amdgcn_mfma_f32_32x32x16_bf16(a, bb, acc, 0, 0, 0); }
#pragma unroll
                for (int r = 0; r < 16; ++r) { const int trow = 32 * tt + crow32(r, hi), scol = 32 * tc + r32; P[trow * 72 + scol] = (bf16)f2bf(scol <= trow ? acc[r] : 0.f); }
            }
        } else {
#pragma unroll
            for (int ks = 0; ks < 2; ++ks) { const bf16x8_t a = *(const bf16x8_t*)(QE + (32 * tt + r32) * 40 + 16 * ks + 8 * hi), bb = *(const bf16x8_t*)(ST + (32 * tc + r32) * 40 + 16 * ks + 8 * hi);
                acc = __builtin_amdgcn_mfma_f32_32x32x16_bf16(a, bb, acc, 0, 0, 0); }
        }
        __syncthreads();
        if (wave >= 4) {
            const int nks = tt == 0 ? 2 : 4;
            for (int ks = 0; ks < nks; ++ks) { const bf16x8_t a = *(const bf16x8_t*)(P + (32 * tt + r32) * 72 + 16 * ks + 8 * hi), bb = *(const bf16x8_t*)(VT + (32 * tc + r32) * 72 + 16 * ks + 8 * hi);
                acc = __builtin_amdgcn_mfma_f32_32x32x16_bf16(a, bb, acc, 0, 0, 0); }
#pragma unroll
            for (int r = 0; r < 16; ++r) O[(32 * tt + crow32(r, hi)) * 65 + 32 * tc + r32] = acc[r];
        }
        __syncthreads();
        { const int t = tid >> 3, e0 = (tid & 7) * 8; float o[8]; float ss = 0.f;
#pragma unroll
          for (int i = 0; i < 8; ++i) { o[i] = O[t * 65 + e0 + i]; ss += o[i] * o[i]; }
          ss += __shfl_xor(ss, 1); ss += __shfl_xor(ss, 2); ss += __shfl_xor(ss, 4);
          const float rs = 1.0f / sqrtf(ss * (1.f / 64.f) + LN_EPS);
          const float* ng = p.gla_norm_g + l * 384 + h * 64 + e0; const u32x4 gr = cur.gr;
          float r[8];
#pragma unroll
          for (int i = 0; i < 4; ++i) { const float ga = bf2f(gr[i] & 0xffffu), gb = __uint_as_float(gr[i] & 0xffff0000u);
              r[2 * i] = o[2 * i] * rs * ng[2 * i] * (ga * sigmoidf_(ga)); r[2 * i + 1] = o[2 * i + 1] * rs * ng[2 * i + 1] * (gb * sigmoidf_(gb)); }
          u32x4 w; w.x = pk2(r[0], r[1]); w.y = pk2(r[2], r[3]); w.z = pk2(r[4], r[5]); w.w = pk2(r[6], r[7]);
          *(u32x4*)(MIX + (tok0 + t) * D + MC_B + h * 64 + e0) = w; }
        cur = nxt;
    }
}

constexpr int LDSQ_OFF = LDS_BYTES - 1024;
constexpr int CW_ATTNQ = 8192;
__device__ __forceinline__ void phase_fox_mfma(const Params& p, int l, unsigned char* lds) {
    const attn_body::bf16* H = (const attn_body::bf16*)(p.ws + WS_H);
    const attn_body::AttnTensors AT{H + HC_CQ, H + HC_CK, H + HC_CV, (attn_body::bf16*)(p.ws + WS_MIX) + MC_C, (const float*)(p.ws + WS_CK), (const float*)(p.ws + WS_FKT), (const float*)(p.ws + WS_FQB)};
    const attn_body::QueueOrder S{(unsigned*)(p.ws + WS_CTL) + CW_ATTNQ + l * 64, (volatile __attribute__((address_space(3))) int*)((__attribute__((address_space(3))) unsigned char*)lds + LDSQ_OFF)};
    attn_body::attn_phase<attn_body::QueueOrder>((char*)lds, AT, S);
}

__device__ __forceinline__ void phase_ln(const _Float16* Y, const float* g, const float* bta, float* dst, bf16* dstb, unsigned char* xq = nullptr, float* xs = nullptr) {
    const int tid = tid_l(), lane = tid & 63, wave = tid >> 6; typedef _Float16 h4 __attribute__((ext_vector_type(4)));
    const int stride = grid_l() * 8; int row = bid_l() * 8 + wave;
    if (row >= T) return;
    h4 cur[4];
#pragma unroll
    for (int j = 0; j < 4; ++j) cur[j] = *(const h4*)(Y + (size_t)row * D + j * 256 + lane * 4);
#pragma unroll 1
    for (; row < T; row += stride) {
        h4 nxt[4]; const int nr = row + stride < T ? row + stride : row;
#pragma unroll
        for (int j = 0; j < 4; ++j) nxt[j] = *(const h4*)(Y + (size_t)nr * D + j * 256 + lane * 4);
        __builtin_amdgcn_sched_barrier(0);
        f32x4 v[4]; float s = 0.f;
#pragma unroll
        for (int j = 0; j < 4; ++j) { v[j] = (f32x4){(float)cur[j][0], (float)cur[j][1], (float)cur[j][2], (float)cur[j][3]}; s += (v[j][0] + v[j][1]) + (v[j][2] + v[j][3]); }
        const float mean = wave_sum(s) * (1.f / D); float s2 = 0.f;
#pragma unroll
        for (int j = 0; j < 4; ++j) { v[j] = v[j] - mean; s2 += (v[j][0] * v[j][0] + v[j][1] * v[j][1]) + (v[j][2] * v[j][2] + v[j][3] * v[j][3]); }
        const float rstd = 1.0f / sqrtf(wave_sum(s2) * (1.f / D) + LN_EPS);
        float am = 0.f;
#pragma unroll
        for (int j = 0; j < 4; ++j) { const f32x4 g4 = *(const f32x4*)(g + j * 256 + lane * 4), b4 = *(const f32x4*)(bta + j * 256 + lane * 4);
            const f32x4 o = v[j] * rstd * g4 + b4; v[j] = o;
            am = fmaxf(am, fmaxf(fmaxf(fabsf(o[0]), fabsf(o[1])), fmaxf(fabsf(o[2]), fabsf(o[3]))));
            if (dst) *(f32x4*)(dst + (size_t)row * D + j * 256 + lane * 4) = o;
            if (dstb) { u32x2 w; w.x = pk2(o[0], o[1]); w.y = pk2(o[2], o[3]); *(u32x2*)(dstb + (size_t)row * D + j * 256 + lane * 4) = w; } }
        if (xq) {
            am = wave_max(am); const float sc = am > 0.f ? 119.0f / am : 0.f;
#pragma unroll
            for (int j = 0; j < 4; ++j) { unsigned hh = 0u, ll = 0u;
#pragma unroll
                for (int i = 0; i < 4; ++i) { const int q8 = (int)__builtin_rintf(v[j][i] * sc), qh = (q8 + 8) >> 4, ql = q8 - (qh << 4); hh |= ((unsigned)qh & 15u) << (4 * i); ll |= ((unsigned)ql & 15u) << (4 * i); }
                *(unsigned short*)(xq + (size_t)row * D + j * 128 + lane * 2) = (unsigned short)hh; *(unsigned short*)(xq + (size_t)row * D + 512 + j * 128 + lane * 2) = (unsigned short)ll; }
            if (lane == 0) xs[row] = am * (1.0f / 119.0f); }
#pragma unroll
        for (int j = 0; j < 4; ++j) cur[j] = nxt[j];
    }
}

__device__ __forceinline__ int f2ord(float x) { const int i = __float_as_int(x); return i ^ ((i >> 31) & 0x7fffffff); }
__device__ __forceinline__ float ord2f(int k) { return __int_as_float(k ^ ((k >> 31) & 0x7fffffff)); }
__device__ __forceinline__ void phase_topk(const Params& p, unsigned char* lds) {
    const int tid = tid_l(), lane = tid & 63, wave = tid >> 6;
    unsigned char* wreg = lds + wave * 17408; unsigned char* tab = wreg;
    const _Float16* SC = (const _Float16*)(p.ws + WS_SC); int* EIDX = (int*)(p.ws + WS_EIDX); float* GATE = (float*)(p.ws + WS_GATE);
    for (int g = bid_l() * 512 + tid; g < T * 16; g += grid_l() * 512) {
        const int tok = g >> 4, hc = g & 15;
        typedef _Float16 h8 __attribute__((ext_vector_type(8)));
        { const unsigned char* blk = (const unsigned char*)(SC + (size_t)(g - lane) * 128);
          u32x4 st[16];
#pragma unroll
          for (int j = 0; j < 16; ++j) st[j] = *(const u32x4*)(blk + (size_t)(j * 64 + lane) * 16);
          __builtin_amdgcn_wave_barrier();
#pragma unroll
          for (int j = 0; j < 16; ++j) { const int c = j * 64 + lane; *(u32x4*)(wreg + (c + (c >> 4)) * 16) = st[j]; }
          __builtin_amdgcn_wave_barrier(); }
        const unsigned char* lp = wreg + lane * 272;
#define TK_CE(a, b) do { const int hi_ = max(a, b), lo_ = min(a, b); a = hi_; b = lo_; } while (0)
#define TK_SORT16(v) do { TK_CE(v[0], v[1]); TK_CE(v[3], v[2]); TK_CE(v[4], v[5]); TK_CE(v[7], v[6]); TK_CE(v[8], v[9]); TK_CE(v[11], v[10]); TK_CE(v[12], v[13]); TK_CE(v[15], v[14]); TK_CE(v[0], v[2]); TK_CE(v[1], v[3]); TK_CE(v[6], v[4]); TK_CE(v[7], v[5]); TK_CE(v[8], v[10]); TK_CE(v[9], v[11]); TK_CE(v[14], v[12]); TK_CE(v[15], v[13]); TK_CE(v[0], v[1]); TK_CE(v[2], v[3]); TK_CE(v[5], v[4]); TK_CE(v[7], v[6]); TK_CE(v[8], v[9]); TK_CE(v[10], v[11]); TK_CE(v[13], v[12]); TK_CE(v[15], v[14]); TK_CE(v[0], v[4]); TK_CE(v[1], v[5]); TK_CE(v[2], v[6]); TK_CE(v[3], v[7]); TK_CE(v[12], v[8]); TK_CE(v[13], v[9]); TK_CE(v[14], v[10]); TK_CE(v[15], v[11]); TK_CE(v[0], v[2]); TK_CE(v[1], v[3]); TK_CE(v[4], v[6]); TK_CE(v[5], v[7]); TK_CE(v[10], v[8]); TK_CE(v[11], v[9]); TK_CE(v[14], v[12]); TK_CE(v[15], v[13]); TK_CE(v[0], v[1]); TK_CE(v[2], v[3]); TK_CE(v[4], v[5]); TK_CE(v[6], v[7]); TK_CE(v[9], v[8]); TK_CE(v[11], v[10]); TK_CE(v[13], v[12]); TK_CE(v[15], v[14]); TK_CE(v[0], v[8]); TK_CE(v[1], v[9]); TK_CE(v[2], v[10]); TK_CE(v[3], v[11]); TK_CE(v[4], v[12]); TK_CE(v[5], v[13]); TK_CE(v[6], v[14]); TK_CE(v[7], v[15]); TK_CE(v[0], v[4]); TK_CE(v[1], v[5]); TK_CE(v[2], v[6]); TK_CE(v[3], v[7]); TK_CE(v[8], v[12]); TK_CE(v[9], v[13]); TK_CE(v[10], v[14]); TK_CE(v[11], v[15]); TK_CE(v[0], v[2]); TK_CE(v[1], v[3]); TK_CE(v[4], v[6]); TK_CE(v[5], v[7]); TK_CE(v[8], v[10]); TK_CE(v[9], v[11]); TK_CE(v[12], v[14]); TK_CE(v[13], v[15]); TK_CE(v[0], v[1]); TK_CE(v[2], v[3]); TK_CE(v[4], v[5]); TK_CE(v[6], v[7]); TK_CE(v[8], v[9]); TK_CE(v[10], v[11]); TK_CE(v[12], v[13]); TK_CE(v[14], v[15]); } while (0)
#define TK_BMERGE(tk) do { TK_CE(tk[0], tk[8]); TK_CE(tk[1], tk[9]); TK_CE(tk[2], tk[10]); TK_CE(tk[3], tk[11]); TK_CE(tk[4], tk[12]); TK_CE(tk[5], tk[13]); TK_CE(tk[6], tk[14]); TK_CE(tk[7], tk[15]); TK_CE(tk[0], tk[4]); TK_CE(tk[1], tk[5]); TK_CE(tk[2], tk[6]); TK_CE(tk[3], tk[7]); TK_CE(tk[8], tk[12]); TK_CE(tk[9], tk[13]); TK_CE(tk[10], tk[14]); TK_CE(tk[11], tk[15]); TK_CE(tk[0], tk[2]); TK_CE(tk[1], tk[3]); TK_CE(tk[4], tk[6]); TK_CE(tk[5], tk[7]); TK_CE(tk[8], tk[10]); TK_CE(tk[9], tk[11]); TK_CE(tk[12], tk[14]); TK_CE(tk[13], tk[15]); TK_CE(tk[0], tk[1]); TK_CE(tk[2], tk[3]); TK_CE(tk[4], tk[5]); TK_CE(tk[6], tk[7]); TK_CE(tk[8], tk[9]); TK_CE(tk[10], tk[11]); TK_CE(tk[12], tk[13]); TK_CE(tk[14], tk[15]); } while (0)
        int tk[16];
#pragma unroll 1
        for (int gi = 0; gi < 8; ++gi) { const h8 cA = *(const h8*)(lp + gi * 32), c1_ = *(const h8*)(lp + gi * 32 + 16);
            int v[16];
#pragma unroll
            for (int j = 0; j < 8; ++j) { v[j] = (f2ord((float)cA[j]) & ~127) | (127 - (gi * 16 + j)); v[8 + j] = (f2ord((float)c1_[j]) & ~127) | (127 - (gi * 16 + 8 + j)); }
            TK_SORT16(v);
            if (gi == 0) {
#pragma unroll
                for (int j = 0; j < 16; ++j) tk[j] = v[j]; }
            else {
#pragma unroll
                for (int j = 0; j < 16; ++j) tk[j] = max(tk[j], v[15 - j]);
                TK_BMERGE(tk); }
            }
        __builtin_amdgcn_wave_barrier();
        float av[16], bv[16]; int ai[16], bi[16]; const bool c1 = (hc & 1) != 0;
#pragma unroll
        for (int j = 0; j < 16; ++j) { const int ok = __shfl_xor(tk[j], 1); const int ka = c1 ? ok : tk[j], kb = c1 ? tk[j] : ok;
            av[j] = ord2f(ka & ~127); ai[j] = 127 - (ka & 127); bv[j] = ord2f(kb & ~127); bi[j] = 127 - (kb & 127); }
#pragma unroll
        for (int j = 0; j < 16; ++j) { tab[j * 64 + lane] = (unsigned char)ai[j]; tab[(16 + j) * 64 + lane] = (unsigned char)bi[j]; }
#define TK_KEY(i, j) ((f2ord(av[i] + bv[j]) & ~255) | (255 - ((i) * 16 + (j))))
        int ck[16], g1[16], g2[16], g3[16]; constexpr int TKPAD = (int)0x80000000;
#pragma unroll
        for (int j = 0; j < 16; ++j) ck[j] = TK_KEY(0, j);
#pragma unroll
        for (int j = 0; j < 8; ++j) g1[j] = TK_KEY(1, j);
        g1[8] = TKPAD; g1[9] = TKPAD; g1[10] = TKPAD; g1[11] = TK_KEY(2, 4); g1[12] = TK_KEY(2, 3); g1[13] = TK_KEY(2, 2); g1[14] = TK_KEY(2, 1); g1[15] = TK_KEY(2, 0);
        TK_BMERGE(g1);
        g2[0] = TK_KEY(3, 0); g2[1] = TK_KEY(3, 1); g2[2] = TK_KEY(3, 2); g2[3] = TK_KEY(3, 3); g2[4] = TK_KEY(4, 0); g2[5] = TK_KEY(4, 1); g2[6] = TK_KEY(4, 2); g2[7] = TK_KEY(5, 0); g2[8] = TK_KEY(5, 1);
        g2[9] = TK_KEY(6, 0); g2[10] = TK_KEY(6, 1); g2[11] = TK_KEY(7, 0); g2[12] = TK_KEY(7, 1); g2[13] = TKPAD; g2[14] = TKPAD; g2[15] = TKPAD;
        TK_SORT16(g2);
#pragma unroll
        for (int i = 0; i < 8; ++i) { g3[i] = TK_KEY(8 + i, 0); g3[8 + i] = TKPAD; }
#pragma unroll
        for (int j = 0; j < 16; ++j) { ck[j] = max(ck[j], g1[15 - j]); g2[j] = max(g2[j], g3[15 - j]); }
        TK_BMERGE(ck); TK_BMERGE(g2);
#pragma unroll
        for (int j = 0; j < 16; ++j) ck[j] = max(ck[j], g2[15 - j]);
        TK_BMERGE(ck);
#undef TK_KEY
#undef TK_SORT16
#undef TK_BMERGE
#undef TK_CE
        float den = 0.f; float ex[16]; const float c0 = ord2f(ck[0] & ~255);
#pragma unroll
        for (int j = 0; j < 16; ++j) { ex[j] = __expf(ord2f(ck[j] & ~255) - c0); den += ex[j]; }
        const float inv = 1.0f / den;
        if (!c1) { int* ep = EIDX + (size_t)tok * 128 + (hc >> 1) * 16; float* gp = GATE + (size_t)tok * 128 + (hc >> 1) * 16;
#pragma unroll
            for (int q = 0; q < 4; ++q) { u32x4 ev; f32x4 gv;
#pragma unroll
                for (int j = 0; j < 4; ++j) { const int flat = 255 - (ck[4 * q + j] & 255); ev[j] = (unsigned)((int)tab[(flat >> 4) * 64 + lane] * 128 + (int)tab[(16 + (flat & 15)) * 64 + lane]); gv[j] = ex[4 * q + j] * inv; }
                *(u32x4*)(ep + 4 * q) = ev; *(f32x4*)(gp + 4 * q) = gv; } }
    }
}

struct PeerUMeta { int e_lo, e_hi; float g_lo, g_hi, xs; u32x4 xh0, xh1, xl0, xl1; };
__device__ __forceinline__ PeerUMeta peer_umeta_load(const unsigned char* XQ, const float* XS, const int* EIDX, const float* GATE, int tok, int lane) {
    PeerUMeta m; const unsigned char* xr = XQ + (size_t)tok * D + (lane & 15) * 16;
    m.e_lo = EIDX[(size_t)tok * 128 + lane]; m.e_hi = EIDX[(size_t)tok * 128 + 64 + lane]; m.g_lo = GATE[(size_t)tok * 128 + lane]; m.g_hi = GATE[(size_t)tok * 128 + 64 + lane]; m.xs = XS[tok];
    m.xh0 = *(const u32x4*)(xr); m.xh1 = *(const u32x4*)(xr + 256); m.xl0 = *(const u32x4*)(xr + 512); m.xl1 = *(const u32x4*)(xr + 768);
    return m;
}
template <int CTRL> __device__ __forceinline__ int dpp_movi(int v) { return __builtin_amdgcn_update_dpp(0, v, CTRL, 0xf, 0xf, false); }
__device__ __forceinline__ float gelu_tanh_fast(float h) { const float z = 0.7978845608028654f * (h + 0.044715f * h * h * h); const float t = 1.0f - 2.0f * __builtin_amdgcn_rcpf(__expf(2.0f * z) + 1.0f); return 0.5f * h * (1.0f + t); }
#define PU_IDS(I, E, kk) do { _Pragma("unroll") for (int a_ = 0; a_ < 4; ++a_) I[a_] = __builtin_amdgcn_ds_bpermute((g4 << 2) + (((kk) + 4 * a_) << 2), (E)); } while (0)
#define PU_LOAD(R, I) do { _Pragma("unroll") for (int a_ = 0; a_ < 4; ++a_) { const unsigned char* p_ = U4l + (size_t)I[a_] * 512; R[2 * a_] = *(const u32x4*)(p_); R[2 * a_ + 1] = *(const u32x4*)(p_ + 256); } \
        __builtin_amdgcn_sched_barrier(0); } while (0)
#define PU_COMP(R, M) do { int t_[4]; \
        _Pragma("unroll") for (int a_ = 0; a_ < 4; ++a_) { int h_ = 0, l_ = 0; \
            _Pragma("unroll") for (int w_ = 0; w_ < 4; ++w_) { h_ = __builtin_amdgcn_sdot8((int)R[2 * a_][w_], (int)cur.xh0[w_], h_, false); l_ = __builtin_amdgcn_sdot8((int)R[2 * a_][w_], (int)cur.xl0[w_], l_, false); \
                                                               h_ = __builtin_amdgcn_sdot8((int)R[2 * a_ + 1][w_], (int)cur.xh1[w_], h_, false); l_ = __builtin_amdgcn_sdot8((int)R[2 * a_ + 1][w_], (int)cur.xl1[w_], l_, false); } \
            int s_ = 16 * h_ + l_; s_ += dpp_movi<0x128>(s_); s_ += dpp_movi<0x124>(s_); s_ += dpp_movi<0x122>(s_); s_ += dpp_movi<0x121>(s_); t_[a_] = s_; } \
        M = (l16 & 2) ? ((l16 & 1) ? t_[3] : t_[2]) : ((l16 & 1) ? t_[1] : t_[0]); __builtin_amdgcn_sched_barrier(0); } while (0)
__device__ __forceinline__ void phase_peer_u(const Params& p, unsigned char* lds) {
    const int tid = tid_l(), lane = tid & 63, wave = tid >> 6, l16 = lane & 15, g4 = lane >> 4;
    const unsigned char* XQ = p.ws + WS_XQ; const float* XS = (const float*)(p.ws + WS_XS); const float* RS = (const float*)(p.ws + WS_RS); const float* VS = (const float*)(p.ws + WS_VS);
    const unsigned char* U4l = p.ws + WS_U + l16 * 16;
    const int* EIDX = (const int*)(p.ws + WS_EIDX); float* GATE = (float*)(p.ws + WS_GATE);
    const int stride = grid_l() * 8; int tok = __builtin_amdgcn_readfirstlane(bid_l() * 8 + wave);
    if (tok >= T) return;
    PeerUMeta cur = peer_umeta_load(XQ, XS, EIDX, GATE, tok, lane);
    u32x4 Ra[8], Rb[8]; int Ia[4], Ib[4];
    PU_IDS(Ia, cur.e_lo, 0); PU_LOAD(Ra, Ia); PU_IDS(Ib, cur.e_lo, 16);
    const int qd = ((((lane & 3) << 4) + ((lane >> 2) & 3)) << 2);
#pragma unroll 1
    for (; tok < T; tok += stride) {
        const PeerUMeta nxt = peer_umeta_load(XQ, XS, EIDX, GATE, tok + stride < T ? tok + stride : tok, lane);
        const float rs_lo = RS[cur.e_lo], rs_hi = RS[cur.e_hi], vs_lo = VS[cur.e_lo], vs_hi = VS[cur.e_hi];
        __builtin_amdgcn_sched_barrier(0);
        int m0, m1, m2, m3, m4, m5, m6, m7;
        PU_LOAD(Rb, Ib); PU_IDS(Ia, cur.e_lo, 32); PU_COMP(Ra, m0);
        PU_LOAD(Ra, Ia); PU_IDS(Ib, cur.e_lo, 48); PU_COMP(Rb, m1);
        PU_LOAD(Rb, Ib); PU_IDS(Ia, cur.e_hi, 0);  PU_COMP(Ra, m2);
        PU_LOAD(Ra, Ia); PU_IDS(Ib, cur.e_hi, 16); PU_COMP(Rb, m3);
        PU_LOAD(Rb, Ib); PU_IDS(Ia, cur.e_hi, 32); PU_COMP(Ra, m4);
        PU_LOAD(Ra, Ia); PU_IDS(Ib, cur.e_hi, 48); PU_COMP(Rb, m5);
        PU_LOAD(Rb, Ib); PU_IDS(Ia, nxt.e_lo, 0);  PU_COMP(Ra, m6);
        PU_LOAD(Ra, Ia); PU_IDS(Ib, nxt.e_lo, 16); PU_COMP(Rb, m7);
        const int d0 = __builtin_amdgcn_ds_bpermute(qd, m0), d1 = __builtin_amdgcn_ds_bpermute(qd, m1), d2 = __builtin_amdgcn_ds_bpermute(qd, m2), d3 = __builtin_amdgcn_ds_bpermute(qd, m3);
        const int d4 = __builtin_amdgcn_ds_bpermute(qd, m4), d5 = __builtin_amdgcn_ds_bpermute(qd, m5), d6 = __builtin_amdgcn_ds_bpermute(qd, m6), d7 = __builtin_amdgcn_ds_bpermute(qd, m7);
        const float c_lo = (float)((lane & 32) ? ((lane & 16) ? d3 : d2) : ((lane & 16) ? d1 : d0)), c_hi = (float)((lane & 32) ? ((lane & 16) ? d7 : d6) : ((lane & 16) ? d5 : d4));
        GATE[(size_t)tok * 128 + lane] = cur.g_lo * gelu_tanh_fast(c_lo * (rs_lo * cur.xs)) * vs_lo;
        GATE[(size_t)tok * 128 + 64 + lane] = cur.g_hi * gelu_tanh_fast(c_hi * (rs_hi * cur.xs)) * vs_hi;
        cur = nxt;
    }
}
#undef PU_IDS
#undef PU_LOAD
#undef PU_COMP
struct PeerVMeta { int e_lo, e_hi; float c_lo, c_hi; u32x4 x0, x1; };
__device__ __forceinline__ PeerVMeta peer_vmeta_load(const int* EIDX, const float* COEF, const bf16* XB, int tok, int lane) {
    PeerVMeta m;
    m.e_lo = EIDX[(size_t)tok * 128 + lane]; m.e_hi = EIDX[(size_t)tok * 128 + 64 + lane]; m.c_lo = COEF[(size_t)tok * 128 + lane]; m.c_hi = COEF[(size_t)tok * 128 + 64 + lane];
    const int xo = (lane & 31) * 32 + (lane >> 5) * 16;
    m.x0 = *(const u32x4*)(XB + (size_t)tok * D + xo); m.x1 = *(const u32x4*)(XB + (size_t)tok * D + xo + 8);
    return m;
}
#define PV_ISSUE(VR, CF, PE, PC, jj) do { _Pragma("unroll") for (int q = 0; q < 8; ++q) { const int a_ = hb + (((jj) + q) << 2); const int e_ = __builtin_amdgcn_ds_bpermute(a_, (int)(PE)); \
        CF[q] = __int_as_float(__builtin_amdgcn_ds_bpermute(a_, (int)(PC))); VR[q] = *(const u32x4*)(V4l + (size_t)e_ * 512); } __builtin_amdgcn_sched_barrier(0); } while (0)
#define PV_COMPUTE(VR, CF) do { _Pragma("unroll") for (int q = 0; q < 8; ++q) { const f32x2v c2 = (f32x2v){CF[q], CF[q]}; \
        _Pragma("unroll") for (int w = 0; w < 4; ++w) { \
            acc[4 * w] += __builtin_amdgcn_cvt_scalef32_pk_f32_fp4(VR[q][w], 1.0f, 0) * c2; acc[4 * w + 1] += __builtin_amdgcn_cvt_scalef32_pk_f32_fp4(VR[q][w], 1.0f, 1) * c2; \
            acc[4 * w + 2] += __builtin_amdgcn_cvt_scalef32_pk_f32_fp4(VR[q][w], 1.0f, 2) * c2; acc[4 * w + 3] += __builtin_amdgcn_cvt_scalef32_pk_f32_fp4(VR[q][w], 1.0f, 3) * c2; } } \
        __builtin_amdgcn_sched_barrier(0); } while (0)
__device__ __forceinline__ void phase_peer_v(const Params& p) {
    const int tid = tid_l(), lane = tid & 63, wave = tid >> 6;
    const unsigned char* V4l = p.ws + WS_V + (lane & 31) * 16;
    const int* EIDX = (const int*)(p.ws + WS_EIDX); const float* COEF = (const float*)(p.ws + WS_GATE);
    bf16* XB = (bf16*)(p.ws + WS_XB);
    const int hb = (lane & 32) << 2;
    const int xo = (lane & 31) * 32 + (lane >> 5) * 16;
    const int stride = grid_l() * 8; int tok = __builtin_amdgcn_readfirstlane(bid_l() * 8 + wave);
    if (tok >= T) return;
    PeerVMeta cur = peer_vmeta_load(EIDX, COEF, XB, tok, lane);
    auto se = __builtin_amdgcn_permlane32_swap((unsigned)cur.e_lo, (unsigned)cur.e_hi, false, false); auto sc_ = __builtin_amdgcn_permlane32_swap(__float_as_uint(cur.c_lo), __float_as_uint(cur.c_hi), false, false);
    u32x4 vrA[8], vrB[8]; float cfA[8], cfB[8];
    PV_ISSUE(vrA, cfA, se[0], sc_[0], 0);
#pragma unroll 1
    for (; tok < T; tok += stride) {
        const PeerVMeta nxt = peer_vmeta_load(EIDX, COEF, XB, tok + stride < T ? tok + stride : tok, lane);
        __builtin_amdgcn_sched_barrier(0);
        f32x2v acc[16];
#pragma unroll
        for (int i = 0; i < 16; ++i) acc[i] = (f32x2v){0.f, 0.f};
        PV_ISSUE(vrB, cfB, se[0], sc_[0], 8);  PV_COMPUTE(vrA, cfA);
        PV_ISSUE(vrA, cfA, se[0], sc_[0], 16); PV_COMPUTE(vrB, cfB);
        PV_ISSUE(vrB, cfB, se[0], sc_[0], 24); PV_COMPUTE(vrA, cfA);
        PV_ISSUE(vrA, cfA, se[1], sc_[1], 0);  PV_COMPUTE(vrB, cfB);
        PV_ISSUE(vrB, cfB, se[1], sc_[1], 8);  PV_COMPUTE(vrA, cfA);
        PV_ISSUE(vrA, cfA, se[1], sc_[1], 16); PV_COMPUTE(vrB, cfB);
        PV_ISSUE(vrB, cfB, se[1], sc_[1], 24); PV_COMPUTE(vrA, cfA);
        se = __builtin_amdgcn_permlane32_swap((unsigned)nxt.e_lo, (unsigned)nxt.e_hi, false, false); sc_ = __builtin_amdgcn_permlane32_swap(__float_as_uint(nxt.c_lo), __float_as_uint(nxt.c_hi), false, false);
        PV_ISSUE(vrA, cfA, se[0], sc_[0], 0);  PV_COMPUTE(vrB, cfB);
        float sres[16];
#pragma unroll
        for (int i = 0; i < 8; ++i)
#pragma unroll
            for (int c = 0; c < 2; ++c) { const auto r_ = __builtin_amdgcn_permlane32_swap(__float_as_uint(acc[i][c]), __float_as_uint(acc[8 + i][c]), false, false);
                sres[2 * i + c] = __uint_as_float(r_[0]) + __uint_as_float(r_[1]); }
        float r[16];
#pragma unroll
        for (int i = 0; i < 4; ++i) { r[2 * i] = ALPHA * bf2f(cur.x0[i] & 0xffffu) + sres[2 * i]; r[2 * i + 1] = ALPHA * __uint_as_float(cur.x0[i] & 0xffff0000u) + sres[2 * i + 1];
                                      r[8 + 2 * i] = ALPHA * bf2f(cur.x1[i] & 0xffffu) + sres[8 + 2 * i]; r[8 + 2 * i + 1] = ALPHA * __uint_as_float(cur.x1[i] & 0xffff0000u) + sres[8 + 2 * i + 1]; }
#pragma unroll
        for (int w = 0; w < 2; ++w) { u32x4 o; o.x = pk2(r[8 * w], r[8 * w + 1]); o.y = pk2(r[8 * w + 2], r[8 * w + 3]); o.z = pk2(r[8 * w + 4], r[8 * w + 5]); o.w = pk2(r[8 * w + 6], r[8 * w + 7]);
            *(u32x4*)(XB + (size_t)tok * D + xo + 8 * w) = o; }
        cur = nxt;
    }
}
#undef PV_ISSUE
#undef PV_COMPUTE
#define GAS __attribute__((address_space(1)))
#define LAS __attribute__((address_space(3)))
#define XB_TMO      128
#define XB_XCNT(j)  (256  + 64 * (j))
#define XB_XSUB(j)  (1280 + 64 * (j))
#define XB_XGEN(j)  (2304 + 64 * (j))
#define XB_TOP      3328
#define XB_TOPGEN   3392
#define XCD_BAR_WORDS 3456
#define XB_SPIN_CAP (1u << 18)

__device__ __forceinline__ unsigned xb_ld(unsigned* p)              { return __hip_atomic_load(p, __ATOMIC_RELAXED, __HIP_MEMORY_SCOPE_AGENT); }
__device__ __forceinline__ unsigned xb_add(unsigned* p, unsigned v) { return __hip_atomic_fetch_add(p, v, __ATOMIC_RELAXED, __HIP_MEMORY_SCOPE_AGENT); }
__device__ __forceinline__ unsigned xb_xcc_id() { return (unsigned)__builtin_amdgcn_s_getreg((3 << 11) | 20) & 0xFu; }
#define XB_SPIN(cond, bar) do { unsigned _sp = 0; while (cond) { __builtin_amdgcn_s_sleep(1); \
    if ((++_sp & 255u) == 0u) { if (xb_ld(&(bar)[XB_TMO])) break; if (_sp > XB_SPIN_CAP) { atomicAdd(&(bar)[XB_TMO], 1u); break; } } } } while (0)

struct XcdBarrier {
    unsigned* bar; unsigned x;
    volatile LAS unsigned* st;
};

__device__ __forceinline__ XcdBarrier xcd_barrier_post(unsigned* bar, volatile LAS unsigned* st) {
    XcdBarrier b; b.bar = bar; b.x = xb_xcc_id(); b.st = st;
    if (threadIdx.x == 0) (void)xb_add(&bar[XB_XCNT(b.x)], 1u);
    return b;
}
__device__ __forceinline__ void xcd_barrier_complete(unsigned* bar, unsigned x, unsigned& nloc, unsigned& nx) {
    const unsigned G = gridDim.x * gridDim.y * gridDim.z;
    unsigned sum, cnt, mine, sp = 0u;
    for (;;) {
        sum = 0u; cnt = 0u; mine = 0u;
#pragma unroll
        for (unsigned j = 0; j < 16; ++j) { const unsigned c = xb_ld(&bar[XB_XCNT(j)]); sum += c; cnt += (c > 0u) ? 1u : 0u; mine = (j == x) ? c : mine; }
        if (sum == G) break;
        __builtin_amdgcn_s_sleep(1);
        if ((++sp & 255u) == 0u) { if (xb_ld(&bar[XB_TMO])) break; if (sp > XB_SPIN_CAP) { atomicAdd(&bar[XB_TMO], 1u); break; } }
    }
    nloc = mine > 0u ? mine : 1u; nx = cnt > 0u ? cnt : 1u;
}

__device__ __forceinline__ void xcd_barrier(const XcdBarrier& b) {
    asm volatile("s_waitcnt vmcnt(0)" ::: "memory");
    __syncthreads();
    if (threadIdx.x == 0) {
        unsigned* bar = b.bar;
        __builtin_amdgcn_s_waitcnt(0);
        unsigned nloc = b.st[0], nx = b.st[1];
        if (nloc == 0u) { xcd_barrier_complete(bar, b.x, nloc, nx); b.st[0] = nloc; b.st[1] = nx; }
        const unsigned old = xb_add(&bar[XB_XSUB(b.x)], 1u);
        const unsigned gen = old / nloc;
        if (old + 1u == (gen + 1u) * nloc) {
            __builtin_amdgcn_fence(__ATOMIC_RELEASE, "agent");
            asm volatile("s_waitcnt vmcnt(0)" ::: "memory");
            const unsigned og = xb_add(&bar[XB_TOP], 1u);
            const unsigned tg = og / nx;
            if (og + 1u == (tg + 1u) * nx) xb_add(&bar[XB_TOPGEN], 1u);
            else XB_SPIN(xb_ld(&bar[XB_TOPGEN]) == tg, bar);
            __builtin_amdgcn_fence(__ATOMIC_ACQUIRE, "agent");
            xb_add(&bar[XB_XGEN(b.x)], 1u);
            asm volatile("s_waitcnt vmcnt(0)" ::: "memory");
        } else {
            XB_SPIN(xb_ld(&bar[XB_XGEN(b.x)]) == gen, bar);
            __builtin_amdgcn_fence(__ATOMIC_ACQUIRE, "agent");
            asm volatile("s_waitcnt vmcnt(0)" ::: "memory");
        }
    }
    __syncthreads();
}
enum { PH_PRO_A, PH_PRO_B, PH_CVT, PH_GEMM_IN, PH_GEMM_E, PH_CONV, PH_FOXCUM, PH_FOXNORM, PH_GLA1, PH_GLA2, PH_GLA3, PH_FOX, PH_GEMM_OUT, PH_LN1, PH_GEMM_SC, PH_TOPK, PH_PEERU, PH_PEERV, PH_GEMM_PLE, PH_LN2, PH_COUNT };

template <int PH> __device__ __forceinline__ void run_phase(const Params& p, int l, unsigned char* lds) {
    if constexpr (PH == PH_PRO_A) phase_pro_a(p, lds);
    else if constexpr (PH == PH_PRO_B) phase_pro_b(p, lds);
    else if constexpr (PH == PH_CVT) phase_cvt(p, l);
    else if constexpr (PH == PH_GEMM_IN) phase_gemm_in(p, l, lds);
    else if constexpr (PH == PH_GEMM_E) phase_gemm_e(p, l, lds);
    else if constexpr (PH == PH_CONV) phase_conv(p, l, lds);
    else if constexpr (PH == PH_FOXCUM) phase_fox_cum(p, l, lds);
    else if constexpr (PH == PH_FOXNORM) phase_fox_norm(p, lds);
    else if constexpr (PH == PH_GLA1) phase_gla_b1(p, l, lds);
    else if constexpr (PH == PH_GLA2) phase_gla_b2(p);
    else if constexpr (PH == PH_GLA3) phase_gla_b3(p, l, lds);
    else if constexpr (PH == PH_FOX) phase_fox_mfma(p, l, lds);
    else if constexpr (PH == PH_GEMM_OUT) phase_gemm_out(p, l, lds);
    else if constexpr (PH == PH_LN1) phase_ln((const _Float16*)(p.ws + WS_Y), p.ln1_g + (size_t)l * D, p.ln1_b + (size_t)l * D, nullptr, (bf16*)(p.ws + WS_XB), p.ws + WS_XQ, (float*)(p.ws + WS_XS));
    else if constexpr (PH == PH_GEMM_SC) phase_gemm_sc(p, l, lds);
    else if constexpr (PH == PH_TOPK) phase_topk(p, lds);
    else if constexpr (PH == PH_PEERU) phase_peer_u(p, lds);
    else if constexpr (PH == PH_PEERV) phase_peer_v(p);
    else if constexpr (PH == PH_GEMM_PLE) phase_gemm_ple(p, l, lds);
    else if constexpr (PH == PH_LN2) phase_ln((const _Float16*)(p.ws + WS_Y), p.ln2_g + (size_t)l * D, p.ln2_b + (size_t)l * D, l == DEPTH - 1 ? p.out : nullptr, l == DEPTH - 1 ? nullptr : (bf16*)(p.ws + WS_XB));
}

constexpr int MISC_OFF = LDS_BYTES - 512;
constexpr int CW_BAR = 4096;
static_assert(MISC_OFF + 128 <= LDS_BYTES && (CW_BAR + XCD_BAR_WORDS) * 4 <= (int)CTL_ZERO_BYTES, "control words");

typedef __attribute__((address_space(4))) const Params CParams;
#define PHASE(PH) do { CParams* q_ = pp; asm volatile("" : "+s"(q_)); Params lp_; __builtin_memcpy(&lp_, q_, sizeof(Params)); run_phase<PH>(lp_, l, lds); } while (0)
__global__ void __launch_bounds__(512, 2) mk_fwd(Params p_unused) {
#if defined(__HIP_DEVICE_COMPILE__)
    extern __shared__ __attribute__((aligned(16))) unsigned char lds[];
    CParams* pp = (CParams*)__builtin_amdgcn_kernarg_segment_ptr();
    unsigned char* ws0; { CParams* q_ = pp; asm volatile("" : "+s"(q_)); ws0 = q_->ws; }
    volatile LAS unsigned* MISC = (volatile LAS unsigned*)((LAS unsigned char*)lds + MISC_OFF);
    if (threadIdx.x < 32) MISC[threadIdx.x] = 0u;
    __syncthreads();
    (void)xcd_barrier_post((unsigned*)(ws0 + WS_CTL) + CW_BAR, MISC + 8);
#define GB() do { CParams* qb_ = pp; asm volatile("" : "+s"(qb_)); XcdBarrier b_; b_.bar = (unsigned*)(qb_->ws + WS_CTL) + CW_BAR; b_.x = xb_xcc_id(); b_.st = MISC + 8; xcd_barrier(b_); } while (0)
    { const int l = 0; PHASE(PH_PRO_A); PHASE(PH_PRO_B); } GB();
    for (int l = 0; l < DEPTH; ++l) {
        PHASE(PH_CVT); PHASE(PH_GEMM_IN); GB();
        PHASE(PH_GEMM_E); PHASE(PH_CONV); PHASE(PH_FOXCUM); PHASE(PH_FOXNORM); PHASE(PH_GLA1); GB();
        PHASE(PH_GLA2); PHASE(PH_FOX); GB();
        PHASE(PH_GLA3); GB();
        PHASE(PH_GEMM_OUT); GB();
        PHASE(PH_LN1); GB();
        PHASE(PH_GEMM_SC); GB();
        PHASE(PH_TOPK); GB();
        PHASE(PH_PEERU); GB();
        PHASE(PH_PEERV); GB();
        PHASE(PH_GEMM_PLE); GB();
        PHASE(PH_LN2); GB();
    }
#undef GB
#endif
}

extern "C" void kernel_launch(void* const* d_in, const int* in_sizes, int n_in, void* d_out, int out_size, void* d_ws, size_t ws_size, hipStream_t stream) {
    static int grid = 0;
    if (grid == 0) {
        if (n_in != 23 || ws_size < WS_END) { fprintf(stderr, "kernel_launch: unexpected n_in %d or ws_size %zu\n", n_in, ws_size); grid = -1; return; }
        int dev = 0, cus = 0, per_cu = 0;
        if (hipGetDevice(&dev) != hipSuccess || hipDeviceGetAttribute(&cus, hipDeviceAttributeMultiprocessorCount, dev) != hipSuccess) { grid = -1; return; }
        if (hipFuncSetAttribute((const void*)mk_fwd, hipFuncAttributeMaxDynamicSharedMemorySize, LDS_BYTES) != hipSuccess) { grid = -1; return; }
        if (hipOccupancyMaxActiveBlocksPerMultiprocessor(&per_cu, (const void*)mk_fwd, 512, LDS_BYTES) != hipSuccess || per_cu < 1) { fprintf(stderr, "kernel_launch: occupancy query says %d\n", per_cu); }
        (void)hipGetLastError();
        grid = cus;
    }
    if (grid < 0) return;
    if (hipMemsetAsync((char*)d_ws + WS_CTL, 0, CTL_ZERO_BYTES, stream) != hipSuccess) return;
    Params p; memset(&p, 0, sizeof(p));
    const float** f = (const float**)&p;
    for (int i = 0; i < 23; ++i) f[i] = (const float*)d_in[i];
    p.out = (float*)d_out; p.ws = (unsigned char*)d_ws;
    hipLaunchKernelGGL(mk_fwd, dim3(grid), dim3(512), LDS_BYTES, stream, p);
}
```
